# Optimizing an MI355X kernel written in HIP

```python
import math
import jax, jax.numpy as jnp
from jax import lax
import numpy as np

D_MODEL = 2048
BATCH = 4
SEQ = 2048
DEPTH = 1

N_Q_HEADS = 32
N_KV_HEADS = 4
HEAD_DIM = 64
Q_PER_KV = N_Q_HEADS // N_KV_HEADS
WINDOW = 128
BLOCK = 128
ATTN_WIDTH = N_Q_HEADS * HEAD_DIM
KV_WIDTH = N_KV_HEADS * HEAD_DIM

CONV_WIDTH = D_MODEL
CONV_K = 3

N_BRANCHES = 2

Q_OFF = 0
K_OFF = Q_OFF + ATTN_WIDTH
V_OFF = K_OFF + KV_WIDTH
CB_OFF = V_OFF + KV_WIDTH
CC_OFF = CB_OFF + CONV_WIDTH
CH_OFF = CC_OFF + CONV_WIDTH
G_OFF = CH_OFF + CONV_WIDTH
IN_WIDTH = G_OFF + N_BRANCHES * D_MODEL

PEER_HEADS = 8
PEER_N_KEYS = 128
PEER_N_EXPERTS = PEER_N_KEYS * PEER_N_KEYS
PEER_TOPK = 16
PEER_QDIM = 256
PEER_HALF = PEER_QDIM // 2
PEER_CHUNK = 128

LN_EPS = 1e-5
ALPHA = (2.0 * DEPTH) ** 0.25
BETA = (8.0 * DEPTH) ** -0.25

kernel_name = "hybrid_swa_sink_shortconv_peer_deepnorm"


def layer_norm(x, g, b):
    xf = x.astype(jnp.float32)
    mu = jnp.mean(xf, axis=-1, keepdims=True)
    var = jnp.mean(jnp.square(xf - mu), axis=-1, keepdims=True)
    y = (xf - mu) * lax.rsqrt(var + LN_EPS) * g.astype(jnp.float32) + b.astype(jnp.float32)
    return y.astype(x.dtype)


def sliding_window_sink_attention(q, k, v, sinks):
    b_, s_ = q.shape[0], q.shape[1]
    nb = s_ // BLOCK
    qb = q.reshape(b_, nb, BLOCK, N_KV_HEADS, Q_PER_KV, HEAD_DIM)
    kb = k.reshape(b_, nb, BLOCK, N_KV_HEADS, HEAD_DIM)
    vb = v.reshape(b_, nb, BLOCK, N_KV_HEADS, HEAD_DIM)

    def with_prev(t):
        prev = jnp.pad(t, ((0, 0), (1, 0), (0, 0), (0, 0), (0, 0)))[:, :-1]
        return jnp.concatenate([prev, t], axis=2)

    kw = with_prev(kb)
    vw = with_prev(vb)
    scores = jnp.einsum('bnqhgd,bnkhd->bnhgqk', qb, kw).astype(jnp.float32) * (HEAD_DIM ** -0.5)

    qi = jnp.arange(BLOCK)[:, None]
    kj = jnp.arange(2 * BLOCK)[None, :]
    rel = BLOCK + qi - kj
    band = (rel >= 0) & (rel < WINDOW)
    kpos = jnp.arange(nb)[:, None] * BLOCK - BLOCK + kj
    mask = band[None] & (kpos >= 0)[:, None, :]
    scores = jnp.where(mask[None, :, None, None], scores, -jnp.inf)

    sink = sinks.astype(jnp.float32).reshape(N_KV_HEADS, Q_PER_KV)[None, None, :, :, None, None]
    m = jnp.maximum(jnp.max(scores, axis=-1, keepdims=True), sink)
    p = jnp.exp(scores - m)
    denom = jnp.sum(p, axis=-1, keepdims=True) + jnp.exp(sink - m)
    probs = (p / denom).astype(v.dtype)
    out = jnp.einsum('bnhgqk,bnkhd->bnqhgd', probs, vw)
    return out.reshape(b_, s_, ATTN_WIDTH)


def causal_short_conv(u, w):
    return lax.conv_general_dilated(
        u, w[:, None, :].astype(u.dtype), window_strides=(1,), padding=[(CONV_K - 1, 0)],
        dimension_numbers=('NWC', 'WIO', 'NWC'), feature_group_count=u.shape[-1])


def peer_ffn(x, w_q, sub_keys, u_tab, v_tab):
    b_, s_, d_ = x.shape
    t_ = b_ * s_
    xt = x.reshape(t_, d_)
    q = (xt @ w_q).reshape(t_, PEER_HEADS, 2, PEER_HALF)
    s = jnp.einsum('thpc,hpnc->thpn', q, sub_keys).astype(jnp.float32)
    top_s, top_i = lax.top_k(s, PEER_TOPK)
    cand_s = top_s[:, :, 0, :, None] + top_s[:, :, 1, None, :]
    cand_i = top_i[:, :, 0, :, None] * PEER_N_KEYS + top_i[:, :, 1, None, :]
    cand_s = cand_s.reshape(t_, PEER_HEADS, PEER_TOPK * PEER_TOPK)
    cand_i = cand_i.reshape(t_, PEER_HEADS, PEER_TOPK * PEER_TOPK)
    best_s, best_pos = lax.top_k(cand_s, PEER_TOPK)
    expert = jnp.take_along_axis(cand_i, best_pos, axis=-1)
    gate = jax.nn.softmax(best_s, axis=-1)

    nc = t_ // PEER_CHUNK

    def per_block(args):
        xc, ec, gc = args
        u = jnp.take(u_tab, ec, axis=0)
        act = jax.nn.gelu(jnp.einsum('cd,chkd->chk', xc, u).astype(jnp.float32), approximate=False)
        wgt = (gc * act).astype(xc.dtype)
        v = jnp.take(v_tab, ec, axis=0)
        return jnp.einsum('chk,chkd->cd', wgt, v)

    y = lax.map(per_block, (xt.reshape(nc, PEER_CHUNK, d_),
                            expert.reshape(nc, PEER_CHUNK, PEER_HEADS, PEER_TOPK),
                            gate.reshape(nc, PEER_CHUNK, PEER_HEADS, PEER_TOPK)))
    return y.reshape(b_, s_, d_)


def setup_inputs(seed: int = 0) -> dict:
    key = jax.random.key(seed)
    ks = jax.random.split(key, 17)
    f32 = jnp.float32
    nrm = lambda k, shape, scale: jax.random.normal(k, shape, f32) * scale
    x = jax.random.normal(ks[0], (BATCH, SEQ, D_MODEL), f32)
    w_in = nrm(ks[1], (DEPTH, D_MODEL, IN_WIDTH), D_MODEL ** -0.5)
    b_gate = nrm(ks[2], (DEPTH, N_BRANCHES * D_MODEL), 0.02)
    sinks = nrm(ks[3], (DEPTH, N_Q_HEADS), 0.5)
    conv_w = nrm(ks[4], (DEPTH, CONV_K, CONV_WIDTH), CONV_K ** -0.5)
    w_attn_out = nrm(ks[5], (DEPTH, ATTN_WIDTH, D_MODEL), ATTN_WIDTH ** -0.5)
    w_conv_out = nrm(ks[6], (DEPTH, CONV_WIDTH, D_MODEL), CONV_WIDTH ** -0.5)
    w_o = nrm(ks[7], (DEPTH, D_MODEL, D_MODEL), BETA * D_MODEL ** -0.5)
    ln1_g = 1.0 + nrm(ks[8], (DEPTH, D_MODEL), 0.02)
    ln1_b = nrm(ks[9], (DEPTH, D_MODEL), 0.02)
    peer_w_q = nrm(ks[10], (DEPTH, D_MODEL, PEER_HEADS * PEER_QDIM), D_MODEL ** -0.5)
    peer_sub_keys = nrm(ks[11], (DEPTH, PEER_HEADS, 2, PEER_N_KEYS, PEER_HALF), PEER_HALF ** -0.5)
    peer_u = nrm(ks[12], (DEPTH, PEER_N_EXPERTS, D_MODEL), D_MODEL ** -0.5)
    peer_v = nrm(ks[13], (DEPTH, PEER_N_EXPERTS, D_MODEL), BETA)
    ln2_g = 1.0 + nrm(ks[14], (DEPTH, D_MODEL), 0.02)
    ln2_b = nrm(ks[15], (DEPTH, D_MODEL), 0.02)
    return {"x": x, "w_in": w_in, "b_gate": b_gate, "sinks": sinks, "conv_w": conv_w,
            "w_attn_out": w_attn_out, "w_conv_out": w_conv_out, "w_o": w_o,
            "ln1_g": ln1_g, "ln1_b": ln1_b, "peer_w_q": peer_w_q, "peer_sub_keys": peer_sub_keys,
            "peer_u": peer_u, "peer_v": peer_v, "ln2_g": ln2_g, "ln2_b": ln2_b}


def reference(x, w_in, b_gate, sinks, conv_w, w_attn_out, w_conv_out, w_o, ln1_g, ln1_b,
              peer_w_q, peer_sub_keys, peer_u, peer_v, ln2_g, ln2_b):
    b_, s_ = x.shape[0], x.shape[1]
    h = x
    for l in range(DEPTH):
        z = h @ w_in[l]
        q = z[..., Q_OFF:K_OFF].reshape(b_, s_, N_Q_HEADS, HEAD_DIM)
        k = z[..., K_OFF:V_OFF].reshape(b_, s_, N_KV_HEADS, HEAD_DIM)
        v = z[..., V_OFF:CB_OFF].reshape(b_, s_, N_KV_HEADS, HEAD_DIM)
        cb = z[..., CB_OFF:CC_OFF]
        cc = z[..., CC_OFF:CH_OFF]
        ch = z[..., CH_OFF:G_OFF]
        gates = jax.nn.sigmoid((z[..., G_OFF:] + b_gate[l]).astype(jnp.float32)).astype(h.dtype)

        attn = sliding_window_sink_attention(q, k, v, sinks[l]) @ w_attn_out[l]
        conv = (cb * causal_short_conv(cc * ch, conv_w[l])) @ w_conv_out[l]
        merged = gates[..., :D_MODEL] * attn + gates[..., D_MODEL:] * conv
        mixed = merged @ w_o[l]
        h = layer_norm(ALPHA * h + mixed, ln1_g[l], ln1_b[l])

        ffn = peer_ffn(h, peer_w_q[l], peer_sub_keys[l], peer_u[l], peer_v[l])
        h = layer_norm(ALPHA * h + ffn, ln2_g[l], ln2_b[l])
    return h
```

```cpp
#include <hip/hip_runtime.h>
#include <cstdio>
#include <cstdint>
namespace pg8 {
#define PG8_LAS __attribute__((address_space(3)))
typedef unsigned short bf16_t;
typedef short bf16x8 __attribute__((ext_vector_type(8)));
typedef float f32x4 __attribute__((ext_vector_type(4)));
typedef unsigned u32x4 __attribute__((ext_vector_type(4)));
constexpr int BM = 256, BK = 64, HALF = 128, HTB = HALF * BK * 2  , STAGE_BYTES = 8 * HTB, NXCD = 8, WGM = 8;

__host__ __device__ __forceinline__ int lds_byte(int r, int c) { const int st = (r >> 4) * 2 + (c >> 5), rr = r & 15, cc = c & 31, ob = rr * 64 + cc * 2; return st * 1024 + (ob ^ (((ob >> 9) & 1) << 5)); }
__host__ __device__ __forceinline__ void stage_rc(int b, int& R, int& C) { const int st = b / 1024, sb = b % 1024, swz = sb ^ (((sb >> 9) & 1) << 5); R = (st >> 1) * 16 + swz / 64; C = (st & 1) * 32 + (swz % 64) / 2; }
__host__ __device__ __forceinline__ int perm32(int rho) { const int n = rho >> 4, i = rho & 15; return 8 * (i >> 2) + 4 * n + (i & 3); }

struct Unit { int pm, pn; };
struct Gemm { const bf16_t* A; const bf16_t* Bt; int M, N, K; };

struct StaticOrder {
    int nM, nN, nwg, G, c;
    __host__ __device__ void init(int M, int N, int G_, int c_) { nM = M / BM; nN = N / BM; nwg = nM * nN; G = G_; c = c_; }
    __host__ __device__ bool next(int i, Unit& u) const {
        const long L = (long)i * G + c; if (L >= nwg) return false;
        int wgid = (int)L; { const int q = nwg / NXCD, r = nwg % NXCD, xcd = wgid % NXCD, off = wgid / NXCD; wgid = (xcd < r ? xcd * (q + 1) : r * (q + 1) + (xcd - r) * q) + off; }
        const int nig = WGM * nN, gid = wgid / nig, fm = gid * WGM, gsz = (nM - fm) < WGM ? (nM - fm) : WGM;
        u.pm = fm + ((wgid % nig) % gsz); u.pn = (wgid % nig) / gsz; return true;
    }
    __device__ __forceinline__ void a_ready(const Unit&) const {}
    __device__ __forceinline__ void done(const Unit&) const {}
};


__device__ __forceinline__ unsigned cvt_pk_bf16(float lo, float hi) { unsigned r; asm volatile("v_cvt_pk_bf16_f32 %0, %1, %2" : "=v"(r) : "v"(lo), "v"(hi)); return r; }
__device__ __forceinline__ float bf_lo(unsigned w) { return __builtin_bit_cast(float, w << 16); }
__device__ __forceinline__ float bf_hi(unsigned w) { return __builtin_bit_cast(float, w & 0xffff0000u); }
__device__ __forceinline__ float sigmoidf_(float x) { return __builtin_amdgcn_rcpf(1.0f + __expf(-x)); }

struct EpiBf16 {
    static constexpr bool PERM = true, AFTER_DRAIN = false;
    bf16_t* O; int ldc;
    __device__ __forceinline__ void operator()(const f32x4 (&acc)[2][2][4][2], const Unit& u, int wr, int wc, int fr, int fq) const {
        const int row0 = u.pm * BM + wr * 64 + fr, col0 = u.pn * BM + wc * 32 + 8 * fq;
#pragma unroll
        for (int ai = 0; ai < 2; ++ai)
#pragma unroll
            for (int m = 0; m < 4; ++m) { bf16_t* rowp = O + (size_t)(row0 + ai * HALF + m * 16) * ldc + col0;
#pragma unroll
                for (int bj = 0; bj < 2; ++bj) { const f32x4 v0 = acc[ai][bj][m][0], v1 = acc[ai][bj][m][1];
                    u32x4 w; w.x = cvt_pk_bf16(v0[0], v0[1]); w.y = cvt_pk_bf16(v0[2], v0[3]); w.z = cvt_pk_bf16(v1[0], v1[1]); w.w = cvt_pk_bf16(v1[2], v1[3]);
                    *(u32x4*)(rowp + bj * HALF) = w; } }
    }
};
template <int SECOND> struct EpiGate {
    static constexpr bool PERM = true, AFTER_DRAIN = false;
    bf16_t* O; const bf16_t* T; const bf16_t* Zg; const float* bg; int ldc, ldz;
    __device__ __forceinline__ void operator()(const f32x4 (&acc)[2][2][4][2], const Unit& u, int wr, int wc, int fr, int fq) const {
        const int row0 = u.pm * BM + wr * 64 + fr, col0 = u.pn * BM + wc * 32 + 8 * fq;
        f32x4 bv[2][2];
#pragma unroll
        for (int bj = 0; bj < 2; ++bj)
#pragma unroll
            for (int n = 0; n < 2; ++n) bv[bj][n] = *(const f32x4*)(bg + col0 + bj * HALF + 4 * n);
#pragma unroll
        for (int ai = 0; ai < 2; ++ai)
#pragma unroll
            for (int m = 0; m < 4; ++m) { const size_t row = (size_t)(row0 + ai * HALF + m * 16);
#pragma unroll
                for (int bj = 0; bj < 2; ++bj) { const int c = col0 + bj * HALF;
                    const u32x4 zg = *(const u32x4*)(Zg + row * ldz + c);
                    f32x4 v0 = acc[ai][bj][m][0], v1 = acc[ai][bj][m][1];
                    v0[0] *= sigmoidf_(bf_lo(zg.x) + bv[bj][0][0]); v0[1] *= sigmoidf_(bf_hi(zg.x) + bv[bj][0][1]);
                    v0[2] *= sigmoidf_(bf_lo(zg.y) + bv[bj][0][2]); v0[3] *= sigmoidf_(bf_hi(zg.y) + bv[bj][0][3]);
                    v1[0] *= sigmoidf_(bf_lo(zg.z) + bv[bj][1][0]); v1[1] *= sigmoidf_(bf_hi(zg.z) + bv[bj][1][1]);
                    v1[2] *= sigmoidf_(bf_lo(zg.w) + bv[bj][1][2]); v1[3] *= sigmoidf_(bf_hi(zg.w) + bv[bj][1][3]);
                    if (SECOND) { const u32x4 t = *(const u32x4*)(T + row * ldc + c);
                        v0[0] += bf_lo(t.x); v0[1] += bf_hi(t.x); v0[2] += bf_lo(t.y); v0[3] += bf_hi(t.y);
                        v1[0] += bf_lo(t.z); v1[1] += bf_hi(t.z); v1[2] += bf_lo(t.w); v1[3] += bf_hi(t.w); }
                    u32x4 w; w.x = cvt_pk_bf16(v0[0], v0[1]); w.y = cvt_pk_bf16(v0[2], v0[3]); w.z = cvt_pk_bf16(v1[0], v1[1]); w.w = cvt_pk_bf16(v1[2], v1[3]);
                    *(u32x4*)(O + row * ldc + c) = w; } }
    }
};
struct EpiF32 {
    static constexpr bool PERM = false, AFTER_DRAIN = false;
    float* C; int ldc; const float* R; float scale;
    __device__ __forceinline__ void operator()(const f32x4 (&acc)[2][2][4][2], const Unit& u, int wr, int wc, int fr, int fq) const {
        const int row0 = u.pm * BM + wr * 64 + fr, col0 = u.pn * BM + wc * 32 + 4 * fq;
#pragma unroll
        for (int ai = 0; ai < 2; ++ai)
#pragma unroll
            for (int m = 0; m < 4; ++m) { const size_t off = (size_t)(row0 + ai * HALF + m * 16) * ldc + col0;
#pragma unroll
                for (int bj = 0; bj < 2; ++bj)
#pragma unroll
                    for (int n = 0; n < 2; ++n) { f32x4 v = acc[ai][bj][m][n];
                        if (R) v += *(const f32x4*)(R + off + bj * HALF + n * 16) * scale;
                        *(f32x4*)(C + off + bj * HALF + n * 16) = v; } }
    }
};

template <class Epi, class Sched, bool ALIGN_EPI = false, bool SP2 = false>
__device__ __forceinline__ void gemm_phase(PG8_LAS unsigned char* lds, const Gemm g, const Sched& S, const Epi& E) {
    int tid_ = threadIdx.x; asm volatile("" : "+v"(tid_));
    const int tid = tid_, wid = __builtin_amdgcn_readfirstlane(tid >> 6), lane = tid & 63, wr = wid >> 2, wc = wid & 3, fr = lane & 15, fq = lane >> 4;
    const int K = g.K, nt = K / BK;
    unsigned voffA[2], voffB[2];
#pragma unroll
    for (int i = 0; i < 2; ++i) { int R, C; stage_rc(tid * 16 + i * 8192, R, C); const int Rb = Epi::PERM ? ((R & ~31) + perm32(R & 31)) : R;
        voffA[i] = (unsigned)(R * K + C) * 2u; voffB[i] = (unsigned)(Rb * K + C) * 2u; }
    const size_t kstep = (size_t)(BK * 2);
    const size_t hstep = (size_t)HALF * K * 2;
    const size_t tstep = 2 * hstep;
    const unsigned ldsw = (unsigned)wid * 1024u;
    const int aoff = lds_byte(wr * 64 + fr, fq * 8), boff = lds_byte(wc * 32 + fr, fq * 8);
#define PG8_SA(b, h) (((b) * 2 + (h)) * HTB)
#define PG8_SB(b, h) ((4 + (b) * 2 + (h)) * HTB)
#define PG8_STAGE(bufoff, gbase, voff) do { _Pragma("unroll") for (int _i = 0; _i < 2; ++_i) \
        __builtin_amdgcn_global_load_lds((const unsigned*)((const char*)(gbase) + (voff)[_i]), (PG8_LAS unsigned*)(lds + (bufoff) + ldsw + _i * 8192), 16, 0, 0); } while (0)
#define PG8_LDA(dst, b, h) do { _Pragma("unroll") for (int m = 0; m < 4; ++m) _Pragma("unroll") for (int k = 0; k < 2; ++k) dst[m][k] = *(const PG8_LAS bf16x8*)(lds + PG8_SA(b, h) + aoff + m * 2048 + k * 1024); } while (0)
#define PG8_LDB(dst, b, h) do { _Pragma("unroll") for (int n = 0; n < 2; ++n) _Pragma("unroll") for (int k = 0; k < 2; ++k) dst[n][k] = *(const PG8_LAS bf16x8*)(lds + PG8_SB(b, h) + boff + n * 2048 + k * 1024); } while (0)
#define PG8_MMA(ai, bj, At, Bt) do { __builtin_amdgcn_s_setprio(1); _Pragma("unroll") for (int m = 0; m < 4; ++m) _Pragma("unroll") for (int n = 0; n < 2; ++n) _Pragma("unroll") for (int k = 0; k < 2; ++k) \
        acc[ai][bj][m][n] = __builtin_amdgcn_mfma_f32_16x16x32_bf16(Bt[n][k], At[m][k], acc[ai][bj][m][n], 0, 0, 0); __builtin_amdgcn_s_setprio(0); } while (0)
#define PG8_WAIT_V(n) asm volatile("s_waitcnt vmcnt(" #n ")" ::: "memory")
#define PG8_WAIT_L(n) asm volatile("s_waitcnt lgkmcnt(" #n ")" ::: "memory")
#define PG8_BAR __builtin_amdgcn_s_barrier()
#define PG8_SCHED __builtin_amdgcn_sched_barrier(0)
    Unit cur, nxt; int ui = 0;
    if (!S.next(0, cur)) return;
    f32x4 acc[2][2][4][2];
#pragma unroll
    for (int a = 0; a < 2; ++a)
#pragma unroll
        for (int b = 0; b < 2; ++b)
#pragma unroll
            for (int m = 0; m < 4; ++m)
#pragma unroll
                for (int n = 0; n < 2; ++n) acc[a][b][m][n] = (f32x4){0.f, 0.f, 0.f, 0.f};
    bf16x8 At[4][2], B0[2][2], B1[2][2];
    const char* cA = (const char*)g.A + (size_t)cur.pm * tstep; const char* cB = (const char*)g.Bt + (size_t)cur.pn * tstep;
    S.a_ready(cur);
    if constexpr (SP2) {
        PG8_STAGE(PG8_SB(0, 0), cB, voffB); PG8_STAGE(PG8_SB(0, 1), cB + hstep, voffB); PG8_STAGE(PG8_SA(0, 0), cA, voffA); PG8_STAGE(PG8_SA(0, 1), cA + hstep, voffA);
        if (wr == 1) PG8_BAR;
        PG8_WAIT_V(2); PG8_BAR;
        PG8_STAGE(PG8_SB(1, 0), cB + kstep, voffB); PG8_STAGE(PG8_SA(1, 0), cA + kstep, voffA); PG8_STAGE(PG8_SB(1, 1), cB + hstep + kstep, voffB);
        PG8_WAIT_V(6); PG8_BAR;
    } else {
        PG8_STAGE(PG8_SB(0, 0), cB, voffB); PG8_STAGE(PG8_SA(0, 0), cA, voffA); PG8_STAGE(PG8_SB(0, 1), cB + hstep, voffB); PG8_STAGE(PG8_SA(0, 1), cA + hstep, voffA);
        if (wr == 1) PG8_BAR;
        PG8_WAIT_V(4); PG8_BAR;
        PG8_STAGE(PG8_SB(1, 0), cB + kstep, voffB); PG8_STAGE(PG8_SA(1, 0), cA + kstep, voffA); PG8_STAGE(PG8_SB(1, 1), cB + hstep + kstep, voffB);
        PG8_WAIT_V(6); PG8_BAR;
    }
    for (;;) {
        const bool has_next = S.next(ui + 1, nxt);
        const char* nA = has_next ? (const char*)g.A + (size_t)nxt.pm * tstep : cA; const char* nB = has_next ? (const char*)g.Bt + (size_t)nxt.pn * tstep : cB;
        for (int t = 0; t < nt; t += 2) {
            const bool last = (t == nt - 2);
            const char* a1 = cA + (size_t)(t + 1) * kstep;
            const char* a2 = last ? nA : cA + (size_t)(t + 2) * kstep; const char* b2 = last ? nB : cB + (size_t)(t + 2) * kstep;
            const char* a3 = a2 + kstep; const char* b3 = b2 + kstep;
            if (last && has_next) S.a_ready(nxt);
            if constexpr (SP2) {
            PG8_LDB(B0, 0, 0); PG8_LDB(B1, 0, 1); PG8_SCHED; PG8_LDA(At, 0, 0); PG8_STAGE(PG8_SA(1, 1), a1 + hstep, voffA);
            PG8_WAIT_V(8); PG8_WAIT_L(0); PG8_BAR; PG8_MMA(0, 0, At, B0); PG8_MMA(0, 1, At, B1); PG8_BAR; PG8_SCHED;
            PG8_LDA(At, 0, 1); PG8_STAGE(PG8_SB(0, 0), b2, voffB); PG8_STAGE(PG8_SB(0, 1), b2 + hstep, voffB); PG8_STAGE(PG8_SA(0, 0), a2, voffA);
            PG8_WAIT_V(8); PG8_WAIT_L(0); PG8_BAR; PG8_MMA(1, 0, At, B0); PG8_MMA(1, 1, At, B1); PG8_BAR; PG8_SCHED;
            PG8_LDB(B0, 1, 0); PG8_LDB(B1, 1, 1); PG8_SCHED; PG8_LDA(At, 1, 0); PG8_STAGE(PG8_SA(0, 1), a2 + hstep, voffA);
            PG8_WAIT_V(8); PG8_WAIT_L(0); PG8_BAR; PG8_MMA(0, 0, At, B0); PG8_MMA(0, 1, At, B1); PG8_BAR; PG8_SCHED;
            PG8_LDA(At, 1, 1); PG8_STAGE(PG8_SB(1, 0), b3, voffB); PG8_STAGE(PG8_SB(1, 1), b3 + hstep, voffB); PG8_STAGE(PG8_SA(1, 0), a3, voffA);
            PG8_WAIT_V(8); PG8_WAIT_L(0); PG8_BAR; PG8_MMA(1, 0, At, B0); PG8_MMA(1, 1, At, B1); PG8_BAR; PG8_SCHED;
            } else {
            PG8_LDB(B0, 0, 0); PG8_SCHED; PG8_LDA(At, 0, 0); PG8_STAGE(PG8_SA(1, 1), a1 + hstep, voffA);
            PG8_WAIT_L(8); PG8_BAR; PG8_WAIT_L(0); PG8_MMA(0, 0, At, B0); PG8_BAR; PG8_SCHED;
            PG8_LDB(B1, 0, 1); PG8_STAGE(PG8_SB(0, 0), b2, voffB);
            PG8_BAR; PG8_WAIT_L(0); PG8_MMA(0, 1, At, B1); PG8_BAR;
            PG8_LDA(At, 0, 1); PG8_STAGE(PG8_SA(0, 0), a2, voffA);
            PG8_BAR; PG8_WAIT_L(0); PG8_MMA(1, 0, At, B0); PG8_BAR; PG8_SCHED;
            PG8_STAGE(PG8_SB(0, 1), b2 + hstep, voffB);
            PG8_WAIT_V(6); PG8_BAR; PG8_MMA(1, 1, At, B1); PG8_BAR;
            PG8_LDB(B0, 1, 0); PG8_SCHED; PG8_LDA(At, 1, 0); PG8_STAGE(PG8_SA(0, 1), a2 + hstep, voffA);
            PG8_WAIT_L(8); PG8_BAR; PG8_WAIT_L(0); PG8_MMA(0, 0, At, B0); PG8_BAR; PG8_SCHED;
            PG8_LDB(B1, 1, 1); PG8_STAGE(PG8_SB(1, 0), b3, voffB);
            PG8_BAR; PG8_WAIT_L(0); PG8_MMA(0, 1, At, B1); PG8_BAR;
            PG8_LDA(At, 1, 1); PG8_STAGE(PG8_SA(1, 0), a3, voffA);
            PG8_BAR; PG8_WAIT_L(0); PG8_MMA(1, 0, At, B0); PG8_BAR; PG8_SCHED;
            PG8_STAGE(PG8_SB(1, 1), b3 + hstep, voffB);
            PG8_WAIT_V(6); PG8_BAR; PG8_MMA(1, 1, At, B1); PG8_BAR;
            }
        }
        if constexpr (ALIGN_EPI) { if (wr == 0) PG8_BAR; }
        if constexpr (!Epi::AFTER_DRAIN) { E(acc, cur, wr, wc, fr, fq); S.done(cur); }
        if (!has_next) break;
#pragma unroll
        for (int a = 0; a < 2; ++a)
#pragma unroll
            for (int b = 0; b < 2; ++b)
#pragma unroll
                for (int m = 0; m < 4; ++m)
#pragma unroll
                    for (int n = 0; n < 2; ++n) acc[a][b][m][n] = (f32x4){0.f, 0.f, 0.f, 0.f};
        cur = nxt; cA = nA; cB = nB; ++ui;
        if constexpr (ALIGN_EPI) { if (wr == 1) PG8_BAR; }
    }
    PG8_WAIT_V(0);
    if constexpr (!ALIGN_EPI) { if (wr == 0) PG8_BAR; }
    PG8_BAR;
    if constexpr (Epi::AFTER_DRAIN) { E.fused(acc, cur, wr, wc, fr, fq, lds, wid, lane); S.done(cur); }
#undef PG8_SA
#undef PG8_SB
#undef PG8_STAGE
#undef PG8_LDA
#undef PG8_LDB
#undef PG8_MMA
#undef PG8_WAIT_V
#undef PG8_WAIT_L
#undef PG8_BAR
#undef PG8_SCHED
}
}
#define GAS __attribute__((address_space(1)))
#define LAS __attribute__((address_space(3)))
typedef unsigned short bf16;
typedef unsigned v4u __attribute__((ext_vector_type(4)));
typedef float f32x4 __attribute__((ext_vector_type(4)));
typedef short bf16x8 __attribute__((ext_vector_type(8)));
typedef GAS unsigned gu32;
typedef GAS unsigned long long gu64;
#define RLX_AGENT __ATOMIC_RELAXED, __HIP_MEMORY_SCOPE_AGENT
#define LDS_WAIT() asm volatile("s_waitcnt lgkmcnt(0)" ::: "memory")
#define VM_WAIT() asm volatile("s_waitcnt vmcnt(0)" ::: "memory")
__device__ __forceinline__ unsigned long long rt() { return __builtin_amdgcn_s_memrealtime(); }
__device__ __forceinline__ unsigned f2bf(float f) { unsigned u = __builtin_bit_cast(unsigned, f); return (u + 0x7fffu + ((u >> 16) & 1u)) >> 16; }
__device__ __forceinline__ unsigned pk2(float lo, float hi) { return f2bf(lo) | (f2bf(hi) << 16); }

#define XB_TMO      128
#define XB_XCNT(j)  (256  + 64 * (j))
#define XB_XSUB(j)  (1280 + 64 * (j))
#define XB_XGEN(j)  (2304 + 64 * (j))
#define XB_TOP      3328
#define XB_TOPGEN   3392
#define XCD_BAR_WORDS 3456
#define XB_SPIN_CAP (1u << 18)

__device__ __forceinline__ unsigned xb_ld(unsigned* p)              { return __hip_atomic_load(p, __ATOMIC_RELAXED, __HIP_MEMORY_SCOPE_AGENT); }
__device__ __forceinline__ unsigned xb_add(unsigned* p, unsigned v) { return __hip_atomic_fetch_add(p, v, __ATOMIC_RELAXED, __HIP_MEMORY_SCOPE_AGENT); }
__device__ __forceinline__ unsigned xb_xcc_id() { return (unsigned)__builtin_amdgcn_s_getreg((3 << 11) | 20) & 0xFu; }
#define XB_SPIN(cond, bar) do { unsigned _sp = 0; while (cond) { __builtin_amdgcn_s_sleep(1); \
    if ((++_sp & 255u) == 0u) { if (xb_ld(&(bar)[XB_TMO])) break; if (_sp > XB_SPIN_CAP) { atomicAdd(&(bar)[XB_TMO], 1u); break; } } } } while (0)

struct XcdBarrier {
    unsigned* bar; unsigned x;
    volatile LAS unsigned* st;
};

__device__ __forceinline__ XcdBarrier xcd_barrier_post(unsigned* bar, volatile LAS unsigned* st) {
    XcdBarrier b; b.bar = bar; b.x = xb_xcc_id(); b.st = st;
    if (threadIdx.x == 0) (void)xb_add(&bar[XB_XCNT(b.x)], 1u);
    return b;
}
__device__ __forceinline__ void xcd_barrier_complete(unsigned* bar, unsigned x, unsigned& nloc, unsigned& nx) {
    const unsigned G = gridDim.x * gridDim.y * gridDim.z;
    unsigned sum, cnt, mine, sp = 0u;
    for (;;) {
        sum = 0u; cnt = 0u; mine = 0u;
#pragma unroll
        for (unsigned j = 0; j < 16; ++j) { const unsigned c = xb_ld(&bar[XB_XCNT(j)]); sum += c; cnt += (c > 0u) ? 1u : 0u; mine = (j == x) ? c : mine; }
        if (sum == G) break;
        __builtin_amdgcn_s_sleep(1);
        if ((++sp & 255u) == 0u) { if (xb_ld(&bar[XB_TMO])) break; if (sp > XB_SPIN_CAP) { atomicAdd(&bar[XB_TMO], 1u); break; } }
    }
    nloc = mine > 0u ? mine : 1u; nx = cnt > 0u ? cnt : 1u;
}

__device__ __forceinline__ void xcd_barrier(const XcdBarrier& b) {
    asm volatile("s_waitcnt vmcnt(0)" ::: "memory");
    __syncthreads();
    if (threadIdx.x == 0) {
        unsigned* bar = b.bar;
        __builtin_amdgcn_s_waitcnt(0);
        unsigned nloc = b.st[0], nx = b.st[1];
        if (nloc == 0u) { xcd_barrier_complete(bar, b.x, nloc, nx); b.st[0] = nloc; b.st[1] = nx; }
        const unsigned old = xb_add(&bar[XB_XSUB(b.x)], 1u);
        const unsigned gen = old / nloc;
        if (old + 1u == (gen + 1u) * nloc) {
            __builtin_amdgcn_fence(__ATOMIC_RELEASE, "agent");
            asm volatile("s_waitcnt vmcnt(0)" ::: "memory");
            const unsigned og = xb_add(&bar[XB_TOP], 1u);
            const unsigned tg = og / nx;
            if (og + 1u == (tg + 1u) * nx) xb_add(&bar[XB_TOPGEN], 1u);
            else XB_SPIN(xb_ld(&bar[XB_TOPGEN]) == tg, bar);
            __builtin_amdgcn_fence(__ATOMIC_ACQUIRE, "agent");
            xb_add(&bar[XB_XGEN(b.x)], 1u);
            asm volatile("s_waitcnt vmcnt(0)" ::: "memory");
        } else {
            XB_SPIN(xb_ld(&bar[XB_XGEN(b.x)]) == gen, bar);
            __builtin_amdgcn_fence(__ATOMIC_ACQUIRE, "agent");
            asm volatile("s_waitcnt vmcnt(0)" ::: "memory");
        }
    }
    __syncthreads();
}

constexpr int NWAVES = 8, NTHREADS = 512;
constexpr int BATCH = 4, SEQ = 2048, D = 2048, M = BATCH * SEQ;
constexpr int NQH = 32, NKVH = 4, HD = 64, QPKV = 8, WINDOW = 128;
constexpr int Q_OFF = 0, K_OFF = 2048, V_OFF = 2304, CB_OFF = 2560, CC_OFF = 4608, CH_OFF = 6656, G_OFF = 8704, IN_W = 12800;
constexpr int PH = 8, PNK = 128, PTOPK = 16, PNE = 16384;
constexpr float LN_EPS = 1e-5f;
constexpr float ALPHA = 1.189207115002721f;

#ifndef MK_PER_PHASE
#define MK_PER_PHASE 0
#endif
constexpr int N_PHASES = 9;

constexpr size_t MiB = 1u << 20;
constexpr size_t WS_CTL = 0, CTL_ZERO_BYTES = 1 * MiB;
constexpr size_t WS_WIN = 1 * MiB;
constexpr size_t WS_WA = 51 * MiB, WS_WC = 59 * MiB, WS_WO = 67 * MiB, WS_WF = 75 * MiB;
constexpr size_t WS_XB = 83 * MiB;
constexpr size_t WS_MERGED = WS_XB;
constexpr size_t WS_Z = 115 * MiB;
constexpr size_t WS_H1 = 115 * MiB;
constexpr size_t WS_H1B = 179 * MiB;
constexpr size_t WS_SC = 211 * MiB;
constexpr size_t WS_EX = 275 * MiB;
constexpr size_t WS_GT = 279 * MiB;
constexpr size_t WS_AO = 315 * MiB, WS_CI = 347 * MiB, WS_TMP = 379 * MiB;
constexpr size_t WS_END = 411 * MiB;
constexpr int CW_BAR = 4096;

constexpr int RING_BYTES = 131072;
constexpr int LDSCTL_OFF = 147456, MISC_OFF = LDSCTL_OFF + 320;
constexpr int LDS_BYTES = LDSCTL_OFF + 512;

typedef float f32x16 __attribute__((ext_vector_type(16)));
typedef unsigned v2u __attribute__((ext_vector_type(2)));
__device__ __forceinline__ float wave_sum(float v) {
#pragma unroll
    for (int o = 1; o < 64; o <<= 1) v += __shfl_xor(v, o);
    return v;
}
__device__ __forceinline__ float vmaxf(float a, float b) { float r; asm("v_max_f32_e32 %0, %1, %2" : "=v"(r) : "v"(a), "v"(b)); return r; }
__device__ __forceinline__ float vminf(float a, float b) { float r; asm("v_min_f32_e32 %0, %1, %2" : "=v"(r) : "v"(a), "v"(b)); return r; }

__device__ __forceinline__ void p0_transpose_item(const float* W, int K, int N, bf16* WT, LAS float* scr, int item, int lane) {
    const int nblk = N / 32, kb = item / nblk, nb = item % nblk, k0 = 64 * kb, n0 = 32 * nb;
#pragma unroll 8
    for (int i = 0; i < 32; ++i) { const int kk = 2 * i + (lane >> 5); scr[kk * 33 + (lane & 31)] = W[(size_t)(k0 + kk) * N + n0 + (lane & 31)]; }
    LDS_WAIT(); asm volatile("" ::: "memory");
    const int c = lane & 7;
#pragma unroll
    for (int j = 0; j < 4; ++j) { const int n = (lane >> 3) + 8 * j; const LAS float* s = scr + (8 * c) * 33 + n;
        v4u o; o.x = pk2(s[0 * 33], s[1 * 33]); o.y = pk2(s[2 * 33], s[3 * 33]); o.z = pk2(s[4 * 33], s[5 * 33]); o.w = pk2(s[6 * 33], s[7 * 33]);
        *(GAS v4u*)(WT + (size_t)(n0 + n) * K + k0 + 8 * c) = o; }
    LDS_WAIT(); asm volatile("" ::: "memory");
}
__device__ __forceinline__ void p0_wf_item(const float* wq, const float* sk, bf16* WfT, LAS unsigned char* lds, int item, int tid) {
    const int hp = item >> 5, dt = item & 31;
    LAS f32x4* SK4 = (LAS f32x4*)lds;
    LAS f32x4* WQ4 = SK4 + 128 * 33;
    const float* skp = sk + (size_t)hp * 128 * 128;
    for (int i = tid; i < 128 * 32; i += NTHREADS) { const int n = i >> 5, c4 = i & 31; SK4[n * 33 + c4] = *(const f32x4*)(skp + n * 128 + 4 * c4); }
    for (int i = tid; i < 64 * 32; i += NTHREADS) { const int r = i >> 5, c4 = i & 31; WQ4[r * 33 + c4] = *(const f32x4*)(wq + (size_t)(64 * dt + r) * 2048 + hp * 128 + 4 * c4); }
    __syncthreads();
    const int td = tid & 15, tn = tid >> 4;
    float acc[4][4];
#pragma unroll
    for (int i = 0; i < 4; ++i)
#pragma unroll
        for (int j = 0; j < 4; ++j) acc[i][j] = 0.f;
#pragma unroll 4
    for (int c4 = 0; c4 < 32; ++c4) {
        f32x4 a[4], b[4];
#pragma unroll
        for (int i = 0; i < 4; ++i) a[i] = SK4[(4 * tn + i) * 33 + c4];
#pragma unroll
        for (int j = 0; j < 4; ++j) b[j] = WQ4[(td + 16 * j) * 33 + c4];
#pragma unroll
        for (int i = 0; i < 4; ++i)
#pragma unroll
            for (int j = 0; j < 4; ++j) acc[i][j] += a[i].x * b[j].x + a[i].y * b[j].y + a[i].z * b[j].z + a[i].w * b[j].w;
    }
#pragma unroll
    for (int i = 0; i < 4; ++i)
#pragma unroll
        for (int j = 0; j < 4; ++j) WfT[(size_t)(hp * 128 + 4 * tn + i) * 2048 + 64 * dt + td + 16 * j] = (bf16)f2bf(acc[i][j]);
    __syncthreads();
}

__device__ __forceinline__ int perm16(int o) { return 8 * ((o >> 2) & 1) + 4 * (o >> 3) + (o & 3); }
__device__ __forceinline__ void attn_unit(int unit, const bf16* z, bf16* ao, const float* sinks, LAS unsigned char* lds, int tid) {
    const int lane = tid & 63, wid = __builtin_amdgcn_readfirstlane(tid >> 6), r32 = lane & 31, hi = lane >> 5;
    const int nb = unit & 15, kvh = (unit >> 4) & 3, b = unit >> 6;
    LAS bf16* Ks = (LAS bf16*)lds;
    LAS bf16* Vt = (LAS bf16*)(lds + 256 * 144);
    const size_t tok0 = (size_t)b * SEQ;
#pragma unroll
    for (int i = 0; i < 4; ++i) {
        const int ci = tid + NTHREADS * i, key = ci >> 3, dc = ci & 7;
        int kpos = 128 * (nb - 1) + key; if (kpos < 0) kpos = 0;
        const bf16* src = z + (tok0 + kpos) * IN_W + K_OFF + kvh * HD + dc * 8;
        const v4u kv = *(const GAS v4u*)src, vv = *(const GAS v4u*)(src + (V_OFF - K_OFF));
        *(LAS v4u*)(Ks + key * 72 + dc * 8) = kv;
        const int pos = (key & ~15) + perm16(key & 15);
        LAS bf16* vp = Vt + (dc * 8) * 264 + pos;
        vp[0 * 264] = (bf16)(vv.x & 0xffffu); vp[1 * 264] = (bf16)(vv.x >> 16); vp[2 * 264] = (bf16)(vv.y & 0xffffu); vp[3 * 264] = (bf16)(vv.y >> 16);
        vp[4 * 264] = (bf16)(vv.z & 0xffffu); vp[5 * 264] = (bf16)(vv.z >> 16); vp[6 * 264] = (bf16)(vv.w & 0xffffu); vp[7 * 264] = (bf16)(vv.w >> 16);
    }
    __syncthreads();
    const int hq = kvh * QPKV + wid;
    const float LOG2E = 1.4426950408889634f;
    const float sink2 = sinks[hq] * LOG2E, sc = 0.125f * LOG2E;
#pragma unroll 1
    for (int qg = 0; qg < 4; ++qg) {
        const size_t tok = tok0 + 128 * nb + 32 * qg + r32;
        bf16x8 qf[4];
#pragma unroll
        for (int ks = 0; ks < 4; ++ks) qf[ks] = *(const GAS bf16x8*)(z + tok * IN_W + Q_OFF + hq * HD + 16 * ks + 8 * hi);
        f32x16 s[5];
#pragma unroll
        for (int kt = 0; kt < 5; ++kt) {
            s[kt] = (f32x16){0.f, 0.f, 0.f, 0.f, 0.f, 0.f, 0.f, 0.f, 0.f, 0.f, 0.f, 0.f, 0.f, 0.f, 0.f, 0.f};
#pragma unroll
            for (int ks = 0; ks < 4; ++ks) {
                const bf16x8 kf = *(const LAS bf16x8*)(Ks + (32 * (qg + kt) + r32) * 72 + 16 * ks + 8 * hi);
                s[kt] = __builtin_amdgcn_mfma_f32_32x32x16_bf16(kf, qf[ks], s[kt], 0, 0, 0);
            }
        }
        float mx = sink2;
#pragma unroll
        for (int kt = 0; kt < 5; ++kt) {
            const bool tile_dead = (nb == 0) && (qg + kt < 4);
#pragma unroll
            for (int r = 0; r < 16; ++r) {
                const int krow = (r & 3) + 8 * (r >> 2) + 4 * hi;
                bool valid = !tile_dead;
                if (kt == 0) valid = valid && (krow > r32);
                if (kt == 4) valid = valid && (krow <= r32);
                const float v = valid ? s[kt][r] * sc : -INFINITY;
                s[kt][r] = v; mx = fmaxf(mx, v);
            }
        }
        mx = fmaxf(mx, __shfl_xor(mx, 32));
        float sum = 0.f;
#pragma unroll
        for (int kt = 0; kt < 5; ++kt)
#pragma unroll
            for (int r = 0; r < 16; ++r) { const float p = __builtin_amdgcn_exp2f(s[kt][r] - mx); s[kt][r] = p; sum += p; }
        sum += __shfl_xor(sum, 32);
        const float inv = 1.0f / (sum + __builtin_amdgcn_exp2f(sink2 - mx));
        f32x16 o[2];
        o[0] = (f32x16){0.f, 0.f, 0.f, 0.f, 0.f, 0.f, 0.f, 0.f, 0.f, 0.f, 0.f, 0.f, 0.f, 0.f, 0.f, 0.f}; o[1] = o[0];
#pragma unroll
        for (int kt = 0; kt < 5; ++kt)
#pragma unroll
            for (int s2 = 0; s2 < 2; ++s2) {
                v4u pw; pw.x = pg8::cvt_pk_bf16(s[kt][8 * s2 + 0], s[kt][8 * s2 + 1]); pw.y = pg8::cvt_pk_bf16(s[kt][8 * s2 + 2], s[kt][8 * s2 + 3]);
                pw.z = pg8::cvt_pk_bf16(s[kt][8 * s2 + 4], s[kt][8 * s2 + 5]); pw.w = pg8::cvt_pk_bf16(s[kt][8 * s2 + 6], s[kt][8 * s2 + 7]);
                const bf16x8 pa = __builtin_bit_cast(bf16x8, pw);
#pragma unroll
                for (int dt = 0; dt < 2; ++dt) {
                    const bf16x8 vf = *(const LAS bf16x8*)(Vt + (32 * dt + r32) * 264 + 32 * (qg + kt) + 16 * s2 + 8 * hi);
                    o[dt] = __builtin_amdgcn_mfma_f32_32x32x16_bf16(vf, pa, o[dt], 0, 0, 0);
                }
            }
        bf16* op = ao + tok * D + hq * HD;
#pragma unroll
        for (int dt = 0; dt < 2; ++dt)
#pragma unroll
            for (int g = 0; g < 4; ++g) {
                v2u w; w.x = pg8::cvt_pk_bf16(o[dt][4 * g + 0] * inv, o[dt][4 * g + 1] * inv); w.y = pg8::cvt_pk_bf16(o[dt][4 * g + 2] * inv, o[dt][4 * g + 3] * inv);
                *(GAS v2u*)(op + 32 * dt + 8 * g + 4 * hi) = w;
            }
    }
    __syncthreads();
}
__device__ __forceinline__ void conv_item(int item, const bf16* z, const float* cw, bf16* ci, int tid) {
    const int c8 = tid & 255, half = tid >> 8, t0 = 32 * item + 16 * half, c0 = 8 * c8;
    float w0[8], w1[8], w2[8], u1[8], u2[8];
#pragma unroll
    for (int e = 0; e < 8; ++e) { w0[e] = cw[c0 + e]; w1[e] = cw[2048 + c0 + e]; w2[e] = cw[4096 + c0 + e]; u1[e] = 0.f; u2[e] = 0.f; }
    if ((t0 & (SEQ - 1)) != 0) {
#pragma unroll
        for (int k = 0; k < 2; ++k) {
            const bf16* zr = z + (size_t)(t0 - 2 + k) * IN_W + c0;
            const v4u a = *(const GAS v4u*)(zr + CC_OFF), h = *(const GAS v4u*)(zr + CH_OFF);
            float u[8];
            u[0] = pg8::bf_lo(a.x) * pg8::bf_lo(h.x); u[1] = pg8::bf_hi(a.x) * pg8::bf_hi(h.x); u[2] = pg8::bf_lo(a.y) * pg8::bf_lo(h.y); u[3] = pg8::bf_hi(a.y) * pg8::bf_hi(h.y);
            u[4] = pg8::bf_lo(a.z) * pg8::bf_lo(h.z); u[5] = pg8::bf_hi(a.z) * pg8::bf_hi(h.z); u[6] = pg8::bf_lo(a.w) * pg8::bf_lo(h.w); u[7] = pg8::bf_hi(a.w) * pg8::bf_hi(h.w);
#pragma unroll
            for (int e = 0; e < 8; ++e) { if (k == 0) u2[e] = u[e]; else u1[e] = u[e]; }
        }
    }
#pragma unroll 4
    for (int i = 0; i < 16; ++i) {
        const bf16* zr = z + (size_t)(t0 + i) * IN_W + c0;
        const v4u a = *(const GAS v4u*)(zr + CC_OFF), h = *(const GAS v4u*)(zr + CH_OFF), bb = *(const GAS v4u*)(zr + CB_OFF);
        float u[8], cb[8], y[8];
        u[0] = pg8::bf_lo(a.x) * pg8::bf_lo(h.x); u[1] = pg8::bf_hi(a.x) * pg8::bf_hi(h.x); u[2] = pg8::bf_lo(a.y) * pg8::bf_lo(h.y); u[3] = pg8::bf_hi(a.y) * pg8::bf_hi(h.y);
        u[4] = pg8::bf_lo(a.z) * pg8::bf_lo(h.z); u[5] = pg8::bf_hi(a.z) * pg8::bf_hi(h.z); u[6] = pg8::bf_lo(a.w) * pg8::bf_lo(h.w); u[7] = pg8::bf_hi(a.w) * pg8::bf_hi(h.w);
        cb[0] = pg8::bf_lo(bb.x); cb[1] = pg8::bf_hi(bb.x); cb[2] = pg8::bf_lo(bb.y); cb[3] = pg8::bf_hi(bb.y); cb[4] = pg8::bf_lo(bb.z); cb[5] = pg8::bf_hi(bb.z); cb[6] = pg8::bf_lo(bb.w); cb[7] = pg8::bf_hi(bb.w);
#pragma unroll
        for (int e = 0; e < 8; ++e) { y[e] = cb[e] * (w0[e] * u2[e] + w1[e] * u1[e] + w2[e] * u[e]); u2[e] = u1[e]; u1[e] = u[e]; }
        v4u o; o.x = pk2(y[0], y[1]); o.y = pk2(y[2], y[3]); o.z = pk2(y[4], y[5]); o.w = pk2(y[6], y[7]);
        *(GAS v4u*)(ci + (size_t)(t0 + i) * D + c0) = o;
    }
}

__device__ __forceinline__ void ln1_row(float* r1row, bf16* hbrow, const float* g, const float* bta, int lane) {
    GAS f32x4* xr = (GAS f32x4*)r1row + lane;
    f32x4 v[8]; float s = 0.f;
#pragma unroll
    for (int j = 0; j < 8; ++j) { v[j] = xr[64 * j]; s += (v[j].x + v[j].y) + (v[j].z + v[j].w); }
    const float mean = wave_sum(s) * (1.f / D); float s2 = 0.f;
#pragma unroll
    for (int j = 0; j < 8; ++j) { v[j] = v[j] - mean; s2 += (v[j].x * v[j].x + v[j].y * v[j].y) + (v[j].z * v[j].z + v[j].w * v[j].w); }
    const float rstd = 1.f / sqrtf(wave_sum(s2) * (1.f / D) + LN_EPS);
    GAS v2u* o8 = (GAS v2u*)hbrow + lane;
#pragma unroll
    for (int j = 0; j < 8; ++j) {
        const f32x4 gg = *((const GAS f32x4*)g + lane + 64 * j), bb = *((const GAS f32x4*)bta + lane + 64 * j);
        const f32x4 y = v[j] * rstd * gg + bb;
        xr[64 * j] = y;
        v2u w; w.x = pk2(y.x, y.y); w.y = pk2(y.z, y.w); o8[64 * j] = w;
    }
}

constexpr int TK_ROWF = 136;
constexpr int TK_IDX_OFF = 256 * TK_ROWF * 4;
__device__ __forceinline__ void topk_pass(int pass, const float* scores, int* experts, float* gates, LAS unsigned char* lds, int tid) {
    LAS float* S = (LAS float*)lds;
    LAS unsigned char* IDX = lds + TK_IDX_OFF;
    const float* src = scores + (size_t)pass * (256 * 128);
#pragma unroll 4
    for (int i = 0; i < 16; ++i) { const int f4 = tid + NTHREADS * i, row = f4 >> 5, c4 = f4 & 31; *(LAS f32x4*)(S + row * TK_ROWF + 4 * c4) = *(const GAS f32x4*)(src + (size_t)f4 * 4); }
    __syncthreads();
    const int row = tid >> 1, sub = tid & 1;
    float L[16];
#pragma unroll
    for (int j = 0; j < 16; ++j) L[j] = -INFINITY;
#pragma unroll 2
    for (int i = 0; i < 16; ++i) {
        const int c4 = 2 * i + sub;
        const f32x4 v = *(const LAS f32x4*)(S + row * TK_ROWF + 4 * c4);
#pragma unroll
        for (int e = 0; e < 4; ++e) {
            const float ve = v[e];
            float x = __uint_as_float((__float_as_uint(ve) & ~0x7Fu) | (unsigned)(4 * c4 + e));
#pragma unroll
            for (int j = 0; j < 16; ++j) { const float h = vmaxf(L[j], x); x = vminf(L[j], x); L[j] = h; }
        }
    }
    {
        float P[16];
#pragma unroll
        for (int j = 0; j < 16; ++j) P[j] = __shfl_xor(L[j], 1);
#pragma unroll
        for (int j = 0; j < 16; ++j) L[j] = vmaxf(L[j], P[15 - j]);
#pragma unroll
        for (int st = 8; st >= 1; st >>= 1)
#pragma unroll
            for (int j = 0; j < 16; ++j) if ((j & st) == 0) { const float h = vmaxf(L[j], L[j + st]), l = vminf(L[j], L[j + st]); L[j] = h; L[j + st] = l; }
    }
    if (sub == 0) {
#pragma unroll
        for (int q = 0; q < 4; ++q) {
            unsigned w = 0;
#pragma unroll
            for (int e = 0; e < 4; ++e) w |= (__builtin_bit_cast(unsigned, L[4 * q + e]) & 0x7Fu) << (8 * e);
            *(LAS unsigned*)(IDX + row * 16 + 4 * q) = w;
        }
    }
    float A[16], B[16];
#pragma unroll
    for (int j = 0; j < 16; ++j) { const float o = __shfl_xor(L[j], 2); const bool isb = (tid & 2) != 0; A[j] = isb ? o : L[j]; B[j] = isb ? L[j] : o; }
    float F[16];
#pragma unroll
    for (int j = 0; j < 16; ++j) F[j] = -INFINITY;
#pragma unroll
    for (int i = 0; i < 16; ++i)
#pragma unroll
        for (int j = 0; j < 16; ++j) if ((i + 1) * (j + 1) <= 16) {
            const float sm = A[i] + B[j];
            float x = __builtin_bit_cast(float, (__builtin_bit_cast(unsigned, sm) & ~0xFFu) | (unsigned)(i * 16 + j));
#pragma unroll
            for (int k = 0; k < 16; ++k) { const float h = vmaxf(F[k], x); x = vminf(F[k], x); F[k] = h; }
        }
    __syncthreads();
    if ((tid & 3) == 0) {
        const int rowA = (tid >> 2) * 2, rowB = rowA + 1;
        const size_t prob = (size_t)pass * 128 + (tid >> 2);
        float g[16]; int ex[16]; float gs = 0.f;
#pragma unroll
        for (int k = 0; k < 16; ++k) {
            const unsigned code = __builtin_bit_cast(unsigned, F[k]) & 0xFFu;
            const int ia = IDX[rowA * 16 + (code >> 4)], ib = IDX[rowB * 16 + (code & 15)];
            ex[k] = ia * PNK + ib;
            g[k] = __expf(F[k] - F[0]); gs += g[k];
        }
        const float ginv = 1.0f / gs;
#pragma unroll
        for (int q = 0; q < 4; ++q) {
            *(GAS f32x4*)(gates + prob * 16 + 4 * q) = (f32x4){g[4 * q] * ginv, g[4 * q + 1] * ginv, g[4 * q + 2] * ginv, g[4 * q + 3] * ginv};
            typedef int i32x4 __attribute__((ext_vector_type(4)));
            *(GAS i32x4*)(experts + prob * 16 + 4 * q) = (i32x4){ex[4 * q], ex[4 * q + 1], ex[4 * q + 2], ex[4 * q + 3]};
        }
    }
    __syncthreads();
}

__device__ __forceinline__ float gelu_erf(float v) { return 0.5f * v * (1.0f + erff(v * 0.70710678118654752f)); }
__device__ __forceinline__ void peer_token(int t, const float* h1, const int* experts, const float* gates, const float* utab, const float* vtab,
                                           const float* g2, const float* b2, float* out, LAS unsigned char* lds, int tid) {
    const int lane = tid & 63, wid = __builtin_amdgcn_readfirstlane(tid >> 6);
    const GAS f32x4* xr4 = (const GAS f32x4*)(h1 + (size_t)t * D) + lane;
    f32x4 xr[8], ya[8];
#pragma unroll
    for (int j = 0; j < 8; ++j) { xr[j] = xr4[64 * j]; ya[j] = (f32x4){0.f, 0.f, 0.f, 0.f}; }
    const int* ep = experts + ((size_t)t * PH + wid) * PTOPK;
    const float* gp = gates + ((size_t)t * PH + wid) * PTOPK;
#pragma unroll 1
    for (int k = 0; k < PTOPK; k += 2) {
        const int e0 = __builtin_amdgcn_readfirstlane(ep[k]), e1 = __builtin_amdgcn_readfirstlane(ep[k + 1]);
        const float g0 = gp[k], g1 = gp[k + 1];
        const GAS f32x4* u0 = (const GAS f32x4*)(utab + (size_t)e0 * D) + lane; const GAS f32x4* u1 = (const GAS f32x4*)(utab + (size_t)e1 * D) + lane;
        const GAS f32x4* v0 = (const GAS f32x4*)(vtab + (size_t)e0 * D) + lane; const GAS f32x4* v1 = (const GAS f32x4*)(vtab + (size_t)e1 * D) + lane;
        f32x4 a[8], b[8];
#pragma unroll
        for (int j = 0; j < 8; ++j) { a[j] = u0[64 * j]; b[j] = u1[64 * j]; }
        float d0 = 0.f, d1 = 0.f;
#pragma unroll
        for (int j = 0; j < 8; ++j) { d0 += (a[j].x * xr[j].x + a[j].y * xr[j].y) + (a[j].z * xr[j].z + a[j].w * xr[j].w); d1 += (b[j].x * xr[j].x + b[j].y * xr[j].y) + (b[j].z * xr[j].z + b[j].w * xr[j].w); }
#pragma unroll
        for (int j = 0; j < 8; ++j) { a[j] = v0[64 * j]; b[j] = v1[64 * j]; }
        d0 = wave_sum(d0); d1 = wave_sum(d1);
        const float w0 = g0 * gelu_erf(d0), w1 = g1 * gelu_erf(d1);
#pragma unroll
        for (int j = 0; j < 8; ++j) ya[j] += a[j] * w0 + b[j] * w1;
    }
    LAS f32x4* Y4 = (LAS f32x4*)lds;
    LAS float* RED = (LAS float*)(lds + 65536);
#pragma unroll
    for (int j = 0; j < 8; ++j) Y4[wid * 512 + lane + 64 * j] = ya[j];
    __syncthreads();
    f32x4 y = Y4[tid];
#pragma unroll
    for (int w = 1; w < 8; ++w) y += Y4[w * 512 + tid];
    const f32x4 hx = *((const GAS f32x4*)(h1 + (size_t)t * D) + tid);
    f32x4 r = hx * ALPHA + y;
    float s = wave_sum((r.x + r.y) + (r.z + r.w));
    if (lane == 0) RED[wid] = s;
    __syncthreads();
    float tot = 0.f;
#pragma unroll
    for (int w = 0; w < 8; ++w) tot += RED[w];
    const float mean = tot * (1.f / D);
    r = r - mean;
    float s2 = wave_sum((r.x * r.x + r.y * r.y) + (r.z * r.z + r.w * r.w));
    if (lane == 0) RED[8 + wid] = s2;
    __syncthreads();
    float tot2 = 0.f;
#pragma unroll
    for (int w = 0; w < 8; ++w) tot2 += RED[8 + w];
    const float rstd = 1.f / sqrtf(tot2 * (1.f / D) + LN_EPS);
    const f32x4 gg = *((const GAS f32x4*)g2 + tid), bb = *((const GAS f32x4*)b2 + tid);
    *((GAS f32x4*)(out + (size_t)t * D) + tid) = r * rstd * gg + bb;
    __syncthreads();
}

struct Args { const float* in[16]; float* out; unsigned char* ws; int ph_lo, ph_hi; };
__global__ void __launch_bounds__(NTHREADS, 2) mk_fwd(Args args) {
    extern __shared__ __attribute__((aligned(16))) unsigned char lds_raw[];
    LAS unsigned char* lds = (LAS unsigned char*)lds_raw;
    volatile LAS unsigned* MISC = (volatile LAS unsigned*)(lds + MISC_OFF);
    const int tid0 = threadIdx.x;
    const int G = gridDim.x, bx = blockIdx.x;
    unsigned char* ws = args.ws;
    gu32* ctl = (gu32*)(ws + WS_CTL);
#define IN_(i) (args.in[i])
#define x_in IN_(0)
#define w_in IN_(1)
#define b_gate IN_(2)
#define sinks IN_(3)
#define conv_w IN_(4)
#define w_ao IN_(5)
#define w_co IN_(6)
#define w_o IN_(7)
#define ln1_g IN_(8)
#define ln1_b IN_(9)
#define w_q IN_(10)
#define sub_keys IN_(11)
#define peer_u IN_(12)
#define peer_v IN_(13)
#define ln2_g IN_(14)
#define ln2_b IN_(15)
#define WinT ((bf16*)(ws + WS_WIN))
#define WaT ((bf16*)(ws + WS_WA))
#define WcT ((bf16*)(ws + WS_WC))
#define WoT ((bf16*)(ws + WS_WO))
#define WfT ((bf16*)(ws + WS_WF))
#define XB ((bf16*)(ws + WS_XB))
#define MERGED ((bf16*)(ws + WS_MERGED))
#define Z ((bf16*)(ws + WS_Z))
#define H1 ((float*)(ws + WS_H1))
#define H1B ((bf16*)(ws + WS_H1B))
#define SC ((float*)(ws + WS_SC))
#define EX ((int*)(ws + WS_EX))
#define GT ((float*)(ws + WS_GT))
#define AO ((bf16*)(ws + WS_AO))
#define CI ((bf16*)(ws + WS_CI))
#define TMP ((bf16*)(ws + WS_TMP))
    for (int u = tid0; u < (LDS_BYTES - LDSCTL_OFF) / 4; u += NTHREADS) ((LAS unsigned*)(lds + LDSCTL_OFF))[u] = 0u;
    __syncthreads();
    XcdBarrier bar; bar.bar = (unsigned*)(ctl + CW_BAR); bar.x = 0; bar.st = nullptr;
    if (!MK_PER_PHASE) bar = xcd_barrier_post((unsigned*)(ctl + CW_BAR), MISC + 8);
    const int lo = args.ph_lo, hi = args.ph_hi;
#ifndef PH_MASK
#define PH_MASK 0x1FF
#endif
#define IN(k) (((PH_MASK >> (k)) & 1) && lo <= (k) && (k) < hi)
#define SEAM(k) do { if (IN(k) && IN((k) + 1)) xcd_barrier(bar); } while (0)
#define PHASE_TID() int tid = tid0; asm volatile("" : "+v"(tid)); const int lane = tid & 63, wave = __builtin_amdgcn_readfirstlane(tid >> 6); (void)lane; (void)wave

    if (IN(0)) {
        PHASE_TID();
        for (int it = bx; it < 16 * 32; it += G) p0_wf_item(w_q, sub_keys, WfT, lds, it, tid);
        LAS float* scr = (LAS float*)(lds + wave * 16384);
        const int gw = bx * NWAVES + wave, NGW = G * NWAVES;
        constexpr int I_IN = (D / 64) * (IN_W / 32), I_SQ = (D / 64) * (D / 32);
        for (int it = gw; it < I_IN + 3 * I_SQ; it += NGW) {
            int r = it;
            if (r < I_IN) { p0_transpose_item(w_in, D, IN_W, WinT, scr, r, lane); continue; } r -= I_IN;
            if (r < I_SQ) { p0_transpose_item(w_ao, D, D, WaT, scr, r, lane); continue; } r -= I_SQ;
            if (r < I_SQ) { p0_transpose_item(w_co, D, D, WcT, scr, r, lane); continue; } r -= I_SQ;
            p0_transpose_item(w_o, D, D, WoT, scr, r, lane);
        }
        const size_t n8 = (size_t)M * D / 8;
        for (size_t i = (size_t)bx * NTHREADS + tid; i < n8; i += (size_t)G * NTHREADS) {
            const f32x4 a = *((const GAS f32x4*)x_in + 2 * i), b = *((const GAS f32x4*)x_in + 2 * i + 1);
            v4u o; o.x = pk2(a.x, a.y); o.y = pk2(a.z, a.w); o.z = pk2(b.x, b.y); o.w = pk2(b.z, b.w);
            *((GAS v4u*)XB + i) = o;
        }
    }
    SEAM(0);
    if (IN(1)) {
        pg8::Gemm g{XB, WinT, M, IN_W, D}; pg8::StaticOrder S; S.init(M, IN_W, G, bx);
        pg8::EpiBf16 E{Z, IN_W};
        pg8::gemm_phase<pg8::EpiBf16, pg8::StaticOrder, true, true>(lds, g, S, E);
    }
    SEAM(1);
    if (IN(2)) {
        PHASE_TID();
        for (int u = bx; u < BATCH * NKVH * 16; u += G) attn_unit(u, Z, AO, sinks, lds, tid);
        for (int it = bx; it < M / 32; it += G) conv_item(it, Z, conv_w, CI, tid);
    }
    SEAM(2);
    if (IN(3)) {
        pg8::StaticOrder S; S.init(M, D, G, bx);
        { pg8::Gemm g{AO, WaT, M, D, D}; pg8::EpiGate<0> E{TMP, nullptr, Z + G_OFF, b_gate, D, IN_W};
          pg8::gemm_phase<pg8::EpiGate<0>, pg8::StaticOrder, true, true>(lds, g, S, E); }
        { pg8::Gemm g{CI, WcT, M, D, D}; pg8::EpiGate<1> E{MERGED, TMP, Z + G_OFF + D, b_gate + D, D, IN_W};
          pg8::gemm_phase<pg8::EpiGate<1>, pg8::StaticOrder, true, true>(lds, g, S, E); }
    }
    SEAM(3);
    if (IN(4)) {
        pg8::Gemm g{MERGED, WoT, M, D, D}; pg8::StaticOrder S; S.init(M, D, G, bx);
        pg8::EpiF32 E{H1, D, x_in, ALPHA};
        pg8::gemm_phase<pg8::EpiF32, pg8::StaticOrder, true, true>(lds, g, S, E);
    }
    SEAM(4);
    if (IN(5)) {
        PHASE_TID();
        const int gw = bx * NWAVES + wave, NGW = G * NWAVES;
        for (int m = gw; m < M; m += NGW) ln1_row(H1 + (size_t)m * D, H1B + (size_t)m * D, ln1_g, ln1_b, lane);
    }
    SEAM(5);
    if (IN(6)) {
        pg8::Gemm g{H1B, WfT, M, D, D}; pg8::StaticOrder S; S.init(M, D, G, bx);
        pg8::EpiF32 E{SC, D, nullptr, 0.f};
        pg8::gemm_phase<pg8::EpiF32, pg8::StaticOrder, true, true>(lds, g, S, E);
    }
    SEAM(6);
    if (IN(7)) {
        PHASE_TID();
        for (int p = bx; p < (M * PH) / 128; p += G) topk_pass(p, SC, EX, GT, lds, tid);
    }
    SEAM(7);
    if (IN(8)) {
        PHASE_TID();
        for (int t = bx; t < M; t += G) peer_token(t, H1, EX, GT, peer_u, peer_v, ln2_g, ln2_b, args.out, lds, tid);
    }
#undef IN
#undef SEAM
}

extern "C" void kernel_launch(void* const* d_in, const int* in_sizes, int n_in, void* d_out, int out_size, void* d_ws, size_t ws_size, hipStream_t stream) {
    static int grid = 0;
    if (grid == 0) {
        if (n_in != 16 || out_size != M * D || ws_size < WS_END) { fprintf(stderr, "kernel_launch: unexpected shapes (n_in %d out %d ws %zu)\n", n_in, out_size, ws_size); grid = -1; return; }
        int dev = 0, cus = 0, per_cu = 0;
        if (hipGetDevice(&dev) != hipSuccess || hipDeviceGetAttribute(&cus, hipDeviceAttributeMultiprocessorCount, dev) != hipSuccess) { grid = -1; return; }
        if (hipFuncSetAttribute((const void*)mk_fwd, hipFuncAttributeMaxDynamicSharedMemorySize, LDS_BYTES) != hipSuccess) { fprintf(stderr, "kernel_launch: hipFuncSetAttribute failed\n"); grid = -1; return; }
        if (hipOccupancyMaxActiveBlocksPerMultiprocessor(&per_cu, (const void*)mk_fwd, NTHREADS, LDS_BYTES) != hipSuccess || per_cu < 1) { fprintf(stderr, "kernel_launch: occupancy query says %d\n", per_cu); per_cu = 1; }
        (void)hipGetLastError();
        if (per_cu > 1) per_cu = 1;
        grid = cus * per_cu;
    }
    if (grid < 0) return;
    if (hipMemsetAsync((char*)d_ws + WS_CTL, 0, CTL_ZERO_BYTES, stream) != hipSuccess) { fprintf(stderr, "kernel_launch: memset failed\n"); return; }
    Args a{};
    for (int i = 0; i < 16; ++i) a.in[i] = (const float*)d_in[i];
    a.out = (float*)d_out; a.ws = (unsigned char*)d_ws;
#if MK_PER_PHASE
    for (int p = 0; p < N_PHASES; ++p) { a.ph_lo = p; a.ph_hi = p + 1; hipLaunchKernelGGL(mk_fwd, dim3(grid), dim3(NTHREADS), LDS_BYTES, stream, a); }
#else
    a.ph_lo = 0; a.ph_hi = N_PHASES;
    void* kargs[] = {&a};
    hipError_t e = hipLaunchCooperativeKernel((const void*)mk_fwd, dim3(grid), dim3(NTHREADS), kargs, LDS_BYTES, stream);
    if (e != hipSuccess) fprintf(stderr, "kernel_launch: cooperative launch failed: %s (grid %d)\n", hipGetErrorString(e), grid);
#endif
}
```

```cpp
#include <hip/hip_runtime.h>
#include <cstdio>
#include <cstdint>
namespace pg8 {
#define PG8_LAS __attribute__((address_space(3)))
typedef unsigned short bf16_t;
typedef short bf16x8 __attribute__((ext_vector_type(8)));
typedef float f32x4 __attribute__((ext_vector_type(4)));
typedef unsigned u32x4 __attribute__((ext_vector_type(4)));
constexpr int BM = 256, BK = 64, HALF = 128, HTB = HALF * BK * 2  , STAGE_BYTES = 8 * HTB, NXCD = 8, WGM = 8;

__host__ __device__ __forceinline__ int lds_byte(int r, int c) { const int st = (r >> 4) * 2 + (c >> 5), rr = r & 15, cc = c & 31, ob = rr * 64 + cc * 2; return st * 1024 + (ob ^ (((ob >> 9) & 1) << 5)); }
__host__ __device__ __forceinline__ void stage_rc(int b, int& R, int& C) { const int st = b / 1024, sb = b % 1024, swz = sb ^ (((sb >> 9) & 1) << 5); R = (st >> 1) * 16 + swz / 64; C = (st & 1) * 32 + (swz % 64) / 2; }
__host__ __device__ __forceinline__ int perm32(int rho) { const int n = rho >> 4, i = rho & 15; return 8 * (i >> 2) + 4 * n + (i & 3); }

struct Unit { int pm, pn; };
struct Gemm { const bf16_t* A; const bf16_t* Bt; int M, N, K; };

struct StaticOrder {
    int nM, nN, nwg, G, c;
    __host__ __device__ void init(int M, int N, int G_, int c_) { nM = M / BM; nN = N / BM; nwg = nM * nN; G = G_; c = c_; }
    __host__ __device__ bool next(int i, Unit& u) const {
        const long L = (long)i * G + c; if (L >= nwg) return false;
        int wgid = (int)L; { const int q = nwg / NXCD, r = nwg % NXCD, xcd = wgid % NXCD, off = wgid / NXCD; wgid = (xcd < r ? xcd * (q + 1) : r * (q + 1) + (xcd - r) * q) + off; }
        const int nig = WGM * nN, gid = wgid / nig, fm = gid * WGM, gsz = (nM - fm) < WGM ? (nM - fm) : WGM;
        u.pm = fm + ((wgid % nig) % gsz); u.pn = (wgid % nig) / gsz; return true;
    }
    __device__ __forceinline__ void a_ready(const Unit&) const {}
    __device__ __forceinline__ void done(const Unit&) const {}
};


__device__ __forceinline__ unsigned cvt_pk_bf16(float lo, float hi) { unsigned r; asm volatile("v_cvt_pk_bf16_f32 %0, %1, %2" : "=v"(r) : "v"(lo), "v"(hi)); return r; }
__device__ __forceinline__ float bf_lo(unsigned w) { return __builtin_bit_cast(float, w << 16); }
__device__ __forceinline__ float bf_hi(unsigned w) { return __builtin_bit_cast(float, w & 0xffff0000u); }
__device__ __forceinline__ float sigmoidf_(float x) { return __builtin_amdgcn_rcpf(1.0f + __expf(-x)); }

struct EpiBf16 {
    static constexpr bool PERM = true, AFTER_DRAIN = false;
    bf16_t* O; int ldc;
    __device__ __forceinline__ void operator()(const f32x4 (&acc)[2][2][4][2], const Unit& u, int wr, int wc, int fr, int fq) const {
        const int row0 = u.pm * BM + wr * 64 + fr, col0 = u.pn * BM + wc * 32 + 8 * fq;
#pragma unroll
        for (int ai = 0; ai < 2; ++ai)
#pragma unroll
            for (int m = 0; m < 4; ++m) { bf16_t* rowp = O + (size_t)(row0 + ai * HALF + m * 16) * ldc + col0;
#pragma unroll
                for (int bj = 0; bj < 2; ++bj) { const f32x4 v0 = acc[ai][bj][m][0], v1 = acc[ai][bj][m][1];
                    u32x4 w; w.x = cvt_pk_bf16(v0[0], v0[1]); w.y = cvt_pk_bf16(v0[2], v0[3]); w.z = cvt_pk_bf16(v1[0], v1[1]); w.w = cvt_pk_bf16(v1[2], v1[3]);
                    *(u32x4*)(rowp + bj * HALF) = w; } }
    }
};
template <int SECOND> struct EpiGate {
    static constexpr bool PERM = true, AFTER_DRAIN = false;
    bf16_t* O; const bf16_t* T; const bf16_t* Zg; const float* bg; int ldc, ldz;
    __device__ __forceinline__ void operator()(const f32x4 (&acc)[2][2][4][2], const Unit& u, int wr, int wc, int fr, int fq) const {
        const int row0 = u.pm * BM + wr * 64 + fr, col0 = u.pn * BM + wc * 32 + 8 * fq;
        f32x4 bv[2][2];
#pragma unroll
        for (int bj = 0; bj < 2; ++bj)
#pragma unroll
            for (int n = 0; n < 2; ++n) bv[bj][n] = *(const f32x4*)(bg + col0 + bj * HALF + 4 * n);
#pragma unroll
        for (int ai = 0; ai < 2; ++ai)
#pragma unroll
            for (int m = 0; m < 4; ++m) { const size_t row = (size_t)(row0 + ai * HALF + m * 16);
#pragma unroll
                for (int bj = 0; bj < 2; ++bj) { const int c = col0 + bj * HALF;
                    const u32x4 zg = *(const u32x4*)(Zg + row * ldz + c);
                    f32x4 v0 = acc[ai][bj][m][0], v1 = acc[ai][bj][m][1];
                    v0[0] *= sigmoidf_(bf_lo(zg.x) + bv[bj][0][0]); v0[1] *= sigmoidf_(bf_hi(zg.x) + bv[bj][0][1]);
                    v0[2] *= sigmoidf_(bf_lo(zg.y) + bv[bj][0][2]); v0[3] *= sigmoidf_(bf_hi(zg.y) + bv[bj][0][3]);
                    v1[0] *= sigmoidf_(bf_lo(zg.z) + bv[bj][1][0]); v1[1] *= sigmoidf_(bf_hi(zg.z) + bv[bj][1][1]);
                    v1[2] *= sigmoidf_(bf_lo(zg.w) + bv[bj][1][2]); v1[3] *= sigmoidf_(bf_hi(zg.w) + bv[bj][1][3]);
                    if (SECOND) { const u32x4 t = *(const u32x4*)(T + row * ldc + c);
                        v0[0] += bf_lo(t.x); v0[1] += bf_hi(t.x); v0[2] += bf_lo(t.y); v0[3] += bf_hi(t.y);
                        v1[0] += bf_lo(t.z); v1[1] += bf_hi(t.z); v1[2] += bf_lo(t.w); v1[3] += bf_hi(t.w); }
                    u32x4 w; w.x = cvt_pk_bf16(v0[0], v0[1]); w.y = cvt_pk_bf16(v0[2], v0[3]); w.z = cvt_pk_bf16(v1[0], v1[1]); w.w = cvt_pk_bf16(v1[2], v1[3]);
                    *(u32x4*)(O + row * ldc + c) = w; } }
    }
};
struct EpiF32 {
    static constexpr bool PERM = false, AFTER_DRAIN = false;
    float* C; int ldc; const float* R; float scale;
    __device__ __forceinline__ void operator()(const f32x4 (&acc)[2][2][4][2], const Unit& u, int wr, int wc, int fr, int fq) const {
        const int row0 = u.pm * BM + wr * 64 + fr, col0 = u.pn * BM + wc * 32 + 4 * fq;
#pragma unroll
        for (int ai = 0; ai < 2; ++ai)
#pragma unroll
            for (int m = 0; m < 4; ++m) { const size_t off = (size_t)(row0 + ai * HALF + m * 16) * ldc + col0;
#pragma unroll
                for (int bj = 0; bj < 2; ++bj)
#pragma unroll
                    for (int n = 0; n < 2; ++n) { f32x4 v = acc[ai][bj][m][n];
                        if (R) v += *(const f32x4*)(R + off + bj * HALF + n * 16) * scale;
                        *(f32x4*)(C + off + bj * HALF + n * 16) = v; } }
    }
};

template <class Epi, class Sched, bool ALIGN_EPI = false, bool SP2 = false>
__device__ __forceinline__ void gemm_phase(PG8_LAS unsigned char* lds, const Gemm g, const Sched& S, const Epi& E) {
    int tid_ = threadIdx.x; asm volatile("" : "+v"(tid_));
    const int tid = tid_, wid = __builtin_amdgcn_readfirstlane(tid >> 6), lane = tid & 63, wr = wid >> 2, wc = wid & 3, fr = lane & 15, fq = lane >> 4;
    const int K = g.K, nt = K / BK;
    unsigned voffA[2], voffB[2];
#pragma unroll
    for (int i = 0; i < 2; ++i) { int R, C; stage_rc(tid * 16 + i * 8192, R, C); const int Rb = Epi::PERM ? ((R & ~31) + perm32(R & 31)) : R;
        voffA[i] = (unsigned)(R * K + C) * 2u; voffB[i] = (unsigned)(Rb * K + C) * 2u; }
    const size_t kstep = (size_t)(BK * 2);
    const size_t hstep = (size_t)HALF * K * 2;
    const size_t tstep = 2 * hstep;
    const unsigned ldsw = (unsigned)wid * 1024u;
    const int aoff = lds_byte(wr * 64 + fr, fq * 8), boff = lds_byte(wc * 32 + fr, fq * 8);
#define PG8_SA(b, h) (((b) * 2 + (h)) * HTB)
#define PG8_SB(b, h) ((4 + (b) * 2 + (h)) * HTB)
#define PG8_STAGE(bufoff, gbase, voff) do { _Pragma("unroll") for (int _i = 0; _i < 2; ++_i) \
        __builtin_amdgcn_global_load_lds((const unsigned*)((const char*)(gbase) + (voff)[_i]), (PG8_LAS unsigned*)(lds + (bufoff) + ldsw + _i * 8192), 16, 0, 0); } while (0)
#define PG8_LDA(dst, b, h) do { _Pragma("unroll") for (int m = 0; m < 4; ++m) _Pragma("unroll") for (int k = 0; k < 2; ++k) dst[m][k] = *(const PG8_LAS bf16x8*)(lds + PG8_SA(b, h) + aoff + m * 2048 + k * 1024); } while (0)
#define PG8_LDB(dst, b, h) do { _Pragma("unroll") for (int n = 0; n < 2; ++n) _Pragma("unroll") for (int k = 0; k < 2; ++k) dst[n][k] = *(const PG8_LAS bf16x8*)(lds + PG8_SB(b, h) + boff + n * 2048 + k * 1024); } while (0)
#define PG8_MMA(ai, bj, At, Bt) do { __builtin_amdgcn_s_setprio(1); _Pragma("unroll") for (int m = 0; m < 4; ++m) _Pragma("unroll") for (int n = 0; n < 2; ++n) _Pragma("unroll") for (int k = 0; k < 2; ++k) \
        acc[ai][bj][m][n] = __builtin_amdgcn_mfma_f32_16x16x32_bf16(Bt[n][k], At[m][k], acc[ai][bj][m][n], 0, 0, 0); __builtin_amdgcn_s_setprio(0); } while (0)
#define PG8_WAIT_V(n) asm volatile("s_waitcnt vmcnt(" #n ")" ::: "memory")
#define PG8_WAIT_L(n) asm volatile("s_waitcnt lgkmcnt(" #n ")" ::: "memory")
#define PG8_BAR __builtin_amdgcn_s_barrier()
#define PG8_SCHED __builtin_amdgcn_sched_barrier(0)
    Unit cur, nxt; int ui = 0;
    if (!S.next(0, cur)) return;
    f32x4 acc[2][2][4][2];
#pragma unroll
    for (int a = 0; a < 2; ++a)
#pragma unroll
        for (int b = 0; b < 2; ++b)
#pragma unroll
            for (int m = 0; m < 4; ++m)
#pragma unroll
                for (int n = 0; n < 2; ++n) acc[a][b][m][n] = (f32x4){0.f, 0.f, 0.f, 0.f};
    bf16x8 At[4][2], B0[2][2], B1[2][2];
    const char* cA = (const char*)g.A + (size_t)cur.pm * tstep; const char* cB = (const char*)g.Bt + (size_t)cur.pn * tstep;
    S.a_ready(cur);
    if constexpr (SP2) {
        PG8_STAGE(PG8_SB(0, 0), cB, voffB); PG8_STAGE(PG8_SB(0, 1), cB + hstep, voffB); PG8_STAGE(PG8_SA(0, 0), cA, voffA); PG8_STAGE(PG8_SA(0, 1), cA + hstep, voffA);
        if (wr == 1) PG8_BAR;
        PG8_WAIT_V(2); PG8_BAR;
        PG8_STAGE(PG8_SB(1, 0), cB + kstep, voffB); PG8_STAGE(PG8_SA(1, 0), cA + kstep, voffA); PG8_STAGE(PG8_SB(1, 1), cB + hstep + kstep, voffB);
        PG8_WAIT_V(6); PG8_BAR;
    } else {
        PG8_STAGE(PG8_SB(0, 0), cB, voffB); PG8_STAGE(PG8_SA(0, 0), cA, voffA); PG8_STAGE(PG8_SB(0, 1), cB + hstep, voffB); PG8_STAGE(PG8_SA(0, 1), cA + hstep, voffA);
        if (wr == 1) PG8_BAR;
        PG8_WAIT_V(4); PG8_BAR;
        PG8_STAGE(PG8_SB(1, 0), cB + kstep, voffB); PG8_STAGE(PG8_SA(1, 0), cA + kstep, voffA); PG8_STAGE(PG8_SB(1, 1), cB + hstep + kstep, voffB);
        PG8_WAIT_V(6); PG8_BAR;
    }
    for (;;) {
        const bool has_next = S.next(ui + 1, nxt);
        const char* nA = has_next ? (const char*)g.A + (size_t)nxt.pm * tstep : cA; const char* nB = has_next ? (const char*)g.Bt + (size_t)nxt.pn * tstep : cB;
        for (int t = 0; t < nt; t += 2) {
            const bool last = (t == nt - 2);
            const char* a1 = cA + (size_t)(t + 1) * kstep;
            const char* a2 = last ? nA : cA + (size_t)(t + 2) * kstep; const char* b2 = last ? nB : cB + (size_t)(t + 2) * kstep;
            const char* a3 = a2 + kstep; const char* b3 = b2 + kstep;
            if (last && has_next) S.a_ready(nxt);
            if constexpr (SP2) {
            PG8_LDB(B0, 0, 0); PG8_LDB(B1, 0, 1); PG8_SCHED; PG8_LDA(At, 0, 0); PG8_STAGE(PG8_SA(1, 1), a1 + hstep, voffA);
            PG8_WAIT_V(8); PG8_WAIT_L(0); PG8_BAR; PG8_MMA(0, 0, At, B0); PG8_MMA(0, 1, At, B1); PG8_BAR; PG8_SCHED;
            PG8_LDA(At, 0, 1); PG8_STAGE(PG8_SB(0, 0), b2, voffB); PG8_STAGE(PG8_SB(0, 1), b2 + hstep, voffB); PG8_STAGE(PG8_SA(0, 0), a2, voffA);
            PG8_WAIT_V(8); PG8_WAIT_L(0); PG8_BAR; PG8_MMA(1, 0, At, B0); PG8_MMA(1, 1, At, B1); PG8_BAR; PG8_SCHED;
            PG8_LDB(B0, 1, 0); PG8_LDB(B1, 1, 1); PG8_SCHED; PG8_LDA(At, 1, 0); PG8_STAGE(PG8_SA(0, 1), a2 + hstep, voffA);
            PG8_WAIT_V(8); PG8_WAIT_L(0); PG8_BAR; PG8_MMA(0, 0, At, B0); PG8_MMA(0, 1, At, B1); PG8_BAR; PG8_SCHED;
            PG8_LDA(At, 1, 1); PG8_STAGE(PG8_SB(1, 0), b3, voffB); PG8_STAGE(PG8_SB(1, 1), b3 + hstep, voffB); PG8_STAGE(PG8_SA(1, 0), a3, voffA);
            PG8_WAIT_V(8); PG8_WAIT_L(0); PG8_BAR; PG8_MMA(1, 0, At, B0); PG8_MMA(1, 1, At, B1); PG8_BAR; PG8_SCHED;
            } else {
            PG8_LDB(B0, 0, 0); PG8_SCHED; PG8_LDA(At, 0, 0); PG8_STAGE(PG8_SA(1, 1), a1 + hstep, voffA);
            PG8_WAIT_L(8); PG8_BAR; PG8_WAIT_L(0); PG8_MMA(0, 0, At, B0); PG8_BAR; PG8_SCHED;
            PG8_LDB(B1, 0, 1); PG8_STAGE(PG8_SB(0, 0), b2, voffB);
            PG8_BAR; PG8_WAIT_L(0); PG8_MMA(0, 1, At, B1); PG8_BAR;
            PG8_LDA(At, 0, 1); PG8_STAGE(PG8_SA(0, 0), a2, voffA);
            PG8_BAR; PG8_WAIT_L(0); PG8_MMA(1, 0, At, B0); PG8_BAR; PG8_SCHED;
            PG8_STAGE(PG8_SB(0, 1), b2 + hstep, voffB);
            PG8_WAIT_V(6); PG8_BAR; PG8_MMA(1, 1, At, B1); PG8_BAR;
            PG8_LDB(B0, 1, 0); PG8_SCHED; PG8_LDA(At, 1, 0); PG8_STAGE(PG8_SA(0, 1), a2 + hstep, voffA);
            PG8_WAIT_L(8); PG8_BAR; PG8_WAIT_L(0); PG8_MMA(0, 0, At, B0); PG8_BAR; PG8_SCHED;
            PG8_LDB(B1, 1, 1); PG8_STAGE(PG8_SB(1, 0), b3, voffB);
            PG8_BAR; PG8_WAIT_L(0); PG8_MMA(0, 1, At, B1); PG8_BAR;
            PG8_LDA(At, 1, 1); PG8_STAGE(PG8_SA(1, 0), a3, voffA);
            PG8_BAR; PG8_WAIT_L(0); PG8_MMA(1, 0, At, B0); PG8_BAR; PG8_SCHED;
            PG8_STAGE(PG8_SB(1, 1), b3 + hstep, voffB);
            PG8_WAIT_V(6); PG8_BAR; PG8_MMA(1, 1, At, B1); PG8_BAR;
            }
        }
        if constexpr (ALIGN_EPI) { if (wr == 0) PG8_BAR; }
        if constexpr (!Epi::AFTER_DRAIN) { E(acc, cur, wr, wc, fr, fq); S.done(cur); }
        if (!has_next) break;
#pragma unroll
        for (int a = 0; a < 2; ++a)
#pragma unroll
            for (int b = 0; b < 2; ++b)
#pragma unroll
                for (int m = 0; m < 4; ++m)
#pragma unroll
                    for (int n = 0; n < 2; ++n) acc[a][b][m][n] = (f32x4){0.f, 0.f, 0.f, 0.f};
        cur = nxt; cA = nA; cB = nB; ++ui;
        if constexpr (ALIGN_EPI) { if (wr == 1) PG8_BAR; }
    }
    PG8_WAIT_V(0);
    if constexpr (!ALIGN_EPI) { if (wr == 0) PG8_BAR; }
    PG8_BAR;
    if constexpr (Epi::AFTER_DRAIN) { E.fused(acc, cur, wr, wc, fr, fq, lds, wid, lane); S.done(cur); }
#undef PG8_SA
#undef PG8_SB
#undef PG8_STAGE
#undef PG8_LDA
#undef PG8_LDB
#undef PG8_MMA
#undef PG8_WAIT_V
#undef PG8_WAIT_L
#undef PG8_BAR
#undef PG8_SCHED
}
}
#define GAS __attribute__((address_space(1)))
#define LAS __attribute__((address_space(3)))
typedef unsigned short bf16;
typedef unsigned v4u __attribute__((ext_vector_type(4)));
typedef float f32x4 __attribute__((ext_vector_type(4)));
typedef short bf16x8 __attribute__((ext_vector_type(8)));
typedef GAS unsigned gu32;
typedef GAS unsigned long long gu64;
#define RLX_AGENT __ATOMIC_RELAXED, __HIP_MEMORY_SCOPE_AGENT
#define LDS_WAIT() asm volatile("s_waitcnt lgkmcnt(0)" ::: "memory")
#define VM_WAIT() asm volatile("s_waitcnt vmcnt(0)" ::: "memory")
__device__ __forceinline__ unsigned long long rt() { return __builtin_amdgcn_s_memrealtime(); }
__device__ __forceinline__ unsigned f2bf(float f) { unsigned u = __builtin_bit_cast(unsigned, f); return (u + 0x7fffu + ((u >> 16) & 1u)) >> 16; }
__device__ __forceinline__ unsigned pk2(float lo, float hi) { return f2bf(lo) | (f2bf(hi) << 16); }

#define XB_TMO      128
#define XB_XCNT(j)  (256  + 64 * (j))
#define XB_XSUB(j)  (1280 + 64 * (j))
#define XB_XGEN(j)  (2304 + 64 * (j))
#define XB_TOP      3328
#define XB_TOPGEN   3392
#define XCD_BAR_WORDS 3456
#define XB_SPIN_CAP (1u << 18)

__device__ __forceinline__ unsigned xb_ld(unsigned* p)              { return __hip_atomic_load(p, __ATOMIC_RELAXED, __HIP_MEMORY_SCOPE_AGENT); }
__device__ __forceinline__ unsigned xb_add(unsigned* p, unsigned v) { return __hip_atomic_fetch_add(p, v, __ATOMIC_RELAXED, __HIP_MEMORY_SCOPE_AGENT); }
__device__ __forceinline__ unsigned xb_xcc_id() { return (unsigned)__builtin_amdgcn_s_getreg((3 << 11) | 20) & 0xFu; }
#define XB_SPIN(cond, bar) do { unsigned _sp = 0; while (cond) { __builtin_amdgcn_s_sleep(1); \
    if ((++_sp & 255u) == 0u) { if (xb_ld(&(bar)[XB_TMO])) break; if (_sp > XB_SPIN_CAP) { atomicAdd(&(bar)[XB_TMO], 1u); break; } } } } while (0)

struct XcdBarrier {
    unsigned* bar; unsigned x;
    volatile LAS unsigned* st;
};

__device__ __forceinline__ XcdBarrier xcd_barrier_post(unsigned* bar, volatile LAS unsigned* st) {
    XcdBarrier b; b.bar = bar; b.x = xb_xcc_id(); b.st = st;
    if (threadIdx.x == 0) (void)xb_add(&bar[XB_XCNT(b.x)], 1u);
    return b;
}
__device__ __forceinline__ void xcd_barrier_complete(unsigned* bar, unsigned x, unsigned& nloc, unsigned& nx) {
    const unsigned G = gridDim.x * gridDim.y * gridDim.z;
    unsigned sum, cnt, mine, sp = 0u;
    for (;;) {
        sum = 0u; cnt = 0u; mine = 0u;
#pragma unroll
        for (unsigned j = 0; j < 16; ++j) { const unsigned c = xb_ld(&bar[XB_XCNT(j)]); sum += c; cnt += (c > 0u) ? 1u : 0u; mine = (j == x) ? c : mine; }
        if (sum == G) break;
        __builtin_amdgcn_s_sleep(1);
        if ((++sp & 255u) == 0u) { if (xb_ld(&bar[XB_TMO])) break; if (sp > XB_SPIN_CAP) { atomicAdd(&bar[XB_TMO], 1u); break; } }
    }
    nloc = mine > 0u ? mine : 1u; nx = cnt > 0u ? cnt : 1u;
}

__device__ __forceinline__ void xcd_barrier(const XcdBarrier& b) {
    asm volatile("s_waitcnt vmcnt(0)" ::: "memory");
    __syncthreads();
    if (threadIdx.x == 0) {
        unsigned* bar = b.bar;
        __builtin_amdgcn_s_waitcnt(0);
        unsigned nloc = b.st[0], nx = b.st[1];
        if (nloc == 0u) { xcd_barrier_complete(bar, b.x, nloc, nx); b.st[0] = nloc; b.st[1] = nx; }
        const unsigned old = xb_add(&bar[XB_XSUB(b.x)], 1u);
        const unsigned gen = old / nloc;
        if (old + 1u == (gen + 1u) * nloc) {
            __builtin_amdgcn_fence(__ATOMIC_RELEASE, "agent");
            asm volatile("s_waitcnt vmcnt(0)" ::: "memory");
            const unsigned og = xb_add(&bar[XB_TOP], 1u);
            const unsigned tg = og / nx;
            if (og + 1u == (tg + 1u) * nx) xb_add(&bar[XB_TOPGEN], 1u);
            else XB_SPIN(xb_ld(&bar[XB_TOPGEN]) == tg, bar);
            __builtin_amdgcn_fence(__ATOMIC_ACQUIRE, "agent");
            xb_add(&bar[XB_XGEN(b.x)], 1u);
            asm volatile("s_waitcnt vmcnt(0)" ::: "memory");
        } else {
            XB_SPIN(xb_ld(&bar[XB_XGEN(b.x)]) == gen, bar);
            __builtin_amdgcn_fence(__ATOMIC_ACQUIRE, "agent");
            asm volatile("s_waitcnt vmcnt(0)" ::: "memory");
        }
    }
    __syncthreads();
}

constexpr int NWAVES = 8, NTHREADS = 512;
constexpr int BATCH = 4, SEQ = 2048, D = 2048, M = BATCH * SEQ;
constexpr int NQH = 32, NKVH = 4, HD = 64, QPKV = 8, WINDOW = 128;
constexpr int Q_OFF = 0, K_OFF = 2048, V_OFF = 2304, CB_OFF = 2560, CC_OFF = 4608, CH_OFF = 6656, G_OFF = 8704, IN_W = 12800;
constexpr int PH = 8, PNK = 128, PTOPK = 16, PNE = 16384;
constexpr float LN_EPS = 1e-5f;
constexpr float ALPHA = 1.189207115002721f;

#ifndef MK_PER_PHASE
#define MK_PER_PHASE 0
#endif
constexpr int N_PHASES = 9;

constexpr size_t MiB = 1u << 20;
constexpr size_t WS_CTL = 0, CTL_ZERO_BYTES = 1 * MiB;
constexpr size_t WS_WIN = 1 * MiB;
constexpr size_t WS_WA = 51 * MiB, WS_WC = 59 * MiB, WS_WO = 67 * MiB, WS_WF = 75 * MiB;
constexpr size_t WS_XB = 83 * MiB;
constexpr size_t WS_MERGED = WS_XB;
constexpr size_t WS_Z = 115 * MiB;
constexpr size_t WS_H1 = 115 * MiB;
constexpr size_t WS_H1B = 179 * MiB;
constexpr size_t WS_SC = 211 * MiB;
constexpr size_t WS_EX = 275 * MiB;
constexpr size_t WS_GT = 279 * MiB;
constexpr size_t WS_AO = 315 * MiB, WS_CI = 347 * MiB, WS_TMP = 379 * MiB;
constexpr size_t WS_UB = 315 * MiB, WS_VB = 379 * MiB;
constexpr size_t WS_END = 443 * MiB;
constexpr int CW_BAR = 4096;

constexpr int RING_BYTES = 131072;
constexpr int LDSCTL_OFF = 147456, MISC_OFF = LDSCTL_OFF + 320;
constexpr int LDS_BYTES = LDSCTL_OFF + 512;

typedef float f32x16 __attribute__((ext_vector_type(16)));
typedef unsigned v2u __attribute__((ext_vector_type(2)));
__device__ __forceinline__ float wave_sum(float v) {
#pragma unroll
    for (int o = 1; o < 64; o <<= 1) v += __shfl_xor(v, o);
    return v;
}
__device__ __forceinline__ float vmaxf(float a, float b) { float r; asm("v_max_f32_e32 %0, %1, %2" : "=v"(r) : "v"(a), "v"(b)); return r; }
__device__ __forceinline__ float vminf(float a, float b) { float r; asm("v_min_f32_e32 %0, %1, %2" : "=v"(r) : "v"(a), "v"(b)); return r; }

__device__ __forceinline__ void p0_transpose_item(const float* W, int K, int N, bf16* WT, LAS float* scr, int item, int lane) {
    const int nblk = N / 32, kb = item / nblk, nb = item % nblk, k0 = 64 * kb, n0 = 32 * nb;
#pragma unroll 8
    for (int i = 0; i < 32; ++i) { const int kk = 2 * i + (lane >> 5); scr[kk * 33 + (lane & 31)] = W[(size_t)(k0 + kk) * N + n0 + (lane & 31)]; }
    LDS_WAIT(); asm volatile("" ::: "memory");
    const int c = lane & 7;
#pragma unroll
    for (int j = 0; j < 4; ++j) { const int n = (lane >> 3) + 8 * j; const LAS float* s = scr + (8 * c) * 33 + n;
        v4u o; o.x = pk2(s[0 * 33], s[1 * 33]); o.y = pk2(s[2 * 33], s[3 * 33]); o.z = pk2(s[4 * 33], s[5 * 33]); o.w = pk2(s[6 * 33], s[7 * 33]);
        *(GAS v4u*)(WT + (size_t)(n0 + n) * K + k0 + 8 * c) = o; }
    LDS_WAIT(); asm volatile("" ::: "memory");
}
__device__ __forceinline__ void p0_wf_item(const float* wq, const float* sk, bf16* WfT, LAS unsigned char* lds, int item, int tid) {
    const int hp = item >> 5, dt = item & 31;
    LAS f32x4* SK4 = (LAS f32x4*)lds;
    LAS f32x4* WQ4 = SK4 + 128 * 33;
    const float* skp = sk + (size_t)hp * 128 * 128;
    for (int i = tid; i < 128 * 32; i += NTHREADS) { const int n = i >> 5, c4 = i & 31; SK4[n * 33 + c4] = *(const f32x4*)(skp + n * 128 + 4 * c4); }
    for (int i = tid; i < 64 * 32; i += NTHREADS) { const int r = i >> 5, c4 = i & 31; WQ4[r * 33 + c4] = *(const f32x4*)(wq + (size_t)(64 * dt + r) * 2048 + hp * 128 + 4 * c4); }
    __syncthreads();
    const int td = tid & 15, tn = tid >> 4;
    float acc[4][4];
#pragma unroll
    for (int i = 0; i < 4; ++i)
#pragma unroll
        for (int j = 0; j < 4; ++j) acc[i][j] = 0.f;
#pragma unroll 4
    for (int c4 = 0; c4 < 32; ++c4) {
        f32x4 a[4], b[4];
#pragma unroll
        for (int i = 0; i < 4; ++i) a[i] = SK4[(4 * tn + i) * 33 + c4];
#pragma unroll
        for (int j = 0; j < 4; ++j) b[j] = WQ4[(td + 16 * j) * 33 + c4];
#pragma unroll
        for (int i = 0; i < 4; ++i)
#pragma unroll
            for (int j = 0; j < 4; ++j) acc[i][j] += a[i].x * b[j].x + a[i].y * b[j].y + a[i].z * b[j].z + a[i].w * b[j].w;
    }
#pragma unroll
    for (int i = 0; i < 4; ++i)
#pragma unroll
        for (int j = 0; j < 4; ++j) WfT[(size_t)(hp * 128 + 4 * tn + i) * 2048 + 64 * dt + td + 16 * j] = (bf16)f2bf(acc[i][j]);
    __syncthreads();
}

__device__ __forceinline__ int perm16(int o) { return 8 * ((o >> 2) & 1) + 4 * (o >> 3) + (o & 3); }
__device__ __forceinline__ void attn_unit(int unit, const bf16* z, bf16* ao, const float* sinks, LAS unsigned char* lds, int tid) {
    const int lane = tid & 63, wid = __builtin_amdgcn_readfirstlane(tid >> 6), r32 = lane & 31, hi = lane >> 5;
    const int nb = unit & 15, kvh = (unit >> 4) & 3, b = unit >> 6;
    LAS bf16* Ks = (LAS bf16*)lds;
    LAS bf16* Vt = (LAS bf16*)(lds + 256 * 144);
    const size_t tok0 = (size_t)b * SEQ;
#pragma unroll
    for (int i = 0; i < 4; ++i) {
        const int ci = tid + NTHREADS * i, key = ci >> 3, dc = ci & 7;
        int kpos = 128 * (nb - 1) + key; if (kpos < 0) kpos = 0;
        const bf16* src = z + (tok0 + kpos) * IN_W + K_OFF + kvh * HD + dc * 8;
        const v4u kv = *(const GAS v4u*)src, vv = *(const GAS v4u*)(src + (V_OFF - K_OFF));
        *(LAS v4u*)(Ks + key * 72 + dc * 8) = kv;
        const int pos = (key & ~15) + perm16(key & 15);
        LAS bf16* vp = Vt + (dc * 8) * 264 + pos;
        vp[0 * 264] = (bf16)(vv.x & 0xffffu); vp[1 * 264] = (bf16)(vv.x >> 16); vp[2 * 264] = (bf16)(vv.y & 0xffffu); vp[3 * 264] = (bf16)(vv.y >> 16);
        vp[4 * 264] = (bf16)(vv.z & 0xffffu); vp[5 * 264] = (bf16)(vv.z >> 16); vp[6 * 264] = (bf16)(vv.w & 0xffffu); vp[7 * 264] = (bf16)(vv.w >> 16);
    }
    __syncthreads();
    const int hq = kvh * QPKV + wid;
    const float LOG2E = 1.4426950408889634f;
    const float sink2 = sinks[hq] * LOG2E, sc = 0.125f * LOG2E;
#pragma unroll 1
    for (int qg = 0; qg < 4; ++qg) {
        const size_t tok = tok0 + 128 * nb + 32 * qg + r32;
        bf16x8 qf[4];
#pragma unroll
        for (int ks = 0; ks < 4; ++ks) qf[ks] = *(const GAS bf16x8*)(z + tok * IN_W + Q_OFF + hq * HD + 16 * ks + 8 * hi);
        f32x16 s[5];
#pragma unroll
        for (int kt = 0; kt < 5; ++kt) {
            s[kt] = (f32x16){0.f, 0.f, 0.f, 0.f, 0.f, 0.f, 0.f, 0.f, 0.f, 0.f, 0.f, 0.f, 0.f, 0.f, 0.f, 0.f};
#pragma unroll
            for (int ks = 0; ks < 4; ++ks) {
                const bf16x8 kf = *(const LAS bf16x8*)(Ks + (32 * (qg + kt) + r32) * 72 + 16 * ks + 8 * hi);
                s[kt] = __builtin_amdgcn_mfma_f32_32x32x16_bf16(kf, qf[ks], s[kt], 0, 0, 0);
            }
        }
        float mx = sink2;
#pragma unroll
        for (int kt = 0; kt < 5; ++kt) {
            const bool tile_dead = (nb == 0) && (qg + kt < 4);
#pragma unroll
            for (int r = 0; r < 16; ++r) {
                const int krow = (r & 3) + 8 * (r >> 2) + 4 * hi;
                bool valid = !tile_dead;
                if (kt == 0) valid = valid && (krow > r32);
                if (kt == 4) valid = valid && (krow <= r32);
                const float v = valid ? s[kt][r] * sc : -INFINITY;
                s[kt][r] = v; mx = fmaxf(mx, v);
            }
        }
        mx = fmaxf(mx, __shfl_xor(mx, 32));
        float sum = 0.f;
#pragma unroll
        for (int kt = 0; kt < 5; ++kt)
#pragma unroll
            for (int r = 0; r < 16; ++r) { const float p = __builtin_amdgcn_exp2f(s[kt][r] - mx); s[kt][r] = p; sum += p; }
        sum += __shfl_xor(sum, 32);
        const float inv = 1.0f / (sum + __builtin_amdgcn_exp2f(sink2 - mx));
        f32x16 o[2];
        o[0] = (f32x16){0.f, 0.f, 0.f, 0.f, 0.f, 0.f, 0.f, 0.f, 0.f, 0.f, 0.f, 0.f, 0.f, 0.f, 0.f, 0.f}; o[1] = o[0];
#pragma unroll
        for (int kt = 0; kt < 5; ++kt)
#pragma unroll
            for (int s2 = 0; s2 < 2; ++s2) {
                v4u pw; pw.x = pg8::cvt_pk_bf16(s[kt][8 * s2 + 0], s[kt][8 * s2 + 1]); pw.y = pg8::cvt_pk_bf16(s[kt][8 * s2 + 2], s[kt][8 * s2 + 3]);
                pw.z = pg8::cvt_pk_bf16(s[kt][8 * s2 + 4], s[kt][8 * s2 + 5]); pw.w = pg8::cvt_pk_bf16(s[kt][8 * s2 + 6], s[kt][8 * s2 + 7]);
                const bf16x8 pa = __builtin_bit_cast(bf16x8, pw);
#pragma unroll
                for (int dt = 0; dt < 2; ++dt) {
                    const bf16x8 vf = *(const LAS bf16x8*)(Vt + (32 * dt + r32) * 264 + 32 * (qg + kt) + 16 * s2 + 8 * hi);
                    o[dt] = __builtin_amdgcn_mfma_f32_32x32x16_bf16(vf, pa, o[dt], 0, 0, 0);
                }
            }
        bf16* op = ao + tok * D + hq * HD;
#pragma unroll
        for (int dt = 0; dt < 2; ++dt)
#pragma unroll
            for (int g = 0; g < 4; ++g) {
                v2u w; w.x = pg8::cvt_pk_bf16(o[dt][4 * g + 0] * inv, o[dt][4 * g + 1] * inv); w.y = pg8::cvt_pk_bf16(o[dt][4 * g + 2] * inv, o[dt][4 * g + 3] * inv);
                *(GAS v2u*)(op + 32 * dt + 8 * g + 4 * hi) = w;
            }
    }
    __syncthreads();
}
__device__ __forceinline__ void conv_item(int item, const bf16* z, const float* cw, bf16* ci, int tid) {
    const int c8 = tid & 255, half = tid >> 8, t0 = 32 * item + 16 * half, c0 = 8 * c8;
    float w0[8], w1[8], w2[8], u1[8], u2[8];
#pragma unroll
    for (int e = 0; e < 8; ++e) { w0[e] = cw[c0 + e]; w1[e] = cw[2048 + c0 + e]; w2[e] = cw[4096 + c0 + e]; u1[e] = 0.f; u2[e] = 0.f; }
    if ((t0 & (SEQ - 1)) != 0) {
#pragma unroll
        for (int k = 0; k < 2; ++k) {
            const bf16* zr = z + (size_t)(t0 - 2 + k) * IN_W + c0;
            const v4u a = *(const GAS v4u*)(zr + CC_OFF), h = *(const GAS v4u*)(zr + CH_OFF);
            float u[8];
            u[0] = pg8::bf_lo(a.x) * pg8::bf_lo(h.x); u[1] = pg8::bf_hi(a.x) * pg8::bf_hi(h.x); u[2] = pg8::bf_lo(a.y) * pg8::bf_lo(h.y); u[3] = pg8::bf_hi(a.y) * pg8::bf_hi(h.y);
            u[4] = pg8::bf_lo(a.z) * pg8::bf_lo(h.z); u[5] = pg8::bf_hi(a.z) * pg8::bf_hi(h.z); u[6] = pg8::bf_lo(a.w) * pg8::bf_lo(h.w); u[7] = pg8::bf_hi(a.w) * pg8::bf_hi(h.w);
#pragma unroll
            for (int e = 0; e < 8; ++e) { if (k == 0) u2[e] = u[e]; else u1[e] = u[e]; }
        }
    }
#pragma unroll 4
    for (int i = 0; i < 16; ++i) {
        const bf16* zr = z + (size_t)(t0 + i) * IN_W + c0;
        const v4u a = *(const GAS v4u*)(zr + CC_OFF), h = *(const GAS v4u*)(zr + CH_OFF), bb = *(const GAS v4u*)(zr + CB_OFF);
        float u[8], cb[8], y[8];
        u[0] = pg8::bf_lo(a.x) * pg8::bf_lo(h.x); u[1] = pg8::bf_hi(a.x) * pg8::bf_hi(h.x); u[2] = pg8::bf_lo(a.y) * pg8::bf_lo(h.y); u[3] = pg8::bf_hi(a.y) * pg8::bf_hi(h.y);
        u[4] = pg8::bf_lo(a.z) * pg8::bf_lo(h.z); u[5] = pg8::bf_hi(a.z) * pg8::bf_hi(h.z); u[6] = pg8::bf_lo(a.w) * pg8::bf_lo(h.w); u[7] = pg8::bf_hi(a.w) * pg8::bf_hi(h.w);
        cb[0] = pg8::bf_lo(bb.x); cb[1] = pg8::bf_hi(bb.x); cb[2] = pg8::bf_lo(bb.y); cb[3] = pg8::bf_hi(bb.y); cb[4] = pg8::bf_lo(bb.z); cb[5] = pg8::bf_hi(bb.z); cb[6] = pg8::bf_lo(bb.w); cb[7] = pg8::bf_hi(bb.w);
#pragma unroll
        for (int e = 0; e < 8; ++e) { y[e] = cb[e] * (w0[e] * u2[e] + w1[e] * u1[e] + w2[e] * u[e]); u2[e] = u1[e]; u1[e] = u[e]; }
        v4u o; o.x = pk2(y[0], y[1]); o.y = pk2(y[2], y[3]); o.z = pk2(y[4], y[5]); o.w = pk2(y[6], y[7]);
        *(GAS v4u*)(ci + (size_t)(t0 + i) * D + c0) = o;
    }
}

__device__ __forceinline__ void ln1_row(float* r1row, bf16* hbrow, const float* g, const float* bta, int lane) {
    GAS f32x4* xr = (GAS f32x4*)r1row + lane;
    f32x4 v[8]; float s = 0.f;
#pragma unroll
    for (int j = 0; j < 8; ++j) { v[j] = xr[64 * j]; s += (v[j].x + v[j].y) + (v[j].z + v[j].w); }
    const float mean = wave_sum(s) * (1.f / D); float s2 = 0.f;
#pragma unroll
    for (int j = 0; j < 8; ++j) { v[j] = v[j] - mean; s2 += (v[j].x * v[j].x + v[j].y * v[j].y) + (v[j].z * v[j].z + v[j].w * v[j].w); }
    const float rstd = 1.f / sqrtf(wave_sum(s2) * (1.f / D) + LN_EPS);
    GAS v2u* o8 = (GAS v2u*)hbrow + lane;
#pragma unroll
    for (int j = 0; j < 8; ++j) {
        const f32x4 gg = *((const GAS f32x4*)g + lane + 64 * j), bb = *((const GAS f32x4*)bta + lane + 64 * j);
        const f32x4 y = v[j] * rstd * gg + bb;
        xr[64 * j] = y;
        v2u w; w.x = pk2(y.x, y.y); w.y = pk2(y.z, y.w); o8[64 * j] = w;
    }
}

constexpr int TK_ROWF = 136;
constexpr int TK_IDX_OFF = 256 * TK_ROWF * 4;
__device__ __forceinline__ void topk_pass(int pass, const float* scores, int* experts, float* gates, LAS unsigned char* lds, int tid) {
    LAS float* S = (LAS float*)lds;
    LAS unsigned char* IDX = lds + TK_IDX_OFF;
    const float* src = scores + (size_t)pass * (256 * 128);
#pragma unroll 4
    for (int i = 0; i < 16; ++i) { const int f4 = tid + NTHREADS * i, row = f4 >> 5, c4 = f4 & 31; *(LAS f32x4*)(S + row * TK_ROWF + 4 * c4) = *(const GAS f32x4*)(src + (size_t)f4 * 4); }
    __syncthreads();
    const int row = tid >> 1, sub = tid & 1;
    float L[16];
#pragma unroll
    for (int j = 0; j < 16; ++j) L[j] = -INFINITY;
#pragma unroll 2
    for (int i = 0; i < 16; ++i) {
        const int c4 = 2 * i + sub;
        const f32x4 v = *(const LAS f32x4*)(S + row * TK_ROWF + 4 * c4);
#pragma unroll
        for (int e = 0; e < 4; ++e) {
            const float ve = v[e];
            float x = __uint_as_float((__float_as_uint(ve) & ~0x7Fu) | (unsigned)(4 * c4 + e));
#pragma unroll
            for (int j = 0; j < 16; ++j) { const float h = vmaxf(L[j], x); x = vminf(L[j], x); L[j] = h; }
        }
    }
    {
        float P[16];
#pragma unroll
        for (int j = 0; j < 16; ++j) P[j] = __shfl_xor(L[j], 1);
#pragma unroll
        for (int j = 0; j < 16; ++j) L[j] = vmaxf(L[j], P[15 - j]);
#pragma unroll
        for (int st = 8; st >= 1; st >>= 1)
#pragma unroll
            for (int j = 0; j < 16; ++j) if ((j & st) == 0) { const float h = vmaxf(L[j], L[j + st]), l = vminf(L[j], L[j + st]); L[j] = h; L[j + st] = l; }
    }
    if (sub == 0) {
#pragma unroll
        for (int q = 0; q < 4; ++q) {
            unsigned w = 0;
#pragma unroll
            for (int e = 0; e < 4; ++e) w |= (__builtin_bit_cast(unsigned, L[4 * q + e]) & 0x7Fu) << (8 * e);
            *(LAS unsigned*)(IDX + row * 16 + 4 * q) = w;
        }
    }
    float A[16], B[16];
#pragma unroll
    for (int j = 0; j < 16; ++j) { const float o = __shfl_xor(L[j], 2); const bool isb = (tid & 2) != 0; A[j] = isb ? o : L[j]; B[j] = isb ? L[j] : o; }
    float F[16];
#pragma unroll
    for (int j = 0; j < 16; ++j) F[j] = -INFINITY;
#pragma unroll
    for (int i = 0; i < 16; ++i)
#pragma unroll
        for (int j = 0; j < 16; ++j) if ((i + 1) * (j + 1) <= 16) {
            const float sm = A[i] + B[j];
            float x = __builtin_bit_cast(float, (__builtin_bit_cast(unsigned, sm) & ~0xFFu) | (unsigned)(i * 16 + j));
#pragma unroll
            for (int k = 0; k < 16; ++k) { const float h = vmaxf(F[k], x); x = vminf(F[k], x); F[k] = h; }
        }
    __syncthreads();
    if ((tid & 3) == 0) {
        const int rowA = (tid >> 2) * 2, rowB = rowA + 1;
        const size_t prob = (size_t)pass * 128 + (tid >> 2);
        float g[16]; int ex[16]; float gs = 0.f;
#pragma unroll
        for (int k = 0; k < 16; ++k) {
            const unsigned code = __builtin_bit_cast(unsigned, F[k]) & 0xFFu;
            const int ia = IDX[rowA * 16 + (code >> 4)], ib = IDX[rowB * 16 + (code & 15)];
            ex[k] = ia * PNK + ib;
            g[k] = __expf(F[k] - F[0]); gs += g[k];
        }
        const float ginv = 1.0f / gs;
#pragma unroll
        for (int q = 0; q < 4; ++q) {
            *(GAS f32x4*)(gates + prob * 16 + 4 * q) = (f32x4){g[4 * q] * ginv, g[4 * q + 1] * ginv, g[4 * q + 2] * ginv, g[4 * q + 3] * ginv};
            typedef int i32x4 __attribute__((ext_vector_type(4)));
            *(GAS i32x4*)(experts + prob * 16 + 4 * q) = (i32x4){ex[4 * q], ex[4 * q + 1], ex[4 * q + 2], ex[4 * q + 3]};
        }
    }
    __syncthreads();
}

__device__ __forceinline__ float gelu_erf(float v) { return 0.5f * v * (1.0f + erff(v * 0.70710678118654752f)); }
typedef __bf16 bf16x2_t __attribute__((ext_vector_type(2)));
__device__ __forceinline__ float dot2bf(unsigned a, unsigned b, float acc) { return __builtin_amdgcn_fdot2_f32_bf16(__builtin_bit_cast(bf16x2_t, a), __builtin_bit_cast(bf16x2_t, b), acc, false); }
__device__ __forceinline__ float dot8bf(const v4u a, const v4u b, float acc) { acc = dot2bf(a.x, b.x, acc); acc = dot2bf(a.y, b.y, acc); acc = dot2bf(a.z, b.z, acc); return dot2bf(a.w, b.w, acc); }
__device__ __forceinline__ void axpy8bf(float (&y)[8], const v4u v, float w) {
    y[0] += w * pg8::bf_lo(v.x); y[1] += w * pg8::bf_hi(v.x); y[2] += w * pg8::bf_lo(v.y); y[3] += w * pg8::bf_hi(v.y);
    y[4] += w * pg8::bf_lo(v.z); y[5] += w * pg8::bf_hi(v.z); y[6] += w * pg8::bf_lo(v.w); y[7] += w * pg8::bf_hi(v.w);
}
__device__ __forceinline__ void peer_token(int t, const float* h1, const bf16* h1b, const int* experts, const float* gates, const bf16* utab, const bf16* vtab,
                                           const float* g2, const float* b2, float* out, LAS unsigned char* lds, int tid) {
    const int lane = tid & 63, wid = __builtin_amdgcn_readfirstlane(tid >> 6);
    v4u xb[4]; float ya[4][8];
#pragma unroll
    for (int j = 0; j < 4; ++j) { xb[j] = *((const GAS v4u*)(h1b + (size_t)t * D) + lane + 64 * j);
#pragma unroll
        for (int e = 0; e < 8; ++e) ya[j][e] = 0.f; }
    const int* ep = experts + ((size_t)t * PH + wid) * PTOPK;
    const float* gp = gates + ((size_t)t * PH + wid) * PTOPK;
#pragma unroll 1
    for (int k = 0; k < PTOPK; k += 4) {
        v4u ur[4][4], vr[4][4]; float g[4], d[4];
#pragma unroll
        for (int r = 0; r < 4; ++r) { const int e = __builtin_amdgcn_readfirstlane(ep[k + r]); g[r] = gp[k + r];
            const GAS v4u* up = (const GAS v4u*)(utab + (size_t)e * D) + lane; const GAS v4u* vp = (const GAS v4u*)(vtab + (size_t)e * D) + lane;
#pragma unroll
            for (int j = 0; j < 4; ++j) ur[r][j] = up[64 * j];
#pragma unroll
            for (int j = 0; j < 4; ++j) vr[r][j] = vp[64 * j]; }
#pragma unroll
        for (int r = 0; r < 4; ++r) { float a = 0.f, b = 0.f; a = dot8bf(ur[r][0], xb[0], a); b = dot8bf(ur[r][1], xb[1], b); a = dot8bf(ur[r][2], xb[2], a); b = dot8bf(ur[r][3], xb[3], b); d[r] = a + b; }
#pragma unroll
        for (int r = 0; r < 4; ++r) d[r] = wave_sum(d[r]);
#pragma unroll
        for (int r = 0; r < 4; ++r) { const float w = g[r] * gelu_erf(d[r]);
#pragma unroll
            for (int j = 0; j < 4; ++j) axpy8bf(ya[j], vr[r][j], w); }
    }
    LAS f32x4* Y4 = (LAS f32x4*)lds;
    LAS float* RED = (LAS float*)(lds + 65536);
#pragma unroll
    for (int j = 0; j < 4; ++j) { Y4[wid * 512 + 2 * (lane + 64 * j)] = (f32x4){ya[j][0], ya[j][1], ya[j][2], ya[j][3]}; Y4[wid * 512 + 2 * (lane + 64 * j) + 1] = (f32x4){ya[j][4], ya[j][5], ya[j][6], ya[j][7]}; }
    __syncthreads();
    f32x4 y = Y4[tid];
#pragma unroll
    for (int w = 1; w < 8; ++w) y += Y4[w * 512 + tid];
    const f32x4 hx = *((const GAS f32x4*)(h1 + (size_t)t * D) + tid);
    f32x4 r = hx * ALPHA + y;
    float s = wave_sum((r.x + r.y) + (r.z + r.w));
    if (lane == 0) RED[wid] = s;
    __syncthreads();
    float tot = 0.f;
#pragma unroll
    for (int w = 0; w < 8; ++w) tot += RED[w];
    const float mean = tot * (1.f / D);
    r = r - mean;
    float s2 = wave_sum((r.x * r.x + r.y * r.y) + (r.z * r.z + r.w * r.w));
    if (lane == 0) RED[8 + wid] = s2;
    __syncthreads();
    float tot2 = 0.f;
#pragma unroll
    for (int w = 0; w < 8; ++w) tot2 += RED[8 + w];
    const float rstd = 1.f / sqrtf(tot2 * (1.f / D) + LN_EPS);
    const f32x4 gg = *((const GAS f32x4*)g2 + tid), bb = *((const GAS f32x4*)b2 + tid);
    *((GAS f32x4*)(out + (size_t)t * D) + tid) = r * rstd * gg + bb;
    __syncthreads();
}

struct Args { const float* in[16]; float* out; unsigned char* ws; int ph_lo, ph_hi; };
__global__ void __launch_bounds__(NTHREADS, 2) mk_fwd(Args args) {
    extern __shared__ __attribute__((aligned(16))) unsigned char lds_raw[];
    LAS unsigned char* lds = (LAS unsigned char*)lds_raw;
    volatile LAS unsigned* MISC = (volatile LAS unsigned*)(lds + MISC_OFF);
    const int tid0 = threadIdx.x;
    const int G = gridDim.x, bx = blockIdx.x;
    unsigned char* ws = args.ws;
    gu32* ctl = (gu32*)(ws + WS_CTL);
#define IN_(i) (args.in[i])
#define x_in IN_(0)
#define w_in IN_(1)
#define b_gate IN_(2)
#define sinks IN_(3)
#define conv_w IN_(4)
#define w_ao IN_(5)
#define w_co IN_(6)
#define w_o IN_(7)
#define ln1_g IN_(8)
#define ln1_b IN_(9)
#define w_q IN_(10)
#define sub_keys IN_(11)
#define peer_u IN_(12)
#define peer_v IN_(13)
#define ln2_g IN_(14)
#define ln2_b IN_(15)
#define WinT ((bf16*)(ws + WS_WIN))
#define WaT ((bf16*)(ws + WS_WA))
#define WcT ((bf16*)(ws + WS_WC))
#define WoT ((bf16*)(ws + WS_WO))
#define WfT ((bf16*)(ws + WS_WF))
#define XB ((bf16*)(ws + WS_XB))
#define MERGED ((bf16*)(ws + WS_MERGED))
#define Z ((bf16*)(ws + WS_Z))
#define H1 ((float*)(ws + WS_H1))
#define H1B ((bf16*)(ws + WS_H1B))
#define SC ((float*)(ws + WS_SC))
#define EX ((int*)(ws + WS_EX))
#define GT ((float*)(ws + WS_GT))
#define AO ((bf16*)(ws + WS_AO))
#define CI ((bf16*)(ws + WS_CI))
#define TMP ((bf16*)(ws + WS_TMP))
#define UB ((bf16*)(ws + WS_UB))
#define VB ((bf16*)(ws + WS_VB))
    for (int u = tid0; u < (LDS_BYTES - LDSCTL_OFF) / 4; u += NTHREADS) ((LAS unsigned*)(lds + LDSCTL_OFF))[u] = 0u;
    __syncthreads();
    XcdBarrier bar; bar.bar = (unsigned*)(ctl + CW_BAR); bar.x = 0; bar.st = nullptr;
    if (!MK_PER_PHASE) bar = xcd_barrier_post((unsigned*)(ctl + CW_BAR), MISC + 8);
    const int lo = args.ph_lo, hi = args.ph_hi;
#ifndef PH_MASK
#define PH_MASK 0x1FF
#endif
#define IN(k) (((PH_MASK >> (k)) & 1) && lo <= (k) && (k) < hi)
#define SEAM(k) do { if (IN(k) && IN((k) + 1)) xcd_barrier(bar); } while (0)
#define PHASE_TID() int tid = tid0; asm volatile("" : "+v"(tid)); const int lane = tid & 63, wave = __builtin_amdgcn_readfirstlane(tid >> 6); (void)lane; (void)wave

    if (IN(0)) {
        PHASE_TID();
        for (int it = bx; it < 16 * 32; it += G) p0_wf_item(w_q, sub_keys, WfT, lds, it, tid);
        LAS float* scr = (LAS float*)(lds + wave * 16384);
        const int gw = bx * NWAVES + wave, NGW = G * NWAVES;
        constexpr int I_IN = (D / 64) * (IN_W / 32), I_SQ = (D / 64) * (D / 32);
        for (int it = gw; it < I_IN + 3 * I_SQ; it += NGW) {
            int r = it;
            if (r < I_IN) { p0_transpose_item(w_in, D, IN_W, WinT, scr, r, lane); continue; } r -= I_IN;
            if (r < I_SQ) { p0_transpose_item(w_ao, D, D, WaT, scr, r, lane); continue; } r -= I_SQ;
            if (r < I_SQ) { p0_transpose_item(w_co, D, D, WcT, scr, r, lane); continue; } r -= I_SQ;
            p0_transpose_item(w_o, D, D, WoT, scr, r, lane);
        }
        const size_t n8 = (size_t)M * D / 8;
        for (size_t i = (size_t)bx * NTHREADS + tid; i < n8; i += (size_t)G * NTHREADS) {
            const f32x4 a = *((const GAS f32x4*)x_in + 2 * i), b = *((const GAS f32x4*)x_in + 2 * i + 1);
            v4u o; o.x = pk2(a.x, a.y); o.y = pk2(a.z, a.w); o.z = pk2(b.x, b.y); o.w = pk2(b.z, b.w);
            *((GAS v4u*)XB + i) = o;
        }
    }
    SEAM(0);
    if (IN(1)) {
        pg8::Gemm g{XB, WinT, M, IN_W, D}; pg8::StaticOrder S; S.init(M, IN_W, G, bx);
        pg8::EpiBf16 E{Z, IN_W};
        pg8::gemm_phase<pg8::EpiBf16, pg8::StaticOrder, true, true>(lds, g, S, E);
    }
    SEAM(1);
    if (IN(2)) {
        PHASE_TID();
        for (int u = bx; u < BATCH * NKVH * 16; u += G) attn_unit(u, Z, AO, sinks, lds, tid);
        for (int it = bx; it < M / 32; it += G) conv_item(it, Z, conv_w, CI, tid);
    }
    SEAM(2);
    if (IN(3)) {
        pg8::StaticOrder S; S.init(M, D, G, bx);
        { pg8::Gemm g{AO, WaT, M, D, D}; pg8::EpiGate<0> E{TMP, nullptr, Z + G_OFF, b_gate, D, IN_W};
          pg8::gemm_phase<pg8::EpiGate<0>, pg8::StaticOrder, true, true>(lds, g, S, E); }
        { pg8::Gemm g{CI, WcT, M, D, D}; pg8::EpiGate<1> E{MERGED, TMP, Z + G_OFF + D, b_gate + D, D, IN_W};
          pg8::gemm_phase<pg8::EpiGate<1>, pg8::StaticOrder, true, true>(lds, g, S, E); }
    }
    SEAM(3);
    if (IN(4)) {
        pg8::Gemm g{MERGED, WoT, M, D, D}; pg8::StaticOrder S; S.init(M, D, G, bx);
        pg8::EpiF32 E{H1, D, x_in, ALPHA};
        pg8::gemm_phase<pg8::EpiF32, pg8::StaticOrder, true, true>(lds, g, S, E);
    }
    SEAM(4);
    if (IN(5)) {
        PHASE_TID();
        const int gw = bx * NWAVES + wave, NGW = G * NWAVES;
        for (int m = gw; m < M; m += NGW) ln1_row(H1 + (size_t)m * D, H1B + (size_t)m * D, ln1_g, ln1_b, lane);
        const size_t n8 = (size_t)PNE * D / 8;
        for (size_t i = (size_t)bx * NTHREADS + tid; i < 2 * n8; i += (size_t)G * NTHREADS) {
            const bool sec = i >= n8; const size_t ii = sec ? i - n8 : i;
            const GAS f32x4* src = (const GAS f32x4*)(sec ? peer_v : peer_u) + 2 * ii;
            const f32x4 a = src[0], b = src[1];
            v4u o; o.x = pk2(a.x, a.y); o.y = pk2(a.z, a.w); o.z = pk2(b.x, b.y); o.w = pk2(b.z, b.w);
            *((GAS v4u*)(sec ? VB : UB) + ii) = o;
        }
    }
    SEAM(5);
    if (IN(6)) {
        pg8::Gemm g{H1B, WfT, M, D, D}; pg8::StaticOrder S; S.init(M, D, G, bx);
        pg8::EpiF32 E{SC, D, nullptr, 0.f};
        pg8::gemm_phase<pg8::EpiF32, pg8::StaticOrder, true, true>(lds, g, S, E);
    }
    SEAM(6);
    if (IN(7)) {
        PHASE_TID();
        for (int p = bx; p < (M * PH) / 128; p += G) topk_pass(p, SC, EX, GT, lds, tid);
    }
    SEAM(7);
    if (IN(8)) {
        PHASE_TID();
        for (int t = bx; t < M; t += G) peer_token(t, H1, H1B, EX, GT, UB, VB, ln2_g, ln2_b, args.out, lds, tid);
    }
#undef IN
#undef SEAM
}

extern "C" void kernel_launch(void* const* d_in, const int* in_sizes, int n_in, void* d_out, int out_size, void* d_ws, size_t ws_size, hipStream_t stream) {
    static int grid = 0;
    if (grid == 0) {
        if (n_in != 16 || out_size != M * D || ws_size < WS_END) { fprintf(stderr, "kernel_launch: unexpected shapes (n_in %d out %d ws %zu)\n", n_in, out_size, ws_size); grid = -1; return; }
        int dev = 0, cus = 0, per_cu = 0;
        if (hipGetDevice(&dev) != hipSuccess || hipDeviceGetAttribute(&cus, hipDeviceAttributeMultiprocessorCount, dev) != hipSuccess) { grid = -1; return; }
        if (hipFuncSetAttribute((const void*)mk_fwd, hipFuncAttributeMaxDynamicSharedMemorySize, LDS_BYTES) != hipSuccess) { fprintf(stderr, "kernel_launch: hipFuncSetAttribute failed\n"); grid = -1; return; }
        if (hipOccupancyMaxActiveBlocksPerMultiprocessor(&per_cu, (const void*)mk_fwd, NTHREADS, LDS_BYTES) != hipSuccess || per_cu < 1) { fprintf(stderr, "kernel_launch: occupancy query says %d\n", per_cu); per_cu = 1; }
        (void)hipGetLastError();
        if (per_cu > 1) per_cu = 1;
        grid = cus * per_cu;
    }
    if (grid < 0) return;
    if (hipMemsetAsync((char*)d_ws + WS_CTL, 0, CTL_ZERO_BYTES, stream) != hipSuccess) { fprintf(stderr, "kernel_launch: memset failed\n"); return; }
    Args a{};
    for (int i = 0; i < 16; ++i) a.in[i] = (const float*)d_in[i];
    a.out = (float*)d_out; a.ws = (unsigned char*)d_ws;
#if MK_PER_PHASE
    for (int p = 0; p < N_PHASES; ++p) { a.ph_lo = p; a.ph_hi = p + 1; hipLaunchKernelGGL(mk_fwd, dim3(grid), dim3(NTHREADS), LDS_BYTES, stream, a); }
#else
    a.ph_lo = 0; a.ph_hi = N_PHASES;
    void* kargs[] = {&a};
    hipError_t e = hipLaunchCooperativeKernel((const void*)mk_fwd, dim3(grid), dim3(NTHREADS), kargs, LDS_BYTES, stream);
    if (e != hipSuccess) fprintf(stderr, "kernel_launch: cooperative launch failed: %s (grid %d)\n", hipGetErrorString(e), grid);
#endif
}
```

```cpp
#include <hip/hip_runtime.h>
#include <cstdio>
#include <cstdint>
namespace pg8 {
#define PG8_LAS __attribute__((address_space(3)))
typedef unsigned short bf16_t;
typedef short bf16x8 __attribute__((ext_vector_type(8)));
typedef float f32x4 __attribute__((ext_vector_type(4)));
typedef unsigned u32x4 __attribute__((ext_vector_type(4)));
constexpr int BM = 256, BK = 64, HALF = 128, HTB = HALF * BK * 2  , STAGE_BYTES = 8 * HTB, NXCD = 8, WGM = 8;

__host__ __device__ __forceinline__ int lds_byte(int r, int c) { const int st = (r >> 4) * 2 + (c >> 5), rr = r & 15, cc = c & 31, ob = rr * 64 + cc * 2; return st * 1024 + (ob ^ (((ob >> 9) & 1) << 5)); }
__host__ __device__ __forceinline__ void stage_rc(int b, int& R, int& C) { const int st = b / 1024, sb = b % 1024, swz = sb ^ (((sb >> 9) & 1) << 5); R = (st >> 1) * 16 + swz / 64; C = (st & 1) * 32 + (swz % 64) / 2; }
__host__ __device__ __forceinline__ int perm32(int rho) { const int n = rho >> 4, i = rho & 15; return 8 * (i >> 2) + 4 * n + (i & 3); }

struct Unit { int pm, pn; };
struct Gemm { const bf16_t* A; const bf16_t* Bt; int M, N, K; };

struct StaticOrder {
    int nM, nN, nwg, G, c;
    __host__ __device__ void init(int M, int N, int G_, int c_) { nM = M / BM; nN = N / BM; nwg = nM * nN; G = G_; c = c_; }
    __host__ __device__ bool next(int i, Unit& u) const {
        const long L = (long)i * G + c; if (L >= nwg) return false;
        int wgid = (int)L; { const int q = nwg / NXCD, r = nwg % NXCD, xcd = wgid % NXCD, off = wgid / NXCD; wgid = (xcd < r ? xcd * (q + 1) : r * (q + 1) + (xcd - r) * q) + off; }
        const int nig = WGM * nN, gid = wgid / nig, fm = gid * WGM, gsz = (nM - fm) < WGM ? (nM - fm) : WGM;
        u.pm = fm + ((wgid % nig) % gsz); u.pn = (wgid % nig) / gsz; return true;
    }
    __device__ __forceinline__ void a_ready(const Unit&) const {}
    __device__ __forceinline__ void done(const Unit&) const {}
};


__device__ __forceinline__ unsigned cvt_pk_bf16(float lo, float hi) { unsigned r; asm volatile("v_cvt_pk_bf16_f32 %0, %1, %2" : "=v"(r) : "v"(lo), "v"(hi)); return r; }
__device__ __forceinline__ float bf_lo(unsigned w) { return __builtin_bit_cast(float, w << 16); }
__device__ __forceinline__ float bf_hi(unsigned w) { return __builtin_bit_cast(float, w & 0xffff0000u); }
__device__ __forceinline__ float sigmoidf_(float x) { return __builtin_amdgcn_rcpf(1.0f + __expf(-x)); }

struct EpiBf16 {
    static constexpr bool PERM = true, AFTER_DRAIN = false;
    bf16_t* O; int ldc;
    __device__ __forceinline__ void operator()(const f32x4 (&acc)[2][2][4][2], const Unit& u, int wr, int wc, int fr, int fq) const {
        const int row0 = u.pm * BM + wr * 64 + fr, col0 = u.pn * BM + wc * 32 + 8 * fq;
#pragma unroll
        for (int ai = 0; ai < 2; ++ai)
#pragma unroll
            for (int m = 0; m < 4; ++m) { bf16_t* rowp = O + (size_t)(row0 + ai * HALF + m * 16) * ldc + col0;
#pragma unroll
                for (int bj = 0; bj < 2; ++bj) { const f32x4 v0 = acc[ai][bj][m][0], v1 = acc[ai][bj][m][1];
                    u32x4 w; w.x = cvt_pk_bf16(v0[0], v0[1]); w.y = cvt_pk_bf16(v0[2], v0[3]); w.z = cvt_pk_bf16(v1[0], v1[1]); w.w = cvt_pk_bf16(v1[2], v1[3]);
                    *(u32x4*)(rowp + bj * HALF) = w; } }
    }
};
template <int SECOND> struct EpiGate {
    static constexpr bool PERM = true, AFTER_DRAIN = false;
    bf16_t* O; const bf16_t* T; const bf16_t* Zg; const float* bg; int ldc, ldz;
    __device__ __forceinline__ void operator()(const f32x4 (&acc)[2][2][4][2], const Unit& u, int wr, int wc, int fr, int fq) const {
        const int row0 = u.pm * BM + wr * 64 + fr, col0 = u.pn * BM + wc * 32 + 8 * fq;
        f32x4 bv[2][2];
#pragma unroll
        for (int bj = 0; bj < 2; ++bj)
#pragma unroll
            for (int n = 0; n < 2; ++n) bv[bj][n] = *(const f32x4*)(bg + col0 + bj * HALF + 4 * n);
#pragma unroll
        for (int ai = 0; ai < 2; ++ai)
#pragma unroll
            for (int m = 0; m < 4; ++m) { const size_t row = (size_t)(row0 + ai * HALF + m * 16);
#pragma unroll
                for (int bj = 0; bj < 2; ++bj) { const int c = col0 + bj * HALF;
                    const u32x4 zg = *(const u32x4*)(Zg + row * ldz + c);
                    f32x4 v0 = acc[ai][bj][m][0], v1 = acc[ai][bj][m][1];
                    v0[0] *= sigmoidf_(bf_lo(zg.x) + bv[bj][0][0]); v0[1] *= sigmoidf_(bf_hi(zg.x) + bv[bj][0][1]);
                    v0[2] *= sigmoidf_(bf_lo(zg.y) + bv[bj][0][2]); v0[3] *= sigmoidf_(bf_hi(zg.y) + bv[bj][0][3]);
                    v1[0] *= sigmoidf_(bf_lo(zg.z) + bv[bj][1][0]); v1[1] *= sigmoidf_(bf_hi(zg.z) + bv[bj][1][1]);
                    v1[2] *= sigmoidf_(bf_lo(zg.w) + bv[bj][1][2]); v1[3] *= sigmoidf_(bf_hi(zg.w) + bv[bj][1][3]);
                    if (SECOND) { const u32x4 t = *(const u32x4*)(T + row * ldc + c);
                        v0[0] += bf_lo(t.x); v0[1] += bf_hi(t.x); v0[2] += bf_lo(t.y); v0[3] += bf_hi(t.y);
                        v1[0] += bf_lo(t.z); v1[1] += bf_hi(t.z); v1[2] += bf_lo(t.w); v1[3] += bf_hi(t.w); }
                    u32x4 w; w.x = cvt_pk_bf16(v0[0], v0[1]); w.y = cvt_pk_bf16(v0[2], v0[3]); w.z = cvt_pk_bf16(v1[0], v1[1]); w.w = cvt_pk_bf16(v1[2], v1[3]);
                    *(u32x4*)(O + row * ldc + c) = w; } }
    }
};
struct EpiF32 {
    static constexpr bool PERM = false, AFTER_DRAIN = false;
    float* C; int ldc; const float* R; float scale;
    __device__ __forceinline__ void operator()(const f32x4 (&acc)[2][2][4][2], const Unit& u, int wr, int wc, int fr, int fq) const {
        const int row0 = u.pm * BM + wr * 64 + fr, col0 = u.pn * BM + wc * 32 + 4 * fq;
#pragma unroll
        for (int ai = 0; ai < 2; ++ai)
#pragma unroll
            for (int m = 0; m < 4; ++m) { const size_t off = (size_t)(row0 + ai * HALF + m * 16) * ldc + col0;
#pragma unroll
                for (int bj = 0; bj < 2; ++bj)
#pragma unroll
                    for (int n = 0; n < 2; ++n) { f32x4 v = acc[ai][bj][m][n];
                        if (R) v += *(const f32x4*)(R + off + bj * HALF + n * 16) * scale;
                        *(f32x4*)(C + off + bj * HALF + n * 16) = v; } }
    }
};

template <class Epi, class Sched, bool ALIGN_EPI = false, bool SP2 = false>
__device__ __forceinline__ void gemm_phase(PG8_LAS unsigned char* lds, const Gemm g, const Sched& S, const Epi& E) {
    int tid_ = threadIdx.x; asm volatile("" : "+v"(tid_));
    const int tid = tid_, wid = __builtin_amdgcn_readfirstlane(tid >> 6), lane = tid & 63, wr = wid >> 2, wc = wid & 3, fr = lane & 15, fq = lane >> 4;
    const int K = g.K, nt = K / BK;
    unsigned voffA[2], voffB[2];
#pragma unroll
    for (int i = 0; i < 2; ++i) { int R, C; stage_rc(tid * 16 + i * 8192, R, C); const int Rb = Epi::PERM ? ((R & ~31) + perm32(R & 31)) : R;
        voffA[i] = (unsigned)(R * K + C) * 2u; voffB[i] = (unsigned)(Rb * K + C) * 2u; }
    const size_t kstep = (size_t)(BK * 2);
    const size_t hstep = (size_t)HALF * K * 2;
    const size_t tstep = 2 * hstep;
    const unsigned ldsw = (unsigned)wid * 1024u;
    const int aoff = lds_byte(wr * 64 + fr, fq * 8), boff = lds_byte(wc * 32 + fr, fq * 8);
#define PG8_SA(b, h) (((b) * 2 + (h)) * HTB)
#define PG8_SB(b, h) ((4 + (b) * 2 + (h)) * HTB)
#define PG8_STAGE(bufoff, gbase, voff) do { _Pragma("unroll") for (int _i = 0; _i < 2; ++_i) \
        __builtin_amdgcn_global_load_lds((const unsigned*)((const char*)(gbase) + (voff)[_i]), (PG8_LAS unsigned*)(lds + (bufoff) + ldsw + _i * 8192), 16, 0, 0); } while (0)
#define PG8_LDA(dst, b, h) do { _Pragma("unroll") for (int m = 0; m < 4; ++m) _Pragma("unroll") for (int k = 0; k < 2; ++k) dst[m][k] = *(const PG8_LAS bf16x8*)(lds + PG8_SA(b, h) + aoff + m * 2048 + k * 1024); } while (0)
#define PG8_LDB(dst, b, h) do { _Pragma("unroll") for (int n = 0; n < 2; ++n) _Pragma("unroll") for (int k = 0; k < 2; ++k) dst[n][k] = *(const PG8_LAS bf16x8*)(lds + PG8_SB(b, h) + boff + n * 2048 + k * 1024); } while (0)
#define PG8_MMA(ai, bj, At, Bt) do { __builtin_amdgcn_s_setprio(1); _Pragma("unroll") for (int m = 0; m < 4; ++m) _Pragma("unroll") for (int n = 0; n < 2; ++n) _Pragma("unroll") for (int k = 0; k < 2; ++k) \
        acc[ai][bj][m][n] = __builtin_amdgcn_mfma_f32_16x16x32_bf16(Bt[n][k], At[m][k], acc[ai][bj][m][n], 0, 0, 0); __builtin_amdgcn_s_setprio(0); } while (0)
#define PG8_WAIT_V(n) asm volatile("s_waitcnt vmcnt(" #n ")" ::: "memory")
#define PG8_WAIT_L(n) asm volatile("s_waitcnt lgkmcnt(" #n ")" ::: "memory")
#define PG8_BAR __builtin_amdgcn_s_barrier()
#define PG8_SCHED __builtin_amdgcn_sched_barrier(0)
    Unit cur, nxt; int ui = 0;
    if (!S.next(0, cur)) return;
    f32x4 acc[2][2][4][2];
#pragma unroll
    for (int a = 0; a < 2; ++a)
#pragma unroll
        for (int b = 0; b < 2; ++b)
#pragma unroll
            for (int m = 0; m < 4; ++m)
#pragma unroll
                for (int n = 0; n < 2; ++n) acc[a][b][m][n] = (f32x4){0.f, 0.f, 0.f, 0.f};
    bf16x8 At[4][2], B0[2][2], B1[2][2];
    const char* cA = (const char*)g.A + (size_t)cur.pm * tstep; const char* cB = (const char*)g.Bt + (size_t)cur.pn * tstep;
    S.a_ready(cur);
    if constexpr (SP2) {
        PG8_STAGE(PG8_SB(0, 0), cB, voffB); PG8_STAGE(PG8_SB(0, 1), cB + hstep, voffB); PG8_STAGE(PG8_SA(0, 0), cA, voffA); PG8_STAGE(PG8_SA(0, 1), cA + hstep, voffA);
        if (wr == 1) PG8_BAR;
        PG8_WAIT_V(2); PG8_BAR;
        PG8_STAGE(PG8_SB(1, 0), cB + kstep, voffB); PG8_STAGE(PG8_SA(1, 0), cA + kstep, voffA); PG8_STAGE(PG8_SB(1, 1), cB + hstep + kstep, voffB);
        PG8_WAIT_V(6); PG8_BAR;
    } else {
        PG8_STAGE(PG8_SB(0, 0), cB, voffB); PG8_STAGE(PG8_SA(0, 0), cA, voffA); PG8_STAGE(PG8_SB(0, 1), cB + hstep, voffB); PG8_STAGE(PG8_SA(0, 1), cA + hstep, voffA);
        if (wr == 1) PG8_BAR;
        PG8_WAIT_V(4); PG8_BAR;
        PG8_STAGE(PG8_SB(1, 0), cB + kstep, voffB); PG8_STAGE(PG8_SA(1, 0), cA + kstep, voffA); PG8_STAGE(PG8_SB(1, 1), cB + hstep + kstep, voffB);
        PG8_WAIT_V(6); PG8_BAR;
    }
    for (;;) {
        const bool has_next = S.next(ui + 1, nxt);
        const char* nA = has_next ? (const char*)g.A + (size_t)nxt.pm * tstep : cA; const char* nB = has_next ? (const char*)g.Bt + (size_t)nxt.pn * tstep : cB;
        for (int t = 0; t < nt; t += 2) {
            const bool last = (t == nt - 2);
            const char* a1 = cA + (size_t)(t + 1) * kstep;
            const char* a2 = last ? nA : cA + (size_t)(t + 2) * kstep; const char* b2 = last ? nB : cB + (size_t)(t + 2) * kstep;
            const char* a3 = a2 + kstep; const char* b3 = b2 + kstep;
            if (last && has_next) S.a_ready(nxt);
            if constexpr (SP2) {
            PG8_LDB(B0, 0, 0); PG8_LDB(B1, 0, 1); PG8_SCHED; PG8_LDA(At, 0, 0); PG8_STAGE(PG8_SA(1, 1), a1 + hstep, voffA);
            PG8_WAIT_V(8); PG8_WAIT_L(0); PG8_BAR; PG8_MMA(0, 0, At, B0); PG8_MMA(0, 1, At, B1); PG8_BAR; PG8_SCHED;
            PG8_LDA(At, 0, 1); PG8_STAGE(PG8_SB(0, 0), b2, voffB); PG8_STAGE(PG8_SB(0, 1), b2 + hstep, voffB); PG8_STAGE(PG8_SA(0, 0), a2, voffA);
            PG8_WAIT_V(8); PG8_WAIT_L(0); PG8_BAR; PG8_MMA(1, 0, At, B0); PG8_MMA(1, 1, At, B1); PG8_BAR; PG8_SCHED;
            PG8_LDB(B0, 1, 0); PG8_LDB(B1, 1, 1); PG8_SCHED; PG8_LDA(At, 1, 0); PG8_STAGE(PG8_SA(0, 1), a2 + hstep, voffA);
            PG8_WAIT_V(8); PG8_WAIT_L(0); PG8_BAR; PG8_MMA(0, 0, At, B0); PG8_MMA(0, 1, At, B1); PG8_BAR; PG8_SCHED;
            PG8_LDA(At, 1, 1); PG8_STAGE(PG8_SB(1, 0), b3, voffB); PG8_STAGE(PG8_SB(1, 1), b3 + hstep, voffB); PG8_STAGE(PG8_SA(1, 0), a3, voffA);
            PG8_WAIT_V(8); PG8_WAIT_L(0); PG8_BAR; PG8_MMA(1, 0, At, B0); PG8_MMA(1, 1, At, B1); PG8_BAR; PG8_SCHED;
            } else {
            PG8_LDB(B0, 0, 0); PG8_SCHED; PG8_LDA(At, 0, 0); PG8_STAGE(PG8_SA(1, 1), a1 + hstep, voffA);
            PG8_WAIT_L(8); PG8_BAR; PG8_WAIT_L(0); PG8_MMA(0, 0, At, B0); PG8_BAR; PG8_SCHED;
            PG8_LDB(B1, 0, 1); PG8_STAGE(PG8_SB(0, 0), b2, voffB);
            PG8_BAR; PG8_WAIT_L(0); PG8_MMA(0, 1, At, B1); PG8_BAR;
            PG8_LDA(At, 0, 1); PG8_STAGE(PG8_SA(0, 0), a2, voffA);
            PG8_BAR; PG8_WAIT_L(0); PG8_MMA(1, 0, At, B0); PG8_BAR; PG8_SCHED;
            PG8_STAGE(PG8_SB(0, 1), b2 + hstep, voffB);
            PG8_WAIT_V(6); PG8_BAR; PG8_MMA(1, 1, At, B1); PG8_BAR;
            PG8_LDB(B0, 1, 0); PG8_SCHED; PG8_LDA(At, 1, 0); PG8_STAGE(PG8_SA(0, 1), a2 + hstep, voffA);
            PG8_WAIT_L(8); PG8_BAR; PG8_WAIT_L(0); PG8_MMA(0, 0, At, B0); PG8_BAR; PG8_SCHED;
            PG8_LDB(B1, 1, 1); PG8_STAGE(PG8_SB(1, 0), b3, voffB);
            PG8_BAR; PG8_WAIT_L(0); PG8_MMA(0, 1, At, B1); PG8_BAR;
            PG8_LDA(At, 1, 1); PG8_STAGE(PG8_SA(1, 0), a3, voffA);
            PG8_BAR; PG8_WAIT_L(0); PG8_MMA(1, 0, At, B0); PG8_BAR; PG8_SCHED;
            PG8_STAGE(PG8_SB(1, 1), b3 + hstep, voffB);
            PG8_WAIT_V(6); PG8_BAR; PG8_MMA(1, 1, At, B1); PG8_BAR;
            }
        }
        if constexpr (ALIGN_EPI) { if (wr == 0) PG8_BAR; }
        if constexpr (!Epi::AFTER_DRAIN) { E(acc, cur, wr, wc, fr, fq); S.done(cur); }
        if (!has_next) break;
#pragma unroll
        for (int a = 0; a < 2; ++a)
#pragma unroll
            for (int b = 0; b < 2; ++b)
#pragma unroll
                for (int m = 0; m < 4; ++m)
#pragma unroll
                    for (int n = 0; n < 2; ++n) acc[a][b][m][n] = (f32x4){0.f, 0.f, 0.f, 0.f};
        cur = nxt; cA = nA; cB = nB; ++ui;
        if constexpr (ALIGN_EPI) { if (wr == 1) PG8_BAR; }
    }
    PG8_WAIT_V(0);
    if constexpr (!ALIGN_EPI) { if (wr == 0) PG8_BAR; }
    PG8_BAR;
    if constexpr (Epi::AFTER_DRAIN) { E.fused(acc, cur, wr, wc, fr, fq, lds, wid, lane); S.done(cur); }
#undef PG8_SA
#undef PG8_SB
#undef PG8_STAGE
#undef PG8_LDA
#undef PG8_LDB
#undef PG8_MMA
#undef PG8_WAIT_V
#undef PG8_WAIT_L
#undef PG8_BAR
#undef PG8_SCHED
}
}
#define GAS __attribute__((address_space(1)))
#define LAS __attribute__((address_space(3)))
typedef unsigned short bf16;
typedef unsigned v4u __attribute__((ext_vector_type(4)));
typedef float f32x4 __attribute__((ext_vector_type(4)));
typedef short bf16x8 __attribute__((ext_vector_type(8)));
typedef GAS unsigned gu32;
typedef GAS unsigned long long gu64;
#define RLX_AGENT __ATOMIC_RELAXED, __HIP_MEMORY_SCOPE_AGENT
#define LDS_WAIT() asm volatile("s_waitcnt lgkmcnt(0)" ::: "memory")
#define VM_WAIT() asm volatile("s_waitcnt vmcnt(0)" ::: "memory")
__device__ __forceinline__ unsigned long long rt() { return __builtin_amdgcn_s_memrealtime(); }
__device__ __forceinline__ unsigned f2bf(float f) { unsigned u = __builtin_bit_cast(unsigned, f); return (u + 0x7fffu + ((u >> 16) & 1u)) >> 16; }
__device__ __forceinline__ unsigned pk2(float lo, float hi) { return f2bf(lo) | (f2bf(hi) << 16); }

#define XB_TMO      128
#define XB_XCNT(j)  (256  + 64 * (j))
#define XB_XSUB(j)  (1280 + 64 * (j))
#define XB_XGEN(j)  (2304 + 64 * (j))
#define XB_TOP      3328
#define XB_TOPGEN   3392
#define XCD_BAR_WORDS 3456
#define XB_SPIN_CAP (1u << 18)

__device__ __forceinline__ unsigned xb_ld(unsigned* p)              { return __hip_atomic_load(p, __ATOMIC_RELAXED, __HIP_MEMORY_SCOPE_AGENT); }
__device__ __forceinline__ unsigned xb_add(unsigned* p, unsigned v) { return __hip_atomic_fetch_add(p, v, __ATOMIC_RELAXED, __HIP_MEMORY_SCOPE_AGENT); }
__device__ __forceinline__ unsigned xb_xcc_id() { return (unsigned)__builtin_amdgcn_s_getreg((3 << 11) | 20) & 0xFu; }
#define XB_SPIN(cond, bar) do { unsigned _sp = 0; while (cond) { __builtin_amdgcn_s_sleep(1); \
    if ((++_sp & 255u) == 0u) { if (xb_ld(&(bar)[XB_TMO])) break; if (_sp > XB_SPIN_CAP) { atomicAdd(&(bar)[XB_TMO], 1u); break; } } } } while (0)

struct XcdBarrier {
    unsigned* bar; unsigned x;
    volatile LAS unsigned* st;
};

__device__ __forceinline__ XcdBarrier xcd_barrier_post(unsigned* bar, volatile LAS unsigned* st) {
    XcdBarrier b; b.bar = bar; b.x = xb_xcc_id(); b.st = st;
    if (threadIdx.x == 0) (void)xb_add(&bar[XB_XCNT(b.x)], 1u);
    return b;
}
__device__ __forceinline__ void xcd_barrier_complete(unsigned* bar, unsigned x, unsigned& nloc, unsigned& nx) {
    const unsigned G = gridDim.x * gridDim.y * gridDim.z;
    unsigned sum, cnt, mine, sp = 0u;
    for (;;) {
        sum = 0u; cnt = 0u; mine = 0u;
#pragma unroll
        for (unsigned j = 0; j < 16; ++j) { const unsigned c = xb_ld(&bar[XB_XCNT(j)]); sum += c; cnt += (c > 0u) ? 1u : 0u; mine = (j == x) ? c : mine; }
        if (sum == G) break;
        __builtin_amdgcn_s_sleep(1);
        if ((++sp & 255u) == 0u) { if (xb_ld(&bar[XB_TMO])) break; if (sp > XB_SPIN_CAP) { atomicAdd(&bar[XB_TMO], 1u); break; } }
    }
    nloc = mine > 0u ? mine : 1u; nx = cnt > 0u ? cnt : 1u;
}

__device__ __forceinline__ void xcd_barrier(const XcdBarrier& b) {
    asm volatile("s_waitcnt vmcnt(0)" ::: "memory");
    __syncthreads();
    if (threadIdx.x == 0) {
        unsigned* bar = b.bar;
        __builtin_amdgcn_s_waitcnt(0);
        unsigned nloc = b.st[0], nx = b.st[1];
        if (nloc == 0u) { xcd_barrier_complete(bar, b.x, nloc, nx); b.st[0] = nloc; b.st[1] = nx; }
        const unsigned old = xb_add(&bar[XB_XSUB(b.x)], 1u);
        const unsigned gen = old / nloc;
        if (old + 1u == (gen + 1u) * nloc) {
            __builtin_amdgcn_fence(__ATOMIC_RELEASE, "agent");
            asm volatile("s_waitcnt vmcnt(0)" ::: "memory");
            const unsigned og = xb_add(&bar[XB_TOP], 1u);
            const unsigned tg = og / nx;
            if (og + 1u == (tg + 1u) * nx) xb_add(&bar[XB_TOPGEN], 1u);
            else XB_SPIN(xb_ld(&bar[XB_TOPGEN]) == tg, bar);
            __builtin_amdgcn_fence(__ATOMIC_ACQUIRE, "agent");
            xb_add(&bar[XB_XGEN(b.x)], 1u);
            asm volatile("s_waitcnt vmcnt(0)" ::: "memory");
        } else {
            XB_SPIN(xb_ld(&bar[XB_XGEN(b.x)]) == gen, bar);
            __builtin_amdgcn_fence(__ATOMIC_ACQUIRE, "agent");
            asm volatile("s_waitcnt vmcnt(0)" ::: "memory");
        }
    }
    __syncthreads();
}

constexpr int NWAVES = 8, NTHREADS = 512;
constexpr int BATCH = 4, SEQ = 2048, D = 2048, M = BATCH * SEQ;
constexpr int NQH = 32, NKVH = 4, HD = 64, QPKV = 8, WINDOW = 128;
constexpr int Q_OFF = 0, K_OFF = 2048, V_OFF = 2304, CB_OFF = 2560, CC_OFF = 4608, CH_OFF = 6656, G_OFF = 8704, IN_W = 12800;
constexpr int PH = 8, PNK = 128, PTOPK = 16, PNE = 16384;
constexpr float LN_EPS = 1e-5f;
constexpr float ALPHA = 1.189207115002721f;

#ifndef MK_PER_PHASE
#define MK_PER_PHASE 0
#endif
constexpr int N_PHASES = 9;

constexpr size_t MiB = 1u << 20;
constexpr size_t WS_CTL = 0, CTL_ZERO_BYTES = 1 * MiB;
constexpr size_t WS_WIN = 1 * MiB;
constexpr size_t WS_WA = 51 * MiB, WS_WC = 59 * MiB, WS_WO = 67 * MiB, WS_WF = 75 * MiB;
constexpr size_t WS_XB = 83 * MiB;
constexpr size_t WS_MERGED = WS_XB;
constexpr size_t WS_Z = 115 * MiB;
constexpr size_t WS_H1 = 115 * MiB;
constexpr size_t WS_H1B = 179 * MiB;
constexpr size_t WS_SC = 211 * MiB;
constexpr size_t WS_EX = 275 * MiB;
constexpr size_t WS_GT = 279 * MiB;
constexpr size_t WS_AO = 315 * MiB, WS_CI = 347 * MiB, WS_TMP = 379 * MiB;
constexpr size_t WS_U8 = 411 * MiB, WS_V8 = 443 * MiB;
constexpr size_t WS_SU = 475 * MiB, WS_SV = WS_SU + 65536;
constexpr size_t WS_END = 476 * MiB;
constexpr int CW_BAR = 4096;

constexpr int RING_BYTES = 131072;
constexpr int LDSCTL_OFF = 147456, MISC_OFF = LDSCTL_OFF + 320;
constexpr int LDS_BYTES = LDSCTL_OFF + 512;

typedef float f32x16 __attribute__((ext_vector_type(16)));
typedef unsigned v2u __attribute__((ext_vector_type(2)));
__device__ __forceinline__ float wave_sum(float v) {
#pragma unroll
    for (int o = 1; o < 64; o <<= 1) v += __shfl_xor(v, o);
    return v;
}
__device__ __forceinline__ float vmaxf(float a, float b) { float r; asm("v_max_f32_e32 %0, %1, %2" : "=v"(r) : "v"(a), "v"(b)); return r; }
__device__ __forceinline__ float vminf(float a, float b) { float r; asm("v_min_f32_e32 %0, %1, %2" : "=v"(r) : "v"(a), "v"(b)); return r; }

__device__ __forceinline__ void p0_transpose_item(const float* W, int K, int N, bf16* WT, LAS float* scr, int item, int lane) {
    const int nblk = N / 32, kb = item / nblk, nb = item % nblk, k0 = 64 * kb, n0 = 32 * nb;
#pragma unroll 8
    for (int i = 0; i < 32; ++i) { const int kk = 2 * i + (lane >> 5); scr[kk * 33 + (lane & 31)] = W[(size_t)(k0 + kk) * N + n0 + (lane & 31)]; }
    LDS_WAIT(); asm volatile("" ::: "memory");
    const int c = lane & 7;
#pragma unroll
    for (int j = 0; j < 4; ++j) { const int n = (lane >> 3) + 8 * j; const LAS float* s = scr + (8 * c) * 33 + n;
        v4u o; o.x = pk2(s[0 * 33], s[1 * 33]); o.y = pk2(s[2 * 33], s[3 * 33]); o.z = pk2(s[4 * 33], s[5 * 33]); o.w = pk2(s[6 * 33], s[7 * 33]);
        *(GAS v4u*)(WT + (size_t)(n0 + n) * K + k0 + 8 * c) = o; }
    LDS_WAIT(); asm volatile("" ::: "memory");
}
__device__ __forceinline__ void p0_wf_item(const float* wq, const float* sk, bf16* WfT, LAS unsigned char* lds, int item, int tid) {
    const int hp = item >> 5, dt = item & 31;
    LAS f32x4* SK4 = (LAS f32x4*)lds;
    LAS f32x4* WQ4 = SK4 + 128 * 33;
    const float* skp = sk + (size_t)hp * 128 * 128;
    for (int i = tid; i < 128 * 32; i += NTHREADS) { const int n = i >> 5, c4 = i & 31; SK4[n * 33 + c4] = *(const f32x4*)(skp + n * 128 + 4 * c4); }
    for (int i = tid; i < 64 * 32; i += NTHREADS) { const int r = i >> 5, c4 = i & 31; WQ4[r * 33 + c4] = *(const f32x4*)(wq + (size_t)(64 * dt + r) * 2048 + hp * 128 + 4 * c4); }
    __syncthreads();
    const int td = tid & 15, tn = tid >> 4;
    float acc[4][4];
#pragma unroll
    for (int i = 0; i < 4; ++i)
#pragma unroll
        for (int j = 0; j < 4; ++j) acc[i][j] = 0.f;
#pragma unroll 4
    for (int c4 = 0; c4 < 32; ++c4) {
        f32x4 a[4], b[4];
#pragma unroll
        for (int i = 0; i < 4; ++i) a[i] = SK4[(4 * tn + i) * 33 + c4];
#pragma unroll
        for (int j = 0; j < 4; ++j) b[j] = WQ4[(td + 16 * j) * 33 + c4];
#pragma unroll
        for (int i = 0; i < 4; ++i)
#pragma unroll
            for (int j = 0; j < 4; ++j) acc[i][j] += a[i].x * b[j].x + a[i].y * b[j].y + a[i].z * b[j].z + a[i].w * b[j].w;
    }
#pragma unroll
    for (int i = 0; i < 4; ++i)
#pragma unroll
        for (int j = 0; j < 4; ++j) WfT[(size_t)(hp * 128 + 4 * tn + i) * 2048 + 64 * dt + td + 16 * j] = (bf16)f2bf(acc[i][j]);
    __syncthreads();
}

__device__ __forceinline__ int perm16(int o) { return 8 * ((o >> 2) & 1) + 4 * (o >> 3) + (o & 3); }
__device__ __forceinline__ void attn_unit(int unit, const bf16* z, bf16* ao, const float* sinks, LAS unsigned char* lds, int tid) {
    const int lane = tid & 63, wid = __builtin_amdgcn_readfirstlane(tid >> 6), r32 = lane & 31, hi = lane >> 5;
    const int nb = unit & 15, kvh = (unit >> 4) & 3, b = unit >> 6;
    LAS bf16* Ks = (LAS bf16*)lds;
    LAS bf16* Vt = (LAS bf16*)(lds + 256 * 144);
    const size_t tok0 = (size_t)b * SEQ;
#pragma unroll
    for (int i = 0; i < 4; ++i) {
        const int ci = tid + NTHREADS * i, key = ci >> 3, dc = ci & 7;
        int kpos = 128 * (nb - 1) + key; if (kpos < 0) kpos = 0;
        const bf16* src = z + (tok0 + kpos) * IN_W + K_OFF + kvh * HD + dc * 8;
        const v4u kv = *(const GAS v4u*)src, vv = *(const GAS v4u*)(src + (V_OFF - K_OFF));
        *(LAS v4u*)(Ks + key * 72 + dc * 8) = kv;
        const int pos = (key & ~15) + perm16(key & 15);
        LAS bf16* vp = Vt + (dc * 8) * 264 + pos;
        vp[0 * 264] = (bf16)(vv.x & 0xffffu); vp[1 * 264] = (bf16)(vv.x >> 16); vp[2 * 264] = (bf16)(vv.y & 0xffffu); vp[3 * 264] = (bf16)(vv.y >> 16);
        vp[4 * 264] = (bf16)(vv.z & 0xffffu); vp[5 * 264] = (bf16)(vv.z >> 16); vp[6 * 264] = (bf16)(vv.w & 0xffffu); vp[7 * 264] = (bf16)(vv.w >> 16);
    }
    __syncthreads();
    const int hq = kvh * QPKV + wid;
    const float LOG2E = 1.4426950408889634f;
    const float sink2 = sinks[hq] * LOG2E, sc = 0.125f * LOG2E;
#pragma unroll 1
    for (int qg = 0; qg < 4; ++qg) {
        const size_t tok = tok0 + 128 * nb + 32 * qg + r32;
        bf16x8 qf[4];
#pragma unroll
        for (int ks = 0; ks < 4; ++ks) qf[ks] = *(const GAS bf16x8*)(z + tok * IN_W + Q_OFF + hq * HD + 16 * ks + 8 * hi);
        f32x16 s[5];
#pragma unroll
        for (int kt = 0; kt < 5; ++kt) {
            s[kt] = (f32x16){0.f, 0.f, 0.f, 0.f, 0.f, 0.f, 0.f, 0.f, 0.f, 0.f, 0.f, 0.f, 0.f, 0.f, 0.f, 0.f};
#pragma unroll
            for (int ks = 0; ks < 4; ++ks) {
                const bf16x8 kf = *(const LAS bf16x8*)(Ks + (32 * (qg + kt) + r32) * 72 + 16 * ks + 8 * hi);
                s[kt] = __builtin_amdgcn_mfma_f32_32x32x16_bf16(kf, qf[ks], s[kt], 0, 0, 0);
            }
        }
        float mx = sink2;
#pragma unroll
        for (int kt = 0; kt < 5; ++kt) {
            const bool tile_dead = (nb == 0) && (qg + kt < 4);
#pragma unroll
            for (int r = 0; r < 16; ++r) {
                const int krow = (r & 3) + 8 * (r >> 2) + 4 * hi;
                bool valid = !tile_dead;
                if (kt == 0) valid = valid && (krow > r32);
                if (kt == 4) valid = valid && (krow <= r32);
                const float v = valid ? s[kt][r] * sc : -INFINITY;
                s[kt][r] = v; mx = fmaxf(mx, v);
            }
        }
        mx = fmaxf(mx, __shfl_xor(mx, 32));
        float sum = 0.f;
#pragma unroll
        for (int kt = 0; kt < 5; ++kt)
#pragma unroll
            for (int r = 0; r < 16; ++r) { const float p = __builtin_amdgcn_exp2f(s[kt][r] - mx); s[kt][r] = p; sum += p; }
        sum += __shfl_xor(sum, 32);
        const float inv = 1.0f / (sum + __builtin_amdgcn_exp2f(sink2 - mx));
        f32x16 o[2];
        o[0] = (f32x16){0.f, 0.f, 0.f, 0.f, 0.f, 0.f, 0.f, 0.f, 0.f, 0.f, 0.f, 0.f, 0.f, 0.f, 0.f, 0.f}; o[1] = o[0];
#pragma unroll
        for (int kt = 0; kt < 5; ++kt)
#pragma unroll
            for (int s2 = 0; s2 < 2; ++s2) {
                v4u pw; pw.x = pg8::cvt_pk_bf16(s[kt][8 * s2 + 0], s[kt][8 * s2 + 1]); pw.y = pg8::cvt_pk_bf16(s[kt][8 * s2 + 2], s[kt][8 * s2 + 3]);
                pw.z = pg8::cvt_pk_bf16(s[kt][8 * s2 + 4], s[kt][8 * s2 + 5]); pw.w = pg8::cvt_pk_bf16(s[kt][8 * s2 + 6], s[kt][8 * s2 + 7]);
                const bf16x8 pa = __builtin_bit_cast(bf16x8, pw);
#pragma unroll
                for (int dt = 0; dt < 2; ++dt) {
                    const bf16x8 vf = *(const LAS bf16x8*)(Vt + (32 * dt + r32) * 264 + 32 * (qg + kt) + 16 * s2 + 8 * hi);
                    o[dt] = __builtin_amdgcn_mfma_f32_32x32x16_bf16(vf, pa, o[dt], 0, 0, 0);
                }
            }
        bf16* op = ao + tok * D + hq * HD;
#pragma unroll
        for (int dt = 0; dt < 2; ++dt)
#pragma unroll
            for (int g = 0; g < 4; ++g) {
                v2u w; w.x = pg8::cvt_pk_bf16(o[dt][4 * g + 0] * inv, o[dt][4 * g + 1] * inv); w.y = pg8::cvt_pk_bf16(o[dt][4 * g + 2] * inv, o[dt][4 * g + 3] * inv);
                *(GAS v2u*)(op + 32 * dt + 8 * g + 4 * hi) = w;
            }
    }
    __syncthreads();
}
__device__ __forceinline__ void conv_item(int item, const bf16* z, const float* cw, bf16* ci, int tid) {
    const int c8 = tid & 255, half = tid >> 8, t0 = 32 * item + 16 * half, c0 = 8 * c8;
    float w0[8], w1[8], w2[8], u1[8], u2[8];
#pragma unroll
    for (int e = 0; e < 8; ++e) { w0[e] = cw[c0 + e]; w1[e] = cw[2048 + c0 + e]; w2[e] = cw[4096 + c0 + e]; u1[e] = 0.f; u2[e] = 0.f; }
    if ((t0 & (SEQ - 1)) != 0) {
#pragma unroll
        for (int k = 0; k < 2; ++k) {
            const bf16* zr = z + (size_t)(t0 - 2 + k) * IN_W + c0;
            const v4u a = *(const GAS v4u*)(zr + CC_OFF), h = *(const GAS v4u*)(zr + CH_OFF);
            float u[8];
            u[0] = pg8::bf_lo(a.x) * pg8::bf_lo(h.x); u[1] = pg8::bf_hi(a.x) * pg8::bf_hi(h.x); u[2] = pg8::bf_lo(a.y) * pg8::bf_lo(h.y); u[3] = pg8::bf_hi(a.y) * pg8::bf_hi(h.y);
            u[4] = pg8::bf_lo(a.z) * pg8::bf_lo(h.z); u[5] = pg8::bf_hi(a.z) * pg8::bf_hi(h.z); u[6] = pg8::bf_lo(a.w) * pg8::bf_lo(h.w); u[7] = pg8::bf_hi(a.w) * pg8::bf_hi(h.w);
#pragma unroll
            for (int e = 0; e < 8; ++e) { if (k == 0) u2[e] = u[e]; else u1[e] = u[e]; }
        }
    }
#pragma unroll 4
    for (int i = 0; i < 16; ++i) {
        const bf16* zr = z + (size_t)(t0 + i) * IN_W + c0;
        const v4u a = *(const GAS v4u*)(zr + CC_OFF), h = *(const GAS v4u*)(zr + CH_OFF), bb = *(const GAS v4u*)(zr + CB_OFF);
        float u[8], cb[8], y[8];
        u[0] = pg8::bf_lo(a.x) * pg8::bf_lo(h.x); u[1] = pg8::bf_hi(a.x) * pg8::bf_hi(h.x); u[2] = pg8::bf_lo(a.y) * pg8::bf_lo(h.y); u[3] = pg8::bf_hi(a.y) * pg8::bf_hi(h.y);
        u[4] = pg8::bf_lo(a.z) * pg8::bf_lo(h.z); u[5] = pg8::bf_hi(a.z) * pg8::bf_hi(h.z); u[6] = pg8::bf_lo(a.w) * pg8::bf_lo(h.w); u[7] = pg8::bf_hi(a.w) * pg8::bf_hi(h.w);
        cb[0] = pg8::bf_lo(bb.x); cb[1] = pg8::bf_hi(bb.x); cb[2] = pg8::bf_lo(bb.y); cb[3] = pg8::bf_hi(bb.y); cb[4] = pg8::bf_lo(bb.z); cb[5] = pg8::bf_hi(bb.z); cb[6] = pg8::bf_lo(bb.w); cb[7] = pg8::bf_hi(bb.w);
#pragma unroll
        for (int e = 0; e < 8; ++e) { y[e] = cb[e] * (w0[e] * u2[e] + w1[e] * u1[e] + w2[e] * u[e]); u2[e] = u1[e]; u1[e] = u[e]; }
        v4u o; o.x = pk2(y[0], y[1]); o.y = pk2(y[2], y[3]); o.z = pk2(y[4], y[5]); o.w = pk2(y[6], y[7]);
        *(GAS v4u*)(ci + (size_t)(t0 + i) * D + c0) = o;
    }
}

__device__ __forceinline__ void ln1_row(float* r1row, bf16* hbrow, const float* g, const float* bta, int lane) {
    GAS f32x4* xr = (GAS f32x4*)r1row + lane;
    f32x4 v[8]; float s = 0.f;
#pragma unroll
    for (int j = 0; j < 8; ++j) { v[j] = xr[64 * j]; s += (v[j].x + v[j].y) + (v[j].z + v[j].w); }
    const float mean = wave_sum(s) * (1.f / D); float s2 = 0.f;
#pragma unroll
    for (int j = 0; j < 8; ++j) { v[j] = v[j] - mean; s2 += (v[j].x * v[j].x + v[j].y * v[j].y) + (v[j].z * v[j].z + v[j].w * v[j].w); }
    const float rstd = 1.f / sqrtf(wave_sum(s2) * (1.f / D) + LN_EPS);
    GAS v2u* o8 = (GAS v2u*)hbrow + lane;
#pragma unroll
    for (int j = 0; j < 8; ++j) {
        const f32x4 gg = *((const GAS f32x4*)g + lane + 64 * j), bb = *((const GAS f32x4*)bta + lane + 64 * j);
        const f32x4 y = v[j] * rstd * gg + bb;
        xr[64 * j] = y;
        v2u w; w.x = pk2(y.x, y.y); w.y = pk2(y.z, y.w); o8[64 * j] = w;
    }
}

constexpr int TK_ROWF = 136;
constexpr int TK_IDX_OFF = 256 * TK_ROWF * 4;
__device__ __forceinline__ void topk_pass(int pass, const float* scores, int* experts, float* gates, LAS unsigned char* lds, int tid) {
    LAS float* S = (LAS float*)lds;
    LAS unsigned char* IDX = lds + TK_IDX_OFF;
    const float* src = scores + (size_t)pass * (256 * 128);
#pragma unroll 4
    for (int i = 0; i < 16; ++i) { const int f4 = tid + NTHREADS * i, row = f4 >> 5, c4 = f4 & 31; *(LAS f32x4*)(S + row * TK_ROWF + 4 * c4) = *(const GAS f32x4*)(src + (size_t)f4 * 4); }
    __syncthreads();
    const int row = tid >> 1, sub = tid & 1;
    float L[16];
#pragma unroll
    for (int j = 0; j < 16; ++j) L[j] = -INFINITY;
#pragma unroll 2
    for (int i = 0; i < 16; ++i) {
        const int c4 = 2 * i + sub;
        const f32x4 v = *(const LAS f32x4*)(S + row * TK_ROWF + 4 * c4);
#pragma unroll
        for (int e = 0; e < 4; ++e) {
            const float ve = v[e];
            float x = __uint_as_float((__float_as_uint(ve) & ~0x7Fu) | (unsigned)(4 * c4 + e));
#pragma unroll
            for (int j = 0; j < 16; ++j) { const float h = vmaxf(L[j], x); x = vminf(L[j], x); L[j] = h; }
        }
    }
    {
        float P[16];
#pragma unroll
        for (int j = 0; j < 16; ++j) P[j] = __shfl_xor(L[j], 1);
#pragma unroll
        for (int j = 0; j < 16; ++j) L[j] = vmaxf(L[j], P[15 - j]);
#pragma unroll
        for (int st = 8; st >= 1; st >>= 1)
#pragma unroll
            for (int j = 0; j < 16; ++j) if ((j & st) == 0) { const float h = vmaxf(L[j], L[j + st]), l = vminf(L[j], L[j + st]); L[j] = h; L[j + st] = l; }
    }
    if (sub == 0) {
#pragma unroll
        for (int q = 0; q < 4; ++q) {
            unsigned w = 0;
#pragma unroll
            for (int e = 0; e < 4; ++e) w |= (__builtin_bit_cast(unsigned, L[4 * q + e]) & 0x7Fu) << (8 * e);
            *(LAS unsigned*)(IDX + row * 16 + 4 * q) = w;
        }
    }
    float A[16], B[16];
#pragma unroll
    for (int j = 0; j < 16; ++j) { const float o = __shfl_xor(L[j], 2); const bool isb = (tid & 2) != 0; A[j] = isb ? o : L[j]; B[j] = isb ? L[j] : o; }
    float F[16];
#pragma unroll
    for (int j = 0; j < 16; ++j) F[j] = -INFINITY;
#pragma unroll
    for (int i = 0; i < 16; ++i)
#pragma unroll
        for (int j = 0; j < 16; ++j) if ((i + 1) * (j + 1) <= 16) {
            const float sm = A[i] + B[j];
            float x = __builtin_bit_cast(float, (__builtin_bit_cast(unsigned, sm) & ~0xFFu) | (unsigned)(i * 16 + j));
#pragma unroll
            for (int k = 0; k < 16; ++k) { const float h = vmaxf(F[k], x); x = vminf(F[k], x); F[k] = h; }
        }
    __syncthreads();
    if ((tid & 3) == 0) {
        const int rowA = (tid >> 2) * 2, rowB = rowA + 1;
        const size_t prob = (size_t)pass * 128 + (tid >> 2);
        float g[16]; int ex[16]; float gs = 0.f;
#pragma unroll
        for (int k = 0; k < 16; ++k) {
            const unsigned code = __builtin_bit_cast(unsigned, F[k]) & 0xFFu;
            const int ia = IDX[rowA * 16 + (code >> 4)], ib = IDX[rowB * 16 + (code & 15)];
            ex[k] = ia * PNK + ib;
            g[k] = __expf(F[k] - F[0]); gs += g[k];
        }
        const float ginv = 1.0f / gs;
#pragma unroll
        for (int q = 0; q < 4; ++q) {
            *(GAS f32x4*)(gates + prob * 16 + 4 * q) = (f32x4){g[4 * q] * ginv, g[4 * q + 1] * ginv, g[4 * q + 2] * ginv, g[4 * q + 3] * ginv};
            typedef int i32x4 __attribute__((ext_vector_type(4)));
            *(GAS i32x4*)(experts + prob * 16 + 4 * q) = (i32x4){ex[4 * q], ex[4 * q + 1], ex[4 * q + 2], ex[4 * q + 3]};
        }
    }
    __syncthreads();
}

__device__ __forceinline__ float gelu_erf(float v) { return 0.5f * v * (1.0f + erff(v * 0.70710678118654752f)); }
typedef __bf16 bf16x2_t __attribute__((ext_vector_type(2)));
typedef float f32x2_t __attribute__((ext_vector_type(2)));
__device__ __forceinline__ float dot2bf(bf16x2_t a, unsigned b, float acc) { return __builtin_amdgcn_fdot2_f32_bf16(a, __builtin_bit_cast(bf16x2_t, b), acc, false); }
__device__ __forceinline__ float dot4f8(unsigned w8, unsigned x01, unsigned x23, float acc) {
    acc = dot2bf(__builtin_amdgcn_cvt_scalef32_pk_bf16_fp8(w8, 1.0f, false), x01, acc);
    return dot2bf(__builtin_amdgcn_cvt_scalef32_pk_bf16_fp8(w8, 1.0f, true), x23, acc);
}
__device__ __forceinline__ void axpy4f8(float* y, unsigned w8, float w) {
    const f32x2_t lo = __builtin_amdgcn_cvt_pk_f32_fp8(w8, false), hi = __builtin_amdgcn_cvt_pk_f32_fp8(w8, true);
    y[0] += w * lo.x; y[1] += w * lo.y; y[2] += w * hi.x; y[3] += w * hi.y;
}
__device__ __forceinline__ void row_to_fp8(const float* src, unsigned char* dst, float* inv, int lane) {
    f32x4 v[2][4]; float mx = 0.f;
#pragma unroll
    for (int j = 0; j < 2; ++j)
#pragma unroll
        for (int q = 0; q < 4; ++q) { v[j][q] = *((const GAS f32x4*)src + 4 * (lane + 64 * j) + q);
            mx = fmaxf(mx, fmaxf(fmaxf(fabsf(v[j][q].x), fabsf(v[j][q].y)), fmaxf(fabsf(v[j][q].z), fabsf(v[j][q].w)))); }
#pragma unroll
    for (int o = 1; o < 64; o <<= 1) mx = fmaxf(mx, __shfl_xor(mx, o));
    const float sc = mx > 0.f ? 384.0f / mx : 1.0f;
#pragma unroll
    for (int j = 0; j < 2; ++j) { v4u o;
        int w;
        w = 0; w = __builtin_amdgcn_cvt_pk_fp8_f32(v[j][0].x * sc, v[j][0].y * sc, w, false); w = __builtin_amdgcn_cvt_pk_fp8_f32(v[j][0].z * sc, v[j][0].w * sc, w, true); o.x = (unsigned)w;
        w = 0; w = __builtin_amdgcn_cvt_pk_fp8_f32(v[j][1].x * sc, v[j][1].y * sc, w, false); w = __builtin_amdgcn_cvt_pk_fp8_f32(v[j][1].z * sc, v[j][1].w * sc, w, true); o.y = (unsigned)w;
        w = 0; w = __builtin_amdgcn_cvt_pk_fp8_f32(v[j][2].x * sc, v[j][2].y * sc, w, false); w = __builtin_amdgcn_cvt_pk_fp8_f32(v[j][2].z * sc, v[j][2].w * sc, w, true); o.z = (unsigned)w;
        w = 0; w = __builtin_amdgcn_cvt_pk_fp8_f32(v[j][3].x * sc, v[j][3].y * sc, w, false); w = __builtin_amdgcn_cvt_pk_fp8_f32(v[j][3].z * sc, v[j][3].w * sc, w, true); o.w = (unsigned)w;
        *((GAS v4u*)dst + lane + 64 * j) = o; }
    if (lane == 0) *inv = mx > 0.f ? mx * (1.0f / 384.0f) : 1.0f;
}
__device__ __forceinline__ void peer_token(int t, const float* h1, const bf16* h1b, const int* experts, const float* gates, const unsigned char* u8, const unsigned char* v8,
                                           const float* su, const float* sv, const float* g2, const float* b2, float* out, LAS unsigned char* lds, int tid) {
    const int lane = tid & 63, wid = __builtin_amdgcn_readfirstlane(tid >> 6);
    v4u xb[2][2]; float ya[2][16];
#pragma unroll
    for (int j = 0; j < 2; ++j) { xb[j][0] = *((const GAS v4u*)(h1b + (size_t)t * D) + 2 * (lane + 64 * j)); xb[j][1] = *((const GAS v4u*)(h1b + (size_t)t * D) + 2 * (lane + 64 * j) + 1);
#pragma unroll
        for (int e = 0; e < 16; ++e) ya[j][e] = 0.f; }
    const int* ep = experts + ((size_t)t * PH + wid) * PTOPK;
    const float* gp = gates + ((size_t)t * PH + wid) * PTOPK;
#pragma unroll 1
    for (int k = 0; k < PTOPK; k += 8) {
        v4u ur[8][2], vr[8][2]; float g[8], d[8];
#pragma unroll
        for (int r = 0; r < 8; ++r) { const int e = __builtin_amdgcn_readfirstlane(ep[k + r]); g[r] = gp[k + r] * sv[e]; d[r] = su[e];
            const GAS v4u* up = (const GAS v4u*)(u8 + (size_t)e * D) + lane; const GAS v4u* vp = (const GAS v4u*)(v8 + (size_t)e * D) + lane;
            ur[r][0] = up[0]; ur[r][1] = up[64]; vr[r][0] = vp[0]; vr[r][1] = vp[64]; }
#pragma unroll
        for (int r = 0; r < 8; ++r) { float a = 0.f, b = 0.f;
            a = dot4f8(ur[r][0].x, xb[0][0].x, xb[0][0].y, a); b = dot4f8(ur[r][0].y, xb[0][0].z, xb[0][0].w, b); a = dot4f8(ur[r][0].z, xb[0][1].x, xb[0][1].y, a); b = dot4f8(ur[r][0].w, xb[0][1].z, xb[0][1].w, b);
            a = dot4f8(ur[r][1].x, xb[1][0].x, xb[1][0].y, a); b = dot4f8(ur[r][1].y, xb[1][0].z, xb[1][0].w, b); a = dot4f8(ur[r][1].z, xb[1][1].x, xb[1][1].y, a); b = dot4f8(ur[r][1].w, xb[1][1].z, xb[1][1].w, b);
            d[r] *= wave_sum(a + b); }
#pragma unroll
        for (int r = 0; r < 8; ++r) { const float w = g[r] * gelu_erf(d[r]);
#pragma unroll
            for (int j = 0; j < 2; ++j) { axpy4f8(&ya[j][0], vr[r][j].x, w); axpy4f8(&ya[j][4], vr[r][j].y, w); axpy4f8(&ya[j][8], vr[r][j].z, w); axpy4f8(&ya[j][12], vr[r][j].w, w); } }
    }
    LAS f32x4* Y4 = (LAS f32x4*)lds;
    LAS float* RED = (LAS float*)(lds + 65536);
#pragma unroll
    for (int j = 0; j < 2; ++j)
#pragma unroll
        for (int q = 0; q < 4; ++q) Y4[wid * 512 + 4 * (lane + 64 * j) + q] = (f32x4){ya[j][4 * q], ya[j][4 * q + 1], ya[j][4 * q + 2], ya[j][4 * q + 3]};
    __syncthreads();
    f32x4 y = Y4[tid];
#pragma unroll
    for (int w = 1; w < 8; ++w) y += Y4[w * 512 + tid];
    const f32x4 hx = *((const GAS f32x4*)(h1 + (size_t)t * D) + tid);
    f32x4 r = hx * ALPHA + y;
    float s = wave_sum((r.x + r.y) + (r.z + r.w));
    if (lane == 0) RED[wid] = s;
    __syncthreads();
    float tot = 0.f;
#pragma unroll
    for (int w = 0; w < 8; ++w) tot += RED[w];
    const float mean = tot * (1.f / D);
    r = r - mean;
    float s2 = wave_sum((r.x * r.x + r.y * r.y) + (r.z * r.z + r.w * r.w));
    if (lane == 0) RED[8 + wid] = s2;
    __syncthreads();
    float tot2 = 0.f;
#pragma unroll
    for (int w = 0; w < 8; ++w) tot2 += RED[8 + w];
    const float rstd = 1.f / sqrtf(tot2 * (1.f / D) + LN_EPS);
    const f32x4 gg = *((const GAS f32x4*)g2 + tid), bb = *((const GAS f32x4*)b2 + tid);
    *((GAS f32x4*)(out + (size_t)t * D) + tid) = r * rstd * gg + bb;
    __syncthreads();
}

struct Args { const float* in[16]; float* out; unsigned char* ws; int ph_lo, ph_hi; };
__global__ void __launch_bounds__(NTHREADS, 2) mk_fwd(Args args) {
    extern __shared__ __attribute__((aligned(16))) unsigned char lds_raw[];
    LAS unsigned char* lds = (LAS unsigned char*)lds_raw;
    volatile LAS unsigned* MISC = (volatile LAS unsigned*)(lds + MISC_OFF);
    const int tid0 = threadIdx.x;
    const int G = gridDim.x, bx = blockIdx.x;
    unsigned char* ws = args.ws;
    gu32* ctl = (gu32*)(ws + WS_CTL);
#define IN_(i) (args.in[i])
#define x_in IN_(0)
#define w_in IN_(1)
#define b_gate IN_(2)
#define sinks IN_(3)
#define conv_w IN_(4)
#define w_ao IN_(5)
#define w_co IN_(6)
#define w_o IN_(7)
#define ln1_g IN_(8)
#define ln1_b IN_(9)
#define w_q IN_(10)
#define sub_keys IN_(11)
#define peer_u IN_(12)
#define peer_v IN_(13)
#define ln2_g IN_(14)
#define ln2_b IN_(15)
#define WinT ((bf16*)(ws + WS_WIN))
#define WaT ((bf16*)(ws + WS_WA))
#define WcT ((bf16*)(ws + WS_WC))
#define WoT ((bf16*)(ws + WS_WO))
#define WfT ((bf16*)(ws + WS_WF))
#define XB ((bf16*)(ws + WS_XB))
#define MERGED ((bf16*)(ws + WS_MERGED))
#define Z ((bf16*)(ws + WS_Z))
#define H1 ((float*)(ws + WS_H1))
#define H1B ((bf16*)(ws + WS_H1B))
#define SC ((float*)(ws + WS_SC))
#define EX ((int*)(ws + WS_EX))
#define GT ((float*)(ws + WS_GT))
#define AO ((bf16*)(ws + WS_AO))
#define CI ((bf16*)(ws + WS_CI))
#define TMP ((bf16*)(ws + WS_TMP))
#define U8 ((unsigned char*)(ws + WS_U8))
#define V8 ((unsigned char*)(ws + WS_V8))
#define SU ((float*)(ws + WS_SU))
#define SV ((float*)(ws + WS_SV))
    for (int u = tid0; u < (LDS_BYTES - LDSCTL_OFF) / 4; u += NTHREADS) ((LAS unsigned*)(lds + LDSCTL_OFF))[u] = 0u;
    __syncthreads();
    XcdBarrier bar; bar.bar = (unsigned*)(ctl + CW_BAR); bar.x = 0; bar.st = nullptr;
    if (!MK_PER_PHASE) bar = xcd_barrier_post((unsigned*)(ctl + CW_BAR), MISC + 8);
    const int lo = args.ph_lo, hi = args.ph_hi;
#ifndef PH_MASK
#define PH_MASK 0x1FF
#endif
#define IN(k) (((PH_MASK >> (k)) & 1) && lo <= (k) && (k) < hi)
#define SEAM(k) do { if (IN(k) && IN((k) + 1)) xcd_barrier(bar); } while (0)
#ifndef DBL_MASK
#define DBL_MASK 0
#endif
#define REP(k) for (int rep_ = 0; rep_ < 1 + ((DBL_MASK >> (k)) & 1); ++rep_)
#define PHASE_TID() int tid = tid0; asm volatile("" : "+v"(tid)); const int lane = tid & 63, wave = __builtin_amdgcn_readfirstlane(tid >> 6); (void)lane; (void)wave

    if (IN(0)) REP(0) {
        PHASE_TID();
        for (int it = bx; it < 16 * 32; it += G) p0_wf_item(w_q, sub_keys, WfT, lds, it, tid);
        LAS float* scr = (LAS float*)(lds + wave * 16384);
        const int gw = bx * NWAVES + wave, NGW = G * NWAVES;
        constexpr int I_IN = (D / 64) * (IN_W / 32), I_SQ = (D / 64) * (D / 32);
        for (int it = gw; it < I_IN + 3 * I_SQ; it += NGW) {
            int r = it;
            if (r < I_IN) { p0_transpose_item(w_in, D, IN_W, WinT, scr, r, lane); continue; } r -= I_IN;
            if (r < I_SQ) { p0_transpose_item(w_ao, D, D, WaT, scr, r, lane); continue; } r -= I_SQ;
            if (r < I_SQ) { p0_transpose_item(w_co, D, D, WcT, scr, r, lane); continue; } r -= I_SQ;
            p0_transpose_item(w_o, D, D, WoT, scr, r, lane);
        }
        const size_t n8 = (size_t)M * D / 8;
        for (size_t i = (size_t)bx * NTHREADS + tid; i < n8; i += (size_t)G * NTHREADS) {
            const f32x4 a = *((const GAS f32x4*)x_in + 2 * i), b = *((const GAS f32x4*)x_in + 2 * i + 1);
            v4u o; o.x = pk2(a.x, a.y); o.y = pk2(a.z, a.w); o.z = pk2(b.x, b.y); o.w = pk2(b.z, b.w);
            *((GAS v4u*)XB + i) = o;
        }
    }
    SEAM(0);
    if (IN(1)) REP(1) {
        pg8::Gemm g{XB, WinT, M, IN_W, D}; pg8::StaticOrder S; S.init(M, IN_W, G, bx);
        pg8::EpiBf16 E{Z, IN_W};
        pg8::gemm_phase<pg8::EpiBf16, pg8::StaticOrder, true, true>(lds, g, S, E);
    }
    SEAM(1);
    if (IN(2)) REP(2) {
        PHASE_TID();
        for (int u = bx; u < BATCH * NKVH * 16; u += G) attn_unit(u, Z, AO, sinks, lds, tid);
        for (int it = bx; it < M / 32; it += G) conv_item(it, Z, conv_w, CI, tid);
    }
    SEAM(2);
    if (IN(3)) REP(3) {
        pg8::StaticOrder S; S.init(M, D, G, bx);
        { pg8::Gemm g{AO, WaT, M, D, D}; pg8::EpiGate<0> E{TMP, nullptr, Z + G_OFF, b_gate, D, IN_W};
          pg8::gemm_phase<pg8::EpiGate<0>, pg8::StaticOrder, true, true>(lds, g, S, E); }
        { pg8::Gemm g{CI, WcT, M, D, D}; pg8::EpiGate<1> E{MERGED, TMP, Z + G_OFF + D, b_gate + D, D, IN_W};
          pg8::gemm_phase<pg8::EpiGate<1>, pg8::StaticOrder, true, true>(lds, g, S, E); }
    }
    SEAM(3);
    if (IN(4)) REP(4) {
        pg8::Gemm g{MERGED, WoT, M, D, D}; pg8::StaticOrder S; S.init(M, D, G, bx);
        pg8::EpiF32 E{H1, D, x_in, ALPHA};
        pg8::gemm_phase<pg8::EpiF32, pg8::StaticOrder, true, true>(lds, g, S, E);
    }
    SEAM(4);
    if (IN(5)) REP(5) {
        PHASE_TID();
        const int gw = bx * NWAVES + wave, NGW = G * NWAVES;
        for (int m = gw; m < M; m += NGW) ln1_row(H1 + (size_t)m * D, H1B + (size_t)m * D, ln1_g, ln1_b, lane);
        for (int r = gw; r < 2 * PNE; r += NGW) {
            const bool sec = r >= PNE; const int e = sec ? r - PNE : r;
            row_to_fp8((sec ? peer_v : peer_u) + (size_t)e * D, (sec ? V8 : U8) + (size_t)e * D, (sec ? SV : SU) + e, lane);
        }
    }
    SEAM(5);
    if (IN(6)) REP(6) {
        pg8::Gemm g{H1B, WfT, M, D, D}; pg8::StaticOrder S; S.init(M, D, G, bx);
        pg8::EpiF32 E{SC, D, nullptr, 0.f};
        pg8::gemm_phase<pg8::EpiF32, pg8::StaticOrder, true, true>(lds, g, S, E);
    }
    SEAM(6);
    if (IN(7)) REP(7) {
        PHASE_TID();
        for (int p = bx; p < (M * PH) / 128; p += G) topk_pass(p, SC, EX, GT, lds, tid);
    }
    SEAM(7);
    if (IN(8)) REP(8) {
        PHASE_TID();
        for (int t = bx; t < M; t += G) peer_token(t, H1, H1B, EX, GT, U8, V8, SU, SV, ln2_g, ln2_b, args.out, lds, tid);
    }
#undef IN
#undef SEAM
}

extern "C" void kernel_launch(void* const* d_in, const int* in_sizes, int n_in, void* d_out, int out_size, void* d_ws, size_t ws_size, hipStream_t stream) {
    static int grid = 0;
    if (grid == 0) {
        if (n_in != 16 || out_size != M * D || ws_size < WS_END) { fprintf(stderr, "kernel_launch: unexpected shapes (n_in %d out %d ws %zu)\n", n_in, out_size, ws_size); grid = -1; return; }
        int dev = 0, cus = 0, per_cu = 0;
        if (hipGetDevice(&dev) != hipSuccess || hipDeviceGetAttribute(&cus, hipDeviceAttributeMultiprocessorCount, dev) != hipSuccess) { grid = -1; return; }
        if (hipFuncSetAttribute((const void*)mk_fwd, hipFuncAttributeMaxDynamicSharedMemorySize, LDS_BYTES) != hipSuccess) { fprintf(stderr, "kernel_launch: hipFuncSetAttribute failed\n"); grid = -1; return; }
        if (hipOccupancyMaxActiveBlocksPerMultiprocessor(&per_cu, (const void*)mk_fwd, NTHREADS, LDS_BYTES) != hipSuccess || per_cu < 1) { fprintf(stderr, "kernel_launch: occupancy query says %d\n", per_cu); per_cu = 1; }
        (void)hipGetLastError();
        if (per_cu > 1) per_cu = 1;
        grid = cus * per_cu;
    }
    if (grid < 0) return;
    if (hipMemsetAsync((char*)d_ws + WS_CTL, 0, CTL_ZERO_BYTES, stream) != hipSuccess) { fprintf(stderr, "kernel_launch: memset failed\n"); return; }
    Args a{};
    for (int i = 0; i < 16; ++i) a.in[i] = (const float*)d_in[i];
    a.out = (float*)d_out; a.ws = (unsigned char*)d_ws;
#if MK_PER_PHASE
    for (int p = 0; p < N_PHASES; ++p) { a.ph_lo = p; a.ph_hi = p + 1; hipLaunchKernelGGL(mk_fwd, dim3(grid), dim3(NTHREADS), LDS_BYTES, stream, a); }
#else
    a.ph_lo = 0; a.ph_hi = N_PHASES;
    void* kargs[] = {&a};
    hipError_t e = hipLaunchCooperativeKernel((const void*)mk_fwd, dim3(grid), dim3(NTHREADS), kargs, LDS_BYTES, stream);
    if (e != hipSuccess) fprintf(stderr, "kernel_launch: cooperative launch failed: %s (grid %d)\n", hipGetErrorString(e), grid);
#endif
}
```

```cpp
#include <hip/hip_runtime.h>
#include <cstdio>
#include <cstdint>
namespace pg8 {
#define PG8_LAS __attribute__((address_space(3)))
typedef unsigned short bf16_t;
typedef short bf16x8 __attribute__((ext_vector_type(8)));
typedef float f32x4 __attribute__((ext_vector_type(4)));
typedef unsigned u32x4 __attribute__((ext_vector_type(4)));
constexpr int BM = 256, BK = 64, HALF = 128, HTB = HALF * BK * 2  , STAGE_BYTES = 8 * HTB, NXCD = 8, WGM = 8;

__host__ __device__ __forceinline__ int lds_byte(int r, int c) { const int st = (r >> 4) * 2 + (c >> 5), rr = r & 15, cc = c & 31, ob = rr * 64 + cc * 2; return st * 1024 + (ob ^ (((ob >> 9) & 1) << 5)); }
__host__ __device__ __forceinline__ void stage_rc(int b, int& R, int& C) { const int st = b / 1024, sb = b % 1024, swz = sb ^ (((sb >> 9) & 1) << 5); R = (st >> 1) * 16 + swz / 64; C = (st & 1) * 32 + (swz % 64) / 2; }
__host__ __device__ __forceinline__ int perm32(int rho) { const int n = rho >> 4, i = rho & 15; return 8 * (i >> 2) + 4 * n + (i & 3); }

struct Unit { int pm, pn; };
struct Gemm { const bf16_t* A; const bf16_t* Bt; int M, N, K; };

struct StaticOrder {
    int nM, nN, nwg, G, c;
    __host__ __device__ void init(int M, int N, int G_, int c_) { nM = M / BM; nN = N / BM; nwg = nM * nN; G = G_; c = c_; }
    __host__ __device__ bool next(int i, Unit& u) const {
        const long L = (long)i * G + c; if (L >= nwg) return false;
        int wgid = (int)L; { const int q = nwg / NXCD, r = nwg % NXCD, xcd = wgid % NXCD, off = wgid / NXCD; wgid = (xcd < r ? xcd * (q + 1) : r * (q + 1) + (xcd - r) * q) + off; }
        const int nig = WGM * nN, gid = wgid / nig, fm = gid * WGM, gsz = (nM - fm) < WGM ? (nM - fm) : WGM;
        u.pm = fm + ((wgid % nig) % gsz); u.pn = (wgid % nig) / gsz; return true;
    }
    __device__ __forceinline__ void a_ready(const Unit&) const {}
    __device__ __forceinline__ void done(const Unit&) const {}
};


__device__ __forceinline__ unsigned cvt_pk_bf16(float lo, float hi) { unsigned r; asm volatile("v_cvt_pk_bf16_f32 %0, %1, %2" : "=v"(r) : "v"(lo), "v"(hi)); return r; }
__device__ __forceinline__ float bf_lo(unsigned w) { return __builtin_bit_cast(float, w << 16); }
__device__ __forceinline__ float bf_hi(unsigned w) { return __builtin_bit_cast(float, w & 0xffff0000u); }
__device__ __forceinline__ float sigmoidf_(float x) { return __builtin_amdgcn_rcpf(1.0f + __expf(-x)); }

struct EpiBf16 {
    static constexpr bool PERM = true, AFTER_DRAIN = false;
    bf16_t* O; int ldc;
    __device__ __forceinline__ void operator()(const f32x4 (&acc)[2][2][4][2], const Unit& u, int wr, int wc, int fr, int fq) const {
        const int row0 = u.pm * BM + wr * 64 + fr, col0 = u.pn * BM + wc * 32 + 8 * fq;
#pragma unroll
        for (int ai = 0; ai < 2; ++ai)
#pragma unroll
            for (int m = 0; m < 4; ++m) { bf16_t* rowp = O + (size_t)(row0 + ai * HALF + m * 16) * ldc + col0;
#pragma unroll
                for (int bj = 0; bj < 2; ++bj) { const f32x4 v0 = acc[ai][bj][m][0], v1 = acc[ai][bj][m][1];
                    u32x4 w; w.x = cvt_pk_bf16(v0[0], v0[1]); w.y = cvt_pk_bf16(v0[2], v0[3]); w.z = cvt_pk_bf16(v1[0], v1[1]); w.w = cvt_pk_bf16(v1[2], v1[3]);
                    *(u32x4*)(rowp + bj * HALF) = w; } }
    }
};
template <int SECOND> struct EpiGate {
    static constexpr bool PERM = true, AFTER_DRAIN = false;
    bf16_t* O; const bf16_t* T; const bf16_t* Zg; const float* bg; int ldc, ldz;
    __device__ __forceinline__ void operator()(const f32x4 (&acc)[2][2][4][2], const Unit& u, int wr, int wc, int fr, int fq) const {
        const int row0 = u.pm * BM + wr * 64 + fr, col0 = u.pn * BM + wc * 32 + 8 * fq;
        f32x4 bv[2][2];
#pragma unroll
        for (int bj = 0; bj < 2; ++bj)
#pragma unroll
            for (int n = 0; n < 2; ++n) bv[bj][n] = *(const f32x4*)(bg + col0 + bj * HALF + 4 * n);
#pragma unroll
        for (int ai = 0; ai < 2; ++ai)
#pragma unroll
            for (int m = 0; m < 4; ++m) { const size_t row = (size_t)(row0 + ai * HALF + m * 16);
#pragma unroll
                for (int bj = 0; bj < 2; ++bj) { const int c = col0 + bj * HALF;
                    const u32x4 zg = *(const u32x4*)(Zg + row * ldz + c);
                    f32x4 v0 = acc[ai][bj][m][0], v1 = acc[ai][bj][m][1];
                    v0[0] *= sigmoidf_(bf_lo(zg.x) + bv[bj][0][0]); v0[1] *= sigmoidf_(bf_hi(zg.x) + bv[bj][0][1]);
                    v0[2] *= sigmoidf_(bf_lo(zg.y) + bv[bj][0][2]); v0[3] *= sigmoidf_(bf_hi(zg.y) + bv[bj][0][3]);
                    v1[0] *= sigmoidf_(bf_lo(zg.z) + bv[bj][1][0]); v1[1] *= sigmoidf_(bf_hi(zg.z) + bv[bj][1][1]);
                    v1[2] *= sigmoidf_(bf_lo(zg.w) + bv[bj][1][2]); v1[3] *= sigmoidf_(bf_hi(zg.w) + bv[bj][1][3]);
                    if (SECOND) { const u32x4 t = *(const u32x4*)(T + row * ldc + c);
                        v0[0] += bf_lo(t.x); v0[1] += bf_hi(t.x); v0[2] += bf_lo(t.y); v0[3] += bf_hi(t.y);
                        v1[0] += bf_lo(t.z); v1[1] += bf_hi(t.z); v1[2] += bf_lo(t.w); v1[3] += bf_hi(t.w); }
                    u32x4 w; w.x = cvt_pk_bf16(v0[0], v0[1]); w.y = cvt_pk_bf16(v0[2], v0[3]); w.z = cvt_pk_bf16(v1[0], v1[1]); w.w = cvt_pk_bf16(v1[2], v1[3]);
                    *(u32x4*)(O + row * ldc + c) = w; } }
    }
};
struct EpiF32 {
    static constexpr bool PERM = false, AFTER_DRAIN = false;
    float* C; int ldc; const float* R; float scale;
    __device__ __forceinline__ void operator()(const f32x4 (&acc)[2][2][4][2], const Unit& u, int wr, int wc, int fr, int fq) const {
        const int row0 = u.pm * BM + wr * 64 + fr, col0 = u.pn * BM + wc * 32 + 4 * fq;
#pragma unroll
        for (int ai = 0; ai < 2; ++ai)
#pragma unroll
            for (int m = 0; m < 4; ++m) { const size_t off = (size_t)(row0 + ai * HALF + m * 16) * ldc + col0;
#pragma unroll
                for (int bj = 0; bj < 2; ++bj)
#pragma unroll
                    for (int n = 0; n < 2; ++n) { f32x4 v = acc[ai][bj][m][n];
                        if (R) v += *(const f32x4*)(R + off + bj * HALF + n * 16) * scale;
                        *(f32x4*)(C + off + bj * HALF + n * 16) = v; } }
    }
};

template <class Epi, class Sched, bool ALIGN_EPI = false, bool SP2 = false>
__device__ __forceinline__ void gemm_phase(PG8_LAS unsigned char* lds, const Gemm g, const Sched& S, const Epi& E) {
    int tid_ = threadIdx.x; asm volatile("" : "+v"(tid_));
    const int tid = tid_, wid = __builtin_amdgcn_readfirstlane(tid >> 6), lane = tid & 63, wr = wid >> 2, wc = wid & 3, fr = lane & 15, fq = lane >> 4;
    const int K = g.K, nt = K / BK;
    unsigned voffA[2], voffB[2];
#pragma unroll
    for (int i = 0; i < 2; ++i) { int R, C; stage_rc(tid * 16 + i * 8192, R, C); const int Rb = Epi::PERM ? ((R & ~31) + perm32(R & 31)) : R;
        voffA[i] = (unsigned)(R * K + C) * 2u; voffB[i] = (unsigned)(Rb * K + C) * 2u; }
    const size_t kstep = (size_t)(BK * 2);
    const size_t hstep = (size_t)HALF * K * 2;
    const size_t tstep = 2 * hstep;
    const unsigned ldsw = (unsigned)wid * 1024u;
    const int aoff = lds_byte(wr * 64 + fr, fq * 8), boff = lds_byte(wc * 32 + fr, fq * 8);
#define PG8_SA(b, h) (((b) * 2 + (h)) * HTB)
#define PG8_SB(b, h) ((4 + (b) * 2 + (h)) * HTB)
#define PG8_STAGE(bufoff, gbase, voff) do { _Pragma("unroll") for (int _i = 0; _i < 2; ++_i) \
        __builtin_amdgcn_global_load_lds((const unsigned*)((const char*)(gbase) + (voff)[_i]), (PG8_LAS unsigned*)(lds + (bufoff) + ldsw + _i * 8192), 16, 0, 0); } while (0)
#define PG8_LDA(dst, b, h) do { _Pragma("unroll") for (int m = 0; m < 4; ++m) _Pragma("unroll") for (int k = 0; k < 2; ++k) dst[m][k] = *(const PG8_LAS bf16x8*)(lds + PG8_SA(b, h) + aoff + m * 2048 + k * 1024); } while (0)
#define PG8_LDB(dst, b, h) do { _Pragma("unroll") for (int n = 0; n < 2; ++n) _Pragma("unroll") for (int k = 0; k < 2; ++k) dst[n][k] = *(const PG8_LAS bf16x8*)(lds + PG8_SB(b, h) + boff + n * 2048 + k * 1024); } while (0)
#define PG8_MMA(ai, bj, At, Bt) do { __builtin_amdgcn_s_setprio(1); _Pragma("unroll") for (int m = 0; m < 4; ++m) _Pragma("unroll") for (int n = 0; n < 2; ++n) _Pragma("unroll") for (int k = 0; k < 2; ++k) \
        acc[ai][bj][m][n] = __builtin_amdgcn_mfma_f32_16x16x32_bf16(Bt[n][k], At[m][k], acc[ai][bj][m][n], 0, 0, 0); __builtin_amdgcn_s_setprio(0); } while (0)
#define PG8_WAIT_V(n) asm volatile("s_waitcnt vmcnt(" #n ")" ::: "memory")
#define PG8_WAIT_L(n) asm volatile("s_waitcnt lgkmcnt(" #n ")" ::: "memory")
#define PG8_BAR __builtin_amdgcn_s_barrier()
#define PG8_SCHED __builtin_amdgcn_sched_barrier(0)
    Unit cur, nxt; int ui = 0;
    if (!S.next(0, cur)) return;
    f32x4 acc[2][2][4][2];
#pragma unroll
    for (int a = 0; a < 2; ++a)
#pragma unroll
        for (int b = 0; b < 2; ++b)
#pragma unroll
            for (int m = 0; m < 4; ++m)
#pragma unroll
                for (int n = 0; n < 2; ++n) acc[a][b][m][n] = (f32x4){0.f, 0.f, 0.f, 0.f};
    bf16x8 At[4][2], B0[2][2], B1[2][2];
    const char* cA = (const char*)g.A + (size_t)cur.pm * tstep; const char* cB = (const char*)g.Bt + (size_t)cur.pn * tstep;
    S.a_ready(cur);
    if constexpr (SP2) {
        PG8_STAGE(PG8_SB(0, 0), cB, voffB); PG8_STAGE(PG8_SB(0, 1), cB + hstep, voffB); PG8_STAGE(PG8_SA(0, 0), cA, voffA); PG8_STAGE(PG8_SA(0, 1), cA + hstep, voffA);
        if (wr == 1) PG8_BAR;
        PG8_WAIT_V(2); PG8_BAR;
        PG8_STAGE(PG8_SB(1, 0), cB + kstep, voffB); PG8_STAGE(PG8_SA(1, 0), cA + kstep, voffA); PG8_STAGE(PG8_SB(1, 1), cB + hstep + kstep, voffB);
        PG8_WAIT_V(6); PG8_BAR;
    } else {
        PG8_STAGE(PG8_SB(0, 0), cB, voffB); PG8_STAGE(PG8_SA(0, 0), cA, voffA); PG8_STAGE(PG8_SB(0, 1), cB + hstep, voffB); PG8_STAGE(PG8_SA(0, 1), cA + hstep, voffA);
        if (wr == 1) PG8_BAR;
        PG8_WAIT_V(4); PG8_BAR;
        PG8_STAGE(PG8_SB(1, 0), cB + kstep, voffB); PG8_STAGE(PG8_SA(1, 0), cA + kstep, voffA); PG8_STAGE(PG8_SB(1, 1), cB + hstep + kstep, voffB);
        PG8_WAIT_V(6); PG8_BAR;
    }
    for (;;) {
        const bool has_next = S.next(ui + 1, nxt);
        const char* nA = has_next ? (const char*)g.A + (size_t)nxt.pm * tstep : cA; const char* nB = has_next ? (const char*)g.Bt + (size_t)nxt.pn * tstep : cB;
        for (int t = 0; t < nt; t += 2) {
            const bool last = (t == nt - 2);
            const char* a1 = cA + (size_t)(t + 1) * kstep;
            const char* a2 = last ? nA : cA + (size_t)(t + 2) * kstep; const char* b2 = last ? nB : cB + (size_t)(t + 2) * kstep;
            const char* a3 = a2 + kstep; const char* b3 = b2 + kstep;
            if (last && has_next) S.a_ready(nxt);
            if constexpr (SP2) {
            PG8_LDB(B0, 0, 0); PG8_LDB(B1, 0, 1); PG8_SCHED; PG8_LDA(At, 0, 0); PG8_STAGE(PG8_SA(1, 1), a1 + hstep, voffA);
            PG8_WAIT_V(8); PG8_WAIT_L(0); PG8_BAR; PG8_MMA(0, 0, At, B0); PG8_MMA(0, 1, At, B1); PG8_BAR; PG8_SCHED;
            PG8_LDA(At, 0, 1); PG8_STAGE(PG8_SB(0, 0), b2, voffB); PG8_STAGE(PG8_SB(0, 1), b2 + hstep, voffB); PG8_STAGE(PG8_SA(0, 0), a2, voffA);
            PG8_WAIT_V(8); PG8_WAIT_L(0); PG8_BAR; PG8_MMA(1, 0, At, B0); PG8_MMA(1, 1, At, B1); PG8_BAR; PG8_SCHED;
            PG8_LDB(B0, 1, 0); PG8_LDB(B1, 1, 1); PG8_SCHED; PG8_LDA(At, 1, 0); PG8_STAGE(PG8_SA(0, 1), a2 + hstep, voffA);
            PG8_WAIT_V(8); PG8_WAIT_L(0); PG8_BAR; PG8_MMA(0, 0, At, B0); PG8_MMA(0, 1, At, B1); PG8_BAR; PG8_SCHED;
            PG8_LDA(At, 1, 1); PG8_STAGE(PG8_SB(1, 0), b3, voffB); PG8_STAGE(PG8_SB(1, 1), b3 + hstep, voffB); PG8_STAGE(PG8_SA(1, 0), a3, voffA);
            PG8_WAIT_V(8); PG8_WAIT_L(0); PG8_BAR; PG8_MMA(1, 0, At, B0); PG8_MMA(1, 1, At, B1); PG8_BAR; PG8_SCHED;
            } else {
            PG8_LDB(B0, 0, 0); PG8_SCHED; PG8_LDA(At, 0, 0); PG8_STAGE(PG8_SA(1, 1), a1 + hstep, voffA);
            PG8_WAIT_L(8); PG8_BAR; PG8_WAIT_L(0); PG8_MMA(0, 0, At, B0); PG8_BAR; PG8_SCHED;
            PG8_LDB(B1, 0, 1); PG8_STAGE(PG8_SB(0, 0), b2, voffB);
            PG8_BAR; PG8_WAIT_L(0); PG8_MMA(0, 1, At, B1); PG8_BAR;
            PG8_LDA(At, 0, 1); PG8_STAGE(PG8_SA(0, 0), a2, voffA);
            PG8_BAR; PG8_WAIT_L(0); PG8_MMA(1, 0, At, B0); PG8_BAR; PG8_SCHED;
            PG8_STAGE(PG8_SB(0, 1), b2 + hstep, voffB);
            PG8_WAIT_V(6); PG8_BAR; PG8_MMA(1, 1, At, B1); PG8_BAR;
            PG8_LDB(B0, 1, 0); PG8_SCHED; PG8_LDA(At, 1, 0); PG8_STAGE(PG8_SA(0, 1), a2 + hstep, voffA);
            PG8_WAIT_L(8); PG8_BAR; PG8_WAIT_L(0); PG8_MMA(0, 0, At, B0); PG8_BAR; PG8_SCHED;
            PG8_LDB(B1, 1, 1); PG8_STAGE(PG8_SB(1, 0), b3, voffB);
            PG8_BAR; PG8_WAIT_L(0); PG8_MMA(0, 1, At, B1); PG8_BAR;
            PG8_LDA(At, 1, 1); PG8_STAGE(PG8_SA(1, 0), a3, voffA);
            PG8_BAR; PG8_WAIT_L(0); PG8_MMA(1, 0, At, B0); PG8_BAR; PG8_SCHED;
            PG8_STAGE(PG8_SB(1, 1), b3 + hstep, voffB);
            PG8_WAIT_V(6); PG8_BAR; PG8_MMA(1, 1, At, B1); PG8_BAR;
            }
        }
        if constexpr (ALIGN_EPI) { if (wr == 0) PG8_BAR; }
        if constexpr (!Epi::AFTER_DRAIN) { E(acc, cur, wr, wc, fr, fq); S.done(cur); }
        if (!has_next) break;
#pragma unroll
        for (int a = 0; a < 2; ++a)
#pragma unroll
            for (int b = 0; b < 2; ++b)
#pragma unroll
                for (int m = 0; m < 4; ++m)
#pragma unroll
                    for (int n = 0; n < 2; ++n) acc[a][b][m][n] = (f32x4){0.f, 0.f, 0.f, 0.f};
        cur = nxt; cA = nA; cB = nB; ++ui;
        if constexpr (ALIGN_EPI) { if (wr == 1) PG8_BAR; }
    }
    PG8_WAIT_V(0);
    if constexpr (!ALIGN_EPI) { if (wr == 0) PG8_BAR; }
    PG8_BAR;
    if constexpr (Epi::AFTER_DRAIN) { E.fused(acc, cur, wr, wc, fr, fq, lds, wid, lane); S.done(cur); }
#undef PG8_SA
#undef PG8_SB
#undef PG8_STAGE
#undef PG8_LDA
#undef PG8_LDB
#undef PG8_MMA
#undef PG8_WAIT_V
#undef PG8_WAIT_L
#undef PG8_BAR
#undef PG8_SCHED
}
}
#define GAS __attribute__((address_space(1)))
#define LAS __attribute__((address_space(3)))
typedef unsigned short bf16;
typedef unsigned v4u __attribute__((ext_vector_type(4)));
typedef float f32x4 __attribute__((ext_vector_type(4)));
typedef short bf16x8 __attribute__((ext_vector_type(8)));
typedef GAS unsigned gu32;
typedef GAS unsigned long long gu64;
#define RLX_AGENT __ATOMIC_RELAXED, __HIP_MEMORY_SCOPE_AGENT
#define LDS_WAIT() asm volatile("s_waitcnt lgkmcnt(0)" ::: "memory")
#define VM_WAIT() asm volatile("s_waitcnt vmcnt(0)" ::: "memory")
__device__ __forceinline__ unsigned long long rt() { return __builtin_amdgcn_s_memrealtime(); }
__device__ __forceinline__ unsigned f2bf(float f) { unsigned u = __builtin_bit_cast(unsigned, f); return (u + 0x7fffu + ((u >> 16) & 1u)) >> 16; }
__device__ __forceinline__ unsigned pk2(float lo, float hi) { return f2bf(lo) | (f2bf(hi) << 16); }

#define XB_TMO      128
#define XB_XCNT(j)  (256  + 64 * (j))
#define XB_XSUB(j)  (1280 + 64 * (j))
#define XB_XGEN(j)  (2304 + 64 * (j))
#define XB_TOP      3328
#define XB_TOPGEN   3392
#define XCD_BAR_WORDS 3456
#define XB_SPIN_CAP (1u << 18)

__device__ __forceinline__ unsigned xb_ld(unsigned* p)              { return __hip_atomic_load(p, __ATOMIC_RELAXED, __HIP_MEMORY_SCOPE_AGENT); }
__device__ __forceinline__ unsigned xb_add(unsigned* p, unsigned v) { return __hip_atomic_fetch_add(p, v, __ATOMIC_RELAXED, __HIP_MEMORY_SCOPE_AGENT); }
__device__ __forceinline__ unsigned xb_xcc_id() { return (unsigned)__builtin_amdgcn_s_getreg((3 << 11) | 20) & 0xFu; }
#define XB_SPIN(cond, bar) do { unsigned _sp = 0; while (cond) { __builtin_amdgcn_s_sleep(1); \
    if ((++_sp & 255u) == 0u) { if (xb_ld(&(bar)[XB_TMO])) break; if (_sp > XB_SPIN_CAP) { atomicAdd(&(bar)[XB_TMO], 1u); break; } } } } while (0)

struct XcdBarrier {
    unsigned* bar; unsigned x;
    volatile LAS unsigned* st;
};

__device__ __forceinline__ XcdBarrier xcd_barrier_post(unsigned* bar, volatile LAS unsigned* st) {
    XcdBarrier b; b.bar = bar; b.x = xb_xcc_id(); b.st = st;
    if (threadIdx.x == 0) (void)xb_add(&bar[XB_XCNT(b.x)], 1u);
    return b;
}
__device__ __forceinline__ void xcd_barrier_complete(unsigned* bar, unsigned x, unsigned& nloc, unsigned& nx) {
    const unsigned G = gridDim.x * gridDim.y * gridDim.z;
    unsigned sum, cnt, mine, sp = 0u;
    for (;;) {
        sum = 0u; cnt = 0u; mine = 0u;
#pragma unroll
        for (unsigned j = 0; j < 16; ++j) { const unsigned c = xb_ld(&bar[XB_XCNT(j)]); sum += c; cnt += (c > 0u) ? 1u : 0u; mine = (j == x) ? c : mine; }
        if (sum == G) break;
        __builtin_amdgcn_s_sleep(1);
        if ((++sp & 255u) == 0u) { if (xb_ld(&bar[XB_TMO])) break; if (sp > XB_SPIN_CAP) { atomicAdd(&bar[XB_TMO], 1u); break; } }
    }
    nloc = mine > 0u ? mine : 1u; nx = cnt > 0u ? cnt : 1u;
}

__device__ __forceinline__ void xcd_barrier(const XcdBarrier& b) {
    asm volatile("s_waitcnt vmcnt(0)" ::: "memory");
    __syncthreads();
    if (threadIdx.x == 0) {
        unsigned* bar = b.bar;
        __builtin_amdgcn_s_waitcnt(0);
        unsigned nloc = b.st[0], nx = b.st[1];
        if (nloc == 0u) { xcd_barrier_complete(bar, b.x, nloc, nx); b.st[0] = nloc; b.st[1] = nx; }
        const unsigned old = xb_add(&bar[XB_XSUB(b.x)], 1u);
        const unsigned gen = old / nloc;
        if (old + 1u == (gen + 1u) * nloc) {
            __builtin_amdgcn_fence(__ATOMIC_RELEASE, "agent");
            asm volatile("s_waitcnt vmcnt(0)" ::: "memory");
            const unsigned og = xb_add(&bar[XB_TOP], 1u);
            const unsigned tg = og / nx;
            if (og + 1u == (tg + 1u) * nx) xb_add(&bar[XB_TOPGEN], 1u);
            else XB_SPIN(xb_ld(&bar[XB_TOPGEN]) == tg, bar);
            __builtin_amdgcn_fence(__ATOMIC_ACQUIRE, "agent");
            xb_add(&bar[XB_XGEN(b.x)], 1u);
            asm volatile("s_waitcnt vmcnt(0)" ::: "memory");
        } else {
            XB_SPIN(xb_ld(&bar[XB_XGEN(b.x)]) == gen, bar);
            __builtin_amdgcn_fence(__ATOMIC_ACQUIRE, "agent");
            asm volatile("s_waitcnt vmcnt(0)" ::: "memory");
        }
    }
    __syncthreads();
}

constexpr int NWAVES = 8, NTHREADS = 512;
constexpr int BATCH = 4, SEQ = 2048, D = 2048, M = BATCH * SEQ;
constexpr int NQH = 32, NKVH = 4, HD = 64, QPKV = 8, WINDOW = 128;
constexpr int Q_OFF = 0, K_OFF = 2048, V_OFF = 2304, CB_OFF = 2560, CC_OFF = 4608, CH_OFF = 6656, G_OFF = 8704, IN_W = 12800;
constexpr int PH = 8, PNK = 128, PTOPK = 16, PNE = 16384;
constexpr float LN_EPS = 1e-5f;
constexpr float ALPHA = 1.189207115002721f;

#ifndef MK_PER_PHASE
#define MK_PER_PHASE 0
#endif
constexpr int N_PHASES = 11;

constexpr size_t MiB = 1u << 20;
constexpr size_t WS_CTL = 0, CTL_ZERO_BYTES = 1 * MiB;
constexpr size_t WS_WIN = 1 * MiB;
constexpr size_t WS_WA = 51 * MiB, WS_WC = 59 * MiB, WS_WO = 67 * MiB, WS_WF = 75 * MiB;
constexpr size_t WS_XB = 83 * MiB;
constexpr size_t WS_MERGED = WS_XB;
constexpr size_t WS_Z = 115 * MiB;
constexpr size_t WS_H1 = 115 * MiB;
constexpr size_t WS_H1B = 179 * MiB;
constexpr size_t WS_SC = 211 * MiB;
constexpr size_t WS_EX = 275 * MiB;
constexpr size_t WS_GT = 279 * MiB;
constexpr size_t WS_AO = 315 * MiB, WS_CI = 347 * MiB, WS_TMP = 379 * MiB;
constexpr size_t WS_U8 = 411 * MiB, WS_V8 = 443 * MiB;
constexpr size_t WS_SU = 475 * MiB, WS_SV = WS_SU + 65536;
constexpr size_t WS_PA = WS_SC;
constexpr size_t WS_ST = 379 * MiB;
constexpr size_t WS_END = 476 * MiB;
constexpr int CW_Q = 12288;
constexpr size_t SLICE_BYTES = (size_t)PNE * 256;
constexpr int CW_BAR = 4096;

constexpr int RING_BYTES = 131072;
constexpr int LDSCTL_OFF = 147456, MISC_OFF = LDSCTL_OFF + 320;
constexpr int LDS_BYTES = LDSCTL_OFF + 512;

typedef float f32x16 __attribute__((ext_vector_type(16)));
typedef unsigned v2u __attribute__((ext_vector_type(2)));
__device__ __forceinline__ float wave_sum(float v) {
#pragma unroll
    for (int o = 1; o < 64; o <<= 1) v += __shfl_xor(v, o);
    return v;
}
__device__ __forceinline__ float vmaxf(float a, float b) { float r; asm("v_max_f32_e32 %0, %1, %2" : "=v"(r) : "v"(a), "v"(b)); return r; }
__device__ __forceinline__ float vminf(float a, float b) { float r; asm("v_min_f32_e32 %0, %1, %2" : "=v"(r) : "v"(a), "v"(b)); return r; }

__device__ __forceinline__ void p0_transpose_item(const float* W, int K, int N, bf16* WT, LAS float* scr, int item, int lane) {
    const int nblk = N / 32, kb = item / nblk, nb = item % nblk, k0 = 64 * kb, n0 = 32 * nb;
#pragma unroll 8
    for (int i = 0; i < 32; ++i) { const int kk = 2 * i + (lane >> 5); scr[kk * 33 + (lane & 31)] = W[(size_t)(k0 + kk) * N + n0 + (lane & 31)]; }
    LDS_WAIT(); asm volatile("" ::: "memory");
    const int c = lane & 7;
#pragma unroll
    for (int j = 0; j < 4; ++j) { const int n = (lane >> 3) + 8 * j; const LAS float* s = scr + (8 * c) * 33 + n;
        v4u o; o.x = pk2(s[0 * 33], s[1 * 33]); o.y = pk2(s[2 * 33], s[3 * 33]); o.z = pk2(s[4 * 33], s[5 * 33]); o.w = pk2(s[6 * 33], s[7 * 33]);
        *(GAS v4u*)(WT + (size_t)(n0 + n) * K + k0 + 8 * c) = o; }
    LDS_WAIT(); asm volatile("" ::: "memory");
}
__device__ __forceinline__ void p0_wf_item(const float* wq, const float* sk, bf16* WfT, LAS unsigned char* lds, int item, int tid) {
    const int hp = item >> 5, dt = item & 31;
    LAS f32x4* SK4 = (LAS f32x4*)lds;
    LAS f32x4* WQ4 = SK4 + 128 * 33;
    const float* skp = sk + (size_t)hp * 128 * 128;
    for (int i = tid; i < 128 * 32; i += NTHREADS) { const int n = i >> 5, c4 = i & 31; SK4[n * 33 + c4] = *(const f32x4*)(skp + n * 128 + 4 * c4); }
    for (int i = tid; i < 64 * 32; i += NTHREADS) { const int r = i >> 5, c4 = i & 31; WQ4[r * 33 + c4] = *(const f32x4*)(wq + (size_t)(64 * dt + r) * 2048 + hp * 128 + 4 * c4); }
    __syncthreads();
    const int td = tid & 15, tn = tid >> 4;
    float acc[4][4];
#pragma unroll
    for (int i = 0; i < 4; ++i)
#pragma unroll
        for (int j = 0; j < 4; ++j) acc[i][j] = 0.f;
#pragma unroll 4
    for (int c4 = 0; c4 < 32; ++c4) {
        f32x4 a[4], b[4];
#pragma unroll
        for (int i = 0; i < 4; ++i) a[i] = SK4[(4 * tn + i) * 33 + c4];
#pragma unroll
        for (int j = 0; j < 4; ++j) b[j] = WQ4[(td + 16 * j) * 33 + c4];
#pragma unroll
        for (int i = 0; i < 4; ++i)
#pragma unroll
            for (int j = 0; j < 4; ++j) acc[i][j] += a[i].x * b[j].x + a[i].y * b[j].y + a[i].z * b[j].z + a[i].w * b[j].w;
    }
#pragma unroll
    for (int i = 0; i < 4; ++i)
#pragma unroll
        for (int j = 0; j < 4; ++j) WfT[(size_t)(hp * 128 + 4 * tn + i) * 2048 + 64 * dt + td + 16 * j] = (bf16)f2bf(acc[i][j]);
    __syncthreads();
}

__device__ __forceinline__ int perm16(int o) { return 8 * ((o >> 2) & 1) + 4 * (o >> 3) + (o & 3); }
__device__ __forceinline__ void attn_unit(int unit, const bf16* z, bf16* ao, const float* sinks, LAS unsigned char* lds, int tid) {
    const int lane = tid & 63, wid = __builtin_amdgcn_readfirstlane(tid >> 6), r32 = lane & 31, hi = lane >> 5;
    const int nb = unit & 15, kvh = (unit >> 4) & 3, b = unit >> 6;
    LAS bf16* Ks = (LAS bf16*)lds;
    LAS bf16* Vt = (LAS bf16*)(lds + 256 * 144);
    const size_t tok0 = (size_t)b * SEQ;
#pragma unroll
    for (int i = 0; i < 4; ++i) {
        const int ci = tid + NTHREADS * i, key = ci >> 3, dc = ci & 7;
        int kpos = 128 * (nb - 1) + key; if (kpos < 0) kpos = 0;
        const bf16* src = z + (tok0 + kpos) * IN_W + K_OFF + kvh * HD + dc * 8;
        const v4u kv = *(const GAS v4u*)src, vv = *(const GAS v4u*)(src + (V_OFF - K_OFF));
        *(LAS v4u*)(Ks + key * 72 + dc * 8) = kv;
        const int pos = (key & ~15) + perm16(key & 15);
        LAS bf16* vp = Vt + (dc * 8) * 264 + pos;
        vp[0 * 264] = (bf16)(vv.x & 0xffffu); vp[1 * 264] = (bf16)(vv.x >> 16); vp[2 * 264] = (bf16)(vv.y & 0xffffu); vp[3 * 264] = (bf16)(vv.y >> 16);
        vp[4 * 264] = (bf16)(vv.z & 0xffffu); vp[5 * 264] = (bf16)(vv.z >> 16); vp[6 * 264] = (bf16)(vv.w & 0xffffu); vp[7 * 264] = (bf16)(vv.w >> 16);
    }
    __syncthreads();
    const int hq = kvh * QPKV + wid;
    const float LOG2E = 1.4426950408889634f;
    const float sink2 = sinks[hq] * LOG2E, sc = 0.125f * LOG2E;
#pragma unroll 1
    for (int qg = 0; qg < 4; ++qg) {
        const size_t tok = tok0 + 128 * nb + 32 * qg + r32;
        bf16x8 qf[4];
#pragma unroll
        for (int ks = 0; ks < 4; ++ks) qf[ks] = *(const GAS bf16x8*)(z + tok * IN_W + Q_OFF + hq * HD + 16 * ks + 8 * hi);
        f32x16 s[5];
#pragma unroll
        for (int kt = 0; kt < 5; ++kt) {
            s[kt] = (f32x16){0.f, 0.f, 0.f, 0.f, 0.f, 0.f, 0.f, 0.f, 0.f, 0.f, 0.f, 0.f, 0.f, 0.f, 0.f, 0.f};
#pragma unroll
            for (int ks = 0; ks < 4; ++ks) {
                const bf16x8 kf = *(const LAS bf16x8*)(Ks + (32 * (qg + kt) + r32) * 72 + 16 * ks + 8 * hi);
                s[kt] = __builtin_amdgcn_mfma_f32_32x32x16_bf16(kf, qf[ks], s[kt], 0, 0, 0);
            }
        }
        float mx = sink2;
#pragma unroll
        for (int kt = 0; kt < 5; ++kt) {
            const bool tile_dead = (nb == 0) && (qg + kt < 4);
#pragma unroll
            for (int r = 0; r < 16; ++r) {
                const int krow = (r & 3) + 8 * (r >> 2) + 4 * hi;
                bool valid = !tile_dead;
                if (kt == 0) valid = valid && (krow > r32);
                if (kt == 4) valid = valid && (krow <= r32);
                const float v = valid ? s[kt][r] * sc : -INFINITY;
                s[kt][r] = v; mx = fmaxf(mx, v);
            }
        }
        mx = fmaxf(mx, __shfl_xor(mx, 32));
        float sum = 0.f;
#pragma unroll
        for (int kt = 0; kt < 5; ++kt)
#pragma unroll
            for (int r = 0; r < 16; ++r) { const float p = __builtin_amdgcn_exp2f(s[kt][r] - mx); s[kt][r] = p; sum += p; }
        sum += __shfl_xor(sum, 32);
        const float inv = 1.0f / (sum + __builtin_amdgcn_exp2f(sink2 - mx));
        f32x16 o[2];
        o[0] = (f32x16){0.f, 0.f, 0.f, 0.f, 0.f, 0.f, 0.f, 0.f, 0.f, 0.f, 0.f, 0.f, 0.f, 0.f, 0.f, 0.f}; o[1] = o[0];
#pragma unroll
        for (int kt = 0; kt < 5; ++kt)
#pragma unroll
            for (int s2 = 0; s2 < 2; ++s2) {
                v4u pw; pw.x = pg8::cvt_pk_bf16(s[kt][8 * s2 + 0], s[kt][8 * s2 + 1]); pw.y = pg8::cvt_pk_bf16(s[kt][8 * s2 + 2], s[kt][8 * s2 + 3]);
                pw.z = pg8::cvt_pk_bf16(s[kt][8 * s2 + 4], s[kt][8 * s2 + 5]); pw.w = pg8::cvt_pk_bf16(s[kt][8 * s2 + 6], s[kt][8 * s2 + 7]);
                const bf16x8 pa = __builtin_bit_cast(bf16x8, pw);
#pragma unroll
                for (int dt = 0; dt < 2; ++dt) {
                    const bf16x8 vf = *(const LAS bf16x8*)(Vt + (32 * dt + r32) * 264 + 32 * (qg + kt) + 16 * s2 + 8 * hi);
                    o[dt] = __builtin_amdgcn_mfma_f32_32x32x16_bf16(vf, pa, o[dt], 0, 0, 0);
                }
            }
        bf16* op = ao + tok * D + hq * HD;
#pragma unroll
        for (int dt = 0; dt < 2; ++dt)
#pragma unroll
            for (int g = 0; g < 4; ++g) {
                v2u w; w.x = pg8::cvt_pk_bf16(o[dt][4 * g + 0] * inv, o[dt][4 * g + 1] * inv); w.y = pg8::cvt_pk_bf16(o[dt][4 * g + 2] * inv, o[dt][4 * g + 3] * inv);
                *(GAS v2u*)(op + 32 * dt + 8 * g + 4 * hi) = w;
            }
    }
    __syncthreads();
}
__device__ __forceinline__ void conv_item(int item, const bf16* z, const float* cw, bf16* ci, int tid) {
    const int c8 = tid & 255, half = tid >> 8, t0 = 32 * item + 16 * half, c0 = 8 * c8;
    float w0[8], w1[8], w2[8], u1[8], u2[8];
#pragma unroll
    for (int e = 0; e < 8; ++e) { w0[e] = cw[c0 + e]; w1[e] = cw[2048 + c0 + e]; w2[e] = cw[4096 + c0 + e]; u1[e] = 0.f; u2[e] = 0.f; }
    if ((t0 & (SEQ - 1)) != 0) {
#pragma unroll
        for (int k = 0; k < 2; ++k) {
            const bf16* zr = z + (size_t)(t0 - 2 + k) * IN_W + c0;
            const v4u a = *(const GAS v4u*)(zr + CC_OFF), h = *(const GAS v4u*)(zr + CH_OFF);
            float u[8];
            u[0] = pg8::bf_lo(a.x) * pg8::bf_lo(h.x); u[1] = pg8::bf_hi(a.x) * pg8::bf_hi(h.x); u[2] = pg8::bf_lo(a.y) * pg8::bf_lo(h.y); u[3] = pg8::bf_hi(a.y) * pg8::bf_hi(h.y);
            u[4] = pg8::bf_lo(a.z) * pg8::bf_lo(h.z); u[5] = pg8::bf_hi(a.z) * pg8::bf_hi(h.z); u[6] = pg8::bf_lo(a.w) * pg8::bf_lo(h.w); u[7] = pg8::bf_hi(a.w) * pg8::bf_hi(h.w);
#pragma unroll
            for (int e = 0; e < 8; ++e) { if (k == 0) u2[e] = u[e]; else u1[e] = u[e]; }
        }
    }
#pragma unroll 4
    for (int i = 0; i < 16; ++i) {
        const bf16* zr = z + (size_t)(t0 + i) * IN_W + c0;
        const v4u a = *(const GAS v4u*)(zr + CC_OFF), h = *(const GAS v4u*)(zr + CH_OFF), bb = *(const GAS v4u*)(zr + CB_OFF);
        float u[8], cb[8], y[8];
        u[0] = pg8::bf_lo(a.x) * pg8::bf_lo(h.x); u[1] = pg8::bf_hi(a.x) * pg8::bf_hi(h.x); u[2] = pg8::bf_lo(a.y) * pg8::bf_lo(h.y); u[3] = pg8::bf_hi(a.y) * pg8::bf_hi(h.y);
        u[4] = pg8::bf_lo(a.z) * pg8::bf_lo(h.z); u[5] = pg8::bf_hi(a.z) * pg8::bf_hi(h.z); u[6] = pg8::bf_lo(a.w) * pg8::bf_lo(h.w); u[7] = pg8::bf_hi(a.w) * pg8::bf_hi(h.w);
        cb[0] = pg8::bf_lo(bb.x); cb[1] = pg8::bf_hi(bb.x); cb[2] = pg8::bf_lo(bb.y); cb[3] = pg8::bf_hi(bb.y); cb[4] = pg8::bf_lo(bb.z); cb[5] = pg8::bf_hi(bb.z); cb[6] = pg8::bf_lo(bb.w); cb[7] = pg8::bf_hi(bb.w);
#pragma unroll
        for (int e = 0; e < 8; ++e) { y[e] = cb[e] * (w0[e] * u2[e] + w1[e] * u1[e] + w2[e] * u[e]); u2[e] = u1[e]; u1[e] = u[e]; }
        v4u o; o.x = pk2(y[0], y[1]); o.y = pk2(y[2], y[3]); o.z = pk2(y[4], y[5]); o.w = pk2(y[6], y[7]);
        *(GAS v4u*)(ci + (size_t)(t0 + i) * D + c0) = o;
    }
}

__device__ __forceinline__ void ln1_row(float* r1row, bf16* hbrow, const float* g, const float* bta, int lane) {
    GAS f32x4* xr = (GAS f32x4*)r1row + lane;
    f32x4 v[8]; float s = 0.f;
#pragma unroll
    for (int j = 0; j < 8; ++j) { v[j] = xr[64 * j]; s += (v[j].x + v[j].y) + (v[j].z + v[j].w); }
    const float mean = wave_sum(s) * (1.f / D); float s2 = 0.f;
#pragma unroll
    for (int j = 0; j < 8; ++j) { v[j] = v[j] - mean; s2 += (v[j].x * v[j].x + v[j].y * v[j].y) + (v[j].z * v[j].z + v[j].w * v[j].w); }
    const float rstd = 1.f / sqrtf(wave_sum(s2) * (1.f / D) + LN_EPS);
    GAS v2u* o8 = (GAS v2u*)hbrow + lane;
#pragma unroll
    for (int j = 0; j < 8; ++j) {
        const f32x4 gg = *((const GAS f32x4*)g + lane + 64 * j), bb = *((const GAS f32x4*)bta + lane + 64 * j);
        const f32x4 y = v[j] * rstd * gg + bb;
        xr[64 * j] = y;
        v2u w; w.x = pk2(y.x, y.y); w.y = pk2(y.z, y.w); o8[64 * j] = w;
    }
}

constexpr int TK_ROWF = 136;
constexpr int TK_IDX_OFF = 256 * TK_ROWF * 4;
__device__ __forceinline__ void topk_pass(int pass, const float* scores, int* experts, float* gates, LAS unsigned char* lds, int tid) {
    LAS float* S = (LAS float*)lds;
    LAS unsigned char* IDX = lds + TK_IDX_OFF;
    const float* src = scores + (size_t)pass * (256 * 128);
#pragma unroll 4
    for (int i = 0; i < 16; ++i) { const int f4 = tid + NTHREADS * i, row = f4 >> 5, c4 = f4 & 31; *(LAS f32x4*)(S + row * TK_ROWF + 4 * c4) = *(const GAS f32x4*)(src + (size_t)f4 * 4); }
    __syncthreads();
    const int row = tid >> 1, sub = tid & 1;
    float L[16];
#pragma unroll
    for (int j = 0; j < 16; ++j) L[j] = -INFINITY;
#pragma unroll 2
    for (int i = 0; i < 16; ++i) {
        const int c4 = 2 * i + sub;
        const f32x4 v = *(const LAS f32x4*)(S + row * TK_ROWF + 4 * c4);
#pragma unroll
        for (int e = 0; e < 4; ++e) {
            const float ve = v[e];
            float x = __uint_as_float((__float_as_uint(ve) & ~0x7Fu) | (unsigned)(4 * c4 + e));
#pragma unroll
            for (int j = 0; j < 16; ++j) { const float h = vmaxf(L[j], x); x = vminf(L[j], x); L[j] = h; }
        }
    }
    {
        float P[16];
#pragma unroll
        for (int j = 0; j < 16; ++j) P[j] = __shfl_xor(L[j], 1);
#pragma unroll
        for (int j = 0; j < 16; ++j) L[j] = vmaxf(L[j], P[15 - j]);
#pragma unroll
        for (int st = 8; st >= 1; st >>= 1)
#pragma unroll
            for (int j = 0; j < 16; ++j) if ((j & st) == 0) { const float h = vmaxf(L[j], L[j + st]), l = vminf(L[j], L[j + st]); L[j] = h; L[j + st] = l; }
    }
    if (sub == 0) {
#pragma unroll
        for (int q = 0; q < 4; ++q) {
            unsigned w = 0;
#pragma unroll
            for (int e = 0; e < 4; ++e) w |= (__builtin_bit_cast(unsigned, L[4 * q + e]) & 0x7Fu) << (8 * e);
            *(LAS unsigned*)(IDX + row * 16 + 4 * q) = w;
        }
    }
    float A[16], B[16];
#pragma unroll
    for (int j = 0; j < 16; ++j) { const float o = __shfl_xor(L[j], 2); const bool isb = (tid & 2) != 0; A[j] = isb ? o : L[j]; B[j] = isb ? L[j] : o; }
    float F[16];
#pragma unroll
    for (int j = 0; j < 16; ++j) F[j] = -INFINITY;
#pragma unroll
    for (int i = 0; i < 16; ++i)
#pragma unroll
        for (int j = 0; j < 16; ++j) if ((i + 1) * (j + 1) <= 16) {
            const float sm = A[i] + B[j];
            float x = __builtin_bit_cast(float, (__builtin_bit_cast(unsigned, sm) & ~0xFFu) | (unsigned)(i * 16 + j));
#pragma unroll
            for (int k = 0; k < 16; ++k) { const float h = vmaxf(F[k], x); x = vminf(F[k], x); F[k] = h; }
        }
    __syncthreads();
    if ((tid & 3) == 0) {
        const int rowA = (tid >> 2) * 2, rowB = rowA + 1;
        const size_t prob = (size_t)pass * 128 + (tid >> 2);
        float g[16]; int ex[16]; float gs = 0.f;
#pragma unroll
        for (int k = 0; k < 16; ++k) {
            const unsigned code = __builtin_bit_cast(unsigned, F[k]) & 0xFFu;
            const int ia = IDX[rowA * 16 + (code >> 4)], ib = IDX[rowB * 16 + (code & 15)];
            ex[k] = ia * PNK + ib;
            g[k] = __expf(F[k] - F[0]); gs += g[k];
        }
        const float ginv = 1.0f / gs;
#pragma unroll
        for (int q = 0; q < 4; ++q) {
            *(GAS f32x4*)(gates + prob * 16 + 4 * q) = (f32x4){g[4 * q] * ginv, g[4 * q + 1] * ginv, g[4 * q + 2] * ginv, g[4 * q + 3] * ginv};
            typedef int i32x4 __attribute__((ext_vector_type(4)));
            *(GAS i32x4*)(experts + prob * 16 + 4 * q) = (i32x4){ex[4 * q], ex[4 * q + 1], ex[4 * q + 2], ex[4 * q + 3]};
        }
    }
    __syncthreads();
}

__device__ __forceinline__ float gelu_erf(float v) { return 0.5f * v * (1.0f + erff(v * 0.70710678118654752f)); }
typedef __bf16 bf16x2_t __attribute__((ext_vector_type(2)));
typedef float f32x2_t __attribute__((ext_vector_type(2)));
__device__ __forceinline__ float dot2bf(bf16x2_t a, unsigned b, float acc) { return __builtin_amdgcn_fdot2_f32_bf16(a, __builtin_bit_cast(bf16x2_t, b), acc, false); }
__device__ __forceinline__ float dot4f8(unsigned w8, unsigned x01, unsigned x23, float acc) {
    acc = dot2bf(__builtin_amdgcn_cvt_scalef32_pk_bf16_fp8(w8, 1.0f, false), x01, acc);
    return dot2bf(__builtin_amdgcn_cvt_scalef32_pk_bf16_fp8(w8, 1.0f, true), x23, acc);
}
__device__ __forceinline__ void axpy4f8(float* y, unsigned w8, float w) {
    const f32x2_t lo = __builtin_amdgcn_cvt_pk_f32_fp8(w8, false), hi = __builtin_amdgcn_cvt_pk_f32_fp8(w8, true);
    y[0] += w * lo.x; y[1] += w * lo.y; y[2] += w * hi.x; y[3] += w * hi.y;
}
__device__ __forceinline__ void row_to_fp8(const float* src, unsigned char* dst, float* inv, int lane) {
    f32x4 v[2][4]; float mx = 0.f;
#pragma unroll
    for (int j = 0; j < 2; ++j)
#pragma unroll
        for (int q = 0; q < 4; ++q) { v[j][q] = *((const GAS f32x4*)src + 4 * (lane + 64 * j) + q);
            mx = fmaxf(mx, fmaxf(fmaxf(fabsf(v[j][q].x), fabsf(v[j][q].y)), fmaxf(fabsf(v[j][q].z), fabsf(v[j][q].w)))); }
#pragma unroll
    for (int o = 1; o < 64; o <<= 1) mx = fmaxf(mx, __shfl_xor(mx, o));
    const float sc = mx > 0.f ? 384.0f / mx : 1.0f;
#pragma unroll
    for (int j = 0; j < 2; ++j) { v4u o;
        int w;
        w = 0; w = __builtin_amdgcn_cvt_pk_fp8_f32(v[j][0].x * sc, v[j][0].y * sc, w, false); w = __builtin_amdgcn_cvt_pk_fp8_f32(v[j][0].z * sc, v[j][0].w * sc, w, true); o.x = (unsigned)w;
        w = 0; w = __builtin_amdgcn_cvt_pk_fp8_f32(v[j][1].x * sc, v[j][1].y * sc, w, false); w = __builtin_amdgcn_cvt_pk_fp8_f32(v[j][1].z * sc, v[j][1].w * sc, w, true); o.y = (unsigned)w;
        w = 0; w = __builtin_amdgcn_cvt_pk_fp8_f32(v[j][2].x * sc, v[j][2].y * sc, w, false); w = __builtin_amdgcn_cvt_pk_fp8_f32(v[j][2].z * sc, v[j][2].w * sc, w, true); o.z = (unsigned)w;
        w = 0; w = __builtin_amdgcn_cvt_pk_fp8_f32(v[j][3].x * sc, v[j][3].y * sc, w, false); w = __builtin_amdgcn_cvt_pk_fp8_f32(v[j][3].z * sc, v[j][3].w * sc, w, true); o.w = (unsigned)w;
        { const int ch = lane + 64 * j; *((GAS v4u*)(dst + (size_t)(ch >> 4) * SLICE_BYTES) + (ch & 15)) = o; } }
    if (lane == 0) *inv = mx > 0.f ? mx * (1.0f / 384.0f) : 1.0f;
}
__device__ __forceinline__ float row16_allsum(float a) {
    a += __builtin_bit_cast(float, __builtin_amdgcn_update_dpp(0, __builtin_bit_cast(int, a), 0x128, 0xf, 0xf, false));
    a += __builtin_bit_cast(float, __builtin_amdgcn_update_dpp(0, __builtin_bit_cast(int, a), 0x124, 0xf, 0xf, false));
    a += __builtin_bit_cast(float, __builtin_amdgcn_update_dpp(0, __builtin_bit_cast(int, a), 0x122, 0xf, 0xf, false));
    a += __builtin_bit_cast(float, __builtin_amdgcn_update_dpp(0, __builtin_bit_cast(int, a), 0x121, 0xf, 0xf, false));
    return a;
}
__device__ __forceinline__ int q_pull(unsigned* q, int lane) { int v = 0; if (lane == 0) v = (int)__hip_atomic_fetch_add(q, 1u, __ATOMIC_RELAXED, __HIP_MEMORY_SCOPE_AGENT); return __builtin_amdgcn_readfirstlane(v); }
constexpr int PEER_TG = 8;
__device__ __forceinline__ void peer_a_token(int t, int s, const bf16* h1b, const int* experts, const unsigned char* u8s, float* pa, int lane_) {
    int lane = lane_; asm volatile("" : "+v"(lane));
    const int g = lane >> 4, c = lane & 15;
    const int id0 = experts[(size_t)t * 128 + lane], id1 = experts[(size_t)t * 128 + 64 + lane];
    const GAS v4u* xp = (const GAS v4u*)(h1b + (size_t)t * D + 256 * s + 16 * c);
    const v4u x0 = xp[0], x1 = xp[1];
    const unsigned char* ub = u8s + (size_t)s * SLICE_BYTES + 16 * c;
    float res[32];
#pragma unroll
    for (int hb = 0; hb < 2; ++hb) {
        v4u ur[16];
#pragma unroll
        for (int i = 0; i < 16; ++i) { const int id = __shfl(hb ? id1 : id0, 4 * i + g); ur[i] = *(const GAS v4u*)(ub + (size_t)id * 256); }
#pragma unroll
        for (int i = 0; i < 16; ++i) { float a = 0.f, b = 0.f;
            a = dot4f8(ur[i].x, x0.x, x0.y, a); b = dot4f8(ur[i].y, x0.z, x0.w, b); a = dot4f8(ur[i].z, x1.x, x1.y, a); b = dot4f8(ur[i].w, x1.z, x1.w, b);
            res[16 * hb + i] = row16_allsum(a + b); }
    }
    if (c == 15) { GAS f32x4* dst = (GAS f32x4*)(pa + ((size_t)t * 8 + s) * 128 + g * 32);
#pragma unroll
        for (int q = 0; q < 8; ++q) dst[q] = (f32x4){res[4 * q], res[4 * q + 1], res[4 * q + 2], res[4 * q + 3]}; }
}
__device__ __forceinline__ void peer_b_token(int t, int s, const float* h1, const int* experts, const float* gates, const unsigned char* v8s, const float* su, const float* sv,
                                             const float* pa, float* out, float* st, int lane_) {
    int lane = lane_; asm volatile("" : "+v"(lane));
    const int g = lane >> 4, c = lane & 15;
    int id[2]; float w[2];
#pragma unroll
    for (int h = 0; h < 2; ++h) { const int k = lane + 64 * h, pos = (k & 3) * 32 + (k >> 2);
        id[h] = experts[(size_t)t * 128 + k];
        float a = 0.f;
#pragma unroll
        for (int s2 = 0; s2 < 8; ++s2) a += pa[((size_t)t * 8 + s2) * 128 + pos];
        w[h] = gates[(size_t)t * 128 + k] * gelu_erf(a * su[id[h]]) * sv[id[h]]; }
    const unsigned char* vb = v8s + (size_t)s * SLICE_BYTES + 16 * c;
    float ya[16];
#pragma unroll
    for (int e = 0; e < 16; ++e) ya[e] = 0.f;
#pragma unroll
    for (int hb = 0; hb < 4; ++hb) {
        v4u vr[8];
#pragma unroll
        for (int i = 0; i < 8; ++i) { const int e = __shfl(id[hb >> 1], 4 * (i + 8 * (hb & 1)) + g); vr[i] = *(const GAS v4u*)(vb + (size_t)e * 256); }
#pragma unroll
        for (int i = 0; i < 8; ++i) { const float wk = __shfl(w[hb >> 1], 4 * (i + 8 * (hb & 1)) + g);
            axpy4f8(&ya[0], vr[i].x, wk); axpy4f8(&ya[4], vr[i].y, wk); axpy4f8(&ya[8], vr[i].z, wk); axpy4f8(&ya[12], vr[i].w, wk); }
    }
#pragma unroll
    for (int e = 0; e < 16; ++e) { ya[e] += __shfl_xor(ya[e], 16); ya[e] += __shfl_xor(ya[e], 32); }
    const GAS f32x4* hp = (const GAS f32x4*)(h1 + (size_t)t * D + 256 * s + 16 * c);
    float sm = 0.f, sq = 0.f; f32x4 r[4];
#pragma unroll
    for (int q = 0; q < 4; ++q) { const f32x4 hx = hp[q]; r[q] = hx * ALPHA + (f32x4){ya[4 * q], ya[4 * q + 1], ya[4 * q + 2], ya[4 * q + 3]};
        sm += (r[q].x + r[q].y) + (r[q].z + r[q].w); sq += (r[q].x * r[q].x + r[q].y * r[q].y) + (r[q].z * r[q].z + r[q].w * r[q].w); }
    sm = row16_allsum(sm); sq = row16_allsum(sq);
    if (g == 0) { GAS f32x4* op = (GAS f32x4*)(out + (size_t)t * D + 256 * s + 16 * c);
#pragma unroll
        for (int q = 0; q < 4; ++q) op[q] = r[q];
        if (c == 0) { st[((size_t)t * 8 + s) * 2] = sm; st[((size_t)t * 8 + s) * 2 + 1] = sq; } }
}
__device__ __forceinline__ void peer_c_row(int t, float* out, const float* st, const float* g2, const float* b2, int lane) {
    float sm = 0.f, sq = 0.f;
#pragma unroll
    for (int s = 0; s < 8; ++s) { sm += st[((size_t)t * 8 + s) * 2]; sq += st[((size_t)t * 8 + s) * 2 + 1]; }
    const float mean = sm * (1.f / D), var = sq * (1.f / D) - mean * mean, rstd = 1.f / sqrtf(fmaxf(var, 0.f) + LN_EPS);
    GAS f32x4* xr = (GAS f32x4*)(out + (size_t)t * D) + lane;
#pragma unroll
    for (int j = 0; j < 8; ++j) { const f32x4 v = xr[64 * j]; const f32x4 gg = *((const GAS f32x4*)g2 + lane + 64 * j), bb = *((const GAS f32x4*)b2 + lane + 64 * j);
        xr[64 * j] = (v - mean) * rstd * gg + bb; }
}

struct Args { const float* in[16]; float* out; unsigned char* ws; int ph_lo, ph_hi; };
__global__ void __launch_bounds__(NTHREADS, 2) mk_fwd(Args args) {
    extern __shared__ __attribute__((aligned(16))) unsigned char lds_raw[];
    LAS unsigned char* lds = (LAS unsigned char*)lds_raw;
    volatile LAS unsigned* MISC = (volatile LAS unsigned*)(lds + MISC_OFF);
    const int tid0 = threadIdx.x;
    const int G = gridDim.x, bx = blockIdx.x;
    unsigned char* ws = args.ws;
    gu32* ctl = (gu32*)(ws + WS_CTL);
#define IN_(i) (args.in[i])
#define x_in IN_(0)
#define w_in IN_(1)
#define b_gate IN_(2)
#define sinks IN_(3)
#define conv_w IN_(4)
#define w_ao IN_(5)
#define w_co IN_(6)
#define w_o IN_(7)
#define ln1_g IN_(8)
#define ln1_b IN_(9)
#define w_q IN_(10)
#define sub_keys IN_(11)
#define peer_u IN_(12)
#define peer_v IN_(13)
#define ln2_g IN_(14)
#define ln2_b IN_(15)
#define WinT ((bf16*)(ws + WS_WIN))
#define WaT ((bf16*)(ws + WS_WA))
#define WcT ((bf16*)(ws + WS_WC))
#define WoT ((bf16*)(ws + WS_WO))
#define WfT ((bf16*)(ws + WS_WF))
#define XB ((bf16*)(ws + WS_XB))
#define MERGED ((bf16*)(ws + WS_MERGED))
#define Z ((bf16*)(ws + WS_Z))
#define H1 ((float*)(ws + WS_H1))
#define H1B ((bf16*)(ws + WS_H1B))
#define SC ((float*)(ws + WS_SC))
#define EX ((int*)(ws + WS_EX))
#define GT ((float*)(ws + WS_GT))
#define AO ((bf16*)(ws + WS_AO))
#define CI ((bf16*)(ws + WS_CI))
#define TMP ((bf16*)(ws + WS_TMP))
#define U8 ((unsigned char*)(ws + WS_U8))
#define V8 ((unsigned char*)(ws + WS_V8))
#define SU ((float*)(ws + WS_SU))
#define SV ((float*)(ws + WS_SV))
#define PA ((float*)(ws + WS_PA))
#define ST ((float*)(ws + WS_ST))
    for (int u = tid0; u < (LDS_BYTES - LDSCTL_OFF) / 4; u += NTHREADS) ((LAS unsigned*)(lds + LDSCTL_OFF))[u] = 0u;
    __syncthreads();
    XcdBarrier bar; bar.bar = (unsigned*)(ctl + CW_BAR); bar.x = 0; bar.st = nullptr;
    if (!MK_PER_PHASE) bar = xcd_barrier_post((unsigned*)(ctl + CW_BAR), MISC + 8);
    const int lo = args.ph_lo, hi = args.ph_hi;
#ifndef PH_MASK
#define PH_MASK 0x7FF
#endif
#define IN(k) (((PH_MASK >> (k)) & 1) && lo <= (k) && (k) < hi)
#define SEAM(k) do { if (IN(k) && IN((k) + 1)) xcd_barrier(bar); } while (0)
#ifndef DBL_MASK
#define DBL_MASK 0
#endif
#define REP(k) for (int rep_ = 0; rep_ < 1 + ((DBL_MASK >> (k)) & 1); ++rep_)
#define PHASE_TID() int tid = tid0; asm volatile("" : "+v"(tid)); const int lane = tid & 63, wave = __builtin_amdgcn_readfirstlane(tid >> 6); (void)lane; (void)wave

    if (IN(0)) REP(0) {
        PHASE_TID();
        for (int it = bx; it < 16 * 32; it += G) p0_wf_item(w_q, sub_keys, WfT, lds, it, tid);
        LAS float* scr = (LAS float*)(lds + wave * 16384);
        const int gw = bx * NWAVES + wave, NGW = G * NWAVES;
        constexpr int I_IN = (D / 64) * (IN_W / 32), I_SQ = (D / 64) * (D / 32);
        for (int it = gw; it < I_IN + 3 * I_SQ; it += NGW) {
            int r = it;
            if (r < I_IN) { p0_transpose_item(w_in, D, IN_W, WinT, scr, r, lane); continue; } r -= I_IN;
            if (r < I_SQ) { p0_transpose_item(w_ao, D, D, WaT, scr, r, lane); continue; } r -= I_SQ;
            if (r < I_SQ) { p0_transpose_item(w_co, D, D, WcT, scr, r, lane); continue; } r -= I_SQ;
            p0_transpose_item(w_o, D, D, WoT, scr, r, lane);
        }
        const size_t n8 = (size_t)M * D / 8;
        for (size_t i = (size_t)bx * NTHREADS + tid; i < n8; i += (size_t)G * NTHREADS) {
            const f32x4 a = *((const GAS f32x4*)x_in + 2 * i), b = *((const GAS f32x4*)x_in + 2 * i + 1);
            v4u o; o.x = pk2(a.x, a.y); o.y = pk2(a.z, a.w); o.z = pk2(b.x, b.y); o.w = pk2(b.z, b.w);
            *((GAS v4u*)XB + i) = o;
        }
    }
    SEAM(0);
    if (IN(1)) REP(1) {
        pg8::Gemm g{XB, WinT, M, IN_W, D}; pg8::StaticOrder S; S.init(M, IN_W, G, bx);
        pg8::EpiBf16 E{Z, IN_W};
        pg8::gemm_phase<pg8::EpiBf16, pg8::StaticOrder, true, true>(lds, g, S, E);
    }
    SEAM(1);
    if (IN(2)) REP(2) {
        PHASE_TID();
        for (int u = bx; u < BATCH * NKVH * 16; u += G) attn_unit(u, Z, AO, sinks, lds, tid);
        for (int it = bx; it < M / 32; it += G) conv_item(it, Z, conv_w, CI, tid);
    }
    SEAM(2);
    if (IN(3)) REP(3) {
        pg8::StaticOrder S; S.init(M, D, G, bx);
        { pg8::Gemm g{AO, WaT, M, D, D}; pg8::EpiGate<0> E{TMP, nullptr, Z + G_OFF, b_gate, D, IN_W};
          pg8::gemm_phase<pg8::EpiGate<0>, pg8::StaticOrder, true, true>(lds, g, S, E); }
        { pg8::Gemm g{CI, WcT, M, D, D}; pg8::EpiGate<1> E{MERGED, TMP, Z + G_OFF + D, b_gate + D, D, IN_W};
          pg8::gemm_phase<pg8::EpiGate<1>, pg8::StaticOrder, true, true>(lds, g, S, E); }
    }
    SEAM(3);
    if (IN(4)) REP(4) {
        pg8::Gemm g{MERGED, WoT, M, D, D}; pg8::StaticOrder S; S.init(M, D, G, bx);
        pg8::EpiF32 E{H1, D, x_in, ALPHA};
        pg8::gemm_phase<pg8::EpiF32, pg8::StaticOrder, true, true>(lds, g, S, E);
    }
    SEAM(4);
    if (IN(5)) REP(5) {
        PHASE_TID();
        const int gw = bx * NWAVES + wave, NGW = G * NWAVES;
        for (int m = gw; m < M; m += NGW) ln1_row(H1 + (size_t)m * D, H1B + (size_t)m * D, ln1_g, ln1_b, lane);
#ifndef DBL_CONV
#define DBL_CONV 0
#endif
        for (int rep2 = 0; rep2 <= DBL_CONV; ++rep2)
        for (int r = gw; r < 2 * PNE; r += NGW) {
            const bool sec = r >= PNE; const int e = sec ? r - PNE : r;
            row_to_fp8((sec ? peer_v : peer_u) + (size_t)e * D, (sec ? V8 : U8) + (size_t)e * 256, (sec ? SV : SU) + e, lane);
        }
    }
    SEAM(5);
    if (IN(6)) REP(6) {
        pg8::Gemm g{H1B, WfT, M, D, D}; pg8::StaticOrder S; S.init(M, D, G, bx);
        pg8::EpiF32 E{SC, D, nullptr, 0.f};
        pg8::gemm_phase<pg8::EpiF32, pg8::StaticOrder, true, true>(lds, g, S, E);
    }
    SEAM(6);
    if (IN(7)) REP(7) {
        PHASE_TID();
        for (int p = bx; p < (M * PH) / 128; p += G) topk_pass(p, SC, EX, GT, lds, tid);
    }
    SEAM(7);
    if (IN(8)) REP(8) {
        PHASE_TID();
        const int xcc = (int)(xb_xcc_id() & 7u);
#pragma unroll 1
        for (int sl = 0; sl < 8; ++sl) { const int s = (xcc + sl) & 7;
            for (;;) { const int tg = q_pull((unsigned*)(ctl + CW_Q + 64 * s), lane); if (tg >= M / PEER_TG) break;
#pragma unroll 1
                for (int tt = 0; tt < PEER_TG; ++tt) peer_a_token(tg * PEER_TG + tt, s, H1B, EX, U8, PA, lane); } }
    }
    SEAM(8);
    if (IN(9)) REP(9) {
        PHASE_TID();
        const int xcc = (int)(xb_xcc_id() & 7u);
#pragma unroll 1
        for (int sl = 0; sl < 8; ++sl) { const int s = (xcc + sl) & 7;
            for (;;) { const int tg = q_pull((unsigned*)(ctl + CW_Q + 64 * (8 + s)), lane); if (tg >= M / PEER_TG) break;
#pragma unroll 1
                for (int tt = 0; tt < PEER_TG; ++tt) peer_b_token(tg * PEER_TG + tt, s, H1, EX, GT, V8, SU, SV, PA, args.out, ST, lane); } }
    }
    SEAM(9);
    if (IN(10)) REP(10) {
        PHASE_TID();
        const int gw = bx * NWAVES + wave, NGW = G * NWAVES;
        for (int t = gw; t < M; t += NGW) peer_c_row(t, args.out, ST, ln2_g, ln2_b, lane);
    }
#undef IN
#undef SEAM
}

extern "C" void kernel_launch(void* const* d_in, const int* in_sizes, int n_in, void* d_out, int out_size, void* d_ws, size_t ws_size, hipStream_t stream) {
    static int grid = 0;
    if (grid == 0) {
        if (n_in != 16 || out_size != M * D || ws_size < WS_END) { fprintf(stderr, "kernel_launch: unexpected shapes (n_in %d out %d ws %zu)\n", n_in, out_size, ws_size); grid = -1; return; }
        int dev = 0, cus = 0, per_cu = 0;
        if (hipGetDevice(&dev) != hipSuccess || hipDeviceGetAttribute(&cus, hipDeviceAttributeMultiprocessorCount, dev) != hipSuccess) { grid = -1; return; }
        if (hipFuncSetAttribute((const void*)mk_fwd, hipFuncAttributeMaxDynamicSharedMemorySize, LDS_BYTES) != hipSuccess) { fprintf(stderr, "kernel_launch: hipFuncSetAttribute failed\n"); grid = -1; return; }
        if (hipOccupancyMaxActiveBlocksPerMultiprocessor(&per_cu, (const void*)mk_fwd, NTHREADS, LDS_BYTES) != hipSuccess || per_cu < 1) { fprintf(stderr, "kernel_launch: occupancy query says %d\n", per_cu); per_cu = 1; }
        (void)hipGetLastError();
        if (per_cu > 1) per_cu = 1;
        grid = cus * per_cu;
    }
    if (grid < 0) return;
    if (hipMemsetAsync((char*)d_ws + WS_CTL, 0, CTL_ZERO_BYTES, stream) != hipSuccess) { fprintf(stderr, "kernel_launch: memset failed\n"); return; }
    Args a{};
    for (int i = 0; i < 16; ++i) a.in[i] = (const float*)d_in[i];
    a.out = (float*)d_out; a.ws = (unsigned char*)d_ws;
#if MK_PER_PHASE
    for (int p = 0; p < N_PHASES; ++p) { a.ph_lo = p; a.ph_hi = p + 1; hipLaunchKernelGGL(mk_fwd, dim3(grid), dim3(NTHREADS), LDS_BYTES, stream, a); }
#else
    a.ph_lo = 0; a.ph_hi = N_PHASES;
    void* kargs[] = {&a};
    hipError_t e = hipLaunchCooperativeKernel((const void*)mk_fwd, dim3(grid), dim3(NTHREADS), kargs, LDS_BYTES, stream);
    if (e != hipSuccess) fprintf(stderr, "kernel_launch: cooperative launch failed: %s (grid %d)\n", hipGetErrorString(e), grid);
#endif
}
```

```cpp
#include <hip/hip_runtime.h>
#include <cstdio>
#include <cstdint>
namespace pg8 {
#define PG8_LAS __attribute__((address_space(3)))
typedef unsigned short bf16_t;
typedef short bf16x8 __attribute__((ext_vector_type(8)));
typedef float f32x4 __attribute__((ext_vector_type(4)));
typedef unsigned u32x4 __attribute__((ext_vector_type(4)));
constexpr int BM = 256, BK = 64, HALF = 128, HTB = HALF * BK * 2  , STAGE_BYTES = 8 * HTB, NXCD = 8, WGM = 8;

__host__ __device__ __forceinline__ int lds_byte(int r, int c) { const int st = (r >> 4) * 2 + (c >> 5), rr = r & 15, cc = c & 31, ob = rr * 64 + cc * 2; return st * 1024 + (ob ^ (((ob >> 9) & 1) << 5)); }
__host__ __device__ __forceinline__ void stage_rc(int b, int& R, int& C) { const int st = b / 1024, sb = b % 1024, swz = sb ^ (((sb >> 9) & 1) << 5); R = (st >> 1) * 16 + swz / 64; C = (st & 1) * 32 + (swz % 64) / 2; }
__host__ __device__ __forceinline__ int perm32(int rho) { const int n = rho >> 4, i = rho & 15; return 8 * (i >> 2) + 4 * n + (i & 3); }

struct Unit { int pm, pn; };
struct Gemm { const bf16_t* A; const bf16_t* Bt; int M, N, K; };

struct StaticOrder {
    int nM, nN, nwg, G, c;
    __host__ __device__ void init(int M, int N, int G_, int c_) { nM = M / BM; nN = N / BM; nwg = nM * nN; G = G_; c = c_; }
    __host__ __device__ bool next(int i, Unit& u) const {
        const long L = (long)i * G + c; if (L >= nwg) return false;
        int wgid = (int)L; { const int q = nwg / NXCD, r = nwg % NXCD, xcd = wgid % NXCD, off = wgid / NXCD; wgid = (xcd < r ? xcd * (q + 1) : r * (q + 1) + (xcd - r) * q) + off; }
        const int nig = WGM * nN, gid = wgid / nig, fm = gid * WGM, gsz = (nM - fm) < WGM ? (nM - fm) : WGM;
        u.pm = fm + ((wgid % nig) % gsz); u.pn = (wgid % nig) / gsz; return true;
    }
    __device__ __forceinline__ void a_ready(const Unit&) const {}
    __device__ __forceinline__ void done(const Unit&) const {}
};


__device__ __forceinline__ unsigned cvt_pk_bf16(float lo, float hi) { unsigned r; asm volatile("v_cvt_pk_bf16_f32 %0, %1, %2" : "=v"(r) : "v"(lo), "v"(hi)); return r; }
__device__ __forceinline__ float bf_lo(unsigned w) { return __builtin_bit_cast(float, w << 16); }
__device__ __forceinline__ float bf_hi(unsigned w) { return __builtin_bit_cast(float, w & 0xffff0000u); }
__device__ __forceinline__ float sigmoidf_(float x) { return __builtin_amdgcn_rcpf(1.0f + __expf(-x)); }

struct EpiBf16 {
    static constexpr bool PERM = true, AFTER_DRAIN = false;
    bf16_t* O; int ldc;
    __device__ __forceinline__ void operator()(const f32x4 (&acc)[2][2][4][2], const Unit& u, int wr, int wc, int fr, int fq) const {
        const int row0 = u.pm * BM + wr * 64 + fr, col0 = u.pn * BM + wc * 32 + 8 * fq;
#pragma unroll
        for (int ai = 0; ai < 2; ++ai)
#pragma unroll
            for (int m = 0; m < 4; ++m) { bf16_t* rowp = O + (size_t)(row0 + ai * HALF + m * 16) * ldc + col0;
#pragma unroll
                for (int bj = 0; bj < 2; ++bj) { const f32x4 v0 = acc[ai][bj][m][0], v1 = acc[ai][bj][m][1];
                    u32x4 w; w.x = cvt_pk_bf16(v0[0], v0[1]); w.y = cvt_pk_bf16(v0[2], v0[3]); w.z = cvt_pk_bf16(v1[0], v1[1]); w.w = cvt_pk_bf16(v1[2], v1[3]);
                    *(u32x4*)(rowp + bj * HALF) = w; } }
    }
};
template <int SECOND> struct EpiGate {
    static constexpr bool PERM = true, AFTER_DRAIN = false;
    bf16_t* O; const bf16_t* T; const bf16_t* Zg; const float* bg; int ldc, ldz;
    __device__ __forceinline__ void operator()(const f32x4 (&acc)[2][2][4][2], const Unit& u, int wr, int wc, int fr, int fq) const {
        const int row0 = u.pm * BM + wr * 64 + fr, col0 = u.pn * BM + wc * 32 + 8 * fq;
        f32x4 bv[2][2];
#pragma unroll
        for (int bj = 0; bj < 2; ++bj)
#pragma unroll
            for (int n = 0; n < 2; ++n) bv[bj][n] = *(const f32x4*)(bg + col0 + bj * HALF + 4 * n);
#pragma unroll
        for (int ai = 0; ai < 2; ++ai)
#pragma unroll
            for (int m = 0; m < 4; ++m) { const size_t row = (size_t)(row0 + ai * HALF + m * 16);
#pragma unroll
                for (int bj = 0; bj < 2; ++bj) { const int c = col0 + bj * HALF;
                    const u32x4 zg = *(const u32x4*)(Zg + row * ldz + c);
                    f32x4 v0 = acc[ai][bj][m][0], v1 = acc[ai][bj][m][1];
                    v0[0] *= sigmoidf_(bf_lo(zg.x) + bv[bj][0][0]); v0[1] *= sigmoidf_(bf_hi(zg.x) + bv[bj][0][1]);
                    v0[2] *= sigmoidf_(bf_lo(zg.y) + bv[bj][0][2]); v0[3] *= sigmoidf_(bf_hi(zg.y) + bv[bj][0][3]);
                    v1[0] *= sigmoidf_(bf_lo(zg.z) + bv[bj][1][0]); v1[1] *= sigmoidf_(bf_hi(zg.z) + bv[bj][1][1]);
                    v1[2] *= sigmoidf_(bf_lo(zg.w) + bv[bj][1][2]); v1[3] *= sigmoidf_(bf_hi(zg.w) + bv[bj][1][3]);
                    if (SECOND) { const u32x4 t = *(const u32x4*)(T + row * ldc + c);
                        v0[0] += bf_lo(t.x); v0[1] += bf_hi(t.x); v0[2] += bf_lo(t.y); v0[3] += bf_hi(t.y);
                        v1[0] += bf_lo(t.z); v1[1] += bf_hi(t.z); v1[2] += bf_lo(t.w); v1[3] += bf_hi(t.w); }
                    u32x4 w; w.x = cvt_pk_bf16(v0[0], v0[1]); w.y = cvt_pk_bf16(v0[2], v0[3]); w.z = cvt_pk_bf16(v1[0], v1[1]); w.w = cvt_pk_bf16(v1[2], v1[3]);
                    *(u32x4*)(O + row * ldc + c) = w; } }
    }
};
struct EpiF32 {
    static constexpr bool PERM = false, AFTER_DRAIN = false;
    float* C; int ldc; const float* R; float scale;
    __device__ __forceinline__ void operator()(const f32x4 (&acc)[2][2][4][2], const Unit& u, int wr, int wc, int fr, int fq) const {
        const int row0 = u.pm * BM + wr * 64 + fr, col0 = u.pn * BM + wc * 32 + 4 * fq;
#pragma unroll
        for (int ai = 0; ai < 2; ++ai)
#pragma unroll
            for (int m = 0; m < 4; ++m) { const size_t off = (size_t)(row0 + ai * HALF + m * 16) * ldc + col0;
#pragma unroll
                for (int bj = 0; bj < 2; ++bj)
#pragma unroll
                    for (int n = 0; n < 2; ++n) { f32x4 v = acc[ai][bj][m][n];
                        if (R) v += *(const f32x4*)(R + off + bj * HALF + n * 16) * scale;
                        *(f32x4*)(C + off + bj * HALF + n * 16) = v; } }
    }
};

template <class Epi, class Sched, bool ALIGN_EPI = false, bool SP2 = false>
__device__ __forceinline__ void gemm_phase(PG8_LAS unsigned char* lds, const Gemm g, const Sched& S, const Epi& E) {
    int tid_ = threadIdx.x; asm volatile("" : "+v"(tid_));
    const int tid = tid_, wid = __builtin_amdgcn_readfirstlane(tid >> 6), lane = tid & 63, wr = wid >> 2, wc = wid & 3, fr = lane & 15, fq = lane >> 4;
    const int K = g.K, nt = K / BK;
    unsigned voffA[2], voffB[2];
#pragma unroll
    for (int i = 0; i < 2; ++i) { int R, C; stage_rc(tid * 16 + i * 8192, R, C); const int Rb = Epi::PERM ? ((R & ~31) + perm32(R & 31)) : R;
        voffA[i] = (unsigned)(R * K + C) * 2u; voffB[i] = (unsigned)(Rb * K + C) * 2u; }
    const size_t kstep = (size_t)(BK * 2);
    const size_t hstep = (size_t)HALF * K * 2;
    const size_t tstep = 2 * hstep;
    const unsigned ldsw = (unsigned)wid * 1024u;
    const int aoff = lds_byte(wr * 64 + fr, fq * 8), boff = lds_byte(wc * 32 + fr, fq * 8);
#define PG8_SA(b, h) (((b) * 2 + (h)) * HTB)
#define PG8_SB(b, h) ((4 + (b) * 2 + (h)) * HTB)
#define PG8_STAGE(bufoff, gbase, voff) do { _Pragma("unroll") for (int _i = 0; _i < 2; ++_i) \
        __builtin_amdgcn_global_load_lds((const unsigned*)((const char*)(gbase) + (voff)[_i]), (PG8_LAS unsigned*)(lds + (bufoff) + ldsw + _i * 8192), 16, 0, 0); } while (0)
#define PG8_LDA(dst, b, h) do { _Pragma("unroll") for (int m = 0; m < 4; ++m) _Pragma("unroll") for (int k = 0; k < 2; ++k) dst[m][k] = *(const PG8_LAS bf16x8*)(lds + PG8_SA(b, h) + aoff + m * 2048 + k * 1024); } while (0)
#define PG8_LDB(dst, b, h) do { _Pragma("unroll") for (int n = 0; n < 2; ++n) _Pragma("unroll") for (int k = 0; k < 2; ++k) dst[n][k] = *(const PG8_LAS bf16x8*)(lds + PG8_SB(b, h) + boff + n * 2048 + k * 1024); } while (0)
#define PG8_MMA(ai, bj, At, Bt) do { __builtin_amdgcn_s_setprio(1); _Pragma("unroll") for (int m = 0; m < 4; ++m) _Pragma("unroll") for (int n = 0; n < 2; ++n) _Pragma("unroll") for (int k = 0; k < 2; ++k) \
        acc[ai][bj][m][n] = __builtin_amdgcn_mfma_f32_16x16x32_bf16(Bt[n][k], At[m][k], acc[ai][bj][m][n], 0, 0, 0); __builtin_amdgcn_s_setprio(0); } while (0)
#define PG8_WAIT_V(n) asm volatile("s_waitcnt vmcnt(" #n ")" ::: "memory")
#define PG8_WAIT_L(n) asm volatile("s_waitcnt lgkmcnt(" #n ")" ::: "memory")
#define PG8_BAR __builtin_amdgcn_s_barrier()
#define PG8_SCHED __builtin_amdgcn_sched_barrier(0)
    Unit cur, nxt; int ui = 0;
    if (!S.next(0, cur)) return;
    f32x4 acc[2][2][4][2];
#pragma unroll
    for (int a = 0; a < 2; ++a)
#pragma unroll
        for (int b = 0; b < 2; ++b)
#pragma unroll
            for (int m = 0; m < 4; ++m)
#pragma unroll
                for (int n = 0; n < 2; ++n) acc[a][b][m][n] = (f32x4){0.f, 0.f, 0.f, 0.f};
    bf16x8 At[4][2], B0[2][2], B1[2][2];
    const char* cA = (const char*)g.A + (size_t)cur.pm * tstep; const char* cB = (const char*)g.Bt + (size_t)cur.pn * tstep;
    S.a_ready(cur);
    if constexpr (SP2) {
        PG8_STAGE(PG8_SB(0, 0), cB, voffB); PG8_STAGE(PG8_SB(0, 1), cB + hstep, voffB); PG8_STAGE(PG8_SA(0, 0), cA, voffA); PG8_STAGE(PG8_SA(0, 1), cA + hstep, voffA);
        if (wr == 1) PG8_BAR;
        PG8_WAIT_V(2); PG8_BAR;
        PG8_STAGE(PG8_SB(1, 0), cB + kstep, voffB); PG8_STAGE(PG8_SA(1, 0), cA + kstep, voffA); PG8_STAGE(PG8_SB(1, 1), cB + hstep + kstep, voffB);
        PG8_WAIT_V(6); PG8_BAR;
    } else {
        PG8_STAGE(PG8_SB(0, 0), cB, voffB); PG8_STAGE(PG8_SA(0, 0), cA, voffA); PG8_STAGE(PG8_SB(0, 1), cB + hstep, voffB); PG8_STAGE(PG8_SA(0, 1), cA + hstep, voffA);
        if (wr == 1) PG8_BAR;
        PG8_WAIT_V(4); PG8_BAR;
        PG8_STAGE(PG8_SB(1, 0), cB + kstep, voffB); PG8_STAGE(PG8_SA(1, 0), cA + kstep, voffA); PG8_STAGE(PG8_SB(1, 1), cB + hstep + kstep, voffB);
        PG8_WAIT_V(6); PG8_BAR;
    }
    for (;;) {
        const bool has_next = S.next(ui + 1, nxt);
        const char* nA = has_next ? (const char*)g.A + (size_t)nxt.pm * tstep : cA; const char* nB = has_next ? (const char*)g.Bt + (size_t)nxt.pn * tstep : cB;
        for (int t = 0; t < nt; t += 2) {
            const bool last = (t == nt - 2);
            const char* a1 = cA + (size_t)(t + 1) * kstep;
            const char* a2 = last ? nA : cA + (size_t)(t + 2) * kstep; const char* b2 = last ? nB : cB + (size_t)(t + 2) * kstep;
            const char* a3 = a2 + kstep; const char* b3 = b2 + kstep;
            if (last && has_next) S.a_ready(nxt);
            if constexpr (SP2) {
            PG8_LDB(B0, 0, 0); PG8_LDB(B1, 0, 1); PG8_SCHED; PG8_LDA(At, 0, 0); PG8_STAGE(PG8_SA(1, 1), a1 + hstep, voffA);
            PG8_WAIT_V(8); PG8_WAIT_L(0); PG8_BAR; PG8_MMA(0, 0, At, B0); PG8_MMA(0, 1, At, B1); PG8_BAR; PG8_SCHED;
            PG8_LDA(At, 0, 1); PG8_STAGE(PG8_SB(0, 0), b2, voffB); PG8_STAGE(PG8_SB(0, 1), b2 + hstep, voffB); PG8_STAGE(PG8_SA(0, 0), a2, voffA);
            PG8_WAIT_V(8); PG8_WAIT_L(0); PG8_BAR; PG8_MMA(1, 0, At, B0); PG8_MMA(1, 1, At, B1); PG8_BAR; PG8_SCHED;
            PG8_LDB(B0, 1, 0); PG8_LDB(B1, 1, 1); PG8_SCHED; PG8_LDA(At, 1, 0); PG8_STAGE(PG8_SA(0, 1), a2 + hstep, voffA);
            PG8_WAIT_V(8); PG8_WAIT_L(0); PG8_BAR; PG8_MMA(0, 0, At, B0); PG8_MMA(0, 1, At, B1); PG8_BAR; PG8_SCHED;
            PG8_LDA(At, 1, 1); PG8_STAGE(PG8_SB(1, 0), b3, voffB); PG8_STAGE(PG8_SB(1, 1), b3 + hstep, voffB); PG8_STAGE(PG8_SA(1, 0), a3, voffA);
            PG8_WAIT_V(8); PG8_WAIT_L(0); PG8_BAR; PG8_MMA(1, 0, At, B0); PG8_MMA(1, 1, At, B1); PG8_BAR; PG8_SCHED;
            } else {
            PG8_LDB(B0, 0, 0); PG8_SCHED; PG8_LDA(At, 0, 0); PG8_STAGE(PG8_SA(1, 1), a1 + hstep, voffA);
            PG8_WAIT_L(8); PG8_BAR; PG8_WAIT_L(0); PG8_MMA(0, 0, At, B0); PG8_BAR; PG8_SCHED;
            PG8_LDB(B1, 0, 1); PG8_STAGE(PG8_SB(0, 0), b2, voffB);
            PG8_BAR; PG8_WAIT_L(0); PG8_MMA(0, 1, At, B1); PG8_BAR;
            PG8_LDA(At, 0, 1); PG8_STAGE(PG8_SA(0, 0), a2, voffA);
            PG8_BAR; PG8_WAIT_L(0); PG8_MMA(1, 0, At, B0); PG8_BAR; PG8_SCHED;
            PG8_STAGE(PG8_SB(0, 1), b2 + hstep, voffB);
            PG8_WAIT_V(6); PG8_BAR; PG8_MMA(1, 1, At, B1); PG8_BAR;
            PG8_LDB(B0, 1, 0); PG8_SCHED; PG8_LDA(At, 1, 0); PG8_STAGE(PG8_SA(0, 1), a2 + hstep, voffA);
            PG8_WAIT_L(8); PG8_BAR; PG8_WAIT_L(0); PG8_MMA(0, 0, At, B0); PG8_BAR; PG8_SCHED;
            PG8_LDB(B1, 1, 1); PG8_STAGE(PG8_SB(1, 0), b3, voffB);
            PG8_BAR; PG8_WAIT_L(0); PG8_MMA(0, 1, At, B1); PG8_BAR;
            PG8_LDA(At, 1, 1); PG8_STAGE(PG8_SA(1, 0), a3, voffA);
            PG8_BAR; PG8_WAIT_L(0); PG8_MMA(1, 0, At, B0); PG8_BAR; PG8_SCHED;
            PG8_STAGE(PG8_SB(1, 1), b3 + hstep, voffB);
            PG8_WAIT_V(6); PG8_BAR; PG8_MMA(1, 1, At, B1); PG8_BAR;
            }
        }
        if constexpr (ALIGN_EPI) { if (wr == 0) PG8_BAR; }
        if constexpr (!Epi::AFTER_DRAIN) { E(acc, cur, wr, wc, fr, fq); S.done(cur); }
        if (!has_next) break;
#pragma unroll
        for (int a = 0; a < 2; ++a)
#pragma unroll
            for (int b = 0; b < 2; ++b)
#pragma unroll
                for (int m = 0; m < 4; ++m)
#pragma unroll
                    for (int n = 0; n < 2; ++n) acc[a][b][m][n] = (f32x4){0.f, 0.f, 0.f, 0.f};
        cur = nxt; cA = nA; cB = nB; ++ui;
        if constexpr (ALIGN_EPI) { if (wr == 1) PG8_BAR; }
    }
    PG8_WAIT_V(0);
    if constexpr (!ALIGN_EPI) { if (wr == 0) PG8_BAR; }
    PG8_BAR;
    if constexpr (Epi::AFTER_DRAIN) { E.fused(acc, cur, wr, wc, fr, fq, lds, wid, lane); S.done(cur); }
#undef PG8_SA
#undef PG8_SB
#undef PG8_STAGE
#undef PG8_LDA
#undef PG8_LDB
#undef PG8_MMA
#undef PG8_WAIT_V
#undef PG8_WAIT_L
#undef PG8_BAR
#undef PG8_SCHED
}
}
#define GAS __attribute__((address_space(1)))
#define LAS __attribute__((address_space(3)))
typedef unsigned short bf16;
typedef unsigned v4u __attribute__((ext_vector_type(4)));
typedef float f32x4 __attribute__((ext_vector_type(4)));
typedef short bf16x8 __attribute__((ext_vector_type(8)));
typedef GAS unsigned gu32;
typedef GAS unsigned long long gu64;
#define RLX_AGENT __ATOMIC_RELAXED, __HIP_MEMORY_SCOPE_AGENT
#define LDS_WAIT() asm volatile("s_waitcnt lgkmcnt(0)" ::: "memory")
#define VM_WAIT() asm volatile("s_waitcnt vmcnt(0)" ::: "memory")
__device__ __forceinline__ unsigned long long rt() { return __builtin_amdgcn_s_memrealtime(); }
__device__ __forceinline__ unsigned f2bf(float f) { unsigned u = __builtin_bit_cast(unsigned, f); return (u + 0x7fffu + ((u >> 16) & 1u)) >> 16; }
__device__ __forceinline__ unsigned pk2(float lo, float hi) { return f2bf(lo) | (f2bf(hi) << 16); }

#define XB_TMO      128
#define XB_XCNT(j)  (256  + 64 * (j))
#define XB_XSUB(j)  (1280 + 64 * (j))
#define XB_XGEN(j)  (2304 + 64 * (j))
#define XB_TOP      3328
#define XB_TOPGEN   3392
#define XCD_BAR_WORDS 3456
#define XB_SPIN_CAP (1u << 18)

__device__ __forceinline__ unsigned xb_ld(unsigned* p)              { return __hip_atomic_load(p, __ATOMIC_RELAXED, __HIP_MEMORY_SCOPE_AGENT); }
__device__ __forceinline__ unsigned xb_add(unsigned* p, unsigned v) { return __hip_atomic_fetch_add(p, v, __ATOMIC_RELAXED, __HIP_MEMORY_SCOPE_AGENT); }
__device__ __forceinline__ unsigned xb_xcc_id() { return (unsigned)__builtin_amdgcn_s_getreg((3 << 11) | 20) & 0xFu; }
#define XB_SPIN(cond, bar) do { unsigned _sp = 0; while (cond) { __builtin_amdgcn_s_sleep(1); \
    if ((++_sp & 255u) == 0u) { if (xb_ld(&(bar)[XB_TMO])) break; if (_sp > XB_SPIN_CAP) { atomicAdd(&(bar)[XB_TMO], 1u); break; } } } } while (0)

struct XcdBarrier {
    unsigned* bar; unsigned x;
    volatile LAS unsigned* st;
};

__device__ __forceinline__ XcdBarrier xcd_barrier_post(unsigned* bar, volatile LAS unsigned* st) {
    XcdBarrier b; b.bar = bar; b.x = xb_xcc_id(); b.st = st;
    if (threadIdx.x == 0) (void)xb_add(&bar[XB_XCNT(b.x)], 1u);
    return b;
}
__device__ __forceinline__ void xcd_barrier_complete(unsigned* bar, unsigned x, unsigned& nloc, unsigned& nx) {
    const unsigned G = gridDim.x * gridDim.y * gridDim.z;
    unsigned sum, cnt, mine, sp = 0u;
    for (;;) {
        sum = 0u; cnt = 0u; mine = 0u;
#pragma unroll
        for (unsigned j = 0; j < 16; ++j) { const unsigned c = xb_ld(&bar[XB_XCNT(j)]); sum += c; cnt += (c > 0u) ? 1u : 0u; mine = (j == x) ? c : mine; }
        if (sum == G) break;
        __builtin_amdgcn_s_sleep(1);
        if ((++sp & 255u) == 0u) { if (xb_ld(&bar[XB_TMO])) break; if (sp > XB_SPIN_CAP) { atomicAdd(&bar[XB_TMO], 1u); break; } }
    }
    nloc = mine > 0u ? mine : 1u; nx = cnt > 0u ? cnt : 1u;
}

__device__ __forceinline__ void xcd_barrier(const XcdBarrier& b) {
    asm volatile("s_waitcnt vmcnt(0)" ::: "memory");
    __syncthreads();
    if (threadIdx.x == 0) {
        unsigned* bar = b.bar;
        __builtin_amdgcn_s_waitcnt(0);
        unsigned nloc = b.st[0], nx = b.st[1];
        if (nloc == 0u) { xcd_barrier_complete(bar, b.x, nloc, nx); b.st[0] = nloc; b.st[1] = nx; }
        const unsigned old = xb_add(&bar[XB_XSUB(b.x)], 1u);
        const unsigned gen = old / nloc;
        if (old + 1u == (gen + 1u) * nloc) {
            __builtin_amdgcn_fence(__ATOMIC_RELEASE, "agent");
            asm volatile("s_waitcnt vmcnt(0)" ::: "memory");
            const unsigned og = xb_add(&bar[XB_TOP], 1u);
            const unsigned tg = og / nx;
            if (og + 1u == (tg + 1u) * nx) xb_add(&bar[XB_TOPGEN], 1u);
            else XB_SPIN(xb_ld(&bar[XB_TOPGEN]) == tg, bar);
            __builtin_amdgcn_fence(__ATOMIC_ACQUIRE, "agent");
            xb_add(&bar[XB_XGEN(b.x)], 1u);
            asm volatile("s_waitcnt vmcnt(0)" ::: "memory");
        } else {
            XB_SPIN(xb_ld(&bar[XB_XGEN(b.x)]) == gen, bar);
            __builtin_amdgcn_fence(__ATOMIC_ACQUIRE, "agent");
            asm volatile("s_waitcnt vmcnt(0)" ::: "memory");
        }
    }
    __syncthreads();
}

constexpr int NWAVES = 8, NTHREADS = 512;
constexpr int BATCH = 4, SEQ = 2048, D = 2048, M = BATCH * SEQ;
constexpr int NQH = 32, NKVH = 4, HD = 64, QPKV = 8, WINDOW = 128;
constexpr int Q_OFF = 0, K_OFF = 2048, V_OFF = 2304, CB_OFF = 2560, CC_OFF = 4608, CH_OFF = 6656, G_OFF = 8704, IN_W = 12800;
constexpr int PH = 8, PNK = 128, PTOPK = 16, PNE = 16384;
constexpr float LN_EPS = 1e-5f;
constexpr float ALPHA = 1.189207115002721f;

#ifndef MK_PER_PHASE
#define MK_PER_PHASE 0
#endif
constexpr int N_PHASES = 12;

constexpr size_t MiB = 1u << 20;
constexpr size_t WS_CTL = 0, CTL_ZERO_BYTES = 1 * MiB;
constexpr size_t WS_WIN = 1 * MiB;
constexpr size_t WS_WA = 51 * MiB, WS_WC = 59 * MiB, WS_WO = 67 * MiB, WS_WF = 75 * MiB;
constexpr size_t WS_XB = 83 * MiB;
constexpr size_t WS_MERGED = WS_XB;
constexpr size_t WS_Z = 115 * MiB;
constexpr size_t WS_H1 = 115 * MiB;
constexpr size_t WS_H1B = 179 * MiB;
constexpr size_t WS_SC = 211 * MiB;
constexpr size_t WS_EX = 275 * MiB;
constexpr size_t WS_GT = 279 * MiB;
constexpr size_t WS_AO = 315 * MiB, WS_CI = 347 * MiB, WS_TMP = 379 * MiB;
constexpr size_t WS_U8 = 411 * MiB, WS_V8 = 443 * MiB;
constexpr size_t WS_SU = 475 * MiB, WS_SV = WS_SU + 65536;
constexpr size_t WS_PA = WS_SC;
constexpr size_t WS_WB = 380 * MiB;
constexpr size_t WS_ST = 379 * MiB;
constexpr size_t WS_END = 476 * MiB;
constexpr int CW_Q = 12288;
constexpr size_t SLICE_BYTES = (size_t)PNE * 256;
constexpr int CW_BAR = 4096;

constexpr int RING_BYTES = 131072;
constexpr int LDSCTL_OFF = 147456, MISC_OFF = LDSCTL_OFF + 320;
constexpr int LDS_BYTES = LDSCTL_OFF + 512;

typedef float f32x16 __attribute__((ext_vector_type(16)));
typedef unsigned v2u __attribute__((ext_vector_type(2)));
__device__ __forceinline__ float wave_sum(float v) {
#pragma unroll
    for (int o = 1; o < 64; o <<= 1) v += __shfl_xor(v, o);
    return v;
}
__device__ __forceinline__ float vmaxf(float a, float b) { float r; asm("v_max_f32_e32 %0, %1, %2" : "=v"(r) : "v"(a), "v"(b)); return r; }
__device__ __forceinline__ float vminf(float a, float b) { float r; asm("v_min_f32_e32 %0, %1, %2" : "=v"(r) : "v"(a), "v"(b)); return r; }

__device__ __forceinline__ void p0_transpose_item(const float* W, int K, int N, bf16* WT, LAS float* scr, int item, int lane) {
    const int nblk = N / 32, kb = item / nblk, nb = item % nblk, k0 = 64 * kb, n0 = 32 * nb;
#pragma unroll 8
    for (int i = 0; i < 32; ++i) { const int kk = 2 * i + (lane >> 5); scr[kk * 33 + (lane & 31)] = W[(size_t)(k0 + kk) * N + n0 + (lane & 31)]; }
    LDS_WAIT(); asm volatile("" ::: "memory");
    const int c = lane & 7;
#pragma unroll
    for (int j = 0; j < 4; ++j) { const int n = (lane >> 3) + 8 * j; const LAS float* s = scr + (8 * c) * 33 + n;
        v4u o; o.x = pk2(s[0 * 33], s[1 * 33]); o.y = pk2(s[2 * 33], s[3 * 33]); o.z = pk2(s[4 * 33], s[5 * 33]); o.w = pk2(s[6 * 33], s[7 * 33]);
        *(GAS v4u*)(WT + (size_t)(n0 + n) * K + k0 + 8 * c) = o; }
    LDS_WAIT(); asm volatile("" ::: "memory");
}
__device__ __forceinline__ void p0_wf_item(const float* wq, const float* sk, bf16* WfT, LAS unsigned char* lds, int item, int tid) {
    const int hp = item >> 5, dt = item & 31;
    LAS f32x4* SK4 = (LAS f32x4*)lds;
    LAS f32x4* WQ4 = SK4 + 128 * 33;
    const float* skp = sk + (size_t)hp * 128 * 128;
    for (int i = tid; i < 128 * 32; i += NTHREADS) { const int n = i >> 5, c4 = i & 31; SK4[n * 33 + c4] = *(const f32x4*)(skp + n * 128 + 4 * c4); }
    for (int i = tid; i < 64 * 32; i += NTHREADS) { const int r = i >> 5, c4 = i & 31; WQ4[r * 33 + c4] = *(const f32x4*)(wq + (size_t)(64 * dt + r) * 2048 + hp * 128 + 4 * c4); }
    __syncthreads();
    const int td = tid & 15, tn = tid >> 4;
    float acc[4][4];
#pragma unroll
    for (int i = 0; i < 4; ++i)
#pragma unroll
        for (int j = 0; j < 4; ++j) acc[i][j] = 0.f;
#pragma unroll 4
    for (int c4 = 0; c4 < 32; ++c4) {
        f32x4 a[4], b[4];
#pragma unroll
        for (int i = 0; i < 4; ++i) a[i] = SK4[(4 * tn + i) * 33 + c4];
#pragma unroll
        for (int j = 0; j < 4; ++j) b[j] = WQ4[(td + 16 * j) * 33 + c4];
#pragma unroll
        for (int i = 0; i < 4; ++i)
#pragma unroll
            for (int j = 0; j < 4; ++j) acc[i][j] += a[i].x * b[j].x + a[i].y * b[j].y + a[i].z * b[j].z + a[i].w * b[j].w;
    }
#pragma unroll
    for (int i = 0; i < 4; ++i)
#pragma unroll
        for (int j = 0; j < 4; ++j) WfT[(size_t)(hp * 128 + 4 * tn + i) * 2048 + 64 * dt + td + 16 * j] = (bf16)f2bf(acc[i][j]);
    __syncthreads();
}

__device__ __forceinline__ int perm16(int o) { return 8 * ((o >> 2) & 1) + 4 * (o >> 3) + (o & 3); }
__device__ __forceinline__ void attn_unit(int unit, const bf16* z, bf16* ao, const float* sinks, LAS unsigned char* lds, int tid) {
    const int lane = tid & 63, wid = __builtin_amdgcn_readfirstlane(tid >> 6), r32 = lane & 31, hi = lane >> 5;
    const int nb = unit & 15, kvh = (unit >> 4) & 3, b = unit >> 6;
    LAS bf16* Ks = (LAS bf16*)lds;
    LAS bf16* Vt = (LAS bf16*)(lds + 256 * 144);
    const size_t tok0 = (size_t)b * SEQ;
#pragma unroll
    for (int i = 0; i < 4; ++i) {
        const int ci = tid + NTHREADS * i, key = ci >> 3, dc = ci & 7;
        int kpos = 128 * (nb - 1) + key; if (kpos < 0) kpos = 0;
        const bf16* src = z + (tok0 + kpos) * IN_W + K_OFF + kvh * HD + dc * 8;
        const v4u kv = *(const GAS v4u*)src, vv = *(const GAS v4u*)(src + (V_OFF - K_OFF));
        *(LAS v4u*)(Ks + key * 72 + dc * 8) = kv;
        const int pos = (key & ~15) + perm16(key & 15);
        LAS bf16* vp = Vt + (dc * 8) * 264 + pos;
        vp[0 * 264] = (bf16)(vv.x & 0xffffu); vp[1 * 264] = (bf16)(vv.x >> 16); vp[2 * 264] = (bf16)(vv.y & 0xffffu); vp[3 * 264] = (bf16)(vv.y >> 16);
        vp[4 * 264] = (bf16)(vv.z & 0xffffu); vp[5 * 264] = (bf16)(vv.z >> 16); vp[6 * 264] = (bf16)(vv.w & 0xffffu); vp[7 * 264] = (bf16)(vv.w >> 16);
    }
    __syncthreads();
    const int hq = kvh * QPKV + wid;
    const float LOG2E = 1.4426950408889634f;
    const float sink2 = sinks[hq] * LOG2E, sc = 0.125f * LOG2E;
#pragma unroll 1
    for (int qg = 0; qg < 4; ++qg) {
        const size_t tok = tok0 + 128 * nb + 32 * qg + r32;
        bf16x8 qf[4];
#pragma unroll
        for (int ks = 0; ks < 4; ++ks) qf[ks] = *(const GAS bf16x8*)(z + tok * IN_W + Q_OFF + hq * HD + 16 * ks + 8 * hi);
        f32x16 s[5];
#pragma unroll
        for (int kt = 0; kt < 5; ++kt) {
            s[kt] = (f32x16){0.f, 0.f, 0.f, 0.f, 0.f, 0.f, 0.f, 0.f, 0.f, 0.f, 0.f, 0.f, 0.f, 0.f, 0.f, 0.f};
#pragma unroll
            for (int ks = 0; ks < 4; ++ks) {
                const bf16x8 kf = *(const LAS bf16x8*)(Ks + (32 * (qg + kt) + r32) * 72 + 16 * ks + 8 * hi);
                s[kt] = __builtin_amdgcn_mfma_f32_32x32x16_bf16(kf, qf[ks], s[kt], 0, 0, 0);
            }
        }
        float mx = sink2;
#pragma unroll
        for (int kt = 0; kt < 5; ++kt) {
            const bool tile_dead = (nb == 0) && (qg + kt < 4);
#pragma unroll
            for (int r = 0; r < 16; ++r) {
                const int krow = (r & 3) + 8 * (r >> 2) + 4 * hi;
                bool valid = !tile_dead;
                if (kt == 0) valid = valid && (krow > r32);
                if (kt == 4) valid = valid && (krow <= r32);
                const float v = valid ? s[kt][r] * sc : -INFINITY;
                s[kt][r] = v; mx = fmaxf(mx, v);
            }
        }
        mx = fmaxf(mx, __shfl_xor(mx, 32));
        float sum = 0.f;
#pragma unroll
        for (int kt = 0; kt < 5; ++kt)
#pragma unroll
            for (int r = 0; r < 16; ++r) { const float p = __builtin_amdgcn_exp2f(s[kt][r] - mx); s[kt][r] = p; sum += p; }
        sum += __shfl_xor(sum, 32);
        const float inv = 1.0f / (sum + __builtin_amdgcn_exp2f(sink2 - mx));
        f32x16 o[2];
        o[0] = (f32x16){0.f, 0.f, 0.f, 0.f, 0.f, 0.f, 0.f, 0.f, 0.f, 0.f, 0.f, 0.f, 0.f, 0.f, 0.f, 0.f}; o[1] = o[0];
#pragma unroll
        for (int kt = 0; kt < 5; ++kt)
#pragma unroll
            for (int s2 = 0; s2 < 2; ++s2) {
                v4u pw; pw.x = pg8::cvt_pk_bf16(s[kt][8 * s2 + 0], s[kt][8 * s2 + 1]); pw.y = pg8::cvt_pk_bf16(s[kt][8 * s2 + 2], s[kt][8 * s2 + 3]);
                pw.z = pg8::cvt_pk_bf16(s[kt][8 * s2 + 4], s[kt][8 * s2 + 5]); pw.w = pg8::cvt_pk_bf16(s[kt][8 * s2 + 6], s[kt][8 * s2 + 7]);
                const bf16x8 pa = __builtin_bit_cast(bf16x8, pw);
#pragma unroll
                for (int dt = 0; dt < 2; ++dt) {
                    const bf16x8 vf = *(const LAS bf16x8*)(Vt + (32 * dt + r32) * 264 + 32 * (qg + kt) + 16 * s2 + 8 * hi);
                    o[dt] = __builtin_amdgcn_mfma_f32_32x32x16_bf16(vf, pa, o[dt], 0, 0, 0);
                }
            }
        bf16* op = ao + tok * D + hq * HD;
#pragma unroll
        for (int dt = 0; dt < 2; ++dt)
#pragma unroll
            for (int g = 0; g < 4; ++g) {
                v2u w; w.x = pg8::cvt_pk_bf16(o[dt][4 * g + 0] * inv, o[dt][4 * g + 1] * inv); w.y = pg8::cvt_pk_bf16(o[dt][4 * g + 2] * inv, o[dt][4 * g + 3] * inv);
                *(GAS v2u*)(op + 32 * dt + 8 * g + 4 * hi) = w;
            }
    }
    __syncthreads();
}
__device__ __forceinline__ void conv_item(int item, const bf16* z, const float* cw, bf16* ci, int tid) {
    const int c8 = tid & 255, half = tid >> 8, t0 = 32 * item + 16 * half, c0 = 8 * c8;
    float w0[8], w1[8], w2[8], u1[8], u2[8];
#pragma unroll
    for (int e = 0; e < 8; ++e) { w0[e] = cw[c0 + e]; w1[e] = cw[2048 + c0 + e]; w2[e] = cw[4096 + c0 + e]; u1[e] = 0.f; u2[e] = 0.f; }
    if ((t0 & (SEQ - 1)) != 0) {
#pragma unroll
        for (int k = 0; k < 2; ++k) {
            const bf16* zr = z + (size_t)(t0 - 2 + k) * IN_W + c0;
            const v4u a = *(const GAS v4u*)(zr + CC_OFF), h = *(const GAS v4u*)(zr + CH_OFF);
            float u[8];
            u[0] = pg8::bf_lo(a.x) * pg8::bf_lo(h.x); u[1] = pg8::bf_hi(a.x) * pg8::bf_hi(h.x); u[2] = pg8::bf_lo(a.y) * pg8::bf_lo(h.y); u[3] = pg8::bf_hi(a.y) * pg8::bf_hi(h.y);
            u[4] = pg8::bf_lo(a.z) * pg8::bf_lo(h.z); u[5] = pg8::bf_hi(a.z) * pg8::bf_hi(h.z); u[6] = pg8::bf_lo(a.w) * pg8::bf_lo(h.w); u[7] = pg8::bf_hi(a.w) * pg8::bf_hi(h.w);
#pragma unroll
            for (int e = 0; e < 8; ++e) { if (k == 0) u2[e] = u[e]; else u1[e] = u[e]; }
        }
    }
#pragma unroll 4
    for (int i = 0; i < 16; ++i) {
        const bf16* zr = z + (size_t)(t0 + i) * IN_W + c0;
        const v4u a = *(const GAS v4u*)(zr + CC_OFF), h = *(const GAS v4u*)(zr + CH_OFF), bb = *(const GAS v4u*)(zr + CB_OFF);
        float u[8], cb[8], y[8];
        u[0] = pg8::bf_lo(a.x) * pg8::bf_lo(h.x); u[1] = pg8::bf_hi(a.x) * pg8::bf_hi(h.x); u[2] = pg8::bf_lo(a.y) * pg8::bf_lo(h.y); u[3] = pg8::bf_hi(a.y) * pg8::bf_hi(h.y);
        u[4] = pg8::bf_lo(a.z) * pg8::bf_lo(h.z); u[5] = pg8::bf_hi(a.z) * pg8::bf_hi(h.z); u[6] = pg8::bf_lo(a.w) * pg8::bf_lo(h.w); u[7] = pg8::bf_hi(a.w) * pg8::bf_hi(h.w);
        cb[0] = pg8::bf_lo(bb.x); cb[1] = pg8::bf_hi(bb.x); cb[2] = pg8::bf_lo(bb.y); cb[3] = pg8::bf_hi(bb.y); cb[4] = pg8::bf_lo(bb.z); cb[5] = pg8::bf_hi(bb.z); cb[6] = pg8::bf_lo(bb.w); cb[7] = pg8::bf_hi(bb.w);
#pragma unroll
        for (int e = 0; e < 8; ++e) { y[e] = cb[e] * (w0[e] * u2[e] + w1[e] * u1[e] + w2[e] * u[e]); u2[e] = u1[e]; u1[e] = u[e]; }
        v4u o; o.x = pk2(y[0], y[1]); o.y = pk2(y[2], y[3]); o.z = pk2(y[4], y[5]); o.w = pk2(y[6], y[7]);
        *(GAS v4u*)(ci + (size_t)(t0 + i) * D + c0) = o;
    }
}

__device__ __forceinline__ void ln1_row(float* r1row, bf16* hbrow, const float* g, const float* bta, int lane) {
    GAS f32x4* xr = (GAS f32x4*)r1row + lane;
    f32x4 v[8]; float s = 0.f;
#pragma unroll
    for (int j = 0; j < 8; ++j) { v[j] = xr[64 * j]; s += (v[j].x + v[j].y) + (v[j].z + v[j].w); }
    const float mean = wave_sum(s) * (1.f / D); float s2 = 0.f;
#pragma unroll
    for (int j = 0; j < 8; ++j) { v[j] = v[j] - mean; s2 += (v[j].x * v[j].x + v[j].y * v[j].y) + (v[j].z * v[j].z + v[j].w * v[j].w); }
    const float rstd = 1.f / sqrtf(wave_sum(s2) * (1.f / D) + LN_EPS);
    GAS v2u* o8 = (GAS v2u*)hbrow + lane;
#pragma unroll
    for (int j = 0; j < 8; ++j) {
        const f32x4 gg = *((const GAS f32x4*)g + lane + 64 * j), bb = *((const GAS f32x4*)bta + lane + 64 * j);
        const f32x4 y = v[j] * rstd * gg + bb;
        xr[64 * j] = y;
        v2u w; w.x = pk2(y.x, y.y); w.y = pk2(y.z, y.w); o8[64 * j] = w;
    }
}

constexpr int TK_ROWF = 136;
constexpr int TK_IDX_OFF = 256 * TK_ROWF * 4;
__device__ __forceinline__ void topk_pass(int pass, const float* scores, int* experts, float* gates, LAS unsigned char* lds, int tid) {
    LAS float* S = (LAS float*)lds;
    LAS unsigned char* IDX = lds + TK_IDX_OFF;
    const float* src = scores + (size_t)pass * (256 * 128);
#pragma unroll 4
    for (int i = 0; i < 16; ++i) { const int f4 = tid + NTHREADS * i, row = f4 >> 5, c4 = f4 & 31; *(LAS f32x4*)(S + row * TK_ROWF + 4 * c4) = *(const GAS f32x4*)(src + (size_t)f4 * 4); }
    __syncthreads();
    const int row = tid >> 1, sub = tid & 1;
    float L[16];
#pragma unroll
    for (int j = 0; j < 16; ++j) L[j] = -INFINITY;
#pragma unroll 2
    for (int i = 0; i < 16; ++i) {
        const int c4 = 2 * i + sub;
        const f32x4 v = *(const LAS f32x4*)(S + row * TK_ROWF + 4 * c4);
#pragma unroll
        for (int e = 0; e < 4; ++e) {
            const float ve = v[e];
            float x = __uint_as_float((__float_as_uint(ve) & ~0x7Fu) | (unsigned)(4 * c4 + e));
#pragma unroll
            for (int j = 0; j < 16; ++j) { const float h = vmaxf(L[j], x); x = vminf(L[j], x); L[j] = h; }
        }
    }
    {
        float P[16];
#pragma unroll
        for (int j = 0; j < 16; ++j) P[j] = __shfl_xor(L[j], 1);
#pragma unroll
        for (int j = 0; j < 16; ++j) L[j] = vmaxf(L[j], P[15 - j]);
#pragma unroll
        for (int st = 8; st >= 1; st >>= 1)
#pragma unroll
            for (int j = 0; j < 16; ++j) if ((j & st) == 0) { const float h = vmaxf(L[j], L[j + st]), l = vminf(L[j], L[j + st]); L[j] = h; L[j + st] = l; }
    }
    if (sub == 0) {
#pragma unroll
        for (int q = 0; q < 4; ++q) {
            unsigned w = 0;
#pragma unroll
            for (int e = 0; e < 4; ++e) w |= (__builtin_bit_cast(unsigned, L[4 * q + e]) & 0x7Fu) << (8 * e);
            *(LAS unsigned*)(IDX + row * 16 + 4 * q) = w;
        }
    }
    float A[16], B[16];
#pragma unroll
    for (int j = 0; j < 16; ++j) { const float o = __shfl_xor(L[j], 2); const bool isb = (tid & 2) != 0; A[j] = isb ? o : L[j]; B[j] = isb ? L[j] : o; }
    float F[16];
#pragma unroll
    for (int j = 0; j < 16; ++j) F[j] = -INFINITY;
#pragma unroll
    for (int i = 0; i < 16; ++i)
#pragma unroll
        for (int j = 0; j < 16; ++j) if ((i + 1) * (j + 1) <= 16) {
            const float sm = A[i] + B[j];
            float x = __builtin_bit_cast(float, (__builtin_bit_cast(unsigned, sm) & ~0xFFu) | (unsigned)(i * 16 + j));
#pragma unroll
            for (int k = 0; k < 16; ++k) { const float h = vmaxf(F[k], x); x = vminf(F[k], x); F[k] = h; }
        }
    __syncthreads();
    if ((tid & 3) == 0) {
        const int rowA = (tid >> 2) * 2, rowB = rowA + 1;
        const size_t prob = (size_t)pass * 128 + (tid >> 2);
        float g[16]; int ex[16]; float gs = 0.f;
#pragma unroll
        for (int k = 0; k < 16; ++k) {
            const unsigned code = __builtin_bit_cast(unsigned, F[k]) & 0xFFu;
            const int ia = IDX[rowA * 16 + (code >> 4)], ib = IDX[rowB * 16 + (code & 15)];
            ex[k] = ia * PNK + ib;
            g[k] = __expf(F[k] - F[0]); gs += g[k];
        }
        const float ginv = 1.0f / gs;
#pragma unroll
        for (int q = 0; q < 4; ++q) {
            *(GAS f32x4*)(gates + prob * 16 + 4 * q) = (f32x4){g[4 * q] * ginv, g[4 * q + 1] * ginv, g[4 * q + 2] * ginv, g[4 * q + 3] * ginv};
            typedef int i32x4 __attribute__((ext_vector_type(4)));
            *(GAS i32x4*)(experts + prob * 16 + 4 * q) = (i32x4){ex[4 * q], ex[4 * q + 1], ex[4 * q + 2], ex[4 * q + 3]};
        }
    }
    __syncthreads();
}

__device__ __forceinline__ float gelu_erf(float v) { return 0.5f * v * (1.0f + erff(v * 0.70710678118654752f)); }
typedef __bf16 bf16x2_t __attribute__((ext_vector_type(2)));
typedef float f32x2_t __attribute__((ext_vector_type(2)));
__device__ __forceinline__ float dot2bf(bf16x2_t a, unsigned b, float acc) { return __builtin_amdgcn_fdot2_f32_bf16(a, __builtin_bit_cast(bf16x2_t, b), acc, false); }
__device__ __forceinline__ float dot4f8(unsigned w8, unsigned x01, unsigned x23, float acc) {
    acc = dot2bf(__builtin_amdgcn_cvt_scalef32_pk_bf16_fp8(w8, 1.0f, false), x01, acc);
    return dot2bf(__builtin_amdgcn_cvt_scalef32_pk_bf16_fp8(w8, 1.0f, true), x23, acc);
}
__device__ __forceinline__ void axpy4f8(float* y, unsigned w8, float w) {
    const f32x2_t lo = __builtin_amdgcn_cvt_pk_f32_fp8(w8, false), hi = __builtin_amdgcn_cvt_pk_f32_fp8(w8, true);
    y[0] += w * lo.x; y[1] += w * lo.y; y[2] += w * hi.x; y[3] += w * hi.y;
}
__device__ __forceinline__ void row_to_fp8(const float* src, unsigned char* dst, float* inv, int lane) {
    f32x4 v[2][4]; float mx = 0.f;
#pragma unroll
    for (int j = 0; j < 2; ++j)
#pragma unroll
        for (int q = 0; q < 4; ++q) { v[j][q] = *((const GAS f32x4*)src + 4 * (lane + 64 * j) + q);
            mx = fmaxf(mx, fmaxf(fmaxf(fabsf(v[j][q].x), fabsf(v[j][q].y)), fmaxf(fabsf(v[j][q].z), fabsf(v[j][q].w)))); }
#pragma unroll
    for (int o = 1; o < 64; o <<= 1) mx = fmaxf(mx, __shfl_xor(mx, o));
    const float sc = mx > 0.f ? 384.0f / mx : 1.0f;
#pragma unroll
    for (int j = 0; j < 2; ++j) { v4u o;
        int w;
        w = 0; w = __builtin_amdgcn_cvt_pk_fp8_f32(v[j][0].x * sc, v[j][0].y * sc, w, false); w = __builtin_amdgcn_cvt_pk_fp8_f32(v[j][0].z * sc, v[j][0].w * sc, w, true); o.x = (unsigned)w;
        w = 0; w = __builtin_amdgcn_cvt_pk_fp8_f32(v[j][1].x * sc, v[j][1].y * sc, w, false); w = __builtin_amdgcn_cvt_pk_fp8_f32(v[j][1].z * sc, v[j][1].w * sc, w, true); o.y = (unsigned)w;
        w = 0; w = __builtin_amdgcn_cvt_pk_fp8_f32(v[j][2].x * sc, v[j][2].y * sc, w, false); w = __builtin_amdgcn_cvt_pk_fp8_f32(v[j][2].z * sc, v[j][2].w * sc, w, true); o.z = (unsigned)w;
        w = 0; w = __builtin_amdgcn_cvt_pk_fp8_f32(v[j][3].x * sc, v[j][3].y * sc, w, false); w = __builtin_amdgcn_cvt_pk_fp8_f32(v[j][3].z * sc, v[j][3].w * sc, w, true); o.w = (unsigned)w;
        { const int ch = lane + 64 * j; *((GAS v4u*)(dst + (size_t)(ch >> 4) * SLICE_BYTES) + (ch & 15)) = o; } }
    if (lane == 0) *inv = mx > 0.f ? mx * (1.0f / 384.0f) : 1.0f;
}
__device__ __forceinline__ float row16_allsum(float a) {
    a += __builtin_bit_cast(float, __builtin_amdgcn_update_dpp(0, __builtin_bit_cast(int, a), 0x128, 0xf, 0xf, false));
    a += __builtin_bit_cast(float, __builtin_amdgcn_update_dpp(0, __builtin_bit_cast(int, a), 0x124, 0xf, 0xf, false));
    a += __builtin_bit_cast(float, __builtin_amdgcn_update_dpp(0, __builtin_bit_cast(int, a), 0x122, 0xf, 0xf, false));
    a += __builtin_bit_cast(float, __builtin_amdgcn_update_dpp(0, __builtin_bit_cast(int, a), 0x121, 0xf, 0xf, false));
    return a;
}
__device__ __forceinline__ int q_pull(unsigned* q, int lane) { int v = 0; if (lane == 0) v = (int)__hip_atomic_fetch_add(q, 1u, __ATOMIC_RELAXED, __HIP_MEMORY_SCOPE_AGENT); return __builtin_amdgcn_readfirstlane(v); }
constexpr int PEER_TG = 8;
__device__ __forceinline__ void peer_a_token(int t, int s, const bf16* h1b, const int* experts, const unsigned char* u8s, float* pa, int lane_) {
    int lane = lane_; asm volatile("" : "+v"(lane));
    const int g = lane >> 4, c = lane & 15;
    const int id0 = experts[(size_t)t * 128 + lane], id1 = experts[(size_t)t * 128 + 64 + lane];
    const GAS v4u* xp = (const GAS v4u*)(h1b + (size_t)t * D + 256 * s + 16 * c);
    const v4u x0 = xp[0], x1 = xp[1];
    const GAS unsigned char* ub = (const GAS unsigned char*)(u8s + (size_t)s * SLICE_BYTES); const unsigned offc = 16u * (unsigned)c;
    float res[32];
#pragma unroll
    for (int hb = 0; hb < 2; ++hb) {
        v4u ur[16];
#pragma unroll
        for (int i = 0; i < 16; ++i) { const unsigned id = (unsigned)__shfl(hb ? id1 : id0, 4 * i + g); ur[i] = *(const GAS v4u*)(ub + (id * 256u + offc)); }
#pragma unroll
        for (int i = 0; i < 16; ++i) { float a = 0.f, b = 0.f;
            a = dot4f8(ur[i].x, x0.x, x0.y, a); b = dot4f8(ur[i].y, x0.z, x0.w, b); a = dot4f8(ur[i].z, x1.x, x1.y, a); b = dot4f8(ur[i].w, x1.z, x1.w, b);
            res[16 * hb + i] = row16_allsum(a + b); }
    }
    if (c == 15) { GAS f32x4* dst = (GAS f32x4*)(pa + ((size_t)t * 8 + s) * 128 + g * 32);
#pragma unroll
        for (int q = 0; q < 8; ++q) dst[q] = (f32x4){res[4 * q], res[4 * q + 1], res[4 * q + 2], res[4 * q + 3]}; }
}
__device__ __forceinline__ void peer_w_elem(size_t i, const int* experts, const float* gates, const float* su, const float* sv, const float* pa, float* wb) {
    const size_t t = i >> 7; const int k = (int)(i & 127), pos = (k & 3) * 32 + (k >> 2);
    const int e = experts[i];
    float a = 0.f;
#pragma unroll
    for (int s2 = 0; s2 < 8; ++s2) a += pa[(t * 8 + s2) * 128 + pos];
    wb[i] = gates[i] * gelu_erf(a * su[e]) * sv[e];
}
#define PB_LOAD(R, IDV, HALF) do { _Pragma("unroll") for (int i_ = 0; i_ < 8; ++i_) { const unsigned e_ = (unsigned)__shfl(IDV, 4 * (i_ + 8 * (HALF)) + g); \
        R[i_] = *(const GAS v4u*)(vb + (e_ * 256u + offc)); } } while (0)
#define PB_COMP(R, WV, HALF) do { _Pragma("unroll") for (int i_ = 0; i_ < 8; ++i_) { const float wk_ = __shfl(WV, 4 * (i_ + 8 * (HALF)) + g); \
        axpy4f8(&ya[0], R[i_].x, wk_); axpy4f8(&ya[4], R[i_].y, wk_); axpy4f8(&ya[8], R[i_].z, wk_); axpy4f8(&ya[12], R[i_].w, wk_); } } while (0)
__device__ __forceinline__ void peer_b_task(int t0, int s, const float* h1, const int* experts, const float* wb, const unsigned char* v8s, float* out, float* st, int lane_) {
    int lane = lane_; asm volatile("" : "+v"(lane));
    const int g = lane >> 4, c = lane & 15;
    const GAS unsigned char* vb = (const GAS unsigned char*)(v8s + (size_t)s * SLICE_BYTES);
    const unsigned offc = 16u * (unsigned)c;
    int idc0 = experts[(size_t)t0 * 128 + lane], idc1 = experts[(size_t)t0 * 128 + lane + 64];
    float wc0 = wb[(size_t)t0 * 128 + lane], wc1 = wb[(size_t)t0 * 128 + lane + 64];
    v4u RA[8], RB[8];
    PB_LOAD(RA, idc0, 0);
#pragma unroll 1
    for (int tt = 0; tt < PEER_TG; ++tt) {
        const int t = t0 + tt, tn = tt + 1 < PEER_TG ? t + 1 : t;
        const int idn0 = experts[(size_t)tn * 128 + lane], idn1 = experts[(size_t)tn * 128 + lane + 64];
        const float wn0 = wb[(size_t)tn * 128 + lane], wn1 = wb[(size_t)tn * 128 + lane + 64];
        float ya[16];
#pragma unroll
        for (int e = 0; e < 16; ++e) ya[e] = 0.f;
#pragma unroll 1
        for (int hb = 0; hb < 2; ++hb) {
            const int idv = hb ? idc1 : idc0, idx = hb ? idn0 : idc1; const float wv = hb ? wc1 : wc0;
            PB_LOAD(RB, idv, 1); PB_COMP(RA, wv, 0);
            asm volatile("" ::: "memory");
            PB_LOAD(RA, idx, 0); PB_COMP(RB, wv, 1);
        }
#pragma unroll
        for (int e = 0; e < 16; ++e) { ya[e] += __shfl_xor(ya[e], 16); ya[e] += __shfl_xor(ya[e], 32); }
        const GAS f32x4* hp = (const GAS f32x4*)(h1 + (size_t)t * D + 256 * s + 16 * c);
        float sm = 0.f, sq = 0.f; f32x4 r[4];
#pragma unroll
        for (int q = 0; q < 4; ++q) { r[q] = hp[q] * ALPHA + (f32x4){ya[4 * q], ya[4 * q + 1], ya[4 * q + 2], ya[4 * q + 3]};
            sm += (r[q].x + r[q].y) + (r[q].z + r[q].w); sq += (r[q].x * r[q].x + r[q].y * r[q].y) + (r[q].z * r[q].z + r[q].w * r[q].w); }
        sm = row16_allsum(sm); sq = row16_allsum(sq);
        if (g == 0) { GAS f32x4* op = (GAS f32x4*)(out + (size_t)t * D + 256 * s + 16 * c);
#pragma unroll
            for (int q = 0; q < 4; ++q) op[q] = r[q];
            if (c == 0) { st[((size_t)t * 8 + s) * 2] = sm; st[((size_t)t * 8 + s) * 2 + 1] = sq; } }
        idc0 = idn0; idc1 = idn1; wc0 = wn0; wc1 = wn1;
    }
}
__device__ __forceinline__ void peer_c_row(int t, float* out, const float* st, const float* g2, const float* b2, int lane) {
    float sm = 0.f, sq = 0.f;
#pragma unroll
    for (int s = 0; s < 8; ++s) { sm += st[((size_t)t * 8 + s) * 2]; sq += st[((size_t)t * 8 + s) * 2 + 1]; }
    const float mean = sm * (1.f / D), var = sq * (1.f / D) - mean * mean, rstd = 1.f / sqrtf(fmaxf(var, 0.f) + LN_EPS);
    GAS f32x4* xr = (GAS f32x4*)(out + (size_t)t * D) + lane;
#pragma unroll
    for (int j = 0; j < 8; ++j) { const f32x4 v = xr[64 * j]; const f32x4 gg = *((const GAS f32x4*)g2 + lane + 64 * j), bb = *((const GAS f32x4*)b2 + lane + 64 * j);
        xr[64 * j] = (v - mean) * rstd * gg + bb; }
}

struct Args { const float* in[16]; float* out; unsigned char* ws; int ph_lo, ph_hi; };
__global__ void __launch_bounds__(NTHREADS, 2) mk_fwd(Args args) {
    extern __shared__ __attribute__((aligned(16))) unsigned char lds_raw[];
    LAS unsigned char* lds = (LAS unsigned char*)lds_raw;
    volatile LAS unsigned* MISC = (volatile LAS unsigned*)(lds + MISC_OFF);
    const int tid0 = threadIdx.x;
    const int G = gridDim.x, bx = blockIdx.x;
    unsigned char* ws = args.ws;
    gu32* ctl = (gu32*)(ws + WS_CTL);
#define IN_(i) (args.in[i])
#define x_in IN_(0)
#define w_in IN_(1)
#define b_gate IN_(2)
#define sinks IN_(3)
#define conv_w IN_(4)
#define w_ao IN_(5)
#define w_co IN_(6)
#define w_o IN_(7)
#define ln1_g IN_(8)
#define ln1_b IN_(9)
#define w_q IN_(10)
#define sub_keys IN_(11)
#define peer_u IN_(12)
#define peer_v IN_(13)
#define ln2_g IN_(14)
#define ln2_b IN_(15)
#define WinT ((bf16*)(ws + WS_WIN))
#define WaT ((bf16*)(ws + WS_WA))
#define WcT ((bf16*)(ws + WS_WC))
#define WoT ((bf16*)(ws + WS_WO))
#define WfT ((bf16*)(ws + WS_WF))
#define XB ((bf16*)(ws + WS_XB))
#define MERGED ((bf16*)(ws + WS_MERGED))
#define Z ((bf16*)(ws + WS_Z))
#define H1 ((float*)(ws + WS_H1))
#define H1B ((bf16*)(ws + WS_H1B))
#define SC ((float*)(ws + WS_SC))
#define EX ((int*)(ws + WS_EX))
#define GT ((float*)(ws + WS_GT))
#define AO ((bf16*)(ws + WS_AO))
#define CI ((bf16*)(ws + WS_CI))
#define TMP ((bf16*)(ws + WS_TMP))
#define U8 ((unsigned char*)(ws + WS_U8))
#define V8 ((unsigned char*)(ws + WS_V8))
#define SU ((float*)(ws + WS_SU))
#define SV ((float*)(ws + WS_SV))
#define PA ((float*)(ws + WS_PA))
#define ST ((float*)(ws + WS_ST))
#define WB ((float*)(ws + WS_WB))
    for (int u = tid0; u < (LDS_BYTES - LDSCTL_OFF) / 4; u += NTHREADS) ((LAS unsigned*)(lds + LDSCTL_OFF))[u] = 0u;
    __syncthreads();
    XcdBarrier bar; bar.bar = (unsigned*)(ctl + CW_BAR); bar.x = 0; bar.st = nullptr;
    if (!MK_PER_PHASE) bar = xcd_barrier_post((unsigned*)(ctl + CW_BAR), MISC + 8);
    const int lo = args.ph_lo, hi = args.ph_hi;
#ifndef PH_MASK
#define PH_MASK 0xFFF
#endif
#define IN(k) (((PH_MASK >> (k)) & 1) && lo <= (k) && (k) < hi)
#define SEAM(k) do { if (IN(k) && IN((k) + 1)) xcd_barrier(bar); } while (0)
#ifndef DBL_MASK
#define DBL_MASK 0
#endif
#define REP(k) for (int rep_ = 0; rep_ < 1 + ((DBL_MASK >> (k)) & 1); ++rep_)
#define PHASE_TID() int tid = tid0; asm volatile("" : "+v"(tid)); const int lane = tid & 63, wave = __builtin_amdgcn_readfirstlane(tid >> 6); (void)lane; (void)wave

    if (IN(0)) REP(0) {
        PHASE_TID();
        for (int it = bx; it < 16 * 32; it += G) p0_wf_item(w_q, sub_keys, WfT, lds, it, tid);
        LAS float* scr = (LAS float*)(lds + wave * 16384);
        const int gw = bx * NWAVES + wave, NGW = G * NWAVES;
        constexpr int I_IN = (D / 64) * (IN_W / 32), I_SQ = (D / 64) * (D / 32);
        for (int it = gw; it < I_IN + 3 * I_SQ; it += NGW) {
            int r = it;
            if (r < I_IN) { p0_transpose_item(w_in, D, IN_W, WinT, scr, r, lane); continue; } r -= I_IN;
            if (r < I_SQ) { p0_transpose_item(w_ao, D, D, WaT, scr, r, lane); continue; } r -= I_SQ;
            if (r < I_SQ) { p0_transpose_item(w_co, D, D, WcT, scr, r, lane); continue; } r -= I_SQ;
            p0_transpose_item(w_o, D, D, WoT, scr, r, lane);
        }
        const size_t n8 = (size_t)M * D / 8;
        for (size_t i = (size_t)bx * NTHREADS + tid; i < n8; i += (size_t)G * NTHREADS) {
            const f32x4 a = *((const GAS f32x4*)x_in + 2 * i), b = *((const GAS f32x4*)x_in + 2 * i + 1);
            v4u o; o.x = pk2(a.x, a.y); o.y = pk2(a.z, a.w); o.z = pk2(b.x, b.y); o.w = pk2(b.z, b.w);
            *((GAS v4u*)XB + i) = o;
        }
    }
    SEAM(0);
    if (IN(1)) REP(1) {
        pg8::Gemm g{XB, WinT, M, IN_W, D}; pg8::StaticOrder S; S.init(M, IN_W, G, bx);
        pg8::EpiBf16 E{Z, IN_W};
        pg8::gemm_phase<pg8::EpiBf16, pg8::StaticOrder, true, true>(lds, g, S, E);
    }
    SEAM(1);
    if (IN(2)) REP(2) {
        PHASE_TID();
        for (int u = bx; u < BATCH * NKVH * 16; u += G) attn_unit(u, Z, AO, sinks, lds, tid);
        for (int it = bx; it < M / 32; it += G) conv_item(it, Z, conv_w, CI, tid);
    }
    SEAM(2);
    if (IN(3)) REP(3) {
        pg8::StaticOrder S; S.init(M, D, G, bx);
        { pg8::Gemm g{AO, WaT, M, D, D}; pg8::EpiGate<0> E{TMP, nullptr, Z + G_OFF, b_gate, D, IN_W};
          pg8::gemm_phase<pg8::EpiGate<0>, pg8::StaticOrder, true, true>(lds, g, S, E); }
        { pg8::Gemm g{CI, WcT, M, D, D}; pg8::EpiGate<1> E{MERGED, TMP, Z + G_OFF + D, b_gate + D, D, IN_W};
          pg8::gemm_phase<pg8::EpiGate<1>, pg8::StaticOrder, true, true>(lds, g, S, E); }
    }
    SEAM(3);
    if (IN(4)) REP(4) {
        pg8::Gemm g{MERGED, WoT, M, D, D}; pg8::StaticOrder S; S.init(M, D, G, bx);
        pg8::EpiF32 E{H1, D, x_in, ALPHA};
        pg8::gemm_phase<pg8::EpiF32, pg8::StaticOrder, true, true>(lds, g, S, E);
    }
    SEAM(4);
    if (IN(5)) REP(5) {
        PHASE_TID();
        const int gw = bx * NWAVES + wave, NGW = G * NWAVES;
        for (int m = gw; m < M; m += NGW) ln1_row(H1 + (size_t)m * D, H1B + (size_t)m * D, ln1_g, ln1_b, lane);
#ifndef DBL_CONV
#define DBL_CONV 0
#endif
        for (int rep2 = 0; rep2 <= DBL_CONV; ++rep2)
        for (int r = gw; r < 2 * PNE; r += NGW) {
            const bool sec = r >= PNE; const int e = sec ? r - PNE : r;
            row_to_fp8((sec ? peer_v : peer_u) + (size_t)e * D, (sec ? V8 : U8) + (size_t)e * 256, (sec ? SV : SU) + e, lane);
        }
    }
    SEAM(5);
    if (IN(6)) REP(6) {
        pg8::Gemm g{H1B, WfT, M, D, D}; pg8::StaticOrder S; S.init(M, D, G, bx);
        pg8::EpiF32 E{SC, D, nullptr, 0.f};
        pg8::gemm_phase<pg8::EpiF32, pg8::StaticOrder, true, true>(lds, g, S, E);
    }
    SEAM(6);
    if (IN(7)) REP(7) {
        PHASE_TID();
        for (int p = bx; p < (M * PH) / 128; p += G) topk_pass(p, SC, EX, GT, lds, tid);
    }
    SEAM(7);
    if (IN(8)) REP(8) {
        PHASE_TID();
        const int xcc = (int)(xb_xcc_id() & 7u);
#pragma unroll 1
        for (int sl = 0; sl < 8; ++sl) { const int s = (xcc + sl) & 7;
            for (;;) { const int tg = q_pull((unsigned*)(ctl + CW_Q + 64 * (s + 16 * rep_)), lane); if (tg >= M / PEER_TG) break;
#pragma unroll 1
                for (int tt = 0; tt < PEER_TG; ++tt) peer_a_token(tg * PEER_TG + tt, s, H1B, EX, U8, PA, lane); } }
    }
    SEAM(8);
    if (IN(9)) REP(9) {
        PHASE_TID();
        for (size_t i = (size_t)bx * NTHREADS + tid; i < (size_t)M * 128; i += (size_t)G * NTHREADS) peer_w_elem(i, EX, GT, SU, SV, PA, WB);
    }
    SEAM(9);
    if (IN(10)) REP(10) {
        PHASE_TID();
        const int xcc = (int)(xb_xcc_id() & 7u);
#pragma unroll 1
        for (int sl = 0; sl < 8; ++sl) { const int s = (xcc + sl) & 7;
            for (;;) { const int tg = q_pull((unsigned*)(ctl + CW_Q + 64 * (8 + s + 16 * rep_)), lane); if (tg >= M / PEER_TG) break;
                peer_b_task(tg * PEER_TG, s, H1, EX, WB, V8, args.out, ST, lane); } }
    }
    SEAM(10);
    if (IN(11)) REP(11) {
        PHASE_TID();
        const int gw = bx * NWAVES + wave, NGW = G * NWAVES;
        for (int t = gw; t < M; t += NGW) peer_c_row(t, args.out, ST, ln2_g, ln2_b, lane);
    }
#undef IN
#undef SEAM
}

extern "C" void kernel_launch(void* const* d_in, const int* in_sizes, int n_in, void* d_out, int out_size, void* d_ws, size_t ws_size, hipStream_t stream) {
    static int grid = 0;
    if (grid == 0) {
        if (n_in != 16 || out_size != M * D || ws_size < WS_END) { fprintf(stderr, "kernel_launch: unexpected shapes (n_in %d out %d ws %zu)\n", n_in, out_size, ws_size); grid = -1; return; }
        int dev = 0, cus = 0, per_cu = 0;
        if (hipGetDevice(&dev) != hipSuccess || hipDeviceGetAttribute(&cus, hipDeviceAttributeMultiprocessorCount, dev) != hipSuccess) { grid = -1; return; }
        if (hipFuncSetAttribute((const void*)mk_fwd, hipFuncAttributeMaxDynamicSharedMemorySize, LDS_BYTES) != hipSuccess) { fprintf(stderr, "kernel_launch: hipFuncSetAttribute failed\n"); grid = -1; return; }
        if (hipOccupancyMaxActiveBlocksPerMultiprocessor(&per_cu, (const void*)mk_fwd, NTHREADS, LDS_BYTES) != hipSuccess || per_cu < 1) { fprintf(stderr, "kernel_launch: occupancy query says %d\n", per_cu); per_cu = 1; }
        (void)hipGetLastError();
        if (per_cu > 1) per_cu = 1;
        grid = cus * per_cu;
    }
    if (grid < 0) return;
    if (hipMemsetAsync((char*)d_ws + WS_CTL, 0, CTL_ZERO_BYTES, stream) != hipSuccess) { fprintf(stderr, "kernel_launch: memset failed\n"); return; }
    Args a{};
    for (int i = 0; i < 16; ++i) a.in[i] = (const float*)d_in[i];
    a.out = (float*)d_out; a.ws = (unsigned char*)d_ws;
#if MK_PER_PHASE
    for (int p = 0; p < N_PHASES; ++p) { a.ph_lo = p; a.ph_hi = p + 1; hipLaunchKernelGGL(mk_fwd, dim3(grid), dim3(NTHREADS), LDS_BYTES, stream, a); }
#else
    a.ph_lo = 0; a.ph_hi = N_PHASES;
    void* kargs[] = {&a};
    hipError_t e = hipLaunchCooperativeKernel((const void*)mk_fwd, dim3(grid), dim3(NTHREADS), kargs, LDS_BYTES, stream);
    if (e != hipSuccess) fprintf(stderr, "kernel_launch: cooperative launch failed: %s (grid %d)\n", hipGetErrorString(e), grid);
#endif
}
```

```cpp
#include <hip/hip_runtime.h>
#include <cstdio>
#include <cstdint>
namespace pg8 {
#define PG8_LAS __attribute__((address_space(3)))
typedef unsigned short bf16_t;
typedef short bf16x8 __attribute__((ext_vector_type(8)));
typedef float f32x4 __attribute__((ext_vector_type(4)));
typedef unsigned u32x4 __attribute__((ext_vector_type(4)));
constexpr int BM = 256, BK = 64, HALF = 128, HTB = HALF * BK * 2  , STAGE_BYTES = 8 * HTB, NXCD = 8, WGM = 8;

__host__ __device__ __forceinline__ int lds_byte(int r, int c) { const int st = (r >> 4) * 2 + (c >> 5), rr = r & 15, cc = c & 31, ob = rr * 64 + cc * 2; return st * 1024 + (ob ^ (((ob >> 9) & 1) << 5)); }
__host__ __device__ __forceinline__ void stage_rc(int b, int& R, int& C) { const int st = b / 1024, sb = b % 1024, swz = sb ^ (((sb >> 9) & 1) << 5); R = (st >> 1) * 16 + swz / 64; C = (st & 1) * 32 + (swz % 64) / 2; }
__host__ __device__ __forceinline__ int perm32(int rho) { const int n = rho >> 4, i = rho & 15; return 8 * (i >> 2) + 4 * n + (i & 3); }

struct Unit { int pm, pn; };
struct Gemm { const bf16_t* A; const bf16_t* Bt; int M, N, K; };

struct StaticOrder {
    int nM, nN, nwg, G, c;
    __host__ __device__ void init(int M, int N, int G_, int c_) { nM = M / BM; nN = N / BM; nwg = nM * nN; G = G_; c = c_; }
    __host__ __device__ bool next(int i, Unit& u) const {
        const long L = (long)i * G + c; if (L >= nwg) return false;
        int wgid = (int)L; { const int q = nwg / NXCD, r = nwg % NXCD, xcd = wgid % NXCD, off = wgid / NXCD; wgid = (xcd < r ? xcd * (q + 1) : r * (q + 1) + (xcd - r) * q) + off; }
        const int nig = WGM * nN, gid = wgid / nig, fm = gid * WGM, gsz = (nM - fm) < WGM ? (nM - fm) : WGM;
        u.pm = fm + ((wgid % nig) % gsz); u.pn = (wgid % nig) / gsz; return true;
    }
    __device__ __forceinline__ void a_ready(const Unit&) const {}
    __device__ __forceinline__ void done(const Unit&) const {}
};


__device__ __forceinline__ unsigned cvt_pk_bf16(float lo, float hi) { unsigned r; asm volatile("v_cvt_pk_bf16_f32 %0, %1, %2" : "=v"(r) : "v"(lo), "v"(hi)); return r; }
__device__ __forceinline__ float bf_lo(unsigned w) { return __builtin_bit_cast(float, w << 16); }
__device__ __forceinline__ float bf_hi(unsigned w) { return __builtin_bit_cast(float, w & 0xffff0000u); }
__device__ __forceinline__ float sigmoidf_(float x) { return __builtin_amdgcn_rcpf(1.0f + __expf(-x)); }

struct EpiBf16 {
    static constexpr bool PERM = true, AFTER_DRAIN = false;
    bf16_t* O; int ldc;
    __device__ __forceinline__ void operator()(const f32x4 (&acc)[2][2][4][2], const Unit& u, int wr, int wc, int fr, int fq) const {
        const int row0 = u.pm * BM + wr * 64 + fr, col0 = u.pn * BM + wc * 32 + 8 * fq;
#pragma unroll
        for (int ai = 0; ai < 2; ++ai)
#pragma unroll
            for (int m = 0; m < 4; ++m) { bf16_t* rowp = O + (size_t)(row0 + ai * HALF + m * 16) * ldc + col0;
#pragma unroll
                for (int bj = 0; bj < 2; ++bj) { const f32x4 v0 = acc[ai][bj][m][0], v1 = acc[ai][bj][m][1];
                    u32x4 w; w.x = cvt_pk_bf16(v0[0], v0[1]); w.y = cvt_pk_bf16(v0[2], v0[3]); w.z = cvt_pk_bf16(v1[0], v1[1]); w.w = cvt_pk_bf16(v1[2], v1[3]);
                    *(u32x4*)(rowp + bj * HALF) = w; } }
    }
};
template <int SECOND> struct EpiGate {
    static constexpr bool PERM = true, AFTER_DRAIN = false;
    bf16_t* O; const bf16_t* T; const bf16_t* Zg; const float* bg; int ldc, ldz;
    __device__ __forceinline__ void operator()(const f32x4 (&acc)[2][2][4][2], const Unit& u, int wr, int wc, int fr, int fq) const {
        const int row0 = u.pm * BM + wr * 64 + fr, col0 = u.pn * BM + wc * 32 + 8 * fq;
        f32x4 bv[2][2];
#pragma unroll
        for (int bj = 0; bj < 2; ++bj)
#pragma unroll
            for (int n = 0; n < 2; ++n) bv[bj][n] = *(const f32x4*)(bg + col0 + bj * HALF + 4 * n);
#pragma unroll
        for (int ai = 0; ai < 2; ++ai)
#pragma unroll
            for (int m = 0; m < 4; ++m) { const size_t row = (size_t)(row0 + ai * HALF + m * 16);
#pragma unroll
                for (int bj = 0; bj < 2; ++bj) { const int c = col0 + bj * HALF;
                    const u32x4 zg = *(const u32x4*)(Zg + row * ldz + c);
                    f32x4 v0 = acc[ai][bj][m][0], v1 = acc[ai][bj][m][1];
                    v0[0] *= sigmoidf_(bf_lo(zg.x) + bv[bj][0][0]); v0[1] *= sigmoidf_(bf_hi(zg.x) + bv[bj][0][1]);
                    v0[2] *= sigmoidf_(bf_lo(zg.y) + bv[bj][0][2]); v0[3] *= sigmoidf_(bf_hi(zg.y) + bv[bj][0][3]);
                    v1[0] *= sigmoidf_(bf_lo(zg.z) + bv[bj][1][0]); v1[1] *= sigmoidf_(bf_hi(zg.z) + bv[bj][1][1]);
                    v1[2] *= sigmoidf_(bf_lo(zg.w) + bv[bj][1][2]); v1[3] *= sigmoidf_(bf_hi(zg.w) + bv[bj][1][3]);
                    if (SECOND) { const u32x4 t = *(const u32x4*)(T + row * ldc + c);
                        v0[0] += bf_lo(t.x); v0[1] += bf_hi(t.x); v0[2] += bf_lo(t.y); v0[3] += bf_hi(t.y);
                        v1[0] += bf_lo(t.z); v1[1] += bf_hi(t.z); v1[2] += bf_lo(t.w); v1[3] += bf_hi(t.w); }
                    u32x4 w; w.x = cvt_pk_bf16(v0[0], v0[1]); w.y = cvt_pk_bf16(v0[2], v0[3]); w.z = cvt_pk_bf16(v1[0], v1[1]); w.w = cvt_pk_bf16(v1[2], v1[3]);
                    *(u32x4*)(O + row * ldc + c) = w; } }
    }
};
struct EpiF32 {
    static constexpr bool PERM = false, AFTER_DRAIN = false;
    float* C; int ldc; const float* R; float scale;
    __device__ __forceinline__ void operator()(const f32x4 (&acc)[2][2][4][2], const Unit& u, int wr, int wc, int fr, int fq) const {
        const int row0 = u.pm * BM + wr * 64 + fr, col0 = u.pn * BM + wc * 32 + 4 * fq;
#pragma unroll
        for (int ai = 0; ai < 2; ++ai)
#pragma unroll
            for (int m = 0; m < 4; ++m) { const size_t off = (size_t)(row0 + ai * HALF + m * 16) * ldc + col0;
#pragma unroll
                for (int bj = 0; bj < 2; ++bj)
#pragma unroll
                    for (int n = 0; n < 2; ++n) { f32x4 v = acc[ai][bj][m][n];
                        if (R) v += *(const f32x4*)(R + off + bj * HALF + n * 16) * scale;
                        *(f32x4*)(C + off + bj * HALF + n * 16) = v; } }
    }
};

template <class Epi, class Sched, bool ALIGN_EPI = false, bool SP2 = false>
__device__ __forceinline__ void gemm_phase(PG8_LAS unsigned char* lds, const Gemm g, const Sched& S, const Epi& E) {
    int tid_ = threadIdx.x; asm volatile("" : "+v"(tid_));
    const int tid = tid_, wid = __builtin_amdgcn_readfirstlane(tid >> 6), lane = tid & 63, wr = wid >> 2, wc = wid & 3, fr = lane & 15, fq = lane >> 4;
    const int K = g.K, nt = K / BK;
    unsigned voffA[2], voffB[2];
#pragma unroll
    for (int i = 0; i < 2; ++i) { int R, C; stage_rc(tid * 16 + i * 8192, R, C); const int Rb = Epi::PERM ? ((R & ~31) + perm32(R & 31)) : R;
        voffA[i] = (unsigned)(R * K + C) * 2u; voffB[i] = (unsigned)(Rb * K + C) * 2u; }
    const size_t kstep = (size_t)(BK * 2);
    const size_t hstep = (size_t)HALF * K * 2;
    const size_t tstep = 2 * hstep;
    const unsigned ldsw = (unsigned)wid * 1024u;
    const int aoff = lds_byte(wr * 64 + fr, fq * 8), boff = lds_byte(wc * 32 + fr, fq * 8);
#define PG8_SA(b, h) (((b) * 2 + (h)) * HTB)
#define PG8_SB(b, h) ((4 + (b) * 2 + (h)) * HTB)
#define PG8_STAGE(bufoff, gbase, voff) do { _Pragma("unroll") for (int _i = 0; _i < 2; ++_i) \
        __builtin_amdgcn_global_load_lds((const unsigned*)((const char*)(gbase) + (voff)[_i]), (PG8_LAS unsigned*)(lds + (bufoff) + ldsw + _i * 8192), 16, 0, 0); } while (0)
#define PG8_LDA(dst, b, h) do { _Pragma("unroll") for (int m = 0; m < 4; ++m) _Pragma("unroll") for (int k = 0; k < 2; ++k) dst[m][k] = *(const PG8_LAS bf16x8*)(lds + PG8_SA(b, h) + aoff + m * 2048 + k * 1024); } while (0)
#define PG8_LDB(dst, b, h) do { _Pragma("unroll") for (int n = 0; n < 2; ++n) _Pragma("unroll") for (int k = 0; k < 2; ++k) dst[n][k] = *(const PG8_LAS bf16x8*)(lds + PG8_SB(b, h) + boff + n * 2048 + k * 1024); } while (0)
#define PG8_MMA(ai, bj, At, Bt) do { __builtin_amdgcn_s_setprio(1); _Pragma("unroll") for (int m = 0; m < 4; ++m) _Pragma("unroll") for (int n = 0; n < 2; ++n) _Pragma("unroll") for (int k = 0; k < 2; ++k) \
        acc[ai][bj][m][n] = __builtin_amdgcn_mfma_f32_16x16x32_bf16(Bt[n][k], At[m][k], acc[ai][bj][m][n], 0, 0, 0); __builtin_amdgcn_s_setprio(0); } while (0)
#define PG8_WAIT_V(n) asm volatile("s_waitcnt vmcnt(" #n ")" ::: "memory")
#define PG8_WAIT_L(n) asm volatile("s_waitcnt lgkmcnt(" #n ")" ::: "memory")
#define PG8_BAR __builtin_amdgcn_s_barrier()
#define PG8_SCHED __builtin_amdgcn_sched_barrier(0)
    Unit cur, nxt; int ui = 0;
    if (!S.next(0, cur)) return;
    f32x4 acc[2][2][4][2];
#pragma unroll
    for (int a = 0; a < 2; ++a)
#pragma unroll
        for (int b = 0; b < 2; ++b)
#pragma unroll
            for (int m = 0; m < 4; ++m)
#pragma unroll
                for (int n = 0; n < 2; ++n) acc[a][b][m][n] = (f32x4){0.f, 0.f, 0.f, 0.f};
    bf16x8 At[4][2], B0[2][2], B1[2][2];
    const char* cA = (const char*)g.A + (size_t)cur.pm * tstep; const char* cB = (const char*)g.Bt + (size_t)cur.pn * tstep;
    S.a_ready(cur);
    if constexpr (SP2) {
        PG8_STAGE(PG8_SB(0, 0), cB, voffB); PG8_STAGE(PG8_SB(0, 1), cB + hstep, voffB); PG8_STAGE(PG8_SA(0, 0), cA, voffA); PG8_STAGE(PG8_SA(0, 1), cA + hstep, voffA);
        if (wr == 1) PG8_BAR;
        PG8_WAIT_V(2); PG8_BAR;
        PG8_STAGE(PG8_SB(1, 0), cB + kstep, voffB); PG8_STAGE(PG8_SA(1, 0), cA + kstep, voffA); PG8_STAGE(PG8_SB(1, 1), cB + hstep + kstep, voffB);
        PG8_WAIT_V(6); PG8_BAR;
    } else {
        PG8_STAGE(PG8_SB(0, 0), cB, voffB); PG8_STAGE(PG8_SA(0, 0), cA, voffA); PG8_STAGE(PG8_SB(0, 1), cB + hstep, voffB); PG8_STAGE(PG8_SA(0, 1), cA + hstep, voffA);
        if (wr == 1) PG8_BAR;
        PG8_WAIT_V(4); PG8_BAR;
        PG8_STAGE(PG8_SB(1, 0), cB + kstep, voffB); PG8_STAGE(PG8_SA(1, 0), cA + kstep, voffA); PG8_STAGE(PG8_SB(1, 1), cB + hstep + kstep, voffB);
        PG8_WAIT_V(6); PG8_BAR;
    }
    for (;;) {
        const bool has_next = S.next(ui + 1, nxt);
        const char* nA = has_next ? (const char*)g.A + (size_t)nxt.pm * tstep : cA; const char* nB = has_next ? (const char*)g.Bt + (size_t)nxt.pn * tstep : cB;
        for (int t = 0; t < nt; t += 2) {
            const bool last = (t == nt - 2);
            const char* a1 = cA + (size_t)(t + 1) * kstep;
            const char* a2 = last ? nA : cA + (size_t)(t + 2) * kstep; const char* b2 = last ? nB : cB + (size_t)(t + 2) * kstep;
            const char* a3 = a2 + kstep; const char* b3 = b2 + kstep;
            if (last && has_next) S.a_ready(nxt);
            if constexpr (SP2) {
            PG8_LDB(B0, 0, 0); PG8_LDB(B1, 0, 1); PG8_SCHED; PG8_LDA(At, 0, 0); PG8_STAGE(PG8_SA(1, 1), a1 + hstep, voffA);
            PG8_WAIT_V(8); PG8_WAIT_L(0); PG8_BAR; PG8_MMA(0, 0, At, B0); PG8_MMA(0, 1, At, B1); PG8_BAR; PG8_SCHED;
            PG8_LDA(At, 0, 1); PG8_STAGE(PG8_SB(0, 0), b2, voffB); PG8_STAGE(PG8_SB(0, 1), b2 + hstep, voffB); PG8_STAGE(PG8_SA(0, 0), a2, voffA);
            PG8_WAIT_V(8); PG8_WAIT_L(0); PG8_BAR; PG8_MMA(1, 0, At, B0); PG8_MMA(1, 1, At, B1); PG8_BAR; PG8_SCHED;
            PG8_LDB(B0, 1, 0); PG8_LDB(B1, 1, 1); PG8_SCHED; PG8_LDA(At, 1, 0); PG8_STAGE(PG8_SA(0, 1), a2 + hstep, voffA);
            PG8_WAIT_V(8); PG8_WAIT_L(0); PG8_BAR; PG8_MMA(0, 0, At, B0); PG8_MMA(0, 1, At, B1); PG8_BAR; PG8_SCHED;
            PG8_LDA(At, 1, 1); PG8_STAGE(PG8_SB(1, 0), b3, voffB); PG8_STAGE(PG8_SB(1, 1), b3 + hstep, voffB); PG8_STAGE(PG8_SA(1, 0), a3, voffA);
            PG8_WAIT_V(8); PG8_WAIT_L(0); PG8_BAR; PG8_MMA(1, 0, At, B0); PG8_MMA(1, 1, At, B1); PG8_BAR; PG8_SCHED;
            } else {
            PG8_LDB(B0, 0, 0); PG8_SCHED; PG8_LDA(At, 0, 0); PG8_STAGE(PG8_SA(1, 1), a1 + hstep, voffA);
            PG8_WAIT_L(8); PG8_BAR; PG8_WAIT_L(0); PG8_MMA(0, 0, At, B0); PG8_BAR; PG8_SCHED;
            PG8_LDB(B1, 0, 1); PG8_STAGE(PG8_SB(0, 0), b2, voffB);
            PG8_BAR; PG8_WAIT_L(0); PG8_MMA(0, 1, At, B1); PG8_BAR;
            PG8_LDA(At, 0, 1); PG8_STAGE(PG8_SA(0, 0), a2, voffA);
            PG8_BAR; PG8_WAIT_L(0); PG8_MMA(1, 0, At, B0); PG8_BAR; PG8_SCHED;
            PG8_STAGE(PG8_SB(0, 1), b2 + hstep, voffB);
            PG8_WAIT_V(6); PG8_BAR; PG8_MMA(1, 1, At, B1); PG8_BAR;
            PG8_LDB(B0, 1, 0); PG8_SCHED; PG8_LDA(At, 1, 0); PG8_STAGE(PG8_SA(0, 1), a2 + hstep, voffA);
            PG8_WAIT_L(8); PG8_BAR; PG8_WAIT_L(0); PG8_MMA(0, 0, At, B0); PG8_BAR; PG8_SCHED;
            PG8_LDB(B1, 1, 1); PG8_STAGE(PG8_SB(1, 0), b3, voffB);
            PG8_BAR; PG8_WAIT_L(0); PG8_MMA(0, 1, At, B1); PG8_BAR;
            PG8_LDA(At, 1, 1); PG8_STAGE(PG8_SA(1, 0), a3, voffA);
            PG8_BAR; PG8_WAIT_L(0); PG8_MMA(1, 0, At, B0); PG8_BAR; PG8_SCHED;
            PG8_STAGE(PG8_SB(1, 1), b3 + hstep, voffB);
            PG8_WAIT_V(6); PG8_BAR; PG8_MMA(1, 1, At, B1); PG8_BAR;
            }
        }
        if constexpr (ALIGN_EPI) { if (wr == 0) PG8_BAR; }
        if constexpr (!Epi::AFTER_DRAIN) { E(acc, cur, wr, wc, fr, fq); S.done(cur); }
        if (!has_next) break;
#pragma unroll
        for (int a = 0; a < 2; ++a)
#pragma unroll
            for (int b = 0; b < 2; ++b)
#pragma unroll
                for (int m = 0; m < 4; ++m)
#pragma unroll
                    for (int n = 0; n < 2; ++n) acc[a][b][m][n] = (f32x4){0.f, 0.f, 0.f, 0.f};
        cur = nxt; cA = nA; cB = nB; ++ui;
        if constexpr (ALIGN_EPI) { if (wr == 1) PG8_BAR; }
    }
    PG8_WAIT_V(0);
    if constexpr (!ALIGN_EPI) { if (wr == 0) PG8_BAR; }
    PG8_BAR;
    if constexpr (Epi::AFTER_DRAIN) { E.fused(acc, cur, wr, wc, fr, fq, lds, wid, lane); S.done(cur); }
#undef PG8_SA
#undef PG8_SB
#undef PG8_STAGE
#undef PG8_LDA
#undef PG8_LDB
#undef PG8_MMA
#undef PG8_WAIT_V
#undef PG8_WAIT_L
#undef PG8_BAR
#undef PG8_SCHED
}
}
#define GAS __attribute__((address_space(1)))
#define LAS __attribute__((address_space(3)))
typedef unsigned short bf16;
typedef unsigned v4u __attribute__((ext_vector_type(4)));
typedef float f32x4 __attribute__((ext_vector_type(4)));
typedef short bf16x8 __attribute__((ext_vector_type(8)));
typedef GAS unsigned gu32;
typedef GAS unsigned long long gu64;
#define RLX_AGENT __ATOMIC_RELAXED, __HIP_MEMORY_SCOPE_AGENT
#define LDS_WAIT() asm volatile("s_waitcnt lgkmcnt(0)" ::: "memory")
#define VM_WAIT() asm volatile("s_waitcnt vmcnt(0)" ::: "memory")
__device__ __forceinline__ unsigned long long rt() { return __builtin_amdgcn_s_memrealtime(); }
__device__ __forceinline__ unsigned f2bf(float f) { unsigned u = __builtin_bit_cast(unsigned, f); return (u + 0x7fffu + ((u >> 16) & 1u)) >> 16; }
__device__ __forceinline__ unsigned pk2(float lo, float hi) { return f2bf(lo) | (f2bf(hi) << 16); }

#define XB_TMO      128
#define XB_XCNT(j)  (256  + 64 * (j))
#define XB_XSUB(j)  (1280 + 64 * (j))
#define XB_XGEN(j)  (2304 + 64 * (j))
#define XB_TOP      3328
#define XB_TOPGEN   3392
#define XCD_BAR_WORDS 3456
#define XB_SPIN_CAP (1u << 18)

__device__ __forceinline__ unsigned xb_ld(unsigned* p)              { return __hip_atomic_load(p, __ATOMIC_RELAXED, __HIP_MEMORY_SCOPE_AGENT); }
__device__ __forceinline__ unsigned xb_add(unsigned* p, unsigned v) { return __hip_atomic_fetch_add(p, v, __ATOMIC_RELAXED, __HIP_MEMORY_SCOPE_AGENT); }
__device__ __forceinline__ unsigned xb_xcc_id() { return (unsigned)__builtin_amdgcn_s_getreg((3 << 11) | 20) & 0xFu; }
#define XB_SPIN(cond, bar) do { unsigned _sp = 0; while (cond) { __builtin_amdgcn_s_sleep(1); \
    if ((++_sp & 255u) == 0u) { if (xb_ld(&(bar)[XB_TMO])) break; if (_sp > XB_SPIN_CAP) { atomicAdd(&(bar)[XB_TMO], 1u); break; } } } } while (0)

struct XcdBarrier {
    unsigned* bar; unsigned x;
    volatile LAS unsigned* st;
};

__device__ __forceinline__ XcdBarrier xcd_barrier_post(unsigned* bar, volatile LAS unsigned* st) {
    XcdBarrier b; b.bar = bar; b.x = xb_xcc_id(); b.st = st;
    if (threadIdx.x == 0) (void)xb_add(&bar[XB_XCNT(b.x)], 1u);
    return b;
}
__device__ __forceinline__ void xcd_barrier_complete(unsigned* bar, unsigned x, unsigned& nloc, unsigned& nx) {
    const unsigned G = gridDim.x * gridDim.y * gridDim.z;
    unsigned sum, cnt, mine, sp = 0u;
    for (;;) {
        sum = 0u; cnt = 0u; mine = 0u;
#pragma unroll
        for (unsigned j = 0; j < 16; ++j) { const unsigned c = xb_ld(&bar[XB_XCNT(j)]); sum += c; cnt += (c > 0u) ? 1u : 0u; mine = (j == x) ? c : mine; }
        if (sum == G) break;
        __builtin_amdgcn_s_sleep(1);
        if ((++sp & 255u) == 0u) { if (xb_ld(&bar[XB_TMO])) break; if (sp > XB_SPIN_CAP) { atomicAdd(&bar[XB_TMO], 1u); break; } }
    }
    nloc = mine > 0u ? mine : 1u; nx = cnt > 0u ? cnt : 1u;
}

__device__ __forceinline__ void xcd_barrier(const XcdBarrier& b) {
    asm volatile("s_waitcnt vmcnt(0)" ::: "memory");
    __syncthreads();
    if (threadIdx.x == 0) {
        unsigned* bar = b.bar;
        __builtin_amdgcn_s_waitcnt(0);
        unsigned nloc = b.st[0], nx = b.st[1];
        if (nloc == 0u) { xcd_barrier_complete(bar, b.x, nloc, nx); b.st[0] = nloc; b.st[1] = nx; }
        const unsigned old = xb_add(&bar[XB_XSUB(b.x)], 1u);
        const unsigned gen = old / nloc;
        if (old + 1u == (gen + 1u) * nloc) {
            __builtin_amdgcn_fence(__ATOMIC_RELEASE, "agent");
            asm volatile("s_waitcnt vmcnt(0)" ::: "memory");
            const unsigned og = xb_add(&bar[XB_TOP], 1u);
            const unsigned tg = og / nx;
            if (og + 1u == (tg + 1u) * nx) xb_add(&bar[XB_TOPGEN], 1u);
            else XB_SPIN(xb_ld(&bar[XB_TOPGEN]) == tg, bar);
            __builtin_amdgcn_fence(__ATOMIC_ACQUIRE, "agent");
            xb_add(&bar[XB_XGEN(b.x)], 1u);
            asm volatile("s_waitcnt vmcnt(0)" ::: "memory");
        } else {
            XB_SPIN(xb_ld(&bar[XB_XGEN(b.x)]) == gen, bar);
            __builtin_amdgcn_fence(__ATOMIC_ACQUIRE, "agent");
            asm volatile("s_waitcnt vmcnt(0)" ::: "memory");
        }
    }
    __syncthreads();
}

constexpr int NWAVES = 8, NTHREADS = 512;
constexpr int BATCH = 4, SEQ = 2048, D = 2048, M = BATCH * SEQ;
constexpr int NQH = 32, NKVH = 4, HD = 64, QPKV = 8, WINDOW = 128;
constexpr int Q_OFF = 0, K_OFF = 2048, V_OFF = 2304, CB_OFF = 2560, CC_OFF = 4608, CH_OFF = 6656, G_OFF = 8704, IN_W = 12800;
constexpr int PH = 8, PNK = 128, PTOPK = 16, PNE = 16384;
constexpr float LN_EPS = 1e-5f;
constexpr float ALPHA = 1.189207115002721f;

#ifndef MK_PER_PHASE
#define MK_PER_PHASE 0
#endif
constexpr int N_PHASES = 12;

constexpr size_t MiB = 1u << 20;
constexpr size_t WS_CTL = 0, CTL_ZERO_BYTES = 1 * MiB;
constexpr size_t WS_WIN = 1 * MiB;
constexpr size_t WS_WA = 51 * MiB, WS_WC = 59 * MiB, WS_WO = 67 * MiB, WS_WF = 75 * MiB;
constexpr size_t WS_XB = 83 * MiB;
constexpr size_t WS_MERGED = WS_XB;
constexpr size_t WS_Z = 115 * MiB;
constexpr size_t WS_H1 = 115 * MiB;
constexpr size_t WS_H1B = 179 * MiB;
constexpr size_t WS_SC = 211 * MiB;
constexpr size_t WS_EX = 275 * MiB;
constexpr size_t WS_GT = 279 * MiB;
constexpr size_t WS_AO = 315 * MiB, WS_CI = 347 * MiB, WS_TMP = 379 * MiB;
constexpr size_t WS_U8 = 411 * MiB, WS_V8 = 443 * MiB;
constexpr size_t WS_SU = 475 * MiB, WS_SV = WS_SU + 65536;
constexpr size_t WS_PA = WS_SC;
constexpr size_t WS_XQ = 283 * MiB;
constexpr size_t WS_SX = 299 * MiB;
constexpr size_t WS_WB = 380 * MiB;
constexpr size_t WS_ST = 379 * MiB;
constexpr size_t WS_END = 476 * MiB;
constexpr int CW_Q = 12288;
constexpr size_t SLICE_BYTES = (size_t)PNE * 256;
constexpr int CW_BAR = 4096;

constexpr int RING_BYTES = 131072;
constexpr int LDSCTL_OFF = 147456, MISC_OFF = LDSCTL_OFF + 320;
constexpr int LDS_BYTES = LDSCTL_OFF + 512;

typedef float f32x16 __attribute__((ext_vector_type(16)));
typedef unsigned v2u __attribute__((ext_vector_type(2)));
__device__ __forceinline__ float wave_sum(float v) {
#pragma unroll
    for (int o = 1; o < 64; o <<= 1) v += __shfl_xor(v, o);
    return v;
}
__device__ __forceinline__ float vmaxf(float a, float b) { float r; asm("v_max_f32_e32 %0, %1, %2" : "=v"(r) : "v"(a), "v"(b)); return r; }
__device__ __forceinline__ float vminf(float a, float b) { float r; asm("v_min_f32_e32 %0, %1, %2" : "=v"(r) : "v"(a), "v"(b)); return r; }

__device__ __forceinline__ void p0_transpose_item(const float* W, int K, int N, bf16* WT, LAS float* scr, int item, int lane) {
    const int nblk = N / 32, kb = item / nblk, nb = item % nblk, k0 = 64 * kb, n0 = 32 * nb;
#pragma unroll 8
    for (int i = 0; i < 32; ++i) { const int kk = 2 * i + (lane >> 5); scr[kk * 33 + (lane & 31)] = W[(size_t)(k0 + kk) * N + n0 + (lane & 31)]; }
    LDS_WAIT(); asm volatile("" ::: "memory");
    const int c = lane & 7;
#pragma unroll
    for (int j = 0; j < 4; ++j) { const int n = (lane >> 3) + 8 * j; const LAS float* s = scr + (8 * c) * 33 + n;
        v4u o; o.x = pk2(s[0 * 33], s[1 * 33]); o.y = pk2(s[2 * 33], s[3 * 33]); o.z = pk2(s[4 * 33], s[5 * 33]); o.w = pk2(s[6 * 33], s[7 * 33]);
        *(GAS v4u*)(WT + (size_t)(n0 + n) * K + k0 + 8 * c) = o; }
    LDS_WAIT(); asm volatile("" ::: "memory");
}
__device__ __forceinline__ void p0_wf_item(const float* wq, const float* sk, bf16* WfT, LAS unsigned char* lds, int item, int tid) {
    const int hp = item >> 5, dt = item & 31;
    LAS f32x4* SK4 = (LAS f32x4*)lds;
    LAS f32x4* WQ4 = SK4 + 128 * 33;
    const float* skp = sk + (size_t)hp * 128 * 128;
    for (int i = tid; i < 128 * 32; i += NTHREADS) { const int n = i >> 5, c4 = i & 31; SK4[n * 33 + c4] = *(const f32x4*)(skp + n * 128 + 4 * c4); }
    for (int i = tid; i < 64 * 32; i += NTHREADS) { const int r = i >> 5, c4 = i & 31; WQ4[r * 33 + c4] = *(const f32x4*)(wq + (size_t)(64 * dt + r) * 2048 + hp * 128 + 4 * c4); }
    __syncthreads();
    const int td = tid & 15, tn = tid >> 4;
    float acc[4][4];
#pragma unroll
    for (int i = 0; i < 4; ++i)
#pragma unroll
        for (int j = 0; j < 4; ++j) acc[i][j] = 0.f;
#pragma unroll 4
    for (int c4 = 0; c4 < 32; ++c4) {
        f32x4 a[4], b[4];
#pragma unroll
        for (int i = 0; i < 4; ++i) a[i] = SK4[(4 * tn + i) * 33 + c4];
#pragma unroll
        for (int j = 0; j < 4; ++j) b[j] = WQ4[(td + 16 * j) * 33 + c4];
#pragma unroll
        for (int i = 0; i < 4; ++i)
#pragma unroll
            for (int j = 0; j < 4; ++j) acc[i][j] += a[i].x * b[j].x + a[i].y * b[j].y + a[i].z * b[j].z + a[i].w * b[j].w;
    }
#pragma unroll
    for (int i = 0; i < 4; ++i)
#pragma unroll
        for (int j = 0; j < 4; ++j) WfT[(size_t)(hp * 128 + 4 * tn + i) * 2048 + 64 * dt + td + 16 * j] = (bf16)f2bf(acc[i][j]);
    __syncthreads();
}

__device__ __forceinline__ int perm16(int o) { return 8 * ((o >> 2) & 1) + 4 * (o >> 3) + (o & 3); }
__device__ __forceinline__ void attn_unit(int unit, const bf16* z, bf16* ao, const float* sinks, LAS unsigned char* lds, int tid) {
    const int lane = tid & 63, wid = __builtin_amdgcn_readfirstlane(tid >> 6), r32 = lane & 31, hi = lane >> 5;
    const int nb = unit & 15, kvh = (unit >> 4) & 3, b = unit >> 6;
    LAS bf16* Ks = (LAS bf16*)lds;
    LAS bf16* Vt = (LAS bf16*)(lds + 256 * 144);
    const size_t tok0 = (size_t)b * SEQ;
#pragma unroll
    for (int i = 0; i < 4; ++i) {
        const int ci = tid + NTHREADS * i, key = ci >> 3, dc = ci & 7;
        int kpos = 128 * (nb - 1) + key; if (kpos < 0) kpos = 0;
        const bf16* src = z + (tok0 + kpos) * IN_W + K_OFF + kvh * HD + dc * 8;
        const v4u kv = *(const GAS v4u*)src, vv = *(const GAS v4u*)(src + (V_OFF - K_OFF));
        *(LAS v4u*)(Ks + key * 72 + dc * 8) = kv;
        const int pos = (key & ~15) + perm16(key & 15);
        LAS bf16* vp = Vt + (dc * 8) * 264 + pos;
        vp[0 * 264] = (bf16)(vv.x & 0xffffu); vp[1 * 264] = (bf16)(vv.x >> 16); vp[2 * 264] = (bf16)(vv.y & 0xffffu); vp[3 * 264] = (bf16)(vv.y >> 16);
        vp[4 * 264] = (bf16)(vv.z & 0xffffu); vp[5 * 264] = (bf16)(vv.z >> 16); vp[6 * 264] = (bf16)(vv.w & 0xffffu); vp[7 * 264] = (bf16)(vv.w >> 16);
    }
    __syncthreads();
    const int hq = kvh * QPKV + wid;
    const float LOG2E = 1.4426950408889634f;
    const float sink2 = sinks[hq] * LOG2E, sc = 0.125f * LOG2E;
#pragma unroll 1
    for (int qg = 0; qg < 4; ++qg) {
        const size_t tok = tok0 + 128 * nb + 32 * qg + r32;
        bf16x8 qf[4];
#pragma unroll
        for (int ks = 0; ks < 4; ++ks) qf[ks] = *(const GAS bf16x8*)(z + tok * IN_W + Q_OFF + hq * HD + 16 * ks + 8 * hi);
        f32x16 s[5];
#pragma unroll
        for (int kt = 0; kt < 5; ++kt) {
            s[kt] = (f32x16){0.f, 0.f, 0.f, 0.f, 0.f, 0.f, 0.f, 0.f, 0.f, 0.f, 0.f, 0.f, 0.f, 0.f, 0.f, 0.f};
#pragma unroll
            for (int ks = 0; ks < 4; ++ks) {
                const bf16x8 kf = *(const LAS bf16x8*)(Ks + (32 * (qg + kt) + r32) * 72 + 16 * ks + 8 * hi);
                s[kt] = __builtin_amdgcn_mfma_f32_32x32x16_bf16(kf, qf[ks], s[kt], 0, 0, 0);
            }
        }
        float mx = sink2;
#pragma unroll
        for (int kt = 0; kt < 5; ++kt) {
            const bool tile_dead = (nb == 0) && (qg + kt < 4);
#pragma unroll
            for (int r = 0; r < 16; ++r) {
                const int krow = (r & 3) + 8 * (r >> 2) + 4 * hi;
                bool valid = !tile_dead;
                if (kt == 0) valid = valid && (krow > r32);
                if (kt == 4) valid = valid && (krow <= r32);
                const float v = valid ? s[kt][r] * sc : -INFINITY;
                s[kt][r] = v; mx = fmaxf(mx, v);
            }
        }
        mx = fmaxf(mx, __shfl_xor(mx, 32));
        float sum = 0.f;
#pragma unroll
        for (int kt = 0; kt < 5; ++kt)
#pragma unroll
            for (int r = 0; r < 16; ++r) { const float p = __builtin_amdgcn_exp2f(s[kt][r] - mx); s[kt][r] = p; sum += p; }
        sum += __shfl_xor(sum, 32);
        const float inv = 1.0f / (sum + __builtin_amdgcn_exp2f(sink2 - mx));
        f32x16 o[2];
        o[0] = (f32x16){0.f, 0.f, 0.f, 0.f, 0.f, 0.f, 0.f, 0.f, 0.f, 0.f, 0.f, 0.f, 0.f, 0.f, 0.f, 0.f}; o[1] = o[0];
#pragma unroll
        for (int kt = 0; kt < 5; ++kt)
#pragma unroll
            for (int s2 = 0; s2 < 2; ++s2) {
                v4u pw; pw.x = pg8::cvt_pk_bf16(s[kt][8 * s2 + 0], s[kt][8 * s2 + 1]); pw.y = pg8::cvt_pk_bf16(s[kt][8 * s2 + 2], s[kt][8 * s2 + 3]);
                pw.z = pg8::cvt_pk_bf16(s[kt][8 * s2 + 4], s[kt][8 * s2 + 5]); pw.w = pg8::cvt_pk_bf16(s[kt][8 * s2 + 6], s[kt][8 * s2 + 7]);
                const bf16x8 pa = __builtin_bit_cast(bf16x8, pw);
#pragma unroll
                for (int dt = 0; dt < 2; ++dt) {
                    const bf16x8 vf = *(const LAS bf16x8*)(Vt + (32 * dt + r32) * 264 + 32 * (qg + kt) + 16 * s2 + 8 * hi);
                    o[dt] = __builtin_amdgcn_mfma_f32_32x32x16_bf16(vf, pa, o[dt], 0, 0, 0);
                }
            }
        bf16* op = ao + tok * D + hq * HD;
#pragma unroll
        for (int dt = 0; dt < 2; ++dt)
#pragma unroll
            for (int g = 0; g < 4; ++g) {
                v2u w; w.x = pg8::cvt_pk_bf16(o[dt][4 * g + 0] * inv, o[dt][4 * g + 1] * inv); w.y = pg8::cvt_pk_bf16(o[dt][4 * g + 2] * inv, o[dt][4 * g + 3] * inv);
                *(GAS v2u*)(op + 32 * dt + 8 * g + 4 * hi) = w;
            }
    }
    __syncthreads();
}
__device__ __forceinline__ void conv_item(int item, const bf16* z, const float* cw, bf16* ci, int tid) {
    const int c8 = tid & 255, half = tid >> 8, t0 = 32 * item + 16 * half, c0 = 8 * c8;
    float w0[8], w1[8], w2[8], u1[8], u2[8];
#pragma unroll
    for (int e = 0; e < 8; ++e) { w0[e] = cw[c0 + e]; w1[e] = cw[2048 + c0 + e]; w2[e] = cw[4096 + c0 + e]; u1[e] = 0.f; u2[e] = 0.f; }
    if ((t0 & (SEQ - 1)) != 0) {
#pragma unroll
        for (int k = 0; k < 2; ++k) {
            const bf16* zr = z + (size_t)(t0 - 2 + k) * IN_W + c0;
            const v4u a = *(const GAS v4u*)(zr + CC_OFF), h = *(const GAS v4u*)(zr + CH_OFF);
            float u[8];
            u[0] = pg8::bf_lo(a.x) * pg8::bf_lo(h.x); u[1] = pg8::bf_hi(a.x) * pg8::bf_hi(h.x); u[2] = pg8::bf_lo(a.y) * pg8::bf_lo(h.y); u[3] = pg8::bf_hi(a.y) * pg8::bf_hi(h.y);
            u[4] = pg8::bf_lo(a.z) * pg8::bf_lo(h.z); u[5] = pg8::bf_hi(a.z) * pg8::bf_hi(h.z); u[6] = pg8::bf_lo(a.w) * pg8::bf_lo(h.w); u[7] = pg8::bf_hi(a.w) * pg8::bf_hi(h.w);
#pragma unroll
            for (int e = 0; e < 8; ++e) { if (k == 0) u2[e] = u[e]; else u1[e] = u[e]; }
        }
    }
#pragma unroll 4
    for (int i = 0; i < 16; ++i) {
        const bf16* zr = z + (size_t)(t0 + i) * IN_W + c0;
        const v4u a = *(const GAS v4u*)(zr + CC_OFF), h = *(const GAS v4u*)(zr + CH_OFF), bb = *(const GAS v4u*)(zr + CB_OFF);
        float u[8], cb[8], y[8];
        u[0] = pg8::bf_lo(a.x) * pg8::bf_lo(h.x); u[1] = pg8::bf_hi(a.x) * pg8::bf_hi(h.x); u[2] = pg8::bf_lo(a.y) * pg8::bf_lo(h.y); u[3] = pg8::bf_hi(a.y) * pg8::bf_hi(h.y);
        u[4] = pg8::bf_lo(a.z) * pg8::bf_lo(h.z); u[5] = pg8::bf_hi(a.z) * pg8::bf_hi(h.z); u[6] = pg8::bf_lo(a.w) * pg8::bf_lo(h.w); u[7] = pg8::bf_hi(a.w) * pg8::bf_hi(h.w);
        cb[0] = pg8::bf_lo(bb.x); cb[1] = pg8::bf_hi(bb.x); cb[2] = pg8::bf_lo(bb.y); cb[3] = pg8::bf_hi(bb.y); cb[4] = pg8::bf_lo(bb.z); cb[5] = pg8::bf_hi(bb.z); cb[6] = pg8::bf_lo(bb.w); cb[7] = pg8::bf_hi(bb.w);
#pragma unroll
        for (int e = 0; e < 8; ++e) { y[e] = cb[e] * (w0[e] * u2[e] + w1[e] * u1[e] + w2[e] * u[e]); u2[e] = u1[e]; u1[e] = u[e]; }
        v4u o; o.x = pk2(y[0], y[1]); o.y = pk2(y[2], y[3]); o.z = pk2(y[4], y[5]); o.w = pk2(y[6], y[7]);
        *(GAS v4u*)(ci + (size_t)(t0 + i) * D + c0) = o;
    }
}

__device__ __forceinline__ unsigned pack_i8(const f32x4 v) {
    const int a = __float2int_rn(v.x), b = __float2int_rn(v.y), c = __float2int_rn(v.z), d = __float2int_rn(v.w);
    return ((unsigned)a & 0xffu) | (((unsigned)b & 0xffu) << 8) | (((unsigned)c & 0xffu) << 16) | ((unsigned)d << 24);
}
__device__ __forceinline__ void ln1_row(float* r1row, bf16* hbrow, signed char* xqrow, float* sxp, const float* g, const float* bta, int lane) {
    GAS f32x4* xr = (GAS f32x4*)r1row + lane;
    f32x4 v[8]; float s = 0.f;
#pragma unroll
    for (int j = 0; j < 8; ++j) { v[j] = xr[64 * j]; s += (v[j].x + v[j].y) + (v[j].z + v[j].w); }
    const float mean = wave_sum(s) * (1.f / D); float s2 = 0.f;
#pragma unroll
    for (int j = 0; j < 8; ++j) { v[j] = v[j] - mean; s2 += (v[j].x * v[j].x + v[j].y * v[j].y) + (v[j].z * v[j].z + v[j].w * v[j].w); }
    const float rstd = 1.f / sqrtf(wave_sum(s2) * (1.f / D) + LN_EPS);
    GAS v2u* o8 = (GAS v2u*)hbrow + lane; float mx = 0.f;
#pragma unroll
    for (int j = 0; j < 8; ++j) {
        const f32x4 gg = *((const GAS f32x4*)g + lane + 64 * j), bb = *((const GAS f32x4*)bta + lane + 64 * j);
        const f32x4 y = v[j] * rstd * gg + bb; v[j] = y;
        xr[64 * j] = y;
        v2u w; w.x = pk2(y.x, y.y); w.y = pk2(y.z, y.w); o8[64 * j] = w;
        mx = fmaxf(mx, fmaxf(fmaxf(fabsf(y.x), fabsf(y.y)), fmaxf(fabsf(y.z), fabsf(y.w))));
    }
#pragma unroll
    for (int o = 1; o < 64; o <<= 1) mx = fmaxf(mx, __shfl_xor(mx, o));
    const float qs = mx > 0.f ? 127.0f / mx : 1.0f;
    GAS unsigned* q8 = (GAS unsigned*)xqrow + lane;
#pragma unroll
    for (int j = 0; j < 8; ++j) q8[64 * j] = pack_i8(v[j] * qs);
    if (lane == 0) *sxp = mx > 0.f ? mx * (1.0f / 127.0f) : 1.0f;
}

constexpr int TK_ROWF = 136;
constexpr int TK_IDX_OFF = 256 * TK_ROWF * 4;
__device__ __forceinline__ void topk_core(LAS unsigned char* lds, size_t prob0, int pstride, int* experts, float* gates, int tid) {
    LAS float* S = (LAS float*)lds;
    LAS unsigned char* IDX = lds + TK_IDX_OFF;
    const int row = tid >> 1, sub = tid & 1;
    float L[16];
#pragma unroll
    for (int j = 0; j < 16; ++j) L[j] = -INFINITY;
#pragma unroll 2
    for (int i = 0; i < 16; ++i) {
        const int c4 = 2 * i + sub;
        const f32x4 v = *(const LAS f32x4*)(S + row * TK_ROWF + 4 * c4);
#pragma unroll
        for (int e = 0; e < 4; ++e) {
            const float ve = v[e];
            float x = __uint_as_float((__float_as_uint(ve) & ~0x7Fu) | (unsigned)(4 * c4 + e));
#pragma unroll
            for (int j = 0; j < 16; ++j) { const float h = vmaxf(L[j], x); x = vminf(L[j], x); L[j] = h; }
        }
    }
    {
        float P[16];
#pragma unroll
        for (int j = 0; j < 16; ++j) P[j] = __shfl_xor(L[j], 1);
#pragma unroll
        for (int j = 0; j < 16; ++j) L[j] = vmaxf(L[j], P[15 - j]);
#pragma unroll
        for (int st = 8; st >= 1; st >>= 1)
#pragma unroll
            for (int j = 0; j < 16; ++j) if ((j & st) == 0) { const float h = vmaxf(L[j], L[j + st]), l = vminf(L[j], L[j + st]); L[j] = h; L[j + st] = l; }
    }
    if (sub == 0) {
#pragma unroll
        for (int q = 0; q < 4; ++q) {
            unsigned w = 0;
#pragma unroll
            for (int e = 0; e < 4; ++e) w |= (__builtin_bit_cast(unsigned, L[4 * q + e]) & 0x7Fu) << (8 * e);
            *(LAS unsigned*)(IDX + row * 16 + 4 * q) = w;
        }
    }
    float A[16], B[16];
#pragma unroll
    for (int j = 0; j < 16; ++j) { const float o = __shfl_xor(L[j], 2); const bool isb = (tid & 2) != 0; A[j] = isb ? o : L[j]; B[j] = isb ? L[j] : o; }
    float F[16];
#pragma unroll
    for (int j = 0; j < 16; ++j) F[j] = -INFINITY;
#pragma unroll
    for (int i = 0; i < 16; ++i)
#pragma unroll
        for (int j = 0; j < 16; ++j) if ((i + 1) * (j + 1) <= 16) {
            const float sm = A[i] + B[j];
            float x = __builtin_bit_cast(float, (__builtin_bit_cast(unsigned, sm) & ~0xFFu) | (unsigned)(i * 16 + j));
#pragma unroll
            for (int k = 0; k < 16; ++k) { const float h = vmaxf(F[k], x); x = vminf(F[k], x); F[k] = h; }
        }
    __syncthreads();
    if ((tid & 3) == 0) {
        const int rowA = (tid >> 2) * 2, rowB = rowA + 1;
        const size_t prob = prob0 + (size_t)pstride * (tid >> 2);
        float g[16]; int ex[16]; float gs = 0.f;
#pragma unroll
        for (int k = 0; k < 16; ++k) {
            const unsigned code = __builtin_bit_cast(unsigned, F[k]) & 0xFFu;
            const int ia = IDX[rowA * 16 + (code >> 4)], ib = IDX[rowB * 16 + (code & 15)];
            ex[k] = ia * PNK + ib;
            g[k] = __expf(F[k] - F[0]); gs += g[k];
        }
        const float ginv = 1.0f / gs;
#pragma unroll
        for (int q = 0; q < 4; ++q) {
            *(GAS f32x4*)(gates + prob * 16 + 4 * q) = (f32x4){g[4 * q] * ginv, g[4 * q + 1] * ginv, g[4 * q + 2] * ginv, g[4 * q + 3] * ginv};
            typedef int i32x4 __attribute__((ext_vector_type(4)));
            *(GAS i32x4*)(experts + prob * 16 + 4 * q) = (i32x4){ex[4 * q], ex[4 * q + 1], ex[4 * q + 2], ex[4 * q + 3]};
        }
    }
    __syncthreads();
}
__device__ __forceinline__ void topk_pass(int pass, const float* scores, int* experts, float* gates, LAS unsigned char* lds, int tid) {
    LAS float* S = (LAS float*)lds;
    const float* src = scores + (size_t)pass * (256 * 128);
#pragma unroll 4
    for (int i = 0; i < 16; ++i) { const int f4 = tid + NTHREADS * i, row = f4 >> 5, c4 = f4 & 31; *(LAS f32x4*)(S + row * TK_ROWF + 4 * c4) = *(const GAS f32x4*)(src + (size_t)f4 * 4); }
    __syncthreads();
    topk_core(lds, (size_t)pass * 128, 1, experts, gates, tid);
}
struct EpiTopK {
    static constexpr bool PERM = false, AFTER_DRAIN = true;
    int* experts; float* gates;
    __device__ __forceinline__ void fused(pg8::f32x4 (&acc)[2][2][4][2], const pg8::Unit& u, int wr, int wc, int fr, int fq, LAS unsigned char* lds, int wid, int lane) const {
        LAS float* S = (LAS float*)lds;
        const int tid = wid * 64 + lane;
#pragma unroll
        for (int ai = 0; ai < 2; ++ai) {
#pragma unroll
            for (int bj = 0; bj < 2; ++bj)
#pragma unroll
                for (int mm = 0; mm < 4; ++mm)
#pragma unroll
                    for (int n = 0; n < 2; ++n) { const int rl = 64 * wr + 16 * mm + fr; *(LAS pg8::f32x4*)(S + (2 * rl + bj) * TK_ROWF + 32 * wc + 16 * n + 4 * fq) = acc[ai][bj][mm][n]; }
            __syncthreads();
            topk_core(lds, ((size_t)u.pm * 256 + 128 * ai) * PH + u.pn, PH, experts, gates, tid);
        }
    }
};

__device__ __forceinline__ float gelu_erf(float v) { return 0.5f * v * (1.0f + erff(v * 0.70710678118654752f)); }
typedef __bf16 bf16x2_t __attribute__((ext_vector_type(2)));
typedef float f32x2_t __attribute__((ext_vector_type(2)));
__device__ __forceinline__ float dot2bf(bf16x2_t a, unsigned b, float acc) { return __builtin_amdgcn_fdot2_f32_bf16(a, __builtin_bit_cast(bf16x2_t, b), acc, false); }
__device__ __forceinline__ float dot4f8(unsigned w8, unsigned x01, unsigned x23, float acc) {
    acc = dot2bf(__builtin_amdgcn_cvt_scalef32_pk_bf16_fp8(w8, 1.0f, false), x01, acc);
    return dot2bf(__builtin_amdgcn_cvt_scalef32_pk_bf16_fp8(w8, 1.0f, true), x23, acc);
}
__device__ __forceinline__ void axpy4f8(float* y, unsigned w8, float w) {
    const f32x2_t lo = __builtin_amdgcn_cvt_pk_f32_fp8(w8, false), hi = __builtin_amdgcn_cvt_pk_f32_fp8(w8, true);
    y[0] += w * lo.x; y[1] += w * lo.y; y[2] += w * hi.x; y[3] += w * hi.y;
}
__device__ __forceinline__ void row_to_fp8(const float* src, unsigned char* dst, float* inv, int lane) {
    f32x4 v[2][4]; float mx = 0.f;
#pragma unroll
    for (int j = 0; j < 2; ++j)
#pragma unroll
        for (int q = 0; q < 4; ++q) { v[j][q] = *((const GAS f32x4*)src + 4 * (lane + 64 * j) + q);
            mx = fmaxf(mx, fmaxf(fmaxf(fabsf(v[j][q].x), fabsf(v[j][q].y)), fmaxf(fabsf(v[j][q].z), fabsf(v[j][q].w)))); }
#pragma unroll
    for (int o = 1; o < 64; o <<= 1) mx = fmaxf(mx, __shfl_xor(mx, o));
    const float sc = mx > 0.f ? 384.0f / mx : 1.0f;
#pragma unroll
    for (int j = 0; j < 2; ++j) { v4u o;
        int w;
        w = 0; w = __builtin_amdgcn_cvt_pk_fp8_f32(v[j][0].x * sc, v[j][0].y * sc, w, false); w = __builtin_amdgcn_cvt_pk_fp8_f32(v[j][0].z * sc, v[j][0].w * sc, w, true); o.x = (unsigned)w;
        w = 0; w = __builtin_amdgcn_cvt_pk_fp8_f32(v[j][1].x * sc, v[j][1].y * sc, w, false); w = __builtin_amdgcn_cvt_pk_fp8_f32(v[j][1].z * sc, v[j][1].w * sc, w, true); o.y = (unsigned)w;
        w = 0; w = __builtin_amdgcn_cvt_pk_fp8_f32(v[j][2].x * sc, v[j][2].y * sc, w, false); w = __builtin_amdgcn_cvt_pk_fp8_f32(v[j][2].z * sc, v[j][2].w * sc, w, true); o.z = (unsigned)w;
        w = 0; w = __builtin_amdgcn_cvt_pk_fp8_f32(v[j][3].x * sc, v[j][3].y * sc, w, false); w = __builtin_amdgcn_cvt_pk_fp8_f32(v[j][3].z * sc, v[j][3].w * sc, w, true); o.w = (unsigned)w;
        { const int ch = lane + 64 * j; *((GAS v4u*)(dst + (size_t)(ch >> 4) * SLICE_BYTES) + (ch & 15)) = o; } }
    if (lane == 0) *inv = mx > 0.f ? mx * (1.0f / 384.0f) : 1.0f;
}
__device__ __forceinline__ void row_to_i8(const float* src, unsigned char* dst, float* inv, int lane) {
    f32x4 v[2][4]; float mx = 0.f;
#pragma unroll
    for (int j = 0; j < 2; ++j)
#pragma unroll
        for (int q = 0; q < 4; ++q) { v[j][q] = *((const GAS f32x4*)src + 4 * (lane + 64 * j) + q);
            mx = fmaxf(mx, fmaxf(fmaxf(fabsf(v[j][q].x), fabsf(v[j][q].y)), fmaxf(fabsf(v[j][q].z), fabsf(v[j][q].w)))); }
#pragma unroll
    for (int o = 1; o < 64; o <<= 1) mx = fmaxf(mx, __shfl_xor(mx, o));
    const float sc = mx > 0.f ? 127.0f / mx : 1.0f;
#pragma unroll
    for (int j = 0; j < 2; ++j) { v4u o; o.x = pack_i8(v[j][0] * sc); o.y = pack_i8(v[j][1] * sc); o.z = pack_i8(v[j][2] * sc); o.w = pack_i8(v[j][3] * sc);
        { const int ch = lane + 64 * j; *((GAS v4u*)(dst + (size_t)(ch >> 4) * SLICE_BYTES) + (ch & 15)) = o; } }
    if (lane == 0) *inv = mx > 0.f ? mx * (1.0f / 127.0f) : 1.0f;
}
__device__ __forceinline__ float row16_allsum(float a) {
    a += __builtin_bit_cast(float, __builtin_amdgcn_update_dpp(0, __builtin_bit_cast(int, a), 0x128, 0xf, 0xf, false));
    a += __builtin_bit_cast(float, __builtin_amdgcn_update_dpp(0, __builtin_bit_cast(int, a), 0x124, 0xf, 0xf, false));
    a += __builtin_bit_cast(float, __builtin_amdgcn_update_dpp(0, __builtin_bit_cast(int, a), 0x122, 0xf, 0xf, false));
    a += __builtin_bit_cast(float, __builtin_amdgcn_update_dpp(0, __builtin_bit_cast(int, a), 0x121, 0xf, 0xf, false));
    return a;
}
__device__ __forceinline__ int q_pull(unsigned* q, int lane) { int v = 0; if (lane == 0) v = (int)__hip_atomic_fetch_add(q, 1u, __ATOMIC_RELAXED, __HIP_MEMORY_SCOPE_AGENT); return __builtin_amdgcn_readfirstlane(v); }
constexpr int PEER_TG = 8;
__device__ __forceinline__ int row16_allsum_i(int a) {
    a += __builtin_amdgcn_update_dpp(0, a, 0x128, 0xf, 0xf, false);
    a += __builtin_amdgcn_update_dpp(0, a, 0x124, 0xf, 0xf, false);
    a += __builtin_amdgcn_update_dpp(0, a, 0x122, 0xf, 0xf, false);
    a += __builtin_amdgcn_update_dpp(0, a, 0x121, 0xf, 0xf, false);
    return a;
}
#define PA_LOAD(R, IDV, HALF) do { _Pragma("unroll") for (int i_ = 0; i_ < 8; ++i_) { const unsigned e_ = (unsigned)__shfl(IDV, 4 * (i_ + 8 * (HALF)) + g); \
        R[i_] = *(const GAS v4u*)(ub + (e_ * 256u + offc)); } } while (0)
#define PA_COMP(R, HALF) do { _Pragma("unroll") for (int i_ = 0; i_ < 8; ++i_) { int a_ = __builtin_amdgcn_sdot4((int)R[i_].x, (int)xc.x, 0, false); a_ = __builtin_amdgcn_sdot4((int)R[i_].y, (int)xc.y, a_, false); \
        a_ = __builtin_amdgcn_sdot4((int)R[i_].z, (int)xc.z, a_, false); a_ = __builtin_amdgcn_sdot4((int)R[i_].w, (int)xc.w, a_, false); r16[8 * (HALF) + i_] = row16_allsum_i(a_); } } while (0)
__device__ __forceinline__ void peer_a_task(int t0, int s, const signed char* xq, const int* experts, const unsigned char* u8s, int* pa, int lane_) {
    int lane = lane_; asm volatile("" : "+v"(lane));
    const int g = lane >> 4, c = lane & 15;
    const GAS unsigned char* ub = (const GAS unsigned char*)(u8s + (size_t)s * SLICE_BYTES);
    const unsigned offc = 16u * (unsigned)c;
    int idc0 = experts[(size_t)t0 * 128 + lane], idc1 = experts[(size_t)t0 * 128 + lane + 64];
    v4u xc = *(const GAS v4u*)(xq + (size_t)t0 * D + 256 * s + 16 * c);
    v4u RA[8], RB[8];
    PA_LOAD(RA, idc0, 0);
#pragma unroll 1
    for (int tt = 0; tt < PEER_TG; ++tt) {
        const int t = t0 + tt, tn = tt + 1 < PEER_TG ? t + 1 : t;
        const int idn0 = experts[(size_t)tn * 128 + lane], idn1 = experts[(size_t)tn * 128 + lane + 64];
        const v4u xn = *(const GAS v4u*)(xq + (size_t)tn * D + 256 * s + 16 * c);
#pragma unroll 1
        for (int hb = 0; hb < 2; ++hb) {
            const int idv = hb ? idc1 : idc0, idx = hb ? idn0 : idc1;
            int r16[16];
            PA_LOAD(RB, idv, 1); PA_COMP(RA, 0);
            asm volatile("" ::: "memory");
            PA_LOAD(RA, idx, 0); PA_COMP(RB, 1);
            if (c == 15) { typedef int i32x4 __attribute__((ext_vector_type(4))); GAS i32x4* dst = (GAS i32x4*)(pa + ((size_t)t * 8 + s) * 128 + g * 32 + 16 * hb);
#pragma unroll
                for (int q = 0; q < 4; ++q) dst[q] = (i32x4){r16[4 * q], r16[4 * q + 1], r16[4 * q + 2], r16[4 * q + 3]}; }
        }
        idc0 = idn0; idc1 = idn1; xc = xn;
    }
}
__device__ __forceinline__ void peer_w_elem(size_t i, const int* experts, const float* gates, const float* su, const float* sv, const float* sx, const int* pa, float* wb) {
    const size_t t = i >> 7; const int k = (int)(i & 127), pos = (k & 3) * 32 + (k >> 2);
    const int e = experts[i];
    int a = 0;
#pragma unroll
    for (int s2 = 0; s2 < 8; ++s2) a += pa[(t * 8 + s2) * 128 + pos];
    wb[i] = gates[i] * gelu_erf((float)a * (su[e] * sx[t])) * sv[e];
}
#define PB_LOAD(R, IDV, HALF) do { _Pragma("unroll") for (int i_ = 0; i_ < 8; ++i_) { const unsigned e_ = (unsigned)__shfl(IDV, 4 * (i_ + 8 * (HALF)) + g); \
        R[i_] = *(const GAS v4u*)(vb + (e_ * 256u + offc)); } } while (0)
#define PB_COMP(R, WV, HALF) do { _Pragma("unroll") for (int i_ = 0; i_ < 8; ++i_) { const float wk_ = __shfl(WV, 4 * (i_ + 8 * (HALF)) + g); \
        axpy4f8(&ya[0], R[i_].x, wk_); axpy4f8(&ya[4], R[i_].y, wk_); axpy4f8(&ya[8], R[i_].z, wk_); axpy4f8(&ya[12], R[i_].w, wk_); } } while (0)
__device__ __forceinline__ void peer_b_task(int t0, int s, const float* h1, const int* experts, const float* wb, const unsigned char* v8s, float* out, float* st, int lane_) {
    int lane = lane_; asm volatile("" : "+v"(lane));
    const int g = lane >> 4, c = lane & 15;
    const GAS unsigned char* vb = (const GAS unsigned char*)(v8s + (size_t)s * SLICE_BYTES);
    const unsigned offc = 16u * (unsigned)c;
    int idc0 = experts[(size_t)t0 * 128 + lane], idc1 = experts[(size_t)t0 * 128 + lane + 64];
    float wc0 = wb[(size_t)t0 * 128 + lane], wc1 = wb[(size_t)t0 * 128 + lane + 64];
    v4u RA[8], RB[8];
    PB_LOAD(RA, idc0, 0);
#pragma unroll 1
    for (int tt = 0; tt < PEER_TG; ++tt) {
        const int t = t0 + tt, tn = tt + 1 < PEER_TG ? t + 1 : t;
        const int idn0 = experts[(size_t)tn * 128 + lane], idn1 = experts[(size_t)tn * 128 + lane + 64];
        const float wn0 = wb[(size_t)tn * 128 + lane], wn1 = wb[(size_t)tn * 128 + lane + 64];
        float ya[16];
#pragma unroll
        for (int e = 0; e < 16; ++e) ya[e] = 0.f;
#pragma unroll 1
        for (int hb = 0; hb < 2; ++hb) {
            const int idv = hb ? idc1 : idc0, idx = hb ? idn0 : idc1; const float wv = hb ? wc1 : wc0;
            PB_LOAD(RB, idv, 1); PB_COMP(RA, wv, 0);
            asm volatile("" ::: "memory");
            PB_LOAD(RA, idx, 0); PB_COMP(RB, wv, 1);
        }
#pragma unroll
        for (int e = 0; e < 16; ++e) { ya[e] += __shfl_xor(ya[e], 16); ya[e] += __shfl_xor(ya[e], 32); }
        const GAS f32x4* hp = (const GAS f32x4*)(h1 + (size_t)t * D + 256 * s + 16 * c);
        float sm = 0.f, sq = 0.f; f32x4 r[4];
#pragma unroll
        for (int q = 0; q < 4; ++q) { r[q] = hp[q] * ALPHA + (f32x4){ya[4 * q], ya[4 * q + 1], ya[4 * q + 2], ya[4 * q + 3]};
            sm += (r[q].x + r[q].y) + (r[q].z + r[q].w); sq += (r[q].x * r[q].x + r[q].y * r[q].y) + (r[q].z * r[q].z + r[q].w * r[q].w); }
        sm = row16_allsum(sm); sq = row16_allsum(sq);
        if (g == 0) { GAS f32x4* op = (GAS f32x4*)(out + (size_t)t * D + 256 * s + 16 * c);
#pragma unroll
            for (int q = 0; q < 4; ++q) op[q] = r[q];
            if (c == 0) { st[((size_t)t * 8 + s) * 2] = sm; st[((size_t)t * 8 + s) * 2 + 1] = sq; } }
        idc0 = idn0; idc1 = idn1; wc0 = wn0; wc1 = wn1;
    }
}
__device__ __forceinline__ void peer_c_row(int t, float* out, const float* st, const float* g2, const float* b2, int lane) {
    float sm = 0.f, sq = 0.f;
#pragma unroll
    for (int s = 0; s < 8; ++s) { sm += st[((size_t)t * 8 + s) * 2]; sq += st[((size_t)t * 8 + s) * 2 + 1]; }
    const float mean = sm * (1.f / D), var = sq * (1.f / D) - mean * mean, rstd = 1.f / sqrtf(fmaxf(var, 0.f) + LN_EPS);
    GAS f32x4* xr = (GAS f32x4*)(out + (size_t)t * D) + lane;
#pragma unroll
    for (int j = 0; j < 8; ++j) { const f32x4 v = xr[64 * j]; const f32x4 gg = *((const GAS f32x4*)g2 + lane + 64 * j), bb = *((const GAS f32x4*)b2 + lane + 64 * j);
        xr[64 * j] = (v - mean) * rstd * gg + bb; }
}

struct Args { const float* in[16]; float* out; unsigned char* ws; int ph_lo, ph_hi; };
__global__ void __launch_bounds__(NTHREADS, 2) mk_fwd(Args args) {
    extern __shared__ __attribute__((aligned(16))) unsigned char lds_raw[];
    LAS unsigned char* lds = (LAS unsigned char*)lds_raw;
    volatile LAS unsigned* MISC = (volatile LAS unsigned*)(lds + MISC_OFF);
    const int tid0 = threadIdx.x;
    const int G = gridDim.x, bx = blockIdx.x;
    unsigned char* ws = args.ws;
    gu32* ctl = (gu32*)(ws + WS_CTL);
#define IN_(i) (args.in[i])
#define x_in IN_(0)
#define w_in IN_(1)
#define b_gate IN_(2)
#define sinks IN_(3)
#define conv_w IN_(4)
#define w_ao IN_(5)
#define w_co IN_(6)
#define w_o IN_(7)
#define ln1_g IN_(8)
#define ln1_b IN_(9)
#define w_q IN_(10)
#define sub_keys IN_(11)
#define peer_u IN_(12)
#define peer_v IN_(13)
#define ln2_g IN_(14)
#define ln2_b IN_(15)
#define WinT ((bf16*)(ws + WS_WIN))
#define WaT ((bf16*)(ws + WS_WA))
#define WcT ((bf16*)(ws + WS_WC))
#define WoT ((bf16*)(ws + WS_WO))
#define WfT ((bf16*)(ws + WS_WF))
#define XB ((bf16*)(ws + WS_XB))
#define MERGED ((bf16*)(ws + WS_MERGED))
#define Z ((bf16*)(ws + WS_Z))
#define H1 ((float*)(ws + WS_H1))
#define H1B ((bf16*)(ws + WS_H1B))
#define SC ((float*)(ws + WS_SC))
#define EX ((int*)(ws + WS_EX))
#define GT ((float*)(ws + WS_GT))
#define AO ((bf16*)(ws + WS_AO))
#define CI ((bf16*)(ws + WS_CI))
#define TMP ((bf16*)(ws + WS_TMP))
#define U8 ((unsigned char*)(ws + WS_U8))
#define V8 ((unsigned char*)(ws + WS_V8))
#define SU ((float*)(ws + WS_SU))
#define SV ((float*)(ws + WS_SV))
#define PA ((int*)(ws + WS_PA))
#define ST ((float*)(ws + WS_ST))
#define WB ((float*)(ws + WS_WB))
#define XQ ((signed char*)(ws + WS_XQ))
#define SX ((float*)(ws + WS_SX))
    for (int u = tid0; u < (LDS_BYTES - LDSCTL_OFF) / 4; u += NTHREADS) ((LAS unsigned*)(lds + LDSCTL_OFF))[u] = 0u;
    __syncthreads();
    XcdBarrier bar; bar.bar = (unsigned*)(ctl + CW_BAR); bar.x = 0; bar.st = nullptr;
    if (!MK_PER_PHASE) bar = xcd_barrier_post((unsigned*)(ctl + CW_BAR), MISC + 8);
    const int lo = args.ph_lo, hi = args.ph_hi;
#ifndef PH_MASK
#define PH_MASK 0xFFF
#endif
#define IN(k) (((PH_MASK >> (k)) & 1) && lo <= (k) && (k) < hi)
#define SEAM(k) do { if (IN(k) && IN((k) + 1)) xcd_barrier(bar); } while (0)
#ifndef DBL_MASK
#define DBL_MASK 0
#endif
#define REP(k) for (int rep_ = 0; rep_ < 1 + ((DBL_MASK >> (k)) & 1); ++rep_)
#define PHASE_TID() int tid = tid0; asm volatile("" : "+v"(tid)); const int lane = tid & 63, wave = __builtin_amdgcn_readfirstlane(tid >> 6); (void)lane; (void)wave

    if (IN(0)) REP(0) {
        PHASE_TID();
        for (int it = bx; it < 16 * 32; it += G) p0_wf_item(w_q, sub_keys, WfT, lds, it, tid);
        LAS float* scr = (LAS float*)(lds + wave * 16384);
        const int gw = bx * NWAVES + wave, NGW = G * NWAVES;
        constexpr int I_IN = (D / 64) * (IN_W / 32), I_SQ = (D / 64) * (D / 32);
        for (int it = gw; it < I_IN + 3 * I_SQ; it += NGW) {
            int r = it;
            if (r < I_IN) { p0_transpose_item(w_in, D, IN_W, WinT, scr, r, lane); continue; } r -= I_IN;
            if (r < I_SQ) { p0_transpose_item(w_ao, D, D, WaT, scr, r, lane); continue; } r -= I_SQ;
            if (r < I_SQ) { p0_transpose_item(w_co, D, D, WcT, scr, r, lane); continue; } r -= I_SQ;
            p0_transpose_item(w_o, D, D, WoT, scr, r, lane);
        }
        const size_t n8 = (size_t)M * D / 8;
        for (size_t i = (size_t)bx * NTHREADS + tid; i < n8; i += (size_t)G * NTHREADS) {
            const f32x4 a = *((const GAS f32x4*)x_in + 2 * i), b = *((const GAS f32x4*)x_in + 2 * i + 1);
            v4u o; o.x = pk2(a.x, a.y); o.y = pk2(a.z, a.w); o.z = pk2(b.x, b.y); o.w = pk2(b.z, b.w);
            *((GAS v4u*)XB + i) = o;
        }
    }
    SEAM(0);
    if (IN(1)) REP(1) {
        pg8::Gemm g{XB, WinT, M, IN_W, D}; pg8::StaticOrder S; S.init(M, IN_W, G, bx);
        pg8::EpiBf16 E{Z, IN_W};
        pg8::gemm_phase<pg8::EpiBf16, pg8::StaticOrder, true, true>(lds, g, S, E);
        { PHASE_TID();
#ifndef DBL_CONV
#define DBL_CONV 0
#endif
          for (int rep2 = 0; rep2 <= DBL_CONV; ++rep2)
          for (;;) { const int ch = q_pull((unsigned*)(ctl + CW_Q + 64 * (32 + rep2)), lane); if (ch >= 2 * PNE / 16) break;
#pragma unroll 1
              for (int rr = 0; rr < 16; ++rr) { const int r = ch * 16 + rr; const bool sec = r >= PNE; const int e = sec ? r - PNE : r;
                  if (sec) row_to_fp8(peer_v + (size_t)e * D, V8 + (size_t)e * 256, SV + e, lane); else row_to_i8(peer_u + (size_t)e * D, U8 + (size_t)e * 256, SU + e, lane); } } }
    }
    SEAM(1);
    if (IN(2)) REP(2) {
        PHASE_TID();
        for (int u = bx; u < BATCH * NKVH * 16; u += G) attn_unit(u, Z, AO, sinks, lds, tid);
        for (int it = bx; it < M / 32; it += G) conv_item(it, Z, conv_w, CI, tid);
    }
    SEAM(2);
    if (IN(3)) REP(3) {
        pg8::StaticOrder S; S.init(M, D, G, bx);
        { pg8::Gemm g{AO, WaT, M, D, D}; pg8::EpiGate<0> E{TMP, nullptr, Z + G_OFF, b_gate, D, IN_W};
          pg8::gemm_phase<pg8::EpiGate<0>, pg8::StaticOrder, true, true>(lds, g, S, E); }
        { pg8::Gemm g{CI, WcT, M, D, D}; pg8::EpiGate<1> E{MERGED, TMP, Z + G_OFF + D, b_gate + D, D, IN_W};
          pg8::gemm_phase<pg8::EpiGate<1>, pg8::StaticOrder, true, true>(lds, g, S, E); }
    }
    SEAM(3);
    if (IN(4)) REP(4) {
        pg8::Gemm g{MERGED, WoT, M, D, D}; pg8::StaticOrder S; S.init(M, D, G, bx);
        pg8::EpiF32 E{H1, D, x_in, ALPHA};
        pg8::gemm_phase<pg8::EpiF32, pg8::StaticOrder, true, true>(lds, g, S, E);
    }
    SEAM(4);
    if (IN(5)) REP(5) {
        PHASE_TID();
        const int gw = bx * NWAVES + wave, NGW = G * NWAVES;
        for (int m = gw; m < M; m += NGW) ln1_row(H1 + (size_t)m * D, H1B + (size_t)m * D, XQ + (size_t)m * D, SX + m, ln1_g, ln1_b, lane);
    }
    SEAM(5);
    if (IN(6)) REP(6) {
        pg8::Gemm g{H1B, WfT, M, D, D}; pg8::StaticOrder S; S.init(M, D, G, bx);
        if (G == 256) { EpiTopK E{EX, GT}; pg8::gemm_phase<EpiTopK, pg8::StaticOrder, false, true>(lds, g, S, E); }
        else { pg8::EpiF32 E{SC, D, nullptr, 0.f}; pg8::gemm_phase<pg8::EpiF32, pg8::StaticOrder, true, true>(lds, g, S, E); }
    }
    if (G != 256) SEAM(6);
    if (IN(7)) REP(7) {
        PHASE_TID();
        if (G != 256) for (int p = bx; p < (M * PH) / 128; p += G) topk_pass(p, SC, EX, GT, lds, tid);
    }
    SEAM(7);
    if (IN(8)) REP(8) {
        PHASE_TID();
        const int xcc = (int)(xb_xcc_id() & 7u);
#pragma unroll 1
        for (int sl = 0; sl < 8; ++sl) { const int s = (xcc + sl) & 7;
            for (;;) { const int tg = q_pull((unsigned*)(ctl + CW_Q + 64 * (s + 16 * rep_)), lane); if (tg >= M / PEER_TG) break;
                peer_a_task(tg * PEER_TG, s, XQ, EX, U8, PA, lane); } }
    }
    SEAM(8);
    if (IN(9)) REP(9) {
        PHASE_TID();
        for (size_t i = (size_t)bx * NTHREADS + tid; i < (size_t)M * 128; i += (size_t)G * NTHREADS) peer_w_elem(i, EX, GT, SU, SV, SX, PA, WB);
    }
    SEAM(9);
    if (IN(10)) REP(10) {
        PHASE_TID();
        const int xcc = (int)(xb_xcc_id() & 7u);
#pragma unroll 1
        for (int sl = 0; sl < 8; ++sl) { const int s = (xcc + sl) & 7;
            for (;;) { const int tg = q_pull((unsigned*)(ctl + CW_Q + 64 * (8 + s + 16 * rep_)), lane); if (tg >= M / PEER_TG) break;
                peer_b_task(tg * PEER_TG, s, H1, EX, WB, V8, args.out, ST, lane); } }
    }
    SEAM(10);
    if (IN(11)) REP(11) {
        PHASE_TID();
        const int gw = bx * NWAVES + wave, NGW = G * NWAVES;
        for (int t = gw; t < M; t += NGW) peer_c_row(t, args.out, ST, ln2_g, ln2_b, lane);
    }
#undef IN
#undef SEAM
}

extern "C" void kernel_launch(void* const* d_in, const int* in_sizes, int n_in, void* d_out, int out_size, void* d_ws, size_t ws_size, hipStream_t stream) {
    static int grid = 0;
    if (grid == 0) {
        if (n_in != 16 || out_size != M * D || ws_size < WS_END) { fprintf(stderr, "kernel_launch: unexpected shapes (n_in %d out %d ws %zu)\n", n_in, out_size, ws_size); grid = -1; return; }
        int dev = 0, cus = 0, per_cu = 0;
        if (hipGetDevice(&dev) != hipSuccess || hipDeviceGetAttribute(&cus, hipDeviceAttributeMultiprocessorCount, dev) != hipSuccess) { grid = -1; return; }
        if (hipFuncSetAttribute((const void*)mk_fwd, hipFuncAttributeMaxDynamicSharedMemorySize, LDS_BYTES) != hipSuccess) { fprintf(stderr, "kernel_launch: hipFuncSetAttribute failed\n"); grid = -1; return; }
        if (hipOccupancyMaxActiveBlocksPerMultiprocessor(&per_cu, (const void*)mk_fwd, NTHREADS, LDS_BYTES) != hipSuccess || per_cu < 1) { fprintf(stderr, "kernel_launch: occupancy query says %d\n", per_cu); per_cu = 1; }
        (void)hipGetLastError();
        if (per_cu > 1) per_cu = 1;
        grid = cus * per_cu;
    }
    if (grid < 0) return;
    if (hipMemsetAsync((char*)d_ws + WS_CTL, 0, CTL_ZERO_BYTES, stream) != hipSuccess) { fprintf(stderr, "kernel_launch: memset failed\n"); return; }
    Args a{};
    for (int i = 0; i < 16; ++i) a.in[i] = (const float*)d_in[i];
    a.out = (float*)d_out; a.ws = (unsigned char*)d_ws;
#if MK_PER_PHASE
    for (int p = 0; p < N_PHASES; ++p) { a.ph_lo = p; a.ph_hi = p + 1; hipLaunchKernelGGL(mk_fwd, dim3(grid), dim3(NTHREADS), LDS_BYTES, stream, a); }
#else
    a.ph_lo = 0; a.ph_hi = N_PHASES;
    void* kargs[] = {&a};
    hipError_t e = hipLaunchCooperativeKernel((const void*)mk_fwd, dim3(grid), dim3(NTHREADS), kargs, LDS_BYTES, stream);
    if (e != hipSuccess) fprintf(stderr, "kernel_launch: cooperative launch failed: %s (grid %d)\n", hipGetErrorString(e), grid);
#endif
}
```

```cpp
#include <hip/hip_runtime.h>
#include <cstdio>
#include <cstdint>
namespace pg8 {
#define PG8_LAS __attribute__((address_space(3)))
typedef unsigned short bf16_t;
typedef short bf16x8 __attribute__((ext_vector_type(8)));
typedef float f32x4 __attribute__((ext_vector_type(4)));
typedef unsigned u32x4 __attribute__((ext_vector_type(4)));
constexpr int BM = 256, BK = 64, HALF = 128, HTB = HALF * BK * 2  , STAGE_BYTES = 8 * HTB, NXCD = 8, WGM = 8;

__host__ __device__ __forceinline__ int lds_byte(int r, int c) { const int st = (r >> 4) * 2 + (c >> 5), rr = r & 15, cc = c & 31, ob = rr * 64 + cc * 2; return st * 1024 + (ob ^ (((ob >> 9) & 1) << 5)); }
__host__ __device__ __forceinline__ void stage_rc(int b, int& R, int& C) { const int st = b / 1024, sb = b % 1024, swz = sb ^ (((sb >> 9) & 1) << 5); R = (st >> 1) * 16 + swz / 64; C = (st & 1) * 32 + (swz % 64) / 2; }
__host__ __device__ __forceinline__ int perm32(int rho) { const int n = rho >> 4, i = rho & 15; return 8 * (i >> 2) + 4 * n + (i & 3); }

struct Unit { int pm, pn; };
struct Gemm { const bf16_t* A; const bf16_t* Bt; int M, N, K; };

struct StaticOrder {
    int nM, nN, nwg, G, c;
    __host__ __device__ void init(int M, int N, int G_, int c_) { nM = M / BM; nN = N / BM; nwg = nM * nN; G = G_; c = c_; }
    __host__ __device__ bool next(int i, Unit& u) const {
        const long L = (long)i * G + c; if (L >= nwg) return false;
        int wgid = (int)L; { const int q = nwg / NXCD, r = nwg % NXCD, xcd = wgid % NXCD, off = wgid / NXCD; wgid = (xcd < r ? xcd * (q + 1) : r * (q + 1) + (xcd - r) * q) + off; }
        const int nig = WGM * nN, gid = wgid / nig, fm = gid * WGM, gsz = (nM - fm) < WGM ? (nM - fm) : WGM;
        u.pm = fm + ((wgid % nig) % gsz); u.pn = (wgid % nig) / gsz; return true;
    }
    __device__ __forceinline__ void a_ready(const Unit&) const {}
    __device__ __forceinline__ void done(const Unit&) const {}
};


__device__ __forceinline__ unsigned cvt_pk_bf16(float lo, float hi) { unsigned r; asm volatile("v_cvt_pk_bf16_f32 %0, %1, %2" : "=v"(r) : "v"(lo), "v"(hi)); return r; }
__device__ __forceinline__ float bf_lo(unsigned w) { return __builtin_bit_cast(float, w << 16); }
__device__ __forceinline__ float bf_hi(unsigned w) { return __builtin_bit_cast(float, w & 0xffff0000u); }
__device__ __forceinline__ float sigmoidf_(float x) { return __builtin_amdgcn_rcpf(1.0f + __expf(-x)); }

struct EpiBf16 {
    static constexpr bool PERM = true, AFTER_DRAIN = false;
    bf16_t* O; int ldc;
    __device__ __forceinline__ void operator()(const f32x4 (&acc)[2][2][4][2], const Unit& u, int wr, int wc, int fr, int fq) const {
        const int row0 = u.pm * BM + wr * 64 + fr, col0 = u.pn * BM + wc * 32 + 8 * fq;
#pragma unroll
        for (int ai = 0; ai < 2; ++ai)
#pragma unroll
            for (int m = 0; m < 4; ++m) { bf16_t* rowp = O + (size_t)(row0 + ai * HALF + m * 16) * ldc + col0;
#pragma unroll
                for (int bj = 0; bj < 2; ++bj) { const f32x4 v0 = acc[ai][bj][m][0], v1 = acc[ai][bj][m][1];
                    u32x4 w; w.x = cvt_pk_bf16(v0[0], v0[1]); w.y = cvt_pk_bf16(v0[2], v0[3]); w.z = cvt_pk_bf16(v1[0], v1[1]); w.w = cvt_pk_bf16(v1[2], v1[3]);
                    *(u32x4*)(rowp + bj * HALF) = w; } }
    }
};
template <int SECOND> struct EpiGate {
    static constexpr bool PERM = true, AFTER_DRAIN = false;
    bf16_t* O; const bf16_t* T; const bf16_t* Zg; const float* bg; int ldc, ldz;
    __device__ __forceinline__ void operator()(const f32x4 (&acc)[2][2][4][2], const Unit& u, int wr, int wc, int fr, int fq) const {
        const int row0 = u.pm * BM + wr * 64 + fr, col0 = u.pn * BM + wc * 32 + 8 * fq;
        f32x4 bv[2][2];
#pragma unroll
        for (int bj = 0; bj < 2; ++bj)
#pragma unroll
            for (int n = 0; n < 2; ++n) bv[bj][n] = *(const f32x4*)(bg + col0 + bj * HALF + 4 * n);
#pragma unroll
        for (int ai = 0; ai < 2; ++ai)
#pragma unroll
            for (int m = 0; m < 4; ++m) { const size_t row = (size_t)(row0 + ai * HALF + m * 16);
#pragma unroll
                for (int bj = 0; bj < 2; ++bj) { const int c = col0 + bj * HALF;
                    const u32x4 zg = *(const u32x4*)(Zg + row * ldz + c);
                    f32x4 v0 = acc[ai][bj][m][0], v1 = acc[ai][bj][m][1];
                    v0[0] *= sigmoidf_(bf_lo(zg.x) + bv[bj][0][0]); v0[1] *= sigmoidf_(bf_hi(zg.x) + bv[bj][0][1]);
                    v0[2] *= sigmoidf_(bf_lo(zg.y) + bv[bj][0][2]); v0[3] *= sigmoidf_(bf_hi(zg.y) + bv[bj][0][3]);
                    v1[0] *= sigmoidf_(bf_lo(zg.z) + bv[bj][1][0]); v1[1] *= sigmoidf_(bf_hi(zg.z) + bv[bj][1][1]);
                    v1[2] *= sigmoidf_(bf_lo(zg.w) + bv[bj][1][2]); v1[3] *= sigmoidf_(bf_hi(zg.w) + bv[bj][1][3]);
                    if (SECOND) { const u32x4 t = *(const u32x4*)(T + row * ldc + c);
                        v0[0] += bf_lo(t.x); v0[1] += bf_hi(t.x); v0[2] += bf_lo(t.y); v0[3] += bf_hi(t.y);
                        v1[0] += bf_lo(t.z); v1[1] += bf_hi(t.z); v1[2] += bf_lo(t.w); v1[3] += bf_hi(t.w); }
                    u32x4 w; w.x = cvt_pk_bf16(v0[0], v0[1]); w.y = cvt_pk_bf16(v0[2], v0[3]); w.z = cvt_pk_bf16(v1[0], v1[1]); w.w = cvt_pk_bf16(v1[2], v1[3]);
                    *(u32x4*)(O + row * ldc + c) = w; } }
    }
};
struct EpiF32 {
    static constexpr bool PERM = false, AFTER_DRAIN = false;
    float* C; int ldc; const float* R; float scale;
    __device__ __forceinline__ void operator()(const f32x4 (&acc)[2][2][4][2], const Unit& u, int wr, int wc, int fr, int fq) const {
        const int row0 = u.pm * BM + wr * 64 + fr, col0 = u.pn * BM + wc * 32 + 4 * fq;
#pragma unroll
        for (int ai = 0; ai < 2; ++ai)
#pragma unroll
            for (int m = 0; m < 4; ++m) { const size_t off = (size_t)(row0 + ai * HALF + m * 16) * ldc + col0;
#pragma unroll
                for (int bj = 0; bj < 2; ++bj)
#pragma unroll
                    for (int n = 0; n < 2; ++n) { f32x4 v = acc[ai][bj][m][n];
                        if (R) v += *(const f32x4*)(R + off + bj * HALF + n * 16) * scale;
                        *(f32x4*)(C + off + bj * HALF + n * 16) = v; } }
    }
};
struct EpiResBf16 {
    static constexpr bool PERM = true, AFTER_DRAIN = false;
    bf16_t* O; int ldc; const float* R; float scale;
    __device__ __forceinline__ void operator()(const f32x4 (&acc)[2][2][4][2], const Unit& u, int wr, int wc, int fr, int fq) const {
        const int row0 = u.pm * BM + wr * 64 + fr, col0 = u.pn * BM + wc * 32 + 8 * fq;
#pragma unroll
        for (int ai = 0; ai < 2; ++ai)
#pragma unroll
            for (int m = 0; m < 4; ++m) { const size_t off = (size_t)(row0 + ai * HALF + m * 16) * ldc + col0;
#pragma unroll
                for (int bj = 0; bj < 2; ++bj) { const f32x4 r0 = *(const f32x4*)(R + off + bj * HALF), r1 = *(const f32x4*)(R + off + bj * HALF + 4);
                    const f32x4 v0 = acc[ai][bj][m][0] + r0 * scale, v1 = acc[ai][bj][m][1] + r1 * scale;
                    u32x4 w; w.x = cvt_pk_bf16(v0[0], v0[1]); w.y = cvt_pk_bf16(v0[2], v0[3]); w.z = cvt_pk_bf16(v1[0], v1[1]); w.w = cvt_pk_bf16(v1[2], v1[3]);
                    *(u32x4*)(O + off + bj * HALF) = w; } }
    }
};

template <class Epi, class Sched, bool ALIGN_EPI = false, bool SP2 = false>
__device__ __forceinline__ void gemm_phase(PG8_LAS unsigned char* lds, const Gemm g, const Sched& S, const Epi& E) {
    int tid_ = threadIdx.x; asm volatile("" : "+v"(tid_));
    const int tid = tid_, wid = __builtin_amdgcn_readfirstlane(tid >> 6), lane = tid & 63, wr = wid >> 2, wc = wid & 3, fr = lane & 15, fq = lane >> 4;
    const int K = g.K, nt = K / BK;
    unsigned voffA[2], voffB[2];
#pragma unroll
    for (int i = 0; i < 2; ++i) { int R, C; stage_rc(tid * 16 + i * 8192, R, C); const int Rb = Epi::PERM ? ((R & ~31) + perm32(R & 31)) : R;
        voffA[i] = (unsigned)(R * K + C) * 2u; voffB[i] = (unsigned)(Rb * K + C) * 2u; }
    const size_t kstep = (size_t)(BK * 2);
    const size_t hstep = (size_t)HALF * K * 2;
    const size_t tstep = 2 * hstep;
    const unsigned ldsw = (unsigned)wid * 1024u;
    const int aoff = lds_byte(wr * 64 + fr, fq * 8), boff = lds_byte(wc * 32 + fr, fq * 8);
#define PG8_SA(b, h) (((b) * 2 + (h)) * HTB)
#define PG8_SB(b, h) ((4 + (b) * 2 + (h)) * HTB)
#define PG8_STAGE(bufoff, gbase, voff) do { _Pragma("unroll") for (int _i = 0; _i < 2; ++_i) \
        __builtin_amdgcn_global_load_lds((const unsigned*)((const char*)(gbase) + (voff)[_i]), (PG8_LAS unsigned*)(lds + (bufoff) + ldsw + _i * 8192), 16, 0, 0); } while (0)
#define PG8_LDA(dst, b, h) do { _Pragma("unroll") for (int m = 0; m < 4; ++m) _Pragma("unroll") for (int k = 0; k < 2; ++k) dst[m][k] = *(const PG8_LAS bf16x8*)(lds + PG8_SA(b, h) + aoff + m * 2048 + k * 1024); } while (0)
#define PG8_LDB(dst, b, h) do { _Pragma("unroll") for (int n = 0; n < 2; ++n) _Pragma("unroll") for (int k = 0; k < 2; ++k) dst[n][k] = *(const PG8_LAS bf16x8*)(lds + PG8_SB(b, h) + boff + n * 2048 + k * 1024); } while (0)
#define PG8_MMA(ai, bj, At, Bt) do { __builtin_amdgcn_s_setprio(1); _Pragma("unroll") for (int m = 0; m < 4; ++m) _Pragma("unroll") for (int n = 0; n < 2; ++n) _Pragma("unroll") for (int k = 0; k < 2; ++k) \
        acc[ai][bj][m][n] = __builtin_amdgcn_mfma_f32_16x16x32_bf16(Bt[n][k], At[m][k], acc[ai][bj][m][n], 0, 0, 0); __builtin_amdgcn_s_setprio(0); } while (0)
#define PG8_WAIT_V(n) asm volatile("s_waitcnt vmcnt(" #n ")" ::: "memory")
#define PG8_WAIT_L(n) asm volatile("s_waitcnt lgkmcnt(" #n ")" ::: "memory")
#define PG8_BAR __builtin_amdgcn_s_barrier()
#define PG8_SCHED __builtin_amdgcn_sched_barrier(0)
    Unit cur, nxt; int ui = 0;
    if (!S.next(0, cur)) return;
    f32x4 acc[2][2][4][2];
#pragma unroll
    for (int a = 0; a < 2; ++a)
#pragma unroll
        for (int b = 0; b < 2; ++b)
#pragma unroll
            for (int m = 0; m < 4; ++m)
#pragma unroll
                for (int n = 0; n < 2; ++n) acc[a][b][m][n] = (f32x4){0.f, 0.f, 0.f, 0.f};
    bf16x8 At[4][2], B0[2][2], B1[2][2];
    const char* cA = (const char*)g.A + (size_t)cur.pm * tstep; const char* cB = (const char*)g.Bt + (size_t)cur.pn * tstep;
    S.a_ready(cur);
    if constexpr (SP2) {
        PG8_STAGE(PG8_SB(0, 0), cB, voffB); PG8_STAGE(PG8_SB(0, 1), cB + hstep, voffB); PG8_STAGE(PG8_SA(0, 0), cA, voffA); PG8_STAGE(PG8_SA(0, 1), cA + hstep, voffA);
        if (wr == 1) PG8_BAR;
        PG8_WAIT_V(2); PG8_BAR;
        PG8_STAGE(PG8_SB(1, 0), cB + kstep, voffB); PG8_STAGE(PG8_SA(1, 0), cA + kstep, voffA); PG8_STAGE(PG8_SB(1, 1), cB + hstep + kstep, voffB);
        PG8_WAIT_V(6); PG8_BAR;
    } else {
        PG8_STAGE(PG8_SB(0, 0), cB, voffB); PG8_STAGE(PG8_SA(0, 0), cA, voffA); PG8_STAGE(PG8_SB(0, 1), cB + hstep, voffB); PG8_STAGE(PG8_SA(0, 1), cA + hstep, voffA);
        if (wr == 1) PG8_BAR;
        PG8_WAIT_V(4); PG8_BAR;
        PG8_STAGE(PG8_SB(1, 0), cB + kstep, voffB); PG8_STAGE(PG8_SA(1, 0), cA + kstep, voffA); PG8_STAGE(PG8_SB(1, 1), cB + hstep + kstep, voffB);
        PG8_WAIT_V(6); PG8_BAR;
    }
    for (;;) {
        const bool has_next = S.next(ui + 1, nxt);
        const char* nA = has_next ? (const char*)g.A + (size_t)nxt.pm * tstep : cA; const char* nB = has_next ? (const char*)g.Bt + (size_t)nxt.pn * tstep : cB;
        for (int t = 0; t < nt; t += 2) {
            const bool last = (t == nt - 2);
            const char* a1 = cA + (size_t)(t + 1) * kstep;
            const char* a2 = last ? nA : cA + (size_t)(t + 2) * kstep; const char* b2 = last ? nB : cB + (size_t)(t + 2) * kstep;
            const char* a3 = a2 + kstep; const char* b3 = b2 + kstep;
            if (last && has_next) S.a_ready(nxt);
            if constexpr (SP2) {
            PG8_LDB(B0, 0, 0); PG8_LDB(B1, 0, 1); PG8_SCHED; PG8_LDA(At, 0, 0); PG8_STAGE(PG8_SA(1, 1), a1 + hstep, voffA);
            PG8_WAIT_V(8); PG8_WAIT_L(0); PG8_BAR; PG8_MMA(0, 0, At, B0); PG8_MMA(0, 1, At, B1); PG8_BAR; PG8_SCHED;
            PG8_LDA(At, 0, 1); PG8_STAGE(PG8_SB(0, 0), b2, voffB); PG8_STAGE(PG8_SB(0, 1), b2 + hstep, voffB); PG8_STAGE(PG8_SA(0, 0), a2, voffA);
            PG8_WAIT_V(8); PG8_WAIT_L(0); PG8_BAR; PG8_MMA(1, 0, At, B0); PG8_MMA(1, 1, At, B1); PG8_BAR; PG8_SCHED;
            PG8_LDB(B0, 1, 0); PG8_LDB(B1, 1, 1); PG8_SCHED; PG8_LDA(At, 1, 0); PG8_STAGE(PG8_SA(0, 1), a2 + hstep, voffA);
            PG8_WAIT_V(8); PG8_WAIT_L(0); PG8_BAR; PG8_MMA(0, 0, At, B0); PG8_MMA(0, 1, At, B1); PG8_BAR; PG8_SCHED;
            PG8_LDA(At, 1, 1); PG8_STAGE(PG8_SB(1, 0), b3, voffB); PG8_STAGE(PG8_SB(1, 1), b3 + hstep, voffB); PG8_STAGE(PG8_SA(1, 0), a3, voffA);
            PG8_WAIT_V(8); PG8_WAIT_L(0); PG8_BAR; PG8_MMA(1, 0, At, B0); PG8_MMA(1, 1, At, B1); PG8_BAR; PG8_SCHED;
            } else {
            PG8_LDB(B0, 0, 0); PG8_SCHED; PG8_LDA(At, 0, 0); PG8_STAGE(PG8_SA(1, 1), a1 + hstep, voffA);
            PG8_WAIT_L(8); PG8_BAR; PG8_WAIT_L(0); PG8_MMA(0, 0, At, B0); PG8_BAR; PG8_SCHED;
            PG8_LDB(B1, 0, 1); PG8_STAGE(PG8_SB(0, 0), b2, voffB);
            PG8_BAR; PG8_WAIT_L(0); PG8_MMA(0, 1, At, B1); PG8_BAR;
            PG8_LDA(At, 0, 1); PG8_STAGE(PG8_SA(0, 0), a2, voffA);
            PG8_BAR; PG8_WAIT_L(0); PG8_MMA(1, 0, At, B0); PG8_BAR; PG8_SCHED;
            PG8_STAGE(PG8_SB(0, 1), b2 + hstep, voffB);
            PG8_WAIT_V(6); PG8_BAR; PG8_MMA(1, 1, At, B1); PG8_BAR;
            PG8_LDB(B0, 1, 0); PG8_SCHED; PG8_LDA(At, 1, 0); PG8_STAGE(PG8_SA(0, 1), a2 + hstep, voffA);
            PG8_WAIT_L(8); PG8_BAR; PG8_WAIT_L(0); PG8_MMA(0, 0, At, B0); PG8_BAR; PG8_SCHED;
            PG8_LDB(B1, 1, 1); PG8_STAGE(PG8_SB(1, 0), b3, voffB);
            PG8_BAR; PG8_WAIT_L(0); PG8_MMA(0, 1, At, B1); PG8_BAR;
            PG8_LDA(At, 1, 1); PG8_STAGE(PG8_SA(1, 0), a3, voffA);
            PG8_BAR; PG8_WAIT_L(0); PG8_MMA(1, 0, At, B0); PG8_BAR; PG8_SCHED;
            PG8_STAGE(PG8_SB(1, 1), b3 + hstep, voffB);
            PG8_WAIT_V(6); PG8_BAR; PG8_MMA(1, 1, At, B1); PG8_BAR;
            }
        }
        if constexpr (ALIGN_EPI) { if (wr == 0) PG8_BAR; }
        if constexpr (!Epi::AFTER_DRAIN) { E(acc, cur, wr, wc, fr, fq); S.done(cur); }
        if (!has_next) break;
#pragma unroll
        for (int a = 0; a < 2; ++a)
#pragma unroll
            for (int b = 0; b < 2; ++b)
#pragma unroll
                for (int m = 0; m < 4; ++m)
#pragma unroll
                    for (int n = 0; n < 2; ++n) acc[a][b][m][n] = (f32x4){0.f, 0.f, 0.f, 0.f};
        cur = nxt; cA = nA; cB = nB; ++ui;
        if constexpr (ALIGN_EPI) { if (wr == 1) PG8_BAR; }
    }
    PG8_WAIT_V(0);
    if constexpr (!ALIGN_EPI) { if (wr == 0) PG8_BAR; }
    PG8_BAR;
    if constexpr (Epi::AFTER_DRAIN) { E.fused(acc, cur, wr, wc, fr, fq, lds, wid, lane); S.done(cur); }
#undef PG8_SA
#undef PG8_SB
#undef PG8_STAGE
#undef PG8_LDA
#undef PG8_LDB
#undef PG8_MMA
#undef PG8_WAIT_V
#undef PG8_WAIT_L
#undef PG8_BAR
#undef PG8_SCHED
}
}
#define GAS __attribute__((address_space(1)))
#define LAS __attribute__((address_space(3)))
typedef unsigned short bf16;
typedef unsigned v4u __attribute__((ext_vector_type(4)));
typedef float f32x4 __attribute__((ext_vector_type(4)));
typedef short bf16x8 __attribute__((ext_vector_type(8)));
typedef GAS unsigned gu32;
typedef GAS unsigned long long gu64;
#define RLX_AGENT __ATOMIC_RELAXED, __HIP_MEMORY_SCOPE_AGENT
#define LDS_WAIT() asm volatile("s_waitcnt lgkmcnt(0)" ::: "memory")
#define VM_WAIT() asm volatile("s_waitcnt vmcnt(0)" ::: "memory")
__device__ __forceinline__ unsigned long long rt() { return __builtin_amdgcn_s_memrealtime(); }
__device__ __forceinline__ unsigned f2bf(float f) { unsigned u = __builtin_bit_cast(unsigned, f); return (u + 0x7fffu + ((u >> 16) & 1u)) >> 16; }
__device__ __forceinline__ unsigned pk2(float lo, float hi) { return f2bf(lo) | (f2bf(hi) << 16); }

#define XB_TMO      128
#define XB_XCNT(j)  (256  + 64 * (j))
#define XB_XSUB(j)  (1280 + 64 * (j))
#define XB_XGEN(j)  (2304 + 64 * (j))
#define XB_TOP      3328
#define XB_TOPGEN   3392
#define XCD_BAR_WORDS 3456
#define XB_SPIN_CAP (1u << 18)

__device__ __forceinline__ unsigned xb_ld(unsigned* p)              { return __hip_atomic_load(p, __ATOMIC_RELAXED, __HIP_MEMORY_SCOPE_AGENT); }
__device__ __forceinline__ unsigned xb_add(unsigned* p, unsigned v) { return __hip_atomic_fetch_add(p, v, __ATOMIC_RELAXED, __HIP_MEMORY_SCOPE_AGENT); }
__device__ __forceinline__ unsigned xb_xcc_id() { return (unsigned)__builtin_amdgcn_s_getreg((3 << 11) | 20) & 0xFu; }
#define XB_SPIN(cond, bar) do { unsigned _sp = 0; while (cond) { __builtin_amdgcn_s_sleep(1); \
    if ((++_sp & 255u) == 0u) { if (xb_ld(&(bar)[XB_TMO])) break; if (_sp > XB_SPIN_CAP) { atomicAdd(&(bar)[XB_TMO], 1u); break; } } } } while (0)

struct XcdBarrier {
    unsigned* bar; unsigned x;
    volatile LAS unsigned* st;
};

__device__ __forceinline__ XcdBarrier xcd_barrier_post(unsigned* bar, volatile LAS unsigned* st) {
    XcdBarrier b; b.bar = bar; b.x = xb_xcc_id(); b.st = st;
    if (threadIdx.x == 0) (void)xb_add(&bar[XB_XCNT(b.x)], 1u);
    return b;
}
__device__ __forceinline__ void xcd_barrier_complete(unsigned* bar, unsigned x, unsigned& nloc, unsigned& nx) {
    const unsigned G = gridDim.x * gridDim.y * gridDim.z;
    unsigned sum, cnt, mine, sp = 0u;
    for (;;) {
        sum = 0u; cnt = 0u; mine = 0u;
#pragma unroll
        for (unsigned j = 0; j < 16; ++j) { const unsigned c = xb_ld(&bar[XB_XCNT(j)]); sum += c; cnt += (c > 0u) ? 1u : 0u; mine = (j == x) ? c : mine; }
        if (sum == G) break;
        __builtin_amdgcn_s_sleep(1);
        if ((++sp & 255u) == 0u) { if (xb_ld(&bar[XB_TMO])) break; if (sp > XB_SPIN_CAP) { atomicAdd(&bar[XB_TMO], 1u); break; } }
    }
    nloc = mine > 0u ? mine : 1u; nx = cnt > 0u ? cnt : 1u;
}

__device__ __forceinline__ void xcd_barrier(const XcdBarrier& b) {
    asm volatile("s_waitcnt vmcnt(0)" ::: "memory");
    __syncthreads();
    if (threadIdx.x == 0) {
        unsigned* bar = b.bar;
        __builtin_amdgcn_s_waitcnt(0);
        unsigned nloc = b.st[0], nx = b.st[1];
        if (nloc == 0u) { xcd_barrier_complete(bar, b.x, nloc, nx); b.st[0] = nloc; b.st[1] = nx; }
        const unsigned old = xb_add(&bar[XB_XSUB(b.x)], 1u);
        const unsigned gen = old / nloc;
        if (old + 1u == (gen + 1u) * nloc) {
            __builtin_amdgcn_fence(__ATOMIC_RELEASE, "agent");
            asm volatile("s_waitcnt vmcnt(0)" ::: "memory");
            const unsigned og = xb_add(&bar[XB_TOP], 1u);
            const unsigned tg = og / nx;
            if (og + 1u == (tg + 1u) * nx) xb_add(&bar[XB_TOPGEN], 1u);
            else XB_SPIN(xb_ld(&bar[XB_TOPGEN]) == tg, bar);
            __builtin_amdgcn_fence(__ATOMIC_ACQUIRE, "agent");
            xb_add(&bar[XB_XGEN(b.x)], 1u);
            asm volatile("s_waitcnt vmcnt(0)" ::: "memory");
        } else {
            XB_SPIN(xb_ld(&bar[XB_XGEN(b.x)]) == gen, bar);
            __builtin_amdgcn_fence(__ATOMIC_ACQUIRE, "agent");
            asm volatile("s_waitcnt vmcnt(0)" ::: "memory");
        }
    }
    __syncthreads();
}

constexpr int NWAVES = 8, NTHREADS = 512;
constexpr int BATCH = 4, SEQ = 2048, D = 2048, M = BATCH * SEQ;
constexpr int NQH = 32, NKVH = 4, HD = 64, QPKV = 8, WINDOW = 128;
constexpr int Q_OFF = 0, K_OFF = 2048, V_OFF = 2304, CB_OFF = 2560, CC_OFF = 4608, CH_OFF = 6656, G_OFF = 8704, IN_W = 12800;
constexpr int PH = 8, PNK = 128, PTOPK = 16, PNE = 16384;
constexpr float LN_EPS = 1e-5f;
constexpr float ALPHA = 1.189207115002721f;

#ifndef MK_PER_PHASE
#define MK_PER_PHASE 0
#endif
constexpr int N_PHASES = 12;

constexpr size_t MiB = 1u << 20;
constexpr size_t WS_CTL = 0, CTL_ZERO_BYTES = 1 * MiB;
constexpr size_t WS_WIN = 1 * MiB;
constexpr size_t WS_WA = 51 * MiB, WS_WC = 59 * MiB, WS_WO = 67 * MiB, WS_WF = 75 * MiB;
constexpr size_t WS_XB = 83 * MiB;
constexpr size_t WS_MERGED = WS_XB;
constexpr size_t WS_Z = 115 * MiB;
constexpr size_t WS_R2B = 115 * MiB;
constexpr size_t WS_H1B = 179 * MiB;
constexpr size_t WS_SC = 211 * MiB;
constexpr size_t WS_EX = 275 * MiB;
constexpr size_t WS_GT = 279 * MiB;
constexpr size_t WS_AO = 315 * MiB, WS_CI = 347 * MiB, WS_TMP = 379 * MiB;
constexpr size_t WS_U8 = 411 * MiB, WS_V8 = 443 * MiB;
constexpr size_t WS_SU = 475 * MiB, WS_SV = WS_SU + 65536;
constexpr size_t WS_PA = WS_SC;
constexpr size_t WS_XQ = 283 * MiB;
constexpr size_t WS_SX = 299 * MiB;
constexpr size_t WS_WB = 380 * MiB;
constexpr size_t WS_ST = 379 * MiB;
constexpr size_t WS_END = 476 * MiB;
constexpr int CW_Q = 12288;
constexpr size_t SLICE_BYTES = (size_t)PNE * 256;
constexpr int CW_BAR = 4096;

constexpr int RING_BYTES = 131072;
constexpr int LDSCTL_OFF = 147456, MISC_OFF = LDSCTL_OFF + 320;
constexpr int LDS_BYTES = LDSCTL_OFF + 512;

typedef float f32x16 __attribute__((ext_vector_type(16)));
typedef unsigned v2u __attribute__((ext_vector_type(2)));
__device__ __forceinline__ float wave_sum(float v) {
#pragma unroll
    for (int o = 1; o < 64; o <<= 1) v += __shfl_xor(v, o);
    return v;
}
__device__ __forceinline__ float vmaxf(float a, float b) { float r; asm("v_max_f32_e32 %0, %1, %2" : "=v"(r) : "v"(a), "v"(b)); return r; }
__device__ __forceinline__ float vminf(float a, float b) { float r; asm("v_min_f32_e32 %0, %1, %2" : "=v"(r) : "v"(a), "v"(b)); return r; }

__device__ __forceinline__ void p0_transpose_item(const float* W, int K, int N, bf16* WT, LAS float* scr, int item, int lane) {
    const int nblk = N / 32, kb = item / nblk, nb = item % nblk, k0 = 64 * kb, n0 = 32 * nb;
#pragma unroll 8
    for (int i = 0; i < 32; ++i) { const int kk = 2 * i + (lane >> 5); scr[kk * 33 + (lane & 31)] = W[(size_t)(k0 + kk) * N + n0 + (lane & 31)]; }
    LDS_WAIT(); asm volatile("" ::: "memory");
    const int c = lane & 7;
#pragma unroll
    for (int j = 0; j < 4; ++j) { const int n = (lane >> 3) + 8 * j; const LAS float* s = scr + (8 * c) * 33 + n;
        v4u o; o.x = pk2(s[0 * 33], s[1 * 33]); o.y = pk2(s[2 * 33], s[3 * 33]); o.z = pk2(s[4 * 33], s[5 * 33]); o.w = pk2(s[6 * 33], s[7 * 33]);
        *(GAS v4u*)(WT + (size_t)(n0 + n) * K + k0 + 8 * c) = o; }
    LDS_WAIT(); asm volatile("" ::: "memory");
}
__device__ __forceinline__ void p0_wf_item(const float* wq, const float* sk, bf16* WfT, LAS unsigned char* lds, int item, int tid) {
    const int hp = item >> 5, dt = item & 31;
    LAS f32x4* SK4 = (LAS f32x4*)lds;
    LAS f32x4* WQ4 = SK4 + 128 * 33;
    const float* skp = sk + (size_t)hp * 128 * 128;
    for (int i = tid; i < 128 * 32; i += NTHREADS) { const int n = i >> 5, c4 = i & 31; SK4[n * 33 + c4] = *(const f32x4*)(skp + n * 128 + 4 * c4); }
    for (int i = tid; i < 64 * 32; i += NTHREADS) { const int r = i >> 5, c4 = i & 31; WQ4[r * 33 + c4] = *(const f32x4*)(wq + (size_t)(64 * dt + r) * 2048 + hp * 128 + 4 * c4); }
    __syncthreads();
    const int td = tid & 15, tn = tid >> 4;
    float acc[4][4];
#pragma unroll
    for (int i = 0; i < 4; ++i)
#pragma unroll
        for (int j = 0; j < 4; ++j) acc[i][j] = 0.f;
#pragma unroll 4
    for (int c4 = 0; c4 < 32; ++c4) {
        f32x4 a[4], b[4];
#pragma unroll
        for (int i = 0; i < 4; ++i) a[i] = SK4[(4 * tn + i) * 33 + c4];
#pragma unroll
        for (int j = 0; j < 4; ++j) b[j] = WQ4[(td + 16 * j) * 33 + c4];
#pragma unroll
        for (int i = 0; i < 4; ++i)
#pragma unroll
            for (int j = 0; j < 4; ++j) acc[i][j] += a[i].x * b[j].x + a[i].y * b[j].y + a[i].z * b[j].z + a[i].w * b[j].w;
    }
#pragma unroll
    for (int i = 0; i < 4; ++i)
#pragma unroll
        for (int j = 0; j < 4; ++j) WfT[(size_t)(hp * 128 + 4 * tn + i) * 2048 + 64 * dt + td + 16 * j] = (bf16)f2bf(acc[i][j]);
    __syncthreads();
}

__device__ __forceinline__ int perm16(int o) { return 8 * ((o >> 2) & 1) + 4 * (o >> 3) + (o & 3); }
__device__ __forceinline__ void attn_unit(int unit, const bf16* z, bf16* ao, const float* sinks, LAS unsigned char* lds, int tid) {
    const int lane = tid & 63, wid = __builtin_amdgcn_readfirstlane(tid >> 6), r32 = lane & 31, hi = lane >> 5;
    const int nb = unit & 15, kvh = (unit >> 4) & 3, b = unit >> 6;
    LAS bf16* Ks = (LAS bf16*)lds;
    LAS bf16* Vt = (LAS bf16*)(lds + 256 * 144);
    const size_t tok0 = (size_t)b * SEQ;
#pragma unroll
    for (int i = 0; i < 4; ++i) {
        const int ci = tid + NTHREADS * i, key = ci >> 3, dc = ci & 7;
        int kpos = 128 * (nb - 1) + key; if (kpos < 0) kpos = 0;
        const bf16* src = z + (tok0 + kpos) * IN_W + K_OFF + kvh * HD + dc * 8;
        const v4u kv = *(const GAS v4u*)src, vv = *(const GAS v4u*)(src + (V_OFF - K_OFF));
        *(LAS v4u*)(Ks + key * 72 + dc * 8) = kv;
        const int pos = (key & ~15) + perm16(key & 15);
        LAS bf16* vp = Vt + (dc * 8) * 264 + pos;
        vp[0 * 264] = (bf16)(vv.x & 0xffffu); vp[1 * 264] = (bf16)(vv.x >> 16); vp[2 * 264] = (bf16)(vv.y & 0xffffu); vp[3 * 264] = (bf16)(vv.y >> 16);
        vp[4 * 264] = (bf16)(vv.z & 0xffffu); vp[5 * 264] = (bf16)(vv.z >> 16); vp[6 * 264] = (bf16)(vv.w & 0xffffu); vp[7 * 264] = (bf16)(vv.w >> 16);
    }
    __syncthreads();
    const int hq = kvh * QPKV + wid;
    const float LOG2E = 1.4426950408889634f;
    const float sink2 = sinks[hq] * LOG2E, sc = 0.125f * LOG2E;
#pragma unroll 1
    for (int qg = 0; qg < 4; ++qg) {
        const size_t tok = tok0 + 128 * nb + 32 * qg + r32;
        bf16x8 qf[4];
#pragma unroll
        for (int ks = 0; ks < 4; ++ks) qf[ks] = *(const GAS bf16x8*)(z + tok * IN_W + Q_OFF + hq * HD + 16 * ks + 8 * hi);
        f32x16 s[5];
#pragma unroll
        for (int kt = 0; kt < 5; ++kt) {
            s[kt] = (f32x16){0.f, 0.f, 0.f, 0.f, 0.f, 0.f, 0.f, 0.f, 0.f, 0.f, 0.f, 0.f, 0.f, 0.f, 0.f, 0.f};
#pragma unroll
            for (int ks = 0; ks < 4; ++ks) {
                const bf16x8 kf = *(const LAS bf16x8*)(Ks + (32 * (qg + kt) + r32) * 72 + 16 * ks + 8 * hi);
                s[kt] = __builtin_amdgcn_mfma_f32_32x32x16_bf16(kf, qf[ks], s[kt], 0, 0, 0);
            }
        }
        float mx = sink2;
#pragma unroll
        for (int kt = 0; kt < 5; ++kt) {
            const bool tile_dead = (nb == 0) && (qg + kt < 4);
#pragma unroll
            for (int r = 0; r < 16; ++r) {
                const int krow = (r & 3) + 8 * (r >> 2) + 4 * hi;
                bool valid = !tile_dead;
                if (kt == 0) valid = valid && (krow > r32);
                if (kt == 4) valid = valid && (krow <= r32);
                const float v = valid ? s[kt][r] * sc : -INFINITY;
                s[kt][r] = v; mx = fmaxf(mx, v);
            }
        }
        mx = fmaxf(mx, __shfl_xor(mx, 32));
        float sum = 0.f;
#pragma unroll
        for (int kt = 0; kt < 5; ++kt)
#pragma unroll
            for (int r = 0; r < 16; ++r) { const float p = __builtin_amdgcn_exp2f(s[kt][r] - mx); s[kt][r] = p; sum += p; }
        sum += __shfl_xor(sum, 32);
        const float inv = 1.0f / (sum + __builtin_amdgcn_exp2f(sink2 - mx));
        f32x16 o[2];
        o[0] = (f32x16){0.f, 0.f, 0.f, 0.f, 0.f, 0.f, 0.f, 0.f, 0.f, 0.f, 0.f, 0.f, 0.f, 0.f, 0.f, 0.f}; o[1] = o[0];
#pragma unroll
        for (int kt = 0; kt < 5; ++kt)
#pragma unroll
            for (int s2 = 0; s2 < 2; ++s2) {
                v4u pw; pw.x = pg8::cvt_pk_bf16(s[kt][8 * s2 + 0], s[kt][8 * s2 + 1]); pw.y = pg8::cvt_pk_bf16(s[kt][8 * s2 + 2], s[kt][8 * s2 + 3]);
                pw.z = pg8::cvt_pk_bf16(s[kt][8 * s2 + 4], s[kt][8 * s2 + 5]); pw.w = pg8::cvt_pk_bf16(s[kt][8 * s2 + 6], s[kt][8 * s2 + 7]);
                const bf16x8 pa = __builtin_bit_cast(bf16x8, pw);
#pragma unroll
                for (int dt = 0; dt < 2; ++dt) {
                    const bf16x8 vf = *(const LAS bf16x8*)(Vt + (32 * dt + r32) * 264 + 32 * (qg + kt) + 16 * s2 + 8 * hi);
                    o[dt] = __builtin_amdgcn_mfma_f32_32x32x16_bf16(vf, pa, o[dt], 0, 0, 0);
                }
            }
        bf16* op = ao + tok * D + hq * HD;
#pragma unroll
        for (int dt = 0; dt < 2; ++dt)
#pragma unroll
            for (int g = 0; g < 4; ++g) {
                v2u w; w.x = pg8::cvt_pk_bf16(o[dt][4 * g + 0] * inv, o[dt][4 * g + 1] * inv); w.y = pg8::cvt_pk_bf16(o[dt][4 * g + 2] * inv, o[dt][4 * g + 3] * inv);
                *(GAS v2u*)(op + 32 * dt + 8 * g + 4 * hi) = w;
            }
    }
    __syncthreads();
}
__device__ __forceinline__ void conv_item(int item, const bf16* z, const float* cw, bf16* ci, int tid) {
    const int c8 = tid & 255, half = tid >> 8, t0 = 32 * item + 16 * half, c0 = 8 * c8;
    float w0[8], w1[8], w2[8], u1[8], u2[8];
#pragma unroll
    for (int e = 0; e < 8; ++e) { w0[e] = cw[c0 + e]; w1[e] = cw[2048 + c0 + e]; w2[e] = cw[4096 + c0 + e]; u1[e] = 0.f; u2[e] = 0.f; }
    if ((t0 & (SEQ - 1)) != 0) {
#pragma unroll
        for (int k = 0; k < 2; ++k) {
            const bf16* zr = z + (size_t)(t0 - 2 + k) * IN_W + c0;
            const v4u a = *(const GAS v4u*)(zr + CC_OFF), h = *(const GAS v4u*)(zr + CH_OFF);
            float u[8];
            u[0] = pg8::bf_lo(a.x) * pg8::bf_lo(h.x); u[1] = pg8::bf_hi(a.x) * pg8::bf_hi(h.x); u[2] = pg8::bf_lo(a.y) * pg8::bf_lo(h.y); u[3] = pg8::bf_hi(a.y) * pg8::bf_hi(h.y);
            u[4] = pg8::bf_lo(a.z) * pg8::bf_lo(h.z); u[5] = pg8::bf_hi(a.z) * pg8::bf_hi(h.z); u[6] = pg8::bf_lo(a.w) * pg8::bf_lo(h.w); u[7] = pg8::bf_hi(a.w) * pg8::bf_hi(h.w);
#pragma unroll
            for (int e = 0; e < 8; ++e) { if (k == 0) u2[e] = u[e]; else u1[e] = u[e]; }
        }
    }
#pragma unroll 4
    for (int i = 0; i < 16; ++i) {
        const bf16* zr = z + (size_t)(t0 + i) * IN_W + c0;
        const v4u a = *(const GAS v4u*)(zr + CC_OFF), h = *(const GAS v4u*)(zr + CH_OFF), bb = *(const GAS v4u*)(zr + CB_OFF);
        float u[8], cb[8], y[8];
        u[0] = pg8::bf_lo(a.x) * pg8::bf_lo(h.x); u[1] = pg8::bf_hi(a.x) * pg8::bf_hi(h.x); u[2] = pg8::bf_lo(a.y) * pg8::bf_lo(h.y); u[3] = pg8::bf_hi(a.y) * pg8::bf_hi(h.y);
        u[4] = pg8::bf_lo(a.z) * pg8::bf_lo(h.z); u[5] = pg8::bf_hi(a.z) * pg8::bf_hi(h.z); u[6] = pg8::bf_lo(a.w) * pg8::bf_lo(h.w); u[7] = pg8::bf_hi(a.w) * pg8::bf_hi(h.w);
        cb[0] = pg8::bf_lo(bb.x); cb[1] = pg8::bf_hi(bb.x); cb[2] = pg8::bf_lo(bb.y); cb[3] = pg8::bf_hi(bb.y); cb[4] = pg8::bf_lo(bb.z); cb[5] = pg8::bf_hi(bb.z); cb[6] = pg8::bf_lo(bb.w); cb[7] = pg8::bf_hi(bb.w);
#pragma unroll
        for (int e = 0; e < 8; ++e) { y[e] = cb[e] * (w0[e] * u2[e] + w1[e] * u1[e] + w2[e] * u[e]); u2[e] = u1[e]; u1[e] = u[e]; }
        v4u o; o.x = pk2(y[0], y[1]); o.y = pk2(y[2], y[3]); o.z = pk2(y[4], y[5]); o.w = pk2(y[6], y[7]);
        *(GAS v4u*)(ci + (size_t)(t0 + i) * D + c0) = o;
    }
}

__device__ __forceinline__ unsigned pack_i8(const f32x4 v) {
    const int a = __float2int_rn(v.x), b = __float2int_rn(v.y), c = __float2int_rn(v.z), d = __float2int_rn(v.w);
    return ((unsigned)a & 0xffu) | (((unsigned)b & 0xffu) << 8) | (((unsigned)c & 0xffu) << 16) | ((unsigned)d << 24);
}
__device__ __forceinline__ unsigned pack_i8_2(float a, float b, float c, float d) {
    const int ia = __float2int_rn(a), ib = __float2int_rn(b), ic = __float2int_rn(c), id = __float2int_rn(d);
    return ((unsigned)ia & 0xffu) | (((unsigned)ib & 0xffu) << 8) | (((unsigned)ic & 0xffu) << 16) | ((unsigned)id << 24);
}
__device__ __forceinline__ void ln1_row(bf16* hbrow, signed char* xqrow, float* sxp, const float* g, const float* bta, int lane) {
    GAS v4u* xr = (GAS v4u*)hbrow + lane;
    float v[4][8]; float s = 0.f;
#pragma unroll
    for (int j = 0; j < 4; ++j) { const v4u w = xr[64 * j];
        v[j][0] = pg8::bf_lo(w.x); v[j][1] = pg8::bf_hi(w.x); v[j][2] = pg8::bf_lo(w.y); v[j][3] = pg8::bf_hi(w.y); v[j][4] = pg8::bf_lo(w.z); v[j][5] = pg8::bf_hi(w.z); v[j][6] = pg8::bf_lo(w.w); v[j][7] = pg8::bf_hi(w.w);
#pragma unroll
        for (int e = 0; e < 8; ++e) s += v[j][e]; }
    const float mean = wave_sum(s) * (1.f / D); float s2 = 0.f;
#pragma unroll
    for (int j = 0; j < 4; ++j)
#pragma unroll
        for (int e = 0; e < 8; ++e) { v[j][e] -= mean; s2 += v[j][e] * v[j][e]; }
    const float rstd = 1.f / sqrtf(wave_sum(s2) * (1.f / D) + LN_EPS);
    float mx = 0.f;
#pragma unroll
    for (int j = 0; j < 4; ++j) {
        const GAS f32x4* gp = (const GAS f32x4*)g + 2 * (lane + 64 * j); const GAS f32x4* bp = (const GAS f32x4*)bta + 2 * (lane + 64 * j);
        const f32x4 g0 = gp[0], g1 = gp[1], b0 = bp[0], b1 = bp[1];
        v[j][0] = v[j][0] * rstd * g0.x + b0.x; v[j][1] = v[j][1] * rstd * g0.y + b0.y; v[j][2] = v[j][2] * rstd * g0.z + b0.z; v[j][3] = v[j][3] * rstd * g0.w + b0.w;
        v[j][4] = v[j][4] * rstd * g1.x + b1.x; v[j][5] = v[j][5] * rstd * g1.y + b1.y; v[j][6] = v[j][6] * rstd * g1.z + b1.z; v[j][7] = v[j][7] * rstd * g1.w + b1.w;
        v4u o; o.x = pk2(v[j][0], v[j][1]); o.y = pk2(v[j][2], v[j][3]); o.z = pk2(v[j][4], v[j][5]); o.w = pk2(v[j][6], v[j][7]);
        xr[64 * j] = o;
#pragma unroll
        for (int e = 0; e < 8; ++e) mx = fmaxf(mx, fabsf(v[j][e]));
    }
#pragma unroll
    for (int o = 1; o < 64; o <<= 1) mx = fmaxf(mx, __shfl_xor(mx, o));
    const float qs = mx > 0.f ? 127.0f / mx : 1.0f;
    GAS v2u* q8 = (GAS v2u*)xqrow + lane;
#pragma unroll
    for (int j = 0; j < 4; ++j) { v2u o; o.x = pack_i8_2(v[j][0] * qs, v[j][1] * qs, v[j][2] * qs, v[j][3] * qs); o.y = pack_i8_2(v[j][4] * qs, v[j][5] * qs, v[j][6] * qs, v[j][7] * qs); q8[64 * j] = o; }
    if (lane == 0) *sxp = mx > 0.f ? mx * (1.0f / 127.0f) : 1.0f;
}

constexpr int TK_ROWF = 136;
constexpr int TK_IDX_OFF = 256 * TK_ROWF * 4;
__device__ __forceinline__ void topk_core(LAS unsigned char* lds, size_t prob0, int pstride, int* experts, float* gates, int tid) {
    LAS float* S = (LAS float*)lds;
    LAS unsigned char* IDX = lds + TK_IDX_OFF;
    const int row = tid >> 1, sub = tid & 1;
    float L[16];
#pragma unroll
    for (int j = 0; j < 16; ++j) L[j] = -INFINITY;
#pragma unroll 2
    for (int i = 0; i < 16; ++i) {
        const int c4 = 2 * i + sub;
        const f32x4 v = *(const LAS f32x4*)(S + row * TK_ROWF + 4 * c4);
#pragma unroll
        for (int e = 0; e < 4; ++e) {
            const float ve = v[e];
            float x = __uint_as_float((__float_as_uint(ve) & ~0x7Fu) | (unsigned)(4 * c4 + e));
#pragma unroll
            for (int j = 0; j < 16; ++j) { const float h = vmaxf(L[j], x); x = vminf(L[j], x); L[j] = h; }
        }
    }
    {
        float P[16];
#pragma unroll
        for (int j = 0; j < 16; ++j) P[j] = __shfl_xor(L[j], 1);
#pragma unroll
        for (int j = 0; j < 16; ++j) L[j] = vmaxf(L[j], P[15 - j]);
#pragma unroll
        for (int st = 8; st >= 1; st >>= 1)
#pragma unroll
            for (int j = 0; j < 16; ++j) if ((j & st) == 0) { const float h = vmaxf(L[j], L[j + st]), l = vminf(L[j], L[j + st]); L[j] = h; L[j + st] = l; }
    }
    if (sub == 0) {
#pragma unroll
        for (int q = 0; q < 4; ++q) {
            unsigned w = 0;
#pragma unroll
            for (int e = 0; e < 4; ++e) w |= (__builtin_bit_cast(unsigned, L[4 * q + e]) & 0x7Fu) << (8 * e);
            *(LAS unsigned*)(IDX + row * 16 + 4 * q) = w;
        }
    }
    float A[16], B[16];
#pragma unroll
    for (int j = 0; j < 16; ++j) { const float o = __shfl_xor(L[j], 2); const bool isb = (tid & 2) != 0; A[j] = isb ? o : L[j]; B[j] = isb ? L[j] : o; }
    float F[16];
#pragma unroll
    for (int j = 0; j < 16; ++j) F[j] = -INFINITY;
#pragma unroll
    for (int i = 0; i < 16; ++i)
#pragma unroll
        for (int j = 0; j < 16; ++j) if ((i + 1) * (j + 1) <= 16) {
            const float sm = A[i] + B[j];
            float x = __builtin_bit_cast(float, (__builtin_bit_cast(unsigned, sm) & ~0xFFu) | (unsigned)(i * 16 + j));
#pragma unroll
            for (int k = 0; k < 16; ++k) { const float h = vmaxf(F[k], x); x = vminf(F[k], x); F[k] = h; }
        }
    __syncthreads();
    if ((tid & 3) == 0) {
        const int rowA = (tid >> 2) * 2, rowB = rowA + 1;
        const size_t prob = prob0 + (size_t)pstride * (tid >> 2);
        float g[16]; int ex[16]; float gs = 0.f;
#pragma unroll
        for (int k = 0; k < 16; ++k) {
            const unsigned code = __builtin_bit_cast(unsigned, F[k]) & 0xFFu;
            const int ia = IDX[rowA * 16 + (code >> 4)], ib = IDX[rowB * 16 + (code & 15)];
            ex[k] = ia * PNK + ib;
            g[k] = __expf(F[k] - F[0]); gs += g[k];
        }
        const float ginv = 1.0f / gs;
#pragma unroll
        for (int q = 0; q < 4; ++q) {
            *(GAS f32x4*)(gates + prob * 16 + 4 * q) = (f32x4){g[4 * q] * ginv, g[4 * q + 1] * ginv, g[4 * q + 2] * ginv, g[4 * q + 3] * ginv};
            typedef int i32x4 __attribute__((ext_vector_type(4)));
            *(GAS i32x4*)(experts + prob * 16 + 4 * q) = (i32x4){ex[4 * q], ex[4 * q + 1], ex[4 * q + 2], ex[4 * q + 3]};
        }
    }
    __syncthreads();
}
__device__ __forceinline__ void topk_pass(int pass, const float* scores, int* experts, float* gates, LAS unsigned char* lds, int tid) {
    LAS float* S = (LAS float*)lds;
    const float* src = scores + (size_t)pass * (256 * 128);
#pragma unroll 4
    for (int i = 0; i < 16; ++i) { const int f4 = tid + NTHREADS * i, row = f4 >> 5, c4 = f4 & 31; *(LAS f32x4*)(S + row * TK_ROWF + 4 * c4) = *(const GAS f32x4*)(src + (size_t)f4 * 4); }
    __syncthreads();
    topk_core(lds, (size_t)pass * 128, 1, experts, gates, tid);
}
struct EpiTopK {
    static constexpr bool PERM = false, AFTER_DRAIN = true;
    int* experts; float* gates;
    __device__ __forceinline__ void fused(pg8::f32x4 (&acc)[2][2][4][2], const pg8::Unit& u, int wr, int wc, int fr, int fq, LAS unsigned char* lds, int wid, int lane) const {
        LAS float* S = (LAS float*)lds;
        const int tid = wid * 64 + lane;
#pragma unroll
        for (int ai = 0; ai < 2; ++ai) {
#pragma unroll
            for (int bj = 0; bj < 2; ++bj)
#pragma unroll
                for (int mm = 0; mm < 4; ++mm)
#pragma unroll
                    for (int n = 0; n < 2; ++n) { const int rl = 64 * wr + 16 * mm + fr; *(LAS pg8::f32x4*)(S + (2 * rl + bj) * TK_ROWF + 32 * wc + 16 * n + 4 * fq) = acc[ai][bj][mm][n]; }
            __syncthreads();
            topk_core(lds, ((size_t)u.pm * 256 + 128 * ai) * PH + u.pn, PH, experts, gates, tid);
        }
    }
};

__device__ __forceinline__ float gelu_erf(float v) { return 0.5f * v * (1.0f + erff(v * 0.70710678118654752f)); }
typedef __bf16 bf16x2_t __attribute__((ext_vector_type(2)));
typedef float f32x2_t __attribute__((ext_vector_type(2)));
__device__ __forceinline__ float dot2bf(bf16x2_t a, unsigned b, float acc) { return __builtin_amdgcn_fdot2_f32_bf16(a, __builtin_bit_cast(bf16x2_t, b), acc, false); }
__device__ __forceinline__ float dot4f8(unsigned w8, unsigned x01, unsigned x23, float acc) {
    acc = dot2bf(__builtin_amdgcn_cvt_scalef32_pk_bf16_fp8(w8, 1.0f, false), x01, acc);
    return dot2bf(__builtin_amdgcn_cvt_scalef32_pk_bf16_fp8(w8, 1.0f, true), x23, acc);
}
__device__ __forceinline__ void axpy4f8(float* y, unsigned w8, float w) {
    const f32x2_t lo = __builtin_amdgcn_cvt_pk_f32_fp8(w8, false), hi = __builtin_amdgcn_cvt_pk_f32_fp8(w8, true);
    y[0] += w * lo.x; y[1] += w * lo.y; y[2] += w * hi.x; y[3] += w * hi.y;
}
__device__ __forceinline__ void axpy4f8v(f32x2_t* y2, unsigned w8, float w) {
    const f32x2_t lo = __builtin_amdgcn_cvt_pk_f32_fp8(w8, false), hi = __builtin_amdgcn_cvt_pk_f32_fp8(w8, true);
    const f32x2_t ww = {w, w};
    y2[0] = __builtin_elementwise_fma(lo, ww, y2[0]); y2[1] = __builtin_elementwise_fma(hi, ww, y2[1]);
}
__device__ __forceinline__ void row_to_fp8(const float* src, unsigned char* dst, float* inv, int lane) {
    f32x4 v[2][4]; float mx = 0.f;
#pragma unroll
    for (int j = 0; j < 2; ++j)
#pragma unroll
        for (int q = 0; q < 4; ++q) { v[j][q] = *((const GAS f32x4*)src + 4 * (lane + 64 * j) + q);
            mx = fmaxf(mx, fmaxf(fmaxf(fabsf(v[j][q].x), fabsf(v[j][q].y)), fmaxf(fabsf(v[j][q].z), fabsf(v[j][q].w)))); }
#pragma unroll
    for (int o = 1; o < 64; o <<= 1) mx = fmaxf(mx, __shfl_xor(mx, o));
    const float sc = mx > 0.f ? 384.0f / mx : 1.0f;
#pragma unroll
    for (int j = 0; j < 2; ++j) { v4u o;
        int w;
        w = 0; w = __builtin_amdgcn_cvt_pk_fp8_f32(v[j][0].x * sc, v[j][0].y * sc, w, false); w = __builtin_amdgcn_cvt_pk_fp8_f32(v[j][0].z * sc, v[j][0].w * sc, w, true); o.x = (unsigned)w;
        w = 0; w = __builtin_amdgcn_cvt_pk_fp8_f32(v[j][1].x * sc, v[j][1].y * sc, w, false); w = __builtin_amdgcn_cvt_pk_fp8_f32(v[j][1].z * sc, v[j][1].w * sc, w, true); o.y = (unsigned)w;
        w = 0; w = __builtin_amdgcn_cvt_pk_fp8_f32(v[j][2].x * sc, v[j][2].y * sc, w, false); w = __builtin_amdgcn_cvt_pk_fp8_f32(v[j][2].z * sc, v[j][2].w * sc, w, true); o.z = (unsigned)w;
        w = 0; w = __builtin_amdgcn_cvt_pk_fp8_f32(v[j][3].x * sc, v[j][3].y * sc, w, false); w = __builtin_amdgcn_cvt_pk_fp8_f32(v[j][3].z * sc, v[j][3].w * sc, w, true); o.w = (unsigned)w;
        { const int ch = lane + 64 * j; *((GAS v4u*)(dst + (size_t)(ch >> 4) * SLICE_BYTES) + (ch & 15)) = o; } }
    if (lane == 0) *inv = mx > 0.f ? mx * (1.0f / 384.0f) : 1.0f;
}
__device__ __forceinline__ void row_to_i8(const float* src, unsigned char* dst, float* inv, int lane) {
    f32x4 v[2][4]; float mx = 0.f;
#pragma unroll
    for (int j = 0; j < 2; ++j)
#pragma unroll
        for (int q = 0; q < 4; ++q) { v[j][q] = *((const GAS f32x4*)src + 4 * (lane + 64 * j) + q);
            mx = fmaxf(mx, fmaxf(fmaxf(fabsf(v[j][q].x), fabsf(v[j][q].y)), fmaxf(fabsf(v[j][q].z), fabsf(v[j][q].w)))); }
#pragma unroll
    for (int o = 1; o < 64; o <<= 1) mx = fmaxf(mx, __shfl_xor(mx, o));
    const float sc = mx > 0.f ? 127.0f / mx : 1.0f;
#pragma unroll
    for (int j = 0; j < 2; ++j) { v4u o; o.x = pack_i8(v[j][0] * sc); o.y = pack_i8(v[j][1] * sc); o.z = pack_i8(v[j][2] * sc); o.w = pack_i8(v[j][3] * sc);
        { const int ch = lane + 64 * j; *((GAS v4u*)(dst + (size_t)(ch >> 4) * SLICE_BYTES) + (ch & 15)) = o; } }
    if (lane == 0) *inv = mx > 0.f ? mx * (1.0f / 127.0f) : 1.0f;
}
__device__ __forceinline__ float row16_allsum(float a) {
    a += __builtin_bit_cast(float, __builtin_amdgcn_update_dpp(0, __builtin_bit_cast(int, a), 0x128, 0xf, 0xf, false));
    a += __builtin_bit_cast(float, __builtin_amdgcn_update_dpp(0, __builtin_bit_cast(int, a), 0x124, 0xf, 0xf, false));
    a += __builtin_bit_cast(float, __builtin_amdgcn_update_dpp(0, __builtin_bit_cast(int, a), 0x122, 0xf, 0xf, false));
    a += __builtin_bit_cast(float, __builtin_amdgcn_update_dpp(0, __builtin_bit_cast(int, a), 0x121, 0xf, 0xf, false));
    return a;
}
__device__ __forceinline__ int q_pull(unsigned* q, int lane) { int v = 0; if (lane == 0) v = (int)__hip_atomic_fetch_add(q, 1u, __ATOMIC_RELAXED, __HIP_MEMORY_SCOPE_AGENT); return __builtin_amdgcn_readfirstlane(v); }
constexpr int PEER_TG = 8;
constexpr int PEER_N8 = 640, PEER_N4 = 512, PEER_N2 = 512, PEER_NTASK = PEER_N8 + PEER_N4 + PEER_N2;
__device__ __forceinline__ void peer_task_tokens(int idx, int& t0, int& n) {
    if (idx < PEER_N8) { t0 = 8 * idx; n = 8; } else if (idx < PEER_N8 + PEER_N4) { t0 = 8 * PEER_N8 + 4 * (idx - PEER_N8); n = 4; } else { t0 = 8 * PEER_N8 + 4 * PEER_N4 + 2 * (idx - PEER_N8 - PEER_N4); n = 2; }
}
__device__ __forceinline__ int row16_allsum_i(int a) {
    a += __builtin_amdgcn_update_dpp(0, a, 0x128, 0xf, 0xf, false);
    a += __builtin_amdgcn_update_dpp(0, a, 0x124, 0xf, 0xf, false);
    a += __builtin_amdgcn_update_dpp(0, a, 0x122, 0xf, 0xf, false);
    a += __builtin_amdgcn_update_dpp(0, a, 0x121, 0xf, 0xf, false);
    return a;
}
#define PA_LOAD(R, IDV, HALF) do { _Pragma("unroll") for (int i_ = 0; i_ < 8; ++i_) { const unsigned e_ = (unsigned)__shfl(IDV, 4 * (i_ + 8 * (HALF)) + g); \
        R[i_] = *(const GAS v4u*)(ub + (e_ * 256u + offc)); } } while (0)
#define PA_COMP(R, HALF) do { _Pragma("unroll") for (int i_ = 0; i_ < 8; ++i_) { int a_ = __builtin_amdgcn_sdot4((int)R[i_].x, (int)xc.x, 0, false); a_ = __builtin_amdgcn_sdot4((int)R[i_].y, (int)xc.y, a_, false); \
        a_ = __builtin_amdgcn_sdot4((int)R[i_].z, (int)xc.z, a_, false); a_ = __builtin_amdgcn_sdot4((int)R[i_].w, (int)xc.w, a_, false); r16[8 * (HALF) + i_] = row16_allsum_i(a_); } } while (0)
__device__ __forceinline__ void peer_a_task(int t0, int ntok, int s, const signed char* xq, const int* experts, const unsigned char* u8s, int* pa, int lane_) {
    int lane = lane_; asm volatile("" : "+v"(lane));
    const int g = lane >> 4, c = lane & 15;
    const GAS unsigned char* ub = (const GAS unsigned char*)(u8s + (size_t)s * SLICE_BYTES);
    const unsigned offc = 16u * (unsigned)c;
    int idc0 = experts[(size_t)t0 * 128 + lane], idc1 = experts[(size_t)t0 * 128 + lane + 64];
    v4u xc = *(const GAS v4u*)(xq + (size_t)t0 * D + 256 * s + 16 * c);
    v4u RA[8], RB[8];
    PA_LOAD(RA, idc0, 0);
#pragma unroll 1
    for (int tt = 0; tt < ntok; ++tt) {
        const int t = t0 + tt, tn = tt + 1 < ntok ? t + 1 : t;
        const int idn0 = experts[(size_t)tn * 128 + lane], idn1 = experts[(size_t)tn * 128 + lane + 64];
        const v4u xn = *(const GAS v4u*)(xq + (size_t)tn * D + 256 * s + 16 * c);
#pragma unroll 1
        for (int hb = 0; hb < 2; ++hb) {
            const int idv = hb ? idc1 : idc0, idx = hb ? idn0 : idc1;
            int r16[16];
            PA_LOAD(RB, idv, 1); PA_COMP(RA, 0);
            asm volatile("" ::: "memory");
            PA_LOAD(RA, idx, 0); PA_COMP(RB, 1);
            if (c == 15) { typedef int i32x4 __attribute__((ext_vector_type(4))); GAS i32x4* dst = (GAS i32x4*)(pa + ((size_t)t * 8 + s) * 128 + g * 32 + 16 * hb);
#pragma unroll
                for (int q = 0; q < 4; ++q) dst[q] = (i32x4){r16[4 * q], r16[4 * q + 1], r16[4 * q + 2], r16[4 * q + 3]}; }
        }
        idc0 = idn0; idc1 = idn1; xc = xn;
    }
}
__device__ __forceinline__ void peer_w_elem(size_t i, const int* experts, const float* gates, const float* su, const float* sv, const float* sx, const int* pa, float* wb) {
    const size_t t = i >> 7; const int k = (int)(i & 127), pos = (k & 3) * 32 + (k >> 2);
    const int e = experts[i];
    int a = 0;
#pragma unroll
    for (int s2 = 0; s2 < 8; ++s2) a += pa[(t * 8 + s2) * 128 + pos];
    wb[i] = gates[i] * gelu_erf((float)a * (su[e] * sx[t])) * sv[e];
}
#define PB_LOAD(R, IDV, HALF) do { _Pragma("unroll") for (int i_ = 0; i_ < 8; ++i_) { const unsigned e_ = (unsigned)__shfl(IDV, 4 * (i_ + 8 * (HALF)) + g); \
        R[i_] = *(const GAS v4u*)(vb + (e_ * 256u + offc)); } } while (0)
#define PB_COMP(R, WV, HALF) do { _Pragma("unroll") for (int i_ = 0; i_ < 8; ++i_) { const float wk_ = __shfl(WV, 4 * (i_ + 8 * (HALF)) + g); \
        axpy4f8v(&ya2[0], R[i_].x, wk_); axpy4f8v(&ya2[2], R[i_].y, wk_); axpy4f8v(&ya2[4], R[i_].z, wk_); axpy4f8v(&ya2[6], R[i_].w, wk_); } } while (0)
__device__ __forceinline__ void peer_b_task(int t0, int ntok, int s, const bf16* h1, const int* experts, const float* wb, const unsigned char* v8s, bf16* out, float* st, int lane_) {
    int lane = lane_; asm volatile("" : "+v"(lane));
    const int g = lane >> 4, c = lane & 15;
    const GAS unsigned char* vb = (const GAS unsigned char*)(v8s + (size_t)s * SLICE_BYTES);
    const unsigned offc = 16u * (unsigned)c;
    int idc0 = experts[(size_t)t0 * 128 + lane], idc1 = experts[(size_t)t0 * 128 + lane + 64];
    float wc0 = wb[(size_t)t0 * 128 + lane], wc1 = wb[(size_t)t0 * 128 + lane + 64];
    v4u RA[8], RB[8];
    PB_LOAD(RA, idc0, 0);
#pragma unroll 1
    for (int tt = 0; tt < ntok; ++tt) {
        const int t = t0 + tt, tn = tt + 1 < ntok ? t + 1 : t;
        const int idn0 = experts[(size_t)tn * 128 + lane], idn1 = experts[(size_t)tn * 128 + lane + 64];
        const float wn0 = wb[(size_t)tn * 128 + lane], wn1 = wb[(size_t)tn * 128 + lane + 64];
        f32x2_t ya2[8];
#pragma unroll
        for (int e = 0; e < 8; ++e) ya2[e] = (f32x2_t){0.f, 0.f};
#pragma unroll 1
        for (int hb = 0; hb < 2; ++hb) {
            const int idv = hb ? idc1 : idc0, idx = hb ? idn0 : idc1; const float wv = hb ? wc1 : wc0;
            PB_LOAD(RB, idv, 1); PB_COMP(RA, wv, 0);
            asm volatile("" ::: "memory");
            PB_LOAD(RA, idx, 0); PB_COMP(RB, wv, 1);
        }
        float ya[16];
#pragma unroll
        for (int e = 0; e < 8; ++e) { ya[2 * e] = ya2[e].x; ya[2 * e + 1] = ya2[e].y; }
#pragma unroll
        for (int e = 0; e < 16; ++e) { ya[e] += __shfl_xor(ya[e], 16); ya[e] += __shfl_xor(ya[e], 32); }
        const GAS v4u* hp = (const GAS v4u*)(h1 + (size_t)t * D + 256 * s + 16 * c);
        const v4u h0 = hp[0], h1v = hp[1];
        float hx[16];
        hx[0] = pg8::bf_lo(h0.x); hx[1] = pg8::bf_hi(h0.x); hx[2] = pg8::bf_lo(h0.y); hx[3] = pg8::bf_hi(h0.y); hx[4] = pg8::bf_lo(h0.z); hx[5] = pg8::bf_hi(h0.z); hx[6] = pg8::bf_lo(h0.w); hx[7] = pg8::bf_hi(h0.w);
        hx[8] = pg8::bf_lo(h1v.x); hx[9] = pg8::bf_hi(h1v.x); hx[10] = pg8::bf_lo(h1v.y); hx[11] = pg8::bf_hi(h1v.y); hx[12] = pg8::bf_lo(h1v.z); hx[13] = pg8::bf_hi(h1v.z); hx[14] = pg8::bf_lo(h1v.w); hx[15] = pg8::bf_hi(h1v.w);
        float sm = 0.f, sq = 0.f;
#pragma unroll
        for (int e = 0; e < 16; ++e) { ya[e] = hx[e] * ALPHA + ya[e]; sm += ya[e]; sq += ya[e] * ya[e]; }
        sm = row16_allsum(sm); sq = row16_allsum(sq);
        if (g == 0) { GAS v4u* op = (GAS v4u*)(out + (size_t)t * D + 256 * s + 16 * c);
            v4u o0, o1; o0.x = pk2(ya[0], ya[1]); o0.y = pk2(ya[2], ya[3]); o0.z = pk2(ya[4], ya[5]); o0.w = pk2(ya[6], ya[7]);
            o1.x = pk2(ya[8], ya[9]); o1.y = pk2(ya[10], ya[11]); o1.z = pk2(ya[12], ya[13]); o1.w = pk2(ya[14], ya[15]);
            op[0] = o0; op[1] = o1;
            if (c == 0) { st[((size_t)t * 8 + s) * 2] = sm; st[((size_t)t * 8 + s) * 2 + 1] = sq; } }
        idc0 = idn0; idc1 = idn1; wc0 = wn0; wc1 = wn1;
    }
}
__device__ __forceinline__ void peer_c_row(int t, const bf16* r2, float* out, const float* st, const float* g2, const float* b2, int lane) {
    float sm = 0.f, sq = 0.f;
#pragma unroll
    for (int s = 0; s < 8; ++s) { sm += st[((size_t)t * 8 + s) * 2]; sq += st[((size_t)t * 8 + s) * 2 + 1]; }
    const float mean = sm * (1.f / D), var = sq * (1.f / D) - mean * mean, rstd = 1.f / sqrtf(fmaxf(var, 0.f) + LN_EPS);
    const GAS v4u* xr = (const GAS v4u*)(r2 + (size_t)t * D) + lane;
    GAS f32x4* op = (GAS f32x4*)(out + (size_t)t * D);
#pragma unroll
    for (int j = 0; j < 4; ++j) { const v4u w = xr[64 * j]; const int c4 = 2 * (lane + 64 * j);
        const f32x4 g0 = *((const GAS f32x4*)g2 + c4), g1 = *((const GAS f32x4*)g2 + c4 + 1), b0 = *((const GAS f32x4*)b2 + c4), b1 = *((const GAS f32x4*)b2 + c4 + 1);
        const f32x4 v0 = (f32x4){pg8::bf_lo(w.x), pg8::bf_hi(w.x), pg8::bf_lo(w.y), pg8::bf_hi(w.y)}, v1 = (f32x4){pg8::bf_lo(w.z), pg8::bf_hi(w.z), pg8::bf_lo(w.w), pg8::bf_hi(w.w)};
        op[c4] = (v0 - mean) * rstd * g0 + b0; op[c4 + 1] = (v1 - mean) * rstd * g1 + b1; }
}

struct Args { const float* in[16]; float* out; unsigned char* ws; int ph_lo, ph_hi; };
__global__ void __launch_bounds__(NTHREADS, 2) mk_fwd(Args args) {
    extern __shared__ __attribute__((aligned(16))) unsigned char lds_raw[];
    LAS unsigned char* lds = (LAS unsigned char*)lds_raw;
    volatile LAS unsigned* MISC = (volatile LAS unsigned*)(lds + MISC_OFF);
    const int tid0 = threadIdx.x;
    const int G = gridDim.x, bx = blockIdx.x;
    unsigned char* ws = args.ws;
    gu32* ctl = (gu32*)(ws + WS_CTL);
#define IN_(i) (args.in[i])
#define x_in IN_(0)
#define w_in IN_(1)
#define b_gate IN_(2)
#define sinks IN_(3)
#define conv_w IN_(4)
#define w_ao IN_(5)
#define w_co IN_(6)
#define w_o IN_(7)
#define ln1_g IN_(8)
#define ln1_b IN_(9)
#define w_q IN_(10)
#define sub_keys IN_(11)
#define peer_u IN_(12)
#define peer_v IN_(13)
#define ln2_g IN_(14)
#define ln2_b IN_(15)
#define WinT ((bf16*)(ws + WS_WIN))
#define WaT ((bf16*)(ws + WS_WA))
#define WcT ((bf16*)(ws + WS_WC))
#define WoT ((bf16*)(ws + WS_WO))
#define WfT ((bf16*)(ws + WS_WF))
#define XB ((bf16*)(ws + WS_XB))
#define MERGED ((bf16*)(ws + WS_MERGED))
#define Z ((bf16*)(ws + WS_Z))
#define R2B ((bf16*)(ws + WS_R2B))
#define H1B ((bf16*)(ws + WS_H1B))
#define SC ((float*)(ws + WS_SC))
#define EX ((int*)(ws + WS_EX))
#define GT ((float*)(ws + WS_GT))
#define AO ((bf16*)(ws + WS_AO))
#define CI ((bf16*)(ws + WS_CI))
#define TMP ((bf16*)(ws + WS_TMP))
#define U8 ((unsigned char*)(ws + WS_U8))
#define V8 ((unsigned char*)(ws + WS_V8))
#define SU ((float*)(ws + WS_SU))
#define SV ((float*)(ws + WS_SV))
#define PA ((int*)(ws + WS_PA))
#define ST ((float*)(ws + WS_ST))
#define WB ((float*)(ws + WS_WB))
#define XQ ((signed char*)(ws + WS_XQ))
#define SX ((float*)(ws + WS_SX))
    for (int u = tid0; u < (LDS_BYTES - LDSCTL_OFF) / 4; u += NTHREADS) ((LAS unsigned*)(lds + LDSCTL_OFF))[u] = 0u;
    __syncthreads();
    XcdBarrier bar; bar.bar = (unsigned*)(ctl + CW_BAR); bar.x = 0; bar.st = nullptr;
    if (!MK_PER_PHASE) bar = xcd_barrier_post((unsigned*)(ctl + CW_BAR), MISC + 8);
    const int lo = args.ph_lo, hi = args.ph_hi;
#ifndef PH_MASK
#define PH_MASK 0xFFF
#endif
#define IN(k) (((PH_MASK >> (k)) & 1) && lo <= (k) && (k) < hi)
#ifndef DBL_BAR
#define DBL_BAR 0
#endif
#define SEAM(k) do { if (IN(k) && IN((k) + 1)) { xcd_barrier(bar); if (DBL_BAR) xcd_barrier(bar); } } while (0)
#ifndef DBL_MASK
#define DBL_MASK 0
#endif
#define REP(k) for (int rep_ = 0; rep_ < 1 + ((DBL_MASK >> (k)) & 1); ++rep_)
#define PHASE_TID() int tid = tid0; asm volatile("" : "+v"(tid)); const int lane = tid & 63, wave = __builtin_amdgcn_readfirstlane(tid >> 6); (void)lane; (void)wave

    if (IN(0)) REP(0) {
        PHASE_TID();
        for (int it = bx; it < 16 * 32; it += G) p0_wf_item(w_q, sub_keys, WfT, lds, it, tid);
        LAS float* scr = (LAS float*)(lds + wave * 16384);
        const int gw = bx * NWAVES + wave, NGW = G * NWAVES;
        constexpr int I_IN = (D / 64) * (IN_W / 32), I_SQ = (D / 64) * (D / 32);
        for (int it = gw; it < I_IN + 3 * I_SQ; it += NGW) {
            int r = it;
            if (r < I_IN) { p0_transpose_item(w_in, D, IN_W, WinT, scr, r, lane); continue; } r -= I_IN;
            if (r < I_SQ) { p0_transpose_item(w_ao, D, D, WaT, scr, r, lane); continue; } r -= I_SQ;
            if (r < I_SQ) { p0_transpose_item(w_co, D, D, WcT, scr, r, lane); continue; } r -= I_SQ;
            p0_transpose_item(w_o, D, D, WoT, scr, r, lane);
        }
        const size_t n8 = (size_t)M * D / 8;
        for (size_t i = (size_t)bx * NTHREADS + tid; i < n8; i += (size_t)G * NTHREADS) {
            const f32x4 a = *((const GAS f32x4*)x_in + 2 * i), b = *((const GAS f32x4*)x_in + 2 * i + 1);
            v4u o; o.x = pk2(a.x, a.y); o.y = pk2(a.z, a.w); o.z = pk2(b.x, b.y); o.w = pk2(b.z, b.w);
            *((GAS v4u*)XB + i) = o;
        }
    }
    SEAM(0);
    if (IN(1)) REP(1) {
        pg8::Gemm g{XB, WinT, M, IN_W, D}; pg8::StaticOrder S; S.init(M, IN_W, G, bx);
        pg8::EpiBf16 E{Z, IN_W};
        pg8::gemm_phase<pg8::EpiBf16, pg8::StaticOrder, true, true>(lds, g, S, E);
        { PHASE_TID();
#ifndef DBL_CONV
#define DBL_CONV 0
#endif
          for (int rep2 = 0; rep2 <= DBL_CONV; ++rep2)
          for (;;) { const int ch = q_pull((unsigned*)(ctl + CW_Q + 64 * (32 + rep2)), lane); if (ch >= 2 * PNE / 16) break;
#pragma unroll 1
              for (int rr = 0; rr < 16; ++rr) { const int r = ch * 16 + rr; const bool sec = r >= PNE; const int e = sec ? r - PNE : r;
                  if (sec) row_to_fp8(peer_v + (size_t)e * D, V8 + (size_t)e * 256, SV + e, lane); else row_to_i8(peer_u + (size_t)e * D, U8 + (size_t)e * 256, SU + e, lane); } } }
    }
    SEAM(1);
    if (IN(2)) REP(2) {
        PHASE_TID();
        for (int u = bx; u < BATCH * NKVH * 16; u += G) attn_unit(u, Z, AO, sinks, lds, tid);
        for (int it = bx; it < M / 32; it += G) conv_item(it, Z, conv_w, CI, tid);
    }
    SEAM(2);
    if (IN(3)) REP(3) {
        pg8::StaticOrder S; S.init(M, D, G, bx);
        { pg8::Gemm g{AO, WaT, M, D, D}; pg8::EpiGate<0> E{TMP, nullptr, Z + G_OFF, b_gate, D, IN_W};
          pg8::gemm_phase<pg8::EpiGate<0>, pg8::StaticOrder, true, true>(lds, g, S, E); }
        { pg8::Gemm g{CI, WcT, M, D, D}; pg8::EpiGate<1> E{MERGED, TMP, Z + G_OFF + D, b_gate + D, D, IN_W};
          pg8::gemm_phase<pg8::EpiGate<1>, pg8::StaticOrder, true, true>(lds, g, S, E); }
    }
    SEAM(3);
    if (IN(4)) REP(4) {
        pg8::Gemm g{MERGED, WoT, M, D, D}; pg8::StaticOrder S; S.init(M, D, G, bx);
        pg8::EpiResBf16 E{H1B, D, x_in, ALPHA};
        pg8::gemm_phase<pg8::EpiResBf16, pg8::StaticOrder, true, true>(lds, g, S, E);
    }
    SEAM(4);
    if (IN(5)) REP(5) {
        PHASE_TID();
        const int gw = bx * NWAVES + wave, NGW = G * NWAVES;
        for (int m = gw; m < M; m += NGW) ln1_row(H1B + (size_t)m * D, XQ + (size_t)m * D, SX + m, ln1_g, ln1_b, lane);
    }
    SEAM(5);
    if (IN(6)) REP(6) {
        pg8::Gemm g{H1B, WfT, M, D, D}; pg8::StaticOrder S; S.init(M, D, G, bx);
        if (G == 256) { EpiTopK E{EX, GT}; pg8::gemm_phase<EpiTopK, pg8::StaticOrder, false, true>(lds, g, S, E); }
        else { pg8::EpiF32 E{SC, D, nullptr, 0.f}; pg8::gemm_phase<pg8::EpiF32, pg8::StaticOrder, true, true>(lds, g, S, E); }
    }
    if (G != 256) SEAM(6);
    if (IN(7)) REP(7) {
        PHASE_TID();
        if (G != 256) for (int p = bx; p < (M * PH) / 128; p += G) topk_pass(p, SC, EX, GT, lds, tid);
    }
    SEAM(7);
    if (IN(8)) REP(8) {
        PHASE_TID();
        const int xcc = (int)(xb_xcc_id() & 7u);
#pragma unroll 1
#ifndef SCRAMBLE
#define SCRAMBLE 0
#endif
        for (int sl = 0; sl < 8; ++sl) { const int s = (xcc + sl + (SCRAMBLE ? wave : 0)) & 7;
            for (;;) { const int tg = q_pull((unsigned*)(ctl + CW_Q + 64 * (s + 16 * rep_)), lane); if (tg >= PEER_NTASK) break;
                int t0, nt; peer_task_tokens(tg, t0, nt); peer_a_task(t0, nt, s, XQ, EX, U8, PA, lane); } }
    }
    SEAM(8);
    if (IN(9)) REP(9) {
        PHASE_TID();
        for (size_t i = (size_t)bx * NTHREADS + tid; i < (size_t)M * 128; i += (size_t)G * NTHREADS) peer_w_elem(i, EX, GT, SU, SV, SX, PA, WB);
    }
    SEAM(9);
    if (IN(10)) REP(10) {
        PHASE_TID();
        const int xcc = (int)(xb_xcc_id() & 7u);
#pragma unroll 1
#ifndef SCRAMBLE
#define SCRAMBLE 0
#endif
        for (int sl = 0; sl < 8; ++sl) { const int s = (xcc + sl + (SCRAMBLE ? wave : 0)) & 7;
            for (;;) { const int tg = q_pull((unsigned*)(ctl + CW_Q + 64 * (8 + s + 16 * rep_)), lane); if (tg >= PEER_NTASK) break;
                int t0, nt; peer_task_tokens(tg, t0, nt); peer_b_task(t0, nt, s, H1B, EX, WB, V8, R2B, ST, lane); } }
    }
    SEAM(10);
    if (IN(11)) REP(11) {
        PHASE_TID();
        const int gw = bx * NWAVES + wave, NGW = G * NWAVES;
        for (int t = gw; t < M; t += NGW) peer_c_row(t, R2B, args.out, ST, ln2_g, ln2_b, lane);
    }
#undef IN
#undef SEAM
}

extern "C" void kernel_launch(void* const* d_in, const int* in_sizes, int n_in, void* d_out, int out_size, void* d_ws, size_t ws_size, hipStream_t stream) {
    static int grid = 0;
    if (grid == 0) {
        if (n_in != 16 || out_size != M * D || ws_size < WS_END) { fprintf(stderr, "kernel_launch: unexpected shapes (n_in %d out %d ws %zu)\n", n_in, out_size, ws_size); grid = -1; return; }
        int dev = 0, cus = 0, per_cu = 0;
        if (hipGetDevice(&dev) != hipSuccess || hipDeviceGetAttribute(&cus, hipDeviceAttributeMultiprocessorCount, dev) != hipSuccess) { grid = -1; return; }
        if (hipFuncSetAttribute((const void*)mk_fwd, hipFuncAttributeMaxDynamicSharedMemorySize, LDS_BYTES) != hipSuccess) { fprintf(stderr, "kernel_launch: hipFuncSetAttribute failed\n"); grid = -1; return; }
        if (hipOccupancyMaxActiveBlocksPerMultiprocessor(&per_cu, (const void*)mk_fwd, NTHREADS, LDS_BYTES) != hipSuccess || per_cu < 1) { fprintf(stderr, "kernel_launch: occupancy query says %d\n", per_cu); per_cu = 1; }
        (void)hipGetLastError();
        if (per_cu > 1) per_cu = 1;
        grid = cus * per_cu;
    }
    if (grid < 0) return;
    if (hipMemsetAsync((char*)d_ws + WS_CTL, 0, CTL_ZERO_BYTES, stream) != hipSuccess) { fprintf(stderr, "kernel_launch: memset failed\n"); return; }
    Args a{};
    for (int i = 0; i < 16; ++i) a.in[i] = (const float*)d_in[i];
    a.out = (float*)d_out; a.ws = (unsigned char*)d_ws;
#if MK_PER_PHASE
    for (int p = 0; p < N_PHASES; ++p) { a.ph_lo = p; a.ph_hi = p + 1; hipLaunchKernelGGL(mk_fwd, dim3(grid), dim3(NTHREADS), LDS_BYTES, stream, a); }
#else
    a.ph_lo = 0; a.ph_hi = N_PHASES;
    void* kargs[] = {&a};
#ifdef PLAIN_LAUNCH
    (void)kargs; hipLaunchKernelGGL(mk_fwd, dim3(grid), dim3(NTHREADS), LDS_BYTES, stream, a); hipError_t e = hipPeekAtLastError();
#else
    hipError_t e = hipLaunchCooperativeKernel((const void*)mk_fwd, dim3(grid), dim3(NTHREADS), kargs, LDS_BYTES, stream);
#endif
    if (e != hipSuccess) fprintf(stderr, "kernel_launch: cooperative launch failed: %s (grid %d)\n", hipGetErrorString(e), grid);
#endif
}
```

```cpp
#include <hip/hip_runtime.h>
#include <cstdio>
#include <cstdint>
namespace pg8 {
#define PG8_LAS __attribute__((address_space(3)))
typedef unsigned short bf16_t;
typedef short bf16x8 __attribute__((ext_vector_type(8)));
typedef float f32x4 __attribute__((ext_vector_type(4)));
typedef unsigned u32x4 __attribute__((ext_vector_type(4)));
constexpr int BM = 256, BK = 64, HALF = 128, HTB = HALF * BK * 2  , STAGE_BYTES = 8 * HTB, NXCD = 8, WGM = 8;

__host__ __device__ __forceinline__ int lds_byte(int r, int c) { const int st = (r >> 4) * 2 + (c >> 5), rr = r & 15, cc = c & 31, ob = rr * 64 + cc * 2; return st * 1024 + (ob ^ (((ob >> 9) & 1) << 5)); }
__host__ __device__ __forceinline__ void stage_rc(int b, int& R, int& C) { const int st = b / 1024, sb = b % 1024, swz = sb ^ (((sb >> 9) & 1) << 5); R = (st >> 1) * 16 + swz / 64; C = (st & 1) * 32 + (swz % 64) / 2; }
__host__ __device__ __forceinline__ int perm32(int rho) { const int n = rho >> 4, i = rho & 15; return 8 * (i >> 2) + 4 * n + (i & 3); }

struct Unit { int pm, pn; };
struct Gemm { const bf16_t* A; const bf16_t* Bt; int M, N, K; };

struct StaticOrder {
    int nM, nN, nwg, G, c;
    __host__ __device__ void init(int M, int N, int G_, int c_) { nM = M / BM; nN = N / BM; nwg = nM * nN; G = G_; c = c_; }
    __host__ __device__ bool next(int i, Unit& u) const {
        const long L = (long)i * G + c; if (L >= nwg) return false;
        int wgid = (int)L; { const int q = nwg / NXCD, r = nwg % NXCD, xcd = wgid % NXCD, off = wgid / NXCD; wgid = (xcd < r ? xcd * (q + 1) : r * (q + 1) + (xcd - r) * q) + off; }
        const int nig = WGM * nN, gid = wgid / nig, fm = gid * WGM, gsz = (nM - fm) < WGM ? (nM - fm) : WGM;
        u.pm = fm + ((wgid % nig) % gsz); u.pn = (wgid % nig) / gsz; return true;
    }
    __device__ __forceinline__ void a_ready(const Unit&) const {}
    __device__ __forceinline__ void done(const Unit&) const {}
};


__device__ __forceinline__ unsigned cvt_pk_bf16(float lo, float hi) { unsigned r; asm volatile("v_cvt_pk_bf16_f32 %0, %1, %2" : "=v"(r) : "v"(lo), "v"(hi)); return r; }
__device__ __forceinline__ float bf_lo(unsigned w) { return __builtin_bit_cast(float, w << 16); }
__device__ __forceinline__ float bf_hi(unsigned w) { return __builtin_bit_cast(float, w & 0xffff0000u); }
__device__ __forceinline__ float sigmoidf_(float x) { return __builtin_amdgcn_rcpf(1.0f + __expf(-x)); }

struct EpiBf16 {
    static constexpr bool PERM = true, AFTER_DRAIN = false;
    bf16_t* O; int ldc;
    __device__ __forceinline__ void operator()(const f32x4 (&acc)[2][2][4][2], const Unit& u, int wr, int wc, int fr, int fq) const {
        const int row0 = u.pm * BM + wr * 64 + fr, col0 = u.pn * BM + wc * 32 + 8 * fq;
#pragma unroll
        for (int ai = 0; ai < 2; ++ai)
#pragma unroll
            for (int m = 0; m < 4; ++m) { bf16_t* rowp = O + (size_t)(row0 + ai * HALF + m * 16) * ldc + col0;
#pragma unroll
                for (int bj = 0; bj < 2; ++bj) { const f32x4 v0 = acc[ai][bj][m][0], v1 = acc[ai][bj][m][1];
                    u32x4 w; w.x = cvt_pk_bf16(v0[0], v0[1]); w.y = cvt_pk_bf16(v0[2], v0[3]); w.z = cvt_pk_bf16(v1[0], v1[1]); w.w = cvt_pk_bf16(v1[2], v1[3]);
                    *(u32x4*)(rowp + bj * HALF) = w; } }
    }
};
template <int SECOND> struct EpiGate {
    static constexpr bool PERM = true, AFTER_DRAIN = false;
    bf16_t* O; const bf16_t* T; const bf16_t* Zg; const float* bg; int ldc, ldz;
    __device__ __forceinline__ void operator()(const f32x4 (&acc)[2][2][4][2], const Unit& u, int wr, int wc, int fr, int fq) const {
        const int row0 = u.pm * BM + wr * 64 + fr, col0 = u.pn * BM + wc * 32 + 8 * fq;
        f32x4 bv[2][2];
#pragma unroll
        for (int bj = 0; bj < 2; ++bj)
#pragma unroll
            for (int n = 0; n < 2; ++n) bv[bj][n] = *(const f32x4*)(bg + col0 + bj * HALF + 4 * n);
#pragma unroll
        for (int ai = 0; ai < 2; ++ai)
#pragma unroll
            for (int m = 0; m < 4; ++m) { const size_t row = (size_t)(row0 + ai * HALF + m * 16);
#pragma unroll
                for (int bj = 0; bj < 2; ++bj) { const int c = col0 + bj * HALF;
                    const u32x4 zg = *(const u32x4*)(Zg + row * ldz + c);
                    f32x4 v0 = acc[ai][bj][m][0], v1 = acc[ai][bj][m][1];
                    v0[0] *= sigmoidf_(bf_lo(zg.x) + bv[bj][0][0]); v0[1] *= sigmoidf_(bf_hi(zg.x) + bv[bj][0][1]);
                    v0[2] *= sigmoidf_(bf_lo(zg.y) + bv[bj][0][2]); v0[3] *= sigmoidf_(bf_hi(zg.y) + bv[bj][0][3]);
                    v1[0] *= sigmoidf_(bf_lo(zg.z) + bv[bj][1][0]); v1[1] *= sigmoidf_(bf_hi(zg.z) + bv[bj][1][1]);
                    v1[2] *= sigmoidf_(bf_lo(zg.w) + bv[bj][1][2]); v1[3] *= sigmoidf_(bf_hi(zg.w) + bv[bj][1][3]);
                    if (SECOND) { const u32x4 t = *(const u32x4*)(T + row * ldc + c);
                        v0[0] += bf_lo(t.x); v0[1] += bf_hi(t.x); v0[2] += bf_lo(t.y); v0[3] += bf_hi(t.y);
                        v1[0] += bf_lo(t.z); v1[1] += bf_hi(t.z); v1[2] += bf_lo(t.w); v1[3] += bf_hi(t.w); }
                    u32x4 w; w.x = cvt_pk_bf16(v0[0], v0[1]); w.y = cvt_pk_bf16(v0[2], v0[3]); w.z = cvt_pk_bf16(v1[0], v1[1]); w.w = cvt_pk_bf16(v1[2], v1[3]);
                    *(u32x4*)(O + row * ldc + c) = w; } }
    }
};
struct EpiF32 {
    static constexpr bool PERM = false, AFTER_DRAIN = false;
    float* C; int ldc; const float* R; float scale;
    __device__ __forceinline__ void operator()(const f32x4 (&acc)[2][2][4][2], const Unit& u, int wr, int wc, int fr, int fq) const {
        const int row0 = u.pm * BM + wr * 64 + fr, col0 = u.pn * BM + wc * 32 + 4 * fq;
#pragma unroll
        for (int ai = 0; ai < 2; ++ai)
#pragma unroll
            for (int m = 0; m < 4; ++m) { const size_t off = (size_t)(row0 + ai * HALF + m * 16) * ldc + col0;
#pragma unroll
                for (int bj = 0; bj < 2; ++bj)
#pragma unroll
                    for (int n = 0; n < 2; ++n) { f32x4 v = acc[ai][bj][m][n];
                        if (R) v += *(const f32x4*)(R + off + bj * HALF + n * 16) * scale;
                        *(f32x4*)(C + off + bj * HALF + n * 16) = v; } }
    }
};
struct EpiResBf16 {
    static constexpr bool PERM = true, AFTER_DRAIN = false;
    bf16_t* O; int ldc; const float* R; float scale;
    __device__ __forceinline__ void operator()(const f32x4 (&acc)[2][2][4][2], const Unit& u, int wr, int wc, int fr, int fq) const {
        const int row0 = u.pm * BM + wr * 64 + fr, col0 = u.pn * BM + wc * 32 + 8 * fq;
#pragma unroll
        for (int ai = 0; ai < 2; ++ai)
#pragma unroll
            for (int m = 0; m < 4; ++m) { const size_t off = (size_t)(row0 + ai * HALF + m * 16) * ldc + col0;
#pragma unroll
                for (int bj = 0; bj < 2; ++bj) { const f32x4 r0 = *(const f32x4*)(R + off + bj * HALF), r1 = *(const f32x4*)(R + off + bj * HALF + 4);
                    const f32x4 v0 = acc[ai][bj][m][0] + r0 * scale, v1 = acc[ai][bj][m][1] + r1 * scale;
                    u32x4 w; w.x = cvt_pk_bf16(v0[0], v0[1]); w.y = cvt_pk_bf16(v0[2], v0[3]); w.z = cvt_pk_bf16(v1[0], v1[1]); w.w = cvt_pk_bf16(v1[2], v1[3]);
                    *(u32x4*)(O + off + bj * HALF) = w; } }
    }
};

template <class Epi, class Sched, bool ALIGN_EPI = false, bool SP2 = false>
__device__ __forceinline__ void gemm_phase(PG8_LAS unsigned char* lds, const Gemm g, const Sched& S, const Epi& E) {
    int tid_ = threadIdx.x; asm volatile("" : "+v"(tid_));
    const int tid = tid_, wid = __builtin_amdgcn_readfirstlane(tid >> 6), lane = tid & 63, wr = wid >> 2, wc = wid & 3, fr = lane & 15, fq = lane >> 4;
    const int K = g.K, nt = K / BK;
    unsigned voffA[2], voffB[2];
#pragma unroll
    for (int i = 0; i < 2; ++i) { int R, C; stage_rc(tid * 16 + i * 8192, R, C); const int Rb = Epi::PERM ? ((R & ~31) + perm32(R & 31)) : R;
        voffA[i] = (unsigned)(R * K + C) * 2u; voffB[i] = (unsigned)(Rb * K + C) * 2u; }
    const size_t kstep = (size_t)(BK * 2);
    const size_t hstep = (size_t)HALF * K * 2;
    const size_t tstep = 2 * hstep;
    const unsigned ldsw = (unsigned)wid * 1024u;
    const int aoff = lds_byte(wr * 64 + fr, fq * 8), boff = lds_byte(wc * 32 + fr, fq * 8);
#define PG8_SA(b, h) (((b) * 2 + (h)) * HTB)
#define PG8_SB(b, h) ((4 + (b) * 2 + (h)) * HTB)
#define PG8_STAGE(bufoff, gbase, voff) do { _Pragma("unroll") for (int _i = 0; _i < 2; ++_i) \
        __builtin_amdgcn_global_load_lds((const unsigned*)((const char*)(gbase) + (voff)[_i]), (PG8_LAS unsigned*)(lds + (bufoff) + ldsw + _i * 8192), 16, 0, 0); } while (0)
#define PG8_LDA(dst, b, h) do { _Pragma("unroll") for (int m = 0; m < 4; ++m) _Pragma("unroll") for (int k = 0; k < 2; ++k) dst[m][k] = *(const PG8_LAS bf16x8*)(lds + PG8_SA(b, h) + aoff + m * 2048 + k * 1024); } while (0)
#define PG8_LDB(dst, b, h) do { _Pragma("unroll") for (int n = 0; n < 2; ++n) _Pragma("unroll") for (int k = 0; k < 2; ++k) dst[n][k] = *(const PG8_LAS bf16x8*)(lds + PG8_SB(b, h) + boff + n * 2048 + k * 1024); } while (0)
#define PG8_MMA(ai, bj, At, Bt) do { __builtin_amdgcn_s_setprio(1); _Pragma("unroll") for (int m = 0; m < 4; ++m) _Pragma("unroll") for (int n = 0; n < 2; ++n) _Pragma("unroll") for (int k = 0; k < 2; ++k) \
        acc[ai][bj][m][n] = __builtin_amdgcn_mfma_f32_16x16x32_bf16(Bt[n][k], At[m][k], acc[ai][bj][m][n], 0, 0, 0); __builtin_amdgcn_s_setprio(0); } while (0)
#define PG8_WAIT_V(n) asm volatile("s_waitcnt vmcnt(" #n ")" ::: "memory")
#define PG8_WAIT_L(n) asm volatile("s_waitcnt lgkmcnt(" #n ")" ::: "memory")
#define PG8_BAR __builtin_amdgcn_s_barrier()
#define PG8_SCHED __builtin_amdgcn_sched_barrier(0)
    Unit cur, nxt; int ui = 0;
    if (!S.next(0, cur)) return;
    f32x4 acc[2][2][4][2];
#pragma unroll
    for (int a = 0; a < 2; ++a)
#pragma unroll
        for (int b = 0; b < 2; ++b)
#pragma unroll
            for (int m = 0; m < 4; ++m)
#pragma unroll
                for (int n = 0; n < 2; ++n) acc[a][b][m][n] = (f32x4){0.f, 0.f, 0.f, 0.f};
    bf16x8 At[4][2], B0[2][2], B1[2][2];
    const char* cA = (const char*)g.A + (size_t)cur.pm * tstep; const char* cB = (const char*)g.Bt + (size_t)cur.pn * tstep;
    S.a_ready(cur);
    if constexpr (SP2) {
        PG8_STAGE(PG8_SB(0, 0), cB, voffB); PG8_STAGE(PG8_SB(0, 1), cB + hstep, voffB); PG8_STAGE(PG8_SA(0, 0), cA, voffA); PG8_STAGE(PG8_SA(0, 1), cA + hstep, voffA);
        if (wr == 1) PG8_BAR;
        PG8_WAIT_V(2); PG8_BAR;
        PG8_STAGE(PG8_SB(1, 0), cB + kstep, voffB); PG8_STAGE(PG8_SA(1, 0), cA + kstep, voffA); PG8_STAGE(PG8_SB(1, 1), cB + hstep + kstep, voffB);
        PG8_WAIT_V(6); PG8_BAR;
    } else {
        PG8_STAGE(PG8_SB(0, 0), cB, voffB); PG8_STAGE(PG8_SA(0, 0), cA, voffA); PG8_STAGE(PG8_SB(0, 1), cB + hstep, voffB); PG8_STAGE(PG8_SA(0, 1), cA + hstep, voffA);
        if (wr == 1) PG8_BAR;
        PG8_WAIT_V(4); PG8_BAR;
        PG8_STAGE(PG8_SB(1, 0), cB + kstep, voffB); PG8_STAGE(PG8_SA(1, 0), cA + kstep, voffA); PG8_STAGE(PG8_SB(1, 1), cB + hstep + kstep, voffB);
        PG8_WAIT_V(6); PG8_BAR;
    }
    for (;;) {
        const bool has_next = S.next(ui + 1, nxt);
        const char* nA = has_next ? (const char*)g.A + (size_t)nxt.pm * tstep : cA; const char* nB = has_next ? (const char*)g.Bt + (size_t)nxt.pn * tstep : cB;
        for (int t = 0; t < nt; t += 2) {
            const bool last = (t == nt - 2);
            const char* a1 = cA + (size_t)(t + 1) * kstep;
            const char* a2 = last ? nA : cA + (size_t)(t + 2) * kstep; const char* b2 = last ? nB : cB + (size_t)(t + 2) * kstep;
            const char* a3 = a2 + kstep; const char* b3 = b2 + kstep;
            if (last && has_next) S.a_ready(nxt);
            if constexpr (SP2) {
            PG8_LDB(B0, 0, 0); PG8_LDB(B1, 0, 1); PG8_SCHED; PG8_LDA(At, 0, 0); PG8_STAGE(PG8_SA(1, 1), a1 + hstep, voffA);
            PG8_WAIT_V(8); PG8_WAIT_L(0); PG8_BAR; PG8_MMA(0, 0, At, B0); PG8_MMA(0, 1, At, B1); PG8_BAR; PG8_SCHED;
            PG8_LDA(At, 0, 1); PG8_STAGE(PG8_SB(0, 0), b2, voffB); PG8_STAGE(PG8_SB(0, 1), b2 + hstep, voffB); PG8_STAGE(PG8_SA(0, 0), a2, voffA);
            PG8_WAIT_V(8); PG8_WAIT_L(0); PG8_BAR; PG8_MMA(1, 0, At, B0); PG8_MMA(1, 1, At, B1); PG8_BAR; PG8_SCHED;
            PG8_LDB(B0, 1, 0); PG8_LDB(B1, 1, 1); PG8_SCHED; PG8_LDA(At, 1, 0); PG8_STAGE(PG8_SA(0, 1), a2 + hstep, voffA);
            PG8_WAIT_V(8); PG8_WAIT_L(0); PG8_BAR; PG8_MMA(0, 0, At, B0); PG8_MMA(0, 1, At, B1); PG8_BAR; PG8_SCHED;
            PG8_LDA(At, 1, 1); PG8_STAGE(PG8_SB(1, 0), b3, voffB); PG8_STAGE(PG8_SB(1, 1), b3 + hstep, voffB); PG8_STAGE(PG8_SA(1, 0), a3, voffA);
            PG8_WAIT_V(8); PG8_WAIT_L(0); PG8_BAR; PG8_MMA(1, 0, At, B0); PG8_MMA(1, 1, At, B1); PG8_BAR; PG8_SCHED;
            } else {
            PG8_LDB(B0, 0, 0); PG8_SCHED; PG8_LDA(At, 0, 0); PG8_STAGE(PG8_SA(1, 1), a1 + hstep, voffA);
            PG8_WAIT_L(8); PG8_BAR; PG8_WAIT_L(0); PG8_MMA(0, 0, At, B0); PG8_BAR; PG8_SCHED;
            PG8_LDB(B1, 0, 1); PG8_STAGE(PG8_SB(0, 0), b2, voffB);
            PG8_BAR; PG8_WAIT_L(0); PG8_MMA(0, 1, At, B1); PG8_BAR;
            PG8_LDA(At, 0, 1); PG8_STAGE(PG8_SA(0, 0), a2, voffA);
            PG8_BAR; PG8_WAIT_L(0); PG8_MMA(1, 0, At, B0); PG8_BAR; PG8_SCHED;
            PG8_STAGE(PG8_SB(0, 1), b2 + hstep, voffB);
            PG8_WAIT_V(6); PG8_BAR; PG8_MMA(1, 1, At, B1); PG8_BAR;
            PG8_LDB(B0, 1, 0); PG8_SCHED; PG8_LDA(At, 1, 0); PG8_STAGE(PG8_SA(0, 1), a2 + hstep, voffA);
            PG8_WAIT_L(8); PG8_BAR; PG8_WAIT_L(0); PG8_MMA(0, 0, At, B0); PG8_BAR; PG8_SCHED;
            PG8_LDB(B1, 1, 1); PG8_STAGE(PG8_SB(1, 0), b3, voffB);
            PG8_BAR; PG8_WAIT_L(0); PG8_MMA(0, 1, At, B1); PG8_BAR;
            PG8_LDA(At, 1, 1); PG8_STAGE(PG8_SA(1, 0), a3, voffA);
            PG8_BAR; PG8_WAIT_L(0); PG8_MMA(1, 0, At, B0); PG8_BAR; PG8_SCHED;
            PG8_STAGE(PG8_SB(1, 1), b3 + hstep, voffB);
            PG8_WAIT_V(6); PG8_BAR; PG8_MMA(1, 1, At, B1); PG8_BAR;
            }
        }
        if constexpr (ALIGN_EPI) { if (wr == 0) PG8_BAR; }
        if constexpr (!Epi::AFTER_DRAIN) { E(acc, cur, wr, wc, fr, fq); S.done(cur); }
        if (!has_next) break;
#pragma unroll
        for (int a = 0; a < 2; ++a)
#pragma unroll
            for (int b = 0; b < 2; ++b)
#pragma unroll
                for (int m = 0; m < 4; ++m)
#pragma unroll
                    for (int n = 0; n < 2; ++n) acc[a][b][m][n] = (f32x4){0.f, 0.f, 0.f, 0.f};
        cur = nxt; cA = nA; cB = nB; ++ui;
        if constexpr (ALIGN_EPI) { if (wr == 1) PG8_BAR; }
    }
    PG8_WAIT_V(0);
    if constexpr (!ALIGN_EPI) { if (wr == 0) PG8_BAR; }
    PG8_BAR;
    if constexpr (Epi::AFTER_DRAIN) { E.fused(acc, cur, wr, wc, fr, fq, lds, wid, lane); S.done(cur); }
#undef PG8_SA
#undef PG8_SB
#undef PG8_STAGE
#undef PG8_LDA
#undef PG8_LDB
#undef PG8_MMA
#undef PG8_WAIT_V
#undef PG8_WAIT_L
#undef PG8_BAR
#undef PG8_SCHED
}
}
#define GAS __attribute__((address_space(1)))
#define LAS __attribute__((address_space(3)))
typedef unsigned short bf16;
typedef unsigned v4u __attribute__((ext_vector_type(4)));
typedef float f32x4 __attribute__((ext_vector_type(4)));
typedef short bf16x8 __attribute__((ext_vector_type(8)));
typedef GAS unsigned gu32;
typedef GAS unsigned long long gu64;
#define RLX_AGENT __ATOMIC_RELAXED, __HIP_MEMORY_SCOPE_AGENT
#define LDS_WAIT() asm volatile("s_waitcnt lgkmcnt(0)" ::: "memory")
#define VM_WAIT() asm volatile("s_waitcnt vmcnt(0)" ::: "memory")
__device__ __forceinline__ unsigned long long rt() { return __builtin_amdgcn_s_memrealtime(); }
__device__ __forceinline__ unsigned f2bf(float f) { unsigned u = __builtin_bit_cast(unsigned, f); return (u + 0x7fffu + ((u >> 16) & 1u)) >> 16; }
__device__ __forceinline__ unsigned pk2(float lo, float hi) { return f2bf(lo) | (f2bf(hi) << 16); }

#define XB_TMO      128
#define XB_XCNT(j)  (256  + 64 * (j))
#define XB_XSUB(j)  (1280 + 64 * (j))
#define XB_XGEN(j)  (2304 + 64 * (j))
#define XB_TOP      3328
#define XB_TOPGEN   3392
#define XCD_BAR_WORDS 3456
#define XB_SPIN_CAP (1u << 18)

__device__ __forceinline__ unsigned xb_ld(unsigned* p)              { return __hip_atomic_load(p, __ATOMIC_RELAXED, __HIP_MEMORY_SCOPE_AGENT); }
__device__ __forceinline__ unsigned xb_add(unsigned* p, unsigned v) { return __hip_atomic_fetch_add(p, v, __ATOMIC_RELAXED, __HIP_MEMORY_SCOPE_AGENT); }
__device__ __forceinline__ unsigned xb_xcc_id() { return (unsigned)__builtin_amdgcn_s_getreg((3 << 11) | 20) & 0xFu; }
#define XB_SPIN(cond, bar) do { unsigned _sp = 0; while (cond) { __builtin_amdgcn_s_sleep(1); \
    if ((++_sp & 255u) == 0u) { if (xb_ld(&(bar)[XB_TMO])) break; if (_sp > XB_SPIN_CAP) { atomicAdd(&(bar)[XB_TMO], 1u); break; } } } } while (0)

struct XcdBarrier {
    unsigned* bar; unsigned x;
    volatile LAS unsigned* st;
};

__device__ __forceinline__ XcdBarrier xcd_barrier_post(unsigned* bar, volatile LAS unsigned* st) {
    XcdBarrier b; b.bar = bar; b.x = xb_xcc_id(); b.st = st;
    if (threadIdx.x == 0) (void)xb_add(&bar[XB_XCNT(b.x)], 1u);
    return b;
}
__device__ __forceinline__ void xcd_barrier_complete(unsigned* bar, unsigned x, unsigned& nloc, unsigned& nx) {
    const unsigned G = gridDim.x * gridDim.y * gridDim.z;
    unsigned sum, cnt, mine, sp = 0u;
    for (;;) {
        sum = 0u; cnt = 0u; mine = 0u;
#pragma unroll
        for (unsigned j = 0; j < 16; ++j) { const unsigned c = xb_ld(&bar[XB_XCNT(j)]); sum += c; cnt += (c > 0u) ? 1u : 0u; mine = (j == x) ? c : mine; }
        if (sum == G) break;
        __builtin_amdgcn_s_sleep(1);
        if ((++sp & 255u) == 0u) { if (xb_ld(&bar[XB_TMO])) break; if (sp > XB_SPIN_CAP) { atomicAdd(&bar[XB_TMO], 1u); break; } }
    }
    nloc = mine > 0u ? mine : 1u; nx = cnt > 0u ? cnt : 1u;
}

__device__ __forceinline__ void xcd_barrier(const XcdBarrier& b) {
    asm volatile("s_waitcnt vmcnt(0)" ::: "memory");
    __syncthreads();
    if (threadIdx.x == 0) {
        unsigned* bar = b.bar;
        __builtin_amdgcn_s_waitcnt(0);
        unsigned nloc = b.st[0], nx = b.st[1];
        if (nloc == 0u) { xcd_barrier_complete(bar, b.x, nloc, nx); b.st[0] = nloc; b.st[1] = nx; }
        const unsigned old = xb_add(&bar[XB_XSUB(b.x)], 1u);
        const unsigned gen = old / nloc;
        if (old + 1u == (gen + 1u) * nloc) {
            __builtin_amdgcn_fence(__ATOMIC_RELEASE, "agent");
            asm volatile("s_waitcnt vmcnt(0)" ::: "memory");
            const unsigned og = xb_add(&bar[XB_TOP], 1u);
            const unsigned tg = og / nx;
            if (og + 1u == (tg + 1u) * nx) xb_add(&bar[XB_TOPGEN], 1u);
            else XB_SPIN(xb_ld(&bar[XB_TOPGEN]) == tg, bar);
            __builtin_amdgcn_fence(__ATOMIC_ACQUIRE, "agent");
            xb_add(&bar[XB_XGEN(b.x)], 1u);
            asm volatile("s_waitcnt vmcnt(0)" ::: "memory");
        } else {
            XB_SPIN(xb_ld(&bar[XB_XGEN(b.x)]) == gen, bar);
            __builtin_amdgcn_fence(__ATOMIC_ACQUIRE, "agent");
            asm volatile("s_waitcnt vmcnt(0)" ::: "memory");
        }
    }
    __syncthreads();
}

constexpr int NWAVES = 8, NTHREADS = 512;
constexpr int BATCH = 4, SEQ = 2048, D = 2048, M = BATCH * SEQ;
constexpr int NQH = 32, NKVH = 4, HD = 64, QPKV = 8, WINDOW = 128;
constexpr int Q_OFF = 0, K_OFF = 2048, V_OFF = 2304, CB_OFF = 2560, CC_OFF = 4608, CH_OFF = 6656, G_OFF = 8704, IN_W = 12800;
constexpr int PH = 8, PNK = 128, PTOPK = 16, PNE = 16384;
constexpr float LN_EPS = 1e-5f;
constexpr float ALPHA = 1.189207115002721f;

#ifndef MK_PER_PHASE
#define MK_PER_PHASE 0
#endif
constexpr int N_PHASES = 12;

constexpr size_t MiB = 1u << 20;
constexpr size_t WS_CTL = 0, CTL_ZERO_BYTES = 1 * MiB;
constexpr size_t WS_WIN = 1 * MiB;
constexpr size_t WS_WA = 51 * MiB, WS_WC = 59 * MiB, WS_WO = 67 * MiB, WS_WF = 75 * MiB;
constexpr size_t WS_XB = 83 * MiB;
constexpr size_t WS_MERGED = WS_XB;
constexpr size_t WS_Z = 115 * MiB;
constexpr size_t WS_R2B = 115 * MiB;
constexpr size_t WS_H1B = 179 * MiB;
constexpr size_t WS_SC = 211 * MiB;
constexpr size_t WS_EX = 275 * MiB;
constexpr size_t WS_GT = 279 * MiB;
constexpr size_t WS_AO = 315 * MiB, WS_CI = 347 * MiB, WS_TMP = 379 * MiB;
constexpr size_t WS_U8 = 411 * MiB, WS_V8 = 443 * MiB;
constexpr size_t WS_SU = 475 * MiB, WS_SV = WS_SU + 65536;
constexpr size_t WS_PA = WS_SC;
constexpr size_t WS_XQ = 283 * MiB;
constexpr size_t WS_SX = 299 * MiB;
constexpr size_t WS_WB = 380 * MiB;
constexpr size_t WS_ST = 379 * MiB;
constexpr size_t WS_END = 476 * MiB;
constexpr int CW_Q = 12288;
constexpr size_t SLICE_BYTES = (size_t)PNE * 256;
constexpr int CW_BAR = 4096;

constexpr int RING_BYTES = 131072;
constexpr int LDSCTL_OFF = 147456, MISC_OFF = LDSCTL_OFF + 320;
constexpr int LDS_BYTES = LDSCTL_OFF + 512;

typedef float f32x16 __attribute__((ext_vector_type(16)));
typedef unsigned v2u __attribute__((ext_vector_type(2)));
__device__ __forceinline__ float wave_sum(float v) {
#pragma unroll
    for (int o = 1; o < 64; o <<= 1) v += __shfl_xor(v, o);
    return v;
}
__device__ __forceinline__ float vmaxf(float a, float b) { float r; asm("v_max_f32_e32 %0, %1, %2" : "=v"(r) : "v"(a), "v"(b)); return r; }
__device__ __forceinline__ float vminf(float a, float b) { float r; asm("v_min_f32_e32 %0, %1, %2" : "=v"(r) : "v"(a), "v"(b)); return r; }

__device__ __forceinline__ void p0_transpose_item(const float* W, int K, int N, bf16* WT, LAS float* scr, int item, int lane) {
    const int nblk = N / 32, kb = item / nblk, nb = item % nblk, k0 = 64 * kb, n0 = 32 * nb;
#pragma unroll 8
    for (int i = 0; i < 32; ++i) { const int kk = 2 * i + (lane >> 5); scr[kk * 33 + (lane & 31)] = W[(size_t)(k0 + kk) * N + n0 + (lane & 31)]; }
    LDS_WAIT(); asm volatile("" ::: "memory");
    const int c = lane & 7;
#pragma unroll
    for (int j = 0; j < 4; ++j) { const int n = (lane >> 3) + 8 * j; const LAS float* s = scr + (8 * c) * 33 + n;
        v4u o; o.x = pk2(s[0 * 33], s[1 * 33]); o.y = pk2(s[2 * 33], s[3 * 33]); o.z = pk2(s[4 * 33], s[5 * 33]); o.w = pk2(s[6 * 33], s[7 * 33]);
        *(GAS v4u*)(WT + (size_t)(n0 + n) * K + k0 + 8 * c) = o; }
    LDS_WAIT(); asm volatile("" ::: "memory");
}
__device__ __forceinline__ void p0_wf_item(const float* wq, const float* sk, bf16* WfT, LAS unsigned char* lds, int item, int tid) {
    const int hp = item >> 5, dt = item & 31;
    LAS f32x4* SK4 = (LAS f32x4*)lds;
    LAS f32x4* WQ4 = SK4 + 128 * 33;
    const float* skp = sk + (size_t)hp * 128 * 128;
    for (int i = tid; i < 128 * 32; i += NTHREADS) { const int n = i >> 5, c4 = i & 31; SK4[n * 33 + c4] = *(const f32x4*)(skp + n * 128 + 4 * c4); }
    for (int i = tid; i < 64 * 32; i += NTHREADS) { const int r = i >> 5, c4 = i & 31; WQ4[r * 33 + c4] = *(const f32x4*)(wq + (size_t)(64 * dt + r) * 2048 + hp * 128 + 4 * c4); }
    __syncthreads();
    const int td = tid & 15, tn = tid >> 4;
    float acc[4][4];
#pragma unroll
    for (int i = 0; i < 4; ++i)
#pragma unroll
        for (int j = 0; j < 4; ++j) acc[i][j] = 0.f;
#pragma unroll 4
    for (int c4 = 0; c4 < 32; ++c4) {
        f32x4 a[4], b[4];
#pragma unroll
        for (int i = 0; i < 4; ++i) a[i] = SK4[(4 * tn + i) * 33 + c4];
#pragma unroll
        for (int j = 0; j < 4; ++j) b[j] = WQ4[(td + 16 * j) * 33 + c4];
#pragma unroll
        for (int i = 0; i < 4; ++i)
#pragma unroll
            for (int j = 0; j < 4; ++j) acc[i][j] += a[i].x * b[j].x + a[i].y * b[j].y + a[i].z * b[j].z + a[i].w * b[j].w;
    }
#pragma unroll
    for (int i = 0; i < 4; ++i)
#pragma unroll
        for (int j = 0; j < 4; ++j) WfT[(size_t)(hp * 128 + 4 * tn + i) * 2048 + 64 * dt + td + 16 * j] = (bf16)f2bf(acc[i][j]);
    __syncthreads();
}

__device__ __forceinline__ int perm16(int o) { return 8 * ((o >> 2) & 1) + 4 * (o >> 3) + (o & 3); }
__device__ __forceinline__ void attn_unit(int unit, const bf16* z, bf16* ao, const float* sinks, LAS unsigned char* lds, int tid) {
    const int lane = tid & 63, wid = __builtin_amdgcn_readfirstlane(tid >> 6), r32 = lane & 31, hi = lane >> 5;
    const int nb = unit & 15, kvh = (unit >> 4) & 3, b = unit >> 6;
    LAS bf16* Ks = (LAS bf16*)lds;
    LAS bf16* Vt = (LAS bf16*)(lds + 256 * 144);
    const size_t tok0 = (size_t)b * SEQ;
#pragma unroll
    for (int i = 0; i < 4; ++i) {
        const int ci = tid + NTHREADS * i, key = ci >> 3, dc = ci & 7;
        int kpos = 128 * (nb - 1) + key; if (kpos < 0) kpos = 0;
        const bf16* src = z + (tok0 + kpos) * IN_W + K_OFF + kvh * HD + dc * 8;
        const v4u kv = *(const GAS v4u*)src, vv = *(const GAS v4u*)(src + (V_OFF - K_OFF));
        *(LAS v4u*)(Ks + key * 72 + dc * 8) = kv;
        const int pos = (key & ~15) + perm16(key & 15);
        LAS bf16* vp = Vt + (dc * 8) * 264 + pos;
        vp[0 * 264] = (bf16)(vv.x & 0xffffu); vp[1 * 264] = (bf16)(vv.x >> 16); vp[2 * 264] = (bf16)(vv.y & 0xffffu); vp[3 * 264] = (bf16)(vv.y >> 16);
        vp[4 * 264] = (bf16)(vv.z & 0xffffu); vp[5 * 264] = (bf16)(vv.z >> 16); vp[6 * 264] = (bf16)(vv.w & 0xffffu); vp[7 * 264] = (bf16)(vv.w >> 16);
    }
    __syncthreads();
    const int hq = kvh * QPKV + wid;
    const float LOG2E = 1.4426950408889634f;
    const float sink2 = sinks[hq] * LOG2E, sc = 0.125f * LOG2E;
#pragma unroll 1
    for (int qg = 0; qg < 4; ++qg) {
        const size_t tok = tok0 + 128 * nb + 32 * qg + r32;
        bf16x8 qf[4];
#pragma unroll
        for (int ks = 0; ks < 4; ++ks) qf[ks] = *(const GAS bf16x8*)(z + tok * IN_W + Q_OFF + hq * HD + 16 * ks + 8 * hi);
        f32x16 s[5];
#pragma unroll
        for (int kt = 0; kt < 5; ++kt) {
            s[kt] = (f32x16){0.f, 0.f, 0.f, 0.f, 0.f, 0.f, 0.f, 0.f, 0.f, 0.f, 0.f, 0.f, 0.f, 0.f, 0.f, 0.f};
#pragma unroll
            for (int ks = 0; ks < 4; ++ks) {
                const bf16x8 kf = *(const LAS bf16x8*)(Ks + (32 * (qg + kt) + r32) * 72 + 16 * ks + 8 * hi);
                s[kt] = __builtin_amdgcn_mfma_f32_32x32x16_bf16(kf, qf[ks], s[kt], 0, 0, 0);
            }
        }
        float mx = sink2;
#pragma unroll
        for (int kt = 0; kt < 5; ++kt) {
            const bool tile_dead = (nb == 0) && (qg + kt < 4);
#pragma unroll
            for (int r = 0; r < 16; ++r) {
                const int krow = (r & 3) + 8 * (r >> 2) + 4 * hi;
                bool valid = !tile_dead;
                if (kt == 0) valid = valid && (krow > r32);
                if (kt == 4) valid = valid && (krow <= r32);
                const float v = valid ? s[kt][r] * sc : -INFINITY;
                s[kt][r] = v; mx = fmaxf(mx, v);
            }
        }
        mx = fmaxf(mx, __shfl_xor(mx, 32));
        float sum = 0.f;
#pragma unroll
        for (int kt = 0; kt < 5; ++kt)
#pragma unroll
            for (int r = 0; r < 16; ++r) { const float p = __builtin_amdgcn_exp2f(s[kt][r] - mx); s[kt][r] = p; sum += p; }
        sum += __shfl_xor(sum, 32);
        const float inv = 1.0f / (sum + __builtin_amdgcn_exp2f(sink2 - mx));
        f32x16 o[2];
        o[0] = (f32x16){0.f, 0.f, 0.f, 0.f, 0.f, 0.f, 0.f, 0.f, 0.f, 0.f, 0.f, 0.f, 0.f, 0.f, 0.f, 0.f}; o[1] = o[0];
#pragma unroll
        for (int kt = 0; kt < 5; ++kt)
#pragma unroll
            for (int s2 = 0; s2 < 2; ++s2) {
                v4u pw; pw.x = pg8::cvt_pk_bf16(s[kt][8 * s2 + 0], s[kt][8 * s2 + 1]); pw.y = pg8::cvt_pk_bf16(s[kt][8 * s2 + 2], s[kt][8 * s2 + 3]);
                pw.z = pg8::cvt_pk_bf16(s[kt][8 * s2 + 4], s[kt][8 * s2 + 5]); pw.w = pg8::cvt_pk_bf16(s[kt][8 * s2 + 6], s[kt][8 * s2 + 7]);
                const bf16x8 pa = __builtin_bit_cast(bf16x8, pw);
#pragma unroll
                for (int dt = 0; dt < 2; ++dt) {
                    const bf16x8 vf = *(const LAS bf16x8*)(Vt + (32 * dt + r32) * 264 + 32 * (qg + kt) + 16 * s2 + 8 * hi);
                    o[dt] = __builtin_amdgcn_mfma_f32_32x32x16_bf16(vf, pa, o[dt], 0, 0, 0);
                }
            }
        bf16* op = ao + tok * D + hq * HD;
#pragma unroll
        for (int dt = 0; dt < 2; ++dt)
#pragma unroll
            for (int g = 0; g < 4; ++g) {
                v2u w; w.x = pg8::cvt_pk_bf16(o[dt][4 * g + 0] * inv, o[dt][4 * g + 1] * inv); w.y = pg8::cvt_pk_bf16(o[dt][4 * g + 2] * inv, o[dt][4 * g + 3] * inv);
                *(GAS v2u*)(op + 32 * dt + 8 * g + 4 * hi) = w;
            }
    }
    __syncthreads();
}
__device__ __forceinline__ void conv_item(int item, const bf16* z, const float* cw, bf16* ci, int tid) {
    const int c8 = tid & 255, half = tid >> 8, t0 = 32 * item + 16 * half, c0 = 8 * c8;
    float w0[8], w1[8], w2[8], u1[8], u2[8];
#pragma unroll
    for (int e = 0; e < 8; ++e) { w0[e] = cw[c0 + e]; w1[e] = cw[2048 + c0 + e]; w2[e] = cw[4096 + c0 + e]; u1[e] = 0.f; u2[e] = 0.f; }
    if ((t0 & (SEQ - 1)) != 0) {
#pragma unroll
        for (int k = 0; k < 2; ++k) {
            const bf16* zr = z + (size_t)(t0 - 2 + k) * IN_W + c0;
            const v4u a = *(const GAS v4u*)(zr + CC_OFF), h = *(const GAS v4u*)(zr + CH_OFF);
            float u[8];
            u[0] = pg8::bf_lo(a.x) * pg8::bf_lo(h.x); u[1] = pg8::bf_hi(a.x) * pg8::bf_hi(h.x); u[2] = pg8::bf_lo(a.y) * pg8::bf_lo(h.y); u[3] = pg8::bf_hi(a.y) * pg8::bf_hi(h.y);
            u[4] = pg8::bf_lo(a.z) * pg8::bf_lo(h.z); u[5] = pg8::bf_hi(a.z) * pg8::bf_hi(h.z); u[6] = pg8::bf_lo(a.w) * pg8::bf_lo(h.w); u[7] = pg8::bf_hi(a.w) * pg8::bf_hi(h.w);
#pragma unroll
            for (int e = 0; e < 8; ++e) { if (k == 0) u2[e] = u[e]; else u1[e] = u[e]; }
        }
    }
#pragma unroll 4
    for (int i = 0; i < 16; ++i) {
        const bf16* zr = z + (size_t)(t0 + i) * IN_W + c0;
        const v4u a = *(const GAS v4u*)(zr + CC_OFF), h = *(const GAS v4u*)(zr + CH_OFF), bb = *(const GAS v4u*)(zr + CB_OFF);
        float u[8], cb[8], y[8];
        u[0] = pg8::bf_lo(a.x) * pg8::bf_lo(h.x); u[1] = pg8::bf_hi(a.x) * pg8::bf_hi(h.x); u[2] = pg8::bf_lo(a.y) * pg8::bf_lo(h.y); u[3] = pg8::bf_hi(a.y) * pg8::bf_hi(h.y);
        u[4] = pg8::bf_lo(a.z) * pg8::bf_lo(h.z); u[5] = pg8::bf_hi(a.z) * pg8::bf_hi(h.z); u[6] = pg8::bf_lo(a.w) * pg8::bf_lo(h.w); u[7] = pg8::bf_hi(a.w) * pg8::bf_hi(h.w);
        cb[0] = pg8::bf_lo(bb.x); cb[1] = pg8::bf_hi(bb.x); cb[2] = pg8::bf_lo(bb.y); cb[3] = pg8::bf_hi(bb.y); cb[4] = pg8::bf_lo(bb.z); cb[5] = pg8::bf_hi(bb.z); cb[6] = pg8::bf_lo(bb.w); cb[7] = pg8::bf_hi(bb.w);
#pragma unroll
        for (int e = 0; e < 8; ++e) { y[e] = cb[e] * (w0[e] * u2[e] + w1[e] * u1[e] + w2[e] * u[e]); u2[e] = u1[e]; u1[e] = u[e]; }
        v4u o; o.x = pk2(y[0], y[1]); o.y = pk2(y[2], y[3]); o.z = pk2(y[4], y[5]); o.w = pk2(y[6], y[7]);
        *(GAS v4u*)(ci + (size_t)(t0 + i) * D + c0) = o;
    }
}

__device__ __forceinline__ unsigned pack_i8(const f32x4 v) {
    const int a = __float2int_rn(v.x), b = __float2int_rn(v.y), c = __float2int_rn(v.z), d = __float2int_rn(v.w);
    return ((unsigned)a & 0xffu) | (((unsigned)b & 0xffu) << 8) | (((unsigned)c & 0xffu) << 16) | ((unsigned)d << 24);
}
__device__ __forceinline__ unsigned pack_i8_2(float a, float b, float c, float d) {
    const int ia = __float2int_rn(a), ib = __float2int_rn(b), ic = __float2int_rn(c), id = __float2int_rn(d);
    return ((unsigned)ia & 0xffu) | (((unsigned)ib & 0xffu) << 8) | (((unsigned)ic & 0xffu) << 16) | ((unsigned)id << 24);
}
__device__ __forceinline__ void ln1_row(bf16* hbrow, signed char* xqrow, float* sxp, const float* g, const float* bta, int lane) {
    GAS v4u* xr = (GAS v4u*)hbrow + lane;
    float v[4][8]; float s = 0.f;
#pragma unroll
    for (int j = 0; j < 4; ++j) { const v4u w = xr[64 * j];
        v[j][0] = pg8::bf_lo(w.x); v[j][1] = pg8::bf_hi(w.x); v[j][2] = pg8::bf_lo(w.y); v[j][3] = pg8::bf_hi(w.y); v[j][4] = pg8::bf_lo(w.z); v[j][5] = pg8::bf_hi(w.z); v[j][6] = pg8::bf_lo(w.w); v[j][7] = pg8::bf_hi(w.w);
#pragma unroll
        for (int e = 0; e < 8; ++e) s += v[j][e]; }
    const float mean = wave_sum(s) * (1.f / D); float s2 = 0.f;
#pragma unroll
    for (int j = 0; j < 4; ++j)
#pragma unroll
        for (int e = 0; e < 8; ++e) { v[j][e] -= mean; s2 += v[j][e] * v[j][e]; }
    const float rstd = 1.f / sqrtf(wave_sum(s2) * (1.f / D) + LN_EPS);
    float mx = 0.f;
#pragma unroll
    for (int j = 0; j < 4; ++j) {
        const GAS f32x4* gp = (const GAS f32x4*)g + 2 * (lane + 64 * j); const GAS f32x4* bp = (const GAS f32x4*)bta + 2 * (lane + 64 * j);
        const f32x4 g0 = gp[0], g1 = gp[1], b0 = bp[0], b1 = bp[1];
        v[j][0] = v[j][0] * rstd * g0.x + b0.x; v[j][1] = v[j][1] * rstd * g0.y + b0.y; v[j][2] = v[j][2] * rstd * g0.z + b0.z; v[j][3] = v[j][3] * rstd * g0.w + b0.w;
        v[j][4] = v[j][4] * rstd * g1.x + b1.x; v[j][5] = v[j][5] * rstd * g1.y + b1.y; v[j][6] = v[j][6] * rstd * g1.z + b1.z; v[j][7] = v[j][7] * rstd * g1.w + b1.w;
        v4u o; o.x = pk2(v[j][0], v[j][1]); o.y = pk2(v[j][2], v[j][3]); o.z = pk2(v[j][4], v[j][5]); o.w = pk2(v[j][6], v[j][7]);
        xr[64 * j] = o;
#pragma unroll
        for (int e = 0; e < 8; ++e) mx = fmaxf(mx, fabsf(v[j][e]));
    }
#pragma unroll
    for (int o = 1; o < 64; o <<= 1) mx = fmaxf(mx, __shfl_xor(mx, o));
    const float qs = mx > 0.f ? 127.0f / mx : 1.0f;
    GAS v2u* q8 = (GAS v2u*)xqrow + lane;
#pragma unroll
    for (int j = 0; j < 4; ++j) { v2u o; o.x = pack_i8_2(v[j][0] * qs, v[j][1] * qs, v[j][2] * qs, v[j][3] * qs); o.y = pack_i8_2(v[j][4] * qs, v[j][5] * qs, v[j][6] * qs, v[j][7] * qs); q8[64 * j] = o; }
    if (lane == 0) *sxp = mx > 0.f ? mx * (1.0f / 127.0f) : 1.0f;
}

constexpr int TK_ROWF = 136;
constexpr int TK_IDX_OFF = 256 * TK_ROWF * 4;
__device__ __forceinline__ void topk_core(LAS unsigned char* lds, size_t prob0, int pstride, int* experts, float* gates, int tid) {
    LAS float* S = (LAS float*)lds;
    LAS unsigned char* IDX = lds + TK_IDX_OFF;
    const int row = tid >> 1, sub = tid & 1;
#define TK_CE(a, b) do { const float h_ = vmaxf(a, b), l_ = vminf(a, b); a = h_; b = l_; } while (0)
#define TK_SORT16(V) do { _Pragma("unroll") for (int k_ = 2; k_ <= 16; k_ <<= 1) _Pragma("unroll") for (int j_ = k_ >> 1; j_ > 0; j_ >>= 1) _Pragma("unroll") for (int i_ = 0; i_ < 16; ++i_) { \
        const int l_i = i_ ^ j_; if (l_i > i_) { if ((i_ & k_) == 0) TK_CE(V[i_], V[l_i]); else TK_CE(V[l_i], V[i_]); } } } while (0)
#define TK_MERGE16(Lv, Xv) do { _Pragma("unroll") for (int j_ = 0; j_ < 16; ++j_) Lv[j_] = vmaxf(Lv[j_], Xv[15 - j_]); \
        _Pragma("unroll") for (int st_ = 8; st_ >= 1; st_ >>= 1) _Pragma("unroll") for (int j_ = 0; j_ < 16; ++j_) if ((j_ & st_) == 0) TK_CE(Lv[j_], Lv[j_ + st_]); } while (0)
    float L[16];
#pragma unroll
    for (int q = 0; q < 4; ++q) {
        float C[16];
#pragma unroll
        for (int i = 0; i < 4; ++i) { const int c4 = 2 * (4 * q + i) + sub;
            const f32x4 v = *(const LAS f32x4*)(S + row * TK_ROWF + 4 * c4);
#pragma unroll
            for (int e = 0; e < 4; ++e) { const float ve = v[e];
                C[4 * i + e] = __uint_as_float((__float_as_uint(ve) & ~0x7Fu) | (unsigned)(4 * c4 + e)); } }
        TK_SORT16(C);
        if (q == 0) {
#pragma unroll
            for (int j = 0; j < 16; ++j) L[j] = C[j];
        } else TK_MERGE16(L, C);
    }
    {
        float P[16];
#pragma unroll
        for (int j = 0; j < 16; ++j) P[j] = __shfl_xor(L[j], 1);
        TK_MERGE16(L, P);
    }
    if (sub == 0) {
#pragma unroll
        for (int q = 0; q < 4; ++q) {
            unsigned w = 0;
#pragma unroll
            for (int e = 0; e < 4; ++e) w |= (__builtin_bit_cast(unsigned, L[4 * q + e]) & 0x7Fu) << (8 * e);
            *(LAS unsigned*)(IDX + row * 16 + 4 * q) = w;
        }
    }
    float A[16], B[16];
#pragma unroll
    for (int j = 0; j < 16; ++j) { const float o = __shfl_xor(L[j], 2); const bool isb = (tid & 2) != 0; A[j] = isb ? o : L[j]; B[j] = isb ? L[j] : o; }
#define TK_KEY(i, j) __uint_as_float((__float_as_uint(A[i] + B[j]) & ~0xFFu) | (unsigned)(255 - ((i) * 16 + (j))))
    float F[16], X[16];
#pragma unroll
    for (int j = 0; j < 16; ++j) F[j] = TK_KEY(0, j);
#pragma unroll
    for (int i = 1; i < 16; ++i) X[i - 1] = TK_KEY(i, 0);
    X[15] = -INFINITY; TK_MERGE16(F, X);
#pragma unroll
    for (int i = 0; i < 16; ++i) X[i] = -INFINITY;
#pragma unroll
    for (int i = 1; i <= 7; ++i) X[i - 1] = TK_KEY(i, 1);
    TK_MERGE16(F, X);
#pragma unroll
    for (int i = 0; i < 16; ++i) X[i] = -INFINITY;
#pragma unroll
    for (int j = 2; j <= 7; ++j) X[j - 2] = TK_KEY(1, j);
    TK_MERGE16(F, X);
    { const float rest[6] = {TK_KEY(2, 2), TK_KEY(2, 3), TK_KEY(2, 4), TK_KEY(3, 2), TK_KEY(3, 3), TK_KEY(4, 2)};
#pragma unroll
      for (int r = 0; r < 6; ++r) { float x = rest[r];
#pragma unroll
          for (int k = 0; k < 16; ++k) { const float h = vmaxf(F[k], x); x = vminf(F[k], x); F[k] = h; } } }
    __syncthreads();
    if ((tid & 3) == 0) {
        const int rowA = (tid >> 2) * 2, rowB = rowA + 1;
        const size_t prob = prob0 + (size_t)pstride * (tid >> 2);
        float g[16]; int ex[16]; float gs = 0.f;
#pragma unroll
        for (int k = 0; k < 16; ++k) {
            const unsigned code = 255u - (__builtin_bit_cast(unsigned, F[k]) & 0xFFu);
            const int ia = IDX[rowA * 16 + (code >> 4)], ib = IDX[rowB * 16 + (code & 15)];
            ex[k] = ia * PNK + ib;
            g[k] = __expf(F[k] - F[0]); gs += g[k];
        }
        const float ginv = 1.0f / gs;
#pragma unroll
        for (int q = 0; q < 4; ++q) {
            *(GAS f32x4*)(gates + prob * 16 + 4 * q) = (f32x4){g[4 * q] * ginv, g[4 * q + 1] * ginv, g[4 * q + 2] * ginv, g[4 * q + 3] * ginv};
            typedef int i32x4 __attribute__((ext_vector_type(4)));
            *(GAS i32x4*)(experts + prob * 16 + 4 * q) = (i32x4){ex[4 * q], ex[4 * q + 1], ex[4 * q + 2], ex[4 * q + 3]};
        }
    }
    __syncthreads();
}
__device__ __forceinline__ void topk_pass(int pass, const float* scores, int* experts, float* gates, LAS unsigned char* lds, int tid) {
    LAS float* S = (LAS float*)lds;
    const float* src = scores + (size_t)pass * (256 * 128);
#pragma unroll 4
    for (int i = 0; i < 16; ++i) { const int f4 = tid + NTHREADS * i, row = f4 >> 5, c4 = f4 & 31; *(LAS f32x4*)(S + row * TK_ROWF + 4 * c4) = *(const GAS f32x4*)(src + (size_t)f4 * 4); }
    __syncthreads();
    topk_core(lds, (size_t)pass * 128, 1, experts, gates, tid);
}
struct EpiTopK {
    static constexpr bool PERM = false, AFTER_DRAIN = true;
    int* experts; float* gates;
    __device__ __forceinline__ void fused(pg8::f32x4 (&acc)[2][2][4][2], const pg8::Unit& u, int wr, int wc, int fr, int fq, LAS unsigned char* lds, int wid, int lane) const {
        LAS float* S = (LAS float*)lds;
        const int tid = wid * 64 + lane;
#pragma unroll
        for (int ai = 0; ai < 2; ++ai) {
#pragma unroll
            for (int bj = 0; bj < 2; ++bj)
#pragma unroll
                for (int mm = 0; mm < 4; ++mm)
#pragma unroll
                    for (int n = 0; n < 2; ++n) { const int rl = 64 * wr + 16 * mm + fr; *(LAS pg8::f32x4*)(S + (2 * rl + bj) * TK_ROWF + 32 * wc + 16 * n + 4 * fq) = acc[ai][bj][mm][n]; }
            __syncthreads();
            topk_core(lds, ((size_t)u.pm * 256 + 128 * ai) * PH + u.pn, PH, experts, gates, tid);
        }
    }
};

__device__ __forceinline__ float gelu_erf(float v) { return 0.5f * v * (1.0f + erff(v * 0.70710678118654752f)); }
typedef __bf16 bf16x2_t __attribute__((ext_vector_type(2)));
typedef float f32x2_t __attribute__((ext_vector_type(2)));
__device__ __forceinline__ float dot2bf(bf16x2_t a, unsigned b, float acc) { return __builtin_amdgcn_fdot2_f32_bf16(a, __builtin_bit_cast(bf16x2_t, b), acc, false); }
__device__ __forceinline__ float dot4f8(unsigned w8, unsigned x01, unsigned x23, float acc) {
    acc = dot2bf(__builtin_amdgcn_cvt_scalef32_pk_bf16_fp8(w8, 1.0f, false), x01, acc);
    return dot2bf(__builtin_amdgcn_cvt_scalef32_pk_bf16_fp8(w8, 1.0f, true), x23, acc);
}
__device__ __forceinline__ void axpy4f8(float* y, unsigned w8, float w) {
    const f32x2_t lo = __builtin_amdgcn_cvt_pk_f32_fp8(w8, false), hi = __builtin_amdgcn_cvt_pk_f32_fp8(w8, true);
    y[0] += w * lo.x; y[1] += w * lo.y; y[2] += w * hi.x; y[3] += w * hi.y;
}
__device__ __forceinline__ void axpy4f8v(f32x2_t* y2, unsigned w8, float w) {
    const f32x2_t lo = __builtin_amdgcn_cvt_pk_f32_fp8(w8, false), hi = __builtin_amdgcn_cvt_pk_f32_fp8(w8, true);
    const f32x2_t ww = {w, w};
    y2[0] = __builtin_elementwise_fma(lo, ww, y2[0]); y2[1] = __builtin_elementwise_fma(hi, ww, y2[1]);
}
__device__ __forceinline__ void row_to_fp8(const float* src, unsigned char* dst, float* inv, int lane) {
    f32x4 v[2][4]; float mx = 0.f;
#pragma unroll
    for (int j = 0; j < 2; ++j)
#pragma unroll
        for (int q = 0; q < 4; ++q) { v[j][q] = *((const GAS f32x4*)src + 4 * (lane + 64 * j) + q);
            mx = fmaxf(mx, fmaxf(fmaxf(fabsf(v[j][q].x), fabsf(v[j][q].y)), fmaxf(fabsf(v[j][q].z), fabsf(v[j][q].w)))); }
#pragma unroll
    for (int o = 1; o < 64; o <<= 1) mx = fmaxf(mx, __shfl_xor(mx, o));
    const float sc = mx > 0.f ? 384.0f / mx : 1.0f;
#pragma unroll
    for (int j = 0; j < 2; ++j) { v4u o;
        int w;
        w = 0; w = __builtin_amdgcn_cvt_pk_fp8_f32(v[j][0].x * sc, v[j][0].y * sc, w, false); w = __builtin_amdgcn_cvt_pk_fp8_f32(v[j][0].z * sc, v[j][0].w * sc, w, true); o.x = (unsigned)w;
        w = 0; w = __builtin_amdgcn_cvt_pk_fp8_f32(v[j][1].x * sc, v[j][1].y * sc, w, false); w = __builtin_amdgcn_cvt_pk_fp8_f32(v[j][1].z * sc, v[j][1].w * sc, w, true); o.y = (unsigned)w;
        w = 0; w = __builtin_amdgcn_cvt_pk_fp8_f32(v[j][2].x * sc, v[j][2].y * sc, w, false); w = __builtin_amdgcn_cvt_pk_fp8_f32(v[j][2].z * sc, v[j][2].w * sc, w, true); o.z = (unsigned)w;
        w = 0; w = __builtin_amdgcn_cvt_pk_fp8_f32(v[j][3].x * sc, v[j][3].y * sc, w, false); w = __builtin_amdgcn_cvt_pk_fp8_f32(v[j][3].z * sc, v[j][3].w * sc, w, true); o.w = (unsigned)w;
        { const int ch = lane + 64 * j; *((GAS v4u*)(dst + (size_t)(ch >> 4) * SLICE_BYTES) + (ch & 15)) = o; } }
    if (lane == 0) *inv = mx > 0.f ? mx * (1.0f / 384.0f) : 1.0f;
}
__device__ __forceinline__ void row_to_i8(const float* src, unsigned char* dst, float* inv, int lane) {
    f32x4 v[2][4]; float mx = 0.f;
#pragma unroll
    for (int j = 0; j < 2; ++j)
#pragma unroll
        for (int q = 0; q < 4; ++q) { v[j][q] = *((const GAS f32x4*)src + 4 * (lane + 64 * j) + q);
            mx = fmaxf(mx, fmaxf(fmaxf(fabsf(v[j][q].x), fabsf(v[j][q].y)), fmaxf(fabsf(v[j][q].z), fabsf(v[j][q].w)))); }
#pragma unroll
    for (int o = 1; o < 64; o <<= 1) mx = fmaxf(mx, __shfl_xor(mx, o));
    const float sc = mx > 0.f ? 127.0f / mx : 1.0f;
#pragma unroll
    for (int j = 0; j < 2; ++j) { v4u o; o.x = pack_i8(v[j][0] * sc); o.y = pack_i8(v[j][1] * sc); o.z = pack_i8(v[j][2] * sc); o.w = pack_i8(v[j][3] * sc);
        { const int ch = lane + 64 * j; *((GAS v4u*)(dst + (size_t)(ch >> 4) * SLICE_BYTES) + (ch & 15)) = o; } }
    if (lane == 0) *inv = mx > 0.f ? mx * (1.0f / 127.0f) : 1.0f;
}
__device__ __forceinline__ float row16_allsum(float a) {
    a += __builtin_bit_cast(float, __builtin_amdgcn_update_dpp(0, __builtin_bit_cast(int, a), 0x128, 0xf, 0xf, false));
    a += __builtin_bit_cast(float, __builtin_amdgcn_update_dpp(0, __builtin_bit_cast(int, a), 0x124, 0xf, 0xf, false));
    a += __builtin_bit_cast(float, __builtin_amdgcn_update_dpp(0, __builtin_bit_cast(int, a), 0x122, 0xf, 0xf, false));
    a += __builtin_bit_cast(float, __builtin_amdgcn_update_dpp(0, __builtin_bit_cast(int, a), 0x121, 0xf, 0xf, false));
    return a;
}
__device__ __forceinline__ int q_pull(unsigned* q, int lane) { int v = 0; if (lane == 0) v = (int)__hip_atomic_fetch_add(q, 1u, __ATOMIC_RELAXED, __HIP_MEMORY_SCOPE_AGENT); return __builtin_amdgcn_readfirstlane(v); }
constexpr int PEER_TG = 8;
constexpr int PEER_N8 = 640, PEER_N4 = 512, PEER_N2 = 512, PEER_NTASK = PEER_N8 + PEER_N4 + PEER_N2;
__device__ __forceinline__ void peer_task_tokens(int idx, int& t0, int& n) {
    if (idx < PEER_N8) { t0 = 8 * idx; n = 8; } else if (idx < PEER_N8 + PEER_N4) { t0 = 8 * PEER_N8 + 4 * (idx - PEER_N8); n = 4; } else { t0 = 8 * PEER_N8 + 4 * PEER_N4 + 2 * (idx - PEER_N8 - PEER_N4); n = 2; }
}
__device__ __forceinline__ int row16_allsum_i(int a) {
    a += __builtin_amdgcn_update_dpp(0, a, 0x128, 0xf, 0xf, false);
    a += __builtin_amdgcn_update_dpp(0, a, 0x124, 0xf, 0xf, false);
    a += __builtin_amdgcn_update_dpp(0, a, 0x122, 0xf, 0xf, false);
    a += __builtin_amdgcn_update_dpp(0, a, 0x121, 0xf, 0xf, false);
    return a;
}
#define PA_LOAD(R, IDV, HALF) do { _Pragma("unroll") for (int i_ = 0; i_ < 8; ++i_) { const unsigned e_ = (unsigned)__shfl(IDV, 4 * (i_ + 8 * (HALF)) + g); \
        R[i_] = *(const GAS v4u*)(ub + (e_ * 256u + offc)); } } while (0)
#define PA_COMP(R, HALF) do { _Pragma("unroll") for (int i_ = 0; i_ < 8; ++i_) { int a_ = __builtin_amdgcn_sdot4((int)R[i_].x, (int)xc.x, 0, false); a_ = __builtin_amdgcn_sdot4((int)R[i_].y, (int)xc.y, a_, false); \
        a_ = __builtin_amdgcn_sdot4((int)R[i_].z, (int)xc.z, a_, false); a_ = __builtin_amdgcn_sdot4((int)R[i_].w, (int)xc.w, a_, false); r16[8 * (HALF) + i_] = row16_allsum_i(a_); } } while (0)
__device__ __forceinline__ void peer_a_task(int t0, int ntok, int s, const signed char* xq, const int* experts, const unsigned char* u8s, int* pa, int lane_) {
    int lane = lane_; asm volatile("" : "+v"(lane));
    const int g = lane >> 4, c = lane & 15;
    const GAS unsigned char* ub = (const GAS unsigned char*)(u8s + (size_t)s * SLICE_BYTES);
    const unsigned offc = 16u * (unsigned)c;
    int idc0 = experts[(size_t)t0 * 128 + lane], idc1 = experts[(size_t)t0 * 128 + lane + 64];
    v4u xc = *(const GAS v4u*)(xq + (size_t)t0 * D + 256 * s + 16 * c);
    v4u RA[8], RB[8];
    PA_LOAD(RA, idc0, 0);
#pragma unroll 1
    for (int tt = 0; tt < ntok; ++tt) {
        const int t = t0 + tt, tn = tt + 1 < ntok ? t + 1 : t;
        const int idn0 = experts[(size_t)tn * 128 + lane], idn1 = experts[(size_t)tn * 128 + lane + 64];
        const v4u xn = *(const GAS v4u*)(xq + (size_t)tn * D + 256 * s + 16 * c);
#pragma unroll 1
        for (int hb = 0; hb < 2; ++hb) {
            const int idv = hb ? idc1 : idc0, idx = hb ? idn0 : idc1;
            int r16[16];
            PA_LOAD(RB, idv, 1); PA_COMP(RA, 0);
            asm volatile("" ::: "memory");
            PA_LOAD(RA, idx, 0); PA_COMP(RB, 1);
            if (c == 15) { typedef int i32x4 __attribute__((ext_vector_type(4))); GAS i32x4* dst = (GAS i32x4*)(pa + ((size_t)t * 8 + s) * 128 + g * 32 + 16 * hb);
#pragma unroll
                for (int q = 0; q < 4; ++q) dst[q] = (i32x4){r16[4 * q], r16[4 * q + 1], r16[4 * q + 2], r16[4 * q + 3]}; }
        }
        idc0 = idn0; idc1 = idn1; xc = xn;
    }
}
__device__ __forceinline__ void peer_w_elem(size_t i, const int* experts, const float* gates, const float* su, const float* sv, const float* sx, const int* pa, float* wb) {
    const size_t t = i >> 7; const int k = (int)(i & 127), pos = (k & 3) * 32 + (k >> 2);
    const int e = experts[i];
    int a = 0;
#pragma unroll
    for (int s2 = 0; s2 < 8; ++s2) a += pa[(t * 8 + s2) * 128 + pos];
    wb[i] = gates[i] * gelu_erf((float)a * (su[e] * sx[t])) * sv[e];
}
#define PB_LOAD(R, IDV, HALF) do { _Pragma("unroll") for (int i_ = 0; i_ < 8; ++i_) { const unsigned e_ = (unsigned)__shfl(IDV, 4 * (i_ + 8 * (HALF)) + g); \
        R[i_] = *(const GAS v4u*)(vb + (e_ * 256u + offc)); } } while (0)
#define PB_COMP(R, WV, HALF) do { _Pragma("unroll") for (int i_ = 0; i_ < 8; ++i_) { const float wk_ = __shfl(WV, 4 * (i_ + 8 * (HALF)) + g); \
        axpy4f8v(&ya2[0], R[i_].x, wk_); axpy4f8v(&ya2[2], R[i_].y, wk_); axpy4f8v(&ya2[4], R[i_].z, wk_); axpy4f8v(&ya2[6], R[i_].w, wk_); } } while (0)
__device__ __forceinline__ void peer_b_task(int t0, int ntok, int s, const bf16* h1, const int* experts, const float* wb, const unsigned char* v8s, bf16* out, float* st, int lane_) {
    int lane = lane_; asm volatile("" : "+v"(lane));
    const int g = lane >> 4, c = lane & 15;
    const GAS unsigned char* vb = (const GAS unsigned char*)(v8s + (size_t)s * SLICE_BYTES);
    const unsigned offc = 16u * (unsigned)c;
    int idc0 = experts[(size_t)t0 * 128 + lane], idc1 = experts[(size_t)t0 * 128 + lane + 64];
    float wc0 = wb[(size_t)t0 * 128 + lane], wc1 = wb[(size_t)t0 * 128 + lane + 64];
    v4u RA[8], RB[8];
    PB_LOAD(RA, idc0, 0);
#pragma unroll 1
    for (int tt = 0; tt < ntok; ++tt) {
        const int t = t0 + tt, tn = tt + 1 < ntok ? t + 1 : t;
        const int idn0 = experts[(size_t)tn * 128 + lane], idn1 = experts[(size_t)tn * 128 + lane + 64];
        const float wn0 = wb[(size_t)tn * 128 + lane], wn1 = wb[(size_t)tn * 128 + lane + 64];
        f32x2_t ya2[8];
#pragma unroll
        for (int e = 0; e < 8; ++e) ya2[e] = (f32x2_t){0.f, 0.f};
#pragma unroll 1
        for (int hb = 0; hb < 2; ++hb) {
            const int idv = hb ? idc1 : idc0, idx = hb ? idn0 : idc1; const float wv = hb ? wc1 : wc0;
            PB_LOAD(RB, idv, 1); PB_COMP(RA, wv, 0);
            asm volatile("" ::: "memory");
            PB_LOAD(RA, idx, 0); PB_COMP(RB, wv, 1);
        }
        float ya[16];
#pragma unroll
        for (int e = 0; e < 8; ++e) { ya[2 * e] = ya2[e].x; ya[2 * e + 1] = ya2[e].y; }
#pragma unroll
        for (int e = 0; e < 16; ++e) { ya[e] += __shfl_xor(ya[e], 16); ya[e] += __shfl_xor(ya[e], 32); }
        const GAS v4u* hp = (const GAS v4u*)(h1 + (size_t)t * D + 256 * s + 16 * c);
        const v4u h0 = hp[0], h1v = hp[1];
        float hx[16];
        hx[0] = pg8::bf_lo(h0.x); hx[1] = pg8::bf_hi(h0.x); hx[2] = pg8::bf_lo(h0.y); hx[3] = pg8::bf_hi(h0.y); hx[4] = pg8::bf_lo(h0.z); hx[5] = pg8::bf_hi(h0.z); hx[6] = pg8::bf_lo(h0.w); hx[7] = pg8::bf_hi(h0.w);
        hx[8] = pg8::bf_lo(h1v.x); hx[9] = pg8::bf_hi(h1v.x); hx[10] = pg8::bf_lo(h1v.y); hx[11] = pg8::bf_hi(h1v.y); hx[12] = pg8::bf_lo(h1v.z); hx[13] = pg8::bf_hi(h1v.z); hx[14] = pg8::bf_lo(h1v.w); hx[15] = pg8::bf_hi(h1v.w);
        float sm = 0.f, sq = 0.f;
#pragma unroll
        for (int e = 0; e < 16; ++e) { ya[e] = hx[e] * ALPHA + ya[e]; sm += ya[e]; sq += ya[e] * ya[e]; }
        sm = row16_allsum(sm); sq = row16_allsum(sq);
        if (g == 0) { GAS v4u* op = (GAS v4u*)(out + (size_t)t * D + 256 * s + 16 * c);
            v4u o0, o1; o0.x = pk2(ya[0], ya[1]); o0.y = pk2(ya[2], ya[3]); o0.z = pk2(ya[4], ya[5]); o0.w = pk2(ya[6], ya[7]);
            o1.x = pk2(ya[8], ya[9]); o1.y = pk2(ya[10], ya[11]); o1.z = pk2(ya[12], ya[13]); o1.w = pk2(ya[14], ya[15]);
            op[0] = o0; op[1] = o1;
            if (c == 0) { st[((size_t)t * 8 + s) * 2] = sm; st[((size_t)t * 8 + s) * 2 + 1] = sq; } }
        idc0 = idn0; idc1 = idn1; wc0 = wn0; wc1 = wn1;
    }
}
__device__ __forceinline__ void peer_c_row(int t, const bf16* r2, float* out, const float* st, const float* g2, const float* b2, int lane) {
    float sm = 0.f, sq = 0.f;
#pragma unroll
    for (int s = 0; s < 8; ++s) { sm += st[((size_t)t * 8 + s) * 2]; sq += st[((size_t)t * 8 + s) * 2 + 1]; }
    const float mean = sm * (1.f / D), var = sq * (1.f / D) - mean * mean, rstd = 1.f / sqrtf(fmaxf(var, 0.f) + LN_EPS);
    const GAS v4u* xr = (const GAS v4u*)(r2 + (size_t)t * D) + lane;
    GAS f32x4* op = (GAS f32x4*)(out + (size_t)t * D);
#pragma unroll
    for (int j = 0; j < 4; ++j) { const v4u w = xr[64 * j]; const int c4 = 2 * (lane + 64 * j);
        const f32x4 g0 = *((const GAS f32x4*)g2 + c4), g1 = *((const GAS f32x4*)g2 + c4 + 1), b0 = *((const GAS f32x4*)b2 + c4), b1 = *((const GAS f32x4*)b2 + c4 + 1);
        const f32x4 v0 = (f32x4){pg8::bf_lo(w.x), pg8::bf_hi(w.x), pg8::bf_lo(w.y), pg8::bf_hi(w.y)}, v1 = (f32x4){pg8::bf_lo(w.z), pg8::bf_hi(w.z), pg8::bf_lo(w.w), pg8::bf_hi(w.w)};
        op[c4] = (v0 - mean) * rstd * g0 + b0; op[c4 + 1] = (v1 - mean) * rstd * g1 + b1; }
}

struct Args { const float* in[16]; float* out; unsigned char* ws; int ph_lo, ph_hi; };
__global__ void __launch_bounds__(NTHREADS, 2) mk_fwd(Args args) {
    extern __shared__ __attribute__((aligned(16))) unsigned char lds_raw[];
    LAS unsigned char* lds = (LAS unsigned char*)lds_raw;
    volatile LAS unsigned* MISC = (volatile LAS unsigned*)(lds + MISC_OFF);
    const int tid0 = threadIdx.x;
    const int G = gridDim.x, bx = blockIdx.x;
    unsigned char* ws = args.ws;
    gu32* ctl = (gu32*)(ws + WS_CTL);
#define IN_(i) (args.in[i])
#define x_in IN_(0)
#define w_in IN_(1)
#define b_gate IN_(2)
#define sinks IN_(3)
#define conv_w IN_(4)
#define w_ao IN_(5)
#define w_co IN_(6)
#define w_o IN_(7)
#define ln1_g IN_(8)
#define ln1_b IN_(9)
#define w_q IN_(10)
#define sub_keys IN_(11)
#define peer_u IN_(12)
#define peer_v IN_(13)
#define ln2_g IN_(14)
#define ln2_b IN_(15)
#define WinT ((bf16*)(ws + WS_WIN))
#define WaT ((bf16*)(ws + WS_WA))
#define WcT ((bf16*)(ws + WS_WC))
#define WoT ((bf16*)(ws + WS_WO))
#define WfT ((bf16*)(ws + WS_WF))
#define XB ((bf16*)(ws + WS_XB))
#define MERGED ((bf16*)(ws + WS_MERGED))
#define Z ((bf16*)(ws + WS_Z))
#define R2B ((bf16*)(ws + WS_R2B))
#define H1B ((bf16*)(ws + WS_H1B))
#define SC ((float*)(ws + WS_SC))
#define EX ((int*)(ws + WS_EX))
#define GT ((float*)(ws + WS_GT))
#define AO ((bf16*)(ws + WS_AO))
#define CI ((bf16*)(ws + WS_CI))
#define TMP ((bf16*)(ws + WS_TMP))
#define U8 ((unsigned char*)(ws + WS_U8))
#define V8 ((unsigned char*)(ws + WS_V8))
#define SU ((float*)(ws + WS_SU))
#define SV ((float*)(ws + WS_SV))
#define PA ((int*)(ws + WS_PA))
#define ST ((float*)(ws + WS_ST))
#define WB ((float*)(ws + WS_WB))
#define XQ ((signed char*)(ws + WS_XQ))
#define SX ((float*)(ws + WS_SX))
    for (int u = tid0; u < (LDS_BYTES - LDSCTL_OFF) / 4; u += NTHREADS) ((LAS unsigned*)(lds + LDSCTL_OFF))[u] = 0u;
    __syncthreads();
    XcdBarrier bar; bar.bar = (unsigned*)(ctl + CW_BAR); bar.x = 0; bar.st = nullptr;
    if (!MK_PER_PHASE) bar = xcd_barrier_post((unsigned*)(ctl + CW_BAR), MISC + 8);
    const int lo = args.ph_lo, hi = args.ph_hi;
#ifndef PH_MASK
#define PH_MASK 0xFFF
#endif
#define IN(k) (((PH_MASK >> (k)) & 1) && lo <= (k) && (k) < hi)
#ifndef DBL_BAR
#define DBL_BAR 0
#endif
#define SEAM(k) do { if (IN(k) && IN((k) + 1)) { xcd_barrier(bar); if (DBL_BAR) xcd_barrier(bar); } } while (0)
#ifndef DBL_MASK
#define DBL_MASK 0
#endif
#define REP(k) for (int rep_ = 0; rep_ < 1 + ((DBL_MASK >> (k)) & 1); ++rep_)
#define PHASE_TID() int tid = tid0; asm volatile("" : "+v"(tid)); const int lane = tid & 63, wave = __builtin_amdgcn_readfirstlane(tid >> 6); (void)lane; (void)wave

    if (IN(0)) REP(0) {
        PHASE_TID();
        for (int it = bx; it < 16 * 32; it += G) p0_wf_item(w_q, sub_keys, WfT, lds, it, tid);
        LAS float* scr = (LAS float*)(lds + wave * 16384);
        const int gw = bx * NWAVES + wave, NGW = G * NWAVES;
        constexpr int I_IN = (D / 64) * (IN_W / 32), I_SQ = (D / 64) * (D / 32);
        for (int it = gw; it < I_IN + 3 * I_SQ; it += NGW) {
            int r = it;
            if (r < I_IN) { p0_transpose_item(w_in, D, IN_W, WinT, scr, r, lane); continue; } r -= I_IN;
            if (r < I_SQ) { p0_transpose_item(w_ao, D, D, WaT, scr, r, lane); continue; } r -= I_SQ;
            if (r < I_SQ) { p0_transpose_item(w_co, D, D, WcT, scr, r, lane); continue; } r -= I_SQ;
            p0_transpose_item(w_o, D, D, WoT, scr, r, lane);
        }
        const size_t n8 = (size_t)M * D / 8;
        for (size_t i = (size_t)bx * NTHREADS + tid; i < n8; i += (size_t)G * NTHREADS) {
            const f32x4 a = *((const GAS f32x4*)x_in + 2 * i), b = *((const GAS f32x4*)x_in + 2 * i + 1);
            v4u o; o.x = pk2(a.x, a.y); o.y = pk2(a.z, a.w); o.z = pk2(b.x, b.y); o.w = pk2(b.z, b.w);
            *((GAS v4u*)XB + i) = o;
        }
    }
    SEAM(0);
    if (IN(1)) REP(1) {
        pg8::Gemm g{XB, WinT, M, IN_W, D}; pg8::StaticOrder S; S.init(M, IN_W, G, bx);
        pg8::EpiBf16 E{Z, IN_W};
        pg8::gemm_phase<pg8::EpiBf16, pg8::StaticOrder, true, true>(lds, g, S, E);
        { PHASE_TID();
#ifndef DBL_CONV
#define DBL_CONV 0
#endif
          for (int rep2 = 0; rep2 <= DBL_CONV; ++rep2)
          for (;;) { const int ch = q_pull((unsigned*)(ctl + CW_Q + 64 * (32 + rep2)), lane); if (ch >= 2 * PNE / 16) break;
#pragma unroll 1
              for (int rr = 0; rr < 16; ++rr) { const int r = ch * 16 + rr; const bool sec = r >= PNE; const int e = sec ? r - PNE : r;
                  if (sec) row_to_fp8(peer_v + (size_t)e * D, V8 + (size_t)e * 256, SV + e, lane); else row_to_i8(peer_u + (size_t)e * D, U8 + (size_t)e * 256, SU + e, lane); } } }
    }
    SEAM(1);
    if (IN(2)) REP(2) {
        PHASE_TID();
        for (int u = bx; u < BATCH * NKVH * 16; u += G) attn_unit(u, Z, AO, sinks, lds, tid);
        for (int it = bx; it < M / 32; it += G) conv_item(it, Z, conv_w, CI, tid);
    }
    SEAM(2);
    if (IN(3)) REP(3) {
        pg8::StaticOrder S; S.init(M, D, G, bx);
        { pg8::Gemm g{AO, WaT, M, D, D}; pg8::EpiGate<0> E{TMP, nullptr, Z + G_OFF, b_gate, D, IN_W};
          pg8::gemm_phase<pg8::EpiGate<0>, pg8::StaticOrder, true, true>(lds, g, S, E); }
        { pg8::Gemm g{CI, WcT, M, D, D}; pg8::EpiGate<1> E{MERGED, TMP, Z + G_OFF + D, b_gate + D, D, IN_W};
          pg8::gemm_phase<pg8::EpiGate<1>, pg8::StaticOrder, true, true>(lds, g, S, E); }
    }
    SEAM(3);
    if (IN(4)) REP(4) {
        pg8::Gemm g{MERGED, WoT, M, D, D}; pg8::StaticOrder S; S.init(M, D, G, bx);
        pg8::EpiResBf16 E{H1B, D, x_in, ALPHA};
        pg8::gemm_phase<pg8::EpiResBf16, pg8::StaticOrder, true, true>(lds, g, S, E);
    }
    SEAM(4);
    if (IN(5)) REP(5) {
        PHASE_TID();
        const int gw = bx * NWAVES + wave, NGW = G * NWAVES;
        for (int m = gw; m < M; m += NGW) ln1_row(H1B + (size_t)m * D, XQ + (size_t)m * D, SX + m, ln1_g, ln1_b, lane);
    }
    SEAM(5);
    if (IN(6)) REP(6) {
        pg8::Gemm g{H1B, WfT, M, D, D}; pg8::StaticOrder S; S.init(M, D, G, bx);
        if (G == 256) { EpiTopK E{EX, GT}; pg8::gemm_phase<EpiTopK, pg8::StaticOrder, false, true>(lds, g, S, E); }
        else { pg8::EpiF32 E{SC, D, nullptr, 0.f}; pg8::gemm_phase<pg8::EpiF32, pg8::StaticOrder, true, true>(lds, g, S, E); }
    }
    if (G != 256) SEAM(6);
    if (IN(7)) REP(7) {
        PHASE_TID();
        if (G != 256) for (int p = bx; p < (M * PH) / 128; p += G) topk_pass(p, SC, EX, GT, lds, tid);
    }
    SEAM(7);
    if (IN(8)) REP(8) {
        PHASE_TID();
        const int xcc = (int)(xb_xcc_id() & 7u);
#pragma unroll 1
#ifndef SCRAMBLE
#define SCRAMBLE 0
#endif
        for (int sl = 0; sl < 8; ++sl) { const int s = (xcc + sl + (SCRAMBLE ? wave : 0)) & 7;
            for (;;) { const int tg = q_pull((unsigned*)(ctl + CW_Q + 64 * (s + 16 * rep_)), lane); if (tg >= PEER_NTASK) break;
                int t0, nt; peer_task_tokens(tg, t0, nt); peer_a_task(t0, nt, s, XQ, EX, U8, PA, lane); } }
    }
    SEAM(8);
    if (IN(9)) REP(9) {
        PHASE_TID();
        for (size_t i = (size_t)bx * NTHREADS + tid; i < (size_t)M * 128; i += (size_t)G * NTHREADS) peer_w_elem(i, EX, GT, SU, SV, SX, PA, WB);
    }
    SEAM(9);
    if (IN(10)) REP(10) {
        PHASE_TID();
        const int xcc = (int)(xb_xcc_id() & 7u);
#pragma unroll 1
#ifndef SCRAMBLE
#define SCRAMBLE 0
#endif
        for (int sl = 0; sl < 8; ++sl) { const int s = (xcc + sl + (SCRAMBLE ? wave : 0)) & 7;
            for (;;) { const int tg = q_pull((unsigned*)(ctl + CW_Q + 64 * (8 + s + 16 * rep_)), lane); if (tg >= PEER_NTASK) break;
                int t0, nt; peer_task_tokens(tg, t0, nt); peer_b_task(t0, nt, s, H1B, EX, WB, V8, R2B, ST, lane); } }
    }
    SEAM(10);
    if (IN(11)) REP(11) {
        PHASE_TID();
        const int gw = bx * NWAVES + wave, NGW = G * NWAVES;
        for (int t = gw; t < M; t += NGW) peer_c_row(t, R2B, args.out, ST, ln2_g, ln2_b, lane);
    }
#undef IN
#undef SEAM
}

extern "C" void kernel_launch(void* const* d_in, const int* in_sizes, int n_in, void* d_out, int out_size, void* d_ws, size_t ws_size, hipStream_t stream) {
    static int grid = 0;
    if (grid == 0) {
        if (n_in != 16 || out_size != M * D || ws_size < WS_END) { fprintf(stderr, "kernel_launch: unexpected shapes (n_in %d out %d ws %zu)\n", n_in, out_size, ws_size); grid = -1; return; }
        int dev = 0, cus = 0, per_cu = 0;
        if (hipGetDevice(&dev) != hipSuccess || hipDeviceGetAttribute(&cus, hipDeviceAttributeMultiprocessorCount, dev) != hipSuccess) { grid = -1; return; }
        if (hipFuncSetAttribute((const void*)mk_fwd, hipFuncAttributeMaxDynamicSharedMemorySize, LDS_BYTES) != hipSuccess) { fprintf(stderr, "kernel_launch: hipFuncSetAttribute failed\n"); grid = -1; return; }
        if (hipOccupancyMaxActiveBlocksPerMultiprocessor(&per_cu, (const void*)mk_fwd, NTHREADS, LDS_BYTES) != hipSuccess || per_cu < 1) { fprintf(stderr, "kernel_launch: occupancy query says %d\n", per_cu); per_cu = 1; }
        (void)hipGetLastError();
        if (per_cu > 1) per_cu = 1;
        grid = cus * per_cu;
    }
    if (grid < 0) return;
    if (hipMemsetAsync((char*)d_ws + WS_CTL, 0, CTL_ZERO_BYTES, stream) != hipSuccess) { fprintf(stderr, "kernel_launch: memset failed\n"); return; }
    Args a{};
    for (int i = 0; i < 16; ++i) a.in[i] = (const float*)d_in[i];
    a.out = (float*)d_out; a.ws = (unsigned char*)d_ws;
#if MK_PER_PHASE
    for (int p = 0; p < N_PHASES; ++p) { a.ph_lo = p; a.ph_hi = p + 1; hipLaunchKernelGGL(mk_fwd, dim3(grid), dim3(NTHREADS), LDS_BYTES, stream, a); }
#else
    a.ph_lo = 0; a.ph_hi = N_PHASES;
    void* kargs[] = {&a};
#ifdef PLAIN_LAUNCH
    (void)kargs; hipLaunchKernelGGL(mk_fwd, dim3(grid), dim3(NTHREADS), LDS_BYTES, stream, a); hipError_t e = hipPeekAtLastError();
#else
    hipError_t e = hipLaunchCooperativeKernel((const void*)mk_fwd, dim3(grid), dim3(NTHREADS), kargs, LDS_BYTES, stream);
#endif
    if (e != hipSuccess) fprintf(stderr, "kernel_launch: cooperative launch failed: %s (grid %d)\n", hipGetErrorString(e), grid);
#endif
}
```

```cpp
#include <hip/hip_runtime.h>
#include <cstdio>
#include <cstdint>
namespace pg8 {
#define PG8_LAS __attribute__((address_space(3)))
typedef unsigned short bf16_t;
typedef short bf16x8 __attribute__((ext_vector_type(8)));
typedef float f32x4 __attribute__((ext_vector_type(4)));
typedef unsigned u32x4 __attribute__((ext_vector_type(4)));
constexpr int BM = 256, BK = 64, HALF = 128, HTB = HALF * BK * 2  , STAGE_BYTES = 8 * HTB, NXCD = 8, WGM = 8;

__host__ __device__ __forceinline__ int lds_byte(int r, int c) { const int st = (r >> 4) * 2 + (c >> 5), rr = r & 15, cc = c & 31, ob = rr * 64 + cc * 2; return st * 1024 + (ob ^ (((ob >> 9) & 1) << 5)); }
__host__ __device__ __forceinline__ void stage_rc(int b, int& R, int& C) { const int st = b / 1024, sb = b % 1024, swz = sb ^ (((sb >> 9) & 1) << 5); R = (st >> 1) * 16 + swz / 64; C = (st & 1) * 32 + (swz % 64) / 2; }
__host__ __device__ __forceinline__ int perm32(int rho) { const int n = rho >> 4, i = rho & 15; return 8 * (i >> 2) + 4 * n + (i & 3); }

struct Unit { int pm, pn; };
struct Gemm { const bf16_t* A; const bf16_t* Bt; int M, N, K; };

struct StaticOrder {
    int nM, nN, nwg, G, c;
    __host__ __device__ void init(int M, int N, int G_, int c_) { nM = M / BM; nN = N / BM; nwg = nM * nN; G = G_; c = c_; }
    __host__ __device__ bool next(int i, Unit& u) const {
        const long L = (long)i * G + c; if (L >= nwg) return false;
        int wgid = (int)L; { const int q = nwg / NXCD, r = nwg % NXCD, xcd = wgid % NXCD, off = wgid / NXCD; wgid = (xcd < r ? xcd * (q + 1) : r * (q + 1) + (xcd - r) * q) + off; }
        const int nig = WGM * nN, gid = wgid / nig, fm = gid * WGM, gsz = (nM - fm) < WGM ? (nM - fm) : WGM;
        u.pm = fm + ((wgid % nig) % gsz); u.pn = (wgid % nig) / gsz; return true;
    }
    __device__ __forceinline__ void a_ready(const Unit&) const {}
    __device__ __forceinline__ void done(const Unit&) const {}
};


__device__ __forceinline__ unsigned cvt_pk_bf16(float lo, float hi) { unsigned r; asm volatile("v_cvt_pk_bf16_f32 %0, %1, %2" : "=v"(r) : "v"(lo), "v"(hi)); return r; }
__device__ __forceinline__ float bf_lo(unsigned w) { return __builtin_bit_cast(float, w << 16); }
__device__ __forceinline__ float bf_hi(unsigned w) { return __builtin_bit_cast(float, w & 0xffff0000u); }
__device__ __forceinline__ float sigmoidf_(float x) { return __builtin_amdgcn_rcpf(1.0f + __expf(-x)); }

struct EpiBf16 {
    static constexpr bool PERM = true, AFTER_DRAIN = false;
    bf16_t* O; int ldc;
    __device__ __forceinline__ void operator()(const f32x4 (&acc)[2][2][4][2], const Unit& u, int wr, int wc, int fr, int fq) const {
        const int row0 = u.pm * BM + wr * 64 + fr, col0 = u.pn * BM + wc * 32 + 8 * fq;
#pragma unroll
        for (int ai = 0; ai < 2; ++ai)
#pragma unroll
            for (int m = 0; m < 4; ++m) { bf16_t* rowp = O + (size_t)(row0 + ai * HALF + m * 16) * ldc + col0;
#pragma unroll
                for (int bj = 0; bj < 2; ++bj) { const f32x4 v0 = acc[ai][bj][m][0], v1 = acc[ai][bj][m][1];
                    u32x4 w; w.x = cvt_pk_bf16(v0[0], v0[1]); w.y = cvt_pk_bf16(v0[2], v0[3]); w.z = cvt_pk_bf16(v1[0], v1[1]); w.w = cvt_pk_bf16(v1[2], v1[3]);
                    *(u32x4*)(rowp + bj * HALF) = w; } }
    }
};
template <int SECOND> struct EpiGate {
    static constexpr bool PERM = true, AFTER_DRAIN = false;
    bf16_t* O; const bf16_t* T; const bf16_t* Zg; const float* bg; int ldc, ldz;
    __device__ __forceinline__ void operator()(const f32x4 (&acc)[2][2][4][2], const Unit& u, int wr, int wc, int fr, int fq) const {
        const int row0 = u.pm * BM + wr * 64 + fr, col0 = u.pn * BM + wc * 32 + 8 * fq;
        f32x4 bv[2][2];
#pragma unroll
        for (int bj = 0; bj < 2; ++bj)
#pragma unroll
            for (int n = 0; n < 2; ++n) bv[bj][n] = *(const f32x4*)(bg + col0 + bj * HALF + 4 * n);
#pragma unroll
        for (int ai = 0; ai < 2; ++ai)
#pragma unroll
            for (int m = 0; m < 4; ++m) { const size_t row = (size_t)(row0 + ai * HALF + m * 16);
#pragma unroll
                for (int bj = 0; bj < 2; ++bj) { const int c = col0 + bj * HALF;
                    const u32x4 zg = *(const u32x4*)(Zg + row * ldz + c);
                    f32x4 v0 = acc[ai][bj][m][0], v1 = acc[ai][bj][m][1];
                    v0[0] *= sigmoidf_(bf_lo(zg.x) + bv[bj][0][0]); v0[1] *= sigmoidf_(bf_hi(zg.x) + bv[bj][0][1]);
                    v0[2] *= sigmoidf_(bf_lo(zg.y) + bv[bj][0][2]); v0[3] *= sigmoidf_(bf_hi(zg.y) + bv[bj][0][3]);
                    v1[0] *= sigmoidf_(bf_lo(zg.z) + bv[bj][1][0]); v1[1] *= sigmoidf_(bf_hi(zg.z) + bv[bj][1][1]);
                    v1[2] *= sigmoidf_(bf_lo(zg.w) + bv[bj][1][2]); v1[3] *= sigmoidf_(bf_hi(zg.w) + bv[bj][1][3]);
                    if (SECOND) { const u32x4 t = *(const u32x4*)(T + row * ldc + c);
                        v0[0] += bf_lo(t.x); v0[1] += bf_hi(t.x); v0[2] += bf_lo(t.y); v0[3] += bf_hi(t.y);
                        v1[0] += bf_lo(t.z); v1[1] += bf_hi(t.z); v1[2] += bf_lo(t.w); v1[3] += bf_hi(t.w); }
                    u32x4 w; w.x = cvt_pk_bf16(v0[0], v0[1]); w.y = cvt_pk_bf16(v0[2], v0[3]); w.z = cvt_pk_bf16(v1[0], v1[1]); w.w = cvt_pk_bf16(v1[2], v1[3]);
                    *(u32x4*)(O + row * ldc + c) = w; } }
    }
};
struct EpiF32 {
    static constexpr bool PERM = false, AFTER_DRAIN = false;
    float* C; int ldc; const float* R; float scale;
    __device__ __forceinline__ void operator()(const f32x4 (&acc)[2][2][4][2], const Unit& u, int wr, int wc, int fr, int fq) const {
        const int row0 = u.pm * BM + wr * 64 + fr, col0 = u.pn * BM + wc * 32 + 4 * fq;
#pragma unroll
        for (int ai = 0; ai < 2; ++ai)
#pragma unroll
            for (int m = 0; m < 4; ++m) { const size_t off = (size_t)(row0 + ai * HALF + m * 16) * ldc + col0;
#pragma unroll
                for (int bj = 0; bj < 2; ++bj)
#pragma unroll
                    for (int n = 0; n < 2; ++n) { f32x4 v = acc[ai][bj][m][n];
                        if (R) v += *(const f32x4*)(R + off + bj * HALF + n * 16) * scale;
                        *(f32x4*)(C + off + bj * HALF + n * 16) = v; } }
    }
};
struct EpiResBf16 {
    static constexpr bool PERM = true, AFTER_DRAIN = false;
    bf16_t* O; int ldc; const float* R; float scale;
    __device__ __forceinline__ void operator()(const f32x4 (&acc)[2][2][4][2], const Unit& u, int wr, int wc, int fr, int fq) const {
        const int row0 = u.pm * BM + wr * 64 + fr, col0 = u.pn * BM + wc * 32 + 8 * fq;
#pragma unroll
        for (int ai = 0; ai < 2; ++ai)
#pragma unroll
            for (int m = 0; m < 4; ++m) { const size_t off = (size_t)(row0 + ai * HALF + m * 16) * ldc + col0;
#pragma unroll
                for (int bj = 0; bj < 2; ++bj) { const f32x4 r0 = *(const f32x4*)(R + off + bj * HALF), r1 = *(const f32x4*)(R + off + bj * HALF + 4);
                    const f32x4 v0 = acc[ai][bj][m][0] + r0 * scale, v1 = acc[ai][bj][m][1] + r1 * scale;
                    u32x4 w; w.x = cvt_pk_bf16(v0[0], v0[1]); w.y = cvt_pk_bf16(v0[2], v0[3]); w.z = cvt_pk_bf16(v1[0], v1[1]); w.w = cvt_pk_bf16(v1[2], v1[3]);
                    *(u32x4*)(O + off + bj * HALF) = w; } }
    }
};

template <class Epi, class Sched, bool ALIGN_EPI = false, bool SP2 = false>
__device__ __forceinline__ void gemm_phase(PG8_LAS unsigned char* lds, const Gemm g, const Sched& S, const Epi& E) {
    int tid_ = threadIdx.x; asm volatile("" : "+v"(tid_));
    const int tid = tid_, wid = __builtin_amdgcn_readfirstlane(tid >> 6), lane = tid & 63, wr = wid >> 2, wc = wid & 3, fr = lane & 15, fq = lane >> 4;
    const int K = g.K, nt = K / BK;
    unsigned voffA[2], voffB[2];
#pragma unroll
    for (int i = 0; i < 2; ++i) { int R, C; stage_rc(tid * 16 + i * 8192, R, C); const int Rb = Epi::PERM ? ((R & ~31) + perm32(R & 31)) : R;
        voffA[i] = (unsigned)(R * K + C) * 2u; voffB[i] = (unsigned)(Rb * K + C) * 2u; }
    const size_t kstep = (size_t)(BK * 2);
    const size_t hstep = (size_t)HALF * K * 2;
    const size_t tstep = 2 * hstep;
    const unsigned ldsw = (unsigned)wid * 1024u;
    const int aoff = lds_byte(wr * 64 + fr, fq * 8), boff = lds_byte(wc * 32 + fr, fq * 8);
#define PG8_SA(b, h) (((b) * 2 + (h)) * HTB)
#define PG8_SB(b, h) ((4 + (b) * 2 + (h)) * HTB)
#define PG8_STAGE(bufoff, gbase, voff) do { _Pragma("unroll") for (int _i = 0; _i < 2; ++_i) \
        __builtin_amdgcn_global_load_lds((const unsigned*)((const char*)(gbase) + (voff)[_i]), (PG8_LAS unsigned*)(lds + (bufoff) + ldsw + _i * 8192), 16, 0, 0); } while (0)
#define PG8_LDA(dst, b, h) do { _Pragma("unroll") for (int m = 0; m < 4; ++m) _Pragma("unroll") for (int k = 0; k < 2; ++k) dst[m][k] = *(const PG8_LAS bf16x8*)(lds + PG8_SA(b, h) + aoff + m * 2048 + k * 1024); } while (0)
#define PG8_LDB(dst, b, h) do { _Pragma("unroll") for (int n = 0; n < 2; ++n) _Pragma("unroll") for (int k = 0; k < 2; ++k) dst[n][k] = *(const PG8_LAS bf16x8*)(lds + PG8_SB(b, h) + boff + n * 2048 + k * 1024); } while (0)
#define PG8_MMA(ai, bj, At, Bt) do { __builtin_amdgcn_s_setprio(1); _Pragma("unroll") for (int m = 0; m < 4; ++m) _Pragma("unroll") for (int n = 0; n < 2; ++n) _Pragma("unroll") for (int k = 0; k < 2; ++k) \
        acc[ai][bj][m][n] = __builtin_amdgcn_mfma_f32_16x16x32_bf16(Bt[n][k], At[m][k], acc[ai][bj][m][n], 0, 0, 0); __builtin_amdgcn_s_setprio(0); } while (0)
#define PG8_WAIT_V(n) asm volatile("s_waitcnt vmcnt(" #n ")" ::: "memory")
#define PG8_WAIT_L(n) asm volatile("s_waitcnt lgkmcnt(" #n ")" ::: "memory")
#define PG8_BAR __builtin_amdgcn_s_barrier()
#define PG8_SCHED __builtin_amdgcn_sched_barrier(0)
    Unit cur, nxt; int ui = 0;
    if (!S.next(0, cur)) return;
    f32x4 acc[2][2][4][2];
#pragma unroll
    for (int a = 0; a < 2; ++a)
#pragma unroll
        for (int b = 0; b < 2; ++b)
#pragma unroll
            for (int m = 0; m < 4; ++m)
#pragma unroll
                for (int n = 0; n < 2; ++n) acc[a][b][m][n] = (f32x4){0.f, 0.f, 0.f, 0.f};
    bf16x8 At[4][2], B0[2][2], B1[2][2];
    const char* cA = (const char*)g.A + (size_t)cur.pm * tstep; const char* cB = (const char*)g.Bt + (size_t)cur.pn * tstep;
    S.a_ready(cur);
    if constexpr (SP2) {
        PG8_STAGE(PG8_SB(0, 0), cB, voffB); PG8_STAGE(PG8_SB(0, 1), cB + hstep, voffB); PG8_STAGE(PG8_SA(0, 0), cA, voffA); PG8_STAGE(PG8_SA(0, 1), cA + hstep, voffA);
        if (wr == 1) PG8_BAR;
        PG8_WAIT_V(2); PG8_BAR;
        PG8_STAGE(PG8_SB(1, 0), cB + kstep, voffB); PG8_STAGE(PG8_SA(1, 0), cA + kstep, voffA); PG8_STAGE(PG8_SB(1, 1), cB + hstep + kstep, voffB);
        PG8_WAIT_V(6); PG8_BAR;
    } else {
        PG8_STAGE(PG8_SB(0, 0), cB, voffB); PG8_STAGE(PG8_SA(0, 0), cA, voffA); PG8_STAGE(PG8_SB(0, 1), cB + hstep, voffB); PG8_STAGE(PG8_SA(0, 1), cA + hstep, voffA);
        if (wr == 1) PG8_BAR;
        PG8_WAIT_V(4); PG8_BAR;
        PG8_STAGE(PG8_SB(1, 0), cB + kstep, voffB); PG8_STAGE(PG8_SA(1, 0), cA + kstep, voffA); PG8_STAGE(PG8_SB(1, 1), cB + hstep + kstep, voffB);
        PG8_WAIT_V(6); PG8_BAR;
    }
    for (;;) {
        const bool has_next = S.next(ui + 1, nxt);
        const char* nA = has_next ? (const char*)g.A + (size_t)nxt.pm * tstep : cA; const char* nB = has_next ? (const char*)g.Bt + (size_t)nxt.pn * tstep : cB;
        for (int t = 0; t < nt; t += 2) {
            const bool last = (t == nt - 2);
            const char* a1 = cA + (size_t)(t + 1) * kstep;
            const char* a2 = last ? nA : cA + (size_t)(t + 2) * kstep; const char* b2 = last ? nB : cB + (size_t)(t + 2) * kstep;
            const char* a3 = a2 + kstep; const char* b3 = b2 + kstep;
            if (last && has_next) S.a_ready(nxt);
            if constexpr (SP2) {
            PG8_LDB(B0, 0, 0); PG8_LDB(B1, 0, 1); PG8_SCHED; PG8_LDA(At, 0, 0); PG8_STAGE(PG8_SA(1, 1), a1 + hstep, voffA);
            PG8_WAIT_V(8); PG8_WAIT_L(0); PG8_BAR; PG8_MMA(0, 0, At, B0); PG8_MMA(0, 1, At, B1); PG8_BAR; PG8_SCHED;
            PG8_LDA(At, 0, 1); PG8_STAGE(PG8_SB(0, 0), b2, voffB); PG8_STAGE(PG8_SB(0, 1), b2 + hstep, voffB); PG8_STAGE(PG8_SA(0, 0), a2, voffA);
            PG8_WAIT_V(8); PG8_WAIT_L(0); PG8_BAR; PG8_MMA(1, 0, At, B0); PG8_MMA(1, 1, At, B1); PG8_BAR; PG8_SCHED;
            PG8_LDB(B0, 1, 0); PG8_LDB(B1, 1, 1); PG8_SCHED; PG8_LDA(At, 1, 0); PG8_STAGE(PG8_SA(0, 1), a2 + hstep, voffA);
            PG8_WAIT_V(8); PG8_WAIT_L(0); PG8_BAR; PG8_MMA(0, 0, At, B0); PG8_MMA(0, 1, At, B1); PG8_BAR; PG8_SCHED;
            PG8_LDA(At, 1, 1); PG8_STAGE(PG8_SB(1, 0), b3, voffB); PG8_STAGE(PG8_SB(1, 1), b3 + hstep, voffB); PG8_STAGE(PG8_SA(1, 0), a3, voffA);
            PG8_WAIT_V(8); PG8_WAIT_L(0); PG8_BAR; PG8_MMA(1, 0, At, B0); PG8_MMA(1, 1, At, B1); PG8_BAR; PG8_SCHED;
            } else {
            PG8_LDB(B0, 0, 0); PG8_SCHED; PG8_LDA(At, 0, 0); PG8_STAGE(PG8_SA(1, 1), a1 + hstep, voffA);
            PG8_WAIT_L(8); PG8_BAR; PG8_WAIT_L(0); PG8_MMA(0, 0, At, B0); PG8_BAR; PG8_SCHED;
            PG8_LDB(B1, 0, 1); PG8_STAGE(PG8_SB(0, 0), b2, voffB);
            PG8_BAR; PG8_WAIT_L(0); PG8_MMA(0, 1, At, B1); PG8_BAR;
            PG8_LDA(At, 0, 1); PG8_STAGE(PG8_SA(0, 0), a2, voffA);
            PG8_BAR; PG8_WAIT_L(0); PG8_MMA(1, 0, At, B0); PG8_BAR; PG8_SCHED;
            PG8_STAGE(PG8_SB(0, 1), b2 + hstep, voffB);
            PG8_WAIT_V(6); PG8_BAR; PG8_MMA(1, 1, At, B1); PG8_BAR;
            PG8_LDB(B0, 1, 0); PG8_SCHED; PG8_LDA(At, 1, 0); PG8_STAGE(PG8_SA(0, 1), a2 + hstep, voffA);
            PG8_WAIT_L(8); PG8_BAR; PG8_WAIT_L(0); PG8_MMA(0, 0, At, B0); PG8_BAR; PG8_SCHED;
            PG8_LDB(B1, 1, 1); PG8_STAGE(PG8_SB(1, 0), b3, voffB);
            PG8_BAR; PG8_WAIT_L(0); PG8_MMA(0, 1, At, B1); PG8_BAR;
            PG8_LDA(At, 1, 1); PG8_STAGE(PG8_SA(1, 0), a3, voffA);
            PG8_BAR; PG8_WAIT_L(0); PG8_MMA(1, 0, At, B0); PG8_BAR; PG8_SCHED;
            PG8_STAGE(PG8_SB(1, 1), b3 + hstep, voffB);
            PG8_WAIT_V(6); PG8_BAR; PG8_MMA(1, 1, At, B1); PG8_BAR;
            }
        }
        if constexpr (ALIGN_EPI) { if (wr == 0) PG8_BAR; }
        if constexpr (!Epi::AFTER_DRAIN) { E(acc, cur, wr, wc, fr, fq); S.done(cur); }
        if (!has_next) break;
#pragma unroll
        for (int a = 0; a < 2; ++a)
#pragma unroll
            for (int b = 0; b < 2; ++b)
#pragma unroll
                for (int m = 0; m < 4; ++m)
#pragma unroll
                    for (int n = 0; n < 2; ++n) acc[a][b][m][n] = (f32x4){0.f, 0.f, 0.f, 0.f};
        cur = nxt; cA = nA; cB = nB; ++ui;
        if constexpr (ALIGN_EPI) { if (wr == 1) PG8_BAR; }
    }
    PG8_WAIT_V(0);
    if constexpr (!ALIGN_EPI) { if (wr == 0) PG8_BAR; }
    PG8_BAR;
    if constexpr (Epi::AFTER_DRAIN) { E.fused(acc, cur, wr, wc, fr, fq, lds, wid, lane); S.done(cur); }
#undef PG8_SA
#undef PG8_SB
#undef PG8_STAGE
#undef PG8_LDA
#undef PG8_LDB
#undef PG8_MMA
#undef PG8_WAIT_V
#undef PG8_WAIT_L
#undef PG8_BAR
#undef PG8_SCHED
}
}
#define GAS __attribute__((address_space(1)))
#define LAS __attribute__((address_space(3)))
typedef unsigned short bf16;
typedef unsigned v4u __attribute__((ext_vector_type(4)));
typedef float f32x4 __attribute__((ext_vector_type(4)));
typedef short bf16x8 __attribute__((ext_vector_type(8)));
typedef GAS unsigned gu32;
typedef GAS unsigned long long gu64;
#define RLX_AGENT __ATOMIC_RELAXED, __HIP_MEMORY_SCOPE_AGENT
#define LDS_WAIT() asm volatile("s_waitcnt lgkmcnt(0)" ::: "memory")
#define VM_WAIT() asm volatile("s_waitcnt vmcnt(0)" ::: "memory")
__device__ __forceinline__ unsigned long long rt() { return __builtin_amdgcn_s_memrealtime(); }
__device__ __forceinline__ unsigned f2bf(float f) { unsigned u = __builtin_bit_cast(unsigned, f); return (u + 0x7fffu + ((u >> 16) & 1u)) >> 16; }
__device__ __forceinline__ unsigned pk2(float lo, float hi) { return f2bf(lo) | (f2bf(hi) << 16); }

#define XB_TMO      128
#define XB_XCNT(j)  (256  + 64 * (j))
#define XB_XSUB(j)  (1280 + 64 * (j))
#define XB_XGEN(j)  (2304 + 64 * (j))
#define XB_TOP      3328
#define XB_TOPGEN   3392
#define XCD_BAR_WORDS 3456
#define XB_SPIN_CAP (1u << 18)

__device__ __forceinline__ unsigned xb_ld(unsigned* p)              { return __hip_atomic_load(p, __ATOMIC_RELAXED, __HIP_MEMORY_SCOPE_AGENT); }
__device__ __forceinline__ unsigned xb_add(unsigned* p, unsigned v) { return __hip_atomic_fetch_add(p, v, __ATOMIC_RELAXED, __HIP_MEMORY_SCOPE_AGENT); }
__device__ __forceinline__ unsigned xb_xcc_id() { return (unsigned)__builtin_amdgcn_s_getreg((3 << 11) | 20) & 0xFu; }
#define XB_SPIN(cond, bar) do { unsigned _sp = 0; while (cond) { __builtin_amdgcn_s_sleep(1); \
    if ((++_sp & 255u) == 0u) { if (xb_ld(&(bar)[XB_TMO])) break; if (_sp > XB_SPIN_CAP) { atomicAdd(&(bar)[XB_TMO], 1u); break; } } } } while (0)

struct XcdBarrier {
    unsigned* bar; unsigned x;
    volatile LAS unsigned* st;
};

__device__ __forceinline__ XcdBarrier xcd_barrier_post(unsigned* bar, volatile LAS unsigned* st) {
    XcdBarrier b; b.bar = bar; b.x = xb_xcc_id(); b.st = st;
    if (threadIdx.x == 0) (void)xb_add(&bar[XB_XCNT(b.x)], 1u);
    return b;
}
__device__ __forceinline__ void xcd_barrier_complete(unsigned* bar, unsigned x, unsigned& nloc, unsigned& nx) {
    const unsigned G = gridDim.x * gridDim.y * gridDim.z;
    unsigned sum, cnt, mine, sp = 0u;
    for (;;) {
        sum = 0u; cnt = 0u; mine = 0u;
#pragma unroll
        for (unsigned j = 0; j < 16; ++j) { const unsigned c = xb_ld(&bar[XB_XCNT(j)]); sum += c; cnt += (c > 0u) ? 1u : 0u; mine = (j == x) ? c : mine; }
        if (sum == G) break;
        __builtin_amdgcn_s_sleep(1);
        if ((++sp & 255u) == 0u) { if (xb_ld(&bar[XB_TMO])) break; if (sp > XB_SPIN_CAP) { atomicAdd(&bar[XB_TMO], 1u); break; } }
    }
    nloc = mine > 0u ? mine : 1u; nx = cnt > 0u ? cnt : 1u;
}

__device__ __forceinline__ void xcd_barrier(const XcdBarrier& b) {
    asm volatile("s_waitcnt vmcnt(0)" ::: "memory");
    __syncthreads();
    if (threadIdx.x == 0) {
        unsigned* bar = b.bar;
        __builtin_amdgcn_s_waitcnt(0);
        unsigned nloc = b.st[0], nx = b.st[1];
        if (nloc == 0u) { xcd_barrier_complete(bar, b.x, nloc, nx); b.st[0] = nloc; b.st[1] = nx; }
        const unsigned old = xb_add(&bar[XB_XSUB(b.x)], 1u);
        const unsigned gen = old / nloc;
        if (old + 1u == (gen + 1u) * nloc) {
            __builtin_amdgcn_fence(__ATOMIC_RELEASE, "agent");
            asm volatile("s_waitcnt vmcnt(0)" ::: "memory");
            const unsigned og = xb_add(&bar[XB_TOP], 1u);
            const unsigned tg = og / nx;
            if (og + 1u == (tg + 1u) * nx) xb_add(&bar[XB_TOPGEN], 1u);
            else XB_SPIN(xb_ld(&bar[XB_TOPGEN]) == tg, bar);
            __builtin_amdgcn_fence(__ATOMIC_ACQUIRE, "agent");
            xb_add(&bar[XB_XGEN(b.x)], 1u);
            asm volatile("s_waitcnt vmcnt(0)" ::: "memory");
        } else {
            XB_SPIN(xb_ld(&bar[XB_XGEN(b.x)]) == gen, bar);
            __builtin_amdgcn_fence(__ATOMIC_ACQUIRE, "agent");
            asm volatile("s_waitcnt vmcnt(0)" ::: "memory");
        }
    }
    __syncthreads();
}

constexpr int NWAVES = 8, NTHREADS = 512;
constexpr int BATCH = 4, SEQ = 2048, D = 2048, M = BATCH * SEQ;
constexpr int NQH = 32, NKVH = 4, HD = 64, QPKV = 8, WINDOW = 128;
constexpr int Q_OFF = 0, K_OFF = 2048, V_OFF = 2304, CB_OFF = 2560, CC_OFF = 4608, CH_OFF = 6656, G_OFF = 8704, IN_W = 12800;
constexpr int PH = 8, PNK = 128, PTOPK = 16, PNE = 16384;
constexpr float LN_EPS = 1e-5f;
constexpr float ALPHA = 1.189207115002721f;

#ifndef MK_PER_PHASE
#define MK_PER_PHASE 0
#endif
constexpr int N_PHASES = 12;

constexpr size_t MiB = 1u << 20;
constexpr size_t WS_CTL = 0, CTL_ZERO_BYTES = 1 * MiB;
constexpr size_t WS_WIN = 1 * MiB;
constexpr size_t WS_WA = 51 * MiB, WS_WC = 59 * MiB, WS_WO = 67 * MiB, WS_WF = 75 * MiB;
constexpr size_t WS_XB = 83 * MiB;
constexpr size_t WS_MERGED = WS_XB;
constexpr size_t WS_Z = 115 * MiB;
constexpr size_t WS_R2B = 115 * MiB;
constexpr size_t WS_H1B = 179 * MiB;
constexpr size_t WS_SC = 211 * MiB;
constexpr size_t WS_EX = 275 * MiB;
constexpr size_t WS_GT = 279 * MiB;
constexpr size_t WS_AO = 315 * MiB, WS_CI = 347 * MiB, WS_TMP = 379 * MiB;
constexpr size_t WS_U8 = 411 * MiB, WS_V8 = 443 * MiB;
constexpr size_t WS_SU = 475 * MiB, WS_SV = WS_SU + 65536;
constexpr size_t WS_PA = WS_SC;
constexpr size_t WS_XQ = 283 * MiB;
constexpr size_t WS_SX = 299 * MiB;
constexpr size_t WS_WB = 380 * MiB;
constexpr size_t WS_ST = 379 * MiB;
constexpr size_t WS_END = 476 * MiB;
constexpr int CW_Q = 12288;
constexpr size_t SLICE_BYTES = (size_t)PNE * 256;
constexpr int CW_BAR = 4096;

constexpr int RING_BYTES = 131072;
constexpr int LDSCTL_OFF = 147456, MISC_OFF = LDSCTL_OFF + 320;
constexpr int LDS_BYTES = LDSCTL_OFF + 512;

typedef float f32x16 __attribute__((ext_vector_type(16)));
typedef unsigned v2u __attribute__((ext_vector_type(2)));
__device__ __forceinline__ float wave_sum(float v) {
#pragma unroll
    for (int o = 1; o < 64; o <<= 1) v += __shfl_xor(v, o);
    return v;
}
__device__ __forceinline__ float vmaxf(float a, float b) { float r; asm("v_max_f32_e32 %0, %1, %2" : "=v"(r) : "v"(a), "v"(b)); return r; }
__device__ __forceinline__ float vminf(float a, float b) { float r; asm("v_min_f32_e32 %0, %1, %2" : "=v"(r) : "v"(a), "v"(b)); return r; }

__device__ __forceinline__ void p0_transpose_item(const float* W, int K, int N, bf16* WT, LAS float* scr, int item, int lane) {
    const int nblk = N / 32, kb = item / nblk, nb = item % nblk, k0 = 64 * kb, n0 = 32 * nb;
#pragma unroll 8
    for (int i = 0; i < 32; ++i) { const int kk = 2 * i + (lane >> 5); scr[kk * 33 + (lane & 31)] = W[(size_t)(k0 + kk) * N + n0 + (lane & 31)]; }
    LDS_WAIT(); asm volatile("" ::: "memory");
    const int c = lane & 7;
#pragma unroll
    for (int j = 0; j < 4; ++j) { const int n = (lane >> 3) + 8 * j; const LAS float* s = scr + (8 * c) * 33 + n;
        v4u o; o.x = pk2(s[0 * 33], s[1 * 33]); o.y = pk2(s[2 * 33], s[3 * 33]); o.z = pk2(s[4 * 33], s[5 * 33]); o.w = pk2(s[6 * 33], s[7 * 33]);
        *(GAS v4u*)(WT + (size_t)(n0 + n) * K + k0 + 8 * c) = o; }
    LDS_WAIT(); asm volatile("" ::: "memory");
}
__device__ __forceinline__ void p0_wf_item(const float* wq, const float* sk, bf16* WfT, LAS unsigned char* lds, int item, int tid) {
    const int hp = item >> 5, dt = item & 31;
    LAS f32x4* SK4 = (LAS f32x4*)lds;
    LAS f32x4* WQ4 = SK4 + 128 * 33;
    const float* skp = sk + (size_t)hp * 128 * 128;
    for (int i = tid; i < 128 * 32; i += NTHREADS) { const int n = i >> 5, c4 = i & 31; SK4[n * 33 + c4] = *(const f32x4*)(skp + n * 128 + 4 * c4); }
    for (int i = tid; i < 64 * 32; i += NTHREADS) { const int r = i >> 5, c4 = i & 31; WQ4[r * 33 + c4] = *(const f32x4*)(wq + (size_t)(64 * dt + r) * 2048 + hp * 128 + 4 * c4); }
    __syncthreads();
    const int td = tid & 15, tn = tid >> 4;
    float acc[4][4];
#pragma unroll
    for (int i = 0; i < 4; ++i)
#pragma unroll
        for (int j = 0; j < 4; ++j) acc[i][j] = 0.f;
#pragma unroll 4
    for (int c4 = 0; c4 < 32; ++c4) {
        f32x4 a[4], b[4];
#pragma unroll
        for (int i = 0; i < 4; ++i) a[i] = SK4[(4 * tn + i) * 33 + c4];
#pragma unroll
        for (int j = 0; j < 4; ++j) b[j] = WQ4[(td + 16 * j) * 33 + c4];
#pragma unroll
        for (int i = 0; i < 4; ++i)
#pragma unroll
            for (int j = 0; j < 4; ++j) acc[i][j] += a[i].x * b[j].x + a[i].y * b[j].y + a[i].z * b[j].z + a[i].w * b[j].w;
    }
#pragma unroll
    for (int i = 0; i < 4; ++i)
#pragma unroll
        for (int j = 0; j < 4; ++j) WfT[(size_t)(hp * 128 + 4 * tn + i) * 2048 + 64 * dt + td + 16 * j] = (bf16)f2bf(acc[i][j]);
    __syncthreads();
}

__device__ __forceinline__ int perm16(int o) { return 8 * ((o >> 2) & 1) + 4 * (o >> 3) + (o & 3); }
__device__ __forceinline__ void attn_unit(int unit, const bf16* z, bf16* ao, const float* sinks, LAS unsigned char* lds, int tid) {
    const int lane = tid & 63, wid = __builtin_amdgcn_readfirstlane(tid >> 6), r32 = lane & 31, hi = lane >> 5;
    const int nb = unit & 15, kvh = (unit >> 4) & 3, b = unit >> 6;
    LAS bf16* Ks = (LAS bf16*)lds;
    LAS bf16* Vt = (LAS bf16*)(lds + 256 * 144);
    const size_t tok0 = (size_t)b * SEQ;
#pragma unroll
    for (int i = 0; i < 4; ++i) {
        const int ci = tid + NTHREADS * i, key = ci >> 3, dc = ci & 7;
        int kpos = 128 * (nb - 1) + key; if (kpos < 0) kpos = 0;
        const bf16* src = z + (tok0 + kpos) * IN_W + K_OFF + kvh * HD + dc * 8;
        const v4u kv = *(const GAS v4u*)src, vv = *(const GAS v4u*)(src + (V_OFF - K_OFF));
        *(LAS v4u*)(Ks + key * 72 + dc * 8) = kv;
        const int pos = (key & ~15) + perm16(key & 15);
        LAS bf16* vp = Vt + (dc * 8) * 264 + pos;
        vp[0 * 264] = (bf16)(vv.x & 0xffffu); vp[1 * 264] = (bf16)(vv.x >> 16); vp[2 * 264] = (bf16)(vv.y & 0xffffu); vp[3 * 264] = (bf16)(vv.y >> 16);
        vp[4 * 264] = (bf16)(vv.z & 0xffffu); vp[5 * 264] = (bf16)(vv.z >> 16); vp[6 * 264] = (bf16)(vv.w & 0xffffu); vp[7 * 264] = (bf16)(vv.w >> 16);
    }
    __syncthreads();
    const int hq = kvh * QPKV + wid;
    const float LOG2E = 1.4426950408889634f;
    const float sink2 = sinks[hq] * LOG2E, sc = 0.125f * LOG2E;
#pragma unroll 1
    for (int qg = 0; qg < 4; ++qg) {
        const size_t tok = tok0 + 128 * nb + 32 * qg + r32;
        bf16x8 qf[4];
#pragma unroll
        for (int ks = 0; ks < 4; ++ks) qf[ks] = *(const GAS bf16x8*)(z + tok * IN_W + Q_OFF + hq * HD + 16 * ks + 8 * hi);
        f32x16 s[5];
#pragma unroll
        for (int kt = 0; kt < 5; ++kt) {
            s[kt] = (f32x16){0.f, 0.f, 0.f, 0.f, 0.f, 0.f, 0.f, 0.f, 0.f, 0.f, 0.f, 0.f, 0.f, 0.f, 0.f, 0.f};
#pragma unroll
            for (int ks = 0; ks < 4; ++ks) {
                const bf16x8 kf = *(const LAS bf16x8*)(Ks + (32 * (qg + kt) + r32) * 72 + 16 * ks + 8 * hi);
                s[kt] = __builtin_amdgcn_mfma_f32_32x32x16_bf16(kf, qf[ks], s[kt], 0, 0, 0);
            }
        }
        float mx = sink2;
#pragma unroll
        for (int kt = 0; kt < 5; ++kt) {
            const bool tile_dead = (nb == 0) && (qg + kt < 4);
#pragma unroll
            for (int r = 0; r < 16; ++r) {
                const int krow = (r & 3) + 8 * (r >> 2) + 4 * hi;
                bool valid = !tile_dead;
                if (kt == 0) valid = valid && (krow > r32);
                if (kt == 4) valid = valid && (krow <= r32);
                const float v = valid ? s[kt][r] * sc : -INFINITY;
                s[kt][r] = v; mx = fmaxf(mx, v);
            }
        }
        mx = fmaxf(mx, __shfl_xor(mx, 32));
        float sum = 0.f;
#pragma unroll
        for (int kt = 0; kt < 5; ++kt)
#pragma unroll
            for (int r = 0; r < 16; ++r) { const float p = __builtin_amdgcn_exp2f(s[kt][r] - mx); s[kt][r] = p; sum += p; }
        sum += __shfl_xor(sum, 32);
        const float inv = 1.0f / (sum + __builtin_amdgcn_exp2f(sink2 - mx));
        f32x16 o[2];
        o[0] = (f32x16){0.f, 0.f, 0.f, 0.f, 0.f, 0.f, 0.f, 0.f, 0.f, 0.f, 0.f, 0.f, 0.f, 0.f, 0.f, 0.f}; o[1] = o[0];
#pragma unroll
        for (int kt = 0; kt < 5; ++kt)
#pragma unroll
            for (int s2 = 0; s2 < 2; ++s2) {
                v4u pw; pw.x = pg8::cvt_pk_bf16(s[kt][8 * s2 + 0], s[kt][8 * s2 + 1]); pw.y = pg8::cvt_pk_bf16(s[kt][8 * s2 + 2], s[kt][8 * s2 + 3]);
                pw.z = pg8::cvt_pk_bf16(s[kt][8 * s2 + 4], s[kt][8 * s2 + 5]); pw.w = pg8::cvt_pk_bf16(s[kt][8 * s2 + 6], s[kt][8 * s2 + 7]);
                const bf16x8 pa = __builtin_bit_cast(bf16x8, pw);
#pragma unroll
                for (int dt = 0; dt < 2; ++dt) {
                    const bf16x8 vf = *(const LAS bf16x8*)(Vt + (32 * dt + r32) * 264 + 32 * (qg + kt) + 16 * s2 + 8 * hi);
                    o[dt] = __builtin_amdgcn_mfma_f32_32x32x16_bf16(vf, pa, o[dt], 0, 0, 0);
                }
            }
        bf16* op = ao + tok * D + hq * HD;
#pragma unroll
        for (int dt = 0; dt < 2; ++dt)
#pragma unroll
            for (int g = 0; g < 4; ++g) {
                v2u w; w.x = pg8::cvt_pk_bf16(o[dt][4 * g + 0] * inv, o[dt][4 * g + 1] * inv); w.y = pg8::cvt_pk_bf16(o[dt][4 * g + 2] * inv, o[dt][4 * g + 3] * inv);
                *(GAS v2u*)(op + 32 * dt + 8 * g + 4 * hi) = w;
            }
    }
    __syncthreads();
}
__device__ __forceinline__ void conv_item(int item, const bf16* z, const float* cw, bf16* ci, int tid) {
    const int c8 = tid & 255, half = tid >> 8, t0 = 32 * item + 16 * half, c0 = 8 * c8;
    float w0[8], w1[8], w2[8], u1[8], u2[8];
#pragma unroll
    for (int e = 0; e < 8; ++e) { w0[e] = cw[c0 + e]; w1[e] = cw[2048 + c0 + e]; w2[e] = cw[4096 + c0 + e]; u1[e] = 0.f; u2[e] = 0.f; }
    if ((t0 & (SEQ - 1)) != 0) {
#pragma unroll
        for (int k = 0; k < 2; ++k) {
            const bf16* zr = z + (size_t)(t0 - 2 + k) * IN_W + c0;
            const v4u a = *(const GAS v4u*)(zr + CC_OFF), h = *(const GAS v4u*)(zr + CH_OFF);
            float u[8];
            u[0] = pg8::bf_lo(a.x) * pg8::bf_lo(h.x); u[1] = pg8::bf_hi(a.x) * pg8::bf_hi(h.x); u[2] = pg8::bf_lo(a.y) * pg8::bf_lo(h.y); u[3] = pg8::bf_hi(a.y) * pg8::bf_hi(h.y);
            u[4] = pg8::bf_lo(a.z) * pg8::bf_lo(h.z); u[5] = pg8::bf_hi(a.z) * pg8::bf_hi(h.z); u[6] = pg8::bf_lo(a.w) * pg8::bf_lo(h.w); u[7] = pg8::bf_hi(a.w) * pg8::bf_hi(h.w);
#pragma unroll
            for (int e = 0; e < 8; ++e) { if (k == 0) u2[e] = u[e]; else u1[e] = u[e]; }
        }
    }
#pragma unroll 4
    for (int i = 0; i < 16; ++i) {
        const bf16* zr = z + (size_t)(t0 + i) * IN_W + c0;
        const v4u a = *(const GAS v4u*)(zr + CC_OFF), h = *(const GAS v4u*)(zr + CH_OFF), bb = *(const GAS v4u*)(zr + CB_OFF);
        float u[8], cb[8], y[8];
        u[0] = pg8::bf_lo(a.x) * pg8::bf_lo(h.x); u[1] = pg8::bf_hi(a.x) * pg8::bf_hi(h.x); u[2] = pg8::bf_lo(a.y) * pg8::bf_lo(h.y); u[3] = pg8::bf_hi(a.y) * pg8::bf_hi(h.y);
        u[4] = pg8::bf_lo(a.z) * pg8::bf_lo(h.z); u[5] = pg8::bf_hi(a.z) * pg8::bf_hi(h.z); u[6] = pg8::bf_lo(a.w) * pg8::bf_lo(h.w); u[7] = pg8::bf_hi(a.w) * pg8::bf_hi(h.w);
        cb[0] = pg8::bf_lo(bb.x); cb[1] = pg8::bf_hi(bb.x); cb[2] = pg8::bf_lo(bb.y); cb[3] = pg8::bf_hi(bb.y); cb[4] = pg8::bf_lo(bb.z); cb[5] = pg8::bf_hi(bb.z); cb[6] = pg8::bf_lo(bb.w); cb[7] = pg8::bf_hi(bb.w);
#pragma unroll
        for (int e = 0; e < 8; ++e) { y[e] = cb[e] * (w0[e] * u2[e] + w1[e] * u1[e] + w2[e] * u[e]); u2[e] = u1[e]; u1[e] = u[e]; }
        v4u o; o.x = pk2(y[0], y[1]); o.y = pk2(y[2], y[3]); o.z = pk2(y[4], y[5]); o.w = pk2(y[6], y[7]);
        *(GAS v4u*)(ci + (size_t)(t0 + i) * D + c0) = o;
    }
}

__device__ __forceinline__ unsigned pack_i8(const f32x4 v) {
    const int a = __float2int_rn(v.x), b = __float2int_rn(v.y), c = __float2int_rn(v.z), d = __float2int_rn(v.w);
    return ((unsigned)a & 0xffu) | (((unsigned)b & 0xffu) << 8) | (((unsigned)c & 0xffu) << 16) | ((unsigned)d << 24);
}
__device__ __forceinline__ unsigned pack_i8_2(float a, float b, float c, float d) {
    const int ia = __float2int_rn(a), ib = __float2int_rn(b), ic = __float2int_rn(c), id = __float2int_rn(d);
    return ((unsigned)ia & 0xffu) | (((unsigned)ib & 0xffu) << 8) | (((unsigned)ic & 0xffu) << 16) | ((unsigned)id << 24);
}
__device__ __forceinline__ void ln1_row(bf16* hbrow, signed char* xqrow, float* sxp, const float* g, const float* bta, int lane) {
    GAS v4u* xr = (GAS v4u*)hbrow + lane;
    float v[4][8]; float s = 0.f;
#pragma unroll
    for (int j = 0; j < 4; ++j) { const v4u w = xr[64 * j];
        v[j][0] = pg8::bf_lo(w.x); v[j][1] = pg8::bf_hi(w.x); v[j][2] = pg8::bf_lo(w.y); v[j][3] = pg8::bf_hi(w.y); v[j][4] = pg8::bf_lo(w.z); v[j][5] = pg8::bf_hi(w.z); v[j][6] = pg8::bf_lo(w.w); v[j][7] = pg8::bf_hi(w.w);
#pragma unroll
        for (int e = 0; e < 8; ++e) s += v[j][e]; }
    const float mean = wave_sum(s) * (1.f / D); float s2 = 0.f;
#pragma unroll
    for (int j = 0; j < 4; ++j)
#pragma unroll
        for (int e = 0; e < 8; ++e) { v[j][e] -= mean; s2 += v[j][e] * v[j][e]; }
    const float rstd = 1.f / sqrtf(wave_sum(s2) * (1.f / D) + LN_EPS);
    float mx = 0.f;
#pragma unroll
    for (int j = 0; j < 4; ++j) {
        const GAS f32x4* gp = (const GAS f32x4*)g + 2 * (lane + 64 * j); const GAS f32x4* bp = (const GAS f32x4*)bta + 2 * (lane + 64 * j);
        const f32x4 g0 = gp[0], g1 = gp[1], b0 = bp[0], b1 = bp[1];
        v[j][0] = v[j][0] * rstd * g0.x + b0.x; v[j][1] = v[j][1] * rstd * g0.y + b0.y; v[j][2] = v[j][2] * rstd * g0.z + b0.z; v[j][3] = v[j][3] * rstd * g0.w + b0.w;
        v[j][4] = v[j][4] * rstd * g1.x + b1.x; v[j][5] = v[j][5] * rstd * g1.y + b1.y; v[j][6] = v[j][6] * rstd * g1.z + b1.z; v[j][7] = v[j][7] * rstd * g1.w + b1.w;
        v4u o; o.x = pk2(v[j][0], v[j][1]); o.y = pk2(v[j][2], v[j][3]); o.z = pk2(v[j][4], v[j][5]); o.w = pk2(v[j][6], v[j][7]);
        xr[64 * j] = o;
#pragma unroll
        for (int e = 0; e < 8; ++e) mx = fmaxf(mx, fabsf(v[j][e]));
    }
#pragma unroll
    for (int o = 1; o < 64; o <<= 1) mx = fmaxf(mx, __shfl_xor(mx, o));
    const float qs = mx > 0.f ? 127.0f / mx : 1.0f;
    GAS v2u* q8 = (GAS v2u*)xqrow + lane;
#pragma unroll
    for (int j = 0; j < 4; ++j) { v2u o; o.x = pack_i8_2(v[j][0] * qs, v[j][1] * qs, v[j][2] * qs, v[j][3] * qs); o.y = pack_i8_2(v[j][4] * qs, v[j][5] * qs, v[j][6] * qs, v[j][7] * qs); q8[64 * j] = o; }
    if (lane == 0) *sxp = mx > 0.f ? mx * (1.0f / 127.0f) : 1.0f;
}

constexpr int TK_ROWF = 136;
constexpr int TK_IDX_OFF = 256 * TK_ROWF * 4;
__device__ __forceinline__ void topk_core(LAS unsigned char* lds, size_t prob0, int pstride, int* experts, float* gates, int tid) {
    LAS float* S = (LAS float*)lds;
    LAS unsigned char* IDX = lds + TK_IDX_OFF;
    const int row = tid >> 1, sub = tid & 1;
#define TK_CE(a, b) do { const float h_ = vmaxf(a, b), l_ = vminf(a, b); a = h_; b = l_; } while (0)
#define TK_SORT16(V) do { _Pragma("unroll") for (int k_ = 2; k_ <= 16; k_ <<= 1) _Pragma("unroll") for (int j_ = k_ >> 1; j_ > 0; j_ >>= 1) _Pragma("unroll") for (int i_ = 0; i_ < 16; ++i_) { \
        const int l_i = i_ ^ j_; if (l_i > i_) { if ((i_ & k_) == 0) TK_CE(V[i_], V[l_i]); else TK_CE(V[l_i], V[i_]); } } } while (0)
#define TK_MERGE16(Lv, Xv) do { _Pragma("unroll") for (int j_ = 0; j_ < 16; ++j_) Lv[j_] = vmaxf(Lv[j_], Xv[15 - j_]); \
        _Pragma("unroll") for (int st_ = 8; st_ >= 1; st_ >>= 1) _Pragma("unroll") for (int j_ = 0; j_ < 16; ++j_) if ((j_ & st_) == 0) TK_CE(Lv[j_], Lv[j_ + st_]); } while (0)
    float L[16];
#pragma unroll
    for (int q = 0; q < 4; ++q) {
        float C[16];
#pragma unroll
        for (int i = 0; i < 4; ++i) { const int c4 = 2 * (4 * q + i) + sub;
            const f32x4 v = *(const LAS f32x4*)(S + row * TK_ROWF + 4 * c4);
#pragma unroll
            for (int e = 0; e < 4; ++e) { const float ve = v[e];
                C[4 * i + e] = __uint_as_float((__float_as_uint(ve) & ~0x7Fu) | (unsigned)(4 * c4 + e)); } }
        TK_SORT16(C);
        if (q == 0) {
#pragma unroll
            for (int j = 0; j < 16; ++j) L[j] = C[j];
        } else TK_MERGE16(L, C);
    }
    {
        float P[16];
#pragma unroll
        for (int j = 0; j < 16; ++j) P[j] = __shfl_xor(L[j], 1);
        TK_MERGE16(L, P);
    }
    if (sub == 0) {
#pragma unroll
        for (int q = 0; q < 4; ++q) {
            unsigned w = 0;
#pragma unroll
            for (int e = 0; e < 4; ++e) w |= (__builtin_bit_cast(unsigned, L[4 * q + e]) & 0x7Fu) << (8 * e);
            *(LAS unsigned*)(IDX + row * 16 + 4 * q) = w;
        }
    }
    float A[16], B[16];
#pragma unroll
    for (int j = 0; j < 16; ++j) { const float o = __shfl_xor(L[j], 2); const bool isb = (tid & 2) != 0; A[j] = isb ? o : L[j]; B[j] = isb ? L[j] : o; }
#define TK_KEY(i, j) __uint_as_float((__float_as_uint(A[i] + B[j]) & ~0xFFu) | (unsigned)(255 - ((i) * 16 + (j))))
    float F[16], X[16];
#pragma unroll
    for (int j = 0; j < 16; ++j) F[j] = TK_KEY(0, j);
#pragma unroll
    for (int i = 1; i < 16; ++i) X[i - 1] = TK_KEY(i, 0);
    X[15] = -INFINITY; TK_MERGE16(F, X);
#pragma unroll
    for (int i = 0; i < 16; ++i) X[i] = -INFINITY;
#pragma unroll
    for (int i = 1; i <= 7; ++i) X[i - 1] = TK_KEY(i, 1);
    TK_MERGE16(F, X);
#pragma unroll
    for (int i = 0; i < 16; ++i) X[i] = -INFINITY;
#pragma unroll
    for (int j = 2; j <= 7; ++j) X[j - 2] = TK_KEY(1, j);
    TK_MERGE16(F, X);
    { const float rest[6] = {TK_KEY(2, 2), TK_KEY(2, 3), TK_KEY(2, 4), TK_KEY(3, 2), TK_KEY(3, 3), TK_KEY(4, 2)};
#pragma unroll
      for (int r = 0; r < 6; ++r) { float x = rest[r];
#pragma unroll
          for (int k = 0; k < 16; ++k) { const float h = vmaxf(F[k], x); x = vminf(F[k], x); F[k] = h; } } }
    __syncthreads();
    if ((tid & 3) == 0) {
        const int rowA = (tid >> 2) * 2, rowB = rowA + 1;
        const size_t prob = prob0 + (size_t)pstride * (tid >> 2);
        float g[16]; int ex[16]; float gs = 0.f;
#pragma unroll
        for (int k = 0; k < 16; ++k) {
            const unsigned code = 255u - (__builtin_bit_cast(unsigned, F[k]) & 0xFFu);
            const int ia = IDX[rowA * 16 + (code >> 4)], ib = IDX[rowB * 16 + (code & 15)];
            ex[k] = ia * PNK + ib;
            g[k] = __expf(F[k] - F[0]); gs += g[k];
        }
        const float ginv = 1.0f / gs;
#pragma unroll
        for (int q = 0; q < 4; ++q) {
            *(GAS f32x4*)(gates + prob * 16 + 4 * q) = (f32x4){g[4 * q] * ginv, g[4 * q + 1] * ginv, g[4 * q + 2] * ginv, g[4 * q + 3] * ginv};
            typedef int i32x4 __attribute__((ext_vector_type(4)));
            *(GAS i32x4*)(experts + prob * 16 + 4 * q) = (i32x4){ex[4 * q], ex[4 * q + 1], ex[4 * q + 2], ex[4 * q + 3]};
        }
    }
    __syncthreads();
}
__device__ __forceinline__ void topk_pass(int pass, const float* scores, int* experts, float* gates, LAS unsigned char* lds, int tid) {
    LAS float* S = (LAS float*)lds;
    const float* src = scores + (size_t)pass * (256 * 128);
#pragma unroll 4
    for (int i = 0; i < 16; ++i) { const int f4 = tid + NTHREADS * i, row = f4 >> 5, c4 = f4 & 31; *(LAS f32x4*)(S + row * TK_ROWF + 4 * c4) = *(const GAS f32x4*)(src + (size_t)f4 * 4); }
    __syncthreads();
    topk_core(lds, (size_t)pass * 128, 1, experts, gates, tid);
}
struct EpiTopK {
    static constexpr bool PERM = false, AFTER_DRAIN = true;
    int* experts; float* gates;
    __device__ __forceinline__ void fused(pg8::f32x4 (&acc)[2][2][4][2], const pg8::Unit& u, int wr, int wc, int fr, int fq, LAS unsigned char* lds, int wid, int lane) const {
        LAS float* S = (LAS float*)lds;
        const int tid = wid * 64 + lane;
#pragma unroll
        for (int ai = 0; ai < 2; ++ai) {
#pragma unroll
            for (int bj = 0; bj < 2; ++bj)
#pragma unroll
                for (int mm = 0; mm < 4; ++mm)
#pragma unroll
                    for (int n = 0; n < 2; ++n) { const int rl = 64 * wr + 16 * mm + fr; *(LAS pg8::f32x4*)(S + (2 * rl + bj) * TK_ROWF + 32 * wc + 16 * n + 4 * fq) = acc[ai][bj][mm][n]; }
            __syncthreads();
            topk_core(lds, ((size_t)u.pm * 256 + 128 * ai) * PH + u.pn, PH, experts, gates, tid);
        }
    }
};

__device__ __forceinline__ float gelu_erf(float v) { return 0.5f * v * (1.0f + erff(v * 0.70710678118654752f)); }
typedef __bf16 bf16x2_t __attribute__((ext_vector_type(2)));
typedef float f32x2_t __attribute__((ext_vector_type(2)));
__device__ __forceinline__ float dot2bf(bf16x2_t a, unsigned b, float acc) { return __builtin_amdgcn_fdot2_f32_bf16(a, __builtin_bit_cast(bf16x2_t, b), acc, false); }
__device__ __forceinline__ float dot4f8(unsigned w8, unsigned x01, unsigned x23, float acc) {
    acc = dot2bf(__builtin_amdgcn_cvt_scalef32_pk_bf16_fp8(w8, 1.0f, false), x01, acc);
    return dot2bf(__builtin_amdgcn_cvt_scalef32_pk_bf16_fp8(w8, 1.0f, true), x23, acc);
}
__device__ __forceinline__ void axpy4f8(float* y, unsigned w8, float w) {
    const f32x2_t lo = __builtin_amdgcn_cvt_pk_f32_fp8(w8, false), hi = __builtin_amdgcn_cvt_pk_f32_fp8(w8, true);
    y[0] += w * lo.x; y[1] += w * lo.y; y[2] += w * hi.x; y[3] += w * hi.y;
}
__device__ __forceinline__ void axpy4f8v(f32x2_t* y2, unsigned w8, float w) {
    const f32x2_t lo = __builtin_amdgcn_cvt_pk_f32_fp8(w8, false), hi = __builtin_amdgcn_cvt_pk_f32_fp8(w8, true);
    const f32x2_t ww = {w, w};
    y2[0] = __builtin_elementwise_fma(lo, ww, y2[0]); y2[1] = __builtin_elementwise_fma(hi, ww, y2[1]);
}
__device__ __forceinline__ void row_to_fp8(const float* src, unsigned char* dst, float* inv, int lane) {
    f32x4 v[2][4]; float mx = 0.f;
#pragma unroll
    for (int j = 0; j < 2; ++j)
#pragma unroll
        for (int q = 0; q < 4; ++q) { v[j][q] = *((const GAS f32x4*)src + 4 * (lane + 64 * j) + q);
            mx = fmaxf(mx, fmaxf(fmaxf(fabsf(v[j][q].x), fabsf(v[j][q].y)), fmaxf(fabsf(v[j][q].z), fabsf(v[j][q].w)))); }
#pragma unroll
    for (int o = 1; o < 64; o <<= 1) mx = fmaxf(mx, __shfl_xor(mx, o));
    const float sc = mx > 0.f ? 384.0f / mx : 1.0f;
#pragma unroll
    for (int j = 0; j < 2; ++j) { v4u o;
        int w;
        w = 0; w = __builtin_amdgcn_cvt_pk_fp8_f32(v[j][0].x * sc, v[j][0].y * sc, w, false); w = __builtin_amdgcn_cvt_pk_fp8_f32(v[j][0].z * sc, v[j][0].w * sc, w, true); o.x = (unsigned)w;
        w = 0; w = __builtin_amdgcn_cvt_pk_fp8_f32(v[j][1].x * sc, v[j][1].y * sc, w, false); w = __builtin_amdgcn_cvt_pk_fp8_f32(v[j][1].z * sc, v[j][1].w * sc, w, true); o.y = (unsigned)w;
        w = 0; w = __builtin_amdgcn_cvt_pk_fp8_f32(v[j][2].x * sc, v[j][2].y * sc, w, false); w = __builtin_amdgcn_cvt_pk_fp8_f32(v[j][2].z * sc, v[j][2].w * sc, w, true); o.z = (unsigned)w;
        w = 0; w = __builtin_amdgcn_cvt_pk_fp8_f32(v[j][3].x * sc, v[j][3].y * sc, w, false); w = __builtin_amdgcn_cvt_pk_fp8_f32(v[j][3].z * sc, v[j][3].w * sc, w, true); o.w = (unsigned)w;
        { const int ch = lane + 64 * j; *((GAS v4u*)(dst + (size_t)(ch >> 4) * SLICE_BYTES) + (ch & 15)) = o; } }
    if (lane == 0) *inv = mx > 0.f ? mx * (1.0f / 384.0f) : 1.0f;
}
__device__ __forceinline__ void row_to_i8(const float* src, unsigned char* dst, float* inv, int lane) {
    f32x4 v[2][4]; float mx = 0.f;
#pragma unroll
    for (int j = 0; j < 2; ++j)
#pragma unroll
        for (int q = 0; q < 4; ++q) { v[j][q] = *((const GAS f32x4*)src + 4 * (lane + 64 * j) + q);
            mx = fmaxf(mx, fmaxf(fmaxf(fabsf(v[j][q].x), fabsf(v[j][q].y)), fmaxf(fabsf(v[j][q].z), fabsf(v[j][q].w)))); }
#pragma unroll
    for (int o = 1; o < 64; o <<= 1) mx = fmaxf(mx, __shfl_xor(mx, o));
    const float sc = mx > 0.f ? 127.0f / mx : 1.0f;
#pragma unroll
    for (int j = 0; j < 2; ++j) { v4u o; o.x = pack_i8(v[j][0] * sc); o.y = pack_i8(v[j][1] * sc); o.z = pack_i8(v[j][2] * sc); o.w = pack_i8(v[j][3] * sc);
        { const int ch = lane + 64 * j; *((GAS v4u*)(dst + (size_t)(ch >> 4) * SLICE_BYTES) + (ch & 15)) = o; } }
    if (lane == 0) *inv = mx > 0.f ? mx * (1.0f / 127.0f) : 1.0f;
}
__device__ __forceinline__ float row16_allsum(float a) {
    a += __builtin_bit_cast(float, __builtin_amdgcn_update_dpp(0, __builtin_bit_cast(int, a), 0x128, 0xf, 0xf, false));
    a += __builtin_bit_cast(float, __builtin_amdgcn_update_dpp(0, __builtin_bit_cast(int, a), 0x124, 0xf, 0xf, false));
    a += __builtin_bit_cast(float, __builtin_amdgcn_update_dpp(0, __builtin_bit_cast(int, a), 0x122, 0xf, 0xf, false));
    a += __builtin_bit_cast(float, __builtin_amdgcn_update_dpp(0, __builtin_bit_cast(int, a), 0x121, 0xf, 0xf, false));
    return a;
}
__device__ __forceinline__ int q_pull(unsigned* q, int lane) { int v = 0; if (lane == 0) v = (int)__hip_atomic_fetch_add(q, 1u, __ATOMIC_RELAXED, __HIP_MEMORY_SCOPE_AGENT); return __builtin_amdgcn_readfirstlane(v); }
constexpr int PEER_TG = 8;
constexpr int PEER_N8 = 640, PEER_N4 = 512, PEER_N2 = 512, PEER_NTASK = PEER_N8 + PEER_N4 + PEER_N2;
__device__ __forceinline__ void peer_task_tokens(int idx, int& t0, int& n) {
    if (idx < PEER_N8) { t0 = 8 * idx; n = 8; } else if (idx < PEER_N8 + PEER_N4) { t0 = 8 * PEER_N8 + 4 * (idx - PEER_N8); n = 4; } else { t0 = 8 * PEER_N8 + 4 * PEER_N4 + 2 * (idx - PEER_N8 - PEER_N4); n = 2; }
}
__device__ __forceinline__ int row16_allsum_i(int a) {
    a += __builtin_amdgcn_update_dpp(0, a, 0x128, 0xf, 0xf, false);
    a += __builtin_amdgcn_update_dpp(0, a, 0x124, 0xf, 0xf, false);
    a += __builtin_amdgcn_update_dpp(0, a, 0x122, 0xf, 0xf, false);
    a += __builtin_amdgcn_update_dpp(0, a, 0x121, 0xf, 0xf, false);
    return a;
}
#define PA_LOAD(R, IDV, HALF) do { _Pragma("unroll") for (int i_ = 0; i_ < 8; ++i_) { const unsigned e_ = (unsigned)__shfl(IDV, 4 * (i_ + 8 * (HALF)) + g); \
        R[i_] = *(const GAS v4u*)(ub + (e_ * 256u + offc)); } } while (0)
#define PA_COMP(R, HALF) do { _Pragma("unroll") for (int i_ = 0; i_ < 8; ++i_) { int a_ = __builtin_amdgcn_sdot4((int)R[i_].x, (int)xc.x, 0, false); a_ = __builtin_amdgcn_sdot4((int)R[i_].y, (int)xc.y, a_, false); \
        a_ = __builtin_amdgcn_sdot4((int)R[i_].z, (int)xc.z, a_, false); a_ = __builtin_amdgcn_sdot4((int)R[i_].w, (int)xc.w, a_, false); r16[8 * (HALF) + i_] = row16_allsum_i(a_); } } while (0)
__device__ __forceinline__ void peer_a_task(int t0, int ntok, int s, const signed char* xq, const int* experts, const unsigned char* u8s, int* pa, int lane_) {
    int lane = lane_; asm volatile("" : "+v"(lane));
    const int g = lane >> 4, c = lane & 15;
    const GAS unsigned char* ub = (const GAS unsigned char*)(u8s + (size_t)s * SLICE_BYTES);
    const unsigned offc = 16u * (unsigned)c;
    int idc0 = experts[(size_t)t0 * 128 + lane], idc1 = experts[(size_t)t0 * 128 + lane + 64];
    v4u xc = *(const GAS v4u*)(xq + (size_t)t0 * D + 256 * s + 16 * c);
    v4u RA[8], RB[8];
    PA_LOAD(RA, idc0, 0);
#pragma unroll 1
    for (int tt = 0; tt < ntok; ++tt) {
        const int t = t0 + tt, tn = tt + 1 < ntok ? t + 1 : t;
        const int idn0 = experts[(size_t)tn * 128 + lane], idn1 = experts[(size_t)tn * 128 + lane + 64];
        const v4u xn = *(const GAS v4u*)(xq + (size_t)tn * D + 256 * s + 16 * c);
#pragma unroll 1
        for (int hb = 0; hb < 2; ++hb) {
            const int idv = hb ? idc1 : idc0, idx = hb ? idn0 : idc1;
            int r16[16];
            PA_LOAD(RB, idv, 1); PA_COMP(RA, 0);
            asm volatile("" ::: "memory");
            PA_LOAD(RA, idx, 0); PA_COMP(RB, 1);
            if (c == 15) { typedef int i32x4 __attribute__((ext_vector_type(4))); GAS i32x4* dst = (GAS i32x4*)(pa + ((size_t)t * 8 + s) * 128 + g * 32 + 16 * hb);
#pragma unroll
                for (int q = 0; q < 4; ++q) dst[q] = (i32x4){r16[4 * q], r16[4 * q + 1], r16[4 * q + 2], r16[4 * q + 3]}; }
        }
        idc0 = idn0; idc1 = idn1; xc = xn;
    }
}
__device__ __forceinline__ void peer_w_elem(size_t i, const int* experts, const float* gates, const float* su, const float* sv, const float* sx, const int* pa, float* wb) {
    const size_t t = i >> 7; const int k = (int)(i & 127), pos = (k & 3) * 32 + (k >> 2);
    const int e = experts[i];
    int a = 0;
#pragma unroll
    for (int s2 = 0; s2 < 8; ++s2) a += pa[(t * 8 + s2) * 128 + pos];
    wb[i] = gates[i] * gelu_erf((float)a * (su[e] * sx[t])) * sv[e];
}
#define PB_LOAD(R, IDV, HALF) do { _Pragma("unroll") for (int i_ = 0; i_ < 8; ++i_) { const unsigned e_ = (unsigned)__shfl(IDV, 4 * (i_ + 8 * (HALF)) + g); \
        R[i_] = *(const GAS v4u*)(vb + (e_ * 256u + offc)); } } while (0)
#define PB_COMP(R, WV, HALF) do { _Pragma("unroll") for (int i_ = 0; i_ < 8; ++i_) { const float wk_ = __shfl(WV, 4 * (i_ + 8 * (HALF)) + g); \
        axpy4f8v(&ya2[0], R[i_].x, wk_); axpy4f8v(&ya2[2], R[i_].y, wk_); axpy4f8v(&ya2[4], R[i_].z, wk_); axpy4f8v(&ya2[6], R[i_].w, wk_); } } while (0)
__device__ __forceinline__ void peer_b_task(int t0, int ntok, int s, const bf16* h1, const int* experts, const float* wb, const unsigned char* v8s, bf16* out, float* st, int lane_) {
    int lane = lane_; asm volatile("" : "+v"(lane));
    const int g = lane >> 4, c = lane & 15;
    const GAS unsigned char* vb = (const GAS unsigned char*)(v8s + (size_t)s * SLICE_BYTES);
    const unsigned offc = 16u * (unsigned)c;
    int idc0 = experts[(size_t)t0 * 128 + lane], idc1 = experts[(size_t)t0 * 128 + lane + 64];
    float wc0 = wb[(size_t)t0 * 128 + lane], wc1 = wb[(size_t)t0 * 128 + lane + 64];
    v4u RA[8], RB[8];
    PB_LOAD(RA, idc0, 0);
#pragma unroll 1
    for (int tt = 0; tt < ntok; ++tt) {
        const int t = t0 + tt, tn = tt + 1 < ntok ? t + 1 : t;
        const int idn0 = experts[(size_t)tn * 128 + lane], idn1 = experts[(size_t)tn * 128 + lane + 64];
        const float wn0 = wb[(size_t)tn * 128 + lane], wn1 = wb[(size_t)tn * 128 + lane + 64];
        f32x2_t ya2[8];
#pragma unroll
        for (int e = 0; e < 8; ++e) ya2[e] = (f32x2_t){0.f, 0.f};
#pragma unroll 1
        for (int hb = 0; hb < 2; ++hb) {
            const int idv = hb ? idc1 : idc0, idx = hb ? idn0 : idc1; const float wv = hb ? wc1 : wc0;
            PB_LOAD(RB, idv, 1); PB_COMP(RA, wv, 0);
            asm volatile("" ::: "memory");
            PB_LOAD(RA, idx, 0); PB_COMP(RB, wv, 1);
        }
        float ya[16];
#pragma unroll
        for (int e = 0; e < 8; ++e) { ya[2 * e] = ya2[e].x; ya[2 * e + 1] = ya2[e].y; }
#pragma unroll
        for (int e = 0; e < 16; ++e) { ya[e] += __shfl_xor(ya[e], 16); ya[e] += __shfl_xor(ya[e], 32); }
        const GAS v4u* hp = (const GAS v4u*)(h1 + (size_t)t * D + 256 * s + 16 * c);
        const v4u h0 = hp[0], h1v = hp[1];
        float hx[16];
        hx[0] = pg8::bf_lo(h0.x); hx[1] = pg8::bf_hi(h0.x); hx[2] = pg8::bf_lo(h0.y); hx[3] = pg8::bf_hi(h0.y); hx[4] = pg8::bf_lo(h0.z); hx[5] = pg8::bf_hi(h0.z); hx[6] = pg8::bf_lo(h0.w); hx[7] = pg8::bf_hi(h0.w);
        hx[8] = pg8::bf_lo(h1v.x); hx[9] = pg8::bf_hi(h1v.x); hx[10] = pg8::bf_lo(h1v.y); hx[11] = pg8::bf_hi(h1v.y); hx[12] = pg8::bf_lo(h1v.z); hx[13] = pg8::bf_hi(h1v.z); hx[14] = pg8::bf_lo(h1v.w); hx[15] = pg8::bf_hi(h1v.w);
        float sm = 0.f, sq = 0.f;
#pragma unroll
        for (int e = 0; e < 16; ++e) { ya[e] = hx[e] * ALPHA + ya[e]; sm += ya[e]; sq += ya[e] * ya[e]; }
        sm = row16_allsum(sm); sq = row16_allsum(sq);
        if (g == 0) { GAS v4u* op = (GAS v4u*)(out + (size_t)t * D + 256 * s + 16 * c);
            v4u o0, o1; o0.x = pk2(ya[0], ya[1]); o0.y = pk2(ya[2], ya[3]); o0.z = pk2(ya[4], ya[5]); o0.w = pk2(ya[6], ya[7]);
            o1.x = pk2(ya[8], ya[9]); o1.y = pk2(ya[10], ya[11]); o1.z = pk2(ya[12], ya[13]); o1.w = pk2(ya[14], ya[15]);
            op[0] = o0; op[1] = o1;
            if (c == 0) { st[((size_t)t * 8 + s) * 2] = sm; st[((size_t)t * 8 + s) * 2 + 1] = sq; } }
        idc0 = idn0; idc1 = idn1; wc0 = wn0; wc1 = wn1;
    }
}
__device__ __forceinline__ void peer_c_row(int t, const bf16* r2, float* out, const float* st, const float* g2, const float* b2, int lane) {
    float sm = 0.f, sq = 0.f;
#pragma unroll
    for (int s = 0; s < 8; ++s) { sm += st[((size_t)t * 8 + s) * 2]; sq += st[((size_t)t * 8 + s) * 2 + 1]; }
    const float mean = sm * (1.f / D), var = sq * (1.f / D) - mean * mean, rstd = 1.f / sqrtf(fmaxf(var, 0.f) + LN_EPS);
    const GAS v4u* xr = (const GAS v4u*)(r2 + (size_t)t * D) + lane;
    GAS f32x4* op = (GAS f32x4*)(out + (size_t)t * D);
#pragma unroll
    for (int j = 0; j < 4; ++j) { const v4u w = xr[64 * j]; const int c4 = 2 * (lane + 64 * j);
        const f32x4 g0 = *((const GAS f32x4*)g2 + c4), g1 = *((const GAS f32x4*)g2 + c4 + 1), b0 = *((const GAS f32x4*)b2 + c4), b1 = *((const GAS f32x4*)b2 + c4 + 1);
        const f32x4 v0 = (f32x4){pg8::bf_lo(w.x), pg8::bf_hi(w.x), pg8::bf_lo(w.y), pg8::bf_hi(w.y)}, v1 = (f32x4){pg8::bf_lo(w.z), pg8::bf_hi(w.z), pg8::bf_lo(w.w), pg8::bf_hi(w.w)};
        op[c4] = (v0 - mean) * rstd * g0 + b0; op[c4 + 1] = (v1 - mean) * rstd * g1 + b1; }
}

struct Args { const float* in[16]; float* out; unsigned char* ws; int ph_lo, ph_hi; };
__global__ void __launch_bounds__(NTHREADS, 2) mk_fwd(Args args) {
    extern __shared__ __attribute__((aligned(16))) unsigned char lds_raw[];
    LAS unsigned char* lds = (LAS unsigned char*)lds_raw;
    volatile LAS unsigned* MISC = (volatile LAS unsigned*)(lds + MISC_OFF);
    const int tid0 = threadIdx.x;
    const int G = gridDim.x, bx = blockIdx.x;
    unsigned char* ws = args.ws;
    gu32* ctl = (gu32*)(ws + WS_CTL);
#define IN_(i) (args.in[i])
#define x_in IN_(0)
#define w_in IN_(1)
#define b_gate IN_(2)
#define sinks IN_(3)
#define conv_w IN_(4)
#define w_ao IN_(5)
#define w_co IN_(6)
#define w_o IN_(7)
#define ln1_g IN_(8)
#define ln1_b IN_(9)
#define w_q IN_(10)
#define sub_keys IN_(11)
#define peer_u IN_(12)
#define peer_v IN_(13)
#define ln2_g IN_(14)
#define ln2_b IN_(15)
#define WinT ((bf16*)(ws + WS_WIN))
#define WaT ((bf16*)(ws + WS_WA))
#define WcT ((bf16*)(ws + WS_WC))
#define WoT ((bf16*)(ws + WS_WO))
#define WfT ((bf16*)(ws + WS_WF))
#define XB ((bf16*)(ws + WS_XB))
#define MERGED ((bf16*)(ws + WS_MERGED))
#define Z ((bf16*)(ws + WS_Z))
#define R2B ((bf16*)(ws + WS_R2B))
#define H1B ((bf16*)(ws + WS_H1B))
#define SC ((float*)(ws + WS_SC))
#define EX ((int*)(ws + WS_EX))
#define GT ((float*)(ws + WS_GT))
#define AO ((bf16*)(ws + WS_AO))
#define CI ((bf16*)(ws + WS_CI))
#define TMP ((bf16*)(ws + WS_TMP))
#define U8 ((unsigned char*)(ws + WS_U8))
#define V8 ((unsigned char*)(ws + WS_V8))
#define SU ((float*)(ws + WS_SU))
#define SV ((float*)(ws + WS_SV))
#define PA ((int*)(ws + WS_PA))
#define ST ((float*)(ws + WS_ST))
#define WB ((float*)(ws + WS_WB))
#define XQ ((signed char*)(ws + WS_XQ))
#define SX ((float*)(ws + WS_SX))
    for (int u = tid0; u < (LDS_BYTES - LDSCTL_OFF) / 4; u += NTHREADS) ((LAS unsigned*)(lds + LDSCTL_OFF))[u] = 0u;
    __syncthreads();
    XcdBarrier bar; bar.bar = (unsigned*)(ctl + CW_BAR); bar.x = 0; bar.st = nullptr;
    if (!MK_PER_PHASE) bar = xcd_barrier_post((unsigned*)(ctl + CW_BAR), MISC + 8);
    const int lo = args.ph_lo, hi = args.ph_hi;
#ifndef PH_MASK
#define PH_MASK 0xFFF
#endif
#define IN(k) (((PH_MASK >> (k)) & 1) && lo <= (k) && (k) < hi)
#ifndef DBL_BAR
#define DBL_BAR 0
#endif
#define SEAM(k) do { if (IN(k) && IN((k) + 1)) { xcd_barrier(bar); if (DBL_BAR) xcd_barrier(bar); } } while (0)
#ifndef DBL_MASK
#define DBL_MASK 0
#endif
#define REP(k) for (int rep_ = 0; rep_ < 1 + ((DBL_MASK >> (k)) & 1); ++rep_)
#define PHASE_TID() int tid = tid0; asm volatile("" : "+v"(tid)); const int lane = tid & 63, wave = __builtin_amdgcn_readfirstlane(tid >> 6); (void)lane; (void)wave

    if (IN(0)) REP(0) {
        PHASE_TID();
        const bool conv_first = ((bx >> 3) & 1) == 0;
#pragma unroll 1
        for (int part = 0; part < 2; ++part) {
            if ((part == 0) == conv_first) {
                int tid = tid0; asm volatile("" : "+v"(tid)); const int lane = tid & 63, wave = __builtin_amdgcn_readfirstlane(tid >> 6);
                LAS float* scr = (LAS float*)(lds + wave * 16384);
                const int gw = bx * NWAVES + wave, NGW = G * NWAVES;
                constexpr int I_IN = (D / 64) * (IN_W / 32), I_SQ = (D / 64) * (D / 32);
                for (int it = gw; it < I_IN + 3 * I_SQ; it += NGW) {
                    int r = it;
                    if (r < I_IN) { p0_transpose_item(w_in, D, IN_W, WinT, scr, r, lane); continue; } r -= I_IN;
                    if (r < I_SQ) { p0_transpose_item(w_ao, D, D, WaT, scr, r, lane); continue; } r -= I_SQ;
                    if (r < I_SQ) { p0_transpose_item(w_co, D, D, WcT, scr, r, lane); continue; } r -= I_SQ;
                    p0_transpose_item(w_o, D, D, WoT, scr, r, lane);
                }
                const size_t n8 = (size_t)M * D / 8;
                for (size_t i = (size_t)bx * NTHREADS + tid; i < n8; i += (size_t)G * NTHREADS) {
                    const f32x4 a = *((const GAS f32x4*)x_in + 2 * i), b = *((const GAS f32x4*)x_in + 2 * i + 1);
                    v4u o; o.x = pk2(a.x, a.y); o.y = pk2(a.z, a.w); o.z = pk2(b.x, b.y); o.w = pk2(b.z, b.w);
                    *((GAS v4u*)XB + i) = o;
                }
                __syncthreads();
            }
            if (part == 0) for (int it = bx; it < 16 * 32; it += G) p0_wf_item(w_q, sub_keys, WfT, lds, it, tid);
        }
    }
    SEAM(0);
    if (IN(1)) REP(1) {
        pg8::Gemm g{XB, WinT, M, IN_W, D}; pg8::StaticOrder S; S.init(M, IN_W, G, bx);
        pg8::EpiBf16 E{Z, IN_W};
        pg8::gemm_phase<pg8::EpiBf16, pg8::StaticOrder, true, true>(lds, g, S, E);
        { PHASE_TID();
#ifndef DBL_CONV
#define DBL_CONV 0
#endif
          for (int rep2 = 0; rep2 <= DBL_CONV; ++rep2)
          for (;;) { const int ch = q_pull((unsigned*)(ctl + CW_Q + 64 * (32 + rep2)), lane); if (ch >= 2 * PNE / 16) break;
#pragma unroll 1
              for (int rr = 0; rr < 16; ++rr) { const int r = ch * 16 + rr; const bool sec = r >= PNE; const int e = sec ? r - PNE : r;
                  if (sec) row_to_fp8(peer_v + (size_t)e * D, V8 + (size_t)e * 256, SV + e, lane); else row_to_i8(peer_u + (size_t)e * D, U8 + (size_t)e * 256, SU + e, lane); } } }
    }
    SEAM(1);
    if (IN(2)) REP(2) {
        PHASE_TID();
        const bool conv_first = ((bx >> 3) & 1) == 0;
#pragma unroll 1
        for (int part = 0; part < 2; ++part) {
            if ((part == 0) == conv_first) { int t2 = tid0; asm volatile("" : "+v"(t2)); for (int it = bx; it < M / 32; it += G) conv_item(it, Z, conv_w, CI, t2); }
            if (part == 0) for (int u = bx; u < BATCH * NKVH * 16; u += G) attn_unit(u, Z, AO, sinks, lds, tid);
        }
    }
    SEAM(2);
    if (IN(3)) REP(3) {
        pg8::StaticOrder S; S.init(M, D, G, bx);
        { pg8::Gemm g{AO, WaT, M, D, D}; pg8::EpiGate<0> E{TMP, nullptr, Z + G_OFF, b_gate, D, IN_W};
          pg8::gemm_phase<pg8::EpiGate<0>, pg8::StaticOrder, true, true>(lds, g, S, E); }
        { pg8::Gemm g{CI, WcT, M, D, D}; pg8::EpiGate<1> E{MERGED, TMP, Z + G_OFF + D, b_gate + D, D, IN_W};
          pg8::gemm_phase<pg8::EpiGate<1>, pg8::StaticOrder, true, true>(lds, g, S, E); }
    }
    SEAM(3);
    if (IN(4)) REP(4) {
        pg8::Gemm g{MERGED, WoT, M, D, D}; pg8::StaticOrder S; S.init(M, D, G, bx);
        pg8::EpiResBf16 E{H1B, D, x_in, ALPHA};
        pg8::gemm_phase<pg8::EpiResBf16, pg8::StaticOrder, true, true>(lds, g, S, E);
    }
    SEAM(4);
    if (IN(5)) REP(5) {
        PHASE_TID();
        const int gw = bx * NWAVES + wave, NGW = G * NWAVES;
        for (int m = gw; m < M; m += NGW) ln1_row(H1B + (size_t)m * D, XQ + (size_t)m * D, SX + m, ln1_g, ln1_b, lane);
    }
    SEAM(5);
    if (IN(6)) REP(6) {
        pg8::Gemm g{H1B, WfT, M, D, D}; pg8::StaticOrder S; S.init(M, D, G, bx);
        if (G == 256) { EpiTopK E{EX, GT}; pg8::gemm_phase<EpiTopK, pg8::StaticOrder, false, true>(lds, g, S, E); }
        else { pg8::EpiF32 E{SC, D, nullptr, 0.f}; pg8::gemm_phase<pg8::EpiF32, pg8::StaticOrder, true, true>(lds, g, S, E); }
    }
    if (G != 256) SEAM(6);
    if (IN(7)) REP(7) {
        PHASE_TID();
        if (G != 256) for (int p = bx; p < (M * PH) / 128; p += G) topk_pass(p, SC, EX, GT, lds, tid);
    }
    SEAM(7);
    if (IN(8)) REP(8) {
        PHASE_TID();
        const int xcc = (int)(xb_xcc_id() & 7u);
#pragma unroll 1
#ifndef SCRAMBLE
#define SCRAMBLE 0
#endif
        for (int sl = 0; sl < 8; ++sl) { const int s = (xcc + sl + (SCRAMBLE ? wave : 0)) & 7;
            for (;;) { const int tg = q_pull((unsigned*)(ctl + CW_Q + 64 * (s + 16 * rep_)), lane); if (tg >= PEER_NTASK) break;
                int t0, nt; peer_task_tokens(tg, t0, nt); peer_a_task(t0, nt, s, XQ, EX, U8, PA, lane); } }
    }
    SEAM(8);
    if (IN(9)) REP(9) {
        PHASE_TID();
        for (size_t i = (size_t)bx * NTHREADS + tid; i < (size_t)M * 128; i += (size_t)G * NTHREADS) peer_w_elem(i, EX, GT, SU, SV, SX, PA, WB);
    }
    SEAM(9);
    if (IN(10)) REP(10) {
        PHASE_TID();
        const int xcc = (int)(xb_xcc_id() & 7u);
#pragma unroll 1
#ifndef SCRAMBLE
#define SCRAMBLE 0
#endif
        for (int sl = 0; sl < 8; ++sl) { const int s = (xcc + sl + (SCRAMBLE ? wave : 0)) & 7;
            for (;;) { const int tg = q_pull((unsigned*)(ctl + CW_Q + 64 * (8 + s + 16 * rep_)), lane); if (tg >= PEER_NTASK) break;
                int t0, nt; peer_task_tokens(tg, t0, nt); peer_b_task(t0, nt, s, H1B, EX, WB, V8, R2B, ST, lane); } }
    }
    SEAM(10);
    if (IN(11)) REP(11) {
        PHASE_TID();
        const int gw = bx * NWAVES + wave, NGW = G * NWAVES;
        for (int t = gw; t < M; t += NGW) peer_c_row(t, R2B, args.out, ST, ln2_g, ln2_b, lane);
    }
#undef IN
#undef SEAM
}

extern "C" void kernel_launch(void* const* d_in, const int* in_sizes, int n_in, void* d_out, int out_size, void* d_ws, size_t ws_size, hipStream_t stream) {
    static int grid = 0;
    if (grid == 0) {
        if (n_in != 16 || out_size != M * D || ws_size < WS_END) { fprintf(stderr, "kernel_launch: unexpected shapes (n_in %d out %d ws %zu)\n", n_in, out_size, ws_size); grid = -1; return; }
        int dev = 0, cus = 0, per_cu = 0;
        if (hipGetDevice(&dev) != hipSuccess || hipDeviceGetAttribute(&cus, hipDeviceAttributeMultiprocessorCount, dev) != hipSuccess) { grid = -1; return; }
        if (hipFuncSetAttribute((const void*)mk_fwd, hipFuncAttributeMaxDynamicSharedMemorySize, LDS_BYTES) != hipSuccess) { fprintf(stderr, "kernel_launch: hipFuncSetAttribute failed\n"); grid = -1; return; }
        if (hipOccupancyMaxActiveBlocksPerMultiprocessor(&per_cu, (const void*)mk_fwd, NTHREADS, LDS_BYTES) != hipSuccess || per_cu < 1) { fprintf(stderr, "kernel_launch: occupancy query says %d\n", per_cu); per_cu = 1; }
        (void)hipGetLastError();
        if (per_cu > 1) per_cu = 1;
        grid = cus * per_cu;
    }
    if (grid < 0) return;
    if (hipMemsetAsync((char*)d_ws + WS_CTL, 0, CTL_ZERO_BYTES, stream) != hipSuccess) { fprintf(stderr, "kernel_launch: memset failed\n"); return; }
    Args a{};
    for (int i = 0; i < 16; ++i) a.in[i] = (const float*)d_in[i];
    a.out = (float*)d_out; a.ws = (unsigned char*)d_ws;
#if MK_PER_PHASE
    for (int p = 0; p < N_PHASES; ++p) { a.ph_lo = p; a.ph_hi = p + 1; hipLaunchKernelGGL(mk_fwd, dim3(grid), dim3(NTHREADS), LDS_BYTES, stream, a); }
#else
    a.ph_lo = 0; a.ph_hi = N_PHASES;
    void* kargs[] = {&a};
#ifdef PLAIN_LAUNCH
    (void)kargs; hipLaunchKernelGGL(mk_fwd, dim3(grid), dim3(NTHREADS), LDS_BYTES, stream, a); hipError_t e = hipPeekAtLastError();
#else
    hipError_t e = hipLaunchCooperativeKernel((const void*)mk_fwd, dim3(grid), dim3(NTHREADS), kargs, LDS_BYTES, stream);
#endif
    if (e != hipSuccess) fprintf(stderr, "kernel_launch: cooperative launch failed: %s (grid %d)\n", hipGetErrorString(e), grid);
#endif
}
```

```cpp
#include <hip/hip_runtime.h>
#include <cstdio>
#include <cstdint>
namespace pg8 {
#define PG8_LAS __attribute__((address_space(3)))
typedef unsigned short bf16_t;
typedef short bf16x8 __attribute__((ext_vector_type(8)));
typedef float f32x4 __attribute__((ext_vector_type(4)));
typedef unsigned u32x4 __attribute__((ext_vector_type(4)));
constexpr int BM = 256, BK = 64, HALF = 128, HTB = HALF * BK * 2  , STAGE_BYTES = 8 * HTB, NXCD = 8, WGM = 8;

__host__ __device__ __forceinline__ int lds_byte(int r, int c) { const int st = (r >> 4) * 2 + (c >> 5), rr = r & 15, cc = c & 31, ob = rr * 64 + cc * 2; return st * 1024 + (ob ^ (((ob >> 9) & 1) << 5)); }
__host__ __device__ __forceinline__ void stage_rc(int b, int& R, int& C) { const int st = b / 1024, sb = b % 1024, swz = sb ^ (((sb >> 9) & 1) << 5); R = (st >> 1) * 16 + swz / 64; C = (st & 1) * 32 + (swz % 64) / 2; }
__host__ __device__ __forceinline__ int perm32(int rho) { const int n = rho >> 4, i = rho & 15; return 8 * (i >> 2) + 4 * n + (i & 3); }

struct Unit { int pm, pn; };
struct Gemm { const bf16_t* A; const bf16_t* Bt; int M, N, K; };

struct StaticOrder {
    int nM, nN, nwg, G, c;
    __host__ __device__ void init(int M, int N, int G_, int c_) { nM = M / BM; nN = N / BM; nwg = nM * nN; G = G_; c = c_; }
    __host__ __device__ bool next(int i, Unit& u) const {
        const long L = (long)i * G + c; if (L >= nwg) return false;
        int wgid = (int)L; { const int q = nwg / NXCD, r = nwg % NXCD, xcd = wgid % NXCD, off = wgid / NXCD; wgid = (xcd < r ? xcd * (q + 1) : r * (q + 1) + (xcd - r) * q) + off; }
        const int nig = WGM * nN, gid = wgid / nig, fm = gid * WGM, gsz = (nM - fm) < WGM ? (nM - fm) : WGM;
        u.pm = fm + ((wgid % nig) % gsz); u.pn = (wgid % nig) / gsz; return true;
    }
    __device__ __forceinline__ void a_ready(const Unit&) const {}
    __device__ __forceinline__ void done(const Unit&) const {}
};


__device__ __forceinline__ unsigned cvt_pk_bf16(float lo, float hi) { unsigned r; asm volatile("v_cvt_pk_bf16_f32 %0, %1, %2" : "=v"(r) : "v"(lo), "v"(hi)); return r; }
__device__ __forceinline__ float bf_lo(unsigned w) { return __builtin_bit_cast(float, w << 16); }
__device__ __forceinline__ float bf_hi(unsigned w) { return __builtin_bit_cast(float, w & 0xffff0000u); }
__device__ __forceinline__ float sigmoidf_(float x) { return __builtin_amdgcn_rcpf(1.0f + __expf(-x)); }

struct EpiBf16 {
    static constexpr bool PERM = true, AFTER_DRAIN = false;
    bf16_t* O; int ldc;
    __device__ __forceinline__ void operator()(const f32x4 (&acc)[2][2][4][2], const Unit& u, int wr, int wc, int fr, int fq) const {
        const int row0 = u.pm * BM + wr * 64 + fr, col0 = u.pn * BM + wc * 32 + 8 * fq;
#pragma unroll
        for (int ai = 0; ai < 2; ++ai)
#pragma unroll
            for (int m = 0; m < 4; ++m) { bf16_t* rowp = O + (size_t)(row0 + ai * HALF + m * 16) * ldc + col0;
#pragma unroll
                for (int bj = 0; bj < 2; ++bj) { const f32x4 v0 = acc[ai][bj][m][0], v1 = acc[ai][bj][m][1];
                    u32x4 w; w.x = cvt_pk_bf16(v0[0], v0[1]); w.y = cvt_pk_bf16(v0[2], v0[3]); w.z = cvt_pk_bf16(v1[0], v1[1]); w.w = cvt_pk_bf16(v1[2], v1[3]);
                    *(u32x4*)(rowp + bj * HALF) = w; } }
    }
};
template <int SECOND> struct EpiGate {
    static constexpr bool PERM = true, AFTER_DRAIN = false;
    bf16_t* O; const bf16_t* T; const bf16_t* Zg; const float* bg; int ldc, ldz;
    __device__ __forceinline__ void operator()(const f32x4 (&acc)[2][2][4][2], const Unit& u, int wr, int wc, int fr, int fq) const {
        const int row0 = u.pm * BM + wr * 64 + fr, col0 = u.pn * BM + wc * 32 + 8 * fq;
        f32x4 bv[2][2];
#pragma unroll
        for (int bj = 0; bj < 2; ++bj)
#pragma unroll
            for (int n = 0; n < 2; ++n) bv[bj][n] = *(const f32x4*)(bg + col0 + bj * HALF + 4 * n);
#pragma unroll
        for (int ai = 0; ai < 2; ++ai)
#pragma unroll
            for (int m = 0; m < 4; ++m) { const size_t row = (size_t)(row0 + ai * HALF + m * 16);
#pragma unroll
                for (int bj = 0; bj < 2; ++bj) { const int c = col0 + bj * HALF;
                    const u32x4 zg = *(const u32x4*)(Zg + row * ldz + c);
                    f32x4 v0 = acc[ai][bj][m][0], v1 = acc[ai][bj][m][1];
                    v0[0] *= sigmoidf_(bf_lo(zg.x) + bv[bj][0][0]); v0[1] *= sigmoidf_(bf_hi(zg.x) + bv[bj][0][1]);
                    v0[2] *= sigmoidf_(bf_lo(zg.y) + bv[bj][0][2]); v0[3] *= sigmoidf_(bf_hi(zg.y) + bv[bj][0][3]);
                    v1[0] *= sigmoidf_(bf_lo(zg.z) + bv[bj][1][0]); v1[1] *= sigmoidf_(bf_hi(zg.z) + bv[bj][1][1]);
                    v1[2] *= sigmoidf_(bf_lo(zg.w) + bv[bj][1][2]); v1[3] *= sigmoidf_(bf_hi(zg.w) + bv[bj][1][3]);
                    if (SECOND) { const u32x4 t = *(const u32x4*)(T + row * ldc + c);
                        v0[0] += bf_lo(t.x); v0[1] += bf_hi(t.x); v0[2] += bf_lo(t.y); v0[3] += bf_hi(t.y);
                        v1[0] += bf_lo(t.z); v1[1] += bf_hi(t.z); v1[2] += bf_lo(t.w); v1[3] += bf_hi(t.w); }
                    u32x4 w; w.x = cvt_pk_bf16(v0[0], v0[1]); w.y = cvt_pk_bf16(v0[2], v0[3]); w.z = cvt_pk_bf16(v1[0], v1[1]); w.w = cvt_pk_bf16(v1[2], v1[3]);
                    *(u32x4*)(O + row * ldc + c) = w; } }
    }
};
struct EpiF32 {
    static constexpr bool PERM = false, AFTER_DRAIN = false;
    float* C; int ldc; const float* R; float scale;
    __device__ __forceinline__ void operator()(const f32x4 (&acc)[2][2][4][2], const Unit& u, int wr, int wc, int fr, int fq) const {
        const int row0 = u.pm * BM + wr * 64 + fr, col0 = u.pn * BM + wc * 32 + 4 * fq;
#pragma unroll
        for (int ai = 0; ai < 2; ++ai)
#pragma unroll
            for (int m = 0; m < 4; ++m) { const size_t off = (size_t)(row0 + ai * HALF + m * 16) * ldc + col0;
#pragma unroll
                for (int bj = 0; bj < 2; ++bj)
#pragma unroll
                    for (int n = 0; n < 2; ++n) { f32x4 v = acc[ai][bj][m][n];
                        if (R) v += *(const f32x4*)(R + off + bj * HALF + n * 16) * scale;
                        *(f32x4*)(C + off + bj * HALF + n * 16) = v; } }
    }
};
struct EpiResBf16 {
    static constexpr bool PERM = true, AFTER_DRAIN = false;
    bf16_t* O; int ldc; const float* R; float scale;
    __device__ __forceinline__ void operator()(const f32x4 (&acc)[2][2][4][2], const Unit& u, int wr, int wc, int fr, int fq) const {
        const int row0 = u.pm * BM + wr * 64 + fr, col0 = u.pn * BM + wc * 32 + 8 * fq;
#pragma unroll
        for (int ai = 0; ai < 2; ++ai)
#pragma unroll
            for (int m = 0; m < 4; ++m) { const size_t off = (size_t)(row0 + ai * HALF + m * 16) * ldc + col0;
#pragma unroll
                for (int bj = 0; bj < 2; ++bj) { const f32x4 r0 = *(const f32x4*)(R + off + bj * HALF), r1 = *(const f32x4*)(R + off + bj * HALF + 4);
                    const f32x4 v0 = acc[ai][bj][m][0] + r0 * scale, v1 = acc[ai][bj][m][1] + r1 * scale;
                    u32x4 w; w.x = cvt_pk_bf16(v0[0], v0[1]); w.y = cvt_pk_bf16(v0[2], v0[3]); w.z = cvt_pk_bf16(v1[0], v1[1]); w.w = cvt_pk_bf16(v1[2], v1[3]);
                    *(u32x4*)(O + off + bj * HALF) = w; } }
    }
};

template <class Epi, class Sched, bool ALIGN_EPI = false, bool SP2 = false>
__device__ __forceinline__ void gemm_phase(PG8_LAS unsigned char* lds, const Gemm g, const Sched& S, const Epi& E) {
    int tid_ = threadIdx.x; asm volatile("" : "+v"(tid_));
    const int tid = tid_, wid = __builtin_amdgcn_readfirstlane(tid >> 6), lane = tid & 63, wr = wid >> 2, wc = wid & 3, fr = lane & 15, fq = lane >> 4;
    const int K = g.K, nt = K / BK;
    unsigned voffA[2], voffB[2];
#pragma unroll
    for (int i = 0; i < 2; ++i) { int R, C; stage_rc(tid * 16 + i * 8192, R, C); const int Rb = Epi::PERM ? ((R & ~31) + perm32(R & 31)) : R;
        voffA[i] = (unsigned)(R * K + C) * 2u; voffB[i] = (unsigned)(Rb * K + C) * 2u; }
    const size_t kstep = (size_t)(BK * 2);
    const size_t hstep = (size_t)HALF * K * 2;
    const size_t tstep = 2 * hstep;
    const unsigned ldsw = (unsigned)wid * 1024u;
    const int aoff = lds_byte(wr * 64 + fr, fq * 8), boff = lds_byte(wc * 32 + fr, fq * 8);
#define PG8_SA(b, h) (((b) * 2 + (h)) * HTB)
#define PG8_SB(b, h) ((4 + (b) * 2 + (h)) * HTB)
#define PG8_STAGE(bufoff, gbase, voff) do { _Pragma("unroll") for (int _i = 0; _i < 2; ++_i) \
        __builtin_amdgcn_global_load_lds((const unsigned*)((const char*)(gbase) + (voff)[_i]), (PG8_LAS unsigned*)(lds + (bufoff) + ldsw + _i * 8192), 16, 0, 0); } while (0)
#define PG8_LDA(dst, b, h) do { _Pragma("unroll") for (int m = 0; m < 4; ++m) _Pragma("unroll") for (int k = 0; k < 2; ++k) dst[m][k] = *(const PG8_LAS bf16x8*)(lds + PG8_SA(b, h) + aoff + m * 2048 + k * 1024); } while (0)
#define PG8_LDB(dst, b, h) do { _Pragma("unroll") for (int n = 0; n < 2; ++n) _Pragma("unroll") for (int k = 0; k < 2; ++k) dst[n][k] = *(const PG8_LAS bf16x8*)(lds + PG8_SB(b, h) + boff + n * 2048 + k * 1024); } while (0)
#define PG8_MMA(ai, bj, At, Bt) do { __builtin_amdgcn_s_setprio(1); _Pragma("unroll") for (int m = 0; m < 4; ++m) _Pragma("unroll") for (int n = 0; n < 2; ++n) _Pragma("unroll") for (int k = 0; k < 2; ++k) \
        acc[ai][bj][m][n] = __builtin_amdgcn_mfma_f32_16x16x32_bf16(Bt[n][k], At[m][k], acc[ai][bj][m][n], 0, 0, 0); __builtin_amdgcn_s_setprio(0); } while (0)
#define PG8_WAIT_V(n) asm volatile("s_waitcnt vmcnt(" #n ")" ::: "memory")
#define PG8_WAIT_L(n) asm volatile("s_waitcnt lgkmcnt(" #n ")" ::: "memory")
#define PG8_BAR __builtin_amdgcn_s_barrier()
#define PG8_SCHED __builtin_amdgcn_sched_barrier(0)
    Unit cur, nxt; int ui = 0;
    if (!S.next(0, cur)) return;
    f32x4 acc[2][2][4][2];
#pragma unroll
    for (int a = 0; a < 2; ++a)
#pragma unroll
        for (int b = 0; b < 2; ++b)
#pragma unroll
            for (int m = 0; m < 4; ++m)
#pragma unroll
                for (int n = 0; n < 2; ++n) acc[a][b][m][n] = (f32x4){0.f, 0.f, 0.f, 0.f};
    bf16x8 At[4][2], B0[2][2], B1[2][2];
    const char* cA = (const char*)g.A + (size_t)cur.pm * tstep; const char* cB = (const char*)g.Bt + (size_t)cur.pn * tstep;
    S.a_ready(cur);
    if constexpr (SP2) {
        PG8_STAGE(PG8_SB(0, 0), cB, voffB); PG8_STAGE(PG8_SB(0, 1), cB + hstep, voffB); PG8_STAGE(PG8_SA(0, 0), cA, voffA); PG8_STAGE(PG8_SA(0, 1), cA + hstep, voffA);
        if (wr == 1) PG8_BAR;
        PG8_WAIT_V(2); PG8_BAR;
        PG8_STAGE(PG8_SB(1, 0), cB + kstep, voffB); PG8_STAGE(PG8_SA(1, 0), cA + kstep, voffA); PG8_STAGE(PG8_SB(1, 1), cB + hstep + kstep, voffB);
        PG8_WAIT_V(6); PG8_BAR;
    } else {
        PG8_STAGE(PG8_SB(0, 0), cB, voffB); PG8_STAGE(PG8_SA(0, 0), cA, voffA); PG8_STAGE(PG8_SB(0, 1), cB + hstep, voffB); PG8_STAGE(PG8_SA(0, 1), cA + hstep, voffA);
        if (wr == 1) PG8_BAR;
        PG8_WAIT_V(4); PG8_BAR;
        PG8_STAGE(PG8_SB(1, 0), cB + kstep, voffB); PG8_STAGE(PG8_SA(1, 0), cA + kstep, voffA); PG8_STAGE(PG8_SB(1, 1), cB + hstep + kstep, voffB);
        PG8_WAIT_V(6); PG8_BAR;
    }
    for (;;) {
        const bool has_next = S.next(ui + 1, nxt);
        const char* nA = has_next ? (const char*)g.A + (size_t)nxt.pm * tstep : cA; const char* nB = has_next ? (const char*)g.Bt + (size_t)nxt.pn * tstep : cB;
        for (int t = 0; t < nt; t += 2) {
            const bool last = (t == nt - 2);
            const char* a1 = cA + (size_t)(t + 1) * kstep;
            const char* a2 = last ? nA : cA + (size_t)(t + 2) * kstep; const char* b2 = last ? nB : cB + (size_t)(t + 2) * kstep;
            const char* a3 = a2 + kstep; const char* b3 = b2 + kstep;
            if (last && has_next) S.a_ready(nxt);
            if constexpr (SP2) {
            PG8_LDB(B0, 0, 0); PG8_LDB(B1, 0, 1); PG8_SCHED; PG8_LDA(At, 0, 0); PG8_STAGE(PG8_SA(1, 1), a1 + hstep, voffA);
            PG8_WAIT_V(8); PG8_WAIT_L(0); PG8_BAR; PG8_MMA(0, 0, At, B0); PG8_MMA(0, 1, At, B1); PG8_BAR; PG8_SCHED;
            PG8_LDA(At, 0, 1); PG8_STAGE(PG8_SB(0, 0), b2, voffB); PG8_STAGE(PG8_SB(0, 1), b2 + hstep, voffB); PG8_STAGE(PG8_SA(0, 0), a2, voffA);
            PG8_WAIT_V(8); PG8_WAIT_L(0); PG8_BAR; PG8_MMA(1, 0, At, B0); PG8_MMA(1, 1, At, B1); PG8_BAR; PG8_SCHED;
            PG8_LDB(B0, 1, 0); PG8_LDB(B1, 1, 1); PG8_SCHED; PG8_LDA(At, 1, 0); PG8_STAGE(PG8_SA(0, 1), a2 + hstep, voffA);
            PG8_WAIT_V(8); PG8_WAIT_L(0); PG8_BAR; PG8_MMA(0, 0, At, B0); PG8_MMA(0, 1, At, B1); PG8_BAR; PG8_SCHED;
            PG8_LDA(At, 1, 1); PG8_STAGE(PG8_SB(1, 0), b3, voffB); PG8_STAGE(PG8_SB(1, 1), b3 + hstep, voffB); PG8_STAGE(PG8_SA(1, 0), a3, voffA);
            PG8_WAIT_V(8); PG8_WAIT_L(0); PG8_BAR; PG8_MMA(1, 0, At, B0); PG8_MMA(1, 1, At, B1); PG8_BAR; PG8_SCHED;
            } else {
            PG8_LDB(B0, 0, 0); PG8_SCHED; PG8_LDA(At, 0, 0); PG8_STAGE(PG8_SA(1, 1), a1 + hstep, voffA);
            PG8_WAIT_L(8); PG8_BAR; PG8_WAIT_L(0); PG8_MMA(0, 0, At, B0); PG8_BAR; PG8_SCHED;
            PG8_LDB(B1, 0, 1); PG8_STAGE(PG8_SB(0, 0), b2, voffB);
            PG8_BAR; PG8_WAIT_L(0); PG8_MMA(0, 1, At, B1); PG8_BAR;
            PG8_LDA(At, 0, 1); PG8_STAGE(PG8_SA(0, 0), a2, voffA);
            PG8_BAR; PG8_WAIT_L(0); PG8_MMA(1, 0, At, B0); PG8_BAR; PG8_SCHED;
            PG8_STAGE(PG8_SB(0, 1), b2 + hstep, voffB);
            PG8_WAIT_V(6); PG8_BAR; PG8_MMA(1, 1, At, B1); PG8_BAR;
            PG8_LDB(B0, 1, 0); PG8_SCHED; PG8_LDA(At, 1, 0); PG8_STAGE(PG8_SA(0, 1), a2 + hstep, voffA);
            PG8_WAIT_L(8); PG8_BAR; PG8_WAIT_L(0); PG8_MMA(0, 0, At, B0); PG8_BAR; PG8_SCHED;
            PG8_LDB(B1, 1, 1); PG8_STAGE(PG8_SB(1, 0), b3, voffB);
            PG8_BAR; PG8_WAIT_L(0); PG8_MMA(0, 1, At, B1); PG8_BAR;
            PG8_LDA(At, 1, 1); PG8_STAGE(PG8_SA(1, 0), a3, voffA);
            PG8_BAR; PG8_WAIT_L(0); PG8_MMA(1, 0, At, B0); PG8_BAR; PG8_SCHED;
            PG8_STAGE(PG8_SB(1, 1), b3 + hstep, voffB);
            PG8_WAIT_V(6); PG8_BAR; PG8_MMA(1, 1, At, B1); PG8_BAR;
            }
        }
        if constexpr (ALIGN_EPI) { if (wr == 0) PG8_BAR; }
        if constexpr (!Epi::AFTER_DRAIN) { E(acc, cur, wr, wc, fr, fq); S.done(cur); }
        if (!has_next) break;
#pragma unroll
        for (int a = 0; a < 2; ++a)
#pragma unroll
            for (int b = 0; b < 2; ++b)
#pragma unroll
                for (int m = 0; m < 4; ++m)
#pragma unroll
                    for (int n = 0; n < 2; ++n) acc[a][b][m][n] = (f32x4){0.f, 0.f, 0.f, 0.f};
        cur = nxt; cA = nA; cB = nB; ++ui;
        if constexpr (ALIGN_EPI) { if (wr == 1) PG8_BAR; }
    }
    PG8_WAIT_V(0);
    if constexpr (!ALIGN_EPI) { if (wr == 0) PG8_BAR; }
    PG8_BAR;
    if constexpr (Epi::AFTER_DRAIN) { E.fused(acc, cur, wr, wc, fr, fq, lds, wid, lane); S.done(cur); }
#undef PG8_SA
#undef PG8_SB
#undef PG8_STAGE
#undef PG8_LDA
#undef PG8_LDB
#undef PG8_MMA
#undef PG8_WAIT_V
#undef PG8_WAIT_L
#undef PG8_BAR
#undef PG8_SCHED
}
}
#define GAS __attribute__((address_space(1)))
#define LAS __attribute__((address_space(3)))
typedef unsigned short bf16;
typedef unsigned v4u __attribute__((ext_vector_type(4)));
typedef float f32x4 __attribute__((ext_vector_type(4)));
typedef short bf16x8 __attribute__((ext_vector_type(8)));
typedef GAS unsigned gu32;
typedef GAS unsigned long long gu64;
#define RLX_AGENT __ATOMIC_RELAXED, __HIP_MEMORY_SCOPE_AGENT
#define LDS_WAIT() asm volatile("s_waitcnt lgkmcnt(0)" ::: "memory")
#define VM_WAIT() asm volatile("s_waitcnt vmcnt(0)" ::: "memory")
__device__ __forceinline__ unsigned long long rt() { return __builtin_amdgcn_s_memrealtime(); }
__device__ __forceinline__ unsigned f2bf(float f) { unsigned u = __builtin_bit_cast(unsigned, f); return (u + 0x7fffu + ((u >> 16) & 1u)) >> 16; }
__device__ __forceinline__ unsigned pk2(float lo, float hi) { return f2bf(lo) | (f2bf(hi) << 16); }

#define XB_TMO      128
#define XB_XCNT(j)  (256  + 64 * (j))
#define XB_XSUB(j)  (1280 + 64 * (j))
#define XB_XGEN(j)  (2304 + 64 * (j))
#define XB_TOP      3328
#define XB_TOPGEN   3392
#define XCD_BAR_WORDS 3456
#define XB_SPIN_CAP (1u << 18)

__device__ __forceinline__ unsigned xb_ld(unsigned* p)              { return __hip_atomic_load(p, __ATOMIC_RELAXED, __HIP_MEMORY_SCOPE_AGENT); }
__device__ __forceinline__ unsigned xb_add(unsigned* p, unsigned v) { return __hip_atomic_fetch_add(p, v, __ATOMIC_RELAXED, __HIP_MEMORY_SCOPE_AGENT); }
__device__ __forceinline__ unsigned xb_xcc_id() { return (unsigned)__builtin_amdgcn_s_getreg((3 << 11) | 20) & 0xFu; }
#define XB_SPIN(cond, bar) do { unsigned _sp = 0; while (cond) { __builtin_amdgcn_s_sleep(1); \
    if ((++_sp & 255u) == 0u) { if (xb_ld(&(bar)[XB_TMO])) break; if (_sp > XB_SPIN_CAP) { atomicAdd(&(bar)[XB_TMO], 1u); break; } } } } while (0)

struct XcdBarrier {
    unsigned* bar; unsigned x;
    volatile LAS unsigned* st;
};

__device__ __forceinline__ XcdBarrier xcd_barrier_post(unsigned* bar, volatile LAS unsigned* st) {
    XcdBarrier b; b.bar = bar; b.x = xb_xcc_id(); b.st = st;
    if (threadIdx.x == 0) (void)xb_add(&bar[XB_XCNT(b.x)], 1u);
    return b;
}
__device__ __forceinline__ void xcd_barrier_complete(unsigned* bar, unsigned x, unsigned& nloc, unsigned& nx) {
    const unsigned G = gridDim.x * gridDim.y * gridDim.z;
    unsigned sum, cnt, mine, sp = 0u;
    for (;;) {
        sum = 0u; cnt = 0u; mine = 0u;
#pragma unroll
        for (unsigned j = 0; j < 16; ++j) { const unsigned c = xb_ld(&bar[XB_XCNT(j)]); sum += c; cnt += (c > 0u) ? 1u : 0u; mine = (j == x) ? c : mine; }
        if (sum == G) break;
        __builtin_amdgcn_s_sleep(1);
        if ((++sp & 255u) == 0u) { if (xb_ld(&bar[XB_TMO])) break; if (sp > XB_SPIN_CAP) { atomicAdd(&bar[XB_TMO], 1u); break; } }
    }
    nloc = mine > 0u ? mine : 1u; nx = cnt > 0u ? cnt : 1u;
}

__device__ __forceinline__ void xcd_barrier(const XcdBarrier& b) {
    asm volatile("s_waitcnt vmcnt(0)" ::: "memory");
    __syncthreads();
    if (threadIdx.x == 0) {
        unsigned* bar = b.bar;
        __builtin_amdgcn_s_waitcnt(0);
        unsigned nloc = b.st[0], nx = b.st[1];
        if (nloc == 0u) { xcd_barrier_complete(bar, b.x, nloc, nx); b.st[0] = nloc; b.st[1] = nx; }
        const unsigned old = xb_add(&bar[XB_XSUB(b.x)], 1u);
        const unsigned gen = old / nloc;
        if (old + 1u == (gen + 1u) * nloc) {
            __builtin_amdgcn_fence(__ATOMIC_RELEASE, "agent");
            asm volatile("s_waitcnt vmcnt(0)" ::: "memory");
            const unsigned og = xb_add(&bar[XB_TOP], 1u);
            const unsigned tg = og / nx;
            if (og + 1u == (tg + 1u) * nx) xb_add(&bar[XB_TOPGEN], 1u);
            else XB_SPIN(xb_ld(&bar[XB_TOPGEN]) == tg, bar);
            __builtin_amdgcn_fence(__ATOMIC_ACQUIRE, "agent");
            xb_add(&bar[XB_XGEN(b.x)], 1u);
            asm volatile("s_waitcnt vmcnt(0)" ::: "memory");
        } else {
            XB_SPIN(xb_ld(&bar[XB_XGEN(b.x)]) == gen, bar);
            __builtin_amdgcn_fence(__ATOMIC_ACQUIRE, "agent");
            asm volatile("s_waitcnt vmcnt(0)" ::: "memory");
        }
    }
    __syncthreads();
}

constexpr int NWAVES = 8, NTHREADS = 512;
constexpr int BATCH = 4, SEQ = 2048, D = 2048, M = BATCH * SEQ;
constexpr int NQH = 32, NKVH = 4, HD = 64, QPKV = 8, WINDOW = 128;
constexpr int Q_OFF = 0, K_OFF = 2048, V_OFF = 2304, CB_OFF = 2560, CC_OFF = 4608, CH_OFF = 6656, G_OFF = 8704, IN_W = 12800;
constexpr int PH = 8, PNK = 128, PTOPK = 16, PNE = 16384;
constexpr float LN_EPS = 1e-5f;
constexpr float ALPHA = 1.189207115002721f;

#ifndef MK_PER_PHASE
#define MK_PER_PHASE 0
#endif
constexpr int N_PHASES = 12;

constexpr size_t MiB = 1u << 20;
constexpr size_t WS_CTL = 0, CTL_ZERO_BYTES = 1 * MiB;
constexpr size_t WS_WIN = 1 * MiB;
constexpr size_t WS_WA = 51 * MiB, WS_WC = 59 * MiB, WS_WO = 67 * MiB, WS_WF = 75 * MiB;
constexpr size_t WS_XB = 83 * MiB;
constexpr size_t WS_MERGED = WS_XB;
constexpr size_t WS_Z = 115 * MiB;
constexpr size_t WS_R2B = 115 * MiB;
constexpr size_t WS_H1B = 179 * MiB;
constexpr size_t WS_SC = 211 * MiB;
constexpr size_t WS_EX = 275 * MiB;
constexpr size_t WS_GT = 279 * MiB;
constexpr size_t WS_AO = 315 * MiB, WS_CI = 347 * MiB, WS_TMP = 379 * MiB;
constexpr size_t WS_U8 = 411 * MiB, WS_V8 = 443 * MiB;
constexpr size_t WS_SU = 475 * MiB, WS_SV = WS_SU + 65536;
constexpr size_t WS_PA = WS_SC;
constexpr size_t WS_XQ = 283 * MiB;
constexpr size_t WS_SX = 299 * MiB;
constexpr size_t WS_WB = 380 * MiB;
constexpr size_t WS_ST = 379 * MiB;
constexpr size_t WS_END = 476 * MiB;
constexpr int CW_Q = 12288;
constexpr size_t SLICE_BYTES = (size_t)PNE * 256;
constexpr int CW_BAR = 4096;

constexpr int RING_BYTES = 131072;
constexpr int LDSCTL_OFF = 147456, MISC_OFF = LDSCTL_OFF + 320;
constexpr int LDS_BYTES = LDSCTL_OFF + 512;

typedef float f32x16 __attribute__((ext_vector_type(16)));
typedef unsigned v2u __attribute__((ext_vector_type(2)));
__device__ __forceinline__ float wave_sum(float v) {
#pragma unroll
    for (int o = 1; o < 64; o <<= 1) v += __shfl_xor(v, o);
    return v;
}
__device__ __forceinline__ float vmaxf(float a, float b) { float r; asm("v_max_f32_e32 %0, %1, %2" : "=v"(r) : "v"(a), "v"(b)); return r; }
__device__ __forceinline__ float vminf(float a, float b) { float r; asm("v_min_f32_e32 %0, %1, %2" : "=v"(r) : "v"(a), "v"(b)); return r; }

__device__ __forceinline__ void p0_transpose_item(const float* W, int K, int N, bf16* WT, LAS float* scr, int item, int lane) {
    const int nblk = N / 32, kb = item / nblk, nb = item % nblk, k0 = 64 * kb, n0 = 32 * nb;
#pragma unroll 8
    for (int i = 0; i < 32; ++i) { const int kk = 2 * i + (lane >> 5); scr[kk * 33 + (lane & 31)] = W[(size_t)(k0 + kk) * N + n0 + (lane & 31)]; }
    LDS_WAIT(); asm volatile("" ::: "memory");
    const int c = lane & 7;
#pragma unroll
    for (int j = 0; j < 4; ++j) { const int n = (lane >> 3) + 8 * j; const LAS float* s = scr + (8 * c) * 33 + n;
        v4u o; o.x = pk2(s[0 * 33], s[1 * 33]); o.y = pk2(s[2 * 33], s[3 * 33]); o.z = pk2(s[4 * 33], s[5 * 33]); o.w = pk2(s[6 * 33], s[7 * 33]);
        *(GAS v4u*)(WT + (size_t)(n0 + n) * K + k0 + 8 * c) = o; }
    LDS_WAIT(); asm volatile("" ::: "memory");
}
__device__ __forceinline__ void p0_wf_item(const float* wq, const float* sk, bf16* WfT, LAS unsigned char* lds, int item, int tid) {
    const int hp = item >> 5, dt = item & 31;
    LAS f32x4* SK4 = (LAS f32x4*)lds;
    LAS f32x4* WQ4 = SK4 + 128 * 33;
    const float* skp = sk + (size_t)hp * 128 * 128;
    for (int i = tid; i < 128 * 32; i += NTHREADS) { const int n = i >> 5, c4 = i & 31; SK4[n * 33 + c4] = *(const f32x4*)(skp + n * 128 + 4 * c4); }
    for (int i = tid; i < 64 * 32; i += NTHREADS) { const int r = i >> 5, c4 = i & 31; WQ4[r * 33 + c4] = *(const f32x4*)(wq + (size_t)(64 * dt + r) * 2048 + hp * 128 + 4 * c4); }
    __syncthreads();
    const int td = tid & 15, tn = tid >> 4;
    float acc[4][4];
#pragma unroll
    for (int i = 0; i < 4; ++i)
#pragma unroll
        for (int j = 0; j < 4; ++j) acc[i][j] = 0.f;
#pragma unroll 4
    for (int c4 = 0; c4 < 32; ++c4) {
        f32x4 a[4], b[4];
#pragma unroll
        for (int i = 0; i < 4; ++i) a[i] = SK4[(4 * tn + i) * 33 + c4];
#pragma unroll
        for (int j = 0; j < 4; ++j) b[j] = WQ4[(td + 16 * j) * 33 + c4];
#pragma unroll
        for (int i = 0; i < 4; ++i)
#pragma unroll
            for (int j = 0; j < 4; ++j) acc[i][j] += a[i].x * b[j].x + a[i].y * b[j].y + a[i].z * b[j].z + a[i].w * b[j].w;
    }
#pragma unroll
    for (int i = 0; i < 4; ++i)
#pragma unroll
        for (int j = 0; j < 4; ++j) WfT[(size_t)(hp * 128 + 4 * tn + i) * 2048 + 64 * dt + td + 16 * j] = (bf16)f2bf(acc[i][j]);
    __syncthreads();
}

__device__ __forceinline__ int perm16(int o) { return 8 * ((o >> 2) & 1) + 4 * (o >> 3) + (o & 3); }
__device__ __forceinline__ void attn_unit(int unit, const bf16* z, bf16* ao, const float* sinks, LAS unsigned char* lds, int tid) {
    const int lane = tid & 63, wid = __builtin_amdgcn_readfirstlane(tid >> 6), r32 = lane & 31, hi = lane >> 5;
    const int nb = unit & 15, kvh = (unit >> 4) & 3, b = unit >> 6;
    LAS bf16* Ks = (LAS bf16*)lds;
    LAS bf16* Vt = (LAS bf16*)(lds + 256 * 144);
    const size_t tok0 = (size_t)b * SEQ;
#pragma unroll
    for (int i = 0; i < 4; ++i) {
        const int ci = tid + NTHREADS * i, key = ci >> 3, dc = ci & 7;
        int kpos = 128 * (nb - 1) + key; if (kpos < 0) kpos = 0;
        const bf16* src = z + (tok0 + kpos) * IN_W + K_OFF + kvh * HD + dc * 8;
        const v4u kv = *(const GAS v4u*)src, vv = *(const GAS v4u*)(src + (V_OFF - K_OFF));
        *(LAS v4u*)(Ks + key * 72 + dc * 8) = kv;
        const int pos = (key & ~15) + perm16(key & 15);
        LAS bf16* vp = Vt + (dc * 8) * 264 + pos;
        vp[0 * 264] = (bf16)(vv.x & 0xffffu); vp[1 * 264] = (bf16)(vv.x >> 16); vp[2 * 264] = (bf16)(vv.y & 0xffffu); vp[3 * 264] = (bf16)(vv.y >> 16);
        vp[4 * 264] = (bf16)(vv.z & 0xffffu); vp[5 * 264] = (bf16)(vv.z >> 16); vp[6 * 264] = (bf16)(vv.w & 0xffffu); vp[7 * 264] = (bf16)(vv.w >> 16);
    }
    __syncthreads();
    const int hq = kvh * QPKV + wid;
    const float LOG2E = 1.4426950408889634f;
    const float sink2 = sinks[hq] * LOG2E, sc = 0.125f * LOG2E;
#pragma unroll 1
    for (int qg = 0; qg < 4; ++qg) {
        const size_t tok = tok0 + 128 * nb + 32 * qg + r32;
        bf16x8 qf[4];
#pragma unroll
        for (int ks = 0; ks < 4; ++ks) qf[ks] = *(const GAS bf16x8*)(z + tok * IN_W + Q_OFF + hq * HD + 16 * ks + 8 * hi);
        f32x16 s[5];
#pragma unroll
        for (int kt = 0; kt < 5; ++kt) {
            s[kt] = (f32x16){0.f, 0.f, 0.f, 0.f, 0.f, 0.f, 0.f, 0.f, 0.f, 0.f, 0.f, 0.f, 0.f, 0.f, 0.f, 0.f};
#pragma unroll
            for (int ks = 0; ks < 4; ++ks) {
                const bf16x8 kf = *(const LAS bf16x8*)(Ks + (32 * (qg + kt) + r32) * 72 + 16 * ks + 8 * hi);
                s[kt] = __builtin_amdgcn_mfma_f32_32x32x16_bf16(kf, qf[ks], s[kt], 0, 0, 0);
            }
        }
        float mx = sink2;
#pragma unroll
        for (int kt = 0; kt < 5; ++kt) {
            const bool tile_dead = (nb == 0) && (qg + kt < 4);
#pragma unroll
            for (int r = 0; r < 16; ++r) {
                const int krow = (r & 3) + 8 * (r >> 2) + 4 * hi;
                bool valid = !tile_dead;
                if (kt == 0) valid = valid && (krow > r32);
                if (kt == 4) valid = valid && (krow <= r32);
                const float v = valid ? s[kt][r] * sc : -INFINITY;
                s[kt][r] = v; mx = fmaxf(mx, v);
            }
        }
        mx = fmaxf(mx, __shfl_xor(mx, 32));
        float sum = 0.f;
#pragma unroll
        for (int kt = 0; kt < 5; ++kt)
#pragma unroll
            for (int r = 0; r < 16; ++r) { const float p = __builtin_amdgcn_exp2f(s[kt][r] - mx); s[kt][r] = p; sum += p; }
        sum += __shfl_xor(sum, 32);
        const float inv = 1.0f / (sum + __builtin_amdgcn_exp2f(sink2 - mx));
        f32x16 o[2];
        o[0] = (f32x16){0.f, 0.f, 0.f, 0.f, 0.f, 0.f, 0.f, 0.f, 0.f, 0.f, 0.f, 0.f, 0.f, 0.f, 0.f, 0.f}; o[1] = o[0];
#pragma unroll
        for (int kt = 0; kt < 5; ++kt)
#pragma unroll
            for (int s2 = 0; s2 < 2; ++s2) {
                v4u pw; pw.x = pg8::cvt_pk_bf16(s[kt][8 * s2 + 0], s[kt][8 * s2 + 1]); pw.y = pg8::cvt_pk_bf16(s[kt][8 * s2 + 2], s[kt][8 * s2 + 3]);
                pw.z = pg8::cvt_pk_bf16(s[kt][8 * s2 + 4], s[kt][8 * s2 + 5]); pw.w = pg8::cvt_pk_bf16(s[kt][8 * s2 + 6], s[kt][8 * s2 + 7]);
                const bf16x8 pa = __builtin_bit_cast(bf16x8, pw);
#pragma unroll
                for (int dt = 0; dt < 2; ++dt) {
                    const bf16x8 vf = *(const LAS bf16x8*)(Vt + (32 * dt + r32) * 264 + 32 * (qg + kt) + 16 * s2 + 8 * hi);
                    o[dt] = __builtin_amdgcn_mfma_f32_32x32x16_bf16(vf, pa, o[dt], 0, 0, 0);
                }
            }
        bf16* op = ao + tok * D + hq * HD;
#pragma unroll
        for (int dt = 0; dt < 2; ++dt)
#pragma unroll
            for (int g = 0; g < 4; ++g) {
                v2u w; w.x = pg8::cvt_pk_bf16(o[dt][4 * g + 0] * inv, o[dt][4 * g + 1] * inv); w.y = pg8::cvt_pk_bf16(o[dt][4 * g + 2] * inv, o[dt][4 * g + 3] * inv);
                *(GAS v2u*)(op + 32 * dt + 8 * g + 4 * hi) = w;
            }
    }
    __syncthreads();
}
__device__ __forceinline__ void conv_item(int item, const bf16* z, const float* cw, bf16* ci, int tid) {
    const int c8 = tid & 255, half = tid >> 8, t0 = 32 * item + 16 * half, c0 = 8 * c8;
    float w0[8], w1[8], w2[8], u1[8], u2[8];
#pragma unroll
    for (int e = 0; e < 8; ++e) { w0[e] = cw[c0 + e]; w1[e] = cw[2048 + c0 + e]; w2[e] = cw[4096 + c0 + e]; u1[e] = 0.f; u2[e] = 0.f; }
    if ((t0 & (SEQ - 1)) != 0) {
#pragma unroll
        for (int k = 0; k < 2; ++k) {
            const bf16* zr = z + (size_t)(t0 - 2 + k) * IN_W + c0;
            const v4u a = *(const GAS v4u*)(zr + CC_OFF), h = *(const GAS v4u*)(zr + CH_OFF);
            float u[8];
            u[0] = pg8::bf_lo(a.x) * pg8::bf_lo(h.x); u[1] = pg8::bf_hi(a.x) * pg8::bf_hi(h.x); u[2] = pg8::bf_lo(a.y) * pg8::bf_lo(h.y); u[3] = pg8::bf_hi(a.y) * pg8::bf_hi(h.y);
            u[4] = pg8::bf_lo(a.z) * pg8::bf_lo(h.z); u[5] = pg8::bf_hi(a.z) * pg8::bf_hi(h.z); u[6] = pg8::bf_lo(a.w) * pg8::bf_lo(h.w); u[7] = pg8::bf_hi(a.w) * pg8::bf_hi(h.w);
#pragma unroll
            for (int e = 0; e < 8; ++e) { if (k == 0) u2[e] = u[e]; else u1[e] = u[e]; }
        }
    }
#pragma unroll 4
    for (int i = 0; i < 16; ++i) {
        const bf16* zr = z + (size_t)(t0 + i) * IN_W + c0;
        const v4u a = *(const GAS v4u*)(zr + CC_OFF), h = *(const GAS v4u*)(zr + CH_OFF), bb = *(const GAS v4u*)(zr + CB_OFF);
        float u[8], cb[8], y[8];
        u[0] = pg8::bf_lo(a.x) * pg8::bf_lo(h.x); u[1] = pg8::bf_hi(a.x) * pg8::bf_hi(h.x); u[2] = pg8::bf_lo(a.y) * pg8::bf_lo(h.y); u[3] = pg8::bf_hi(a.y) * pg8::bf_hi(h.y);
        u[4] = pg8::bf_lo(a.z) * pg8::bf_lo(h.z); u[5] = pg8::bf_hi(a.z) * pg8::bf_hi(h.z); u[6] = pg8::bf_lo(a.w) * pg8::bf_lo(h.w); u[7] = pg8::bf_hi(a.w) * pg8::bf_hi(h.w);
        cb[0] = pg8::bf_lo(bb.x); cb[1] = pg8::bf_hi(bb.x); cb[2] = pg8::bf_lo(bb.y); cb[3] = pg8::bf_hi(bb.y); cb[4] = pg8::bf_lo(bb.z); cb[5] = pg8::bf_hi(bb.z); cb[6] = pg8::bf_lo(bb.w); cb[7] = pg8::bf_hi(bb.w);
#pragma unroll
        for (int e = 0; e < 8; ++e) { y[e] = cb[e] * (w0[e] * u2[e] + w1[e] * u1[e] + w2[e] * u[e]); u2[e] = u1[e]; u1[e] = u[e]; }
        v4u o; o.x = pk2(y[0], y[1]); o.y = pk2(y[2], y[3]); o.z = pk2(y[4], y[5]); o.w = pk2(y[6], y[7]);
        *(GAS v4u*)(ci + (size_t)(t0 + i) * D + c0) = o;
    }
}

__device__ __forceinline__ unsigned pack_i8(const f32x4 v) {
    const int a = __float2int_rn(v.x), b = __float2int_rn(v.y), c = __float2int_rn(v.z), d = __float2int_rn(v.w);
    return ((unsigned)a & 0xffu) | (((unsigned)b & 0xffu) << 8) | (((unsigned)c & 0xffu) << 16) | ((unsigned)d << 24);
}
__device__ __forceinline__ unsigned pack_i8_2(float a, float b, float c, float d) {
    const int ia = __float2int_rn(a), ib = __float2int_rn(b), ic = __float2int_rn(c), id = __float2int_rn(d);
    return ((unsigned)ia & 0xffu) | (((unsigned)ib & 0xffu) << 8) | (((unsigned)ic & 0xffu) << 16) | ((unsigned)id << 24);
}
__device__ __forceinline__ void ln1_row(bf16* hbrow, signed char* xqrow, float* sxp, const float* g, const float* bta, int lane) {
    GAS v4u* xr = (GAS v4u*)hbrow + lane;
    float v[4][8]; float s = 0.f;
#pragma unroll
    for (int j = 0; j < 4; ++j) { const v4u w = xr[64 * j];
        v[j][0] = pg8::bf_lo(w.x); v[j][1] = pg8::bf_hi(w.x); v[j][2] = pg8::bf_lo(w.y); v[j][3] = pg8::bf_hi(w.y); v[j][4] = pg8::bf_lo(w.z); v[j][5] = pg8::bf_hi(w.z); v[j][6] = pg8::bf_lo(w.w); v[j][7] = pg8::bf_hi(w.w);
#pragma unroll
        for (int e = 0; e < 8; ++e) s += v[j][e]; }
    const float mean = wave_sum(s) * (1.f / D); float s2 = 0.f;
#pragma unroll
    for (int j = 0; j < 4; ++j)
#pragma unroll
        for (int e = 0; e < 8; ++e) { v[j][e] -= mean; s2 += v[j][e] * v[j][e]; }
    const float rstd = 1.f / sqrtf(wave_sum(s2) * (1.f / D) + LN_EPS);
    float mx = 0.f;
#pragma unroll
    for (int j = 0; j < 4; ++j) {
        const GAS f32x4* gp = (const GAS f32x4*)g + 2 * (lane + 64 * j); const GAS f32x4* bp = (const GAS f32x4*)bta + 2 * (lane + 64 * j);
        const f32x4 g0 = gp[0], g1 = gp[1], b0 = bp[0], b1 = bp[1];
        v[j][0] = v[j][0] * rstd * g0.x + b0.x; v[j][1] = v[j][1] * rstd * g0.y + b0.y; v[j][2] = v[j][2] * rstd * g0.z + b0.z; v[j][3] = v[j][3] * rstd * g0.w + b0.w;
        v[j][4] = v[j][4] * rstd * g1.x + b1.x; v[j][5] = v[j][5] * rstd * g1.y + b1.y; v[j][6] = v[j][6] * rstd * g1.z + b1.z; v[j][7] = v[j][7] * rstd * g1.w + b1.w;
        v4u o; o.x = pk2(v[j][0], v[j][1]); o.y = pk2(v[j][2], v[j][3]); o.z = pk2(v[j][4], v[j][5]); o.w = pk2(v[j][6], v[j][7]);
        xr[64 * j] = o;
#pragma unroll
        for (int e = 0; e < 8; ++e) mx = fmaxf(mx, fabsf(v[j][e]));
    }
#pragma unroll
    for (int o = 1; o < 64; o <<= 1) mx = fmaxf(mx, __shfl_xor(mx, o));
    const float qs = mx > 0.f ? 127.0f / mx : 1.0f;
    GAS v2u* q8 = (GAS v2u*)xqrow + lane;
#pragma unroll
    for (int j = 0; j < 4; ++j) { v2u o; o.x = pack_i8_2(v[j][0] * qs, v[j][1] * qs, v[j][2] * qs, v[j][3] * qs); o.y = pack_i8_2(v[j][4] * qs, v[j][5] * qs, v[j][6] * qs, v[j][7] * qs); q8[64 * j] = o; }
    if (lane == 0) *sxp = mx > 0.f ? mx * (1.0f / 127.0f) : 1.0f;
}

constexpr int TK_ROWF = 136;
constexpr int TK_IDX_OFF = 256 * TK_ROWF * 4;
__device__ __forceinline__ void topk_core(LAS unsigned char* lds, size_t prob0, int pstride, int* experts, float* gates, int tid) {
    LAS float* S = (LAS float*)lds;
    LAS unsigned char* IDX = lds + TK_IDX_OFF;
    const int row = tid >> 1, sub = tid & 1;
#define TK_CE(a, b) do { const float h_ = vmaxf(a, b), l_ = vminf(a, b); a = h_; b = l_; } while (0)
#define TK_SORT16(V) do { _Pragma("unroll") for (int k_ = 2; k_ <= 16; k_ <<= 1) _Pragma("unroll") for (int j_ = k_ >> 1; j_ > 0; j_ >>= 1) _Pragma("unroll") for (int i_ = 0; i_ < 16; ++i_) { \
        const int l_i = i_ ^ j_; if (l_i > i_) { if ((i_ & k_) == 0) TK_CE(V[i_], V[l_i]); else TK_CE(V[l_i], V[i_]); } } } while (0)
#define TK_MERGE16(Lv, Xv) do { _Pragma("unroll") for (int j_ = 0; j_ < 16; ++j_) Lv[j_] = vmaxf(Lv[j_], Xv[15 - j_]); \
        _Pragma("unroll") for (int st_ = 8; st_ >= 1; st_ >>= 1) _Pragma("unroll") for (int j_ = 0; j_ < 16; ++j_) if ((j_ & st_) == 0) TK_CE(Lv[j_], Lv[j_ + st_]); } while (0)
    float L[16];
#pragma unroll
    for (int q = 0; q < 4; ++q) {
        float C[16];
#pragma unroll
        for (int i = 0; i < 4; ++i) { const int c4 = 2 * (4 * q + i) + sub;
            const f32x4 v = *(const LAS f32x4*)(S + row * TK_ROWF + 4 * c4);
#pragma unroll
            for (int e = 0; e < 4; ++e) { const float ve = v[e];
                C[4 * i + e] = __uint_as_float((__float_as_uint(ve) & ~0x7Fu) | (unsigned)(4 * c4 + e)); } }
        TK_SORT16(C);
        if (q == 0) {
#pragma unroll
            for (int j = 0; j < 16; ++j) L[j] = C[j];
        } else TK_MERGE16(L, C);
    }
    {
        float P[16];
#pragma unroll
        for (int j = 0; j < 16; ++j) P[j] = __shfl_xor(L[j], 1);
        TK_MERGE16(L, P);
    }
    if (sub == 0) {
#pragma unroll
        for (int q = 0; q < 4; ++q) {
            unsigned w = 0;
#pragma unroll
            for (int e = 0; e < 4; ++e) w |= (__builtin_bit_cast(unsigned, L[4 * q + e]) & 0x7Fu) << (8 * e);
            *(LAS unsigned*)(IDX + row * 16 + 4 * q) = w;
        }
    }
    float A[16], B[16];
#pragma unroll
    for (int j = 0; j < 16; ++j) { const float o = __shfl_xor(L[j], 2); const bool isb = (tid & 2) != 0; A[j] = isb ? o : L[j]; B[j] = isb ? L[j] : o; }
#define TK_KEY(i, j) __uint_as_float((__float_as_uint(A[i] + B[j]) & ~0xFFu) | (unsigned)(255 - ((i) * 16 + (j))))
    float F[16], X[16];
#pragma unroll
    for (int j = 0; j < 16; ++j) F[j] = TK_KEY(0, j);
#pragma unroll
    for (int i = 1; i < 16; ++i) X[i - 1] = TK_KEY(i, 0);
    X[15] = -INFINITY; TK_MERGE16(F, X);
#pragma unroll
    for (int i = 0; i < 16; ++i) X[i] = -INFINITY;
#pragma unroll
    for (int i = 1; i <= 7; ++i) X[i - 1] = TK_KEY(i, 1);
    TK_MERGE16(F, X);
#pragma unroll
    for (int i = 0; i < 16; ++i) X[i] = -INFINITY;
#pragma unroll
    for (int j = 2; j <= 7; ++j) X[j - 2] = TK_KEY(1, j);
    TK_MERGE16(F, X);
    { const float rest[6] = {TK_KEY(2, 2), TK_KEY(2, 3), TK_KEY(2, 4), TK_KEY(3, 2), TK_KEY(3, 3), TK_KEY(4, 2)};
#pragma unroll
      for (int r = 0; r < 6; ++r) { float x = rest[r];
#pragma unroll
          for (int k = 0; k < 16; ++k) { const float h = vmaxf(F[k], x); x = vminf(F[k], x); F[k] = h; } } }
    __syncthreads();
    if ((tid & 3) == 0) {
        const int rowA = (tid >> 2) * 2, rowB = rowA + 1;
        const size_t prob = prob0 + (size_t)pstride * (tid >> 2);
        float g[16]; int ex[16]; float gs = 0.f;
#pragma unroll
        for (int k = 0; k < 16; ++k) {
            const unsigned code = 255u - (__builtin_bit_cast(unsigned, F[k]) & 0xFFu);
            const int ia = IDX[rowA * 16 + (code >> 4)], ib = IDX[rowB * 16 + (code & 15)];
            ex[k] = ia * PNK + ib;
            g[k] = __expf(F[k] - F[0]); gs += g[k];
        }
        const float ginv = 1.0f / gs;
#pragma unroll
        for (int q = 0; q < 4; ++q) {
            *(GAS f32x4*)(gates + prob * 16 + 4 * q) = (f32x4){g[4 * q] * ginv, g[4 * q + 1] * ginv, g[4 * q + 2] * ginv, g[4 * q + 3] * ginv};
            typedef int i32x4 __attribute__((ext_vector_type(4)));
            *(GAS i32x4*)(experts + prob * 16 + 4 * q) = (i32x4){ex[4 * q], ex[4 * q + 1], ex[4 * q + 2], ex[4 * q + 3]};
        }
    }
    __syncthreads();
}
__device__ __forceinline__ void topk_pass(int pass, const float* scores, int* experts, float* gates, LAS unsigned char* lds, int tid) {
    LAS float* S = (LAS float*)lds;
    const float* src = scores + (size_t)pass * (256 * 128);
#pragma unroll 4
    for (int i = 0; i < 16; ++i) { const int f4 = tid + NTHREADS * i, row = f4 >> 5, c4 = f4 & 31; *(LAS f32x4*)(S + row * TK_ROWF + 4 * c4) = *(const GAS f32x4*)(src + (size_t)f4 * 4); }
    __syncthreads();
    topk_core(lds, (size_t)pass * 128, 1, experts, gates, tid);
}
struct EpiTopK {
    static constexpr bool PERM = false, AFTER_DRAIN = true;
    int* experts; float* gates;
    __device__ __forceinline__ void fused(pg8::f32x4 (&acc)[2][2][4][2], const pg8::Unit& u, int wr, int wc, int fr, int fq, LAS unsigned char* lds, int wid, int lane) const {
        LAS float* S = (LAS float*)lds;
        const int tid = wid * 64 + lane;
#pragma unroll
        for (int ai = 0; ai < 2; ++ai) {
#pragma unroll
            for (int bj = 0; bj < 2; ++bj)
#pragma unroll
                for (int mm = 0; mm < 4; ++mm)
#pragma unroll
                    for (int n = 0; n < 2; ++n) { const int rl = 64 * wr + 16 * mm + fr; *(LAS pg8::f32x4*)(S + (2 * rl + bj) * TK_ROWF + 32 * wc + 16 * n + 4 * fq) = acc[ai][bj][mm][n]; }
            __syncthreads();
            topk_core(lds, ((size_t)u.pm * 256 + 128 * ai) * PH + u.pn, PH, experts, gates, tid);
        }
    }
};

__device__ __forceinline__ float gelu_erf(float v) { return 0.5f * v * (1.0f + erff(v * 0.70710678118654752f)); }
typedef __bf16 bf16x2_t __attribute__((ext_vector_type(2)));
typedef float f32x2_t __attribute__((ext_vector_type(2)));
__device__ __forceinline__ float dot2bf(bf16x2_t a, unsigned b, float acc) { return __builtin_amdgcn_fdot2_f32_bf16(a, __builtin_bit_cast(bf16x2_t, b), acc, false); }
__device__ __forceinline__ float dot4f8(unsigned w8, unsigned x01, unsigned x23, float acc) {
    acc = dot2bf(__builtin_amdgcn_cvt_scalef32_pk_bf16_fp8(w8, 1.0f, false), x01, acc);
    return dot2bf(__builtin_amdgcn_cvt_scalef32_pk_bf16_fp8(w8, 1.0f, true), x23, acc);
}
__device__ __forceinline__ void axpy4f8(float* y, unsigned w8, float w) {
    const f32x2_t lo = __builtin_amdgcn_cvt_pk_f32_fp8(w8, false), hi = __builtin_amdgcn_cvt_pk_f32_fp8(w8, true);
    y[0] += w * lo.x; y[1] += w * lo.y; y[2] += w * hi.x; y[3] += w * hi.y;
}
__device__ __forceinline__ void axpy4f8v(f32x2_t* y2, unsigned w8, float w) {
    const f32x2_t lo = __builtin_amdgcn_cvt_pk_f32_fp8(w8, false), hi = __builtin_amdgcn_cvt_pk_f32_fp8(w8, true);
    const f32x2_t ww = {w, w};
    y2[0] = __builtin_elementwise_fma(lo, ww, y2[0]); y2[1] = __builtin_elementwise_fma(hi, ww, y2[1]);
}
__device__ __forceinline__ void row_to_fp8(const float* src, unsigned char* dst, float* inv, int lane) {
    f32x4 v[2][4]; float mx = 0.f;
#pragma unroll
    for (int j = 0; j < 2; ++j)
#pragma unroll
        for (int q = 0; q < 4; ++q) { v[j][q] = *((const GAS f32x4*)src + 4 * (lane + 64 * j) + q);
            mx = fmaxf(mx, fmaxf(fmaxf(fabsf(v[j][q].x), fabsf(v[j][q].y)), fmaxf(fabsf(v[j][q].z), fabsf(v[j][q].w)))); }
#pragma unroll
    for (int o = 1; o < 64; o <<= 1) mx = fmaxf(mx, __shfl_xor(mx, o));
    const float sc = mx > 0.f ? 384.0f / mx : 1.0f;
#pragma unroll
    for (int j = 0; j < 2; ++j) { v4u o;
        int w;
        w = 0; w = __builtin_amdgcn_cvt_pk_fp8_f32(v[j][0].x * sc, v[j][0].y * sc, w, false); w = __builtin_amdgcn_cvt_pk_fp8_f32(v[j][0].z * sc, v[j][0].w * sc, w, true); o.x = (unsigned)w;
        w = 0; w = __builtin_amdgcn_cvt_pk_fp8_f32(v[j][1].x * sc, v[j][1].y * sc, w, false); w = __builtin_amdgcn_cvt_pk_fp8_f32(v[j][1].z * sc, v[j][1].w * sc, w, true); o.y = (unsigned)w;
        w = 0; w = __builtin_amdgcn_cvt_pk_fp8_f32(v[j][2].x * sc, v[j][2].y * sc, w, false); w = __builtin_amdgcn_cvt_pk_fp8_f32(v[j][2].z * sc, v[j][2].w * sc, w, true); o.z = (unsigned)w;
        w = 0; w = __builtin_amdgcn_cvt_pk_fp8_f32(v[j][3].x * sc, v[j][3].y * sc, w, false); w = __builtin_amdgcn_cvt_pk_fp8_f32(v[j][3].z * sc, v[j][3].w * sc, w, true); o.w = (unsigned)w;
        { const int ch = lane + 64 * j; *((GAS v4u*)(dst + (size_t)(ch >> 4) * SLICE_BYTES) + (ch & 15)) = o; } }
    if (lane == 0) *inv = mx > 0.f ? mx * (1.0f / 384.0f) : 1.0f;
}
__device__ __forceinline__ void row_to_i8(const float* src, unsigned char* dst, float* inv, int lane) {
    f32x4 v[2][4]; float mx = 0.f;
#pragma unroll
    for (int j = 0; j < 2; ++j)
#pragma unroll
        for (int q = 0; q < 4; ++q) { v[j][q] = *((const GAS f32x4*)src + 4 * (lane + 64 * j) + q);
            mx = fmaxf(mx, fmaxf(fmaxf(fabsf(v[j][q].x), fabsf(v[j][q].y)), fmaxf(fabsf(v[j][q].z), fabsf(v[j][q].w)))); }
#pragma unroll
    for (int o = 1; o < 64; o <<= 1) mx = fmaxf(mx, __shfl_xor(mx, o));
    const float sc = mx > 0.f ? 127.0f / mx : 1.0f;
#pragma unroll
    for (int j = 0; j < 2; ++j) { v4u o; o.x = pack_i8(v[j][0] * sc); o.y = pack_i8(v[j][1] * sc); o.z = pack_i8(v[j][2] * sc); o.w = pack_i8(v[j][3] * sc);
        { const int ch = lane + 64 * j; *((GAS v4u*)(dst + (size_t)(ch >> 4) * SLICE_BYTES) + (ch & 15)) = o; } }
    if (lane == 0) *inv = mx > 0.f ? mx * (1.0f / 127.0f) : 1.0f;
}
__device__ __forceinline__ float row16_allsum(float a) {
    a += __builtin_bit_cast(float, __builtin_amdgcn_update_dpp(0, __builtin_bit_cast(int, a), 0x128, 0xf, 0xf, false));
    a += __builtin_bit_cast(float, __builtin_amdgcn_update_dpp(0, __builtin_bit_cast(int, a), 0x124, 0xf, 0xf, false));
    a += __builtin_bit_cast(float, __builtin_amdgcn_update_dpp(0, __builtin_bit_cast(int, a), 0x122, 0xf, 0xf, false));
    a += __builtin_bit_cast(float, __builtin_amdgcn_update_dpp(0, __builtin_bit_cast(int, a), 0x121, 0xf, 0xf, false));
    return a;
}
__device__ __forceinline__ int q_pull(unsigned* q, int lane) { int v = 0; if (lane == 0) v = (int)__hip_atomic_fetch_add(q, 1u, __ATOMIC_RELAXED, __HIP_MEMORY_SCOPE_AGENT); return __builtin_amdgcn_readfirstlane(v); }
constexpr int PEER_TG = 8;
constexpr int PEER_N8 = 640, PEER_N4 = 512, PEER_N2 = 512, PEER_NTASK = PEER_N8 + PEER_N4 + PEER_N2;
__device__ __forceinline__ void peer_task_tokens(int idx, int& t0, int& n) {
    if (idx < PEER_N8) { t0 = 8 * idx; n = 8; } else if (idx < PEER_N8 + PEER_N4) { t0 = 8 * PEER_N8 + 4 * (idx - PEER_N8); n = 4; } else { t0 = 8 * PEER_N8 + 4 * PEER_N4 + 2 * (idx - PEER_N8 - PEER_N4); n = 2; }
}
__device__ __forceinline__ int row16_allsum_i(int a) {
    a += __builtin_amdgcn_update_dpp(0, a, 0x128, 0xf, 0xf, false);
    a += __builtin_amdgcn_update_dpp(0, a, 0x124, 0xf, 0xf, false);
    a += __builtin_amdgcn_update_dpp(0, a, 0x122, 0xf, 0xf, false);
    a += __builtin_amdgcn_update_dpp(0, a, 0x121, 0xf, 0xf, false);
    return a;
}
#define PA_LOAD(R, IDV, HALF) do { _Pragma("unroll") for (int i_ = 0; i_ < 8; ++i_) { const unsigned e_ = (unsigned)__shfl(IDV, 4 * (i_ + 8 * (HALF)) + g); \
        R[i_] = *(const GAS v4u*)(ub + (e_ * 256u + offc)); } } while (0)
#define PA_COMP(R, HALF) do { _Pragma("unroll") for (int i_ = 0; i_ < 8; ++i_) { int a_ = __builtin_amdgcn_sdot4((int)R[i_].x, (int)xc.x, 0, false); a_ = __builtin_amdgcn_sdot4((int)R[i_].y, (int)xc.y, a_, false); \
        a_ = __builtin_amdgcn_sdot4((int)R[i_].z, (int)xc.z, a_, false); a_ = __builtin_amdgcn_sdot4((int)R[i_].w, (int)xc.w, a_, false); r16[8 * (HALF) + i_] = row16_allsum_i(a_); } } while (0)
__device__ __forceinline__ void peer_a_task(int t0, int ntok, int s, const signed char* xq, const int* experts, const unsigned char* u8s, int* pa, int lane_) {
    int lane = lane_; asm volatile("" : "+v"(lane));
    const int g = lane >> 4, c = lane & 15;
    const GAS unsigned char* ub = (const GAS unsigned char*)(u8s + (size_t)s * SLICE_BYTES);
    const unsigned offc = 16u * (unsigned)c;
    int idc0 = experts[(size_t)t0 * 128 + lane], idc1 = experts[(size_t)t0 * 128 + lane + 64];
    v4u xc = *(const GAS v4u*)(xq + (size_t)t0 * D + 256 * s + 16 * c);
    v4u RA[8], RB[8];
    PA_LOAD(RA, idc0, 0);
#pragma unroll 1
    for (int tt = 0; tt < ntok; ++tt) {
        const int t = t0 + tt, tn = tt + 1 < ntok ? t + 1 : t;
        const int idn0 = experts[(size_t)tn * 128 + lane], idn1 = experts[(size_t)tn * 128 + lane + 64];
        const v4u xn = *(const GAS v4u*)(xq + (size_t)tn * D + 256 * s + 16 * c);
#pragma unroll 1
        for (int hb = 0; hb < 2; ++hb) {
            const int idv = hb ? idc1 : idc0, idx = hb ? idn0 : idc1;
            int r16[16];
            PA_LOAD(RB, idv, 1); PA_COMP(RA, 0);
            asm volatile("" ::: "memory");
            PA_LOAD(RA, idx, 0); PA_COMP(RB, 1);
            if (c == 15) { typedef int i32x4 __attribute__((ext_vector_type(4))); GAS i32x4* dst = (GAS i32x4*)(pa + ((size_t)t * 8 + s) * 128 + g * 32 + 16 * hb);
#pragma unroll
                for (int q = 0; q < 4; ++q) dst[q] = (i32x4){r16[4 * q], r16[4 * q + 1], r16[4 * q + 2], r16[4 * q + 3]}; }
        }
        idc0 = idn0; idc1 = idn1; xc = xn;
    }
}
__device__ __forceinline__ void peer_w_elem(size_t i, const int* experts, const float* gates, const float* su, const float* sv, const float* sx, const int* pa, float* wb) {
    const size_t t = i >> 7; const int k = (int)(i & 127), pos = (k & 3) * 32 + (k >> 2);
    const int e = experts[i];
    int a = 0;
#pragma unroll
    for (int s2 = 0; s2 < 8; ++s2) a += pa[(t * 8 + s2) * 128 + pos];
    wb[i] = gates[i] * gelu_erf((float)a * (su[e] * sx[t])) * sv[e];
}
#define PB_LOAD(R, IDV, HALF) do { _Pragma("unroll") for (int i_ = 0; i_ < 8; ++i_) { const unsigned e_ = (unsigned)__shfl(IDV, 4 * (i_ + 8 * (HALF)) + g); \
        R[i_] = *(const GAS v4u*)(vb + (e_ * 256u + offc)); } } while (0)
#define PB_COMP(R, WV, HALF) do { _Pragma("unroll") for (int i_ = 0; i_ < 8; ++i_) { const float wk_ = __shfl(WV, 4 * (i_ + 8 * (HALF)) + g); \
        axpy4f8v(&ya2[0], R[i_].x, wk_); axpy4f8v(&ya2[2], R[i_].y, wk_); axpy4f8v(&ya2[4], R[i_].z, wk_); axpy4f8v(&ya2[6], R[i_].w, wk_); } } while (0)
__device__ __forceinline__ void peer_b_task(int t0, int ntok, int s, const bf16* h1, const int* experts, const float* wb, const unsigned char* v8s, bf16* out, float* st, int lane_) {
    int lane = lane_; asm volatile("" : "+v"(lane));
    const int g = lane >> 4, c = lane & 15;
    const GAS unsigned char* vb = (const GAS unsigned char*)(v8s + (size_t)s * SLICE_BYTES);
    const unsigned offc = 16u * (unsigned)c;
    int idc0 = experts[(size_t)t0 * 128 + lane], idc1 = experts[(size_t)t0 * 128 + lane + 64];
    float wc0 = wb[(size_t)t0 * 128 + lane], wc1 = wb[(size_t)t0 * 128 + lane + 64];
    v4u RA[8], RB[8];
    PB_LOAD(RA, idc0, 0);
#pragma unroll 1
    for (int tt = 0; tt < ntok; ++tt) {
        const int t = t0 + tt, tn = tt + 1 < ntok ? t + 1 : t;
        const int idn0 = experts[(size_t)tn * 128 + lane], idn1 = experts[(size_t)tn * 128 + lane + 64];
        const float wn0 = wb[(size_t)tn * 128 + lane], wn1 = wb[(size_t)tn * 128 + lane + 64];
        f32x2_t ya2[8];
#pragma unroll
        for (int e = 0; e < 8; ++e) ya2[e] = (f32x2_t){0.f, 0.f};
#pragma unroll 1
        for (int hb = 0; hb < 2; ++hb) {
            const int idv = hb ? idc1 : idc0, idx = hb ? idn0 : idc1; const float wv = hb ? wc1 : wc0;
            PB_LOAD(RB, idv, 1); PB_COMP(RA, wv, 0);
            asm volatile("" ::: "memory");
            PB_LOAD(RA, idx, 0); PB_COMP(RB, wv, 1);
        }
        float ya[16];
#pragma unroll
        for (int e = 0; e < 8; ++e) { ya[2 * e] = ya2[e].x; ya[2 * e + 1] = ya2[e].y; }
#pragma unroll
        for (int e = 0; e < 16; ++e) { ya[e] += __shfl_xor(ya[e], 16); ya[e] += __shfl_xor(ya[e], 32); }
        const GAS v4u* hp = (const GAS v4u*)(h1 + (size_t)t * D + 256 * s + 16 * c);
        const v4u h0 = hp[0], h1v = hp[1];
        float hx[16];
        hx[0] = pg8::bf_lo(h0.x); hx[1] = pg8::bf_hi(h0.x); hx[2] = pg8::bf_lo(h0.y); hx[3] = pg8::bf_hi(h0.y); hx[4] = pg8::bf_lo(h0.z); hx[5] = pg8::bf_hi(h0.z); hx[6] = pg8::bf_lo(h0.w); hx[7] = pg8::bf_hi(h0.w);
        hx[8] = pg8::bf_lo(h1v.x); hx[9] = pg8::bf_hi(h1v.x); hx[10] = pg8::bf_lo(h1v.y); hx[11] = pg8::bf_hi(h1v.y); hx[12] = pg8::bf_lo(h1v.z); hx[13] = pg8::bf_hi(h1v.z); hx[14] = pg8::bf_lo(h1v.w); hx[15] = pg8::bf_hi(h1v.w);
        float sm = 0.f, sq = 0.f;
#pragma unroll
        for (int e = 0; e < 16; ++e) { ya[e] = hx[e] * ALPHA + ya[e]; sm += ya[e]; sq += ya[e] * ya[e]; }
        sm = row16_allsum(sm); sq = row16_allsum(sq);
        if (g == 0) { GAS v4u* op = (GAS v4u*)(out + (size_t)t * D + 256 * s + 16 * c);
            v4u o0, o1; o0.x = pk2(ya[0], ya[1]); o0.y = pk2(ya[2], ya[3]); o0.z = pk2(ya[4], ya[5]); o0.w = pk2(ya[6], ya[7]);
            o1.x = pk2(ya[8], ya[9]); o1.y = pk2(ya[10], ya[11]); o1.z = pk2(ya[12], ya[13]); o1.w = pk2(ya[14], ya[15]);
            op[0] = o0; op[1] = o1;
            if (c == 0) { st[((size_t)t * 8 + s) * 2] = sm; st[((size_t)t * 8 + s) * 2 + 1] = sq; } }
        idc0 = idn0; idc1 = idn1; wc0 = wn0; wc1 = wn1;
    }
}
__device__ __forceinline__ void peer_c_row(int t, const bf16* r2, float* out, const float* st, const float* g2, const float* b2, int lane) {
    float sm = 0.f, sq = 0.f;
#pragma unroll
    for (int s = 0; s < 8; ++s) { sm += st[((size_t)t * 8 + s) * 2]; sq += st[((size_t)t * 8 + s) * 2 + 1]; }
    const float mean = sm * (1.f / D), var = sq * (1.f / D) - mean * mean, rstd = 1.f / sqrtf(fmaxf(var, 0.f) + LN_EPS);
    const GAS v4u* xr = (const GAS v4u*)(r2 + (size_t)t * D) + lane;
    GAS f32x4* op = (GAS f32x4*)(out + (size_t)t * D);
#pragma unroll
    for (int j = 0; j < 4; ++j) { const v4u w = xr[64 * j]; const int c4 = 2 * (lane + 64 * j);
        const f32x4 g0 = *((const GAS f32x4*)g2 + c4), g1 = *((const GAS f32x4*)g2 + c4 + 1), b0 = *((const GAS f32x4*)b2 + c4), b1 = *((const GAS f32x4*)b2 + c4 + 1);
        const f32x4 v0 = (f32x4){pg8::bf_lo(w.x), pg8::bf_hi(w.x), pg8::bf_lo(w.y), pg8::bf_hi(w.y)}, v1 = (f32x4){pg8::bf_lo(w.z), pg8::bf_hi(w.z), pg8::bf_lo(w.w), pg8::bf_hi(w.w)};
        op[c4] = (v0 - mean) * rstd * g0 + b0; op[c4 + 1] = (v1 - mean) * rstd * g1 + b1; }
}

struct ConvOrder : pg8::StaticOrder {
    const float* pu; const float* pv; unsigned char* u8; unsigned char* v8; float* su; float* sv; int slot; mutable int calls;
    static constexpr int CONV_ROWS = 4, CONV_CALLS = 6;
    __device__ __forceinline__ void done(const pg8::Unit&) const {
        if (slot < 0) return;
        int lane = threadIdx.x & 63; asm volatile("" : "+v"(lane));
        const int wave = __builtin_amdgcn_readfirstlane(threadIdx.x >> 6);
        const int base = ((slot * NWAVES + wave) * CONV_CALLS + calls) * CONV_ROWS;
        if (calls < CONV_CALLS) {
#pragma unroll 1
            for (int j = 0; j < CONV_ROWS; ++j) { const int r = base + j; if (r < 2 * PNE) { const bool sec = r >= PNE; const int e = sec ? r - PNE : r;
                if (sec) row_to_fp8(pv + (size_t)e * D, v8 + (size_t)e * 256, sv + e, lane); else row_to_i8(pu + (size_t)e * D, u8 + (size_t)e * 256, su + e, lane); } }
        }
        ++calls;
    }
};

struct Args { const float* in[16]; float* out; unsigned char* ws; int ph_lo, ph_hi; };
__global__ void __launch_bounds__(NTHREADS, 2) mk_fwd(Args args) {
    extern __shared__ __attribute__((aligned(16))) unsigned char lds_raw[];
    LAS unsigned char* lds = (LAS unsigned char*)lds_raw;
    volatile LAS unsigned* MISC = (volatile LAS unsigned*)(lds + MISC_OFF);
    const int tid0 = threadIdx.x;
    const int G = gridDim.x, bx = blockIdx.x;
    unsigned char* ws = args.ws;
    gu32* ctl = (gu32*)(ws + WS_CTL);
#define IN_(i) (args.in[i])
#define x_in IN_(0)
#define w_in IN_(1)
#define b_gate IN_(2)
#define sinks IN_(3)
#define conv_w IN_(4)
#define w_ao IN_(5)
#define w_co IN_(6)
#define w_o IN_(7)
#define ln1_g IN_(8)
#define ln1_b IN_(9)
#define w_q IN_(10)
#define sub_keys IN_(11)
#define peer_u IN_(12)
#define peer_v IN_(13)
#define ln2_g IN_(14)
#define ln2_b IN_(15)
#define WinT ((bf16*)(ws + WS_WIN))
#define WaT ((bf16*)(ws + WS_WA))
#define WcT ((bf16*)(ws + WS_WC))
#define WoT ((bf16*)(ws + WS_WO))
#define WfT ((bf16*)(ws + WS_WF))
#define XB ((bf16*)(ws + WS_XB))
#define MERGED ((bf16*)(ws + WS_MERGED))
#define Z ((bf16*)(ws + WS_Z))
#define R2B ((bf16*)(ws + WS_R2B))
#define H1B ((bf16*)(ws + WS_H1B))
#define SC ((float*)(ws + WS_SC))
#define EX ((int*)(ws + WS_EX))
#define GT ((float*)(ws + WS_GT))
#define AO ((bf16*)(ws + WS_AO))
#define CI ((bf16*)(ws + WS_CI))
#define TMP ((bf16*)(ws + WS_TMP))
#define U8 ((unsigned char*)(ws + WS_U8))
#define V8 ((unsigned char*)(ws + WS_V8))
#define SU ((float*)(ws + WS_SU))
#define SV ((float*)(ws + WS_SV))
#define PA ((int*)(ws + WS_PA))
#define ST ((float*)(ws + WS_ST))
#define WB ((float*)(ws + WS_WB))
#define XQ ((signed char*)(ws + WS_XQ))
#define SX ((float*)(ws + WS_SX))
    for (int u = tid0; u < (LDS_BYTES - LDSCTL_OFF) / 4; u += NTHREADS) ((LAS unsigned*)(lds + LDSCTL_OFF))[u] = 0u;
    __syncthreads();
    XcdBarrier bar; bar.bar = (unsigned*)(ctl + CW_BAR); bar.x = 0; bar.st = nullptr;
    if (!MK_PER_PHASE) bar = xcd_barrier_post((unsigned*)(ctl + CW_BAR), MISC + 8);
    const int lo = args.ph_lo, hi = args.ph_hi;
#ifndef PH_MASK
#define PH_MASK 0xFFF
#endif
#define IN(k) (((PH_MASK >> (k)) & 1) && lo <= (k) && (k) < hi)
#ifndef DBL_BAR
#define DBL_BAR 0
#endif
#define SEAM(k) do { if (IN(k) && IN((k) + 1)) { xcd_barrier(bar); if (DBL_BAR) xcd_barrier(bar); } } while (0)
#ifndef DBL_MASK
#define DBL_MASK 0
#endif
#define REP(k) for (int rep_ = 0; rep_ < 1 + ((DBL_MASK >> (k)) & 1); ++rep_)
#define PHASE_TID() int tid = tid0; asm volatile("" : "+v"(tid)); const int lane = tid & 63, wave = __builtin_amdgcn_readfirstlane(tid >> 6); (void)lane; (void)wave

    if (IN(0)) REP(0) {
        PHASE_TID();
        const bool conv_first = ((bx >> 3) & 1) == 0;
#pragma unroll 1
        for (int part = 0; part < 2; ++part) {
            if ((part == 0) == conv_first) {
                int tid = tid0; asm volatile("" : "+v"(tid)); const int lane = tid & 63, wave = __builtin_amdgcn_readfirstlane(tid >> 6);
                LAS float* scr = (LAS float*)(lds + wave * 16384);
                const int gw = bx * NWAVES + wave, NGW = G * NWAVES;
                constexpr int I_IN = (D / 64) * (IN_W / 32), I_SQ = (D / 64) * (D / 32);
                for (int it = gw; it < I_IN + 3 * I_SQ; it += NGW) {
                    int r = it;
                    if (r < I_IN) { p0_transpose_item(w_in, D, IN_W, WinT, scr, r, lane); continue; } r -= I_IN;
                    if (r < I_SQ) { p0_transpose_item(w_ao, D, D, WaT, scr, r, lane); continue; } r -= I_SQ;
                    if (r < I_SQ) { p0_transpose_item(w_co, D, D, WcT, scr, r, lane); continue; } r -= I_SQ;
                    p0_transpose_item(w_o, D, D, WoT, scr, r, lane);
                }
                const size_t n8 = (size_t)M * D / 8;
                for (size_t i = (size_t)bx * NTHREADS + tid; i < n8; i += (size_t)G * NTHREADS) {
                    const f32x4 a = *((const GAS f32x4*)x_in + 2 * i), b = *((const GAS f32x4*)x_in + 2 * i + 1);
                    v4u o; o.x = pk2(a.x, a.y); o.y = pk2(a.z, a.w); o.z = pk2(b.x, b.y); o.w = pk2(b.z, b.w);
                    *((GAS v4u*)XB + i) = o;
                }
                __syncthreads();
            }
            if (part == 0) for (int it = bx; it < 16 * 32; it += G) p0_wf_item(w_q, sub_keys, WfT, lds, it, tid);
        }
    }
    SEAM(0);
    if (IN(1)) REP(1) {
        pg8::Gemm g{XB, WinT, M, IN_W, D}; ConvOrder S; S.init(M, IN_W, G, bx);
        S.pu = peer_u; S.pv = peer_v; S.u8 = U8; S.v8 = V8; S.su = SU; S.sv = SV; S.calls = 0;
        S.slot = (G == 256 && bx >= 64) ? bx - 64 : -1;
        pg8::EpiBf16 E{Z, IN_W};
        pg8::gemm_phase<pg8::EpiBf16, ConvOrder, true, true>(lds, g, S, E);
        if (G != 256) {
            PHASE_TID();
            for (int r = bx * NWAVES + wave; r < 2 * PNE; r += G * NWAVES) { const bool sec = r >= PNE; const int e = sec ? r - PNE : r;
                if (sec) row_to_fp8(peer_v + (size_t)e * D, V8 + (size_t)e * 256, SV + e, lane); else row_to_i8(peer_u + (size_t)e * D, U8 + (size_t)e * 256, SU + e, lane); }
        }
    }
    SEAM(1);
    if (IN(2)) REP(2) {
        PHASE_TID();
        const bool conv_first = ((bx >> 3) & 1) == 0;
#pragma unroll 1
        for (int part = 0; part < 2; ++part) {
            if ((part == 0) == conv_first) { int t2 = tid0; asm volatile("" : "+v"(t2)); for (int it = bx; it < M / 32; it += G) conv_item(it, Z, conv_w, CI, t2); }
            if (part == 0) for (int u = bx; u < BATCH * NKVH * 16; u += G) attn_unit(u, Z, AO, sinks, lds, tid);
        }
    }
    SEAM(2);
    if (IN(3)) REP(3) {
        pg8::StaticOrder S; S.init(M, D, G, bx);
        { pg8::Gemm g{AO, WaT, M, D, D}; pg8::EpiGate<0> E{TMP, nullptr, Z + G_OFF, b_gate, D, IN_W};
          pg8::gemm_phase<pg8::EpiGate<0>, pg8::StaticOrder, true, true>(lds, g, S, E); }
        { pg8::Gemm g{CI, WcT, M, D, D}; pg8::EpiGate<1> E{MERGED, TMP, Z + G_OFF + D, b_gate + D, D, IN_W};
          pg8::gemm_phase<pg8::EpiGate<1>, pg8::StaticOrder, true, true>(lds, g, S, E); }
    }
    SEAM(3);
    if (IN(4)) REP(4) {
        pg8::Gemm g{MERGED, WoT, M, D, D}; pg8::StaticOrder S; S.init(M, D, G, bx);
        pg8::EpiResBf16 E{H1B, D, x_in, ALPHA};
        pg8::gemm_phase<pg8::EpiResBf16, pg8::StaticOrder, true, true>(lds, g, S, E);
    }
    SEAM(4);
    if (IN(5)) REP(5) {
        PHASE_TID();
        const int gw = bx * NWAVES + wave, NGW = G * NWAVES;
        for (int m = gw; m < M; m += NGW) ln1_row(H1B + (size_t)m * D, XQ + (size_t)m * D, SX + m, ln1_g, ln1_b, lane);
    }
    SEAM(5);
    if (IN(6)) REP(6) {
        pg8::Gemm g{H1B, WfT, M, D, D}; pg8::StaticOrder S; S.init(M, D, G, bx);
        if (G == 256) { EpiTopK E{EX, GT}; pg8::gemm_phase<EpiTopK, pg8::StaticOrder, false, true>(lds, g, S, E); }
        else { pg8::EpiF32 E{SC, D, nullptr, 0.f}; pg8::gemm_phase<pg8::EpiF32, pg8::StaticOrder, true, true>(lds, g, S, E); }
    }
    if (G != 256) SEAM(6);
    if (IN(7)) REP(7) {
        PHASE_TID();
        if (G != 256) for (int p = bx; p < (M * PH) / 128; p += G) topk_pass(p, SC, EX, GT, lds, tid);
    }
    SEAM(7);
    if (IN(8)) REP(8) {
        PHASE_TID();
        const int xcc = (int)(xb_xcc_id() & 7u);
#pragma unroll 1
#ifndef SCRAMBLE
#define SCRAMBLE 0
#endif
        for (int sl = 0; sl < 8; ++sl) { const int s = (xcc + sl + (SCRAMBLE ? wave : 0)) & 7;
            for (;;) { const int tg = q_pull((unsigned*)(ctl + CW_Q + 64 * (s + 16 * rep_)), lane); if (tg >= PEER_NTASK) break;
                int t0, nt; peer_task_tokens(tg, t0, nt); peer_a_task(t0, nt, s, XQ, EX, U8, PA, lane); } }
    }
    SEAM(8);
    if (IN(9)) REP(9) {
        PHASE_TID();
        for (size_t i = (size_t)bx * NTHREADS + tid; i < (size_t)M * 128; i += (size_t)G * NTHREADS) peer_w_elem(i, EX, GT, SU, SV, SX, PA, WB);
    }
    SEAM(9);
    if (IN(10)) REP(10) {
        PHASE_TID();
        const int xcc = (int)(xb_xcc_id() & 7u);
#pragma unroll 1
#ifndef SCRAMBLE
#define SCRAMBLE 0
#endif
        for (int sl = 0; sl < 8; ++sl) { const int s = (xcc + sl + (SCRAMBLE ? wave : 0)) & 7;
            for (;;) { const int tg = q_pull((unsigned*)(ctl + CW_Q + 64 * (8 + s + 16 * rep_)), lane); if (tg >= PEER_NTASK) break;
                int t0, nt; peer_task_tokens(tg, t0, nt); peer_b_task(t0, nt, s, H1B, EX, WB, V8, R2B, ST, lane); } }
    }
    SEAM(10);
    if (IN(11)) REP(11) {
        PHASE_TID();
        const int gw = bx * NWAVES + wave, NGW = G * NWAVES;
        for (int t = gw; t < M; t += NGW) peer_c_row(t, R2B, args.out, ST, ln2_g, ln2_b, lane);
    }
#undef IN
#undef SEAM
}

extern "C" void kernel_launch(void* const* d_in, const int* in_sizes, int n_in, void* d_out, int out_size, void* d_ws, size_t ws_size, hipStream_t stream) {
    static int grid = 0;
    if (grid == 0) {
        if (n_in != 16 || out_size != M * D || ws_size < WS_END) { fprintf(stderr, "kernel_launch: unexpected shapes (n_in %d out %d ws %zu)\n", n_in, out_size, ws_size); grid = -1; return; }
        int dev = 0, cus = 0, per_cu = 0;
        if (hipGetDevice(&dev) != hipSuccess || hipDeviceGetAttribute(&cus, hipDeviceAttributeMultiprocessorCount, dev) != hipSuccess) { grid = -1; return; }
        if (hipFuncSetAttribute((const void*)mk_fwd, hipFuncAttributeMaxDynamicSharedMemorySize, LDS_BYTES) != hipSuccess) { fprintf(stderr, "kernel_launch: hipFuncSetAttribute failed\n"); grid = -1; return; }
        if (hipOccupancyMaxActiveBlocksPerMultiprocessor(&per_cu, (const void*)mk_fwd, NTHREADS, LDS_BYTES) != hipSuccess || per_cu < 1) { fprintf(stderr, "kernel_launch: occupancy query says %d\n", per_cu); per_cu = 1; }
        (void)hipGetLastError();
        if (per_cu > 1) per_cu = 1;
        grid = cus * per_cu;
    }
    if (grid < 0) return;
    if (hipMemsetAsync((char*)d_ws + WS_CTL, 0, CTL_ZERO_BYTES, stream) != hipSuccess) { fprintf(stderr, "kernel_launch: memset failed\n"); return; }
    Args a{};
    for (int i = 0; i < 16; ++i) a.in[i] = (const float*)d_in[i];
    a.out = (float*)d_out; a.ws = (unsigned char*)d_ws;
#if MK_PER_PHASE
    for (int p = 0; p < N_PHASES; ++p) { a.ph_lo = p; a.ph_hi = p + 1; hipLaunchKernelGGL(mk_fwd, dim3(grid), dim3(NTHREADS), LDS_BYTES, stream, a); }
#else
    a.ph_lo = 0; a.ph_hi = N_PHASES;
    void* kargs[] = {&a};
#ifdef PLAIN_LAUNCH
    (void)kargs; hipLaunchKernelGGL(mk_fwd, dim3(grid), dim3(NTHREADS), LDS_BYTES, stream, a); hipError_t e = hipPeekAtLastError();
#else
    hipError_t e = hipLaunchCooperativeKernel((const void*)mk_fwd, dim3(grid), dim3(NTHREADS), kargs, LDS_BYTES, stream);
#endif
    if (e != hipSuccess) fprintf(stderr, "kernel_launch: cooperative launch failed: %s (grid %d)\n", hipGetErrorString(e), grid);
#endif
}
```

```cpp
#include <hip/hip_runtime.h>
#include <cstdio>
#include <cstdint>
#include <type_traits>
namespace pg8 {
#define PG8_LAS __attribute__((address_space(3)))
typedef unsigned short bf16_t;
typedef short bf16x8 __attribute__((ext_vector_type(8)));
typedef float f32x4 __attribute__((ext_vector_type(4)));
typedef unsigned u32x4 __attribute__((ext_vector_type(4)));
constexpr int BM = 256, BK = 64, HALF = 128, HTB = HALF * BK * 2  , STAGE_BYTES = 8 * HTB, NXCD = 8, WGM = 8;

__host__ __device__ __forceinline__ int lds_byte(int r, int c) { const int st = (r >> 4) * 2 + (c >> 5), rr = r & 15, cc = c & 31, ob = rr * 64 + cc * 2; return st * 1024 + (ob ^ (((ob >> 9) & 1) << 5)); }
__host__ __device__ __forceinline__ void stage_rc(int b, int& R, int& C) { const int st = b / 1024, sb = b % 1024, swz = sb ^ (((sb >> 9) & 1) << 5); R = (st >> 1) * 16 + swz / 64; C = (st & 1) * 32 + (swz % 64) / 2; }
__host__ __device__ __forceinline__ int perm32(int rho) { const int n = rho >> 4, i = rho & 15; return 8 * (i >> 2) + 4 * n + (i & 3); }

struct Unit { int pm, pn; };
struct Gemm { const bf16_t* A; const bf16_t* Bt; int M, N, K; };

struct StaticOrder {
    int nM, nN, nwg, G, c;
    __host__ __device__ void init(int M, int N, int G_, int c_) { nM = M / BM; nN = N / BM; nwg = nM * nN; G = G_; c = c_; }
    __host__ __device__ bool next(int i, Unit& u) const {
        const long L = (long)i * G + c; if (L >= nwg) return false;
        int wgid = (int)L; { const int q = nwg / NXCD, r = nwg % NXCD, xcd = wgid % NXCD, off = wgid / NXCD; wgid = (xcd < r ? xcd * (q + 1) : r * (q + 1) + (xcd - r) * q) + off; }
        const int nig = WGM * nN, gid = wgid / nig, fm = gid * WGM, gsz = (nM - fm) < WGM ? (nM - fm) : WGM;
        u.pm = fm + ((wgid % nig) % gsz); u.pn = (wgid % nig) / gsz; return true;
    }
    __device__ __forceinline__ void a_ready(const Unit&) const {}
    __device__ __forceinline__ void done(const Unit&) const {}
};


__device__ __forceinline__ unsigned cvt_pk_bf16(float lo, float hi) { unsigned r; asm volatile("v_cvt_pk_bf16_f32 %0, %1, %2" : "=v"(r) : "v"(lo), "v"(hi)); return r; }
__device__ __forceinline__ float bf_lo(unsigned w) { return __builtin_bit_cast(float, w << 16); }
__device__ __forceinline__ float bf_hi(unsigned w) { return __builtin_bit_cast(float, w & 0xffff0000u); }
__device__ __forceinline__ float sigmoidf_(float x) { return __builtin_amdgcn_rcpf(1.0f + __expf(-x)); }

struct EpiBf16 {
    static constexpr bool PERM = true, AFTER_DRAIN = false;
    bf16_t* O; int ldc;
    __device__ __forceinline__ void operator()(const f32x4 (&acc)[2][2][4][2], const Unit& u, int wr, int wc, int fr, int fq) const {
        const int row0 = u.pm * BM + wr * 64 + fr, col0 = u.pn * BM + wc * 32 + 8 * fq;
#pragma unroll
        for (int ai = 0; ai < 2; ++ai)
#pragma unroll
            for (int m = 0; m < 4; ++m) { bf16_t* rowp = O + (size_t)(row0 + ai * HALF + m * 16) * ldc + col0;
#pragma unroll
                for (int bj = 0; bj < 2; ++bj) { const f32x4 v0 = acc[ai][bj][m][0], v1 = acc[ai][bj][m][1];
                    u32x4 w; w.x = cvt_pk_bf16(v0[0], v0[1]); w.y = cvt_pk_bf16(v0[2], v0[3]); w.z = cvt_pk_bf16(v1[0], v1[1]); w.w = cvt_pk_bf16(v1[2], v1[3]);
                    *(u32x4*)(rowp + bj * HALF) = w; } }
    }
};
template <int SECOND> struct EpiGate {
    static constexpr bool PERM = true, AFTER_DRAIN = false;
    bf16_t* O; const bf16_t* T; const bf16_t* Zg; const float* bg; int ldc, ldz;
    __device__ __forceinline__ void operator()(const f32x4 (&acc)[2][2][4][2], const Unit& u, int wr, int wc, int fr, int fq) const {
        const int row0 = u.pm * BM + wr * 64 + fr, col0 = u.pn * BM + wc * 32 + 8 * fq;
        f32x4 bv[2][2];
#pragma unroll
        for (int bj = 0; bj < 2; ++bj)
#pragma unroll
            for (int n = 0; n < 2; ++n) bv[bj][n] = *(const f32x4*)(bg + col0 + bj * HALF + 4 * n);
#pragma unroll
        for (int ai = 0; ai < 2; ++ai)
#pragma unroll
            for (int m = 0; m < 4; ++m) { const size_t row = (size_t)(row0 + ai * HALF + m * 16);
#pragma unroll
                for (int bj = 0; bj < 2; ++bj) { const int c = col0 + bj * HALF;
                    const u32x4 zg = *(const u32x4*)(Zg + row * ldz + c);
                    f32x4 v0 = acc[ai][bj][m][0], v1 = acc[ai][bj][m][1];
                    v0[0] *= sigmoidf_(bf_lo(zg.x) + bv[bj][0][0]); v0[1] *= sigmoidf_(bf_hi(zg.x) + bv[bj][0][1]);
                    v0[2] *= sigmoidf_(bf_lo(zg.y) + bv[bj][0][2]); v0[3] *= sigmoidf_(bf_hi(zg.y) + bv[bj][0][3]);
                    v1[0] *= sigmoidf_(bf_lo(zg.z) + bv[bj][1][0]); v1[1] *= sigmoidf_(bf_hi(zg.z) + bv[bj][1][1]);
                    v1[2] *= sigmoidf_(bf_lo(zg.w) + bv[bj][1][2]); v1[3] *= sigmoidf_(bf_hi(zg.w) + bv[bj][1][3]);
                    if (SECOND) { const u32x4 t = *(const u32x4*)(T + row * ldc + c);
                        v0[0] += bf_lo(t.x); v0[1] += bf_hi(t.x); v0[2] += bf_lo(t.y); v0[3] += bf_hi(t.y);
                        v1[0] += bf_lo(t.z); v1[1] += bf_hi(t.z); v1[2] += bf_lo(t.w); v1[3] += bf_hi(t.w); }
                    u32x4 w; w.x = cvt_pk_bf16(v0[0], v0[1]); w.y = cvt_pk_bf16(v0[2], v0[3]); w.z = cvt_pk_bf16(v1[0], v1[1]); w.w = cvt_pk_bf16(v1[2], v1[3]);
                    *(u32x4*)(O + row * ldc + c) = w; } }
    }
};
struct EpiF32 {
    static constexpr bool PERM = false, AFTER_DRAIN = false;
    float* C; int ldc; const float* R; float scale;
    __device__ __forceinline__ void operator()(const f32x4 (&acc)[2][2][4][2], const Unit& u, int wr, int wc, int fr, int fq) const {
        const int row0 = u.pm * BM + wr * 64 + fr, col0 = u.pn * BM + wc * 32 + 4 * fq;
#pragma unroll
        for (int ai = 0; ai < 2; ++ai)
#pragma unroll
            for (int m = 0; m < 4; ++m) { const size_t off = (size_t)(row0 + ai * HALF + m * 16) * ldc + col0;
#pragma unroll
                for (int bj = 0; bj < 2; ++bj)
#pragma unroll
                    for (int n = 0; n < 2; ++n) { f32x4 v = acc[ai][bj][m][n];
                        if (R) v += *(const f32x4*)(R + off + bj * HALF + n * 16) * scale;
                        *(f32x4*)(C + off + bj * HALF + n * 16) = v; } }
    }
};
struct EpiResBf16 {
    static constexpr bool PERM = true, AFTER_DRAIN = false;
    bf16_t* O; int ldc; const float* R; float scale;
    __device__ __forceinline__ void operator()(const f32x4 (&acc)[2][2][4][2], const Unit& u, int wr, int wc, int fr, int fq) const {
        const int row0 = u.pm * BM + wr * 64 + fr, col0 = u.pn * BM + wc * 32 + 8 * fq;
#pragma unroll
        for (int ai = 0; ai < 2; ++ai)
#pragma unroll
            for (int m = 0; m < 4; ++m) { const size_t off = (size_t)(row0 + ai * HALF + m * 16) * ldc + col0;
#pragma unroll
                for (int bj = 0; bj < 2; ++bj) { const f32x4 r0 = *(const f32x4*)(R + off + bj * HALF), r1 = *(const f32x4*)(R + off + bj * HALF + 4);
                    const f32x4 v0 = acc[ai][bj][m][0] + r0 * scale, v1 = acc[ai][bj][m][1] + r1 * scale;
                    u32x4 w; w.x = cvt_pk_bf16(v0[0], v0[1]); w.y = cvt_pk_bf16(v0[2], v0[3]); w.z = cvt_pk_bf16(v1[0], v1[1]); w.w = cvt_pk_bf16(v1[2], v1[3]);
                    *(u32x4*)(O + off + bj * HALF) = w; } }
    }
};
typedef int i32x4e __attribute__((ext_vector_type(4)));
struct EpiI8Bf16 {
    static constexpr bool PERM = true, AFTER_DRAIN = false;
    bf16_t* O; int ldc; const float* sa; const float* sb;
    __device__ __forceinline__ void operator()(const i32x4e (&acc)[2][2][4][2], const Unit& u, int wr, int wc, int fr, int fq) const {
        const int row0 = u.pm * BM + wr * 64 + fr, col0 = u.pn * BM + wc * 32 + 8 * fq;
        f32x4 sbv[2][2];
#pragma unroll
        for (int bj = 0; bj < 2; ++bj)
#pragma unroll
            for (int n = 0; n < 2; ++n) sbv[bj][n] = *(const f32x4*)(sb + col0 + bj * HALF + 4 * n);
#pragma unroll
        for (int ai = 0; ai < 2; ++ai)
#pragma unroll
            for (int m = 0; m < 4; ++m) { const int row = row0 + ai * HALF + m * 16; const float sr = sa[row]; bf16_t* rowp = O + (size_t)row * ldc + col0;
#pragma unroll
                for (int bj = 0; bj < 2; ++bj) { const i32x4e a0 = acc[ai][bj][m][0], a1 = acc[ai][bj][m][1];
                    const f32x4 v0 = (f32x4){(float)a0[0], (float)a0[1], (float)a0[2], (float)a0[3]} * sbv[bj][0] * sr, v1 = (f32x4){(float)a1[0], (float)a1[1], (float)a1[2], (float)a1[3]} * sbv[bj][1] * sr;
                    u32x4 w; w.x = cvt_pk_bf16(v0[0], v0[1]); w.y = cvt_pk_bf16(v0[2], v0[3]); w.z = cvt_pk_bf16(v1[0], v1[1]); w.w = cvt_pk_bf16(v1[2], v1[3]);
                    *(u32x4*)(rowp + bj * HALF) = w; } }
    }
};

typedef int i32x4 __attribute__((ext_vector_type(4)));
template <class Epi, class Sched, bool ALIGN_EPI = false, bool SP2 = false, bool I8 = false>
__device__ __forceinline__ void gemm_phase(PG8_LAS unsigned char* lds, const Gemm g, const Sched& S, const Epi& E) {
    int tid_ = threadIdx.x; asm volatile("" : "+v"(tid_));
    const int tid = tid_, wid = __builtin_amdgcn_readfirstlane(tid >> 6), lane = tid & 63, wr = wid >> 2, wc = wid & 3, fr = lane & 15, fq = lane >> 4;
    const int K = g.K, nt = K / BK;
    unsigned voffA[2], voffB[2];
#pragma unroll
    for (int i = 0; i < 2; ++i) { int R, C; stage_rc(tid * 16 + i * 8192, R, C); const int Rb = Epi::PERM ? ((R & ~31) + perm32(R & 31)) : R;
        voffA[i] = (unsigned)(R * K + C) * 2u; voffB[i] = (unsigned)(Rb * K + C) * 2u; }
    const size_t kstep = (size_t)(BK * 2);
    const size_t hstep = (size_t)HALF * K * 2;
    const size_t tstep = 2 * hstep;
    const unsigned ldsw = (unsigned)wid * 1024u;
    const int aoff = lds_byte(wr * 64 + fr, fq * 8), boff = lds_byte(wc * 32 + fr, fq * 8);
#define PG8_SA(b, h) (((b) * 2 + (h)) * HTB)
#define PG8_SB(b, h) ((4 + (b) * 2 + (h)) * HTB)
#define PG8_STAGE(bufoff, gbase, voff) do { _Pragma("unroll") for (int _i = 0; _i < 2; ++_i) \
        __builtin_amdgcn_global_load_lds((const unsigned*)((const char*)(gbase) + (voff)[_i]), (PG8_LAS unsigned*)(lds + (bufoff) + ldsw + _i * 8192), 16, 0, 0); } while (0)
#define PG8_LDA(dst, b, h) do { _Pragma("unroll") for (int m = 0; m < 4; ++m) _Pragma("unroll") for (int k = 0; k < 2; ++k) dst[m][k] = *(const PG8_LAS bf16x8*)(lds + PG8_SA(b, h) + aoff + m * 2048 + k * 1024); } while (0)
#define PG8_LDB(dst, b, h) do { _Pragma("unroll") for (int n = 0; n < 2; ++n) _Pragma("unroll") for (int k = 0; k < 2; ++k) dst[n][k] = *(const PG8_LAS bf16x8*)(lds + PG8_SB(b, h) + boff + n * 2048 + k * 1024); } while (0)
#define PG8_MMA(ai, bj, At, Bt) do { __builtin_amdgcn_s_setprio(1); _Pragma("unroll") for (int m = 0; m < 4; ++m) _Pragma("unroll") for (int n = 0; n < 2; ++n) _Pragma("unroll") for (int k = 0; k < 2; ++k) \
        { if constexpr (I8) acc[ai][bj][m][n] = __builtin_bit_cast(acc_t, __builtin_amdgcn_mfma_i32_16x16x64_i8(__builtin_bit_cast(i32x4, Bt[n][k]), __builtin_bit_cast(i32x4, At[m][k]), __builtin_bit_cast(i32x4, acc[ai][bj][m][n]), 0, 0, 0)); \
          else acc[ai][bj][m][n] = __builtin_bit_cast(acc_t, __builtin_amdgcn_mfma_f32_16x16x32_bf16(Bt[n][k], At[m][k], __builtin_bit_cast(f32x4, acc[ai][bj][m][n]), 0, 0, 0)); } __builtin_amdgcn_s_setprio(0); } while (0)
#define PG8_WAIT_V(n) asm volatile("s_waitcnt vmcnt(" #n ")" ::: "memory")
#define PG8_WAIT_L(n) asm volatile("s_waitcnt lgkmcnt(" #n ")" ::: "memory")
#define PG8_BAR __builtin_amdgcn_s_barrier()
#define PG8_SCHED __builtin_amdgcn_sched_barrier(0)
    Unit cur, nxt; int ui = 0;
    if (!S.next(0, cur)) return;
    typedef typename std::conditional<I8, i32x4, f32x4>::type acc_t;
    acc_t acc[2][2][4][2];
#pragma unroll
    for (int a = 0; a < 2; ++a)
#pragma unroll
        for (int b = 0; b < 2; ++b)
#pragma unroll
            for (int m = 0; m < 4; ++m)
#pragma unroll
                for (int n = 0; n < 2; ++n) acc[a][b][m][n] = acc_t{};
    bf16x8 At[4][2], B0[2][2], B1[2][2];
    const char* cA = (const char*)g.A + (size_t)cur.pm * tstep; const char* cB = (const char*)g.Bt + (size_t)cur.pn * tstep;
    S.a_ready(cur);
    if constexpr (SP2) {
        PG8_STAGE(PG8_SB(0, 0), cB, voffB); PG8_STAGE(PG8_SB(0, 1), cB + hstep, voffB); PG8_STAGE(PG8_SA(0, 0), cA, voffA); PG8_STAGE(PG8_SA(0, 1), cA + hstep, voffA);
        if (wr == 1) PG8_BAR;
        PG8_WAIT_V(2); PG8_BAR;
        PG8_STAGE(PG8_SB(1, 0), cB + kstep, voffB); PG8_STAGE(PG8_SA(1, 0), cA + kstep, voffA); PG8_STAGE(PG8_SB(1, 1), cB + hstep + kstep, voffB);
        PG8_WAIT_V(6); PG8_BAR;
    } else {
        PG8_STAGE(PG8_SB(0, 0), cB, voffB); PG8_STAGE(PG8_SA(0, 0), cA, voffA); PG8_STAGE(PG8_SB(0, 1), cB + hstep, voffB); PG8_STAGE(PG8_SA(0, 1), cA + hstep, voffA);
        if (wr == 1) PG8_BAR;
        PG8_WAIT_V(4); PG8_BAR;
        PG8_STAGE(PG8_SB(1, 0), cB + kstep, voffB); PG8_STAGE(PG8_SA(1, 0), cA + kstep, voffA); PG8_STAGE(PG8_SB(1, 1), cB + hstep + kstep, voffB);
        PG8_WAIT_V(6); PG8_BAR;
    }
    for (;;) {
        const bool has_next = S.next(ui + 1, nxt);
        const char* nA = has_next ? (const char*)g.A + (size_t)nxt.pm * tstep : cA; const char* nB = has_next ? (const char*)g.Bt + (size_t)nxt.pn * tstep : cB;
        for (int t = 0; t < nt; t += 2) {
            const bool last = (t == nt - 2);
            const char* a1 = cA + (size_t)(t + 1) * kstep;
            const char* a2 = last ? nA : cA + (size_t)(t + 2) * kstep; const char* b2 = last ? nB : cB + (size_t)(t + 2) * kstep;
            const char* a3 = a2 + kstep; const char* b3 = b2 + kstep;
            if (last && has_next) S.a_ready(nxt);
            if constexpr (SP2) {
            PG8_LDB(B0, 0, 0); PG8_LDB(B1, 0, 1); PG8_SCHED; PG8_LDA(At, 0, 0); PG8_STAGE(PG8_SA(1, 1), a1 + hstep, voffA);
            PG8_WAIT_V(8); PG8_WAIT_L(0); PG8_BAR; PG8_MMA(0, 0, At, B0); PG8_MMA(0, 1, At, B1); PG8_BAR; PG8_SCHED;
            PG8_LDA(At, 0, 1); PG8_STAGE(PG8_SB(0, 0), b2, voffB); PG8_STAGE(PG8_SB(0, 1), b2 + hstep, voffB); PG8_STAGE(PG8_SA(0, 0), a2, voffA);
            PG8_WAIT_V(8); PG8_WAIT_L(0); PG8_BAR; PG8_MMA(1, 0, At, B0); PG8_MMA(1, 1, At, B1); PG8_BAR; PG8_SCHED;
            PG8_LDB(B0, 1, 0); PG8_LDB(B1, 1, 1); PG8_SCHED; PG8_LDA(At, 1, 0); PG8_STAGE(PG8_SA(0, 1), a2 + hstep, voffA);
            PG8_WAIT_V(8); PG8_WAIT_L(0); PG8_BAR; PG8_MMA(0, 0, At, B0); PG8_MMA(0, 1, At, B1); PG8_BAR; PG8_SCHED;
            PG8_LDA(At, 1, 1); PG8_STAGE(PG8_SB(1, 0), b3, voffB); PG8_STAGE(PG8_SB(1, 1), b3 + hstep, voffB); PG8_STAGE(PG8_SA(1, 0), a3, voffA);
            PG8_WAIT_V(8); PG8_WAIT_L(0); PG8_BAR; PG8_MMA(1, 0, At, B0); PG8_MMA(1, 1, At, B1); PG8_BAR; PG8_SCHED;
            } else {
            PG8_LDB(B0, 0, 0); PG8_SCHED; PG8_LDA(At, 0, 0); PG8_STAGE(PG8_SA(1, 1), a1 + hstep, voffA);
            PG8_WAIT_L(8); PG8_BAR; PG8_WAIT_L(0); PG8_MMA(0, 0, At, B0); PG8_BAR; PG8_SCHED;
            PG8_LDB(B1, 0, 1); PG8_STAGE(PG8_SB(0, 0), b2, voffB);
            PG8_BAR; PG8_WAIT_L(0); PG8_MMA(0, 1, At, B1); PG8_BAR;
            PG8_LDA(At, 0, 1); PG8_STAGE(PG8_SA(0, 0), a2, voffA);
            PG8_BAR; PG8_WAIT_L(0); PG8_MMA(1, 0, At, B0); PG8_BAR; PG8_SCHED;
            PG8_STAGE(PG8_SB(0, 1), b2 + hstep, voffB);
            PG8_WAIT_V(6); PG8_BAR; PG8_MMA(1, 1, At, B1); PG8_BAR;
            PG8_LDB(B0, 1, 0); PG8_SCHED; PG8_LDA(At, 1, 0); PG8_STAGE(PG8_SA(0, 1), a2 + hstep, voffA);
            PG8_WAIT_L(8); PG8_BAR; PG8_WAIT_L(0); PG8_MMA(0, 0, At, B0); PG8_BAR; PG8_SCHED;
            PG8_LDB(B1, 1, 1); PG8_STAGE(PG8_SB(1, 0), b3, voffB);
            PG8_BAR; PG8_WAIT_L(0); PG8_MMA(0, 1, At, B1); PG8_BAR;
            PG8_LDA(At, 1, 1); PG8_STAGE(PG8_SA(1, 0), a3, voffA);
            PG8_BAR; PG8_WAIT_L(0); PG8_MMA(1, 0, At, B0); PG8_BAR; PG8_SCHED;
            PG8_STAGE(PG8_SB(1, 1), b3 + hstep, voffB);
            PG8_WAIT_V(6); PG8_BAR; PG8_MMA(1, 1, At, B1); PG8_BAR;
            }
        }
        if constexpr (ALIGN_EPI) { if (wr == 0) PG8_BAR; }
        if constexpr (!Epi::AFTER_DRAIN) { E(acc, cur, wr, wc, fr, fq); S.done(cur); }
        if (!has_next) break;
#pragma unroll
        for (int a = 0; a < 2; ++a)
#pragma unroll
            for (int b = 0; b < 2; ++b)
#pragma unroll
                for (int m = 0; m < 4; ++m)
#pragma unroll
                    for (int n = 0; n < 2; ++n) acc[a][b][m][n] = acc_t{};
        cur = nxt; cA = nA; cB = nB; ++ui;
        if constexpr (ALIGN_EPI) { if (wr == 1) PG8_BAR; }
    }
    PG8_WAIT_V(0);
    if constexpr (!ALIGN_EPI) { if (wr == 0) PG8_BAR; }
    PG8_BAR;
    if constexpr (Epi::AFTER_DRAIN) { E.fused(acc, cur, wr, wc, fr, fq, lds, wid, lane); S.done(cur); }
#undef PG8_SA
#undef PG8_SB
#undef PG8_STAGE
#undef PG8_LDA
#undef PG8_LDB
#undef PG8_MMA
#undef PG8_WAIT_V
#undef PG8_WAIT_L
#undef PG8_BAR
#undef PG8_SCHED
}
}
#define GAS __attribute__((address_space(1)))
#define LAS __attribute__((address_space(3)))
typedef unsigned short bf16;
typedef unsigned v4u __attribute__((ext_vector_type(4)));
typedef float f32x4 __attribute__((ext_vector_type(4)));
typedef short bf16x8 __attribute__((ext_vector_type(8)));
typedef GAS unsigned gu32;
typedef GAS unsigned long long gu64;
#define RLX_AGENT __ATOMIC_RELAXED, __HIP_MEMORY_SCOPE_AGENT
#define LDS_WAIT() asm volatile("s_waitcnt lgkmcnt(0)" ::: "memory")
#define VM_WAIT() asm volatile("s_waitcnt vmcnt(0)" ::: "memory")
__device__ __forceinline__ unsigned long long rt() { return __builtin_amdgcn_s_memrealtime(); }
__device__ __forceinline__ unsigned f2bf(float f) { unsigned u = __builtin_bit_cast(unsigned, f); return (u + 0x7fffu + ((u >> 16) & 1u)) >> 16; }
__device__ __forceinline__ unsigned pk2(float lo, float hi) { return f2bf(lo) | (f2bf(hi) << 16); }

#define XB_TMO      128
#define XB_XCNT(j)  (256  + 64 * (j))
#define XB_XSUB(j)  (1280 + 64 * (j))
#define XB_XGEN(j)  (2304 + 64 * (j))
#define XB_TOP      3328
#define XB_TOPGEN   3392
#define XCD_BAR_WORDS 3456
#define XB_SPIN_CAP (1u << 18)

__device__ __forceinline__ unsigned xb_ld(unsigned* p)              { return __hip_atomic_load(p, __ATOMIC_RELAXED, __HIP_MEMORY_SCOPE_AGENT); }
__device__ __forceinline__ unsigned xb_add(unsigned* p, unsigned v) { return __hip_atomic_fetch_add(p, v, __ATOMIC_RELAXED, __HIP_MEMORY_SCOPE_AGENT); }
__device__ __forceinline__ unsigned xb_xcc_id() { return (unsigned)__builtin_amdgcn_s_getreg((3 << 11) | 20) & 0xFu; }
#define XB_SPIN(cond, bar) do { unsigned _sp = 0; while (cond) { __builtin_amdgcn_s_sleep(1); \
    if ((++_sp & 255u) == 0u) { if (xb_ld(&(bar)[XB_TMO])) break; if (_sp > XB_SPIN_CAP) { atomicAdd(&(bar)[XB_TMO], 1u); break; } } } } while (0)

struct XcdBarrier {
    unsigned* bar; unsigned x;
    volatile LAS unsigned* st;
};

__device__ __forceinline__ XcdBarrier xcd_barrier_post(unsigned* bar, volatile LAS unsigned* st) {
    XcdBarrier b; b.bar = bar; b.x = xb_xcc_id(); b.st = st;
    if (threadIdx.x == 0) (void)xb_add(&bar[XB_XCNT(b.x)], 1u);
    return b;
}
__device__ __forceinline__ void xcd_barrier_complete(unsigned* bar, unsigned x, unsigned& nloc, unsigned& nx) {
    const unsigned G = gridDim.x * gridDim.y * gridDim.z;
    unsigned sum, cnt, mine, sp = 0u;
    for (;;) {
        sum = 0u; cnt = 0u; mine = 0u;
#pragma unroll
        for (unsigned j = 0; j < 16; ++j) { const unsigned c = xb_ld(&bar[XB_XCNT(j)]); sum += c; cnt += (c > 0u) ? 1u : 0u; mine = (j == x) ? c : mine; }
        if (sum == G) break;
        __builtin_amdgcn_s_sleep(1);
        if ((++sp & 255u) == 0u) { if (xb_ld(&bar[XB_TMO])) break; if (sp > XB_SPIN_CAP) { atomicAdd(&bar[XB_TMO], 1u); break; } }
    }
    nloc = mine > 0u ? mine : 1u; nx = cnt > 0u ? cnt : 1u;
}

__device__ __forceinline__ void xcd_barrier(const XcdBarrier& b) {
    asm volatile("s_waitcnt vmcnt(0)" ::: "memory");
    __syncthreads();
    if (threadIdx.x == 0) {
        unsigned* bar = b.bar;
        __builtin_amdgcn_s_waitcnt(0);
        unsigned nloc = b.st[0], nx = b.st[1];
        if (nloc == 0u) { xcd_barrier_complete(bar, b.x, nloc, nx); b.st[0] = nloc; b.st[1] = nx; }
        const unsigned old = xb_add(&bar[XB_XSUB(b.x)], 1u);
        const unsigned gen = old / nloc;
        if (old + 1u == (gen + 1u) * nloc) {
            __builtin_amdgcn_fence(__ATOMIC_RELEASE, "agent");
            asm volatile("s_waitcnt vmcnt(0)" ::: "memory");
            const unsigned og = xb_add(&bar[XB_TOP], 1u);
            const unsigned tg = og / nx;
            if (og + 1u == (tg + 1u) * nx) xb_add(&bar[XB_TOPGEN], 1u);
            else XB_SPIN(xb_ld(&bar[XB_TOPGEN]) == tg, bar);
            __builtin_amdgcn_fence(__ATOMIC_ACQUIRE, "agent");
            xb_add(&bar[XB_XGEN(b.x)], 1u);
            asm volatile("s_waitcnt vmcnt(0)" ::: "memory");
        } else {
            XB_SPIN(xb_ld(&bar[XB_XGEN(b.x)]) == gen, bar);
            __builtin_amdgcn_fence(__ATOMIC_ACQUIRE, "agent");
            asm volatile("s_waitcnt vmcnt(0)" ::: "memory");
        }
    }
    __syncthreads();
}

constexpr int NWAVES = 8, NTHREADS = 512;
constexpr int BATCH = 4, SEQ = 2048, D = 2048, M = BATCH * SEQ;
constexpr int NQH = 32, NKVH = 4, HD = 64, QPKV = 8, WINDOW = 128;
constexpr int Q_OFF = 0, K_OFF = 2048, V_OFF = 2304, CB_OFF = 2560, CC_OFF = 4608, CH_OFF = 6656, G_OFF = 8704, IN_W = 12800;
constexpr int PH = 8, PNK = 128, PTOPK = 16, PNE = 16384;
constexpr float LN_EPS = 1e-5f;
constexpr float ALPHA = 1.189207115002721f;

#ifndef MK_PER_PHASE
#define MK_PER_PHASE 0
#endif
constexpr int N_PHASES = 12;

constexpr size_t MiB = 1u << 20;
constexpr size_t WS_CTL = 0, CTL_ZERO_BYTES = 1 * MiB;
constexpr size_t WS_WIN = 1 * MiB;
constexpr size_t WS_WA = 51 * MiB, WS_WC = 59 * MiB, WS_WO = 67 * MiB, WS_WF = 75 * MiB;
constexpr size_t WS_XB = 83 * MiB;
constexpr size_t WS_MERGED = WS_XB;
constexpr size_t WS_Z = 115 * MiB;
constexpr size_t WS_R2B = 115 * MiB;
constexpr size_t WS_H1B = 179 * MiB;
constexpr size_t WS_SC = 211 * MiB;
constexpr size_t WS_EX = 275 * MiB;
constexpr size_t WS_GT = 279 * MiB;
constexpr size_t WS_AO = 315 * MiB, WS_CI = 347 * MiB, WS_TMP = 379 * MiB;
constexpr size_t WS_U8 = 411 * MiB, WS_V8 = 443 * MiB;
constexpr size_t WS_SU = 475 * MiB, WS_SV = WS_SU + 65536;
constexpr size_t WS_PA = WS_SC;
constexpr size_t WS_XQ = 283 * MiB;
constexpr size_t WS_SX = 299 * MiB;
constexpr size_t WS_WB = 380 * MiB;
constexpr size_t WS_ST = 379 * MiB;
constexpr size_t WS_XA8 = WS_XB;
constexpr size_t WS_WIN8 = 476 * MiB;
constexpr size_t WS_SWIN = 501 * MiB, WS_SXA = WS_SWIN + 65536;
constexpr size_t WS_END = 502 * MiB;
constexpr int CW_Q = 12288;
constexpr size_t SLICE_BYTES = (size_t)PNE * 256;
constexpr int CW_BAR = 4096;

constexpr int RING_BYTES = 131072;
constexpr int LDSCTL_OFF = 147456, MISC_OFF = LDSCTL_OFF + 320;
constexpr int LDS_BYTES = LDSCTL_OFF + 512;

typedef float f32x16 __attribute__((ext_vector_type(16)));
typedef unsigned v2u __attribute__((ext_vector_type(2)));
__device__ __forceinline__ float wave_sum(float v) {
#pragma unroll
    for (int o = 1; o < 64; o <<= 1) v += __shfl_xor(v, o);
    return v;
}
__device__ __forceinline__ float vmaxf(float a, float b) { float r; asm("v_max_f32_e32 %0, %1, %2" : "=v"(r) : "v"(a), "v"(b)); return r; }
__device__ __forceinline__ float vminf(float a, float b) { float r; asm("v_min_f32_e32 %0, %1, %2" : "=v"(r) : "v"(a), "v"(b)); return r; }

__device__ __forceinline__ void p0_transpose_item(const float* W, int K, int N, bf16* WT, LAS float* scr, int item, int lane) {
    const int nblk = N / 32, kb = item / nblk, nb = item % nblk, k0 = 64 * kb, n0 = 32 * nb;
#pragma unroll 8
    for (int i = 0; i < 32; ++i) { const int kk = 2 * i + (lane >> 5); scr[kk * 33 + (lane & 31)] = W[(size_t)(k0 + kk) * N + n0 + (lane & 31)]; }
    LDS_WAIT(); asm volatile("" ::: "memory");
    const int c = lane & 7;
#pragma unroll
    for (int j = 0; j < 4; ++j) { const int n = (lane >> 3) + 8 * j; const LAS float* s = scr + (8 * c) * 33 + n;
        v4u o; o.x = pk2(s[0 * 33], s[1 * 33]); o.y = pk2(s[2 * 33], s[3 * 33]); o.z = pk2(s[4 * 33], s[5 * 33]); o.w = pk2(s[6 * 33], s[7 * 33]);
        *(GAS v4u*)(WT + (size_t)(n0 + n) * K + k0 + 8 * c) = o; }
    LDS_WAIT(); asm volatile("" ::: "memory");
}
__device__ __forceinline__ void p0_wf_item(const float* wq, const float* sk, bf16* WfT, LAS unsigned char* lds, int item, int tid) {
    const int hp = item >> 5, dt = item & 31;
    LAS f32x4* SK4 = (LAS f32x4*)lds;
    LAS f32x4* WQ4 = SK4 + 128 * 33;
    const float* skp = sk + (size_t)hp * 128 * 128;
    for (int i = tid; i < 128 * 32; i += NTHREADS) { const int n = i >> 5, c4 = i & 31; SK4[n * 33 + c4] = *(const f32x4*)(skp + n * 128 + 4 * c4); }
    for (int i = tid; i < 64 * 32; i += NTHREADS) { const int r = i >> 5, c4 = i & 31; WQ4[r * 33 + c4] = *(const f32x4*)(wq + (size_t)(64 * dt + r) * 2048 + hp * 128 + 4 * c4); }
    __syncthreads();
    const int td = tid & 15, tn = tid >> 4;
    float acc[4][4];
#pragma unroll
    for (int i = 0; i < 4; ++i)
#pragma unroll
        for (int j = 0; j < 4; ++j) acc[i][j] = 0.f;
#pragma unroll 4
    for (int c4 = 0; c4 < 32; ++c4) {
        f32x4 a[4], b[4];
#pragma unroll
        for (int i = 0; i < 4; ++i) a[i] = SK4[(4 * tn + i) * 33 + c4];
#pragma unroll
        for (int j = 0; j < 4; ++j) b[j] = WQ4[(td + 16 * j) * 33 + c4];
#pragma unroll
        for (int i = 0; i < 4; ++i)
#pragma unroll
            for (int j = 0; j < 4; ++j) acc[i][j] += a[i].x * b[j].x + a[i].y * b[j].y + a[i].z * b[j].z + a[i].w * b[j].w;
    }
#pragma unroll
    for (int i = 0; i < 4; ++i)
#pragma unroll
        for (int j = 0; j < 4; ++j) WfT[(size_t)(hp * 128 + 4 * tn + i) * 2048 + 64 * dt + td + 16 * j] = (bf16)f2bf(acc[i][j]);
    __syncthreads();
}

__device__ __forceinline__ int perm16(int o) { return 8 * ((o >> 2) & 1) + 4 * (o >> 3) + (o & 3); }
__device__ __forceinline__ void attn_unit(int unit, const bf16* z, bf16* ao, const float* sinks, LAS unsigned char* lds, int tid) {
    const int lane = tid & 63, wid = __builtin_amdgcn_readfirstlane(tid >> 6), r32 = lane & 31, hi = lane >> 5;
    const int nb = unit & 15, kvh = (unit >> 4) & 3, b = unit >> 6;
    LAS bf16* Ks = (LAS bf16*)lds;
    LAS bf16* Vt = (LAS bf16*)(lds + 256 * 144);
    const size_t tok0 = (size_t)b * SEQ;
#pragma unroll
    for (int i = 0; i < 4; ++i) {
        const int ci = tid + NTHREADS * i, key = ci >> 3, dc = ci & 7;
        int kpos = 128 * (nb - 1) + key; if (kpos < 0) kpos = 0;
        const bf16* src = z + (tok0 + kpos) * IN_W + K_OFF + kvh * HD + dc * 8;
        const v4u kv = *(const GAS v4u*)src, vv = *(const GAS v4u*)(src + (V_OFF - K_OFF));
        *(LAS v4u*)(Ks + key * 72 + dc * 8) = kv;
        const int pos = (key & ~15) + perm16(key & 15);
        LAS bf16* vp = Vt + (dc * 8) * 264 + pos;
        vp[0 * 264] = (bf16)(vv.x & 0xffffu); vp[1 * 264] = (bf16)(vv.x >> 16); vp[2 * 264] = (bf16)(vv.y & 0xffffu); vp[3 * 264] = (bf16)(vv.y >> 16);
        vp[4 * 264] = (bf16)(vv.z & 0xffffu); vp[5 * 264] = (bf16)(vv.z >> 16); vp[6 * 264] = (bf16)(vv.w & 0xffffu); vp[7 * 264] = (bf16)(vv.w >> 16);
    }
    __syncthreads();
    const int hq = kvh * QPKV + wid;
    const float LOG2E = 1.4426950408889634f;
    const float sink2 = sinks[hq] * LOG2E, sc = 0.125f * LOG2E;
#pragma unroll 1
    for (int qg = 0; qg < 4; ++qg) {
        const size_t tok = tok0 + 128 * nb + 32 * qg + r32;
        bf16x8 qf[4];
#pragma unroll
        for (int ks = 0; ks < 4; ++ks) qf[ks] = *(const GAS bf16x8*)(z + tok * IN_W + Q_OFF + hq * HD + 16 * ks + 8 * hi);
        f32x16 s[5];
#pragma unroll
        for (int kt = 0; kt < 5; ++kt) {
            s[kt] = (f32x16){0.f, 0.f, 0.f, 0.f, 0.f, 0.f, 0.f, 0.f, 0.f, 0.f, 0.f, 0.f, 0.f, 0.f, 0.f, 0.f};
#pragma unroll
            for (int ks = 0; ks < 4; ++ks) {
                const bf16x8 kf = *(const LAS bf16x8*)(Ks + (32 * (qg + kt) + r32) * 72 + 16 * ks + 8 * hi);
                s[kt] = __builtin_amdgcn_mfma_f32_32x32x16_bf16(kf, qf[ks], s[kt], 0, 0, 0);
            }
        }
        float mx = sink2;
#pragma unroll
        for (int kt = 0; kt < 5; ++kt) {
            const bool tile_dead = (nb == 0) && (qg + kt < 4);
#pragma unroll
            for (int r = 0; r < 16; ++r) {
                const int krow = (r & 3) + 8 * (r >> 2) + 4 * hi;
                bool valid = !tile_dead;
                if (kt == 0) valid = valid && (krow > r32);
                if (kt == 4) valid = valid && (krow <= r32);
                const float v = valid ? s[kt][r] * sc : -INFINITY;
                s[kt][r] = v; mx = fmaxf(mx, v);
            }
        }
        mx = fmaxf(mx, __shfl_xor(mx, 32));
        float sum = 0.f;
#pragma unroll
        for (int kt = 0; kt < 5; ++kt)
#pragma unroll
            for (int r = 0; r < 16; ++r) { const float p = __builtin_amdgcn_exp2f(s[kt][r] - mx); s[kt][r] = p; sum += p; }
        sum += __shfl_xor(sum, 32);
        const float inv = 1.0f / (sum + __builtin_amdgcn_exp2f(sink2 - mx));
        f32x16 o[2];
        o[0] = (f32x16){0.f, 0.f, 0.f, 0.f, 0.f, 0.f, 0.f, 0.f, 0.f, 0.f, 0.f, 0.f, 0.f, 0.f, 0.f, 0.f}; o[1] = o[0];
#pragma unroll
        for (int kt = 0; kt < 5; ++kt)
#pragma unroll
            for (int s2 = 0; s2 < 2; ++s2) {
                v4u pw; pw.x = pg8::cvt_pk_bf16(s[kt][8 * s2 + 0], s[kt][8 * s2 + 1]); pw.y = pg8::cvt_pk_bf16(s[kt][8 * s2 + 2], s[kt][8 * s2 + 3]);
                pw.z = pg8::cvt_pk_bf16(s[kt][8 * s2 + 4], s[kt][8 * s2 + 5]); pw.w = pg8::cvt_pk_bf16(s[kt][8 * s2 + 6], s[kt][8 * s2 + 7]);
                const bf16x8 pa = __builtin_bit_cast(bf16x8, pw);
#pragma unroll
                for (int dt = 0; dt < 2; ++dt) {
                    const bf16x8 vf = *(const LAS bf16x8*)(Vt + (32 * dt + r32) * 264 + 32 * (qg + kt) + 16 * s2 + 8 * hi);
                    o[dt] = __builtin_amdgcn_mfma_f32_32x32x16_bf16(vf, pa, o[dt], 0, 0, 0);
                }
            }
        bf16* op = ao + tok * D + hq * HD;
#pragma unroll
        for (int dt = 0; dt < 2; ++dt)
#pragma unroll
            for (int g = 0; g < 4; ++g) {
                v2u w; w.x = pg8::cvt_pk_bf16(o[dt][4 * g + 0] * inv, o[dt][4 * g + 1] * inv); w.y = pg8::cvt_pk_bf16(o[dt][4 * g + 2] * inv, o[dt][4 * g + 3] * inv);
                *(GAS v2u*)(op + 32 * dt + 8 * g + 4 * hi) = w;
            }
    }
    __syncthreads();
}
__device__ __forceinline__ void conv_item(int item, const bf16* z, const float* cw, bf16* ci, int tid) {
    const int c8 = tid & 255, half = tid >> 8, t0 = 32 * item + 16 * half, c0 = 8 * c8;
    float w0[8], w1[8], w2[8], u1[8], u2[8];
#pragma unroll
    for (int e = 0; e < 8; ++e) { w0[e] = cw[c0 + e]; w1[e] = cw[2048 + c0 + e]; w2[e] = cw[4096 + c0 + e]; u1[e] = 0.f; u2[e] = 0.f; }
    if ((t0 & (SEQ - 1)) != 0) {
#pragma unroll
        for (int k = 0; k < 2; ++k) {
            const bf16* zr = z + (size_t)(t0 - 2 + k) * IN_W + c0;
            const v4u a = *(const GAS v4u*)(zr + CC_OFF), h = *(const GAS v4u*)(zr + CH_OFF);
            float u[8];
            u[0] = pg8::bf_lo(a.x) * pg8::bf_lo(h.x); u[1] = pg8::bf_hi(a.x) * pg8::bf_hi(h.x); u[2] = pg8::bf_lo(a.y) * pg8::bf_lo(h.y); u[3] = pg8::bf_hi(a.y) * pg8::bf_hi(h.y);
            u[4] = pg8::bf_lo(a.z) * pg8::bf_lo(h.z); u[5] = pg8::bf_hi(a.z) * pg8::bf_hi(h.z); u[6] = pg8::bf_lo(a.w) * pg8::bf_lo(h.w); u[7] = pg8::bf_hi(a.w) * pg8::bf_hi(h.w);
#pragma unroll
            for (int e = 0; e < 8; ++e) { if (k == 0) u2[e] = u[e]; else u1[e] = u[e]; }
        }
    }
#pragma unroll 4
    for (int i = 0; i < 16; ++i) {
        const bf16* zr = z + (size_t)(t0 + i) * IN_W + c0;
        const v4u a = *(const GAS v4u*)(zr + CC_OFF), h = *(const GAS v4u*)(zr + CH_OFF), bb = *(const GAS v4u*)(zr + CB_OFF);
        float u[8], cb[8], y[8];
        u[0] = pg8::bf_lo(a.x) * pg8::bf_lo(h.x); u[1] = pg8::bf_hi(a.x) * pg8::bf_hi(h.x); u[2] = pg8::bf_lo(a.y) * pg8::bf_lo(h.y); u[3] = pg8::bf_hi(a.y) * pg8::bf_hi(h.y);
        u[4] = pg8::bf_lo(a.z) * pg8::bf_lo(h.z); u[5] = pg8::bf_hi(a.z) * pg8::bf_hi(h.z); u[6] = pg8::bf_lo(a.w) * pg8::bf_lo(h.w); u[7] = pg8::bf_hi(a.w) * pg8::bf_hi(h.w);
        cb[0] = pg8::bf_lo(bb.x); cb[1] = pg8::bf_hi(bb.x); cb[2] = pg8::bf_lo(bb.y); cb[3] = pg8::bf_hi(bb.y); cb[4] = pg8::bf_lo(bb.z); cb[5] = pg8::bf_hi(bb.z); cb[6] = pg8::bf_lo(bb.w); cb[7] = pg8::bf_hi(bb.w);
#pragma unroll
        for (int e = 0; e < 8; ++e) { y[e] = cb[e] * (w0[e] * u2[e] + w1[e] * u1[e] + w2[e] * u[e]); u2[e] = u1[e]; u1[e] = u[e]; }
        v4u o; o.x = pk2(y[0], y[1]); o.y = pk2(y[2], y[3]); o.z = pk2(y[4], y[5]); o.w = pk2(y[6], y[7]);
        *(GAS v4u*)(ci + (size_t)(t0 + i) * D + c0) = o;
    }
}

__device__ __forceinline__ unsigned pack_i8(const f32x4 v) {
    const int a = __float2int_rn(v.x), b = __float2int_rn(v.y), c = __float2int_rn(v.z), d = __float2int_rn(v.w);
    return ((unsigned)a & 0xffu) | (((unsigned)b & 0xffu) << 8) | (((unsigned)c & 0xffu) << 16) | ((unsigned)d << 24);
}
__device__ __forceinline__ unsigned pack_i8_2(float a, float b, float c, float d) {
    const int ia = __float2int_rn(a), ib = __float2int_rn(b), ic = __float2int_rn(c), id = __float2int_rn(d);
    return ((unsigned)ia & 0xffu) | (((unsigned)ib & 0xffu) << 8) | (((unsigned)ic & 0xffu) << 16) | ((unsigned)id << 24);
}
__device__ __forceinline__ void ln1_row(bf16* hbrow, signed char* xqrow, float* sxp, const float* g, const float* bta, int lane) {
    GAS v4u* xr = (GAS v4u*)hbrow + lane;
    float v[4][8]; float s = 0.f;
#pragma unroll
    for (int j = 0; j < 4; ++j) { const v4u w = xr[64 * j];
        v[j][0] = pg8::bf_lo(w.x); v[j][1] = pg8::bf_hi(w.x); v[j][2] = pg8::bf_lo(w.y); v[j][3] = pg8::bf_hi(w.y); v[j][4] = pg8::bf_lo(w.z); v[j][5] = pg8::bf_hi(w.z); v[j][6] = pg8::bf_lo(w.w); v[j][7] = pg8::bf_hi(w.w);
#pragma unroll
        for (int e = 0; e < 8; ++e) s += v[j][e]; }
    const float mean = wave_sum(s) * (1.f / D); float s2 = 0.f;
#pragma unroll
    for (int j = 0; j < 4; ++j)
#pragma unroll
        for (int e = 0; e < 8; ++e) { v[j][e] -= mean; s2 += v[j][e] * v[j][e]; }
    const float rstd = 1.f / sqrtf(wave_sum(s2) * (1.f / D) + LN_EPS);
    float mx = 0.f;
#pragma unroll
    for (int j = 0; j < 4; ++j) {
        const GAS f32x4* gp = (const GAS f32x4*)g + 2 * (lane + 64 * j); const GAS f32x4* bp = (const GAS f32x4*)bta + 2 * (lane + 64 * j);
        const f32x4 g0 = gp[0], g1 = gp[1], b0 = bp[0], b1 = bp[1];
        v[j][0] = v[j][0] * rstd * g0.x + b0.x; v[j][1] = v[j][1] * rstd * g0.y + b0.y; v[j][2] = v[j][2] * rstd * g0.z + b0.z; v[j][3] = v[j][3] * rstd * g0.w + b0.w;
        v[j][4] = v[j][4] * rstd * g1.x + b1.x; v[j][5] = v[j][5] * rstd * g1.y + b1.y; v[j][6] = v[j][6] * rstd * g1.z + b1.z; v[j][7] = v[j][7] * rstd * g1.w + b1.w;
        v4u o; o.x = pk2(v[j][0], v[j][1]); o.y = pk2(v[j][2], v[j][3]); o.z = pk2(v[j][4], v[j][5]); o.w = pk2(v[j][6], v[j][7]);
        xr[64 * j] = o;
#pragma unroll
        for (int e = 0; e < 8; ++e) mx = fmaxf(mx, fabsf(v[j][e]));
    }
#pragma unroll
    for (int o = 1; o < 64; o <<= 1) mx = fmaxf(mx, __shfl_xor(mx, o));
    const float qs = mx > 0.f ? 127.0f / mx : 1.0f;
    GAS v2u* q8 = (GAS v2u*)xqrow + lane;
#pragma unroll
    for (int j = 0; j < 4; ++j) { v2u o; o.x = pack_i8_2(v[j][0] * qs, v[j][1] * qs, v[j][2] * qs, v[j][3] * qs); o.y = pack_i8_2(v[j][4] * qs, v[j][5] * qs, v[j][6] * qs, v[j][7] * qs); q8[64 * j] = o; }
    if (lane == 0) *sxp = mx > 0.f ? mx * (1.0f / 127.0f) : 1.0f;
}

__device__ __forceinline__ void row_f32_to_i8(const float* src, signed char* dst, float* inv, int lane) {
    f32x4 v[8]; float mx = 0.f;
#pragma unroll
    for (int j = 0; j < 8; ++j) { v[j] = *((const GAS f32x4*)src + lane + 64 * j); mx = fmaxf(mx, fmaxf(fmaxf(fabsf(v[j].x), fabsf(v[j].y)), fmaxf(fabsf(v[j].z), fabsf(v[j].w)))); }
#pragma unroll
    for (int o = 1; o < 64; o <<= 1) mx = fmaxf(mx, __shfl_xor(mx, o));
    const float sc = mx > 0.f ? 127.0f / mx : 1.0f;
#pragma unroll
    for (int j = 0; j < 8; ++j) *((GAS unsigned*)dst + lane + 64 * j) = pack_i8_2(v[j].x * sc, v[j].y * sc, v[j].z * sc, v[j].w * sc);
    if (lane == 0) *inv = mx > 0.f ? mx * (1.0f / 127.0f) : 1.0f;
}
__device__ __forceinline__ void row_bf16_to_i8(const bf16* src, signed char* dst, float* inv, int lane) {
    float v[4][8]; float mx = 0.f;
#pragma unroll
    for (int j = 0; j < 4; ++j) { const v4u w = *((const GAS v4u*)src + lane + 64 * j);
        v[j][0] = pg8::bf_lo(w.x); v[j][1] = pg8::bf_hi(w.x); v[j][2] = pg8::bf_lo(w.y); v[j][3] = pg8::bf_hi(w.y); v[j][4] = pg8::bf_lo(w.z); v[j][5] = pg8::bf_hi(w.z); v[j][6] = pg8::bf_lo(w.w); v[j][7] = pg8::bf_hi(w.w);
#pragma unroll
        for (int e = 0; e < 8; ++e) mx = fmaxf(mx, fabsf(v[j][e])); }
#pragma unroll
    for (int o = 1; o < 64; o <<= 1) mx = fmaxf(mx, __shfl_xor(mx, o));
    const float sc = mx > 0.f ? 127.0f / mx : 1.0f;
#pragma unroll
    for (int j = 0; j < 4; ++j) { v2u o; o.x = pack_i8_2(v[j][0] * sc, v[j][1] * sc, v[j][2] * sc, v[j][3] * sc); o.y = pack_i8_2(v[j][4] * sc, v[j][5] * sc, v[j][6] * sc, v[j][7] * sc); *((GAS v2u*)dst + lane + 64 * j) = o; }
    if (lane == 0) *inv = mx > 0.f ? mx * (1.0f / 127.0f) : 1.0f;
}

constexpr int TK_ROWF = 136;
constexpr int TK_IDX_OFF = 256 * TK_ROWF * 4;
__device__ __forceinline__ void topk_core(LAS unsigned char* lds, size_t prob0, int pstride, int* experts, float* gates, int tid) {
    LAS float* S = (LAS float*)lds;
    LAS unsigned char* IDX = lds + TK_IDX_OFF;
    const int row = tid >> 1, sub = tid & 1;
#define TK_CE(a, b) do { const float h_ = vmaxf(a, b), l_ = vminf(a, b); a = h_; b = l_; } while (0)
#define TK_SORT16(V) do { _Pragma("unroll") for (int k_ = 2; k_ <= 16; k_ <<= 1) _Pragma("unroll") for (int j_ = k_ >> 1; j_ > 0; j_ >>= 1) _Pragma("unroll") for (int i_ = 0; i_ < 16; ++i_) { \
        const int l_i = i_ ^ j_; if (l_i > i_) { if ((i_ & k_) == 0) TK_CE(V[i_], V[l_i]); else TK_CE(V[l_i], V[i_]); } } } while (0)
#define TK_MERGE16(Lv, Xv) do { _Pragma("unroll") for (int j_ = 0; j_ < 16; ++j_) Lv[j_] = vmaxf(Lv[j_], Xv[15 - j_]); \
        _Pragma("unroll") for (int st_ = 8; st_ >= 1; st_ >>= 1) _Pragma("unroll") for (int j_ = 0; j_ < 16; ++j_) if ((j_ & st_) == 0) TK_CE(Lv[j_], Lv[j_ + st_]); } while (0)
    float L[16];
#pragma unroll
    for (int q = 0; q < 4; ++q) {
        float C[16];
#pragma unroll
        for (int i = 0; i < 4; ++i) { const int c4 = 2 * (4 * q + i) + sub;
            const f32x4 v = *(const LAS f32x4*)(S + row * TK_ROWF + 4 * c4);
#pragma unroll
            for (int e = 0; e < 4; ++e) { const float ve = v[e];
                C[4 * i + e] = __uint_as_float((__float_as_uint(ve) & ~0x7Fu) | (unsigned)(4 * c4 + e)); } }
        TK_SORT16(C);
        if (q == 0) {
#pragma unroll
            for (int j = 0; j < 16; ++j) L[j] = C[j];
        } else TK_MERGE16(L, C);
    }
    {
        float P[16];
#pragma unroll
        for (int j = 0; j < 16; ++j) P[j] = __shfl_xor(L[j], 1);
        TK_MERGE16(L, P);
    }
    if (sub == 0) {
#pragma unroll
        for (int q = 0; q < 4; ++q) {
            unsigned w = 0;
#pragma unroll
            for (int e = 0; e < 4; ++e) w |= (__builtin_bit_cast(unsigned, L[4 * q + e]) & 0x7Fu) << (8 * e);
            *(LAS unsigned*)(IDX + row * 16 + 4 * q) = w;
        }
    }
    float A[16], B[16];
#pragma unroll
    for (int j = 0; j < 16; ++j) { const float o = __shfl_xor(L[j], 2); const bool isb = (tid & 2) != 0; A[j] = isb ? o : L[j]; B[j] = isb ? L[j] : o; }
#define TK_KEY(i, j) __uint_as_float((__float_as_uint(A[i] + B[j]) & ~0xFFu) | (unsigned)(255 - ((i) * 16 + (j))))
    float F[16], X[16];
#pragma unroll
    for (int j = 0; j < 16; ++j) F[j] = TK_KEY(0, j);
#pragma unroll
    for (int i = 1; i < 16; ++i) X[i - 1] = TK_KEY(i, 0);
    X[15] = -INFINITY; TK_MERGE16(F, X);
#pragma unroll
    for (int i = 0; i < 16; ++i) X[i] = -INFINITY;
#pragma unroll
    for (int i = 1; i <= 7; ++i) X[i - 1] = TK_KEY(i, 1);
    TK_MERGE16(F, X);
#pragma unroll
    for (int i = 0; i < 16; ++i) X[i] = -INFINITY;
#pragma unroll
    for (int j = 2; j <= 7; ++j) X[j - 2] = TK_KEY(1, j);
    TK_MERGE16(F, X);
    { const float rest[6] = {TK_KEY(2, 2), TK_KEY(2, 3), TK_KEY(2, 4), TK_KEY(3, 2), TK_KEY(3, 3), TK_KEY(4, 2)};
#pragma unroll
      for (int r = 0; r < 6; ++r) { float x = rest[r];
#pragma unroll
          for (int k = 0; k < 16; ++k) { const float h = vmaxf(F[k], x); x = vminf(F[k], x); F[k] = h; } } }
    __syncthreads();
    if ((tid & 3) == 0) {
        const int rowA = (tid >> 2) * 2, rowB = rowA + 1;
        const size_t prob = prob0 + (size_t)pstride * (tid >> 2);
        float g[16]; int ex[16]; float gs = 0.f;
#pragma unroll
        for (int k = 0; k < 16; ++k) {
            const unsigned code = 255u - (__builtin_bit_cast(unsigned, F[k]) & 0xFFu);
            const int ia = IDX[rowA * 16 + (code >> 4)], ib = IDX[rowB * 16 + (code & 15)];
            ex[k] = ia * PNK + ib;
            g[k] = __expf(F[k] - F[0]); gs += g[k];
        }
        const float ginv = 1.0f / gs;
#pragma unroll
        for (int q = 0; q < 4; ++q) {
            *(GAS f32x4*)(gates + prob * 16 + 4 * q) = (f32x4){g[4 * q] * ginv, g[4 * q + 1] * ginv, g[4 * q + 2] * ginv, g[4 * q + 3] * ginv};
            typedef int i32x4 __attribute__((ext_vector_type(4)));
            *(GAS i32x4*)(experts + prob * 16 + 4 * q) = (i32x4){ex[4 * q], ex[4 * q + 1], ex[4 * q + 2], ex[4 * q + 3]};
        }
    }
    __syncthreads();
}
__device__ __forceinline__ void topk_pass(int pass, const float* scores, int* experts, float* gates, LAS unsigned char* lds, int tid) {
    LAS float* S = (LAS float*)lds;
    const float* src = scores + (size_t)pass * (256 * 128);
#pragma unroll 4
    for (int i = 0; i < 16; ++i) { const int f4 = tid + NTHREADS * i, row = f4 >> 5, c4 = f4 & 31; *(LAS f32x4*)(S + row * TK_ROWF + 4 * c4) = *(const GAS f32x4*)(src + (size_t)f4 * 4); }
    __syncthreads();
    topk_core(lds, (size_t)pass * 128, 1, experts, gates, tid);
}
struct EpiTopK {
    static constexpr bool PERM = false, AFTER_DRAIN = true;
    int* experts; float* gates;
    __device__ __forceinline__ void fused(pg8::f32x4 (&acc)[2][2][4][2], const pg8::Unit& u, int wr, int wc, int fr, int fq, LAS unsigned char* lds, int wid, int lane) const {
        LAS float* S = (LAS float*)lds;
        const int tid = wid * 64 + lane;
#pragma unroll
        for (int ai = 0; ai < 2; ++ai) {
#pragma unroll
            for (int bj = 0; bj < 2; ++bj)
#pragma unroll
                for (int mm = 0; mm < 4; ++mm)
#pragma unroll
                    for (int n = 0; n < 2; ++n) { const int rl = 64 * wr + 16 * mm + fr; *(LAS pg8::f32x4*)(S + (2 * rl + bj) * TK_ROWF + 32 * wc + 16 * n + 4 * fq) = acc[ai][bj][mm][n]; }
            __syncthreads();
            topk_core(lds, ((size_t)u.pm * 256 + 128 * ai) * PH + u.pn, PH, experts, gates, tid);
        }
    }
};

__device__ __forceinline__ float gelu_erf(float v) { return 0.5f * v * (1.0f + erff(v * 0.70710678118654752f)); }
typedef __bf16 bf16x2_t __attribute__((ext_vector_type(2)));
typedef float f32x2_t __attribute__((ext_vector_type(2)));
__device__ __forceinline__ float dot2bf(bf16x2_t a, unsigned b, float acc) { return __builtin_amdgcn_fdot2_f32_bf16(a, __builtin_bit_cast(bf16x2_t, b), acc, false); }
__device__ __forceinline__ float dot4f8(unsigned w8, unsigned x01, unsigned x23, float acc) {
    acc = dot2bf(__builtin_amdgcn_cvt_scalef32_pk_bf16_fp8(w8, 1.0f, false), x01, acc);
    return dot2bf(__builtin_amdgcn_cvt_scalef32_pk_bf16_fp8(w8, 1.0f, true), x23, acc);
}
__device__ __forceinline__ void axpy4f8(float* y, unsigned w8, float w) {
    const f32x2_t lo = __builtin_amdgcn_cvt_pk_f32_fp8(w8, false), hi = __builtin_amdgcn_cvt_pk_f32_fp8(w8, true);
    y[0] += w * lo.x; y[1] += w * lo.y; y[2] += w * hi.x; y[3] += w * hi.y;
}
__device__ __forceinline__ void axpy4f8v(f32x2_t* y2, unsigned w8, float w) {
    const f32x2_t lo = __builtin_amdgcn_cvt_pk_f32_fp8(w8, false), hi = __builtin_amdgcn_cvt_pk_f32_fp8(w8, true);
    const f32x2_t ww = {w, w};
    y2[0] = __builtin_elementwise_fma(lo, ww, y2[0]); y2[1] = __builtin_elementwise_fma(hi, ww, y2[1]);
}
__device__ __forceinline__ void row_to_fp8(const float* src, unsigned char* dst, float* inv, int lane) {
    f32x4 v[2][4]; float mx = 0.f;
#pragma unroll
    for (int j = 0; j < 2; ++j)
#pragma unroll
        for (int q = 0; q < 4; ++q) { v[j][q] = *((const GAS f32x4*)src + 4 * (lane + 64 * j) + q);
            mx = fmaxf(mx, fmaxf(fmaxf(fabsf(v[j][q].x), fabsf(v[j][q].y)), fmaxf(fabsf(v[j][q].z), fabsf(v[j][q].w)))); }
#pragma unroll
    for (int o = 1; o < 64; o <<= 1) mx = fmaxf(mx, __shfl_xor(mx, o));
    const float sc = mx > 0.f ? 384.0f / mx : 1.0f;
#pragma unroll
    for (int j = 0; j < 2; ++j) { v4u o;
        int w;
        w = 0; w = __builtin_amdgcn_cvt_pk_fp8_f32(v[j][0].x * sc, v[j][0].y * sc, w, false); w = __builtin_amdgcn_cvt_pk_fp8_f32(v[j][0].z * sc, v[j][0].w * sc, w, true); o.x = (unsigned)w;
        w = 0; w = __builtin_amdgcn_cvt_pk_fp8_f32(v[j][1].x * sc, v[j][1].y * sc, w, false); w = __builtin_amdgcn_cvt_pk_fp8_f32(v[j][1].z * sc, v[j][1].w * sc, w, true); o.y = (unsigned)w;
        w = 0; w = __builtin_amdgcn_cvt_pk_fp8_f32(v[j][2].x * sc, v[j][2].y * sc, w, false); w = __builtin_amdgcn_cvt_pk_fp8_f32(v[j][2].z * sc, v[j][2].w * sc, w, true); o.z = (unsigned)w;
        w = 0; w = __builtin_amdgcn_cvt_pk_fp8_f32(v[j][3].x * sc, v[j][3].y * sc, w, false); w = __builtin_amdgcn_cvt_pk_fp8_f32(v[j][3].z * sc, v[j][3].w * sc, w, true); o.w = (unsigned)w;
        { const int ch = lane + 64 * j; *((GAS v4u*)(dst + (size_t)(ch >> 4) * SLICE_BYTES) + (ch & 15)) = o; } }
    if (lane == 0) *inv = mx > 0.f ? mx * (1.0f / 384.0f) : 1.0f;
}
__device__ __forceinline__ void row_to_i8(const float* src, unsigned char* dst, float* inv, int lane) {
    f32x4 v[2][4]; float mx = 0.f;
#pragma unroll
    for (int j = 0; j < 2; ++j)
#pragma unroll
        for (int q = 0; q < 4; ++q) { v[j][q] = *((const GAS f32x4*)src + 4 * (lane + 64 * j) + q);
            mx = fmaxf(mx, fmaxf(fmaxf(fabsf(v[j][q].x), fabsf(v[j][q].y)), fmaxf(fabsf(v[j][q].z), fabsf(v[j][q].w)))); }
#pragma unroll
    for (int o = 1; o < 64; o <<= 1) mx = fmaxf(mx, __shfl_xor(mx, o));
    const float sc = mx > 0.f ? 127.0f / mx : 1.0f;
#pragma unroll
    for (int j = 0; j < 2; ++j) { v4u o; o.x = pack_i8(v[j][0] * sc); o.y = pack_i8(v[j][1] * sc); o.z = pack_i8(v[j][2] * sc); o.w = pack_i8(v[j][3] * sc);
        { const int ch = lane + 64 * j; *((GAS v4u*)(dst + (size_t)(ch >> 4) * SLICE_BYTES) + (ch & 15)) = o; } }
    if (lane == 0) *inv = mx > 0.f ? mx * (1.0f / 127.0f) : 1.0f;
}
__device__ __forceinline__ float row16_allsum(float a) {
    a += __builtin_bit_cast(float, __builtin_amdgcn_update_dpp(0, __builtin_bit_cast(int, a), 0x128, 0xf, 0xf, false));
    a += __builtin_bit_cast(float, __builtin_amdgcn_update_dpp(0, __builtin_bit_cast(int, a), 0x124, 0xf, 0xf, false));
    a += __builtin_bit_cast(float, __builtin_amdgcn_update_dpp(0, __builtin_bit_cast(int, a), 0x122, 0xf, 0xf, false));
    a += __builtin_bit_cast(float, __builtin_amdgcn_update_dpp(0, __builtin_bit_cast(int, a), 0x121, 0xf, 0xf, false));
    return a;
}
__device__ __forceinline__ int q_pull(unsigned* q, int lane) { int v = 0; if (lane == 0) v = (int)__hip_atomic_fetch_add(q, 1u, __ATOMIC_RELAXED, __HIP_MEMORY_SCOPE_AGENT); return __builtin_amdgcn_readfirstlane(v); }
constexpr int PEER_TG = 8;
constexpr int PEER_N8 = 640, PEER_N4 = 512, PEER_N2 = 512, PEER_NTASK = PEER_N8 + PEER_N4 + PEER_N2;
__device__ __forceinline__ void peer_task_tokens(int idx, int& t0, int& n) {
    if (idx < PEER_N8) { t0 = 8 * idx; n = 8; } else if (idx < PEER_N8 + PEER_N4) { t0 = 8 * PEER_N8 + 4 * (idx - PEER_N8); n = 4; } else { t0 = 8 * PEER_N8 + 4 * PEER_N4 + 2 * (idx - PEER_N8 - PEER_N4); n = 2; }
}
__device__ __forceinline__ int row16_allsum_i(int a) {
    a += __builtin_amdgcn_update_dpp(0, a, 0x128, 0xf, 0xf, false);
    a += __builtin_amdgcn_update_dpp(0, a, 0x124, 0xf, 0xf, false);
    a += __builtin_amdgcn_update_dpp(0, a, 0x122, 0xf, 0xf, false);
    a += __builtin_amdgcn_update_dpp(0, a, 0x121, 0xf, 0xf, false);
    return a;
}
#define PA_LOAD(R, IDV, HALF) do { _Pragma("unroll") for (int i_ = 0; i_ < 8; ++i_) { const unsigned e_ = (unsigned)__shfl(IDV, 4 * (i_ + 8 * (HALF)) + g); \
        R[i_] = *(const GAS v4u*)(ub + (e_ * 256u + offc)); } } while (0)
#define PA_COMP(R, HALF) do { _Pragma("unroll") for (int i_ = 0; i_ < 8; ++i_) { int a_ = __builtin_amdgcn_sdot4((int)R[i_].x, (int)xc.x, 0, false); a_ = __builtin_amdgcn_sdot4((int)R[i_].y, (int)xc.y, a_, false); \
        a_ = __builtin_amdgcn_sdot4((int)R[i_].z, (int)xc.z, a_, false); a_ = __builtin_amdgcn_sdot4((int)R[i_].w, (int)xc.w, a_, false); r16[8 * (HALF) + i_] = row16_allsum_i(a_); } } while (0)
__device__ __forceinline__ void peer_a_task(int t0, int ntok, int s, const signed char* xq, const int* experts, const unsigned char* u8s, int* pa, int lane_) {
    int lane = lane_; asm volatile("" : "+v"(lane));
    const int g = lane >> 4, c = lane & 15;
    const GAS unsigned char* ub = (const GAS unsigned char*)(u8s + (size_t)s * SLICE_BYTES);
    const unsigned offc = 16u * (unsigned)c;
    int idc0 = experts[(size_t)t0 * 128 + lane], idc1 = experts[(size_t)t0 * 128 + lane + 64];
    v4u xc = *(const GAS v4u*)(xq + (size_t)t0 * D + 256 * s + 16 * c);
    v4u RA[8], RB[8];
    PA_LOAD(RA, idc0, 0);
#pragma unroll 1
    for (int tt = 0; tt < ntok; ++tt) {
        const int t = t0 + tt, tn = tt + 1 < ntok ? t + 1 : t;
        const int idn0 = experts[(size_t)tn * 128 + lane], idn1 = experts[(size_t)tn * 128 + lane + 64];
        const v4u xn = *(const GAS v4u*)(xq + (size_t)tn * D + 256 * s + 16 * c);
#pragma unroll 1
        for (int hb = 0; hb < 2; ++hb) {
            const int idv = hb ? idc1 : idc0, idx = hb ? idn0 : idc1;
            int r16[16];
            PA_LOAD(RB, idv, 1); PA_COMP(RA, 0);
            asm volatile("" ::: "memory");
            PA_LOAD(RA, idx, 0); PA_COMP(RB, 1);
            if (c == 15) { typedef int i32x4 __attribute__((ext_vector_type(4))); GAS i32x4* dst = (GAS i32x4*)(pa + ((size_t)t * 8 + s) * 128 + g * 32 + 16 * hb);
#pragma unroll
                for (int q = 0; q < 4; ++q) dst[q] = (i32x4){r16[4 * q], r16[4 * q + 1], r16[4 * q + 2], r16[4 * q + 3]}; }
        }
        idc0 = idn0; idc1 = idn1; xc = xn;
    }
}
__device__ __forceinline__ void peer_w_elem(size_t i, const int* experts, const float* gates, const float* su, const float* sv, const float* sx, const int* pa, float* wb) {
    const size_t t = i >> 7; const int k = (int)(i & 127), pos = (k & 3) * 32 + (k >> 2);
    const int e = experts[i];
    int a = 0;
#pragma unroll
    for (int s2 = 0; s2 < 8; ++s2) a += pa[(t * 8 + s2) * 128 + pos];
    wb[i] = gates[i] * gelu_erf((float)a * (su[e] * sx[t])) * sv[e];
}
#define PB_LOAD(R, IDV, HALF) do { _Pragma("unroll") for (int i_ = 0; i_ < 8; ++i_) { const unsigned e_ = (unsigned)__shfl(IDV, 4 * (i_ + 8 * (HALF)) + g); \
        R[i_] = *(const GAS v4u*)(vb + (e_ * 256u + offc)); } } while (0)
#define PB_COMP(R, WV, HALF) do { _Pragma("unroll") for (int i_ = 0; i_ < 8; ++i_) { const float wk_ = __shfl(WV, 4 * (i_ + 8 * (HALF)) + g); \
        axpy4f8v(&ya2[0], R[i_].x, wk_); axpy4f8v(&ya2[2], R[i_].y, wk_); axpy4f8v(&ya2[4], R[i_].z, wk_); axpy4f8v(&ya2[6], R[i_].w, wk_); } } while (0)
__device__ __forceinline__ void peer_b_task(int t0, int ntok, int s, const bf16* h1, const int* experts, const float* wb, const unsigned char* v8s, bf16* out, float* st, int lane_) {
    int lane = lane_; asm volatile("" : "+v"(lane));
    const int g = lane >> 4, c = lane & 15;
    const GAS unsigned char* vb = (const GAS unsigned char*)(v8s + (size_t)s * SLICE_BYTES);
    const unsigned offc = 16u * (unsigned)c;
    int idc0 = experts[(size_t)t0 * 128 + lane], idc1 = experts[(size_t)t0 * 128 + lane + 64];
    float wc0 = wb[(size_t)t0 * 128 + lane], wc1 = wb[(size_t)t0 * 128 + lane + 64];
    v4u RA[8], RB[8];
    PB_LOAD(RA, idc0, 0);
#pragma unroll 1
    for (int tt = 0; tt < ntok; ++tt) {
        const int t = t0 + tt, tn = tt + 1 < ntok ? t + 1 : t;
        const int idn0 = experts[(size_t)tn * 128 + lane], idn1 = experts[(size_t)tn * 128 + lane + 64];
        const float wn0 = wb[(size_t)tn * 128 + lane], wn1 = wb[(size_t)tn * 128 + lane + 64];
        f32x2_t ya2[8];
#pragma unroll
        for (int e = 0; e < 8; ++e) ya2[e] = (f32x2_t){0.f, 0.f};
#pragma unroll 1
        for (int hb = 0; hb < 2; ++hb) {
            const int idv = hb ? idc1 : idc0, idx = hb ? idn0 : idc1; const float wv = hb ? wc1 : wc0;
            PB_LOAD(RB, idv, 1); PB_COMP(RA, wv, 0);
            asm volatile("" ::: "memory");
            PB_LOAD(RA, idx, 0); PB_COMP(RB, wv, 1);
        }
        float ya[16];
#pragma unroll
        for (int e = 0; e < 8; ++e) { ya[2 * e] = ya2[e].x; ya[2 * e + 1] = ya2[e].y; }
#pragma unroll
        for (int e = 0; e < 16; ++e) { ya[e] += __shfl_xor(ya[e], 16); ya[e] += __shfl_xor(ya[e], 32); }
        const GAS v4u* hp = (const GAS v4u*)(h1 + (size_t)t * D + 256 * s + 16 * c);
        const v4u h0 = hp[0], h1v = hp[1];
        float hx[16];
        hx[0] = pg8::bf_lo(h0.x); hx[1] = pg8::bf_hi(h0.x); hx[2] = pg8::bf_lo(h0.y); hx[3] = pg8::bf_hi(h0.y); hx[4] = pg8::bf_lo(h0.z); hx[5] = pg8::bf_hi(h0.z); hx[6] = pg8::bf_lo(h0.w); hx[7] = pg8::bf_hi(h0.w);
        hx[8] = pg8::bf_lo(h1v.x); hx[9] = pg8::bf_hi(h1v.x); hx[10] = pg8::bf_lo(h1v.y); hx[11] = pg8::bf_hi(h1v.y); hx[12] = pg8::bf_lo(h1v.z); hx[13] = pg8::bf_hi(h1v.z); hx[14] = pg8::bf_lo(h1v.w); hx[15] = pg8::bf_hi(h1v.w);
        float sm = 0.f, sq = 0.f;
#pragma unroll
        for (int e = 0; e < 16; ++e) { ya[e] = hx[e] * ALPHA + ya[e]; sm += ya[e]; sq += ya[e] * ya[e]; }
        sm = row16_allsum(sm); sq = row16_allsum(sq);
        if (g == 0) { GAS v4u* op = (GAS v4u*)(out + (size_t)t * D + 256 * s + 16 * c);
            v4u o0, o1; o0.x = pk2(ya[0], ya[1]); o0.y = pk2(ya[2], ya[3]); o0.z = pk2(ya[4], ya[5]); o0.w = pk2(ya[6], ya[7]);
            o1.x = pk2(ya[8], ya[9]); o1.y = pk2(ya[10], ya[11]); o1.z = pk2(ya[12], ya[13]); o1.w = pk2(ya[14], ya[15]);
            op[0] = o0; op[1] = o1;
            if (c == 0) { st[((size_t)t * 8 + s) * 2] = sm; st[((size_t)t * 8 + s) * 2 + 1] = sq; } }
        idc0 = idn0; idc1 = idn1; wc0 = wn0; wc1 = wn1;
    }
}
__device__ __forceinline__ void peer_c_row(int t, const bf16* r2, float* out, const float* st, const float* g2, const float* b2, int lane) {
    float sm = 0.f, sq = 0.f;
#pragma unroll
    for (int s = 0; s < 8; ++s) { sm += st[((size_t)t * 8 + s) * 2]; sq += st[((size_t)t * 8 + s) * 2 + 1]; }
    const float mean = sm * (1.f / D), var = sq * (1.f / D) - mean * mean, rstd = 1.f / sqrtf(fmaxf(var, 0.f) + LN_EPS);
    const GAS v4u* xr = (const GAS v4u*)(r2 + (size_t)t * D) + lane;
    GAS f32x4* op = (GAS f32x4*)(out + (size_t)t * D);
#pragma unroll
    for (int j = 0; j < 4; ++j) { const v4u w = xr[64 * j]; const int c4 = 2 * (lane + 64 * j);
        const f32x4 g0 = *((const GAS f32x4*)g2 + c4), g1 = *((const GAS f32x4*)g2 + c4 + 1), b0 = *((const GAS f32x4*)b2 + c4), b1 = *((const GAS f32x4*)b2 + c4 + 1);
        const f32x4 v0 = (f32x4){pg8::bf_lo(w.x), pg8::bf_hi(w.x), pg8::bf_lo(w.y), pg8::bf_hi(w.y)}, v1 = (f32x4){pg8::bf_lo(w.z), pg8::bf_hi(w.z), pg8::bf_lo(w.w), pg8::bf_hi(w.w)};
        op[c4] = (v0 - mean) * rstd * g0 + b0; op[c4 + 1] = (v1 - mean) * rstd * g1 + b1; }
}

struct ConvOrder : pg8::StaticOrder {
    const float* pu; const float* pv; unsigned char* u8; unsigned char* v8; float* su; float* sv; int slot; mutable int calls;
    static constexpr int CONV_ROWS = 4, CONV_CALLS = 6;
    __device__ __forceinline__ void done(const pg8::Unit&) const {
        if (slot < 0) return;
        int lane = threadIdx.x & 63; asm volatile("" : "+v"(lane));
        const int wave = __builtin_amdgcn_readfirstlane(threadIdx.x >> 6);
        const int base = ((slot * NWAVES + wave) * CONV_CALLS + calls) * CONV_ROWS;
        if (calls < CONV_CALLS) {
#pragma unroll 1
            for (int j = 0; j < CONV_ROWS; ++j) { const int r = base + j; if (r < 2 * PNE) { const bool sec = r >= PNE; const int e = sec ? r - PNE : r;
                if (sec) row_to_fp8(pv + (size_t)e * D, v8 + (size_t)e * 256, sv + e, lane); else row_to_i8(pu + (size_t)e * D, u8 + (size_t)e * 256, su + e, lane); } }
        }
        ++calls;
    }
};

struct Args { const float* in[16]; float* out; unsigned char* ws; int ph_lo, ph_hi; };
__global__ void __launch_bounds__(NTHREADS, 2) mk_fwd(Args args) {
    extern __shared__ __attribute__((aligned(16))) unsigned char lds_raw[];
    LAS unsigned char* lds = (LAS unsigned char*)lds_raw;
    volatile LAS unsigned* MISC = (volatile LAS unsigned*)(lds + MISC_OFF);
    const int tid0 = threadIdx.x;
    const int G = gridDim.x, bx = blockIdx.x;
    unsigned char* ws = args.ws;
    gu32* ctl = (gu32*)(ws + WS_CTL);
#define IN_(i) (args.in[i])
#define x_in IN_(0)
#define w_in IN_(1)
#define b_gate IN_(2)
#define sinks IN_(3)
#define conv_w IN_(4)
#define w_ao IN_(5)
#define w_co IN_(6)
#define w_o IN_(7)
#define ln1_g IN_(8)
#define ln1_b IN_(9)
#define w_q IN_(10)
#define sub_keys IN_(11)
#define peer_u IN_(12)
#define peer_v IN_(13)
#define ln2_g IN_(14)
#define ln2_b IN_(15)
#define WinT ((bf16*)(ws + WS_WIN))
#define WaT ((bf16*)(ws + WS_WA))
#define WcT ((bf16*)(ws + WS_WC))
#define WoT ((bf16*)(ws + WS_WO))
#define WfT ((bf16*)(ws + WS_WF))
#define XB ((bf16*)(ws + WS_XB))
#define MERGED ((bf16*)(ws + WS_MERGED))
#define Z ((bf16*)(ws + WS_Z))
#define R2B ((bf16*)(ws + WS_R2B))
#define H1B ((bf16*)(ws + WS_H1B))
#define SC ((float*)(ws + WS_SC))
#define EX ((int*)(ws + WS_EX))
#define GT ((float*)(ws + WS_GT))
#define AO ((bf16*)(ws + WS_AO))
#define CI ((bf16*)(ws + WS_CI))
#define TMP ((bf16*)(ws + WS_TMP))
#define U8 ((unsigned char*)(ws + WS_U8))
#define V8 ((unsigned char*)(ws + WS_V8))
#define SU ((float*)(ws + WS_SU))
#define SV ((float*)(ws + WS_SV))
#define PA ((int*)(ws + WS_PA))
#define ST ((float*)(ws + WS_ST))
#define WB ((float*)(ws + WS_WB))
#define XA8 ((signed char*)(ws + WS_XA8))
#define WIN8 ((signed char*)(ws + WS_WIN8))
#define SWIN ((float*)(ws + WS_SWIN))
#define SXA ((float*)(ws + WS_SXA))
#define XQ ((signed char*)(ws + WS_XQ))
#define SX ((float*)(ws + WS_SX))
    for (int u = tid0; u < (LDS_BYTES - LDSCTL_OFF) / 4; u += NTHREADS) ((LAS unsigned*)(lds + LDSCTL_OFF))[u] = 0u;
    __syncthreads();
    XcdBarrier bar; bar.bar = (unsigned*)(ctl + CW_BAR); bar.x = 0; bar.st = nullptr;
    if (!MK_PER_PHASE) bar = xcd_barrier_post((unsigned*)(ctl + CW_BAR), MISC + 8);
    const int lo = args.ph_lo, hi = args.ph_hi;
#ifndef PH_MASK
#define PH_MASK 0xFFF
#endif
#define IN(k) (((PH_MASK >> (k)) & 1) && lo <= (k) && (k) < hi)
#ifndef DBL_BAR
#define DBL_BAR 0
#endif
#define SEAM(k) do { if (IN(k) && IN((k) + 1)) { xcd_barrier(bar); if (DBL_BAR) xcd_barrier(bar); } } while (0)
#ifndef DBL_MASK
#define DBL_MASK 0
#endif
#define REP(k) for (int rep_ = 0; rep_ < 1 + ((DBL_MASK >> (k)) & 1); ++rep_)
#define PHASE_TID() int tid = tid0; asm volatile("" : "+v"(tid)); const int lane = tid & 63, wave = __builtin_amdgcn_readfirstlane(tid >> 6); (void)lane; (void)wave

    if (IN(0)) REP(0) {
        PHASE_TID();
        const bool conv_first = ((bx >> 3) & 1) == 0;
#pragma unroll 1
        for (int part = 0; part < 2; ++part) {
            if ((part == 0) == conv_first) {
                int tid = tid0; asm volatile("" : "+v"(tid)); const int lane = tid & 63, wave = __builtin_amdgcn_readfirstlane(tid >> 6);
                LAS float* scr = (LAS float*)(lds + wave * 16384);
                const int gw = bx * NWAVES + wave, NGW = G * NWAVES;
                constexpr int I_IN = (D / 64) * (IN_W / 32), I_SQ = (D / 64) * (D / 32);
                for (int it = gw; it < I_IN + 3 * I_SQ; it += NGW) {
                    int r = it;
                    if (r < I_IN) { p0_transpose_item(w_in, D, IN_W, WinT, scr, r, lane); continue; } r -= I_IN;
                    if (r < I_SQ) { p0_transpose_item(w_ao, D, D, WaT, scr, r, lane); continue; } r -= I_SQ;
                    if (r < I_SQ) { p0_transpose_item(w_co, D, D, WcT, scr, r, lane); continue; } r -= I_SQ;
                    p0_transpose_item(w_o, D, D, WoT, scr, r, lane);
                }
                for (int r = gw; r < M; r += NGW) row_f32_to_i8(x_in + (size_t)r * D, XA8 + (size_t)r * D, SXA + r, lane);
                __syncthreads();
            }
            if (part == 0) for (int it = bx; it < 16 * 32; it += G) p0_wf_item(w_q, sub_keys, WfT, lds, it, tid);
        }
    }
    SEAM(0);
    if (IN(1)) REP(1) {
        { PHASE_TID();
          for (int r = bx * NWAVES + wave; r < IN_W; r += G * NWAVES) row_bf16_to_i8(WinT + (size_t)r * D, WIN8 + (size_t)r * D, SWIN + r, lane); }
        if (!MK_PER_PHASE) xcd_barrier(bar);
        pg8::Gemm g{(const bf16*)XA8, (const bf16*)WIN8, M, IN_W, D / 2}; ConvOrder S; S.init(M, IN_W, G, bx);
        S.pu = peer_u; S.pv = peer_v; S.u8 = U8; S.v8 = V8; S.su = SU; S.sv = SV; S.calls = 0;
        S.slot = (G == 256 && bx >= 64) ? bx - 64 : -1;
        pg8::EpiI8Bf16 E{Z, IN_W, SXA, SWIN};
        pg8::gemm_phase<pg8::EpiI8Bf16, ConvOrder, true, true, true>(lds, g, S, E);
        if (G != 256) {
            PHASE_TID();
            for (int r = bx * NWAVES + wave; r < 2 * PNE; r += G * NWAVES) { const bool sec = r >= PNE; const int e = sec ? r - PNE : r;
                if (sec) row_to_fp8(peer_v + (size_t)e * D, V8 + (size_t)e * 256, SV + e, lane); else row_to_i8(peer_u + (size_t)e * D, U8 + (size_t)e * 256, SU + e, lane); }
        }
    }
    SEAM(1);
    if (IN(2)) REP(2) {
        PHASE_TID();
        const bool conv_first = ((bx >> 3) & 1) == 0;
#pragma unroll 1
        for (int part = 0; part < 2; ++part) {
            if ((part == 0) == conv_first) { int t2 = tid0; asm volatile("" : "+v"(t2)); for (int it = bx; it < M / 32; it += G) conv_item(it, Z, conv_w, CI, t2); }
            if (part == 0) for (int u = bx; u < BATCH * NKVH * 16; u += G) attn_unit(u, Z, AO, sinks, lds, tid);
        }
    }
    SEAM(2);
    if (IN(3)) REP(3) {
        pg8::StaticOrder S; S.init(M, D, G, bx);
        { pg8::Gemm g{AO, WaT, M, D, D}; pg8::EpiGate<0> E{TMP, nullptr, Z + G_OFF, b_gate, D, IN_W};
          pg8::gemm_phase<pg8::EpiGate<0>, pg8::StaticOrder, true, true>(lds, g, S, E); }
        { pg8::Gemm g{CI, WcT, M, D, D}; pg8::EpiGate<1> E{MERGED, TMP, Z + G_OFF + D, b_gate + D, D, IN_W};
          pg8::gemm_phase<pg8::EpiGate<1>, pg8::StaticOrder, true, true>(lds, g, S, E); }
    }
    SEAM(3);
    if (IN(4)) REP(4) {
        pg8::Gemm g{MERGED, WoT, M, D, D}; pg8::StaticOrder S; S.init(M, D, G, bx);
        pg8::EpiResBf16 E{H1B, D, x_in, ALPHA};
        pg8::gemm_phase<pg8::EpiResBf16, pg8::StaticOrder, true, true>(lds, g, S, E);
    }
    SEAM(4);
    if (IN(5)) REP(5) {
        PHASE_TID();
        const int gw = bx * NWAVES + wave, NGW = G * NWAVES;
        for (int m = gw; m < M; m += NGW) ln1_row(H1B + (size_t)m * D, XQ + (size_t)m * D, SX + m, ln1_g, ln1_b, lane);
    }
    SEAM(5);
    if (IN(6)) REP(6) {
        pg8::Gemm g{H1B, WfT, M, D, D}; pg8::StaticOrder S; S.init(M, D, G, bx);
        if (G == 256) { EpiTopK E{EX, GT}; pg8::gemm_phase<EpiTopK, pg8::StaticOrder, false, true>(lds, g, S, E); }
        else { pg8::EpiF32 E{SC, D, nullptr, 0.f}; pg8::gemm_phase<pg8::EpiF32, pg8::StaticOrder, true, true>(lds, g, S, E); }
    }
    if (G != 256) SEAM(6);
    if (IN(7)) REP(7) {
        PHASE_TID();
        if (G != 256) for (int p = bx; p < (M * PH) / 128; p += G) topk_pass(p, SC, EX, GT, lds, tid);
    }
    SEAM(7);
    if (IN(8)) REP(8) {
        PHASE_TID();
        const int xcc = (int)(xb_xcc_id() & 7u);
#pragma unroll 1
#ifndef SCRAMBLE
#define SCRAMBLE 0
#endif
        for (int sl = 0; sl < 8; ++sl) { const int s = (xcc + sl + (SCRAMBLE ? wave : 0)) & 7;
            for (;;) { const int tg = q_pull((unsigned*)(ctl + CW_Q + 64 * (s + 16 * rep_)), lane); if (tg >= PEER_NTASK) break;
                int t0, nt; peer_task_tokens(tg, t0, nt); peer_a_task(t0, nt, s, XQ, EX, U8, PA, lane); } }
    }
    SEAM(8);
    if (IN(9)) REP(9) {
        PHASE_TID();
        for (size_t i = (size_t)bx * NTHREADS + tid; i < (size_t)M * 128; i += (size_t)G * NTHREADS) peer_w_elem(i, EX, GT, SU, SV, SX, PA, WB);
    }
    SEAM(9);
    if (IN(10)) REP(10) {
        PHASE_TID();
        const int xcc = (int)(xb_xcc_id() & 7u);
#pragma unroll 1
#ifndef SCRAMBLE
#define SCRAMBLE 0
#endif
        for (int sl = 0; sl < 8; ++sl) { const int s = (xcc + sl + (SCRAMBLE ? wave : 0)) & 7;
            for (;;) { const int tg = q_pull((unsigned*)(ctl + CW_Q + 64 * (8 + s + 16 * rep_)), lane); if (tg >= PEER_NTASK) break;
                int t0, nt; peer_task_tokens(tg, t0, nt); peer_b_task(t0, nt, s, H1B, EX, WB, V8, R2B, ST, lane); } }
    }
    SEAM(10);
    if (IN(11)) REP(11) {
        PHASE_TID();
        const int gw = bx * NWAVES + wave, NGW = G * NWAVES;
        for (int t = gw; t < M; t += NGW) peer_c_row(t, R2B, args.out, ST, ln2_g, ln2_b, lane);
    }
#undef IN
#undef SEAM
}

extern "C" void kernel_launch(void* const* d_in, const int* in_sizes, int n_in, void* d_out, int out_size, void* d_ws, size_t ws_size, hipStream_t stream) {
    static int grid = 0;
    if (grid == 0) {
        if (n_in != 16 || out_size != M * D || ws_size < WS_END) { fprintf(stderr, "kernel_launch: unexpected shapes (n_in %d out %d ws %zu)\n", n_in, out_size, ws_size); grid = -1; return; }
        int dev = 0, cus = 0, per_cu = 0;
        if (hipGetDevice(&dev) != hipSuccess || hipDeviceGetAttribute(&cus, hipDeviceAttributeMultiprocessorCount, dev) != hipSuccess) { grid = -1; return; }
        if (hipFuncSetAttribute((const void*)mk_fwd, hipFuncAttributeMaxDynamicSharedMemorySize, LDS_BYTES) != hipSuccess) { fprintf(stderr, "kernel_launch: hipFuncSetAttribute failed\n"); grid = -1; return; }
        if (hipOccupancyMaxActiveBlocksPerMultiprocessor(&per_cu, (const void*)mk_fwd, NTHREADS, LDS_BYTES) != hipSuccess || per_cu < 1) { fprintf(stderr, "kernel_launch: occupancy query says %d\n", per_cu); per_cu = 1; }
        (void)hipGetLastError();
        if (per_cu > 1) per_cu = 1;
        grid = cus * per_cu;
    }
    if (grid < 0) return;
    if (hipMemsetAsync((char*)d_ws + WS_CTL, 0, CTL_ZERO_BYTES, stream) != hipSuccess) { fprintf(stderr, "kernel_launch: memset failed\n"); return; }
    Args a{};
    for (int i = 0; i < 16; ++i) a.in[i] = (const float*)d_in[i];
    a.out = (float*)d_out; a.ws = (unsigned char*)d_ws;
#if MK_PER_PHASE
    for (int p = 0; p < N_PHASES; ++p) { a.ph_lo = p; a.ph_hi = p + 1; hipLaunchKernelGGL(mk_fwd, dim3(grid), dim3(NTHREADS), LDS_BYTES, stream, a); }
#else
    a.ph_lo = 0; a.ph_hi = N_PHASES;
    void* kargs[] = {&a};
#ifdef PLAIN_LAUNCH
    (void)kargs; hipLaunchKernelGGL(mk_fwd, dim3(grid), dim3(NTHREADS), LDS_BYTES, stream, a); hipError_t e = hipPeekAtLastError();
#else
    hipError_t e = hipLaunchCooperativeKernel((const void*)mk_fwd, dim3(grid), dim3(NTHREADS), kargs, LDS_BYTES, stream);
#endif
    if (e != hipSuccess) fprintf(stderr, "kernel_launch: cooperative launch failed: %s (grid %d)\n", hipGetErrorString(e), grid);
#endif
}
```

```cpp
#include <hip/hip_runtime.h>
#include <cstdio>
#include <cstdint>
#include <type_traits>
namespace pg8 {
#define PG8_LAS __attribute__((address_space(3)))
typedef unsigned short bf16_t;
typedef short bf16x8 __attribute__((ext_vector_type(8)));
typedef float f32x4 __attribute__((ext_vector_type(4)));
typedef unsigned u32x4 __attribute__((ext_vector_type(4)));
constexpr int BM = 256, BK = 64, HALF = 128, HTB = HALF * BK * 2  , STAGE_BYTES = 8 * HTB, NXCD = 8, WGM = 8;

__host__ __device__ __forceinline__ int lds_byte(int r, int c) { const int st = (r >> 4) * 2 + (c >> 5), rr = r & 15, cc = c & 31, ob = rr * 64 + cc * 2; return st * 1024 + (ob ^ (((ob >> 9) & 1) << 5)); }
__host__ __device__ __forceinline__ void stage_rc(int b, int& R, int& C) { const int st = b / 1024, sb = b % 1024, swz = sb ^ (((sb >> 9) & 1) << 5); R = (st >> 1) * 16 + swz / 64; C = (st & 1) * 32 + (swz % 64) / 2; }
__host__ __device__ __forceinline__ int perm32(int rho) { const int n = rho >> 4, i = rho & 15; return 8 * (i >> 2) + 4 * n + (i & 3); }

struct Unit { int pm, pn, w; };
struct Gemm { const bf16_t* A; const bf16_t* Bt; int M, N, K; const bf16_t* A2 = nullptr; const bf16_t* Bt2 = nullptr; };

struct StaticOrder {
    int nM, nN, nwg, G, c;
    __host__ __device__ void init(int M, int N, int G_, int c_) { nM = M / BM; nN = N / BM; nwg = nM * nN; G = G_; c = c_; }
    __host__ __device__ bool next(int i, Unit& u) const {
        const long L = (long)i * G + c; if (L >= nwg) return false;
        int wgid = (int)L; { const int q = nwg / NXCD, r = nwg % NXCD, xcd = wgid % NXCD, off = wgid / NXCD; wgid = (xcd < r ? xcd * (q + 1) : r * (q + 1) + (xcd - r) * q) + off; }
        const int nig = WGM * nN, gid = wgid / nig, fm = gid * WGM, gsz = (nM - fm) < WGM ? (nM - fm) : WGM;
        u.pm = fm + ((wgid % nig) % gsz); u.pn = (wgid % nig) / gsz; u.w = 0; return true;
    }
    __device__ __forceinline__ void a_ready(const Unit&) const {}
    __device__ __forceinline__ void done(const Unit&) const {}
};


__device__ __forceinline__ unsigned cvt_pk_bf16(float lo, float hi) { unsigned r; asm volatile("v_cvt_pk_bf16_f32 %0, %1, %2" : "=v"(r) : "v"(lo), "v"(hi)); return r; }
__device__ __forceinline__ float bf_lo(unsigned w) { return __builtin_bit_cast(float, w << 16); }
__device__ __forceinline__ float bf_hi(unsigned w) { return __builtin_bit_cast(float, w & 0xffff0000u); }
__device__ __forceinline__ float sigmoidf_(float x) { return __builtin_amdgcn_rcpf(1.0f + __expf(-x)); }

struct EpiBf16 {
    static constexpr bool PERM = true, AFTER_DRAIN = false;
    bf16_t* O; int ldc;
    __device__ __forceinline__ void operator()(const f32x4 (&acc)[2][2][4][2], const Unit& u, int wr, int wc, int fr, int fq) const {
        const int row0 = u.pm * BM + wr * 64 + fr, col0 = u.pn * BM + wc * 32 + 8 * fq;
#pragma unroll
        for (int ai = 0; ai < 2; ++ai)
#pragma unroll
            for (int m = 0; m < 4; ++m) { bf16_t* rowp = O + (size_t)(row0 + ai * HALF + m * 16) * ldc + col0;
#pragma unroll
                for (int bj = 0; bj < 2; ++bj) { const f32x4 v0 = acc[ai][bj][m][0], v1 = acc[ai][bj][m][1];
                    u32x4 w; w.x = cvt_pk_bf16(v0[0], v0[1]); w.y = cvt_pk_bf16(v0[2], v0[3]); w.z = cvt_pk_bf16(v1[0], v1[1]); w.w = cvt_pk_bf16(v1[2], v1[3]);
                    *(u32x4*)(rowp + bj * HALF) = w; } }
    }
};
template <int SECOND> struct EpiGate {
    static constexpr bool PERM = true, AFTER_DRAIN = false;
    bf16_t* O; const bf16_t* T; const bf16_t* Zg; const float* bg; int ldc, ldz;
    __device__ __forceinline__ void operator()(const f32x4 (&acc)[2][2][4][2], const Unit& u, int wr, int wc, int fr, int fq) const {
        const int row0 = u.pm * BM + wr * 64 + fr, col0 = u.pn * BM + wc * 32 + 8 * fq;
        f32x4 bv[2][2];
#pragma unroll
        for (int bj = 0; bj < 2; ++bj)
#pragma unroll
            for (int n = 0; n < 2; ++n) bv[bj][n] = *(const f32x4*)(bg + col0 + bj * HALF + 4 * n);
#pragma unroll
        for (int ai = 0; ai < 2; ++ai)
#pragma unroll
            for (int m = 0; m < 4; ++m) { const size_t row = (size_t)(row0 + ai * HALF + m * 16);
#pragma unroll
                for (int bj = 0; bj < 2; ++bj) { const int c = col0 + bj * HALF;
                    const u32x4 zg = *(const u32x4*)(Zg + row * ldz + c);
                    f32x4 v0 = acc[ai][bj][m][0], v1 = acc[ai][bj][m][1];
                    v0[0] *= sigmoidf_(bf_lo(zg.x) + bv[bj][0][0]); v0[1] *= sigmoidf_(bf_hi(zg.x) + bv[bj][0][1]);
                    v0[2] *= sigmoidf_(bf_lo(zg.y) + bv[bj][0][2]); v0[3] *= sigmoidf_(bf_hi(zg.y) + bv[bj][0][3]);
                    v1[0] *= sigmoidf_(bf_lo(zg.z) + bv[bj][1][0]); v1[1] *= sigmoidf_(bf_hi(zg.z) + bv[bj][1][1]);
                    v1[2] *= sigmoidf_(bf_lo(zg.w) + bv[bj][1][2]); v1[3] *= sigmoidf_(bf_hi(zg.w) + bv[bj][1][3]);
                    if (SECOND) { const u32x4 t = *(const u32x4*)(T + row * ldc + c);
                        v0[0] += bf_lo(t.x); v0[1] += bf_hi(t.x); v0[2] += bf_lo(t.y); v0[3] += bf_hi(t.y);
                        v1[0] += bf_lo(t.z); v1[1] += bf_hi(t.z); v1[2] += bf_lo(t.w); v1[3] += bf_hi(t.w); }
                    u32x4 w; w.x = cvt_pk_bf16(v0[0], v0[1]); w.y = cvt_pk_bf16(v0[2], v0[3]); w.z = cvt_pk_bf16(v1[0], v1[1]); w.w = cvt_pk_bf16(v1[2], v1[3]);
                    *(u32x4*)(O + row * ldc + c) = w; } }
    }
};
struct EpiF32 {
    static constexpr bool PERM = false, AFTER_DRAIN = false;
    float* C; int ldc; const float* R; float scale;
    __device__ __forceinline__ void operator()(const f32x4 (&acc)[2][2][4][2], const Unit& u, int wr, int wc, int fr, int fq) const {
        const int row0 = u.pm * BM + wr * 64 + fr, col0 = u.pn * BM + wc * 32 + 4 * fq;
#pragma unroll
        for (int ai = 0; ai < 2; ++ai)
#pragma unroll
            for (int m = 0; m < 4; ++m) { const size_t off = (size_t)(row0 + ai * HALF + m * 16) * ldc + col0;
#pragma unroll
                for (int bj = 0; bj < 2; ++bj)
#pragma unroll
                    for (int n = 0; n < 2; ++n) { f32x4 v = acc[ai][bj][m][n];
                        if (R) v += *(const f32x4*)(R + off + bj * HALF + n * 16) * scale;
                        *(f32x4*)(C + off + bj * HALF + n * 16) = v; } }
    }
};
struct EpiResBf16 {
    static constexpr bool PERM = true, AFTER_DRAIN = false;
    bf16_t* O; int ldc; const float* R; float scale;
    __device__ __forceinline__ void operator()(const f32x4 (&acc)[2][2][4][2], const Unit& u, int wr, int wc, int fr, int fq) const {
        const int row0 = u.pm * BM + wr * 64 + fr, col0 = u.pn * BM + wc * 32 + 8 * fq;
#pragma unroll
        for (int ai = 0; ai < 2; ++ai)
#pragma unroll
            for (int m = 0; m < 4; ++m) { const size_t off = (size_t)(row0 + ai * HALF + m * 16) * ldc + col0;
#pragma unroll
                for (int bj = 0; bj < 2; ++bj) { const f32x4 r0 = *(const f32x4*)(R + off + bj * HALF), r1 = *(const f32x4*)(R + off + bj * HALF + 4);
                    const f32x4 v0 = acc[ai][bj][m][0] + r0 * scale, v1 = acc[ai][bj][m][1] + r1 * scale;
                    u32x4 w; w.x = cvt_pk_bf16(v0[0], v0[1]); w.y = cvt_pk_bf16(v0[2], v0[3]); w.z = cvt_pk_bf16(v1[0], v1[1]); w.w = cvt_pk_bf16(v1[2], v1[3]);
                    *(u32x4*)(O + off + bj * HALF) = w; } }
    }
};
typedef int i32x4e __attribute__((ext_vector_type(4)));
struct EpiI8Bf16 {
    static constexpr bool PERM = true, AFTER_DRAIN = false;
    bf16_t* O; int ldc; const float* sa; const float* sb;
    __device__ __forceinline__ void operator()(const i32x4e (&acc)[2][2][4][2], const Unit& u, int wr, int wc, int fr, int fq) const {
        const int row0 = u.pm * BM + wr * 64 + fr, col0 = u.pn * BM + wc * 32 + 8 * fq;
        f32x4 sbv[2][2];
#pragma unroll
        for (int bj = 0; bj < 2; ++bj)
#pragma unroll
            for (int n = 0; n < 2; ++n) sbv[bj][n] = *(const f32x4*)(sb + col0 + bj * HALF + 4 * n);
#pragma unroll
        for (int ai = 0; ai < 2; ++ai)
#pragma unroll
            for (int m = 0; m < 4; ++m) { const int row = row0 + ai * HALF + m * 16; const float sr = sa[row]; bf16_t* rowp = O + (size_t)row * ldc + col0;
#pragma unroll
                for (int bj = 0; bj < 2; ++bj) { const i32x4e a0 = acc[ai][bj][m][0], a1 = acc[ai][bj][m][1];
                    const f32x4 v0 = (f32x4){(float)a0[0], (float)a0[1], (float)a0[2], (float)a0[3]} * sbv[bj][0] * sr, v1 = (f32x4){(float)a1[0], (float)a1[1], (float)a1[2], (float)a1[3]} * sbv[bj][1] * sr;
                    u32x4 w; w.x = cvt_pk_bf16(v0[0], v0[1]); w.y = cvt_pk_bf16(v0[2], v0[3]); w.z = cvt_pk_bf16(v1[0], v1[1]); w.w = cvt_pk_bf16(v1[2], v1[3]);
                    *(u32x4*)(rowp + bj * HALF) = w; } }
    }
};
template <int SECOND> struct EpiGateI8 {
    static constexpr bool PERM = true, AFTER_DRAIN = false;
    bf16_t* O; const bf16_t* T; const bf16_t* Zg; const float* bg; int ldc, ldz; const float* sa; const float* sb;
    __device__ __forceinline__ void operator()(const i32x4e (&acc)[2][2][4][2], const Unit& u, int wr, int wc, int fr, int fq) const {
        const int row0 = u.pm * BM + wr * 64 + fr, col0 = u.pn * BM + wc * 32 + 8 * fq;
        f32x4 bv[2][2], sbv[2][2];
#pragma unroll
        for (int bj = 0; bj < 2; ++bj)
#pragma unroll
            for (int n = 0; n < 2; ++n) { bv[bj][n] = *(const f32x4*)(bg + col0 + bj * HALF + 4 * n); sbv[bj][n] = *(const f32x4*)(sb + col0 + bj * HALF + 4 * n); }
#pragma unroll
        for (int ai = 0; ai < 2; ++ai)
#pragma unroll
            for (int m = 0; m < 4; ++m) { const size_t row = (size_t)(row0 + ai * HALF + m * 16); const float sr = sa[row];
#pragma unroll
                for (int bj = 0; bj < 2; ++bj) { const int c = col0 + bj * HALF;
                    const u32x4 zg = *(const u32x4*)(Zg + row * ldz + c);
                    const i32x4e a0 = acc[ai][bj][m][0], a1 = acc[ai][bj][m][1];
                    f32x4 v0 = (f32x4){(float)a0[0], (float)a0[1], (float)a0[2], (float)a0[3]} * sbv[bj][0] * sr, v1 = (f32x4){(float)a1[0], (float)a1[1], (float)a1[2], (float)a1[3]} * sbv[bj][1] * sr;
                    v0[0] *= sigmoidf_(bf_lo(zg.x) + bv[bj][0][0]); v0[1] *= sigmoidf_(bf_hi(zg.x) + bv[bj][0][1]);
                    v0[2] *= sigmoidf_(bf_lo(zg.y) + bv[bj][0][2]); v0[3] *= sigmoidf_(bf_hi(zg.y) + bv[bj][0][3]);
                    v1[0] *= sigmoidf_(bf_lo(zg.z) + bv[bj][1][0]); v1[1] *= sigmoidf_(bf_hi(zg.z) + bv[bj][1][1]);
                    v1[2] *= sigmoidf_(bf_lo(zg.w) + bv[bj][1][2]); v1[3] *= sigmoidf_(bf_hi(zg.w) + bv[bj][1][3]);
                    if (SECOND) { const u32x4 t = *(const u32x4*)(T + row * ldc + c);
                        v0[0] += bf_lo(t.x); v0[1] += bf_hi(t.x); v0[2] += bf_lo(t.y); v0[3] += bf_hi(t.y);
                        v1[0] += bf_lo(t.z); v1[1] += bf_hi(t.z); v1[2] += bf_lo(t.w); v1[3] += bf_hi(t.w); }
                    u32x4 w; w.x = cvt_pk_bf16(v0[0], v0[1]); w.y = cvt_pk_bf16(v0[2], v0[3]); w.z = cvt_pk_bf16(v1[0], v1[1]); w.w = cvt_pk_bf16(v1[2], v1[3]);
                    *(u32x4*)(O + row * ldc + c) = w; } }
    }
};

typedef int i32x4 __attribute__((ext_vector_type(4)));
template <class Epi, class Sched, bool ALIGN_EPI = false, bool SP2 = false, bool I8 = false>
__device__ __forceinline__ void gemm_phase(PG8_LAS unsigned char* lds, const Gemm g, const Sched& S, const Epi& E) {
    int tid_ = threadIdx.x; asm volatile("" : "+v"(tid_));
    const int tid = tid_, wid = __builtin_amdgcn_readfirstlane(tid >> 6), lane = tid & 63, wr = wid >> 2, wc = wid & 3, fr = lane & 15, fq = lane >> 4;
    const int K = g.K, nt = K / BK;
    unsigned voffA[2], voffB[2];
#pragma unroll
    for (int i = 0; i < 2; ++i) { int R, C; stage_rc(tid * 16 + i * 8192, R, C); const int Rb = Epi::PERM ? ((R & ~31) + perm32(R & 31)) : R;
        voffA[i] = (unsigned)(R * K + C) * 2u; voffB[i] = (unsigned)(Rb * K + C) * 2u; }
    const size_t kstep = (size_t)(BK * 2);
    const size_t hstep = (size_t)HALF * K * 2;
    const size_t tstep = 2 * hstep;
    const unsigned ldsw = (unsigned)wid * 1024u;
    const int aoff = lds_byte(wr * 64 + fr, fq * 8), boff = lds_byte(wc * 32 + fr, fq * 8);
#define PG8_SA(b, h) (((b) * 2 + (h)) * HTB)
#define PG8_SB(b, h) ((4 + (b) * 2 + (h)) * HTB)
#define PG8_STAGE(bufoff, gbase, voff) do { _Pragma("unroll") for (int _i = 0; _i < 2; ++_i) \
        __builtin_amdgcn_global_load_lds((const unsigned*)((const char*)(gbase) + (voff)[_i]), (PG8_LAS unsigned*)(lds + (bufoff) + ldsw + _i * 8192), 16, 0, 0); } while (0)
#define PG8_LDA(dst, b, h) do { _Pragma("unroll") for (int m = 0; m < 4; ++m) _Pragma("unroll") for (int k = 0; k < 2; ++k) dst[m][k] = *(const PG8_LAS bf16x8*)(lds + PG8_SA(b, h) + aoff + m * 2048 + k * 1024); } while (0)
#define PG8_LDB(dst, b, h) do { _Pragma("unroll") for (int n = 0; n < 2; ++n) _Pragma("unroll") for (int k = 0; k < 2; ++k) dst[n][k] = *(const PG8_LAS bf16x8*)(lds + PG8_SB(b, h) + boff + n * 2048 + k * 1024); } while (0)
#define PG8_MMA(ai, bj, At, Bt) do { __builtin_amdgcn_s_setprio(1); _Pragma("unroll") for (int m = 0; m < 4; ++m) _Pragma("unroll") for (int n = 0; n < 2; ++n) _Pragma("unroll") for (int k = 0; k < 2; ++k) \
        { if constexpr (I8) acc[ai][bj][m][n] = __builtin_bit_cast(acc_t, __builtin_amdgcn_mfma_i32_16x16x64_i8(__builtin_bit_cast(i32x4, Bt[n][k]), __builtin_bit_cast(i32x4, At[m][k]), __builtin_bit_cast(i32x4, acc[ai][bj][m][n]), 0, 0, 0)); \
          else acc[ai][bj][m][n] = __builtin_bit_cast(acc_t, __builtin_amdgcn_mfma_f32_16x16x32_bf16(Bt[n][k], At[m][k], __builtin_bit_cast(f32x4, acc[ai][bj][m][n]), 0, 0, 0)); } __builtin_amdgcn_s_setprio(0); } while (0)
#define PG8_WAIT_V(n) asm volatile("s_waitcnt vmcnt(" #n ")" ::: "memory")
#define PG8_WAIT_L(n) asm volatile("s_waitcnt lgkmcnt(" #n ")" ::: "memory")
#define PG8_BAR __builtin_amdgcn_s_barrier()
#define PG8_SCHED __builtin_amdgcn_sched_barrier(0)
    Unit cur, nxt; int ui = 0;
    if (!S.next(0, cur)) return;
    typedef typename std::conditional<I8, i32x4, f32x4>::type acc_t;
    acc_t acc[2][2][4][2];
#pragma unroll
    for (int a = 0; a < 2; ++a)
#pragma unroll
        for (int b = 0; b < 2; ++b)
#pragma unroll
            for (int m = 0; m < 4; ++m)
#pragma unroll
                for (int n = 0; n < 2; ++n) acc[a][b][m][n] = acc_t{};
    bf16x8 At[4][2], B0[2][2], B1[2][2];
    const char* cA = (const char*)(cur.w ? g.A2 : g.A) + (size_t)cur.pm * tstep; const char* cB = (const char*)(cur.w ? g.Bt2 : g.Bt) + (size_t)cur.pn * tstep;
    S.a_ready(cur);
    if constexpr (SP2) {
        PG8_STAGE(PG8_SB(0, 0), cB, voffB); PG8_STAGE(PG8_SB(0, 1), cB + hstep, voffB); PG8_STAGE(PG8_SA(0, 0), cA, voffA); PG8_STAGE(PG8_SA(0, 1), cA + hstep, voffA);
        if (wr == 1) PG8_BAR;
        PG8_WAIT_V(2); PG8_BAR;
        PG8_STAGE(PG8_SB(1, 0), cB + kstep, voffB); PG8_STAGE(PG8_SA(1, 0), cA + kstep, voffA); PG8_STAGE(PG8_SB(1, 1), cB + hstep + kstep, voffB);
        PG8_WAIT_V(6); PG8_BAR;
    } else {
        PG8_STAGE(PG8_SB(0, 0), cB, voffB); PG8_STAGE(PG8_SA(0, 0), cA, voffA); PG8_STAGE(PG8_SB(0, 1), cB + hstep, voffB); PG8_STAGE(PG8_SA(0, 1), cA + hstep, voffA);
        if (wr == 1) PG8_BAR;
        PG8_WAIT_V(4); PG8_BAR;
        PG8_STAGE(PG8_SB(1, 0), cB + kstep, voffB); PG8_STAGE(PG8_SA(1, 0), cA + kstep, voffA); PG8_STAGE(PG8_SB(1, 1), cB + hstep + kstep, voffB);
        PG8_WAIT_V(6); PG8_BAR;
    }
    for (;;) {
        const bool has_next = S.next(ui + 1, nxt);
        const char* nA = has_next ? (const char*)(nxt.w ? g.A2 : g.A) + (size_t)nxt.pm * tstep : cA; const char* nB = has_next ? (const char*)(nxt.w ? g.Bt2 : g.Bt) + (size_t)nxt.pn * tstep : cB;
        for (int t = 0; t < nt; t += 2) {
            const bool last = (t == nt - 2);
            const char* a1 = cA + (size_t)(t + 1) * kstep;
            const char* a2 = last ? nA : cA + (size_t)(t + 2) * kstep; const char* b2 = last ? nB : cB + (size_t)(t + 2) * kstep;
            const char* a3 = a2 + kstep; const char* b3 = b2 + kstep;
            if (last && has_next) S.a_ready(nxt);
            if constexpr (SP2) {
            PG8_LDB(B0, 0, 0); PG8_LDB(B1, 0, 1); PG8_SCHED; PG8_LDA(At, 0, 0); PG8_STAGE(PG8_SA(1, 1), a1 + hstep, voffA);
            PG8_WAIT_V(8); PG8_WAIT_L(0); PG8_BAR; PG8_MMA(0, 0, At, B0); PG8_MMA(0, 1, At, B1); PG8_BAR; PG8_SCHED;
            PG8_LDA(At, 0, 1); PG8_STAGE(PG8_SB(0, 0), b2, voffB); PG8_STAGE(PG8_SB(0, 1), b2 + hstep, voffB); PG8_STAGE(PG8_SA(0, 0), a2, voffA);
            PG8_WAIT_V(8); PG8_WAIT_L(0); PG8_BAR; PG8_MMA(1, 0, At, B0); PG8_MMA(1, 1, At, B1); PG8_BAR; PG8_SCHED;
            PG8_LDB(B0, 1, 0); PG8_LDB(B1, 1, 1); PG8_SCHED; PG8_LDA(At, 1, 0); PG8_STAGE(PG8_SA(0, 1), a2 + hstep, voffA);
            PG8_WAIT_V(8); PG8_WAIT_L(0); PG8_BAR; PG8_MMA(0, 0, At, B0); PG8_MMA(0, 1, At, B1); PG8_BAR; PG8_SCHED;
            PG8_LDA(At, 1, 1); PG8_STAGE(PG8_SB(1, 0), b3, voffB); PG8_STAGE(PG8_SB(1, 1), b3 + hstep, voffB); PG8_STAGE(PG8_SA(1, 0), a3, voffA);
            PG8_WAIT_V(8); PG8_WAIT_L(0); PG8_BAR; PG8_MMA(1, 0, At, B0); PG8_MMA(1, 1, At, B1); PG8_BAR; PG8_SCHED;
            } else {
            PG8_LDB(B0, 0, 0); PG8_SCHED; PG8_LDA(At, 0, 0); PG8_STAGE(PG8_SA(1, 1), a1 + hstep, voffA);
            PG8_WAIT_L(8); PG8_BAR; PG8_WAIT_L(0); PG8_MMA(0, 0, At, B0); PG8_BAR; PG8_SCHED;
            PG8_LDB(B1, 0, 1); PG8_STAGE(PG8_SB(0, 0), b2, voffB);
            PG8_BAR; PG8_WAIT_L(0); PG8_MMA(0, 1, At, B1); PG8_BAR;
            PG8_LDA(At, 0, 1); PG8_STAGE(PG8_SA(0, 0), a2, voffA);
            PG8_BAR; PG8_WAIT_L(0); PG8_MMA(1, 0, At, B0); PG8_BAR; PG8_SCHED;
            PG8_STAGE(PG8_SB(0, 1), b2 + hstep, voffB);
            PG8_WAIT_V(6); PG8_BAR; PG8_MMA(1, 1, At, B1); PG8_BAR;
            PG8_LDB(B0, 1, 0); PG8_SCHED; PG8_LDA(At, 1, 0); PG8_STAGE(PG8_SA(0, 1), a2 + hstep, voffA);
            PG8_WAIT_L(8); PG8_BAR; PG8_WAIT_L(0); PG8_MMA(0, 0, At, B0); PG8_BAR; PG8_SCHED;
            PG8_LDB(B1, 1, 1); PG8_STAGE(PG8_SB(1, 0), b3, voffB);
            PG8_BAR; PG8_WAIT_L(0); PG8_MMA(0, 1, At, B1); PG8_BAR;
            PG8_LDA(At, 1, 1); PG8_STAGE(PG8_SA(1, 0), a3, voffA);
            PG8_BAR; PG8_WAIT_L(0); PG8_MMA(1, 0, At, B0); PG8_BAR; PG8_SCHED;
            PG8_STAGE(PG8_SB(1, 1), b3 + hstep, voffB);
            PG8_WAIT_V(6); PG8_BAR; PG8_MMA(1, 1, At, B1); PG8_BAR;
            }
        }
        if constexpr (ALIGN_EPI) { if (wr == 0) PG8_BAR; }
        if constexpr (!Epi::AFTER_DRAIN) { E(acc, cur, wr, wc, fr, fq); S.done(cur); }
        if (!has_next) break;
#pragma unroll
        for (int a = 0; a < 2; ++a)
#pragma unroll
            for (int b = 0; b < 2; ++b)
#pragma unroll
                for (int m = 0; m < 4; ++m)
#pragma unroll
                    for (int n = 0; n < 2; ++n) acc[a][b][m][n] = acc_t{};
        cur = nxt; cA = nA; cB = nB; ++ui;
        if constexpr (ALIGN_EPI) { if (wr == 1) PG8_BAR; }
    }
    PG8_WAIT_V(0);
    if constexpr (!ALIGN_EPI) { if (wr == 0) PG8_BAR; }
    PG8_BAR;
    if constexpr (Epi::AFTER_DRAIN) { E.fused(acc, cur, wr, wc, fr, fq, lds, wid, lane); S.done(cur); }
#undef PG8_SA
#undef PG8_SB
#undef PG8_STAGE
#undef PG8_LDA
#undef PG8_LDB
#undef PG8_MMA
#undef PG8_WAIT_V
#undef PG8_WAIT_L
#undef PG8_BAR
#undef PG8_SCHED
}
}
#define GAS __attribute__((address_space(1)))
#define LAS __attribute__((address_space(3)))
typedef unsigned short bf16;
typedef unsigned v4u __attribute__((ext_vector_type(4)));
typedef float f32x4 __attribute__((ext_vector_type(4)));
typedef short bf16x8 __attribute__((ext_vector_type(8)));
typedef GAS unsigned gu32;
typedef GAS unsigned long long gu64;
#define RLX_AGENT __ATOMIC_RELAXED, __HIP_MEMORY_SCOPE_AGENT
#define LDS_WAIT() asm volatile("s_waitcnt lgkmcnt(0)" ::: "memory")
#define VM_WAIT() asm volatile("s_waitcnt vmcnt(0)" ::: "memory")
__device__ __forceinline__ unsigned long long rt() { return __builtin_amdgcn_s_memrealtime(); }
__device__ __forceinline__ unsigned f2bf(float f) { unsigned u = __builtin_bit_cast(unsigned, f); return (u + 0x7fffu + ((u >> 16) & 1u)) >> 16; }
__device__ __forceinline__ unsigned pk2(float lo, float hi) { return f2bf(lo) | (f2bf(hi) << 16); }

#define XB_TMO      128
#define XB_XCNT(j)  (256  + 64 * (j))
#define XB_XSUB(j)  (1280 + 64 * (j))
#define XB_XGEN(j)  (2304 + 64 * (j))
#define XB_TOP      3328
#define XB_TOPGEN   3392
#define XCD_BAR_WORDS 3456
#define XB_SPIN_CAP (1u << 18)

__device__ __forceinline__ unsigned xb_ld(unsigned* p)              { return __hip_atomic_load(p, __ATOMIC_RELAXED, __HIP_MEMORY_SCOPE_AGENT); }
__device__ __forceinline__ unsigned xb_add(unsigned* p, unsigned v) { return __hip_atomic_fetch_add(p, v, __ATOMIC_RELAXED, __HIP_MEMORY_SCOPE_AGENT); }
__device__ __forceinline__ unsigned xb_xcc_id() { return (unsigned)__builtin_amdgcn_s_getreg((3 << 11) | 20) & 0xFu; }
#define XB_SPIN(cond, bar) do { unsigned _sp = 0; while (cond) { __builtin_amdgcn_s_sleep(1); \
    if ((++_sp & 255u) == 0u) { if (xb_ld(&(bar)[XB_TMO])) break; if (_sp > XB_SPIN_CAP) { atomicAdd(&(bar)[XB_TMO], 1u); break; } } } } while (0)

struct XcdBarrier {
    unsigned* bar; unsigned x;
    volatile LAS unsigned* st;
};

__device__ __forceinline__ XcdBarrier xcd_barrier_post(unsigned* bar, volatile LAS unsigned* st) {
    XcdBarrier b; b.bar = bar; b.x = xb_xcc_id(); b.st = st;
    if (threadIdx.x == 0) (void)xb_add(&bar[XB_XCNT(b.x)], 1u);
    return b;
}
__device__ __forceinline__ void xcd_barrier_complete(unsigned* bar, unsigned x, unsigned& nloc, unsigned& nx) {
    const unsigned G = gridDim.x * gridDim.y * gridDim.z;
    unsigned sum, cnt, mine, sp = 0u;
    for (;;) {
        sum = 0u; cnt = 0u; mine = 0u;
#pragma unroll
        for (unsigned j = 0; j < 16; ++j) { const unsigned c = xb_ld(&bar[XB_XCNT(j)]); sum += c; cnt += (c > 0u) ? 1u : 0u; mine = (j == x) ? c : mine; }
        if (sum == G) break;
        __builtin_amdgcn_s_sleep(1);
        if ((++sp & 255u) == 0u) { if (xb_ld(&bar[XB_TMO])) break; if (sp > XB_SPIN_CAP) { atomicAdd(&bar[XB_TMO], 1u); break; } }
    }
    nloc = mine > 0u ? mine : 1u; nx = cnt > 0u ? cnt : 1u;
}

__device__ __forceinline__ void xcd_barrier(const XcdBarrier& b) {
    asm volatile("s_waitcnt vmcnt(0)" ::: "memory");
    __syncthreads();
    if (threadIdx.x == 0) {
        unsigned* bar = b.bar;
        __builtin_amdgcn_s_waitcnt(0);
        unsigned nloc = b.st[0], nx = b.st[1];
        if (nloc == 0u) { xcd_barrier_complete(bar, b.x, nloc, nx); b.st[0] = nloc; b.st[1] = nx; }
        const unsigned old = xb_add(&bar[XB_XSUB(b.x)], 1u);
        const unsigned gen = old / nloc;
        if (old + 1u == (gen + 1u) * nloc) {
            __builtin_amdgcn_fence(__ATOMIC_RELEASE, "agent");
            asm volatile("s_waitcnt vmcnt(0)" ::: "memory");
            const unsigned og = xb_add(&bar[XB_TOP], 1u);
            const unsigned tg = og / nx;
            if (og + 1u == (tg + 1u) * nx) xb_add(&bar[XB_TOPGEN], 1u);
            else XB_SPIN(xb_ld(&bar[XB_TOPGEN]) == tg, bar);
            __builtin_amdgcn_fence(__ATOMIC_ACQUIRE, "agent");
            xb_add(&bar[XB_XGEN(b.x)], 1u);
            asm volatile("s_waitcnt vmcnt(0)" ::: "memory");
        } else {
            XB_SPIN(xb_ld(&bar[XB_XGEN(b.x)]) == gen, bar);
            __builtin_amdgcn_fence(__ATOMIC_ACQUIRE, "agent");
            asm volatile("s_waitcnt vmcnt(0)" ::: "memory");
        }
    }
    __syncthreads();
}

constexpr int NWAVES = 8, NTHREADS = 512;
constexpr int BATCH = 4, SEQ = 2048, D = 2048, M = BATCH * SEQ;
constexpr int NQH = 32, NKVH = 4, HD = 64, QPKV = 8, WINDOW = 128;
constexpr int Q_OFF = 0, K_OFF = 2048, V_OFF = 2304, CB_OFF = 2560, CC_OFF = 4608, CH_OFF = 6656, G_OFF = 8704, IN_W = 12800;
constexpr int PH = 8, PNK = 128, PTOPK = 16, PNE = 16384;
constexpr float LN_EPS = 1e-5f;
constexpr float ALPHA = 1.189207115002721f;

#ifndef MK_PER_PHASE
#define MK_PER_PHASE 0
#endif
constexpr int N_PHASES = 12;

constexpr size_t MiB = 1u << 20;
constexpr size_t WS_CTL = 0, CTL_ZERO_BYTES = 1 * MiB;
constexpr size_t WS_WIN = 1 * MiB;
constexpr size_t WS_WA = 51 * MiB, WS_WC = 59 * MiB, WS_WO = 67 * MiB, WS_WF = 75 * MiB;
constexpr size_t WS_XB = 83 * MiB;
constexpr size_t WS_MERGED = WS_XB;
constexpr size_t WS_Z = 115 * MiB;
constexpr size_t WS_R2B = 115 * MiB;
constexpr size_t WS_H1B = 179 * MiB;
constexpr size_t WS_SC = 211 * MiB;
constexpr size_t WS_EX = 275 * MiB;
constexpr size_t WS_GT = 279 * MiB;
constexpr size_t WS_AO = 315 * MiB, WS_CI = 347 * MiB, WS_TMP = 379 * MiB;
constexpr size_t WS_U8 = 411 * MiB, WS_V8 = 443 * MiB;
constexpr size_t WS_SU = 475 * MiB, WS_SV = WS_SU + 65536;
constexpr size_t WS_PA = WS_SC;
constexpr size_t WS_XQ = 283 * MiB;
constexpr size_t WS_SX = 299 * MiB;
constexpr size_t WS_WB = 380 * MiB;
constexpr size_t WS_ST = 379 * MiB;
constexpr size_t WS_XA8 = WS_XB;
constexpr size_t WS_WIN8 = 476 * MiB;
constexpr size_t WS_SWIN = 501 * MiB, WS_SXA = WS_SWIN + 65536;
constexpr size_t WS_END = 502 * MiB;
constexpr int CW_Q = 12288;
constexpr size_t SLICE_BYTES = (size_t)PNE * 256;
constexpr int CW_BAR = 4096;

constexpr int RING_BYTES = 131072;
constexpr int LDSCTL_OFF = 147456, MISC_OFF = LDSCTL_OFF + 320;
constexpr int LDS_BYTES = LDSCTL_OFF + 512;

typedef float f32x16 __attribute__((ext_vector_type(16)));
typedef unsigned v2u __attribute__((ext_vector_type(2)));
__device__ __forceinline__ float wave_sum(float v) {
#pragma unroll
    for (int o = 1; o < 64; o <<= 1) v += __shfl_xor(v, o);
    return v;
}
__device__ __forceinline__ float vmaxf(float a, float b) { float r; asm("v_max_f32_e32 %0, %1, %2" : "=v"(r) : "v"(a), "v"(b)); return r; }
__device__ __forceinline__ float vminf(float a, float b) { float r; asm("v_min_f32_e32 %0, %1, %2" : "=v"(r) : "v"(a), "v"(b)); return r; }

__device__ __forceinline__ void p0_transpose_item(const float* W, int K, int N, bf16* WT, LAS float* scr, int item, int lane) {
    const int nblk = N / 32, kb = item / nblk, nb = item % nblk, k0 = 64 * kb, n0 = 32 * nb;
#pragma unroll 8
    for (int i = 0; i < 32; ++i) { const int kk = 2 * i + (lane >> 5); scr[kk * 33 + (lane & 31)] = W[(size_t)(k0 + kk) * N + n0 + (lane & 31)]; }
    LDS_WAIT(); asm volatile("" ::: "memory");
    const int c = lane & 7;
#pragma unroll
    for (int j = 0; j < 4; ++j) { const int n = (lane >> 3) + 8 * j; const LAS float* s = scr + (8 * c) * 33 + n;
        v4u o; o.x = pk2(s[0 * 33], s[1 * 33]); o.y = pk2(s[2 * 33], s[3 * 33]); o.z = pk2(s[4 * 33], s[5 * 33]); o.w = pk2(s[6 * 33], s[7 * 33]);
        *(GAS v4u*)(WT + (size_t)(n0 + n) * K + k0 + 8 * c) = o; }
    LDS_WAIT(); asm volatile("" ::: "memory");
}
__device__ __forceinline__ void p0_wf_item(const float* wq, const float* sk, bf16* WfT, LAS unsigned char* lds, int item, int tid) {
    const int hp = item >> 5, dt = item & 31;
    LAS f32x4* SK4 = (LAS f32x4*)lds;
    LAS f32x4* WQ4 = SK4 + 128 * 33;
    const float* skp = sk + (size_t)hp * 128 * 128;
    for (int i = tid; i < 128 * 32; i += NTHREADS) { const int n = i >> 5, c4 = i & 31; SK4[n * 33 + c4] = *(const f32x4*)(skp + n * 128 + 4 * c4); }
    for (int i = tid; i < 64 * 32; i += NTHREADS) { const int r = i >> 5, c4 = i & 31; WQ4[r * 33 + c4] = *(const f32x4*)(wq + (size_t)(64 * dt + r) * 2048 + hp * 128 + 4 * c4); }
    __syncthreads();
    const int td = tid & 15, tn = tid >> 4;
    float acc[4][4];
#pragma unroll
    for (int i = 0; i < 4; ++i)
#pragma unroll
        for (int j = 0; j < 4; ++j) acc[i][j] = 0.f;
#pragma unroll 4
    for (int c4 = 0; c4 < 32; ++c4) {
        f32x4 a[4], b[4];
#pragma unroll
        for (int i = 0; i < 4; ++i) a[i] = SK4[(4 * tn + i) * 33 + c4];
#pragma unroll
        for (int j = 0; j < 4; ++j) b[j] = WQ4[(td + 16 * j) * 33 + c4];
#pragma unroll
        for (int i = 0; i < 4; ++i)
#pragma unroll
            for (int j = 0; j < 4; ++j) acc[i][j] += a[i].x * b[j].x + a[i].y * b[j].y + a[i].z * b[j].z + a[i].w * b[j].w;
    }
#pragma unroll
    for (int i = 0; i < 4; ++i)
#pragma unroll
        for (int j = 0; j < 4; ++j) WfT[(size_t)(hp * 128 + 4 * tn + i) * 2048 + 64 * dt + td + 16 * j] = (bf16)f2bf(acc[i][j]);
    __syncthreads();
}

__device__ __forceinline__ int perm16(int o) { return 8 * ((o >> 2) & 1) + 4 * (o >> 3) + (o & 3); }
__device__ __forceinline__ void attn_unit(int unit, const bf16* z, bf16* ao, const float* sinks, LAS unsigned char* lds, int tid) {
    const int lane = tid & 63, wid = __builtin_amdgcn_readfirstlane(tid >> 6), r32 = lane & 31, hi = lane >> 5;
    const int nb = unit & 15, kvh = (unit >> 4) & 3, b = unit >> 6;
    LAS bf16* Ks = (LAS bf16*)lds;
    LAS bf16* Vt = (LAS bf16*)(lds + 256 * 144);
    const size_t tok0 = (size_t)b * SEQ;
#pragma unroll
    for (int i = 0; i < 4; ++i) {
        const int ci = tid + NTHREADS * i, key = ci >> 3, dc = ci & 7;
        int kpos = 128 * (nb - 1) + key; if (kpos < 0) kpos = 0;
        const bf16* src = z + (tok0 + kpos) * IN_W + K_OFF + kvh * HD + dc * 8;
        const v4u kv = *(const GAS v4u*)src, vv = *(const GAS v4u*)(src + (V_OFF - K_OFF));
        *(LAS v4u*)(Ks + key * 72 + dc * 8) = kv;
        const int pos = (key & ~15) + perm16(key & 15);
        LAS bf16* vp = Vt + (dc * 8) * 264 + pos;
        vp[0 * 264] = (bf16)(vv.x & 0xffffu); vp[1 * 264] = (bf16)(vv.x >> 16); vp[2 * 264] = (bf16)(vv.y & 0xffffu); vp[3 * 264] = (bf16)(vv.y >> 16);
        vp[4 * 264] = (bf16)(vv.z & 0xffffu); vp[5 * 264] = (bf16)(vv.z >> 16); vp[6 * 264] = (bf16)(vv.w & 0xffffu); vp[7 * 264] = (bf16)(vv.w >> 16);
    }
    __syncthreads();
    const int hq = kvh * QPKV + wid;
    const float LOG2E = 1.4426950408889634f;
    const float sink2 = sinks[hq] * LOG2E, sc = 0.125f * LOG2E;
#pragma unroll 1
    for (int qg = 0; qg < 4; ++qg) {
        const size_t tok = tok0 + 128 * nb + 32 * qg + r32;
        bf16x8 qf[4];
#pragma unroll
        for (int ks = 0; ks < 4; ++ks) qf[ks] = *(const GAS bf16x8*)(z + tok * IN_W + Q_OFF + hq * HD + 16 * ks + 8 * hi);
        f32x16 s[5];
#pragma unroll
        for (int kt = 0; kt < 5; ++kt) {
            s[kt] = (f32x16){0.f, 0.f, 0.f, 0.f, 0.f, 0.f, 0.f, 0.f, 0.f, 0.f, 0.f, 0.f, 0.f, 0.f, 0.f, 0.f};
#pragma unroll
            for (int ks = 0; ks < 4; ++ks) {
                const bf16x8 kf = *(const LAS bf16x8*)(Ks + (32 * (qg + kt) + r32) * 72 + 16 * ks + 8 * hi);
                s[kt] = __builtin_amdgcn_mfma_f32_32x32x16_bf16(kf, qf[ks], s[kt], 0, 0, 0);
            }
        }
        float mx = sink2;
#pragma unroll
        for (int kt = 0; kt < 5; ++kt) {
            const bool tile_dead = (nb == 0) && (qg + kt < 4);
#pragma unroll
            for (int r = 0; r < 16; ++r) {
                const int krow = (r & 3) + 8 * (r >> 2) + 4 * hi;
                bool valid = !tile_dead;
                if (kt == 0) valid = valid && (krow > r32);
                if (kt == 4) valid = valid && (krow <= r32);
                const float v = valid ? s[kt][r] * sc : -INFINITY;
                s[kt][r] = v; mx = fmaxf(mx, v);
            }
        }
        mx = fmaxf(mx, __shfl_xor(mx, 32));
        float sum = 0.f;
#pragma unroll
        for (int kt = 0; kt < 5; ++kt)
#pragma unroll
            for (int r = 0; r < 16; ++r) { const float p = __builtin_amdgcn_exp2f(s[kt][r] - mx); s[kt][r] = p; sum += p; }
        sum += __shfl_xor(sum, 32);
        const float inv = 1.0f / (sum + __builtin_amdgcn_exp2f(sink2 - mx));
        f32x16 o[2];
        o[0] = (f32x16){0.f, 0.f, 0.f, 0.f, 0.f, 0.f, 0.f, 0.f, 0.f, 0.f, 0.f, 0.f, 0.f, 0.f, 0.f, 0.f}; o[1] = o[0];
#pragma unroll
        for (int kt = 0; kt < 5; ++kt)
#pragma unroll
            for (int s2 = 0; s2 < 2; ++s2) {
                v4u pw; pw.x = pg8::cvt_pk_bf16(s[kt][8 * s2 + 0], s[kt][8 * s2 + 1]); pw.y = pg8::cvt_pk_bf16(s[kt][8 * s2 + 2], s[kt][8 * s2 + 3]);
                pw.z = pg8::cvt_pk_bf16(s[kt][8 * s2 + 4], s[kt][8 * s2 + 5]); pw.w = pg8::cvt_pk_bf16(s[kt][8 * s2 + 6], s[kt][8 * s2 + 7]);
                const bf16x8 pa = __builtin_bit_cast(bf16x8, pw);
#pragma unroll
                for (int dt = 0; dt < 2; ++dt) {
                    const bf16x8 vf = *(const LAS bf16x8*)(Vt + (32 * dt + r32) * 264 + 32 * (qg + kt) + 16 * s2 + 8 * hi);
                    o[dt] = __builtin_amdgcn_mfma_f32_32x32x16_bf16(vf, pa, o[dt], 0, 0, 0);
                }
            }
        bf16* op = ao + tok * D + hq * HD;
#pragma unroll
        for (int dt = 0; dt < 2; ++dt)
#pragma unroll
            for (int g = 0; g < 4; ++g) {
                v2u w; w.x = pg8::cvt_pk_bf16(o[dt][4 * g + 0] * inv, o[dt][4 * g + 1] * inv); w.y = pg8::cvt_pk_bf16(o[dt][4 * g + 2] * inv, o[dt][4 * g + 3] * inv);
                *(GAS v2u*)(op + 32 * dt + 8 * g + 4 * hi) = w;
            }
    }
    __syncthreads();
}
__device__ __forceinline__ void conv_item(int item, const bf16* z, const float* cw, bf16* ci, int tid) {
    const int c8 = tid & 255, half = tid >> 8, t0 = 32 * item + 16 * half, c0 = 8 * c8;
    float w0[8], w1[8], w2[8], u1[8], u2[8];
#pragma unroll
    for (int e = 0; e < 8; ++e) { w0[e] = cw[c0 + e]; w1[e] = cw[2048 + c0 + e]; w2[e] = cw[4096 + c0 + e]; u1[e] = 0.f; u2[e] = 0.f; }
    if ((t0 & (SEQ - 1)) != 0) {
#pragma unroll
        for (int k = 0; k < 2; ++k) {
            const bf16* zr = z + (size_t)(t0 - 2 + k) * IN_W + c0;
            const v4u a = *(const GAS v4u*)(zr + CC_OFF), h = *(const GAS v4u*)(zr + CH_OFF);
            float u[8];
            u[0] = pg8::bf_lo(a.x) * pg8::bf_lo(h.x); u[1] = pg8::bf_hi(a.x) * pg8::bf_hi(h.x); u[2] = pg8::bf_lo(a.y) * pg8::bf_lo(h.y); u[3] = pg8::bf_hi(a.y) * pg8::bf_hi(h.y);
            u[4] = pg8::bf_lo(a.z) * pg8::bf_lo(h.z); u[5] = pg8::bf_hi(a.z) * pg8::bf_hi(h.z); u[6] = pg8::bf_lo(a.w) * pg8::bf_lo(h.w); u[7] = pg8::bf_hi(a.w) * pg8::bf_hi(h.w);
#pragma unroll
            for (int e = 0; e < 8; ++e) { if (k == 0) u2[e] = u[e]; else u1[e] = u[e]; }
        }
    }
#pragma unroll 4
    for (int i = 0; i < 16; ++i) {
        const bf16* zr = z + (size_t)(t0 + i) * IN_W + c0;
        const v4u a = *(const GAS v4u*)(zr + CC_OFF), h = *(const GAS v4u*)(zr + CH_OFF), bb = *(const GAS v4u*)(zr + CB_OFF);
        float u[8], cb[8], y[8];
        u[0] = pg8::bf_lo(a.x) * pg8::bf_lo(h.x); u[1] = pg8::bf_hi(a.x) * pg8::bf_hi(h.x); u[2] = pg8::bf_lo(a.y) * pg8::bf_lo(h.y); u[3] = pg8::bf_hi(a.y) * pg8::bf_hi(h.y);
        u[4] = pg8::bf_lo(a.z) * pg8::bf_lo(h.z); u[5] = pg8::bf_hi(a.z) * pg8::bf_hi(h.z); u[6] = pg8::bf_lo(a.w) * pg8::bf_lo(h.w); u[7] = pg8::bf_hi(a.w) * pg8::bf_hi(h.w);
        cb[0] = pg8::bf_lo(bb.x); cb[1] = pg8::bf_hi(bb.x); cb[2] = pg8::bf_lo(bb.y); cb[3] = pg8::bf_hi(bb.y); cb[4] = pg8::bf_lo(bb.z); cb[5] = pg8::bf_hi(bb.z); cb[6] = pg8::bf_lo(bb.w); cb[7] = pg8::bf_hi(bb.w);
#pragma unroll
        for (int e = 0; e < 8; ++e) { y[e] = cb[e] * (w0[e] * u2[e] + w1[e] * u1[e] + w2[e] * u[e]); u2[e] = u1[e]; u1[e] = u[e]; }
        v4u o; o.x = pk2(y[0], y[1]); o.y = pk2(y[2], y[3]); o.z = pk2(y[4], y[5]); o.w = pk2(y[6], y[7]);
        *(GAS v4u*)(ci + (size_t)(t0 + i) * D + c0) = o;
    }
}

__device__ __forceinline__ unsigned pack_i8(const f32x4 v) {
    const int a = __float2int_rn(v.x), b = __float2int_rn(v.y), c = __float2int_rn(v.z), d = __float2int_rn(v.w);
    return ((unsigned)a & 0xffu) | (((unsigned)b & 0xffu) << 8) | (((unsigned)c & 0xffu) << 16) | ((unsigned)d << 24);
}
__device__ __forceinline__ unsigned pack_i8_2(float a, float b, float c, float d) {
    const int ia = __float2int_rn(a), ib = __float2int_rn(b), ic = __float2int_rn(c), id = __float2int_rn(d);
    return ((unsigned)ia & 0xffu) | (((unsigned)ib & 0xffu) << 8) | (((unsigned)ic & 0xffu) << 16) | ((unsigned)id << 24);
}
__device__ __forceinline__ void ln1_row(bf16* hbrow, signed char* xqrow, float* sxp, const float* g, const float* bta, int lane) {
    GAS v4u* xr = (GAS v4u*)hbrow + lane;
    float v[4][8]; float s = 0.f;
#pragma unroll
    for (int j = 0; j < 4; ++j) { const v4u w = xr[64 * j];
        v[j][0] = pg8::bf_lo(w.x); v[j][1] = pg8::bf_hi(w.x); v[j][2] = pg8::bf_lo(w.y); v[j][3] = pg8::bf_hi(w.y); v[j][4] = pg8::bf_lo(w.z); v[j][5] = pg8::bf_hi(w.z); v[j][6] = pg8::bf_lo(w.w); v[j][7] = pg8::bf_hi(w.w);
#pragma unroll
        for (int e = 0; e < 8; ++e) s += v[j][e]; }
    const float mean = wave_sum(s) * (1.f / D); float s2 = 0.f;
#pragma unroll
    for (int j = 0; j < 4; ++j)
#pragma unroll
        for (int e = 0; e < 8; ++e) { v[j][e] -= mean; s2 += v[j][e] * v[j][e]; }
    const float rstd = 1.f / sqrtf(wave_sum(s2) * (1.f / D) + LN_EPS);
    float mx = 0.f;
#pragma unroll
    for (int j = 0; j < 4; ++j) {
        const GAS f32x4* gp = (const GAS f32x4*)g + 2 * (lane + 64 * j); const GAS f32x4* bp = (const GAS f32x4*)bta + 2 * (lane + 64 * j);
        const f32x4 g0 = gp[0], g1 = gp[1], b0 = bp[0], b1 = bp[1];
        v[j][0] = v[j][0] * rstd * g0.x + b0.x; v[j][1] = v[j][1] * rstd * g0.y + b0.y; v[j][2] = v[j][2] * rstd * g0.z + b0.z; v[j][3] = v[j][3] * rstd * g0.w + b0.w;
        v[j][4] = v[j][4] * rstd * g1.x + b1.x; v[j][5] = v[j][5] * rstd * g1.y + b1.y; v[j][6] = v[j][6] * rstd * g1.z + b1.z; v[j][7] = v[j][7] * rstd * g1.w + b1.w;
        v4u o; o.x = pk2(v[j][0], v[j][1]); o.y = pk2(v[j][2], v[j][3]); o.z = pk2(v[j][4], v[j][5]); o.w = pk2(v[j][6], v[j][7]);
        xr[64 * j] = o;
#pragma unroll
        for (int e = 0; e < 8; ++e) mx = fmaxf(mx, fabsf(v[j][e]));
    }
#pragma unroll
    for (int o = 1; o < 64; o <<= 1) mx = fmaxf(mx, __shfl_xor(mx, o));
    const float qs = mx > 0.f ? 127.0f / mx : 1.0f;
    GAS v2u* q8 = (GAS v2u*)xqrow + lane;
#pragma unroll
    for (int j = 0; j < 4; ++j) { v2u o; o.x = pack_i8_2(v[j][0] * qs, v[j][1] * qs, v[j][2] * qs, v[j][3] * qs); o.y = pack_i8_2(v[j][4] * qs, v[j][5] * qs, v[j][6] * qs, v[j][7] * qs); q8[64 * j] = o; }
    if (lane == 0) *sxp = mx > 0.f ? mx * (1.0f / 127.0f) : 1.0f;
}

__device__ __forceinline__ void row_f32_to_i8(const float* src, signed char* dst, float* inv, int lane) {
    f32x4 v[8]; float mx = 0.f;
#pragma unroll
    for (int j = 0; j < 8; ++j) { v[j] = *((const GAS f32x4*)src + lane + 64 * j); mx = fmaxf(mx, fmaxf(fmaxf(fabsf(v[j].x), fabsf(v[j].y)), fmaxf(fabsf(v[j].z), fabsf(v[j].w)))); }
#pragma unroll
    for (int o = 1; o < 64; o <<= 1) mx = fmaxf(mx, __shfl_xor(mx, o));
    const float sc = mx > 0.f ? 127.0f / mx : 1.0f;
#pragma unroll
    for (int j = 0; j < 8; ++j) *((GAS unsigned*)dst + lane + 64 * j) = pack_i8_2(v[j].x * sc, v[j].y * sc, v[j].z * sc, v[j].w * sc);
    if (lane == 0) *inv = mx > 0.f ? mx * (1.0f / 127.0f) : 1.0f;
}
__device__ __forceinline__ void row_bf16_to_i8(const bf16* src, signed char* dst, float* inv, int lane) {
    float v[4][8]; float mx = 0.f;
#pragma unroll
    for (int j = 0; j < 4; ++j) { const v4u w = *((const GAS v4u*)src + lane + 64 * j);
        v[j][0] = pg8::bf_lo(w.x); v[j][1] = pg8::bf_hi(w.x); v[j][2] = pg8::bf_lo(w.y); v[j][3] = pg8::bf_hi(w.y); v[j][4] = pg8::bf_lo(w.z); v[j][5] = pg8::bf_hi(w.z); v[j][6] = pg8::bf_lo(w.w); v[j][7] = pg8::bf_hi(w.w);
#pragma unroll
        for (int e = 0; e < 8; ++e) mx = fmaxf(mx, fabsf(v[j][e])); }
#pragma unroll
    for (int o = 1; o < 64; o <<= 1) mx = fmaxf(mx, __shfl_xor(mx, o));
    const float sc = mx > 0.f ? 127.0f / mx : 1.0f;
#pragma unroll
    for (int j = 0; j < 4; ++j) { v2u o; o.x = pack_i8_2(v[j][0] * sc, v[j][1] * sc, v[j][2] * sc, v[j][3] * sc); o.y = pack_i8_2(v[j][4] * sc, v[j][5] * sc, v[j][6] * sc, v[j][7] * sc); *((GAS v2u*)dst + lane + 64 * j) = o; }
    if (lane == 0) *inv = mx > 0.f ? mx * (1.0f / 127.0f) : 1.0f;
}

constexpr int TK_ROWF = 136;
constexpr int TK_IDX_OFF = 256 * TK_ROWF * 4;
__device__ __forceinline__ void topk_core(LAS unsigned char* lds, size_t prob0, int pstride, int* experts, float* gates, int tid) {
    LAS float* S = (LAS float*)lds;
    LAS unsigned char* IDX = lds + TK_IDX_OFF;
    const int row = tid >> 1, sub = tid & 1;
#define TK_CE(a, b) do { const float h_ = vmaxf(a, b), l_ = vminf(a, b); a = h_; b = l_; } while (0)
#define TK_SORT16(V) do { _Pragma("unroll") for (int k_ = 2; k_ <= 16; k_ <<= 1) _Pragma("unroll") for (int j_ = k_ >> 1; j_ > 0; j_ >>= 1) _Pragma("unroll") for (int i_ = 0; i_ < 16; ++i_) { \
        const int l_i = i_ ^ j_; if (l_i > i_) { if ((i_ & k_) == 0) TK_CE(V[i_], V[l_i]); else TK_CE(V[l_i], V[i_]); } } } while (0)
#define TK_MERGE16(Lv, Xv) do { _Pragma("unroll") for (int j_ = 0; j_ < 16; ++j_) Lv[j_] = vmaxf(Lv[j_], Xv[15 - j_]); \
        _Pragma("unroll") for (int st_ = 8; st_ >= 1; st_ >>= 1) _Pragma("unroll") for (int j_ = 0; j_ < 16; ++j_) if ((j_ & st_) == 0) TK_CE(Lv[j_], Lv[j_ + st_]); } while (0)
    float L[16];
#pragma unroll
    for (int q = 0; q < 4; ++q) {
        float C[16];
#pragma unroll
        for (int i = 0; i < 4; ++i) { const int c4 = 2 * (4 * q + i) + sub;
            const f32x4 v = *(const LAS f32x4*)(S + row * TK_ROWF + 4 * c4);
#pragma unroll
            for (int e = 0; e < 4; ++e) { const float ve = v[e];
                C[4 * i + e] = __uint_as_float((__float_as_uint(ve) & ~0x7Fu) | (unsigned)(4 * c4 + e)); } }
        TK_SORT16(C);
        if (q == 0) {
#pragma unroll
            for (int j = 0; j < 16; ++j) L[j] = C[j];
        } else TK_MERGE16(L, C);
    }
    {
        float P[16];
#pragma unroll
        for (int j = 0; j < 16; ++j) P[j] = __shfl_xor(L[j], 1);
        TK_MERGE16(L, P);
    }
    if (sub == 0) {
#pragma unroll
        for (int q = 0; q < 4; ++q) {
            unsigned w = 0;
#pragma unroll
            for (int e = 0; e < 4; ++e) w |= (__builtin_bit_cast(unsigned, L[4 * q + e]) & 0x7Fu) << (8 * e);
            *(LAS unsigned*)(IDX + row * 16 + 4 * q) = w;
        }
    }
    float A[16], B[16];
#pragma unroll
    for (int j = 0; j < 16; ++j) { const float o = __shfl_xor(L[j], 2); const bool isb = (tid & 2) != 0; A[j] = isb ? o : L[j]; B[j] = isb ? L[j] : o; }
#define TK_KEY(i, j) __uint_as_float((__float_as_uint(A[i] + B[j]) & ~0xFFu) | (unsigned)(255 - ((i) * 16 + (j))))
    float F[16], X[16];
#pragma unroll
    for (int j = 0; j < 16; ++j) F[j] = TK_KEY(0, j);
#pragma unroll
    for (int i = 1; i < 16; ++i) X[i - 1] = TK_KEY(i, 0);
    X[15] = -INFINITY; TK_MERGE16(F, X);
#pragma unroll
    for (int i = 0; i < 16; ++i) X[i] = -INFINITY;
#pragma unroll
    for (int i = 1; i <= 7; ++i) X[i - 1] = TK_KEY(i, 1);
    TK_MERGE16(F, X);
#pragma unroll
    for (int i = 0; i < 16; ++i) X[i] = -INFINITY;
#pragma unroll
    for (int j = 2; j <= 7; ++j) X[j - 2] = TK_KEY(1, j);
    TK_MERGE16(F, X);
    { const float rest[6] = {TK_KEY(2, 2), TK_KEY(2, 3), TK_KEY(2, 4), TK_KEY(3, 2), TK_KEY(3, 3), TK_KEY(4, 2)};
#pragma unroll
      for (int r = 0; r < 6; ++r) { float x = rest[r];
#pragma unroll
          for (int k = 0; k < 16; ++k) { const float h = vmaxf(F[k], x); x = vminf(F[k], x); F[k] = h; } } }
    __syncthreads();
    if ((tid & 3) == 0) {
        const int rowA = (tid >> 2) * 2, rowB = rowA + 1;
        const size_t prob = prob0 + (size_t)pstride * (tid >> 2);
        float g[16]; int ex[16]; float gs = 0.f;
#pragma unroll
        for (int k = 0; k < 16; ++k) {
            const unsigned code = 255u - (__builtin_bit_cast(unsigned, F[k]) & 0xFFu);
            const int ia = IDX[rowA * 16 + (code >> 4)], ib = IDX[rowB * 16 + (code & 15)];
            ex[k] = ia * PNK + ib;
            g[k] = __expf(F[k] - F[0]); gs += g[k];
        }
        const float ginv = 1.0f / gs;
#pragma unroll
        for (int q = 0; q < 4; ++q) {
            *(GAS f32x4*)(gates + prob * 16 + 4 * q) = (f32x4){g[4 * q] * ginv, g[4 * q + 1] * ginv, g[4 * q + 2] * ginv, g[4 * q + 3] * ginv};
            typedef int i32x4 __attribute__((ext_vector_type(4)));
            *(GAS i32x4*)(experts + prob * 16 + 4 * q) = (i32x4){ex[4 * q], ex[4 * q + 1], ex[4 * q + 2], ex[4 * q + 3]};
        }
    }
    __syncthreads();
}
__device__ __forceinline__ void topk_pass(int pass, const float* scores, int* experts, float* gates, LAS unsigned char* lds, int tid) {
    LAS float* S = (LAS float*)lds;
    const float* src = scores + (size_t)pass * (256 * 128);
#pragma unroll 4
    for (int i = 0; i < 16; ++i) { const int f4 = tid + NTHREADS * i, row = f4 >> 5, c4 = f4 & 31; *(LAS f32x4*)(S + row * TK_ROWF + 4 * c4) = *(const GAS f32x4*)(src + (size_t)f4 * 4); }
    __syncthreads();
    topk_core(lds, (size_t)pass * 128, 1, experts, gates, tid);
}
struct EpiTopK {
    static constexpr bool PERM = false, AFTER_DRAIN = true;
    int* experts; float* gates;
    __device__ __forceinline__ void fused(pg8::f32x4 (&acc)[2][2][4][2], const pg8::Unit& u, int wr, int wc, int fr, int fq, LAS unsigned char* lds, int wid, int lane) const {
        LAS float* S = (LAS float*)lds;
        const int tid = wid * 64 + lane;
#pragma unroll
        for (int ai = 0; ai < 2; ++ai) {
#pragma unroll
            for (int bj = 0; bj < 2; ++bj)
#pragma unroll
                for (int mm = 0; mm < 4; ++mm)
#pragma unroll
                    for (int n = 0; n < 2; ++n) { const int rl = 64 * wr + 16 * mm + fr; *(LAS pg8::f32x4*)(S + (2 * rl + bj) * TK_ROWF + 32 * wc + 16 * n + 4 * fq) = acc[ai][bj][mm][n]; }
            __syncthreads();
            topk_core(lds, ((size_t)u.pm * 256 + 128 * ai) * PH + u.pn, PH, experts, gates, tid);
        }
    }
};

__device__ __forceinline__ float gelu_erf(float v) { return 0.5f * v * (1.0f + erff(v * 0.70710678118654752f)); }
typedef __bf16 bf16x2_t __attribute__((ext_vector_type(2)));
typedef float f32x2_t __attribute__((ext_vector_type(2)));
__device__ __forceinline__ float dot2bf(bf16x2_t a, unsigned b, float acc) { return __builtin_amdgcn_fdot2_f32_bf16(a, __builtin_bit_cast(bf16x2_t, b), acc, false); }
__device__ __forceinline__ float dot4f8(unsigned w8, unsigned x01, unsigned x23, float acc) {
    acc = dot2bf(__builtin_amdgcn_cvt_scalef32_pk_bf16_fp8(w8, 1.0f, false), x01, acc);
    return dot2bf(__builtin_amdgcn_cvt_scalef32_pk_bf16_fp8(w8, 1.0f, true), x23, acc);
}
__device__ __forceinline__ void axpy4f8(float* y, unsigned w8, float w) {
    const f32x2_t lo = __builtin_amdgcn_cvt_pk_f32_fp8(w8, false), hi = __builtin_amdgcn_cvt_pk_f32_fp8(w8, true);
    y[0] += w * lo.x; y[1] += w * lo.y; y[2] += w * hi.x; y[3] += w * hi.y;
}
__device__ __forceinline__ void axpy4f8v(f32x2_t* y2, unsigned w8, float w) {
    const f32x2_t lo = __builtin_amdgcn_cvt_pk_f32_fp8(w8, false), hi = __builtin_amdgcn_cvt_pk_f32_fp8(w8, true);
    const f32x2_t ww = {w, w};
    y2[0] = __builtin_elementwise_fma(lo, ww, y2[0]); y2[1] = __builtin_elementwise_fma(hi, ww, y2[1]);
}
__device__ __forceinline__ void row_to_fp8(const float* src, unsigned char* dst, float* inv, int lane) {
    f32x4 v[2][4]; float mx = 0.f;
#pragma unroll
    for (int j = 0; j < 2; ++j)
#pragma unroll
        for (int q = 0; q < 4; ++q) { v[j][q] = *((const GAS f32x4*)src + 4 * (lane + 64 * j) + q);
            mx = fmaxf(mx, fmaxf(fmaxf(fabsf(v[j][q].x), fabsf(v[j][q].y)), fmaxf(fabsf(v[j][q].z), fabsf(v[j][q].w)))); }
#pragma unroll
    for (int o = 1; o < 64; o <<= 1) mx = fmaxf(mx, __shfl_xor(mx, o));
    const float sc = mx > 0.f ? 384.0f / mx : 1.0f;
#pragma unroll
    for (int j = 0; j < 2; ++j) { v4u o;
        int w;
        w = 0; w = __builtin_amdgcn_cvt_pk_fp8_f32(v[j][0].x * sc, v[j][0].y * sc, w, false); w = __builtin_amdgcn_cvt_pk_fp8_f32(v[j][0].z * sc, v[j][0].w * sc, w, true); o.x = (unsigned)w;
        w = 0; w = __builtin_amdgcn_cvt_pk_fp8_f32(v[j][1].x * sc, v[j][1].y * sc, w, false); w = __builtin_amdgcn_cvt_pk_fp8_f32(v[j][1].z * sc, v[j][1].w * sc, w, true); o.y = (unsigned)w;
        w = 0; w = __builtin_amdgcn_cvt_pk_fp8_f32(v[j][2].x * sc, v[j][2].y * sc, w, false); w = __builtin_amdgcn_cvt_pk_fp8_f32(v[j][2].z * sc, v[j][2].w * sc, w, true); o.z = (unsigned)w;
        w = 0; w = __builtin_amdgcn_cvt_pk_fp8_f32(v[j][3].x * sc, v[j][3].y * sc, w, false); w = __builtin_amdgcn_cvt_pk_fp8_f32(v[j][3].z * sc, v[j][3].w * sc, w, true); o.w = (unsigned)w;
        { const int ch = lane + 64 * j; *((GAS v4u*)(dst + (size_t)(ch >> 4) * SLICE_BYTES) + (ch & 15)) = o; } }
    if (lane == 0) *inv = mx > 0.f ? mx * (1.0f / 384.0f) : 1.0f;
}
__device__ __forceinline__ void row_to_i8(const float* src, unsigned char* dst, float* inv, int lane) {
    f32x4 v[2][4]; float mx = 0.f;
#pragma unroll
    for (int j = 0; j < 2; ++j)
#pragma unroll
        for (int q = 0; q < 4; ++q) { v[j][q] = *((const GAS f32x4*)src + 4 * (lane + 64 * j) + q);
            mx = fmaxf(mx, fmaxf(fmaxf(fabsf(v[j][q].x), fabsf(v[j][q].y)), fmaxf(fabsf(v[j][q].z), fabsf(v[j][q].w)))); }
#pragma unroll
    for (int o = 1; o < 64; o <<= 1) mx = fmaxf(mx, __shfl_xor(mx, o));
    const float sc = mx > 0.f ? 127.0f / mx : 1.0f;
#pragma unroll
    for (int j = 0; j < 2; ++j) { v4u o; o.x = pack_i8(v[j][0] * sc); o.y = pack_i8(v[j][1] * sc); o.z = pack_i8(v[j][2] * sc); o.w = pack_i8(v[j][3] * sc);
        { const int ch = lane + 64 * j; *((GAS v4u*)(dst + (size_t)(ch >> 4) * SLICE_BYTES) + (ch & 15)) = o; } }
    if (lane == 0) *inv = mx > 0.f ? mx * (1.0f / 127.0f) : 1.0f;
}
__device__ __forceinline__ float row16_allsum(float a) {
    a += __builtin_bit_cast(float, __builtin_amdgcn_update_dpp(0, __builtin_bit_cast(int, a), 0x128, 0xf, 0xf, false));
    a += __builtin_bit_cast(float, __builtin_amdgcn_update_dpp(0, __builtin_bit_cast(int, a), 0x124, 0xf, 0xf, false));
    a += __builtin_bit_cast(float, __builtin_amdgcn_update_dpp(0, __builtin_bit_cast(int, a), 0x122, 0xf, 0xf, false));
    a += __builtin_bit_cast(float, __builtin_amdgcn_update_dpp(0, __builtin_bit_cast(int, a), 0x121, 0xf, 0xf, false));
    return a;
}
__device__ __forceinline__ int q_pull(unsigned* q, int lane) { int v = 0; if (lane == 0) v = (int)__hip_atomic_fetch_add(q, 1u, __ATOMIC_RELAXED, __HIP_MEMORY_SCOPE_AGENT); return __builtin_amdgcn_readfirstlane(v); }
constexpr int PEER_TG = 8;
constexpr int PEER_N8 = 640, PEER_N4 = 512, PEER_N2 = 512, PEER_NTASK = PEER_N8 + PEER_N4 + PEER_N2;
__device__ __forceinline__ void peer_task_tokens(int idx, int& t0, int& n) {
    if (idx < PEER_N8) { t0 = 8 * idx; n = 8; } else if (idx < PEER_N8 + PEER_N4) { t0 = 8 * PEER_N8 + 4 * (idx - PEER_N8); n = 4; } else { t0 = 8 * PEER_N8 + 4 * PEER_N4 + 2 * (idx - PEER_N8 - PEER_N4); n = 2; }
}
__device__ __forceinline__ int row16_allsum_i(int a) {
    a += __builtin_amdgcn_update_dpp(0, a, 0x128, 0xf, 0xf, false);
    a += __builtin_amdgcn_update_dpp(0, a, 0x124, 0xf, 0xf, false);
    a += __builtin_amdgcn_update_dpp(0, a, 0x122, 0xf, 0xf, false);
    a += __builtin_amdgcn_update_dpp(0, a, 0x121, 0xf, 0xf, false);
    return a;
}
#define PA_LOAD(R, IDV, HALF) do { _Pragma("unroll") for (int i_ = 0; i_ < 8; ++i_) { const unsigned e_ = (unsigned)__shfl(IDV, 4 * (i_ + 8 * (HALF)) + g); \
        R[i_] = *(const GAS v4u*)(ub + (e_ * 256u + offc)); } } while (0)
#define PA_COMP(R, HALF) do { _Pragma("unroll") for (int i_ = 0; i_ < 8; ++i_) { int a_ = __builtin_amdgcn_sdot4((int)R[i_].x, (int)xc.x, 0, false); a_ = __builtin_amdgcn_sdot4((int)R[i_].y, (int)xc.y, a_, false); \
        a_ = __builtin_amdgcn_sdot4((int)R[i_].z, (int)xc.z, a_, false); a_ = __builtin_amdgcn_sdot4((int)R[i_].w, (int)xc.w, a_, false); r16[8 * (HALF) + i_] = row16_allsum_i(a_); } } while (0)
__device__ __forceinline__ void peer_a_task(int t0, int ntok, int s, const signed char* xq, const int* experts, const unsigned char* u8s, int* pa, int lane_) {
    int lane = lane_; asm volatile("" : "+v"(lane));
    const int g = lane >> 4, c = lane & 15;
    const GAS unsigned char* ub = (const GAS unsigned char*)(u8s + (size_t)s * SLICE_BYTES);
    const unsigned offc = 16u * (unsigned)c;
    int idc0 = experts[(size_t)t0 * 128 + lane], idc1 = experts[(size_t)t0 * 128 + lane + 64];
    v4u xc = *(const GAS v4u*)(xq + (size_t)t0 * D + 256 * s + 16 * c);
    v4u RA[8], RB[8];
    PA_LOAD(RA, idc0, 0);
#pragma unroll 1
    for (int tt = 0; tt < ntok; ++tt) {
        const int t = t0 + tt, tn = tt + 1 < ntok ? t + 1 : t;
        const int idn0 = experts[(size_t)tn * 128 + lane], idn1 = experts[(size_t)tn * 128 + lane + 64];
        const v4u xn = *(const GAS v4u*)(xq + (size_t)tn * D + 256 * s + 16 * c);
#pragma unroll 1
        for (int hb = 0; hb < 2; ++hb) {
            const int idv = hb ? idc1 : idc0, idx = hb ? idn0 : idc1;
            int r16[16];
            PA_LOAD(RB, idv, 1); PA_COMP(RA, 0);
            asm volatile("" ::: "memory");
            PA_LOAD(RA, idx, 0); PA_COMP(RB, 1);
            if (c == 15) { typedef int i32x4 __attribute__((ext_vector_type(4))); GAS i32x4* dst = (GAS i32x4*)(pa + ((size_t)t * 8 + s) * 128 + g * 32 + 16 * hb);
#pragma unroll
                for (int q = 0; q < 4; ++q) dst[q] = (i32x4){r16[4 * q], r16[4 * q + 1], r16[4 * q + 2], r16[4 * q + 3]}; }
        }
        idc0 = idn0; idc1 = idn1; xc = xn;
    }
}
__device__ __forceinline__ void peer_w_elem(size_t i, const int* experts, const float* gates, const float* su, const float* sv, const float* sx, const int* pa, float* wb) {
    const size_t t = i >> 7; const int k = (int)(i & 127), pos = (k & 3) * 32 + (k >> 2);
    const int e = experts[i];
    int a = 0;
#pragma unroll
    for (int s2 = 0; s2 < 8; ++s2) a += pa[(t * 8 + s2) * 128 + pos];
    wb[i] = gates[i] * gelu_erf((float)a * (su[e] * sx[t])) * sv[e];
}
#define PB_LOAD(R, IDV, HALF) do { _Pragma("unroll") for (int i_ = 0; i_ < 8; ++i_) { const unsigned e_ = (unsigned)__shfl(IDV, 4 * (i_ + 8 * (HALF)) + g); \
        R[i_] = *(const GAS v4u*)(vb + (e_ * 256u + offc)); } } while (0)
#define PB_COMP(R, WV, HALF) do { _Pragma("unroll") for (int i_ = 0; i_ < 8; ++i_) { const float wk_ = __shfl(WV, 4 * (i_ + 8 * (HALF)) + g); \
        axpy4f8v(&ya2[0], R[i_].x, wk_); axpy4f8v(&ya2[2], R[i_].y, wk_); axpy4f8v(&ya2[4], R[i_].z, wk_); axpy4f8v(&ya2[6], R[i_].w, wk_); } } while (0)
__device__ __forceinline__ void peer_b_task(int t0, int ntok, int s, const bf16* h1, const int* experts, const float* wb, const unsigned char* v8s, bf16* out, float* st, int lane_) {
    int lane = lane_; asm volatile("" : "+v"(lane));
    const int g = lane >> 4, c = lane & 15;
    const GAS unsigned char* vb = (const GAS unsigned char*)(v8s + (size_t)s * SLICE_BYTES);
    const unsigned offc = 16u * (unsigned)c;
    int idc0 = experts[(size_t)t0 * 128 + lane], idc1 = experts[(size_t)t0 * 128 + lane + 64];
    float wc0 = wb[(size_t)t0 * 128 + lane], wc1 = wb[(size_t)t0 * 128 + lane + 64];
    v4u RA[8], RB[8];
    PB_LOAD(RA, idc0, 0);
#pragma unroll 1
    for (int tt = 0; tt < ntok; ++tt) {
        const int t = t0 + tt, tn = tt + 1 < ntok ? t + 1 : t;
        const int idn0 = experts[(size_t)tn * 128 + lane], idn1 = experts[(size_t)tn * 128 + lane + 64];
        const float wn0 = wb[(size_t)tn * 128 + lane], wn1 = wb[(size_t)tn * 128 + lane + 64];
        f32x2_t ya2[8];
#pragma unroll
        for (int e = 0; e < 8; ++e) ya2[e] = (f32x2_t){0.f, 0.f};
#pragma unroll 1
        for (int hb = 0; hb < 2; ++hb) {
            const int idv = hb ? idc1 : idc0, idx = hb ? idn0 : idc1; const float wv = hb ? wc1 : wc0;
            PB_LOAD(RB, idv, 1); PB_COMP(RA, wv, 0);
            asm volatile("" ::: "memory");
            PB_LOAD(RA, idx, 0); PB_COMP(RB, wv, 1);
        }
        float ya[16];
#pragma unroll
        for (int e = 0; e < 8; ++e) { ya[2 * e] = ya2[e].x; ya[2 * e + 1] = ya2[e].y; }
#pragma unroll
        for (int e = 0; e < 16; ++e) { ya[e] += __shfl_xor(ya[e], 16); ya[e] += __shfl_xor(ya[e], 32); }
        const GAS v4u* hp = (const GAS v4u*)(h1 + (size_t)t * D + 256 * s + 16 * c);
        const v4u h0 = hp[0], h1v = hp[1];
        float hx[16];
        hx[0] = pg8::bf_lo(h0.x); hx[1] = pg8::bf_hi(h0.x); hx[2] = pg8::bf_lo(h0.y); hx[3] = pg8::bf_hi(h0.y); hx[4] = pg8::bf_lo(h0.z); hx[5] = pg8::bf_hi(h0.z); hx[6] = pg8::bf_lo(h0.w); hx[7] = pg8::bf_hi(h0.w);
        hx[8] = pg8::bf_lo(h1v.x); hx[9] = pg8::bf_hi(h1v.x); hx[10] = pg8::bf_lo(h1v.y); hx[11] = pg8::bf_hi(h1v.y); hx[12] = pg8::bf_lo(h1v.z); hx[13] = pg8::bf_hi(h1v.z); hx[14] = pg8::bf_lo(h1v.w); hx[15] = pg8::bf_hi(h1v.w);
        float sm = 0.f, sq = 0.f;
#pragma unroll
        for (int e = 0; e < 16; ++e) { ya[e] = hx[e] * ALPHA + ya[e]; sm += ya[e]; sq += ya[e] * ya[e]; }
        sm = row16_allsum(sm); sq = row16_allsum(sq);
        if (g == 0) { GAS v4u* op = (GAS v4u*)(out + (size_t)t * D + 256 * s + 16 * c);
            v4u o0, o1; o0.x = pk2(ya[0], ya[1]); o0.y = pk2(ya[2], ya[3]); o0.z = pk2(ya[4], ya[5]); o0.w = pk2(ya[6], ya[7]);
            o1.x = pk2(ya[8], ya[9]); o1.y = pk2(ya[10], ya[11]); o1.z = pk2(ya[12], ya[13]); o1.w = pk2(ya[14], ya[15]);
            op[0] = o0; op[1] = o1;
            if (c == 0) { st[((size_t)t * 8 + s) * 2] = sm; st[((size_t)t * 8 + s) * 2 + 1] = sq; } }
        idc0 = idn0; idc1 = idn1; wc0 = wn0; wc1 = wn1;
    }
}
__device__ __forceinline__ void peer_c_row(int t, const bf16* r2, float* out, const float* st, const float* g2, const float* b2, int lane) {
    float sm = 0.f, sq = 0.f;
#pragma unroll
    for (int s = 0; s < 8; ++s) { sm += st[((size_t)t * 8 + s) * 2]; sq += st[((size_t)t * 8 + s) * 2 + 1]; }
    const float mean = sm * (1.f / D), var = sq * (1.f / D) - mean * mean, rstd = 1.f / sqrtf(fmaxf(var, 0.f) + LN_EPS);
    const GAS v4u* xr = (const GAS v4u*)(r2 + (size_t)t * D) + lane;
    GAS f32x4* op = (GAS f32x4*)(out + (size_t)t * D);
#pragma unroll
    for (int j = 0; j < 4; ++j) { const v4u w = xr[64 * j]; const int c4 = 2 * (lane + 64 * j);
        const f32x4 g0 = *((const GAS f32x4*)g2 + c4), g1 = *((const GAS f32x4*)g2 + c4 + 1), b0 = *((const GAS f32x4*)b2 + c4), b1 = *((const GAS f32x4*)b2 + c4 + 1);
        const f32x4 v0 = (f32x4){pg8::bf_lo(w.x), pg8::bf_hi(w.x), pg8::bf_lo(w.y), pg8::bf_hi(w.y)}, v1 = (f32x4){pg8::bf_lo(w.z), pg8::bf_hi(w.z), pg8::bf_lo(w.w), pg8::bf_hi(w.w)};
        op[c4] = (v0 - mean) * rstd * g0 + b0; op[c4 + 1] = (v1 - mean) * rstd * g1 + b1; }
}

struct TwoPassOrder : pg8::StaticOrder {
    __device__ __forceinline__ bool next(int i, pg8::Unit& u) const { if (!pg8::StaticOrder::next(i >> 1, u)) return false; u.w = i & 1; return true; }
};
struct EpiGate2 {
    static constexpr bool PERM = true, AFTER_DRAIN = false;
    pg8::EpiGate<0> e0; pg8::EpiGate<1> e1;
    __device__ __forceinline__ void operator()(const pg8::f32x4 (&acc)[2][2][4][2], const pg8::Unit& u, int wr, int wc, int fr, int fq) const { if (u.w == 0) e0(acc, u, wr, wc, fr, fq); else e1(acc, u, wr, wc, fr, fq); }
};

struct ConvOrder : pg8::StaticOrder {
    const float* pu; const float* pv; unsigned char* u8; unsigned char* v8; float* su; float* sv; int slot; mutable int calls;
    static constexpr int CONV_ROWS = 4, CONV_CALLS = 6;
    __device__ __forceinline__ void done(const pg8::Unit&) const {
        if (slot < 0) return;
        int lane = threadIdx.x & 63; asm volatile("" : "+v"(lane));
        const int wave = __builtin_amdgcn_readfirstlane(threadIdx.x >> 6);
        const int base = ((slot * NWAVES + wave) * CONV_CALLS + calls) * CONV_ROWS;
        if (calls < CONV_CALLS) {
#pragma unroll 1
            for (int j = 0; j < CONV_ROWS; ++j) { const int r = base + j; if (r < 2 * PNE) { const bool sec = r >= PNE; const int e = sec ? r - PNE : r;
                if (sec) row_to_fp8(pv + (size_t)e * D, v8 + (size_t)e * 256, sv + e, lane); else row_to_i8(pu + (size_t)e * D, u8 + (size_t)e * 256, su + e, lane); } }
        }
        ++calls;
    }
};

struct Args { const float* in[16]; float* out; unsigned char* ws; int ph_lo, ph_hi; };
__global__ void __launch_bounds__(NTHREADS, 2) mk_fwd(Args args) {
    extern __shared__ __attribute__((aligned(16))) unsigned char lds_raw[];
    LAS unsigned char* lds = (LAS unsigned char*)lds_raw;
    volatile LAS unsigned* MISC = (volatile LAS unsigned*)(lds + MISC_OFF);
    const int tid0 = threadIdx.x;
    const int G = gridDim.x, bx = blockIdx.x;
    unsigned char* ws = args.ws;
    gu32* ctl = (gu32*)(ws + WS_CTL);
#define IN_(i) (args.in[i])
#define x_in IN_(0)
#define w_in IN_(1)
#define b_gate IN_(2)
#define sinks IN_(3)
#define conv_w IN_(4)
#define w_ao IN_(5)
#define w_co IN_(6)
#define w_o IN_(7)
#define ln1_g IN_(8)
#define ln1_b IN_(9)
#define w_q IN_(10)
#define sub_keys IN_(11)
#define peer_u IN_(12)
#define peer_v IN_(13)
#define ln2_g IN_(14)
#define ln2_b IN_(15)
#define WinT ((bf16*)(ws + WS_WIN))
#define WaT ((bf16*)(ws + WS_WA))
#define WcT ((bf16*)(ws + WS_WC))
#define WoT ((bf16*)(ws + WS_WO))
#define WfT ((bf16*)(ws + WS_WF))
#define XB ((bf16*)(ws + WS_XB))
#define MERGED ((bf16*)(ws + WS_MERGED))
#define Z ((bf16*)(ws + WS_Z))
#define R2B ((bf16*)(ws + WS_R2B))
#define H1B ((bf16*)(ws + WS_H1B))
#define SC ((float*)(ws + WS_SC))
#define EX ((int*)(ws + WS_EX))
#define GT ((float*)(ws + WS_GT))
#define AO ((bf16*)(ws + WS_AO))
#define CI ((bf16*)(ws + WS_CI))
#define TMP ((bf16*)(ws + WS_TMP))
#define U8 ((unsigned char*)(ws + WS_U8))
#define V8 ((unsigned char*)(ws + WS_V8))
#define SU ((float*)(ws + WS_SU))
#define SV ((float*)(ws + WS_SV))
#define PA ((int*)(ws + WS_PA))
#define ST ((float*)(ws + WS_ST))
#define WB ((float*)(ws + WS_WB))
#define XA8 ((signed char*)(ws + WS_XA8))
#define WIN8 ((signed char*)(ws + WS_WIN8))
#define SWIN ((float*)(ws + WS_SWIN))
#define SXA ((float*)(ws + WS_SXA))
#define XQ ((signed char*)(ws + WS_XQ))
#define SX ((float*)(ws + WS_SX))
    for (int u = tid0; u < (LDS_BYTES - LDSCTL_OFF) / 4; u += NTHREADS) ((LAS unsigned*)(lds + LDSCTL_OFF))[u] = 0u;
    __syncthreads();
    XcdBarrier bar; bar.bar = (unsigned*)(ctl + CW_BAR); bar.x = 0; bar.st = nullptr;
    if (!MK_PER_PHASE) bar = xcd_barrier_post((unsigned*)(ctl + CW_BAR), MISC + 8);
    const int lo = args.ph_lo, hi = args.ph_hi;
#ifndef PH_MASK
#define PH_MASK 0xFFF
#endif
#define IN(k) (((PH_MASK >> (k)) & 1) && lo <= (k) && (k) < hi)
#ifndef DBL_BAR
#define DBL_BAR 0
#endif
#define SEAM(k) do { if (IN(k) && IN((k) + 1)) { xcd_barrier(bar); if (DBL_BAR) xcd_barrier(bar); } } while (0)
#ifndef DBL_MASK
#define DBL_MASK 0
#endif
#define REP(k) for (int rep_ = 0; rep_ < 1 + ((DBL_MASK >> (k)) & 1); ++rep_)
#define PHASE_TID() int tid = tid0; asm volatile("" : "+v"(tid)); const int lane = tid & 63, wave = __builtin_amdgcn_readfirstlane(tid >> 6); (void)lane; (void)wave

    if (IN(0)) REP(0) {
        PHASE_TID();
        const bool conv_first = ((bx >> 3) & 1) == 0;
#pragma unroll 1
        for (int part = 0; part < 2; ++part) {
            if ((part == 0) == conv_first) {
                int tid = tid0; asm volatile("" : "+v"(tid)); const int lane = tid & 63, wave = __builtin_amdgcn_readfirstlane(tid >> 6);
                LAS float* scr = (LAS float*)(lds + wave * 16384);
                const int gw = bx * NWAVES + wave, NGW = G * NWAVES;
                constexpr int I_IN = (D / 64) * (IN_W / 32), I_SQ = (D / 64) * (D / 32);
                for (int it = gw; it < I_IN + 3 * I_SQ; it += NGW) {
                    int r = it;
                    if (r < I_IN) { p0_transpose_item(w_in, D, IN_W, WinT, scr, r, lane); continue; } r -= I_IN;
                    if (r < I_SQ) { p0_transpose_item(w_ao, D, D, WaT, scr, r, lane); continue; } r -= I_SQ;
                    if (r < I_SQ) { p0_transpose_item(w_co, D, D, WcT, scr, r, lane); continue; } r -= I_SQ;
                    p0_transpose_item(w_o, D, D, WoT, scr, r, lane);
                }
                for (int r = gw; r < M; r += NGW) row_f32_to_i8(x_in + (size_t)r * D, XA8 + (size_t)r * D, SXA + r, lane);
                __syncthreads();
            }
            if (part == 0) for (int it = bx; it < 16 * 32; it += G) p0_wf_item(w_q, sub_keys, WfT, lds, it, tid);
        }
    }
    SEAM(0);
    if (IN(1)) REP(1) {
        { PHASE_TID();
          for (int r = bx * NWAVES + wave; r < IN_W; r += G * NWAVES) row_bf16_to_i8(WinT + (size_t)r * D, WIN8 + (size_t)r * D, SWIN + r, lane); }
        if (!MK_PER_PHASE) xcd_barrier(bar);
        pg8::Gemm g{(const bf16*)XA8, (const bf16*)WIN8, M, IN_W, D / 2}; ConvOrder S; S.init(M, IN_W, G, bx);
        S.pu = peer_u; S.pv = peer_v; S.u8 = U8; S.v8 = V8; S.su = SU; S.sv = SV; S.calls = 0;
        S.slot = (G == 256 && bx >= 64) ? bx - 64 : -1;
        pg8::EpiI8Bf16 E{Z, IN_W, SXA, SWIN};
        pg8::gemm_phase<pg8::EpiI8Bf16, ConvOrder, true, true, true>(lds, g, S, E);
        if (G != 256) {
            PHASE_TID();
            for (int r = bx * NWAVES + wave; r < 2 * PNE; r += G * NWAVES) { const bool sec = r >= PNE; const int e = sec ? r - PNE : r;
                if (sec) row_to_fp8(peer_v + (size_t)e * D, V8 + (size_t)e * 256, SV + e, lane); else row_to_i8(peer_u + (size_t)e * D, U8 + (size_t)e * 256, SU + e, lane); }
        }
    }
    SEAM(1);
    if (IN(2)) REP(2) {
        PHASE_TID();
        const bool conv_first = ((bx >> 3) & 1) == 0;
#pragma unroll 1
        for (int part = 0; part < 2; ++part) {
            if ((part == 0) == conv_first) { int t2 = tid0; asm volatile("" : "+v"(t2)); for (int it = bx; it < M / 32; it += G) conv_item(it, Z, conv_w, CI, t2); }
            if (part == 0) for (int u = bx; u < BATCH * NKVH * 16; u += G) attn_unit(u, Z, AO, sinks, lds, tid);
        }
    }
    SEAM(2);
    if (IN(3)) REP(3) {
        TwoPassOrder S; S.init(M, D, G, bx);
        pg8::Gemm g{AO, WaT, M, D, D, CI, WcT};
        EpiGate2 E{pg8::EpiGate<0>{TMP, nullptr, Z + G_OFF, b_gate, D, IN_W}, pg8::EpiGate<1>{MERGED, TMP, Z + G_OFF + D, b_gate + D, D, IN_W}};
        pg8::gemm_phase<EpiGate2, TwoPassOrder, true, true>(lds, g, S, E);
    }
    SEAM(3);
    if (IN(4)) REP(4) {
        pg8::Gemm g{MERGED, WoT, M, D, D}; pg8::StaticOrder S; S.init(M, D, G, bx);
        pg8::EpiResBf16 E{H1B, D, x_in, ALPHA};
        pg8::gemm_phase<pg8::EpiResBf16, pg8::StaticOrder, true, true>(lds, g, S, E);
    }
    SEAM(4);
    if (IN(5)) REP(5) {
        PHASE_TID();
        const int gw = bx * NWAVES + wave, NGW = G * NWAVES;
        for (int m = gw; m < M; m += NGW) ln1_row(H1B + (size_t)m * D, XQ + (size_t)m * D, SX + m, ln1_g, ln1_b, lane);
    }
    SEAM(5);
    if (IN(6)) REP(6) {
        pg8::Gemm g{H1B, WfT, M, D, D}; pg8::StaticOrder S; S.init(M, D, G, bx);
        if (G == 256) { EpiTopK E{EX, GT}; pg8::gemm_phase<EpiTopK, pg8::StaticOrder, false, true>(lds, g, S, E); }
        else { pg8::EpiF32 E{SC, D, nullptr, 0.f}; pg8::gemm_phase<pg8::EpiF32, pg8::StaticOrder, true, true>(lds, g, S, E); }
    }
    if (G != 256) SEAM(6);
    if (IN(7)) REP(7) {
        PHASE_TID();
        if (G != 256) for (int p = bx; p < (M * PH) / 128; p += G) topk_pass(p, SC, EX, GT, lds, tid);
    }
    SEAM(7);
    if (IN(8)) REP(8) {
        PHASE_TID();
        const int xcc = (int)(xb_xcc_id() & 7u);
#pragma unroll 1
#ifndef SCRAMBLE
#define SCRAMBLE 0
#endif
        for (int sl = 0; sl < 8; ++sl) { const int s = (xcc + sl + (SCRAMBLE ? wave : 0)) & 7;
            for (;;) { const int tg = q_pull((unsigned*)(ctl + CW_Q + 64 * (s + 16 * rep_)), lane); if (tg >= PEER_NTASK) break;
                int t0, nt; peer_task_tokens(tg, t0, nt); peer_a_task(t0, nt, s, XQ, EX, U8, PA, lane); } }
    }
    SEAM(8);
    if (IN(9)) REP(9) {
        PHASE_TID();
        for (size_t i = (size_t)bx * NTHREADS + tid; i < (size_t)M * 128; i += (size_t)G * NTHREADS) peer_w_elem(i, EX, GT, SU, SV, SX, PA, WB);
    }
    SEAM(9);
    if (IN(10)) REP(10) {
        PHASE_TID();
        const int xcc = (int)(xb_xcc_id() & 7u);
#pragma unroll 1
#ifndef SCRAMBLE
#define SCRAMBLE 0
#endif
        for (int sl = 0; sl < 8; ++sl) { const int s = (xcc + sl + (SCRAMBLE ? wave : 0)) & 7;
            for (;;) { const int tg = q_pull((unsigned*)(ctl + CW_Q + 64 * (8 + s + 16 * rep_)), lane); if (tg >= PEER_NTASK) break;
                int t0, nt; peer_task_tokens(tg, t0, nt); peer_b_task(t0, nt, s, H1B, EX, WB, V8, R2B, ST, lane); } }
    }
    SEAM(10);
    if (IN(11)) REP(11) {
        PHASE_TID();
        const int gw = bx * NWAVES + wave, NGW = G * NWAVES;
        for (int t = gw; t < M; t += NGW) peer_c_row(t, R2B, args.out, ST, ln2_g, ln2_b, lane);
    }
#undef IN
#undef SEAM
}

extern "C" void kernel_launch(void* const* d_in, const int* in_sizes, int n_in, void* d_out, int out_size, void* d_ws, size_t ws_size, hipStream_t stream) {
    static int grid = 0;
    if (grid == 0) {
        if (n_in != 16 || out_size != M * D || ws_size < WS_END) { fprintf(stderr, "kernel_launch: unexpected shapes (n_in %d out %d ws %zu)\n", n_in, out_size, ws_size); grid = -1; return; }
        int dev = 0, cus = 0, per_cu = 0;
        if (hipGetDevice(&dev) != hipSuccess || hipDeviceGetAttribute(&cus, hipDeviceAttributeMultiprocessorCount, dev) != hipSuccess) { grid = -1; return; }
        if (hipFuncSetAttribute((const void*)mk_fwd, hipFuncAttributeMaxDynamicSharedMemorySize, LDS_BYTES) != hipSuccess) { fprintf(stderr, "kernel_launch: hipFuncSetAttribute failed\n"); grid = -1; return; }
        if (hipOccupancyMaxActiveBlocksPerMultiprocessor(&per_cu, (const void*)mk_fwd, NTHREADS, LDS_BYTES) != hipSuccess || per_cu < 1) { fprintf(stderr, "kernel_launch: occupancy query says %d\n", per_cu); per_cu = 1; }
        (void)hipGetLastError();
        if (per_cu > 1) per_cu = 1;
        grid = cus * per_cu;
    }
    if (grid < 0) return;
    if (hipMemsetAsync((char*)d_ws + WS_CTL, 0, CTL_ZERO_BYTES, stream) != hipSuccess) { fprintf(stderr, "kernel_launch: memset failed\n"); return; }
    Args a{};
    for (int i = 0; i < 16; ++i) a.in[i] = (const float*)d_in[i];
    a.out = (float*)d_out; a.ws = (unsigned char*)d_ws;
#if MK_PER_PHASE
    for (int p = 0; p < N_PHASES; ++p) { a.ph_lo = p; a.ph_hi = p + 1; hipLaunchKernelGGL(mk_fwd, dim3(grid), dim3(NTHREADS), LDS_BYTES, stream, a); }
#else
    a.ph_lo = 0; a.ph_hi = N_PHASES;
    void* kargs[] = {&a};
#ifdef PLAIN_LAUNCH
    (void)kargs; hipLaunchKernelGGL(mk_fwd, dim3(grid), dim3(NTHREADS), LDS_BYTES, stream, a); hipError_t e = hipPeekAtLastError();
#else
    hipError_t e = hipLaunchCooperativeKernel((const void*)mk_fwd, dim3(grid), dim3(NTHREADS), kargs, LDS_BYTES, stream);
#endif
    if (e != hipSuccess) fprintf(stderr, "kernel_launch: cooperative launch failed: %s (grid %d)\n", hipGetErrorString(e), grid);
#endif
}
```

```cpp
#include <hip/hip_runtime.h>
#include <cstdio>
#include <cstdint>
#include <type_traits>
namespace pg8 {
#define PG8_LAS __attribute__((address_space(3)))
typedef unsigned short bf16_t;
typedef short bf16x8 __attribute__((ext_vector_type(8)));
typedef float f32x4 __attribute__((ext_vector_type(4)));
typedef unsigned u32x4 __attribute__((ext_vector_type(4)));
constexpr int BM = 256, BK = 64, HALF = 128, HTB = HALF * BK * 2  , STAGE_BYTES = 8 * HTB, NXCD = 8, WGM = 8;

__host__ __device__ __forceinline__ int lds_byte(int r, int c) { const int st = (r >> 4) * 2 + (c >> 5), rr = r & 15, cc = c & 31, ob = rr * 64 + cc * 2; return st * 1024 + (ob ^ (((ob >> 9) & 1) << 5)); }
__host__ __device__ __forceinline__ void stage_rc(int b, int& R, int& C) { const int st = b / 1024, sb = b % 1024, swz = sb ^ (((sb >> 9) & 1) << 5); R = (st >> 1) * 16 + swz / 64; C = (st & 1) * 32 + (swz % 64) / 2; }
__host__ __device__ __forceinline__ int perm32(int rho) { const int n = rho >> 4, i = rho & 15; return 8 * (i >> 2) + 4 * n + (i & 3); }

struct Unit { int pm, pn, w; };
struct Gemm { const bf16_t* A; const bf16_t* Bt; int M, N, K; const bf16_t* A2 = nullptr; const bf16_t* Bt2 = nullptr; };

struct StaticOrder {
    int nM, nN, nwg, G, c;
    __host__ __device__ void init(int M, int N, int G_, int c_) { nM = M / BM; nN = N / BM; nwg = nM * nN; G = G_; c = c_; }
    __host__ __device__ bool next(int i, Unit& u) const {
        const long L = (long)i * G + c; if (L >= nwg) return false;
        int wgid = (int)L; { const int q = nwg / NXCD, r = nwg % NXCD, xcd = wgid % NXCD, off = wgid / NXCD; wgid = (xcd < r ? xcd * (q + 1) : r * (q + 1) + (xcd - r) * q) + off; }
        const int nig = WGM * nN, gid = wgid / nig, fm = gid * WGM, gsz = (nM - fm) < WGM ? (nM - fm) : WGM;
        u.pm = fm + ((wgid % nig) % gsz); u.pn = (wgid % nig) / gsz; u.w = 0; return true;
    }
    __device__ __forceinline__ void a_ready(const Unit&) const {}
    __device__ __forceinline__ void done(const Unit&) const {}
};


__device__ __forceinline__ unsigned cvt_pk_bf16(float lo, float hi) { unsigned r; asm volatile("v_cvt_pk_bf16_f32 %0, %1, %2" : "=v"(r) : "v"(lo), "v"(hi)); return r; }
__device__ __forceinline__ float bf_lo(unsigned w) { return __builtin_bit_cast(float, w << 16); }
__device__ __forceinline__ float bf_hi(unsigned w) { return __builtin_bit_cast(float, w & 0xffff0000u); }
__device__ __forceinline__ float sigmoidf_(float x) { return __builtin_amdgcn_rcpf(1.0f + __expf(-x)); }

struct EpiBf16 {
    static constexpr bool PERM = true, AFTER_DRAIN = false;
    bf16_t* O; int ldc;
    __device__ __forceinline__ void operator()(const f32x4 (&acc)[2][2][4][2], const Unit& u, int wr, int wc, int fr, int fq) const {
        const int row0 = u.pm * BM + wr * 64 + fr, col0 = u.pn * BM + wc * 32 + 8 * fq;
#pragma unroll
        for (int ai = 0; ai < 2; ++ai)
#pragma unroll
            for (int m = 0; m < 4; ++m) { bf16_t* rowp = O + (size_t)(row0 + ai * HALF + m * 16) * ldc + col0;
#pragma unroll
                for (int bj = 0; bj < 2; ++bj) { const f32x4 v0 = acc[ai][bj][m][0], v1 = acc[ai][bj][m][1];
                    u32x4 w; w.x = cvt_pk_bf16(v0[0], v0[1]); w.y = cvt_pk_bf16(v0[2], v0[3]); w.z = cvt_pk_bf16(v1[0], v1[1]); w.w = cvt_pk_bf16(v1[2], v1[3]);
                    *(u32x4*)(rowp + bj * HALF) = w; } }
    }
};
template <int SECOND> struct EpiGate {
    static constexpr bool PERM = true, AFTER_DRAIN = false;
    bf16_t* O; const bf16_t* T; const bf16_t* Zg; const float* bg; int ldc, ldz;
    __device__ __forceinline__ void operator()(const f32x4 (&acc)[2][2][4][2], const Unit& u, int wr, int wc, int fr, int fq) const {
        const int row0 = u.pm * BM + wr * 64 + fr, col0 = u.pn * BM + wc * 32 + 8 * fq;
        f32x4 bv[2][2];
#pragma unroll
        for (int bj = 0; bj < 2; ++bj)
#pragma unroll
            for (int n = 0; n < 2; ++n) bv[bj][n] = *(const f32x4*)(bg + col0 + bj * HALF + 4 * n);
#pragma unroll
        for (int ai = 0; ai < 2; ++ai)
#pragma unroll
            for (int m = 0; m < 4; ++m) { const size_t row = (size_t)(row0 + ai * HALF + m * 16);
#pragma unroll
                for (int bj = 0; bj < 2; ++bj) { const int c = col0 + bj * HALF;
                    const u32x4 zg = *(const u32x4*)(Zg + row * ldz + c);
                    f32x4 v0 = acc[ai][bj][m][0], v1 = acc[ai][bj][m][1];
                    v0[0] *= sigmoidf_(bf_lo(zg.x) + bv[bj][0][0]); v0[1] *= sigmoidf_(bf_hi(zg.x) + bv[bj][0][1]);
                    v0[2] *= sigmoidf_(bf_lo(zg.y) + bv[bj][0][2]); v0[3] *= sigmoidf_(bf_hi(zg.y) + bv[bj][0][3]);
                    v1[0] *= sigmoidf_(bf_lo(zg.z) + bv[bj][1][0]); v1[1] *= sigmoidf_(bf_hi(zg.z) + bv[bj][1][1]);
                    v1[2] *= sigmoidf_(bf_lo(zg.w) + bv[bj][1][2]); v1[3] *= sigmoidf_(bf_hi(zg.w) + bv[bj][1][3]);
                    if (SECOND) { const u32x4 t = *(const u32x4*)(T + row * ldc + c);
                        v0[0] += bf_lo(t.x); v0[1] += bf_hi(t.x); v0[2] += bf_lo(t.y); v0[3] += bf_hi(t.y);
                        v1[0] += bf_lo(t.z); v1[1] += bf_hi(t.z); v1[2] += bf_lo(t.w); v1[3] += bf_hi(t.w); }
                    u32x4 w; w.x = cvt_pk_bf16(v0[0], v0[1]); w.y = cvt_pk_bf16(v0[2], v0[3]); w.z = cvt_pk_bf16(v1[0], v1[1]); w.w = cvt_pk_bf16(v1[2], v1[3]);
                    *(u32x4*)(O + row * ldc + c) = w; } }
    }
};
struct EpiF32 {
    static constexpr bool PERM = false, AFTER_DRAIN = false;
    float* C; int ldc; const float* R; float scale;
    __device__ __forceinline__ void operator()(const f32x4 (&acc)[2][2][4][2], const Unit& u, int wr, int wc, int fr, int fq) const {
        const int row0 = u.pm * BM + wr * 64 + fr, col0 = u.pn * BM + wc * 32 + 4 * fq;
#pragma unroll
        for (int ai = 0; ai < 2; ++ai)
#pragma unroll
            for (int m = 0; m < 4; ++m) { const size_t off = (size_t)(row0 + ai * HALF + m * 16) * ldc + col0;
#pragma unroll
                for (int bj = 0; bj < 2; ++bj)
#pragma unroll
                    for (int n = 0; n < 2; ++n) { f32x4 v = acc[ai][bj][m][n];
                        if (R) v += *(const f32x4*)(R + off + bj * HALF + n * 16) * scale;
                        *(f32x4*)(C + off + bj * HALF + n * 16) = v; } }
    }
};
struct EpiResBf16 {
    static constexpr bool PERM = true, AFTER_DRAIN = false;
    bf16_t* O; int ldc; const float* R; float scale;
    __device__ __forceinline__ void operator()(const f32x4 (&acc)[2][2][4][2], const Unit& u, int wr, int wc, int fr, int fq) const {
        const int row0 = u.pm * BM + wr * 64 + fr, col0 = u.pn * BM + wc * 32 + 8 * fq;
#pragma unroll
        for (int ai = 0; ai < 2; ++ai)
#pragma unroll
            for (int m = 0; m < 4; ++m) { const size_t off = (size_t)(row0 + ai * HALF + m * 16) * ldc + col0;
#pragma unroll
                for (int bj = 0; bj < 2; ++bj) { const f32x4 r0 = *(const f32x4*)(R + off + bj * HALF), r1 = *(const f32x4*)(R + off + bj * HALF + 4);
                    const f32x4 v0 = acc[ai][bj][m][0] + r0 * scale, v1 = acc[ai][bj][m][1] + r1 * scale;
                    u32x4 w; w.x = cvt_pk_bf16(v0[0], v0[1]); w.y = cvt_pk_bf16(v0[2], v0[3]); w.z = cvt_pk_bf16(v1[0], v1[1]); w.w = cvt_pk_bf16(v1[2], v1[3]);
                    *(u32x4*)(O + off + bj * HALF) = w; } }
    }
};
typedef int i32x4e __attribute__((ext_vector_type(4)));
struct EpiI8Bf16 {
    static constexpr bool PERM = true, AFTER_DRAIN = false;
    bf16_t* O; int ldc; const float* sa; const float* sb;
    __device__ __forceinline__ void operator()(const i32x4e (&acc)[2][2][4][2], const Unit& u, int wr, int wc, int fr, int fq) const {
        const int row0 = u.pm * BM + wr * 64 + fr, col0 = u.pn * BM + wc * 32 + 8 * fq;
        f32x4 sbv[2][2];
#pragma unroll
        for (int bj = 0; bj < 2; ++bj)
#pragma unroll
            for (int n = 0; n < 2; ++n) sbv[bj][n] = *(const f32x4*)(sb + col0 + bj * HALF + 4 * n);
#pragma unroll
        for (int ai = 0; ai < 2; ++ai)
#pragma unroll
            for (int m = 0; m < 4; ++m) { const int row = row0 + ai * HALF + m * 16; const float sr = sa[row]; bf16_t* rowp = O + (size_t)row * ldc + col0;
#pragma unroll
                for (int bj = 0; bj < 2; ++bj) { const i32x4e a0 = acc[ai][bj][m][0], a1 = acc[ai][bj][m][1];
                    const f32x4 v0 = (f32x4){(float)a0[0], (float)a0[1], (float)a0[2], (float)a0[3]} * sbv[bj][0] * sr, v1 = (f32x4){(float)a1[0], (float)a1[1], (float)a1[2], (float)a1[3]} * sbv[bj][1] * sr;
                    u32x4 w; w.x = cvt_pk_bf16(v0[0], v0[1]); w.y = cvt_pk_bf16(v0[2], v0[3]); w.z = cvt_pk_bf16(v1[0], v1[1]); w.w = cvt_pk_bf16(v1[2], v1[3]);
                    *(u32x4*)(rowp + bj * HALF) = w; } }
    }
};
template <int SECOND> struct EpiGateI8 {
    static constexpr bool PERM = true, AFTER_DRAIN = false;
    bf16_t* O; const bf16_t* T; const bf16_t* Zg; const float* bg; int ldc, ldz; const float* sa; const float* sb;
    __device__ __forceinline__ void operator()(const i32x4e (&acc)[2][2][4][2], const Unit& u, int wr, int wc, int fr, int fq) const {
        const int row0 = u.pm * BM + wr * 64 + fr, col0 = u.pn * BM + wc * 32 + 8 * fq;
        f32x4 bv[2][2], sbv[2][2];
#pragma unroll
        for (int bj = 0; bj < 2; ++bj)
#pragma unroll
            for (int n = 0; n < 2; ++n) { bv[bj][n] = *(const f32x4*)(bg + col0 + bj * HALF + 4 * n); sbv[bj][n] = *(const f32x4*)(sb + col0 + bj * HALF + 4 * n); }
#pragma unroll
        for (int ai = 0; ai < 2; ++ai)
#pragma unroll
            for (int m = 0; m < 4; ++m) { const size_t row = (size_t)(row0 + ai * HALF + m * 16); const float sr = sa[row];
#pragma unroll
                for (int bj = 0; bj < 2; ++bj) { const int c = col0 + bj * HALF;
                    const u32x4 zg = *(const u32x4*)(Zg + row * ldz + c);
                    const i32x4e a0 = acc[ai][bj][m][0], a1 = acc[ai][bj][m][1];
                    f32x4 v0 = (f32x4){(float)a0[0], (float)a0[1], (float)a0[2], (float)a0[3]} * sbv[bj][0] * sr, v1 = (f32x4){(float)a1[0], (float)a1[1], (float)a1[2], (float)a1[3]} * sbv[bj][1] * sr;
                    v0[0] *= sigmoidf_(bf_lo(zg.x) + bv[bj][0][0]); v0[1] *= sigmoidf_(bf_hi(zg.x) + bv[bj][0][1]);
                    v0[2] *= sigmoidf_(bf_lo(zg.y) + bv[bj][0][2]); v0[3] *= sigmoidf_(bf_hi(zg.y) + bv[bj][0][3]);
                    v1[0] *= sigmoidf_(bf_lo(zg.z) + bv[bj][1][0]); v1[1] *= sigmoidf_(bf_hi(zg.z) + bv[bj][1][1]);
                    v1[2] *= sigmoidf_(bf_lo(zg.w) + bv[bj][1][2]); v1[3] *= sigmoidf_(bf_hi(zg.w) + bv[bj][1][3]);
                    if (SECOND) { const u32x4 t = *(const u32x4*)(T + row * ldc + c);
                        v0[0] += bf_lo(t.x); v0[1] += bf_hi(t.x); v0[2] += bf_lo(t.y); v0[3] += bf_hi(t.y);
                        v1[0] += bf_lo(t.z); v1[1] += bf_hi(t.z); v1[2] += bf_lo(t.w); v1[3] += bf_hi(t.w); }
                    u32x4 w; w.x = cvt_pk_bf16(v0[0], v0[1]); w.y = cvt_pk_bf16(v0[2], v0[3]); w.z = cvt_pk_bf16(v1[0], v1[1]); w.w = cvt_pk_bf16(v1[2], v1[3]);
                    *(u32x4*)(O + row * ldc + c) = w; } }
    }
};

typedef int i32x4 __attribute__((ext_vector_type(4)));
template <class E, class = void> struct epi_chains : std::false_type {};
template <class E> struct epi_chains<E, std::void_t<decltype(E::CHAIN)>> : std::true_type {};
template <class Epi, class Sched, bool ALIGN_EPI = false, bool SP2 = false, bool I8 = false>
__device__ __forceinline__ void gemm_phase(PG8_LAS unsigned char* lds, const Gemm g, const Sched& S, const Epi& E) {
    int tid_ = threadIdx.x; asm volatile("" : "+v"(tid_));
    const int tid = tid_, wid = __builtin_amdgcn_readfirstlane(tid >> 6), lane = tid & 63, wr = wid >> 2, wc = wid & 3, fr = lane & 15, fq = lane >> 4;
    const int K = g.K, nt = K / BK;
    unsigned voffA[2], voffB[2];
#pragma unroll
    for (int i = 0; i < 2; ++i) { int R, C; stage_rc(tid * 16 + i * 8192, R, C); const int Rb = Epi::PERM ? ((R & ~31) + perm32(R & 31)) : R;
        voffA[i] = (unsigned)(R * K + C) * 2u; voffB[i] = (unsigned)(Rb * K + C) * 2u; }
    const size_t kstep = (size_t)(BK * 2);
    const size_t hstep = (size_t)HALF * K * 2;
    const size_t tstep = 2 * hstep;
    const unsigned ldsw = (unsigned)wid * 1024u;
    const int aoff = lds_byte(wr * 64 + fr, fq * 8), boff = lds_byte(wc * 32 + fr, fq * 8);
#define PG8_SA(b, h) (((b) * 2 + (h)) * HTB)
#define PG8_SB(b, h) ((4 + (b) * 2 + (h)) * HTB)
#define PG8_STAGE(bufoff, gbase, voff) do { _Pragma("unroll") for (int _i = 0; _i < 2; ++_i) \
        __builtin_amdgcn_global_load_lds((const unsigned*)((const char*)(gbase) + (voff)[_i]), (PG8_LAS unsigned*)(lds + (bufoff) + ldsw + _i * 8192), 16, 0, 0); } while (0)
#define PG8_LDA(dst, b, h) do { _Pragma("unroll") for (int m = 0; m < 4; ++m) _Pragma("unroll") for (int k = 0; k < 2; ++k) dst[m][k] = *(const PG8_LAS bf16x8*)(lds + PG8_SA(b, h) + aoff + m * 2048 + k * 1024); } while (0)
#define PG8_LDB(dst, b, h) do { _Pragma("unroll") for (int n = 0; n < 2; ++n) _Pragma("unroll") for (int k = 0; k < 2; ++k) dst[n][k] = *(const PG8_LAS bf16x8*)(lds + PG8_SB(b, h) + boff + n * 2048 + k * 1024); } while (0)
#define PG8_MMA(ai, bj, At, Bt) do { __builtin_amdgcn_s_setprio(1); _Pragma("unroll") for (int m = 0; m < 4; ++m) _Pragma("unroll") for (int n = 0; n < 2; ++n) _Pragma("unroll") for (int k = 0; k < 2; ++k) \
        { if constexpr (I8) acc[ai][bj][m][n] = __builtin_bit_cast(acc_t, __builtin_amdgcn_mfma_i32_16x16x64_i8(__builtin_bit_cast(i32x4, Bt[n][k]), __builtin_bit_cast(i32x4, At[m][k]), __builtin_bit_cast(i32x4, acc[ai][bj][m][n]), 0, 0, 0)); \
          else acc[ai][bj][m][n] = __builtin_bit_cast(acc_t, __builtin_amdgcn_mfma_f32_16x16x32_bf16(Bt[n][k], At[m][k], __builtin_bit_cast(f32x4, acc[ai][bj][m][n]), 0, 0, 0)); } __builtin_amdgcn_s_setprio(0); } while (0)
#define PG8_WAIT_V(n) asm volatile("s_waitcnt vmcnt(" #n ")" ::: "memory")
#define PG8_WAIT_L(n) asm volatile("s_waitcnt lgkmcnt(" #n ")" ::: "memory")
#define PG8_BAR __builtin_amdgcn_s_barrier()
#define PG8_SCHED __builtin_amdgcn_sched_barrier(0)
    Unit cur, nxt; int ui = 0;
    if (!S.next(0, cur)) return;
    typedef typename std::conditional<I8, i32x4, f32x4>::type acc_t;
    acc_t acc[2][2][4][2];
#pragma unroll
    for (int a = 0; a < 2; ++a)
#pragma unroll
        for (int b = 0; b < 2; ++b)
#pragma unroll
            for (int m = 0; m < 4; ++m)
#pragma unroll
                for (int n = 0; n < 2; ++n) acc[a][b][m][n] = acc_t{};
    bf16x8 At[4][2], B0[2][2], B1[2][2];
    const char* cA = (const char*)(cur.w ? g.A2 : g.A) + (size_t)cur.pm * tstep; const char* cB = (const char*)(cur.w ? g.Bt2 : g.Bt) + (size_t)cur.pn * tstep;
    S.a_ready(cur);
    if constexpr (SP2) {
        PG8_STAGE(PG8_SB(0, 0), cB, voffB); PG8_STAGE(PG8_SB(0, 1), cB + hstep, voffB); PG8_STAGE(PG8_SA(0, 0), cA, voffA); PG8_STAGE(PG8_SA(0, 1), cA + hstep, voffA);
        if (wr == 1) PG8_BAR;
        PG8_WAIT_V(2); PG8_BAR;
        PG8_STAGE(PG8_SB(1, 0), cB + kstep, voffB); PG8_STAGE(PG8_SA(1, 0), cA + kstep, voffA); PG8_STAGE(PG8_SB(1, 1), cB + hstep + kstep, voffB);
        PG8_WAIT_V(6); PG8_BAR;
    } else {
        PG8_STAGE(PG8_SB(0, 0), cB, voffB); PG8_STAGE(PG8_SA(0, 0), cA, voffA); PG8_STAGE(PG8_SB(0, 1), cB + hstep, voffB); PG8_STAGE(PG8_SA(0, 1), cA + hstep, voffA);
        if (wr == 1) PG8_BAR;
        PG8_WAIT_V(4); PG8_BAR;
        PG8_STAGE(PG8_SB(1, 0), cB + kstep, voffB); PG8_STAGE(PG8_SA(1, 0), cA + kstep, voffA); PG8_STAGE(PG8_SB(1, 1), cB + hstep + kstep, voffB);
        PG8_WAIT_V(6); PG8_BAR;
    }
    for (;;) {
        const bool has_next = S.next(ui + 1, nxt);
        const char* nA = has_next ? (const char*)(nxt.w ? g.A2 : g.A) + (size_t)nxt.pm * tstep : cA; const char* nB = has_next ? (const char*)(nxt.w ? g.Bt2 : g.Bt) + (size_t)nxt.pn * tstep : cB;
        for (int t = 0; t < nt; t += 2) {
            const bool last = (t == nt - 2);
            const char* a1 = cA + (size_t)(t + 1) * kstep;
            const char* a2 = last ? nA : cA + (size_t)(t + 2) * kstep; const char* b2 = last ? nB : cB + (size_t)(t + 2) * kstep;
            const char* a3 = a2 + kstep; const char* b3 = b2 + kstep;
            if (last && has_next) S.a_ready(nxt);
            if constexpr (SP2) {
            PG8_LDB(B0, 0, 0); PG8_LDB(B1, 0, 1); PG8_SCHED; PG8_LDA(At, 0, 0); PG8_STAGE(PG8_SA(1, 1), a1 + hstep, voffA);
            PG8_WAIT_V(8); PG8_WAIT_L(0); PG8_BAR; PG8_MMA(0, 0, At, B0); PG8_MMA(0, 1, At, B1); PG8_BAR; PG8_SCHED;
            PG8_LDA(At, 0, 1); PG8_STAGE(PG8_SB(0, 0), b2, voffB); PG8_STAGE(PG8_SB(0, 1), b2 + hstep, voffB); PG8_STAGE(PG8_SA(0, 0), a2, voffA);
            PG8_WAIT_V(8); PG8_WAIT_L(0); PG8_BAR; PG8_MMA(1, 0, At, B0); PG8_MMA(1, 1, At, B1); PG8_BAR; PG8_SCHED;
            PG8_LDB(B0, 1, 0); PG8_LDB(B1, 1, 1); PG8_SCHED; PG8_LDA(At, 1, 0); PG8_STAGE(PG8_SA(0, 1), a2 + hstep, voffA);
            PG8_WAIT_V(8); PG8_WAIT_L(0); PG8_BAR; PG8_MMA(0, 0, At, B0); PG8_MMA(0, 1, At, B1); PG8_BAR; PG8_SCHED;
            PG8_LDA(At, 1, 1); PG8_STAGE(PG8_SB(1, 0), b3, voffB); PG8_STAGE(PG8_SB(1, 1), b3 + hstep, voffB); PG8_STAGE(PG8_SA(1, 0), a3, voffA);
            PG8_WAIT_V(8); PG8_WAIT_L(0); PG8_BAR; PG8_MMA(1, 0, At, B0); PG8_MMA(1, 1, At, B1); PG8_BAR; PG8_SCHED;
            } else {
            PG8_LDB(B0, 0, 0); PG8_SCHED; PG8_LDA(At, 0, 0); PG8_STAGE(PG8_SA(1, 1), a1 + hstep, voffA);
            PG8_WAIT_L(8); PG8_BAR; PG8_WAIT_L(0); PG8_MMA(0, 0, At, B0); PG8_BAR; PG8_SCHED;
            PG8_LDB(B1, 0, 1); PG8_STAGE(PG8_SB(0, 0), b2, voffB);
            PG8_BAR; PG8_WAIT_L(0); PG8_MMA(0, 1, At, B1); PG8_BAR;
            PG8_LDA(At, 0, 1); PG8_STAGE(PG8_SA(0, 0), a2, voffA);
            PG8_BAR; PG8_WAIT_L(0); PG8_MMA(1, 0, At, B0); PG8_BAR; PG8_SCHED;
            PG8_STAGE(PG8_SB(0, 1), b2 + hstep, voffB);
            PG8_WAIT_V(6); PG8_BAR; PG8_MMA(1, 1, At, B1); PG8_BAR;
            PG8_LDB(B0, 1, 0); PG8_SCHED; PG8_LDA(At, 1, 0); PG8_STAGE(PG8_SA(0, 1), a2 + hstep, voffA);
            PG8_WAIT_L(8); PG8_BAR; PG8_WAIT_L(0); PG8_MMA(0, 0, At, B0); PG8_BAR; PG8_SCHED;
            PG8_LDB(B1, 1, 1); PG8_STAGE(PG8_SB(1, 0), b3, voffB);
            PG8_BAR; PG8_WAIT_L(0); PG8_MMA(0, 1, At, B1); PG8_BAR;
            PG8_LDA(At, 1, 1); PG8_STAGE(PG8_SA(1, 0), a3, voffA);
            PG8_BAR; PG8_WAIT_L(0); PG8_MMA(1, 0, At, B0); PG8_BAR; PG8_SCHED;
            PG8_STAGE(PG8_SB(1, 1), b3 + hstep, voffB);
            PG8_WAIT_V(6); PG8_BAR; PG8_MMA(1, 1, At, B1); PG8_BAR;
            }
        }
        if constexpr (ALIGN_EPI) { if (wr == 0) PG8_BAR; }
        bool keep_acc = false;
        if constexpr (!Epi::AFTER_DRAIN) { if constexpr (epi_chains<Epi>::value) keep_acc = E.chain(acc, cur, wr, wc, fr, fq); else E(acc, cur, wr, wc, fr, fq); S.done(cur); }
        if (!has_next) break;
        if (!keep_acc) {
#pragma unroll
        for (int a = 0; a < 2; ++a)
#pragma unroll
            for (int b = 0; b < 2; ++b)
#pragma unroll
                for (int m = 0; m < 4; ++m)
#pragma unroll
                    for (int n = 0; n < 2; ++n) acc[a][b][m][n] = acc_t{};
        }
        cur = nxt; cA = nA; cB = nB; ++ui;
        if constexpr (ALIGN_EPI) { if (wr == 1) PG8_BAR; }
    }
    PG8_WAIT_V(0);
    if constexpr (!ALIGN_EPI) { if (wr == 0) PG8_BAR; }
    PG8_BAR;
    if constexpr (Epi::AFTER_DRAIN) { E.fused(acc, cur, wr, wc, fr, fq, lds, wid, lane); S.done(cur); }
#undef PG8_SA
#undef PG8_SB
#undef PG8_STAGE
#undef PG8_LDA
#undef PG8_LDB
#undef PG8_MMA
#undef PG8_WAIT_V
#undef PG8_WAIT_L
#undef PG8_BAR
#undef PG8_SCHED
}
}
#define GAS __attribute__((address_space(1)))
#define LAS __attribute__((address_space(3)))
typedef unsigned short bf16;
typedef unsigned v4u __attribute__((ext_vector_type(4)));
typedef float f32x4 __attribute__((ext_vector_type(4)));
typedef short bf16x8 __attribute__((ext_vector_type(8)));
typedef GAS unsigned gu32;
typedef GAS unsigned long long gu64;
#define RLX_AGENT __ATOMIC_RELAXED, __HIP_MEMORY_SCOPE_AGENT
#define LDS_WAIT() asm volatile("s_waitcnt lgkmcnt(0)" ::: "memory")
#define VM_WAIT() asm volatile("s_waitcnt vmcnt(0)" ::: "memory")
__device__ __forceinline__ unsigned long long rt() { return __builtin_amdgcn_s_memrealtime(); }
__device__ __forceinline__ unsigned f2bf(float f) { unsigned u = __builtin_bit_cast(unsigned, f); return (u + 0x7fffu + ((u >> 16) & 1u)) >> 16; }
__device__ __forceinline__ unsigned pk2(float lo, float hi) { return f2bf(lo) | (f2bf(hi) << 16); }

#define XB_TMO      128
#define XB_XCNT(j)  (256  + 64 * (j))
#define XB_XSUB(j)  (1280 + 64 * (j))
#define XB_XGEN(j)  (2304 + 64 * (j))
#define XB_TOP      3328
#define XB_TOPGEN   3392
#define XCD_BAR_WORDS 3456
#define XB_SPIN_CAP (1u << 18)

__device__ __forceinline__ unsigned xb_ld(unsigned* p)              { return __hip_atomic_load(p, __ATOMIC_RELAXED, __HIP_MEMORY_SCOPE_AGENT); }
__device__ __forceinline__ unsigned xb_add(unsigned* p, unsigned v) { return __hip_atomic_fetch_add(p, v, __ATOMIC_RELAXED, __HIP_MEMORY_SCOPE_AGENT); }
__device__ __forceinline__ unsigned xb_xcc_id() { return (unsigned)__builtin_amdgcn_s_getreg((3 << 11) | 20) & 0xFu; }
#define XB_SPIN(cond, bar) do { unsigned _sp = 0; while (cond) { __builtin_amdgcn_s_sleep(1); \
    if ((++_sp & 255u) == 0u) { if (xb_ld(&(bar)[XB_TMO])) break; if (_sp > XB_SPIN_CAP) { atomicAdd(&(bar)[XB_TMO], 1u); break; } } } } while (0)

struct XcdBarrier {
    unsigned* bar; unsigned x;
    volatile LAS unsigned* st;
};

__device__ __forceinline__ XcdBarrier xcd_barrier_post(unsigned* bar, volatile LAS unsigned* st) {
    XcdBarrier b; b.bar = bar; b.x = xb_xcc_id(); b.st = st;
    if (threadIdx.x == 0) (void)xb_add(&bar[XB_XCNT(b.x)], 1u);
    return b;
}
__device__ __forceinline__ void xcd_barrier_complete(unsigned* bar, unsigned x, unsigned& nloc, unsigned& nx) {
    const unsigned G = gridDim.x * gridDim.y * gridDim.z;
    unsigned sum, cnt, mine, sp = 0u;
    for (;;) {
        sum = 0u; cnt = 0u; mine = 0u;
#pragma unroll
        for (unsigned j = 0; j < 16; ++j) { const unsigned c = xb_ld(&bar[XB_XCNT(j)]); sum += c; cnt += (c > 0u) ? 1u : 0u; mine = (j == x) ? c : mine; }
        if (sum == G) break;
        __builtin_amdgcn_s_sleep(1);
        if ((++sp & 255u) == 0u) { if (xb_ld(&bar[XB_TMO])) break; if (sp > XB_SPIN_CAP) { atomicAdd(&bar[XB_TMO], 1u); break; } }
    }
    nloc = mine > 0u ? mine : 1u; nx = cnt > 0u ? cnt : 1u;
}

__device__ __forceinline__ void xcd_barrier(const XcdBarrier& b) {
    asm volatile("s_waitcnt vmcnt(0)" ::: "memory");
    __syncthreads();
    if (threadIdx.x == 0) {
        unsigned* bar = b.bar;
        __builtin_amdgcn_s_waitcnt(0);
        unsigned nloc = b.st[0], nx = b.st[1];
        if (nloc == 0u) { xcd_barrier_complete(bar, b.x, nloc, nx); b.st[0] = nloc; b.st[1] = nx; }
        const unsigned old = xb_add(&bar[XB_XSUB(b.x)], 1u);
        const unsigned gen = old / nloc;
        if (old + 1u == (gen + 1u) * nloc) {
            __builtin_amdgcn_fence(__ATOMIC_RELEASE, "agent");
            asm volatile("s_waitcnt vmcnt(0)" ::: "memory");
            const unsigned og = xb_add(&bar[XB_TOP], 1u);
            const unsigned tg = og / nx;
            if (og + 1u == (tg + 1u) * nx) xb_add(&bar[XB_TOPGEN], 1u);
            else XB_SPIN(xb_ld(&bar[XB_TOPGEN]) == tg, bar);
            __builtin_amdgcn_fence(__ATOMIC_ACQUIRE, "agent");
            xb_add(&bar[XB_XGEN(b.x)], 1u);
            asm volatile("s_waitcnt vmcnt(0)" ::: "memory");
        } else {
            XB_SPIN(xb_ld(&bar[XB_XGEN(b.x)]) == gen, bar);
            __builtin_amdgcn_fence(__ATOMIC_ACQUIRE, "agent");
            asm volatile("s_waitcnt vmcnt(0)" ::: "memory");
        }
    }
    __syncthreads();
}

constexpr int NWAVES = 8, NTHREADS = 512;
constexpr int BATCH = 4, SEQ = 2048, D = 2048, M = BATCH * SEQ;
constexpr int NQH = 32, NKVH = 4, HD = 64, QPKV = 8, WINDOW = 128;
constexpr int Q_OFF = 0, K_OFF = 2048, V_OFF = 2304, CB_OFF = 2560, CC_OFF = 4608, CH_OFF = 6656, G_OFF = 8704, IN_W = 12800;
constexpr int PH = 8, PNK = 128, PTOPK = 16, PNE = 16384;
constexpr float LN_EPS = 1e-5f;
constexpr float ALPHA = 1.189207115002721f;

#ifndef MK_PER_PHASE
#define MK_PER_PHASE 0
#endif
constexpr int N_PHASES = 12;

constexpr size_t MiB = 1u << 20;
constexpr size_t WS_CTL = 0, CTL_ZERO_BYTES = 1 * MiB;
constexpr size_t WS_WIN = 1 * MiB;
constexpr size_t WS_WA = 51 * MiB, WS_WC = 59 * MiB, WS_WO = 67 * MiB, WS_WF = 75 * MiB;
constexpr size_t WS_XB = 83 * MiB;
constexpr size_t WS_MERGED = WS_XB;
constexpr size_t WS_Z = 115 * MiB;
constexpr size_t WS_R2B = 115 * MiB;
constexpr size_t WS_H1B = 179 * MiB;
constexpr size_t WS_SC = 211 * MiB;
constexpr size_t WS_EX = 275 * MiB;
constexpr size_t WS_GT = 279 * MiB;
constexpr size_t WS_AO = 315 * MiB, WS_CI = 347 * MiB, WS_TMP = 379 * MiB;
constexpr size_t WS_U8 = 411 * MiB, WS_V8 = 443 * MiB;
constexpr size_t WS_SU = 475 * MiB, WS_SV = WS_SU + 65536;
constexpr size_t WS_PA = WS_SC;
constexpr size_t WS_XQ = 283 * MiB;
constexpr size_t WS_SX = 299 * MiB;
constexpr size_t WS_WB = 380 * MiB;
constexpr size_t WS_ST = 379 * MiB;
constexpr size_t WS_XA8 = WS_XB;
constexpr size_t WS_WIN8 = 476 * MiB;
constexpr size_t WS_SWIN = 501 * MiB, WS_SXA = WS_SWIN + 65536;
constexpr size_t WS_WF8 = 502 * MiB;
constexpr size_t WS_SWF = WS_SXA + 65536;
constexpr size_t WS_END = 506 * MiB;
constexpr int CW_Q = 12288;
constexpr size_t SLICE_BYTES = (size_t)PNE * 256;
constexpr int CW_BAR = 4096;

constexpr int RING_BYTES = 131072;
constexpr int LDSCTL_OFF = 147456, MISC_OFF = LDSCTL_OFF + 320;
constexpr int LDS_BYTES = LDSCTL_OFF + 512;

typedef float f32x16 __attribute__((ext_vector_type(16)));
typedef unsigned v2u __attribute__((ext_vector_type(2)));
__device__ __forceinline__ float wave_sum(float v) {
#pragma unroll
    for (int o = 1; o < 64; o <<= 1) v += __shfl_xor(v, o);
    return v;
}
__device__ __forceinline__ float vmaxf(float a, float b) { float r; asm("v_max_f32_e32 %0, %1, %2" : "=v"(r) : "v"(a), "v"(b)); return r; }
__device__ __forceinline__ float vminf(float a, float b) { float r; asm("v_min_f32_e32 %0, %1, %2" : "=v"(r) : "v"(a), "v"(b)); return r; }

__device__ __forceinline__ void p0_transpose_item(const float* W, int K, int N, bf16* WT, LAS float* scr, int item, int lane) {
    const int nblk = N / 32, kb = item / nblk, nb = item % nblk, k0 = 64 * kb, n0 = 32 * nb;
#pragma unroll 8
    for (int i = 0; i < 32; ++i) { const int kk = 2 * i + (lane >> 5); scr[kk * 33 + (lane & 31)] = W[(size_t)(k0 + kk) * N + n0 + (lane & 31)]; }
    LDS_WAIT(); asm volatile("" ::: "memory");
    const int c = lane & 7;
#pragma unroll
    for (int j = 0; j < 4; ++j) { const int n = (lane >> 3) + 8 * j; const LAS float* s = scr + (8 * c) * 33 + n;
        v4u o; o.x = pk2(s[0 * 33], s[1 * 33]); o.y = pk2(s[2 * 33], s[3 * 33]); o.z = pk2(s[4 * 33], s[5 * 33]); o.w = pk2(s[6 * 33], s[7 * 33]);
        *(GAS v4u*)(WT + (size_t)(n0 + n) * K + k0 + 8 * c) = o; }
    LDS_WAIT(); asm volatile("" ::: "memory");
}
__device__ __forceinline__ void p0_wf_item(const float* wq, const float* sk, bf16* WfT, LAS unsigned char* lds, int item, int tid) {
    const int hp = item >> 5, dt = item & 31;
    LAS f32x4* SK4 = (LAS f32x4*)lds;
    LAS f32x4* WQ4 = SK4 + 128 * 33;
    const float* skp = sk + (size_t)hp * 128 * 128;
    for (int i = tid; i < 128 * 32; i += NTHREADS) { const int n = i >> 5, c4 = i & 31; SK4[n * 33 + c4] = *(const f32x4*)(skp + n * 128 + 4 * c4); }
    for (int i = tid; i < 64 * 32; i += NTHREADS) { const int r = i >> 5, c4 = i & 31; WQ4[r * 33 + c4] = *(const f32x4*)(wq + (size_t)(64 * dt + r) * 2048 + hp * 128 + 4 * c4); }
    __syncthreads();
    const int td = tid & 15, tn = tid >> 4;
    float acc[4][4];
#pragma unroll
    for (int i = 0; i < 4; ++i)
#pragma unroll
        for (int j = 0; j < 4; ++j) acc[i][j] = 0.f;
#pragma unroll 4
    for (int c4 = 0; c4 < 32; ++c4) {
        f32x4 a[4], b[4];
#pragma unroll
        for (int i = 0; i < 4; ++i) a[i] = SK4[(4 * tn + i) * 33 + c4];
#pragma unroll
        for (int j = 0; j < 4; ++j) b[j] = WQ4[(td + 16 * j) * 33 + c4];
#pragma unroll
        for (int i = 0; i < 4; ++i)
#pragma unroll
            for (int j = 0; j < 4; ++j) acc[i][j] += a[i].x * b[j].x + a[i].y * b[j].y + a[i].z * b[j].z + a[i].w * b[j].w;
    }
#pragma unroll
    for (int i = 0; i < 4; ++i)
#pragma unroll
        for (int j = 0; j < 4; ++j) WfT[(size_t)(hp * 128 + 4 * tn + i) * 2048 + 64 * dt + td + 16 * j] = (bf16)f2bf(acc[i][j]);
    __syncthreads();
}

__device__ __forceinline__ int perm16(int o) { return 8 * ((o >> 2) & 1) + 4 * (o >> 3) + (o & 3); }
__device__ __forceinline__ void attn_unit(int unit, const bf16* z, bf16* ao, const float* sinks, LAS unsigned char* lds, int tid) {
    const int lane = tid & 63, wid = __builtin_amdgcn_readfirstlane(tid >> 6), r32 = lane & 31, hi = lane >> 5;
    const int nb = unit & 15, kvh = (unit >> 4) & 3, b = unit >> 6;
    LAS bf16* Ks = (LAS bf16*)lds;
    LAS bf16* Vt = (LAS bf16*)(lds + 256 * 144);
    const size_t tok0 = (size_t)b * SEQ;
#pragma unroll
    for (int i = 0; i < 4; ++i) {
        const int ci = tid + NTHREADS * i, key = ci >> 3, dc = ci & 7;
        int kpos = 128 * (nb - 1) + key; if (kpos < 0) kpos = 0;
        const bf16* src = z + (tok0 + kpos) * IN_W + K_OFF + kvh * HD + dc * 8;
        const v4u kv = *(const GAS v4u*)src, vv = *(const GAS v4u*)(src + (V_OFF - K_OFF));
        *(LAS v4u*)(Ks + key * 72 + dc * 8) = kv;
        const int pos = (key & ~15) + perm16(key & 15);
        LAS bf16* vp = Vt + (dc * 8) * 264 + pos;
        vp[0 * 264] = (bf16)(vv.x & 0xffffu); vp[1 * 264] = (bf16)(vv.x >> 16); vp[2 * 264] = (bf16)(vv.y & 0xffffu); vp[3 * 264] = (bf16)(vv.y >> 16);
        vp[4 * 264] = (bf16)(vv.z & 0xffffu); vp[5 * 264] = (bf16)(vv.z >> 16); vp[6 * 264] = (bf16)(vv.w & 0xffffu); vp[7 * 264] = (bf16)(vv.w >> 16);
    }
    __syncthreads();
    const int hq = kvh * QPKV + wid;
    const float LOG2E = 1.4426950408889634f;
    const float sink2 = sinks[hq] * LOG2E, sc = 0.125f * LOG2E;
#pragma unroll 1
    for (int qg = 0; qg < 4; ++qg) {
        const size_t tok = tok0 + 128 * nb + 32 * qg + r32;
        bf16x8 qf[4];
#pragma unroll
        for (int ks = 0; ks < 4; ++ks) qf[ks] = *(const GAS bf16x8*)(z + tok * IN_W + Q_OFF + hq * HD + 16 * ks + 8 * hi);
        f32x16 s[5];
#pragma unroll
        for (int kt = 0; kt < 5; ++kt) {
            s[kt] = (f32x16){0.f, 0.f, 0.f, 0.f, 0.f, 0.f, 0.f, 0.f, 0.f, 0.f, 0.f, 0.f, 0.f, 0.f, 0.f, 0.f};
#pragma unroll
            for (int ks = 0; ks < 4; ++ks) {
                const bf16x8 kf = *(const LAS bf16x8*)(Ks + (32 * (qg + kt) + r32) * 72 + 16 * ks + 8 * hi);
                s[kt] = __builtin_amdgcn_mfma_f32_32x32x16_bf16(kf, qf[ks], s[kt], 0, 0, 0);
            }
        }
        float mx = sink2;
#pragma unroll
        for (int kt = 0; kt < 5; ++kt) {
            const bool tile_dead = (nb == 0) && (qg + kt < 4);
#pragma unroll
            for (int r = 0; r < 16; ++r) {
                const int krow = (r & 3) + 8 * (r >> 2) + 4 * hi;
                bool valid = !tile_dead;
                if (kt == 0) valid = valid && (krow > r32);
                if (kt == 4) valid = valid && (krow <= r32);
                const float v = valid ? s[kt][r] * sc : -INFINITY;
                s[kt][r] = v; mx = fmaxf(mx, v);
            }
        }
        mx = fmaxf(mx, __shfl_xor(mx, 32));
        float sum = 0.f;
#pragma unroll
        for (int kt = 0; kt < 5; ++kt)
#pragma unroll
            for (int r = 0; r < 16; ++r) { const float p = __builtin_amdgcn_exp2f(s[kt][r] - mx); s[kt][r] = p; sum += p; }
        sum += __shfl_xor(sum, 32);
        const float inv = 1.0f / (sum + __builtin_amdgcn_exp2f(sink2 - mx));
        f32x16 o[2];
        o[0] = (f32x16){0.f, 0.f, 0.f, 0.f, 0.f, 0.f, 0.f, 0.f, 0.f, 0.f, 0.f, 0.f, 0.f, 0.f, 0.f, 0.f}; o[1] = o[0];
#pragma unroll
        for (int kt = 0; kt < 5; ++kt)
#pragma unroll
            for (int s2 = 0; s2 < 2; ++s2) {
                v4u pw; pw.x = pg8::cvt_pk_bf16(s[kt][8 * s2 + 0], s[kt][8 * s2 + 1]); pw.y = pg8::cvt_pk_bf16(s[kt][8 * s2 + 2], s[kt][8 * s2 + 3]);
                pw.z = pg8::cvt_pk_bf16(s[kt][8 * s2 + 4], s[kt][8 * s2 + 5]); pw.w = pg8::cvt_pk_bf16(s[kt][8 * s2 + 6], s[kt][8 * s2 + 7]);
                const bf16x8 pa = __builtin_bit_cast(bf16x8, pw);
#pragma unroll
                for (int dt = 0; dt < 2; ++dt) {
                    const bf16x8 vf = *(const LAS bf16x8*)(Vt + (32 * dt + r32) * 264 + 32 * (qg + kt) + 16 * s2 + 8 * hi);
                    o[dt] = __builtin_amdgcn_mfma_f32_32x32x16_bf16(vf, pa, o[dt], 0, 0, 0);
                }
            }
        bf16* op = ao + tok * D + hq * HD;
#pragma unroll
        for (int dt = 0; dt < 2; ++dt)
#pragma unroll
            for (int g = 0; g < 4; ++g) {
                v2u w; w.x = pg8::cvt_pk_bf16(o[dt][4 * g + 0] * inv, o[dt][4 * g + 1] * inv); w.y = pg8::cvt_pk_bf16(o[dt][4 * g + 2] * inv, o[dt][4 * g + 3] * inv);
                *(GAS v2u*)(op + 32 * dt + 8 * g + 4 * hi) = w;
            }
    }
    __syncthreads();
}
__device__ __forceinline__ void conv_item(int item, const bf16* z, const float* cw, bf16* ci, int tid) {
    const int c8 = tid & 255, half = tid >> 8, t0 = 32 * item + 16 * half, c0 = 8 * c8;
    float w0[8], w1[8], w2[8], u1[8], u2[8];
#pragma unroll
    for (int e = 0; e < 8; ++e) { w0[e] = cw[c0 + e]; w1[e] = cw[2048 + c0 + e]; w2[e] = cw[4096 + c0 + e]; u1[e] = 0.f; u2[e] = 0.f; }
    if ((t0 & (SEQ - 1)) != 0) {
#pragma unroll
        for (int k = 0; k < 2; ++k) {
            const bf16* zr = z + (size_t)(t0 - 2 + k) * IN_W + c0;
            const v4u a = *(const GAS v4u*)(zr + CC_OFF), h = *(const GAS v4u*)(zr + CH_OFF);
            float u[8];
            u[0] = pg8::bf_lo(a.x) * pg8::bf_lo(h.x); u[1] = pg8::bf_hi(a.x) * pg8::bf_hi(h.x); u[2] = pg8::bf_lo(a.y) * pg8::bf_lo(h.y); u[3] = pg8::bf_hi(a.y) * pg8::bf_hi(h.y);
            u[4] = pg8::bf_lo(a.z) * pg8::bf_lo(h.z); u[5] = pg8::bf_hi(a.z) * pg8::bf_hi(h.z); u[6] = pg8::bf_lo(a.w) * pg8::bf_lo(h.w); u[7] = pg8::bf_hi(a.w) * pg8::bf_hi(h.w);
#pragma unroll
            for (int e = 0; e < 8; ++e) { if (k == 0) u2[e] = u[e]; else u1[e] = u[e]; }
        }
    }
#pragma unroll 4
    for (int i = 0; i < 16; ++i) {
        const bf16* zr = z + (size_t)(t0 + i) * IN_W + c0;
        const v4u a = *(const GAS v4u*)(zr + CC_OFF), h = *(const GAS v4u*)(zr + CH_OFF), bb = *(const GAS v4u*)(zr + CB_OFF);
        float u[8], cb[8], y[8];
        u[0] = pg8::bf_lo(a.x) * pg8::bf_lo(h.x); u[1] = pg8::bf_hi(a.x) * pg8::bf_hi(h.x); u[2] = pg8::bf_lo(a.y) * pg8::bf_lo(h.y); u[3] = pg8::bf_hi(a.y) * pg8::bf_hi(h.y);
        u[4] = pg8::bf_lo(a.z) * pg8::bf_lo(h.z); u[5] = pg8::bf_hi(a.z) * pg8::bf_hi(h.z); u[6] = pg8::bf_lo(a.w) * pg8::bf_lo(h.w); u[7] = pg8::bf_hi(a.w) * pg8::bf_hi(h.w);
        cb[0] = pg8::bf_lo(bb.x); cb[1] = pg8::bf_hi(bb.x); cb[2] = pg8::bf_lo(bb.y); cb[3] = pg8::bf_hi(bb.y); cb[4] = pg8::bf_lo(bb.z); cb[5] = pg8::bf_hi(bb.z); cb[6] = pg8::bf_lo(bb.w); cb[7] = pg8::bf_hi(bb.w);
#pragma unroll
        for (int e = 0; e < 8; ++e) { y[e] = cb[e] * (w0[e] * u2[e] + w1[e] * u1[e] + w2[e] * u[e]); u2[e] = u1[e]; u1[e] = u[e]; }
        v4u o; o.x = pk2(y[0], y[1]); o.y = pk2(y[2], y[3]); o.z = pk2(y[4], y[5]); o.w = pk2(y[6], y[7]);
        *(GAS v4u*)(ci + (size_t)(t0 + i) * D + c0) = o;
    }
}

__device__ __forceinline__ unsigned pack_i8(const f32x4 v) {
    const int a = __float2int_rn(v.x), b = __float2int_rn(v.y), c = __float2int_rn(v.z), d = __float2int_rn(v.w);
    return ((unsigned)a & 0xffu) | (((unsigned)b & 0xffu) << 8) | (((unsigned)c & 0xffu) << 16) | ((unsigned)d << 24);
}
__device__ __forceinline__ unsigned pack_i8_2(float a, float b, float c, float d) {
    const int ia = __float2int_rn(a), ib = __float2int_rn(b), ic = __float2int_rn(c), id = __float2int_rn(d);
    return ((unsigned)ia & 0xffu) | (((unsigned)ib & 0xffu) << 8) | (((unsigned)ic & 0xffu) << 16) | ((unsigned)id << 24);
}
__device__ __forceinline__ void ln1_row(bf16* hbrow, signed char* xqrow, float* sxp, const float* g, const float* bta, int lane) {
    GAS v4u* xr = (GAS v4u*)hbrow + lane;
    float v[4][8]; float s = 0.f;
#pragma unroll
    for (int j = 0; j < 4; ++j) { const v4u w = xr[64 * j];
        v[j][0] = pg8::bf_lo(w.x); v[j][1] = pg8::bf_hi(w.x); v[j][2] = pg8::bf_lo(w.y); v[j][3] = pg8::bf_hi(w.y); v[j][4] = pg8::bf_lo(w.z); v[j][5] = pg8::bf_hi(w.z); v[j][6] = pg8::bf_lo(w.w); v[j][7] = pg8::bf_hi(w.w);
#pragma unroll
        for (int e = 0; e < 8; ++e) s += v[j][e]; }
    const float mean = wave_sum(s) * (1.f / D); float s2 = 0.f;
#pragma unroll
    for (int j = 0; j < 4; ++j)
#pragma unroll
        for (int e = 0; e < 8; ++e) { v[j][e] -= mean; s2 += v[j][e] * v[j][e]; }
    const float rstd = 1.f / sqrtf(wave_sum(s2) * (1.f / D) + LN_EPS);
    float mx = 0.f;
#pragma unroll
    for (int j = 0; j < 4; ++j) {
        const GAS f32x4* gp = (const GAS f32x4*)g + 2 * (lane + 64 * j); const GAS f32x4* bp = (const GAS f32x4*)bta + 2 * (lane + 64 * j);
        const f32x4 g0 = gp[0], g1 = gp[1], b0 = bp[0], b1 = bp[1];
        v[j][0] = v[j][0] * rstd * g0.x + b0.x; v[j][1] = v[j][1] * rstd * g0.y + b0.y; v[j][2] = v[j][2] * rstd * g0.z + b0.z; v[j][3] = v[j][3] * rstd * g0.w + b0.w;
        v[j][4] = v[j][4] * rstd * g1.x + b1.x; v[j][5] = v[j][5] * rstd * g1.y + b1.y; v[j][6] = v[j][6] * rstd * g1.z + b1.z; v[j][7] = v[j][7] * rstd * g1.w + b1.w;
        v4u o; o.x = pk2(v[j][0], v[j][1]); o.y = pk2(v[j][2], v[j][3]); o.z = pk2(v[j][4], v[j][5]); o.w = pk2(v[j][6], v[j][7]);
        xr[64 * j] = o;
#pragma unroll
        for (int e = 0; e < 8; ++e) mx = fmaxf(mx, fabsf(v[j][e]));
    }
#pragma unroll
    for (int o = 1; o < 64; o <<= 1) mx = fmaxf(mx, __shfl_xor(mx, o));
    const float qs = mx > 0.f ? 127.0f / mx : 1.0f;
    GAS v2u* q8 = (GAS v2u*)xqrow + lane;
#pragma unroll
    for (int j = 0; j < 4; ++j) { v2u o; o.x = pack_i8_2(v[j][0] * qs, v[j][1] * qs, v[j][2] * qs, v[j][3] * qs); o.y = pack_i8_2(v[j][4] * qs, v[j][5] * qs, v[j][6] * qs, v[j][7] * qs); q8[64 * j] = o; }
    if (lane == 0) *sxp = mx > 0.f ? mx * (1.0f / 127.0f) : 1.0f;
}

__device__ __forceinline__ void row_f32_to_i8(const float* src, signed char* dst, float* inv, int lane) {
    f32x4 v[8]; float mx = 0.f;
#pragma unroll
    for (int j = 0; j < 8; ++j) { v[j] = *((const GAS f32x4*)src + lane + 64 * j); mx = fmaxf(mx, fmaxf(fmaxf(fabsf(v[j].x), fabsf(v[j].y)), fmaxf(fabsf(v[j].z), fabsf(v[j].w)))); }
#pragma unroll
    for (int o = 1; o < 64; o <<= 1) mx = fmaxf(mx, __shfl_xor(mx, o));
    const float sc = mx > 0.f ? 127.0f / mx : 1.0f;
#pragma unroll
    for (int j = 0; j < 8; ++j) *((GAS unsigned*)dst + lane + 64 * j) = pack_i8_2(v[j].x * sc, v[j].y * sc, v[j].z * sc, v[j].w * sc);
    if (lane == 0) *inv = mx > 0.f ? mx * (1.0f / 127.0f) : 1.0f;
}
__device__ __forceinline__ void row_bf16_to_i8(const bf16* src, signed char* dst, float* inv, int lane) {
    float v[4][8]; float mx = 0.f;
#pragma unroll
    for (int j = 0; j < 4; ++j) { const v4u w = *((const GAS v4u*)src + lane + 64 * j);
        v[j][0] = pg8::bf_lo(w.x); v[j][1] = pg8::bf_hi(w.x); v[j][2] = pg8::bf_lo(w.y); v[j][3] = pg8::bf_hi(w.y); v[j][4] = pg8::bf_lo(w.z); v[j][5] = pg8::bf_hi(w.z); v[j][6] = pg8::bf_lo(w.w); v[j][7] = pg8::bf_hi(w.w);
#pragma unroll
        for (int e = 0; e < 8; ++e) mx = fmaxf(mx, fabsf(v[j][e])); }
#pragma unroll
    for (int o = 1; o < 64; o <<= 1) mx = fmaxf(mx, __shfl_xor(mx, o));
    const float sc = mx > 0.f ? 127.0f / mx : 1.0f;
#pragma unroll
    for (int j = 0; j < 4; ++j) { v2u o; o.x = pack_i8_2(v[j][0] * sc, v[j][1] * sc, v[j][2] * sc, v[j][3] * sc); o.y = pack_i8_2(v[j][4] * sc, v[j][5] * sc, v[j][6] * sc, v[j][7] * sc); *((GAS v2u*)dst + lane + 64 * j) = o; }
    if (lane == 0) *inv = mx > 0.f ? mx * (1.0f / 127.0f) : 1.0f;
}

constexpr int TK_ROWF = 136;
constexpr int TK_IDX_OFF = 256 * TK_ROWF * 4;
__device__ __forceinline__ void topk_core(LAS unsigned char* lds, size_t prob0, int pstride, int* experts, float* gates, int tid) {
    LAS float* S = (LAS float*)lds;
    LAS unsigned char* IDX = lds + TK_IDX_OFF;
    const int row = tid >> 1, sub = tid & 1;
#define TK_CE(a, b) do { const float h_ = vmaxf(a, b), l_ = vminf(a, b); a = h_; b = l_; } while (0)
#define TK_SORT16(V) do { _Pragma("unroll") for (int k_ = 2; k_ <= 16; k_ <<= 1) _Pragma("unroll") for (int j_ = k_ >> 1; j_ > 0; j_ >>= 1) _Pragma("unroll") for (int i_ = 0; i_ < 16; ++i_) { \
        const int l_i = i_ ^ j_; if (l_i > i_) { if ((i_ & k_) == 0) TK_CE(V[i_], V[l_i]); else TK_CE(V[l_i], V[i_]); } } } while (0)
#define TK_MERGE16(Lv, Xv) do { _Pragma("unroll") for (int j_ = 0; j_ < 16; ++j_) Lv[j_] = vmaxf(Lv[j_], Xv[15 - j_]); \
        _Pragma("unroll") for (int st_ = 8; st_ >= 1; st_ >>= 1) _Pragma("unroll") for (int j_ = 0; j_ < 16; ++j_) if ((j_ & st_) == 0) TK_CE(Lv[j_], Lv[j_ + st_]); } while (0)
    float L[16];
#pragma unroll
    for (int q = 0; q < 4; ++q) {
        float C[16];
#pragma unroll
        for (int i = 0; i < 4; ++i) { const int c4 = 2 * (4 * q + i) + sub;
            const f32x4 v = *(const LAS f32x4*)(S + row * TK_ROWF + 4 * c4);
#pragma unroll
            for (int e = 0; e < 4; ++e) { const float ve = v[e];
                C[4 * i + e] = __uint_as_float((__float_as_uint(ve) & ~0x7Fu) | (unsigned)(4 * c4 + e)); } }
        TK_SORT16(C);
        if (q == 0) {
#pragma unroll
            for (int j = 0; j < 16; ++j) L[j] = C[j];
        } else TK_MERGE16(L, C);
    }
    {
        float P[16];
#pragma unroll
        for (int j = 0; j < 16; ++j) P[j] = __shfl_xor(L[j], 1);
        TK_MERGE16(L, P);
    }
    if (sub == 0) {
#pragma unroll
        for (int q = 0; q < 4; ++q) {
            unsigned w = 0;
#pragma unroll
            for (int e = 0; e < 4; ++e) w |= (__builtin_bit_cast(unsigned, L[4 * q + e]) & 0x7Fu) << (8 * e);
            *(LAS unsigned*)(IDX + row * 16 + 4 * q) = w;
        }
    }
    float A[16], B[16];
#pragma unroll
    for (int j = 0; j < 16; ++j) { const float o = __shfl_xor(L[j], 2); const bool isb = (tid & 2) != 0; A[j] = isb ? o : L[j]; B[j] = isb ? L[j] : o; }
#define TK_KEY(i, j) __uint_as_float((__float_as_uint(A[i] + B[j]) & ~0xFFu) | (unsigned)(255 - ((i) * 16 + (j))))
    float F[16], X[16];
#pragma unroll
    for (int j = 0; j < 16; ++j) F[j] = TK_KEY(0, j);
#pragma unroll
    for (int i = 1; i < 16; ++i) X[i - 1] = TK_KEY(i, 0);
    X[15] = -INFINITY; TK_MERGE16(F, X);
#pragma unroll
    for (int i = 0; i < 16; ++i) X[i] = -INFINITY;
#pragma unroll
    for (int i = 1; i <= 7; ++i) X[i - 1] = TK_KEY(i, 1);
    TK_MERGE16(F, X);
#pragma unroll
    for (int i = 0; i < 16; ++i) X[i] = -INFINITY;
#pragma unroll
    for (int j = 2; j <= 7; ++j) X[j - 2] = TK_KEY(1, j);
    TK_MERGE16(F, X);
    { const float rest[6] = {TK_KEY(2, 2), TK_KEY(2, 3), TK_KEY(2, 4), TK_KEY(3, 2), TK_KEY(3, 3), TK_KEY(4, 2)};
#pragma unroll
      for (int r = 0; r < 6; ++r) { float x = rest[r];
#pragma unroll
          for (int k = 0; k < 16; ++k) { const float h = vmaxf(F[k], x); x = vminf(F[k], x); F[k] = h; } } }
    __syncthreads();
    if ((tid & 3) == 0) {
        const int rowA = (tid >> 2) * 2, rowB = rowA + 1;
        const size_t prob = prob0 + (size_t)pstride * (tid >> 2);
        float g[16]; int ex[16]; float gs = 0.f;
#pragma unroll
        for (int k = 0; k < 16; ++k) {
            const unsigned code = 255u - (__builtin_bit_cast(unsigned, F[k]) & 0xFFu);
            const int ia = IDX[rowA * 16 + (code >> 4)], ib = IDX[rowB * 16 + (code & 15)];
            ex[k] = ia * PNK + ib;
            g[k] = __expf(F[k] - F[0]); gs += g[k];
        }
        const float ginv = 1.0f / gs;
#pragma unroll
        for (int q = 0; q < 4; ++q) {
            *(GAS f32x4*)(gates + prob * 16 + 4 * q) = (f32x4){g[4 * q] * ginv, g[4 * q + 1] * ginv, g[4 * q + 2] * ginv, g[4 * q + 3] * ginv};
            typedef int i32x4 __attribute__((ext_vector_type(4)));
            *(GAS i32x4*)(experts + prob * 16 + 4 * q) = (i32x4){ex[4 * q], ex[4 * q + 1], ex[4 * q + 2], ex[4 * q + 3]};
        }
    }
    __syncthreads();
}
__device__ __forceinline__ void topk_pass(int pass, const float* scores, int* experts, float* gates, LAS unsigned char* lds, int tid) {
    LAS float* S = (LAS float*)lds;
    const float* src = scores + (size_t)pass * (256 * 128);
#pragma unroll 4
    for (int i = 0; i < 16; ++i) { const int f4 = tid + NTHREADS * i, row = f4 >> 5, c4 = f4 & 31; *(LAS f32x4*)(S + row * TK_ROWF + 4 * c4) = *(const GAS f32x4*)(src + (size_t)f4 * 4); }
    __syncthreads();
    topk_core(lds, (size_t)pass * 128, 1, experts, gates, tid);
}
struct EpiTopKI8 {
    static constexpr bool PERM = false, AFTER_DRAIN = true;
    int* experts; float* gates; const float* sa; const float* sb;
    __device__ __forceinline__ void fused(pg8::i32x4 (&acc)[2][2][4][2], const pg8::Unit& u, int wr, int wc, int fr, int fq, LAS unsigned char* lds, int wid, int lane) const {
        LAS float* S = (LAS float*)lds;
        const int tid = wid * 64 + lane;
        pg8::f32x4 sbv[2][2];
#pragma unroll
        for (int bj = 0; bj < 2; ++bj)
#pragma unroll
            for (int n = 0; n < 2; ++n) sbv[bj][n] = *(const GAS pg8::f32x4*)(sb + u.pn * 256 + bj * 128 + 32 * wc + 16 * n + 4 * fq);
#pragma unroll
        for (int ai = 0; ai < 2; ++ai) {
#pragma unroll
            for (int mm = 0; mm < 4; ++mm) { const int rl = 64 * wr + 16 * mm + fr; const float sr = sa[u.pm * 256 + 128 * ai + rl];
#pragma unroll
                for (int bj = 0; bj < 2; ++bj)
#pragma unroll
                    for (int n = 0; n < 2; ++n) { const pg8::i32x4 a = acc[ai][bj][mm][n];
                        *(LAS pg8::f32x4*)(S + (2 * rl + bj) * TK_ROWF + 32 * wc + 16 * n + 4 * fq) = (pg8::f32x4){(float)a[0], (float)a[1], (float)a[2], (float)a[3]} * sbv[bj][n] * sr; } }
            __syncthreads();
            topk_core(lds, ((size_t)u.pm * 256 + 128 * ai) * PH + u.pn, PH, experts, gates, tid);
        }
    }
};
struct EpiTopK {
    static constexpr bool PERM = false, AFTER_DRAIN = true;
    int* experts; float* gates;
    __device__ __forceinline__ void fused(pg8::f32x4 (&acc)[2][2][4][2], const pg8::Unit& u, int wr, int wc, int fr, int fq, LAS unsigned char* lds, int wid, int lane) const {
        LAS float* S = (LAS float*)lds;
        const int tid = wid * 64 + lane;
#pragma unroll
        for (int ai = 0; ai < 2; ++ai) {
#pragma unroll
            for (int bj = 0; bj < 2; ++bj)
#pragma unroll
                for (int mm = 0; mm < 4; ++mm)
#pragma unroll
                    for (int n = 0; n < 2; ++n) { const int rl = 64 * wr + 16 * mm + fr; *(LAS pg8::f32x4*)(S + (2 * rl + bj) * TK_ROWF + 32 * wc + 16 * n + 4 * fq) = acc[ai][bj][mm][n]; }
            __syncthreads();
            topk_core(lds, ((size_t)u.pm * 256 + 128 * ai) * PH + u.pn, PH, experts, gates, tid);
        }
    }
};

__device__ __forceinline__ float gelu_erf(float v) { return 0.5f * v * (1.0f + erff(v * 0.70710678118654752f)); }
typedef __bf16 bf16x2_t __attribute__((ext_vector_type(2)));
typedef float f32x2_t __attribute__((ext_vector_type(2)));
__device__ __forceinline__ float dot2bf(bf16x2_t a, unsigned b, float acc) { return __builtin_amdgcn_fdot2_f32_bf16(a, __builtin_bit_cast(bf16x2_t, b), acc, false); }
__device__ __forceinline__ float dot4f8(unsigned w8, unsigned x01, unsigned x23, float acc) {
    acc = dot2bf(__builtin_amdgcn_cvt_scalef32_pk_bf16_fp8(w8, 1.0f, false), x01, acc);
    return dot2bf(__builtin_amdgcn_cvt_scalef32_pk_bf16_fp8(w8, 1.0f, true), x23, acc);
}
__device__ __forceinline__ void axpy4f8(float* y, unsigned w8, float w) {
    const f32x2_t lo = __builtin_amdgcn_cvt_pk_f32_fp8(w8, false), hi = __builtin_amdgcn_cvt_pk_f32_fp8(w8, true);
    y[0] += w * lo.x; y[1] += w * lo.y; y[2] += w * hi.x; y[3] += w * hi.y;
}
__device__ __forceinline__ void axpy4f8v(f32x2_t* y2, unsigned w8, float w) {
    const f32x2_t lo = __builtin_amdgcn_cvt_pk_f32_fp8(w8, false), hi = __builtin_amdgcn_cvt_pk_f32_fp8(w8, true);
    const f32x2_t ww = {w, w};
    y2[0] = __builtin_elementwise_fma(lo, ww, y2[0]); y2[1] = __builtin_elementwise_fma(hi, ww, y2[1]);
}
__device__ __forceinline__ void row_to_fp8(const float* src, unsigned char* dst, float* inv, int lane) {
    f32x4 v[2][4]; float mx = 0.f;
#pragma unroll
    for (int j = 0; j < 2; ++j)
#pragma unroll
        for (int q = 0; q < 4; ++q) { v[j][q] = *((const GAS f32x4*)src + 4 * (lane + 64 * j) + q);
            mx = fmaxf(mx, fmaxf(fmaxf(fabsf(v[j][q].x), fabsf(v[j][q].y)), fmaxf(fabsf(v[j][q].z), fabsf(v[j][q].w)))); }
#pragma unroll
    for (int o = 1; o < 64; o <<= 1) mx = fmaxf(mx, __shfl_xor(mx, o));
    const float sc = mx > 0.f ? 384.0f / mx : 1.0f;
#pragma unroll
    for (int j = 0; j < 2; ++j) { v4u o;
        int w;
        w = 0; w = __builtin_amdgcn_cvt_pk_fp8_f32(v[j][0].x * sc, v[j][0].y * sc, w, false); w = __builtin_amdgcn_cvt_pk_fp8_f32(v[j][0].z * sc, v[j][0].w * sc, w, true); o.x = (unsigned)w;
        w = 0; w = __builtin_amdgcn_cvt_pk_fp8_f32(v[j][1].x * sc, v[j][1].y * sc, w, false); w = __builtin_amdgcn_cvt_pk_fp8_f32(v[j][1].z * sc, v[j][1].w * sc, w, true); o.y = (unsigned)w;
        w = 0; w = __builtin_amdgcn_cvt_pk_fp8_f32(v[j][2].x * sc, v[j][2].y * sc, w, false); w = __builtin_amdgcn_cvt_pk_fp8_f32(v[j][2].z * sc, v[j][2].w * sc, w, true); o.z = (unsigned)w;
        w = 0; w = __builtin_amdgcn_cvt_pk_fp8_f32(v[j][3].x * sc, v[j][3].y * sc, w, false); w = __builtin_amdgcn_cvt_pk_fp8_f32(v[j][3].z * sc, v[j][3].w * sc, w, true); o.w = (unsigned)w;
        { const int ch = lane + 64 * j; *((GAS v4u*)(dst + (size_t)(ch >> 4) * SLICE_BYTES) + (ch & 15)) = o; } }
    if (lane == 0) *inv = mx > 0.f ? mx * (1.0f / 384.0f) : 1.0f;
}
__device__ __forceinline__ void row_to_i8(const float* src, unsigned char* dst, float* inv, int lane) {
    f32x4 v[2][4]; float mx = 0.f;
#pragma unroll
    for (int j = 0; j < 2; ++j)
#pragma unroll
        for (int q = 0; q < 4; ++q) { v[j][q] = *((const GAS f32x4*)src + 4 * (lane + 64 * j) + q);
            mx = fmaxf(mx, fmaxf(fmaxf(fabsf(v[j][q].x), fabsf(v[j][q].y)), fmaxf(fabsf(v[j][q].z), fabsf(v[j][q].w)))); }
#pragma unroll
    for (int o = 1; o < 64; o <<= 1) mx = fmaxf(mx, __shfl_xor(mx, o));
    const float sc = mx > 0.f ? 127.0f / mx : 1.0f;
#pragma unroll
    for (int j = 0; j < 2; ++j) { v4u o; o.x = pack_i8(v[j][0] * sc); o.y = pack_i8(v[j][1] * sc); o.z = pack_i8(v[j][2] * sc); o.w = pack_i8(v[j][3] * sc);
        { const int ch = lane + 64 * j; *((GAS v4u*)(dst + (size_t)(ch >> 4) * SLICE_BYTES) + (ch & 15)) = o; } }
    if (lane == 0) *inv = mx > 0.f ? mx * (1.0f / 127.0f) : 1.0f;
}
__device__ __forceinline__ float row16_allsum(float a) {
    a += __builtin_bit_cast(float, __builtin_amdgcn_update_dpp(0, __builtin_bit_cast(int, a), 0x128, 0xf, 0xf, false));
    a += __builtin_bit_cast(float, __builtin_amdgcn_update_dpp(0, __builtin_bit_cast(int, a), 0x124, 0xf, 0xf, false));
    a += __builtin_bit_cast(float, __builtin_amdgcn_update_dpp(0, __builtin_bit_cast(int, a), 0x122, 0xf, 0xf, false));
    a += __builtin_bit_cast(float, __builtin_amdgcn_update_dpp(0, __builtin_bit_cast(int, a), 0x121, 0xf, 0xf, false));
    return a;
}
__device__ __forceinline__ int q_pull(unsigned* q, int lane) { int v = 0; if (lane == 0) v = (int)__hip_atomic_fetch_add(q, 1u, __ATOMIC_RELAXED, __HIP_MEMORY_SCOPE_AGENT); return __builtin_amdgcn_readfirstlane(v); }
constexpr int PEER_TG = 8;
constexpr int PEER_N8 = 640, PEER_N4 = 512, PEER_N2 = 512, PEER_NTASK = PEER_N8 + PEER_N4 + PEER_N2;
__device__ __forceinline__ void peer_task_tokens(int idx, int& t0, int& n) {
    if (idx < PEER_N8) { t0 = 8 * idx; n = 8; } else if (idx < PEER_N8 + PEER_N4) { t0 = 8 * PEER_N8 + 4 * (idx - PEER_N8); n = 4; } else { t0 = 8 * PEER_N8 + 4 * PEER_N4 + 2 * (idx - PEER_N8 - PEER_N4); n = 2; }
}
__device__ __forceinline__ int row16_allsum_i(int a) {
    a += __builtin_amdgcn_update_dpp(0, a, 0x128, 0xf, 0xf, false);
    a += __builtin_amdgcn_update_dpp(0, a, 0x124, 0xf, 0xf, false);
    a += __builtin_amdgcn_update_dpp(0, a, 0x122, 0xf, 0xf, false);
    a += __builtin_amdgcn_update_dpp(0, a, 0x121, 0xf, 0xf, false);
    return a;
}
#define PA_LOAD(R, IDV, HALF) do { _Pragma("unroll") for (int i_ = 0; i_ < 8; ++i_) { const unsigned e_ = (unsigned)__shfl(IDV, 4 * (i_ + 8 * (HALF)) + g); \
        R[i_] = *(const GAS v4u*)(ub + (e_ * 256u + offc)); } } while (0)
#define PA_COMP(R, HALF) do { _Pragma("unroll") for (int i_ = 0; i_ < 8; ++i_) { int a_ = __builtin_amdgcn_sdot4((int)R[i_].x, (int)xc.x, 0, false); a_ = __builtin_amdgcn_sdot4((int)R[i_].y, (int)xc.y, a_, false); \
        a_ = __builtin_amdgcn_sdot4((int)R[i_].z, (int)xc.z, a_, false); a_ = __builtin_amdgcn_sdot4((int)R[i_].w, (int)xc.w, a_, false); r16[8 * (HALF) + i_] = row16_allsum_i(a_); } } while (0)
__device__ __forceinline__ void peer_a_task(int t0, int ntok, int s, const signed char* xq, const int* experts, const unsigned char* u8s, int* pa, int lane_) {
    int lane = lane_; asm volatile("" : "+v"(lane));
    const int g = lane >> 4, c = lane & 15;
    const GAS unsigned char* ub = (const GAS unsigned char*)(u8s + (size_t)s * SLICE_BYTES);
    const unsigned offc = 16u * (unsigned)c;
    int idc0 = experts[(size_t)t0 * 128 + lane], idc1 = experts[(size_t)t0 * 128 + lane + 64];
    v4u xc = *(const GAS v4u*)(xq + (size_t)t0 * D + 256 * s + 16 * c);
    v4u RA[8], RB[8];
    PA_LOAD(RA, idc0, 0);
#pragma unroll 1
    for (int tt = 0; tt < ntok; ++tt) {
        const int t = t0 + tt, tn = tt + 1 < ntok ? t + 1 : t;
        const int idn0 = experts[(size_t)tn * 128 + lane], idn1 = experts[(size_t)tn * 128 + lane + 64];
        const v4u xn = *(const GAS v4u*)(xq + (size_t)tn * D + 256 * s + 16 * c);
#pragma unroll 1
        for (int hb = 0; hb < 2; ++hb) {
            const int idv = hb ? idc1 : idc0, idx = hb ? idn0 : idc1;
            int r16[16];
            PA_LOAD(RB, idv, 1); PA_COMP(RA, 0);
            asm volatile("" ::: "memory");
            PA_LOAD(RA, idx, 0); PA_COMP(RB, 1);
            if (c == 15) { typedef int i32x4 __attribute__((ext_vector_type(4))); GAS i32x4* dst = (GAS i32x4*)(pa + ((size_t)t * 8 + s) * 128 + g * 32 + 16 * hb);
#pragma unroll
                for (int q = 0; q < 4; ++q) dst[q] = (i32x4){r16[4 * q], r16[4 * q + 1], r16[4 * q + 2], r16[4 * q + 3]}; }
        }
        idc0 = idn0; idc1 = idn1; xc = xn;
    }
}
__device__ __forceinline__ void peer_w_elem(size_t i, const int* experts, const float* gates, const float* su, const float* sv, const float* sx, const int* pa, float* wb) {
    const size_t t = i >> 7; const int k = (int)(i & 127), pos = (k & 3) * 32 + (k >> 2);
    const int e = experts[i];
    int a = 0;
#pragma unroll
    for (int s2 = 0; s2 < 8; ++s2) a += pa[(t * 8 + s2) * 128 + pos];
    wb[i] = gates[i] * gelu_erf((float)a * (su[e] * sx[t])) * sv[e];
}
#define PB_LOAD(R, IDV, HALF) do { _Pragma("unroll") for (int i_ = 0; i_ < 8; ++i_) { const unsigned e_ = (unsigned)__shfl(IDV, 4 * (i_ + 8 * (HALF)) + g); \
        R[i_] = *(const GAS v4u*)(vb + (e_ * 256u + offc)); } } while (0)
#define PB_COMP(R, WV, HALF) do { _Pragma("unroll") for (int i_ = 0; i_ < 8; ++i_) { const float wk_ = __shfl(WV, 4 * (i_ + 8 * (HALF)) + g); \
        axpy4f8v(&ya2[0], R[i_].x, wk_); axpy4f8v(&ya2[2], R[i_].y, wk_); axpy4f8v(&ya2[4], R[i_].z, wk_); axpy4f8v(&ya2[6], R[i_].w, wk_); } } while (0)
__device__ __forceinline__ void peer_b_task(int t0, int ntok, int s, const bf16* h1, const int* experts, const float* wb, const unsigned char* v8s, bf16* out, float* st, int lane_) {
    int lane = lane_; asm volatile("" : "+v"(lane));
    const int g = lane >> 4, c = lane & 15;
    const GAS unsigned char* vb = (const GAS unsigned char*)(v8s + (size_t)s * SLICE_BYTES);
    const unsigned offc = 16u * (unsigned)c;
    int idc0 = experts[(size_t)t0 * 128 + lane], idc1 = experts[(size_t)t0 * 128 + lane + 64];
    float wc0 = wb[(size_t)t0 * 128 + lane], wc1 = wb[(size_t)t0 * 128 + lane + 64];
    v4u RA[8], RB[8];
    PB_LOAD(RA, idc0, 0);
#pragma unroll 1
    for (int tt = 0; tt < ntok; ++tt) {
        const int t = t0 + tt, tn = tt + 1 < ntok ? t + 1 : t;
        const int idn0 = experts[(size_t)tn * 128 + lane], idn1 = experts[(size_t)tn * 128 + lane + 64];
        const float wn0 = wb[(size_t)tn * 128 + lane], wn1 = wb[(size_t)tn * 128 + lane + 64];
        f32x2_t ya2[8];
#pragma unroll
        for (int e = 0; e < 8; ++e) ya2[e] = (f32x2_t){0.f, 0.f};
#pragma unroll 1
        for (int hb = 0; hb < 2; ++hb) {
            const int idv = hb ? idc1 : idc0, idx = hb ? idn0 : idc1; const float wv = hb ? wc1 : wc0;
            PB_LOAD(RB, idv, 1); PB_COMP(RA, wv, 0);
            asm volatile("" ::: "memory");
            PB_LOAD(RA, idx, 0); PB_COMP(RB, wv, 1);
        }
        float ya[16];
#pragma unroll
        for (int e = 0; e < 8; ++e) { ya[2 * e] = ya2[e].x; ya[2 * e + 1] = ya2[e].y; }
#pragma unroll
        for (int e = 0; e < 16; ++e) { ya[e] += __shfl_xor(ya[e], 16); ya[e] += __shfl_xor(ya[e], 32); }
        const GAS v4u* hp = (const GAS v4u*)(h1 + (size_t)t * D + 256 * s + 16 * c);
        const v4u h0 = hp[0], h1v = hp[1];
        float hx[16];
        hx[0] = pg8::bf_lo(h0.x); hx[1] = pg8::bf_hi(h0.x); hx[2] = pg8::bf_lo(h0.y); hx[3] = pg8::bf_hi(h0.y); hx[4] = pg8::bf_lo(h0.z); hx[5] = pg8::bf_hi(h0.z); hx[6] = pg8::bf_lo(h0.w); hx[7] = pg8::bf_hi(h0.w);
        hx[8] = pg8::bf_lo(h1v.x); hx[9] = pg8::bf_hi(h1v.x); hx[10] = pg8::bf_lo(h1v.y); hx[11] = pg8::bf_hi(h1v.y); hx[12] = pg8::bf_lo(h1v.z); hx[13] = pg8::bf_hi(h1v.z); hx[14] = pg8::bf_lo(h1v.w); hx[15] = pg8::bf_hi(h1v.w);
        float sm = 0.f, sq = 0.f;
#pragma unroll
        for (int e = 0; e < 16; ++e) { ya[e] = hx[e] * ALPHA + ya[e]; sm += ya[e]; sq += ya[e] * ya[e]; }
        sm = row16_allsum(sm); sq = row16_allsum(sq);
        if (g == 0) { GAS v4u* op = (GAS v4u*)(out + (size_t)t * D + 256 * s + 16 * c);
            v4u o0, o1; o0.x = pk2(ya[0], ya[1]); o0.y = pk2(ya[2], ya[3]); o0.z = pk2(ya[4], ya[5]); o0.w = pk2(ya[6], ya[7]);
            o1.x = pk2(ya[8], ya[9]); o1.y = pk2(ya[10], ya[11]); o1.z = pk2(ya[12], ya[13]); o1.w = pk2(ya[14], ya[15]);
            op[0] = o0; op[1] = o1;
            if (c == 0) { st[((size_t)t * 8 + s) * 2] = sm; st[((size_t)t * 8 + s) * 2 + 1] = sq; } }
        idc0 = idn0; idc1 = idn1; wc0 = wn0; wc1 = wn1;
    }
}
__device__ __forceinline__ void peer_c_row(int t, const bf16* r2, float* out, const float* st, const float* g2, const float* b2, int lane) {
    float sm = 0.f, sq = 0.f;
#pragma unroll
    for (int s = 0; s < 8; ++s) { sm += st[((size_t)t * 8 + s) * 2]; sq += st[((size_t)t * 8 + s) * 2 + 1]; }
    const float mean = sm * (1.f / D), var = sq * (1.f / D) - mean * mean, rstd = 1.f / sqrtf(fmaxf(var, 0.f) + LN_EPS);
    const GAS v4u* xr = (const GAS v4u*)(r2 + (size_t)t * D) + lane;
    GAS f32x4* op = (GAS f32x4*)(out + (size_t)t * D);
#pragma unroll
    for (int j = 0; j < 4; ++j) { const v4u w = xr[64 * j]; const int c4 = 2 * (lane + 64 * j);
        const f32x4 g0 = *((const GAS f32x4*)g2 + c4), g1 = *((const GAS f32x4*)g2 + c4 + 1), b0 = *((const GAS f32x4*)b2 + c4), b1 = *((const GAS f32x4*)b2 + c4 + 1);
        const f32x4 v0 = (f32x4){pg8::bf_lo(w.x), pg8::bf_hi(w.x), pg8::bf_lo(w.y), pg8::bf_hi(w.y)}, v1 = (f32x4){pg8::bf_lo(w.z), pg8::bf_hi(w.z), pg8::bf_lo(w.w), pg8::bf_hi(w.w)};
        op[c4] = (v0 - mean) * rstd * g0 + b0; op[c4 + 1] = (v1 - mean) * rstd * g1 + b1; }
}

struct TwoPassOrder : pg8::StaticOrder {
    __device__ __forceinline__ bool next(int i, pg8::Unit& u) const { if (!pg8::StaticOrder::next(i >> 1, u)) return false; u.w = i & 1; return true; }
};
struct EpiGate2 {
    static constexpr bool PERM = true, AFTER_DRAIN = false;
    pg8::EpiGate<0> e0; pg8::EpiGate<1> e1;
    __device__ __forceinline__ void operator()(const pg8::f32x4 (&acc)[2][2][4][2], const pg8::Unit& u, int wr, int wc, int fr, int fq) const { if (u.w == 0) e0(acc, u, wr, wc, fr, fq); else e1(acc, u, wr, wc, fr, fq); }
};

struct ConvOrder : pg8::StaticOrder {
    const float* pu; const float* pv; unsigned char* u8; unsigned char* v8; float* su; float* sv; int slot; mutable int calls;
    static constexpr int CONV_ROWS = 4, CONV_CALLS = 6;
    __device__ __forceinline__ void done(const pg8::Unit&) const {
        if (slot < 0) return;
        int lane = threadIdx.x & 63; asm volatile("" : "+v"(lane));
        const int wave = __builtin_amdgcn_readfirstlane(threadIdx.x >> 6);
        const int base = ((slot * NWAVES + wave) * CONV_CALLS + calls) * CONV_ROWS;
        if (calls < CONV_CALLS) {
#pragma unroll 1
            for (int j = 0; j < CONV_ROWS; ++j) { const int r = base + j; if (r < 2 * PNE) { const bool sec = r >= PNE; const int e = sec ? r - PNE : r;
                if (sec) row_to_fp8(pv + (size_t)e * D, v8 + (size_t)e * 256, sv + e, lane); else row_to_i8(pu + (size_t)e * D, u8 + (size_t)e * 256, su + e, lane); } }
        }
        ++calls;
    }
};

struct Args { const float* in[16]; float* out; unsigned char* ws; int ph_lo, ph_hi; };
__global__ void __launch_bounds__(NTHREADS, 2) mk_fwd(Args args) {
    extern __shared__ __attribute__((aligned(16))) unsigned char lds_raw[];
    LAS unsigned char* lds = (LAS unsigned char*)lds_raw;
    volatile LAS unsigned* MISC = (volatile LAS unsigned*)(lds + MISC_OFF);
    const int tid0 = threadIdx.x;
    const int G = gridDim.x, bx = blockIdx.x;
    unsigned char* ws = args.ws;
    gu32* ctl = (gu32*)(ws + WS_CTL);
#define IN_(i) (args.in[i])
#define x_in IN_(0)
#define w_in IN_(1)
#define b_gate IN_(2)
#define sinks IN_(3)
#define conv_w IN_(4)
#define w_ao IN_(5)
#define w_co IN_(6)
#define w_o IN_(7)
#define ln1_g IN_(8)
#define ln1_b IN_(9)
#define w_q IN_(10)
#define sub_keys IN_(11)
#define peer_u IN_(12)
#define peer_v IN_(13)
#define ln2_g IN_(14)
#define ln2_b IN_(15)
#define WinT ((bf16*)(ws + WS_WIN))
#define WaT ((bf16*)(ws + WS_WA))
#define WcT ((bf16*)(ws + WS_WC))
#define WoT ((bf16*)(ws + WS_WO))
#define WfT ((bf16*)(ws + WS_WF))
#define XB ((bf16*)(ws + WS_XB))
#define MERGED ((bf16*)(ws + WS_MERGED))
#define Z ((bf16*)(ws + WS_Z))
#define R2B ((bf16*)(ws + WS_R2B))
#define H1B ((bf16*)(ws + WS_H1B))
#define SC ((float*)(ws + WS_SC))
#define EX ((int*)(ws + WS_EX))
#define GT ((float*)(ws + WS_GT))
#define AO ((bf16*)(ws + WS_AO))
#define CI ((bf16*)(ws + WS_CI))
#define TMP ((bf16*)(ws + WS_TMP))
#define U8 ((unsigned char*)(ws + WS_U8))
#define V8 ((unsigned char*)(ws + WS_V8))
#define SU ((float*)(ws + WS_SU))
#define SV ((float*)(ws + WS_SV))
#define PA ((int*)(ws + WS_PA))
#define ST ((float*)(ws + WS_ST))
#define WB ((float*)(ws + WS_WB))
#define XA8 ((signed char*)(ws + WS_XA8))
#define WIN8 ((signed char*)(ws + WS_WIN8))
#define SWIN ((float*)(ws + WS_SWIN))
#define SXA ((float*)(ws + WS_SXA))
#define WF8 ((signed char*)(ws + WS_WF8))
#define SWF ((float*)(ws + WS_SWF))
#define XQ ((signed char*)(ws + WS_XQ))
#define SX ((float*)(ws + WS_SX))
    for (int u = tid0; u < (LDS_BYTES - LDSCTL_OFF) / 4; u += NTHREADS) ((LAS unsigned*)(lds + LDSCTL_OFF))[u] = 0u;
    __syncthreads();
    XcdBarrier bar; bar.bar = (unsigned*)(ctl + CW_BAR); bar.x = 0; bar.st = nullptr;
    if (!MK_PER_PHASE) bar = xcd_barrier_post((unsigned*)(ctl + CW_BAR), MISC + 8);
    const int lo = args.ph_lo, hi = args.ph_hi;
#ifndef PH_MASK
#define PH_MASK 0xFFF
#endif
#define IN(k) (((PH_MASK >> (k)) & 1) && lo <= (k) && (k) < hi)
#ifndef DBL_BAR
#define DBL_BAR 0
#endif
#define SEAM(k) do { if (IN(k) && IN((k) + 1)) { xcd_barrier(bar); if (DBL_BAR) xcd_barrier(bar); } } while (0)
#ifndef DBL_MASK
#define DBL_MASK 0
#endif
#define REP(k) for (int rep_ = 0; rep_ < 1 + ((DBL_MASK >> (k)) & 1); ++rep_)
#define PHASE_TID() int tid = tid0; asm volatile("" : "+v"(tid)); const int lane = tid & 63, wave = __builtin_amdgcn_readfirstlane(tid >> 6); (void)lane; (void)wave

    if (IN(0)) REP(0) {
        PHASE_TID();
        const bool conv_first = ((bx >> 3) & 1) == 0;
#pragma unroll 1
        for (int part = 0; part < 2; ++part) {
            if ((part == 0) == conv_first) {
                int tid = tid0; asm volatile("" : "+v"(tid)); const int lane = tid & 63, wave = __builtin_amdgcn_readfirstlane(tid >> 6);
                LAS float* scr = (LAS float*)(lds + wave * 16384);
                const int gw = bx * NWAVES + wave, NGW = G * NWAVES;
                constexpr int I_IN = (D / 64) * (IN_W / 32), I_SQ = (D / 64) * (D / 32);
                for (int it = gw; it < I_IN + 3 * I_SQ; it += NGW) {
                    int r = it;
                    if (r < I_IN) { p0_transpose_item(w_in, D, IN_W, WinT, scr, r, lane); continue; } r -= I_IN;
                    if (r < I_SQ) { p0_transpose_item(w_ao, D, D, WaT, scr, r, lane); continue; } r -= I_SQ;
                    if (r < I_SQ) { p0_transpose_item(w_co, D, D, WcT, scr, r, lane); continue; } r -= I_SQ;
                    p0_transpose_item(w_o, D, D, WoT, scr, r, lane);
                }
                for (int r = gw; r < M; r += NGW) row_f32_to_i8(x_in + (size_t)r * D, XA8 + (size_t)r * D, SXA + r, lane);
                __syncthreads();
            }
            if (part == 0) for (int it = bx; it < 16 * 32; it += G) p0_wf_item(w_q, sub_keys, WfT, lds, it, tid);
        }
    }
    SEAM(0);
    if (IN(1)) REP(1) {
        { PHASE_TID();
          for (int r = bx * NWAVES + wave; r < IN_W + D; r += G * NWAVES) { if (r < IN_W) row_bf16_to_i8(WinT + (size_t)r * D, WIN8 + (size_t)r * D, SWIN + r, lane);
              else { const int q = r - IN_W; row_bf16_to_i8(WfT + (size_t)q * D, WF8 + (size_t)q * D, SWF + q, lane); } } }
        if (!MK_PER_PHASE) xcd_barrier(bar);
        pg8::Gemm g{(const bf16*)XA8, (const bf16*)WIN8, M, IN_W, D / 2}; ConvOrder S; S.init(M, IN_W, G, bx);
        S.pu = peer_u; S.pv = peer_v; S.u8 = U8; S.v8 = V8; S.su = SU; S.sv = SV; S.calls = 0;
        S.slot = (G == 256 && bx >= 64) ? bx - 64 : -1;
        pg8::EpiI8Bf16 E{Z, IN_W, SXA, SWIN};
        pg8::gemm_phase<pg8::EpiI8Bf16, ConvOrder, true, true, true>(lds, g, S, E);
        if (G != 256) {
            PHASE_TID();
            for (int r = bx * NWAVES + wave; r < 2 * PNE; r += G * NWAVES) { const bool sec = r >= PNE; const int e = sec ? r - PNE : r;
                if (sec) row_to_fp8(peer_v + (size_t)e * D, V8 + (size_t)e * 256, SV + e, lane); else row_to_i8(peer_u + (size_t)e * D, U8 + (size_t)e * 256, SU + e, lane); }
        }
    }
    SEAM(1);
    if (IN(2)) REP(2) {
        PHASE_TID();
        const bool conv_first = ((bx >> 3) & 1) == 0;
#pragma unroll 1
        for (int part = 0; part < 2; ++part) {
            if ((part == 0) == conv_first) { int t2 = tid0; asm volatile("" : "+v"(t2)); for (int it = bx; it < M / 32; it += G) conv_item(it, Z, conv_w, CI, t2); }
            if (part == 0) for (int u = bx; u < BATCH * NKVH * 16; u += G) attn_unit(u, Z, AO, sinks, lds, tid);
        }
    }
    SEAM(2);
    if (IN(3)) REP(3) {
        TwoPassOrder S; S.init(M, D, G, bx);
        pg8::Gemm g{AO, WaT, M, D, D, CI, WcT};
        EpiGate2 E{pg8::EpiGate<0>{TMP, nullptr, Z + G_OFF, b_gate, D, IN_W}, pg8::EpiGate<1>{MERGED, TMP, Z + G_OFF + D, b_gate + D, D, IN_W}};
        pg8::gemm_phase<EpiGate2, TwoPassOrder, true, true>(lds, g, S, E);
    }
    SEAM(3);
    if (IN(4)) REP(4) {
        pg8::Gemm g{MERGED, WoT, M, D, D}; pg8::StaticOrder S; S.init(M, D, G, bx);
        pg8::EpiResBf16 E{H1B, D, x_in, ALPHA};
        pg8::gemm_phase<pg8::EpiResBf16, pg8::StaticOrder, true, true>(lds, g, S, E);
    }
    SEAM(4);
    if (IN(5)) REP(5) {
        PHASE_TID();
        const int gw = bx * NWAVES + wave, NGW = G * NWAVES;
        for (int m = gw; m < M; m += NGW) ln1_row(H1B + (size_t)m * D, XQ + (size_t)m * D, SX + m, ln1_g, ln1_b, lane);
    }
    SEAM(5);
    if (IN(6)) REP(6) {
        pg8::Gemm g{H1B, WfT, M, D, D}; pg8::StaticOrder S; S.init(M, D, G, bx);
#ifndef P6_I8
#define P6_I8 1
#endif
        if (G == 256 && P6_I8) { pg8::Gemm g8{(const bf16*)XQ, (const bf16*)WF8, M, D, D / 2}; EpiTopKI8 E{EX, GT, SX, SWF}; pg8::gemm_phase<EpiTopKI8, pg8::StaticOrder, false, true, true>(lds, g8, S, E); }
        else if (G == 256) { EpiTopK E{EX, GT}; pg8::gemm_phase<EpiTopK, pg8::StaticOrder, false, true>(lds, g, S, E); }
        else { pg8::EpiF32 E{SC, D, nullptr, 0.f}; pg8::gemm_phase<pg8::EpiF32, pg8::StaticOrder, true, true>(lds, g, S, E); }
    }
    if (G != 256) SEAM(6);
    if (IN(7)) REP(7) {
        PHASE_TID();
        if (G != 256) for (int p = bx; p < (M * PH) / 128; p += G) topk_pass(p, SC, EX, GT, lds, tid);
    }
    SEAM(7);
    if (IN(8)) REP(8) {
        PHASE_TID();
        const int xcc = (int)(xb_xcc_id() & 7u);
#pragma unroll 1
#ifndef SCRAMBLE
#define SCRAMBLE 0
#endif
        for (int sl = 0; sl < 8; ++sl) { const int s = (xcc + sl + (SCRAMBLE ? wave : 0)) & 7;
            for (;;) { const int tg = q_pull((unsigned*)(ctl + CW_Q + 64 * (s + 16 * rep_)), lane); if (tg >= PEER_NTASK) break;
                int t0, nt; peer_task_tokens(tg, t0, nt); peer_a_task(t0, nt, s, XQ, EX, U8, PA, lane); } }
    }
    SEAM(8);
    if (IN(9)) REP(9) {
        PHASE_TID();
        for (size_t i = (size_t)bx * NTHREADS + tid; i < (size_t)M * 128; i += (size_t)G * NTHREADS) peer_w_elem(i, EX, GT, SU, SV, SX, PA, WB);
    }
    SEAM(9);
    if (IN(10)) REP(10) {
        PHASE_TID();
        const int xcc = (int)(xb_xcc_id() & 7u);
#pragma unroll 1
#ifndef SCRAMBLE
#define SCRAMBLE 0
#endif
        for (int sl = 0; sl < 8; ++sl) { const int s = (xcc + sl + (SCRAMBLE ? wave : 0)) & 7;
            for (;;) { const int tg = q_pull((unsigned*)(ctl + CW_Q + 64 * (8 + s + 16 * rep_)), lane); if (tg >= PEER_NTASK) break;
                int t0, nt; peer_task_tokens(tg, t0, nt); peer_b_task(t0, nt, s, H1B, EX, WB, V8, R2B, ST, lane); } }
    }
    SEAM(10);
    if (IN(11)) REP(11) {
        PHASE_TID();
        const int gw = bx * NWAVES + wave, NGW = G * NWAVES;
        for (int t = gw; t < M; t += NGW) peer_c_row(t, R2B, args.out, ST, ln2_g, ln2_b, lane);
    }
#undef IN
#undef SEAM
}

extern "C" void kernel_launch(void* const* d_in, const int* in_sizes, int n_in, void* d_out, int out_size, void* d_ws, size_t ws_size, hipStream_t stream) {
    static int grid = 0;
    if (grid == 0) {
        if (n_in != 16 || out_size != M * D || ws_size < WS_END) { fprintf(stderr, "kernel_launch: unexpected shapes (n_in %d out %d ws %zu)\n", n_in, out_size, ws_size); grid = -1; return; }
        int dev = 0, cus = 0, per_cu = 0;
        if (hipGetDevice(&dev) != hipSuccess || hipDeviceGetAttribute(&cus, hipDeviceAttributeMultiprocessorCount, dev) != hipSuccess) { grid = -1; return; }
        if (hipFuncSetAttribute((const void*)mk_fwd, hipFuncAttributeMaxDynamicSharedMemorySize, LDS_BYTES) != hipSuccess) { fprintf(stderr, "kernel_launch: hipFuncSetAttribute failed\n"); grid = -1; return; }
        if (hipOccupancyMaxActiveBlocksPerMultiprocessor(&per_cu, (const void*)mk_fwd, NTHREADS, LDS_BYTES) != hipSuccess || per_cu < 1) { fprintf(stderr, "kernel_launch: occupancy query says %d\n", per_cu); per_cu = 1; }
        (void)hipGetLastError();
        if (per_cu > 1) per_cu = 1;
        grid = cus * per_cu;
    }
    if (grid < 0) return;
    if (hipMemsetAsync((char*)d_ws + WS_CTL, 0, CTL_ZERO_BYTES, stream) != hipSuccess) { fprintf(stderr, "kernel_launch: memset failed\n"); return; }
    Args a{};
    for (int i = 0; i < 16; ++i) a.in[i] = (const float*)d_in[i];
    a.out = (float*)d_out; a.ws = (unsigned char*)d_ws;
#if MK_PER_PHASE
    for (int p = 0; p < N_PHASES; ++p) { a.ph_lo = p; a.ph_hi = p + 1; hipLaunchKernelGGL(mk_fwd, dim3(grid), dim3(NTHREADS), LDS_BYTES, stream, a); }
#else
    a.ph_lo = 0; a.ph_hi = N_PHASES;
    void* kargs[] = {&a};
#ifdef PLAIN_LAUNCH
    (void)kargs; hipLaunchKernelGGL(mk_fwd, dim3(grid), dim3(NTHREADS), LDS_BYTES, stream, a); hipError_t e = hipPeekAtLastError();
#else
    hipError_t e = hipLaunchCooperativeKernel((const void*)mk_fwd, dim3(grid), dim3(NTHREADS), kargs, LDS_BYTES, stream);
#endif
    if (e != hipSuccess) fprintf(stderr, "kernel_launch: cooperative launch failed: %s (grid %d)\n", hipGetErrorString(e), grid);
#endif
}
```

```cpp
#include <hip/hip_runtime.h>
#include <cstdio>
#include <cstdint>
#include <type_traits>
namespace pg8 {
#define PG8_LAS __attribute__((address_space(3)))
typedef unsigned short bf16_t;
typedef short bf16x8 __attribute__((ext_vector_type(8)));
typedef float f32x4 __attribute__((ext_vector_type(4)));
typedef unsigned u32x4 __attribute__((ext_vector_type(4)));
constexpr int BM = 256, BK = 64, HALF = 128, HTB = HALF * BK * 2  , STAGE_BYTES = 8 * HTB, NXCD = 8, WGM = 8;

__host__ __device__ __forceinline__ int lds_byte(int r, int c) { const int st = (r >> 4) * 2 + (c >> 5), rr = r & 15, cc = c & 31, ob = rr * 64 + cc * 2; return st * 1024 + (ob ^ (((ob >> 9) & 1) << 5)); }
__host__ __device__ __forceinline__ void stage_rc(int b, int& R, int& C) { const int st = b / 1024, sb = b % 1024, swz = sb ^ (((sb >> 9) & 1) << 5); R = (st >> 1) * 16 + swz / 64; C = (st & 1) * 32 + (swz % 64) / 2; }
__host__ __device__ __forceinline__ int perm32(int rho) { const int n = rho >> 4, i = rho & 15; return 8 * (i >> 2) + 4 * n + (i & 3); }

struct Unit { int pm, pn, w; };
struct Gemm { const bf16_t* A; const bf16_t* Bt; int M, N, K; const bf16_t* A2 = nullptr; const bf16_t* Bt2 = nullptr; };

struct StaticOrder {
    int nM, nN, nwg, G, c;
    __host__ __device__ void init(int M, int N, int G_, int c_) { nM = M / BM; nN = N / BM; nwg = nM * nN; G = G_; c = c_; }
    __host__ __device__ bool next(int i, Unit& u) const {
        const long L = (long)i * G + c; if (L >= nwg) return false;
        int wgid = (int)L; { const int q = nwg / NXCD, r = nwg % NXCD, xcd = wgid % NXCD, off = wgid / NXCD; wgid = (xcd < r ? xcd * (q + 1) : r * (q + 1) + (xcd - r) * q) + off; }
        const int nig = WGM * nN, gid = wgid / nig, fm = gid * WGM, gsz = (nM - fm) < WGM ? (nM - fm) : WGM;
        u.pm = fm + ((wgid % nig) % gsz); u.pn = (wgid % nig) / gsz; u.w = 0; return true;
    }
    __device__ __forceinline__ void a_ready(const Unit&) const {}
    __device__ __forceinline__ void done(const Unit&) const {}
};


__device__ __forceinline__ unsigned cvt_pk_bf16(float lo, float hi) { unsigned r; asm volatile("v_cvt_pk_bf16_f32 %0, %1, %2" : "=v"(r) : "v"(lo), "v"(hi)); return r; }
__device__ __forceinline__ float bf_lo(unsigned w) { return __builtin_bit_cast(float, w << 16); }
__device__ __forceinline__ float bf_hi(unsigned w) { return __builtin_bit_cast(float, w & 0xffff0000u); }
__device__ __forceinline__ float sigmoidf_(float x) { return __builtin_amdgcn_rcpf(1.0f + __expf(-x)); }

struct EpiBf16 {
    static constexpr bool PERM = true, AFTER_DRAIN = false;
    bf16_t* O; int ldc;
    __device__ __forceinline__ void operator()(const f32x4 (&acc)[2][2][4][2], const Unit& u, int wr, int wc, int fr, int fq) const {
        const int row0 = u.pm * BM + wr * 64 + fr, col0 = u.pn * BM + wc * 32 + 8 * fq;
#pragma unroll
        for (int ai = 0; ai < 2; ++ai)
#pragma unroll
            for (int m = 0; m < 4; ++m) { bf16_t* rowp = O + (size_t)(row0 + ai * HALF + m * 16) * ldc + col0;
#pragma unroll
                for (int bj = 0; bj < 2; ++bj) { const f32x4 v0 = acc[ai][bj][m][0], v1 = acc[ai][bj][m][1];
                    u32x4 w; w.x = cvt_pk_bf16(v0[0], v0[1]); w.y = cvt_pk_bf16(v0[2], v0[3]); w.z = cvt_pk_bf16(v1[0], v1[1]); w.w = cvt_pk_bf16(v1[2], v1[3]);
                    *(u32x4*)(rowp + bj * HALF) = w; } }
    }
};
template <int SECOND> struct EpiGate {
    static constexpr bool PERM = true, AFTER_DRAIN = false;
    bf16_t* O; const bf16_t* T; const bf16_t* Zg; const float* bg; int ldc, ldz;
    __device__ __forceinline__ void operator()(const f32x4 (&acc)[2][2][4][2], const Unit& u, int wr, int wc, int fr, int fq) const {
        const int row0 = u.pm * BM + wr * 64 + fr, col0 = u.pn * BM + wc * 32 + 8 * fq;
        f32x4 bv[2][2];
#pragma unroll
        for (int bj = 0; bj < 2; ++bj)
#pragma unroll
            for (int n = 0; n < 2; ++n) bv[bj][n] = *(const f32x4*)(bg + col0 + bj * HALF + 4 * n);
#pragma unroll
        for (int ai = 0; ai < 2; ++ai)
#pragma unroll
            for (int m = 0; m < 4; ++m) { const size_t row = (size_t)(row0 + ai * HALF + m * 16);
#pragma unroll
                for (int bj = 0; bj < 2; ++bj) { const int c = col0 + bj * HALF;
                    const u32x4 zg = *(const u32x4*)(Zg + row * ldz + c);
                    f32x4 v0 = acc[ai][bj][m][0], v1 = acc[ai][bj][m][1];
                    v0[0] *= sigmoidf_(bf_lo(zg.x) + bv[bj][0][0]); v0[1] *= sigmoidf_(bf_hi(zg.x) + bv[bj][0][1]);
                    v0[2] *= sigmoidf_(bf_lo(zg.y) + bv[bj][0][2]); v0[3] *= sigmoidf_(bf_hi(zg.y) + bv[bj][0][3]);
                    v1[0] *= sigmoidf_(bf_lo(zg.z) + bv[bj][1][0]); v1[1] *= sigmoidf_(bf_hi(zg.z) + bv[bj][1][1]);
                    v1[2] *= sigmoidf_(bf_lo(zg.w) + bv[bj][1][2]); v1[3] *= sigmoidf_(bf_hi(zg.w) + bv[bj][1][3]);
                    if (SECOND) { const u32x4 t = *(const u32x4*)(T + row * ldc + c);
                        v0[0] += bf_lo(t.x); v0[1] += bf_hi(t.x); v0[2] += bf_lo(t.y); v0[3] += bf_hi(t.y);
                        v1[0] += bf_lo(t.z); v1[1] += bf_hi(t.z); v1[2] += bf_lo(t.w); v1[3] += bf_hi(t.w); }
                    u32x4 w; w.x = cvt_pk_bf16(v0[0], v0[1]); w.y = cvt_pk_bf16(v0[2], v0[3]); w.z = cvt_pk_bf16(v1[0], v1[1]); w.w = cvt_pk_bf16(v1[2], v1[3]);
                    *(u32x4*)(O + row * ldc + c) = w; } }
    }
};
struct EpiF32 {
    static constexpr bool PERM = false, AFTER_DRAIN = false;
    float* C; int ldc; const float* R; float scale;
    __device__ __forceinline__ void operator()(const f32x4 (&acc)[2][2][4][2], const Unit& u, int wr, int wc, int fr, int fq) const {
        const int row0 = u.pm * BM + wr * 64 + fr, col0 = u.pn * BM + wc * 32 + 4 * fq;
#pragma unroll
        for (int ai = 0; ai < 2; ++ai)
#pragma unroll
            for (int m = 0; m < 4; ++m) { const size_t off = (size_t)(row0 + ai * HALF + m * 16) * ldc + col0;
#pragma unroll
                for (int bj = 0; bj < 2; ++bj)
#pragma unroll
                    for (int n = 0; n < 2; ++n) { f32x4 v = acc[ai][bj][m][n];
                        if (R) v += *(const f32x4*)(R + off + bj * HALF + n * 16) * scale;
                        *(f32x4*)(C + off + bj * HALF + n * 16) = v; } }
    }
};
struct EpiResBf16 {
    static constexpr bool PERM = true, AFTER_DRAIN = false;
    bf16_t* O; int ldc; const float* R; float scale;
    __device__ __forceinline__ void operator()(const f32x4 (&acc)[2][2][4][2], const Unit& u, int wr, int wc, int fr, int fq) const {
        const int row0 = u.pm * BM + wr * 64 + fr, col0 = u.pn * BM + wc * 32 + 8 * fq;
#pragma unroll
        for (int ai = 0; ai < 2; ++ai)
#pragma unroll
            for (int m = 0; m < 4; ++m) { const size_t off = (size_t)(row0 + ai * HALF + m * 16) * ldc + col0;
#pragma unroll
                for (int bj = 0; bj < 2; ++bj) { const f32x4 r0 = *(const f32x4*)(R + off + bj * HALF), r1 = *(const f32x4*)(R + off + bj * HALF + 4);
                    const f32x4 v0 = acc[ai][bj][m][0] + r0 * scale, v1 = acc[ai][bj][m][1] + r1 * scale;
                    u32x4 w; w.x = cvt_pk_bf16(v0[0], v0[1]); w.y = cvt_pk_bf16(v0[2], v0[3]); w.z = cvt_pk_bf16(v1[0], v1[1]); w.w = cvt_pk_bf16(v1[2], v1[3]);
                    *(u32x4*)(O + off + bj * HALF) = w; } }
    }
};
typedef int i32x4e __attribute__((ext_vector_type(4)));
struct EpiI8Bf16 {
    static constexpr bool PERM = true, AFTER_DRAIN = false;
    bf16_t* O; int ldc; const float* sa; const float* sb;
    __device__ __forceinline__ void operator()(const i32x4e (&acc)[2][2][4][2], const Unit& u, int wr, int wc, int fr, int fq) const {
        const int row0 = u.pm * BM + wr * 64 + fr, col0 = u.pn * BM + wc * 32 + 8 * fq;
        f32x4 sbv[2][2];
#pragma unroll
        for (int bj = 0; bj < 2; ++bj)
#pragma unroll
            for (int n = 0; n < 2; ++n) sbv[bj][n] = *(const f32x4*)(sb + col0 + bj * HALF + 4 * n);
#pragma unroll
        for (int ai = 0; ai < 2; ++ai)
#pragma unroll
            for (int m = 0; m < 4; ++m) { const int row = row0 + ai * HALF + m * 16; const float sr = sa[row]; bf16_t* rowp = O + (size_t)row * ldc + col0;
#pragma unroll
                for (int bj = 0; bj < 2; ++bj) { const i32x4e a0 = acc[ai][bj][m][0], a1 = acc[ai][bj][m][1];
                    const f32x4 v0 = (f32x4){(float)a0[0], (float)a0[1], (float)a0[2], (float)a0[3]} * sbv[bj][0] * sr, v1 = (f32x4){(float)a1[0], (float)a1[1], (float)a1[2], (float)a1[3]} * sbv[bj][1] * sr;
                    u32x4 w; w.x = cvt_pk_bf16(v0[0], v0[1]); w.y = cvt_pk_bf16(v0[2], v0[3]); w.z = cvt_pk_bf16(v1[0], v1[1]); w.w = cvt_pk_bf16(v1[2], v1[3]);
                    *(u32x4*)(rowp + bj * HALF) = w; } }
    }
};
template <int SECOND> struct EpiGateI8 {
    static constexpr bool PERM = true, AFTER_DRAIN = false;
    bf16_t* O; const bf16_t* T; const bf16_t* Zg; const float* bg; int ldc, ldz; const float* sa; const float* sb;
    __device__ __forceinline__ void operator()(const i32x4e (&acc)[2][2][4][2], const Unit& u, int wr, int wc, int fr, int fq) const {
        const int row0 = u.pm * BM + wr * 64 + fr, col0 = u.pn * BM + wc * 32 + 8 * fq;
        f32x4 bv[2][2], sbv[2][2];
#pragma unroll
        for (int bj = 0; bj < 2; ++bj)
#pragma unroll
            for (int n = 0; n < 2; ++n) { bv[bj][n] = *(const f32x4*)(bg + col0 + bj * HALF + 4 * n); sbv[bj][n] = *(const f32x4*)(sb + col0 + bj * HALF + 4 * n); }
#pragma unroll
        for (int ai = 0; ai < 2; ++ai)
#pragma unroll
            for (int m = 0; m < 4; ++m) { const size_t row = (size_t)(row0 + ai * HALF + m * 16); const float sr = sa[row];
#pragma unroll
                for (int bj = 0; bj < 2; ++bj) { const int c = col0 + bj * HALF;
                    const u32x4 zg = *(const u32x4*)(Zg + row * ldz + c);
                    const i32x4e a0 = acc[ai][bj][m][0], a1 = acc[ai][bj][m][1];
                    f32x4 v0 = (f32x4){(float)a0[0], (float)a0[1], (float)a0[2], (float)a0[3]} * sbv[bj][0] * sr, v1 = (f32x4){(float)a1[0], (float)a1[1], (float)a1[2], (float)a1[3]} * sbv[bj][1] * sr;
                    v0[0] *= sigmoidf_(bf_lo(zg.x) + bv[bj][0][0]); v0[1] *= sigmoidf_(bf_hi(zg.x) + bv[bj][0][1]);
                    v0[2] *= sigmoidf_(bf_lo(zg.y) + bv[bj][0][2]); v0[3] *= sigmoidf_(bf_hi(zg.y) + bv[bj][0][3]);
                    v1[0] *= sigmoidf_(bf_lo(zg.z) + bv[bj][1][0]); v1[1] *= sigmoidf_(bf_hi(zg.z) + bv[bj][1][1]);
                    v1[2] *= sigmoidf_(bf_lo(zg.w) + bv[bj][1][2]); v1[3] *= sigmoidf_(bf_hi(zg.w) + bv[bj][1][3]);
                    if (SECOND) { const u32x4 t = *(const u32x4*)(T + row * ldc + c);
                        v0[0] += bf_lo(t.x); v0[1] += bf_hi(t.x); v0[2] += bf_lo(t.y); v0[3] += bf_hi(t.y);
                        v1[0] += bf_lo(t.z); v1[1] += bf_hi(t.z); v1[2] += bf_lo(t.w); v1[3] += bf_hi(t.w); }
                    u32x4 w; w.x = cvt_pk_bf16(v0[0], v0[1]); w.y = cvt_pk_bf16(v0[2], v0[3]); w.z = cvt_pk_bf16(v1[0], v1[1]); w.w = cvt_pk_bf16(v1[2], v1[3]);
                    *(u32x4*)(O + row * ldc + c) = w; } }
    }
};

typedef int i32x4 __attribute__((ext_vector_type(4)));
template <class E, class = void> struct epi_chains : std::false_type {};
template <class E> struct epi_chains<E, std::void_t<decltype(E::CHAIN)>> : std::true_type {};
template <class Epi, class Sched, bool ALIGN_EPI = false, bool SP2 = false, bool I8 = false>
__device__ __forceinline__ void gemm_phase(PG8_LAS unsigned char* lds, const Gemm g, const Sched& S, const Epi& E) {
    int tid_ = threadIdx.x; asm volatile("" : "+v"(tid_));
    const int tid = tid_, wid = __builtin_amdgcn_readfirstlane(tid >> 6), lane = tid & 63, wr = wid >> 2, wc = wid & 3, fr = lane & 15, fq = lane >> 4;
    const int K = g.K, nt = K / BK;
    unsigned voffA[2], voffB[2];
#pragma unroll
    for (int i = 0; i < 2; ++i) { int R, C; stage_rc(tid * 16 + i * 8192, R, C); const int Rb = Epi::PERM ? ((R & ~31) + perm32(R & 31)) : R;
        voffA[i] = (unsigned)(R * K + C) * 2u; voffB[i] = (unsigned)(Rb * K + C) * 2u; }
    const size_t kstep = (size_t)(BK * 2);
    const size_t hstep = (size_t)HALF * K * 2;
    const size_t tstep = 2 * hstep;
    const unsigned ldsw = (unsigned)wid * 1024u;
    const int aoff = lds_byte(wr * 64 + fr, fq * 8), boff = lds_byte(wc * 32 + fr, fq * 8);
#define PG8_SA(b, h) (((b) * 2 + (h)) * HTB)
#define PG8_SB(b, h) ((4 + (b) * 2 + (h)) * HTB)
#define PG8_STAGE(bufoff, gbase, voff) do { _Pragma("unroll") for (int _i = 0; _i < 2; ++_i) \
        __builtin_amdgcn_global_load_lds((const unsigned*)((const char*)(gbase) + (voff)[_i]), (PG8_LAS unsigned*)(lds + (bufoff) + ldsw + _i * 8192), 16, 0, 0); } while (0)
#define PG8_LDA(dst, b, h) do { _Pragma("unroll") for (int m = 0; m < 4; ++m) _Pragma("unroll") for (int k = 0; k < 2; ++k) dst[m][k] = *(const PG8_LAS bf16x8*)(lds + PG8_SA(b, h) + aoff + m * 2048 + k * 1024); } while (0)
#define PG8_LDB(dst, b, h) do { _Pragma("unroll") for (int n = 0; n < 2; ++n) _Pragma("unroll") for (int k = 0; k < 2; ++k) dst[n][k] = *(const PG8_LAS bf16x8*)(lds + PG8_SB(b, h) + boff + n * 2048 + k * 1024); } while (0)
#define PG8_MMA(ai, bj, At, Bt) do { __builtin_amdgcn_s_setprio(1); _Pragma("unroll") for (int m = 0; m < 4; ++m) _Pragma("unroll") for (int n = 0; n < 2; ++n) _Pragma("unroll") for (int k = 0; k < 2; ++k) \
        { if constexpr (I8) acc[ai][bj][m][n] = __builtin_bit_cast(acc_t, __builtin_amdgcn_mfma_i32_16x16x64_i8(__builtin_bit_cast(i32x4, Bt[n][k]), __builtin_bit_cast(i32x4, At[m][k]), __builtin_bit_cast(i32x4, acc[ai][bj][m][n]), 0, 0, 0)); \
          else acc[ai][bj][m][n] = __builtin_bit_cast(acc_t, __builtin_amdgcn_mfma_f32_16x16x32_bf16(Bt[n][k], At[m][k], __builtin_bit_cast(f32x4, acc[ai][bj][m][n]), 0, 0, 0)); } __builtin_amdgcn_s_setprio(0); } while (0)
#define PG8_WAIT_V(n) asm volatile("s_waitcnt vmcnt(" #n ")" ::: "memory")
#define PG8_WAIT_L(n) asm volatile("s_waitcnt lgkmcnt(" #n ")" ::: "memory")
#define PG8_BAR __builtin_amdgcn_s_barrier()
#define PG8_SCHED __builtin_amdgcn_sched_barrier(0)
    Unit cur, nxt; int ui = 0;
    if (!S.next(0, cur)) return;
    typedef typename std::conditional<I8, i32x4, f32x4>::type acc_t;
    acc_t acc[2][2][4][2];
#pragma unroll
    for (int a = 0; a < 2; ++a)
#pragma unroll
        for (int b = 0; b < 2; ++b)
#pragma unroll
            for (int m = 0; m < 4; ++m)
#pragma unroll
                for (int n = 0; n < 2; ++n) acc[a][b][m][n] = acc_t{};
    bf16x8 At[4][2], B0[2][2], B1[2][2];
    const char* cA = (const char*)(cur.w ? g.A2 : g.A) + (size_t)cur.pm * tstep; const char* cB = (const char*)(cur.w ? g.Bt2 : g.Bt) + (size_t)cur.pn * tstep;
    S.a_ready(cur);
    if constexpr (SP2) {
        PG8_STAGE(PG8_SB(0, 0), cB, voffB); PG8_STAGE(PG8_SB(0, 1), cB + hstep, voffB); PG8_STAGE(PG8_SA(0, 0), cA, voffA); PG8_STAGE(PG8_SA(0, 1), cA + hstep, voffA);
        if (wr == 1) PG8_BAR;
        PG8_WAIT_V(2); PG8_BAR;
        PG8_STAGE(PG8_SB(1, 0), cB + kstep, voffB); PG8_STAGE(PG8_SA(1, 0), cA + kstep, voffA); PG8_STAGE(PG8_SB(1, 1), cB + hstep + kstep, voffB);
        PG8_WAIT_V(6); PG8_BAR;
    } else {
        PG8_STAGE(PG8_SB(0, 0), cB, voffB); PG8_STAGE(PG8_SA(0, 0), cA, voffA); PG8_STAGE(PG8_SB(0, 1), cB + hstep, voffB); PG8_STAGE(PG8_SA(0, 1), cA + hstep, voffA);
        if (wr == 1) PG8_BAR;
        PG8_WAIT_V(4); PG8_BAR;
        PG8_STAGE(PG8_SB(1, 0), cB + kstep, voffB); PG8_STAGE(PG8_SA(1, 0), cA + kstep, voffA); PG8_STAGE(PG8_SB(1, 1), cB + hstep + kstep, voffB);
        PG8_WAIT_V(6); PG8_BAR;
    }
    for (;;) {
        const bool has_next = S.next(ui + 1, nxt);
        const char* nA = has_next ? (const char*)(nxt.w ? g.A2 : g.A) + (size_t)nxt.pm * tstep : cA; const char* nB = has_next ? (const char*)(nxt.w ? g.Bt2 : g.Bt) + (size_t)nxt.pn * tstep : cB;
        for (int t = 0; t < nt; t += 2) {
            const bool last = (t == nt - 2);
            const char* a1 = cA + (size_t)(t + 1) * kstep;
            const char* a2 = last ? nA : cA + (size_t)(t + 2) * kstep; const char* b2 = last ? nB : cB + (size_t)(t + 2) * kstep;
            const char* a3 = a2 + kstep; const char* b3 = b2 + kstep;
            if (last && has_next) S.a_ready(nxt);
            if constexpr (SP2) {
            PG8_LDB(B0, 0, 0); PG8_LDB(B1, 0, 1); PG8_SCHED; PG8_LDA(At, 0, 0); PG8_STAGE(PG8_SA(1, 1), a1 + hstep, voffA);
            PG8_WAIT_V(8); PG8_WAIT_L(0); PG8_BAR; PG8_MMA(0, 0, At, B0); PG8_MMA(0, 1, At, B1); PG8_BAR; PG8_SCHED;
            PG8_LDA(At, 0, 1); PG8_STAGE(PG8_SB(0, 0), b2, voffB); PG8_STAGE(PG8_SB(0, 1), b2 + hstep, voffB); PG8_STAGE(PG8_SA(0, 0), a2, voffA);
            PG8_WAIT_V(8); PG8_WAIT_L(0); PG8_BAR; PG8_MMA(1, 0, At, B0); PG8_MMA(1, 1, At, B1); PG8_BAR; PG8_SCHED;
            PG8_LDB(B0, 1, 0); PG8_LDB(B1, 1, 1); PG8_SCHED; PG8_LDA(At, 1, 0); PG8_STAGE(PG8_SA(0, 1), a2 + hstep, voffA);
            PG8_WAIT_V(8); PG8_WAIT_L(0); PG8_BAR; PG8_MMA(0, 0, At, B0); PG8_MMA(0, 1, At, B1); PG8_BAR; PG8_SCHED;
            PG8_LDA(At, 1, 1); PG8_STAGE(PG8_SB(1, 0), b3, voffB); PG8_STAGE(PG8_SB(1, 1), b3 + hstep, voffB); PG8_STAGE(PG8_SA(1, 0), a3, voffA);
            PG8_WAIT_V(8); PG8_WAIT_L(0); PG8_BAR; PG8_MMA(1, 0, At, B0); PG8_MMA(1, 1, At, B1); PG8_BAR; PG8_SCHED;
            } else {
            PG8_LDB(B0, 0, 0); PG8_SCHED; PG8_LDA(At, 0, 0); PG8_STAGE(PG8_SA(1, 1), a1 + hstep, voffA);
            PG8_WAIT_L(8); PG8_BAR; PG8_WAIT_L(0); PG8_MMA(0, 0, At, B0); PG8_BAR; PG8_SCHED;
            PG8_LDB(B1, 0, 1); PG8_STAGE(PG8_SB(0, 0), b2, voffB);
            PG8_BAR; PG8_WAIT_L(0); PG8_MMA(0, 1, At, B1); PG8_BAR;
            PG8_LDA(At, 0, 1); PG8_STAGE(PG8_SA(0, 0), a2, voffA);
            PG8_BAR; PG8_WAIT_L(0); PG8_MMA(1, 0, At, B0); PG8_BAR; PG8_SCHED;
            PG8_STAGE(PG8_SB(0, 1), b2 + hstep, voffB);
            PG8_WAIT_V(6); PG8_BAR; PG8_MMA(1, 1, At, B1); PG8_BAR;
            PG8_LDB(B0, 1, 0); PG8_SCHED; PG8_LDA(At, 1, 0); PG8_STAGE(PG8_SA(0, 1), a2 + hstep, voffA);
            PG8_WAIT_L(8); PG8_BAR; PG8_WAIT_L(0); PG8_MMA(0, 0, At, B0); PG8_BAR; PG8_SCHED;
            PG8_LDB(B1, 1, 1); PG8_STAGE(PG8_SB(1, 0), b3, voffB);
            PG8_BAR; PG8_WAIT_L(0); PG8_MMA(0, 1, At, B1); PG8_BAR;
            PG8_LDA(At, 1, 1); PG8_STAGE(PG8_SA(1, 0), a3, voffA);
            PG8_BAR; PG8_WAIT_L(0); PG8_MMA(1, 0, At, B0); PG8_BAR; PG8_SCHED;
            PG8_STAGE(PG8_SB(1, 1), b3 + hstep, voffB);
            PG8_WAIT_V(6); PG8_BAR; PG8_MMA(1, 1, At, B1); PG8_BAR;
            }
        }
        if constexpr (ALIGN_EPI) { if (wr == 0) PG8_BAR; }
        bool keep_acc = false;
        if constexpr (!Epi::AFTER_DRAIN) { if constexpr (epi_chains<Epi>::value) keep_acc = E.chain(acc, cur, wr, wc, fr, fq); else E(acc, cur, wr, wc, fr, fq); S.done(cur); }
        if (!has_next) break;
        if (!keep_acc) {
#pragma unroll
        for (int a = 0; a < 2; ++a)
#pragma unroll
            for (int b = 0; b < 2; ++b)
#pragma unroll
                for (int m = 0; m < 4; ++m)
#pragma unroll
                    for (int n = 0; n < 2; ++n) acc[a][b][m][n] = acc_t{};
        }
        cur = nxt; cA = nA; cB = nB; ++ui;
        if constexpr (ALIGN_EPI) { if (wr == 1) PG8_BAR; }
    }
    PG8_WAIT_V(0);
    if constexpr (!ALIGN_EPI) { if (wr == 0) PG8_BAR; }
    PG8_BAR;
    if constexpr (Epi::AFTER_DRAIN) { E.fused(acc, cur, wr, wc, fr, fq, lds, wid, lane); S.done(cur); }
#undef PG8_SA
#undef PG8_SB
#undef PG8_STAGE
#undef PG8_LDA
#undef PG8_LDB
#undef PG8_MMA
#undef PG8_WAIT_V
#undef PG8_WAIT_L
#undef PG8_BAR
#undef PG8_SCHED
}
}
#define GAS __attribute__((address_space(1)))
#define LAS __attribute__((address_space(3)))
typedef unsigned short bf16;
typedef unsigned v4u __attribute__((ext_vector_type(4)));
typedef float f32x4 __attribute__((ext_vector_type(4)));
typedef short bf16x8 __attribute__((ext_vector_type(8)));
typedef GAS unsigned gu32;
typedef GAS unsigned long long gu64;
#define RLX_AGENT __ATOMIC_RELAXED, __HIP_MEMORY_SCOPE_AGENT
#define LDS_WAIT() asm volatile("s_waitcnt lgkmcnt(0)" ::: "memory")
#define VM_WAIT() asm volatile("s_waitcnt vmcnt(0)" ::: "memory")
__device__ __forceinline__ unsigned long long rt() { return __builtin_amdgcn_s_memrealtime(); }
__device__ __forceinline__ unsigned f2bf(float f) { unsigned u = __builtin_bit_cast(unsigned, f); return (u + 0x7fffu + ((u >> 16) & 1u)) >> 16; }
__device__ __forceinline__ unsigned pk2(float lo, float hi) { return f2bf(lo) | (f2bf(hi) << 16); }

#define XB_TMO      128
#define XB_XCNT(j)  (256  + 64 * (j))
#define XB_XSUB(j)  (1280 + 64 * (j))
#define XB_XGEN(j)  (2304 + 64 * (j))
#define XB_TOP      3328
#define XB_TOPGEN   3392
#define XCD_BAR_WORDS 3456
#define XB_SPIN_CAP (1u << 18)

__device__ __forceinline__ unsigned xb_ld(unsigned* p)              { return __hip_atomic_load(p, __ATOMIC_RELAXED, __HIP_MEMORY_SCOPE_AGENT); }
__device__ __forceinline__ unsigned xb_add(unsigned* p, unsigned v) { return __hip_atomic_fetch_add(p, v, __ATOMIC_RELAXED, __HIP_MEMORY_SCOPE_AGENT); }
__device__ __forceinline__ unsigned xb_xcc_id() { return (unsigned)__builtin_amdgcn_s_getreg((3 << 11) | 20) & 0xFu; }
#define XB_SPIN(cond, bar) do { unsigned _sp = 0; while (cond) { __builtin_amdgcn_s_sleep(1); \
    if ((++_sp & 255u) == 0u) { if (xb_ld(&(bar)[XB_TMO])) break; if (_sp > XB_SPIN_CAP) { atomicAdd(&(bar)[XB_TMO], 1u); break; } } } } while (0)

struct XcdBarrier {
    unsigned* bar; unsigned x;
    volatile LAS unsigned* st;
};

__device__ __forceinline__ XcdBarrier xcd_barrier_post(unsigned* bar, volatile LAS unsigned* st) {
    XcdBarrier b; b.bar = bar; b.x = xb_xcc_id(); b.st = st;
    if (threadIdx.x == 0) (void)xb_add(&bar[XB_XCNT(b.x)], 1u);
    return b;
}
__device__ __forceinline__ void xcd_barrier_complete(unsigned* bar, unsigned x, unsigned& nloc, unsigned& nx) {
    const unsigned G = gridDim.x * gridDim.y * gridDim.z;
    unsigned sum, cnt, mine, sp = 0u;
    for (;;) {
        sum = 0u; cnt = 0u; mine = 0u;
#pragma unroll
        for (unsigned j = 0; j < 16; ++j) { const unsigned c = xb_ld(&bar[XB_XCNT(j)]); sum += c; cnt += (c > 0u) ? 1u : 0u; mine = (j == x) ? c : mine; }
        if (sum == G) break;
        __builtin_amdgcn_s_sleep(1);
        if ((++sp & 255u) == 0u) { if (xb_ld(&bar[XB_TMO])) break; if (sp > XB_SPIN_CAP) { atomicAdd(&bar[XB_TMO], 1u); break; } }
    }
    nloc = mine > 0u ? mine : 1u; nx = cnt > 0u ? cnt : 1u;
}

__device__ __forceinline__ void xcd_barrier(const XcdBarrier& b) {
    asm volatile("s_waitcnt vmcnt(0)" ::: "memory");
    __syncthreads();
    if (threadIdx.x == 0) {
        unsigned* bar = b.bar;
        __builtin_amdgcn_s_waitcnt(0);
        unsigned nloc = b.st[0], nx = b.st[1];
        if (nloc == 0u) { xcd_barrier_complete(bar, b.x, nloc, nx); b.st[0] = nloc; b.st[1] = nx; }
        const unsigned old = xb_add(&bar[XB_XSUB(b.x)], 1u);
        const unsigned gen = old / nloc;
        if (old + 1u == (gen + 1u) * nloc) {
            __builtin_amdgcn_fence(__ATOMIC_RELEASE, "agent");
            asm volatile("s_waitcnt vmcnt(0)" ::: "memory");
            const unsigned og = xb_add(&bar[XB_TOP], 1u);
            const unsigned tg = og / nx;
            if (og + 1u == (tg + 1u) * nx) xb_add(&bar[XB_TOPGEN], 1u);
            else XB_SPIN(xb_ld(&bar[XB_TOPGEN]) == tg, bar);
            __builtin_amdgcn_fence(__ATOMIC_ACQUIRE, "agent");
            xb_add(&bar[XB_XGEN(b.x)], 1u);
            asm volatile("s_waitcnt vmcnt(0)" ::: "memory");
        } else {
            XB_SPIN(xb_ld(&bar[XB_XGEN(b.x)]) == gen, bar);
            __builtin_amdgcn_fence(__ATOMIC_ACQUIRE, "agent");
            asm volatile("s_waitcnt vmcnt(0)" ::: "memory");
        }
    }
    __syncthreads();
}

constexpr int NWAVES = 8, NTHREADS = 512;
constexpr int BATCH = 4, SEQ = 2048, D = 2048, M = BATCH * SEQ;
constexpr int NQH = 32, NKVH = 4, HD = 64, QPKV = 8, WINDOW = 128;
constexpr int Q_OFF = 0, K_OFF = 2048, V_OFF = 2304, CB_OFF = 2560, CC_OFF = 4608, CH_OFF = 6656, G_OFF = 8704, IN_W = 12800;
constexpr int PH = 8, PNK = 128, PTOPK = 16, PNE = 16384;
constexpr float LN_EPS = 1e-5f;
constexpr float ALPHA = 1.189207115002721f;

#ifndef MK_PER_PHASE
#define MK_PER_PHASE 0
#endif
constexpr int N_PHASES = 12;

constexpr size_t MiB = 1u << 20;
constexpr size_t WS_CTL = 0, CTL_ZERO_BYTES = 1 * MiB;
constexpr size_t WS_WIN = 1 * MiB;
constexpr size_t WS_WA = 51 * MiB, WS_WC = 59 * MiB, WS_WO = 67 * MiB, WS_WF = 75 * MiB;
constexpr size_t WS_XB = 83 * MiB;
constexpr size_t WS_MERGED = WS_XB;
constexpr size_t WS_Z = 115 * MiB;
constexpr size_t WS_R2B = 115 * MiB;
constexpr size_t WS_H1B = 179 * MiB;
constexpr size_t WS_SC = 211 * MiB;
constexpr size_t WS_EX = 275 * MiB;
constexpr size_t WS_GT = 279 * MiB;
constexpr size_t WS_AO = 315 * MiB, WS_CI = 347 * MiB, WS_TMP = 379 * MiB;
constexpr size_t WS_U8 = 411 * MiB, WS_V8 = 443 * MiB;
constexpr size_t WS_SU = 475 * MiB, WS_SV = WS_SU + 65536;
constexpr size_t WS_PA = WS_SC;
constexpr size_t WS_XQ = 283 * MiB;
constexpr size_t WS_SX = 299 * MiB;
constexpr size_t WS_WB = 380 * MiB;
constexpr size_t WS_ST = 379 * MiB;
constexpr size_t WS_XA8 = WS_XB;
constexpr size_t WS_WIN8 = 476 * MiB;
constexpr size_t WS_SWIN = 501 * MiB, WS_SXA = WS_SWIN + 65536;
constexpr size_t WS_AO8 = 1 * MiB, WS_CI8 = 17 * MiB, WS_WA8 = 33 * MiB, WS_WC8 = 37 * MiB, WS_S3 = 41 * MiB;
constexpr size_t WS_WF8 = 502 * MiB;
constexpr size_t WS_SWF = WS_SXA + 65536;
constexpr size_t WS_END = 506 * MiB;
constexpr int CW_Q = 12288;
constexpr size_t SLICE_BYTES = (size_t)PNE * 256;
constexpr int CW_BAR = 4096;

constexpr int RING_BYTES = 131072;
constexpr int LDSCTL_OFF = 147456, MISC_OFF = LDSCTL_OFF + 320;
constexpr int LDS_BYTES = LDSCTL_OFF + 512;

typedef float f32x16 __attribute__((ext_vector_type(16)));
typedef unsigned v2u __attribute__((ext_vector_type(2)));
__device__ __forceinline__ float wave_sum(float v) {
#pragma unroll
    for (int o = 1; o < 64; o <<= 1) v += __shfl_xor(v, o);
    return v;
}
__device__ __forceinline__ float vmaxf(float a, float b) { float r; asm("v_max_f32_e32 %0, %1, %2" : "=v"(r) : "v"(a), "v"(b)); return r; }
__device__ __forceinline__ float vminf(float a, float b) { float r; asm("v_min_f32_e32 %0, %1, %2" : "=v"(r) : "v"(a), "v"(b)); return r; }

__device__ __forceinline__ void p0_transpose_item(const float* W, int K, int N, bf16* WT, LAS float* scr, int item, int lane) {
    const int nblk = N / 32, kb = item / nblk, nb = item % nblk, k0 = 64 * kb, n0 = 32 * nb;
#pragma unroll 8
    for (int i = 0; i < 32; ++i) { const int kk = 2 * i + (lane >> 5); scr[kk * 33 + (lane & 31)] = W[(size_t)(k0 + kk) * N + n0 + (lane & 31)]; }
    LDS_WAIT(); asm volatile("" ::: "memory");
    const int c = lane & 7;
#pragma unroll
    for (int j = 0; j < 4; ++j) { const int n = (lane >> 3) + 8 * j; const LAS float* s = scr + (8 * c) * 33 + n;
        v4u o; o.x = pk2(s[0 * 33], s[1 * 33]); o.y = pk2(s[2 * 33], s[3 * 33]); o.z = pk2(s[4 * 33], s[5 * 33]); o.w = pk2(s[6 * 33], s[7 * 33]);
        *(GAS v4u*)(WT + (size_t)(n0 + n) * K + k0 + 8 * c) = o; }
    LDS_WAIT(); asm volatile("" ::: "memory");
}
__device__ __forceinline__ void p0_wf_item(const float* wq, const float* sk, bf16* WfT, LAS unsigned char* lds, int item, int tid) {
    const int hp = item >> 5, dt = item & 31;
    LAS f32x4* SK4 = (LAS f32x4*)lds;
    LAS f32x4* WQ4 = SK4 + 128 * 33;
    const float* skp = sk + (size_t)hp * 128 * 128;
    for (int i = tid; i < 128 * 32; i += NTHREADS) { const int n = i >> 5, c4 = i & 31; SK4[n * 33 + c4] = *(const f32x4*)(skp + n * 128 + 4 * c4); }
    for (int i = tid; i < 64 * 32; i += NTHREADS) { const int r = i >> 5, c4 = i & 31; WQ4[r * 33 + c4] = *(const f32x4*)(wq + (size_t)(64 * dt + r) * 2048 + hp * 128 + 4 * c4); }
    __syncthreads();
    const int td = tid & 15, tn = tid >> 4;
    float acc[4][4];
#pragma unroll
    for (int i = 0; i < 4; ++i)
#pragma unroll
        for (int j = 0; j < 4; ++j) acc[i][j] = 0.f;
#pragma unroll 4
    for (int c4 = 0; c4 < 32; ++c4) {
        f32x4 a[4], b[4];
#pragma unroll
        for (int i = 0; i < 4; ++i) a[i] = SK4[(4 * tn + i) * 33 + c4];
#pragma unroll
        for (int j = 0; j < 4; ++j) b[j] = WQ4[(td + 16 * j) * 33 + c4];
#pragma unroll
        for (int i = 0; i < 4; ++i)
#pragma unroll
            for (int j = 0; j < 4; ++j) acc[i][j] += a[i].x * b[j].x + a[i].y * b[j].y + a[i].z * b[j].z + a[i].w * b[j].w;
    }
#pragma unroll
    for (int i = 0; i < 4; ++i)
#pragma unroll
        for (int j = 0; j < 4; ++j) WfT[(size_t)(hp * 128 + 4 * tn + i) * 2048 + 64 * dt + td + 16 * j] = (bf16)f2bf(acc[i][j]);
    __syncthreads();
}

__device__ __forceinline__ int perm16(int o) { return 8 * ((o >> 2) & 1) + 4 * (o >> 3) + (o & 3); }
__device__ __forceinline__ void attn_unit(int unit, const bf16* z, bf16* ao, const float* sinks, LAS unsigned char* lds, int tid) {
    const int lane = tid & 63, wid = __builtin_amdgcn_readfirstlane(tid >> 6), r32 = lane & 31, hi = lane >> 5;
    const int nb = unit & 15, kvh = (unit >> 4) & 3, b = unit >> 6;
    LAS bf16* Ks = (LAS bf16*)lds;
    LAS bf16* Vt = (LAS bf16*)(lds + 256 * 144);
    const size_t tok0 = (size_t)b * SEQ;
#pragma unroll
    for (int i = 0; i < 4; ++i) {
        const int ci = tid + NTHREADS * i, key = ci >> 3, dc = ci & 7;
        int kpos = 128 * (nb - 1) + key; if (kpos < 0) kpos = 0;
        const bf16* src = z + (tok0 + kpos) * IN_W + K_OFF + kvh * HD + dc * 8;
        const v4u kv = *(const GAS v4u*)src, vv = *(const GAS v4u*)(src + (V_OFF - K_OFF));
        *(LAS v4u*)(Ks + key * 72 + dc * 8) = kv;
        const int pos = (key & ~15) + perm16(key & 15);
        LAS bf16* vp = Vt + (dc * 8) * 264 + pos;
        vp[0 * 264] = (bf16)(vv.x & 0xffffu); vp[1 * 264] = (bf16)(vv.x >> 16); vp[2 * 264] = (bf16)(vv.y & 0xffffu); vp[3 * 264] = (bf16)(vv.y >> 16);
        vp[4 * 264] = (bf16)(vv.z & 0xffffu); vp[5 * 264] = (bf16)(vv.z >> 16); vp[6 * 264] = (bf16)(vv.w & 0xffffu); vp[7 * 264] = (bf16)(vv.w >> 16);
    }
    __syncthreads();
    const int hq = kvh * QPKV + wid;
    const float LOG2E = 1.4426950408889634f;
    const float sink2 = sinks[hq] * LOG2E, sc = 0.125f * LOG2E;
#pragma unroll 1
    for (int qg = 0; qg < 4; ++qg) {
        const size_t tok = tok0 + 128 * nb + 32 * qg + r32;
        bf16x8 qf[4];
#pragma unroll
        for (int ks = 0; ks < 4; ++ks) qf[ks] = *(const GAS bf16x8*)(z + tok * IN_W + Q_OFF + hq * HD + 16 * ks + 8 * hi);
        f32x16 s[5];
#pragma unroll
        for (int kt = 0; kt < 5; ++kt) {
            s[kt] = (f32x16){0.f, 0.f, 0.f, 0.f, 0.f, 0.f, 0.f, 0.f, 0.f, 0.f, 0.f, 0.f, 0.f, 0.f, 0.f, 0.f};
#pragma unroll
            for (int ks = 0; ks < 4; ++ks) {
                const bf16x8 kf = *(const LAS bf16x8*)(Ks + (32 * (qg + kt) + r32) * 72 + 16 * ks + 8 * hi);
                s[kt] = __builtin_amdgcn_mfma_f32_32x32x16_bf16(kf, qf[ks], s[kt], 0, 0, 0);
            }
        }
        float mx = sink2;
#pragma unroll
        for (int kt = 0; kt < 5; ++kt) {
            const bool tile_dead = (nb == 0) && (qg + kt < 4);
#pragma unroll
            for (int r = 0; r < 16; ++r) {
                const int krow = (r & 3) + 8 * (r >> 2) + 4 * hi;
                bool valid = !tile_dead;
                if (kt == 0) valid = valid && (krow > r32);
                if (kt == 4) valid = valid && (krow <= r32);
                const float v = valid ? s[kt][r] * sc : -INFINITY;
                s[kt][r] = v; mx = fmaxf(mx, v);
            }
        }
        mx = fmaxf(mx, __shfl_xor(mx, 32));
        float sum = 0.f;
#pragma unroll
        for (int kt = 0; kt < 5; ++kt)
#pragma unroll
            for (int r = 0; r < 16; ++r) { const float p = __builtin_amdgcn_exp2f(s[kt][r] - mx); s[kt][r] = p; sum += p; }
        sum += __shfl_xor(sum, 32);
        const float inv = 1.0f / (sum + __builtin_amdgcn_exp2f(sink2 - mx));
        f32x16 o[2];
        o[0] = (f32x16){0.f, 0.f, 0.f, 0.f, 0.f, 0.f, 0.f, 0.f, 0.f, 0.f, 0.f, 0.f, 0.f, 0.f, 0.f, 0.f}; o[1] = o[0];
#pragma unroll
        for (int kt = 0; kt < 5; ++kt)
#pragma unroll
            for (int s2 = 0; s2 < 2; ++s2) {
                v4u pw; pw.x = pg8::cvt_pk_bf16(s[kt][8 * s2 + 0], s[kt][8 * s2 + 1]); pw.y = pg8::cvt_pk_bf16(s[kt][8 * s2 + 2], s[kt][8 * s2 + 3]);
                pw.z = pg8::cvt_pk_bf16(s[kt][8 * s2 + 4], s[kt][8 * s2 + 5]); pw.w = pg8::cvt_pk_bf16(s[kt][8 * s2 + 6], s[kt][8 * s2 + 7]);
                const bf16x8 pa = __builtin_bit_cast(bf16x8, pw);
#pragma unroll
                for (int dt = 0; dt < 2; ++dt) {
                    const bf16x8 vf = *(const LAS bf16x8*)(Vt + (32 * dt + r32) * 264 + 32 * (qg + kt) + 16 * s2 + 8 * hi);
                    o[dt] = __builtin_amdgcn_mfma_f32_32x32x16_bf16(vf, pa, o[dt], 0, 0, 0);
                }
            }
        bf16* op = ao + tok * D + hq * HD;
#pragma unroll
        for (int dt = 0; dt < 2; ++dt)
#pragma unroll
            for (int g = 0; g < 4; ++g) {
                v2u w; w.x = pg8::cvt_pk_bf16(o[dt][4 * g + 0] * inv, o[dt][4 * g + 1] * inv); w.y = pg8::cvt_pk_bf16(o[dt][4 * g + 2] * inv, o[dt][4 * g + 3] * inv);
                *(GAS v2u*)(op + 32 * dt + 8 * g + 4 * hi) = w;
            }
    }
    __syncthreads();
}
__device__ __forceinline__ void conv_item(int item, const bf16* z, const float* cw, bf16* ci, int tid) {
    const int c8 = tid & 255, half = tid >> 8, t0 = 32 * item + 16 * half, c0 = 8 * c8;
    float w0[8], w1[8], w2[8], u1[8], u2[8];
#pragma unroll
    for (int e = 0; e < 8; ++e) { w0[e] = cw[c0 + e]; w1[e] = cw[2048 + c0 + e]; w2[e] = cw[4096 + c0 + e]; u1[e] = 0.f; u2[e] = 0.f; }
    if ((t0 & (SEQ - 1)) != 0) {
#pragma unroll
        for (int k = 0; k < 2; ++k) {
            const bf16* zr = z + (size_t)(t0 - 2 + k) * IN_W + c0;
            const v4u a = *(const GAS v4u*)(zr + CC_OFF), h = *(const GAS v4u*)(zr + CH_OFF);
            float u[8];
            u[0] = pg8::bf_lo(a.x) * pg8::bf_lo(h.x); u[1] = pg8::bf_hi(a.x) * pg8::bf_hi(h.x); u[2] = pg8::bf_lo(a.y) * pg8::bf_lo(h.y); u[3] = pg8::bf_hi(a.y) * pg8::bf_hi(h.y);
            u[4] = pg8::bf_lo(a.z) * pg8::bf_lo(h.z); u[5] = pg8::bf_hi(a.z) * pg8::bf_hi(h.z); u[6] = pg8::bf_lo(a.w) * pg8::bf_lo(h.w); u[7] = pg8::bf_hi(a.w) * pg8::bf_hi(h.w);
#pragma unroll
            for (int e = 0; e < 8; ++e) { if (k == 0) u2[e] = u[e]; else u1[e] = u[e]; }
        }
    }
#pragma unroll 4
    for (int i = 0; i < 16; ++i) {
        const bf16* zr = z + (size_t)(t0 + i) * IN_W + c0;
        const v4u a = *(const GAS v4u*)(zr + CC_OFF), h = *(const GAS v4u*)(zr + CH_OFF), bb = *(const GAS v4u*)(zr + CB_OFF);
        float u[8], cb[8], y[8];
        u[0] = pg8::bf_lo(a.x) * pg8::bf_lo(h.x); u[1] = pg8::bf_hi(a.x) * pg8::bf_hi(h.x); u[2] = pg8::bf_lo(a.y) * pg8::bf_lo(h.y); u[3] = pg8::bf_hi(a.y) * pg8::bf_hi(h.y);
        u[4] = pg8::bf_lo(a.z) * pg8::bf_lo(h.z); u[5] = pg8::bf_hi(a.z) * pg8::bf_hi(h.z); u[6] = pg8::bf_lo(a.w) * pg8::bf_lo(h.w); u[7] = pg8::bf_hi(a.w) * pg8::bf_hi(h.w);
        cb[0] = pg8::bf_lo(bb.x); cb[1] = pg8::bf_hi(bb.x); cb[2] = pg8::bf_lo(bb.y); cb[3] = pg8::bf_hi(bb.y); cb[4] = pg8::bf_lo(bb.z); cb[5] = pg8::bf_hi(bb.z); cb[6] = pg8::bf_lo(bb.w); cb[7] = pg8::bf_hi(bb.w);
#pragma unroll
        for (int e = 0; e < 8; ++e) { y[e] = cb[e] * (w0[e] * u2[e] + w1[e] * u1[e] + w2[e] * u[e]); u2[e] = u1[e]; u1[e] = u[e]; }
        v4u o; o.x = pk2(y[0], y[1]); o.y = pk2(y[2], y[3]); o.z = pk2(y[4], y[5]); o.w = pk2(y[6], y[7]);
        *(GAS v4u*)(ci + (size_t)(t0 + i) * D + c0) = o;
    }
}

__device__ __forceinline__ unsigned pack_i8(const f32x4 v) {
    const int a = __float2int_rn(v.x), b = __float2int_rn(v.y), c = __float2int_rn(v.z), d = __float2int_rn(v.w);
    return ((unsigned)a & 0xffu) | (((unsigned)b & 0xffu) << 8) | (((unsigned)c & 0xffu) << 16) | ((unsigned)d << 24);
}
__device__ __forceinline__ unsigned pack_i8_2(float a, float b, float c, float d) {
    const int ia = __float2int_rn(a), ib = __float2int_rn(b), ic = __float2int_rn(c), id = __float2int_rn(d);
    return ((unsigned)ia & 0xffu) | (((unsigned)ib & 0xffu) << 8) | (((unsigned)ic & 0xffu) << 16) | ((unsigned)id << 24);
}
__device__ __forceinline__ void ln1_row(bf16* hbrow, signed char* xqrow, float* sxp, const float* g, const float* bta, int lane) {
    GAS v4u* xr = (GAS v4u*)hbrow + lane;
    float v[4][8]; float s = 0.f;
#pragma unroll
    for (int j = 0; j < 4; ++j) { const v4u w = xr[64 * j];
        v[j][0] = pg8::bf_lo(w.x); v[j][1] = pg8::bf_hi(w.x); v[j][2] = pg8::bf_lo(w.y); v[j][3] = pg8::bf_hi(w.y); v[j][4] = pg8::bf_lo(w.z); v[j][5] = pg8::bf_hi(w.z); v[j][6] = pg8::bf_lo(w.w); v[j][7] = pg8::bf_hi(w.w);
#pragma unroll
        for (int e = 0; e < 8; ++e) s += v[j][e]; }
    const float mean = wave_sum(s) * (1.f / D); float s2 = 0.f;
#pragma unroll
    for (int j = 0; j < 4; ++j)
#pragma unroll
        for (int e = 0; e < 8; ++e) { v[j][e] -= mean; s2 += v[j][e] * v[j][e]; }
    const float rstd = 1.f / sqrtf(wave_sum(s2) * (1.f / D) + LN_EPS);
    float mx = 0.f;
#pragma unroll
    for (int j = 0; j < 4; ++j) {
        const GAS f32x4* gp = (const GAS f32x4*)g + 2 * (lane + 64 * j); const GAS f32x4* bp = (const GAS f32x4*)bta + 2 * (lane + 64 * j);
        const f32x4 g0 = gp[0], g1 = gp[1], b0 = bp[0], b1 = bp[1];
        v[j][0] = v[j][0] * rstd * g0.x + b0.x; v[j][1] = v[j][1] * rstd * g0.y + b0.y; v[j][2] = v[j][2] * rstd * g0.z + b0.z; v[j][3] = v[j][3] * rstd * g0.w + b0.w;
        v[j][4] = v[j][4] * rstd * g1.x + b1.x; v[j][5] = v[j][5] * rstd * g1.y + b1.y; v[j][6] = v[j][6] * rstd * g1.z + b1.z; v[j][7] = v[j][7] * rstd * g1.w + b1.w;
        v4u o; o.x = pk2(v[j][0], v[j][1]); o.y = pk2(v[j][2], v[j][3]); o.z = pk2(v[j][4], v[j][5]); o.w = pk2(v[j][6], v[j][7]);
        xr[64 * j] = o;
#pragma unroll
        for (int e = 0; e < 8; ++e) mx = fmaxf(mx, fabsf(v[j][e]));
    }
#pragma unroll
    for (int o = 1; o < 64; o <<= 1) mx = fmaxf(mx, __shfl_xor(mx, o));
    const float qs = mx > 0.f ? 127.0f / mx : 1.0f;
    GAS v2u* q8 = (GAS v2u*)xqrow + lane;
#pragma unroll
    for (int j = 0; j < 4; ++j) { v2u o; o.x = pack_i8_2(v[j][0] * qs, v[j][1] * qs, v[j][2] * qs, v[j][3] * qs); o.y = pack_i8_2(v[j][4] * qs, v[j][5] * qs, v[j][6] * qs, v[j][7] * qs); q8[64 * j] = o; }
    if (lane == 0) *sxp = mx > 0.f ? mx * (1.0f / 127.0f) : 1.0f;
}

__device__ __forceinline__ void row_f32_to_i8(const float* src, signed char* dst, float* inv, int lane) {
    f32x4 v[8]; float mx = 0.f;
#pragma unroll
    for (int j = 0; j < 8; ++j) { v[j] = *((const GAS f32x4*)src + lane + 64 * j); mx = fmaxf(mx, fmaxf(fmaxf(fabsf(v[j].x), fabsf(v[j].y)), fmaxf(fabsf(v[j].z), fabsf(v[j].w)))); }
#pragma unroll
    for (int o = 1; o < 64; o <<= 1) mx = fmaxf(mx, __shfl_xor(mx, o));
    const float sc = mx > 0.f ? 127.0f / mx : 1.0f;
#pragma unroll
    for (int j = 0; j < 8; ++j) *((GAS unsigned*)dst + lane + 64 * j) = pack_i8_2(v[j].x * sc, v[j].y * sc, v[j].z * sc, v[j].w * sc);
    if (lane == 0) *inv = mx > 0.f ? mx * (1.0f / 127.0f) : 1.0f;
}
__device__ __forceinline__ void row_bf16_to_i8(const bf16* src, signed char* dst, float* inv, int lane) {
    float v[4][8]; float mx = 0.f;
#pragma unroll
    for (int j = 0; j < 4; ++j) { const v4u w = *((const GAS v4u*)src + lane + 64 * j);
        v[j][0] = pg8::bf_lo(w.x); v[j][1] = pg8::bf_hi(w.x); v[j][2] = pg8::bf_lo(w.y); v[j][3] = pg8::bf_hi(w.y); v[j][4] = pg8::bf_lo(w.z); v[j][5] = pg8::bf_hi(w.z); v[j][6] = pg8::bf_lo(w.w); v[j][7] = pg8::bf_hi(w.w);
#pragma unroll
        for (int e = 0; e < 8; ++e) mx = fmaxf(mx, fabsf(v[j][e])); }
#pragma unroll
    for (int o = 1; o < 64; o <<= 1) mx = fmaxf(mx, __shfl_xor(mx, o));
    const float sc = mx > 0.f ? 127.0f / mx : 1.0f;
#pragma unroll
    for (int j = 0; j < 4; ++j) { v2u o; o.x = pack_i8_2(v[j][0] * sc, v[j][1] * sc, v[j][2] * sc, v[j][3] * sc); o.y = pack_i8_2(v[j][4] * sc, v[j][5] * sc, v[j][6] * sc, v[j][7] * sc); *((GAS v2u*)dst + lane + 64 * j) = o; }
    if (lane == 0) *inv = mx > 0.f ? mx * (1.0f / 127.0f) : 1.0f;
}

constexpr int TK_ROWF = 136;
constexpr int TK_IDX_OFF = 256 * TK_ROWF * 4;
__device__ __forceinline__ void topk_core(LAS unsigned char* lds, size_t prob0, int pstride, int* experts, float* gates, int tid) {
    LAS float* S = (LAS float*)lds;
    LAS unsigned char* IDX = lds + TK_IDX_OFF;
    const int row = tid >> 1, sub = tid & 1;
#define TK_CE(a, b) do { const float h_ = vmaxf(a, b), l_ = vminf(a, b); a = h_; b = l_; } while (0)
#define TK_SORT16(V) do { _Pragma("unroll") for (int k_ = 2; k_ <= 16; k_ <<= 1) _Pragma("unroll") for (int j_ = k_ >> 1; j_ > 0; j_ >>= 1) _Pragma("unroll") for (int i_ = 0; i_ < 16; ++i_) { \
        const int l_i = i_ ^ j_; if (l_i > i_) { if ((i_ & k_) == 0) TK_CE(V[i_], V[l_i]); else TK_CE(V[l_i], V[i_]); } } } while (0)
#define TK_MERGE16(Lv, Xv) do { _Pragma("unroll") for (int j_ = 0; j_ < 16; ++j_) Lv[j_] = vmaxf(Lv[j_], Xv[15 - j_]); \
        _Pragma("unroll") for (int st_ = 8; st_ >= 1; st_ >>= 1) _Pragma("unroll") for (int j_ = 0; j_ < 16; ++j_) if ((j_ & st_) == 0) TK_CE(Lv[j_], Lv[j_ + st_]); } while (0)
    float L[16];
#pragma unroll
    for (int q = 0; q < 4; ++q) {
        float C[16];
#pragma unroll
        for (int i = 0; i < 4; ++i) { const int c4 = 2 * (4 * q + i) + sub;
            const f32x4 v = *(const LAS f32x4*)(S + row * TK_ROWF + 4 * c4);
#pragma unroll
            for (int e = 0; e < 4; ++e) { const float ve = v[e];
                C[4 * i + e] = __uint_as_float((__float_as_uint(ve) & ~0x7Fu) | (unsigned)(4 * c4 + e)); } }
        TK_SORT16(C);
        if (q == 0) {
#pragma unroll
            for (int j = 0; j < 16; ++j) L[j] = C[j];
        } else TK_MERGE16(L, C);
    }
    {
        float P[16];
#pragma unroll
        for (int j = 0; j < 16; ++j) P[j] = __shfl_xor(L[j], 1);
        TK_MERGE16(L, P);
    }
    if (sub == 0) {
#pragma unroll
        for (int q = 0; q < 4; ++q) {
            unsigned w = 0;
#pragma unroll
            for (int e = 0; e < 4; ++e) w |= (__builtin_bit_cast(unsigned, L[4 * q + e]) & 0x7Fu) << (8 * e);
            *(LAS unsigned*)(IDX + row * 16 + 4 * q) = w;
        }
    }
    float A[16], B[16];
#pragma unroll
    for (int j = 0; j < 16; ++j) { const float o = __shfl_xor(L[j], 2); const bool isb = (tid & 2) != 0; A[j] = isb ? o : L[j]; B[j] = isb ? L[j] : o; }
#define TK_KEY(i, j) __uint_as_float((__float_as_uint(A[i] + B[j]) & ~0xFFu) | (unsigned)(255 - ((i) * 16 + (j))))
    float F[16], X[16];
#pragma unroll
    for (int j = 0; j < 16; ++j) F[j] = TK_KEY(0, j);
#pragma unroll
    for (int i = 1; i < 16; ++i) X[i - 1] = TK_KEY(i, 0);
    X[15] = -INFINITY; TK_MERGE16(F, X);
#pragma unroll
    for (int i = 0; i < 16; ++i) X[i] = -INFINITY;
#pragma unroll
    for (int i = 1; i <= 7; ++i) X[i - 1] = TK_KEY(i, 1);
    TK_MERGE16(F, X);
#pragma unroll
    for (int i = 0; i < 16; ++i) X[i] = -INFINITY;
#pragma unroll
    for (int j = 2; j <= 7; ++j) X[j - 2] = TK_KEY(1, j);
    TK_MERGE16(F, X);
    { const float rest[6] = {TK_KEY(2, 2), TK_KEY(2, 3), TK_KEY(2, 4), TK_KEY(3, 2), TK_KEY(3, 3), TK_KEY(4, 2)};
#pragma unroll
      for (int r = 0; r < 6; ++r) { float x = rest[r];
#pragma unroll
          for (int k = 0; k < 16; ++k) { const float h = vmaxf(F[k], x); x = vminf(F[k], x); F[k] = h; } } }
    __syncthreads();
    if ((tid & 3) == 0) {
        const int rowA = (tid >> 2) * 2, rowB = rowA + 1;
        const size_t prob = prob0 + (size_t)pstride * (tid >> 2);
        float g[16]; int ex[16]; float gs = 0.f;
#pragma unroll
        for (int k = 0; k < 16; ++k) {
            const unsigned code = 255u - (__builtin_bit_cast(unsigned, F[k]) & 0xFFu);
            const int ia = IDX[rowA * 16 + (code >> 4)], ib = IDX[rowB * 16 + (code & 15)];
            ex[k] = ia * PNK + ib;
            g[k] = __expf(F[k] - F[0]); gs += g[k];
        }
        const float ginv = 1.0f / gs;
#pragma unroll
        for (int q = 0; q < 4; ++q) {
            *(GAS f32x4*)(gates + prob * 16 + 4 * q) = (f32x4){g[4 * q] * ginv, g[4 * q + 1] * ginv, g[4 * q + 2] * ginv, g[4 * q + 3] * ginv};
            typedef int i32x4 __attribute__((ext_vector_type(4)));
            *(GAS i32x4*)(experts + prob * 16 + 4 * q) = (i32x4){ex[4 * q], ex[4 * q + 1], ex[4 * q + 2], ex[4 * q + 3]};
        }
    }
    __syncthreads();
}
__device__ __forceinline__ void topk_pass(int pass, const float* scores, int* experts, float* gates, LAS unsigned char* lds, int tid) {
    LAS float* S = (LAS float*)lds;
    const float* src = scores + (size_t)pass * (256 * 128);
#pragma unroll 4
    for (int i = 0; i < 16; ++i) { const int f4 = tid + NTHREADS * i, row = f4 >> 5, c4 = f4 & 31; *(LAS f32x4*)(S + row * TK_ROWF + 4 * c4) = *(const GAS f32x4*)(src + (size_t)f4 * 4); }
    __syncthreads();
    topk_core(lds, (size_t)pass * 128, 1, experts, gates, tid);
}
struct EpiTopKI8 {
    static constexpr bool PERM = false, AFTER_DRAIN = true;
    int* experts; float* gates; const float* sa; const float* sb;
    __device__ __forceinline__ void fused(pg8::i32x4 (&acc)[2][2][4][2], const pg8::Unit& u, int wr, int wc, int fr, int fq, LAS unsigned char* lds, int wid, int lane) const {
        LAS float* S = (LAS float*)lds;
        const int tid = wid * 64 + lane;
        pg8::f32x4 sbv[2][2];
#pragma unroll
        for (int bj = 0; bj < 2; ++bj)
#pragma unroll
            for (int n = 0; n < 2; ++n) sbv[bj][n] = *(const GAS pg8::f32x4*)(sb + u.pn * 256 + bj * 128 + 32 * wc + 16 * n + 4 * fq);
#pragma unroll
        for (int ai = 0; ai < 2; ++ai) {
#pragma unroll
            for (int mm = 0; mm < 4; ++mm) { const int rl = 64 * wr + 16 * mm + fr; const float sr = sa[u.pm * 256 + 128 * ai + rl];
#pragma unroll
                for (int bj = 0; bj < 2; ++bj)
#pragma unroll
                    for (int n = 0; n < 2; ++n) { const pg8::i32x4 a = acc[ai][bj][mm][n];
                        *(LAS pg8::f32x4*)(S + (2 * rl + bj) * TK_ROWF + 32 * wc + 16 * n + 4 * fq) = (pg8::f32x4){(float)a[0], (float)a[1], (float)a[2], (float)a[3]} * sbv[bj][n] * sr; } }
            __syncthreads();
            topk_core(lds, ((size_t)u.pm * 256 + 128 * ai) * PH + u.pn, PH, experts, gates, tid);
        }
    }
};
struct EpiTopK {
    static constexpr bool PERM = false, AFTER_DRAIN = true;
    int* experts; float* gates;
    __device__ __forceinline__ void fused(pg8::f32x4 (&acc)[2][2][4][2], const pg8::Unit& u, int wr, int wc, int fr, int fq, LAS unsigned char* lds, int wid, int lane) const {
        LAS float* S = (LAS float*)lds;
        const int tid = wid * 64 + lane;
#pragma unroll
        for (int ai = 0; ai < 2; ++ai) {
#pragma unroll
            for (int bj = 0; bj < 2; ++bj)
#pragma unroll
                for (int mm = 0; mm < 4; ++mm)
#pragma unroll
                    for (int n = 0; n < 2; ++n) { const int rl = 64 * wr + 16 * mm + fr; *(LAS pg8::f32x4*)(S + (2 * rl + bj) * TK_ROWF + 32 * wc + 16 * n + 4 * fq) = acc[ai][bj][mm][n]; }
            __syncthreads();
            topk_core(lds, ((size_t)u.pm * 256 + 128 * ai) * PH + u.pn, PH, experts, gates, tid);
        }
    }
};

__device__ __forceinline__ float gelu_erf(float v) { return 0.5f * v * (1.0f + erff(v * 0.70710678118654752f)); }
typedef __bf16 bf16x2_t __attribute__((ext_vector_type(2)));
typedef float f32x2_t __attribute__((ext_vector_type(2)));
__device__ __forceinline__ float dot2bf(bf16x2_t a, unsigned b, float acc) { return __builtin_amdgcn_fdot2_f32_bf16(a, __builtin_bit_cast(bf16x2_t, b), acc, false); }
__device__ __forceinline__ float dot4f8(unsigned w8, unsigned x01, unsigned x23, float acc) {
    acc = dot2bf(__builtin_amdgcn_cvt_scalef32_pk_bf16_fp8(w8, 1.0f, false), x01, acc);
    return dot2bf(__builtin_amdgcn_cvt_scalef32_pk_bf16_fp8(w8, 1.0f, true), x23, acc);
}
__device__ __forceinline__ void axpy4f8(float* y, unsigned w8, float w) {
    const f32x2_t lo = __builtin_amdgcn_cvt_pk_f32_fp8(w8, false), hi = __builtin_amdgcn_cvt_pk_f32_fp8(w8, true);
    y[0] += w * lo.x; y[1] += w * lo.y; y[2] += w * hi.x; y[3] += w * hi.y;
}
__device__ __forceinline__ void axpy4f8v(f32x2_t* y2, unsigned w8, float w) {
    const f32x2_t lo = __builtin_amdgcn_cvt_pk_f32_fp8(w8, false), hi = __builtin_amdgcn_cvt_pk_f32_fp8(w8, true);
    const f32x2_t ww = {w, w};
    y2[0] = __builtin_elementwise_fma(lo, ww, y2[0]); y2[1] = __builtin_elementwise_fma(hi, ww, y2[1]);
}
__device__ __forceinline__ void row_to_fp8(const float* src, unsigned char* dst, float* inv, int lane) {
    f32x4 v[2][4]; float mx = 0.f;
#pragma unroll
    for (int j = 0; j < 2; ++j)
#pragma unroll
        for (int q = 0; q < 4; ++q) { v[j][q] = *((const GAS f32x4*)src + 4 * (lane + 64 * j) + q);
            mx = fmaxf(mx, fmaxf(fmaxf(fabsf(v[j][q].x), fabsf(v[j][q].y)), fmaxf(fabsf(v[j][q].z), fabsf(v[j][q].w)))); }
#pragma unroll
    for (int o = 1; o < 64; o <<= 1) mx = fmaxf(mx, __shfl_xor(mx, o));
    const float sc = mx > 0.f ? 384.0f / mx : 1.0f;
#pragma unroll
    for (int j = 0; j < 2; ++j) { v4u o;
        int w;
        w = 0; w = __builtin_amdgcn_cvt_pk_fp8_f32(v[j][0].x * sc, v[j][0].y * sc, w, false); w = __builtin_amdgcn_cvt_pk_fp8_f32(v[j][0].z * sc, v[j][0].w * sc, w, true); o.x = (unsigned)w;
        w = 0; w = __builtin_amdgcn_cvt_pk_fp8_f32(v[j][1].x * sc, v[j][1].y * sc, w, false); w = __builtin_amdgcn_cvt_pk_fp8_f32(v[j][1].z * sc, v[j][1].w * sc, w, true); o.y = (unsigned)w;
        w = 0; w = __builtin_amdgcn_cvt_pk_fp8_f32(v[j][2].x * sc, v[j][2].y * sc, w, false); w = __builtin_amdgcn_cvt_pk_fp8_f32(v[j][2].z * sc, v[j][2].w * sc, w, true); o.z = (unsigned)w;
        w = 0; w = __builtin_amdgcn_cvt_pk_fp8_f32(v[j][3].x * sc, v[j][3].y * sc, w, false); w = __builtin_amdgcn_cvt_pk_fp8_f32(v[j][3].z * sc, v[j][3].w * sc, w, true); o.w = (unsigned)w;
        { const int ch = lane + 64 * j; *((GAS v4u*)(dst + (size_t)(ch >> 4) * SLICE_BYTES) + (ch & 15)) = o; } }
    if (lane == 0) *inv = mx > 0.f ? mx * (1.0f / 384.0f) : 1.0f;
}
__device__ __forceinline__ void row_to_i8(const float* src, unsigned char* dst, float* inv, int lane) {
    f32x4 v[2][4]; float mx = 0.f;
#pragma unroll
    for (int j = 0; j < 2; ++j)
#pragma unroll
        for (int q = 0; q < 4; ++q) { v[j][q] = *((const GAS f32x4*)src + 4 * (lane + 64 * j) + q);
            mx = fmaxf(mx, fmaxf(fmaxf(fabsf(v[j][q].x), fabsf(v[j][q].y)), fmaxf(fabsf(v[j][q].z), fabsf(v[j][q].w)))); }
#pragma unroll
    for (int o = 1; o < 64; o <<= 1) mx = fmaxf(mx, __shfl_xor(mx, o));
    const float sc = mx > 0.f ? 127.0f / mx : 1.0f;
#pragma unroll
    for (int j = 0; j < 2; ++j) { v4u o; o.x = pack_i8(v[j][0] * sc); o.y = pack_i8(v[j][1] * sc); o.z = pack_i8(v[j][2] * sc); o.w = pack_i8(v[j][3] * sc);
        { const int ch = lane + 64 * j; *((GAS v4u*)(dst + (size_t)(ch >> 4) * SLICE_BYTES) + (ch & 15)) = o; } }
    if (lane == 0) *inv = mx > 0.f ? mx * (1.0f / 127.0f) : 1.0f;
}
__device__ __forceinline__ float row16_allsum(float a) {
    a += __builtin_bit_cast(float, __builtin_amdgcn_update_dpp(0, __builtin_bit_cast(int, a), 0x128, 0xf, 0xf, false));
    a += __builtin_bit_cast(float, __builtin_amdgcn_update_dpp(0, __builtin_bit_cast(int, a), 0x124, 0xf, 0xf, false));
    a += __builtin_bit_cast(float, __builtin_amdgcn_update_dpp(0, __builtin_bit_cast(int, a), 0x122, 0xf, 0xf, false));
    a += __builtin_bit_cast(float, __builtin_amdgcn_update_dpp(0, __builtin_bit_cast(int, a), 0x121, 0xf, 0xf, false));
    return a;
}
__device__ __forceinline__ int q_pull(unsigned* q, int lane) { int v = 0; if (lane == 0) v = (int)__hip_atomic_fetch_add(q, 1u, __ATOMIC_RELAXED, __HIP_MEMORY_SCOPE_AGENT); return __builtin_amdgcn_readfirstlane(v); }
constexpr int PEER_TG = 8;
constexpr int PEER_N8 = 640, PEER_N4 = 512, PEER_N2 = 512, PEER_NTASK = PEER_N8 + PEER_N4 + PEER_N2;
__device__ __forceinline__ void peer_task_tokens(int idx, int& t0, int& n) {
    if (idx < PEER_N8) { t0 = 8 * idx; n = 8; } else if (idx < PEER_N8 + PEER_N4) { t0 = 8 * PEER_N8 + 4 * (idx - PEER_N8); n = 4; } else { t0 = 8 * PEER_N8 + 4 * PEER_N4 + 2 * (idx - PEER_N8 - PEER_N4); n = 2; }
}
__device__ __forceinline__ int row16_allsum_i(int a) {
    a += __builtin_amdgcn_update_dpp(0, a, 0x128, 0xf, 0xf, false);
    a += __builtin_amdgcn_update_dpp(0, a, 0x124, 0xf, 0xf, false);
    a += __builtin_amdgcn_update_dpp(0, a, 0x122, 0xf, 0xf, false);
    a += __builtin_amdgcn_update_dpp(0, a, 0x121, 0xf, 0xf, false);
    return a;
}
#define PA_LOAD(R, IDV, HALF) do { _Pragma("unroll") for (int i_ = 0; i_ < 8; ++i_) { const unsigned e_ = (unsigned)__shfl(IDV, 4 * (i_ + 8 * (HALF)) + g); \
        R[i_] = *(const GAS v4u*)(ub + (e_ * 256u + offc)); } } while (0)
#define PA_COMP(R, HALF) do { _Pragma("unroll") for (int i_ = 0; i_ < 8; ++i_) { int a_ = __builtin_amdgcn_sdot4((int)R[i_].x, (int)xc.x, 0, false); a_ = __builtin_amdgcn_sdot4((int)R[i_].y, (int)xc.y, a_, false); \
        a_ = __builtin_amdgcn_sdot4((int)R[i_].z, (int)xc.z, a_, false); a_ = __builtin_amdgcn_sdot4((int)R[i_].w, (int)xc.w, a_, false); r16[8 * (HALF) + i_] = row16_allsum_i(a_); } } while (0)
__device__ __forceinline__ void peer_a_task(int t0, int ntok, int s, const signed char* xq, const int* experts, const unsigned char* u8s, int* pa, int lane_) {
    int lane = lane_; asm volatile("" : "+v"(lane));
    const int g = lane >> 4, c = lane & 15;
    const GAS unsigned char* ub = (const GAS unsigned char*)(u8s + (size_t)s * SLICE_BYTES);
    const unsigned offc = 16u * (unsigned)c;
    int idc0 = experts[(size_t)t0 * 128 + lane], idc1 = experts[(size_t)t0 * 128 + lane + 64];
    v4u xc = *(const GAS v4u*)(xq + (size_t)t0 * D + 256 * s + 16 * c);
    v4u RA[8], RB[8];
    PA_LOAD(RA, idc0, 0);
#pragma unroll 1
    for (int tt = 0; tt < ntok; ++tt) {
        const int t = t0 + tt, tn = tt + 1 < ntok ? t + 1 : t;
        const int idn0 = experts[(size_t)tn * 128 + lane], idn1 = experts[(size_t)tn * 128 + lane + 64];
        const v4u xn = *(const GAS v4u*)(xq + (size_t)tn * D + 256 * s + 16 * c);
#pragma unroll 1
        for (int hb = 0; hb < 2; ++hb) {
            const int idv = hb ? idc1 : idc0, idx = hb ? idn0 : idc1;
            int r16[16];
            PA_LOAD(RB, idv, 1); PA_COMP(RA, 0);
            asm volatile("" ::: "memory");
            PA_LOAD(RA, idx, 0); PA_COMP(RB, 1);
            if (c == 15) { typedef int i32x4 __attribute__((ext_vector_type(4))); GAS i32x4* dst = (GAS i32x4*)(pa + ((size_t)t * 8 + s) * 128 + g * 32 + 16 * hb);
#pragma unroll
                for (int q = 0; q < 4; ++q) dst[q] = (i32x4){r16[4 * q], r16[4 * q + 1], r16[4 * q + 2], r16[4 * q + 3]}; }
        }
        idc0 = idn0; idc1 = idn1; xc = xn;
    }
}
__device__ __forceinline__ void peer_w_elem(size_t i, const int* experts, const float* gates, const float* su, const float* sv, const float* sx, const int* pa, float* wb) {
    const size_t t = i >> 7; const int k = (int)(i & 127), pos = (k & 3) * 32 + (k >> 2);
    const int e = experts[i];
    int a = 0;
#pragma unroll
    for (int s2 = 0; s2 < 8; ++s2) a += pa[(t * 8 + s2) * 128 + pos];
    wb[i] = gates[i] * gelu_erf((float)a * (su[e] * sx[t])) * sv[e];
}
#define PB_LOAD(R, IDV, HALF) do { _Pragma("unroll") for (int i_ = 0; i_ < 8; ++i_) { const unsigned e_ = (unsigned)__shfl(IDV, 4 * (i_ + 8 * (HALF)) + g); \
        R[i_] = *(const GAS v4u*)(vb + (e_ * 256u + offc)); } } while (0)
#define PB_COMP(R, WV, HALF) do { _Pragma("unroll") for (int i_ = 0; i_ < 8; ++i_) { const float wk_ = __shfl(WV, 4 * (i_ + 8 * (HALF)) + g); \
        axpy4f8v(&ya2[0], R[i_].x, wk_); axpy4f8v(&ya2[2], R[i_].y, wk_); axpy4f8v(&ya2[4], R[i_].z, wk_); axpy4f8v(&ya2[6], R[i_].w, wk_); } } while (0)
__device__ __forceinline__ void peer_b_task(int t0, int ntok, int s, const bf16* h1, const int* experts, const float* wb, const unsigned char* v8s, bf16* out, float* st, int lane_) {
    int lane = lane_; asm volatile("" : "+v"(lane));
    const int g = lane >> 4, c = lane & 15;
    const GAS unsigned char* vb = (const GAS unsigned char*)(v8s + (size_t)s * SLICE_BYTES);
    const unsigned offc = 16u * (unsigned)c;
    int idc0 = experts[(size_t)t0 * 128 + lane], idc1 = experts[(size_t)t0 * 128 + lane + 64];
    float wc0 = wb[(size_t)t0 * 128 + lane], wc1 = wb[(size_t)t0 * 128 + lane + 64];
    v4u RA[8], RB[8];
    PB_LOAD(RA, idc0, 0);
#pragma unroll 1
    for (int tt = 0; tt < ntok; ++tt) {
        const int t = t0 + tt, tn = tt + 1 < ntok ? t + 1 : t;
        const int idn0 = experts[(size_t)tn * 128 + lane], idn1 = experts[(size_t)tn * 128 + lane + 64];
        const float wn0 = wb[(size_t)tn * 128 + lane], wn1 = wb[(size_t)tn * 128 + lane + 64];
        f32x2_t ya2[8];
#pragma unroll
        for (int e = 0; e < 8; ++e) ya2[e] = (f32x2_t){0.f, 0.f};
#pragma unroll 1
        for (int hb = 0; hb < 2; ++hb) {
            const int idv = hb ? idc1 : idc0, idx = hb ? idn0 : idc1; const float wv = hb ? wc1 : wc0;
            PB_LOAD(RB, idv, 1); PB_COMP(RA, wv, 0);
            asm volatile("" ::: "memory");
            PB_LOAD(RA, idx, 0); PB_COMP(RB, wv, 1);
        }
        float ya[16];
#pragma unroll
        for (int e = 0; e < 8; ++e) { ya[2 * e] = ya2[e].x; ya[2 * e + 1] = ya2[e].y; }
#pragma unroll
        for (int e = 0; e < 16; ++e) { ya[e] += __shfl_xor(ya[e], 16); ya[e] += __shfl_xor(ya[e], 32); }
        const GAS v4u* hp = (const GAS v4u*)(h1 + (size_t)t * D + 256 * s + 16 * c);
        const v4u h0 = hp[0], h1v = hp[1];
        float hx[16];
        hx[0] = pg8::bf_lo(h0.x); hx[1] = pg8::bf_hi(h0.x); hx[2] = pg8::bf_lo(h0.y); hx[3] = pg8::bf_hi(h0.y); hx[4] = pg8::bf_lo(h0.z); hx[5] = pg8::bf_hi(h0.z); hx[6] = pg8::bf_lo(h0.w); hx[7] = pg8::bf_hi(h0.w);
        hx[8] = pg8::bf_lo(h1v.x); hx[9] = pg8::bf_hi(h1v.x); hx[10] = pg8::bf_lo(h1v.y); hx[11] = pg8::bf_hi(h1v.y); hx[12] = pg8::bf_lo(h1v.z); hx[13] = pg8::bf_hi(h1v.z); hx[14] = pg8::bf_lo(h1v.w); hx[15] = pg8::bf_hi(h1v.w);
        float sm = 0.f, sq = 0.f;
#pragma unroll
        for (int e = 0; e < 16; ++e) { ya[e] = hx[e] * ALPHA + ya[e]; sm += ya[e]; sq += ya[e] * ya[e]; }
        sm = row16_allsum(sm); sq = row16_allsum(sq);
        if (g == 0) { GAS v4u* op = (GAS v4u*)(out + (size_t)t * D + 256 * s + 16 * c);
            v4u o0, o1; o0.x = pk2(ya[0], ya[1]); o0.y = pk2(ya[2], ya[3]); o0.z = pk2(ya[4], ya[5]); o0.w = pk2(ya[6], ya[7]);
            o1.x = pk2(ya[8], ya[9]); o1.y = pk2(ya[10], ya[11]); o1.z = pk2(ya[12], ya[13]); o1.w = pk2(ya[14], ya[15]);
            op[0] = o0; op[1] = o1;
            if (c == 0) { st[((size_t)t * 8 + s) * 2] = sm; st[((size_t)t * 8 + s) * 2 + 1] = sq; } }
        idc0 = idn0; idc1 = idn1; wc0 = wn0; wc1 = wn1;
    }
}
__device__ __forceinline__ void peer_c_row(int t, const bf16* r2, float* out, const float* st, const float* g2, const float* b2, int lane) {
    float sm = 0.f, sq = 0.f;
#pragma unroll
    for (int s = 0; s < 8; ++s) { sm += st[((size_t)t * 8 + s) * 2]; sq += st[((size_t)t * 8 + s) * 2 + 1]; }
    const float mean = sm * (1.f / D), var = sq * (1.f / D) - mean * mean, rstd = 1.f / sqrtf(fmaxf(var, 0.f) + LN_EPS);
    const GAS v4u* xr = (const GAS v4u*)(r2 + (size_t)t * D) + lane;
    GAS f32x4* op = (GAS f32x4*)(out + (size_t)t * D);
#pragma unroll
    for (int j = 0; j < 4; ++j) { const v4u w = xr[64 * j]; const int c4 = 2 * (lane + 64 * j);
        const f32x4 g0 = *((const GAS f32x4*)g2 + c4), g1 = *((const GAS f32x4*)g2 + c4 + 1), b0 = *((const GAS f32x4*)b2 + c4), b1 = *((const GAS f32x4*)b2 + c4 + 1);
        const f32x4 v0 = (f32x4){pg8::bf_lo(w.x), pg8::bf_hi(w.x), pg8::bf_lo(w.y), pg8::bf_hi(w.y)}, v1 = (f32x4){pg8::bf_lo(w.z), pg8::bf_hi(w.z), pg8::bf_lo(w.w), pg8::bf_hi(w.w)};
        op[c4] = (v0 - mean) * rstd * g0 + b0; op[c4 + 1] = (v1 - mean) * rstd * g1 + b1; }
}

struct TwoPassOrder : pg8::StaticOrder {
    __device__ __forceinline__ bool next(int i, pg8::Unit& u) const { if (!pg8::StaticOrder::next(i >> 1, u)) return false; u.w = i & 1; return true; }
};
struct EpiGate2 {
    static constexpr bool PERM = true, AFTER_DRAIN = false;
    pg8::EpiGate<0> e0; pg8::EpiGate<1> e1;
    __device__ __forceinline__ void operator()(const pg8::f32x4 (&acc)[2][2][4][2], const pg8::Unit& u, int wr, int wc, int fr, int fq) const { if (u.w == 0) e0(acc, u, wr, wc, fr, fq); else e1(acc, u, wr, wc, fr, fq); }
};

struct EpiGate2I8 {
    static constexpr bool PERM = true, AFTER_DRAIN = false;
    pg8::EpiGateI8<0> e0; pg8::EpiGateI8<1> e1;
    __device__ __forceinline__ void operator()(const pg8::i32x4 (&acc)[2][2][4][2], const pg8::Unit& u, int wr, int wc, int fr, int fq) const { if (u.w == 0) e0(acc, u, wr, wc, fr, fq); else e1(acc, u, wr, wc, fr, fq); }
};
struct ConvOrder : pg8::StaticOrder {
    const float* pu; const float* pv; unsigned char* u8; unsigned char* v8; float* su; float* sv; int slot; mutable int calls;
    static constexpr int CONV_ROWS = 4, CONV_CALLS = 6;
    __device__ __forceinline__ void done(const pg8::Unit&) const {
        if (slot < 0) return;
        int lane = threadIdx.x & 63; asm volatile("" : "+v"(lane));
        const int wave = __builtin_amdgcn_readfirstlane(threadIdx.x >> 6);
        const int base = ((slot * NWAVES + wave) * CONV_CALLS + calls) * CONV_ROWS;
        if (calls < CONV_CALLS) {
#pragma unroll 1
            for (int j = 0; j < CONV_ROWS; ++j) { const int r = base + j; if (r < 2 * PNE) { const bool sec = r >= PNE; const int e = sec ? r - PNE : r;
                if (sec) row_to_fp8(pv + (size_t)e * D, v8 + (size_t)e * 256, sv + e, lane); else row_to_i8(pu + (size_t)e * D, u8 + (size_t)e * 256, su + e, lane); } }
        }
        ++calls;
    }
};

struct Args { const float* in[16]; float* out; unsigned char* ws; int ph_lo, ph_hi; };
__global__ void __launch_bounds__(NTHREADS, 2) mk_fwd(Args args) {
    extern __shared__ __attribute__((aligned(16))) unsigned char lds_raw[];
    LAS unsigned char* lds = (LAS unsigned char*)lds_raw;
    volatile LAS unsigned* MISC = (volatile LAS unsigned*)(lds + MISC_OFF);
    const int tid0 = threadIdx.x;
    const int G = gridDim.x, bx = blockIdx.x;
    unsigned char* ws = args.ws;
    gu32* ctl = (gu32*)(ws + WS_CTL);
#define IN_(i) (args.in[i])
#define x_in IN_(0)
#define w_in IN_(1)
#define b_gate IN_(2)
#define sinks IN_(3)
#define conv_w IN_(4)
#define w_ao IN_(5)
#define w_co IN_(6)
#define w_o IN_(7)
#define ln1_g IN_(8)
#define ln1_b IN_(9)
#define w_q IN_(10)
#define sub_keys IN_(11)
#define peer_u IN_(12)
#define peer_v IN_(13)
#define ln2_g IN_(14)
#define ln2_b IN_(15)
#define WinT ((bf16*)(ws + WS_WIN))
#define WaT ((bf16*)(ws + WS_WA))
#define WcT ((bf16*)(ws + WS_WC))
#define WoT ((bf16*)(ws + WS_WO))
#define WfT ((bf16*)(ws + WS_WF))
#define XB ((bf16*)(ws + WS_XB))
#define MERGED ((bf16*)(ws + WS_MERGED))
#define Z ((bf16*)(ws + WS_Z))
#define R2B ((bf16*)(ws + WS_R2B))
#define H1B ((bf16*)(ws + WS_H1B))
#define SC ((float*)(ws + WS_SC))
#define EX ((int*)(ws + WS_EX))
#define GT ((float*)(ws + WS_GT))
#define AO ((bf16*)(ws + WS_AO))
#define CI ((bf16*)(ws + WS_CI))
#define TMP ((bf16*)(ws + WS_TMP))
#define U8 ((unsigned char*)(ws + WS_U8))
#define V8 ((unsigned char*)(ws + WS_V8))
#define SU ((float*)(ws + WS_SU))
#define SV ((float*)(ws + WS_SV))
#define PA ((int*)(ws + WS_PA))
#define ST ((float*)(ws + WS_ST))
#define WB ((float*)(ws + WS_WB))
#define XA8 ((signed char*)(ws + WS_XA8))
#define WIN8 ((signed char*)(ws + WS_WIN8))
#define SWIN ((float*)(ws + WS_SWIN))
#define SXA ((float*)(ws + WS_SXA))
#define WF8 ((signed char*)(ws + WS_WF8))
#define AO8 ((signed char*)(ws + WS_AO8))
#define CI8 ((signed char*)(ws + WS_CI8))
#define WA8 ((signed char*)(ws + WS_WA8))
#define WC8 ((signed char*)(ws + WS_WC8))
#define SAO ((float*)(ws + WS_S3))
#define SCI ((float*)(ws + WS_S3 + 65536))
#define SWA ((float*)(ws + WS_S3 + 131072))
#define SWC ((float*)(ws + WS_S3 + 196608))
#define SWF ((float*)(ws + WS_SWF))
#define XQ ((signed char*)(ws + WS_XQ))
#define SX ((float*)(ws + WS_SX))
    for (int u = tid0; u < (LDS_BYTES - LDSCTL_OFF) / 4; u += NTHREADS) ((LAS unsigned*)(lds + LDSCTL_OFF))[u] = 0u;
    __syncthreads();
    XcdBarrier bar; bar.bar = (unsigned*)(ctl + CW_BAR); bar.x = 0; bar.st = nullptr;
    if (!MK_PER_PHASE) bar = xcd_barrier_post((unsigned*)(ctl + CW_BAR), MISC + 8);
    const int lo = args.ph_lo, hi = args.ph_hi;
#ifndef PH_MASK
#define PH_MASK 0xFFF
#endif
#define IN(k) (((PH_MASK >> (k)) & 1) && lo <= (k) && (k) < hi)
#ifndef DBL_BAR
#define DBL_BAR 0
#endif
#define SEAM(k) do { if (IN(k) && IN((k) + 1)) { xcd_barrier(bar); if (DBL_BAR) xcd_barrier(bar); } } while (0)
#ifndef DBL_MASK
#define DBL_MASK 0
#endif
#define REP(k) for (int rep_ = 0; rep_ < 1 + ((DBL_MASK >> (k)) & 1); ++rep_)
#define PHASE_TID() int tid = tid0; asm volatile("" : "+v"(tid)); const int lane = tid & 63, wave = __builtin_amdgcn_readfirstlane(tid >> 6); (void)lane; (void)wave

    if (IN(0)) REP(0) {
        PHASE_TID();
        const bool conv_first = ((bx >> 3) & 1) == 0;
#pragma unroll 1
        for (int part = 0; part < 2; ++part) {
            if ((part == 0) == conv_first) {
                int tid = tid0; asm volatile("" : "+v"(tid)); const int lane = tid & 63, wave = __builtin_amdgcn_readfirstlane(tid >> 6);
                LAS float* scr = (LAS float*)(lds + wave * 16384);
                const int gw = bx * NWAVES + wave, NGW = G * NWAVES;
                constexpr int I_IN = (D / 64) * (IN_W / 32), I_SQ = (D / 64) * (D / 32);
                for (int it = gw; it < I_IN + 3 * I_SQ; it += NGW) {
                    int r = it;
                    if (r < I_IN) { p0_transpose_item(w_in, D, IN_W, WinT, scr, r, lane); continue; } r -= I_IN;
                    if (r < I_SQ) { p0_transpose_item(w_ao, D, D, WaT, scr, r, lane); continue; } r -= I_SQ;
                    if (r < I_SQ) { p0_transpose_item(w_co, D, D, WcT, scr, r, lane); continue; } r -= I_SQ;
                    p0_transpose_item(w_o, D, D, WoT, scr, r, lane);
                }
                for (int r = gw; r < M; r += NGW) row_f32_to_i8(x_in + (size_t)r * D, XA8 + (size_t)r * D, SXA + r, lane);
                __syncthreads();
            }
            if (part == 0) for (int it = bx; it < 16 * 32; it += G) p0_wf_item(w_q, sub_keys, WfT, lds, it, tid);
        }
    }
    SEAM(0);
    if (IN(1)) REP(1) {
        { PHASE_TID();
          for (int r = bx * NWAVES + wave; r < IN_W + D; r += G * NWAVES) { if (r < IN_W) row_bf16_to_i8(WinT + (size_t)r * D, WIN8 + (size_t)r * D, SWIN + r, lane);
              else { const int q = r - IN_W; row_bf16_to_i8(WfT + (size_t)q * D, WF8 + (size_t)q * D, SWF + q, lane); } } }
        if (!MK_PER_PHASE) xcd_barrier(bar);
        pg8::Gemm g{(const bf16*)XA8, (const bf16*)WIN8, M, IN_W, D / 2}; ConvOrder S; S.init(M, IN_W, G, bx);
        S.pu = peer_u; S.pv = peer_v; S.u8 = U8; S.v8 = V8; S.su = SU; S.sv = SV; S.calls = 0;
        S.slot = (G == 256 && bx >= 64) ? bx - 64 : -1;
        pg8::EpiI8Bf16 E{Z, IN_W, SXA, SWIN};
        pg8::gemm_phase<pg8::EpiI8Bf16, ConvOrder, true, true, true>(lds, g, S, E);
        if (G != 256) {
            PHASE_TID();
            for (int r = bx * NWAVES + wave; r < 2 * PNE; r += G * NWAVES) { const bool sec = r >= PNE; const int e = sec ? r - PNE : r;
                if (sec) row_to_fp8(peer_v + (size_t)e * D, V8 + (size_t)e * 256, SV + e, lane); else row_to_i8(peer_u + (size_t)e * D, U8 + (size_t)e * 256, SU + e, lane); }
        }
    }
    SEAM(1);
    if (IN(2)) REP(2) {
        PHASE_TID();
        const bool conv_first = ((bx >> 3) & 1) == 0;
#pragma unroll 1
        for (int part = 0; part < 2; ++part) {
            if ((part == 0) == conv_first) { int t2 = tid0; asm volatile("" : "+v"(t2)); for (int it = bx; it < M / 32; it += G) conv_item(it, Z, conv_w, CI, t2); }
            if (part == 0) for (int u = bx; u < BATCH * NKVH * 16; u += G) attn_unit(u, Z, AO, sinks, lds, tid);
        }
    }
    SEAM(2);
    if (IN(3)) REP(3) {
        TwoPassOrder S; S.init(M, D, G, bx);
#ifndef P3_I8
#define P3_I8 1
#endif
        if (P3_I8 && !MK_PER_PHASE) {
            { PHASE_TID();
              for (int r = bx * NWAVES + wave; r < 2 * M + 2 * D; r += G * NWAVES) {
                  if (r < M) row_bf16_to_i8(AO + (size_t)r * D, AO8 + (size_t)r * D, SAO + r, lane);
                  else if (r < 2 * M) { const int q = r - M; row_bf16_to_i8(CI + (size_t)q * D, CI8 + (size_t)q * D, SCI + q, lane); }
                  else if (r < 2 * M + D) { const int q = r - 2 * M; row_bf16_to_i8(WaT + (size_t)q * D, WA8 + (size_t)q * D, SWA + q, lane); }
                  else { const int q = r - 2 * M - D; row_bf16_to_i8(WcT + (size_t)q * D, WC8 + (size_t)q * D, SWC + q, lane); } } }
            xcd_barrier(bar);
            pg8::Gemm g{(const bf16*)AO8, (const bf16*)WA8, M, D, D / 2, (const bf16*)CI8, (const bf16*)WC8};
            EpiGate2I8 E{pg8::EpiGateI8<0>{TMP, nullptr, Z + G_OFF, b_gate, D, IN_W, SAO, SWA}, pg8::EpiGateI8<1>{MERGED, TMP, Z + G_OFF + D, b_gate + D, D, IN_W, SCI, SWC}};
            pg8::gemm_phase<EpiGate2I8, TwoPassOrder, true, true, true>(lds, g, S, E);
        } else {
        pg8::Gemm g{AO, WaT, M, D, D, CI, WcT};
        EpiGate2 E{pg8::EpiGate<0>{TMP, nullptr, Z + G_OFF, b_gate, D, IN_W}, pg8::EpiGate<1>{MERGED, TMP, Z + G_OFF + D, b_gate + D, D, IN_W}};
        pg8::gemm_phase<EpiGate2, TwoPassOrder, true, true>(lds, g, S, E);
        }
    }
    SEAM(3);
    if (IN(4)) REP(4) {
        pg8::Gemm g{MERGED, WoT, M, D, D}; pg8::StaticOrder S; S.init(M, D, G, bx);
        pg8::EpiResBf16 E{H1B, D, x_in, ALPHA};
        pg8::gemm_phase<pg8::EpiResBf16, pg8::StaticOrder, true, true>(lds, g, S, E);
    }
    SEAM(4);
    if (IN(5)) REP(5) {
        PHASE_TID();
        const int gw = bx * NWAVES + wave, NGW = G * NWAVES;
        for (int m = gw; m < M; m += NGW) ln1_row(H1B + (size_t)m * D, XQ + (size_t)m * D, SX + m, ln1_g, ln1_b, lane);
    }
    SEAM(5);
    if (IN(6)) REP(6) {
        pg8::Gemm g{H1B, WfT, M, D, D}; pg8::StaticOrder S; S.init(M, D, G, bx);
#ifndef P6_I8
#define P6_I8 1
#endif
        if (G == 256 && P6_I8) { pg8::Gemm g8{(const bf16*)XQ, (const bf16*)WF8, M, D, D / 2}; EpiTopKI8 E{EX, GT, SX, SWF}; pg8::gemm_phase<EpiTopKI8, pg8::StaticOrder, false, true, true>(lds, g8, S, E); }
        else if (G == 256) { EpiTopK E{EX, GT}; pg8::gemm_phase<EpiTopK, pg8::StaticOrder, false, true>(lds, g, S, E); }
        else { pg8::EpiF32 E{SC, D, nullptr, 0.f}; pg8::gemm_phase<pg8::EpiF32, pg8::StaticOrder, true, true>(lds, g, S, E); }
    }
    if (G != 256) SEAM(6);
    if (IN(7)) REP(7) {
        PHASE_TID();
        if (G != 256) for (int p = bx; p < (M * PH) / 128; p += G) topk_pass(p, SC, EX, GT, lds, tid);
    }
    SEAM(7);
    if (IN(8)) REP(8) {
        PHASE_TID();
        const int xcc = (int)(xb_xcc_id() & 7u);
#pragma unroll 1
#ifndef SCRAMBLE
#define SCRAMBLE 0
#endif
        for (int sl = 0; sl < 8; ++sl) { const int s = (xcc + sl + (SCRAMBLE ? wave : 0)) & 7;
            for (;;) { const int tg = q_pull((unsigned*)(ctl + CW_Q + 64 * (s + 16 * rep_)), lane); if (tg >= PEER_NTASK) break;
                int t0, nt; peer_task_tokens(tg, t0, nt); peer_a_task(t0, nt, s, XQ, EX, U8, PA, lane); } }
    }
    SEAM(8);
    if (IN(9)) REP(9) {
        PHASE_TID();
        for (size_t i = (size_t)bx * NTHREADS + tid; i < (size_t)M * 128; i += (size_t)G * NTHREADS) peer_w_elem(i, EX, GT, SU, SV, SX, PA, WB);
    }
    SEAM(9);
    if (IN(10)) REP(10) {
        PHASE_TID();
        const int xcc = (int)(xb_xcc_id() & 7u);
#pragma unroll 1
#ifndef SCRAMBLE
#define SCRAMBLE 0
#endif
        for (int sl = 0; sl < 8; ++sl) { const int s = (xcc + sl + (SCRAMBLE ? wave : 0)) & 7;
            for (;;) { const int tg = q_pull((unsigned*)(ctl + CW_Q + 64 * (8 + s + 16 * rep_)), lane); if (tg >= PEER_NTASK) break;
                int t0, nt; peer_task_tokens(tg, t0, nt); peer_b_task(t0, nt, s, H1B, EX, WB, V8, R2B, ST, lane); } }
    }
    SEAM(10);
    if (IN(11)) REP(11) {
        PHASE_TID();
        const int gw = bx * NWAVES + wave, NGW = G * NWAVES;
        for (int t = gw; t < M; t += NGW) peer_c_row(t, R2B, args.out, ST, ln2_g, ln2_b, lane);
    }
#undef IN
#undef SEAM
}

extern "C" void kernel_launch(void* const* d_in, const int* in_sizes, int n_in, void* d_out, int out_size, void* d_ws, size_t ws_size, hipStream_t stream) {
    static int grid = 0;
    if (grid == 0) {
        if (n_in != 16 || out_size != M * D || ws_size < WS_END) { fprintf(stderr, "kernel_launch: unexpected shapes (n_in %d out %d ws %zu)\n", n_in, out_size, ws_size); grid = -1; return; }
        int dev = 0, cus = 0, per_cu = 0;
        if (hipGetDevice(&dev) != hipSuccess || hipDeviceGetAttribute(&cus, hipDeviceAttributeMultiprocessorCount, dev) != hipSuccess) { grid = -1; return; }
        if (hipFuncSetAttribute((const void*)mk_fwd, hipFuncAttributeMaxDynamicSharedMemorySize, LDS_BYTES) != hipSuccess) { fprintf(stderr, "kernel_launch: hipFuncSetAttribute failed\n"); grid = -1; return; }
        if (hipOccupancyMaxActiveBlocksPerMultiprocessor(&per_cu, (const void*)mk_fwd, NTHREADS, LDS_BYTES) != hipSuccess || per_cu < 1) { fprintf(stderr, "kernel_launch: occupancy query says %d\n", per_cu); per_cu = 1; }
        (void)hipGetLastError();
        if (per_cu > 1) per_cu = 1;
        grid = cus * per_cu;
    }
    if (grid < 0) return;
    if (hipMemsetAsync((char*)d_ws + WS_CTL, 0, CTL_ZERO_BYTES, stream) != hipSuccess) { fprintf(stderr, "kernel_launch: memset failed\n"); return; }
    Args a{};
    for (int i = 0; i < 16; ++i) a.in[i] = (const float*)d_in[i];
    a.out = (float*)d_out; a.ws = (unsigned char*)d_ws;
#if MK_PER_PHASE
    for (int p = 0; p < N_PHASES; ++p) { a.ph_lo = p; a.ph_hi = p + 1; hipLaunchKernelGGL(mk_fwd, dim3(grid), dim3(NTHREADS), LDS_BYTES, stream, a); }
#else
    a.ph_lo = 0; a.ph_hi = N_PHASES;
    void* kargs[] = {&a};
#ifdef PLAIN_LAUNCH
    (void)kargs; hipLaunchKernelGGL(mk_fwd, dim3(grid), dim3(NTHREADS), LDS_BYTES, stream, a); hipError_t e = hipPeekAtLastError();
#else
    hipError_t e = hipLaunchCooperativeKernel((const void*)mk_fwd, dim3(grid), dim3(NTHREADS), kargs, LDS_BYTES, stream);
#endif
    if (e != hipSuccess) fprintf(stderr, "kernel_launch: cooperative launch failed: %s (grid %d)\n", hipGetErrorString(e), grid);
#endif
}
```

```cpp
#include <hip/hip_runtime.h>
#include <cstdio>
#include <cstdint>
#include <type_traits>
namespace pg8 {
#define PG8_LAS __attribute__((address_space(3)))
typedef unsigned short bf16_t;
typedef short bf16x8 __attribute__((ext_vector_type(8)));
typedef float f32x4 __attribute__((ext_vector_type(4)));
typedef unsigned u32x4 __attribute__((ext_vector_type(4)));
constexpr int BM = 256, BK = 64, HALF = 128, HTB = HALF * BK * 2  , STAGE_BYTES = 8 * HTB, NXCD = 8, WGM = 8;

__host__ __device__ __forceinline__ int lds_byte(int r, int c) { const int st = (r >> 4) * 2 + (c >> 5), rr = r & 15, cc = c & 31, ob = rr * 64 + cc * 2; return st * 1024 + (ob ^ (((ob >> 9) & 1) << 5)); }
__host__ __device__ __forceinline__ void stage_rc(int b, int& R, int& C) { const int st = b / 1024, sb = b % 1024, swz = sb ^ (((sb >> 9) & 1) << 5); R = (st >> 1) * 16 + swz / 64; C = (st & 1) * 32 + (swz % 64) / 2; }
__host__ __device__ __forceinline__ int perm32(int rho) { const int n = rho >> 4, i = rho & 15; return 8 * (i >> 2) + 4 * n + (i & 3); }

struct Unit { int pm, pn, w; };
struct Gemm { const bf16_t* A; const bf16_t* Bt; int M, N, K; const bf16_t* A2 = nullptr; const bf16_t* Bt2 = nullptr; };

struct StaticOrder {
    int nM, nN, nwg, G, c;
    __host__ __device__ void init(int M, int N, int G_, int c_) { nM = M / BM; nN = N / BM; nwg = nM * nN; G = G_; c = c_; }
    __host__ __device__ bool next(int i, Unit& u) const {
        const long L = (long)i * G + c; if (L >= nwg) return false;
        int wgid = (int)L; { const int q = nwg / NXCD, r = nwg % NXCD, xcd = wgid % NXCD, off = wgid / NXCD; wgid = (xcd < r ? xcd * (q + 1) : r * (q + 1) + (xcd - r) * q) + off; }
        const int nig = WGM * nN, gid = wgid / nig, fm = gid * WGM, gsz = (nM - fm) < WGM ? (nM - fm) : WGM;
        u.pm = fm + ((wgid % nig) % gsz); u.pn = (wgid % nig) / gsz; u.w = 0; return true;
    }
    __device__ __forceinline__ void a_ready(const Unit&) const {}
    __device__ __forceinline__ void done(const Unit&) const {}
};


__device__ __forceinline__ unsigned cvt_pk_bf16(float lo, float hi) { unsigned r; asm volatile("v_cvt_pk_bf16_f32 %0, %1, %2" : "=v"(r) : "v"(lo), "v"(hi)); return r; }
__device__ __forceinline__ float bf_lo(unsigned w) { return __builtin_bit_cast(float, w << 16); }
__device__ __forceinline__ float bf_hi(unsigned w) { return __builtin_bit_cast(float, w & 0xffff0000u); }
__device__ __forceinline__ float sigmoidf_(float x) { return __builtin_amdgcn_rcpf(1.0f + __expf(-x)); }

struct EpiBf16 {
    static constexpr bool PERM = true, AFTER_DRAIN = false;
    bf16_t* O; int ldc;
    __device__ __forceinline__ void operator()(const f32x4 (&acc)[2][2][4][2], const Unit& u, int wr, int wc, int fr, int fq) const {
        const int row0 = u.pm * BM + wr * 64 + fr, col0 = u.pn * BM + wc * 32 + 8 * fq;
#pragma unroll
        for (int ai = 0; ai < 2; ++ai)
#pragma unroll
            for (int m = 0; m < 4; ++m) { bf16_t* rowp = O + (size_t)(row0 + ai * HALF + m * 16) * ldc + col0;
#pragma unroll
                for (int bj = 0; bj < 2; ++bj) { const f32x4 v0 = acc[ai][bj][m][0], v1 = acc[ai][bj][m][1];
                    u32x4 w; w.x = cvt_pk_bf16(v0[0], v0[1]); w.y = cvt_pk_bf16(v0[2], v0[3]); w.z = cvt_pk_bf16(v1[0], v1[1]); w.w = cvt_pk_bf16(v1[2], v1[3]);
                    *(u32x4*)(rowp + bj * HALF) = w; } }
    }
};
template <int SECOND> struct EpiGate {
    static constexpr bool PERM = true, AFTER_DRAIN = false;
    bf16_t* O; const bf16_t* T; const bf16_t* Zg; const float* bg; int ldc, ldz;
    __device__ __forceinline__ void operator()(const f32x4 (&acc)[2][2][4][2], const Unit& u, int wr, int wc, int fr, int fq) const {
        const int row0 = u.pm * BM + wr * 64 + fr, col0 = u.pn * BM + wc * 32 + 8 * fq;
        f32x4 bv[2][2];
#pragma unroll
        for (int bj = 0; bj < 2; ++bj)
#pragma unroll
            for (int n = 0; n < 2; ++n) bv[bj][n] = *(const f32x4*)(bg + col0 + bj * HALF + 4 * n);
#pragma unroll
        for (int ai = 0; ai < 2; ++ai)
#pragma unroll
            for (int m = 0; m < 4; ++m) { const size_t row = (size_t)(row0 + ai * HALF + m * 16);
#pragma unroll
                for (int bj = 0; bj < 2; ++bj) { const int c = col0 + bj * HALF;
                    const u32x4 zg = *(const u32x4*)(Zg + row * ldz + c);
                    f32x4 v0 = acc[ai][bj][m][0], v1 = acc[ai][bj][m][1];
                    v0[0] *= sigmoidf_(bf_lo(zg.x) + bv[bj][0][0]); v0[1] *= sigmoidf_(bf_hi(zg.x) + bv[bj][0][1]);
                    v0[2] *= sigmoidf_(bf_lo(zg.y) + bv[bj][0][2]); v0[3] *= sigmoidf_(bf_hi(zg.y) + bv[bj][0][3]);
                    v1[0] *= sigmoidf_(bf_lo(zg.z) + bv[bj][1][0]); v1[1] *= sigmoidf_(bf_hi(zg.z) + bv[bj][1][1]);
                    v1[2] *= sigmoidf_(bf_lo(zg.w) + bv[bj][1][2]); v1[3] *= sigmoidf_(bf_hi(zg.w) + bv[bj][1][3]);
                    if (SECOND) { const u32x4 t = *(const u32x4*)(T + row * ldc + c);
                        v0[0] += bf_lo(t.x); v0[1] += bf_hi(t.x); v0[2] += bf_lo(t.y); v0[3] += bf_hi(t.y);
                        v1[0] += bf_lo(t.z); v1[1] += bf_hi(t.z); v1[2] += bf_lo(t.w); v1[3] += bf_hi(t.w); }
                    u32x4 w; w.x = cvt_pk_bf16(v0[0], v0[1]); w.y = cvt_pk_bf16(v0[2], v0[3]); w.z = cvt_pk_bf16(v1[0], v1[1]); w.w = cvt_pk_bf16(v1[2], v1[3]);
                    *(u32x4*)(O + row * ldc + c) = w; } }
    }
};
struct EpiF32 {
    static constexpr bool PERM = false, AFTER_DRAIN = false;
    float* C; int ldc; const float* R; float scale;
    __device__ __forceinline__ void operator()(const f32x4 (&acc)[2][2][4][2], const Unit& u, int wr, int wc, int fr, int fq) const {
        const int row0 = u.pm * BM + wr * 64 + fr, col0 = u.pn * BM + wc * 32 + 4 * fq;
#pragma unroll
        for (int ai = 0; ai < 2; ++ai)
#pragma unroll
            for (int m = 0; m < 4; ++m) { const size_t off = (size_t)(row0 + ai * HALF + m * 16) * ldc + col0;
#pragma unroll
                for (int bj = 0; bj < 2; ++bj)
#pragma unroll
                    for (int n = 0; n < 2; ++n) { f32x4 v = acc[ai][bj][m][n];
                        if (R) v += *(const f32x4*)(R + off + bj * HALF + n * 16) * scale;
                        *(f32x4*)(C + off + bj * HALF + n * 16) = v; } }
    }
};
struct EpiResBf16 {
    static constexpr bool PERM = true, AFTER_DRAIN = false;
    bf16_t* O; int ldc; const float* R; float scale;
    __device__ __forceinline__ void operator()(const f32x4 (&acc)[2][2][4][2], const Unit& u, int wr, int wc, int fr, int fq) const {
        const int row0 = u.pm * BM + wr * 64 + fr, col0 = u.pn * BM + wc * 32 + 8 * fq;
#pragma unroll
        for (int ai = 0; ai < 2; ++ai)
#pragma unroll
            for (int m = 0; m < 4; ++m) { const size_t off = (size_t)(row0 + ai * HALF + m * 16) * ldc + col0;
#pragma unroll
                for (int bj = 0; bj < 2; ++bj) { const f32x4 r0 = *(const f32x4*)(R + off + bj * HALF), r1 = *(const f32x4*)(R + off + bj * HALF + 4);
                    const f32x4 v0 = acc[ai][bj][m][0] + r0 * scale, v1 = acc[ai][bj][m][1] + r1 * scale;
                    u32x4 w; w.x = cvt_pk_bf16(v0[0], v0[1]); w.y = cvt_pk_bf16(v0[2], v0[3]); w.z = cvt_pk_bf16(v1[0], v1[1]); w.w = cvt_pk_bf16(v1[2], v1[3]);
                    *(u32x4*)(O + off + bj * HALF) = w; } }
    }
};
typedef int i32x4e __attribute__((ext_vector_type(4)));
struct EpiI8Bf16 {
    static constexpr bool PERM = true, AFTER_DRAIN = false;
    bf16_t* O; int ldc; const float* sa; const float* sb;
    __device__ __forceinline__ void operator()(const i32x4e (&acc)[2][2][4][2], const Unit& u, int wr, int wc, int fr, int fq) const {
        const int row0 = u.pm * BM + wr * 64 + fr, col0 = u.pn * BM + wc * 32 + 8 * fq;
        f32x4 sbv[2][2];
#pragma unroll
        for (int bj = 0; bj < 2; ++bj)
#pragma unroll
            for (int n = 0; n < 2; ++n) sbv[bj][n] = *(const f32x4*)(sb + col0 + bj * HALF + 4 * n);
#pragma unroll
        for (int ai = 0; ai < 2; ++ai)
#pragma unroll
            for (int m = 0; m < 4; ++m) { const int row = row0 + ai * HALF + m * 16; const float sr = sa[row]; bf16_t* rowp = O + (size_t)row * ldc + col0;
#pragma unroll
                for (int bj = 0; bj < 2; ++bj) { const i32x4e a0 = acc[ai][bj][m][0], a1 = acc[ai][bj][m][1];
                    const f32x4 v0 = (f32x4){(float)a0[0], (float)a0[1], (float)a0[2], (float)a0[3]} * sbv[bj][0] * sr, v1 = (f32x4){(float)a1[0], (float)a1[1], (float)a1[2], (float)a1[3]} * sbv[bj][1] * sr;
                    u32x4 w; w.x = cvt_pk_bf16(v0[0], v0[1]); w.y = cvt_pk_bf16(v0[2], v0[3]); w.z = cvt_pk_bf16(v1[0], v1[1]); w.w = cvt_pk_bf16(v1[2], v1[3]);
                    *(u32x4*)(rowp + bj * HALF) = w; } }
    }
};
template <int SECOND> struct EpiGateI8 {
    static constexpr bool PERM = true, AFTER_DRAIN = false;
    bf16_t* O; const bf16_t* T; const bf16_t* Zg; const float* bg; int ldc, ldz; const float* sa; const float* sb;
    __device__ __forceinline__ void operator()(const i32x4e (&acc)[2][2][4][2], const Unit& u, int wr, int wc, int fr, int fq) const {
        const int row0 = u.pm * BM + wr * 64 + fr, col0 = u.pn * BM + wc * 32 + 8 * fq;
        f32x4 bv[2][2], sbv[2][2];
#pragma unroll
        for (int bj = 0; bj < 2; ++bj)
#pragma unroll
            for (int n = 0; n < 2; ++n) { bv[bj][n] = *(const f32x4*)(bg + col0 + bj * HALF + 4 * n); sbv[bj][n] = *(const f32x4*)(sb + col0 + bj * HALF + 4 * n); }
#pragma unroll
        for (int ai = 0; ai < 2; ++ai)
#pragma unroll
            for (int m = 0; m < 4; ++m) { const size_t row = (size_t)(row0 + ai * HALF + m * 16); const float sr = sa[row];
#pragma unroll
                for (int bj = 0; bj < 2; ++bj) { const int c = col0 + bj * HALF;
                    const u32x4 zg = *(const u32x4*)(Zg + row * ldz + c);
                    const i32x4e a0 = acc[ai][bj][m][0], a1 = acc[ai][bj][m][1];
                    f32x4 v0 = (f32x4){(float)a0[0], (float)a0[1], (float)a0[2], (float)a0[3]} * sbv[bj][0] * sr, v1 = (f32x4){(float)a1[0], (float)a1[1], (float)a1[2], (float)a1[3]} * sbv[bj][1] * sr;
                    v0[0] *= sigmoidf_(bf_lo(zg.x) + bv[bj][0][0]); v0[1] *= sigmoidf_(bf_hi(zg.x) + bv[bj][0][1]);
                    v0[2] *= sigmoidf_(bf_lo(zg.y) + bv[bj][0][2]); v0[3] *= sigmoidf_(bf_hi(zg.y) + bv[bj][0][3]);
                    v1[0] *= sigmoidf_(bf_lo(zg.z) + bv[bj][1][0]); v1[1] *= sigmoidf_(bf_hi(zg.z) + bv[bj][1][1]);
                    v1[2] *= sigmoidf_(bf_lo(zg.w) + bv[bj][1][2]); v1[3] *= sigmoidf_(bf_hi(zg.w) + bv[bj][1][3]);
                    if (SECOND) { const u32x4 t = *(const u32x4*)(T + row * ldc + c);
                        v0[0] += bf_lo(t.x); v0[1] += bf_hi(t.x); v0[2] += bf_lo(t.y); v0[3] += bf_hi(t.y);
                        v1[0] += bf_lo(t.z); v1[1] += bf_hi(t.z); v1[2] += bf_lo(t.w); v1[3] += bf_hi(t.w); }
                    u32x4 w; w.x = cvt_pk_bf16(v0[0], v0[1]); w.y = cvt_pk_bf16(v0[2], v0[3]); w.z = cvt_pk_bf16(v1[0], v1[1]); w.w = cvt_pk_bf16(v1[2], v1[3]);
                    *(u32x4*)(O + row * ldc + c) = w; } }
    }
};
struct EpiResI8Bf16 {
    static constexpr bool PERM = true, AFTER_DRAIN = false;
    bf16_t* O; int ldc; const float* R; float scale; const float* sa; const float* sb;
    __device__ __forceinline__ void operator()(const i32x4e (&acc)[2][2][4][2], const Unit& u, int wr, int wc, int fr, int fq) const {
        const int row0 = u.pm * BM + wr * 64 + fr, col0 = u.pn * BM + wc * 32 + 8 * fq;
        f32x4 sbv[2][2];
#pragma unroll
        for (int bj = 0; bj < 2; ++bj)
#pragma unroll
            for (int n = 0; n < 2; ++n) sbv[bj][n] = *(const f32x4*)(sb + col0 + bj * HALF + 4 * n);
#pragma unroll
        for (int ai = 0; ai < 2; ++ai)
#pragma unroll
            for (int m = 0; m < 4; ++m) { const int row = row0 + ai * HALF + m * 16; const float sr = sa[row]; const size_t off = (size_t)row * ldc + col0;
#pragma unroll
                for (int bj = 0; bj < 2; ++bj) { const f32x4 r0 = *(const f32x4*)(R + off + bj * HALF), r1 = *(const f32x4*)(R + off + bj * HALF + 4);
                    const i32x4e a0 = acc[ai][bj][m][0], a1 = acc[ai][bj][m][1];
                    const f32x4 v0 = (f32x4){(float)a0[0], (float)a0[1], (float)a0[2], (float)a0[3]} * sbv[bj][0] * sr + r0 * scale, v1 = (f32x4){(float)a1[0], (float)a1[1], (float)a1[2], (float)a1[3]} * sbv[bj][1] * sr + r1 * scale;
                    u32x4 w; w.x = cvt_pk_bf16(v0[0], v0[1]); w.y = cvt_pk_bf16(v0[2], v0[3]); w.z = cvt_pk_bf16(v1[0], v1[1]); w.w = cvt_pk_bf16(v1[2], v1[3]);
                    *(u32x4*)(O + off + bj * HALF) = w; } }
    }
};

typedef int i32x4 __attribute__((ext_vector_type(4)));
template <class E, class = void> struct epi_chains : std::false_type {};
template <class E> struct epi_chains<E, std::void_t<decltype(E::CHAIN)>> : std::true_type {};
template <class Epi, class Sched, bool ALIGN_EPI = false, bool SP2 = false, bool I8 = false>
__device__ __forceinline__ void gemm_phase(PG8_LAS unsigned char* lds, const Gemm g, const Sched& S, const Epi& E) {
    int tid_ = threadIdx.x; asm volatile("" : "+v"(tid_));
    const int tid = tid_, wid = __builtin_amdgcn_readfirstlane(tid >> 6), lane = tid & 63, wr = wid >> 2, wc = wid & 3, fr = lane & 15, fq = lane >> 4;
    const int K = g.K, nt = K / BK;
    unsigned voffA[2], voffB[2];
#pragma unroll
    for (int i = 0; i < 2; ++i) { int R, C; stage_rc(tid * 16 + i * 8192, R, C); const int Rb = Epi::PERM ? ((R & ~31) + perm32(R & 31)) : R;
        voffA[i] = (unsigned)(R * K + C) * 2u; voffB[i] = (unsigned)(Rb * K + C) * 2u; }
    const size_t kstep = (size_t)(BK * 2);
    const size_t hstep = (size_t)HALF * K * 2;
    const size_t tstep = 2 * hstep;
    const unsigned ldsw = (unsigned)wid * 1024u;
    const int aoff = lds_byte(wr * 64 + fr, fq * 8), boff = lds_byte(wc * 32 + fr, fq * 8);
#define PG8_SA(b, h) (((b) * 2 + (h)) * HTB)
#define PG8_SB(b, h) ((4 + (b) * 2 + (h)) * HTB)
#define PG8_STAGE(bufoff, gbase, voff) do { _Pragma("unroll") for (int _i = 0; _i < 2; ++_i) \
        __builtin_amdgcn_global_load_lds((const unsigned*)((const char*)(gbase) + (voff)[_i]), (PG8_LAS unsigned*)(lds + (bufoff) + ldsw + _i * 8192), 16, 0, 0); } while (0)
#define PG8_LDA(dst, b, h) do { _Pragma("unroll") for (int m = 0; m < 4; ++m) _Pragma("unroll") for (int k = 0; k < 2; ++k) dst[m][k] = *(const PG8_LAS bf16x8*)(lds + PG8_SA(b, h) + aoff + m * 2048 + k * 1024); } while (0)
#define PG8_LDB(dst, b, h) do { _Pragma("unroll") for (int n = 0; n < 2; ++n) _Pragma("unroll") for (int k = 0; k < 2; ++k) dst[n][k] = *(const PG8_LAS bf16x8*)(lds + PG8_SB(b, h) + boff + n * 2048 + k * 1024); } while (0)
#define PG8_MMA(ai, bj, At, Bt) do { __builtin_amdgcn_s_setprio(1); _Pragma("unroll") for (int m = 0; m < 4; ++m) _Pragma("unroll") for (int n = 0; n < 2; ++n) _Pragma("unroll") for (int k = 0; k < 2; ++k) \
        { if constexpr (I8) acc[ai][bj][m][n] = __builtin_bit_cast(acc_t, __builtin_amdgcn_mfma_i32_16x16x64_i8(__builtin_bit_cast(i32x4, Bt[n][k]), __builtin_bit_cast(i32x4, At[m][k]), __builtin_bit_cast(i32x4, acc[ai][bj][m][n]), 0, 0, 0)); \
          else acc[ai][bj][m][n] = __builtin_bit_cast(acc_t, __builtin_amdgcn_mfma_f32_16x16x32_bf16(Bt[n][k], At[m][k], __builtin_bit_cast(f32x4, acc[ai][bj][m][n]), 0, 0, 0)); } __builtin_amdgcn_s_setprio(0); } while (0)
#define PG8_WAIT_V(n) asm volatile("s_waitcnt vmcnt(" #n ")" ::: "memory")
#define PG8_WAIT_L(n) asm volatile("s_waitcnt lgkmcnt(" #n ")" ::: "memory")
#define PG8_BAR __builtin_amdgcn_s_barrier()
#define PG8_SCHED __builtin_amdgcn_sched_barrier(0)
    Unit cur, nxt; int ui = 0;
    if (!S.next(0, cur)) return;
    typedef typename std::conditional<I8, i32x4, f32x4>::type acc_t;
    acc_t acc[2][2][4][2];
#pragma unroll
    for (int a = 0; a < 2; ++a)
#pragma unroll
        for (int b = 0; b < 2; ++b)
#pragma unroll
            for (int m = 0; m < 4; ++m)
#pragma unroll
                for (int n = 0; n < 2; ++n) acc[a][b][m][n] = acc_t{};
    bf16x8 At[4][2], B0[2][2], B1[2][2];
    const char* cA = (const char*)(cur.w ? g.A2 : g.A) + (size_t)cur.pm * tstep; const char* cB = (const char*)(cur.w ? g.Bt2 : g.Bt) + (size_t)cur.pn * tstep;
    S.a_ready(cur);
    if constexpr (SP2) {
        PG8_STAGE(PG8_SB(0, 0), cB, voffB); PG8_STAGE(PG8_SB(0, 1), cB + hstep, voffB); PG8_STAGE(PG8_SA(0, 0), cA, voffA); PG8_STAGE(PG8_SA(0, 1), cA + hstep, voffA);
        if (wr == 1) PG8_BAR;
        PG8_WAIT_V(2); PG8_BAR;
        PG8_STAGE(PG8_SB(1, 0), cB + kstep, voffB); PG8_STAGE(PG8_SA(1, 0), cA + kstep, voffA); PG8_STAGE(PG8_SB(1, 1), cB + hstep + kstep, voffB);
        PG8_WAIT_V(6); PG8_BAR;
    } else {
        PG8_STAGE(PG8_SB(0, 0), cB, voffB); PG8_STAGE(PG8_SA(0, 0), cA, voffA); PG8_STAGE(PG8_SB(0, 1), cB + hstep, voffB); PG8_STAGE(PG8_SA(0, 1), cA + hstep, voffA);
        if (wr == 1) PG8_BAR;
        PG8_WAIT_V(4); PG8_BAR;
        PG8_STAGE(PG8_SB(1, 0), cB + kstep, voffB); PG8_STAGE(PG8_SA(1, 0), cA + kstep, voffA); PG8_STAGE(PG8_SB(1, 1), cB + hstep + kstep, voffB);
        PG8_WAIT_V(6); PG8_BAR;
    }
    for (;;) {
        const bool has_next = S.next(ui + 1, nxt);
        const char* nA = has_next ? (const char*)(nxt.w ? g.A2 : g.A) + (size_t)nxt.pm * tstep : cA; const char* nB = has_next ? (const char*)(nxt.w ? g.Bt2 : g.Bt) + (size_t)nxt.pn * tstep : cB;
        for (int t = 0; t < nt; t += 2) {
            const bool last = (t == nt - 2);
            const char* a1 = cA + (size_t)(t + 1) * kstep;
            const char* a2 = last ? nA : cA + (size_t)(t + 2) * kstep; const char* b2 = last ? nB : cB + (size_t)(t + 2) * kstep;
            const char* a3 = a2 + kstep; const char* b3 = b2 + kstep;
            if (last && has_next) S.a_ready(nxt);
            if constexpr (SP2) {
            PG8_LDB(B0, 0, 0); PG8_LDB(B1, 0, 1); PG8_SCHED; PG8_LDA(At, 0, 0); PG8_STAGE(PG8_SA(1, 1), a1 + hstep, voffA);
            PG8_WAIT_V(8); PG8_WAIT_L(0); PG8_BAR; PG8_MMA(0, 0, At, B0); PG8_MMA(0, 1, At, B1); PG8_BAR; PG8_SCHED;
            PG8_LDA(At, 0, 1); PG8_STAGE(PG8_SB(0, 0), b2, voffB); PG8_STAGE(PG8_SB(0, 1), b2 + hstep, voffB); PG8_STAGE(PG8_SA(0, 0), a2, voffA);
            PG8_WAIT_V(8); PG8_WAIT_L(0); PG8_BAR; PG8_MMA(1, 0, At, B0); PG8_MMA(1, 1, At, B1); PG8_BAR; PG8_SCHED;
            PG8_LDB(B0, 1, 0); PG8_LDB(B1, 1, 1); PG8_SCHED; PG8_LDA(At, 1, 0); PG8_STAGE(PG8_SA(0, 1), a2 + hstep, voffA);
            PG8_WAIT_V(8); PG8_WAIT_L(0); PG8_BAR; PG8_MMA(0, 0, At, B0); PG8_MMA(0, 1, At, B1); PG8_BAR; PG8_SCHED;
            PG8_LDA(At, 1, 1); PG8_STAGE(PG8_SB(1, 0), b3, voffB); PG8_STAGE(PG8_SB(1, 1), b3 + hstep, voffB); PG8_STAGE(PG8_SA(1, 0), a3, voffA);
            PG8_WAIT_V(8); PG8_WAIT_L(0); PG8_BAR; PG8_MMA(1, 0, At, B0); PG8_MMA(1, 1, At, B1); PG8_BAR; PG8_SCHED;
            } else {
            PG8_LDB(B0, 0, 0); PG8_SCHED; PG8_LDA(At, 0, 0); PG8_STAGE(PG8_SA(1, 1), a1 + hstep, voffA);
            PG8_WAIT_L(8); PG8_BAR; PG8_WAIT_L(0); PG8_MMA(0, 0, At, B0); PG8_BAR; PG8_SCHED;
            PG8_LDB(B1, 0, 1); PG8_STAGE(PG8_SB(0, 0), b2, voffB);
            PG8_BAR; PG8_WAIT_L(0); PG8_MMA(0, 1, At, B1); PG8_BAR;
            PG8_LDA(At, 0, 1); PG8_STAGE(PG8_SA(0, 0), a2, voffA);
            PG8_BAR; PG8_WAIT_L(0); PG8_MMA(1, 0, At, B0); PG8_BAR; PG8_SCHED;
            PG8_STAGE(PG8_SB(0, 1), b2 + hstep, voffB);
            PG8_WAIT_V(6); PG8_BAR; PG8_MMA(1, 1, At, B1); PG8_BAR;
            PG8_LDB(B0, 1, 0); PG8_SCHED; PG8_LDA(At, 1, 0); PG8_STAGE(PG8_SA(0, 1), a2 + hstep, voffA);
            PG8_WAIT_L(8); PG8_BAR; PG8_WAIT_L(0); PG8_MMA(0, 0, At, B0); PG8_BAR; PG8_SCHED;
            PG8_LDB(B1, 1, 1); PG8_STAGE(PG8_SB(1, 0), b3, voffB);
            PG8_BAR; PG8_WAIT_L(0); PG8_MMA(0, 1, At, B1); PG8_BAR;
            PG8_LDA(At, 1, 1); PG8_STAGE(PG8_SA(1, 0), a3, voffA);
            PG8_BAR; PG8_WAIT_L(0); PG8_MMA(1, 0, At, B0); PG8_BAR; PG8_SCHED;
            PG8_STAGE(PG8_SB(1, 1), b3 + hstep, voffB);
            PG8_WAIT_V(6); PG8_BAR; PG8_MMA(1, 1, At, B1); PG8_BAR;
            }
        }
        if constexpr (ALIGN_EPI) { if (wr == 0) PG8_BAR; }
        bool keep_acc = false;
        if constexpr (!Epi::AFTER_DRAIN) { if constexpr (epi_chains<Epi>::value) keep_acc = E.chain(acc, cur, wr, wc, fr, fq); else E(acc, cur, wr, wc, fr, fq); S.done(cur); }
        if (!has_next) break;
        if (!keep_acc) {
#pragma unroll
        for (int a = 0; a < 2; ++a)
#pragma unroll
            for (int b = 0; b < 2; ++b)
#pragma unroll
                for (int m = 0; m < 4; ++m)
#pragma unroll
                    for (int n = 0; n < 2; ++n) acc[a][b][m][n] = acc_t{};
        }
        cur = nxt; cA = nA; cB = nB; ++ui;
        if constexpr (ALIGN_EPI) { if (wr == 1) PG8_BAR; }
    }
    PG8_WAIT_V(0);
    if constexpr (!ALIGN_EPI) { if (wr == 0) PG8_BAR; }
    PG8_BAR;
    if constexpr (Epi::AFTER_DRAIN) { E.fused(acc, cur, wr, wc, fr, fq, lds, wid, lane); S.done(cur); }
#undef PG8_SA
#undef PG8_SB
#undef PG8_STAGE
#undef PG8_LDA
#undef PG8_LDB
#undef PG8_MMA
#undef PG8_WAIT_V
#undef PG8_WAIT_L
#undef PG8_BAR
#undef PG8_SCHED
}
}
#define GAS __attribute__((address_space(1)))
#define LAS __attribute__((address_space(3)))
typedef unsigned short bf16;
typedef unsigned v4u __attribute__((ext_vector_type(4)));
typedef float f32x4 __attribute__((ext_vector_type(4)));
typedef short bf16x8 __attribute__((ext_vector_type(8)));
typedef GAS unsigned gu32;
typedef GAS unsigned long long gu64;
#define RLX_AGENT __ATOMIC_RELAXED, __HIP_MEMORY_SCOPE_AGENT
#define LDS_WAIT() asm volatile("s_waitcnt lgkmcnt(0)" ::: "memory")
#define VM_WAIT() asm volatile("s_waitcnt vmcnt(0)" ::: "memory")
__device__ __forceinline__ unsigned long long rt() { return __builtin_amdgcn_s_memrealtime(); }
__device__ __forceinline__ unsigned f2bf(float f) { unsigned u = __builtin_bit_cast(unsigned, f); return (u + 0x7fffu + ((u >> 16) & 1u)) >> 16; }
__device__ __forceinline__ unsigned pk2(float lo, float hi) { return f2bf(lo) | (f2bf(hi) << 16); }

#define XB_TMO      128
#define XB_XCNT(j)  (256  + 64 * (j))
#define XB_XSUB(j)  (1280 + 64 * (j))
#define XB_XGEN(j)  (2304 + 64 * (j))
#define XB_TOP      3328
#define XB_TOPGEN   3392
#define XCD_BAR_WORDS 3456
#define XB_SPIN_CAP (1u << 18)

__device__ __forceinline__ unsigned xb_ld(unsigned* p)              { return __hip_atomic_load(p, __ATOMIC_RELAXED, __HIP_MEMORY_SCOPE_AGENT); }
__device__ __forceinline__ unsigned xb_add(unsigned* p, unsigned v) { return __hip_atomic_fetch_add(p, v, __ATOMIC_RELAXED, __HIP_MEMORY_SCOPE_AGENT); }
__device__ __forceinline__ unsigned xb_xcc_id() { return (unsigned)__builtin_amdgcn_s_getreg((3 << 11) | 20) & 0xFu; }
#define XB_SPIN(cond, bar) do { unsigned _sp = 0; while (cond) { __builtin_amdgcn_s_sleep(1); \
    if ((++_sp & 255u) == 0u) { if (xb_ld(&(bar)[XB_TMO])) break; if (_sp > XB_SPIN_CAP) { atomicAdd(&(bar)[XB_TMO], 1u); break; } } } } while (0)

struct XcdBarrier {
    unsigned* bar; unsigned x;
    volatile LAS unsigned* st;
};

__device__ __forceinline__ XcdBarrier xcd_barrier_post(unsigned* bar, volatile LAS unsigned* st) {
    XcdBarrier b; b.bar = bar; b.x = xb_xcc_id(); b.st = st;
    if (threadIdx.x == 0) (void)xb_add(&bar[XB_XCNT(b.x)], 1u);
    return b;
}
__device__ __forceinline__ void xcd_barrier_complete(unsigned* bar, unsigned x, unsigned& nloc, unsigned& nx) {
    const unsigned G = gridDim.x * gridDim.y * gridDim.z;
    unsigned sum, cnt, mine, sp = 0u;
    for (;;) {
        sum = 0u; cnt = 0u; mine = 0u;
#pragma unroll
        for (unsigned j = 0; j < 16; ++j) { const unsigned c = xb_ld(&bar[XB_XCNT(j)]); sum += c; cnt += (c > 0u) ? 1u : 0u; mine = (j == x) ? c : mine; }
        if (sum == G) break;
        __builtin_amdgcn_s_sleep(1);
        if ((++sp & 255u) == 0u) { if (xb_ld(&bar[XB_TMO])) break; if (sp > XB_SPIN_CAP) { atomicAdd(&bar[XB_TMO], 1u); break; } }
    }
    nloc = mine > 0u ? mine : 1u; nx = cnt > 0u ? cnt : 1u;
}

__device__ __forceinline__ void xcd_barrier(const XcdBarrier& b) {
    asm volatile("s_waitcnt vmcnt(0)" ::: "memory");
    __syncthreads();
    if (threadIdx.x == 0) {
        unsigned* bar = b.bar;
        __builtin_amdgcn_s_waitcnt(0);
        unsigned nloc = b.st[0], nx = b.st[1];
        if (nloc == 0u) { xcd_barrier_complete(bar, b.x, nloc, nx); b.st[0] = nloc; b.st[1] = nx; }
        const unsigned old = xb_add(&bar[XB_XSUB(b.x)], 1u);
        const unsigned gen = old / nloc;
        if (old + 1u == (gen + 1u) * nloc) {
            __builtin_amdgcn_fence(__ATOMIC_RELEASE, "agent");
            asm volatile("s_waitcnt vmcnt(0)" ::: "memory");
            const unsigned og = xb_add(&bar[XB_TOP], 1u);
            const unsigned tg = og / nx;
            if (og + 1u == (tg + 1u) * nx) xb_add(&bar[XB_TOPGEN], 1u);
            else XB_SPIN(xb_ld(&bar[XB_TOPGEN]) == tg, bar);
            __builtin_amdgcn_fence(__ATOMIC_ACQUIRE, "agent");
            xb_add(&bar[XB_XGEN(b.x)], 1u);
            asm volatile("s_waitcnt vmcnt(0)" ::: "memory");
        } else {
            XB_SPIN(xb_ld(&bar[XB_XGEN(b.x)]) == gen, bar);
            __builtin_amdgcn_fence(__ATOMIC_ACQUIRE, "agent");
            asm volatile("s_waitcnt vmcnt(0)" ::: "memory");
        }
    }
    __syncthreads();
}

constexpr int NWAVES = 8, NTHREADS = 512;
constexpr int BATCH = 4, SEQ = 2048, D = 2048, M = BATCH * SEQ;
constexpr int NQH = 32, NKVH = 4, HD = 64, QPKV = 8, WINDOW = 128;
constexpr int Q_OFF = 0, K_OFF = 2048, V_OFF = 2304, CB_OFF = 2560, CC_OFF = 4608, CH_OFF = 6656, G_OFF = 8704, IN_W = 12800;
constexpr int PH = 8, PNK = 128, PTOPK = 16, PNE = 16384;
constexpr float LN_EPS = 1e-5f;
constexpr float ALPHA = 1.189207115002721f;

#ifndef MK_PER_PHASE
#define MK_PER_PHASE 0
#endif
constexpr int N_PHASES = 12;

constexpr size_t MiB = 1u << 20;
constexpr size_t WS_CTL = 0, CTL_ZERO_BYTES = 1 * MiB;
constexpr size_t WS_WIN = 1 * MiB;
constexpr size_t WS_WA = 51 * MiB, WS_WC = 59 * MiB, WS_WO = 67 * MiB, WS_WF = 75 * MiB;
constexpr size_t WS_XB = 83 * MiB;
constexpr size_t WS_MERGED = WS_XB;
constexpr size_t WS_Z = 115 * MiB;
constexpr size_t WS_R2B = 115 * MiB;
constexpr size_t WS_H1B = 179 * MiB;
constexpr size_t WS_SC = 211 * MiB;
constexpr size_t WS_EX = 275 * MiB;
constexpr size_t WS_GT = 279 * MiB;
constexpr size_t WS_AO = 315 * MiB, WS_CI = 347 * MiB, WS_TMP = 379 * MiB;
constexpr size_t WS_U8 = 411 * MiB, WS_V8 = 443 * MiB;
constexpr size_t WS_SU = 475 * MiB, WS_SV = WS_SU + 65536;
constexpr size_t WS_PA = WS_SC;
constexpr size_t WS_XQ = 283 * MiB;
constexpr size_t WS_SX = 299 * MiB;
constexpr size_t WS_WB = 380 * MiB;
constexpr size_t WS_ST = 379 * MiB;
constexpr size_t WS_XA8 = WS_XB;
constexpr size_t WS_WIN8 = 476 * MiB;
constexpr size_t WS_SWIN = 501 * MiB, WS_SXA = WS_SWIN + 65536;
constexpr size_t WS_AO8 = 1 * MiB, WS_CI8 = 17 * MiB, WS_WA8 = 33 * MiB, WS_WC8 = 37 * MiB, WS_S3 = 41 * MiB;
constexpr size_t WS_WF8 = 502 * MiB;
constexpr size_t WS_SWF = WS_SXA + 65536;
constexpr size_t WS_MG8 = 1 * MiB;
constexpr size_t WS_WO8 = 506 * MiB;
constexpr size_t WS_SMG = WS_S3 + 262144, WS_SWO = WS_SWF + 16384;
constexpr size_t WS_END = 510 * MiB;
constexpr int CW_Q = 12288;
constexpr size_t SLICE_BYTES = (size_t)PNE * 256;
constexpr int CW_BAR = 4096;

constexpr int RING_BYTES = 131072;
constexpr int LDSCTL_OFF = 147456, MISC_OFF = LDSCTL_OFF + 320;
constexpr int LDS_BYTES = LDSCTL_OFF + 512;

typedef float f32x16 __attribute__((ext_vector_type(16)));
typedef unsigned v2u __attribute__((ext_vector_type(2)));
__device__ __forceinline__ float wave_sum(float v) {
#pragma unroll
    for (int o = 1; o < 64; o <<= 1) v += __shfl_xor(v, o);
    return v;
}
__device__ __forceinline__ float vmaxf(float a, float b) { float r; asm("v_max_f32_e32 %0, %1, %2" : "=v"(r) : "v"(a), "v"(b)); return r; }
__device__ __forceinline__ float vminf(float a, float b) { float r; asm("v_min_f32_e32 %0, %1, %2" : "=v"(r) : "v"(a), "v"(b)); return r; }

__device__ __forceinline__ void p0_transpose_item(const float* W, int K, int N, bf16* WT, LAS float* scr, int item, int lane) {
    const int nblk = N / 32, kb = item / nblk, nb = item % nblk, k0 = 64 * kb, n0 = 32 * nb;
#pragma unroll 8
    for (int i = 0; i < 32; ++i) { const int kk = 2 * i + (lane >> 5); scr[kk * 33 + (lane & 31)] = W[(size_t)(k0 + kk) * N + n0 + (lane & 31)]; }
    LDS_WAIT(); asm volatile("" ::: "memory");
    const int c = lane & 7;
#pragma unroll
    for (int j = 0; j < 4; ++j) { const int n = (lane >> 3) + 8 * j; const LAS float* s = scr + (8 * c) * 33 + n;
        v4u o; o.x = pk2(s[0 * 33], s[1 * 33]); o.y = pk2(s[2 * 33], s[3 * 33]); o.z = pk2(s[4 * 33], s[5 * 33]); o.w = pk2(s[6 * 33], s[7 * 33]);
        *(GAS v4u*)(WT + (size_t)(n0 + n) * K + k0 + 8 * c) = o; }
    LDS_WAIT(); asm volatile("" ::: "memory");
}
__device__ __forceinline__ void p0_wf_item(const float* wq, const float* sk, bf16* WfT, LAS unsigned char* lds, int item, int tid) {
    const int hp = item >> 5, dt = item & 31;
    LAS f32x4* SK4 = (LAS f32x4*)lds;
    LAS f32x4* WQ4 = SK4 + 128 * 33;
    const float* skp = sk + (size_t)hp * 128 * 128;
    for (int i = tid; i < 128 * 32; i += NTHREADS) { const int n = i >> 5, c4 = i & 31; SK4[n * 33 + c4] = *(const f32x4*)(skp + n * 128 + 4 * c4); }
    for (int i = tid; i < 64 * 32; i += NTHREADS) { const int r = i >> 5, c4 = i & 31; WQ4[r * 33 + c4] = *(const f32x4*)(wq + (size_t)(64 * dt + r) * 2048 + hp * 128 + 4 * c4); }
    __syncthreads();
    const int td = tid & 15, tn = tid >> 4;
    float acc[4][4];
#pragma unroll
    for (int i = 0; i < 4; ++i)
#pragma unroll
        for (int j = 0; j < 4; ++j) acc[i][j] = 0.f;
#pragma unroll 4
    for (int c4 = 0; c4 < 32; ++c4) {
        f32x4 a[4], b[4];
#pragma unroll
        for (int i = 0; i < 4; ++i) a[i] = SK4[(4 * tn + i) * 33 + c4];
#pragma unroll
        for (int j = 0; j < 4; ++j) b[j] = WQ4[(td + 16 * j) * 33 + c4];
#pragma unroll
        for (int i = 0; i < 4; ++i)
#pragma unroll
            for (int j = 0; j < 4; ++j) acc[i][j] += a[i].x * b[j].x + a[i].y * b[j].y + a[i].z * b[j].z + a[i].w * b[j].w;
    }
#pragma unroll
    for (int i = 0; i < 4; ++i)
#pragma unroll
        for (int j = 0; j < 4; ++j) WfT[(size_t)(hp * 128 + 4 * tn + i) * 2048 + 64 * dt + td + 16 * j] = (bf16)f2bf(acc[i][j]);
    __syncthreads();
}

__device__ __forceinline__ int perm16(int o) { return 8 * ((o >> 2) & 1) + 4 * (o >> 3) + (o & 3); }
__device__ __forceinline__ void attn_unit(int unit, const bf16* z, bf16* ao, const float* sinks, LAS unsigned char* lds, int tid) {
    const int lane = tid & 63, wid = __builtin_amdgcn_readfirstlane(tid >> 6), r32 = lane & 31, hi = lane >> 5;
    const int nb = unit & 15, kvh = (unit >> 4) & 3, b = unit >> 6;
    LAS bf16* Ks = (LAS bf16*)lds;
    LAS bf16* Vt = (LAS bf16*)(lds + 256 * 144);
    const size_t tok0 = (size_t)b * SEQ;
#pragma unroll
    for (int i = 0; i < 4; ++i) {
        const int ci = tid + NTHREADS * i, key = ci >> 3, dc = ci & 7;
        int kpos = 128 * (nb - 1) + key; if (kpos < 0) kpos = 0;
        const bf16* src = z + (tok0 + kpos) * IN_W + K_OFF + kvh * HD + dc * 8;
        const v4u kv = *(const GAS v4u*)src, vv = *(const GAS v4u*)(src + (V_OFF - K_OFF));
        *(LAS v4u*)(Ks + key * 72 + dc * 8) = kv;
        const int pos = (key & ~15) + perm16(key & 15);
        LAS bf16* vp = Vt + (dc * 8) * 264 + pos;
        vp[0 * 264] = (bf16)(vv.x & 0xffffu); vp[1 * 264] = (bf16)(vv.x >> 16); vp[2 * 264] = (bf16)(vv.y & 0xffffu); vp[3 * 264] = (bf16)(vv.y >> 16);
        vp[4 * 264] = (bf16)(vv.z & 0xffffu); vp[5 * 264] = (bf16)(vv.z >> 16); vp[6 * 264] = (bf16)(vv.w & 0xffffu); vp[7 * 264] = (bf16)(vv.w >> 16);
    }
    __syncthreads();
    const int hq = kvh * QPKV + wid;
    const float LOG2E = 1.4426950408889634f;
    const float sink2 = sinks[hq] * LOG2E, sc = 0.125f * LOG2E;
#pragma unroll 1
    for (int qg = 0; qg < 4; ++qg) {
        const size_t tok = tok0 + 128 * nb + 32 * qg + r32;
        bf16x8 qf[4];
#pragma unroll
        for (int ks = 0; ks < 4; ++ks) qf[ks] = *(const GAS bf16x8*)(z + tok * IN_W + Q_OFF + hq * HD + 16 * ks + 8 * hi);
        f32x16 s[5];
#pragma unroll
        for (int kt = 0; kt < 5; ++kt) {
            s[kt] = (f32x16){0.f, 0.f, 0.f, 0.f, 0.f, 0.f, 0.f, 0.f, 0.f, 0.f, 0.f, 0.f, 0.f, 0.f, 0.f, 0.f};
#pragma unroll
            for (int ks = 0; ks < 4; ++ks) {
                const bf16x8 kf = *(const LAS bf16x8*)(Ks + (32 * (qg + kt) + r32) * 72 + 16 * ks + 8 * hi);
                s[kt] = __builtin_amdgcn_mfma_f32_32x32x16_bf16(kf, qf[ks], s[kt], 0, 0, 0);
            }
        }
        float mx = sink2;
#pragma unroll
        for (int kt = 0; kt < 5; ++kt) {
            const bool tile_dead = (nb == 0) && (qg + kt < 4);
#pragma unroll
            for (int r = 0; r < 16; ++r) {
                const int krow = (r & 3) + 8 * (r >> 2) + 4 * hi;
                bool valid = !tile_dead;
                if (kt == 0) valid = valid && (krow > r32);
                if (kt == 4) valid = valid && (krow <= r32);
                const float v = valid ? s[kt][r] * sc : -INFINITY;
                s[kt][r] = v; mx = fmaxf(mx, v);
            }
        }
        mx = fmaxf(mx, __shfl_xor(mx, 32));
        float sum = 0.f;
#pragma unroll
        for (int kt = 0; kt < 5; ++kt)
#pragma unroll
            for (int r = 0; r < 16; ++r) { const float p = __builtin_amdgcn_exp2f(s[kt][r] - mx); s[kt][r] = p; sum += p; }
        sum += __shfl_xor(sum, 32);
        const float inv = 1.0f / (sum + __builtin_amdgcn_exp2f(sink2 - mx));
        f32x16 o[2];
        o[0] = (f32x16){0.f, 0.f, 0.f, 0.f, 0.f, 0.f, 0.f, 0.f, 0.f, 0.f, 0.f, 0.f, 0.f, 0.f, 0.f, 0.f}; o[1] = o[0];
#pragma unroll
        for (int kt = 0; kt < 5; ++kt)
#pragma unroll
            for (int s2 = 0; s2 < 2; ++s2) {
                v4u pw; pw.x = pg8::cvt_pk_bf16(s[kt][8 * s2 + 0], s[kt][8 * s2 + 1]); pw.y = pg8::cvt_pk_bf16(s[kt][8 * s2 + 2], s[kt][8 * s2 + 3]);
                pw.z = pg8::cvt_pk_bf16(s[kt][8 * s2 + 4], s[kt][8 * s2 + 5]); pw.w = pg8::cvt_pk_bf16(s[kt][8 * s2 + 6], s[kt][8 * s2 + 7]);
                const bf16x8 pa = __builtin_bit_cast(bf16x8, pw);
#pragma unroll
                for (int dt = 0; dt < 2; ++dt) {
                    const bf16x8 vf = *(const LAS bf16x8*)(Vt + (32 * dt + r32) * 264 + 32 * (qg + kt) + 16 * s2 + 8 * hi);
                    o[dt] = __builtin_amdgcn_mfma_f32_32x32x16_bf16(vf, pa, o[dt], 0, 0, 0);
                }
            }
        bf16* op = ao + tok * D + hq * HD;
#pragma unroll
        for (int dt = 0; dt < 2; ++dt)
#pragma unroll
            for (int g = 0; g < 4; ++g) {
                v2u w; w.x = pg8::cvt_pk_bf16(o[dt][4 * g + 0] * inv, o[dt][4 * g + 1] * inv); w.y = pg8::cvt_pk_bf16(o[dt][4 * g + 2] * inv, o[dt][4 * g + 3] * inv);
                *(GAS v2u*)(op + 32 * dt + 8 * g + 4 * hi) = w;
            }
    }
    __syncthreads();
}
__device__ __forceinline__ void conv_item(int item, const bf16* z, const float* cw, bf16* ci, int tid) {
    const int c8 = tid & 255, half = tid >> 8, t0 = 32 * item + 16 * half, c0 = 8 * c8;
    float w0[8], w1[8], w2[8], u1[8], u2[8];
#pragma unroll
    for (int e = 0; e < 8; ++e) { w0[e] = cw[c0 + e]; w1[e] = cw[2048 + c0 + e]; w2[e] = cw[4096 + c0 + e]; u1[e] = 0.f; u2[e] = 0.f; }
    if ((t0 & (SEQ - 1)) != 0) {
#pragma unroll
        for (int k = 0; k < 2; ++k) {
            const bf16* zr = z + (size_t)(t0 - 2 + k) * IN_W + c0;
            const v4u a = *(const GAS v4u*)(zr + CC_OFF), h = *(const GAS v4u*)(zr + CH_OFF);
            float u[8];
            u[0] = pg8::bf_lo(a.x) * pg8::bf_lo(h.x); u[1] = pg8::bf_hi(a.x) * pg8::bf_hi(h.x); u[2] = pg8::bf_lo(a.y) * pg8::bf_lo(h.y); u[3] = pg8::bf_hi(a.y) * pg8::bf_hi(h.y);
            u[4] = pg8::bf_lo(a.z) * pg8::bf_lo(h.z); u[5] = pg8::bf_hi(a.z) * pg8::bf_hi(h.z); u[6] = pg8::bf_lo(a.w) * pg8::bf_lo(h.w); u[7] = pg8::bf_hi(a.w) * pg8::bf_hi(h.w);
#pragma unroll
            for (int e = 0; e < 8; ++e) { if (k == 0) u2[e] = u[e]; else u1[e] = u[e]; }
        }
    }
#pragma unroll 4
    for (int i = 0; i < 16; ++i) {
        const bf16* zr = z + (size_t)(t0 + i) * IN_W + c0;
        const v4u a = *(const GAS v4u*)(zr + CC_OFF), h = *(const GAS v4u*)(zr + CH_OFF), bb = *(const GAS v4u*)(zr + CB_OFF);
        float u[8], cb[8], y[8];
        u[0] = pg8::bf_lo(a.x) * pg8::bf_lo(h.x); u[1] = pg8::bf_hi(a.x) * pg8::bf_hi(h.x); u[2] = pg8::bf_lo(a.y) * pg8::bf_lo(h.y); u[3] = pg8::bf_hi(a.y) * pg8::bf_hi(h.y);
        u[4] = pg8::bf_lo(a.z) * pg8::bf_lo(h.z); u[5] = pg8::bf_hi(a.z) * pg8::bf_hi(h.z); u[6] = pg8::bf_lo(a.w) * pg8::bf_lo(h.w); u[7] = pg8::bf_hi(a.w) * pg8::bf_hi(h.w);
        cb[0] = pg8::bf_lo(bb.x); cb[1] = pg8::bf_hi(bb.x); cb[2] = pg8::bf_lo(bb.y); cb[3] = pg8::bf_hi(bb.y); cb[4] = pg8::bf_lo(bb.z); cb[5] = pg8::bf_hi(bb.z); cb[6] = pg8::bf_lo(bb.w); cb[7] = pg8::bf_hi(bb.w);
#pragma unroll
        for (int e = 0; e < 8; ++e) { y[e] = cb[e] * (w0[e] * u2[e] + w1[e] * u1[e] + w2[e] * u[e]); u2[e] = u1[e]; u1[e] = u[e]; }
        v4u o; o.x = pk2(y[0], y[1]); o.y = pk2(y[2], y[3]); o.z = pk2(y[4], y[5]); o.w = pk2(y[6], y[7]);
        *(GAS v4u*)(ci + (size_t)(t0 + i) * D + c0) = o;
    }
}

__device__ __forceinline__ unsigned pack_i8(const f32x4 v) {
    const int a = __float2int_rn(v.x), b = __float2int_rn(v.y), c = __float2int_rn(v.z), d = __float2int_rn(v.w);
    return ((unsigned)a & 0xffu) | (((unsigned)b & 0xffu) << 8) | (((unsigned)c & 0xffu) << 16) | ((unsigned)d << 24);
}
__device__ __forceinline__ unsigned pack_i8_2(float a, float b, float c, float d) {
    const int ia = __float2int_rn(a), ib = __float2int_rn(b), ic = __float2int_rn(c), id = __float2int_rn(d);
    return ((unsigned)ia & 0xffu) | (((unsigned)ib & 0xffu) << 8) | (((unsigned)ic & 0xffu) << 16) | ((unsigned)id << 24);
}
__device__ __forceinline__ void ln1_row(bf16* hbrow, signed char* xqrow, float* sxp, const float* g, const float* bta, int lane) {
    GAS v4u* xr = (GAS v4u*)hbrow + lane;
    float v[4][8]; float s = 0.f;
#pragma unroll
    for (int j = 0; j < 4; ++j) { const v4u w = xr[64 * j];
        v[j][0] = pg8::bf_lo(w.x); v[j][1] = pg8::bf_hi(w.x); v[j][2] = pg8::bf_lo(w.y); v[j][3] = pg8::bf_hi(w.y); v[j][4] = pg8::bf_lo(w.z); v[j][5] = pg8::bf_hi(w.z); v[j][6] = pg8::bf_lo(w.w); v[j][7] = pg8::bf_hi(w.w);
#pragma unroll
        for (int e = 0; e < 8; ++e) s += v[j][e]; }
    const float mean = wave_sum(s) * (1.f / D); float s2 = 0.f;
#pragma unroll
    for (int j = 0; j < 4; ++j)
#pragma unroll
        for (int e = 0; e < 8; ++e) { v[j][e] -= mean; s2 += v[j][e] * v[j][e]; }
    const float rstd = 1.f / sqrtf(wave_sum(s2) * (1.f / D) + LN_EPS);
    float mx = 0.f;
#pragma unroll
    for (int j = 0; j < 4; ++j) {
        const GAS f32x4* gp = (const GAS f32x4*)g + 2 * (lane + 64 * j); const GAS f32x4* bp = (const GAS f32x4*)bta + 2 * (lane + 64 * j);
        const f32x4 g0 = gp[0], g1 = gp[1], b0 = bp[0], b1 = bp[1];
        v[j][0] = v[j][0] * rstd * g0.x + b0.x; v[j][1] = v[j][1] * rstd * g0.y + b0.y; v[j][2] = v[j][2] * rstd * g0.z + b0.z; v[j][3] = v[j][3] * rstd * g0.w + b0.w;
        v[j][4] = v[j][4] * rstd * g1.x + b1.x; v[j][5] = v[j][5] * rstd * g1.y + b1.y; v[j][6] = v[j][6] * rstd * g1.z + b1.z; v[j][7] = v[j][7] * rstd * g1.w + b1.w;
        v4u o; o.x = pk2(v[j][0], v[j][1]); o.y = pk2(v[j][2], v[j][3]); o.z = pk2(v[j][4], v[j][5]); o.w = pk2(v[j][6], v[j][7]);
        xr[64 * j] = o;
#pragma unroll
        for (int e = 0; e < 8; ++e) mx = fmaxf(mx, fabsf(v[j][e]));
    }
#pragma unroll
    for (int o = 1; o < 64; o <<= 1) mx = fmaxf(mx, __shfl_xor(mx, o));
    const float qs = mx > 0.f ? 127.0f / mx : 1.0f;
    GAS v2u* q8 = (GAS v2u*)xqrow + lane;
#pragma unroll
    for (int j = 0; j < 4; ++j) { v2u o; o.x = pack_i8_2(v[j][0] * qs, v[j][1] * qs, v[j][2] * qs, v[j][3] * qs); o.y = pack_i8_2(v[j][4] * qs, v[j][5] * qs, v[j][6] * qs, v[j][7] * qs); q8[64 * j] = o; }
    if (lane == 0) *sxp = mx > 0.f ? mx * (1.0f / 127.0f) : 1.0f;
}

__device__ __forceinline__ void row_f32_to_i8(const float* src, signed char* dst, float* inv, int lane) {
    f32x4 v[8]; float mx = 0.f;
#pragma unroll
    for (int j = 0; j < 8; ++j) { v[j] = *((const GAS f32x4*)src + lane + 64 * j); mx = fmaxf(mx, fmaxf(fmaxf(fabsf(v[j].x), fabsf(v[j].y)), fmaxf(fabsf(v[j].z), fabsf(v[j].w)))); }
#pragma unroll
    for (int o = 1; o < 64; o <<= 1) mx = fmaxf(mx, __shfl_xor(mx, o));
    const float sc = mx > 0.f ? 127.0f / mx : 1.0f;
#pragma unroll
    for (int j = 0; j < 8; ++j) *((GAS unsigned*)dst + lane + 64 * j) = pack_i8_2(v[j].x * sc, v[j].y * sc, v[j].z * sc, v[j].w * sc);
    if (lane == 0) *inv = mx > 0.f ? mx * (1.0f / 127.0f) : 1.0f;
}
__device__ __forceinline__ void row_bf16_to_i8(const bf16* src, signed char* dst, float* inv, int lane) {
    float v[4][8]; float mx = 0.f;
#pragma unroll
    for (int j = 0; j < 4; ++j) { const v4u w = *((const GAS v4u*)src + lane + 64 * j);
        v[j][0] = pg8::bf_lo(w.x); v[j][1] = pg8::bf_hi(w.x); v[j][2] = pg8::bf_lo(w.y); v[j][3] = pg8::bf_hi(w.y); v[j][4] = pg8::bf_lo(w.z); v[j][5] = pg8::bf_hi(w.z); v[j][6] = pg8::bf_lo(w.w); v[j][7] = pg8::bf_hi(w.w);
#pragma unroll
        for (int e = 0; e < 8; ++e) mx = fmaxf(mx, fabsf(v[j][e])); }
#pragma unroll
    for (int o = 1; o < 64; o <<= 1) mx = fmaxf(mx, __shfl_xor(mx, o));
    const float sc = mx > 0.f ? 127.0f / mx : 1.0f;
#pragma unroll
    for (int j = 0; j < 4; ++j) { v2u o; o.x = pack_i8_2(v[j][0] * sc, v[j][1] * sc, v[j][2] * sc, v[j][3] * sc); o.y = pack_i8_2(v[j][4] * sc, v[j][5] * sc, v[j][6] * sc, v[j][7] * sc); *((GAS v2u*)dst + lane + 64 * j) = o; }
    if (lane == 0) *inv = mx > 0.f ? mx * (1.0f / 127.0f) : 1.0f;
}

constexpr int TK_ROWF = 136;
constexpr int TK_IDX_OFF = 256 * TK_ROWF * 4;
__device__ __forceinline__ void topk_core(LAS unsigned char* lds, size_t prob0, int pstride, int* experts, float* gates, int tid) {
    LAS float* S = (LAS float*)lds;
    LAS unsigned char* IDX = lds + TK_IDX_OFF;
    const int row = tid >> 1, sub = tid & 1;
#define TK_CE(a, b) do { const float h_ = vmaxf(a, b), l_ = vminf(a, b); a = h_; b = l_; } while (0)
#define TK_SORT16(V) do { _Pragma("unroll") for (int k_ = 2; k_ <= 16; k_ <<= 1) _Pragma("unroll") for (int j_ = k_ >> 1; j_ > 0; j_ >>= 1) _Pragma("unroll") for (int i_ = 0; i_ < 16; ++i_) { \
        const int l_i = i_ ^ j_; if (l_i > i_) { if ((i_ & k_) == 0) TK_CE(V[i_], V[l_i]); else TK_CE(V[l_i], V[i_]); } } } while (0)
#define TK_MERGE16(Lv, Xv) do { _Pragma("unroll") for (int j_ = 0; j_ < 16; ++j_) Lv[j_] = vmaxf(Lv[j_], Xv[15 - j_]); \
        _Pragma("unroll") for (int st_ = 8; st_ >= 1; st_ >>= 1) _Pragma("unroll") for (int j_ = 0; j_ < 16; ++j_) if ((j_ & st_) == 0) TK_CE(Lv[j_], Lv[j_ + st_]); } while (0)
    float L[16];
#pragma unroll
    for (int q = 0; q < 4; ++q) {
        float C[16];
#pragma unroll
        for (int i = 0; i < 4; ++i) { const int c4 = 2 * (4 * q + i) + sub;
            const f32x4 v = *(const LAS f32x4*)(S + row * TK_ROWF + 4 * c4);
#pragma unroll
            for (int e = 0; e < 4; ++e) { const float ve = v[e];
                C[4 * i + e] = __uint_as_float((__float_as_uint(ve) & ~0x7Fu) | (unsigned)(4 * c4 + e)); } }
        TK_SORT16(C);
        if (q == 0) {
#pragma unroll
            for (int j = 0; j < 16; ++j) L[j] = C[j];
        } else TK_MERGE16(L, C);
    }
    {
        float P[16];
#pragma unroll
        for (int j = 0; j < 16; ++j) P[j] = __shfl_xor(L[j], 1);
        TK_MERGE16(L, P);
    }
    if (sub == 0) {
#pragma unroll
        for (int q = 0; q < 4; ++q) {
            unsigned w = 0;
#pragma unroll
            for (int e = 0; e < 4; ++e) w |= (__builtin_bit_cast(unsigned, L[4 * q + e]) & 0x7Fu) << (8 * e);
            *(LAS unsigned*)(IDX + row * 16 + 4 * q) = w;
        }
    }
    float A[16], B[16];
#pragma unroll
    for (int j = 0; j < 16; ++j) { const float o = __shfl_xor(L[j], 2); const bool isb = (tid & 2) != 0; A[j] = isb ? o : L[j]; B[j] = isb ? L[j] : o; }
#define TK_KEY(i, j) __uint_as_float((__float_as_uint(A[i] + B[j]) & ~0xFFu) | (unsigned)(255 - ((i) * 16 + (j))))
    float F[16], X[16];
#pragma unroll
    for (int j = 0; j < 16; ++j) F[j] = TK_KEY(0, j);
#pragma unroll
    for (int i = 1; i < 16; ++i) X[i - 1] = TK_KEY(i, 0);
    X[15] = -INFINITY; TK_MERGE16(F, X);
#pragma unroll
    for (int i = 0; i < 16; ++i) X[i] = -INFINITY;
#pragma unroll
    for (int i = 1; i <= 7; ++i) X[i - 1] = TK_KEY(i, 1);
    TK_MERGE16(F, X);
#pragma unroll
    for (int i = 0; i < 16; ++i) X[i] = -INFINITY;
#pragma unroll
    for (int j = 2; j <= 7; ++j) X[j - 2] = TK_KEY(1, j);
    TK_MERGE16(F, X);
    { const float rest[6] = {TK_KEY(2, 2), TK_KEY(2, 3), TK_KEY(2, 4), TK_KEY(3, 2), TK_KEY(3, 3), TK_KEY(4, 2)};
#pragma unroll
      for (int r = 0; r < 6; ++r) { float x = rest[r];
#pragma unroll
          for (int k = 0; k < 16; ++k) { const float h = vmaxf(F[k], x); x = vminf(F[k], x); F[k] = h; } } }
    __syncthreads();
    if ((tid & 3) == 0) {
        const int rowA = (tid >> 2) * 2, rowB = rowA + 1;
        const size_t prob = prob0 + (size_t)pstride * (tid >> 2);
        float g[16]; int ex[16]; float gs = 0.f;
#pragma unroll
        for (int k = 0; k < 16; ++k) {
            const unsigned code = 255u - (__builtin_bit_cast(unsigned, F[k]) & 0xFFu);
            const int ia = IDX[rowA * 16 + (code >> 4)], ib = IDX[rowB * 16 + (code & 15)];
            ex[k] = ia * PNK + ib;
            g[k] = __expf(F[k] - F[0]); gs += g[k];
        }
        const float ginv = 1.0f / gs;
#pragma unroll
        for (int q = 0; q < 4; ++q) {
            *(GAS f32x4*)(gates + prob * 16 + 4 * q) = (f32x4){g[4 * q] * ginv, g[4 * q + 1] * ginv, g[4 * q + 2] * ginv, g[4 * q + 3] * ginv};
            typedef int i32x4 __attribute__((ext_vector_type(4)));
            *(GAS i32x4*)(experts + prob * 16 + 4 * q) = (i32x4){ex[4 * q], ex[4 * q + 1], ex[4 * q + 2], ex[4 * q + 3]};
        }
    }
    __syncthreads();
}
__device__ __forceinline__ void topk_pass(int pass, const float* scores, int* experts, float* gates, LAS unsigned char* lds, int tid) {
    LAS float* S = (LAS float*)lds;
    const float* src = scores + (size_t)pass * (256 * 128);
#pragma unroll 4
    for (int i = 0; i < 16; ++i) { const int f4 = tid + NTHREADS * i, row = f4 >> 5, c4 = f4 & 31; *(LAS f32x4*)(S + row * TK_ROWF + 4 * c4) = *(const GAS f32x4*)(src + (size_t)f4 * 4); }
    __syncthreads();
    topk_core(lds, (size_t)pass * 128, 1, experts, gates, tid);
}
struct EpiTopKI8 {
    static constexpr bool PERM = false, AFTER_DRAIN = true;
    int* experts; float* gates; const float* sa; const float* sb;
    __device__ __forceinline__ void fused(pg8::i32x4 (&acc)[2][2][4][2], const pg8::Unit& u, int wr, int wc, int fr, int fq, LAS unsigned char* lds, int wid, int lane) const {
        LAS float* S = (LAS float*)lds;
        const int tid = wid * 64 + lane;
        pg8::f32x4 sbv[2][2];
#pragma unroll
        for (int bj = 0; bj < 2; ++bj)
#pragma unroll
            for (int n = 0; n < 2; ++n) sbv[bj][n] = *(const GAS pg8::f32x4*)(sb + u.pn * 256 + bj * 128 + 32 * wc + 16 * n + 4 * fq);
#pragma unroll
        for (int ai = 0; ai < 2; ++ai) {
#pragma unroll
            for (int mm = 0; mm < 4; ++mm) { const int rl = 64 * wr + 16 * mm + fr; const float sr = sa[u.pm * 256 + 128 * ai + rl];
#pragma unroll
                for (int bj = 0; bj < 2; ++bj)
#pragma unroll
                    for (int n = 0; n < 2; ++n) { const pg8::i32x4 a = acc[ai][bj][mm][n];
                        *(LAS pg8::f32x4*)(S + (2 * rl + bj) * TK_ROWF + 32 * wc + 16 * n + 4 * fq) = (pg8::f32x4){(float)a[0], (float)a[1], (float)a[2], (float)a[3]} * sbv[bj][n] * sr; } }
            __syncthreads();
            topk_core(lds, ((size_t)u.pm * 256 + 128 * ai) * PH + u.pn, PH, experts, gates, tid);
        }
    }
};
struct EpiTopK {
    static constexpr bool PERM = false, AFTER_DRAIN = true;
    int* experts; float* gates;
    __device__ __forceinline__ void fused(pg8::f32x4 (&acc)[2][2][4][2], const pg8::Unit& u, int wr, int wc, int fr, int fq, LAS unsigned char* lds, int wid, int lane) const {
        LAS float* S = (LAS float*)lds;
        const int tid = wid * 64 + lane;
#pragma unroll
        for (int ai = 0; ai < 2; ++ai) {
#pragma unroll
            for (int bj = 0; bj < 2; ++bj)
#pragma unroll
                for (int mm = 0; mm < 4; ++mm)
#pragma unroll
                    for (int n = 0; n < 2; ++n) { const int rl = 64 * wr + 16 * mm + fr; *(LAS pg8::f32x4*)(S + (2 * rl + bj) * TK_ROWF + 32 * wc + 16 * n + 4 * fq) = acc[ai][bj][mm][n]; }
            __syncthreads();
            topk_core(lds, ((size_t)u.pm * 256 + 128 * ai) * PH + u.pn, PH, experts, gates, tid);
        }
    }
};

__device__ __forceinline__ float gelu_erf(float v) { return 0.5f * v * (1.0f + erff(v * 0.70710678118654752f)); }
typedef __bf16 bf16x2_t __attribute__((ext_vector_type(2)));
typedef float f32x2_t __attribute__((ext_vector_type(2)));
__device__ __forceinline__ float dot2bf(bf16x2_t a, unsigned b, float acc) { return __builtin_amdgcn_fdot2_f32_bf16(a, __builtin_bit_cast(bf16x2_t, b), acc, false); }
__device__ __forceinline__ float dot4f8(unsigned w8, unsigned x01, unsigned x23, float acc) {
    acc = dot2bf(__builtin_amdgcn_cvt_scalef32_pk_bf16_fp8(w8, 1.0f, false), x01, acc);
    return dot2bf(__builtin_amdgcn_cvt_scalef32_pk_bf16_fp8(w8, 1.0f, true), x23, acc);
}
__device__ __forceinline__ void axpy4f8(float* y, unsigned w8, float w) {
    const f32x2_t lo = __builtin_amdgcn_cvt_pk_f32_fp8(w8, false), hi = __builtin_amdgcn_cvt_pk_f32_fp8(w8, true);
    y[0] += w * lo.x; y[1] += w * lo.y; y[2] += w * hi.x; y[3] += w * hi.y;
}
__device__ __forceinline__ void axpy4f8v(f32x2_t* y2, unsigned w8, float w) {
    const f32x2_t lo = __builtin_amdgcn_cvt_pk_f32_fp8(w8, false), hi = __builtin_amdgcn_cvt_pk_f32_fp8(w8, true);
    const f32x2_t ww = {w, w};
    y2[0] = __builtin_elementwise_fma(lo, ww, y2[0]); y2[1] = __builtin_elementwise_fma(hi, ww, y2[1]);
}
__device__ __forceinline__ void row_to_fp8(const float* src, unsigned char* dst, float* inv, int lane) {
    f32x4 v[2][4]; float mx = 0.f;
#pragma unroll
    for (int j = 0; j < 2; ++j)
#pragma unroll
        for (int q = 0; q < 4; ++q) { v[j][q] = *((const GAS f32x4*)src + 4 * (lane + 64 * j) + q);
            mx = fmaxf(mx, fmaxf(fmaxf(fabsf(v[j][q].x), fabsf(v[j][q].y)), fmaxf(fabsf(v[j][q].z), fabsf(v[j][q].w)))); }
#pragma unroll
    for (int o = 1; o < 64; o <<= 1) mx = fmaxf(mx, __shfl_xor(mx, o));
    const float sc = mx > 0.f ? 384.0f / mx : 1.0f;
#pragma unroll
    for (int j = 0; j < 2; ++j) { v4u o;
        int w;
        w = 0; w = __builtin_amdgcn_cvt_pk_fp8_f32(v[j][0].x * sc, v[j][0].y * sc, w, false); w = __builtin_amdgcn_cvt_pk_fp8_f32(v[j][0].z * sc, v[j][0].w * sc, w, true); o.x = (unsigned)w;
        w = 0; w = __builtin_amdgcn_cvt_pk_fp8_f32(v[j][1].x * sc, v[j][1].y * sc, w, false); w = __builtin_amdgcn_cvt_pk_fp8_f32(v[j][1].z * sc, v[j][1].w * sc, w, true); o.y = (unsigned)w;
        w = 0; w = __builtin_amdgcn_cvt_pk_fp8_f32(v[j][2].x * sc, v[j][2].y * sc, w, false); w = __builtin_amdgcn_cvt_pk_fp8_f32(v[j][2].z * sc, v[j][2].w * sc, w, true); o.z = (unsigned)w;
        w = 0; w = __builtin_amdgcn_cvt_pk_fp8_f32(v[j][3].x * sc, v[j][3].y * sc, w, false); w = __builtin_amdgcn_cvt_pk_fp8_f32(v[j][3].z * sc, v[j][3].w * sc, w, true); o.w = (unsigned)w;
        { const int ch = lane + 64 * j; *((GAS v4u*)(dst + (size_t)(ch >> 4) * SLICE_BYTES) + (ch & 15)) = o; } }
    if (lane == 0) *inv = mx > 0.f ? mx * (1.0f / 384.0f) : 1.0f;
}
__device__ __forceinline__ void row_to_i8(const float* src, unsigned char* dst, float* inv, int lane) {
    f32x4 v[2][4]; float mx = 0.f;
#pragma unroll
    for (int j = 0; j < 2; ++j)
#pragma unroll
        for (int q = 0; q < 4; ++q) { v[j][q] = *((const GAS f32x4*)src + 4 * (lane + 64 * j) + q);
            mx = fmaxf(mx, fmaxf(fmaxf(fabsf(v[j][q].x), fabsf(v[j][q].y)), fmaxf(fabsf(v[j][q].z), fabsf(v[j][q].w)))); }
#pragma unroll
    for (int o = 1; o < 64; o <<= 1) mx = fmaxf(mx, __shfl_xor(mx, o));
    const float sc = mx > 0.f ? 127.0f / mx : 1.0f;
#pragma unroll
    for (int j = 0; j < 2; ++j) { v4u o; o.x = pack_i8(v[j][0] * sc); o.y = pack_i8(v[j][1] * sc); o.z = pack_i8(v[j][2] * sc); o.w = pack_i8(v[j][3] * sc);
        { const int ch = lane + 64 * j; *((GAS v4u*)(dst + (size_t)(ch >> 4) * SLICE_BYTES) + (ch & 15)) = o; } }
    if (lane == 0) *inv = mx > 0.f ? mx * (1.0f / 127.0f) : 1.0f;
}
__device__ __forceinline__ float row16_allsum(float a) {
    a += __builtin_bit_cast(float, __builtin_amdgcn_update_dpp(0, __builtin_bit_cast(int, a), 0x128, 0xf, 0xf, false));
    a += __builtin_bit_cast(float, __builtin_amdgcn_update_dpp(0, __builtin_bit_cast(int, a), 0x124, 0xf, 0xf, false));
    a += __builtin_bit_cast(float, __builtin_amdgcn_update_dpp(0, __builtin_bit_cast(int, a), 0x122, 0xf, 0xf, false));
    a += __builtin_bit_cast(float, __builtin_amdgcn_update_dpp(0, __builtin_bit_cast(int, a), 0x121, 0xf, 0xf, false));
    return a;
}
__device__ __forceinline__ int q_pull(unsigned* q, int lane) { int v = 0; if (lane == 0) v = (int)__hip_atomic_fetch_add(q, 1u, __ATOMIC_RELAXED, __HIP_MEMORY_SCOPE_AGENT); return __builtin_amdgcn_readfirstlane(v); }
constexpr int PEER_TG = 8;
constexpr int PEER_N8 = 640, PEER_N4 = 512, PEER_N2 = 512, PEER_NTASK = PEER_N8 + PEER_N4 + PEER_N2;
__device__ __forceinline__ void peer_task_tokens(int idx, int& t0, int& n) {
    if (idx < PEER_N8) { t0 = 8 * idx; n = 8; } else if (idx < PEER_N8 + PEER_N4) { t0 = 8 * PEER_N8 + 4 * (idx - PEER_N8); n = 4; } else { t0 = 8 * PEER_N8 + 4 * PEER_N4 + 2 * (idx - PEER_N8 - PEER_N4); n = 2; }
}
__device__ __forceinline__ int row16_allsum_i(int a) {
    a += __builtin_amdgcn_update_dpp(0, a, 0x128, 0xf, 0xf, false);
    a += __builtin_amdgcn_update_dpp(0, a, 0x124, 0xf, 0xf, false);
    a += __builtin_amdgcn_update_dpp(0, a, 0x122, 0xf, 0xf, false);
    a += __builtin_amdgcn_update_dpp(0, a, 0x121, 0xf, 0xf, false);
    return a;
}
#define PA_LOAD(R, IDV, HALF) do { _Pragma("unroll") for (int i_ = 0; i_ < 8; ++i_) { const unsigned e_ = (unsigned)__shfl(IDV, 4 * (i_ + 8 * (HALF)) + g); \
        R[i_] = *(const GAS v4u*)(ub + (e_ * 256u + offc)); } } while (0)
#define PA_COMP(R, HALF) do { _Pragma("unroll") for (int i_ = 0; i_ < 8; ++i_) { int a_ = __builtin_amdgcn_sdot4((int)R[i_].x, (int)xc.x, 0, false); a_ = __builtin_amdgcn_sdot4((int)R[i_].y, (int)xc.y, a_, false); \
        a_ = __builtin_amdgcn_sdot4((int)R[i_].z, (int)xc.z, a_, false); a_ = __builtin_amdgcn_sdot4((int)R[i_].w, (int)xc.w, a_, false); r16[8 * (HALF) + i_] = row16_allsum_i(a_); } } while (0)
__device__ __forceinline__ void peer_a_task(int t0, int ntok, int s, const signed char* xq, const int* experts, const unsigned char* u8s, int* pa, int lane_) {
    int lane = lane_; asm volatile("" : "+v"(lane));
    const int g = lane >> 4, c = lane & 15;
    const GAS unsigned char* ub = (const GAS unsigned char*)(u8s + (size_t)s * SLICE_BYTES);
    const unsigned offc = 16u * (unsigned)c;
    int idc0 = experts[(size_t)t0 * 128 + lane], idc1 = experts[(size_t)t0 * 128 + lane + 64];
    v4u xc = *(const GAS v4u*)(xq + (size_t)t0 * D + 256 * s + 16 * c);
    v4u RA[8], RB[8];
    PA_LOAD(RA, idc0, 0);
#pragma unroll 1
    for (int tt = 0; tt < ntok; ++tt) {
        const int t = t0 + tt, tn = tt + 1 < ntok ? t + 1 : t;
        const int idn0 = experts[(size_t)tn * 128 + lane], idn1 = experts[(size_t)tn * 128 + lane + 64];
        const v4u xn = *(const GAS v4u*)(xq + (size_t)tn * D + 256 * s + 16 * c);
#pragma unroll 1
        for (int hb = 0; hb < 2; ++hb) {
            const int idv = hb ? idc1 : idc0, idx = hb ? idn0 : idc1;
            int r16[16];
            PA_LOAD(RB, idv, 1); PA_COMP(RA, 0);
            asm volatile("" ::: "memory");
            PA_LOAD(RA, idx, 0); PA_COMP(RB, 1);
            if (c == 15) { typedef int i32x4 __attribute__((ext_vector_type(4))); GAS i32x4* dst = (GAS i32x4*)(pa + ((size_t)t * 8 + s) * 128 + g * 32 + 16 * hb);
#pragma unroll
                for (int q = 0; q < 4; ++q) dst[q] = (i32x4){r16[4 * q], r16[4 * q + 1], r16[4 * q + 2], r16[4 * q + 3]}; }
        }
        idc0 = idn0; idc1 = idn1; xc = xn;
    }
}
__device__ __forceinline__ void peer_w_elem(size_t i, const int* experts, const float* gates, const float* su, const float* sv, const float* sx, const int* pa, float* wb) {
    const size_t t = i >> 7; const int k = (int)(i & 127), pos = (k & 3) * 32 + (k >> 2);
    const int e = experts[i];
    int a = 0;
#pragma unroll
    for (int s2 = 0; s2 < 8; ++s2) a += pa[(t * 8 + s2) * 128 + pos];
    wb[i] = gates[i] * gelu_erf((float)a * (su[e] * sx[t])) * sv[e];
}
#define PB_LOAD(R, IDV, HALF) do { _Pragma("unroll") for (int i_ = 0; i_ < 8; ++i_) { const unsigned e_ = (unsigned)__shfl(IDV, 4 * (i_ + 8 * (HALF)) + g); \
        R[i_] = *(const GAS v4u*)(vb + (e_ * 256u + offc)); } } while (0)
#define PB_COMP(R, WV, HALF) do { _Pragma("unroll") for (int i_ = 0; i_ < 8; ++i_) { const float wk_ = __shfl(WV, 4 * (i_ + 8 * (HALF)) + g); \
        axpy4f8v(&ya2[0], R[i_].x, wk_); axpy4f8v(&ya2[2], R[i_].y, wk_); axpy4f8v(&ya2[4], R[i_].z, wk_); axpy4f8v(&ya2[6], R[i_].w, wk_); } } while (0)
__device__ __forceinline__ void peer_b_task(int t0, int ntok, int s, const bf16* h1, const int* experts, const float* wb, const unsigned char* v8s, bf16* out, float* st, int lane_) {
    int lane = lane_; asm volatile("" : "+v"(lane));
    const int g = lane >> 4, c = lane & 15;
    const GAS unsigned char* vb = (const GAS unsigned char*)(v8s + (size_t)s * SLICE_BYTES);
    const unsigned offc = 16u * (unsigned)c;
    int idc0 = experts[(size_t)t0 * 128 + lane], idc1 = experts[(size_t)t0 * 128 + lane + 64];
    float wc0 = wb[(size_t)t0 * 128 + lane], wc1 = wb[(size_t)t0 * 128 + lane + 64];
    v4u RA[8], RB[8];
    PB_LOAD(RA, idc0, 0);
#pragma unroll 1
    for (int tt = 0; tt < ntok; ++tt) {
        const int t = t0 + tt, tn = tt + 1 < ntok ? t + 1 : t;
        const int idn0 = experts[(size_t)tn * 128 + lane], idn1 = experts[(size_t)tn * 128 + lane + 64];
        const float wn0 = wb[(size_t)tn * 128 + lane], wn1 = wb[(size_t)tn * 128 + lane + 64];
        f32x2_t ya2[8];
#pragma unroll
        for (int e = 0; e < 8; ++e) ya2[e] = (f32x2_t){0.f, 0.f};
#pragma unroll 1
        for (int hb = 0; hb < 2; ++hb) {
            const int idv = hb ? idc1 : idc0, idx = hb ? idn0 : idc1; const float wv = hb ? wc1 : wc0;
            PB_LOAD(RB, idv, 1); PB_COMP(RA, wv, 0);
            asm volatile("" ::: "memory");
            PB_LOAD(RA, idx, 0); PB_COMP(RB, wv, 1);
        }
        float ya[16];
#pragma unroll
        for (int e = 0; e < 8; ++e) { ya[2 * e] = ya2[e].x; ya[2 * e + 1] = ya2[e].y; }
#pragma unroll
        for (int e = 0; e < 16; ++e) { ya[e] += __shfl_xor(ya[e], 16); ya[e] += __shfl_xor(ya[e], 32); }
        const GAS v4u* hp = (const GAS v4u*)(h1 + (size_t)t * D + 256 * s + 16 * c);
        const v4u h0 = hp[0], h1v = hp[1];
        float hx[16];
        hx[0] = pg8::bf_lo(h0.x); hx[1] = pg8::bf_hi(h0.x); hx[2] = pg8::bf_lo(h0.y); hx[3] = pg8::bf_hi(h0.y); hx[4] = pg8::bf_lo(h0.z); hx[5] = pg8::bf_hi(h0.z); hx[6] = pg8::bf_lo(h0.w); hx[7] = pg8::bf_hi(h0.w);
        hx[8] = pg8::bf_lo(h1v.x); hx[9] = pg8::bf_hi(h1v.x); hx[10] = pg8::bf_lo(h1v.y); hx[11] = pg8::bf_hi(h1v.y); hx[12] = pg8::bf_lo(h1v.z); hx[13] = pg8::bf_hi(h1v.z); hx[14] = pg8::bf_lo(h1v.w); hx[15] = pg8::bf_hi(h1v.w);
        float sm = 0.f, sq = 0.f;
#pragma unroll
        for (int e = 0; e < 16; ++e) { ya[e] = hx[e] * ALPHA + ya[e]; sm += ya[e]; sq += ya[e] * ya[e]; }
        sm = row16_allsum(sm); sq = row16_allsum(sq);
        if (g == 0) { GAS v4u* op = (GAS v4u*)(out + (size_t)t * D + 256 * s + 16 * c);
            v4u o0, o1; o0.x = pk2(ya[0], ya[1]); o0.y = pk2(ya[2], ya[3]); o0.z = pk2(ya[4], ya[5]); o0.w = pk2(ya[6], ya[7]);
            o1.x = pk2(ya[8], ya[9]); o1.y = pk2(ya[10], ya[11]); o1.z = pk2(ya[12], ya[13]); o1.w = pk2(ya[14], ya[15]);
            op[0] = o0; op[1] = o1;
            if (c == 0) { st[((size_t)t * 8 + s) * 2] = sm; st[((size_t)t * 8 + s) * 2 + 1] = sq; } }
        idc0 = idn0; idc1 = idn1; wc0 = wn0; wc1 = wn1;
    }
}
__device__ __forceinline__ void peer_c_row(int t, const bf16* r2, float* out, const float* st, const float* g2, const float* b2, int lane) {
    float sm = 0.f, sq = 0.f;
#pragma unroll
    for (int s = 0; s < 8; ++s) { sm += st[((size_t)t * 8 + s) * 2]; sq += st[((size_t)t * 8 + s) * 2 + 1]; }
    const float mean = sm * (1.f / D), var = sq * (1.f / D) - mean * mean, rstd = 1.f / sqrtf(fmaxf(var, 0.f) + LN_EPS);
    const GAS v4u* xr = (const GAS v4u*)(r2 + (size_t)t * D) + lane;
    GAS f32x4* op = (GAS f32x4*)(out + (size_t)t * D);
#pragma unroll
    for (int j = 0; j < 4; ++j) { const v4u w = xr[64 * j]; const int c4 = 2 * (lane + 64 * j);
        const f32x4 g0 = *((const GAS f32x4*)g2 + c4), g1 = *((const GAS f32x4*)g2 + c4 + 1), b0 = *((const GAS f32x4*)b2 + c4), b1 = *((const GAS f32x4*)b2 + c4 + 1);
        const f32x4 v0 = (f32x4){pg8::bf_lo(w.x), pg8::bf_hi(w.x), pg8::bf_lo(w.y), pg8::bf_hi(w.y)}, v1 = (f32x4){pg8::bf_lo(w.z), pg8::bf_hi(w.z), pg8::bf_lo(w.w), pg8::bf_hi(w.w)};
        op[c4] = (v0 - mean) * rstd * g0 + b0; op[c4 + 1] = (v1 - mean) * rstd * g1 + b1; }
}

struct TwoPassOrder : pg8::StaticOrder {
    __device__ __forceinline__ bool next(int i, pg8::Unit& u) const { if (!pg8::StaticOrder::next(i >> 1, u)) return false; u.w = i & 1; return true; }
};
struct EpiGate2 {
    static constexpr bool PERM = true, AFTER_DRAIN = false;
    pg8::EpiGate<0> e0; pg8::EpiGate<1> e1;
    __device__ __forceinline__ void operator()(const pg8::f32x4 (&acc)[2][2][4][2], const pg8::Unit& u, int wr, int wc, int fr, int fq) const { if (u.w == 0) e0(acc, u, wr, wc, fr, fq); else e1(acc, u, wr, wc, fr, fq); }
};

struct EpiGate2I8 {
    static constexpr bool PERM = true, AFTER_DRAIN = false;
    pg8::EpiGateI8<0> e0; pg8::EpiGateI8<1> e1;
    __device__ __forceinline__ void operator()(const pg8::i32x4 (&acc)[2][2][4][2], const pg8::Unit& u, int wr, int wc, int fr, int fq) const { if (u.w == 0) e0(acc, u, wr, wc, fr, fq); else e1(acc, u, wr, wc, fr, fq); }
};
struct ConvOrder : pg8::StaticOrder {
    const float* pu; const float* pv; unsigned char* u8; unsigned char* v8; float* su; float* sv; int slot; mutable int calls;
    static constexpr int CONV_ROWS = 4, CONV_CALLS = 6;
    __device__ __forceinline__ void done(const pg8::Unit&) const {
        if (slot < 0) return;
        int lane = threadIdx.x & 63; asm volatile("" : "+v"(lane));
        const int wave = __builtin_amdgcn_readfirstlane(threadIdx.x >> 6);
        const int base = ((slot * NWAVES + wave) * CONV_CALLS + calls) * CONV_ROWS;
        if (calls < CONV_CALLS) {
#pragma unroll 1
            for (int j = 0; j < CONV_ROWS; ++j) { const int r = base + j; if (r < 2 * PNE) { const bool sec = r >= PNE; const int e = sec ? r - PNE : r;
                if (sec) row_to_fp8(pv + (size_t)e * D, v8 + (size_t)e * 256, sv + e, lane); else row_to_i8(pu + (size_t)e * D, u8 + (size_t)e * 256, su + e, lane); } }
        }
        ++calls;
    }
};

struct Args { const float* in[16]; float* out; unsigned char* ws; int ph_lo, ph_hi; };
__global__ void __launch_bounds__(NTHREADS, 2) mk_fwd(Args args) {
    extern __shared__ __attribute__((aligned(16))) unsigned char lds_raw[];
    LAS unsigned char* lds = (LAS unsigned char*)lds_raw;
    volatile LAS unsigned* MISC = (volatile LAS unsigned*)(lds + MISC_OFF);
    const int tid0 = threadIdx.x;
    const int G = gridDim.x, bx = blockIdx.x;
    unsigned char* ws = args.ws;
    gu32* ctl = (gu32*)(ws + WS_CTL);
#define IN_(i) (args.in[i])
#define x_in IN_(0)
#define w_in IN_(1)
#define b_gate IN_(2)
#define sinks IN_(3)
#define conv_w IN_(4)
#define w_ao IN_(5)
#define w_co IN_(6)
#define w_o IN_(7)
#define ln1_g IN_(8)
#define ln1_b IN_(9)
#define w_q IN_(10)
#define sub_keys IN_(11)
#define peer_u IN_(12)
#define peer_v IN_(13)
#define ln2_g IN_(14)
#define ln2_b IN_(15)
#define WinT ((bf16*)(ws + WS_WIN))
#define WaT ((bf16*)(ws + WS_WA))
#define WcT ((bf16*)(ws + WS_WC))
#define WoT ((bf16*)(ws + WS_WO))
#define WfT ((bf16*)(ws + WS_WF))
#define XB ((bf16*)(ws + WS_XB))
#define MERGED ((bf16*)(ws + WS_MERGED))
#define Z ((bf16*)(ws + WS_Z))
#define R2B ((bf16*)(ws + WS_R2B))
#define H1B ((bf16*)(ws + WS_H1B))
#define SC ((float*)(ws + WS_SC))
#define EX ((int*)(ws + WS_EX))
#define GT ((float*)(ws + WS_GT))
#define AO ((bf16*)(ws + WS_AO))
#define CI ((bf16*)(ws + WS_CI))
#define TMP ((bf16*)(ws + WS_TMP))
#define U8 ((unsigned char*)(ws + WS_U8))
#define V8 ((unsigned char*)(ws + WS_V8))
#define SU ((float*)(ws + WS_SU))
#define SV ((float*)(ws + WS_SV))
#define PA ((int*)(ws + WS_PA))
#define ST ((float*)(ws + WS_ST))
#define WB ((float*)(ws + WS_WB))
#define XA8 ((signed char*)(ws + WS_XA8))
#define WIN8 ((signed char*)(ws + WS_WIN8))
#define SWIN ((float*)(ws + WS_SWIN))
#define SXA ((float*)(ws + WS_SXA))
#define WF8 ((signed char*)(ws + WS_WF8))
#define MG8 ((signed char*)(ws + WS_MG8))
#define WO8 ((signed char*)(ws + WS_WO8))
#define SMG ((float*)(ws + WS_SMG))
#define SWO ((float*)(ws + WS_SWO))
#define AO8 ((signed char*)(ws + WS_AO8))
#define CI8 ((signed char*)(ws + WS_CI8))
#define WA8 ((signed char*)(ws + WS_WA8))
#define WC8 ((signed char*)(ws + WS_WC8))
#define SAO ((float*)(ws + WS_S3))
#define SCI ((float*)(ws + WS_S3 + 65536))
#define SWA ((float*)(ws + WS_S3 + 131072))
#define SWC ((float*)(ws + WS_S3 + 196608))
#define SWF ((float*)(ws + WS_SWF))
#define XQ ((signed char*)(ws + WS_XQ))
#define SX ((float*)(ws + WS_SX))
    for (int u = tid0; u < (LDS_BYTES - LDSCTL_OFF) / 4; u += NTHREADS) ((LAS unsigned*)(lds + LDSCTL_OFF))[u] = 0u;
    __syncthreads();
    XcdBarrier bar; bar.bar = (unsigned*)(ctl + CW_BAR); bar.x = 0; bar.st = nullptr;
    if (!MK_PER_PHASE) bar = xcd_barrier_post((unsigned*)(ctl + CW_BAR), MISC + 8);
    const int lo = args.ph_lo, hi = args.ph_hi;
#ifndef PH_MASK
#define PH_MASK 0xFFF
#endif
#define IN(k) (((PH_MASK >> (k)) & 1) && lo <= (k) && (k) < hi)
#ifndef DBL_BAR
#define DBL_BAR 0
#endif
#define SEAM(k) do { if (IN(k) && IN((k) + 1)) { xcd_barrier(bar); if (DBL_BAR) xcd_barrier(bar); } } while (0)
#ifndef DBL_MASK
#define DBL_MASK 0
#endif
#define REP(k) for (int rep_ = 0; rep_ < 1 + ((DBL_MASK >> (k)) & 1); ++rep_)
#define PHASE_TID() int tid = tid0; asm volatile("" : "+v"(tid)); const int lane = tid & 63, wave = __builtin_amdgcn_readfirstlane(tid >> 6); (void)lane; (void)wave

    if (IN(0)) REP(0) {
        PHASE_TID();
        const bool conv_first = ((bx >> 3) & 1) == 0;
#pragma unroll 1
        for (int part = 0; part < 2; ++part) {
            if ((part == 0) == conv_first) {
                int tid = tid0; asm volatile("" : "+v"(tid)); const int lane = tid & 63, wave = __builtin_amdgcn_readfirstlane(tid >> 6);
                LAS float* scr = (LAS float*)(lds + wave * 16384);
                const int gw = bx * NWAVES + wave, NGW = G * NWAVES;
                constexpr int I_IN = (D / 64) * (IN_W / 32), I_SQ = (D / 64) * (D / 32);
                for (int it = gw; it < I_IN + 3 * I_SQ; it += NGW) {
                    int r = it;
                    if (r < I_IN) { p0_transpose_item(w_in, D, IN_W, WinT, scr, r, lane); continue; } r -= I_IN;
                    if (r < I_SQ) { p0_transpose_item(w_ao, D, D, WaT, scr, r, lane); continue; } r -= I_SQ;
                    if (r < I_SQ) { p0_transpose_item(w_co, D, D, WcT, scr, r, lane); continue; } r -= I_SQ;
                    p0_transpose_item(w_o, D, D, WoT, scr, r, lane);
                }
                for (int r = gw; r < M; r += NGW) row_f32_to_i8(x_in + (size_t)r * D, XA8 + (size_t)r * D, SXA + r, lane);
                __syncthreads();
            }
            if (part == 0) for (int it = bx; it < 16 * 32; it += G) p0_wf_item(w_q, sub_keys, WfT, lds, it, tid);
        }
    }
    SEAM(0);
    if (IN(1)) REP(1) {
        { PHASE_TID();
          for (int r = bx * NWAVES + wave; r < IN_W + 2 * D; r += G * NWAVES) { if (r < IN_W) row_bf16_to_i8(WinT + (size_t)r * D, WIN8 + (size_t)r * D, SWIN + r, lane);
              else if (r < IN_W + D) { const int q = r - IN_W; row_bf16_to_i8(WfT + (size_t)q * D, WF8 + (size_t)q * D, SWF + q, lane); }
              else { const int q = r - IN_W - D; row_bf16_to_i8(WoT + (size_t)q * D, WO8 + (size_t)q * D, SWO + q, lane); } } }
        if (!MK_PER_PHASE) xcd_barrier(bar);
        pg8::Gemm g{(const bf16*)XA8, (const bf16*)WIN8, M, IN_W, D / 2}; ConvOrder S; S.init(M, IN_W, G, bx);
        S.pu = peer_u; S.pv = peer_v; S.u8 = U8; S.v8 = V8; S.su = SU; S.sv = SV; S.calls = 0;
        S.slot = (G == 256 && bx >= 64) ? bx - 64 : -1;
        pg8::EpiI8Bf16 E{Z, IN_W, SXA, SWIN};
        pg8::gemm_phase<pg8::EpiI8Bf16, ConvOrder, true, true, true>(lds, g, S, E);
        if (G != 256) {
            PHASE_TID();
            for (int r = bx * NWAVES + wave; r < 2 * PNE; r += G * NWAVES) { const bool sec = r >= PNE; const int e = sec ? r - PNE : r;
                if (sec) row_to_fp8(peer_v + (size_t)e * D, V8 + (size_t)e * 256, SV + e, lane); else row_to_i8(peer_u + (size_t)e * D, U8 + (size_t)e * 256, SU + e, lane); }
        }
    }
    SEAM(1);
    if (IN(2)) REP(2) {
        PHASE_TID();
        const bool conv_first = ((bx >> 3) & 1) == 0;
#pragma unroll 1
        for (int part = 0; part < 2; ++part) {
            if ((part == 0) == conv_first) { int t2 = tid0; asm volatile("" : "+v"(t2)); for (int it = bx; it < M / 32; it += G) conv_item(it, Z, conv_w, CI, t2); }
            if (part == 0) for (int u = bx; u < BATCH * NKVH * 16; u += G) attn_unit(u, Z, AO, sinks, lds, tid);
        }
    }
    SEAM(2);
    if (IN(3)) REP(3) {
        TwoPassOrder S; S.init(M, D, G, bx);
#ifndef P3_I8
#define P3_I8 1
#endif
        if (P3_I8 && !MK_PER_PHASE) {
            { PHASE_TID();
              for (int r = bx * NWAVES + wave; r < 2 * M + 2 * D; r += G * NWAVES) {
                  if (r < M) row_bf16_to_i8(AO + (size_t)r * D, AO8 + (size_t)r * D, SAO + r, lane);
                  else if (r < 2 * M) { const int q = r - M; row_bf16_to_i8(CI + (size_t)q * D, CI8 + (size_t)q * D, SCI + q, lane); }
                  else if (r < 2 * M + D) { const int q = r - 2 * M; row_bf16_to_i8(WaT + (size_t)q * D, WA8 + (size_t)q * D, SWA + q, lane); }
                  else { const int q = r - 2 * M - D; row_bf16_to_i8(WcT + (size_t)q * D, WC8 + (size_t)q * D, SWC + q, lane); } } }
            xcd_barrier(bar);
            pg8::Gemm g{(const bf16*)AO8, (const bf16*)WA8, M, D, D / 2, (const bf16*)CI8, (const bf16*)WC8};
            EpiGate2I8 E{pg8::EpiGateI8<0>{TMP, nullptr, Z + G_OFF, b_gate, D, IN_W, SAO, SWA}, pg8::EpiGateI8<1>{MERGED, TMP, Z + G_OFF + D, b_gate + D, D, IN_W, SCI, SWC}};
            pg8::gemm_phase<EpiGate2I8, TwoPassOrder, true, true, true>(lds, g, S, E);
        } else {
        pg8::Gemm g{AO, WaT, M, D, D, CI, WcT};
        EpiGate2 E{pg8::EpiGate<0>{TMP, nullptr, Z + G_OFF, b_gate, D, IN_W}, pg8::EpiGate<1>{MERGED, TMP, Z + G_OFF + D, b_gate + D, D, IN_W}};
        pg8::gemm_phase<EpiGate2, TwoPassOrder, true, true>(lds, g, S, E);
        }
    }
    SEAM(3);
    if (IN(4)) REP(4) {
        pg8::StaticOrder S; S.init(M, D, G, bx);
#ifndef P4_I8
#define P4_I8 1
#endif
        if (P4_I8 && !MK_PER_PHASE) {
            { PHASE_TID(); for (int r = bx * NWAVES + wave; r < M; r += G * NWAVES) row_bf16_to_i8(MERGED + (size_t)r * D, MG8 + (size_t)r * D, SMG + r, lane); }
            xcd_barrier(bar);
            pg8::Gemm g{(const bf16*)MG8, (const bf16*)WO8, M, D, D / 2};
            pg8::EpiResI8Bf16 E{H1B, D, x_in, ALPHA, SMG, SWO};
            pg8::gemm_phase<pg8::EpiResI8Bf16, pg8::StaticOrder, true, true, true>(lds, g, S, E);
        } else {
        pg8::Gemm g{MERGED, WoT, M, D, D};
        pg8::EpiResBf16 E{H1B, D, x_in, ALPHA};
        pg8::gemm_phase<pg8::EpiResBf16, pg8::StaticOrder, true, true>(lds, g, S, E);
        }
    }
    SEAM(4);
    if (IN(5)) REP(5) {
        PHASE_TID();
        const int gw = bx * NWAVES + wave, NGW = G * NWAVES;
        for (int m = gw; m < M; m += NGW) ln1_row(H1B + (size_t)m * D, XQ + (size_t)m * D, SX + m, ln1_g, ln1_b, lane);
    }
    SEAM(5);
    if (IN(6)) REP(6) {
        pg8::Gemm g{H1B, WfT, M, D, D}; pg8::StaticOrder S; S.init(M, D, G, bx);
#ifndef P6_I8
#define P6_I8 1
#endif
        if (G == 256 && P6_I8) { pg8::Gemm g8{(const bf16*)XQ, (const bf16*)WF8, M, D, D / 2}; EpiTopKI8 E{EX, GT, SX, SWF}; pg8::gemm_phase<EpiTopKI8, pg8::StaticOrder, false, true, true>(lds, g8, S, E); }
        else if (G == 256) { EpiTopK E{EX, GT}; pg8::gemm_phase<EpiTopK, pg8::StaticOrder, false, true>(lds, g, S, E); }
        else { pg8::EpiF32 E{SC, D, nullptr, 0.f}; pg8::gemm_phase<pg8::EpiF32, pg8::StaticOrder, true, true>(lds, g, S, E); }
    }
    if (G != 256) SEAM(6);
    if (IN(7)) REP(7) {
        PHASE_TID();
        if (G != 256) for (int p = bx; p < (M * PH) / 128; p += G) topk_pass(p, SC, EX, GT, lds, tid);
    }
    SEAM(7);
    if (IN(8)) REP(8) {
        PHASE_TID();
        const int xcc = (int)(xb_xcc_id() & 7u);
#pragma unroll 1
#ifndef SCRAMBLE
#define SCRAMBLE 0
#endif
        for (int sl = 0; sl < 8; ++sl) { const int s = (xcc + sl + (SCRAMBLE ? wave : 0)) & 7;
            for (;;) { const int tg = q_pull((unsigned*)(ctl + CW_Q + 64 * (s + 16 * rep_)), lane); if (tg >= PEER_NTASK) break;
                int t0, nt; peer_task_tokens(tg, t0, nt); peer_a_task(t0, nt, s, XQ, EX, U8, PA, lane); } }
    }
    SEAM(8);
    if (IN(9)) REP(9) {
        PHASE_TID();
        for (size_t i = (size_t)bx * NTHREADS + tid; i < (size_t)M * 128; i += (size_t)G * NTHREADS) peer_w_elem(i, EX, GT, SU, SV, SX, PA, WB);
    }
    SEAM(9);
    if (IN(10)) REP(10) {
        PHASE_TID();
        const int xcc = (int)(xb_xcc_id() & 7u);
#pragma unroll 1
#ifndef SCRAMBLE
#define SCRAMBLE 0
#endif
        for (int sl = 0; sl < 8; ++sl) { const int s = (xcc + sl + (SCRAMBLE ? wave : 0)) & 7;
            for (;;) { const int tg = q_pull((unsigned*)(ctl + CW_Q + 64 * (8 + s + 16 * rep_)), lane); if (tg >= PEER_NTASK) break;
                int t0, nt; peer_task_tokens(tg, t0, nt); peer_b_task(t0, nt, s, H1B, EX, WB, V8, R2B, ST, lane); } }
    }
    SEAM(10);
    if (IN(11)) REP(11) {
        PHASE_TID();
        const int gw = bx * NWAVES + wave, NGW = G * NWAVES;
        for (int t = gw; t < M; t += NGW) peer_c_row(t, R2B, args.out, ST, ln2_g, ln2_b, lane);
    }
#undef IN
#undef SEAM
}

extern "C" void kernel_launch(void* const* d_in, const int* in_sizes, int n_in, void* d_out, int out_size, void* d_ws, size_t ws_size, hipStream_t stream) {
    static int grid = 0;
    if (grid == 0) {
        if (n_in != 16 || out_size != M * D || ws_size < WS_END) { fprintf(stderr, "kernel_launch: unexpected shapes (n_in %d out %d ws %zu)\n", n_in, out_size, ws_size); grid = -1; return; }
        int dev = 0, cus = 0, per_cu = 0;
        if (hipGetDevice(&dev) != hipSuccess || hipDeviceGetAttribute(&cus, hipDeviceAttributeMultiprocessorCount, dev) != hipSuccess) { grid = -1; return; }
        if (hipFuncSetAttribute((const void*)mk_fwd, hipFuncAttributeMaxDynamicSharedMemorySize, LDS_BYTES) != hipSuccess) { fprintf(stderr, "kernel_launch: hipFuncSetAttribute failed\n"); grid = -1; return; }
        if (hipOccupancyMaxActiveBlocksPerMultiprocessor(&per_cu, (const void*)mk_fwd, NTHREADS, LDS_BYTES) != hipSuccess || per_cu < 1) { fprintf(stderr, "kernel_launch: occupancy query says %d\n", per_cu); per_cu = 1; }
        (void)hipGetLastError();
        if (per_cu > 1) per_cu = 1;
        grid = cus * per_cu;
    }
    if (grid < 0) return;
    if (hipMemsetAsync((char*)d_ws + WS_CTL, 0, CTL_ZERO_BYTES, stream) != hipSuccess) { fprintf(stderr, "kernel_launch: memset failed\n"); return; }
    Args a{};
    for (int i = 0; i < 16; ++i) a.in[i] = (const float*)d_in[i];
    a.out = (float*)d_out; a.ws = (unsigned char*)d_ws;
#if MK_PER_PHASE
    for (int p = 0; p < N_PHASES; ++p) { a.ph_lo = p; a.ph_hi = p + 1; hipLaunchKernelGGL(mk_fwd, dim3(grid), dim3(NTHREADS), LDS_BYTES, stream, a); }
#else
    a.ph_lo = 0; a.ph_hi = N_PHASES;
    void* kargs[] = {&a};
#ifdef PLAIN_LAUNCH
    (void)kargs; hipLaunchKernelGGL(mk_fwd, dim3(grid), dim3(NTHREADS), LDS_BYTES, stream, a); hipError_t e = hipPeekAtLastError();
#else
    hipError_t e = hipLaunchCooperativeKernel((const void*)mk_fwd, dim3(grid), dim3(NTHREADS), kargs, LDS_BYTES, stream);
#endif
    if (e != hipSuccess) fprintf(stderr, "kernel_launch: cooperative launch failed: %s (grid %d)\n", hipGetErrorString(e), grid);
#endif
}
```

```cpp
#include <hip/hip_runtime.h>
#include <cstdio>
#include <cstdint>
#include <type_traits>
namespace pg8 {
#define PG8_LAS __attribute__((address_space(3)))
typedef unsigned short bf16_t;
typedef short bf16x8 __attribute__((ext_vector_type(8)));
typedef float f32x4 __attribute__((ext_vector_type(4)));
typedef unsigned u32x4 __attribute__((ext_vector_type(4)));
constexpr int BM = 256, BK = 64, HALF = 128, HTB = HALF * BK * 2  , STAGE_BYTES = 8 * HTB, NXCD = 8, WGM = 8;

__host__ __device__ __forceinline__ int lds_byte(int r, int c) { const int st = (r >> 4) * 2 + (c >> 5), rr = r & 15, cc = c & 31, ob = rr * 64 + cc * 2; return st * 1024 + (ob ^ (((ob >> 9) & 1) << 5)); }
__host__ __device__ __forceinline__ void stage_rc(int b, int& R, int& C) { const int st = b / 1024, sb = b % 1024, swz = sb ^ (((sb >> 9) & 1) << 5); R = (st >> 1) * 16 + swz / 64; C = (st & 1) * 32 + (swz % 64) / 2; }
__host__ __device__ __forceinline__ int perm32(int rho) { const int n = rho >> 4, i = rho & 15; return 8 * (i >> 2) + 4 * n + (i & 3); }

struct Unit { int pm, pn, w; };
struct Gemm { const bf16_t* A; const bf16_t* Bt; int M, N, K; const bf16_t* A2 = nullptr; const bf16_t* Bt2 = nullptr; };

struct StaticOrder {
    int nM, nN, nwg, G, c;
    __host__ __device__ void init(int M, int N, int G_, int c_) { nM = M / BM; nN = N / BM; nwg = nM * nN; G = G_; c = c_; }
    __host__ __device__ bool next(int i, Unit& u) const {
        const long L = (long)i * G + c; if (L >= nwg) return false;
        int wgid = (int)L; { const int q = nwg / NXCD, r = nwg % NXCD, xcd = wgid % NXCD, off = wgid / NXCD; wgid = (xcd < r ? xcd * (q + 1) : r * (q + 1) + (xcd - r) * q) + off; }
        const int nig = WGM * nN, gid = wgid / nig, fm = gid * WGM, gsz = (nM - fm) < WGM ? (nM - fm) : WGM;
        u.pm = fm + ((wgid % nig) % gsz); u.pn = (wgid % nig) / gsz; u.w = 0; return true;
    }
    __device__ __forceinline__ void a_ready(const Unit&) const {}
    __device__ __forceinline__ void done(const Unit&) const {}
};


__device__ __forceinline__ unsigned cvt_pk_bf16(float lo, float hi) { unsigned r; asm volatile("v_cvt_pk_bf16_f32 %0, %1, %2" : "=v"(r) : "v"(lo), "v"(hi)); return r; }
__device__ __forceinline__ float bf_lo(unsigned w) { return __builtin_bit_cast(float, w << 16); }
__device__ __forceinline__ float bf_hi(unsigned w) { return __builtin_bit_cast(float, w & 0xffff0000u); }
__device__ __forceinline__ float sigmoidf_(float x) { return __builtin_amdgcn_rcpf(1.0f + __expf(-x)); }

struct EpiBf16 {
    static constexpr bool PERM = true, AFTER_DRAIN = false;
    bf16_t* O; int ldc;
    __device__ __forceinline__ void operator()(const f32x4 (&acc)[2][2][4][2], const Unit& u, int wr, int wc, int fr, int fq) const {
        const int row0 = u.pm * BM + wr * 64 + fr, col0 = u.pn * BM + wc * 32 + 8 * fq;
#pragma unroll
        for (int ai = 0; ai < 2; ++ai)
#pragma unroll
            for (int m = 0; m < 4; ++m) { bf16_t* rowp = O + (size_t)(row0 + ai * HALF + m * 16) * ldc + col0;
#pragma unroll
                for (int bj = 0; bj < 2; ++bj) { const f32x4 v0 = acc[ai][bj][m][0], v1 = acc[ai][bj][m][1];
                    u32x4 w; w.x = cvt_pk_bf16(v0[0], v0[1]); w.y = cvt_pk_bf16(v0[2], v0[3]); w.z = cvt_pk_bf16(v1[0], v1[1]); w.w = cvt_pk_bf16(v1[2], v1[3]);
                    *(u32x4*)(rowp + bj * HALF) = w; } }
    }
};
template <int SECOND> struct EpiGate {
    static constexpr bool PERM = true, AFTER_DRAIN = false;
    bf16_t* O; const bf16_t* T; const bf16_t* Zg; const float* bg; int ldc, ldz;
    __device__ __forceinline__ void operator()(const f32x4 (&acc)[2][2][4][2], const Unit& u, int wr, int wc, int fr, int fq) const {
        const int row0 = u.pm * BM + wr * 64 + fr, col0 = u.pn * BM + wc * 32 + 8 * fq;
        f32x4 bv[2][2];
#pragma unroll
        for (int bj = 0; bj < 2; ++bj)
#pragma unroll
            for (int n = 0; n < 2; ++n) bv[bj][n] = *(const f32x4*)(bg + col0 + bj * HALF + 4 * n);
#pragma unroll
        for (int ai = 0; ai < 2; ++ai)
#pragma unroll
            for (int m = 0; m < 4; ++m) { const size_t row = (size_t)(row0 + ai * HALF + m * 16);
#pragma unroll
                for (int bj = 0; bj < 2; ++bj) { const int c = col0 + bj * HALF;
                    const u32x4 zg = *(const u32x4*)(Zg + row * ldz + c);
                    f32x4 v0 = acc[ai][bj][m][0], v1 = acc[ai][bj][m][1];
                    v0[0] *= sigmoidf_(bf_lo(zg.x) + bv[bj][0][0]); v0[1] *= sigmoidf_(bf_hi(zg.x) + bv[bj][0][1]);
                    v0[2] *= sigmoidf_(bf_lo(zg.y) + bv[bj][0][2]); v0[3] *= sigmoidf_(bf_hi(zg.y) + bv[bj][0][3]);
                    v1[0] *= sigmoidf_(bf_lo(zg.z) + bv[bj][1][0]); v1[1] *= sigmoidf_(bf_hi(zg.z) + bv[bj][1][1]);
                    v1[2] *= sigmoidf_(bf_lo(zg.w) + bv[bj][1][2]); v1[3] *= sigmoidf_(bf_hi(zg.w) + bv[bj][1][3]);
                    if (SECOND) { const u32x4 t = *(const u32x4*)(T + row * ldc + c);
                        v0[0] += bf_lo(t.x); v0[1] += bf_hi(t.x); v0[2] += bf_lo(t.y); v0[3] += bf_hi(t.y);
                        v1[0] += bf_lo(t.z); v1[1] += bf_hi(t.z); v1[2] += bf_lo(t.w); v1[3] += bf_hi(t.w); }
                    u32x4 w; w.x = cvt_pk_bf16(v0[0], v0[1]); w.y = cvt_pk_bf16(v0[2], v0[3]); w.z = cvt_pk_bf16(v1[0], v1[1]); w.w = cvt_pk_bf16(v1[2], v1[3]);
                    *(u32x4*)(O + row * ldc + c) = w; } }
    }
};
struct EpiF32 {
    static constexpr bool PERM = false, AFTER_DRAIN = false;
    float* C; int ldc; const float* R; float scale;
    __device__ __forceinline__ void operator()(const f32x4 (&acc)[2][2][4][2], const Unit& u, int wr, int wc, int fr, int fq) const {
        const int row0 = u.pm * BM + wr * 64 + fr, col0 = u.pn * BM + wc * 32 + 4 * fq;
#pragma unroll
        for (int ai = 0; ai < 2; ++ai)
#pragma unroll
            for (int m = 0; m < 4; ++m) { const size_t off = (size_t)(row0 + ai * HALF + m * 16) * ldc + col0;
#pragma unroll
                for (int bj = 0; bj < 2; ++bj)
#pragma unroll
                    for (int n = 0; n < 2; ++n) { f32x4 v = acc[ai][bj][m][n];
                        if (R) v += *(const f32x4*)(R + off + bj * HALF + n * 16) * scale;
                        *(f32x4*)(C + off + bj * HALF + n * 16) = v; } }
    }
};
struct EpiResBf16 {
    static constexpr bool PERM = true, AFTER_DRAIN = false;
    bf16_t* O; int ldc; const float* R; float scale;
    __device__ __forceinline__ void operator()(const f32x4 (&acc)[2][2][4][2], const Unit& u, int wr, int wc, int fr, int fq) const {
        const int row0 = u.pm * BM + wr * 64 + fr, col0 = u.pn * BM + wc * 32 + 8 * fq;
#pragma unroll
        for (int ai = 0; ai < 2; ++ai)
#pragma unroll
            for (int m = 0; m < 4; ++m) { const size_t off = (size_t)(row0 + ai * HALF + m * 16) * ldc + col0;
#pragma unroll
                for (int bj = 0; bj < 2; ++bj) { const f32x4 r0 = *(const f32x4*)(R + off + bj * HALF), r1 = *(const f32x4*)(R + off + bj * HALF + 4);
                    const f32x4 v0 = acc[ai][bj][m][0] + r0 * scale, v1 = acc[ai][bj][m][1] + r1 * scale;
                    u32x4 w; w.x = cvt_pk_bf16(v0[0], v0[1]); w.y = cvt_pk_bf16(v0[2], v0[3]); w.z = cvt_pk_bf16(v1[0], v1[1]); w.w = cvt_pk_bf16(v1[2], v1[3]);
                    *(u32x4*)(O + off + bj * HALF) = w; } }
    }
};
typedef int i32x4e __attribute__((ext_vector_type(4)));
struct EpiI8Bf16 {
    static constexpr bool PERM = true, AFTER_DRAIN = false;
    bf16_t* O; int ldc; const float* sa; const float* sb;
    __device__ __forceinline__ void operator()(const i32x4e (&acc)[2][2][4][2], const Unit& u, int wr, int wc, int fr, int fq) const {
        const int row0 = u.pm * BM + wr * 64 + fr, col0 = u.pn * BM + wc * 32 + 8 * fq;
        f32x4 sbv[2][2];
#pragma unroll
        for (int bj = 0; bj < 2; ++bj)
#pragma unroll
            for (int n = 0; n < 2; ++n) sbv[bj][n] = *(const f32x4*)(sb + col0 + bj * HALF + 4 * n);
#pragma unroll
        for (int ai = 0; ai < 2; ++ai)
#pragma unroll
            for (int m = 0; m < 4; ++m) { const int row = row0 + ai * HALF + m * 16; const float sr = sa[row]; bf16_t* rowp = O + (size_t)row * ldc + col0;
#pragma unroll
                for (int bj = 0; bj < 2; ++bj) { const i32x4e a0 = acc[ai][bj][m][0], a1 = acc[ai][bj][m][1];
                    const f32x4 v0 = (f32x4){(float)a0[0], (float)a0[1], (float)a0[2], (float)a0[3]} * sbv[bj][0] * sr, v1 = (f32x4){(float)a1[0], (float)a1[1], (float)a1[2], (float)a1[3]} * sbv[bj][1] * sr;
                    u32x4 w; w.x = cvt_pk_bf16(v0[0], v0[1]); w.y = cvt_pk_bf16(v0[2], v0[3]); w.z = cvt_pk_bf16(v1[0], v1[1]); w.w = cvt_pk_bf16(v1[2], v1[3]);
                    *(u32x4*)(rowp + bj * HALF) = w; } }
    }
};
template <int SECOND> struct EpiGateI8 {
    static constexpr bool PERM = true, AFTER_DRAIN = false;
    bf16_t* O; const bf16_t* T; const bf16_t* Zg; const float* bg; int ldc, ldz; const float* sa; const float* sb;
    __device__ __forceinline__ void operator()(const i32x4e (&acc)[2][2][4][2], const Unit& u, int wr, int wc, int fr, int fq) const {
        const int row0 = u.pm * BM + wr * 64 + fr, col0 = u.pn * BM + wc * 32 + 8 * fq;
        f32x4 bv[2][2], sbv[2][2];
#pragma unroll
        for (int bj = 0; bj < 2; ++bj)
#pragma unroll
            for (int n = 0; n < 2; ++n) { bv[bj][n] = *(const f32x4*)(bg + col0 + bj * HALF + 4 * n); sbv[bj][n] = *(const f32x4*)(sb + col0 + bj * HALF + 4 * n); }
#pragma unroll
        for (int ai = 0; ai < 2; ++ai)
#pragma unroll
            for (int m = 0; m < 4; ++m) { const size_t row = (size_t)(row0 + ai * HALF + m * 16); const float sr = sa[row];
#pragma unroll
                for (int bj = 0; bj < 2; ++bj) { const int c = col0 + bj * HALF;
                    const u32x4 zg = *(const u32x4*)(Zg + row * ldz + c);
                    const i32x4e a0 = acc[ai][bj][m][0], a1 = acc[ai][bj][m][1];
                    f32x4 v0 = (f32x4){(float)a0[0], (float)a0[1], (float)a0[2], (float)a0[3]} * sbv[bj][0] * sr, v1 = (f32x4){(float)a1[0], (float)a1[1], (float)a1[2], (float)a1[3]} * sbv[bj][1] * sr;
                    v0[0] *= sigmoidf_(bf_lo(zg.x) + bv[bj][0][0]); v0[1] *= sigmoidf_(bf_hi(zg.x) + bv[bj][0][1]);
                    v0[2] *= sigmoidf_(bf_lo(zg.y) + bv[bj][0][2]); v0[3] *= sigmoidf_(bf_hi(zg.y) + bv[bj][0][3]);
                    v1[0] *= sigmoidf_(bf_lo(zg.z) + bv[bj][1][0]); v1[1] *= sigmoidf_(bf_hi(zg.z) + bv[bj][1][1]);
                    v1[2] *= sigmoidf_(bf_lo(zg.w) + bv[bj][1][2]); v1[3] *= sigmoidf_(bf_hi(zg.w) + bv[bj][1][3]);
                    if (SECOND) { const u32x4 t = *(const u32x4*)(T + row * ldc + c);
                        v0[0] += bf_lo(t.x); v0[1] += bf_hi(t.x); v0[2] += bf_lo(t.y); v0[3] += bf_hi(t.y);
                        v1[0] += bf_lo(t.z); v1[1] += bf_hi(t.z); v1[2] += bf_lo(t.w); v1[3] += bf_hi(t.w); }
                    u32x4 w; w.x = cvt_pk_bf16(v0[0], v0[1]); w.y = cvt_pk_bf16(v0[2], v0[3]); w.z = cvt_pk_bf16(v1[0], v1[1]); w.w = cvt_pk_bf16(v1[2], v1[3]);
                    *(u32x4*)(O + row * ldc + c) = w; } }
    }
};
struct EpiResI8Bf16 {
    static constexpr bool PERM = true, AFTER_DRAIN = false;
    bf16_t* O; int ldc; const float* R; float scale; const float* sa; const float* sb;
    __device__ __forceinline__ void operator()(const i32x4e (&acc)[2][2][4][2], const Unit& u, int wr, int wc, int fr, int fq) const {
        const int row0 = u.pm * BM + wr * 64 + fr, col0 = u.pn * BM + wc * 32 + 8 * fq;
        f32x4 sbv[2][2];
#pragma unroll
        for (int bj = 0; bj < 2; ++bj)
#pragma unroll
            for (int n = 0; n < 2; ++n) sbv[bj][n] = *(const f32x4*)(sb + col0 + bj * HALF + 4 * n);
#pragma unroll
        for (int ai = 0; ai < 2; ++ai)
#pragma unroll
            for (int m = 0; m < 4; ++m) { const int row = row0 + ai * HALF + m * 16; const float sr = sa[row]; const size_t off = (size_t)row * ldc + col0;
#pragma unroll
                for (int bj = 0; bj < 2; ++bj) { const f32x4 r0 = *(const f32x4*)(R + off + bj * HALF), r1 = *(const f32x4*)(R + off + bj * HALF + 4);
                    const i32x4e a0 = acc[ai][bj][m][0], a1 = acc[ai][bj][m][1];
                    const f32x4 v0 = (f32x4){(float)a0[0], (float)a0[1], (float)a0[2], (float)a0[3]} * sbv[bj][0] * sr + r0 * scale, v1 = (f32x4){(float)a1[0], (float)a1[1], (float)a1[2], (float)a1[3]} * sbv[bj][1] * sr + r1 * scale;
                    u32x4 w; w.x = cvt_pk_bf16(v0[0], v0[1]); w.y = cvt_pk_bf16(v0[2], v0[3]); w.z = cvt_pk_bf16(v1[0], v1[1]); w.w = cvt_pk_bf16(v1[2], v1[3]);
                    *(u32x4*)(O + off + bj * HALF) = w; } }
    }
};

typedef int i32x4 __attribute__((ext_vector_type(4)));
template <class E, class = void> struct epi_chains : std::false_type {};
template <class E> struct epi_chains<E, std::void_t<decltype(E::CHAIN)>> : std::true_type {};
template <class Epi, class Sched, bool ALIGN_EPI = false, bool SP2 = false, bool I8 = false>
__device__ __forceinline__ void gemm_phase(PG8_LAS unsigned char* lds, const Gemm g, const Sched& S, const Epi& E) {
    int tid_ = threadIdx.x; asm volatile("" : "+v"(tid_));
    const int tid = tid_, wid = __builtin_amdgcn_readfirstlane(tid >> 6), lane = tid & 63, wr = wid >> 2, wc = wid & 3, fr = lane & 15, fq = lane >> 4;
    const int K = g.K, nt = K / BK;
    unsigned voffA[2], voffB[2];
#pragma unroll
    for (int i = 0; i < 2; ++i) { int R, C; stage_rc(tid * 16 + i * 8192, R, C); const int Rb = Epi::PERM ? ((R & ~31) + perm32(R & 31)) : R;
        voffA[i] = (unsigned)(R * K + C) * 2u; voffB[i] = (unsigned)(Rb * K + C) * 2u; }
    const size_t kstep = (size_t)(BK * 2);
    const size_t hstep = (size_t)HALF * K * 2;
    const size_t tstep = 2 * hstep;
    const unsigned ldsw = (unsigned)wid * 1024u;
    const int aoff = lds_byte(wr * 64 + fr, fq * 8), boff = lds_byte(wc * 32 + fr, fq * 8);
#define PG8_SA(b, h) (((b) * 2 + (h)) * HTB)
#define PG8_SB(b, h) ((4 + (b) * 2 + (h)) * HTB)
#define PG8_STAGE(bufoff, gbase, voff) do { _Pragma("unroll") for (int _i = 0; _i < 2; ++_i) \
        __builtin_amdgcn_global_load_lds((const unsigned*)((const char*)(gbase) + (voff)[_i]), (PG8_LAS unsigned*)(lds + (bufoff) + ldsw + _i * 8192), 16, 0, 0); } while (0)
#define PG8_LDA(dst, b, h) do { _Pragma("unroll") for (int m = 0; m < 4; ++m) _Pragma("unroll") for (int k = 0; k < 2; ++k) dst[m][k] = *(const PG8_LAS bf16x8*)(lds + PG8_SA(b, h) + aoff + m * 2048 + k * 1024); } while (0)
#define PG8_LDB(dst, b, h) do { _Pragma("unroll") for (int n = 0; n < 2; ++n) _Pragma("unroll") for (int k = 0; k < 2; ++k) dst[n][k] = *(const PG8_LAS bf16x8*)(lds + PG8_SB(b, h) + boff + n * 2048 + k * 1024); } while (0)
#define PG8_MMA(ai, bj, At, Bt) do { __builtin_amdgcn_s_setprio(1); _Pragma("unroll") for (int m = 0; m < 4; ++m) _Pragma("unroll") for (int n = 0; n < 2; ++n) _Pragma("unroll") for (int k = 0; k < 2; ++k) \
        { if constexpr (I8) acc[ai][bj][m][n] = __builtin_bit_cast(acc_t, __builtin_amdgcn_mfma_i32_16x16x64_i8(__builtin_bit_cast(i32x4, Bt[n][k]), __builtin_bit_cast(i32x4, At[m][k]), __builtin_bit_cast(i32x4, acc[ai][bj][m][n]), 0, 0, 0)); \
          else acc[ai][bj][m][n] = __builtin_bit_cast(acc_t, __builtin_amdgcn_mfma_f32_16x16x32_bf16(Bt[n][k], At[m][k], __builtin_bit_cast(f32x4, acc[ai][bj][m][n]), 0, 0, 0)); } __builtin_amdgcn_s_setprio(0); } while (0)
#define PG8_WAIT_V(n) asm volatile("s_waitcnt vmcnt(" #n ")" ::: "memory")
#define PG8_WAIT_L(n) asm volatile("s_waitcnt lgkmcnt(" #n ")" ::: "memory")
#define PG8_BAR __builtin_amdgcn_s_barrier()
#define PG8_SCHED __builtin_amdgcn_sched_barrier(0)
    Unit cur, nxt; int ui = 0;
    if (!S.next(0, cur)) return;
    typedef typename std::conditional<I8, i32x4, f32x4>::type acc_t;
    acc_t acc[2][2][4][2];
#pragma unroll
    for (int a = 0; a < 2; ++a)
#pragma unroll
        for (int b = 0; b < 2; ++b)
#pragma unroll
            for (int m = 0; m < 4; ++m)
#pragma unroll
                for (int n = 0; n < 2; ++n) acc[a][b][m][n] = acc_t{};
    bf16x8 At[4][2], B0[2][2], B1[2][2];
    const char* cA = (const char*)(cur.w ? g.A2 : g.A) + (size_t)cur.pm * tstep; const char* cB = (const char*)(cur.w ? g.Bt2 : g.Bt) + (size_t)cur.pn * tstep;
    S.a_ready(cur);
    if constexpr (SP2) {
        PG8_STAGE(PG8_SB(0, 0), cB, voffB); PG8_STAGE(PG8_SB(0, 1), cB + hstep, voffB); PG8_STAGE(PG8_SA(0, 0), cA, voffA); PG8_STAGE(PG8_SA(0, 1), cA + hstep, voffA);
        if (wr == 1) PG8_BAR;
        PG8_WAIT_V(2); PG8_BAR;
        PG8_STAGE(PG8_SB(1, 0), cB + kstep, voffB); PG8_STAGE(PG8_SA(1, 0), cA + kstep, voffA); PG8_STAGE(PG8_SB(1, 1), cB + hstep + kstep, voffB);
        PG8_WAIT_V(6); PG8_BAR;
    } else {
        PG8_STAGE(PG8_SB(0, 0), cB, voffB); PG8_STAGE(PG8_SA(0, 0), cA, voffA); PG8_STAGE(PG8_SB(0, 1), cB + hstep, voffB); PG8_STAGE(PG8_SA(0, 1), cA + hstep, voffA);
        if (wr == 1) PG8_BAR;
        PG8_WAIT_V(4); PG8_BAR;
        PG8_STAGE(PG8_SB(1, 0), cB + kstep, voffB); PG8_STAGE(PG8_SA(1, 0), cA + kstep, voffA); PG8_STAGE(PG8_SB(1, 1), cB + hstep + kstep, voffB);
        PG8_WAIT_V(6); PG8_BAR;
    }
    for (;;) {
        const bool has_next = S.next(ui + 1, nxt);
        const char* nA = has_next ? (const char*)(nxt.w ? g.A2 : g.A) + (size_t)nxt.pm * tstep : cA; const char* nB = has_next ? (const char*)(nxt.w ? g.Bt2 : g.Bt) + (size_t)nxt.pn * tstep : cB;
        for (int t = 0; t < nt; t += 2) {
            const bool last = (t == nt - 2);
            const char* a1 = cA + (size_t)(t + 1) * kstep;
            const char* a2 = last ? nA : cA + (size_t)(t + 2) * kstep; const char* b2 = last ? nB : cB + (size_t)(t + 2) * kstep;
            const char* a3 = a2 + kstep; const char* b3 = b2 + kstep;
            if (last && has_next) S.a_ready(nxt);
            if constexpr (SP2) {
            PG8_LDB(B0, 0, 0); PG8_LDB(B1, 0, 1); PG8_SCHED; PG8_LDA(At, 0, 0); PG8_STAGE(PG8_SA(1, 1), a1 + hstep, voffA);
            PG8_WAIT_V(8); PG8_WAIT_L(0); PG8_BAR; PG8_MMA(0, 0, At, B0); PG8_MMA(0, 1, At, B1); PG8_BAR; PG8_SCHED;
            PG8_LDA(At, 0, 1); PG8_STAGE(PG8_SB(0, 0), b2, voffB); PG8_STAGE(PG8_SB(0, 1), b2 + hstep, voffB); PG8_STAGE(PG8_SA(0, 0), a2, voffA);
            PG8_WAIT_V(8); PG8_WAIT_L(0); PG8_BAR; PG8_MMA(1, 0, At, B0); PG8_MMA(1, 1, At, B1); PG8_BAR; PG8_SCHED;
            PG8_LDB(B0, 1, 0); PG8_LDB(B1, 1, 1); PG8_SCHED; PG8_LDA(At, 1, 0); PG8_STAGE(PG8_SA(0, 1), a2 + hstep, voffA);
            PG8_WAIT_V(8); PG8_WAIT_L(0); PG8_BAR; PG8_MMA(0, 0, At, B0); PG8_MMA(0, 1, At, B1); PG8_BAR; PG8_SCHED;
            PG8_LDA(At, 1, 1); PG8_STAGE(PG8_SB(1, 0), b3, voffB); PG8_STAGE(PG8_SB(1, 1), b3 + hstep, voffB); PG8_STAGE(PG8_SA(1, 0), a3, voffA);
            PG8_WAIT_V(8); PG8_WAIT_L(0); PG8_BAR; PG8_MMA(1, 0, At, B0); PG8_MMA(1, 1, At, B1); PG8_BAR; PG8_SCHED;
            } else {
            PG8_LDB(B0, 0, 0); PG8_SCHED; PG8_LDA(At, 0, 0); PG8_STAGE(PG8_SA(1, 1), a1 + hstep, voffA);
            PG8_WAIT_L(8); PG8_BAR; PG8_WAIT_L(0); PG8_MMA(0, 0, At, B0); PG8_BAR; PG8_SCHED;
            PG8_LDB(B1, 0, 1); PG8_STAGE(PG8_SB(0, 0), b2, voffB);
            PG8_BAR; PG8_WAIT_L(0); PG8_MMA(0, 1, At, B1); PG8_BAR;
            PG8_LDA(At, 0, 1); PG8_STAGE(PG8_SA(0, 0), a2, voffA);
            PG8_BAR; PG8_WAIT_L(0); PG8_MMA(1, 0, At, B0); PG8_BAR; PG8_SCHED;
            PG8_STAGE(PG8_SB(0, 1), b2 + hstep, voffB);
            PG8_WAIT_V(6); PG8_BAR; PG8_MMA(1, 1, At, B1); PG8_BAR;
            PG8_LDB(B0, 1, 0); PG8_SCHED; PG8_LDA(At, 1, 0); PG8_STAGE(PG8_SA(0, 1), a2 + hstep, voffA);
            PG8_WAIT_L(8); PG8_BAR; PG8_WAIT_L(0); PG8_MMA(0, 0, At, B0); PG8_BAR; PG8_SCHED;
            PG8_LDB(B1, 1, 1); PG8_STAGE(PG8_SB(1, 0), b3, voffB);
            PG8_BAR; PG8_WAIT_L(0); PG8_MMA(0, 1, At, B1); PG8_BAR;
            PG8_LDA(At, 1, 1); PG8_STAGE(PG8_SA(1, 0), a3, voffA);
            PG8_BAR; PG8_WAIT_L(0); PG8_MMA(1, 0, At, B0); PG8_BAR; PG8_SCHED;
            PG8_STAGE(PG8_SB(1, 1), b3 + hstep, voffB);
            PG8_WAIT_V(6); PG8_BAR; PG8_MMA(1, 1, At, B1); PG8_BAR;
            }
        }
        if constexpr (ALIGN_EPI) { if (wr == 0) PG8_BAR; }
        bool keep_acc = false;
        if constexpr (!Epi::AFTER_DRAIN) { if constexpr (epi_chains<Epi>::value) keep_acc = E.chain(acc, cur, wr, wc, fr, fq); else E(acc, cur, wr, wc, fr, fq); S.done(cur); }
        if (!has_next) break;
        if (!keep_acc) {
#pragma unroll
        for (int a = 0; a < 2; ++a)
#pragma unroll
            for (int b = 0; b < 2; ++b)
#pragma unroll
                for (int m = 0; m < 4; ++m)
#pragma unroll
                    for (int n = 0; n < 2; ++n) acc[a][b][m][n] = acc_t{};
        }
        cur = nxt; cA = nA; cB = nB; ++ui;
        if constexpr (ALIGN_EPI) { if (wr == 1) PG8_BAR; }
    }
    PG8_WAIT_V(0);
    if constexpr (!ALIGN_EPI) { if (wr == 0) PG8_BAR; }
    PG8_BAR;
    if constexpr (Epi::AFTER_DRAIN) { E.fused(acc, cur, wr, wc, fr, fq, lds, wid, lane); S.done(cur); }
#undef PG8_SA
#undef PG8_SB
#undef PG8_STAGE
#undef PG8_LDA
#undef PG8_LDB
#undef PG8_MMA
#undef PG8_WAIT_V
#undef PG8_WAIT_L
#undef PG8_BAR
#undef PG8_SCHED
}
}
#define GAS __attribute__((address_space(1)))
#define LAS __attribute__((address_space(3)))
typedef unsigned short bf16;
typedef unsigned v4u __attribute__((ext_vector_type(4)));
typedef float f32x4 __attribute__((ext_vector_type(4)));
typedef short bf16x8 __attribute__((ext_vector_type(8)));
typedef GAS unsigned gu32;
typedef GAS unsigned long long gu64;
#define RLX_AGENT __ATOMIC_RELAXED, __HIP_MEMORY_SCOPE_AGENT
#define LDS_WAIT() asm volatile("s_waitcnt lgkmcnt(0)" ::: "memory")
#define VM_WAIT() asm volatile("s_waitcnt vmcnt(0)" ::: "memory")
__device__ __forceinline__ unsigned long long rt() { return __builtin_amdgcn_s_memrealtime(); }
__device__ __forceinline__ unsigned f2bf(float f) { unsigned u = __builtin_bit_cast(unsigned, f); return (u + 0x7fffu + ((u >> 16) & 1u)) >> 16; }
__device__ __forceinline__ unsigned pk2(float lo, float hi) { return f2bf(lo) | (f2bf(hi) << 16); }

#define XB_TMO      128
#define XB_XCNT(j)  (256  + 64 * (j))
#define XB_XSUB(j)  (1280 + 64 * (j))
#define XB_XGEN(j)  (2304 + 64 * (j))
#define XB_TOP      3328
#define XB_TOPGEN   3392
#define XCD_BAR_WORDS 3456
#define XB_SPIN_CAP (1u << 18)

__device__ __forceinline__ unsigned xb_ld(unsigned* p)              { return __hip_atomic_load(p, __ATOMIC_RELAXED, __HIP_MEMORY_SCOPE_AGENT); }
__device__ __forceinline__ unsigned xb_add(unsigned* p, unsigned v) { return __hip_atomic_fetch_add(p, v, __ATOMIC_RELAXED, __HIP_MEMORY_SCOPE_AGENT); }
__device__ __forceinline__ unsigned xb_xcc_id() { return (unsigned)__builtin_amdgcn_s_getreg((3 << 11) | 20) & 0xFu; }
#define XB_SPIN(cond, bar) do { unsigned _sp = 0; while (cond) { __builtin_amdgcn_s_sleep(1); \
    if ((++_sp & 255u) == 0u) { if (xb_ld(&(bar)[XB_TMO])) break; if (_sp > XB_SPIN_CAP) { atomicAdd(&(bar)[XB_TMO], 1u); break; } } } } while (0)

struct XcdBarrier {
    unsigned* bar; unsigned x;
    volatile LAS unsigned* st;
};

__device__ __forceinline__ XcdBarrier xcd_barrier_post(unsigned* bar, volatile LAS unsigned* st) {
    XcdBarrier b; b.bar = bar; b.x = xb_xcc_id(); b.st = st;
    if (threadIdx.x == 0) (void)xb_add(&bar[XB_XCNT(b.x)], 1u);
    return b;
}
__device__ __forceinline__ void xcd_barrier_complete(unsigned* bar, unsigned x, unsigned& nloc, unsigned& nx) {
    const unsigned G = gridDim.x * gridDim.y * gridDim.z;
    unsigned sum, cnt, mine, sp = 0u;
    for (;;) {
        sum = 0u; cnt = 0u; mine = 0u;
#pragma unroll
        for (unsigned j = 0; j < 16; ++j) { const unsigned c = xb_ld(&bar[XB_XCNT(j)]); sum += c; cnt += (c > 0u) ? 1u : 0u; mine = (j == x) ? c : mine; }
        if (sum == G) break;
        __builtin_amdgcn_s_sleep(1);
        if ((++sp & 255u) == 0u) { if (xb_ld(&bar[XB_TMO])) break; if (sp > XB_SPIN_CAP) { atomicAdd(&bar[XB_TMO], 1u); break; } }
    }
    nloc = mine > 0u ? mine : 1u; nx = cnt > 0u ? cnt : 1u;
}

__device__ __forceinline__ void xcd_barrier(const XcdBarrier& b) {
    asm volatile("s_waitcnt vmcnt(0)" ::: "memory");
    __syncthreads();
    if (threadIdx.x == 0) {
        unsigned* bar = b.bar;
        __builtin_amdgcn_s_waitcnt(0);
        unsigned nloc = b.st[0], nx = b.st[1];
        if (nloc == 0u) { xcd_barrier_complete(bar, b.x, nloc, nx); b.st[0] = nloc; b.st[1] = nx; }
        const unsigned old = xb_add(&bar[XB_XSUB(b.x)], 1u);
        const unsigned gen = old / nloc;
        if (old + 1u == (gen + 1u) * nloc) {
            __builtin_amdgcn_fence(__ATOMIC_RELEASE, "agent");
            asm volatile("s_waitcnt vmcnt(0)" ::: "memory");
            const unsigned og = xb_add(&bar[XB_TOP], 1u);
            const unsigned tg = og / nx;
            if (og + 1u == (tg + 1u) * nx) xb_add(&bar[XB_TOPGEN], 1u);
            else XB_SPIN(xb_ld(&bar[XB_TOPGEN]) == tg, bar);
            __builtin_amdgcn_fence(__ATOMIC_ACQUIRE, "agent");
            xb_add(&bar[XB_XGEN(b.x)], 1u);
            asm volatile("s_waitcnt vmcnt(0)" ::: "memory");
        } else {
            XB_SPIN(xb_ld(&bar[XB_XGEN(b.x)]) == gen, bar);
            __builtin_amdgcn_fence(__ATOMIC_ACQUIRE, "agent");
            asm volatile("s_waitcnt vmcnt(0)" ::: "memory");
        }
    }
    __syncthreads();
}

constexpr int NWAVES = 8, NTHREADS = 512;
constexpr int BATCH = 4, SEQ = 2048, D = 2048, M = BATCH * SEQ;
constexpr int NQH = 32, NKVH = 4, HD = 64, QPKV = 8, WINDOW = 128;
constexpr int Q_OFF = 0, K_OFF = 2048, V_OFF = 2304, CB_OFF = 2560, CC_OFF = 4608, CH_OFF = 6656, G_OFF = 8704, IN_W = 12800;
constexpr int PH = 8, PNK = 128, PTOPK = 16, PNE = 16384;
constexpr float LN_EPS = 1e-5f;
constexpr float ALPHA = 1.189207115002721f;

#ifndef MK_PER_PHASE
#define MK_PER_PHASE 0
#endif
constexpr int N_PHASES = 12;

constexpr size_t MiB = 1u << 20;
constexpr size_t WS_CTL = 0, CTL_ZERO_BYTES = 1 * MiB;
constexpr size_t WS_WIN = 1 * MiB;
constexpr size_t WS_WA = 51 * MiB, WS_WC = 59 * MiB, WS_WO = 67 * MiB, WS_WF = 75 * MiB;
constexpr size_t WS_XB = 83 * MiB;
constexpr size_t WS_MERGED = WS_XB;
constexpr size_t WS_Z = 115 * MiB;
constexpr size_t WS_R2B = 115 * MiB;
constexpr size_t WS_H1B = 179 * MiB;
constexpr size_t WS_SC = 211 * MiB;
constexpr size_t WS_EX = 275 * MiB;
constexpr size_t WS_GT = 279 * MiB;
constexpr size_t WS_AO = 315 * MiB, WS_CI = 347 * MiB, WS_TMP = 379 * MiB;
constexpr size_t WS_U8 = 411 * MiB, WS_V8 = 443 * MiB;
constexpr size_t WS_SU = 475 * MiB, WS_SV = WS_SU + 65536;
constexpr size_t WS_PA = WS_SC;
constexpr size_t WS_XQ = 283 * MiB;
constexpr size_t WS_SX = 299 * MiB;
constexpr size_t WS_WB = 380 * MiB;
constexpr size_t WS_ST = 379 * MiB;
constexpr size_t WS_XA8 = WS_XB;
constexpr size_t WS_WIN8 = 476 * MiB;
constexpr size_t WS_SWIN = 501 * MiB, WS_SXA = WS_SWIN + 65536;
constexpr size_t WS_AO8 = 1 * MiB, WS_CI8 = 17 * MiB, WS_WA8 = 33 * MiB, WS_WC8 = 37 * MiB, WS_S3 = 41 * MiB;
constexpr size_t WS_WF8 = 502 * MiB;
constexpr size_t WS_SWF = WS_SXA + 65536;
constexpr size_t WS_MG8 = 1 * MiB;
constexpr size_t WS_WO8 = 506 * MiB;
constexpr size_t WS_SMG = WS_S3 + 262144, WS_SWO = WS_SWF + 16384;
constexpr size_t WS_SEG = 315 * MiB, WS_SOFF = 323 * MiB;
constexpr size_t WS_END = 510 * MiB;
constexpr int CW_Q = 12288;
constexpr size_t SLICE_BYTES = (size_t)PNE * 256;
constexpr int CW_BAR = 4096;

constexpr int RING_BYTES = 131072;
constexpr int LDSCTL_OFF = 163328, MISC_OFF = LDSCTL_OFF + 320;
constexpr int LDS_BYTES = LDSCTL_OFF + 512;

typedef float f32x16 __attribute__((ext_vector_type(16)));
typedef unsigned v2u __attribute__((ext_vector_type(2)));
__device__ __forceinline__ float wave_sum(float v) {
#pragma unroll
    for (int o = 1; o < 64; o <<= 1) v += __shfl_xor(v, o);
    return v;
}
__device__ __forceinline__ float vmaxf(float a, float b) { float r; asm("v_max_f32_e32 %0, %1, %2" : "=v"(r) : "v"(a), "v"(b)); return r; }
__device__ __forceinline__ float vminf(float a, float b) { float r; asm("v_min_f32_e32 %0, %1, %2" : "=v"(r) : "v"(a), "v"(b)); return r; }

__device__ __forceinline__ void p0_transpose_item(const float* W, int K, int N, bf16* WT, LAS float* scr, int item, int lane) {
    const int nblk = N / 32, kb = item / nblk, nb = item % nblk, k0 = 64 * kb, n0 = 32 * nb;
#pragma unroll 8
    for (int i = 0; i < 32; ++i) { const int kk = 2 * i + (lane >> 5); scr[kk * 33 + (lane & 31)] = W[(size_t)(k0 + kk) * N + n0 + (lane & 31)]; }
    LDS_WAIT(); asm volatile("" ::: "memory");
    const int c = lane & 7;
#pragma unroll
    for (int j = 0; j < 4; ++j) { const int n = (lane >> 3) + 8 * j; const LAS float* s = scr + (8 * c) * 33 + n;
        v4u o; o.x = pk2(s[0 * 33], s[1 * 33]); o.y = pk2(s[2 * 33], s[3 * 33]); o.z = pk2(s[4 * 33], s[5 * 33]); o.w = pk2(s[6 * 33], s[7 * 33]);
        *(GAS v4u*)(WT + (size_t)(n0 + n) * K + k0 + 8 * c) = o; }
    LDS_WAIT(); asm volatile("" ::: "memory");
}
__device__ __forceinline__ void p0_wf_item(const float* wq, const float* sk, bf16* WfT, LAS unsigned char* lds, int item, int tid) {
    const int hp = item >> 5, dt = item & 31;
    LAS f32x4* SK4 = (LAS f32x4*)lds;
    LAS f32x4* WQ4 = SK4 + 128 * 33;
    const float* skp = sk + (size_t)hp * 128 * 128;
    for (int i = tid; i < 128 * 32; i += NTHREADS) { const int n = i >> 5, c4 = i & 31; SK4[n * 33 + c4] = *(const f32x4*)(skp + n * 128 + 4 * c4); }
    for (int i = tid; i < 64 * 32; i += NTHREADS) { const int r = i >> 5, c4 = i & 31; WQ4[r * 33 + c4] = *(const f32x4*)(wq + (size_t)(64 * dt + r) * 2048 + hp * 128 + 4 * c4); }
    __syncthreads();
    const int td = tid & 15, tn = tid >> 4;
    float acc[4][4];
#pragma unroll
    for (int i = 0; i < 4; ++i)
#pragma unroll
        for (int j = 0; j < 4; ++j) acc[i][j] = 0.f;
#pragma unroll 4
    for (int c4 = 0; c4 < 32; ++c4) {
        f32x4 a[4], b[4];
#pragma unroll
        for (int i = 0; i < 4; ++i) a[i] = SK4[(4 * tn + i) * 33 + c4];
#pragma unroll
        for (int j = 0; j < 4; ++j) b[j] = WQ4[(td + 16 * j) * 33 + c4];
#pragma unroll
        for (int i = 0; i < 4; ++i)
#pragma unroll
            for (int j = 0; j < 4; ++j) acc[i][j] += a[i].x * b[j].x + a[i].y * b[j].y + a[i].z * b[j].z + a[i].w * b[j].w;
    }
#pragma unroll
    for (int i = 0; i < 4; ++i)
#pragma unroll
        for (int j = 0; j < 4; ++j) WfT[(size_t)(hp * 128 + 4 * tn + i) * 2048 + 64 * dt + td + 16 * j] = (bf16)f2bf(acc[i][j]);
    __syncthreads();
}

__device__ __forceinline__ int perm16(int o) { return 8 * ((o >> 2) & 1) + 4 * (o >> 3) + (o & 3); }
__device__ __forceinline__ void attn_unit(int unit, const bf16* z, bf16* ao, const float* sinks, LAS unsigned char* lds, int tid) {
    const int lane = tid & 63, wid = __builtin_amdgcn_readfirstlane(tid >> 6), r32 = lane & 31, hi = lane >> 5;
    const int nb = unit & 15, kvh = (unit >> 4) & 3, b = unit >> 6;
    LAS bf16* Ks = (LAS bf16*)lds;
    LAS bf16* Vt = (LAS bf16*)(lds + 256 * 144);
    const size_t tok0 = (size_t)b * SEQ;
#pragma unroll
    for (int i = 0; i < 4; ++i) {
        const int ci = tid + NTHREADS * i, key = ci >> 3, dc = ci & 7;
        int kpos = 128 * (nb - 1) + key; if (kpos < 0) kpos = 0;
        const bf16* src = z + (tok0 + kpos) * IN_W + K_OFF + kvh * HD + dc * 8;
        const v4u kv = *(const GAS v4u*)src, vv = *(const GAS v4u*)(src + (V_OFF - K_OFF));
        *(LAS v4u*)(Ks + key * 72 + dc * 8) = kv;
        const int pos = (key & ~15) + perm16(key & 15);
        LAS bf16* vp = Vt + (dc * 8) * 264 + pos;
        vp[0 * 264] = (bf16)(vv.x & 0xffffu); vp[1 * 264] = (bf16)(vv.x >> 16); vp[2 * 264] = (bf16)(vv.y & 0xffffu); vp[3 * 264] = (bf16)(vv.y >> 16);
        vp[4 * 264] = (bf16)(vv.z & 0xffffu); vp[5 * 264] = (bf16)(vv.z >> 16); vp[6 * 264] = (bf16)(vv.w & 0xffffu); vp[7 * 264] = (bf16)(vv.w >> 16);
    }
    __syncthreads();
    const int hq = kvh * QPKV + wid;
    const float LOG2E = 1.4426950408889634f;
    const float sink2 = sinks[hq] * LOG2E, sc = 0.125f * LOG2E;
#pragma unroll 1
    for (int qg = 0; qg < 4; ++qg) {
        const size_t tok = tok0 + 128 * nb + 32 * qg + r32;
        bf16x8 qf[4];
#pragma unroll
        for (int ks = 0; ks < 4; ++ks) qf[ks] = *(const GAS bf16x8*)(z + tok * IN_W + Q_OFF + hq * HD + 16 * ks + 8 * hi);
        f32x16 s[5];
#pragma unroll
        for (int kt = 0; kt < 5; ++kt) {
            s[kt] = (f32x16){0.f, 0.f, 0.f, 0.f, 0.f, 0.f, 0.f, 0.f, 0.f, 0.f, 0.f, 0.f, 0.f, 0.f, 0.f, 0.f};
#pragma unroll
            for (int ks = 0; ks < 4; ++ks) {
                const bf16x8 kf = *(const LAS bf16x8*)(Ks + (32 * (qg + kt) + r32) * 72 + 16 * ks + 8 * hi);
                s[kt] = __builtin_amdgcn_mfma_f32_32x32x16_bf16(kf, qf[ks], s[kt], 0, 0, 0);
            }
        }
        float mx = sink2;
#pragma unroll
        for (int kt = 0; kt < 5; ++kt) {
            const bool tile_dead = (nb == 0) && (qg + kt < 4);
#pragma unroll
            for (int r = 0; r < 16; ++r) {
                const int krow = (r & 3) + 8 * (r >> 2) + 4 * hi;
                bool valid = !tile_dead;
                if (kt == 0) valid = valid && (krow > r32);
                if (kt == 4) valid = valid && (krow <= r32);
                const float v = valid ? s[kt][r] * sc : -INFINITY;
                s[kt][r] = v; mx = fmaxf(mx, v);
            }
        }
        mx = fmaxf(mx, __shfl_xor(mx, 32));
        float sum = 0.f;
#pragma unroll
        for (int kt = 0; kt < 5; ++kt)
#pragma unroll
            for (int r = 0; r < 16; ++r) { const float p = __builtin_amdgcn_exp2f(s[kt][r] - mx); s[kt][r] = p; sum += p; }
        sum += __shfl_xor(sum, 32);
        const float inv = 1.0f / (sum + __builtin_amdgcn_exp2f(sink2 - mx));
        f32x16 o[2];
        o[0] = (f32x16){0.f, 0.f, 0.f, 0.f, 0.f, 0.f, 0.f, 0.f, 0.f, 0.f, 0.f, 0.f, 0.f, 0.f, 0.f, 0.f}; o[1] = o[0];
#pragma unroll
        for (int kt = 0; kt < 5; ++kt)
#pragma unroll
            for (int s2 = 0; s2 < 2; ++s2) {
                v4u pw; pw.x = pg8::cvt_pk_bf16(s[kt][8 * s2 + 0], s[kt][8 * s2 + 1]); pw.y = pg8::cvt_pk_bf16(s[kt][8 * s2 + 2], s[kt][8 * s2 + 3]);
                pw.z = pg8::cvt_pk_bf16(s[kt][8 * s2 + 4], s[kt][8 * s2 + 5]); pw.w = pg8::cvt_pk_bf16(s[kt][8 * s2 + 6], s[kt][8 * s2 + 7]);
                const bf16x8 pa = __builtin_bit_cast(bf16x8, pw);
#pragma unroll
                for (int dt = 0; dt < 2; ++dt) {
                    const bf16x8 vf = *(const LAS bf16x8*)(Vt + (32 * dt + r32) * 264 + 32 * (qg + kt) + 16 * s2 + 8 * hi);
                    o[dt] = __builtin_amdgcn_mfma_f32_32x32x16_bf16(vf, pa, o[dt], 0, 0, 0);
                }
            }
        bf16* op = ao + tok * D + hq * HD;
#pragma unroll
        for (int dt = 0; dt < 2; ++dt)
#pragma unroll
            for (int g = 0; g < 4; ++g) {
                v2u w; w.x = pg8::cvt_pk_bf16(o[dt][4 * g + 0] * inv, o[dt][4 * g + 1] * inv); w.y = pg8::cvt_pk_bf16(o[dt][4 * g + 2] * inv, o[dt][4 * g + 3] * inv);
                *(GAS v2u*)(op + 32 * dt + 8 * g + 4 * hi) = w;
            }
    }
    __syncthreads();
}
__device__ __forceinline__ void conv_item(int item, const bf16* z, const float* cw, bf16* ci, int tid) {
    const int c8 = tid & 255, half = tid >> 8, t0 = 32 * item + 16 * half, c0 = 8 * c8;
    float w0[8], w1[8], w2[8], u1[8], u2[8];
#pragma unroll
    for (int e = 0; e < 8; ++e) { w0[e] = cw[c0 + e]; w1[e] = cw[2048 + c0 + e]; w2[e] = cw[4096 + c0 + e]; u1[e] = 0.f; u2[e] = 0.f; }
    if ((t0 & (SEQ - 1)) != 0) {
#pragma unroll
        for (int k = 0; k < 2; ++k) {
            const bf16* zr = z + (size_t)(t0 - 2 + k) * IN_W + c0;
            const v4u a = *(const GAS v4u*)(zr + CC_OFF), h = *(const GAS v4u*)(zr + CH_OFF);
            float u[8];
            u[0] = pg8::bf_lo(a.x) * pg8::bf_lo(h.x); u[1] = pg8::bf_hi(a.x) * pg8::bf_hi(h.x); u[2] = pg8::bf_lo(a.y) * pg8::bf_lo(h.y); u[3] = pg8::bf_hi(a.y) * pg8::bf_hi(h.y);
            u[4] = pg8::bf_lo(a.z) * pg8::bf_lo(h.z); u[5] = pg8::bf_hi(a.z) * pg8::bf_hi(h.z); u[6] = pg8::bf_lo(a.w) * pg8::bf_lo(h.w); u[7] = pg8::bf_hi(a.w) * pg8::bf_hi(h.w);
#pragma unroll
            for (int e = 0; e < 8; ++e) { if (k == 0) u2[e] = u[e]; else u1[e] = u[e]; }
        }
    }
#pragma unroll 4
    for (int i = 0; i < 16; ++i) {
        const bf16* zr = z + (size_t)(t0 + i) * IN_W + c0;
        const v4u a = *(const GAS v4u*)(zr + CC_OFF), h = *(const GAS v4u*)(zr + CH_OFF), bb = *(const GAS v4u*)(zr + CB_OFF);
        float u[8], cb[8], y[8];
        u[0] = pg8::bf_lo(a.x) * pg8::bf_lo(h.x); u[1] = pg8::bf_hi(a.x) * pg8::bf_hi(h.x); u[2] = pg8::bf_lo(a.y) * pg8::bf_lo(h.y); u[3] = pg8::bf_hi(a.y) * pg8::bf_hi(h.y);
        u[4] = pg8::bf_lo(a.z) * pg8::bf_lo(h.z); u[5] = pg8::bf_hi(a.z) * pg8::bf_hi(h.z); u[6] = pg8::bf_lo(a.w) * pg8::bf_lo(h.w); u[7] = pg8::bf_hi(a.w) * pg8::bf_hi(h.w);
        cb[0] = pg8::bf_lo(bb.x); cb[1] = pg8::bf_hi(bb.x); cb[2] = pg8::bf_lo(bb.y); cb[3] = pg8::bf_hi(bb.y); cb[4] = pg8::bf_lo(bb.z); cb[5] = pg8::bf_hi(bb.z); cb[6] = pg8::bf_lo(bb.w); cb[7] = pg8::bf_hi(bb.w);
#pragma unroll
        for (int e = 0; e < 8; ++e) { y[e] = cb[e] * (w0[e] * u2[e] + w1[e] * u1[e] + w2[e] * u[e]); u2[e] = u1[e]; u1[e] = u[e]; }
        v4u o; o.x = pk2(y[0], y[1]); o.y = pk2(y[2], y[3]); o.z = pk2(y[4], y[5]); o.w = pk2(y[6], y[7]);
        *(GAS v4u*)(ci + (size_t)(t0 + i) * D + c0) = o;
    }
}

__device__ __forceinline__ unsigned pack_i8(const f32x4 v) {
    const int a = __float2int_rn(v.x), b = __float2int_rn(v.y), c = __float2int_rn(v.z), d = __float2int_rn(v.w);
    return ((unsigned)a & 0xffu) | (((unsigned)b & 0xffu) << 8) | (((unsigned)c & 0xffu) << 16) | ((unsigned)d << 24);
}
__device__ __forceinline__ unsigned pack_i8_2(float a, float b, float c, float d) {
    const int ia = __float2int_rn(a), ib = __float2int_rn(b), ic = __float2int_rn(c), id = __float2int_rn(d);
    return ((unsigned)ia & 0xffu) | (((unsigned)ib & 0xffu) << 8) | (((unsigned)ic & 0xffu) << 16) | ((unsigned)id << 24);
}
__device__ __forceinline__ void ln1_row(bf16* hbrow, signed char* xqrow, float* sxp, const float* g, const float* bta, int lane) {
    GAS v4u* xr = (GAS v4u*)hbrow + lane;
    float v[4][8]; float s = 0.f;
#pragma unroll
    for (int j = 0; j < 4; ++j) { const v4u w = xr[64 * j];
        v[j][0] = pg8::bf_lo(w.x); v[j][1] = pg8::bf_hi(w.x); v[j][2] = pg8::bf_lo(w.y); v[j][3] = pg8::bf_hi(w.y); v[j][4] = pg8::bf_lo(w.z); v[j][5] = pg8::bf_hi(w.z); v[j][6] = pg8::bf_lo(w.w); v[j][7] = pg8::bf_hi(w.w);
#pragma unroll
        for (int e = 0; e < 8; ++e) s += v[j][e]; }
    const float mean = wave_sum(s) * (1.f / D); float s2 = 0.f;
#pragma unroll
    for (int j = 0; j < 4; ++j)
#pragma unroll
        for (int e = 0; e < 8; ++e) { v[j][e] -= mean; s2 += v[j][e] * v[j][e]; }
    const float rstd = 1.f / sqrtf(wave_sum(s2) * (1.f / D) + LN_EPS);
    float mx = 0.f;
#pragma unroll
    for (int j = 0; j < 4; ++j) {
        const GAS f32x4* gp = (const GAS f32x4*)g + 2 * (lane + 64 * j); const GAS f32x4* bp = (const GAS f32x4*)bta + 2 * (lane + 64 * j);
        const f32x4 g0 = gp[0], g1 = gp[1], b0 = bp[0], b1 = bp[1];
        v[j][0] = v[j][0] * rstd * g0.x + b0.x; v[j][1] = v[j][1] * rstd * g0.y + b0.y; v[j][2] = v[j][2] * rstd * g0.z + b0.z; v[j][3] = v[j][3] * rstd * g0.w + b0.w;
        v[j][4] = v[j][4] * rstd * g1.x + b1.x; v[j][5] = v[j][5] * rstd * g1.y + b1.y; v[j][6] = v[j][6] * rstd * g1.z + b1.z; v[j][7] = v[j][7] * rstd * g1.w + b1.w;
        v4u o; o.x = pk2(v[j][0], v[j][1]); o.y = pk2(v[j][2], v[j][3]); o.z = pk2(v[j][4], v[j][5]); o.w = pk2(v[j][6], v[j][7]);
        xr[64 * j] = o;
#pragma unroll
        for (int e = 0; e < 8; ++e) mx = fmaxf(mx, fabsf(v[j][e]));
    }
#pragma unroll
    for (int o = 1; o < 64; o <<= 1) mx = fmaxf(mx, __shfl_xor(mx, o));
    const float qs = mx > 0.f ? 127.0f / mx : 1.0f;
    GAS v2u* q8 = (GAS v2u*)xqrow + lane;
#pragma unroll
    for (int j = 0; j < 4; ++j) { v2u o; o.x = pack_i8_2(v[j][0] * qs, v[j][1] * qs, v[j][2] * qs, v[j][3] * qs); o.y = pack_i8_2(v[j][4] * qs, v[j][5] * qs, v[j][6] * qs, v[j][7] * qs); q8[64 * j] = o; }
    if (lane == 0) *sxp = mx > 0.f ? mx * (1.0f / 127.0f) : 1.0f;
}

__device__ __forceinline__ void row_f32_to_i8(const float* src, signed char* dst, float* inv, int lane) {
    f32x4 v[8]; float mx = 0.f;
#pragma unroll
    for (int j = 0; j < 8; ++j) { v[j] = *((const GAS f32x4*)src + lane + 64 * j); mx = fmaxf(mx, fmaxf(fmaxf(fabsf(v[j].x), fabsf(v[j].y)), fmaxf(fabsf(v[j].z), fabsf(v[j].w)))); }
#pragma unroll
    for (int o = 1; o < 64; o <<= 1) mx = fmaxf(mx, __shfl_xor(mx, o));
    const float sc = mx > 0.f ? 127.0f / mx : 1.0f;
#pragma unroll
    for (int j = 0; j < 8; ++j) *((GAS unsigned*)dst + lane + 64 * j) = pack_i8_2(v[j].x * sc, v[j].y * sc, v[j].z * sc, v[j].w * sc);
    if (lane == 0) *inv = mx > 0.f ? mx * (1.0f / 127.0f) : 1.0f;
}
__device__ __forceinline__ void row_bf16_to_i8(const bf16* src, signed char* dst, float* inv, int lane) {
    float v[4][8]; float mx = 0.f;
#pragma unroll
    for (int j = 0; j < 4; ++j) { const v4u w = *((const GAS v4u*)src + lane + 64 * j);
        v[j][0] = pg8::bf_lo(w.x); v[j][1] = pg8::bf_hi(w.x); v[j][2] = pg8::bf_lo(w.y); v[j][3] = pg8::bf_hi(w.y); v[j][4] = pg8::bf_lo(w.z); v[j][5] = pg8::bf_hi(w.z); v[j][6] = pg8::bf_lo(w.w); v[j][7] = pg8::bf_hi(w.w);
#pragma unroll
        for (int e = 0; e < 8; ++e) mx = fmaxf(mx, fabsf(v[j][e])); }
#pragma unroll
    for (int o = 1; o < 64; o <<= 1) mx = fmaxf(mx, __shfl_xor(mx, o));
    const float sc = mx > 0.f ? 127.0f / mx : 1.0f;
#pragma unroll
    for (int j = 0; j < 4; ++j) { v2u o; o.x = pack_i8_2(v[j][0] * sc, v[j][1] * sc, v[j][2] * sc, v[j][3] * sc); o.y = pack_i8_2(v[j][4] * sc, v[j][5] * sc, v[j][6] * sc, v[j][7] * sc); *((GAS v2u*)dst + lane + 64 * j) = o; }
    if (lane == 0) *inv = mx > 0.f ? mx * (1.0f / 127.0f) : 1.0f;
}

constexpr int TK_ROWF = 136;
constexpr int TK_IDX_OFF = 256 * TK_ROWF * 4;
__device__ __forceinline__ void topk_core(LAS unsigned char* lds, size_t prob0, int pstride, int* experts, float* gates, int tid) {
    LAS float* S = (LAS float*)lds;
    LAS unsigned char* IDX = lds + TK_IDX_OFF;
    const int row = tid >> 1, sub = tid & 1;
#define TK_CE(a, b) do { const float h_ = vmaxf(a, b), l_ = vminf(a, b); a = h_; b = l_; } while (0)
#define TK_SORT16(V) do { _Pragma("unroll") for (int k_ = 2; k_ <= 16; k_ <<= 1) _Pragma("unroll") for (int j_ = k_ >> 1; j_ > 0; j_ >>= 1) _Pragma("unroll") for (int i_ = 0; i_ < 16; ++i_) { \
        const int l_i = i_ ^ j_; if (l_i > i_) { if ((i_ & k_) == 0) TK_CE(V[i_], V[l_i]); else TK_CE(V[l_i], V[i_]); } } } while (0)
#define TK_MERGE16(Lv, Xv) do { _Pragma("unroll") for (int j_ = 0; j_ < 16; ++j_) Lv[j_] = vmaxf(Lv[j_], Xv[15 - j_]); \
        _Pragma("unroll") for (int st_ = 8; st_ >= 1; st_ >>= 1) _Pragma("unroll") for (int j_ = 0; j_ < 16; ++j_) if ((j_ & st_) == 0) TK_CE(Lv[j_], Lv[j_ + st_]); } while (0)
    float L[16];
#pragma unroll
    for (int q = 0; q < 4; ++q) {
        float C[16];
#pragma unroll
        for (int i = 0; i < 4; ++i) { const int c4 = 2 * (4 * q + i) + sub;
            const f32x4 v = *(const LAS f32x4*)(S + row * TK_ROWF + 4 * c4);
#pragma unroll
            for (int e = 0; e < 4; ++e) { const float ve = v[e];
                C[4 * i + e] = __uint_as_float((__float_as_uint(ve) & ~0x7Fu) | (unsigned)(4 * c4 + e)); } }
        TK_SORT16(C);
        if (q == 0) {
#pragma unroll
            for (int j = 0; j < 16; ++j) L[j] = C[j];
        } else TK_MERGE16(L, C);
    }
    {
        float P[16];
#pragma unroll
        for (int j = 0; j < 16; ++j) P[j] = __shfl_xor(L[j], 1);
        TK_MERGE16(L, P);
    }
    if (sub == 0) {
#pragma unroll
        for (int q = 0; q < 4; ++q) {
            unsigned w = 0;
#pragma unroll
            for (int e = 0; e < 4; ++e) w |= (__builtin_bit_cast(unsigned, L[4 * q + e]) & 0x7Fu) << (8 * e);
            *(LAS unsigned*)(IDX + row * 16 + 4 * q) = w;
        }
    }
    float A[16], B[16];
#pragma unroll
    for (int j = 0; j < 16; ++j) { const float o = __shfl_xor(L[j], 2); const bool isb = (tid & 2) != 0; A[j] = isb ? o : L[j]; B[j] = isb ? L[j] : o; }
#define TK_KEY(i, j) __uint_as_float((__float_as_uint(A[i] + B[j]) & ~0xFFu) | (unsigned)(255 - ((i) * 16 + (j))))
    float F[16], X[16];
#pragma unroll
    for (int j = 0; j < 16; ++j) F[j] = TK_KEY(0, j);
#pragma unroll
    for (int i = 1; i < 16; ++i) X[i - 1] = TK_KEY(i, 0);
    X[15] = -INFINITY; TK_MERGE16(F, X);
#pragma unroll
    for (int i = 0; i < 16; ++i) X[i] = -INFINITY;
#pragma unroll
    for (int i = 1; i <= 7; ++i) X[i - 1] = TK_KEY(i, 1);
    TK_MERGE16(F, X);
#pragma unroll
    for (int i = 0; i < 16; ++i) X[i] = -INFINITY;
#pragma unroll
    for (int j = 2; j <= 7; ++j) X[j - 2] = TK_KEY(1, j);
    TK_MERGE16(F, X);
    { const float rest[6] = {TK_KEY(2, 2), TK_KEY(2, 3), TK_KEY(2, 4), TK_KEY(3, 2), TK_KEY(3, 3), TK_KEY(4, 2)};
#pragma unroll
      for (int r = 0; r < 6; ++r) { float x = rest[r];
#pragma unroll
          for (int k = 0; k < 16; ++k) { const float h = vmaxf(F[k], x); x = vminf(F[k], x); F[k] = h; } } }
    __syncthreads();
    if ((tid & 3) == 0) {
        const int rowA = (tid >> 2) * 2, rowB = rowA + 1;
        const size_t prob = prob0 + (size_t)pstride * (tid >> 2);
        float g[16]; int ex[16]; float gs = 0.f;
#pragma unroll
        for (int k = 0; k < 16; ++k) {
            const unsigned code = 255u - (__builtin_bit_cast(unsigned, F[k]) & 0xFFu);
            const int ia = IDX[rowA * 16 + (code >> 4)], ib = IDX[rowB * 16 + (code & 15)];
            ex[k] = ia * PNK + ib;
            g[k] = __expf(F[k] - F[0]); gs += g[k];
        }
        const float ginv = 1.0f / gs;
#pragma unroll
        for (int q = 0; q < 4; ++q) {
            *(GAS f32x4*)(gates + prob * 16 + 4 * q) = (f32x4){g[4 * q] * ginv, g[4 * q + 1] * ginv, g[4 * q + 2] * ginv, g[4 * q + 3] * ginv};
            typedef int i32x4 __attribute__((ext_vector_type(4)));
            *(GAS i32x4*)(experts + prob * 16 + 4 * q) = (i32x4){ex[4 * q], ex[4 * q + 1], ex[4 * q + 2], ex[4 * q + 3]};
        }
    }
    __syncthreads();
}
__device__ __forceinline__ void topk_pass(int pass, const float* scores, int* experts, float* gates, LAS unsigned char* lds, int tid) {
    LAS float* S = (LAS float*)lds;
    const float* src = scores + (size_t)pass * (256 * 128);
#pragma unroll 4
    for (int i = 0; i < 16; ++i) { const int f4 = tid + NTHREADS * i, row = f4 >> 5, c4 = f4 & 31; *(LAS f32x4*)(S + row * TK_ROWF + 4 * c4) = *(const GAS f32x4*)(src + (size_t)f4 * 4); }
    __syncthreads();
    topk_core(lds, (size_t)pass * 128, 1, experts, gates, tid);
}
struct EpiTopKI8 {
    static constexpr bool PERM = false, AFTER_DRAIN = true;
    int* experts; float* gates; const float* sa; const float* sb;
    __device__ __forceinline__ void fused(pg8::i32x4 (&acc)[2][2][4][2], const pg8::Unit& u, int wr, int wc, int fr, int fq, LAS unsigned char* lds, int wid, int lane) const {
        LAS float* S = (LAS float*)lds;
        const int tid = wid * 64 + lane;
        pg8::f32x4 sbv[2][2];
#pragma unroll
        for (int bj = 0; bj < 2; ++bj)
#pragma unroll
            for (int n = 0; n < 2; ++n) sbv[bj][n] = *(const GAS pg8::f32x4*)(sb + u.pn * 256 + bj * 128 + 32 * wc + 16 * n + 4 * fq);
#pragma unroll
        for (int ai = 0; ai < 2; ++ai) {
#pragma unroll
            for (int mm = 0; mm < 4; ++mm) { const int rl = 64 * wr + 16 * mm + fr; const float sr = sa[u.pm * 256 + 128 * ai + rl];
#pragma unroll
                for (int bj = 0; bj < 2; ++bj)
#pragma unroll
                    for (int n = 0; n < 2; ++n) { const pg8::i32x4 a = acc[ai][bj][mm][n];
                        *(LAS pg8::f32x4*)(S + (2 * rl + bj) * TK_ROWF + 32 * wc + 16 * n + 4 * fq) = (pg8::f32x4){(float)a[0], (float)a[1], (float)a[2], (float)a[3]} * sbv[bj][n] * sr; } }
            __syncthreads();
            topk_core(lds, ((size_t)u.pm * 256 + 128 * ai) * PH + u.pn, PH, experts, gates, tid);
        }
    }
};
struct EpiTopK {
    static constexpr bool PERM = false, AFTER_DRAIN = true;
    int* experts; float* gates;
    __device__ __forceinline__ void fused(pg8::f32x4 (&acc)[2][2][4][2], const pg8::Unit& u, int wr, int wc, int fr, int fq, LAS unsigned char* lds, int wid, int lane) const {
        LAS float* S = (LAS float*)lds;
        const int tid = wid * 64 + lane;
#pragma unroll
        for (int ai = 0; ai < 2; ++ai) {
#pragma unroll
            for (int bj = 0; bj < 2; ++bj)
#pragma unroll
                for (int mm = 0; mm < 4; ++mm)
#pragma unroll
                    for (int n = 0; n < 2; ++n) { const int rl = 64 * wr + 16 * mm + fr; *(LAS pg8::f32x4*)(S + (2 * rl + bj) * TK_ROWF + 32 * wc + 16 * n + 4 * fq) = acc[ai][bj][mm][n]; }
            __syncthreads();
            topk_core(lds, ((size_t)u.pm * 256 + 128 * ai) * PH + u.pn, PH, experts, gates, tid);
        }
    }
};

__device__ __forceinline__ float gelu_erf(float v) { return 0.5f * v * (1.0f + erff(v * 0.70710678118654752f)); }
typedef __bf16 bf16x2_t __attribute__((ext_vector_type(2)));
typedef float f32x2_t __attribute__((ext_vector_type(2)));
__device__ __forceinline__ float dot2bf(bf16x2_t a, unsigned b, float acc) { return __builtin_amdgcn_fdot2_f32_bf16(a, __builtin_bit_cast(bf16x2_t, b), acc, false); }
__device__ __forceinline__ float dot4f8(unsigned w8, unsigned x01, unsigned x23, float acc) {
    acc = dot2bf(__builtin_amdgcn_cvt_scalef32_pk_bf16_fp8(w8, 1.0f, false), x01, acc);
    return dot2bf(__builtin_amdgcn_cvt_scalef32_pk_bf16_fp8(w8, 1.0f, true), x23, acc);
}
__device__ __forceinline__ void axpy4f8(float* y, unsigned w8, float w) {
    const f32x2_t lo = __builtin_amdgcn_cvt_pk_f32_fp8(w8, false), hi = __builtin_amdgcn_cvt_pk_f32_fp8(w8, true);
    y[0] += w * lo.x; y[1] += w * lo.y; y[2] += w * hi.x; y[3] += w * hi.y;
}
__device__ __forceinline__ void axpy4f8v(f32x2_t* y2, unsigned w8, float w) {
    const f32x2_t lo = __builtin_amdgcn_cvt_pk_f32_fp8(w8, false), hi = __builtin_amdgcn_cvt_pk_f32_fp8(w8, true);
    const f32x2_t ww = {w, w};
    y2[0] = __builtin_elementwise_fma(lo, ww, y2[0]); y2[1] = __builtin_elementwise_fma(hi, ww, y2[1]);
}
__device__ __forceinline__ void row_to_fp8(const float* src, unsigned char* dst, float* inv, int lane) {
    f32x4 v[2][4]; float mx = 0.f;
#pragma unroll
    for (int j = 0; j < 2; ++j)
#pragma unroll
        for (int q = 0; q < 4; ++q) { v[j][q] = *((const GAS f32x4*)src + 4 * (lane + 64 * j) + q);
            mx = fmaxf(mx, fmaxf(fmaxf(fabsf(v[j][q].x), fabsf(v[j][q].y)), fmaxf(fabsf(v[j][q].z), fabsf(v[j][q].w)))); }
#pragma unroll
    for (int o = 1; o < 64; o <<= 1) mx = fmaxf(mx, __shfl_xor(mx, o));
    const float sc = mx > 0.f ? 384.0f / mx : 1.0f;
#pragma unroll
    for (int j = 0; j < 2; ++j) { v4u o;
        int w;
        w = 0; w = __builtin_amdgcn_cvt_pk_fp8_f32(v[j][0].x * sc, v[j][0].y * sc, w, false); w = __builtin_amdgcn_cvt_pk_fp8_f32(v[j][0].z * sc, v[j][0].w * sc, w, true); o.x = (unsigned)w;
        w = 0; w = __builtin_amdgcn_cvt_pk_fp8_f32(v[j][1].x * sc, v[j][1].y * sc, w, false); w = __builtin_amdgcn_cvt_pk_fp8_f32(v[j][1].z * sc, v[j][1].w * sc, w, true); o.y = (unsigned)w;
        w = 0; w = __builtin_amdgcn_cvt_pk_fp8_f32(v[j][2].x * sc, v[j][2].y * sc, w, false); w = __builtin_amdgcn_cvt_pk_fp8_f32(v[j][2].z * sc, v[j][2].w * sc, w, true); o.z = (unsigned)w;
        w = 0; w = __builtin_amdgcn_cvt_pk_fp8_f32(v[j][3].x * sc, v[j][3].y * sc, w, false); w = __builtin_amdgcn_cvt_pk_fp8_f32(v[j][3].z * sc, v[j][3].w * sc, w, true); o.w = (unsigned)w;
        { const int ch = lane + 64 * j; *((GAS v4u*)(dst + (size_t)(ch >> 4) * SLICE_BYTES) + (ch & 15)) = o; } }
    if (lane == 0) *inv = mx > 0.f ? mx * (1.0f / 384.0f) : 1.0f;
}
__device__ __forceinline__ void row_to_i8(const float* src, unsigned char* dst, float* inv, int lane) {
    f32x4 v[2][4]; float mx = 0.f;
#pragma unroll
    for (int j = 0; j < 2; ++j)
#pragma unroll
        for (int q = 0; q < 4; ++q) { v[j][q] = *((const GAS f32x4*)src + 4 * (lane + 64 * j) + q);
            mx = fmaxf(mx, fmaxf(fmaxf(fabsf(v[j][q].x), fabsf(v[j][q].y)), fmaxf(fabsf(v[j][q].z), fabsf(v[j][q].w)))); }
#pragma unroll
    for (int o = 1; o < 64; o <<= 1) mx = fmaxf(mx, __shfl_xor(mx, o));
    const float sc = mx > 0.f ? 127.0f / mx : 1.0f;
#pragma unroll
    for (int j = 0; j < 2; ++j) { v4u o; o.x = pack_i8(v[j][0] * sc); o.y = pack_i8(v[j][1] * sc); o.z = pack_i8(v[j][2] * sc); o.w = pack_i8(v[j][3] * sc);
        { const int ch = lane + 64 * j; *((GAS v4u*)(dst + (size_t)(ch >> 4) * SLICE_BYTES) + (ch & 15)) = o; } }
    if (lane == 0) *inv = mx > 0.f ? mx * (1.0f / 127.0f) : 1.0f;
}
__device__ __forceinline__ float row16_allsum(float a) {
    a += __builtin_bit_cast(float, __builtin_amdgcn_update_dpp(0, __builtin_bit_cast(int, a), 0x128, 0xf, 0xf, false));
    a += __builtin_bit_cast(float, __builtin_amdgcn_update_dpp(0, __builtin_bit_cast(int, a), 0x124, 0xf, 0xf, false));
    a += __builtin_bit_cast(float, __builtin_amdgcn_update_dpp(0, __builtin_bit_cast(int, a), 0x122, 0xf, 0xf, false));
    a += __builtin_bit_cast(float, __builtin_amdgcn_update_dpp(0, __builtin_bit_cast(int, a), 0x121, 0xf, 0xf, false));
    return a;
}
__device__ __forceinline__ int q_pull(unsigned* q, int lane) { int v = 0; if (lane == 0) v = (int)__hip_atomic_fetch_add(q, 1u, __ATOMIC_RELAXED, __HIP_MEMORY_SCOPE_AGENT); return __builtin_amdgcn_readfirstlane(v); }
constexpr int PEER_TG = 8;
constexpr int PEER_N8 = 640, PEER_N4 = 512, PEER_N2 = 512, PEER_NTASK = PEER_N8 + PEER_N4 + PEER_N2;
__device__ __forceinline__ void peer_task_tokens(int idx, int& t0, int& n) {
    if (idx < PEER_N8) { t0 = 8 * idx; n = 8; } else if (idx < PEER_N8 + PEER_N4) { t0 = 8 * PEER_N8 + 4 * (idx - PEER_N8); n = 4; } else { t0 = 8 * PEER_N8 + 4 * PEER_N4 + 2 * (idx - PEER_N8 - PEER_N4); n = 2; }
}
__device__ __forceinline__ int row16_allsum_i(int a) {
    a += __builtin_amdgcn_update_dpp(0, a, 0x128, 0xf, 0xf, false);
    a += __builtin_amdgcn_update_dpp(0, a, 0x124, 0xf, 0xf, false);
    a += __builtin_amdgcn_update_dpp(0, a, 0x122, 0xf, 0xf, false);
    a += __builtin_amdgcn_update_dpp(0, a, 0x121, 0xf, 0xf, false);
    return a;
}
#define PA_LOAD(R, IDV, HALF) do { _Pragma("unroll") for (int i_ = 0; i_ < 8; ++i_) { const unsigned e_ = (unsigned)__shfl(IDV, 4 * (i_ + 8 * (HALF)) + g); \
        R[i_] = *(const GAS v4u*)(ub + (e_ * 256u + offc)); } } while (0)
#define PA_COMP(R, HALF) do { _Pragma("unroll") for (int i_ = 0; i_ < 8; ++i_) { int a_ = __builtin_amdgcn_sdot4((int)R[i_].x, (int)xc.x, 0, false); a_ = __builtin_amdgcn_sdot4((int)R[i_].y, (int)xc.y, a_, false); \
        a_ = __builtin_amdgcn_sdot4((int)R[i_].z, (int)xc.z, a_, false); a_ = __builtin_amdgcn_sdot4((int)R[i_].w, (int)xc.w, a_, false); r16[8 * (HALF) + i_] = row16_allsum_i(a_); } } while (0)
__device__ __forceinline__ void peer_a_task(int t0, int ntok, int s, const signed char* xq, const int* experts, const unsigned char* u8s, int* pa, int lane_) {
    int lane = lane_; asm volatile("" : "+v"(lane));
    const int g = lane >> 4, c = lane & 15;
    const GAS unsigned char* ub = (const GAS unsigned char*)(u8s + (size_t)s * SLICE_BYTES);
    const unsigned offc = 16u * (unsigned)c;
    int idc0 = experts[(size_t)t0 * 128 + lane], idc1 = experts[(size_t)t0 * 128 + lane + 64];
    v4u xc = *(const GAS v4u*)(xq + (size_t)t0 * D + 256 * s + 16 * c);
    v4u RA[8], RB[8];
    PA_LOAD(RA, idc0, 0);
#pragma unroll 1
    for (int tt = 0; tt < ntok; ++tt) {
        const int t = t0 + tt, tn = tt + 1 < ntok ? t + 1 : t;
        const int idn0 = experts[(size_t)tn * 128 + lane], idn1 = experts[(size_t)tn * 128 + lane + 64];
        const v4u xn = *(const GAS v4u*)(xq + (size_t)tn * D + 256 * s + 16 * c);
#pragma unroll 1
        for (int hb = 0; hb < 2; ++hb) {
            const int idv = hb ? idc1 : idc0, idx = hb ? idn0 : idc1;
            int r16[16];
            PA_LOAD(RB, idv, 1); PA_COMP(RA, 0);
            asm volatile("" ::: "memory");
            PA_LOAD(RA, idx, 0); PA_COMP(RB, 1);
            if (c == 15) { typedef int i32x4 __attribute__((ext_vector_type(4))); GAS i32x4* dst = (GAS i32x4*)(pa + ((size_t)t * 8 + s) * 128 + g * 32 + 16 * hb);
#pragma unroll
                for (int q = 0; q < 4; ++q) dst[q] = (i32x4){r16[4 * q], r16[4 * q + 1], r16[4 * q + 2], r16[4 * q + 3]}; }
        }
        idc0 = idn0; idc1 = idn1; xc = xn;
    }
}
constexpr int PA_CH = 112, PA_NCH = (M + PA_CH - 1) / PA_CH;
constexpr int PA_XT = 131072, PA_LOFF = PA_XT + PA_CH * 256;
static_assert(PA_LOFF + PA_NCH * 8 <= LDSCTL_OFF, "LDS map");
__device__ __forceinline__ void peer_bucket(int q, const int* experts, unsigned* seg, int* soff, LAS unsigned char* lds, int tid_) {
    int tid = tid_; asm volatile("" : "+v"(tid));
    LAS int* cnt = (LAS int*)lds;
    if (tid < 128) cnt[tid] = 0;
    __syncthreads();
    const int ntok = (M - q * PA_CH) < PA_CH ? (M - q * PA_CH) : PA_CH, nent = ntok * 128;
    const GAS int* ex = (const GAS int*)(experts + (size_t)q * PA_CH * 128);
    int ev[28];
#pragma unroll
    for (int j = 0; j < 28; ++j) { const int i = tid + NTHREADS * j; ev[j] = i < nent ? ex[i] : -1; }
#pragma unroll
    for (int j = 0; j < 28; ++j) if (ev[j] >= 0) __hip_atomic_fetch_add(cnt + (ev[j] >> 9), 1, __ATOMIC_RELAXED, __HIP_MEMORY_SCOPE_WORKGROUP);
    __syncthreads();
    if (tid < 64) { const int c = tid < 32 ? cnt[tid] : 0; int inc = c;
#pragma unroll
        for (int o = 1; o < 32; o <<= 1) { const int v = __shfl_up(inc, o); if (tid >= o) inc += v; }
        if (tid < 32) { cnt[32 + tid] = inc - c; soff[q * 33 + tid] = inc - c; if (tid == 31) soff[q * 33 + 32] = inc; } }
    __syncthreads();
    GAS unsigned* sg = (GAS unsigned*)(seg + (size_t)q * (PA_CH * 128));
#pragma unroll
    for (int j = 0; j < 28; ++j) if (ev[j] >= 0) { const int i = tid + NTHREADS * j, e = ev[j], r = e >> 9;
        const int p = cnt[32 + r] + __hip_atomic_fetch_add(cnt + 96 + r, 1, __ATOMIC_RELAXED, __HIP_MEMORY_SCOPE_WORKGROUP);
        sg[p] = ((unsigned)(i >> 7) << 16) | ((unsigned)(i & 127) << 9) | (unsigned)(e & 511); }
    __syncthreads();
}
__device__ __forceinline__ int peer_a_pair(unsigned ent, LAS unsigned char* lds, unsigned l16) {
    const unsigned ua = (ent & 511u) * 256u + l16, xa = (unsigned)PA_XT + (ent >> 16) * 256u + l16;
    v4u U[16], X[16];
#pragma unroll
    for (int j = 0; j < 16; ++j) { U[j] = *(const LAS v4u*)(lds + (ua ^ (unsigned)(j << 4))); X[j] = *(const LAS v4u*)(lds + (xa ^ (unsigned)(j << 4))); }
    __builtin_amdgcn_sched_barrier(0);
    int acc = 0;
#pragma unroll
    for (int j = 0; j < 16; ++j) {
        acc = __builtin_amdgcn_sdot4((int)U[j].x, (int)X[j].x, acc, false); acc = __builtin_amdgcn_sdot4((int)U[j].y, (int)X[j].y, acc, false);
        acc = __builtin_amdgcn_sdot4((int)U[j].z, (int)X[j].z, acc, false); acc = __builtin_amdgcn_sdot4((int)U[j].w, (int)X[j].w, acc, false); }
    return acc;
}
#define PAL_PREFETCH(Q) do { const int q_ = (Q); _Pragma("unroll") for (int j_ = 0; j_ < 4; ++j_) { int idx_ = tid + NTHREADS * j_; idx_ = idx_ < PA_CH * 16 ? idx_ : PA_CH * 16 - 1; \
        int tk_ = q_ * PA_CH + (idx_ >> 4); tk_ = tk_ < M ? tk_ : M - 1; xr[j_] = *(const GAS v4u*)(xb + ((size_t)tk_ * D + (size_t)((idx_ & 15) << 4))); } \
        const int nb_ = loff[2 * q_], nn_ = loff[2 * q_ + 1]; int ti_ = tid < nn_ ? tid : nn_ - 1; ti_ = ti_ > 0 ? ti_ : 0; ent = sg[nb_ + ti_]; } while (0)
__device__ __forceinline__ void peer_a_lds(int s, int r, const signed char* xq, const unsigned char* u8s, const unsigned* seg, const int* soff, int* pa, LAS unsigned char* lds, int tid_) {
    int tid = tid_; asm volatile("" : "+v"(tid));
    const unsigned l16 = (unsigned)(tid & 15) << 4;
    LAS int* loff = (LAS int*)(lds + PA_LOFF);
    { const GAS v4u* src = (const GAS v4u*)(u8s + (size_t)s * SLICE_BYTES + (size_t)r * 131072);
#pragma unroll 1
      for (int h = 0; h < 2; ++h) { v4u t[8];
#pragma unroll
          for (int j = 0; j < 8; ++j) t[j] = src[tid + NTHREADS * (8 * h + j)];
#pragma unroll
          for (int j = 0; j < 8; ++j) *(LAS v4u*)(lds + 16 * (tid + NTHREADS * (8 * h + j))) = t[j]; } }
    if (tid < PA_NCH) { const int b = soff[tid * 33 + r], e = soff[tid * 33 + r + 1]; loff[2 * tid] = tid * (PA_CH * 128) + b; loff[2 * tid + 1] = e - b; }
    __syncthreads();
    const GAS unsigned char* xb = (const GAS unsigned char*)(xq + 256 * s);
    const GAS unsigned* sg = (const GAS unsigned*)seg;
    v4u xr[4]; unsigned ent;
#pragma unroll
    for (int j = 0; j < 4; ++j) xr[j] = (v4u){0u, 0u, 0u, 0u};
    PAL_PREFETCH(0);
#pragma unroll 1
    for (int q = 0; q < PA_NCH; ++q) {
        __syncthreads();
#pragma unroll
        for (int j = 0; j < 4; ++j) { const int idx = tid + NTHREADS * j; if (idx < PA_CH * 16) *(LAS v4u*)(lds + PA_XT + 16 * idx) = xr[j]; }
        __syncthreads();
        const int nb = loff[2 * q], n = loff[2 * q + 1]; const unsigned e0 = ent;
        if (q + 1 < PA_NCH) PAL_PREFETCH(q + 1);
        if (tid < n) { const int a = peer_a_pair(e0, lds, l16); const unsigned k = (e0 >> 9) & 127u;
            pa[((size_t)(q * PA_CH + (int)(e0 >> 16)) * 8 + s) * 128 + (k & 3u) * 32u + (k >> 2)] = a; }
#pragma unroll 1
        for (int i = tid + NTHREADS; i < n; i += NTHREADS) { const unsigned e1 = seg[nb + i]; const int a = peer_a_pair(e1, lds, l16); const unsigned k = (e1 >> 9) & 127u;
            pa[((size_t)(q * PA_CH + (int)(e1 >> 16)) * 8 + s) * 128 + (k & 3u) * 32u + (k >> 2)] = a; }
    }
    __syncthreads();
}
__device__ __forceinline__ void peer_w_elem(size_t i, const int* experts, const float* gates, const float* su, const float* sv, const float* sx, const int* pa, float* wb) {
    const size_t t = i >> 7; const int k = (int)(i & 127), pos = (k & 3) * 32 + (k >> 2);
    const int e = experts[i];
    int a = 0;
#pragma unroll
    for (int s2 = 0; s2 < 8; ++s2) a += pa[(t * 8 + s2) * 128 + pos];
    wb[i] = gates[i] * gelu_erf((float)a * (su[e] * sx[t])) * sv[e];
}
#define PB_LOAD(R, IDV, HALF) do { _Pragma("unroll") for (int i_ = 0; i_ < 8; ++i_) { const unsigned e_ = (unsigned)__shfl(IDV, 4 * (i_ + 8 * (HALF)) + g); \
        R[i_] = *(const GAS v4u*)(vb + (e_ * 256u + offc)); } } while (0)
#define PB_COMP(R, WV, HALF) do { _Pragma("unroll") for (int i_ = 0; i_ < 8; ++i_) { const float wk_ = __shfl(WV, 4 * (i_ + 8 * (HALF)) + g); \
        axpy4f8v(&ya2[0], R[i_].x, wk_); axpy4f8v(&ya2[2], R[i_].y, wk_); axpy4f8v(&ya2[4], R[i_].z, wk_); axpy4f8v(&ya2[6], R[i_].w, wk_); } } while (0)
__device__ __forceinline__ void peer_b_task(int t0, int ntok, int s, const bf16* h1, const int* experts, const float* wb, const unsigned char* v8s, bf16* out, float* st, int lane_) {
    int lane = lane_; asm volatile("" : "+v"(lane));
    const int g = lane >> 4, c = lane & 15;
    const GAS unsigned char* vb = (const GAS unsigned char*)(v8s + (size_t)s * SLICE_BYTES);
    const unsigned offc = 16u * (unsigned)c;
    int idc0 = experts[(size_t)t0 * 128 + lane], idc1 = experts[(size_t)t0 * 128 + lane + 64];
    float wc0 = wb[(size_t)t0 * 128 + lane], wc1 = wb[(size_t)t0 * 128 + lane + 64];
    v4u RA[8], RB[8];
    PB_LOAD(RA, idc0, 0);
#pragma unroll 1
    for (int tt = 0; tt < ntok; ++tt) {
        const int t = t0 + tt, tn = tt + 1 < ntok ? t + 1 : t;
        const int idn0 = experts[(size_t)tn * 128 + lane], idn1 = experts[(size_t)tn * 128 + lane + 64];
        const float wn0 = wb[(size_t)tn * 128 + lane], wn1 = wb[(size_t)tn * 128 + lane + 64];
        f32x2_t ya2[8];
#pragma unroll
        for (int e = 0; e < 8; ++e) ya2[e] = (f32x2_t){0.f, 0.f};
#pragma unroll 1
        for (int hb = 0; hb < 2; ++hb) {
            const int idv = hb ? idc1 : idc0, idx = hb ? idn0 : idc1; const float wv = hb ? wc1 : wc0;
            PB_LOAD(RB, idv, 1); PB_COMP(RA, wv, 0);
            asm volatile("" ::: "memory");
            PB_LOAD(RA, idx, 0); PB_COMP(RB, wv, 1);
        }
        float ya[16];
#pragma unroll
        for (int e = 0; e < 8; ++e) { ya[2 * e] = ya2[e].x; ya[2 * e + 1] = ya2[e].y; }
#pragma unroll
        for (int e = 0; e < 16; ++e) { ya[e] += __shfl_xor(ya[e], 16); ya[e] += __shfl_xor(ya[e], 32); }
        const GAS v4u* hp = (const GAS v4u*)(h1 + (size_t)t * D + 256 * s + 16 * c);
        const v4u h0 = hp[0], h1v = hp[1];
        float hx[16];
        hx[0] = pg8::bf_lo(h0.x); hx[1] = pg8::bf_hi(h0.x); hx[2] = pg8::bf_lo(h0.y); hx[3] = pg8::bf_hi(h0.y); hx[4] = pg8::bf_lo(h0.z); hx[5] = pg8::bf_hi(h0.z); hx[6] = pg8::bf_lo(h0.w); hx[7] = pg8::bf_hi(h0.w);
        hx[8] = pg8::bf_lo(h1v.x); hx[9] = pg8::bf_hi(h1v.x); hx[10] = pg8::bf_lo(h1v.y); hx[11] = pg8::bf_hi(h1v.y); hx[12] = pg8::bf_lo(h1v.z); hx[13] = pg8::bf_hi(h1v.z); hx[14] = pg8::bf_lo(h1v.w); hx[15] = pg8::bf_hi(h1v.w);
        float sm = 0.f, sq = 0.f;
#pragma unroll
        for (int e = 0; e < 16; ++e) { ya[e] = hx[e] * ALPHA + ya[e]; sm += ya[e]; sq += ya[e] * ya[e]; }
        sm = row16_allsum(sm); sq = row16_allsum(sq);
        if (g == 0) { GAS v4u* op = (GAS v4u*)(out + (size_t)t * D + 256 * s + 16 * c);
            v4u o0, o1; o0.x = pk2(ya[0], ya[1]); o0.y = pk2(ya[2], ya[3]); o0.z = pk2(ya[4], ya[5]); o0.w = pk2(ya[6], ya[7]);
            o1.x = pk2(ya[8], ya[9]); o1.y = pk2(ya[10], ya[11]); o1.z = pk2(ya[12], ya[13]); o1.w = pk2(ya[14], ya[15]);
            op[0] = o0; op[1] = o1;
            if (c == 0) { st[((size_t)t * 8 + s) * 2] = sm; st[((size_t)t * 8 + s) * 2 + 1] = sq; } }
        idc0 = idn0; idc1 = idn1; wc0 = wn0; wc1 = wn1;
    }
}
__device__ __forceinline__ void peer_c_row(int t, const bf16* r2, float* out, const float* st, const float* g2, const float* b2, int lane) {
    float sm = 0.f, sq = 0.f;
#pragma unroll
    for (int s = 0; s < 8; ++s) { sm += st[((size_t)t * 8 + s) * 2]; sq += st[((size_t)t * 8 + s) * 2 + 1]; }
    const float mean = sm * (1.f / D), var = sq * (1.f / D) - mean * mean, rstd = 1.f / sqrtf(fmaxf(var, 0.f) + LN_EPS);
    const GAS v4u* xr = (const GAS v4u*)(r2 + (size_t)t * D) + lane;
    GAS f32x4* op = (GAS f32x4*)(out + (size_t)t * D);
#pragma unroll
    for (int j = 0; j < 4; ++j) { const v4u w = xr[64 * j]; const int c4 = 2 * (lane + 64 * j);
        const f32x4 g0 = *((const GAS f32x4*)g2 + c4), g1 = *((const GAS f32x4*)g2 + c4 + 1), b0 = *((const GAS f32x4*)b2 + c4), b1 = *((const GAS f32x4*)b2 + c4 + 1);
        const f32x4 v0 = (f32x4){pg8::bf_lo(w.x), pg8::bf_hi(w.x), pg8::bf_lo(w.y), pg8::bf_hi(w.y)}, v1 = (f32x4){pg8::bf_lo(w.z), pg8::bf_hi(w.z), pg8::bf_lo(w.w), pg8::bf_hi(w.w)};
        op[c4] = (v0 - mean) * rstd * g0 + b0; op[c4 + 1] = (v1 - mean) * rstd * g1 + b1; }
}

struct TwoPassOrder : pg8::StaticOrder {
    __device__ __forceinline__ bool next(int i, pg8::Unit& u) const { if (!pg8::StaticOrder::next(i >> 1, u)) return false; u.w = i & 1; return true; }
};
struct EpiGate2 {
    static constexpr bool PERM = true, AFTER_DRAIN = false;
    pg8::EpiGate<0> e0; pg8::EpiGate<1> e1;
    __device__ __forceinline__ void operator()(const pg8::f32x4 (&acc)[2][2][4][2], const pg8::Unit& u, int wr, int wc, int fr, int fq) const { if (u.w == 0) e0(acc, u, wr, wc, fr, fq); else e1(acc, u, wr, wc, fr, fq); }
};

struct EpiGate2I8 {
    static constexpr bool PERM = true, AFTER_DRAIN = false;
    pg8::EpiGateI8<0> e0; pg8::EpiGateI8<1> e1;
    __device__ __forceinline__ void operator()(const pg8::i32x4 (&acc)[2][2][4][2], const pg8::Unit& u, int wr, int wc, int fr, int fq) const { if (u.w == 0) e0(acc, u, wr, wc, fr, fq); else e1(acc, u, wr, wc, fr, fq); }
};
struct ConvOrder : pg8::StaticOrder {
    const float* pu; const float* pv; unsigned char* u8; unsigned char* v8; float* su; float* sv; int slot; mutable int calls;
    static constexpr int CONV_ROWS = 4, CONV_CALLS = 6;
    __device__ __forceinline__ void done(const pg8::Unit&) const {
        if (slot < 0) return;
        int lane = threadIdx.x & 63; asm volatile("" : "+v"(lane));
        const int wave = __builtin_amdgcn_readfirstlane(threadIdx.x >> 6);
        const int base = ((slot * NWAVES + wave) * CONV_CALLS + calls) * CONV_ROWS;
        if (calls < CONV_CALLS) {
#pragma unroll 1
            for (int j = 0; j < CONV_ROWS; ++j) { const int r = base + j; if (r < 2 * PNE) { const bool sec = r >= PNE; const int e = sec ? r - PNE : r;
                if (sec) row_to_fp8(pv + (size_t)e * D, v8 + (size_t)e * 256, sv + e, lane); else row_to_i8(pu + (size_t)e * D, u8 + (size_t)e * 256, su + e, lane); } }
        }
        ++calls;
    }
};

struct Args { const float* in[16]; float* out; unsigned char* ws; int ph_lo, ph_hi; };
__global__ void __launch_bounds__(NTHREADS, 2) mk_fwd(Args args) {
    extern __shared__ __attribute__((aligned(16))) unsigned char lds_raw[];
    LAS unsigned char* lds = (LAS unsigned char*)lds_raw;
    volatile LAS unsigned* MISC = (volatile LAS unsigned*)(lds + MISC_OFF);
    const int tid0 = threadIdx.x;
    const int G = gridDim.x, bx = blockIdx.x;
    unsigned char* ws = args.ws;
    gu32* ctl = (gu32*)(ws + WS_CTL);
#define IN_(i) (args.in[i])
#define x_in IN_(0)
#define w_in IN_(1)
#define b_gate IN_(2)
#define sinks IN_(3)
#define conv_w IN_(4)
#define w_ao IN_(5)
#define w_co IN_(6)
#define w_o IN_(7)
#define ln1_g IN_(8)
#define ln1_b IN_(9)
#define w_q IN_(10)
#define sub_keys IN_(11)
#define peer_u IN_(12)
#define peer_v IN_(13)
#define ln2_g IN_(14)
#define ln2_b IN_(15)
#define WinT ((bf16*)(ws + WS_WIN))
#define WaT ((bf16*)(ws + WS_WA))
#define WcT ((bf16*)(ws + WS_WC))
#define WoT ((bf16*)(ws + WS_WO))
#define WfT ((bf16*)(ws + WS_WF))
#define XB ((bf16*)(ws + WS_XB))
#define MERGED ((bf16*)(ws + WS_MERGED))
#define Z ((bf16*)(ws + WS_Z))
#define R2B ((bf16*)(ws + WS_R2B))
#define H1B ((bf16*)(ws + WS_H1B))
#define SC ((float*)(ws + WS_SC))
#define EX ((int*)(ws + WS_EX))
#define GT ((float*)(ws + WS_GT))
#define AO ((bf16*)(ws + WS_AO))
#define CI ((bf16*)(ws + WS_CI))
#define TMP ((bf16*)(ws + WS_TMP))
#define U8 ((unsigned char*)(ws + WS_U8))
#define V8 ((unsigned char*)(ws + WS_V8))
#define SU ((float*)(ws + WS_SU))
#define SV ((float*)(ws + WS_SV))
#define PA ((int*)(ws + WS_PA))
#define ST ((float*)(ws + WS_ST))
#define WB ((float*)(ws + WS_WB))
#define XA8 ((signed char*)(ws + WS_XA8))
#define WIN8 ((signed char*)(ws + WS_WIN8))
#define SWIN ((float*)(ws + WS_SWIN))
#define SXA ((float*)(ws + WS_SXA))
#define WF8 ((signed char*)(ws + WS_WF8))
#define MG8 ((signed char*)(ws + WS_MG8))
#define WO8 ((signed char*)(ws + WS_WO8))
#define SMG ((float*)(ws + WS_SMG))
#define SWO ((float*)(ws + WS_SWO))
#define AO8 ((signed char*)(ws + WS_AO8))
#define CI8 ((signed char*)(ws + WS_CI8))
#define WA8 ((signed char*)(ws + WS_WA8))
#define WC8 ((signed char*)(ws + WS_WC8))
#define SAO ((float*)(ws + WS_S3))
#define SCI ((float*)(ws + WS_S3 + 65536))
#define SWA ((float*)(ws + WS_S3 + 131072))
#define SWC ((float*)(ws + WS_S3 + 196608))
#define SWF ((float*)(ws + WS_SWF))
#define XQ ((signed char*)(ws + WS_XQ))
#define SX ((float*)(ws + WS_SX))
#define SEG ((unsigned*)(ws + WS_SEG))
#define SOFF ((int*)(ws + WS_SOFF))
    for (int u = tid0; u < (LDS_BYTES - LDSCTL_OFF) / 4; u += NTHREADS) ((LAS unsigned*)(lds + LDSCTL_OFF))[u] = 0u;
    __syncthreads();
    XcdBarrier bar; bar.bar = (unsigned*)(ctl + CW_BAR); bar.x = 0; bar.st = nullptr;
    if (!MK_PER_PHASE) bar = xcd_barrier_post((unsigned*)(ctl + CW_BAR), MISC + 8);
    const int lo = args.ph_lo, hi = args.ph_hi;
#ifndef PH_MASK
#define PH_MASK 0xFFF
#endif
#define IN(k) (((PH_MASK >> (k)) & 1) && lo <= (k) && (k) < hi)
#ifndef DBL_BAR
#define DBL_BAR 0
#endif
#define SEAM(k) do { if (IN(k) && IN((k) + 1)) { xcd_barrier(bar); if (DBL_BAR) xcd_barrier(bar); } } while (0)
#ifndef DBL_MASK
#define DBL_MASK 0
#endif
#define REP(k) for (int rep_ = 0; rep_ < 1 + ((DBL_MASK >> (k)) & 1); ++rep_)
#define PHASE_TID() int tid = tid0; asm volatile("" : "+v"(tid)); const int lane = tid & 63, wave = __builtin_amdgcn_readfirstlane(tid >> 6); (void)lane; (void)wave

    if (IN(0)) REP(0) {
        PHASE_TID();
        const bool conv_first = ((bx >> 3) & 1) == 0;
#pragma unroll 1
        for (int part = 0; part < 2; ++part) {
            if ((part == 0) == conv_first) {
                int tid = tid0; asm volatile("" : "+v"(tid)); const int lane = tid & 63, wave = __builtin_amdgcn_readfirstlane(tid >> 6);
                LAS float* scr = (LAS float*)(lds + wave * 16384);
                const int gw = bx * NWAVES + wave, NGW = G * NWAVES;
                constexpr int I_IN = (D / 64) * (IN_W / 32), I_SQ = (D / 64) * (D / 32);
                for (int it = gw; it < I_IN + 3 * I_SQ; it += NGW) {
                    int r = it;
                    if (r < I_IN) { p0_transpose_item(w_in, D, IN_W, WinT, scr, r, lane); continue; } r -= I_IN;
                    if (r < I_SQ) { p0_transpose_item(w_ao, D, D, WaT, scr, r, lane); continue; } r -= I_SQ;
                    if (r < I_SQ) { p0_transpose_item(w_co, D, D, WcT, scr, r, lane); continue; } r -= I_SQ;
                    p0_transpose_item(w_o, D, D, WoT, scr, r, lane);
                }
                for (int r = gw; r < M; r += NGW) row_f32_to_i8(x_in + (size_t)r * D, XA8 + (size_t)r * D, SXA + r, lane);
                __syncthreads();
            }
            if (part == 0) for (int it = bx; it < 16 * 32; it += G) p0_wf_item(w_q, sub_keys, WfT, lds, it, tid);
        }
    }
    SEAM(0);
    if (IN(1)) REP(1) {
        { PHASE_TID();
          for (int r = bx * NWAVES + wave; r < IN_W + 2 * D; r += G * NWAVES) { if (r < IN_W) row_bf16_to_i8(WinT + (size_t)r * D, WIN8 + (size_t)r * D, SWIN + r, lane);
              else if (r < IN_W + D) { const int q = r - IN_W; row_bf16_to_i8(WfT + (size_t)q * D, WF8 + (size_t)q * D, SWF + q, lane); }
              else { const int q = r - IN_W - D; row_bf16_to_i8(WoT + (size_t)q * D, WO8 + (size_t)q * D, SWO + q, lane); } } }
        if (!MK_PER_PHASE) xcd_barrier(bar);
        pg8::Gemm g{(const bf16*)XA8, (const bf16*)WIN8, M, IN_W, D / 2}; ConvOrder S; S.init(M, IN_W, G, bx);
        S.pu = peer_u; S.pv = peer_v; S.u8 = U8; S.v8 = V8; S.su = SU; S.sv = SV; S.calls = 0;
        S.slot = (G == 256 && bx >= 64) ? bx - 64 : -1;
        pg8::EpiI8Bf16 E{Z, IN_W, SXA, SWIN};
        pg8::gemm_phase<pg8::EpiI8Bf16, ConvOrder, true, true, true>(lds, g, S, E);
        if (G != 256) {
            PHASE_TID();
            for (int r = bx * NWAVES + wave; r < 2 * PNE; r += G * NWAVES) { const bool sec = r >= PNE; const int e = sec ? r - PNE : r;
                if (sec) row_to_fp8(peer_v + (size_t)e * D, V8 + (size_t)e * 256, SV + e, lane); else row_to_i8(peer_u + (size_t)e * D, U8 + (size_t)e * 256, SU + e, lane); }
        }
    }
    SEAM(1);
    if (IN(2)) REP(2) {
        PHASE_TID();
        const bool conv_first = ((bx >> 3) & 1) == 0;
#pragma unroll 1
        for (int part = 0; part < 2; ++part) {
            if ((part == 0) == conv_first) { int t2 = tid0; asm volatile("" : "+v"(t2)); for (int it = bx; it < M / 32; it += G) conv_item(it, Z, conv_w, CI, t2); }
            if (part == 0) for (int u = bx; u < BATCH * NKVH * 16; u += G) attn_unit(u, Z, AO, sinks, lds, tid);
        }
    }
    SEAM(2);
    if (IN(3)) REP(3) {
        TwoPassOrder S; S.init(M, D, G, bx);
#ifndef P3_I8
#define P3_I8 1
#endif
        if (P3_I8 && !MK_PER_PHASE) {
            { PHASE_TID();
              for (int r = bx * NWAVES + wave; r < 2 * M + 2 * D; r += G * NWAVES) {
                  if (r < M) row_bf16_to_i8(AO + (size_t)r * D, AO8 + (size_t)r * D, SAO + r, lane);
                  else if (r < 2 * M) { const int q = r - M; row_bf16_to_i8(CI + (size_t)q * D, CI8 + (size_t)q * D, SCI + q, lane); }
                  else if (r < 2 * M + D) { const int q = r - 2 * M; row_bf16_to_i8(WaT + (size_t)q * D, WA8 + (size_t)q * D, SWA + q, lane); }
                  else { const int q = r - 2 * M - D; row_bf16_to_i8(WcT + (size_t)q * D, WC8 + (size_t)q * D, SWC + q, lane); } } }
            xcd_barrier(bar);
            pg8::Gemm g{(const bf16*)AO8, (const bf16*)WA8, M, D, D / 2, (const bf16*)CI8, (const bf16*)WC8};
            EpiGate2I8 E{pg8::EpiGateI8<0>{TMP, nullptr, Z + G_OFF, b_gate, D, IN_W, SAO, SWA}, pg8::EpiGateI8<1>{MERGED, TMP, Z + G_OFF + D, b_gate + D, D, IN_W, SCI, SWC}};
            pg8::gemm_phase<EpiGate2I8, TwoPassOrder, true, true, true>(lds, g, S, E);
        } else {
        pg8::Gemm g{AO, WaT, M, D, D, CI, WcT};
        EpiGate2 E{pg8::EpiGate<0>{TMP, nullptr, Z + G_OFF, b_gate, D, IN_W}, pg8::EpiGate<1>{MERGED, TMP, Z + G_OFF + D, b_gate + D, D, IN_W}};
        pg8::gemm_phase<EpiGate2, TwoPassOrder, true, true>(lds, g, S, E);
        }
    }
    SEAM(3);
    if (IN(4)) REP(4) {
        pg8::StaticOrder S; S.init(M, D, G, bx);
#ifndef P4_I8
#define P4_I8 1
#endif
        if (P4_I8 && !MK_PER_PHASE) {
            { PHASE_TID(); for (int r = bx * NWAVES + wave; r < M; r += G * NWAVES) row_bf16_to_i8(MERGED + (size_t)r * D, MG8 + (size_t)r * D, SMG + r, lane); }
            xcd_barrier(bar);
            pg8::Gemm g{(const bf16*)MG8, (const bf16*)WO8, M, D, D / 2};
            pg8::EpiResI8Bf16 E{H1B, D, x_in, ALPHA, SMG, SWO};
            pg8::gemm_phase<pg8::EpiResI8Bf16, pg8::StaticOrder, true, true, true>(lds, g, S, E);
        } else {
        pg8::Gemm g{MERGED, WoT, M, D, D};
        pg8::EpiResBf16 E{H1B, D, x_in, ALPHA};
        pg8::gemm_phase<pg8::EpiResBf16, pg8::StaticOrder, true, true>(lds, g, S, E);
        }
    }
    SEAM(4);
    if (IN(5)) REP(5) {
        PHASE_TID();
        const int gw = bx * NWAVES + wave, NGW = G * NWAVES;
        for (int m = gw; m < M; m += NGW) ln1_row(H1B + (size_t)m * D, XQ + (size_t)m * D, SX + m, ln1_g, ln1_b, lane);
    }
    SEAM(5);
    if (IN(6)) REP(6) {
        pg8::Gemm g{H1B, WfT, M, D, D}; pg8::StaticOrder S; S.init(M, D, G, bx);
#ifndef P6_I8
#define P6_I8 1
#endif
        if (G == 256 && P6_I8) { pg8::Gemm g8{(const bf16*)XQ, (const bf16*)WF8, M, D, D / 2}; EpiTopKI8 E{EX, GT, SX, SWF}; pg8::gemm_phase<EpiTopKI8, pg8::StaticOrder, false, true, true>(lds, g8, S, E); }
        else if (G == 256) { EpiTopK E{EX, GT}; pg8::gemm_phase<EpiTopK, pg8::StaticOrder, false, true>(lds, g, S, E); }
        else { pg8::EpiF32 E{SC, D, nullptr, 0.f}; pg8::gemm_phase<pg8::EpiF32, pg8::StaticOrder, true, true>(lds, g, S, E); }
    }
    SEAM(6);
    if (IN(7)) REP(7) {
        PHASE_TID();
        if (G != 256) for (int p = bx; p < (M * PH) / 128; p += G) topk_pass(p, SC, EX, GT, lds, tid);
        else if (bx < PA_NCH) peer_bucket(bx, EX, SEG, SOFF, lds, tid);
    }
    SEAM(7);
    if (IN(8)) REP(8) {
        PHASE_TID();
        if (G == 256) peer_a_lds(bx & 7, bx >> 3, XQ, U8, SEG, SOFF, PA, lds, tid);
        else {
        const int xcc = (int)(xb_xcc_id() & 7u);
#pragma unroll 1
#ifndef SCRAMBLE
#define SCRAMBLE 0
#endif
        for (int sl = 0; sl < 8; ++sl) { const int s = (xcc + sl + (SCRAMBLE ? wave : 0)) & 7;
            for (;;) { const int tg = q_pull((unsigned*)(ctl + CW_Q + 64 * (s + 16 * rep_)), lane); if (tg >= PEER_NTASK) break;
                int t0, nt; peer_task_tokens(tg, t0, nt); peer_a_task(t0, nt, s, XQ, EX, U8, PA, lane); } }
        }
    }
    SEAM(8);
    if (IN(9)) REP(9) {
        PHASE_TID();
        for (size_t i = (size_t)bx * NTHREADS + tid; i < (size_t)M * 128; i += (size_t)G * NTHREADS) peer_w_elem(i, EX, GT, SU, SV, SX, PA, WB);
    }
    SEAM(9);
    if (IN(10)) REP(10) {
        PHASE_TID();
        const int xcc = (int)(xb_xcc_id() & 7u);
#pragma unroll 1
#ifndef SCRAMBLE
#define SCRAMBLE 0
#endif
        for (int sl = 0; sl < 8; ++sl) { const int s = (xcc + sl + (SCRAMBLE ? wave : 0)) & 7;
            for (;;) { const int tg = q_pull((unsigned*)(ctl + CW_Q + 64 * (8 + s + 16 * rep_)), lane); if (tg >= PEER_NTASK) break;
                int t0, nt; peer_task_tokens(tg, t0, nt); peer_b_task(t0, nt, s, H1B, EX, WB, V8, R2B, ST, lane); } }
    }
    SEAM(10);
    if (IN(11)) REP(11) {
        PHASE_TID();
        const int gw = bx * NWAVES + wave, NGW = G * NWAVES;
        for (int t = gw; t < M; t += NGW) peer_c_row(t, R2B, args.out, ST, ln2_g, ln2_b, lane);
    }
#undef IN
#undef SEAM
}

extern "C" void kernel_launch(void* const* d_in, const int* in_sizes, int n_in, void* d_out, int out_size, void* d_ws, size_t ws_size, hipStream_t stream) {
    static int grid = 0;
    if (grid == 0) {
        if (n_in != 16 || out_size != M * D || ws_size < WS_END) { fprintf(stderr, "kernel_launch: unexpected shapes (n_in %d out %d ws %zu)\n", n_in, out_size, ws_size); grid = -1; return; }
        int dev = 0, cus = 0, per_cu = 0;
        if (hipGetDevice(&dev) != hipSuccess || hipDeviceGetAttribute(&cus, hipDeviceAttributeMultiprocessorCount, dev) != hipSuccess) { grid = -1; return; }
        if (hipFuncSetAttribute((const void*)mk_fwd, hipFuncAttributeMaxDynamicSharedMemorySize, LDS_BYTES) != hipSuccess) { fprintf(stderr, "kernel_launch: hipFuncSetAttribute failed\n"); grid = -1; return; }
        if (hipOccupancyMaxActiveBlocksPerMultiprocessor(&per_cu, (const void*)mk_fwd, NTHREADS, LDS_BYTES) != hipSuccess || per_cu < 1) { fprintf(stderr, "kernel_launch: occupancy query says %d\n", per_cu); per_cu = 1; }
        (void)hipGetLastError();
        if (per_cu > 1) per_cu = 1;
        grid = cus * per_cu;
    }
    if (grid < 0) return;
    if (hipMemsetAsync((char*)d_ws + WS_CTL, 0, CTL_ZERO_BYTES, stream) != hipSuccess) { fprintf(stderr, "kernel_launch: memset failed\n"); return; }
    Args a{};
    for (int i = 0; i < 16; ++i) a.in[i] = (const float*)d_in[i];
    a.out = (float*)d_out; a.ws = (unsigned char*)d_ws;
#if MK_PER_PHASE
    for (int p = 0; p < N_PHASES; ++p) { a.ph_lo = p; a.ph_hi = p + 1; hipLaunchKernelGGL(mk_fwd, dim3(grid), dim3(NTHREADS), LDS_BYTES, stream, a); }
#else
    a.ph_lo = 0; a.ph_hi = N_PHASES;
    void* kargs[] = {&a};
#ifdef PLAIN_LAUNCH
    (void)kargs; hipLaunchKernelGGL(mk_fwd, dim3(grid), dim3(NTHREADS), LDS_BYTES, stream, a); hipError_t e = hipPeekAtLastError();
#else
    hipError_t e = hipLaunchCooperativeKernel((const void*)mk_fwd, dim3(grid), dim3(NTHREADS), kargs, LDS_BYTES, stream);
#endif
    if (e != hipSuccess) fprintf(stderr, "kernel_launch: cooperative launch failed: %s (grid %d)\n", hipGetErrorString(e), grid);
#endif
}
```

```cpp
#include <hip/hip_runtime.h>
#include <cstdio>
#include <cstdint>
#include <type_traits>
namespace pg8 {
#define PG8_LAS __attribute__((address_space(3)))
typedef unsigned short bf16_t;
typedef short bf16x8 __attribute__((ext_vector_type(8)));
typedef float f32x4 __attribute__((ext_vector_type(4)));
typedef unsigned u32x4 __attribute__((ext_vector_type(4)));
constexpr int BM = 256, BK = 64, HALF = 128, HTB = HALF * BK * 2  , STAGE_BYTES = 8 * HTB, NXCD = 8, WGM = 8;

__host__ __device__ __forceinline__ int lds_byte(int r, int c) { const int st = (r >> 4) * 2 + (c >> 5), rr = r & 15, cc = c & 31, ob = rr * 64 + cc * 2; return st * 1024 + (ob ^ (((ob >> 9) & 1) << 5)); }
__host__ __device__ __forceinline__ void stage_rc(int b, int& R, int& C) { const int st = b / 1024, sb = b % 1024, swz = sb ^ (((sb >> 9) & 1) << 5); R = (st >> 1) * 16 + swz / 64; C = (st & 1) * 32 + (swz % 64) / 2; }
__host__ __device__ __forceinline__ int perm32(int rho) { const int n = rho >> 4, i = rho & 15; return 8 * (i >> 2) + 4 * n + (i & 3); }

struct Unit { int pm, pn, w; };
struct Gemm { const bf16_t* A; const bf16_t* Bt; int M, N, K; const bf16_t* A2 = nullptr; const bf16_t* Bt2 = nullptr; };

struct StaticOrder {
    int nM, nN, nwg, G, c;
    __host__ __device__ void init(int M, int N, int G_, int c_) { nM = M / BM; nN = N / BM; nwg = nM * nN; G = G_; c = c_; }
    __host__ __device__ bool next(int i, Unit& u) const {
        const long L = (long)i * G + c; if (L >= nwg) return false;
        int wgid = (int)L; { const int q = nwg / NXCD, r = nwg % NXCD, xcd = wgid % NXCD, off = wgid / NXCD; wgid = (xcd < r ? xcd * (q + 1) : r * (q + 1) + (xcd - r) * q) + off; }
        const int nig = WGM * nN, gid = wgid / nig, fm = gid * WGM, gsz = (nM - fm) < WGM ? (nM - fm) : WGM;
        u.pm = fm + ((wgid % nig) % gsz); u.pn = (wgid % nig) / gsz; u.w = 0; return true;
    }
    __device__ __forceinline__ void a_ready(const Unit&) const {}
    __device__ __forceinline__ void done(const Unit&) const {}
};


__device__ __forceinline__ unsigned cvt_pk_bf16(float lo, float hi) { unsigned r; asm volatile("v_cvt_pk_bf16_f32 %0, %1, %2" : "=v"(r) : "v"(lo), "v"(hi)); return r; }
__device__ __forceinline__ float bf_lo(unsigned w) { return __builtin_bit_cast(float, w << 16); }
__device__ __forceinline__ float bf_hi(unsigned w) { return __builtin_bit_cast(float, w & 0xffff0000u); }
__device__ __forceinline__ float sigmoidf_(float x) { return __builtin_amdgcn_rcpf(1.0f + __expf(-x)); }

struct EpiBf16 {
    static constexpr bool PERM = true, AFTER_DRAIN = false;
    bf16_t* O; int ldc;
    __device__ __forceinline__ void operator()(const f32x4 (&acc)[2][2][4][2], const Unit& u, int wr, int wc, int fr, int fq) const {
        const int row0 = u.pm * BM + wr * 64 + fr, col0 = u.pn * BM + wc * 32 + 8 * fq;
#pragma unroll
        for (int ai = 0; ai < 2; ++ai)
#pragma unroll
            for (int m = 0; m < 4; ++m) { bf16_t* rowp = O + (size_t)(row0 + ai * HALF + m * 16) * ldc + col0;
#pragma unroll
                for (int bj = 0; bj < 2; ++bj) { const f32x4 v0 = acc[ai][bj][m][0], v1 = acc[ai][bj][m][1];
                    u32x4 w; w.x = cvt_pk_bf16(v0[0], v0[1]); w.y = cvt_pk_bf16(v0[2], v0[3]); w.z = cvt_pk_bf16(v1[0], v1[1]); w.w = cvt_pk_bf16(v1[2], v1[3]);
                    *(u32x4*)(rowp + bj * HALF) = w; } }
    }
};
template <int SECOND> struct EpiGate {
    static constexpr bool PERM = true, AFTER_DRAIN = false;
    bf16_t* O; const bf16_t* T; const bf16_t* Zg; const float* bg; int ldc, ldz;
    __device__ __forceinline__ void operator()(const f32x4 (&acc)[2][2][4][2], const Unit& u, int wr, int wc, int fr, int fq) const {
        const int row0 = u.pm * BM + wr * 64 + fr, col0 = u.pn * BM + wc * 32 + 8 * fq;
        f32x4 bv[2][2];
#pragma unroll
        for (int bj = 0; bj < 2; ++bj)
#pragma unroll
            for (int n = 0; n < 2; ++n) bv[bj][n] = *(const f32x4*)(bg + col0 + bj * HALF + 4 * n);
#pragma unroll
        for (int ai = 0; ai < 2; ++ai)
#pragma unroll
            for (int m = 0; m < 4; ++m) { const size_t row = (size_t)(row0 + ai * HALF + m * 16);
#pragma unroll
                for (int bj = 0; bj < 2; ++bj) { const int c = col0 + bj * HALF;
                    const u32x4 zg = *(const u32x4*)(Zg + row * ldz + c);
                    f32x4 v0 = acc[ai][bj][m][0], v1 = acc[ai][bj][m][1];
                    v0[0] *= sigmoidf_(bf_lo(zg.x) + bv[bj][0][0]); v0[1] *= sigmoidf_(bf_hi(zg.x) + bv[bj][0][1]);
                    v0[2] *= sigmoidf_(bf_lo(zg.y) + bv[bj][0][2]); v0[3] *= sigmoidf_(bf_hi(zg.y) + bv[bj][0][3]);
                    v1[0] *= sigmoidf_(bf_lo(zg.z) + bv[bj][1][0]); v1[1] *= sigmoidf_(bf_hi(zg.z) + bv[bj][1][1]);
                    v1[2] *= sigmoidf_(bf_lo(zg.w) + bv[bj][1][2]); v1[3] *= sigmoidf_(bf_hi(zg.w) + bv[bj][1][3]);
                    if (SECOND) { const u32x4 t = *(const u32x4*)(T + row * ldc + c);
                        v0[0] += bf_lo(t.x); v0[1] += bf_hi(t.x); v0[2] += bf_lo(t.y); v0[3] += bf_hi(t.y);
                        v1[0] += bf_lo(t.z); v1[1] += bf_hi(t.z); v1[2] += bf_lo(t.w); v1[3] += bf_hi(t.w); }
                    u32x4 w; w.x = cvt_pk_bf16(v0[0], v0[1]); w.y = cvt_pk_bf16(v0[2], v0[3]); w.z = cvt_pk_bf16(v1[0], v1[1]); w.w = cvt_pk_bf16(v1[2], v1[3]);
                    *(u32x4*)(O + row * ldc + c) = w; } }
    }
};
struct EpiF32 {
    static constexpr bool PERM = false, AFTER_DRAIN = false;
    float* C; int ldc; const float* R; float scale;
    __device__ __forceinline__ void operator()(const f32x4 (&acc)[2][2][4][2], const Unit& u, int wr, int wc, int fr, int fq) const {
        const int row0 = u.pm * BM + wr * 64 + fr, col0 = u.pn * BM + wc * 32 + 4 * fq;
#pragma unroll
        for (int ai = 0; ai < 2; ++ai)
#pragma unroll
            for (int m = 0; m < 4; ++m) { const size_t off = (size_t)(row0 + ai * HALF + m * 16) * ldc + col0;
#pragma unroll
                for (int bj = 0; bj < 2; ++bj)
#pragma unroll
                    for (int n = 0; n < 2; ++n) { f32x4 v = acc[ai][bj][m][n];
                        if (R) v += *(const f32x4*)(R + off + bj * HALF + n * 16) * scale;
                        *(f32x4*)(C + off + bj * HALF + n * 16) = v; } }
    }
};
struct EpiResBf16 {
    static constexpr bool PERM = true, AFTER_DRAIN = false;
    bf16_t* O; int ldc; const float* R; float scale;
    __device__ __forceinline__ void operator()(const f32x4 (&acc)[2][2][4][2], const Unit& u, int wr, int wc, int fr, int fq) const {
        const int row0 = u.pm * BM + wr * 64 + fr, col0 = u.pn * BM + wc * 32 + 8 * fq;
#pragma unroll
        for (int ai = 0; ai < 2; ++ai)
#pragma unroll
            for (int m = 0; m < 4; ++m) { const size_t off = (size_t)(row0 + ai * HALF + m * 16) * ldc + col0;
#pragma unroll
                for (int bj = 0; bj < 2; ++bj) { const f32x4 r0 = *(const f32x4*)(R + off + bj * HALF), r1 = *(const f32x4*)(R + off + bj * HALF + 4);
                    const f32x4 v0 = acc[ai][bj][m][0] + r0 * scale, v1 = acc[ai][bj][m][1] + r1 * scale;
                    u32x4 w; w.x = cvt_pk_bf16(v0[0], v0[1]); w.y = cvt_pk_bf16(v0[2], v0[3]); w.z = cvt_pk_bf16(v1[0], v1[1]); w.w = cvt_pk_bf16(v1[2], v1[3]);
                    *(u32x4*)(O + off + bj * HALF) = w; } }
    }
};
typedef int i32x4e __attribute__((ext_vector_type(4)));
struct EpiI8Bf16 {
    static constexpr bool PERM = true, AFTER_DRAIN = false;
    bf16_t* O; int ldc; const float* sa; const float* sb;
    __device__ __forceinline__ void operator()(const i32x4e (&acc)[2][2][4][2], const Unit& u, int wr, int wc, int fr, int fq) const {
        const int row0 = u.pm * BM + wr * 64 + fr, col0 = u.pn * BM + wc * 32 + 8 * fq;
        f32x4 sbv[2][2];
#pragma unroll
        for (int bj = 0; bj < 2; ++bj)
#pragma unroll
            for (int n = 0; n < 2; ++n) sbv[bj][n] = *(const f32x4*)(sb + col0 + bj * HALF + 4 * n);
#pragma unroll
        for (int ai = 0; ai < 2; ++ai)
#pragma unroll
            for (int m = 0; m < 4; ++m) { const int row = row0 + ai * HALF + m * 16; const float sr = sa[row]; bf16_t* rowp = O + (size_t)row * ldc + col0;
#pragma unroll
                for (int bj = 0; bj < 2; ++bj) { const i32x4e a0 = acc[ai][bj][m][0], a1 = acc[ai][bj][m][1];
                    const f32x4 v0 = (f32x4){(float)a0[0], (float)a0[1], (float)a0[2], (float)a0[3]} * sbv[bj][0] * sr, v1 = (f32x4){(float)a1[0], (float)a1[1], (float)a1[2], (float)a1[3]} * sbv[bj][1] * sr;
                    u32x4 w; w.x = cvt_pk_bf16(v0[0], v0[1]); w.y = cvt_pk_bf16(v0[2], v0[3]); w.z = cvt_pk_bf16(v1[0], v1[1]); w.w = cvt_pk_bf16(v1[2], v1[3]);
                    *(u32x4*)(rowp + bj * HALF) = w; } }
    }
};
template <int SECOND> struct EpiGateI8 {
    static constexpr bool PERM = true, AFTER_DRAIN = false;
    bf16_t* O; const bf16_t* T; const bf16_t* Zg; const float* bg; int ldc, ldz; const float* sa; const float* sb;
    __device__ __forceinline__ void operator()(const i32x4e (&acc)[2][2][4][2], const Unit& u, int wr, int wc, int fr, int fq) const {
        const int row0 = u.pm * BM + wr * 64 + fr, col0 = u.pn * BM + wc * 32 + 8 * fq;
        f32x4 bv[2][2], sbv[2][2];
#pragma unroll
        for (int bj = 0; bj < 2; ++bj)
#pragma unroll
            for (int n = 0; n < 2; ++n) { bv[bj][n] = *(const f32x4*)(bg + col0 + bj * HALF + 4 * n); sbv[bj][n] = *(const f32x4*)(sb + col0 + bj * HALF + 4 * n); }
#pragma unroll
        for (int ai = 0; ai < 2; ++ai)
#pragma unroll
            for (int m = 0; m < 4; ++m) { const size_t row = (size_t)(row0 + ai * HALF + m * 16); const float sr = sa[row];
#pragma unroll
                for (int bj = 0; bj < 2; ++bj) { const int c = col0 + bj * HALF;
                    const u32x4 zg = *(const u32x4*)(Zg + row * ldz + c);
                    const i32x4e a0 = acc[ai][bj][m][0], a1 = acc[ai][bj][m][1];
                    f32x4 v0 = (f32x4){(float)a0[0], (float)a0[1], (float)a0[2], (float)a0[3]} * sbv[bj][0] * sr, v1 = (f32x4){(float)a1[0], (float)a1[1], (float)a1[2], (float)a1[3]} * sbv[bj][1] * sr;
                    v0[0] *= sigmoidf_(bf_lo(zg.x) + bv[bj][0][0]); v0[1] *= sigmoidf_(bf_hi(zg.x) + bv[bj][0][1]);
                    v0[2] *= sigmoidf_(bf_lo(zg.y) + bv[bj][0][2]); v0[3] *= sigmoidf_(bf_hi(zg.y) + bv[bj][0][3]);
                    v1[0] *= sigmoidf_(bf_lo(zg.z) + bv[bj][1][0]); v1[1] *= sigmoidf_(bf_hi(zg.z) + bv[bj][1][1]);
                    v1[2] *= sigmoidf_(bf_lo(zg.w) + bv[bj][1][2]); v1[3] *= sigmoidf_(bf_hi(zg.w) + bv[bj][1][3]);
                    if (SECOND) { const u32x4 t = *(const u32x4*)(T + row * ldc + c);
                        v0[0] += bf_lo(t.x); v0[1] += bf_hi(t.x); v0[2] += bf_lo(t.y); v0[3] += bf_hi(t.y);
                        v1[0] += bf_lo(t.z); v1[1] += bf_hi(t.z); v1[2] += bf_lo(t.w); v1[3] += bf_hi(t.w); }
                    u32x4 w; w.x = cvt_pk_bf16(v0[0], v0[1]); w.y = cvt_pk_bf16(v0[2], v0[3]); w.z = cvt_pk_bf16(v1[0], v1[1]); w.w = cvt_pk_bf16(v1[2], v1[3]);
                    *(u32x4*)(O + row * ldc + c) = w; } }
    }
};
struct EpiResI8Bf16 {
    static constexpr bool PERM = true, AFTER_DRAIN = false;
    bf16_t* O; int ldc; const float* R; float scale; const float* sa; const float* sb;
    __device__ __forceinline__ void operator()(const i32x4e (&acc)[2][2][4][2], const Unit& u, int wr, int wc, int fr, int fq) const {
        const int row0 = u.pm * BM + wr * 64 + fr, col0 = u.pn * BM + wc * 32 + 8 * fq;
        f32x4 sbv[2][2];
#pragma unroll
        for (int bj = 0; bj < 2; ++bj)
#pragma unroll
            for (int n = 0; n < 2; ++n) sbv[bj][n] = *(const f32x4*)(sb + col0 + bj * HALF + 4 * n);
#pragma unroll
        for (int ai = 0; ai < 2; ++ai)
#pragma unroll
            for (int m = 0; m < 4; ++m) { const int row = row0 + ai * HALF + m * 16; const float sr = sa[row]; const size_t off = (size_t)row * ldc + col0;
#pragma unroll
                for (int bj = 0; bj < 2; ++bj) { const f32x4 r0 = *(const f32x4*)(R + off + bj * HALF), r1 = *(const f32x4*)(R + off + bj * HALF + 4);
                    const i32x4e a0 = acc[ai][bj][m][0], a1 = acc[ai][bj][m][1];
                    const f32x4 v0 = (f32x4){(float)a0[0], (float)a0[1], (float)a0[2], (float)a0[3]} * sbv[bj][0] * sr + r0 * scale, v1 = (f32x4){(float)a1[0], (float)a1[1], (float)a1[2], (float)a1[3]} * sbv[bj][1] * sr + r1 * scale;
                    u32x4 w; w.x = cvt_pk_bf16(v0[0], v0[1]); w.y = cvt_pk_bf16(v0[2], v0[3]); w.z = cvt_pk_bf16(v1[0], v1[1]); w.w = cvt_pk_bf16(v1[2], v1[3]);
                    *(u32x4*)(O + off + bj * HALF) = w; } }
    }
};

typedef int i32x4 __attribute__((ext_vector_type(4)));
template <class E, class = void> struct epi_chains : std::false_type {};
template <class E> struct epi_chains<E, std::void_t<decltype(E::CHAIN)>> : std::true_type {};
template <class Epi, class Sched, bool ALIGN_EPI = false, bool SP2 = false, bool I8 = false>
__device__ __forceinline__ void gemm_phase(PG8_LAS unsigned char* lds, const Gemm g, const Sched& S, const Epi& E) {
    int tid_ = threadIdx.x; asm volatile("" : "+v"(tid_));
    const int tid = tid_, wid = __builtin_amdgcn_readfirstlane(tid >> 6), lane = tid & 63, wr = wid >> 2, wc = wid & 3, fr = lane & 15, fq = lane >> 4;
    const int K = g.K, nt = K / BK;
    unsigned voffA[2], voffB[2];
#pragma unroll
    for (int i = 0; i < 2; ++i) { int R, C; stage_rc(tid * 16 + i * 8192, R, C); const int Rb = Epi::PERM ? ((R & ~31) + perm32(R & 31)) : R;
        voffA[i] = (unsigned)(R * K + C) * 2u; voffB[i] = (unsigned)(Rb * K + C) * 2u; }
    const size_t kstep = (size_t)(BK * 2);
    const size_t hstep = (size_t)HALF * K * 2;
    const size_t tstep = 2 * hstep;
    const unsigned ldsw = (unsigned)wid * 1024u;
    const int aoff = lds_byte(wr * 64 + fr, fq * 8), boff = lds_byte(wc * 32 + fr, fq * 8);
#define PG8_SA(b, h) (((b) * 2 + (h)) * HTB)
#define PG8_SB(b, h) ((4 + (b) * 2 + (h)) * HTB)
#define PG8_STAGE(bufoff, gbase, voff) do { _Pragma("unroll") for (int _i = 0; _i < 2; ++_i) \
        __builtin_amdgcn_global_load_lds((const unsigned*)((const char*)(gbase) + (voff)[_i]), (PG8_LAS unsigned*)(lds + (bufoff) + ldsw + _i * 8192), 16, 0, 0); } while (0)
#define PG8_LDA(dst, b, h) do { _Pragma("unroll") for (int m = 0; m < 4; ++m) _Pragma("unroll") for (int k = 0; k < 2; ++k) dst[m][k] = *(const PG8_LAS bf16x8*)(lds + PG8_SA(b, h) + aoff + m * 2048 + k * 1024); } while (0)
#define PG8_LDB(dst, b, h) do { _Pragma("unroll") for (int n = 0; n < 2; ++n) _Pragma("unroll") for (int k = 0; k < 2; ++k) dst[n][k] = *(const PG8_LAS bf16x8*)(lds + PG8_SB(b, h) + boff + n * 2048 + k * 1024); } while (0)
#define PG8_MMA(ai, bj, At, Bt) do { __builtin_amdgcn_s_setprio(1); _Pragma("unroll") for (int m = 0; m < 4; ++m) _Pragma("unroll") for (int n = 0; n < 2; ++n) _Pragma("unroll") for (int k = 0; k < 2; ++k) \
        { if constexpr (I8) acc[ai][bj][m][n] = __builtin_bit_cast(acc_t, __builtin_amdgcn_mfma_i32_16x16x64_i8(__builtin_bit_cast(i32x4, Bt[n][k]), __builtin_bit_cast(i32x4, At[m][k]), __builtin_bit_cast(i32x4, acc[ai][bj][m][n]), 0, 0, 0)); \
          else acc[ai][bj][m][n] = __builtin_bit_cast(acc_t, __builtin_amdgcn_mfma_f32_16x16x32_bf16(Bt[n][k], At[m][k], __builtin_bit_cast(f32x4, acc[ai][bj][m][n]), 0, 0, 0)); } __builtin_amdgcn_s_setprio(0); } while (0)
#define PG8_WAIT_V(n) asm volatile("s_waitcnt vmcnt(" #n ")" ::: "memory")
#define PG8_WAIT_L(n) asm volatile("s_waitcnt lgkmcnt(" #n ")" ::: "memory")
#define PG8_BAR __builtin_amdgcn_s_barrier()
#define PG8_SCHED __builtin_amdgcn_sched_barrier(0)
    Unit cur, nxt; int ui = 0;
    if (!S.next(0, cur)) return;
    typedef typename std::conditional<I8, i32x4, f32x4>::type acc_t;
    acc_t acc[2][2][4][2];
#pragma unroll
    for (int a = 0; a < 2; ++a)
#pragma unroll
        for (int b = 0; b < 2; ++b)
#pragma unroll
            for (int m = 0; m < 4; ++m)
#pragma unroll
                for (int n = 0; n < 2; ++n) acc[a][b][m][n] = acc_t{};
    bf16x8 At[4][2], B0[2][2], B1[2][2];
    const char* cA = (const char*)(cur.w ? g.A2 : g.A) + (size_t)cur.pm * tstep; const char* cB = (const char*)(cur.w ? g.Bt2 : g.Bt) + (size_t)cur.pn * tstep;
    S.a_ready(cur);
    if constexpr (SP2) {
        PG8_STAGE(PG8_SB(0, 0), cB, voffB); PG8_STAGE(PG8_SB(0, 1), cB + hstep, voffB); PG8_STAGE(PG8_SA(0, 0), cA, voffA); PG8_STAGE(PG8_SA(0, 1), cA + hstep, voffA);
        if (wr == 1) PG8_BAR;
        PG8_WAIT_V(2); PG8_BAR;
        PG8_STAGE(PG8_SB(1, 0), cB + kstep, voffB); PG8_STAGE(PG8_SA(1, 0), cA + kstep, voffA); PG8_STAGE(PG8_SB(1, 1), cB + hstep + kstep, voffB);
        PG8_WAIT_V(6); PG8_BAR;
    } else {
        PG8_STAGE(PG8_SB(0, 0), cB, voffB); PG8_STAGE(PG8_SA(0, 0), cA, voffA); PG8_STAGE(PG8_SB(0, 1), cB + hstep, voffB); PG8_STAGE(PG8_SA(0, 1), cA + hstep, voffA);
        if (wr == 1) PG8_BAR;
        PG8_WAIT_V(4); PG8_BAR;
        PG8_STAGE(PG8_SB(1, 0), cB + kstep, voffB); PG8_STAGE(PG8_SA(1, 0), cA + kstep, voffA); PG8_STAGE(PG8_SB(1, 1), cB + hstep + kstep, voffB);
        PG8_WAIT_V(6); PG8_BAR;
    }
    for (;;) {
        const bool has_next = S.next(ui + 1, nxt);
        const char* nA = has_next ? (const char*)(nxt.w ? g.A2 : g.A) + (size_t)nxt.pm * tstep : cA; const char* nB = has_next ? (const char*)(nxt.w ? g.Bt2 : g.Bt) + (size_t)nxt.pn * tstep : cB;
        for (int t = 0; t < nt; t += 2) {
            const bool last = (t == nt - 2);
            const char* a1 = cA + (size_t)(t + 1) * kstep;
            const char* a2 = last ? nA : cA + (size_t)(t + 2) * kstep; const char* b2 = last ? nB : cB + (size_t)(t + 2) * kstep;
            const char* a3 = a2 + kstep; const char* b3 = b2 + kstep;
            if (last && has_next) S.a_ready(nxt);
            if constexpr (SP2) {
            PG8_LDB(B0, 0, 0); PG8_LDB(B1, 0, 1); PG8_SCHED; PG8_LDA(At, 0, 0); PG8_STAGE(PG8_SA(1, 1), a1 + hstep, voffA);
            PG8_WAIT_V(8); PG8_WAIT_L(0); PG8_BAR; PG8_MMA(0, 0, At, B0); PG8_MMA(0, 1, At, B1); PG8_BAR; PG8_SCHED;
            PG8_LDA(At, 0, 1); PG8_STAGE(PG8_SB(0, 0), b2, voffB); PG8_STAGE(PG8_SB(0, 1), b2 + hstep, voffB); PG8_STAGE(PG8_SA(0, 0), a2, voffA);
            PG8_WAIT_V(8); PG8_WAIT_L(0); PG8_BAR; PG8_MMA(1, 0, At, B0); PG8_MMA(1, 1, At, B1); PG8_BAR; PG8_SCHED;
            PG8_LDB(B0, 1, 0); PG8_LDB(B1, 1, 1); PG8_SCHED; PG8_LDA(At, 1, 0); PG8_STAGE(PG8_SA(0, 1), a2 + hstep, voffA);
            PG8_WAIT_V(8); PG8_WAIT_L(0); PG8_BAR; PG8_MMA(0, 0, At, B0); PG8_MMA(0, 1, At, B1); PG8_BAR; PG8_SCHED;
            PG8_LDA(At, 1, 1); PG8_STAGE(PG8_SB(1, 0), b3, voffB); PG8_STAGE(PG8_SB(1, 1), b3 + hstep, voffB); PG8_STAGE(PG8_SA(1, 0), a3, voffA);
            PG8_WAIT_V(8); PG8_WAIT_L(0); PG8_BAR; PG8_MMA(1, 0, At, B0); PG8_MMA(1, 1, At, B1); PG8_BAR; PG8_SCHED;
            } else {
            PG8_LDB(B0, 0, 0); PG8_SCHED; PG8_LDA(At, 0, 0); PG8_STAGE(PG8_SA(1, 1), a1 + hstep, voffA);
            PG8_WAIT_L(8); PG8_BAR; PG8_WAIT_L(0); PG8_MMA(0, 0, At, B0); PG8_BAR; PG8_SCHED;
            PG8_LDB(B1, 0, 1); PG8_STAGE(PG8_SB(0, 0), b2, voffB);
            PG8_BAR; PG8_WAIT_L(0); PG8_MMA(0, 1, At, B1); PG8_BAR;
            PG8_LDA(At, 0, 1); PG8_STAGE(PG8_SA(0, 0), a2, voffA);
            PG8_BAR; PG8_WAIT_L(0); PG8_MMA(1, 0, At, B0); PG8_BAR; PG8_SCHED;
            PG8_STAGE(PG8_SB(0, 1), b2 + hstep, voffB);
            PG8_WAIT_V(6); PG8_BAR; PG8_MMA(1, 1, At, B1); PG8_BAR;
            PG8_LDB(B0, 1, 0); PG8_SCHED; PG8_LDA(At, 1, 0); PG8_STAGE(PG8_SA(0, 1), a2 + hstep, voffA);
            PG8_WAIT_L(8); PG8_BAR; PG8_WAIT_L(0); PG8_MMA(0, 0, At, B0); PG8_BAR; PG8_SCHED;
            PG8_LDB(B1, 1, 1); PG8_STAGE(PG8_SB(1, 0), b3, voffB);
            PG8_BAR; PG8_WAIT_L(0); PG8_MMA(0, 1, At, B1); PG8_BAR;
            PG8_LDA(At, 1, 1); PG8_STAGE(PG8_SA(1, 0), a3, voffA);
            PG8_BAR; PG8_WAIT_L(0); PG8_MMA(1, 0, At, B0); PG8_BAR; PG8_SCHED;
            PG8_STAGE(PG8_SB(1, 1), b3 + hstep, voffB);
            PG8_WAIT_V(6); PG8_BAR; PG8_MMA(1, 1, At, B1); PG8_BAR;
            }
        }
        if constexpr (ALIGN_EPI) { if (wr == 0) PG8_BAR; }
        bool keep_acc = false;
        if constexpr (!Epi::AFTER_DRAIN) { if constexpr (epi_chains<Epi>::value) keep_acc = E.chain(acc, cur, wr, wc, fr, fq); else E(acc, cur, wr, wc, fr, fq); S.done(cur); }
        if (!has_next) break;
        if (!keep_acc) {
#pragma unroll
        for (int a = 0; a < 2; ++a)
#pragma unroll
            for (int b = 0; b < 2; ++b)
#pragma unroll
                for (int m = 0; m < 4; ++m)
#pragma unroll
                    for (int n = 0; n < 2; ++n) acc[a][b][m][n] = acc_t{};
        }
        cur = nxt; cA = nA; cB = nB; ++ui;
        if constexpr (ALIGN_EPI) { if (wr == 1) PG8_BAR; }
    }
    PG8_WAIT_V(0);
    if constexpr (!ALIGN_EPI) { if (wr == 0) PG8_BAR; }
    PG8_BAR;
    if constexpr (Epi::AFTER_DRAIN) { E.fused(acc, cur, wr, wc, fr, fq, lds, wid, lane); S.done(cur); }
#undef PG8_SA
#undef PG8_SB
#undef PG8_STAGE
#undef PG8_LDA
#undef PG8_LDB
#undef PG8_MMA
#undef PG8_WAIT_V
#undef PG8_WAIT_L
#undef PG8_BAR
#undef PG8_SCHED
}
}
#define GAS __attribute__((address_space(1)))
#define LAS __attribute__((address_space(3)))
typedef unsigned short bf16;
typedef unsigned v4u __attribute__((ext_vector_type(4)));
typedef float f32x4 __attribute__((ext_vector_type(4)));
typedef short bf16x8 __attribute__((ext_vector_type(8)));
typedef GAS unsigned gu32;
typedef GAS unsigned long long gu64;
#define RLX_AGENT __ATOMIC_RELAXED, __HIP_MEMORY_SCOPE_AGENT
#define LDS_WAIT() asm volatile("s_waitcnt lgkmcnt(0)" ::: "memory")
#define VM_WAIT() asm volatile("s_waitcnt vmcnt(0)" ::: "memory")
__device__ __forceinline__ unsigned long long rt() { return __builtin_amdgcn_s_memrealtime(); }
__device__ __forceinline__ unsigned f2bf(float f) { unsigned u = __builtin_bit_cast(unsigned, f); return (u + 0x7fffu + ((u >> 16) & 1u)) >> 16; }
__device__ __forceinline__ unsigned pk2(float lo, float hi) { return f2bf(lo) | (f2bf(hi) << 16); }

#define XB_TMO      128
#define XB_XCNT(j)  (256  + 64 * (j))
#define XB_XSUB(j)  (1280 + 64 * (j))
#define XB_XGEN(j)  (2304 + 64 * (j))
#define XB_TOP      3328
#define XB_TOPGEN   3392
#define XCD_BAR_WORDS 3456
#define XB_SPIN_CAP (1u << 18)

__device__ __forceinline__ unsigned xb_ld(unsigned* p)              { return __hip_atomic_load(p, __ATOMIC_RELAXED, __HIP_MEMORY_SCOPE_AGENT); }
__device__ __forceinline__ unsigned xb_add(unsigned* p, unsigned v) { return __hip_atomic_fetch_add(p, v, __ATOMIC_RELAXED, __HIP_MEMORY_SCOPE_AGENT); }
__device__ __forceinline__ unsigned xb_xcc_id() { return (unsigned)__builtin_amdgcn_s_getreg((3 << 11) | 20) & 0xFu; }
#define XB_SPIN(cond, bar) do { unsigned _sp = 0; while (cond) { __builtin_amdgcn_s_sleep(1); \
    if ((++_sp & 255u) == 0u) { if (xb_ld(&(bar)[XB_TMO])) break; if (_sp > XB_SPIN_CAP) { atomicAdd(&(bar)[XB_TMO], 1u); break; } } } } while (0)

struct XcdBarrier {
    unsigned* bar; unsigned x;
    volatile LAS unsigned* st;
};

__device__ __forceinline__ XcdBarrier xcd_barrier_post(unsigned* bar, volatile LAS unsigned* st) {
    XcdBarrier b; b.bar = bar; b.x = xb_xcc_id(); b.st = st;
    if (threadIdx.x == 0) (void)xb_add(&bar[XB_XCNT(b.x)], 1u);
    return b;
}
__device__ __forceinline__ void xcd_barrier_complete(unsigned* bar, unsigned x, unsigned& nloc, unsigned& nx) {
    const unsigned G = gridDim.x * gridDim.y * gridDim.z;
    unsigned sum, cnt, mine, sp = 0u;
    for (;;) {
        sum = 0u; cnt = 0u; mine = 0u;
#pragma unroll
        for (unsigned j = 0; j < 16; ++j) { const unsigned c = xb_ld(&bar[XB_XCNT(j)]); sum += c; cnt += (c > 0u) ? 1u : 0u; mine = (j == x) ? c : mine; }
        if (sum == G) break;
        __builtin_amdgcn_s_sleep(1);
        if ((++sp & 255u) == 0u) { if (xb_ld(&bar[XB_TMO])) break; if (sp > XB_SPIN_CAP) { atomicAdd(&bar[XB_TMO], 1u); break; } }
    }
    nloc = mine > 0u ? mine : 1u; nx = cnt > 0u ? cnt : 1u;
}

__device__ __forceinline__ void xcd_barrier(const XcdBarrier& b) {
    asm volatile("s_waitcnt vmcnt(0)" ::: "memory");
    __syncthreads();
    if (threadIdx.x == 0) {
        unsigned* bar = b.bar;
        __builtin_amdgcn_s_waitcnt(0);
        unsigned nloc = b.st[0], nx = b.st[1];
        if (nloc == 0u) { xcd_barrier_complete(bar, b.x, nloc, nx); b.st[0] = nloc; b.st[1] = nx; }
        const unsigned old = xb_add(&bar[XB_XSUB(b.x)], 1u);
        const unsigned gen = old / nloc;
        if (old + 1u == (gen + 1u) * nloc) {
            __builtin_amdgcn_fence(__ATOMIC_RELEASE, "agent");
            asm volatile("s_waitcnt vmcnt(0)" ::: "memory");
            const unsigned og = xb_add(&bar[XB_TOP], 1u);
            const unsigned tg = og / nx;
            if (og + 1u == (tg + 1u) * nx) xb_add(&bar[XB_TOPGEN], 1u);
            else XB_SPIN(xb_ld(&bar[XB_TOPGEN]) == tg, bar);
            __builtin_amdgcn_fence(__ATOMIC_ACQUIRE, "agent");
            xb_add(&bar[XB_XGEN(b.x)], 1u);
            asm volatile("s_waitcnt vmcnt(0)" ::: "memory");
        } else {
            XB_SPIN(xb_ld(&bar[XB_XGEN(b.x)]) == gen, bar);
            __builtin_amdgcn_fence(__ATOMIC_ACQUIRE, "agent");
            asm volatile("s_waitcnt vmcnt(0)" ::: "memory");
        }
    }
    __syncthreads();
}

constexpr int NWAVES = 8, NTHREADS = 512;
constexpr int BATCH = 4, SEQ = 2048, D = 2048, M = BATCH * SEQ;
constexpr int NQH = 32, NKVH = 4, HD = 64, QPKV = 8, WINDOW = 128;
constexpr int Q_OFF = 0, K_OFF = 2048, V_OFF = 2304, CB_OFF = 2560, CC_OFF = 4608, CH_OFF = 6656, G_OFF = 8704, IN_W = 12800;
constexpr int PH = 8, PNK = 128, PTOPK = 16, PNE = 16384;
constexpr float LN_EPS = 1e-5f;
constexpr float ALPHA = 1.189207115002721f;

#ifndef MK_PER_PHASE
#define MK_PER_PHASE 0
#endif
constexpr int N_PHASES = 12;

constexpr size_t MiB = 1u << 20;
constexpr size_t WS_CTL = 0, CTL_ZERO_BYTES = 1 * MiB;
constexpr size_t WS_WIN = 1 * MiB;
constexpr size_t WS_WA = 51 * MiB, WS_WC = 59 * MiB, WS_WO = 67 * MiB, WS_WF = 75 * MiB;
constexpr size_t WS_XB = 83 * MiB;
constexpr size_t WS_MERGED = WS_XB;
constexpr size_t WS_Z = 115 * MiB;
constexpr size_t WS_R2B = 115 * MiB;
constexpr size_t WS_H1B = 179 * MiB;
constexpr size_t WS_SC = 211 * MiB;
constexpr size_t WS_EX = 275 * MiB;
constexpr size_t WS_GT = 279 * MiB;
constexpr size_t WS_AO = 315 * MiB, WS_CI = 347 * MiB, WS_TMP = 379 * MiB;
constexpr size_t WS_U8 = 411 * MiB, WS_V8 = 443 * MiB;
constexpr size_t WS_SU = 475 * MiB, WS_SV = WS_SU + 65536;
constexpr size_t WS_PA = WS_SC;
constexpr size_t WS_XQ = 283 * MiB;
constexpr size_t WS_SX = 299 * MiB;
constexpr size_t WS_WB = 380 * MiB;
constexpr size_t WS_ST = 379 * MiB;
constexpr size_t WS_XA8 = WS_XB;
constexpr size_t WS_WIN8 = 476 * MiB;
constexpr size_t WS_SWIN = 501 * MiB, WS_SXA = WS_SWIN + 65536;
constexpr size_t WS_AO8 = 1 * MiB, WS_CI8 = 17 * MiB, WS_WA8 = 33 * MiB, WS_WC8 = 37 * MiB, WS_S3 = 41 * MiB;
constexpr size_t WS_WF8 = 502 * MiB;
constexpr size_t WS_SWF = WS_SXA + 65536;
constexpr size_t WS_MG8 = 1 * MiB;
constexpr size_t WS_WO8 = 506 * MiB;
constexpr size_t WS_SMG = WS_S3 + 262144, WS_SWO = WS_SWF + 16384;
constexpr size_t WS_SEG = 315 * MiB, WS_SOFF = 323 * MiB;
constexpr size_t WS_END = 510 * MiB;
constexpr int CW_Q = 12288;
constexpr size_t SLICE_BYTES = (size_t)PNE * 256;
constexpr int CW_BAR = 4096;

constexpr int RING_BYTES = 131072;
constexpr int LDSCTL_OFF = 163328, MISC_OFF = LDSCTL_OFF + 320;
constexpr int LDS_BYTES = LDSCTL_OFF + 512;

typedef float f32x16 __attribute__((ext_vector_type(16)));
typedef unsigned v2u __attribute__((ext_vector_type(2)));
__device__ __forceinline__ float wave_sum(float v) {
#pragma unroll
    for (int o = 1; o < 64; o <<= 1) v += __shfl_xor(v, o);
    return v;
}
__device__ __forceinline__ float vmaxf(float a, float b) { float r; asm("v_max_f32_e32 %0, %1, %2" : "=v"(r) : "v"(a), "v"(b)); return r; }
__device__ __forceinline__ float vminf(float a, float b) { float r; asm("v_min_f32_e32 %0, %1, %2" : "=v"(r) : "v"(a), "v"(b)); return r; }

__device__ __forceinline__ void p0_transpose_item(const float* W, int K, int N, bf16* WT, LAS float* scr, int item, int lane) {
    const int nblk = N / 32, kb = item / nblk, nb = item % nblk, k0 = 64 * kb, n0 = 32 * nb;
#pragma unroll 8
    for (int i = 0; i < 32; ++i) { const int kk = 2 * i + (lane >> 5); scr[kk * 33 + (lane & 31)] = W[(size_t)(k0 + kk) * N + n0 + (lane & 31)]; }
    LDS_WAIT(); asm volatile("" ::: "memory");
    const int c = lane & 7;
#pragma unroll
    for (int j = 0; j < 4; ++j) { const int n = (lane >> 3) + 8 * j; const LAS float* s = scr + (8 * c) * 33 + n;
        v4u o; o.x = pk2(s[0 * 33], s[1 * 33]); o.y = pk2(s[2 * 33], s[3 * 33]); o.z = pk2(s[4 * 33], s[5 * 33]); o.w = pk2(s[6 * 33], s[7 * 33]);
        *(GAS v4u*)(WT + (size_t)(n0 + n) * K + k0 + 8 * c) = o; }
    LDS_WAIT(); asm volatile("" ::: "memory");
}
__device__ __forceinline__ void p0_wf_item(const float* wq, const float* sk, bf16* WfT, LAS unsigned char* lds, int item, int tid) {
    const int hp = item >> 5, dt = item & 31;
    LAS f32x4* SK4 = (LAS f32x4*)lds;
    LAS f32x4* WQ4 = SK4 + 128 * 33;
    const float* skp = sk + (size_t)hp * 128 * 128;
    for (int i = tid; i < 128 * 32; i += NTHREADS) { const int n = i >> 5, c4 = i & 31; SK4[n * 33 + c4] = *(const f32x4*)(skp + n * 128 + 4 * c4); }
    for (int i = tid; i < 64 * 32; i += NTHREADS) { const int r = i >> 5, c4 = i & 31; WQ4[r * 33 + c4] = *(const f32x4*)(wq + (size_t)(64 * dt + r) * 2048 + hp * 128 + 4 * c4); }
    __syncthreads();
    const int td = tid & 15, tn = tid >> 4;
    float acc[4][4];
#pragma unroll
    for (int i = 0; i < 4; ++i)
#pragma unroll
        for (int j = 0; j < 4; ++j) acc[i][j] = 0.f;
#pragma unroll 4
    for (int c4 = 0; c4 < 32; ++c4) {
        f32x4 a[4], b[4];
#pragma unroll
        for (int i = 0; i < 4; ++i) a[i] = SK4[(4 * tn + i) * 33 + c4];
#pragma unroll
        for (int j = 0; j < 4; ++j) b[j] = WQ4[(td + 16 * j) * 33 + c4];
#pragma unroll
        for (int i = 0; i < 4; ++i)
#pragma unroll
            for (int j = 0; j < 4; ++j) acc[i][j] += a[i].x * b[j].x + a[i].y * b[j].y + a[i].z * b[j].z + a[i].w * b[j].w;
    }
#pragma unroll
    for (int i = 0; i < 4; ++i)
#pragma unroll
        for (int j = 0; j < 4; ++j) WfT[(size_t)(hp * 128 + 4 * tn + i) * 2048 + 64 * dt + td + 16 * j] = (bf16)f2bf(acc[i][j]);
    __syncthreads();
}

__device__ __forceinline__ int perm16(int o) { return 8 * ((o >> 2) & 1) + 4 * (o >> 3) + (o & 3); }
__device__ __forceinline__ void attn_unit(int unit, const bf16* z, bf16* ao, const float* sinks, LAS unsigned char* lds, int tid) {
    const int lane = tid & 63, wid = __builtin_amdgcn_readfirstlane(tid >> 6), r32 = lane & 31, hi = lane >> 5;
    const int nb = unit & 15, kvh = (unit >> 4) & 3, b = unit >> 6;
    LAS bf16* Ks = (LAS bf16*)lds;
    LAS bf16* Vt = (LAS bf16*)(lds + 256 * 144);
    const size_t tok0 = (size_t)b * SEQ;
#pragma unroll
    for (int i = 0; i < 4; ++i) {
        const int ci = tid + NTHREADS * i, key = ci >> 3, dc = ci & 7;
        int kpos = 128 * (nb - 1) + key; if (kpos < 0) kpos = 0;
        const bf16* src = z + (tok0 + kpos) * IN_W + K_OFF + kvh * HD + dc * 8;
        const v4u kv = *(const GAS v4u*)src, vv = *(const GAS v4u*)(src + (V_OFF - K_OFF));
        *(LAS v4u*)(Ks + key * 72 + dc * 8) = kv;
        const int pos = (key & ~15) + perm16(key & 15);
        LAS bf16* vp = Vt + (dc * 8) * 264 + pos;
        vp[0 * 264] = (bf16)(vv.x & 0xffffu); vp[1 * 264] = (bf16)(vv.x >> 16); vp[2 * 264] = (bf16)(vv.y & 0xffffu); vp[3 * 264] = (bf16)(vv.y >> 16);
        vp[4 * 264] = (bf16)(vv.z & 0xffffu); vp[5 * 264] = (bf16)(vv.z >> 16); vp[6 * 264] = (bf16)(vv.w & 0xffffu); vp[7 * 264] = (bf16)(vv.w >> 16);
    }
    __syncthreads();
    const int hq = kvh * QPKV + wid;
    const float LOG2E = 1.4426950408889634f;
    const float sink2 = sinks[hq] * LOG2E, sc = 0.125f * LOG2E;
#pragma unroll 1
    for (int qg = 0; qg < 4; ++qg) {
        const size_t tok = tok0 + 128 * nb + 32 * qg + r32;
        bf16x8 qf[4];
#pragma unroll
        for (int ks = 0; ks < 4; ++ks) qf[ks] = *(const GAS bf16x8*)(z + tok * IN_W + Q_OFF + hq * HD + 16 * ks + 8 * hi);
        f32x16 s[5];
#pragma unroll
        for (int kt = 0; kt < 5; ++kt) {
            s[kt] = (f32x16){0.f, 0.f, 0.f, 0.f, 0.f, 0.f, 0.f, 0.f, 0.f, 0.f, 0.f, 0.f, 0.f, 0.f, 0.f, 0.f};
#pragma unroll
            for (int ks = 0; ks < 4; ++ks) {
                const bf16x8 kf = *(const LAS bf16x8*)(Ks + (32 * (qg + kt) + r32) * 72 + 16 * ks + 8 * hi);
                s[kt] = __builtin_amdgcn_mfma_f32_32x32x16_bf16(kf, qf[ks], s[kt], 0, 0, 0);
            }
        }
        float mx = sink2;
#pragma unroll
        for (int kt = 0; kt < 5; ++kt) {
            const bool tile_dead = (nb == 0) && (qg + kt < 4);
#pragma unroll
            for (int r = 0; r < 16; ++r) {
                const int krow = (r & 3) + 8 * (r >> 2) + 4 * hi;
                bool valid = !tile_dead;
                if (kt == 0) valid = valid && (krow > r32);
                if (kt == 4) valid = valid && (krow <= r32);
                const float v = valid ? s[kt][r] * sc : -INFINITY;
                s[kt][r] = v; mx = fmaxf(mx, v);
            }
        }
        mx = fmaxf(mx, __shfl_xor(mx, 32));
        float sum = 0.f;
#pragma unroll
        for (int kt = 0; kt < 5; ++kt)
#pragma unroll
            for (int r = 0; r < 16; ++r) { const float p = __builtin_amdgcn_exp2f(s[kt][r] - mx); s[kt][r] = p; sum += p; }
        sum += __shfl_xor(sum, 32);
        const float inv = 1.0f / (sum + __builtin_amdgcn_exp2f(sink2 - mx));
        f32x16 o[2];
        o[0] = (f32x16){0.f, 0.f, 0.f, 0.f, 0.f, 0.f, 0.f, 0.f, 0.f, 0.f, 0.f, 0.f, 0.f, 0.f, 0.f, 0.f}; o[1] = o[0];
#pragma unroll
        for (int kt = 0; kt < 5; ++kt)
#pragma unroll
            for (int s2 = 0; s2 < 2; ++s2) {
                v4u pw; pw.x = pg8::cvt_pk_bf16(s[kt][8 * s2 + 0], s[kt][8 * s2 + 1]); pw.y = pg8::cvt_pk_bf16(s[kt][8 * s2 + 2], s[kt][8 * s2 + 3]);
                pw.z = pg8::cvt_pk_bf16(s[kt][8 * s2 + 4], s[kt][8 * s2 + 5]); pw.w = pg8::cvt_pk_bf16(s[kt][8 * s2 + 6], s[kt][8 * s2 + 7]);
                const bf16x8 pa = __builtin_bit_cast(bf16x8, pw);
#pragma unroll
                for (int dt = 0; dt < 2; ++dt) {
                    const bf16x8 vf = *(const LAS bf16x8*)(Vt + (32 * dt + r32) * 264 + 32 * (qg + kt) + 16 * s2 + 8 * hi);
                    o[dt] = __builtin_amdgcn_mfma_f32_32x32x16_bf16(vf, pa, o[dt], 0, 0, 0);
                }
            }
        bf16* op = ao + tok * D + hq * HD;
#pragma unroll
        for (int dt = 0; dt < 2; ++dt)
#pragma unroll
            for (int g = 0; g < 4; ++g) {
                v2u w; w.x = pg8::cvt_pk_bf16(o[dt][4 * g + 0] * inv, o[dt][4 * g + 1] * inv); w.y = pg8::cvt_pk_bf16(o[dt][4 * g + 2] * inv, o[dt][4 * g + 3] * inv);
                *(GAS v2u*)(op + 32 * dt + 8 * g + 4 * hi) = w;
            }
    }
    __syncthreads();
}
__device__ __forceinline__ void conv_item(int item, const bf16* z, const float* cw, bf16* ci, int tid) {
    const int c8 = tid & 255, half = tid >> 8, t0 = 32 * item + 16 * half, c0 = 8 * c8;
    float w0[8], w1[8], w2[8], u1[8], u2[8];
#pragma unroll
    for (int e = 0; e < 8; ++e) { w0[e] = cw[c0 + e]; w1[e] = cw[2048 + c0 + e]; w2[e] = cw[4096 + c0 + e]; u1[e] = 0.f; u2[e] = 0.f; }
    if ((t0 & (SEQ - 1)) != 0) {
#pragma unroll
        for (int k = 0; k < 2; ++k) {
            const bf16* zr = z + (size_t)(t0 - 2 + k) * IN_W + c0;
            const v4u a = *(const GAS v4u*)(zr + CC_OFF), h = *(const GAS v4u*)(zr + CH_OFF);
            float u[8];
            u[0] = pg8::bf_lo(a.x) * pg8::bf_lo(h.x); u[1] = pg8::bf_hi(a.x) * pg8::bf_hi(h.x); u[2] = pg8::bf_lo(a.y) * pg8::bf_lo(h.y); u[3] = pg8::bf_hi(a.y) * pg8::bf_hi(h.y);
            u[4] = pg8::bf_lo(a.z) * pg8::bf_lo(h.z); u[5] = pg8::bf_hi(a.z) * pg8::bf_hi(h.z); u[6] = pg8::bf_lo(a.w) * pg8::bf_lo(h.w); u[7] = pg8::bf_hi(a.w) * pg8::bf_hi(h.w);
#pragma unroll
            for (int e = 0; e < 8; ++e) { if (k == 0) u2[e] = u[e]; else u1[e] = u[e]; }
        }
    }
#pragma unroll 4
    for (int i = 0; i < 16; ++i) {
        const bf16* zr = z + (size_t)(t0 + i) * IN_W + c0;
        const v4u a = *(const GAS v4u*)(zr + CC_OFF), h = *(const GAS v4u*)(zr + CH_OFF), bb = *(const GAS v4u*)(zr + CB_OFF);
        float u[8], cb[8], y[8];
        u[0] = pg8::bf_lo(a.x) * pg8::bf_lo(h.x); u[1] = pg8::bf_hi(a.x) * pg8::bf_hi(h.x); u[2] = pg8::bf_lo(a.y) * pg8::bf_lo(h.y); u[3] = pg8::bf_hi(a.y) * pg8::bf_hi(h.y);
        u[4] = pg8::bf_lo(a.z) * pg8::bf_lo(h.z); u[5] = pg8::bf_hi(a.z) * pg8::bf_hi(h.z); u[6] = pg8::bf_lo(a.w) * pg8::bf_lo(h.w); u[7] = pg8::bf_hi(a.w) * pg8::bf_hi(h.w);
        cb[0] = pg8::bf_lo(bb.x); cb[1] = pg8::bf_hi(bb.x); cb[2] = pg8::bf_lo(bb.y); cb[3] = pg8::bf_hi(bb.y); cb[4] = pg8::bf_lo(bb.z); cb[5] = pg8::bf_hi(bb.z); cb[6] = pg8::bf_lo(bb.w); cb[7] = pg8::bf_hi(bb.w);
#pragma unroll
        for (int e = 0; e < 8; ++e) { y[e] = cb[e] * (w0[e] * u2[e] + w1[e] * u1[e] + w2[e] * u[e]); u2[e] = u1[e]; u1[e] = u[e]; }
        v4u o; o.x = pk2(y[0], y[1]); o.y = pk2(y[2], y[3]); o.z = pk2(y[4], y[5]); o.w = pk2(y[6], y[7]);
        *(GAS v4u*)(ci + (size_t)(t0 + i) * D + c0) = o;
    }
}

__device__ __forceinline__ unsigned pack_i8(const f32x4 v) {
    const int a = __float2int_rn(v.x), b = __float2int_rn(v.y), c = __float2int_rn(v.z), d = __float2int_rn(v.w);
    return ((unsigned)a & 0xffu) | (((unsigned)b & 0xffu) << 8) | (((unsigned)c & 0xffu) << 16) | ((unsigned)d << 24);
}
__device__ __forceinline__ unsigned pack_i8_2(float a, float b, float c, float d) {
    const int ia = __float2int_rn(a), ib = __float2int_rn(b), ic = __float2int_rn(c), id = __float2int_rn(d);
    return ((unsigned)ia & 0xffu) | (((unsigned)ib & 0xffu) << 8) | (((unsigned)ic & 0xffu) << 16) | ((unsigned)id << 24);
}
__device__ __forceinline__ void ln1_row(bf16* hbrow, signed char* xqrow, float* sxp, const float* g, const float* bta, int lane) {
    GAS v4u* xr = (GAS v4u*)hbrow + lane;
    float v[4][8]; float s = 0.f;
#pragma unroll
    for (int j = 0; j < 4; ++j) { const v4u w = xr[64 * j];
        v[j][0] = pg8::bf_lo(w.x); v[j][1] = pg8::bf_hi(w.x); v[j][2] = pg8::bf_lo(w.y); v[j][3] = pg8::bf_hi(w.y); v[j][4] = pg8::bf_lo(w.z); v[j][5] = pg8::bf_hi(w.z); v[j][6] = pg8::bf_lo(w.w); v[j][7] = pg8::bf_hi(w.w);
#pragma unroll
        for (int e = 0; e < 8; ++e) s += v[j][e]; }
    const float mean = wave_sum(s) * (1.f / D); float s2 = 0.f;
#pragma unroll
    for (int j = 0; j < 4; ++j)
#pragma unroll
        for (int e = 0; e < 8; ++e) { v[j][e] -= mean; s2 += v[j][e] * v[j][e]; }
    const float rstd = 1.f / sqrtf(wave_sum(s2) * (1.f / D) + LN_EPS);
    float mx = 0.f;
#pragma unroll
    for (int j = 0; j < 4; ++j) {
        const GAS f32x4* gp = (const GAS f32x4*)g + 2 * (lane + 64 * j); const GAS f32x4* bp = (const GAS f32x4*)bta + 2 * (lane + 64 * j);
        const f32x4 g0 = gp[0], g1 = gp[1], b0 = bp[0], b1 = bp[1];
        v[j][0] = v[j][0] * rstd * g0.x + b0.x; v[j][1] = v[j][1] * rstd * g0.y + b0.y; v[j][2] = v[j][2] * rstd * g0.z + b0.z; v[j][3] = v[j][3] * rstd * g0.w + b0.w;
        v[j][4] = v[j][4] * rstd * g1.x + b1.x; v[j][5] = v[j][5] * rstd * g1.y + b1.y; v[j][6] = v[j][6] * rstd * g1.z + b1.z; v[j][7] = v[j][7] * rstd * g1.w + b1.w;
        v4u o; o.x = pk2(v[j][0], v[j][1]); o.y = pk2(v[j][2], v[j][3]); o.z = pk2(v[j][4], v[j][5]); o.w = pk2(v[j][6], v[j][7]);
        xr[64 * j] = o;
#pragma unroll
        for (int e = 0; e < 8; ++e) mx = fmaxf(mx, fabsf(v[j][e]));
    }
#pragma unroll
    for (int o = 1; o < 64; o <<= 1) mx = fmaxf(mx, __shfl_xor(mx, o));
    const float qs = mx > 0.f ? 127.0f / mx : 1.0f;
    GAS v2u* q8 = (GAS v2u*)xqrow + lane;
#pragma unroll
    for (int j = 0; j < 4; ++j) { v2u o; o.x = pack_i8_2(v[j][0] * qs, v[j][1] * qs, v[j][2] * qs, v[j][3] * qs); o.y = pack_i8_2(v[j][4] * qs, v[j][5] * qs, v[j][6] * qs, v[j][7] * qs); q8[64 * j] = o; }
    if (lane == 0) *sxp = mx > 0.f ? mx * (1.0f / 127.0f) : 1.0f;
}

__device__ __forceinline__ void row_f32_to_i8(const float* src, signed char* dst, float* inv, int lane) {
    f32x4 v[8]; float mx = 0.f;
#pragma unroll
    for (int j = 0; j < 8; ++j) { v[j] = *((const GAS f32x4*)src + lane + 64 * j); mx = fmaxf(mx, fmaxf(fmaxf(fabsf(v[j].x), fabsf(v[j].y)), fmaxf(fabsf(v[j].z), fabsf(v[j].w)))); }
#pragma unroll
    for (int o = 1; o < 64; o <<= 1) mx = fmaxf(mx, __shfl_xor(mx, o));
    const float sc = mx > 0.f ? 127.0f / mx : 1.0f;
#pragma unroll
    for (int j = 0; j < 8; ++j) *((GAS unsigned*)dst + lane + 64 * j) = pack_i8_2(v[j].x * sc, v[j].y * sc, v[j].z * sc, v[j].w * sc);
    if (lane == 0) *inv = mx > 0.f ? mx * (1.0f / 127.0f) : 1.0f;
}
__device__ __forceinline__ void row_bf16_to_i8(const bf16* src, signed char* dst, float* inv, int lane) {
    float v[4][8]; float mx = 0.f;
#pragma unroll
    for (int j = 0; j < 4; ++j) { const v4u w = *((const GAS v4u*)src + lane + 64 * j);
        v[j][0] = pg8::bf_lo(w.x); v[j][1] = pg8::bf_hi(w.x); v[j][2] = pg8::bf_lo(w.y); v[j][3] = pg8::bf_hi(w.y); v[j][4] = pg8::bf_lo(w.z); v[j][5] = pg8::bf_hi(w.z); v[j][6] = pg8::bf_lo(w.w); v[j][7] = pg8::bf_hi(w.w);
#pragma unroll
        for (int e = 0; e < 8; ++e) mx = fmaxf(mx, fabsf(v[j][e])); }
#pragma unroll
    for (int o = 1; o < 64; o <<= 1) mx = fmaxf(mx, __shfl_xor(mx, o));
    const float sc = mx > 0.f ? 127.0f / mx : 1.0f;
#pragma unroll
    for (int j = 0; j < 4; ++j) { v2u o; o.x = pack_i8_2(v[j][0] * sc, v[j][1] * sc, v[j][2] * sc, v[j][3] * sc); o.y = pack_i8_2(v[j][4] * sc, v[j][5] * sc, v[j][6] * sc, v[j][7] * sc); *((GAS v2u*)dst + lane + 64 * j) = o; }
    if (lane == 0) *inv = mx > 0.f ? mx * (1.0f / 127.0f) : 1.0f;
}

constexpr int TK_ROWF = 136;
constexpr int TK_IDX_OFF = 256 * TK_ROWF * 4;
__device__ __forceinline__ void topk_core(LAS unsigned char* lds, size_t prob0, int pstride, int* experts, float* gates, int tid) {
    LAS float* S = (LAS float*)lds;
    LAS unsigned char* IDX = lds + TK_IDX_OFF;
    const int row = tid >> 1, sub = tid & 1;
#define TK_CE(a, b) do { const float h_ = vmaxf(a, b), l_ = vminf(a, b); a = h_; b = l_; } while (0)
#define TK_SORT16(V) do { _Pragma("unroll") for (int k_ = 2; k_ <= 16; k_ <<= 1) _Pragma("unroll") for (int j_ = k_ >> 1; j_ > 0; j_ >>= 1) _Pragma("unroll") for (int i_ = 0; i_ < 16; ++i_) { \
        const int l_i = i_ ^ j_; if (l_i > i_) { if ((i_ & k_) == 0) TK_CE(V[i_], V[l_i]); else TK_CE(V[l_i], V[i_]); } } } while (0)
#define TK_MERGE16(Lv, Xv) do { _Pragma("unroll") for (int j_ = 0; j_ < 16; ++j_) Lv[j_] = vmaxf(Lv[j_], Xv[15 - j_]); \
        _Pragma("unroll") for (int st_ = 8; st_ >= 1; st_ >>= 1) _Pragma("unroll") for (int j_ = 0; j_ < 16; ++j_) if ((j_ & st_) == 0) TK_CE(Lv[j_], Lv[j_ + st_]); } while (0)
    float L[16];
#pragma unroll
    for (int q = 0; q < 4; ++q) {
        float C[16];
#pragma unroll
        for (int i = 0; i < 4; ++i) { const int c4 = 2 * (4 * q + i) + sub;
            const f32x4 v = *(const LAS f32x4*)(S + row * TK_ROWF + 4 * c4);
#pragma unroll
            for (int e = 0; e < 4; ++e) { const float ve = v[e];
                C[4 * i + e] = __uint_as_float((__float_as_uint(ve) & ~0x7Fu) | (unsigned)(4 * c4 + e)); } }
        TK_SORT16(C);
        if (q == 0) {
#pragma unroll
            for (int j = 0; j < 16; ++j) L[j] = C[j];
        } else TK_MERGE16(L, C);
    }
    {
        float P[16];
#pragma unroll
        for (int j = 0; j < 16; ++j) P[j] = __shfl_xor(L[j], 1);
        TK_MERGE16(L, P);
    }
    if (sub == 0) {
#pragma unroll
        for (int q = 0; q < 4; ++q) {
            unsigned w = 0;
#pragma unroll
            for (int e = 0; e < 4; ++e) w |= (__builtin_bit_cast(unsigned, L[4 * q + e]) & 0x7Fu) << (8 * e);
            *(LAS unsigned*)(IDX + row * 16 + 4 * q) = w;
        }
    }
    float A[16], B[16];
#pragma unroll
    for (int j = 0; j < 16; ++j) { const float o = __shfl_xor(L[j], 2); const bool isb = (tid & 2) != 0; A[j] = isb ? o : L[j]; B[j] = isb ? L[j] : o; }
#define TK_KEY(i, j) __uint_as_float((__float_as_uint(A[i] + B[j]) & ~0xFFu) | (unsigned)(255 - ((i) * 16 + (j))))
    float F[16], X[16];
#pragma unroll
    for (int j = 0; j < 16; ++j) F[j] = TK_KEY(0, j);
#pragma unroll
    for (int i = 1; i < 16; ++i) X[i - 1] = TK_KEY(i, 0);
    X[15] = -INFINITY; TK_MERGE16(F, X);
#pragma unroll
    for (int i = 0; i < 16; ++i) X[i] = -INFINITY;
#pragma unroll
    for (int i = 1; i <= 7; ++i) X[i - 1] = TK_KEY(i, 1);
    TK_MERGE16(F, X);
#pragma unroll
    for (int i = 0; i < 16; ++i) X[i] = -INFINITY;
#pragma unroll
    for (int j = 2; j <= 7; ++j) X[j - 2] = TK_KEY(1, j);
    TK_MERGE16(F, X);
    { const float rest[6] = {TK_KEY(2, 2), TK_KEY(2, 3), TK_KEY(2, 4), TK_KEY(3, 2), TK_KEY(3, 3), TK_KEY(4, 2)};
#pragma unroll
      for (int r = 0; r < 6; ++r) { float x = rest[r];
#pragma unroll
          for (int k = 0; k < 16; ++k) { const float h = vmaxf(F[k], x); x = vminf(F[k], x); F[k] = h; } } }
    __syncthreads();
    if ((tid & 3) == 0) {
        const int rowA = (tid >> 2) * 2, rowB = rowA + 1;
        const size_t prob = prob0 + (size_t)pstride * (tid >> 2);
        float g[16]; int ex[16]; float gs = 0.f;
#pragma unroll
        for (int k = 0; k < 16; ++k) {
            const unsigned code = 255u - (__builtin_bit_cast(unsigned, F[k]) & 0xFFu);
            const int ia = IDX[rowA * 16 + (code >> 4)], ib = IDX[rowB * 16 + (code & 15)];
            ex[k] = ia * PNK + ib;
            g[k] = __expf(F[k] - F[0]); gs += g[k];
        }
        const float ginv = 1.0f / gs;
#pragma unroll
        for (int q = 0; q < 4; ++q) {
            *(GAS f32x4*)(gates + prob * 16 + 4 * q) = (f32x4){g[4 * q] * ginv, g[4 * q + 1] * ginv, g[4 * q + 2] * ginv, g[4 * q + 3] * ginv};
            typedef int i32x4 __attribute__((ext_vector_type(4)));
            *(GAS i32x4*)(experts + prob * 16 + 4 * q) = (i32x4){ex[4 * q], ex[4 * q + 1], ex[4 * q + 2], ex[4 * q + 3]};
        }
    }
    __syncthreads();
}
__device__ __forceinline__ void topk_pass(int pass, const float* scores, int* experts, float* gates, LAS unsigned char* lds, int tid) {
    LAS float* S = (LAS float*)lds;
    const float* src = scores + (size_t)pass * (256 * 128);
#pragma unroll 4
    for (int i = 0; i < 16; ++i) { const int f4 = tid + NTHREADS * i, row = f4 >> 5, c4 = f4 & 31; *(LAS f32x4*)(S + row * TK_ROWF + 4 * c4) = *(const GAS f32x4*)(src + (size_t)f4 * 4); }
    __syncthreads();
    topk_core(lds, (size_t)pass * 128, 1, experts, gates, tid);
}
struct EpiTopKI8 {
    static constexpr bool PERM = false, AFTER_DRAIN = true;
    int* experts; float* gates; const float* sa; const float* sb;
    __device__ __forceinline__ void fused(pg8::i32x4 (&acc)[2][2][4][2], const pg8::Unit& u, int wr, int wc, int fr, int fq, LAS unsigned char* lds, int wid, int lane) const {
        LAS float* S = (LAS float*)lds;
        const int tid = wid * 64 + lane;
        pg8::f32x4 sbv[2][2];
#pragma unroll
        for (int bj = 0; bj < 2; ++bj)
#pragma unroll
            for (int n = 0; n < 2; ++n) sbv[bj][n] = *(const GAS pg8::f32x4*)(sb + u.pn * 256 + bj * 128 + 32 * wc + 16 * n + 4 * fq);
#pragma unroll
        for (int ai = 0; ai < 2; ++ai) {
#pragma unroll
            for (int mm = 0; mm < 4; ++mm) { const int rl = 64 * wr + 16 * mm + fr; const float sr = sa[u.pm * 256 + 128 * ai + rl];
#pragma unroll
                for (int bj = 0; bj < 2; ++bj)
#pragma unroll
                    for (int n = 0; n < 2; ++n) { const pg8::i32x4 a = acc[ai][bj][mm][n];
                        *(LAS pg8::f32x4*)(S + (2 * rl + bj) * TK_ROWF + 32 * wc + 16 * n + 4 * fq) = (pg8::f32x4){(float)a[0], (float)a[1], (float)a[2], (float)a[3]} * sbv[bj][n] * sr; } }
            __syncthreads();
            topk_core(lds, ((size_t)u.pm * 256 + 128 * ai) * PH + u.pn, PH, experts, gates, tid);
        }
    }
};
struct EpiTopK {
    static constexpr bool PERM = false, AFTER_DRAIN = true;
    int* experts; float* gates;
    __device__ __forceinline__ void fused(pg8::f32x4 (&acc)[2][2][4][2], const pg8::Unit& u, int wr, int wc, int fr, int fq, LAS unsigned char* lds, int wid, int lane) const {
        LAS float* S = (LAS float*)lds;
        const int tid = wid * 64 + lane;
#pragma unroll
        for (int ai = 0; ai < 2; ++ai) {
#pragma unroll
            for (int bj = 0; bj < 2; ++bj)
#pragma unroll
                for (int mm = 0; mm < 4; ++mm)
#pragma unroll
                    for (int n = 0; n < 2; ++n) { const int rl = 64 * wr + 16 * mm + fr; *(LAS pg8::f32x4*)(S + (2 * rl + bj) * TK_ROWF + 32 * wc + 16 * n + 4 * fq) = acc[ai][bj][mm][n]; }
            __syncthreads();
            topk_core(lds, ((size_t)u.pm * 256 + 128 * ai) * PH + u.pn, PH, experts, gates, tid);
        }
    }
};

__device__ __forceinline__ float gelu_erf(float v) { return 0.5f * v * (1.0f + erff(v * 0.70710678118654752f)); }
typedef __bf16 bf16x2_t __attribute__((ext_vector_type(2)));
typedef float f32x2_t __attribute__((ext_vector_type(2)));
__device__ __forceinline__ float dot2bf(bf16x2_t a, unsigned b, float acc) { return __builtin_amdgcn_fdot2_f32_bf16(a, __builtin_bit_cast(bf16x2_t, b), acc, false); }
__device__ __forceinline__ float dot4f8(unsigned w8, unsigned x01, unsigned x23, float acc) {
    acc = dot2bf(__builtin_amdgcn_cvt_scalef32_pk_bf16_fp8(w8, 1.0f, false), x01, acc);
    return dot2bf(__builtin_amdgcn_cvt_scalef32_pk_bf16_fp8(w8, 1.0f, true), x23, acc);
}
__device__ __forceinline__ void axpy4f8(float* y, unsigned w8, float w) {
    const f32x2_t lo = __builtin_amdgcn_cvt_pk_f32_fp8(w8, false), hi = __builtin_amdgcn_cvt_pk_f32_fp8(w8, true);
    y[0] += w * lo.x; y[1] += w * lo.y; y[2] += w * hi.x; y[3] += w * hi.y;
}
__device__ __forceinline__ void axpy4f8v(f32x2_t* y2, unsigned w8, float w) {
    const f32x2_t lo = __builtin_amdgcn_cvt_pk_f32_fp8(w8, false), hi = __builtin_amdgcn_cvt_pk_f32_fp8(w8, true);
    const f32x2_t ww = {w, w};
    y2[0] = __builtin_elementwise_fma(lo, ww, y2[0]); y2[1] = __builtin_elementwise_fma(hi, ww, y2[1]);
}
__device__ __forceinline__ void row_to_fp8(const float* src, unsigned char* dst, float* inv, int lane) {
    f32x4 v[2][4]; float mx = 0.f;
#pragma unroll
    for (int j = 0; j < 2; ++j)
#pragma unroll
        for (int q = 0; q < 4; ++q) { v[j][q] = *((const GAS f32x4*)src + 4 * (lane + 64 * j) + q);
            mx = fmaxf(mx, fmaxf(fmaxf(fabsf(v[j][q].x), fabsf(v[j][q].y)), fmaxf(fabsf(v[j][q].z), fabsf(v[j][q].w)))); }
#pragma unroll
    for (int o = 1; o < 64; o <<= 1) mx = fmaxf(mx, __shfl_xor(mx, o));
    const float sc = mx > 0.f ? 384.0f / mx : 1.0f;
#pragma unroll
    for (int j = 0; j < 2; ++j) { v4u o;
        int w;
        w = 0; w = __builtin_amdgcn_cvt_pk_fp8_f32(v[j][0].x * sc, v[j][0].y * sc, w, false); w = __builtin_amdgcn_cvt_pk_fp8_f32(v[j][0].z * sc, v[j][0].w * sc, w, true); o.x = (unsigned)w;
        w = 0; w = __builtin_amdgcn_cvt_pk_fp8_f32(v[j][1].x * sc, v[j][1].y * sc, w, false); w = __builtin_amdgcn_cvt_pk_fp8_f32(v[j][1].z * sc, v[j][1].w * sc, w, true); o.y = (unsigned)w;
        w = 0; w = __builtin_amdgcn_cvt_pk_fp8_f32(v[j][2].x * sc, v[j][2].y * sc, w, false); w = __builtin_amdgcn_cvt_pk_fp8_f32(v[j][2].z * sc, v[j][2].w * sc, w, true); o.z = (unsigned)w;
        w = 0; w = __builtin_amdgcn_cvt_pk_fp8_f32(v[j][3].x * sc, v[j][3].y * sc, w, false); w = __builtin_amdgcn_cvt_pk_fp8_f32(v[j][3].z * sc, v[j][3].w * sc, w, true); o.w = (unsigned)w;
        { const int ch = lane + 64 * j; *((GAS v4u*)(dst + (size_t)(ch >> 4) * SLICE_BYTES) + (ch & 15)) = o; } }
    if (lane == 0) *inv = mx > 0.f ? mx * (1.0f / 384.0f) : 1.0f;
}
__device__ __forceinline__ void row_to_i8(const float* src, unsigned char* dst, float* inv, int lane) {
    f32x4 v[2][4]; float mx = 0.f;
#pragma unroll
    for (int j = 0; j < 2; ++j)
#pragma unroll
        for (int q = 0; q < 4; ++q) { v[j][q] = *((const GAS f32x4*)src + 4 * (lane + 64 * j) + q);
            mx = fmaxf(mx, fmaxf(fmaxf(fabsf(v[j][q].x), fabsf(v[j][q].y)), fmaxf(fabsf(v[j][q].z), fabsf(v[j][q].w)))); }
#pragma unroll
    for (int o = 1; o < 64; o <<= 1) mx = fmaxf(mx, __shfl_xor(mx, o));
    const float sc = mx > 0.f ? 127.0f / mx : 1.0f;
#pragma unroll
    for (int j = 0; j < 2; ++j) { v4u o; o.x = pack_i8(v[j][0] * sc); o.y = pack_i8(v[j][1] * sc); o.z = pack_i8(v[j][2] * sc); o.w = pack_i8(v[j][3] * sc);
        { const int ch = lane + 64 * j; *((GAS v4u*)(dst + (size_t)(ch >> 4) * SLICE_BYTES) + (ch & 15)) = o; } }
    if (lane == 0) *inv = mx > 0.f ? mx * (1.0f / 127.0f) : 1.0f;
}
__device__ __forceinline__ float row16_allsum(float a) {
    a += __builtin_bit_cast(float, __builtin_amdgcn_update_dpp(0, __builtin_bit_cast(int, a), 0x128, 0xf, 0xf, false));
    a += __builtin_bit_cast(float, __builtin_amdgcn_update_dpp(0, __builtin_bit_cast(int, a), 0x124, 0xf, 0xf, false));
    a += __builtin_bit_cast(float, __builtin_amdgcn_update_dpp(0, __builtin_bit_cast(int, a), 0x122, 0xf, 0xf, false));
    a += __builtin_bit_cast(float, __builtin_amdgcn_update_dpp(0, __builtin_bit_cast(int, a), 0x121, 0xf, 0xf, false));
    return a;
}
__device__ __forceinline__ int q_pull(unsigned* q, int lane) { int v = 0; if (lane == 0) v = (int)__hip_atomic_fetch_add(q, 1u, __ATOMIC_RELAXED, __HIP_MEMORY_SCOPE_AGENT); return __builtin_amdgcn_readfirstlane(v); }
constexpr int PEER_TG = 8;
constexpr int PEER_N8 = 640, PEER_N4 = 512, PEER_N2 = 512, PEER_NTASK = PEER_N8 + PEER_N4 + PEER_N2;
__device__ __forceinline__ void peer_task_tokens(int idx, int& t0, int& n) {
    if (idx < PEER_N8) { t0 = 8 * idx; n = 8; } else if (idx < PEER_N8 + PEER_N4) { t0 = 8 * PEER_N8 + 4 * (idx - PEER_N8); n = 4; } else { t0 = 8 * PEER_N8 + 4 * PEER_N4 + 2 * (idx - PEER_N8 - PEER_N4); n = 2; }
}
__device__ __forceinline__ int row16_allsum_i(int a) {
    a += __builtin_amdgcn_update_dpp(0, a, 0x128, 0xf, 0xf, false);
    a += __builtin_amdgcn_update_dpp(0, a, 0x124, 0xf, 0xf, false);
    a += __builtin_amdgcn_update_dpp(0, a, 0x122, 0xf, 0xf, false);
    a += __builtin_amdgcn_update_dpp(0, a, 0x121, 0xf, 0xf, false);
    return a;
}
#define PA_LOAD(R, IDV, HALF) do { _Pragma("unroll") for (int i_ = 0; i_ < 8; ++i_) { const unsigned e_ = (unsigned)__shfl(IDV, 4 * (i_ + 8 * (HALF)) + g); \
        R[i_] = *(const GAS v4u*)(ub + (e_ * 256u + offc)); } } while (0)
#define PA_COMP(R, HALF) do { _Pragma("unroll") for (int i_ = 0; i_ < 8; ++i_) { int a_ = __builtin_amdgcn_sdot4((int)R[i_].x, (int)xc.x, 0, false); a_ = __builtin_amdgcn_sdot4((int)R[i_].y, (int)xc.y, a_, false); \
        a_ = __builtin_amdgcn_sdot4((int)R[i_].z, (int)xc.z, a_, false); a_ = __builtin_amdgcn_sdot4((int)R[i_].w, (int)xc.w, a_, false); r16[8 * (HALF) + i_] = row16_allsum_i(a_); } } while (0)
__device__ __forceinline__ void peer_a_task(int t0, int ntok, int s, const signed char* xq, const int* experts, const unsigned char* u8s, int* pa, int lane_) {
    int lane = lane_; asm volatile("" : "+v"(lane));
    const int g = lane >> 4, c = lane & 15;
    const GAS unsigned char* ub = (const GAS unsigned char*)(u8s + (size_t)s * SLICE_BYTES);
    const unsigned offc = 16u * (unsigned)c;
    int idc0 = experts[(size_t)t0 * 128 + lane], idc1 = experts[(size_t)t0 * 128 + lane + 64];
    v4u xc = *(const GAS v4u*)(xq + (size_t)t0 * D + 256 * s + 16 * c);
    v4u RA[8], RB[8];
    PA_LOAD(RA, idc0, 0);
#pragma unroll 1
    for (int tt = 0; tt < ntok; ++tt) {
        const int t = t0 + tt, tn = tt + 1 < ntok ? t + 1 : t;
        const int idn0 = experts[(size_t)tn * 128 + lane], idn1 = experts[(size_t)tn * 128 + lane + 64];
        const v4u xn = *(const GAS v4u*)(xq + (size_t)tn * D + 256 * s + 16 * c);
#pragma unroll 1
        for (int hb = 0; hb < 2; ++hb) {
            const int idv = hb ? idc1 : idc0, idx = hb ? idn0 : idc1;
            int r16[16];
            PA_LOAD(RB, idv, 1); PA_COMP(RA, 0);
            asm volatile("" ::: "memory");
            PA_LOAD(RA, idx, 0); PA_COMP(RB, 1);
            if (c == 15) { typedef int i32x4 __attribute__((ext_vector_type(4))); GAS i32x4* dst = (GAS i32x4*)(pa + ((size_t)t * 8 + s) * 128 + g * 32 + 16 * hb);
#pragma unroll
                for (int q = 0; q < 4; ++q) dst[q] = (i32x4){r16[4 * q], r16[4 * q + 1], r16[4 * q + 2], r16[4 * q + 3]}; }
        }
        idc0 = idn0; idc1 = idn1; xc = xn;
    }
}
constexpr int PA_CH = 56, PA_NCH = (M + PA_CH - 1) / PA_CH, PA_NCH4 = (PA_NCH + 3) & ~3;
constexpr int PA_XT = 131072, PA_XTB = PA_CH * 256, PA_LOFF = PA_XT + 2 * PA_XTB;
static_assert(PA_LOFF + PA_NCH4 * 8 <= LDSCTL_OFF, "LDS map");
__device__ __forceinline__ void peer_shard_load(int s, int r, const unsigned char* u8s, LAS unsigned char* lds, int tid_) {
    int tid = tid_; asm volatile("" : "+v"(tid));
    const GAS unsigned char* src = (const GAS unsigned char*)(u8s + (size_t)s * SLICE_BYTES);
#pragma unroll 1
    for (int h = 0; h < 2; ++h) { v4u t[8];
#pragma unroll
        for (int j = 0; j < 8; ++j) { const int piece = tid + NTHREADS * (8 * h + j), el = piece >> 4, i = el >> 2, jj = ((r - i) & 31) + 32 * (el & 3);
            t[j] = *(const GAS v4u*)(src + ((size_t)(i * 128 + jj) * 256 + (size_t)((piece & 15) << 4))); }
#pragma unroll
        for (int j = 0; j < 8; ++j) *(LAS v4u*)(lds + 16 * (tid + NTHREADS * (8 * h + j))) = t[j]; }
}
__device__ __forceinline__ void peer_bucket(int q, const int* experts, unsigned* seg, int* soff, LAS unsigned char* lds, int tid_) {
    int tid = tid_; asm volatile("" : "+v"(tid));
    LAS int* cnt = (LAS int*)(lds + PA_XT);
    if (tid < 128) cnt[tid] = 0;
    __syncthreads();
    const int ntok = (M - q * PA_CH) < PA_CH ? (M - q * PA_CH) : PA_CH, nent = ntok * 128;
    const GAS int* ex = (const GAS int*)(experts + (size_t)q * PA_CH * 128);
    int ev[14];
#pragma unroll
    for (int j = 0; j < 14; ++j) { const int i = tid + NTHREADS * j; ev[j] = i < nent ? ex[i] : -1; }
#pragma unroll
    for (int j = 0; j < 14; ++j) if (ev[j] >= 0) __hip_atomic_fetch_add(cnt + (((ev[j] >> 7) + ev[j]) & 31), 1, __ATOMIC_RELAXED, __HIP_MEMORY_SCOPE_WORKGROUP);
    __syncthreads();
    if (tid < 64) { const int c = tid < 32 ? cnt[tid] : 0; int inc = c;
#pragma unroll
        for (int o = 1; o < 32; o <<= 1) { const int v = __shfl_up(inc, o); if (tid >= o) inc += v; }
        if (tid < 32) { cnt[32 + tid] = inc - c; soff[q * 33 + tid] = inc - c; if (tid == 31) soff[q * 33 + 32] = inc; } }
    __syncthreads();
    GAS unsigned* sg = (GAS unsigned*)(seg + (size_t)q * (PA_CH * 128));
#pragma unroll
    for (int j = 0; j < 14; ++j) if (ev[j] >= 0) { const int i = tid + NTHREADS * j, e = ev[j], r = ((e >> 7) + e) & 31;
        const int p = cnt[32 + r] + __hip_atomic_fetch_add(cnt + 96 + r, 1, __ATOMIC_RELAXED, __HIP_MEMORY_SCOPE_WORKGROUP);
        sg[p] = ((unsigned)(i >> 7) << 16) | ((unsigned)(i & 127) << 9) | (unsigned)(((e >> 7) << 2) | ((e >> 5) & 3)); }
    __syncthreads();
}
__device__ __forceinline__ int peer_a_pair(unsigned ent, unsigned xt, unsigned l16) {
    const unsigned ua = (ent & 511u) * 256u + l16, xa = xt + (ent >> 16) * 256u + l16;
    v4u U[8], X[8];
#pragma unroll
    for (int j = 0; j < 8; ++j) { U[j] = *(const LAS v4u*)(ua ^ (unsigned)(j << 4)); X[j] = *(const LAS v4u*)(xa ^ (unsigned)(j << 4)); }
    __builtin_amdgcn_sched_barrier(0);
    int a0 = 0, a1 = 0;
#pragma unroll
    for (int j = 0; j < 8; j += 2) {
        a0 = __builtin_amdgcn_sdot4((int)U[j].x, (int)X[j].x, a0, false); a1 = __builtin_amdgcn_sdot4((int)U[j + 1].x, (int)X[j + 1].x, a1, false);
        a0 = __builtin_amdgcn_sdot4((int)U[j].y, (int)X[j].y, a0, false); a1 = __builtin_amdgcn_sdot4((int)U[j + 1].y, (int)X[j + 1].y, a1, false);
        a0 = __builtin_amdgcn_sdot4((int)U[j].z, (int)X[j].z, a0, false); a1 = __builtin_amdgcn_sdot4((int)U[j + 1].z, (int)X[j + 1].z, a1, false);
        a0 = __builtin_amdgcn_sdot4((int)U[j].w, (int)X[j].w, a0, false); a1 = __builtin_amdgcn_sdot4((int)U[j + 1].w, (int)X[j + 1].w, a1, false); }
    a0 += a1;
    return a0 + __builtin_amdgcn_update_dpp(0, a0, 0x128, 0xf, 0xf, false);
}
#ifdef PROBE_LD
#define PAL_XTRA { const v4u y0_ = *(const GAS v4u*)(xb2 + ((size_t)t0_ * D + l16)), y1_ = *(const GAS v4u*)(xb2 + ((size_t)t1_ * D + l16)); xtra.x ^= y0_.x ^ y1_.y; }
#else
#define PAL_XTRA
#endif
#define PAL_LOAD(Q, XA, XB, EN) do { int q_ = (Q); q_ = q_ < PA_NCH4 ? q_ : PA_NCH4 - 1; int t0_ = q_ * PA_CH + (tid >> 4), t1_ = t0_ + 32; \
        t1_ = (tid >> 4) < PA_CH - 32 ? t1_ : t0_; t0_ = t0_ < M ? t0_ : M - 1; t1_ = t1_ < M ? t1_ : M - 1; \
        XA = *(const GAS v4u*)(xb + ((size_t)t0_ * D + l16)); XB = *(const GAS v4u*)(xb + ((size_t)t1_ * D + l16)); PAL_XTRA \
        const int nb_ = loff[2 * q_], nn_ = loff[2 * q_ + 1]; int ti_ = pidx < nn_ ? pidx : nn_ - 1; ti_ = ti_ > 0 ? ti_ : 0; EN = sg[nb_ + ti_]; } while (0)
#define PAL_WRITE(Q, XA, XB) do { const int b_ = PA_XT + ((Q) & 1) * PA_XTB + 16 * tid; *(LAS v4u*)(lds + b_) = XA; if (tid < (PA_CH - 32) * 16) *(LAS v4u*)(lds + b_ + 16 * NTHREADS) = XB; } while (0)
#ifdef PROBE_ST
#define PAL_STORE(E, A) do { const unsigned k_ = ((E) >> 9) & 127u; const size_t o_ = ((size_t)(q_s * PA_CH + (int)((E) >> 16)) * 8 + s) * 128 + (k_ & 3u) * 32u + (k_ >> 2); pa[o_] = (A); pa[o_ + (8u << 20)] = (A); } while (0)
#else
#define PAL_STORE(E, A) do { const unsigned k_ = ((E) >> 9) & 127u; pa[((size_t)(q_s * PA_CH + (int)((E) >> 16)) * 8 + s) * 128 + (k_ & 3u) * 32u + (k_ >> 2)] = (A); } while (0)
#endif
#ifdef PROBE_WR
#define PAL_XW(Q, XA, XB) do { asm volatile("" ::: "memory"); PAL_WRITE(Q, XA, XB); } while (0)
#elif defined(PROBE_BAR)
#define PAL_XW(Q, XA, XB) do { __syncthreads(); } while (0)
#else
#define PAL_XW(Q, XA, XB) do { } while (0)
#endif
#define PAL_STEP(Q, WXA, WXB, CXA, CXB, CEN) do { const int q_s = (Q); \
        __syncthreads();                       \
        PAL_WRITE(q_s + 1, WXA, WXB); PAL_XW(q_s + 1, WXA, WXB); \
        const unsigned e0_ = CEN; const int nb_s = loff[2 * q_s], n_s = loff[2 * q_s + 1]; const unsigned xt_s = (unsigned)(PA_XT + (q_s & 1) * PA_XTB); \
        PAL_LOAD(q_s + 4, CXA, CXB, CEN); \
        if (pidx < n_s) { const int a_ = peer_a_pair(e0_, xt_s, l16); if (!(tid & 8)) PAL_STORE(e0_, a_); } \
        _Pragma("unroll 1") for (int i_ = pidx + NTHREADS / 2; i_ < n_s; i_ += NTHREADS / 2) { const unsigned e1_ = sg[nb_s + i_]; const int a_ = peer_a_pair(e1_, xt_s, l16); if (!(tid & 8)) PAL_STORE(e1_, a_); } \
    } while (0)
__device__ __forceinline__ void peer_a_lds(int s, const signed char* xq, const unsigned* seg, const int* soff, int r, int* pa, LAS unsigned char* lds, int tid_) {
    int tid = tid_; asm volatile("" : "+v"(tid));
    const unsigned l16 = (unsigned)(tid & 15) << 4;
    const int pidx = (tid >> 4) * 8 + (tid & 7);
    LAS int* loff = (LAS int*)(lds + PA_LOFF);
    if (tid < PA_NCH4) { int b = 0, e = 0; if (tid < PA_NCH) { b = soff[tid * 33 + r]; e = soff[tid * 33 + r + 1]; } loff[2 * tid] = tid * (PA_CH * 128) + b; loff[2 * tid + 1] = e - b; }
    __syncthreads();
    const GAS unsigned char* xb = (const GAS unsigned char*)(xq + 256 * s);
    const GAS unsigned* sg = (const GAS unsigned*)seg;
    const GAS unsigned char* xb2 = (const GAS unsigned char*)(xq + 256 * ((s + 1) & 7)); v4u xtra = (v4u){0u, 0u, 0u, 0u}; (void)xb2;
    v4u x0a, x0b, x1a, x1b, x2a, x2b, x3a, x3b; unsigned en0, en1, en2, en3;
    PAL_LOAD(0, x0a, x0b, en0); PAL_LOAD(1, x1a, x1b, en1); PAL_LOAD(2, x2a, x2b, en2); PAL_LOAD(3, x3a, x3b, en3);
    PAL_WRITE(0, x0a, x0b);
#pragma unroll 1
    for (int q0 = 0; q0 < PA_NCH4; q0 += 4) {
        PAL_STEP(q0, x1a, x1b, x0a, x0b, en0);
        PAL_STEP(q0 + 1, x2a, x2b, x1a, x1b, en1);
        PAL_STEP(q0 + 2, x3a, x3b, x2a, x2b, en2);
        PAL_STEP(q0 + 3, x0a, x0b, x3a, x3b, en3);
    }
    if (xtra.x == 0x12345u) pa[0] = 0;
    __syncthreads();
}
__device__ __forceinline__ void peer_w_elem(size_t i, const int* experts, const float* gates, const float* su, const float* sv, const float* sx, const int* pa, float* wb) {
    const size_t t = i >> 7; const int k = (int)(i & 127), pos = (k & 3) * 32 + (k >> 2);
    const int e = experts[i];
    int a = 0;
#pragma unroll
    for (int s2 = 0; s2 < 8; ++s2) a += pa[(t * 8 + s2) * 128 + pos];
    wb[i] = gates[i] * gelu_erf((float)a * (su[e] * sx[t])) * sv[e];
}
#define PB_LOAD(R, IDV, HALF) do { _Pragma("unroll") for (int i_ = 0; i_ < 8; ++i_) { const unsigned e_ = (unsigned)__shfl(IDV, 4 * (i_ + 8 * (HALF)) + g); \
        R[i_] = *(const GAS v4u*)(vb + (e_ * 256u + offc)); } } while (0)
#define PB_COMP(R, WV, HALF) do { _Pragma("unroll") for (int i_ = 0; i_ < 8; ++i_) { const float wk_ = __shfl(WV, 4 * (i_ + 8 * (HALF)) + g); \
        axpy4f8v(&ya2[0], R[i_].x, wk_); axpy4f8v(&ya2[2], R[i_].y, wk_); axpy4f8v(&ya2[4], R[i_].z, wk_); axpy4f8v(&ya2[6], R[i_].w, wk_); } } while (0)
__device__ __forceinline__ void peer_b_task(int t0, int ntok, int s, const bf16* h1, const int* experts, const float* wb, const unsigned char* v8s, bf16* out, float* st, int lane_) {
    int lane = lane_; asm volatile("" : "+v"(lane));
    const int g = lane >> 4, c = lane & 15;
    const GAS unsigned char* vb = (const GAS unsigned char*)(v8s + (size_t)s * SLICE_BYTES);
    const unsigned offc = 16u * (unsigned)c;
    int idc0 = experts[(size_t)t0 * 128 + lane], idc1 = experts[(size_t)t0 * 128 + lane + 64];
    float wc0 = wb[(size_t)t0 * 128 + lane], wc1 = wb[(size_t)t0 * 128 + lane + 64];
    v4u RA[8], RB[8];
    PB_LOAD(RA, idc0, 0);
#pragma unroll 1
    for (int tt = 0; tt < ntok; ++tt) {
        const int t = t0 + tt, tn = tt + 1 < ntok ? t + 1 : t;
        const int idn0 = experts[(size_t)tn * 128 + lane], idn1 = experts[(size_t)tn * 128 + lane + 64];
        const float wn0 = wb[(size_t)tn * 128 + lane], wn1 = wb[(size_t)tn * 128 + lane + 64];
        f32x2_t ya2[8];
#pragma unroll
        for (int e = 0; e < 8; ++e) ya2[e] = (f32x2_t){0.f, 0.f};
#pragma unroll 1
        for (int hb = 0; hb < 2; ++hb) {
            const int idv = hb ? idc1 : idc0, idx = hb ? idn0 : idc1; const float wv = hb ? wc1 : wc0;
            PB_LOAD(RB, idv, 1); PB_COMP(RA, wv, 0);
            asm volatile("" ::: "memory");
            PB_LOAD(RA, idx, 0); PB_COMP(RB, wv, 1);
        }
        float ya[16];
#pragma unroll
        for (int e = 0; e < 8; ++e) { ya[2 * e] = ya2[e].x; ya[2 * e + 1] = ya2[e].y; }
#pragma unroll
        for (int e = 0; e < 16; ++e) { ya[e] += __shfl_xor(ya[e], 16); ya[e] += __shfl_xor(ya[e], 32); }
        const GAS v4u* hp = (const GAS v4u*)(h1 + (size_t)t * D + 256 * s + 16 * c);
        const v4u h0 = hp[0], h1v = hp[1];
        float hx[16];
        hx[0] = pg8::bf_lo(h0.x); hx[1] = pg8::bf_hi(h0.x); hx[2] = pg8::bf_lo(h0.y); hx[3] = pg8::bf_hi(h0.y); hx[4] = pg8::bf_lo(h0.z); hx[5] = pg8::bf_hi(h0.z); hx[6] = pg8::bf_lo(h0.w); hx[7] = pg8::bf_hi(h0.w);
        hx[8] = pg8::bf_lo(h1v.x); hx[9] = pg8::bf_hi(h1v.x); hx[10] = pg8::bf_lo(h1v.y); hx[11] = pg8::bf_hi(h1v.y); hx[12] = pg8::bf_lo(h1v.z); hx[13] = pg8::bf_hi(h1v.z); hx[14] = pg8::bf_lo(h1v.w); hx[15] = pg8::bf_hi(h1v.w);
        float sm = 0.f, sq = 0.f;
#pragma unroll
        for (int e = 0; e < 16; ++e) { ya[e] = hx[e] * ALPHA + ya[e]; sm += ya[e]; sq += ya[e] * ya[e]; }
        sm = row16_allsum(sm); sq = row16_allsum(sq);
        if (g == 0) { GAS v4u* op = (GAS v4u*)(out + (size_t)t * D + 256 * s + 16 * c);
            v4u o0, o1; o0.x = pk2(ya[0], ya[1]); o0.y = pk2(ya[2], ya[3]); o0.z = pk2(ya[4], ya[5]); o0.w = pk2(ya[6], ya[7]);
            o1.x = pk2(ya[8], ya[9]); o1.y = pk2(ya[10], ya[11]); o1.z = pk2(ya[12], ya[13]); o1.w = pk2(ya[14], ya[15]);
            op[0] = o0; op[1] = o1;
            if (c == 0) { st[((size_t)t * 8 + s) * 2] = sm; st[((size_t)t * 8 + s) * 2 + 1] = sq; } }
        idc0 = idn0; idc1 = idn1; wc0 = wn0; wc1 = wn1;
    }
}
__device__ __forceinline__ void peer_c_row(int t, const bf16* r2, float* out, const float* st, const float* g2, const float* b2, int lane) {
    float sm = 0.f, sq = 0.f;
#pragma unroll
    for (int s = 0; s < 8; ++s) { sm += st[((size_t)t * 8 + s) * 2]; sq += st[((size_t)t * 8 + s) * 2 + 1]; }
    const float mean = sm * (1.f / D), var = sq * (1.f / D) - mean * mean, rstd = 1.f / sqrtf(fmaxf(var, 0.f) + LN_EPS);
    const GAS v4u* xr = (const GAS v4u*)(r2 + (size_t)t * D) + lane;
    GAS f32x4* op = (GAS f32x4*)(out + (size_t)t * D);
#pragma unroll
    for (int j = 0; j < 4; ++j) { const v4u w = xr[64 * j]; const int c4 = 2 * (lane + 64 * j);
        const f32x4 g0 = *((const GAS f32x4*)g2 + c4), g1 = *((const GAS f32x4*)g2 + c4 + 1), b0 = *((const GAS f32x4*)b2 + c4), b1 = *((const GAS f32x4*)b2 + c4 + 1);
        const f32x4 v0 = (f32x4){pg8::bf_lo(w.x), pg8::bf_hi(w.x), pg8::bf_lo(w.y), pg8::bf_hi(w.y)}, v1 = (f32x4){pg8::bf_lo(w.z), pg8::bf_hi(w.z), pg8::bf_lo(w.w), pg8::bf_hi(w.w)};
        op[c4] = (v0 - mean) * rstd * g0 + b0; op[c4 + 1] = (v1 - mean) * rstd * g1 + b1; }
}

struct TwoPassOrder : pg8::StaticOrder {
    __device__ __forceinline__ bool next(int i, pg8::Unit& u) const { if (!pg8::StaticOrder::next(i >> 1, u)) return false; u.w = i & 1; return true; }
};
struct EpiGate2 {
    static constexpr bool PERM = true, AFTER_DRAIN = false;
    pg8::EpiGate<0> e0; pg8::EpiGate<1> e1;
    __device__ __forceinline__ void operator()(const pg8::f32x4 (&acc)[2][2][4][2], const pg8::Unit& u, int wr, int wc, int fr, int fq) const { if (u.w == 0) e0(acc, u, wr, wc, fr, fq); else e1(acc, u, wr, wc, fr, fq); }
};

struct EpiGate2I8 {
    static constexpr bool PERM = true, AFTER_DRAIN = false;
    pg8::EpiGateI8<0> e0; pg8::EpiGateI8<1> e1;
    __device__ __forceinline__ void operator()(const pg8::i32x4 (&acc)[2][2][4][2], const pg8::Unit& u, int wr, int wc, int fr, int fq) const { if (u.w == 0) e0(acc, u, wr, wc, fr, fq); else e1(acc, u, wr, wc, fr, fq); }
};
struct ConvOrder : pg8::StaticOrder {
    const float* pu; const float* pv; unsigned char* u8; unsigned char* v8; float* su; float* sv; int slot; mutable int calls;
    static constexpr int CONV_ROWS = 4, CONV_CALLS = 6;
    __device__ __forceinline__ void done(const pg8::Unit&) const {
        if (slot < 0) return;
        int lane = threadIdx.x & 63; asm volatile("" : "+v"(lane));
        const int wave = __builtin_amdgcn_readfirstlane(threadIdx.x >> 6);
        const int base = ((slot * NWAVES + wave) * CONV_CALLS + calls) * CONV_ROWS;
        if (calls < CONV_CALLS) {
#pragma unroll 1
            for (int j = 0; j < CONV_ROWS; ++j) { const int r = base + j; if (r < 2 * PNE) { const bool sec = r >= PNE; const int e = sec ? r - PNE : r;
                if (sec) row_to_fp8(pv + (size_t)e * D, v8 + (size_t)e * 256, sv + e, lane); else row_to_i8(pu + (size_t)e * D, u8 + (size_t)e * 256, su + e, lane); } }
        }
        ++calls;
    }
};

struct Args { const float* in[16]; float* out; unsigned char* ws; int ph_lo, ph_hi; };
__global__ void __launch_bounds__(NTHREADS, 2) mk_fwd(Args args) {
    extern __shared__ __attribute__((aligned(16))) unsigned char lds_raw[];
    LAS unsigned char* lds = (LAS unsigned char*)lds_raw;
    volatile LAS unsigned* MISC = (volatile LAS unsigned*)(lds + MISC_OFF);
    const int tid0 = threadIdx.x;
    const int G = gridDim.x, bx = blockIdx.x;
    unsigned char* ws = args.ws;
    gu32* ctl = (gu32*)(ws + WS_CTL);
#define IN_(i) (args.in[i])
#define x_in IN_(0)
#define w_in IN_(1)
#define b_gate IN_(2)
#define sinks IN_(3)
#define conv_w IN_(4)
#define w_ao IN_(5)
#define w_co IN_(6)
#define w_o IN_(7)
#define ln1_g IN_(8)
#define ln1_b IN_(9)
#define w_q IN_(10)
#define sub_keys IN_(11)
#define peer_u IN_(12)
#define peer_v IN_(13)
#define ln2_g IN_(14)
#define ln2_b IN_(15)
#define WinT ((bf16*)(ws + WS_WIN))
#define WaT ((bf16*)(ws + WS_WA))
#define WcT ((bf16*)(ws + WS_WC))
#define WoT ((bf16*)(ws + WS_WO))
#define WfT ((bf16*)(ws + WS_WF))
#define XB ((bf16*)(ws + WS_XB))
#define MERGED ((bf16*)(ws + WS_MERGED))
#define Z ((bf16*)(ws + WS_Z))
#define R2B ((bf16*)(ws + WS_R2B))
#define H1B ((bf16*)(ws + WS_H1B))
#define SC ((float*)(ws + WS_SC))
#define EX ((int*)(ws + WS_EX))
#define GT ((float*)(ws + WS_GT))
#define AO ((bf16*)(ws + WS_AO))
#define CI ((bf16*)(ws + WS_CI))
#define TMP ((bf16*)(ws + WS_TMP))
#define U8 ((unsigned char*)(ws + WS_U8))
#define V8 ((unsigned char*)(ws + WS_V8))
#define SU ((float*)(ws + WS_SU))
#define SV ((float*)(ws + WS_SV))
#define PA ((int*)(ws + WS_PA))
#define ST ((float*)(ws + WS_ST))
#define WB ((float*)(ws + WS_WB))
#define XA8 ((signed char*)(ws + WS_XA8))
#define WIN8 ((signed char*)(ws + WS_WIN8))
#define SWIN ((float*)(ws + WS_SWIN))
#define SXA ((float*)(ws + WS_SXA))
#define WF8 ((signed char*)(ws + WS_WF8))
#define MG8 ((signed char*)(ws + WS_MG8))
#define WO8 ((signed char*)(ws + WS_WO8))
#define SMG ((float*)(ws + WS_SMG))
#define SWO ((float*)(ws + WS_SWO))
#define AO8 ((signed char*)(ws + WS_AO8))
#define CI8 ((signed char*)(ws + WS_CI8))
#define WA8 ((signed char*)(ws + WS_WA8))
#define WC8 ((signed char*)(ws + WS_WC8))
#define SAO ((float*)(ws + WS_S3))
#define SCI ((float*)(ws + WS_S3 + 65536))
#define SWA ((float*)(ws + WS_S3 + 131072))
#define SWC ((float*)(ws + WS_S3 + 196608))
#define SWF ((float*)(ws + WS_SWF))
#define XQ ((signed char*)(ws + WS_XQ))
#define SX ((float*)(ws + WS_SX))
#define SEG ((unsigned*)(ws + WS_SEG))
#define SOFF ((int*)(ws + WS_SOFF))
    for (int u = tid0; u < (LDS_BYTES - LDSCTL_OFF) / 4; u += NTHREADS) ((LAS unsigned*)(lds + LDSCTL_OFF))[u] = 0u;
    __syncthreads();
    XcdBarrier bar; bar.bar = (unsigned*)(ctl + CW_BAR); bar.x = 0; bar.st = nullptr;
    if (!MK_PER_PHASE) bar = xcd_barrier_post((unsigned*)(ctl + CW_BAR), MISC + 8);
    const int lo = args.ph_lo, hi = args.ph_hi;
#ifndef PH_MASK
#define PH_MASK 0xFFF
#endif
#define IN(k) (((PH_MASK >> (k)) & 1) && lo <= (k) && (k) < hi)
#ifndef DBL_BAR
#define DBL_BAR 0
#endif
#define SEAM(k) do { if (IN(k) && IN((k) + 1)) { xcd_barrier(bar); if (DBL_BAR) xcd_barrier(bar); } } while (0)
#ifndef DBL_MASK
#define DBL_MASK 0
#endif
#define REP(k) for (int rep_ = 0; rep_ < 1 + ((DBL_MASK >> (k)) & 1); ++rep_)
#define PHASE_TID() int tid = tid0; asm volatile("" : "+v"(tid)); const int lane = tid & 63, wave = __builtin_amdgcn_readfirstlane(tid >> 6); (void)lane; (void)wave

    if (IN(0)) REP(0) {
        PHASE_TID();
        const bool conv_first = ((bx >> 3) & 1) == 0;
#pragma unroll 1
        for (int part = 0; part < 2; ++part) {
            if ((part == 0) == conv_first) {
                int tid = tid0; asm volatile("" : "+v"(tid)); const int lane = tid & 63, wave = __builtin_amdgcn_readfirstlane(tid >> 6);
                LAS float* scr = (LAS float*)(lds + wave * 16384);
                const int gw = bx * NWAVES + wave, NGW = G * NWAVES;
                constexpr int I_IN = (D / 64) * (IN_W / 32), I_SQ = (D / 64) * (D / 32);
                for (int it = gw; it < I_IN + 3 * I_SQ; it += NGW) {
                    int r = it;
                    if (r < I_IN) { p0_transpose_item(w_in, D, IN_W, WinT, scr, r, lane); continue; } r -= I_IN;
                    if (r < I_SQ) { p0_transpose_item(w_ao, D, D, WaT, scr, r, lane); continue; } r -= I_SQ;
                    if (r < I_SQ) { p0_transpose_item(w_co, D, D, WcT, scr, r, lane); continue; } r -= I_SQ;
                    p0_transpose_item(w_o, D, D, WoT, scr, r, lane);
                }
                for (int r = gw; r < M; r += NGW) row_f32_to_i8(x_in + (size_t)r * D, XA8 + (size_t)r * D, SXA + r, lane);
                __syncthreads();
            }
            if (part == 0) for (int it = bx; it < 16 * 32; it += G) p0_wf_item(w_q, sub_keys, WfT, lds, it, tid);
        }
    }
    SEAM(0);
    if (IN(1)) REP(1) {
        { PHASE_TID();
          for (int r = bx * NWAVES + wave; r < IN_W + 2 * D; r += G * NWAVES) { if (r < IN_W) row_bf16_to_i8(WinT + (size_t)r * D, WIN8 + (size_t)r * D, SWIN + r, lane);
              else if (r < IN_W + D) { const int q = r - IN_W; row_bf16_to_i8(WfT + (size_t)q * D, WF8 + (size_t)q * D, SWF + q, lane); }
              else { const int q = r - IN_W - D; row_bf16_to_i8(WoT + (size_t)q * D, WO8 + (size_t)q * D, SWO + q, lane); } } }
        if (!MK_PER_PHASE) xcd_barrier(bar);
        pg8::Gemm g{(const bf16*)XA8, (const bf16*)WIN8, M, IN_W, D / 2}; ConvOrder S; S.init(M, IN_W, G, bx);
        S.pu = peer_u; S.pv = peer_v; S.u8 = U8; S.v8 = V8; S.su = SU; S.sv = SV; S.calls = 0;
        S.slot = (G == 256 && bx >= 64) ? bx - 64 : -1;
        pg8::EpiI8Bf16 E{Z, IN_W, SXA, SWIN};
        pg8::gemm_phase<pg8::EpiI8Bf16, ConvOrder, true, true, true>(lds, g, S, E);
        if (G != 256) {
            PHASE_TID();
            for (int r = bx * NWAVES + wave; r < 2 * PNE; r += G * NWAVES) { const bool sec = r >= PNE; const int e = sec ? r - PNE : r;
                if (sec) row_to_fp8(peer_v + (size_t)e * D, V8 + (size_t)e * 256, SV + e, lane); else row_to_i8(peer_u + (size_t)e * D, U8 + (size_t)e * 256, SU + e, lane); }
        }
    }
    SEAM(1);
    if (IN(2)) REP(2) {
        PHASE_TID();
        const bool conv_first = ((bx >> 3) & 1) == 0;
#pragma unroll 1
        for (int part = 0; part < 2; ++part) {
            if ((part == 0) == conv_first) { int t2 = tid0; asm volatile("" : "+v"(t2)); for (int it = bx; it < M / 32; it += G) conv_item(it, Z, conv_w, CI, t2); }
            if (part == 0) for (int u = bx; u < BATCH * NKVH * 16; u += G) attn_unit(u, Z, AO, sinks, lds, tid);
        }
    }
    SEAM(2);
    if (IN(3)) REP(3) {
        TwoPassOrder S; S.init(M, D, G, bx);
#ifndef P3_I8
#define P3_I8 1
#endif
        if (P3_I8 && !MK_PER_PHASE) {
            { PHASE_TID();
              for (int r = bx * NWAVES + wave; r < 2 * M + 2 * D; r += G * NWAVES) {
                  if (r < M) row_bf16_to_i8(AO + (size_t)r * D, AO8 + (size_t)r * D, SAO + r, lane);
                  else if (r < 2 * M) { const int q = r - M; row_bf16_to_i8(CI + (size_t)q * D, CI8 + (size_t)q * D, SCI + q, lane); }
                  else if (r < 2 * M + D) { const int q = r - 2 * M; row_bf16_to_i8(WaT + (size_t)q * D, WA8 + (size_t)q * D, SWA + q, lane); }
                  else { const int q = r - 2 * M - D; row_bf16_to_i8(WcT + (size_t)q * D, WC8 + (size_t)q * D, SWC + q, lane); } } }
            xcd_barrier(bar);
            pg8::Gemm g{(const bf16*)AO8, (const bf16*)WA8, M, D, D / 2, (const bf16*)CI8, (const bf16*)WC8};
            EpiGate2I8 E{pg8::EpiGateI8<0>{TMP, nullptr, Z + G_OFF, b_gate, D, IN_W, SAO, SWA}, pg8::EpiGateI8<1>{MERGED, TMP, Z + G_OFF + D, b_gate + D, D, IN_W, SCI, SWC}};
            pg8::gemm_phase<EpiGate2I8, TwoPassOrder, true, true, true>(lds, g, S, E);
        } else {
        pg8::Gemm g{AO, WaT, M, D, D, CI, WcT};
        EpiGate2 E{pg8::EpiGate<0>{TMP, nullptr, Z + G_OFF, b_gate, D, IN_W}, pg8::EpiGate<1>{MERGED, TMP, Z + G_OFF + D, b_gate + D, D, IN_W}};
        pg8::gemm_phase<EpiGate2, TwoPassOrder, true, true>(lds, g, S, E);
        }
    }
    SEAM(3);
    if (IN(4)) REP(4) {
        pg8::StaticOrder S; S.init(M, D, G, bx);
#ifndef P4_I8
#define P4_I8 1
#endif
        if (P4_I8 && !MK_PER_PHASE) {
            { PHASE_TID(); for (int r = bx * NWAVES + wave; r < M; r += G * NWAVES) row_bf16_to_i8(MERGED + (size_t)r * D, MG8 + (size_t)r * D, SMG + r, lane); }
            xcd_barrier(bar);
            pg8::Gemm g{(const bf16*)MG8, (const bf16*)WO8, M, D, D / 2};
            pg8::EpiResI8Bf16 E{H1B, D, x_in, ALPHA, SMG, SWO};
            pg8::gemm_phase<pg8::EpiResI8Bf16, pg8::StaticOrder, true, true, true>(lds, g, S, E);
        } else {
        pg8::Gemm g{MERGED, WoT, M, D, D};
        pg8::EpiResBf16 E{H1B, D, x_in, ALPHA};
        pg8::gemm_phase<pg8::EpiResBf16, pg8::StaticOrder, true, true>(lds, g, S, E);
        }
    }
    SEAM(4);
    if (IN(5)) REP(5) {
        PHASE_TID();
        const int gw = bx * NWAVES + wave, NGW = G * NWAVES;
        for (int m = gw; m < M; m += NGW) ln1_row(H1B + (size_t)m * D, XQ + (size_t)m * D, SX + m, ln1_g, ln1_b, lane);
    }
    SEAM(5);
    if (IN(6)) REP(6) {
        pg8::Gemm g{H1B, WfT, M, D, D}; pg8::StaticOrder S; S.init(M, D, G, bx);
#ifndef P6_I8
#define P6_I8 1
#endif
        if (G == 256 && P6_I8) { pg8::Gemm g8{(const bf16*)XQ, (const bf16*)WF8, M, D, D / 2}; EpiTopKI8 E{EX, GT, SX, SWF}; pg8::gemm_phase<EpiTopKI8, pg8::StaticOrder, false, true, true>(lds, g8, S, E); }
        else if (G == 256) { EpiTopK E{EX, GT}; pg8::gemm_phase<EpiTopK, pg8::StaticOrder, false, true>(lds, g, S, E); }
        else { pg8::EpiF32 E{SC, D, nullptr, 0.f}; pg8::gemm_phase<pg8::EpiF32, pg8::StaticOrder, true, true>(lds, g, S, E); }
    }
    SEAM(6);
    if (IN(7)) REP(7) {
        PHASE_TID();
        if (G != 256) for (int p = bx; p < (M * PH) / 128; p += G) topk_pass(p, SC, EX, GT, lds, tid);
        else { peer_shard_load(bx & 7, bx >> 3, U8, lds, tid);
               if (bx < PA_NCH) peer_bucket(bx, EX, SEG, SOFF, lds, tid); }
    }
    SEAM(7);
    if (IN(8)) REP(8) {
        PHASE_TID();
        if (G == 256) peer_a_lds(bx & 7, XQ, SEG, SOFF, bx >> 3, PA, lds, tid);
        else {
        const int xcc = (int)(xb_xcc_id() & 7u);
#pragma unroll 1
#ifndef SCRAMBLE
#define SCRAMBLE 0
#endif
        for (int sl = 0; sl < 8; ++sl) { const int s = (xcc + sl + (SCRAMBLE ? wave : 0)) & 7;
            for (;;) { const int tg = q_pull((unsigned*)(ctl + CW_Q + 64 * (s + 16 * rep_)), lane); if (tg >= PEER_NTASK) break;
                int t0, nt; peer_task_tokens(tg, t0, nt); peer_a_task(t0, nt, s, XQ, EX, U8, PA, lane); } }
        }
    }
    SEAM(8);
    if (IN(9)) REP(9) {
        PHASE_TID();
        for (size_t i = (size_t)bx * NTHREADS + tid; i < (size_t)M * 128; i += (size_t)G * NTHREADS) peer_w_elem(i, EX, GT, SU, SV, SX, PA, WB);
    }
    SEAM(9);
    if (IN(10)) REP(10) {
        PHASE_TID();
        const int xcc = (int)(xb_xcc_id() & 7u);
#pragma unroll 1
#ifndef SCRAMBLE
#define SCRAMBLE 0
#endif
        for (int sl = 0; sl < 8; ++sl) { const int s = (xcc + sl + (SCRAMBLE ? wave : 0)) & 7;
            for (;;) { const int tg = q_pull((unsigned*)(ctl + CW_Q + 64 * (8 + s + 16 * rep_)), lane); if (tg >= PEER_NTASK) break;
                int t0, nt; peer_task_tokens(tg, t0, nt); peer_b_task(t0, nt, s, H1B, EX, WB, V8, R2B, ST, lane); } }
    }
    SEAM(10);
    if (IN(11)) REP(11) {
        PHASE_TID();
        const int gw = bx * NWAVES + wave, NGW = G * NWAVES;
        for (int t = gw; t < M; t += NGW) peer_c_row(t, R2B, args.out, ST, ln2_g, ln2_b, lane);
    }
#undef IN
#undef SEAM
}

extern "C" void kernel_launch(void* const* d_in, const int* in_sizes, int n_in, void* d_out, int out_size, void* d_ws, size_t ws_size, hipStream_t stream) {
    static int grid = 0;
    if (grid == 0) {
        if (n_in != 16 || out_size != M * D || ws_size < WS_END) { fprintf(stderr, "kernel_launch: unexpected shapes (n_in %d out %d ws %zu)\n", n_in, out_size, ws_size); grid = -1; return; }
        int dev = 0, cus = 0, per_cu = 0;
        if (hipGetDevice(&dev) != hipSuccess || hipDeviceGetAttribute(&cus, hipDeviceAttributeMultiprocessorCount, dev) != hipSuccess) { grid = -1; return; }
        if (hipFuncSetAttribute((const void*)mk_fwd, hipFuncAttributeMaxDynamicSharedMemorySize, LDS_BYTES) != hipSuccess) { fprintf(stderr, "kernel_launch: hipFuncSetAttribute failed\n"); grid = -1; return; }
        if (hipOccupancyMaxActiveBlocksPerMultiprocessor(&per_cu, (const void*)mk_fwd, NTHREADS, LDS_BYTES) != hipSuccess || per_cu < 1) { fprintf(stderr, "kernel_launch: occupancy query says %d\n", per_cu); per_cu = 1; }
        (void)hipGetLastError();
        if (per_cu > 1) per_cu = 1;
        grid = cus * per_cu;
    }
    if (grid < 0) return;
    if (hipMemsetAsync((char*)d_ws + WS_CTL, 0, CTL_ZERO_BYTES, stream) != hipSuccess) { fprintf(stderr, "kernel_launch: memset failed\n"); return; }
    Args a{};
    for (int i = 0; i < 16; ++i) a.in[i] = (const float*)d_in[i];
    a.out = (float*)d_out; a.ws = (unsigned char*)d_ws;
#if MK_PER_PHASE
    for (int p = 0; p < N_PHASES; ++p) { a.ph_lo = p; a.ph_hi = p + 1; hipLaunchKernelGGL(mk_fwd, dim3(grid), dim3(NTHREADS), LDS_BYTES, stream, a); }
#else
    a.ph_lo = 0; a.ph_hi = N_PHASES;
    void* kargs[] = {&a};
#ifdef PLAIN_LAUNCH
    (void)kargs; hipLaunchKernelGGL(mk_fwd, dim3(grid), dim3(NTHREADS), LDS_BYTES, stream, a); hipError_t e = hipPeekAtLastError();
#else
    hipError_t e = hipLaunchCooperativeKernel((const void*)mk_fwd, dim3(grid), dim3(NTHREADS), kargs, LDS_BYTES, stream);
#endif
    if (e != hipSuccess) fprintf(stderr, "kernel_launch: cooperative launch failed: %s (grid %d)\n", hipGetErrorString(e), grid);
#endif
}
```

```cpp
#include <hip/hip_runtime.h>
#include <cstdio>
#include <cstdint>
#include <type_traits>
namespace pg8 {
#define PG8_LAS __attribute__((address_space(3)))
typedef unsigned short bf16_t;
typedef short bf16x8 __attribute__((ext_vector_type(8)));
typedef float f32x4 __attribute__((ext_vector_type(4)));
typedef unsigned u32x4 __attribute__((ext_vector_type(4)));
constexpr int BM = 256, BK = 64, HALF = 128, HTB = HALF * BK * 2  , STAGE_BYTES = 8 * HTB, NXCD = 8, WGM = 8;

__host__ __device__ __forceinline__ int lds_byte(int r, int c) { const int st = (r >> 4) * 2 + (c >> 5), rr = r & 15, cc = c & 31, ob = rr * 64 + cc * 2; return st * 1024 + (ob ^ (((ob >> 9) & 1) << 5)); }
__host__ __device__ __forceinline__ void stage_rc(int b, int& R, int& C) { const int st = b / 1024, sb = b % 1024, swz = sb ^ (((sb >> 9) & 1) << 5); R = (st >> 1) * 16 + swz / 64; C = (st & 1) * 32 + (swz % 64) / 2; }
__host__ __device__ __forceinline__ int perm32(int rho) { const int n = rho >> 4, i = rho & 15; return 8 * (i >> 2) + 4 * n + (i & 3); }

struct Unit { int pm, pn, w; };
struct Gemm { const bf16_t* A; const bf16_t* Bt; int M, N, K; const bf16_t* A2 = nullptr; const bf16_t* Bt2 = nullptr; };

struct StaticOrder {
    int nM, nN, nwg, G, c;
    __host__ __device__ void init(int M, int N, int G_, int c_) { nM = M / BM; nN = N / BM; nwg = nM * nN; G = G_; c = c_; }
    __host__ __device__ bool next(int i, Unit& u) const {
        const long L = (long)i * G + c; if (L >= nwg) return false;
        int wgid = (int)L; { const int q = nwg / NXCD, r = nwg % NXCD, xcd = wgid % NXCD, off = wgid / NXCD; wgid = (xcd < r ? xcd * (q + 1) : r * (q + 1) + (xcd - r) * q) + off; }
        const int nig = WGM * nN, gid = wgid / nig, fm = gid * WGM, gsz = (nM - fm) < WGM ? (nM - fm) : WGM;
        u.pm = fm + ((wgid % nig) % gsz); u.pn = (wgid % nig) / gsz; u.w = 0; return true;
    }
    __device__ __forceinline__ void a_ready(const Unit&) const {}
    __device__ __forceinline__ void done(const Unit&) const {}
};


__device__ __forceinline__ unsigned cvt_pk_bf16(float lo, float hi) { unsigned r; asm volatile("v_cvt_pk_bf16_f32 %0, %1, %2" : "=v"(r) : "v"(lo), "v"(hi)); return r; }
__device__ __forceinline__ float bf_lo(unsigned w) { return __builtin_bit_cast(float, w << 16); }
__device__ __forceinline__ float bf_hi(unsigned w) { return __builtin_bit_cast(float, w & 0xffff0000u); }
__device__ __forceinline__ float sigmoidf_(float x) { return __builtin_amdgcn_rcpf(1.0f + __expf(-x)); }

struct EpiBf16 {
    static constexpr bool PERM = true, AFTER_DRAIN = false;
    bf16_t* O; int ldc;
    __device__ __forceinline__ void operator()(const f32x4 (&acc)[2][2][4][2], const Unit& u, int wr, int wc, int fr, int fq) const {
        const int row0 = u.pm * BM + wr * 64 + fr, col0 = u.pn * BM + wc * 32 + 8 * fq;
#pragma unroll
        for (int ai = 0; ai < 2; ++ai)
#pragma unroll
            for (int m = 0; m < 4; ++m) { bf16_t* rowp = O + (size_t)(row0 + ai * HALF + m * 16) * ldc + col0;
#pragma unroll
                for (int bj = 0; bj < 2; ++bj) { const f32x4 v0 = acc[ai][bj][m][0], v1 = acc[ai][bj][m][1];
                    u32x4 w; w.x = cvt_pk_bf16(v0[0], v0[1]); w.y = cvt_pk_bf16(v0[2], v0[3]); w.z = cvt_pk_bf16(v1[0], v1[1]); w.w = cvt_pk_bf16(v1[2], v1[3]);
                    *(u32x4*)(rowp + bj * HALF) = w; } }
    }
};
template <int SECOND> struct EpiGate {
    static constexpr bool PERM = true, AFTER_DRAIN = false;
    bf16_t* O; const bf16_t* T; const bf16_t* Zg; const float* bg; int ldc, ldz;
    __device__ __forceinline__ void operator()(const f32x4 (&acc)[2][2][4][2], const Unit& u, int wr, int wc, int fr, int fq) const {
        const int row0 = u.pm * BM + wr * 64 + fr, col0 = u.pn * BM + wc * 32 + 8 * fq;
        f32x4 bv[2][2];
#pragma unroll
        for (int bj = 0; bj < 2; ++bj)
#pragma unroll
            for (int n = 0; n < 2; ++n) bv[bj][n] = *(const f32x4*)(bg + col0 + bj * HALF + 4 * n);
#pragma unroll
        for (int ai = 0; ai < 2; ++ai)
#pragma unroll
            for (int m = 0; m < 4; ++m) { const size_t row = (size_t)(row0 + ai * HALF + m * 16);
#pragma unroll
                for (int bj = 0; bj < 2; ++bj) { const int c = col0 + bj * HALF;
                    const u32x4 zg = *(const u32x4*)(Zg + row * ldz + c);
                    f32x4 v0 = acc[ai][bj][m][0], v1 = acc[ai][bj][m][1];
                    v0[0] *= sigmoidf_(bf_lo(zg.x) + bv[bj][0][0]); v0[1] *= sigmoidf_(bf_hi(zg.x) + bv[bj][0][1]);
                    v0[2] *= sigmoidf_(bf_lo(zg.y) + bv[bj][0][2]); v0[3] *= sigmoidf_(bf_hi(zg.y) + bv[bj][0][3]);
                    v1[0] *= sigmoidf_(bf_lo(zg.z) + bv[bj][1][0]); v1[1] *= sigmoidf_(bf_hi(zg.z) + bv[bj][1][1]);
                    v1[2] *= sigmoidf_(bf_lo(zg.w) + bv[bj][1][2]); v1[3] *= sigmoidf_(bf_hi(zg.w) + bv[bj][1][3]);
                    if (SECOND) { const u32x4 t = *(const u32x4*)(T + row * ldc + c);
                        v0[0] += bf_lo(t.x); v0[1] += bf_hi(t.x); v0[2] += bf_lo(t.y); v0[3] += bf_hi(t.y);
                        v1[0] += bf_lo(t.z); v1[1] += bf_hi(t.z); v1[2] += bf_lo(t.w); v1[3] += bf_hi(t.w); }
                    u32x4 w; w.x = cvt_pk_bf16(v0[0], v0[1]); w.y = cvt_pk_bf16(v0[2], v0[3]); w.z = cvt_pk_bf16(v1[0], v1[1]); w.w = cvt_pk_bf16(v1[2], v1[3]);
                    *(u32x4*)(O + row * ldc + c) = w; } }
    }
};
struct EpiF32 {
    static constexpr bool PERM = false, AFTER_DRAIN = false;
    float* C; int ldc; const float* R; float scale;
    __device__ __forceinline__ void operator()(const f32x4 (&acc)[2][2][4][2], const Unit& u, int wr, int wc, int fr, int fq) const {
        const int row0 = u.pm * BM + wr * 64 + fr, col0 = u.pn * BM + wc * 32 + 4 * fq;
#pragma unroll
        for (int ai = 0; ai < 2; ++ai)
#pragma unroll
            for (int m = 0; m < 4; ++m) { const size_t off = (size_t)(row0 + ai * HALF + m * 16) * ldc + col0;
#pragma unroll
                for (int bj = 0; bj < 2; ++bj)
#pragma unroll
                    for (int n = 0; n < 2; ++n) { f32x4 v = acc[ai][bj][m][n];
                        if (R) v += *(const f32x4*)(R + off + bj * HALF + n * 16) * scale;
                        *(f32x4*)(C + off + bj * HALF + n * 16) = v; } }
    }
};
struct EpiResBf16 {
    static constexpr bool PERM = true, AFTER_DRAIN = false;
    bf16_t* O; int ldc; const float* R; float scale;
    __device__ __forceinline__ void operator()(const f32x4 (&acc)[2][2][4][2], const Unit& u, int wr, int wc, int fr, int fq) const {
        const int row0 = u.pm * BM + wr * 64 + fr, col0 = u.pn * BM + wc * 32 + 8 * fq;
#pragma unroll
        for (int ai = 0; ai < 2; ++ai)
#pragma unroll
            for (int m = 0; m < 4; ++m) { const size_t off = (size_t)(row0 + ai * HALF + m * 16) * ldc + col0;
#pragma unroll
                for (int bj = 0; bj < 2; ++bj) { const f32x4 r0 = *(const f32x4*)(R + off + bj * HALF), r1 = *(const f32x4*)(R + off + bj * HALF + 4);
                    const f32x4 v0 = acc[ai][bj][m][0] + r0 * scale, v1 = acc[ai][bj][m][1] + r1 * scale;
                    u32x4 w; w.x = cvt_pk_bf16(v0[0], v0[1]); w.y = cvt_pk_bf16(v0[2], v0[3]); w.z = cvt_pk_bf16(v1[0], v1[1]); w.w = cvt_pk_bf16(v1[2], v1[3]);
                    *(u32x4*)(O + off + bj * HALF) = w; } }
    }
};
typedef int i32x4e __attribute__((ext_vector_type(4)));
struct EpiI8Bf16 {
    static constexpr bool PERM = true, AFTER_DRAIN = false;
    bf16_t* O; int ldc; const float* sa; const float* sb;
    __device__ __forceinline__ void operator()(const i32x4e (&acc)[2][2][4][2], const Unit& u, int wr, int wc, int fr, int fq) const {
        const int row0 = u.pm * BM + wr * 64 + fr, col0 = u.pn * BM + wc * 32 + 8 * fq;
        f32x4 sbv[2][2];
#pragma unroll
        for (int bj = 0; bj < 2; ++bj)
#pragma unroll
            for (int n = 0; n < 2; ++n) sbv[bj][n] = *(const f32x4*)(sb + col0 + bj * HALF + 4 * n);
#pragma unroll
        for (int ai = 0; ai < 2; ++ai)
#pragma unroll
            for (int m = 0; m < 4; ++m) { const int row = row0 + ai * HALF + m * 16; const float sr = sa[row]; bf16_t* rowp = O + (size_t)row * ldc + col0;
#pragma unroll
                for (int bj = 0; bj < 2; ++bj) { const i32x4e a0 = acc[ai][bj][m][0], a1 = acc[ai][bj][m][1];
                    const f32x4 v0 = (f32x4){(float)a0[0], (float)a0[1], (float)a0[2], (float)a0[3]} * sbv[bj][0] * sr, v1 = (f32x4){(float)a1[0], (float)a1[1], (float)a1[2], (float)a1[3]} * sbv[bj][1] * sr;
                    u32x4 w; w.x = cvt_pk_bf16(v0[0], v0[1]); w.y = cvt_pk_bf16(v0[2], v0[3]); w.z = cvt_pk_bf16(v1[0], v1[1]); w.w = cvt_pk_bf16(v1[2], v1[3]);
                    *(u32x4*)(rowp + bj * HALF) = w; } }
    }
};
template <int SECOND> struct EpiGateI8 {
    static constexpr bool PERM = true, AFTER_DRAIN = false;
    bf16_t* O; const bf16_t* T; const bf16_t* Zg; const float* bg; int ldc, ldz; const float* sa; const float* sb;
    __device__ __forceinline__ void operator()(const i32x4e (&acc)[2][2][4][2], const Unit& u, int wr, int wc, int fr, int fq) const {
        const int row0 = u.pm * BM + wr * 64 + fr, col0 = u.pn * BM + wc * 32 + 8 * fq;
        f32x4 bv[2][2], sbv[2][2];
#pragma unroll
        for (int bj = 0; bj < 2; ++bj)
#pragma unroll
            for (int n = 0; n < 2; ++n) { bv[bj][n] = *(const f32x4*)(bg + col0 + bj * HALF + 4 * n); sbv[bj][n] = *(const f32x4*)(sb + col0 + bj * HALF + 4 * n); }
#pragma unroll
        for (int ai = 0; ai < 2; ++ai)
#pragma unroll
            for (int m = 0; m < 4; ++m) { const size_t row = (size_t)(row0 + ai * HALF + m * 16); const float sr = sa[row];
#pragma unroll
                for (int bj = 0; bj < 2; ++bj) { const int c = col0 + bj * HALF;
                    const u32x4 zg = *(const u32x4*)(Zg + row * ldz + c);
                    const i32x4e a0 = acc[ai][bj][m][0], a1 = acc[ai][bj][m][1];
                    f32x4 v0 = (f32x4){(float)a0[0], (float)a0[1], (float)a0[2], (float)a0[3]} * sbv[bj][0] * sr, v1 = (f32x4){(float)a1[0], (float)a1[1], (float)a1[2], (float)a1[3]} * sbv[bj][1] * sr;
                    v0[0] *= sigmoidf_(bf_lo(zg.x) + bv[bj][0][0]); v0[1] *= sigmoidf_(bf_hi(zg.x) + bv[bj][0][1]);
                    v0[2] *= sigmoidf_(bf_lo(zg.y) + bv[bj][0][2]); v0[3] *= sigmoidf_(bf_hi(zg.y) + bv[bj][0][3]);
                    v1[0] *= sigmoidf_(bf_lo(zg.z) + bv[bj][1][0]); v1[1] *= sigmoidf_(bf_hi(zg.z) + bv[bj][1][1]);
                    v1[2] *= sigmoidf_(bf_lo(zg.w) + bv[bj][1][2]); v1[3] *= sigmoidf_(bf_hi(zg.w) + bv[bj][1][3]);
                    if (SECOND) { const u32x4 t = *(const u32x4*)(T + row * ldc + c);
                        v0[0] += bf_lo(t.x); v0[1] += bf_hi(t.x); v0[2] += bf_lo(t.y); v0[3] += bf_hi(t.y);
                        v1[0] += bf_lo(t.z); v1[1] += bf_hi(t.z); v1[2] += bf_lo(t.w); v1[3] += bf_hi(t.w); }
                    u32x4 w; w.x = cvt_pk_bf16(v0[0], v0[1]); w.y = cvt_pk_bf16(v0[2], v0[3]); w.z = cvt_pk_bf16(v1[0], v1[1]); w.w = cvt_pk_bf16(v1[2], v1[3]);
                    *(u32x4*)(O + row * ldc + c) = w; } }
    }
};
struct EpiResI8Bf16 {
    static constexpr bool PERM = true, AFTER_DRAIN = false;
    bf16_t* O; int ldc; const float* R; float scale; const float* sa; const float* sb;
    __device__ __forceinline__ void operator()(const i32x4e (&acc)[2][2][4][2], const Unit& u, int wr, int wc, int fr, int fq) const {
        const int row0 = u.pm * BM + wr * 64 + fr, col0 = u.pn * BM + wc * 32 + 8 * fq;
        f32x4 sbv[2][2];
#pragma unroll
        for (int bj = 0; bj < 2; ++bj)
#pragma unroll
            for (int n = 0; n < 2; ++n) sbv[bj][n] = *(const f32x4*)(sb + col0 + bj * HALF + 4 * n);
#pragma unroll
        for (int ai = 0; ai < 2; ++ai)
#pragma unroll
            for (int m = 0; m < 4; ++m) { const int row = row0 + ai * HALF + m * 16; const float sr = sa[row]; const size_t off = (size_t)row * ldc + col0;
#pragma unroll
                for (int bj = 0; bj < 2; ++bj) { const f32x4 r0 = *(const f32x4*)(R + off + bj * HALF), r1 = *(const f32x4*)(R + off + bj * HALF + 4);
                    const i32x4e a0 = acc[ai][bj][m][0], a1 = acc[ai][bj][m][1];
                    const f32x4 v0 = (f32x4){(float)a0[0], (float)a0[1], (float)a0[2], (float)a0[3]} * sbv[bj][0] * sr + r0 * scale, v1 = (f32x4){(float)a1[0], (float)a1[1], (float)a1[2], (float)a1[3]} * sbv[bj][1] * sr + r1 * scale;
                    u32x4 w; w.x = cvt_pk_bf16(v0[0], v0[1]); w.y = cvt_pk_bf16(v0[2], v0[3]); w.z = cvt_pk_bf16(v1[0], v1[1]); w.w = cvt_pk_bf16(v1[2], v1[3]);
                    *(u32x4*)(O + off + bj * HALF) = w; } }
    }
};

typedef int i32x4 __attribute__((ext_vector_type(4)));
template <class E, class = void> struct epi_chains : std::false_type {};
template <class E> struct epi_chains<E, std::void_t<decltype(E::CHAIN)>> : std::true_type {};
template <class Epi, class Sched, bool ALIGN_EPI = false, bool SP2 = false, bool I8 = false>
__device__ __forceinline__ void gemm_phase(PG8_LAS unsigned char* lds, const Gemm g, const Sched& S, const Epi& E) {
    int tid_ = threadIdx.x; asm volatile("" : "+v"(tid_));
    const int tid = tid_, wid = __builtin_amdgcn_readfirstlane(tid >> 6), lane = tid & 63, wr = wid >> 2, wc = wid & 3, fr = lane & 15, fq = lane >> 4;
    const int K = g.K, nt = K / BK;
    unsigned voffA[2], voffB[2];
#pragma unroll
    for (int i = 0; i < 2; ++i) { int R, C; stage_rc(tid * 16 + i * 8192, R, C); const int Rb = Epi::PERM ? ((R & ~31) + perm32(R & 31)) : R;
        voffA[i] = (unsigned)(R * K + C) * 2u; voffB[i] = (unsigned)(Rb * K + C) * 2u; }
    const size_t kstep = (size_t)(BK * 2);
    const size_t hstep = (size_t)HALF * K * 2;
    const size_t tstep = 2 * hstep;
    const unsigned ldsw = (unsigned)wid * 1024u;
    const int aoff = lds_byte(wr * 64 + fr, fq * 8), boff = lds_byte(wc * 32 + fr, fq * 8);
#define PG8_SA(b, h) (((b) * 2 + (h)) * HTB)
#define PG8_SB(b, h) ((4 + (b) * 2 + (h)) * HTB)
#define PG8_STAGE(bufoff, gbase, voff) do { _Pragma("unroll") for (int _i = 0; _i < 2; ++_i) \
        __builtin_amdgcn_global_load_lds((const unsigned*)((const char*)(gbase) + (voff)[_i]), (PG8_LAS unsigned*)(lds + (bufoff) + ldsw + _i * 8192), 16, 0, 0); } while (0)
#define PG8_LDA(dst, b, h) do { _Pragma("unroll") for (int m = 0; m < 4; ++m) _Pragma("unroll") for (int k = 0; k < 2; ++k) dst[m][k] = *(const PG8_LAS bf16x8*)(lds + PG8_SA(b, h) + aoff + m * 2048 + k * 1024); } while (0)
#define PG8_LDB(dst, b, h) do { _Pragma("unroll") for (int n = 0; n < 2; ++n) _Pragma("unroll") for (int k = 0; k < 2; ++k) dst[n][k] = *(const PG8_LAS bf16x8*)(lds + PG8_SB(b, h) + boff + n * 2048 + k * 1024); } while (0)
#define PG8_MMA(ai, bj, At, Bt) do { __builtin_amdgcn_s_setprio(1); _Pragma("unroll") for (int m = 0; m < 4; ++m) _Pragma("unroll") for (int n = 0; n < 2; ++n) _Pragma("unroll") for (int k = 0; k < 2; ++k) \
        { if constexpr (I8) acc[ai][bj][m][n] = __builtin_bit_cast(acc_t, __builtin_amdgcn_mfma_i32_16x16x64_i8(__builtin_bit_cast(i32x4, Bt[n][k]), __builtin_bit_cast(i32x4, At[m][k]), __builtin_bit_cast(i32x4, acc[ai][bj][m][n]), 0, 0, 0)); \
          else acc[ai][bj][m][n] = __builtin_bit_cast(acc_t, __builtin_amdgcn_mfma_f32_16x16x32_bf16(Bt[n][k], At[m][k], __builtin_bit_cast(f32x4, acc[ai][bj][m][n]), 0, 0, 0)); } __builtin_amdgcn_s_setprio(0); } while (0)
#define PG8_WAIT_V(n) asm volatile("s_waitcnt vmcnt(" #n ")" ::: "memory")
#define PG8_WAIT_L(n) asm volatile("s_waitcnt lgkmcnt(" #n ")" ::: "memory")
#define PG8_BAR __builtin_amdgcn_s_barrier()
#define PG8_SCHED __builtin_amdgcn_sched_barrier(0)
    Unit cur, nxt; int ui = 0;
    if (!S.next(0, cur)) return;
    typedef typename std::conditional<I8, i32x4, f32x4>::type acc_t;
    acc_t acc[2][2][4][2];
#pragma unroll
    for (int a = 0; a < 2; ++a)
#pragma unroll
        for (int b = 0; b < 2; ++b)
#pragma unroll
            for (int m = 0; m < 4; ++m)
#pragma unroll
                for (int n = 0; n < 2; ++n) acc[a][b][m][n] = acc_t{};
    bf16x8 At[4][2], B0[2][2], B1[2][2];
    const char* cA = (const char*)(cur.w ? g.A2 : g.A) + (size_t)cur.pm * tstep; const char* cB = (const char*)(cur.w ? g.Bt2 : g.Bt) + (size_t)cur.pn * tstep;
    S.a_ready(cur);
    if constexpr (SP2) {
        PG8_STAGE(PG8_SB(0, 0), cB, voffB); PG8_STAGE(PG8_SB(0, 1), cB + hstep, voffB); PG8_STAGE(PG8_SA(0, 0), cA, voffA); PG8_STAGE(PG8_SA(0, 1), cA + hstep, voffA);
        if (wr == 1) PG8_BAR;
        PG8_WAIT_V(2); PG8_BAR;
        PG8_STAGE(PG8_SB(1, 0), cB + kstep, voffB); PG8_STAGE(PG8_SA(1, 0), cA + kstep, voffA); PG8_STAGE(PG8_SB(1, 1), cB + hstep + kstep, voffB);
        PG8_WAIT_V(6); PG8_BAR;
    } else {
        PG8_STAGE(PG8_SB(0, 0), cB, voffB); PG8_STAGE(PG8_SA(0, 0), cA, voffA); PG8_STAGE(PG8_SB(0, 1), cB + hstep, voffB); PG8_STAGE(PG8_SA(0, 1), cA + hstep, voffA);
        if (wr == 1) PG8_BAR;
        PG8_WAIT_V(4); PG8_BAR;
        PG8_STAGE(PG8_SB(1, 0), cB + kstep, voffB); PG8_STAGE(PG8_SA(1, 0), cA + kstep, voffA); PG8_STAGE(PG8_SB(1, 1), cB + hstep + kstep, voffB);
        PG8_WAIT_V(6); PG8_BAR;
    }
    for (;;) {
        const bool has_next = S.next(ui + 1, nxt);
        const char* nA = has_next ? (const char*)(nxt.w ? g.A2 : g.A) + (size_t)nxt.pm * tstep : cA; const char* nB = has_next ? (const char*)(nxt.w ? g.Bt2 : g.Bt) + (size_t)nxt.pn * tstep : cB;
        for (int t = 0; t < nt; t += 2) {
            const bool last = (t == nt - 2);
            const char* a1 = cA + (size_t)(t + 1) * kstep;
            const char* a2 = last ? nA : cA + (size_t)(t + 2) * kstep; const char* b2 = last ? nB : cB + (size_t)(t + 2) * kstep;
            const char* a3 = a2 + kstep; const char* b3 = b2 + kstep;
            if (last && has_next) S.a_ready(nxt);
            if constexpr (SP2) {
            PG8_LDB(B0, 0, 0); PG8_LDB(B1, 0, 1); PG8_SCHED; PG8_LDA(At, 0, 0); PG8_STAGE(PG8_SA(1, 1), a1 + hstep, voffA);
            PG8_WAIT_V(8); PG8_WAIT_L(0); PG8_BAR; PG8_MMA(0, 0, At, B0); PG8_MMA(0, 1, At, B1); PG8_BAR; PG8_SCHED;
            PG8_LDA(At, 0, 1); PG8_STAGE(PG8_SB(0, 0), b2, voffB); PG8_STAGE(PG8_SB(0, 1), b2 + hstep, voffB); PG8_STAGE(PG8_SA(0, 0), a2, voffA);
            PG8_WAIT_V(8); PG8_WAIT_L(0); PG8_BAR; PG8_MMA(1, 0, At, B0); PG8_MMA(1, 1, At, B1); PG8_BAR; PG8_SCHED;
            PG8_LDB(B0, 1, 0); PG8_LDB(B1, 1, 1); PG8_SCHED; PG8_LDA(At, 1, 0); PG8_STAGE(PG8_SA(0, 1), a2 + hstep, voffA);
            PG8_WAIT_V(8); PG8_WAIT_L(0); PG8_BAR; PG8_MMA(0, 0, At, B0); PG8_MMA(0, 1, At, B1); PG8_BAR; PG8_SCHED;
            PG8_LDA(At, 1, 1); PG8_STAGE(PG8_SB(1, 0), b3, voffB); PG8_STAGE(PG8_SB(1, 1), b3 + hstep, voffB); PG8_STAGE(PG8_SA(1, 0), a3, voffA);
            PG8_WAIT_V(8); PG8_WAIT_L(0); PG8_BAR; PG8_MMA(1, 0, At, B0); PG8_MMA(1, 1, At, B1); PG8_BAR; PG8_SCHED;
            } else {
            PG8_LDB(B0, 0, 0); PG8_SCHED; PG8_LDA(At, 0, 0); PG8_STAGE(PG8_SA(1, 1), a1 + hstep, voffA);
            PG8_WAIT_L(8); PG8_BAR; PG8_WAIT_L(0); PG8_MMA(0, 0, At, B0); PG8_BAR; PG8_SCHED;
            PG8_LDB(B1, 0, 1); PG8_STAGE(PG8_SB(0, 0), b2, voffB);
            PG8_BAR; PG8_WAIT_L(0); PG8_MMA(0, 1, At, B1); PG8_BAR;
            PG8_LDA(At, 0, 1); PG8_STAGE(PG8_SA(0, 0), a2, voffA);
            PG8_BAR; PG8_WAIT_L(0); PG8_MMA(1, 0, At, B0); PG8_BAR; PG8_SCHED;
            PG8_STAGE(PG8_SB(0, 1), b2 + hstep, voffB);
            PG8_WAIT_V(6); PG8_BAR; PG8_MMA(1, 1, At, B1); PG8_BAR;
            PG8_LDB(B0, 1, 0); PG8_SCHED; PG8_LDA(At, 1, 0); PG8_STAGE(PG8_SA(0, 1), a2 + hstep, voffA);
            PG8_WAIT_L(8); PG8_BAR; PG8_WAIT_L(0); PG8_MMA(0, 0, At, B0); PG8_BAR; PG8_SCHED;
            PG8_LDB(B1, 1, 1); PG8_STAGE(PG8_SB(1, 0), b3, voffB);
            PG8_BAR; PG8_WAIT_L(0); PG8_MMA(0, 1, At, B1); PG8_BAR;
            PG8_LDA(At, 1, 1); PG8_STAGE(PG8_SA(1, 0), a3, voffA);
            PG8_BAR; PG8_WAIT_L(0); PG8_MMA(1, 0, At, B0); PG8_BAR; PG8_SCHED;
            PG8_STAGE(PG8_SB(1, 1), b3 + hstep, voffB);
            PG8_WAIT_V(6); PG8_BAR; PG8_MMA(1, 1, At, B1); PG8_BAR;
            }
        }
        if constexpr (ALIGN_EPI) { if (wr == 0) PG8_BAR; }
        bool keep_acc = false;
        if constexpr (!Epi::AFTER_DRAIN) { if constexpr (epi_chains<Epi>::value) keep_acc = E.chain(acc, cur, wr, wc, fr, fq); else E(acc, cur, wr, wc, fr, fq); S.done(cur); }
        if (!has_next) break;
        if (!keep_acc) {
#pragma unroll
        for (int a = 0; a < 2; ++a)
#pragma unroll
            for (int b = 0; b < 2; ++b)
#pragma unroll
                for (int m = 0; m < 4; ++m)
#pragma unroll
                    for (int n = 0; n < 2; ++n) acc[a][b][m][n] = acc_t{};
        }
        cur = nxt; cA = nA; cB = nB; ++ui;
        if constexpr (ALIGN_EPI) { if (wr == 1) PG8_BAR; }
    }
    PG8_WAIT_V(0);
    if constexpr (!ALIGN_EPI) { if (wr == 0) PG8_BAR; }
    PG8_BAR;
    if constexpr (Epi::AFTER_DRAIN) { E.fused(acc, cur, wr, wc, fr, fq, lds, wid, lane); S.done(cur); }
#undef PG8_SA
#undef PG8_SB
#undef PG8_STAGE
#undef PG8_LDA
#undef PG8_LDB
#undef PG8_MMA
#undef PG8_WAIT_V
#undef PG8_WAIT_L
#undef PG8_BAR
#undef PG8_SCHED
}
}
#define GAS __attribute__((address_space(1)))
#define LAS __attribute__((address_space(3)))
typedef unsigned short bf16;
typedef unsigned v4u __attribute__((ext_vector_type(4)));
typedef float f32x4 __attribute__((ext_vector_type(4)));
typedef short bf16x8 __attribute__((ext_vector_type(8)));
typedef GAS unsigned gu32;
typedef GAS unsigned long long gu64;
#define RLX_AGENT __ATOMIC_RELAXED, __HIP_MEMORY_SCOPE_AGENT
#define LDS_WAIT() asm volatile("s_waitcnt lgkmcnt(0)" ::: "memory")
#define VM_WAIT() asm volatile("s_waitcnt vmcnt(0)" ::: "memory")
__device__ __forceinline__ unsigned long long rt() { return __builtin_amdgcn_s_memrealtime(); }
__device__ __forceinline__ unsigned f2bf(float f) { unsigned u = __builtin_bit_cast(unsigned, f); return (u + 0x7fffu + ((u >> 16) & 1u)) >> 16; }
__device__ __forceinline__ unsigned pk2(float lo, float hi) { return f2bf(lo) | (f2bf(hi) << 16); }

#define XB_TMO      128
#define XB_XCNT(j)  (256  + 64 * (j))
#define XB_XSUB(j)  (1280 + 64 * (j))
#define XB_XGEN(j)  (2304 + 64 * (j))
#define XB_TOP      3328
#define XB_TOPGEN   3392
#define XCD_BAR_WORDS 3456
#define XB_SPIN_CAP (1u << 18)

__device__ __forceinline__ unsigned xb_ld(unsigned* p)              { return __hip_atomic_load(p, __ATOMIC_RELAXED, __HIP_MEMORY_SCOPE_AGENT); }
__device__ __forceinline__ unsigned xb_add(unsigned* p, unsigned v) { return __hip_atomic_fetch_add(p, v, __ATOMIC_RELAXED, __HIP_MEMORY_SCOPE_AGENT); }
__device__ __forceinline__ unsigned xb_xcc_id() { return (unsigned)__builtin_amdgcn_s_getreg((3 << 11) | 20) & 0xFu; }
#define XB_SPIN(cond, bar) do { unsigned _sp = 0; while (cond) { __builtin_amdgcn_s_sleep(1); \
    if ((++_sp & 255u) == 0u) { if (xb_ld(&(bar)[XB_TMO])) break; if (_sp > XB_SPIN_CAP) { atomicAdd(&(bar)[XB_TMO], 1u); break; } } } } while (0)

struct XcdBarrier {
    unsigned* bar; unsigned x;
    volatile LAS unsigned* st;
};

__device__ __forceinline__ XcdBarrier xcd_barrier_post(unsigned* bar, volatile LAS unsigned* st) {
    XcdBarrier b; b.bar = bar; b.x = xb_xcc_id(); b.st = st;
    if (threadIdx.x == 0) (void)xb_add(&bar[XB_XCNT(b.x)], 1u);
    return b;
}
__device__ __forceinline__ void xcd_barrier_complete(unsigned* bar, unsigned x, unsigned& nloc, unsigned& nx) {
    const unsigned G = gridDim.x * gridDim.y * gridDim.z;
    unsigned sum, cnt, mine, sp = 0u;
    for (;;) {
        sum = 0u; cnt = 0u; mine = 0u;
#pragma unroll
        for (unsigned j = 0; j < 16; ++j) { const unsigned c = xb_ld(&bar[XB_XCNT(j)]); sum += c; cnt += (c > 0u) ? 1u : 0u; mine = (j == x) ? c : mine; }
        if (sum == G) break;
        __builtin_amdgcn_s_sleep(1);
        if ((++sp & 255u) == 0u) { if (xb_ld(&bar[XB_TMO])) break; if (sp > XB_SPIN_CAP) { atomicAdd(&bar[XB_TMO], 1u); break; } }
    }
    nloc = mine > 0u ? mine : 1u; nx = cnt > 0u ? cnt : 1u;
}

__device__ __forceinline__ void xcd_barrier(const XcdBarrier& b) {
    asm volatile("s_waitcnt vmcnt(0)" ::: "memory");
    __syncthreads();
    if (threadIdx.x == 0) {
        unsigned* bar = b.bar;
        __builtin_amdgcn_s_waitcnt(0);
        unsigned nloc = b.st[0], nx = b.st[1];
        if (nloc == 0u) { xcd_barrier_complete(bar, b.x, nloc, nx); b.st[0] = nloc; b.st[1] = nx; }
        const unsigned old = xb_add(&bar[XB_XSUB(b.x)], 1u);
        const unsigned gen = old / nloc;
        if (old + 1u == (gen + 1u) * nloc) {
            __builtin_amdgcn_fence(__ATOMIC_RELEASE, "agent");
            asm volatile("s_waitcnt vmcnt(0)" ::: "memory");
            const unsigned og = xb_add(&bar[XB_TOP], 1u);
            const unsigned tg = og / nx;
            if (og + 1u == (tg + 1u) * nx) xb_add(&bar[XB_TOPGEN], 1u);
            else XB_SPIN(xb_ld(&bar[XB_TOPGEN]) == tg, bar);
            __builtin_amdgcn_fence(__ATOMIC_ACQUIRE, "agent");
            xb_add(&bar[XB_XGEN(b.x)], 1u);
            asm volatile("s_waitcnt vmcnt(0)" ::: "memory");
        } else {
            XB_SPIN(xb_ld(&bar[XB_XGEN(b.x)]) == gen, bar);
            __builtin_amdgcn_fence(__ATOMIC_ACQUIRE, "agent");
            asm volatile("s_waitcnt vmcnt(0)" ::: "memory");
        }
    }
    __syncthreads();
}

constexpr int NWAVES = 8, NTHREADS = 512;
constexpr int BATCH = 4, SEQ = 2048, D = 2048, M = BATCH * SEQ;
constexpr int NQH = 32, NKVH = 4, HD = 64, QPKV = 8, WINDOW = 128;
constexpr int Q_OFF = 0, K_OFF = 2048, V_OFF = 2304, CB_OFF = 2560, CC_OFF = 4608, CH_OFF = 6656, G_OFF = 8704, IN_W = 12800;
constexpr int PH = 8, PNK = 128, PTOPK = 16, PNE = 16384;
constexpr float LN_EPS = 1e-5f;
constexpr float ALPHA = 1.189207115002721f;

#ifndef MK_PER_PHASE
#define MK_PER_PHASE 0
#endif
constexpr int N_PHASES = 12;

constexpr size_t MiB = 1u << 20;
constexpr size_t WS_CTL = 0, CTL_ZERO_BYTES = 1 * MiB;
constexpr size_t WS_WIN = 1 * MiB;
constexpr size_t WS_WA = 51 * MiB, WS_WC = 59 * MiB, WS_WO = 67 * MiB, WS_WF = 75 * MiB;
constexpr size_t WS_XB = 83 * MiB;
constexpr size_t WS_MERGED = WS_XB;
constexpr size_t WS_Z = 115 * MiB;
constexpr size_t WS_R2B = 115 * MiB;
constexpr size_t WS_H1B = 179 * MiB;
constexpr size_t WS_SC = 211 * MiB;
constexpr size_t WS_EX = 275 * MiB;
constexpr size_t WS_GT = 279 * MiB;
constexpr size_t WS_AO = 315 * MiB, WS_CI = 347 * MiB, WS_TMP = 379 * MiB;
constexpr size_t WS_U8 = 411 * MiB, WS_V8 = 443 * MiB;
constexpr size_t WS_SU = 475 * MiB, WS_SV = WS_SU + 65536;
constexpr size_t WS_PA = WS_SC;
constexpr size_t WS_XQ = 283 * MiB;
constexpr size_t WS_SX = 299 * MiB;
constexpr size_t WS_WB = 380 * MiB;
constexpr size_t WS_ST = 379 * MiB;
constexpr size_t WS_XA8 = WS_XB;
constexpr size_t WS_WIN8 = 476 * MiB;
constexpr size_t WS_SWIN = 501 * MiB, WS_SXA = WS_SWIN + 65536;
constexpr size_t WS_AO8 = 1 * MiB, WS_CI8 = 17 * MiB, WS_WA8 = 33 * MiB, WS_WC8 = 37 * MiB, WS_S3 = 41 * MiB;
constexpr size_t WS_WF8 = 502 * MiB;
constexpr size_t WS_SWF = WS_SXA + 65536;
constexpr size_t WS_MG8 = 1 * MiB;
constexpr size_t WS_WO8 = 506 * MiB;
constexpr size_t WS_SMG = WS_S3 + 262144, WS_SWO = WS_SWF + 16384;
constexpr size_t WS_SEG = 315 * MiB, WS_SOFF = 323 * MiB;
constexpr size_t WS_END = 510 * MiB;
constexpr int CW_Q = 12288;
constexpr size_t SLICE_BYTES = (size_t)PNE * 256;
constexpr int CW_BAR = 4096;

constexpr int RING_BYTES = 131072;
constexpr int LDSCTL_OFF = 163328, MISC_OFF = LDSCTL_OFF + 320;
constexpr int LDS_BYTES = LDSCTL_OFF + 512;

typedef float f32x16 __attribute__((ext_vector_type(16)));
typedef unsigned v2u __attribute__((ext_vector_type(2)));
__device__ __forceinline__ float wave_sum(float v) {
#pragma unroll
    for (int o = 1; o < 64; o <<= 1) v += __shfl_xor(v, o);
    return v;
}
__device__ __forceinline__ float vmaxf(float a, float b) { float r; asm("v_max_f32_e32 %0, %1, %2" : "=v"(r) : "v"(a), "v"(b)); return r; }
__device__ __forceinline__ float vminf(float a, float b) { float r; asm("v_min_f32_e32 %0, %1, %2" : "=v"(r) : "v"(a), "v"(b)); return r; }

__device__ __forceinline__ void p0_transpose_item(const float* W, int K, int N, bf16* WT, LAS float* scr, int item, int lane) {
    const int nblk = N / 32, kb = item / nblk, nb = item % nblk, k0 = 64 * kb, n0 = 32 * nb;
#pragma unroll 8
    for (int i = 0; i < 32; ++i) { const int kk = 2 * i + (lane >> 5); scr[kk * 33 + (lane & 31)] = W[(size_t)(k0 + kk) * N + n0 + (lane & 31)]; }
    LDS_WAIT(); asm volatile("" ::: "memory");
    const int c = lane & 7;
#pragma unroll
    for (int j = 0; j < 4; ++j) { const int n = (lane >> 3) + 8 * j; const LAS float* s = scr + (8 * c) * 33 + n;
        v4u o; o.x = pk2(s[0 * 33], s[1 * 33]); o.y = pk2(s[2 * 33], s[3 * 33]); o.z = pk2(s[4 * 33], s[5 * 33]); o.w = pk2(s[6 * 33], s[7 * 33]);
        *(GAS v4u*)(WT + (size_t)(n0 + n) * K + k0 + 8 * c) = o; }
    LDS_WAIT(); asm volatile("" ::: "memory");
}
__device__ __forceinline__ void p0_wf_item(const float* wq, const float* sk, bf16* WfT, LAS unsigned char* lds, int item, int tid) {
    const int hp = item >> 5, dt = item & 31;
    LAS f32x4* SK4 = (LAS f32x4*)lds;
    LAS f32x4* WQ4 = SK4 + 128 * 33;
    const float* skp = sk + (size_t)hp * 128 * 128;
    for (int i = tid; i < 128 * 32; i += NTHREADS) { const int n = i >> 5, c4 = i & 31; SK4[n * 33 + c4] = *(const f32x4*)(skp + n * 128 + 4 * c4); }
    for (int i = tid; i < 64 * 32; i += NTHREADS) { const int r = i >> 5, c4 = i & 31; WQ4[r * 33 + c4] = *(const f32x4*)(wq + (size_t)(64 * dt + r) * 2048 + hp * 128 + 4 * c4); }
    __syncthreads();
    const int td = tid & 15, tn = tid >> 4;
    float acc[4][4];
#pragma unroll
    for (int i = 0; i < 4; ++i)
#pragma unroll
        for (int j = 0; j < 4; ++j) acc[i][j] = 0.f;
#pragma unroll 4
    for (int c4 = 0; c4 < 32; ++c4) {
        f32x4 a[4], b[4];
#pragma unroll
        for (int i = 0; i < 4; ++i) a[i] = SK4[(4 * tn + i) * 33 + c4];
#pragma unroll
        for (int j = 0; j < 4; ++j) b[j] = WQ4[(td + 16 * j) * 33 + c4];
#pragma unroll
        for (int i = 0; i < 4; ++i)
#pragma unroll
            for (int j = 0; j < 4; ++j) acc[i][j] += a[i].x * b[j].x + a[i].y * b[j].y + a[i].z * b[j].z + a[i].w * b[j].w;
    }
#pragma unroll
    for (int i = 0; i < 4; ++i)
#pragma unroll
        for (int j = 0; j < 4; ++j) WfT[(size_t)(hp * 128 + 4 * tn + i) * 2048 + 64 * dt + td + 16 * j] = (bf16)f2bf(acc[i][j]);
    __syncthreads();
}

__device__ __forceinline__ int perm16(int o) { return 8 * ((o >> 2) & 1) + 4 * (o >> 3) + (o & 3); }
__device__ __forceinline__ void attn_unit(int unit, const bf16* z, bf16* ao, const float* sinks, LAS unsigned char* lds, int tid) {
    const int lane = tid & 63, wid = __builtin_amdgcn_readfirstlane(tid >> 6), r32 = lane & 31, hi = lane >> 5;
    const int nb = unit & 15, kvh = (unit >> 4) & 3, b = unit >> 6;
    LAS bf16* Ks = (LAS bf16*)lds;
    LAS bf16* Vt = (LAS bf16*)(lds + 256 * 144);
    const size_t tok0 = (size_t)b * SEQ;
#pragma unroll
    for (int i = 0; i < 4; ++i) {
        const int ci = tid + NTHREADS * i, key = ci >> 3, dc = ci & 7;
        int kpos = 128 * (nb - 1) + key; if (kpos < 0) kpos = 0;
        const bf16* src = z + (tok0 + kpos) * IN_W + K_OFF + kvh * HD + dc * 8;
        const v4u kv = *(const GAS v4u*)src, vv = *(const GAS v4u*)(src + (V_OFF - K_OFF));
        *(LAS v4u*)(Ks + key * 72 + dc * 8) = kv;
        const int pos = (key & ~15) + perm16(key & 15);
        LAS bf16* vp = Vt + (dc * 8) * 264 + pos;
        vp[0 * 264] = (bf16)(vv.x & 0xffffu); vp[1 * 264] = (bf16)(vv.x >> 16); vp[2 * 264] = (bf16)(vv.y & 0xffffu); vp[3 * 264] = (bf16)(vv.y >> 16);
        vp[4 * 264] = (bf16)(vv.z & 0xffffu); vp[5 * 264] = (bf16)(vv.z >> 16); vp[6 * 264] = (bf16)(vv.w & 0xffffu); vp[7 * 264] = (bf16)(vv.w >> 16);
    }
    __syncthreads();
    const int hq = kvh * QPKV + wid;
    const float LOG2E = 1.4426950408889634f;
    const float sink2 = sinks[hq] * LOG2E, sc = 0.125f * LOG2E;
#pragma unroll 1
    for (int qg = 0; qg < 4; ++qg) {
        const size_t tok = tok0 + 128 * nb + 32 * qg + r32;
        bf16x8 qf[4];
#pragma unroll
        for (int ks = 0; ks < 4; ++ks) qf[ks] = *(const GAS bf16x8*)(z + tok * IN_W + Q_OFF + hq * HD + 16 * ks + 8 * hi);
        f32x16 s[5];
#pragma unroll
        for (int kt = 0; kt < 5; ++kt) {
            s[kt] = (f32x16){0.f, 0.f, 0.f, 0.f, 0.f, 0.f, 0.f, 0.f, 0.f, 0.f, 0.f, 0.f, 0.f, 0.f, 0.f, 0.f};
#pragma unroll
            for (int ks = 0; ks < 4; ++ks) {
                const bf16x8 kf = *(const LAS bf16x8*)(Ks + (32 * (qg + kt) + r32) * 72 + 16 * ks + 8 * hi);
                s[kt] = __builtin_amdgcn_mfma_f32_32x32x16_bf16(kf, qf[ks], s[kt], 0, 0, 0);
            }
        }
        float mx = sink2;
#pragma unroll
        for (int kt = 0; kt < 5; ++kt) {
            const bool tile_dead = (nb == 0) && (qg + kt < 4);
#pragma unroll
            for (int r = 0; r < 16; ++r) {
                const int krow = (r & 3) + 8 * (r >> 2) + 4 * hi;
                bool valid = !tile_dead;
                if (kt == 0) valid = valid && (krow > r32);
                if (kt == 4) valid = valid && (krow <= r32);
                const float v = valid ? s[kt][r] * sc : -INFINITY;
                s[kt][r] = v; mx = fmaxf(mx, v);
            }
        }
        mx = fmaxf(mx, __shfl_xor(mx, 32));
        float sum = 0.f;
#pragma unroll
        for (int kt = 0; kt < 5; ++kt)
#pragma unroll
            for (int r = 0; r < 16; ++r) { const float p = __builtin_amdgcn_exp2f(s[kt][r] - mx); s[kt][r] = p; sum += p; }
        sum += __shfl_xor(sum, 32);
        const float inv = 1.0f / (sum + __builtin_amdgcn_exp2f(sink2 - mx));
        f32x16 o[2];
        o[0] = (f32x16){0.f, 0.f, 0.f, 0.f, 0.f, 0.f, 0.f, 0.f, 0.f, 0.f, 0.f, 0.f, 0.f, 0.f, 0.f, 0.f}; o[1] = o[0];
#pragma unroll
        for (int kt = 0; kt < 5; ++kt)
#pragma unroll
            for (int s2 = 0; s2 < 2; ++s2) {
                v4u pw; pw.x = pg8::cvt_pk_bf16(s[kt][8 * s2 + 0], s[kt][8 * s2 + 1]); pw.y = pg8::cvt_pk_bf16(s[kt][8 * s2 + 2], s[kt][8 * s2 + 3]);
                pw.z = pg8::cvt_pk_bf16(s[kt][8 * s2 + 4], s[kt][8 * s2 + 5]); pw.w = pg8::cvt_pk_bf16(s[kt][8 * s2 + 6], s[kt][8 * s2 + 7]);
                const bf16x8 pa = __builtin_bit_cast(bf16x8, pw);
#pragma unroll
                for (int dt = 0; dt < 2; ++dt) {
                    const bf16x8 vf = *(const LAS bf16x8*)(Vt + (32 * dt + r32) * 264 + 32 * (qg + kt) + 16 * s2 + 8 * hi);
                    o[dt] = __builtin_amdgcn_mfma_f32_32x32x16_bf16(vf, pa, o[dt], 0, 0, 0);
                }
            }
        bf16* op = ao + tok * D + hq * HD;
#pragma unroll
        for (int dt = 0; dt < 2; ++dt)
#pragma unroll
            for (int g = 0; g < 4; ++g) {
                v2u w; w.x = pg8::cvt_pk_bf16(o[dt][4 * g + 0] * inv, o[dt][4 * g + 1] * inv); w.y = pg8::cvt_pk_bf16(o[dt][4 * g + 2] * inv, o[dt][4 * g + 3] * inv);
                *(GAS v2u*)(op + 32 * dt + 8 * g + 4 * hi) = w;
            }
    }
    __syncthreads();
}
__device__ __forceinline__ void conv_item(int item, const bf16* z, const float* cw, bf16* ci, int tid) {
    const int c8 = tid & 255, half = tid >> 8, t0 = 32 * item + 16 * half, c0 = 8 * c8;
    float w0[8], w1[8], w2[8], u1[8], u2[8];
#pragma unroll
    for (int e = 0; e < 8; ++e) { w0[e] = cw[c0 + e]; w1[e] = cw[2048 + c0 + e]; w2[e] = cw[4096 + c0 + e]; u1[e] = 0.f; u2[e] = 0.f; }
    if ((t0 & (SEQ - 1)) != 0) {
#pragma unroll
        for (int k = 0; k < 2; ++k) {
            const bf16* zr = z + (size_t)(t0 - 2 + k) * IN_W + c0;
            const v4u a = *(const GAS v4u*)(zr + CC_OFF), h = *(const GAS v4u*)(zr + CH_OFF);
            float u[8];
            u[0] = pg8::bf_lo(a.x) * pg8::bf_lo(h.x); u[1] = pg8::bf_hi(a.x) * pg8::bf_hi(h.x); u[2] = pg8::bf_lo(a.y) * pg8::bf_lo(h.y); u[3] = pg8::bf_hi(a.y) * pg8::bf_hi(h.y);
            u[4] = pg8::bf_lo(a.z) * pg8::bf_lo(h.z); u[5] = pg8::bf_hi(a.z) * pg8::bf_hi(h.z); u[6] = pg8::bf_lo(a.w) * pg8::bf_lo(h.w); u[7] = pg8::bf_hi(a.w) * pg8::bf_hi(h.w);
#pragma unroll
            for (int e = 0; e < 8; ++e) { if (k == 0) u2[e] = u[e]; else u1[e] = u[e]; }
        }
    }
#pragma unroll 4
    for (int i = 0; i < 16; ++i) {
        const bf16* zr = z + (size_t)(t0 + i) * IN_W + c0;
        const v4u a = *(const GAS v4u*)(zr + CC_OFF), h = *(const GAS v4u*)(zr + CH_OFF), bb = *(const GAS v4u*)(zr + CB_OFF);
        float u[8], cb[8], y[8];
        u[0] = pg8::bf_lo(a.x) * pg8::bf_lo(h.x); u[1] = pg8::bf_hi(a.x) * pg8::bf_hi(h.x); u[2] = pg8::bf_lo(a.y) * pg8::bf_lo(h.y); u[3] = pg8::bf_hi(a.y) * pg8::bf_hi(h.y);
        u[4] = pg8::bf_lo(a.z) * pg8::bf_lo(h.z); u[5] = pg8::bf_hi(a.z) * pg8::bf_hi(h.z); u[6] = pg8::bf_lo(a.w) * pg8::bf_lo(h.w); u[7] = pg8::bf_hi(a.w) * pg8::bf_hi(h.w);
        cb[0] = pg8::bf_lo(bb.x); cb[1] = pg8::bf_hi(bb.x); cb[2] = pg8::bf_lo(bb.y); cb[3] = pg8::bf_hi(bb.y); cb[4] = pg8::bf_lo(bb.z); cb[5] = pg8::bf_hi(bb.z); cb[6] = pg8::bf_lo(bb.w); cb[7] = pg8::bf_hi(bb.w);
#pragma unroll
        for (int e = 0; e < 8; ++e) { y[e] = cb[e] * (w0[e] * u2[e] + w1[e] * u1[e] + w2[e] * u[e]); u2[e] = u1[e]; u1[e] = u[e]; }
        v4u o; o.x = pk2(y[0], y[1]); o.y = pk2(y[2], y[3]); o.z = pk2(y[4], y[5]); o.w = pk2(y[6], y[7]);
        *(GAS v4u*)(ci + (size_t)(t0 + i) * D + c0) = o;
    }
}

__device__ __forceinline__ unsigned pack_i8(const f32x4 v) {
    const int a = __float2int_rn(v.x), b = __float2int_rn(v.y), c = __float2int_rn(v.z), d = __float2int_rn(v.w);
    return ((unsigned)a & 0xffu) | (((unsigned)b & 0xffu) << 8) | (((unsigned)c & 0xffu) << 16) | ((unsigned)d << 24);
}
__device__ __forceinline__ unsigned pack_i8_2(float a, float b, float c, float d) {
    const int ia = __float2int_rn(a), ib = __float2int_rn(b), ic = __float2int_rn(c), id = __float2int_rn(d);
    return ((unsigned)ia & 0xffu) | (((unsigned)ib & 0xffu) << 8) | (((unsigned)ic & 0xffu) << 16) | ((unsigned)id << 24);
}
__device__ __forceinline__ void ln1_row(bf16* hbrow, signed char* xqrow, float* sxp, const float* g, const float* bta, int lane) {
    GAS v4u* xr = (GAS v4u*)hbrow + lane;
    float v[4][8]; float s = 0.f;
#pragma unroll
    for (int j = 0; j < 4; ++j) { const v4u w = xr[64 * j];
        v[j][0] = pg8::bf_lo(w.x); v[j][1] = pg8::bf_hi(w.x); v[j][2] = pg8::bf_lo(w.y); v[j][3] = pg8::bf_hi(w.y); v[j][4] = pg8::bf_lo(w.z); v[j][5] = pg8::bf_hi(w.z); v[j][6] = pg8::bf_lo(w.w); v[j][7] = pg8::bf_hi(w.w);
#pragma unroll
        for (int e = 0; e < 8; ++e) s += v[j][e]; }
    const float mean = wave_sum(s) * (1.f / D); float s2 = 0.f;
#pragma unroll
    for (int j = 0; j < 4; ++j)
#pragma unroll
        for (int e = 0; e < 8; ++e) { v[j][e] -= mean; s2 += v[j][e] * v[j][e]; }
    const float rstd = 1.f / sqrtf(wave_sum(s2) * (1.f / D) + LN_EPS);
    float mx = 0.f;
#pragma unroll
    for (int j = 0; j < 4; ++j) {
        const GAS f32x4* gp = (const GAS f32x4*)g + 2 * (lane + 64 * j); const GAS f32x4* bp = (const GAS f32x4*)bta + 2 * (lane + 64 * j);
        const f32x4 g0 = gp[0], g1 = gp[1], b0 = bp[0], b1 = bp[1];
        v[j][0] = v[j][0] * rstd * g0.x + b0.x; v[j][1] = v[j][1] * rstd * g0.y + b0.y; v[j][2] = v[j][2] * rstd * g0.z + b0.z; v[j][3] = v[j][3] * rstd * g0.w + b0.w;
        v[j][4] = v[j][4] * rstd * g1.x + b1.x; v[j][5] = v[j][5] * rstd * g1.y + b1.y; v[j][6] = v[j][6] * rstd * g1.z + b1.z; v[j][7] = v[j][7] * rstd * g1.w + b1.w;
        v4u o; o.x = pk2(v[j][0], v[j][1]); o.y = pk2(v[j][2], v[j][3]); o.z = pk2(v[j][4], v[j][5]); o.w = pk2(v[j][6], v[j][7]);
        xr[64 * j] = o;
#pragma unroll
        for (int e = 0; e < 8; ++e) mx = fmaxf(mx, fabsf(v[j][e]));
    }
#pragma unroll
    for (int o = 1; o < 64; o <<= 1) mx = fmaxf(mx, __shfl_xor(mx, o));
    const float qs = mx > 0.f ? 127.0f / mx : 1.0f;
    GAS v2u* q8 = (GAS v2u*)xqrow + lane;
#pragma unroll
    for (int j = 0; j < 4; ++j) { v2u o; o.x = pack_i8_2(v[j][0] * qs, v[j][1] * qs, v[j][2] * qs, v[j][3] * qs); o.y = pack_i8_2(v[j][4] * qs, v[j][5] * qs, v[j][6] * qs, v[j][7] * qs); q8[64 * j] = o; }
    if (lane == 0) *sxp = mx > 0.f ? mx * (1.0f / 127.0f) : 1.0f;
}

__device__ __forceinline__ void row_f32_to_i8(const float* src, signed char* dst, float* inv, int lane) {
    f32x4 v[8]; float mx = 0.f;
#pragma unroll
    for (int j = 0; j < 8; ++j) { v[j] = *((const GAS f32x4*)src + lane + 64 * j); mx = fmaxf(mx, fmaxf(fmaxf(fabsf(v[j].x), fabsf(v[j].y)), fmaxf(fabsf(v[j].z), fabsf(v[j].w)))); }
#pragma unroll
    for (int o = 1; o < 64; o <<= 1) mx = fmaxf(mx, __shfl_xor(mx, o));
    const float sc = mx > 0.f ? 127.0f / mx : 1.0f;
#pragma unroll
    for (int j = 0; j < 8; ++j) *((GAS unsigned*)dst + lane + 64 * j) = pack_i8_2(v[j].x * sc, v[j].y * sc, v[j].z * sc, v[j].w * sc);
    if (lane == 0) *inv = mx > 0.f ? mx * (1.0f / 127.0f) : 1.0f;
}
__device__ __forceinline__ void row_bf16_to_i8(const bf16* src, signed char* dst, float* inv, int lane) {
    float v[4][8]; float mx = 0.f;
#pragma unroll
    for (int j = 0; j < 4; ++j) { const v4u w = *((const GAS v4u*)src + lane + 64 * j);
        v[j][0] = pg8::bf_lo(w.x); v[j][1] = pg8::bf_hi(w.x); v[j][2] = pg8::bf_lo(w.y); v[j][3] = pg8::bf_hi(w.y); v[j][4] = pg8::bf_lo(w.z); v[j][5] = pg8::bf_hi(w.z); v[j][6] = pg8::bf_lo(w.w); v[j][7] = pg8::bf_hi(w.w);
#pragma unroll
        for (int e = 0; e < 8; ++e) mx = fmaxf(mx, fabsf(v[j][e])); }
#pragma unroll
    for (int o = 1; o < 64; o <<= 1) mx = fmaxf(mx, __shfl_xor(mx, o));
    const float sc = mx > 0.f ? 127.0f / mx : 1.0f;
#pragma unroll
    for (int j = 0; j < 4; ++j) { v2u o; o.x = pack_i8_2(v[j][0] * sc, v[j][1] * sc, v[j][2] * sc, v[j][3] * sc); o.y = pack_i8_2(v[j][4] * sc, v[j][5] * sc, v[j][6] * sc, v[j][7] * sc); *((GAS v2u*)dst + lane + 64 * j) = o; }
    if (lane == 0) *inv = mx > 0.f ? mx * (1.0f / 127.0f) : 1.0f;
}

constexpr int TK_ROWF = 136;
constexpr int TK_IDX_OFF = 256 * TK_ROWF * 4;
__device__ __forceinline__ void topk_core(LAS unsigned char* lds, size_t prob0, int pstride, int* experts, float* gates, int tid) {
    LAS float* S = (LAS float*)lds;
    LAS unsigned char* IDX = lds + TK_IDX_OFF;
    const int row = tid >> 1, sub = tid & 1;
#define TK_CE(a, b) do { const float h_ = vmaxf(a, b), l_ = vminf(a, b); a = h_; b = l_; } while (0)
#define TK_SORT16(V) do { _Pragma("unroll") for (int k_ = 2; k_ <= 16; k_ <<= 1) _Pragma("unroll") for (int j_ = k_ >> 1; j_ > 0; j_ >>= 1) _Pragma("unroll") for (int i_ = 0; i_ < 16; ++i_) { \
        const int l_i = i_ ^ j_; if (l_i > i_) { if ((i_ & k_) == 0) TK_CE(V[i_], V[l_i]); else TK_CE(V[l_i], V[i_]); } } } while (0)
#define TK_MERGE16(Lv, Xv) do { _Pragma("unroll") for (int j_ = 0; j_ < 16; ++j_) Lv[j_] = vmaxf(Lv[j_], Xv[15 - j_]); \
        _Pragma("unroll") for (int st_ = 8; st_ >= 1; st_ >>= 1) _Pragma("unroll") for (int j_ = 0; j_ < 16; ++j_) if ((j_ & st_) == 0) TK_CE(Lv[j_], Lv[j_ + st_]); } while (0)
    float L[16];
#pragma unroll
    for (int q = 0; q < 4; ++q) {
        float C[16];
#pragma unroll
        for (int i = 0; i < 4; ++i) { const int c4 = 2 * (4 * q + i) + sub;
            const f32x4 v = *(const LAS f32x4*)(S + row * TK_ROWF + 4 * c4);
#pragma unroll
            for (int e = 0; e < 4; ++e) { const float ve = v[e];
                C[4 * i + e] = __uint_as_float((__float_as_uint(ve) & ~0x7Fu) | (unsigned)(4 * c4 + e)); } }
        TK_SORT16(C);
        if (q == 0) {
#pragma unroll
            for (int j = 0; j < 16; ++j) L[j] = C[j];
        } else TK_MERGE16(L, C);
    }
    {
        float P[16];
#pragma unroll
        for (int j = 0; j < 16; ++j) P[j] = __shfl_xor(L[j], 1);
        TK_MERGE16(L, P);
    }
    if (sub == 0) {
#pragma unroll
        for (int q = 0; q < 4; ++q) {
            unsigned w = 0;
#pragma unroll
            for (int e = 0; e < 4; ++e) w |= (__builtin_bit_cast(unsigned, L[4 * q + e]) & 0x7Fu) << (8 * e);
            *(LAS unsigned*)(IDX + row * 16 + 4 * q) = w;
        }
    }
    float A[16], B[16];
#pragma unroll
    for (int j = 0; j < 16; ++j) { const float o = __shfl_xor(L[j], 2); const bool isb = (tid & 2) != 0; A[j] = isb ? o : L[j]; B[j] = isb ? L[j] : o; }
#define TK_KEY(i, j) __uint_as_float((__float_as_uint(A[i] + B[j]) & ~0xFFu) | (unsigned)(255 - ((i) * 16 + (j))))
    float F[16], X[16];
#pragma unroll
    for (int j = 0; j < 16; ++j) F[j] = TK_KEY(0, j);
#pragma unroll
    for (int i = 1; i < 16; ++i) X[i - 1] = TK_KEY(i, 0);
    X[15] = -INFINITY; TK_MERGE16(F, X);
#pragma unroll
    for (int i = 0; i < 16; ++i) X[i] = -INFINITY;
#pragma unroll
    for (int i = 1; i <= 7; ++i) X[i - 1] = TK_KEY(i, 1);
    TK_MERGE16(F, X);
#pragma unroll
    for (int i = 0; i < 16; ++i) X[i] = -INFINITY;
#pragma unroll
    for (int j = 2; j <= 7; ++j) X[j - 2] = TK_KEY(1, j);
    TK_MERGE16(F, X);
    { const float rest[6] = {TK_KEY(2, 2), TK_KEY(2, 3), TK_KEY(2, 4), TK_KEY(3, 2), TK_KEY(3, 3), TK_KEY(4, 2)};
#pragma unroll
      for (int r = 0; r < 6; ++r) { float x = rest[r];
#pragma unroll
          for (int k = 0; k < 16; ++k) { const float h = vmaxf(F[k], x); x = vminf(F[k], x); F[k] = h; } } }
    __syncthreads();
    if ((tid & 3) == 0) {
        const int rowA = (tid >> 2) * 2, rowB = rowA + 1;
        const size_t prob = prob0 + (size_t)pstride * (tid >> 2);
        float g[16]; int ex[16]; float gs = 0.f;
#pragma unroll
        for (int k = 0; k < 16; ++k) {
            const unsigned code = 255u - (__builtin_bit_cast(unsigned, F[k]) & 0xFFu);
            const int ia = IDX[rowA * 16 + (code >> 4)], ib = IDX[rowB * 16 + (code & 15)];
            ex[k] = ia * PNK + ib;
            g[k] = __expf(F[k] - F[0]); gs += g[k];
        }
        const float ginv = 1.0f / gs;
#pragma unroll
        for (int q = 0; q < 4; ++q) {
            *(GAS f32x4*)(gates + prob * 16 + 4 * q) = (f32x4){g[4 * q] * ginv, g[4 * q + 1] * ginv, g[4 * q + 2] * ginv, g[4 * q + 3] * ginv};
            typedef int i32x4 __attribute__((ext_vector_type(4)));
            *(GAS i32x4*)(experts + prob * 16 + 4 * q) = (i32x4){ex[4 * q], ex[4 * q + 1], ex[4 * q + 2], ex[4 * q + 3]};
        }
    }
    __syncthreads();
}
__device__ __forceinline__ void topk_pass(int pass, const float* scores, int* experts, float* gates, LAS unsigned char* lds, int tid) {
    LAS float* S = (LAS float*)lds;
    const float* src = scores + (size_t)pass * (256 * 128);
#pragma unroll 4
    for (int i = 0; i < 16; ++i) { const int f4 = tid + NTHREADS * i, row = f4 >> 5, c4 = f4 & 31; *(LAS f32x4*)(S + row * TK_ROWF + 4 * c4) = *(const GAS f32x4*)(src + (size_t)f4 * 4); }
    __syncthreads();
    topk_core(lds, (size_t)pass * 128, 1, experts, gates, tid);
}
struct EpiTopKI8 {
    static constexpr bool PERM = false, AFTER_DRAIN = true;
    int* experts; float* gates; const float* sa; const float* sb;
    __device__ __forceinline__ void fused(pg8::i32x4 (&acc)[2][2][4][2], const pg8::Unit& u, int wr, int wc, int fr, int fq, LAS unsigned char* lds, int wid, int lane) const {
        LAS float* S = (LAS float*)lds;
        const int tid = wid * 64 + lane;
        pg8::f32x4 sbv[2][2];
#pragma unroll
        for (int bj = 0; bj < 2; ++bj)
#pragma unroll
            for (int n = 0; n < 2; ++n) sbv[bj][n] = *(const GAS pg8::f32x4*)(sb + u.pn * 256 + bj * 128 + 32 * wc + 16 * n + 4 * fq);
#pragma unroll
        for (int ai = 0; ai < 2; ++ai) {
#pragma unroll
            for (int mm = 0; mm < 4; ++mm) { const int rl = 64 * wr + 16 * mm + fr; const float sr = sa[u.pm * 256 + 128 * ai + rl];
#pragma unroll
                for (int bj = 0; bj < 2; ++bj)
#pragma unroll
                    for (int n = 0; n < 2; ++n) { const pg8::i32x4 a = acc[ai][bj][mm][n];
                        *(LAS pg8::f32x4*)(S + (2 * rl + bj) * TK_ROWF + 32 * wc + 16 * n + 4 * fq) = (pg8::f32x4){(float)a[0], (float)a[1], (float)a[2], (float)a[3]} * sbv[bj][n] * sr; } }
            __syncthreads();
            topk_core(lds, ((size_t)u.pm * 256 + 128 * ai) * PH + u.pn, PH, experts, gates, tid);
        }
    }
};
struct EpiTopK {
    static constexpr bool PERM = false, AFTER_DRAIN = true;
    int* experts; float* gates;
    __device__ __forceinline__ void fused(pg8::f32x4 (&acc)[2][2][4][2], const pg8::Unit& u, int wr, int wc, int fr, int fq, LAS unsigned char* lds, int wid, int lane) const {
        LAS float* S = (LAS float*)lds;
        const int tid = wid * 64 + lane;
#pragma unroll
        for (int ai = 0; ai < 2; ++ai) {
#pragma unroll
            for (int bj = 0; bj < 2; ++bj)
#pragma unroll
                for (int mm = 0; mm < 4; ++mm)
#pragma unroll
                    for (int n = 0; n < 2; ++n) { const int rl = 64 * wr + 16 * mm + fr; *(LAS pg8::f32x4*)(S + (2 * rl + bj) * TK_ROWF + 32 * wc + 16 * n + 4 * fq) = acc[ai][bj][mm][n]; }
            __syncthreads();
            topk_core(lds, ((size_t)u.pm * 256 + 128 * ai) * PH + u.pn, PH, experts, gates, tid);
        }
    }
};

__device__ __forceinline__ float gelu_erf(float v) { return 0.5f * v * (1.0f + erff(v * 0.70710678118654752f)); }
typedef __bf16 bf16x2_t __attribute__((ext_vector_type(2)));
typedef float f32x2_t __attribute__((ext_vector_type(2)));
__device__ __forceinline__ float dot2bf(bf16x2_t a, unsigned b, float acc) { return __builtin_amdgcn_fdot2_f32_bf16(a, __builtin_bit_cast(bf16x2_t, b), acc, false); }
__device__ __forceinline__ float dot4f8(unsigned w8, unsigned x01, unsigned x23, float acc) {
    acc = dot2bf(__builtin_amdgcn_cvt_scalef32_pk_bf16_fp8(w8, 1.0f, false), x01, acc);
    return dot2bf(__builtin_amdgcn_cvt_scalef32_pk_bf16_fp8(w8, 1.0f, true), x23, acc);
}
__device__ __forceinline__ void axpy4f8(float* y, unsigned w8, float w) {
    const f32x2_t lo = __builtin_amdgcn_cvt_pk_f32_fp8(w8, false), hi = __builtin_amdgcn_cvt_pk_f32_fp8(w8, true);
    y[0] += w * lo.x; y[1] += w * lo.y; y[2] += w * hi.x; y[3] += w * hi.y;
}
__device__ __forceinline__ void axpy4f8v(f32x2_t* y2, unsigned w8, float w) {
    const f32x2_t lo = __builtin_amdgcn_cvt_pk_f32_fp8(w8, false), hi = __builtin_amdgcn_cvt_pk_f32_fp8(w8, true);
    const f32x2_t ww = {w, w};
    y2[0] = __builtin_elementwise_fma(lo, ww, y2[0]); y2[1] = __builtin_elementwise_fma(hi, ww, y2[1]);
}
__device__ __forceinline__ void row_to_fp8(const float* src, unsigned char* dst, float* inv, int lane) {
    f32x4 v[2][4]; float mx = 0.f;
#pragma unroll
    for (int j = 0; j < 2; ++j)
#pragma unroll
        for (int q = 0; q < 4; ++q) { v[j][q] = *((const GAS f32x4*)src + 4 * (lane + 64 * j) + q);
            mx = fmaxf(mx, fmaxf(fmaxf(fabsf(v[j][q].x), fabsf(v[j][q].y)), fmaxf(fabsf(v[j][q].z), fabsf(v[j][q].w)))); }
#pragma unroll
    for (int o = 1; o < 64; o <<= 1) mx = fmaxf(mx, __shfl_xor(mx, o));
    const float sc = mx > 0.f ? 384.0f / mx : 1.0f;
#pragma unroll
    for (int j = 0; j < 2; ++j) { v4u o;
        int w;
        w = 0; w = __builtin_amdgcn_cvt_pk_fp8_f32(v[j][0].x * sc, v[j][0].y * sc, w, false); w = __builtin_amdgcn_cvt_pk_fp8_f32(v[j][0].z * sc, v[j][0].w * sc, w, true); o.x = (unsigned)w;
        w = 0; w = __builtin_amdgcn_cvt_pk_fp8_f32(v[j][1].x * sc, v[j][1].y * sc, w, false); w = __builtin_amdgcn_cvt_pk_fp8_f32(v[j][1].z * sc, v[j][1].w * sc, w, true); o.y = (unsigned)w;
        w = 0; w = __builtin_amdgcn_cvt_pk_fp8_f32(v[j][2].x * sc, v[j][2].y * sc, w, false); w = __builtin_amdgcn_cvt_pk_fp8_f32(v[j][2].z * sc, v[j][2].w * sc, w, true); o.z = (unsigned)w;
        w = 0; w = __builtin_amdgcn_cvt_pk_fp8_f32(v[j][3].x * sc, v[j][3].y * sc, w, false); w = __builtin_amdgcn_cvt_pk_fp8_f32(v[j][3].z * sc, v[j][3].w * sc, w, true); o.w = (unsigned)w;
        { const int ch = lane + 64 * j; *((GAS v4u*)(dst + (size_t)(ch >> 4) * SLICE_BYTES) + (ch & 15)) = o; } }
    if (lane == 0) *inv = mx > 0.f ? mx * (1.0f / 384.0f) : 1.0f;
}
__device__ __forceinline__ void row_to_i8(const float* src, unsigned char* dst, float* inv, int lane) {
    f32x4 v[2][4]; float mx = 0.f;
#pragma unroll
    for (int j = 0; j < 2; ++j)
#pragma unroll
        for (int q = 0; q < 4; ++q) { v[j][q] = *((const GAS f32x4*)src + 4 * (lane + 64 * j) + q);
            mx = fmaxf(mx, fmaxf(fmaxf(fabsf(v[j][q].x), fabsf(v[j][q].y)), fmaxf(fabsf(v[j][q].z), fabsf(v[j][q].w)))); }
#pragma unroll
    for (int o = 1; o < 64; o <<= 1) mx = fmaxf(mx, __shfl_xor(mx, o));
    const float sc = mx > 0.f ? 127.0f / mx : 1.0f;
#pragma unroll
    for (int j = 0; j < 2; ++j) { v4u o; o.x = pack_i8(v[j][0] * sc); o.y = pack_i8(v[j][1] * sc); o.z = pack_i8(v[j][2] * sc); o.w = pack_i8(v[j][3] * sc);
        { const int ch = lane + 64 * j; *((GAS v4u*)(dst + (size_t)(ch >> 4) * SLICE_BYTES) + (ch & 15)) = o; } }
    if (lane == 0) *inv = mx > 0.f ? mx * (1.0f / 127.0f) : 1.0f;
}
__device__ __forceinline__ float row16_allsum(float a) {
    a += __builtin_bit_cast(float, __builtin_amdgcn_update_dpp(0, __builtin_bit_cast(int, a), 0x128, 0xf, 0xf, false));
    a += __builtin_bit_cast(float, __builtin_amdgcn_update_dpp(0, __builtin_bit_cast(int, a), 0x124, 0xf, 0xf, false));
    a += __builtin_bit_cast(float, __builtin_amdgcn_update_dpp(0, __builtin_bit_cast(int, a), 0x122, 0xf, 0xf, false));
    a += __builtin_bit_cast(float, __builtin_amdgcn_update_dpp(0, __builtin_bit_cast(int, a), 0x121, 0xf, 0xf, false));
    return a;
}
__device__ __forceinline__ int q_pull(unsigned* q, int lane) { int v = 0; if (lane == 0) v = (int)__hip_atomic_fetch_add(q, 1u, __ATOMIC_RELAXED, __HIP_MEMORY_SCOPE_AGENT); return __builtin_amdgcn_readfirstlane(v); }
constexpr int PEER_TG = 8;
constexpr int PEER_N8 = 640, PEER_N4 = 512, PEER_N2 = 512, PEER_NTASK = PEER_N8 + PEER_N4 + PEER_N2;
__device__ __forceinline__ void peer_task_tokens(int idx, int& t0, int& n) {
    if (idx < PEER_N8) { t0 = 8 * idx; n = 8; } else if (idx < PEER_N8 + PEER_N4) { t0 = 8 * PEER_N8 + 4 * (idx - PEER_N8); n = 4; } else { t0 = 8 * PEER_N8 + 4 * PEER_N4 + 2 * (idx - PEER_N8 - PEER_N4); n = 2; }
}
__device__ __forceinline__ int row16_allsum_i(int a) {
    a += __builtin_amdgcn_update_dpp(0, a, 0x128, 0xf, 0xf, false);
    a += __builtin_amdgcn_update_dpp(0, a, 0x124, 0xf, 0xf, false);
    a += __builtin_amdgcn_update_dpp(0, a, 0x122, 0xf, 0xf, false);
    a += __builtin_amdgcn_update_dpp(0, a, 0x121, 0xf, 0xf, false);
    return a;
}
#define PA_LOAD(R, IDV, HALF) do { _Pragma("unroll") for (int i_ = 0; i_ < 8; ++i_) { const unsigned e_ = (unsigned)__shfl(IDV, 4 * (i_ + 8 * (HALF)) + g); \
        R[i_] = *(const GAS v4u*)(ub + (e_ * 256u + offc)); } } while (0)
#define PA_COMP(R, HALF) do { _Pragma("unroll") for (int i_ = 0; i_ < 8; ++i_) { int a_ = __builtin_amdgcn_sdot4((int)R[i_].x, (int)xc.x, 0, false); a_ = __builtin_amdgcn_sdot4((int)R[i_].y, (int)xc.y, a_, false); \
        a_ = __builtin_amdgcn_sdot4((int)R[i_].z, (int)xc.z, a_, false); a_ = __builtin_amdgcn_sdot4((int)R[i_].w, (int)xc.w, a_, false); r16[8 * (HALF) + i_] = row16_allsum_i(a_); } } while (0)
__device__ __forceinline__ void peer_a_task(int t0, int ntok, int s, const signed char* xq, const int* experts, const unsigned char* u8s, int* pa, int lane_) {
    int lane = lane_; asm volatile("" : "+v"(lane));
    const int g = lane >> 4, c = lane & 15;
    const GAS unsigned char* ub = (const GAS unsigned char*)(u8s + (size_t)s * SLICE_BYTES);
    const unsigned offc = 16u * (unsigned)c;
    int idc0 = experts[(size_t)t0 * 128 + lane], idc1 = experts[(size_t)t0 * 128 + lane + 64];
    v4u xc = *(const GAS v4u*)(xq + (size_t)t0 * D + 256 * s + 16 * c);
    v4u RA[8], RB[8];
    PA_LOAD(RA, idc0, 0);
#pragma unroll 1
    for (int tt = 0; tt < ntok; ++tt) {
        const int t = t0 + tt, tn = tt + 1 < ntok ? t + 1 : t;
        const int idn0 = experts[(size_t)tn * 128 + lane], idn1 = experts[(size_t)tn * 128 + lane + 64];
        const v4u xn = *(const GAS v4u*)(xq + (size_t)tn * D + 256 * s + 16 * c);
#pragma unroll 1
        for (int hb = 0; hb < 2; ++hb) {
            const int idv = hb ? idc1 : idc0, idx = hb ? idn0 : idc1;
            int r16[16];
            PA_LOAD(RB, idv, 1); PA_COMP(RA, 0);
            asm volatile("" ::: "memory");
            PA_LOAD(RA, idx, 0); PA_COMP(RB, 1);
            if (c == 15) { typedef int i32x4 __attribute__((ext_vector_type(4))); GAS i32x4* dst = (GAS i32x4*)(pa + ((size_t)t * 8 + s) * 128 + g * 32 + 16 * hb);
#pragma unroll
                for (int q = 0; q < 4; ++q) dst[q] = (i32x4){r16[4 * q], r16[4 * q + 1], r16[4 * q + 2], r16[4 * q + 3]}; }
        }
        idc0 = idn0; idc1 = idn1; xc = xn;
    }
}
constexpr int PA_CH = 56, PA_NCH = (M + PA_CH - 1) / PA_CH, PA_NCH4 = (PA_NCH + 3) & ~3;
constexpr int PA_XT = 131072, PA_XTB = PA_CH * 256, PA_LOFF = PA_XT + 2 * PA_XTB;
static_assert(PA_LOFF + PA_NCH4 * 8 <= LDSCTL_OFF, "LDS map");
__device__ __forceinline__ void peer_shard_load(int s, int r, const unsigned char* u8s, LAS unsigned char* lds, int tid_) {
    int tid = tid_; asm volatile("" : "+v"(tid));
    const GAS unsigned char* src = (const GAS unsigned char*)(u8s + (size_t)s * SLICE_BYTES);
#pragma unroll 1
    for (int h = 0; h < 2; ++h) { v4u t[8];
#pragma unroll
        for (int j = 0; j < 8; ++j) { const int piece = tid + NTHREADS * (8 * h + j), el = piece >> 4, i = el >> 2, jj = ((r - i) & 31) + 32 * (el & 3);
            t[j] = *(const GAS v4u*)(src + ((size_t)(i * 128 + jj) * 256 + (size_t)((piece & 15) << 4))); }
#pragma unroll
        for (int j = 0; j < 8; ++j) *(LAS v4u*)(lds + 16 * (tid + NTHREADS * (8 * h + j))) = t[j]; }
}
__device__ __forceinline__ void peer_bucket(int q, const int* experts, unsigned* seg, int* soff, LAS unsigned char* lds, int tid_) {
    int tid = tid_; asm volatile("" : "+v"(tid));
    LAS int* cnt = (LAS int*)(lds + PA_XT);
    if (tid < 128) cnt[tid] = 0;
    __syncthreads();
    const int ntok = (M - q * PA_CH) < PA_CH ? (M - q * PA_CH) : PA_CH, nent = ntok * 128;
    const GAS int* ex = (const GAS int*)(experts + (size_t)q * PA_CH * 128);
    int ev[14];
#pragma unroll
    for (int j = 0; j < 14; ++j) { const int i = tid + NTHREADS * j; ev[j] = i < nent ? ex[i] : -1; }
#pragma unroll
    for (int j = 0; j < 14; ++j) if (ev[j] >= 0) __hip_atomic_fetch_add(cnt + (((ev[j] >> 7) + ev[j]) & 31), 1, __ATOMIC_RELAXED, __HIP_MEMORY_SCOPE_WORKGROUP);
    __syncthreads();
    if (tid < 64) { const int c = tid < 32 ? cnt[tid] : 0; int inc = c;
#pragma unroll
        for (int o = 1; o < 32; o <<= 1) { const int v = __shfl_up(inc, o); if (tid >= o) inc += v; }
        if (tid < 32) { cnt[32 + tid] = inc - c; soff[q * 33 + tid] = inc - c; if (tid == 31) soff[q * 33 + 32] = inc; } }
    __syncthreads();
    GAS unsigned* sg = (GAS unsigned*)(seg + (size_t)q * (PA_CH * 128));
#pragma unroll
    for (int j = 0; j < 14; ++j) if (ev[j] >= 0) { const int i = tid + NTHREADS * j, e = ev[j], r = ((e >> 7) + e) & 31;
        const int p = cnt[32 + r] + __hip_atomic_fetch_add(cnt + 96 + r, 1, __ATOMIC_RELAXED, __HIP_MEMORY_SCOPE_WORKGROUP);
        sg[p] = ((unsigned)(i >> 7) << 16) | ((unsigned)(i & 127) << 9) | (unsigned)(((e >> 7) << 2) | ((e >> 5) & 3)); }
    __syncthreads();
}
#define PAL_ISSUE(U, X, ENT, XT) do { const unsigned ua_ = ((ENT) & 511u) * 256u + l16, xa_ = (XT) + ((ENT) >> 16) * 256u + l16; \
        _Pragma("unroll") for (int j_ = 0; j_ < 8; ++j_) { U[j_] = *(const LAS v4u*)(ua_ ^ (unsigned)(j_ << 4)); X[j_] = *(const LAS v4u*)(xa_ ^ (unsigned)(j_ << 4)); } } while (0)
#define PAL_DOTS(U, X, ACC) do { int a0_ = 0, a1_ = 0; \
        _Pragma("unroll") for (int j_ = 0; j_ < 8; j_ += 2) { \
            a0_ = __builtin_amdgcn_sdot4((int)U[j_].x, (int)X[j_].x, a0_, false); a1_ = __builtin_amdgcn_sdot4((int)U[j_ + 1].x, (int)X[j_ + 1].x, a1_, false); \
            a0_ = __builtin_amdgcn_sdot4((int)U[j_].y, (int)X[j_].y, a0_, false); a1_ = __builtin_amdgcn_sdot4((int)U[j_ + 1].y, (int)X[j_ + 1].y, a1_, false); \
            a0_ = __builtin_amdgcn_sdot4((int)U[j_].z, (int)X[j_].z, a0_, false); a1_ = __builtin_amdgcn_sdot4((int)U[j_ + 1].z, (int)X[j_ + 1].z, a1_, false); \
            a0_ = __builtin_amdgcn_sdot4((int)U[j_].w, (int)X[j_].w, a0_, false); a1_ = __builtin_amdgcn_sdot4((int)U[j_ + 1].w, (int)X[j_ + 1].w, a1_, false); } \
        a0_ += a1_; ACC = a0_ + __builtin_amdgcn_update_dpp(0, a0_, 0x128, 0xf, 0xf, false); } while (0)
#define PAL_LOAD(Q, XA, XB, EN) do { int q_ = (Q); q_ = q_ < PA_NCH4 ? q_ : PA_NCH4 - 1; const GAS unsigned char* xq_ = xb + (size_t)q_ * (PA_CH * D); \
        XA = *(const GAS v4u*)(xq_ + voff0); XB = *(const GAS v4u*)(xq_ + voff1); EN = sg[(unsigned)(loff[2 * q_] + pidx)]; } while (0)
#define PAL_WRITE(Q, XA, XB) do { const int b_ = PA_XT + ((Q) & 1) * PA_XTB + 16 * tid; *(LAS v4u*)(lds + b_) = XA; if (tid < (PA_CH - 32) * 16) *(LAS v4u*)(lds + b_ + 16 * NTHREADS) = XB; } while (0)
#define PAL_STORE(QQ, E, A) do { const unsigned k_ = ((E) >> 9) & 127u; pa[((size_t)((QQ) * PA_CH + (int)((E) >> 16)) * 8 + s) * 128 + (k_ & 3u) * 32u + (k_ >> 2)] = (A); } while (0)
#define PAL_STEP(Q, WXA, WXB, CXA, CXB, CEN) do { const int q_s = (Q); \
        __syncthreads();                       \
        const unsigned e0_ = CEN; const int nb_s = loff[2 * q_s], n_s = loff[2 * q_s + 1]; const unsigned xt_s = (unsigned)(PA_XT + (q_s & 1) * PA_XTB); \
        PAL_LOAD(q_s + 4, CXA, CXB, CEN);        \
        if (late) { if (pidx < n_prev) { int a_; PAL_DOTS(U, X, a_); if (!(tid & 8)) PAL_STORE(q_s - 1, e_prev, a_); } } \
        _Pragma("unroll 1") for (int i_ = pidx + NTHREADS / 2; i_ < n_s; i_ += NTHREADS / 2) { const unsigned e1_ = sg[nb_s + i_]; PAL_ISSUE(U, X, e1_, xt_s); int a_; PAL_DOTS(U, X, a_); if (!(tid & 8)) PAL_STORE(q_s, e1_, a_); }        \
        PAL_WRITE(q_s + 1, WXA, WXB); \
        if (pidx < n_s) PAL_ISSUE(U, X, e0_, xt_s); \
        __builtin_amdgcn_sched_barrier(0); \
        if (!late) { if (pidx < n_s) { int a_; PAL_DOTS(U, X, a_); if (!(tid & 8)) PAL_STORE(q_s, e0_, a_); } } \
        e_prev = e0_; n_prev = n_s; \
    } while (0)
__device__ __forceinline__ void peer_a_lds(int s, const signed char* xq, const unsigned* seg, const int* soff, int r, int* pa, LAS unsigned char* lds, int tid_) {
    int tid = tid_; asm volatile("" : "+v"(tid));
    const unsigned l16 = (unsigned)(tid & 15) << 4;
    const int pidx = (tid >> 4) * 8 + (tid & 7);
    const bool late = __builtin_amdgcn_readfirstlane(tid >> 8) != 0;
    LAS int* loff = (LAS int*)(lds + PA_LOFF);
    if (tid < PA_NCH4) { int b = 0, e = 0; if (tid < PA_NCH) { b = soff[tid * 33 + r]; e = soff[tid * 33 + r + 1]; } loff[2 * tid] = tid * (PA_CH * 128) + b; loff[2 * tid + 1] = e - b; }
    __syncthreads();
    const GAS unsigned char* xb = (const GAS unsigned char*)(xq + 256 * s);
    const GAS unsigned* sg = (const GAS unsigned*)seg;
    const unsigned voff0 = (unsigned)(tid >> 4) * (unsigned)D + l16, voff1 = voff0 + ((tid >> 4) < PA_CH - 32 ? 32u * (unsigned)D : 0u);
    v4u x0a, x0b, x1a, x1b, x2a, x2b, x3a, x3b; unsigned en0, en1, en2, en3;
    v4u U[8], X[8]; unsigned e_prev = 0u; int n_prev = 0;
#pragma unroll
    for (int j = 0; j < 8; ++j) { U[j] = X[j] = (v4u){0u, 0u, 0u, 0u}; }
    PAL_LOAD(0, x0a, x0b, en0); PAL_LOAD(1, x1a, x1b, en1); PAL_LOAD(2, x2a, x2b, en2); PAL_LOAD(3, x3a, x3b, en3);
    PAL_WRITE(0, x0a, x0b);
#pragma unroll 1
    for (int q0 = 0; q0 < PA_NCH4; q0 += 4) {
        PAL_STEP(q0, x1a, x1b, x0a, x0b, en0);
        PAL_STEP(q0 + 1, x2a, x2b, x1a, x1b, en1);
        PAL_STEP(q0 + 2, x3a, x3b, x2a, x2b, en2);
        PAL_STEP(q0 + 3, x0a, x0b, x3a, x3b, en3);
    }
    __syncthreads();
}
__device__ __forceinline__ void peer_w_elem(size_t i, const int* experts, const float* gates, const float* su, const float* sv, const float* sx, const int* pa, float* wb) {
    const size_t t = i >> 7; const int k = (int)(i & 127), pos = (k & 3) * 32 + (k >> 2);
    const int e = experts[i];
    int a = 0;
#pragma unroll
    for (int s2 = 0; s2 < 8; ++s2) a += pa[(t * 8 + s2) * 128 + pos];
    wb[i] = gates[i] * gelu_erf((float)a * (su[e] * sx[t])) * sv[e];
}
#define PB_LOAD(R, IDV, HALF) do { _Pragma("unroll") for (int i_ = 0; i_ < 8; ++i_) { const unsigned e_ = (unsigned)__shfl(IDV, 4 * (i_ + 8 * (HALF)) + g); \
        R[i_] = *(const GAS v4u*)(vb + (e_ * 256u + offc)); } } while (0)
#define PB_COMP(R, WV, HALF) do { _Pragma("unroll") for (int i_ = 0; i_ < 8; ++i_) { const float wk_ = __shfl(WV, 4 * (i_ + 8 * (HALF)) + g); \
        axpy4f8v(&ya2[0], R[i_].x, wk_); axpy4f8v(&ya2[2], R[i_].y, wk_); axpy4f8v(&ya2[4], R[i_].z, wk_); axpy4f8v(&ya2[6], R[i_].w, wk_); } } while (0)
__device__ __forceinline__ void peer_b_task(int t0, int ntok, int s, const bf16* h1, const int* experts, const float* wb, const unsigned char* v8s, bf16* out, float* st, int lane_) {
    int lane = lane_; asm volatile("" : "+v"(lane));
    const int g = lane >> 4, c = lane & 15;
    const GAS unsigned char* vb = (const GAS unsigned char*)(v8s + (size_t)s * SLICE_BYTES);
    const unsigned offc = 16u * (unsigned)c;
    int idc0 = experts[(size_t)t0 * 128 + lane], idc1 = experts[(size_t)t0 * 128 + lane + 64];
    float wc0 = wb[(size_t)t0 * 128 + lane], wc1 = wb[(size_t)t0 * 128 + lane + 64];
    v4u RA[8], RB[8];
    PB_LOAD(RA, idc0, 0);
#pragma unroll 1
    for (int tt = 0; tt < ntok; ++tt) {
        const int t = t0 + tt, tn = tt + 1 < ntok ? t + 1 : t;
        const int idn0 = experts[(size_t)tn * 128 + lane], idn1 = experts[(size_t)tn * 128 + lane + 64];
        const float wn0 = wb[(size_t)tn * 128 + lane], wn1 = wb[(size_t)tn * 128 + lane + 64];
        f32x2_t ya2[8];
#pragma unroll
        for (int e = 0; e < 8; ++e) ya2[e] = (f32x2_t){0.f, 0.f};
#pragma unroll 1
        for (int hb = 0; hb < 2; ++hb) {
            const int idv = hb ? idc1 : idc0, idx = hb ? idn0 : idc1; const float wv = hb ? wc1 : wc0;
            PB_LOAD(RB, idv, 1); PB_COMP(RA, wv, 0);
            asm volatile("" ::: "memory");
            PB_LOAD(RA, idx, 0); PB_COMP(RB, wv, 1);
        }
        float ya[16];
#pragma unroll
        for (int e = 0; e < 8; ++e) { ya[2 * e] = ya2[e].x; ya[2 * e + 1] = ya2[e].y; }
#pragma unroll
        for (int e = 0; e < 16; ++e) { ya[e] += __shfl_xor(ya[e], 16); ya[e] += __shfl_xor(ya[e], 32); }
        const GAS v4u* hp = (const GAS v4u*)(h1 + (size_t)t * D + 256 * s + 16 * c);
        const v4u h0 = hp[0], h1v = hp[1];
        float hx[16];
        hx[0] = pg8::bf_lo(h0.x); hx[1] = pg8::bf_hi(h0.x); hx[2] = pg8::bf_lo(h0.y); hx[3] = pg8::bf_hi(h0.y); hx[4] = pg8::bf_lo(h0.z); hx[5] = pg8::bf_hi(h0.z); hx[6] = pg8::bf_lo(h0.w); hx[7] = pg8::bf_hi(h0.w);
        hx[8] = pg8::bf_lo(h1v.x); hx[9] = pg8::bf_hi(h1v.x); hx[10] = pg8::bf_lo(h1v.y); hx[11] = pg8::bf_hi(h1v.y); hx[12] = pg8::bf_lo(h1v.z); hx[13] = pg8::bf_hi(h1v.z); hx[14] = pg8::bf_lo(h1v.w); hx[15] = pg8::bf_hi(h1v.w);
        float sm = 0.f, sq = 0.f;
#pragma unroll
        for (int e = 0; e < 16; ++e) { ya[e] = hx[e] * ALPHA + ya[e]; sm += ya[e]; sq += ya[e] * ya[e]; }
        sm = row16_allsum(sm); sq = row16_allsum(sq);
        if (g == 0) { GAS v4u* op = (GAS v4u*)(out + (size_t)t * D + 256 * s + 16 * c);
            v4u o0, o1; o0.x = pk2(ya[0], ya[1]); o0.y = pk2(ya[2], ya[3]); o0.z = pk2(ya[4], ya[5]); o0.w = pk2(ya[6], ya[7]);
            o1.x = pk2(ya[8], ya[9]); o1.y = pk2(ya[10], ya[11]); o1.z = pk2(ya[12], ya[13]); o1.w = pk2(ya[14], ya[15]);
            op[0] = o0; op[1] = o1;
            if (c == 0) { st[((size_t)t * 8 + s) * 2] = sm; st[((size_t)t * 8 + s) * 2 + 1] = sq; } }
        idc0 = idn0; idc1 = idn1; wc0 = wn0; wc1 = wn1;
    }
}
__device__ __forceinline__ void peer_c_row(int t, const bf16* r2, float* out, const float* st, const float* g2, const float* b2, int lane) {
    float sm = 0.f, sq = 0.f;
#pragma unroll
    for (int s = 0; s < 8; ++s) { sm += st[((size_t)t * 8 + s) * 2]; sq += st[((size_t)t * 8 + s) * 2 + 1]; }
    const float mean = sm * (1.f / D), var = sq * (1.f / D) - mean * mean, rstd = 1.f / sqrtf(fmaxf(var, 0.f) + LN_EPS);
    const GAS v4u* xr = (const GAS v4u*)(r2 + (size_t)t * D) + lane;
    GAS f32x4* op = (GAS f32x4*)(out + (size_t)t * D);
#pragma unroll
    for (int j = 0; j < 4; ++j) { const v4u w = xr[64 * j]; const int c4 = 2 * (lane + 64 * j);
        const f32x4 g0 = *((const GAS f32x4*)g2 + c4), g1 = *((const GAS f32x4*)g2 + c4 + 1), b0 = *((const GAS f32x4*)b2 + c4), b1 = *((const GAS f32x4*)b2 + c4 + 1);
        const f32x4 v0 = (f32x4){pg8::bf_lo(w.x), pg8::bf_hi(w.x), pg8::bf_lo(w.y), pg8::bf_hi(w.y)}, v1 = (f32x4){pg8::bf_lo(w.z), pg8::bf_hi(w.z), pg8::bf_lo(w.w), pg8::bf_hi(w.w)};
        op[c4] = (v0 - mean) * rstd * g0 + b0; op[c4 + 1] = (v1 - mean) * rstd * g1 + b1; }
}

struct TwoPassOrder : pg8::StaticOrder {
    __device__ __forceinline__ bool next(int i, pg8::Unit& u) const { if (!pg8::StaticOrder::next(i >> 1, u)) return false; u.w = i & 1; return true; }
};
struct EpiGate2 {
    static constexpr bool PERM = true, AFTER_DRAIN = false;
    pg8::EpiGate<0> e0; pg8::EpiGate<1> e1;
    __device__ __forceinline__ void operator()(const pg8::f32x4 (&acc)[2][2][4][2], const pg8::Unit& u, int wr, int wc, int fr, int fq) const { if (u.w == 0) e0(acc, u, wr, wc, fr, fq); else e1(acc, u, wr, wc, fr, fq); }
};

struct EpiGate2I8 {
    static constexpr bool PERM = true, AFTER_DRAIN = false;
    pg8::EpiGateI8<0> e0; pg8::EpiGateI8<1> e1;
    __device__ __forceinline__ void operator()(const pg8::i32x4 (&acc)[2][2][4][2], const pg8::Unit& u, int wr, int wc, int fr, int fq) const { if (u.w == 0) e0(acc, u, wr, wc, fr, fq); else e1(acc, u, wr, wc, fr, fq); }
};
struct ConvOrder : pg8::StaticOrder {
    const float* pu; const float* pv; unsigned char* u8; unsigned char* v8; float* su; float* sv; int slot; mutable int calls;
    static constexpr int CONV_ROWS = 4, CONV_CALLS = 6;
    __device__ __forceinline__ void done(const pg8::Unit&) const {
        if (slot < 0) return;
        int lane = threadIdx.x & 63; asm volatile("" : "+v"(lane));
        const int wave = __builtin_amdgcn_readfirstlane(threadIdx.x >> 6);
        const int base = ((slot * NWAVES + wave) * CONV_CALLS + calls) * CONV_ROWS;
        if (calls < CONV_CALLS) {
#pragma unroll 1
            for (int j = 0; j < CONV_ROWS; ++j) { const int r = base + j; if (r < 2 * PNE) { const bool sec = r >= PNE; const int e = sec ? r - PNE : r;
                if (sec) row_to_fp8(pv + (size_t)e * D, v8 + (size_t)e * 256, sv + e, lane); else row_to_i8(pu + (size_t)e * D, u8 + (size_t)e * 256, su + e, lane); } }
        }
        ++calls;
    }
};

struct Args { const float* in[16]; float* out; unsigned char* ws; int ph_lo, ph_hi; };
__global__ void __launch_bounds__(NTHREADS, 2) mk_fwd(Args args) {
    extern __shared__ __attribute__((aligned(16))) unsigned char lds_raw[];
    LAS unsigned char* lds = (LAS unsigned char*)lds_raw;
    volatile LAS unsigned* MISC = (volatile LAS unsigned*)(lds + MISC_OFF);
    const int tid0 = threadIdx.x;
    const int G = gridDim.x, bx = blockIdx.x;
    unsigned char* ws = args.ws;
    gu32* ctl = (gu32*)(ws + WS_CTL);
#define IN_(i) (args.in[i])
#define x_in IN_(0)
#define w_in IN_(1)
#define b_gate IN_(2)
#define sinks IN_(3)
#define conv_w IN_(4)
#define w_ao IN_(5)
#define w_co IN_(6)
#define w_o IN_(7)
#define ln1_g IN_(8)
#define ln1_b IN_(9)
#define w_q IN_(10)
#define sub_keys IN_(11)
#define peer_u IN_(12)
#define peer_v IN_(13)
#define ln2_g IN_(14)
#define ln2_b IN_(15)
#define WinT ((bf16*)(ws + WS_WIN))
#define WaT ((bf16*)(ws + WS_WA))
#define WcT ((bf16*)(ws + WS_WC))
#define WoT ((bf16*)(ws + WS_WO))
#define WfT ((bf16*)(ws + WS_WF))
#define XB ((bf16*)(ws + WS_XB))
#define MERGED ((bf16*)(ws + WS_MERGED))
#define Z ((bf16*)(ws + WS_Z))
#define R2B ((bf16*)(ws + WS_R2B))
#define H1B ((bf16*)(ws + WS_H1B))
#define SC ((float*)(ws + WS_SC))
#define EX ((int*)(ws + WS_EX))
#define GT ((float*)(ws + WS_GT))
#define AO ((bf16*)(ws + WS_AO))
#define CI ((bf16*)(ws + WS_CI))
#define TMP ((bf16*)(ws + WS_TMP))
#define U8 ((unsigned char*)(ws + WS_U8))
#define V8 ((unsigned char*)(ws + WS_V8))
#define SU ((float*)(ws + WS_SU))
#define SV ((float*)(ws + WS_SV))
#define PA ((int*)(ws + WS_PA))
#define ST ((float*)(ws + WS_ST))
#define WB ((float*)(ws + WS_WB))
#define XA8 ((signed char*)(ws + WS_XA8))
#define WIN8 ((signed char*)(ws + WS_WIN8))
#define SWIN ((float*)(ws + WS_SWIN))
#define SXA ((float*)(ws + WS_SXA))
#define WF8 ((signed char*)(ws + WS_WF8))
#define MG8 ((signed char*)(ws + WS_MG8))
#define WO8 ((signed char*)(ws + WS_WO8))
#define SMG ((float*)(ws + WS_SMG))
#define SWO ((float*)(ws + WS_SWO))
#define AO8 ((signed char*)(ws + WS_AO8))
#define CI8 ((signed char*)(ws + WS_CI8))
#define WA8 ((signed char*)(ws + WS_WA8))
#define WC8 ((signed char*)(ws + WS_WC8))
#define SAO ((float*)(ws + WS_S3))
#define SCI ((float*)(ws + WS_S3 + 65536))
#define SWA ((float*)(ws + WS_S3 + 131072))
#define SWC ((float*)(ws + WS_S3 + 196608))
#define SWF ((float*)(ws + WS_SWF))
#define XQ ((signed char*)(ws + WS_XQ))
#define SX ((float*)(ws + WS_SX))
#define SEG ((unsigned*)(ws + WS_SEG))
#define SOFF ((int*)(ws + WS_SOFF))
    for (int u = tid0; u < (LDS_BYTES - LDSCTL_OFF) / 4; u += NTHREADS) ((LAS unsigned*)(lds + LDSCTL_OFF))[u] = 0u;
    __syncthreads();
    XcdBarrier bar; bar.bar = (unsigned*)(ctl + CW_BAR); bar.x = 0; bar.st = nullptr;
    if (!MK_PER_PHASE) bar = xcd_barrier_post((unsigned*)(ctl + CW_BAR), MISC + 8);
    const int lo = args.ph_lo, hi = args.ph_hi;
#ifndef PH_MASK
#define PH_MASK 0xFFF
#endif
#define IN(k) (((PH_MASK >> (k)) & 1) && lo <= (k) && (k) < hi)
#ifndef DBL_BAR
#define DBL_BAR 0
#endif
#define SEAM(k) do { if (IN(k) && IN((k) + 1)) { xcd_barrier(bar); if (DBL_BAR) xcd_barrier(bar); } } while (0)
#ifndef DBL_MASK
#define DBL_MASK 0
#endif
#define REP(k) for (int rep_ = 0; rep_ < 1 + ((DBL_MASK >> (k)) & 1); ++rep_)
#define PHASE_TID() int tid = tid0; asm volatile("" : "+v"(tid)); const int lane = tid & 63, wave = __builtin_amdgcn_readfirstlane(tid >> 6); (void)lane; (void)wave

    if (IN(0)) REP(0) {
        PHASE_TID();
        const bool conv_first = ((bx >> 3) & 1) == 0;
#pragma unroll 1
        for (int part = 0; part < 2; ++part) {
            if ((part == 0) == conv_first) {
                int tid = tid0; asm volatile("" : "+v"(tid)); const int lane = tid & 63, wave = __builtin_amdgcn_readfirstlane(tid >> 6);
                LAS float* scr = (LAS float*)(lds + wave * 16384);
                const int gw = bx * NWAVES + wave, NGW = G * NWAVES;
                constexpr int I_IN = (D / 64) * (IN_W / 32), I_SQ = (D / 64) * (D / 32);
                for (int it = gw; it < I_IN + 3 * I_SQ; it += NGW) {
                    int r = it;
                    if (r < I_IN) { p0_transpose_item(w_in, D, IN_W, WinT, scr, r, lane); continue; } r -= I_IN;
                    if (r < I_SQ) { p0_transpose_item(w_ao, D, D, WaT, scr, r, lane); continue; } r -= I_SQ;
                    if (r < I_SQ) { p0_transpose_item(w_co, D, D, WcT, scr, r, lane); continue; } r -= I_SQ;
                    p0_transpose_item(w_o, D, D, WoT, scr, r, lane);
                }
                for (int r = gw; r < M; r += NGW) row_f32_to_i8(x_in + (size_t)r * D, XA8 + (size_t)r * D, SXA + r, lane);
                __syncthreads();
            }
            if (part == 0) for (int it = bx; it < 16 * 32; it += G) p0_wf_item(w_q, sub_keys, WfT, lds, it, tid);
        }
    }
    SEAM(0);
    if (IN(1)) REP(1) {
        { PHASE_TID();
          for (int r = bx * NWAVES + wave; r < IN_W + 2 * D; r += G * NWAVES) { if (r < IN_W) row_bf16_to_i8(WinT + (size_t)r * D, WIN8 + (size_t)r * D, SWIN + r, lane);
              else if (r < IN_W + D) { const int q = r - IN_W; row_bf16_to_i8(WfT + (size_t)q * D, WF8 + (size_t)q * D, SWF + q, lane); }
              else { const int q = r - IN_W - D; row_bf16_to_i8(WoT + (size_t)q * D, WO8 + (size_t)q * D, SWO + q, lane); } } }
        if (!MK_PER_PHASE) xcd_barrier(bar);
        pg8::Gemm g{(const bf16*)XA8, (const bf16*)WIN8, M, IN_W, D / 2}; ConvOrder S; S.init(M, IN_W, G, bx);
        S.pu = peer_u; S.pv = peer_v; S.u8 = U8; S.v8 = V8; S.su = SU; S.sv = SV; S.calls = 0;
        S.slot = (G == 256 && bx >= 64) ? bx - 64 : -1;
        pg8::EpiI8Bf16 E{Z, IN_W, SXA, SWIN};
        pg8::gemm_phase<pg8::EpiI8Bf16, ConvOrder, true, true, true>(lds, g, S, E);
        if (G != 256) {
            PHASE_TID();
            for (int r = bx * NWAVES + wave; r < 2 * PNE; r += G * NWAVES) { const bool sec = r >= PNE; const int e = sec ? r - PNE : r;
                if (sec) row_to_fp8(peer_v + (size_t)e * D, V8 + (size_t)e * 256, SV + e, lane); else row_to_i8(peer_u + (size_t)e * D, U8 + (size_t)e * 256, SU + e, lane); }
        }
    }
    SEAM(1);
    if (IN(2)) REP(2) {
        PHASE_TID();
        const bool conv_first = ((bx >> 3) & 1) == 0;
#pragma unroll 1
        for (int part = 0; part < 2; ++part) {
            if ((part == 0) == conv_first) { int t2 = tid0; asm volatile("" : "+v"(t2)); for (int it = bx; it < M / 32; it += G) conv_item(it, Z, conv_w, CI, t2); }
            if (part == 0) for (int u = bx; u < BATCH * NKVH * 16; u += G) attn_unit(u, Z, AO, sinks, lds, tid);
        }
    }
    SEAM(2);
    if (IN(3)) REP(3) {
        TwoPassOrder S; S.init(M, D, G, bx);
#ifndef P3_I8
#define P3_I8 1
#endif
        if (P3_I8 && !MK_PER_PHASE) {
            { PHASE_TID();
              for (int r = bx * NWAVES + wave; r < 2 * M + 2 * D; r += G * NWAVES) {
                  if (r < M) row_bf16_to_i8(AO + (size_t)r * D, AO8 + (size_t)r * D, SAO + r, lane);
                  else if (r < 2 * M) { const int q = r - M; row_bf16_to_i8(CI + (size_t)q * D, CI8 + (size_t)q * D, SCI + q, lane); }
                  else if (r < 2 * M + D) { const int q = r - 2 * M; row_bf16_to_i8(WaT + (size_t)q * D, WA8 + (size_t)q * D, SWA + q, lane); }
                  else { const int q = r - 2 * M - D; row_bf16_to_i8(WcT + (size_t)q * D, WC8 + (size_t)q * D, SWC + q, lane); } } }
            xcd_barrier(bar);
            pg8::Gemm g{(const bf16*)AO8, (const bf16*)WA8, M, D, D / 2, (const bf16*)CI8, (const bf16*)WC8};
            EpiGate2I8 E{pg8::EpiGateI8<0>{TMP, nullptr, Z + G_OFF, b_gate, D, IN_W, SAO, SWA}, pg8::EpiGateI8<1>{MERGED, TMP, Z + G_OFF + D, b_gate + D, D, IN_W, SCI, SWC}};
            pg8::gemm_phase<EpiGate2I8, TwoPassOrder, true, true, true>(lds, g, S, E);
        } else {
        pg8::Gemm g{AO, WaT, M, D, D, CI, WcT};
        EpiGate2 E{pg8::EpiGate<0>{TMP, nullptr, Z + G_OFF, b_gate, D, IN_W}, pg8::EpiGate<1>{MERGED, TMP, Z + G_OFF + D, b_gate + D, D, IN_W}};
        pg8::gemm_phase<EpiGate2, TwoPassOrder, true, true>(lds, g, S, E);
        }
    }
    SEAM(3);
    if (IN(4)) REP(4) {
        pg8::StaticOrder S; S.init(M, D, G, bx);
#ifndef P4_I8
#define P4_I8 1
#endif
        if (P4_I8 && !MK_PER_PHASE) {
            { PHASE_TID(); for (int r = bx * NWAVES + wave; r < M; r += G * NWAVES) row_bf16_to_i8(MERGED + (size_t)r * D, MG8 + (size_t)r * D, SMG + r, lane); }
            xcd_barrier(bar);
            pg8::Gemm g{(const bf16*)MG8, (const bf16*)WO8, M, D, D / 2};
            pg8::EpiResI8Bf16 E{H1B, D, x_in, ALPHA, SMG, SWO};
            pg8::gemm_phase<pg8::EpiResI8Bf16, pg8::StaticOrder, true, true, true>(lds, g, S, E);
        } else {
        pg8::Gemm g{MERGED, WoT, M, D, D};
        pg8::EpiResBf16 E{H1B, D, x_in, ALPHA};
        pg8::gemm_phase<pg8::EpiResBf16, pg8::StaticOrder, true, true>(lds, g, S, E);
        }
    }
    SEAM(4);
    if (IN(5)) REP(5) {
        PHASE_TID();
        const int gw = bx * NWAVES + wave, NGW = G * NWAVES;
        for (int m = gw; m < M; m += NGW) ln1_row(H1B + (size_t)m * D, XQ + (size_t)m * D, SX + m, ln1_g, ln1_b, lane);
    }
    SEAM(5);
    if (IN(6)) REP(6) {
        pg8::Gemm g{H1B, WfT, M, D, D}; pg8::StaticOrder S; S.init(M, D, G, bx);
#ifndef P6_I8
#define P6_I8 1
#endif
        if (G == 256 && P6_I8) { pg8::Gemm g8{(const bf16*)XQ, (const bf16*)WF8, M, D, D / 2}; EpiTopKI8 E{EX, GT, SX, SWF}; pg8::gemm_phase<EpiTopKI8, pg8::StaticOrder, false, true, true>(lds, g8, S, E); }
        else if (G == 256) { EpiTopK E{EX, GT}; pg8::gemm_phase<EpiTopK, pg8::StaticOrder, false, true>(lds, g, S, E); }
        else { pg8::EpiF32 E{SC, D, nullptr, 0.f}; pg8::gemm_phase<pg8::EpiF32, pg8::StaticOrder, true, true>(lds, g, S, E); }
    }
    SEAM(6);
    if (IN(7)) REP(7) {
        PHASE_TID();
        if (G != 256) for (int p = bx; p < (M * PH) / 128; p += G) topk_pass(p, SC, EX, GT, lds, tid);
        else { peer_shard_load(bx & 7, bx >> 3, U8, lds, tid);
               if (bx < PA_NCH) peer_bucket(bx, EX, SEG, SOFF, lds, tid); }
    }
    SEAM(7);
    if (IN(8)) REP(8) {
        PHASE_TID();
        if (G == 256) peer_a_lds(bx & 7, XQ, SEG, SOFF, bx >> 3, PA, lds, tid);
        else {
        const int xcc = (int)(xb_xcc_id() & 7u);
#pragma unroll 1
#ifndef SCRAMBLE
#define SCRAMBLE 0
#endif
        for (int sl = 0; sl < 8; ++sl) { const int s = (xcc + sl + (SCRAMBLE ? wave : 0)) & 7;
            for (;;) { const int tg = q_pull((unsigned*)(ctl + CW_Q + 64 * (s + 16 * rep_)), lane); if (tg >= PEER_NTASK) break;
                int t0, nt; peer_task_tokens(tg, t0, nt); peer_a_task(t0, nt, s, XQ, EX, U8, PA, lane); } }
        }
    }
    SEAM(8);
    if (IN(9)) REP(9) {
        PHASE_TID();
        for (size_t i = (size_t)bx * NTHREADS + tid; i < (size_t)M * 128; i += (size_t)G * NTHREADS) peer_w_elem(i, EX, GT, SU, SV, SX, PA, WB);
    }
    SEAM(9);
    if (IN(10)) REP(10) {
        PHASE_TID();
        const int xcc = (int)(xb_xcc_id() & 7u);
#pragma unroll 1
#ifndef SCRAMBLE
#define SCRAMBLE 0
#endif
        for (int sl = 0; sl < 8; ++sl) { const int s = (xcc + sl + (SCRAMBLE ? wave : 0)) & 7;
            for (;;) { const int tg = q_pull((unsigned*)(ctl + CW_Q + 64 * (8 + s + 16 * rep_)), lane); if (tg >= PEER_NTASK) break;
                int t0, nt; peer_task_tokens(tg, t0, nt); peer_b_task(t0, nt, s, H1B, EX, WB, V8, R2B, ST, lane); } }
    }
    SEAM(10);
    if (IN(11)) REP(11) {
        PHASE_TID();
        const int gw = bx * NWAVES + wave, NGW = G * NWAVES;
        for (int t = gw; t < M; t += NGW) peer_c_row(t, R2B, args.out, ST, ln2_g, ln2_b, lane);
    }
#undef IN
#undef SEAM
}

extern "C" void kernel_launch(void* const* d_in, const int* in_sizes, int n_in, void* d_out, int out_size, void* d_ws, size_t ws_size, hipStream_t stream) {
    static int grid = 0;
    if (grid == 0) {
        if (n_in != 16 || out_size != M * D || ws_size < WS_END) { fprintf(stderr, "kernel_launch: unexpected shapes (n_in %d out %d ws %zu)\n", n_in, out_size, ws_size); grid = -1; return; }
        int dev = 0, cus = 0, per_cu = 0;
        if (hipGetDevice(&dev) != hipSuccess || hipDeviceGetAttribute(&cus, hipDeviceAttributeMultiprocessorCount, dev) != hipSuccess) { grid = -1; return; }
        if (hipFuncSetAttribute((const void*)mk_fwd, hipFuncAttributeMaxDynamicSharedMemorySize, LDS_BYTES) != hipSuccess) { fprintf(stderr, "kernel_launch: hipFuncSetAttribute failed\n"); grid = -1; return; }
        if (hipOccupancyMaxActiveBlocksPerMultiprocessor(&per_cu, (const void*)mk_fwd, NTHREADS, LDS_BYTES) != hipSuccess || per_cu < 1) { fprintf(stderr, "kernel_launch: occupancy query says %d\n", per_cu); per_cu = 1; }
        (void)hipGetLastError();
        if (per_cu > 1) per_cu = 1;
        grid = cus * per_cu;
    }
    if (grid < 0) return;
    if (hipMemsetAsync((char*)d_ws + WS_CTL, 0, CTL_ZERO_BYTES, stream) != hipSuccess) { fprintf(stderr, "kernel_launch: memset failed\n"); return; }
    Args a{};
    for (int i = 0; i < 16; ++i) a.in[i] = (const float*)d_in[i];
    a.out = (float*)d_out; a.ws = (unsigned char*)d_ws;
#if MK_PER_PHASE
    for (int p = 0; p < N_PHASES; ++p) { a.ph_lo = p; a.ph_hi = p + 1; hipLaunchKernelGGL(mk_fwd, dim3(grid), dim3(NTHREADS), LDS_BYTES, stream, a); }
#else
    a.ph_lo = 0; a.ph_hi = N_PHASES;
    void* kargs[] = {&a};
#ifdef PLAIN_LAUNCH
    (void)kargs; hipLaunchKernelGGL(mk_fwd, dim3(grid), dim3(NTHREADS), LDS_BYTES, stream, a); hipError_t e = hipPeekAtLastError();
#else
    hipError_t e = hipLaunchCooperativeKernel((const void*)mk_fwd, dim3(grid), dim3(NTHREADS), kargs, LDS_BYTES, stream);
#endif
    if (e != hipSuccess) fprintf(stderr, "kernel_launch: cooperative launch failed: %s (grid %d)\n", hipGetErrorString(e), grid);
#endif
}
```

```cpp
#include <hip/hip_runtime.h>
#include <cstdio>
#include <cstdint>
#include <type_traits>
namespace pg8 {
#define PG8_LAS __attribute__((address_space(3)))
typedef unsigned short bf16_t;
typedef short bf16x8 __attribute__((ext_vector_type(8)));
typedef float f32x4 __attribute__((ext_vector_type(4)));
typedef unsigned u32x4 __attribute__((ext_vector_type(4)));
constexpr int BM = 256, BK = 64, HALF = 128, HTB = HALF * BK * 2  , STAGE_BYTES = 8 * HTB, NXCD = 8, WGM = 8;

__host__ __device__ __forceinline__ int lds_byte(int r, int c) { const int st = (r >> 4) * 2 + (c >> 5), rr = r & 15, cc = c & 31, ob = rr * 64 + cc * 2; return st * 1024 + (ob ^ (((ob >> 9) & 1) << 5)); }
__host__ __device__ __forceinline__ void stage_rc(int b, int& R, int& C) { const int st = b / 1024, sb = b % 1024, swz = sb ^ (((sb >> 9) & 1) << 5); R = (st >> 1) * 16 + swz / 64; C = (st & 1) * 32 + (swz % 64) / 2; }
__host__ __device__ __forceinline__ int perm32(int rho) { const int n = rho >> 4, i = rho & 15; return 8 * (i >> 2) + 4 * n + (i & 3); }

struct Unit { int pm, pn, w; };
struct Gemm { const bf16_t* A; const bf16_t* Bt; int M, N, K; const bf16_t* A2 = nullptr; const bf16_t* Bt2 = nullptr; };

struct StaticOrder {
    int nM, nN, nwg, G, c;
    __host__ __device__ void init(int M, int N, int G_, int c_) { nM = M / BM; nN = N / BM; nwg = nM * nN; G = G_; c = c_; }
    __host__ __device__ bool next(int i, Unit& u) const {
        const long L = (long)i * G + c; if (L >= nwg) return false;
        int wgid = (int)L; { const int q = nwg / NXCD, r = nwg % NXCD, xcd = wgid % NXCD, off = wgid / NXCD; wgid = (xcd < r ? xcd * (q + 1) : r * (q + 1) + (xcd - r) * q) + off; }
        const int nig = WGM * nN, gid = wgid / nig, fm = gid * WGM, gsz = (nM - fm) < WGM ? (nM - fm) : WGM;
        u.pm = fm + ((wgid % nig) % gsz); u.pn = (wgid % nig) / gsz; u.w = 0; return true;
    }
    __device__ __forceinline__ void a_ready(const Unit&) const {}
    __device__ __forceinline__ void done(const Unit&) const {}
};


__device__ __forceinline__ unsigned cvt_pk_bf16(float lo, float hi) { unsigned r; asm volatile("v_cvt_pk_bf16_f32 %0, %1, %2" : "=v"(r) : "v"(lo), "v"(hi)); return r; }
__device__ __forceinline__ float bf_lo(unsigned w) { return __builtin_bit_cast(float, w << 16); }
__device__ __forceinline__ float bf_hi(unsigned w) { return __builtin_bit_cast(float, w & 0xffff0000u); }
__device__ __forceinline__ float sigmoidf_(float x) { return __builtin_amdgcn_rcpf(1.0f + __expf(-x)); }

struct EpiBf16 {
    static constexpr bool PERM = true, AFTER_DRAIN = false;
    bf16_t* O; int ldc;
    __device__ __forceinline__ void operator()(const f32x4 (&acc)[2][2][4][2], const Unit& u, int wr, int wc, int fr, int fq) const {
        const int row0 = u.pm * BM + wr * 64 + fr, col0 = u.pn * BM + wc * 32 + 8 * fq;
#pragma unroll
        for (int ai = 0; ai < 2; ++ai)
#pragma unroll
            for (int m = 0; m < 4; ++m) { bf16_t* rowp = O + (size_t)(row0 + ai * HALF + m * 16) * ldc + col0;
#pragma unroll
                for (int bj = 0; bj < 2; ++bj) { const f32x4 v0 = acc[ai][bj][m][0], v1 = acc[ai][bj][m][1];
                    u32x4 w; w.x = cvt_pk_bf16(v0[0], v0[1]); w.y = cvt_pk_bf16(v0[2], v0[3]); w.z = cvt_pk_bf16(v1[0], v1[1]); w.w = cvt_pk_bf16(v1[2], v1[3]);
                    *(u32x4*)(rowp + bj * HALF) = w; } }
    }
};
template <int SECOND> struct EpiGate {
    static constexpr bool PERM = true, AFTER_DRAIN = false;
    bf16_t* O; const bf16_t* T; const bf16_t* Zg; const float* bg; int ldc, ldz;
    __device__ __forceinline__ void operator()(const f32x4 (&acc)[2][2][4][2], const Unit& u, int wr, int wc, int fr, int fq) const {
        const int row0 = u.pm * BM + wr * 64 + fr, col0 = u.pn * BM + wc * 32 + 8 * fq;
        f32x4 bv[2][2];
#pragma unroll
        for (int bj = 0; bj < 2; ++bj)
#pragma unroll
            for (int n = 0; n < 2; ++n) bv[bj][n] = *(const f32x4*)(bg + col0 + bj * HALF + 4 * n);
#pragma unroll
        for (int ai = 0; ai < 2; ++ai)
#pragma unroll
            for (int m = 0; m < 4; ++m) { const size_t row = (size_t)(row0 + ai * HALF + m * 16);
#pragma unroll
                for (int bj = 0; bj < 2; ++bj) { const int c = col0 + bj * HALF;
                    const u32x4 zg = *(const u32x4*)(Zg + row * ldz + c);
                    f32x4 v0 = acc[ai][bj][m][0], v1 = acc[ai][bj][m][1];
                    v0[0] *= sigmoidf_(bf_lo(zg.x) + bv[bj][0][0]); v0[1] *= sigmoidf_(bf_hi(zg.x) + bv[bj][0][1]);
                    v0[2] *= sigmoidf_(bf_lo(zg.y) + bv[bj][0][2]); v0[3] *= sigmoidf_(bf_hi(zg.y) + bv[bj][0][3]);
                    v1[0] *= sigmoidf_(bf_lo(zg.z) + bv[bj][1][0]); v1[1] *= sigmoidf_(bf_hi(zg.z) + bv[bj][1][1]);
                    v1[2] *= sigmoidf_(bf_lo(zg.w) + bv[bj][1][2]); v1[3] *= sigmoidf_(bf_hi(zg.w) + bv[bj][1][3]);
                    if (SECOND) { const u32x4 t = *(const u32x4*)(T + row * ldc + c);
                        v0[0] += bf_lo(t.x); v0[1] += bf_hi(t.x); v0[2] += bf_lo(t.y); v0[3] += bf_hi(t.y);
                        v1[0] += bf_lo(t.z); v1[1] += bf_hi(t.z); v1[2] += bf_lo(t.w); v1[3] += bf_hi(t.w); }
                    u32x4 w; w.x = cvt_pk_bf16(v0[0], v0[1]); w.y = cvt_pk_bf16(v0[2], v0[3]); w.z = cvt_pk_bf16(v1[0], v1[1]); w.w = cvt_pk_bf16(v1[2], v1[3]);
                    *(u32x4*)(O + row * ldc + c) = w; } }
    }
};
struct EpiF32 {
    static constexpr bool PERM = false, AFTER_DRAIN = false;
    float* C; int ldc; const float* R; float scale;
    __device__ __forceinline__ void operator()(const f32x4 (&acc)[2][2][4][2], const Unit& u, int wr, int wc, int fr, int fq) const {
        const int row0 = u.pm * BM + wr * 64 + fr, col0 = u.pn * BM + wc * 32 + 4 * fq;
#pragma unroll
        for (int ai = 0; ai < 2; ++ai)
#pragma unroll
            for (int m = 0; m < 4; ++m) { const size_t off = (size_t)(row0 + ai * HALF + m * 16) * ldc + col0;
#pragma unroll
                for (int bj = 0; bj < 2; ++bj)
#pragma unroll
                    for (int n = 0; n < 2; ++n) { f32x4 v = acc[ai][bj][m][n];
                        if (R) v += *(const f32x4*)(R + off + bj * HALF + n * 16) * scale;
                        *(f32x4*)(C + off + bj * HALF + n * 16) = v; } }
    }
};
struct EpiResBf16 {
    static constexpr bool PERM = true, AFTER_DRAIN = false;
    bf16_t* O; int ldc; const float* R; float scale;
    __device__ __forceinline__ void operator()(const f32x4 (&acc)[2][2][4][2], const Unit& u, int wr, int wc, int fr, int fq) const {
        const int row0 = u.pm * BM + wr * 64 + fr, col0 = u.pn * BM + wc * 32 + 8 * fq;
#pragma unroll
        for (int ai = 0; ai < 2; ++ai)
#pragma unroll
            for (int m = 0; m < 4; ++m) { const size_t off = (size_t)(row0 + ai * HALF + m * 16) * ldc + col0;
#pragma unroll
                for (int bj = 0; bj < 2; ++bj) { const f32x4 r0 = *(const f32x4*)(R + off + bj * HALF), r1 = *(const f32x4*)(R + off + bj * HALF + 4);
                    const f32x4 v0 = acc[ai][bj][m][0] + r0 * scale, v1 = acc[ai][bj][m][1] + r1 * scale;
                    u32x4 w; w.x = cvt_pk_bf16(v0[0], v0[1]); w.y = cvt_pk_bf16(v0[2], v0[3]); w.z = cvt_pk_bf16(v1[0], v1[1]); w.w = cvt_pk_bf16(v1[2], v1[3]);
                    *(u32x4*)(O + off + bj * HALF) = w; } }
    }
};
typedef int i32x4e __attribute__((ext_vector_type(4)));
struct EpiI8Bf16 {
    static constexpr bool PERM = true, AFTER_DRAIN = false;
    bf16_t* O; int ldc; const float* sa; const float* sb;
    __device__ __forceinline__ void operator()(const i32x4e (&acc)[2][2][4][2], const Unit& u, int wr, int wc, int fr, int fq) const {
        const int row0 = u.pm * BM + wr * 64 + fr, col0 = u.pn * BM + wc * 32 + 8 * fq;
        f32x4 sbv[2][2];
#pragma unroll
        for (int bj = 0; bj < 2; ++bj)
#pragma unroll
            for (int n = 0; n < 2; ++n) sbv[bj][n] = *(const f32x4*)(sb + col0 + bj * HALF + 4 * n);
#pragma unroll
        for (int ai = 0; ai < 2; ++ai)
#pragma unroll
            for (int m = 0; m < 4; ++m) { const int row = row0 + ai * HALF + m * 16; const float sr = sa[row]; bf16_t* rowp = O + (size_t)row * ldc + col0;
#pragma unroll
                for (int bj = 0; bj < 2; ++bj) { const i32x4e a0 = acc[ai][bj][m][0], a1 = acc[ai][bj][m][1];
                    const f32x4 v0 = (f32x4){(float)a0[0], (float)a0[1], (float)a0[2], (float)a0[3]} * sbv[bj][0] * sr, v1 = (f32x4){(float)a1[0], (float)a1[1], (float)a1[2], (float)a1[3]} * sbv[bj][1] * sr;
                    u32x4 w; w.x = cvt_pk_bf16(v0[0], v0[1]); w.y = cvt_pk_bf16(v0[2], v0[3]); w.z = cvt_pk_bf16(v1[0], v1[1]); w.w = cvt_pk_bf16(v1[2], v1[3]);
                    *(u32x4*)(rowp + bj * HALF) = w; } }
    }
};
template <int SECOND> struct EpiGateI8 {
    static constexpr bool PERM = true, AFTER_DRAIN = false;
    bf16_t* O; const bf16_t* T; const bf16_t* Zg; const float* bg; int ldc, ldz; const float* sa; const float* sb;
    __device__ __forceinline__ void operator()(const i32x4e (&acc)[2][2][4][2], const Unit& u, int wr, int wc, int fr, int fq) const {
        const int row0 = u.pm * BM + wr * 64 + fr, col0 = u.pn * BM + wc * 32 + 8 * fq;
        f32x4 bv[2][2], sbv[2][2];
#pragma unroll
        for (int bj = 0; bj < 2; ++bj)
#pragma unroll
            for (int n = 0; n < 2; ++n) { bv[bj][n] = *(const f32x4*)(bg + col0 + bj * HALF + 4 * n); sbv[bj][n] = *(const f32x4*)(sb + col0 + bj * HALF + 4 * n); }
#pragma unroll
        for (int ai = 0; ai < 2; ++ai)
#pragma unroll
            for (int m = 0; m < 4; ++m) { const size_t row = (size_t)(row0 + ai * HALF + m * 16); const float sr = sa[row];
#pragma unroll
                for (int bj = 0; bj < 2; ++bj) { const int c = col0 + bj * HALF;
                    const u32x4 zg = *(const u32x4*)(Zg + row * ldz + c);
                    const i32x4e a0 = acc[ai][bj][m][0], a1 = acc[ai][bj][m][1];
                    f32x4 v0 = (f32x4){(float)a0[0], (float)a0[1], (float)a0[2], (float)a0[3]} * sbv[bj][0] * sr, v1 = (f32x4){(float)a1[0], (float)a1[1], (float)a1[2], (float)a1[3]} * sbv[bj][1] * sr;
                    v0[0] *= sigmoidf_(bf_lo(zg.x) + bv[bj][0][0]); v0[1] *= sigmoidf_(bf_hi(zg.x) + bv[bj][0][1]);
                    v0[2] *= sigmoidf_(bf_lo(zg.y) + bv[bj][0][2]); v0[3] *= sigmoidf_(bf_hi(zg.y) + bv[bj][0][3]);
                    v1[0] *= sigmoidf_(bf_lo(zg.z) + bv[bj][1][0]); v1[1] *= sigmoidf_(bf_hi(zg.z) + bv[bj][1][1]);
                    v1[2] *= sigmoidf_(bf_lo(zg.w) + bv[bj][1][2]); v1[3] *= sigmoidf_(bf_hi(zg.w) + bv[bj][1][3]);
                    if (SECOND) { const u32x4 t = *(const u32x4*)(T + row * ldc + c);
                        v0[0] += bf_lo(t.x); v0[1] += bf_hi(t.x); v0[2] += bf_lo(t.y); v0[3] += bf_hi(t.y);
                        v1[0] += bf_lo(t.z); v1[1] += bf_hi(t.z); v1[2] += bf_lo(t.w); v1[3] += bf_hi(t.w); }
                    u32x4 w; w.x = cvt_pk_bf16(v0[0], v0[1]); w.y = cvt_pk_bf16(v0[2], v0[3]); w.z = cvt_pk_bf16(v1[0], v1[1]); w.w = cvt_pk_bf16(v1[2], v1[3]);
                    *(u32x4*)(O + row * ldc + c) = w; } }
    }
};
struct EpiResI8Bf16 {
    static constexpr bool PERM = true, AFTER_DRAIN = false;
    bf16_t* O; int ldc; const float* R; float scale; const float* sa; const float* sb;
    __device__ __forceinline__ void operator()(const i32x4e (&acc)[2][2][4][2], const Unit& u, int wr, int wc, int fr, int fq) const {
        const int row0 = u.pm * BM + wr * 64 + fr, col0 = u.pn * BM + wc * 32 + 8 * fq;
        f32x4 sbv[2][2];
#pragma unroll
        for (int bj = 0; bj < 2; ++bj)
#pragma unroll
            for (int n = 0; n < 2; ++n) sbv[bj][n] = *(const f32x4*)(sb + col0 + bj * HALF + 4 * n);
#pragma unroll
        for (int ai = 0; ai < 2; ++ai)
#pragma unroll
            for (int m = 0; m < 4; ++m) { const int row = row0 + ai * HALF + m * 16; const float sr = sa[row]; const size_t off = (size_t)row * ldc + col0;
#pragma unroll
                for (int bj = 0; bj < 2; ++bj) { const f32x4 r0 = *(const f32x4*)(R + off + bj * HALF), r1 = *(const f32x4*)(R + off + bj * HALF + 4);
                    const i32x4e a0 = acc[ai][bj][m][0], a1 = acc[ai][bj][m][1];
                    const f32x4 v0 = (f32x4){(float)a0[0], (float)a0[1], (float)a0[2], (float)a0[3]} * sbv[bj][0] * sr + r0 * scale, v1 = (f32x4){(float)a1[0], (float)a1[1], (float)a1[2], (float)a1[3]} * sbv[bj][1] * sr + r1 * scale;
                    u32x4 w; w.x = cvt_pk_bf16(v0[0], v0[1]); w.y = cvt_pk_bf16(v0[2], v0[3]); w.z = cvt_pk_bf16(v1[0], v1[1]); w.w = cvt_pk_bf16(v1[2], v1[3]);
                    *(u32x4*)(O + off + bj * HALF) = w; } }
    }
};

typedef int i32x4 __attribute__((ext_vector_type(4)));
template <class E, class = void> struct epi_chains : std::false_type {};
template <class E> struct epi_chains<E, std::void_t<decltype(E::CHAIN)>> : std::true_type {};
template <class Epi, class Sched, bool ALIGN_EPI = false, bool SP2 = false, bool I8 = false>
__device__ __forceinline__ void gemm_phase(PG8_LAS unsigned char* lds, const Gemm g, const Sched& S, const Epi& E) {
    int tid_ = threadIdx.x; asm volatile("" : "+v"(tid_));
    const int tid = tid_, wid = __builtin_amdgcn_readfirstlane(tid >> 6), lane = tid & 63, wr = wid >> 2, wc = wid & 3, fr = lane & 15, fq = lane >> 4;
    const int K = g.K, nt = K / BK;
    unsigned voffA[2], voffB[2];
#pragma unroll
    for (int i = 0; i < 2; ++i) { int R, C; stage_rc(tid * 16 + i * 8192, R, C); const int Rb = Epi::PERM ? ((R & ~31) + perm32(R & 31)) : R;
        voffA[i] = (unsigned)(R * K + C) * 2u; voffB[i] = (unsigned)(Rb * K + C) * 2u; }
    const size_t kstep = (size_t)(BK * 2);
    const size_t hstep = (size_t)HALF * K * 2;
    const size_t tstep = 2 * hstep;
    const unsigned ldsw = (unsigned)wid * 1024u;
    const int aoff = lds_byte(wr * 64 + fr, fq * 8), boff = lds_byte(wc * 32 + fr, fq * 8);
#define PG8_SA(b, h) (((b) * 2 + (h)) * HTB)
#define PG8_SB(b, h) ((4 + (b) * 2 + (h)) * HTB)
#define PG8_STAGE(bufoff, gbase, voff) do { _Pragma("unroll") for (int _i = 0; _i < 2; ++_i) \
        __builtin_amdgcn_global_load_lds((const unsigned*)((const char*)(gbase) + (voff)[_i]), (PG8_LAS unsigned*)(lds + (bufoff) + ldsw + _i * 8192), 16, 0, 0); } while (0)
#define PG8_LDA(dst, b, h) do { _Pragma("unroll") for (int m = 0; m < 4; ++m) _Pragma("unroll") for (int k = 0; k < 2; ++k) dst[m][k] = *(const PG8_LAS bf16x8*)(lds + PG8_SA(b, h) + aoff + m * 2048 + k * 1024); } while (0)
#define PG8_LDB(dst, b, h) do { _Pragma("unroll") for (int n = 0; n < 2; ++n) _Pragma("unroll") for (int k = 0; k < 2; ++k) dst[n][k] = *(const PG8_LAS bf16x8*)(lds + PG8_SB(b, h) + boff + n * 2048 + k * 1024); } while (0)
#define PG8_MMA(ai, bj, At, Bt) do { __builtin_amdgcn_s_setprio(1); _Pragma("unroll") for (int m = 0; m < 4; ++m) _Pragma("unroll") for (int n = 0; n < 2; ++n) _Pragma("unroll") for (int k = 0; k < 2; ++k) \
        { if constexpr (I8) acc[ai][bj][m][n] = __builtin_bit_cast(acc_t, __builtin_amdgcn_mfma_i32_16x16x64_i8(__builtin_bit_cast(i32x4, Bt[n][k]), __builtin_bit_cast(i32x4, At[m][k]), __builtin_bit_cast(i32x4, acc[ai][bj][m][n]), 0, 0, 0)); \
          else acc[ai][bj][m][n] = __builtin_bit_cast(acc_t, __builtin_amdgcn_mfma_f32_16x16x32_bf16(Bt[n][k], At[m][k], __builtin_bit_cast(f32x4, acc[ai][bj][m][n]), 0, 0, 0)); } __builtin_amdgcn_s_setprio(0); } while (0)
#define PG8_WAIT_V(n) asm volatile("s_waitcnt vmcnt(" #n ")" ::: "memory")
#define PG8_WAIT_L(n) asm volatile("s_waitcnt lgkmcnt(" #n ")" ::: "memory")
#define PG8_BAR __builtin_amdgcn_s_barrier()
#define PG8_SCHED __builtin_amdgcn_sched_barrier(0)
    Unit cur, nxt; int ui = 0;
    if (!S.next(0, cur)) return;
    typedef typename std::conditional<I8, i32x4, f32x4>::type acc_t;
    acc_t acc[2][2][4][2];
#pragma unroll
    for (int a = 0; a < 2; ++a)
#pragma unroll
        for (int b = 0; b < 2; ++b)
#pragma unroll
            for (int m = 0; m < 4; ++m)
#pragma unroll
                for (int n = 0; n < 2; ++n) acc[a][b][m][n] = acc_t{};
    bf16x8 At[4][2], B0[2][2], B1[2][2];
    const char* cA = (const char*)(cur.w ? g.A2 : g.A) + (size_t)cur.pm * tstep; const char* cB = (const char*)(cur.w ? g.Bt2 : g.Bt) + (size_t)cur.pn * tstep;
    S.a_ready(cur);
    if constexpr (SP2) {
        PG8_STAGE(PG8_SB(0, 0), cB, voffB); PG8_STAGE(PG8_SB(0, 1), cB + hstep, voffB); PG8_STAGE(PG8_SA(0, 0), cA, voffA); PG8_STAGE(PG8_SA(0, 1), cA + hstep, voffA);
        if (wr == 1) PG8_BAR;
        PG8_WAIT_V(2); PG8_BAR;
        PG8_STAGE(PG8_SB(1, 0), cB + kstep, voffB); PG8_STAGE(PG8_SA(1, 0), cA + kstep, voffA); PG8_STAGE(PG8_SB(1, 1), cB + hstep + kstep, voffB);
        PG8_WAIT_V(6); PG8_BAR;
    } else {
        PG8_STAGE(PG8_SB(0, 0), cB, voffB); PG8_STAGE(PG8_SA(0, 0), cA, voffA); PG8_STAGE(PG8_SB(0, 1), cB + hstep, voffB); PG8_STAGE(PG8_SA(0, 1), cA + hstep, voffA);
        if (wr == 1) PG8_BAR;
        PG8_WAIT_V(4); PG8_BAR;
        PG8_STAGE(PG8_SB(1, 0), cB + kstep, voffB); PG8_STAGE(PG8_SA(1, 0), cA + kstep, voffA); PG8_STAGE(PG8_SB(1, 1), cB + hstep + kstep, voffB);
        PG8_WAIT_V(6); PG8_BAR;
    }
    for (;;) {
        const bool has_next = S.next(ui + 1, nxt);
        const char* nA = has_next ? (const char*)(nxt.w ? g.A2 : g.A) + (size_t)nxt.pm * tstep : cA; const char* nB = has_next ? (const char*)(nxt.w ? g.Bt2 : g.Bt) + (size_t)nxt.pn * tstep : cB;
        for (int t = 0; t < nt; t += 2) {
            const bool last = (t == nt - 2);
            const char* a1 = cA + (size_t)(t + 1) * kstep;
            const char* a2 = last ? nA : cA + (size_t)(t + 2) * kstep; const char* b2 = last ? nB : cB + (size_t)(t + 2) * kstep;
            const char* a3 = a2 + kstep; const char* b3 = b2 + kstep;
            if (last && has_next) S.a_ready(nxt);
            if constexpr (SP2) {
            PG8_LDB(B0, 0, 0); PG8_LDB(B1, 0, 1); PG8_SCHED; PG8_LDA(At, 0, 0); PG8_STAGE(PG8_SA(1, 1), a1 + hstep, voffA);
            PG8_WAIT_V(8); PG8_WAIT_L(0); PG8_BAR; PG8_MMA(0, 0, At, B0); PG8_MMA(0, 1, At, B1); PG8_BAR; PG8_SCHED;
            PG8_LDA(At, 0, 1); PG8_STAGE(PG8_SB(0, 0), b2, voffB); PG8_STAGE(PG8_SB(0, 1), b2 + hstep, voffB); PG8_STAGE(PG8_SA(0, 0), a2, voffA);
            PG8_WAIT_V(8); PG8_WAIT_L(0); PG8_BAR; PG8_MMA(1, 0, At, B0); PG8_MMA(1, 1, At, B1); PG8_BAR; PG8_SCHED;
            PG8_LDB(B0, 1, 0); PG8_LDB(B1, 1, 1); PG8_SCHED; PG8_LDA(At, 1, 0); PG8_STAGE(PG8_SA(0, 1), a2 + hstep, voffA);
            PG8_WAIT_V(8); PG8_WAIT_L(0); PG8_BAR; PG8_MMA(0, 0, At, B0); PG8_MMA(0, 1, At, B1); PG8_BAR; PG8_SCHED;
            PG8_LDA(At, 1, 1); PG8_STAGE(PG8_SB(1, 0), b3, voffB); PG8_STAGE(PG8_SB(1, 1), b3 + hstep, voffB); PG8_STAGE(PG8_SA(1, 0), a3, voffA);
            PG8_WAIT_V(8); PG8_WAIT_L(0); PG8_BAR; PG8_MMA(1, 0, At, B0); PG8_MMA(1, 1, At, B1); PG8_BAR; PG8_SCHED;
            } else {
            PG8_LDB(B0, 0, 0); PG8_SCHED; PG8_LDA(At, 0, 0); PG8_STAGE(PG8_SA(1, 1), a1 + hstep, voffA);
            PG8_WAIT_L(8); PG8_BAR; PG8_WAIT_L(0); PG8_MMA(0, 0, At, B0); PG8_BAR; PG8_SCHED;
            PG8_LDB(B1, 0, 1); PG8_STAGE(PG8_SB(0, 0), b2, voffB);
            PG8_BAR; PG8_WAIT_L(0); PG8_MMA(0, 1, At, B1); PG8_BAR;
            PG8_LDA(At, 0, 1); PG8_STAGE(PG8_SA(0, 0), a2, voffA);
            PG8_BAR; PG8_WAIT_L(0); PG8_MMA(1, 0, At, B0); PG8_BAR; PG8_SCHED;
            PG8_STAGE(PG8_SB(0, 1), b2 + hstep, voffB);
            PG8_WAIT_V(6); PG8_BAR; PG8_MMA(1, 1, At, B1); PG8_BAR;
            PG8_LDB(B0, 1, 0); PG8_SCHED; PG8_LDA(At, 1, 0); PG8_STAGE(PG8_SA(0, 1), a2 + hstep, voffA);
            PG8_WAIT_L(8); PG8_BAR; PG8_WAIT_L(0); PG8_MMA(0, 0, At, B0); PG8_BAR; PG8_SCHED;
            PG8_LDB(B1, 1, 1); PG8_STAGE(PG8_SB(1, 0), b3, voffB);
            PG8_BAR; PG8_WAIT_L(0); PG8_MMA(0, 1, At, B1); PG8_BAR;
            PG8_LDA(At, 1, 1); PG8_STAGE(PG8_SA(1, 0), a3, voffA);
            PG8_BAR; PG8_WAIT_L(0); PG8_MMA(1, 0, At, B0); PG8_BAR; PG8_SCHED;
            PG8_STAGE(PG8_SB(1, 1), b3 + hstep, voffB);
            PG8_WAIT_V(6); PG8_BAR; PG8_MMA(1, 1, At, B1); PG8_BAR;
            }
        }
        if constexpr (ALIGN_EPI) { if (wr == 0) PG8_BAR; }
        bool keep_acc = false;
        if constexpr (!Epi::AFTER_DRAIN) { if constexpr (epi_chains<Epi>::value) keep_acc = E.chain(acc, cur, wr, wc, fr, fq); else E(acc, cur, wr, wc, fr, fq); S.done(cur); }
        if (!has_next) break;
        if (!keep_acc) {
#pragma unroll
        for (int a = 0; a < 2; ++a)
#pragma unroll
            for (int b = 0; b < 2; ++b)
#pragma unroll
                for (int m = 0; m < 4; ++m)
#pragma unroll
                    for (int n = 0; n < 2; ++n) acc[a][b][m][n] = acc_t{};
        }
        cur = nxt; cA = nA; cB = nB; ++ui;
        if constexpr (ALIGN_EPI) { if (wr == 1) PG8_BAR; }
    }
    PG8_WAIT_V(0);
    if constexpr (!ALIGN_EPI) { if (wr == 0) PG8_BAR; }
    PG8_BAR;
    if constexpr (Epi::AFTER_DRAIN) { E.fused(acc, cur, wr, wc, fr, fq, lds, wid, lane); S.done(cur); }
#undef PG8_SA
#undef PG8_SB
#undef PG8_STAGE
#undef PG8_LDA
#undef PG8_LDB
#undef PG8_MMA
#undef PG8_WAIT_V
#undef PG8_WAIT_L
#undef PG8_BAR
#undef PG8_SCHED
}
}
#define GAS __attribute__((address_space(1)))
#define LAS __attribute__((address_space(3)))
typedef unsigned short bf16;
typedef unsigned v4u __attribute__((ext_vector_type(4)));
typedef float f32x4 __attribute__((ext_vector_type(4)));
typedef short bf16x8 __attribute__((ext_vector_type(8)));
typedef GAS unsigned gu32;
typedef GAS unsigned long long gu64;
#define RLX_AGENT __ATOMIC_RELAXED, __HIP_MEMORY_SCOPE_AGENT
#define LDS_WAIT() asm volatile("s_waitcnt lgkmcnt(0)" ::: "memory")
#define VM_WAIT() asm volatile("s_waitcnt vmcnt(0)" ::: "memory")
__device__ __forceinline__ unsigned long long rt() { return __builtin_amdgcn_s_memrealtime(); }
__device__ __forceinline__ unsigned f2bf(float f) { unsigned u = __builtin_bit_cast(unsigned, f); return (u + 0x7fffu + ((u >> 16) & 1u)) >> 16; }
__device__ __forceinline__ unsigned pk2(float lo, float hi) { return f2bf(lo) | (f2bf(hi) << 16); }

#define XB_TMO      128
#define XB_XCNT(j)  (256  + 64 * (j))
#define XB_XSUB(j)  (1280 + 64 * (j))
#define XB_XGEN(j)  (2304 + 64 * (j))
#define XB_TOP      3328
#define XB_TOPGEN   3392
#define XCD_BAR_WORDS 3456
#define XB_SPIN_CAP (1u << 18)

__device__ __forceinline__ unsigned xb_ld(unsigned* p)              { return __hip_atomic_load(p, __ATOMIC_RELAXED, __HIP_MEMORY_SCOPE_AGENT); }
__device__ __forceinline__ unsigned xb_add(unsigned* p, unsigned v) { return __hip_atomic_fetch_add(p, v, __ATOMIC_RELAXED, __HIP_MEMORY_SCOPE_AGENT); }
__device__ __forceinline__ unsigned xb_xcc_id() { return (unsigned)__builtin_amdgcn_s_getreg((3 << 11) | 20) & 0xFu; }
#define XB_SPIN(cond, bar) do { unsigned _sp = 0; while (cond) { __builtin_amdgcn_s_sleep(1); \
    if ((++_sp & 255u) == 0u) { if (xb_ld(&(bar)[XB_TMO])) break; if (_sp > XB_SPIN_CAP) { atomicAdd(&(bar)[XB_TMO], 1u); break; } } } } while (0)

struct XcdBarrier {
    unsigned* bar; unsigned x;
    volatile LAS unsigned* st;
};

__device__ __forceinline__ XcdBarrier xcd_barrier_post(unsigned* bar, volatile LAS unsigned* st) {
    XcdBarrier b; b.bar = bar; b.x = xb_xcc_id(); b.st = st;
    if (threadIdx.x == 0) (void)xb_add(&bar[XB_XCNT(b.x)], 1u);
    return b;
}
__device__ __forceinline__ void xcd_barrier_complete(unsigned* bar, unsigned x, unsigned& nloc, unsigned& nx) {
    const unsigned G = gridDim.x * gridDim.y * gridDim.z;
    unsigned sum, cnt, mine, sp = 0u;
    for (;;) {
        sum = 0u; cnt = 0u; mine = 0u;
#pragma unroll
        for (unsigned j = 0; j < 16; ++j) { const unsigned c = xb_ld(&bar[XB_XCNT(j)]); sum += c; cnt += (c > 0u) ? 1u : 0u; mine = (j == x) ? c : mine; }
        if (sum == G) break;
        __builtin_amdgcn_s_sleep(1);
        if ((++sp & 255u) == 0u) { if (xb_ld(&bar[XB_TMO])) break; if (sp > XB_SPIN_CAP) { atomicAdd(&bar[XB_TMO], 1u); break; } }
    }
    nloc = mine > 0u ? mine : 1u; nx = cnt > 0u ? cnt : 1u;
}

__device__ __forceinline__ void xcd_barrier(const XcdBarrier& b) {
    asm volatile("s_waitcnt vmcnt(0)" ::: "memory");
    __syncthreads();
    if (threadIdx.x == 0) {
        unsigned* bar = b.bar;
        __builtin_amdgcn_s_waitcnt(0);
        unsigned nloc = b.st[0], nx = b.st[1];
        if (nloc == 0u) { xcd_barrier_complete(bar, b.x, nloc, nx); b.st[0] = nloc; b.st[1] = nx; }
        const unsigned old = xb_add(&bar[XB_XSUB(b.x)], 1u);
        const unsigned gen = old / nloc;
        if (old + 1u == (gen + 1u) * nloc) {
            __builtin_amdgcn_fence(__ATOMIC_RELEASE, "agent");
            asm volatile("s_waitcnt vmcnt(0)" ::: "memory");
            const unsigned og = xb_add(&bar[XB_TOP], 1u);
            const unsigned tg = og / nx;
            if (og + 1u == (tg + 1u) * nx) xb_add(&bar[XB_TOPGEN], 1u);
            else XB_SPIN(xb_ld(&bar[XB_TOPGEN]) == tg, bar);
            __builtin_amdgcn_fence(__ATOMIC_ACQUIRE, "agent");
            xb_add(&bar[XB_XGEN(b.x)], 1u);
            asm volatile("s_waitcnt vmcnt(0)" ::: "memory");
        } else {
            XB_SPIN(xb_ld(&bar[XB_XGEN(b.x)]) == gen, bar);
            __builtin_amdgcn_fence(__ATOMIC_ACQUIRE, "agent");
            asm volatile("s_waitcnt vmcnt(0)" ::: "memory");
        }
    }
    __syncthreads();
}

constexpr int NWAVES = 8, NTHREADS = 512;
constexpr int BATCH = 4, SEQ = 2048, D = 2048, M = BATCH * SEQ;
constexpr int NQH = 32, NKVH = 4, HD = 64, QPKV = 8, WINDOW = 128;
constexpr int Q_OFF = 0, K_OFF = 2048, V_OFF = 2304, CB_OFF = 2560, CC_OFF = 4608, CH_OFF = 6656, G_OFF = 8704, IN_W = 12800;
constexpr int PH = 8, PNK = 128, PTOPK = 16, PNE = 16384;
constexpr float LN_EPS = 1e-5f;
constexpr float ALPHA = 1.189207115002721f;

#ifndef MK_PER_PHASE
#define MK_PER_PHASE 0
#endif
constexpr int N_PHASES = 12;

constexpr size_t MiB = 1u << 20;
constexpr size_t WS_CTL = 0, CTL_ZERO_BYTES = 1 * MiB;
constexpr size_t WS_WIN = 1 * MiB;
constexpr size_t WS_WA = 51 * MiB, WS_WC = 59 * MiB, WS_WO = 67 * MiB, WS_WF = 75 * MiB;
constexpr size_t WS_XB = 83 * MiB;
constexpr size_t WS_MERGED = WS_XB;
constexpr size_t WS_Z = 115 * MiB;
constexpr size_t WS_R2B = 115 * MiB;
constexpr size_t WS_H1B = 179 * MiB;
constexpr size_t WS_SC = 211 * MiB;
constexpr size_t WS_EX = 275 * MiB;
constexpr size_t WS_GT = 279 * MiB;
constexpr size_t WS_AO = 315 * MiB, WS_CI = 347 * MiB, WS_TMP = 379 * MiB;
constexpr size_t WS_U8 = 411 * MiB, WS_V8 = 443 * MiB;
constexpr size_t WS_SU = 475 * MiB, WS_SV = WS_SU + 65536;
constexpr size_t WS_PA = WS_SC;
constexpr size_t WS_XQ = 283 * MiB;
constexpr size_t WS_SX = 299 * MiB;
constexpr size_t WS_WB = 380 * MiB;
constexpr size_t WS_ST = 379 * MiB;
constexpr size_t WS_XA8 = WS_XB;
constexpr size_t WS_WIN8 = 476 * MiB;
constexpr size_t WS_SWIN = 501 * MiB, WS_SXA = WS_SWIN + 65536;
constexpr size_t WS_AO8 = 1 * MiB, WS_CI8 = 17 * MiB, WS_WA8 = 33 * MiB, WS_WC8 = 37 * MiB, WS_S3 = 41 * MiB;
constexpr size_t WS_WF8 = 502 * MiB;
constexpr size_t WS_SWF = WS_SXA + 65536;
constexpr size_t WS_MG8 = 1 * MiB;
constexpr size_t WS_WO8 = 506 * MiB;
constexpr size_t WS_SMG = WS_S3 + 262144, WS_SWO = WS_SWF + 16384;
constexpr size_t WS_SEG = 315 * MiB, WS_SOFF = 323 * MiB;
constexpr size_t WS_END = 510 * MiB;
constexpr int CW_Q = 12288;
constexpr size_t SLICE_BYTES = (size_t)PNE * 256;
constexpr int CW_BAR = 4096;

constexpr int RING_BYTES = 131072;
constexpr int LDSCTL_OFF = 163328, MISC_OFF = LDSCTL_OFF + 320;
constexpr int LDS_BYTES = LDSCTL_OFF + 512;

typedef float f32x16 __attribute__((ext_vector_type(16)));
typedef unsigned v2u __attribute__((ext_vector_type(2)));
__device__ __forceinline__ float wave_sum(float v) {
#pragma unroll
    for (int o = 1; o < 64; o <<= 1) v += __shfl_xor(v, o);
    return v;
}
__device__ __forceinline__ float vmaxf(float a, float b) { float r; asm("v_max_f32_e32 %0, %1, %2" : "=v"(r) : "v"(a), "v"(b)); return r; }
__device__ __forceinline__ float vminf(float a, float b) { float r; asm("v_min_f32_e32 %0, %1, %2" : "=v"(r) : "v"(a), "v"(b)); return r; }

__device__ __forceinline__ void p0_transpose_item(const float* W, int K, int N, bf16* WT, LAS float* scr, int item, int lane) {
    const int nblk = N / 32, kb = item / nblk, nb = item % nblk, k0 = 64 * kb, n0 = 32 * nb;
#pragma unroll 8
    for (int i = 0; i < 32; ++i) { const int kk = 2 * i + (lane >> 5); scr[kk * 33 + (lane & 31)] = W[(size_t)(k0 + kk) * N + n0 + (lane & 31)]; }
    LDS_WAIT(); asm volatile("" ::: "memory");
    const int c = lane & 7;
#pragma unroll
    for (int j = 0; j < 4; ++j) { const int n = (lane >> 3) + 8 * j; const LAS float* s = scr + (8 * c) * 33 + n;
        v4u o; o.x = pk2(s[0 * 33], s[1 * 33]); o.y = pk2(s[2 * 33], s[3 * 33]); o.z = pk2(s[4 * 33], s[5 * 33]); o.w = pk2(s[6 * 33], s[7 * 33]);
        *(GAS v4u*)(WT + (size_t)(n0 + n) * K + k0 + 8 * c) = o; }
    LDS_WAIT(); asm volatile("" ::: "memory");
}
__device__ __forceinline__ void p0_wf_item(const float* wq, const float* sk, bf16* WfT, LAS unsigned char* lds, int item, int tid) {
    const int hp = item >> 5, dt = item & 31;
    LAS f32x4* SK4 = (LAS f32x4*)lds;
    LAS f32x4* WQ4 = SK4 + 128 * 33;
    const float* skp = sk + (size_t)hp * 128 * 128;
    for (int i = tid; i < 128 * 32; i += NTHREADS) { const int n = i >> 5, c4 = i & 31; SK4[n * 33 + c4] = *(const f32x4*)(skp + n * 128 + 4 * c4); }
    for (int i = tid; i < 64 * 32; i += NTHREADS) { const int r = i >> 5, c4 = i & 31; WQ4[r * 33 + c4] = *(const f32x4*)(wq + (size_t)(64 * dt + r) * 2048 + hp * 128 + 4 * c4); }
    __syncthreads();
    const int td = tid & 15, tn = tid >> 4;
    float acc[4][4];
#pragma unroll
    for (int i = 0; i < 4; ++i)
#pragma unroll
        for (int j = 0; j < 4; ++j) acc[i][j] = 0.f;
#pragma unroll 4
    for (int c4 = 0; c4 < 32; ++c4) {
        f32x4 a[4], b[4];
#pragma unroll
        for (int i = 0; i < 4; ++i) a[i] = SK4[(4 * tn + i) * 33 + c4];
#pragma unroll
        for (int j = 0; j < 4; ++j) b[j] = WQ4[(td + 16 * j) * 33 + c4];
#pragma unroll
        for (int i = 0; i < 4; ++i)
#pragma unroll
            for (int j = 0; j < 4; ++j) acc[i][j] += a[i].x * b[j].x + a[i].y * b[j].y + a[i].z * b[j].z + a[i].w * b[j].w;
    }
#pragma unroll
    for (int i = 0; i < 4; ++i)
#pragma unroll
        for (int j = 0; j < 4; ++j) WfT[(size_t)(hp * 128 + 4 * tn + i) * 2048 + 64 * dt + td + 16 * j] = (bf16)f2bf(acc[i][j]);
    __syncthreads();
}

__device__ __forceinline__ int perm16(int o) { return 8 * ((o >> 2) & 1) + 4 * (o >> 3) + (o & 3); }
__device__ __forceinline__ void attn_unit(int unit, const bf16* z, bf16* ao, const float* sinks, LAS unsigned char* lds, int tid) {
    const int lane = tid & 63, wid = __builtin_amdgcn_readfirstlane(tid >> 6), r32 = lane & 31, hi = lane >> 5;
    const int nb = unit & 15, kvh = (unit >> 4) & 3, b = unit >> 6;
    LAS bf16* Ks = (LAS bf16*)lds;
    LAS bf16* Vt = (LAS bf16*)(lds + 256 * 144);
    const size_t tok0 = (size_t)b * SEQ;
#pragma unroll
    for (int i = 0; i < 4; ++i) {
        const int ci = tid + NTHREADS * i, key = ci >> 3, dc = ci & 7;
        int kpos = 128 * (nb - 1) + key; if (kpos < 0) kpos = 0;
        const bf16* src = z + (tok0 + kpos) * IN_W + K_OFF + kvh * HD + dc * 8;
        const v4u kv = *(const GAS v4u*)src, vv = *(const GAS v4u*)(src + (V_OFF - K_OFF));
        *(LAS v4u*)(Ks + key * 72 + dc * 8) = kv;
        const int pos = (key & ~15) + perm16(key & 15);
        LAS bf16* vp = Vt + (dc * 8) * 264 + pos;
        vp[0 * 264] = (bf16)(vv.x & 0xffffu); vp[1 * 264] = (bf16)(vv.x >> 16); vp[2 * 264] = (bf16)(vv.y & 0xffffu); vp[3 * 264] = (bf16)(vv.y >> 16);
        vp[4 * 264] = (bf16)(vv.z & 0xffffu); vp[5 * 264] = (bf16)(vv.z >> 16); vp[6 * 264] = (bf16)(vv.w & 0xffffu); vp[7 * 264] = (bf16)(vv.w >> 16);
    }
    __syncthreads();
    const int hq = kvh * QPKV + wid;
    const float LOG2E = 1.4426950408889634f;
    const float sink2 = sinks[hq] * LOG2E, sc = 0.125f * LOG2E;
#pragma unroll 1
    for (int qg = 0; qg < 4; ++qg) {
        const size_t tok = tok0 + 128 * nb + 32 * qg + r32;
        bf16x8 qf[4];
#pragma unroll
        for (int ks = 0; ks < 4; ++ks) qf[ks] = *(const GAS bf16x8*)(z + tok * IN_W + Q_OFF + hq * HD + 16 * ks + 8 * hi);
        f32x16 s[5];
#pragma unroll
        for (int kt = 0; kt < 5; ++kt) {
            s[kt] = (f32x16){0.f, 0.f, 0.f, 0.f, 0.f, 0.f, 0.f, 0.f, 0.f, 0.f, 0.f, 0.f, 0.f, 0.f, 0.f, 0.f};
#pragma unroll
            for (int ks = 0; ks < 4; ++ks) {
                const bf16x8 kf = *(const LAS bf16x8*)(Ks + (32 * (qg + kt) + r32) * 72 + 16 * ks + 8 * hi);
                s[kt] = __builtin_amdgcn_mfma_f32_32x32x16_bf16(kf, qf[ks], s[kt], 0, 0, 0);
            }
        }
        float mx = sink2;
#pragma unroll
        for (int kt = 0; kt < 5; ++kt) {
            const bool tile_dead = (nb == 0) && (qg + kt < 4);
#pragma unroll
            for (int r = 0; r < 16; ++r) {
                const int krow = (r & 3) + 8 * (r >> 2) + 4 * hi;
                bool valid = !tile_dead;
                if (kt == 0) valid = valid && (krow > r32);
                if (kt == 4) valid = valid && (krow <= r32);
                const float v = valid ? s[kt][r] * sc : -INFINITY;
                s[kt][r] = v; mx = fmaxf(mx, v);
            }
        }
        mx = fmaxf(mx, __shfl_xor(mx, 32));
        float sum = 0.f;
#pragma unroll
        for (int kt = 0; kt < 5; ++kt)
#pragma unroll
            for (int r = 0; r < 16; ++r) { const float p = __builtin_amdgcn_exp2f(s[kt][r] - mx); s[kt][r] = p; sum += p; }
        sum += __shfl_xor(sum, 32);
        const float inv = 1.0f / (sum + __builtin_amdgcn_exp2f(sink2 - mx));
        f32x16 o[2];
        o[0] = (f32x16){0.f, 0.f, 0.f, 0.f, 0.f, 0.f, 0.f, 0.f, 0.f, 0.f, 0.f, 0.f, 0.f, 0.f, 0.f, 0.f}; o[1] = o[0];
#pragma unroll
        for (int kt = 0; kt < 5; ++kt)
#pragma unroll
            for (int s2 = 0; s2 < 2; ++s2) {
                v4u pw; pw.x = pg8::cvt_pk_bf16(s[kt][8 * s2 + 0], s[kt][8 * s2 + 1]); pw.y = pg8::cvt_pk_bf16(s[kt][8 * s2 + 2], s[kt][8 * s2 + 3]);
                pw.z = pg8::cvt_pk_bf16(s[kt][8 * s2 + 4], s[kt][8 * s2 + 5]); pw.w = pg8::cvt_pk_bf16(s[kt][8 * s2 + 6], s[kt][8 * s2 + 7]);
                const bf16x8 pa = __builtin_bit_cast(bf16x8, pw);
#pragma unroll
                for (int dt = 0; dt < 2; ++dt) {
                    const bf16x8 vf = *(const LAS bf16x8*)(Vt + (32 * dt + r32) * 264 + 32 * (qg + kt) + 16 * s2 + 8 * hi);
                    o[dt] = __builtin_amdgcn_mfma_f32_32x32x16_bf16(vf, pa, o[dt], 0, 0, 0);
                }
            }
        bf16* op = ao + tok * D + hq * HD;
#pragma unroll
        for (int dt = 0; dt < 2; ++dt)
#pragma unroll
            for (int g = 0; g < 4; ++g) {
                v2u w; w.x = pg8::cvt_pk_bf16(o[dt][4 * g + 0] * inv, o[dt][4 * g + 1] * inv); w.y = pg8::cvt_pk_bf16(o[dt][4 * g + 2] * inv, o[dt][4 * g + 3] * inv);
                *(GAS v2u*)(op + 32 * dt + 8 * g + 4 * hi) = w;
            }
    }
    __syncthreads();
}
__device__ __forceinline__ void conv_item(int item, const bf16* z, const float* cw, bf16* ci, int tid) {
    const int c8 = tid & 255, half = tid >> 8, t0 = 32 * item + 16 * half, c0 = 8 * c8;
    float w0[8], w1[8], w2[8], u1[8], u2[8];
#pragma unroll
    for (int e = 0; e < 8; ++e) { w0[e] = cw[c0 + e]; w1[e] = cw[2048 + c0 + e]; w2[e] = cw[4096 + c0 + e]; u1[e] = 0.f; u2[e] = 0.f; }
    if ((t0 & (SEQ - 1)) != 0) {
#pragma unroll
        for (int k = 0; k < 2; ++k) {
            const bf16* zr = z + (size_t)(t0 - 2 + k) * IN_W + c0;
            const v4u a = *(const GAS v4u*)(zr + CC_OFF), h = *(const GAS v4u*)(zr + CH_OFF);
            float u[8];
            u[0] = pg8::bf_lo(a.x) * pg8::bf_lo(h.x); u[1] = pg8::bf_hi(a.x) * pg8::bf_hi(h.x); u[2] = pg8::bf_lo(a.y) * pg8::bf_lo(h.y); u[3] = pg8::bf_hi(a.y) * pg8::bf_hi(h.y);
            u[4] = pg8::bf_lo(a.z) * pg8::bf_lo(h.z); u[5] = pg8::bf_hi(a.z) * pg8::bf_hi(h.z); u[6] = pg8::bf_lo(a.w) * pg8::bf_lo(h.w); u[7] = pg8::bf_hi(a.w) * pg8::bf_hi(h.w);
#pragma unroll
            for (int e = 0; e < 8; ++e) { if (k == 0) u2[e] = u[e]; else u1[e] = u[e]; }
        }
    }
#pragma unroll 4
    for (int i = 0; i < 16; ++i) {
        const bf16* zr = z + (size_t)(t0 + i) * IN_W + c0;
        const v4u a = *(const GAS v4u*)(zr + CC_OFF), h = *(const GAS v4u*)(zr + CH_OFF), bb = *(const GAS v4u*)(zr + CB_OFF);
        float u[8], cb[8], y[8];
        u[0] = pg8::bf_lo(a.x) * pg8::bf_lo(h.x); u[1] = pg8::bf_hi(a.x) * pg8::bf_hi(h.x); u[2] = pg8::bf_lo(a.y) * pg8::bf_lo(h.y); u[3] = pg8::bf_hi(a.y) * pg8::bf_hi(h.y);
        u[4] = pg8::bf_lo(a.z) * pg8::bf_lo(h.z); u[5] = pg8::bf_hi(a.z) * pg8::bf_hi(h.z); u[6] = pg8::bf_lo(a.w) * pg8::bf_lo(h.w); u[7] = pg8::bf_hi(a.w) * pg8::bf_hi(h.w);
        cb[0] = pg8::bf_lo(bb.x); cb[1] = pg8::bf_hi(bb.x); cb[2] = pg8::bf_lo(bb.y); cb[3] = pg8::bf_hi(bb.y); cb[4] = pg8::bf_lo(bb.z); cb[5] = pg8::bf_hi(bb.z); cb[6] = pg8::bf_lo(bb.w); cb[7] = pg8::bf_hi(bb.w);
#pragma unroll
        for (int e = 0; e < 8; ++e) { y[e] = cb[e] * (w0[e] * u2[e] + w1[e] * u1[e] + w2[e] * u[e]); u2[e] = u1[e]; u1[e] = u[e]; }
        v4u o; o.x = pk2(y[0], y[1]); o.y = pk2(y[2], y[3]); o.z = pk2(y[4], y[5]); o.w = pk2(y[6], y[7]);
        *(GAS v4u*)(ci + (size_t)(t0 + i) * D + c0) = o;
    }
}

__device__ __forceinline__ unsigned pack_i8(const f32x4 v) {
    const int a = __float2int_rn(v.x), b = __float2int_rn(v.y), c = __float2int_rn(v.z), d = __float2int_rn(v.w);
    return ((unsigned)a & 0xffu) | (((unsigned)b & 0xffu) << 8) | (((unsigned)c & 0xffu) << 16) | ((unsigned)d << 24);
}
__device__ __forceinline__ unsigned pack_i8_2(float a, float b, float c, float d) {
    const int ia = __float2int_rn(a), ib = __float2int_rn(b), ic = __float2int_rn(c), id = __float2int_rn(d);
    return ((unsigned)ia & 0xffu) | (((unsigned)ib & 0xffu) << 8) | (((unsigned)ic & 0xffu) << 16) | ((unsigned)id << 24);
}
__device__ __forceinline__ void ln1_row(bf16* hbrow, signed char* xqrow, float* sxp, const float* g, const float* bta, int lane) {
    GAS v4u* xr = (GAS v4u*)hbrow + lane;
    float v[4][8]; float s = 0.f;
#pragma unroll
    for (int j = 0; j < 4; ++j) { const v4u w = xr[64 * j];
        v[j][0] = pg8::bf_lo(w.x); v[j][1] = pg8::bf_hi(w.x); v[j][2] = pg8::bf_lo(w.y); v[j][3] = pg8::bf_hi(w.y); v[j][4] = pg8::bf_lo(w.z); v[j][5] = pg8::bf_hi(w.z); v[j][6] = pg8::bf_lo(w.w); v[j][7] = pg8::bf_hi(w.w);
#pragma unroll
        for (int e = 0; e < 8; ++e) s += v[j][e]; }
    const float mean = wave_sum(s) * (1.f / D); float s2 = 0.f;
#pragma unroll
    for (int j = 0; j < 4; ++j)
#pragma unroll
        for (int e = 0; e < 8; ++e) { v[j][e] -= mean; s2 += v[j][e] * v[j][e]; }
    const float rstd = 1.f / sqrtf(wave_sum(s2) * (1.f / D) + LN_EPS);
    float mx = 0.f;
#pragma unroll
    for (int j = 0; j < 4; ++j) {
        const GAS f32x4* gp = (const GAS f32x4*)g + 2 * (lane + 64 * j); const GAS f32x4* bp = (const GAS f32x4*)bta + 2 * (lane + 64 * j);
        const f32x4 g0 = gp[0], g1 = gp[1], b0 = bp[0], b1 = bp[1];
        v[j][0] = v[j][0] * rstd * g0.x + b0.x; v[j][1] = v[j][1] * rstd * g0.y + b0.y; v[j][2] = v[j][2] * rstd * g0.z + b0.z; v[j][3] = v[j][3] * rstd * g0.w + b0.w;
        v[j][4] = v[j][4] * rstd * g1.x + b1.x; v[j][5] = v[j][5] * rstd * g1.y + b1.y; v[j][6] = v[j][6] * rstd * g1.z + b1.z; v[j][7] = v[j][7] * rstd * g1.w + b1.w;
        v4u o; o.x = pk2(v[j][0], v[j][1]); o.y = pk2(v[j][2], v[j][3]); o.z = pk2(v[j][4], v[j][5]); o.w = pk2(v[j][6], v[j][7]);
        xr[64 * j] = o;
#pragma unroll
        for (int e = 0; e < 8; ++e) mx = fmaxf(mx, fabsf(v[j][e]));
    }
#pragma unroll
    for (int o = 1; o < 64; o <<= 1) mx = fmaxf(mx, __shfl_xor(mx, o));
    const float qs = mx > 0.f ? 127.0f / mx : 1.0f;
    GAS v2u* q8 = (GAS v2u*)xqrow + lane;
#pragma unroll
    for (int j = 0; j < 4; ++j) { v2u o; o.x = pack_i8_2(v[j][0] * qs, v[j][1] * qs, v[j][2] * qs, v[j][3] * qs); o.y = pack_i8_2(v[j][4] * qs, v[j][5] * qs, v[j][6] * qs, v[j][7] * qs); q8[64 * j] = o; }
    if (lane == 0) *sxp = mx > 0.f ? mx * (1.0f / 127.0f) : 1.0f;
}

__device__ __forceinline__ void row_f32_to_i8(const float* src, signed char* dst, float* inv, int lane) {
    f32x4 v[8]; float mx = 0.f;
#pragma unroll
    for (int j = 0; j < 8; ++j) { v[j] = *((const GAS f32x4*)src + lane + 64 * j); mx = fmaxf(mx, fmaxf(fmaxf(fabsf(v[j].x), fabsf(v[j].y)), fmaxf(fabsf(v[j].z), fabsf(v[j].w)))); }
#pragma unroll
    for (int o = 1; o < 64; o <<= 1) mx = fmaxf(mx, __shfl_xor(mx, o));
    const float sc = mx > 0.f ? 127.0f / mx : 1.0f;
#pragma unroll
    for (int j = 0; j < 8; ++j) *((GAS unsigned*)dst + lane + 64 * j) = pack_i8_2(v[j].x * sc, v[j].y * sc, v[j].z * sc, v[j].w * sc);
    if (lane == 0) *inv = mx > 0.f ? mx * (1.0f / 127.0f) : 1.0f;
}
__device__ __forceinline__ void row_bf16_to_i8(const bf16* src, signed char* dst, float* inv, int lane) {
    float v[4][8]; float mx = 0.f;
#pragma unroll
    for (int j = 0; j < 4; ++j) { const v4u w = *((const GAS v4u*)src + lane + 64 * j);
        v[j][0] = pg8::bf_lo(w.x); v[j][1] = pg8::bf_hi(w.x); v[j][2] = pg8::bf_lo(w.y); v[j][3] = pg8::bf_hi(w.y); v[j][4] = pg8::bf_lo(w.z); v[j][5] = pg8::bf_hi(w.z); v[j][6] = pg8::bf_lo(w.w); v[j][7] = pg8::bf_hi(w.w);
#pragma unroll
        for (int e = 0; e < 8; ++e) mx = fmaxf(mx, fabsf(v[j][e])); }
#pragma unroll
    for (int o = 1; o < 64; o <<= 1) mx = fmaxf(mx, __shfl_xor(mx, o));
    const float sc = mx > 0.f ? 127.0f / mx : 1.0f;
#pragma unroll
    for (int j = 0; j < 4; ++j) { v2u o; o.x = pack_i8_2(v[j][0] * sc, v[j][1] * sc, v[j][2] * sc, v[j][3] * sc); o.y = pack_i8_2(v[j][4] * sc, v[j][5] * sc, v[j][6] * sc, v[j][7] * sc); *((GAS v2u*)dst + lane + 64 * j) = o; }
    if (lane == 0) *inv = mx > 0.f ? mx * (1.0f / 127.0f) : 1.0f;
}

constexpr int TK_ROWF = 136;
constexpr int TK_IDX_OFF = 256 * TK_ROWF * 4;
__device__ __forceinline__ void topk_core(LAS unsigned char* lds, size_t prob0, int pstride, int* experts, float* gates, int tid) {
    LAS float* S = (LAS float*)lds;
    LAS unsigned char* IDX = lds + TK_IDX_OFF;
    const int row = tid >> 1, sub = tid & 1;
#define TK_CE(a, b) do { const float h_ = vmaxf(a, b), l_ = vminf(a, b); a = h_; b = l_; } while (0)
#define TK_SORT16(V) do { _Pragma("unroll") for (int k_ = 2; k_ <= 16; k_ <<= 1) _Pragma("unroll") for (int j_ = k_ >> 1; j_ > 0; j_ >>= 1) _Pragma("unroll") for (int i_ = 0; i_ < 16; ++i_) { \
        const int l_i = i_ ^ j_; if (l_i > i_) { if ((i_ & k_) == 0) TK_CE(V[i_], V[l_i]); else TK_CE(V[l_i], V[i_]); } } } while (0)
#define TK_MERGE16(Lv, Xv) do { _Pragma("unroll") for (int j_ = 0; j_ < 16; ++j_) Lv[j_] = vmaxf(Lv[j_], Xv[15 - j_]); \
        _Pragma("unroll") for (int st_ = 8; st_ >= 1; st_ >>= 1) _Pragma("unroll") for (int j_ = 0; j_ < 16; ++j_) if ((j_ & st_) == 0) TK_CE(Lv[j_], Lv[j_ + st_]); } while (0)
    float L[16];
#pragma unroll
    for (int q = 0; q < 4; ++q) {
        float C[16];
#pragma unroll
        for (int i = 0; i < 4; ++i) { const int c4 = 2 * (4 * q + i) + sub;
            const f32x4 v = *(const LAS f32x4*)(S + row * TK_ROWF + 4 * c4);
#pragma unroll
            for (int e = 0; e < 4; ++e) { const float ve = v[e];
                C[4 * i + e] = __uint_as_float((__float_as_uint(ve) & ~0x7Fu) | (unsigned)(4 * c4 + e)); } }
        TK_SORT16(C);
        if (q == 0) {
#pragma unroll
            for (int j = 0; j < 16; ++j) L[j] = C[j];
        } else TK_MERGE16(L, C);
    }
    {
        float P[16];
#pragma unroll
        for (int j = 0; j < 16; ++j) P[j] = __shfl_xor(L[j], 1);
        TK_MERGE16(L, P);
    }
    if (sub == 0) {
#pragma unroll
        for (int q = 0; q < 4; ++q) {
            unsigned w = 0;
#pragma unroll
            for (int e = 0; e < 4; ++e) w |= (__builtin_bit_cast(unsigned, L[4 * q + e]) & 0x7Fu) << (8 * e);
            *(LAS unsigned*)(IDX + row * 16 + 4 * q) = w;
        }
    }
    float A[16], B[16];
#pragma unroll
    for (int j = 0; j < 16; ++j) { const float o = __shfl_xor(L[j], 2); const bool isb = (tid & 2) != 0; A[j] = isb ? o : L[j]; B[j] = isb ? L[j] : o; }
#define TK_KEY(i, j) __uint_as_float((__float_as_uint(A[i] + B[j]) & ~0xFFu) | (unsigned)(255 - ((i) * 16 + (j))))
    float F[16], X[16];
#pragma unroll
    for (int j = 0; j < 16; ++j) F[j] = TK_KEY(0, j);
#pragma unroll
    for (int i = 1; i < 16; ++i) X[i - 1] = TK_KEY(i, 0);
    X[15] = -INFINITY; TK_MERGE16(F, X);
#pragma unroll
    for (int i = 0; i < 16; ++i) X[i] = -INFINITY;
#pragma unroll
    for (int i = 1; i <= 7; ++i) X[i - 1] = TK_KEY(i, 1);
    TK_MERGE16(F, X);
#pragma unroll
    for (int i = 0; i < 16; ++i) X[i] = -INFINITY;
#pragma unroll
    for (int j = 2; j <= 7; ++j) X[j - 2] = TK_KEY(1, j);
    TK_MERGE16(F, X);
    { const float rest[6] = {TK_KEY(2, 2), TK_KEY(2, 3), TK_KEY(2, 4), TK_KEY(3, 2), TK_KEY(3, 3), TK_KEY(4, 2)};
#pragma unroll
      for (int r = 0; r < 6; ++r) { float x = rest[r];
#pragma unroll
          for (int k = 0; k < 16; ++k) { const float h = vmaxf(F[k], x); x = vminf(F[k], x); F[k] = h; } } }
    __syncthreads();
    if ((tid & 3) == 0) {
        const int rowA = (tid >> 2) * 2, rowB = rowA + 1;
        const size_t prob = prob0 + (size_t)pstride * (tid >> 2);
        float g[16]; int ex[16]; float gs = 0.f;
#pragma unroll
        for (int k = 0; k < 16; ++k) {
            const unsigned code = 255u - (__builtin_bit_cast(unsigned, F[k]) & 0xFFu);
            const int ia = IDX[rowA * 16 + (code >> 4)], ib = IDX[rowB * 16 + (code & 15)];
            ex[k] = ia * PNK + ib;
            g[k] = __expf(F[k] - F[0]); gs += g[k];
        }
        const float ginv = 1.0f / gs;
#pragma unroll
        for (int q = 0; q < 4; ++q) {
            *(GAS f32x4*)(gates + prob * 16 + 4 * q) = (f32x4){g[4 * q] * ginv, g[4 * q + 1] * ginv, g[4 * q + 2] * ginv, g[4 * q + 3] * ginv};
            typedef int i32x4 __attribute__((ext_vector_type(4)));
            *(GAS i32x4*)(experts + prob * 16 + 4 * q) = (i32x4){ex[4 * q], ex[4 * q + 1], ex[4 * q + 2], ex[4 * q + 3]};
        }
    }
    __syncthreads();
}
__device__ __forceinline__ void topk_pass(int pass, const float* scores, int* experts, float* gates, LAS unsigned char* lds, int tid) {
    LAS float* S = (LAS float*)lds;
    const float* src = scores + (size_t)pass * (256 * 128);
#pragma unroll 4
    for (int i = 0; i < 16; ++i) { const int f4 = tid + NTHREADS * i, row = f4 >> 5, c4 = f4 & 31; *(LAS f32x4*)(S + row * TK_ROWF + 4 * c4) = *(const GAS f32x4*)(src + (size_t)f4 * 4); }
    __syncthreads();
    topk_core(lds, (size_t)pass * 128, 1, experts, gates, tid);
}
struct EpiTopKI8 {
    static constexpr bool PERM = false, AFTER_DRAIN = true;
    int* experts; float* gates; const float* sa; const float* sb;
    __device__ __forceinline__ void fused(pg8::i32x4 (&acc)[2][2][4][2], const pg8::Unit& u, int wr, int wc, int fr, int fq, LAS unsigned char* lds, int wid, int lane) const {
        LAS float* S = (LAS float*)lds;
        const int tid = wid * 64 + lane;
        pg8::f32x4 sbv[2][2];
#pragma unroll
        for (int bj = 0; bj < 2; ++bj)
#pragma unroll
            for (int n = 0; n < 2; ++n) sbv[bj][n] = *(const GAS pg8::f32x4*)(sb + u.pn * 256 + bj * 128 + 32 * wc + 16 * n + 4 * fq);
#pragma unroll
        for (int ai = 0; ai < 2; ++ai) {
#pragma unroll
            for (int mm = 0; mm < 4; ++mm) { const int rl = 64 * wr + 16 * mm + fr; const float sr = sa[u.pm * 256 + 128 * ai + rl];
#pragma unroll
                for (int bj = 0; bj < 2; ++bj)
#pragma unroll
                    for (int n = 0; n < 2; ++n) { const pg8::i32x4 a = acc[ai][bj][mm][n];
                        *(LAS pg8::f32x4*)(S + (2 * rl + bj) * TK_ROWF + 32 * wc + 16 * n + 4 * fq) = (pg8::f32x4){(float)a[0], (float)a[1], (float)a[2], (float)a[3]} * sbv[bj][n] * sr; } }
            __syncthreads();
            topk_core(lds, ((size_t)u.pm * 256 + 128 * ai) * PH + u.pn, PH, experts, gates, tid);
        }
    }
};
struct EpiTopK {
    static constexpr bool PERM = false, AFTER_DRAIN = true;
    int* experts; float* gates;
    __device__ __forceinline__ void fused(pg8::f32x4 (&acc)[2][2][4][2], const pg8::Unit& u, int wr, int wc, int fr, int fq, LAS unsigned char* lds, int wid, int lane) const {
        LAS float* S = (LAS float*)lds;
        const int tid = wid * 64 + lane;
#pragma unroll
        for (int ai = 0; ai < 2; ++ai) {
#pragma unroll
            for (int bj = 0; bj < 2; ++bj)
#pragma unroll
                for (int mm = 0; mm < 4; ++mm)
#pragma unroll
                    for (int n = 0; n < 2; ++n) { const int rl = 64 * wr + 16 * mm + fr; *(LAS pg8::f32x4*)(S + (2 * rl + bj) * TK_ROWF + 32 * wc + 16 * n + 4 * fq) = acc[ai][bj][mm][n]; }
            __syncthreads();
            topk_core(lds, ((size_t)u.pm * 256 + 128 * ai) * PH + u.pn, PH, experts, gates, tid);
        }
    }
};

__device__ __forceinline__ float gelu_erf(float v) { return 0.5f * v * (1.0f + erff(v * 0.70710678118654752f)); }
typedef __bf16 bf16x2_t __attribute__((ext_vector_type(2)));
typedef float f32x2_t __attribute__((ext_vector_type(2)));
__device__ __forceinline__ float dot2bf(bf16x2_t a, unsigned b, float acc) { return __builtin_amdgcn_fdot2_f32_bf16(a, __builtin_bit_cast(bf16x2_t, b), acc, false); }
__device__ __forceinline__ float dot4f8(unsigned w8, unsigned x01, unsigned x23, float acc) {
    acc = dot2bf(__builtin_amdgcn_cvt_scalef32_pk_bf16_fp8(w8, 1.0f, false), x01, acc);
    return dot2bf(__builtin_amdgcn_cvt_scalef32_pk_bf16_fp8(w8, 1.0f, true), x23, acc);
}
__device__ __forceinline__ void axpy4f8(float* y, unsigned w8, float w) {
    const f32x2_t lo = __builtin_amdgcn_cvt_pk_f32_fp8(w8, false), hi = __builtin_amdgcn_cvt_pk_f32_fp8(w8, true);
    y[0] += w * lo.x; y[1] += w * lo.y; y[2] += w * hi.x; y[3] += w * hi.y;
}
__device__ __forceinline__ void axpy4f8v(f32x2_t* y2, unsigned w8, float w) {
    const f32x2_t lo = __builtin_amdgcn_cvt_pk_f32_fp8(w8, false), hi = __builtin_amdgcn_cvt_pk_f32_fp8(w8, true);
    const f32x2_t ww = {w, w};
    y2[0] = __builtin_elementwise_fma(lo, ww, y2[0]); y2[1] = __builtin_elementwise_fma(hi, ww, y2[1]);
}
__device__ __forceinline__ void row_to_fp8(const float* src, unsigned char* dst, float* inv, int lane) {
    f32x4 v[2][4]; float mx = 0.f;
#pragma unroll
    for (int j = 0; j < 2; ++j)
#pragma unroll
        for (int q = 0; q < 4; ++q) { v[j][q] = *((const GAS f32x4*)src + 4 * (lane + 64 * j) + q);
            mx = fmaxf(mx, fmaxf(fmaxf(fabsf(v[j][q].x), fabsf(v[j][q].y)), fmaxf(fabsf(v[j][q].z), fabsf(v[j][q].w)))); }
#pragma unroll
    for (int o = 1; o < 64; o <<= 1) mx = fmaxf(mx, __shfl_xor(mx, o));
    const float sc = mx > 0.f ? 384.0f / mx : 1.0f;
#pragma unroll
    for (int j = 0; j < 2; ++j) { v4u o;
        int w;
        w = 0; w = __builtin_amdgcn_cvt_pk_fp8_f32(v[j][0].x * sc, v[j][0].y * sc, w, false); w = __builtin_amdgcn_cvt_pk_fp8_f32(v[j][0].z * sc, v[j][0].w * sc, w, true); o.x = (unsigned)w;
        w = 0; w = __builtin_amdgcn_cvt_pk_fp8_f32(v[j][1].x * sc, v[j][1].y * sc, w, false); w = __builtin_amdgcn_cvt_pk_fp8_f32(v[j][1].z * sc, v[j][1].w * sc, w, true); o.y = (unsigned)w;
        w = 0; w = __builtin_amdgcn_cvt_pk_fp8_f32(v[j][2].x * sc, v[j][2].y * sc, w, false); w = __builtin_amdgcn_cvt_pk_fp8_f32(v[j][2].z * sc, v[j][2].w * sc, w, true); o.z = (unsigned)w;
        w = 0; w = __builtin_amdgcn_cvt_pk_fp8_f32(v[j][3].x * sc, v[j][3].y * sc, w, false); w = __builtin_amdgcn_cvt_pk_fp8_f32(v[j][3].z * sc, v[j][3].w * sc, w, true); o.w = (unsigned)w;
        { const int ch = lane + 64 * j; *((GAS v4u*)(dst + (size_t)(ch >> 4) * SLICE_BYTES) + (ch & 15)) = o; } }
    if (lane == 0) *inv = mx > 0.f ? mx * (1.0f / 384.0f) : 1.0f;
}
__device__ __forceinline__ void row_to_i8(const float* src, unsigned char* dst, float* inv, int lane) {
    f32x4 v[2][4]; float mx = 0.f;
#pragma unroll
    for (int j = 0; j < 2; ++j)
#pragma unroll
        for (int q = 0; q < 4; ++q) { v[j][q] = *((const GAS f32x4*)src + 4 * (lane + 64 * j) + q);
            mx = fmaxf(mx, fmaxf(fmaxf(fabsf(v[j][q].x), fabsf(v[j][q].y)), fmaxf(fabsf(v[j][q].z), fabsf(v[j][q].w)))); }
#pragma unroll
    for (int o = 1; o < 64; o <<= 1) mx = fmaxf(mx, __shfl_xor(mx, o));
    const float sc = mx > 0.f ? 127.0f / mx : 1.0f;
#pragma unroll
    for (int j = 0; j < 2; ++j) { v4u o; o.x = pack_i8(v[j][0] * sc); o.y = pack_i8(v[j][1] * sc); o.z = pack_i8(v[j][2] * sc); o.w = pack_i8(v[j][3] * sc);
        { const int ch = lane + 64 * j; *((GAS v4u*)(dst + (size_t)(ch >> 4) * SLICE_BYTES) + (ch & 15)) = o; } }
    if (lane == 0) *inv = mx > 0.f ? mx * (1.0f / 127.0f) : 1.0f;
}
__device__ __forceinline__ float row16_allsum(float a) {
    a += __builtin_bit_cast(float, __builtin_amdgcn_update_dpp(0, __builtin_bit_cast(int, a), 0x128, 0xf, 0xf, false));
    a += __builtin_bit_cast(float, __builtin_amdgcn_update_dpp(0, __builtin_bit_cast(int, a), 0x124, 0xf, 0xf, false));
    a += __builtin_bit_cast(float, __builtin_amdgcn_update_dpp(0, __builtin_bit_cast(int, a), 0x122, 0xf, 0xf, false));
    a += __builtin_bit_cast(float, __builtin_amdgcn_update_dpp(0, __builtin_bit_cast(int, a), 0x121, 0xf, 0xf, false));
    return a;
}
__device__ __forceinline__ int q_pull(unsigned* q, int lane) { int v = 0; if (lane == 0) v = (int)__hip_atomic_fetch_add(q, 1u, __ATOMIC_RELAXED, __HIP_MEMORY_SCOPE_AGENT); return __builtin_amdgcn_readfirstlane(v); }
constexpr int PEER_TG = 8;
constexpr int PEER_N8 = 640, PEER_N4 = 512, PEER_N2 = 512, PEER_NTASK = PEER_N8 + PEER_N4 + PEER_N2;
__device__ __forceinline__ void peer_task_tokens(int idx, int& t0, int& n) {
    if (idx < PEER_N8) { t0 = 8 * idx; n = 8; } else if (idx < PEER_N8 + PEER_N4) { t0 = 8 * PEER_N8 + 4 * (idx - PEER_N8); n = 4; } else { t0 = 8 * PEER_N8 + 4 * PEER_N4 + 2 * (idx - PEER_N8 - PEER_N4); n = 2; }
}
__device__ __forceinline__ int row16_allsum_i(int a) {
    a += __builtin_amdgcn_update_dpp(0, a, 0x128, 0xf, 0xf, false);
    a += __builtin_amdgcn_update_dpp(0, a, 0x124, 0xf, 0xf, false);
    a += __builtin_amdgcn_update_dpp(0, a, 0x122, 0xf, 0xf, false);
    a += __builtin_amdgcn_update_dpp(0, a, 0x121, 0xf, 0xf, false);
    return a;
}
#define PA_LOAD(R, IDV, HALF) do { _Pragma("unroll") for (int i_ = 0; i_ < 8; ++i_) { const unsigned e_ = (unsigned)__shfl(IDV, 4 * (i_ + 8 * (HALF)) + g); \
        R[i_] = *(const GAS v4u*)(ub + (e_ * 256u + offc)); } } while (0)
#define PA_COMP(R, HALF) do { _Pragma("unroll") for (int i_ = 0; i_ < 8; ++i_) { int a_ = __builtin_amdgcn_sdot4((int)R[i_].x, (int)xc.x, 0, false); a_ = __builtin_amdgcn_sdot4((int)R[i_].y, (int)xc.y, a_, false); \
        a_ = __builtin_amdgcn_sdot4((int)R[i_].z, (int)xc.z, a_, false); a_ = __builtin_amdgcn_sdot4((int)R[i_].w, (int)xc.w, a_, false); r16[8 * (HALF) + i_] = row16_allsum_i(a_); } } while (0)
__device__ __forceinline__ void peer_a_task(int t0, int ntok, int s, const signed char* xq, const int* experts, const unsigned char* u8s, int* pa, int lane_) {
    int lane = lane_; asm volatile("" : "+v"(lane));
    const int g = lane >> 4, c = lane & 15;
    const GAS unsigned char* ub = (const GAS unsigned char*)(u8s + (size_t)s * SLICE_BYTES);
    const unsigned offc = 16u * (unsigned)c;
    int idc0 = experts[(size_t)t0 * 128 + lane], idc1 = experts[(size_t)t0 * 128 + lane + 64];
    v4u xc = *(const GAS v4u*)(xq + (size_t)t0 * D + 256 * s + 16 * c);
    v4u RA[8], RB[8];
    PA_LOAD(RA, idc0, 0);
#pragma unroll 1
    for (int tt = 0; tt < ntok; ++tt) {
        const int t = t0 + tt, tn = tt + 1 < ntok ? t + 1 : t;
        const int idn0 = experts[(size_t)tn * 128 + lane], idn1 = experts[(size_t)tn * 128 + lane + 64];
        const v4u xn = *(const GAS v4u*)(xq + (size_t)tn * D + 256 * s + 16 * c);
#pragma unroll 1
        for (int hb = 0; hb < 2; ++hb) {
            const int idv = hb ? idc1 : idc0, idx = hb ? idn0 : idc1;
            int r16[16];
            PA_LOAD(RB, idv, 1); PA_COMP(RA, 0);
            asm volatile("" ::: "memory");
            PA_LOAD(RA, idx, 0); PA_COMP(RB, 1);
            if (c == 15) { typedef int i32x4 __attribute__((ext_vector_type(4))); GAS i32x4* dst = (GAS i32x4*)(pa + ((size_t)t * 8 + s) * 128 + g * 32 + 16 * hb);
#pragma unroll
                for (int q = 0; q < 4; ++q) dst[q] = (i32x4){r16[4 * q], r16[4 * q + 1], r16[4 * q + 2], r16[4 * q + 3]}; }
        }
        idc0 = idn0; idc1 = idn1; xc = xn;
    }
}
constexpr int PA_CH = 56, PA_NCH = (M + PA_CH - 1) / PA_CH, PA_NCH4 = (PA_NCH + 3) & ~3;
constexpr int PA_XT = 131072, PA_XTB = PA_CH * 256, PA_LOFF = PA_XT + 2 * PA_XTB;
static_assert(PA_LOFF + PA_NCH4 * 8 <= LDSCTL_OFF, "LDS map");
__device__ __forceinline__ void peer_shard_load(int s, int r, const unsigned char* u8s, LAS unsigned char* lds, int tid_) {
    int tid = tid_; asm volatile("" : "+v"(tid));
    const GAS unsigned char* src = (const GAS unsigned char*)(u8s + (size_t)s * SLICE_BYTES);
#pragma unroll 1
    for (int h = 0; h < 2; ++h) { v4u t[8];
#pragma unroll
        for (int j = 0; j < 8; ++j) { const int piece = tid + NTHREADS * (8 * h + j), el = piece >> 4, i = el >> 2, jj = ((r - i) & 31) + 32 * (el & 3);
            t[j] = *(const GAS v4u*)(src + ((size_t)(i * 128 + jj) * 256 + (size_t)((piece & 15) << 4))); }
#pragma unroll
        for (int j = 0; j < 8; ++j) *(LAS v4u*)(lds + 16 * (tid + NTHREADS * (8 * h + j))) = t[j]; }
}
__device__ __forceinline__ void peer_bucket(int q, const int* experts, unsigned* seg, int* soff, LAS unsigned char* lds, int tid_) {
    int tid = tid_; asm volatile("" : "+v"(tid));
    LAS int* cnt = (LAS int*)(lds + PA_XT);
    if (tid < 128) cnt[tid] = 0;
    __syncthreads();
    const int ntok = (M - q * PA_CH) < PA_CH ? (M - q * PA_CH) : PA_CH, nent = ntok * 128;
    const GAS int* ex = (const GAS int*)(experts + (size_t)q * PA_CH * 128);
    int ev[14];
#pragma unroll
    for (int j = 0; j < 14; ++j) { const int i = tid + NTHREADS * j; ev[j] = i < nent ? ex[i] : -1; }
#pragma unroll
    for (int j = 0; j < 14; ++j) if (ev[j] >= 0) __hip_atomic_fetch_add(cnt + (((ev[j] >> 7) + ev[j]) & 31), 1, __ATOMIC_RELAXED, __HIP_MEMORY_SCOPE_WORKGROUP);
    __syncthreads();
    if (tid < 64) { const int c = tid < 32 ? cnt[tid] : 0; int inc = c;
#pragma unroll
        for (int o = 1; o < 32; o <<= 1) { const int v = __shfl_up(inc, o); if (tid >= o) inc += v; }
        if (tid < 32) { cnt[32 + tid] = inc - c; soff[q * 33 + tid] = inc - c; if (tid == 31) soff[q * 33 + 32] = inc; } }
    __syncthreads();
    GAS unsigned* sg = (GAS unsigned*)(seg + (size_t)q * (PA_CH * 128));
#pragma unroll
    for (int j = 0; j < 14; ++j) if (ev[j] >= 0) { const int i = tid + NTHREADS * j, e = ev[j], r = ((e >> 7) + e) & 31;
        const int p = cnt[32 + r] + __hip_atomic_fetch_add(cnt + 96 + r, 1, __ATOMIC_RELAXED, __HIP_MEMORY_SCOPE_WORKGROUP);
        sg[p] = ((unsigned)(i >> 7) << 16) | ((unsigned)(i & 127) << 9) | (unsigned)(((e >> 7) << 2) | ((e >> 5) & 3)); }
    __syncthreads();
}
#define PAL_ISSUE(U, X, ENT, XT) do { const unsigned ua_ = ((ENT) & 511u) * 256u + l16, xa_ = (XT) + ((ENT) >> 16) * 256u + l16; \
        _Pragma("unroll") for (int j_ = 0; j_ < 8; ++j_) { U[j_] = *(const LAS v4u*)(ua_ ^ (unsigned)(j_ << 4)); X[j_] = *(const LAS v4u*)(xa_ ^ (unsigned)(j_ << 4)); } } while (0)
#define PAL_DOTS(U, X, ACC) do { int a0_ = 0, a1_ = 0; \
        _Pragma("unroll") for (int j_ = 0; j_ < 8; j_ += 2) { \
            a0_ = __builtin_amdgcn_sdot4((int)U[j_].x, (int)X[j_].x, a0_, false); a1_ = __builtin_amdgcn_sdot4((int)U[j_ + 1].x, (int)X[j_ + 1].x, a1_, false); \
            a0_ = __builtin_amdgcn_sdot4((int)U[j_].y, (int)X[j_].y, a0_, false); a1_ = __builtin_amdgcn_sdot4((int)U[j_ + 1].y, (int)X[j_ + 1].y, a1_, false); \
            a0_ = __builtin_amdgcn_sdot4((int)U[j_].z, (int)X[j_].z, a0_, false); a1_ = __builtin_amdgcn_sdot4((int)U[j_ + 1].z, (int)X[j_ + 1].z, a1_, false); \
            a0_ = __builtin_amdgcn_sdot4((int)U[j_].w, (int)X[j_].w, a0_, false); a1_ = __builtin_amdgcn_sdot4((int)U[j_ + 1].w, (int)X[j_ + 1].w, a1_, false); } \
        a0_ += a1_; ACC = a0_ + __builtin_amdgcn_update_dpp(0, a0_, 0x128, 0xf, 0xf, false); } while (0)
#define PAL_LOAD(Q, XA, XB, EN) do { int q_ = (Q); q_ = q_ < PA_NCH4 ? q_ : PA_NCH4 - 1; const GAS unsigned char* xq_ = xb + (size_t)q_ * (PA_CH * D); \
        XA = *(const GAS v4u*)(xq_ + voff0); XB = *(const GAS v4u*)(xq_ + voff1); EN = sg[(unsigned)(loff[2 * q_] + pidx)]; } while (0)
#define PAL_WRITE(Q, XA, XB) do { const int b_ = PA_XT + ((Q) & 1) * PA_XTB + 16 * tid; *(LAS v4u*)(lds + b_) = XA; if (tid < (PA_CH - 32) * 16) *(LAS v4u*)(lds + b_ + 16 * NTHREADS) = XB; } while (0)
#define PAL_STORE(QQ, E, A) do { const unsigned k_ = ((E) >> 9) & 127u; pa[((size_t)((QQ) * PA_CH + (int)((E) >> 16)) * 8 + s) * 128 + (k_ & 3u) * 32u + (k_ >> 2)] = (A); } while (0)
#define CV_NONE do { } while (0)
#define CV_ISSUE do { if (late && cv_it < 16) { const GAS f32x4* src_ = (const GAS f32x4*)(pv + (size_t)(cv_e0 + cv_it) * D); \
        _Pragma("unroll") for (int j_ = 0; j_ < 2; ++j_) _Pragma("unroll") for (int q_ = 0; q_ < 4; ++q_) cvr[j_][q_] = src_[4 * (lane + 64 * j_) + q_]; } } while (0)
#define CV_FINISH do { if (late && cv_it < 16) { float mx_ = 0.f; \
        _Pragma("unroll") for (int j_ = 0; j_ < 2; ++j_) _Pragma("unroll") for (int q_ = 0; q_ < 4; ++q_) mx_ = fmaxf(mx_, fmaxf(fmaxf(fabsf(cvr[j_][q_].x), fabsf(cvr[j_][q_].y)), fmaxf(fabsf(cvr[j_][q_].z), fabsf(cvr[j_][q_].w)))); \
        _Pragma("unroll") for (int o_ = 1; o_ < 64; o_ <<= 1) mx_ = fmaxf(mx_, __shfl_xor(mx_, o_)); \
        const float sc_ = mx_ > 0.f ? 384.0f / mx_ : 1.0f; const int e_ = cv_e0 + cv_it; \
        _Pragma("unroll") for (int j_ = 0; j_ < 2; ++j_) { v4u o_; int w_; \
            w_ = 0; w_ = __builtin_amdgcn_cvt_pk_fp8_f32(cvr[j_][0].x * sc_, cvr[j_][0].y * sc_, w_, false); w_ = __builtin_amdgcn_cvt_pk_fp8_f32(cvr[j_][0].z * sc_, cvr[j_][0].w * sc_, w_, true); o_.x = (unsigned)w_; \
            w_ = 0; w_ = __builtin_amdgcn_cvt_pk_fp8_f32(cvr[j_][1].x * sc_, cvr[j_][1].y * sc_, w_, false); w_ = __builtin_amdgcn_cvt_pk_fp8_f32(cvr[j_][1].z * sc_, cvr[j_][1].w * sc_, w_, true); o_.y = (unsigned)w_; \
            w_ = 0; w_ = __builtin_amdgcn_cvt_pk_fp8_f32(cvr[j_][2].x * sc_, cvr[j_][2].y * sc_, w_, false); w_ = __builtin_amdgcn_cvt_pk_fp8_f32(cvr[j_][2].z * sc_, cvr[j_][2].w * sc_, w_, true); o_.z = (unsigned)w_; \
            w_ = 0; w_ = __builtin_amdgcn_cvt_pk_fp8_f32(cvr[j_][3].x * sc_, cvr[j_][3].y * sc_, w_, false); w_ = __builtin_amdgcn_cvt_pk_fp8_f32(cvr[j_][3].z * sc_, cvr[j_][3].w * sc_, w_, true); o_.w = (unsigned)w_; \
            const int ch_ = lane + 64 * j_; *((GAS v4u*)(v8 + (size_t)e_ * 256 + (size_t)(ch_ >> 4) * SLICE_BYTES) + (ch_ & 15)) = o_; } \
        if (lane == 0) sv[e_] = mx_ > 0.f ? mx_ * (1.0f / 384.0f) : 1.0f; } } while (0)
#define PAL_STEP(Q, WXA, WXB, CXA, CXB, CEN, HOOK) do { const int q_s = (Q); \
        __syncthreads();                       \
        const unsigned e0_ = CEN; const int nb_s = loff[2 * q_s], n_s = loff[2 * q_s + 1]; const unsigned xt_s = (unsigned)(PA_XT + (q_s & 1) * PA_XTB); \
        PAL_LOAD(q_s + 4, CXA, CXB, CEN);        \
        if (late) { if (pidx < n_prev) { int a_; PAL_DOTS(U, X, a_); if (!(tid & 8)) PAL_STORE(q_s - 1, e_prev, a_); } } \
        _Pragma("unroll 1") for (int i_ = pidx + NTHREADS / 2; i_ < n_s; i_ += NTHREADS / 2) { const unsigned e1_ = sg[nb_s + i_]; PAL_ISSUE(U, X, e1_, xt_s); int a_; PAL_DOTS(U, X, a_); if (!(tid & 8)) PAL_STORE(q_s, e1_, a_); }        \
        PAL_WRITE(q_s + 1, WXA, WXB); \
        if (pidx < n_s) PAL_ISSUE(U, X, e0_, xt_s); \
        __builtin_amdgcn_sched_barrier(0); \
        if (!late) { if (pidx < n_s) { int a_; PAL_DOTS(U, X, a_); if (!(tid & 8)) PAL_STORE(q_s, e0_, a_); } } \
        HOOK; \
        e_prev = e0_; n_prev = n_s; \
    } while (0)
__device__ __forceinline__ void peer_a_lds(int s, const signed char* xq, const unsigned* seg, const int* soff, int r, int* pa, LAS unsigned char* lds, int tid_, const float* pv, unsigned char* v8, float* sv, int cv_e0) {
    int tid = tid_; asm volatile("" : "+v"(tid));
    const unsigned l16 = (unsigned)(tid & 15) << 4;
    const int pidx = (tid >> 4) * 8 + (tid & 7);
    const bool late = __builtin_amdgcn_readfirstlane(tid >> 8) != 0;
    const int lane = tid & 63; cv_e0 += (__builtin_amdgcn_readfirstlane(tid >> 6) & 3) * 16; f32x4 cvr[2][4]; int cv_it = 0;
#pragma unroll
    for (int j = 0; j < 2; ++j)
#pragma unroll
        for (int q = 0; q < 4; ++q) cvr[j][q] = (f32x4){0.f, 0.f, 0.f, 0.f};
    LAS int* loff = (LAS int*)(lds + PA_LOFF);
    if (tid < PA_NCH4) { int b = 0, e = 0; if (tid < PA_NCH) { b = soff[tid * 33 + r]; e = soff[tid * 33 + r + 1]; } loff[2 * tid] = tid * (PA_CH * 128) + b; loff[2 * tid + 1] = e - b; }
    __syncthreads();
    const GAS unsigned char* xb = (const GAS unsigned char*)(xq + 256 * s);
    const GAS unsigned* sg = (const GAS unsigned*)seg;
    const unsigned voff0 = (unsigned)(tid >> 4) * (unsigned)D + l16, voff1 = voff0 + ((tid >> 4) < PA_CH - 32 ? 32u * (unsigned)D : 0u);
    v4u x0a, x0b, x1a, x1b, x2a, x2b, x3a, x3b; unsigned en0, en1, en2, en3;
    v4u U[8], X[8]; unsigned e_prev = 0u; int n_prev = 0;
#pragma unroll
    for (int j = 0; j < 8; ++j) { U[j] = X[j] = (v4u){0u, 0u, 0u, 0u}; }
    PAL_LOAD(0, x0a, x0b, en0); PAL_LOAD(1, x1a, x1b, en1); PAL_LOAD(2, x2a, x2b, en2); PAL_LOAD(3, x3a, x3b, en3);
    PAL_WRITE(0, x0a, x0b);
#pragma unroll 1
    for (int q0 = 0; q0 < PA_NCH4; q0 += 4) {
        PAL_STEP(q0, x1a, x1b, x0a, x0b, en0, CV_ISSUE);
        PAL_STEP(q0 + 1, x2a, x2b, x1a, x1b, en1, CV_NONE);
        PAL_STEP(q0 + 2, x3a, x3b, x2a, x2b, en2, CV_FINISH);
        PAL_STEP(q0 + 3, x0a, x0b, x3a, x3b, en3, CV_NONE);
        ++cv_it;
    }
    __syncthreads();
}
__device__ __forceinline__ void peer_w_elem(size_t i, const int* experts, const float* gates, const float* su, const float* sv, const float* sx, const int* pa, float* wb) {
    const size_t t = i >> 7; const int k = (int)(i & 127), pos = (k & 3) * 32 + (k >> 2);
    const int e = experts[i];
    int a = 0;
#pragma unroll
    for (int s2 = 0; s2 < 8; ++s2) a += pa[(t * 8 + s2) * 128 + pos];
    wb[i] = gates[i] * gelu_erf((float)a * (su[e] * sx[t])) * sv[e];
}
#define PB_LOAD(R, IDV, HALF) do { _Pragma("unroll") for (int i_ = 0; i_ < 8; ++i_) { const unsigned e_ = (unsigned)__shfl(IDV, 4 * (i_ + 8 * (HALF)) + g); \
        R[i_] = *(const GAS v4u*)(vb + (e_ * 256u + offc)); } } while (0)
#define PB_COMP(R, WV, HALF) do { _Pragma("unroll") for (int i_ = 0; i_ < 8; ++i_) { const float wk_ = __shfl(WV, 4 * (i_ + 8 * (HALF)) + g); \
        axpy4f8v(&ya2[0], R[i_].x, wk_); axpy4f8v(&ya2[2], R[i_].y, wk_); axpy4f8v(&ya2[4], R[i_].z, wk_); axpy4f8v(&ya2[6], R[i_].w, wk_); } } while (0)
__device__ __forceinline__ void peer_b_task(int t0, int ntok, int s, const bf16* h1, const int* experts, const float* wb, const unsigned char* v8s, bf16* out, float* st, int lane_) {
    int lane = lane_; asm volatile("" : "+v"(lane));
    const int g = lane >> 4, c = lane & 15;
    const GAS unsigned char* vb = (const GAS unsigned char*)(v8s + (size_t)s * SLICE_BYTES);
    const unsigned offc = 16u * (unsigned)c;
    int idc0 = experts[(size_t)t0 * 128 + lane], idc1 = experts[(size_t)t0 * 128 + lane + 64];
    float wc0 = wb[(size_t)t0 * 128 + lane], wc1 = wb[(size_t)t0 * 128 + lane + 64];
    v4u RA[8], RB[8];
    PB_LOAD(RA, idc0, 0);
#pragma unroll 1
    for (int tt = 0; tt < ntok; ++tt) {
        const int t = t0 + tt, tn = tt + 1 < ntok ? t + 1 : t;
        const int idn0 = experts[(size_t)tn * 128 + lane], idn1 = experts[(size_t)tn * 128 + lane + 64];
        const float wn0 = wb[(size_t)tn * 128 + lane], wn1 = wb[(size_t)tn * 128 + lane + 64];
        f32x2_t ya2[8];
#pragma unroll
        for (int e = 0; e < 8; ++e) ya2[e] = (f32x2_t){0.f, 0.f};
#pragma unroll 1
        for (int hb = 0; hb < 2; ++hb) {
            const int idv = hb ? idc1 : idc0, idx = hb ? idn0 : idc1; const float wv = hb ? wc1 : wc0;
            PB_LOAD(RB, idv, 1); PB_COMP(RA, wv, 0);
            asm volatile("" ::: "memory");
            PB_LOAD(RA, idx, 0); PB_COMP(RB, wv, 1);
        }
        float ya[16];
#pragma unroll
        for (int e = 0; e < 8; ++e) { ya[2 * e] = ya2[e].x; ya[2 * e + 1] = ya2[e].y; }
#pragma unroll
        for (int e = 0; e < 16; ++e) { ya[e] += __shfl_xor(ya[e], 16); ya[e] += __shfl_xor(ya[e], 32); }
        const GAS v4u* hp = (const GAS v4u*)(h1 + (size_t)t * D + 256 * s + 16 * c);
        const v4u h0 = hp[0], h1v = hp[1];
        float hx[16];
        hx[0] = pg8::bf_lo(h0.x); hx[1] = pg8::bf_hi(h0.x); hx[2] = pg8::bf_lo(h0.y); hx[3] = pg8::bf_hi(h0.y); hx[4] = pg8::bf_lo(h0.z); hx[5] = pg8::bf_hi(h0.z); hx[6] = pg8::bf_lo(h0.w); hx[7] = pg8::bf_hi(h0.w);
        hx[8] = pg8::bf_lo(h1v.x); hx[9] = pg8::bf_hi(h1v.x); hx[10] = pg8::bf_lo(h1v.y); hx[11] = pg8::bf_hi(h1v.y); hx[12] = pg8::bf_lo(h1v.z); hx[13] = pg8::bf_hi(h1v.z); hx[14] = pg8::bf_lo(h1v.w); hx[15] = pg8::bf_hi(h1v.w);
        float sm = 0.f, sq = 0.f;
#pragma unroll
        for (int e = 0; e < 16; ++e) { ya[e] = hx[e] * ALPHA + ya[e]; sm += ya[e]; sq += ya[e] * ya[e]; }
        sm = row16_allsum(sm); sq = row16_allsum(sq);
        if (g == 0) { GAS v4u* op = (GAS v4u*)(out + (size_t)t * D + 256 * s + 16 * c);
            v4u o0, o1; o0.x = pk2(ya[0], ya[1]); o0.y = pk2(ya[2], ya[3]); o0.z = pk2(ya[4], ya[5]); o0.w = pk2(ya[6], ya[7]);
            o1.x = pk2(ya[8], ya[9]); o1.y = pk2(ya[10], ya[11]); o1.z = pk2(ya[12], ya[13]); o1.w = pk2(ya[14], ya[15]);
            op[0] = o0; op[1] = o1;
            if (c == 0) { st[((size_t)t * 8 + s) * 2] = sm; st[((size_t)t * 8 + s) * 2 + 1] = sq; } }
        idc0 = idn0; idc1 = idn1; wc0 = wn0; wc1 = wn1;
    }
}
__device__ __forceinline__ void peer_c_row(int t, const bf16* r2, float* out, const float* st, const float* g2, const float* b2, int lane) {
    float sm = 0.f, sq = 0.f;
#pragma unroll
    for (int s = 0; s < 8; ++s) { sm += st[((size_t)t * 8 + s) * 2]; sq += st[((size_t)t * 8 + s) * 2 + 1]; }
    const float mean = sm * (1.f / D), var = sq * (1.f / D) - mean * mean, rstd = 1.f / sqrtf(fmaxf(var, 0.f) + LN_EPS);
    const GAS v4u* xr = (const GAS v4u*)(r2 + (size_t)t * D) + lane;
    GAS f32x4* op = (GAS f32x4*)(out + (size_t)t * D);
#pragma unroll
    for (int j = 0; j < 4; ++j) { const v4u w = xr[64 * j]; const int c4 = 2 * (lane + 64 * j);
        const f32x4 g0 = *((const GAS f32x4*)g2 + c4), g1 = *((const GAS f32x4*)g2 + c4 + 1), b0 = *((const GAS f32x4*)b2 + c4), b1 = *((const GAS f32x4*)b2 + c4 + 1);
        const f32x4 v0 = (f32x4){pg8::bf_lo(w.x), pg8::bf_hi(w.x), pg8::bf_lo(w.y), pg8::bf_hi(w.y)}, v1 = (f32x4){pg8::bf_lo(w.z), pg8::bf_hi(w.z), pg8::bf_lo(w.w), pg8::bf_hi(w.w)};
        op[c4] = (v0 - mean) * rstd * g0 + b0; op[c4 + 1] = (v1 - mean) * rstd * g1 + b1; }
}

struct TwoPassOrder : pg8::StaticOrder {
    __device__ __forceinline__ bool next(int i, pg8::Unit& u) const { if (!pg8::StaticOrder::next(i >> 1, u)) return false; u.w = i & 1; return true; }
};
struct EpiGate2 {
    static constexpr bool PERM = true, AFTER_DRAIN = false;
    pg8::EpiGate<0> e0; pg8::EpiGate<1> e1;
    __device__ __forceinline__ void operator()(const pg8::f32x4 (&acc)[2][2][4][2], const pg8::Unit& u, int wr, int wc, int fr, int fq) const { if (u.w == 0) e0(acc, u, wr, wc, fr, fq); else e1(acc, u, wr, wc, fr, fq); }
};

struct EpiGate2I8 {
    static constexpr bool PERM = true, AFTER_DRAIN = false;
    pg8::EpiGateI8<0> e0; pg8::EpiGateI8<1> e1;
    __device__ __forceinline__ void operator()(const pg8::i32x4 (&acc)[2][2][4][2], const pg8::Unit& u, int wr, int wc, int fr, int fq) const { if (u.w == 0) e0(acc, u, wr, wc, fr, fq); else e1(acc, u, wr, wc, fr, fq); }
};
struct ConvOrder : pg8::StaticOrder {
    const float* pu; const float* pv; unsigned char* u8; unsigned char* v8; float* su; float* sv; int slot; mutable int calls;
    static constexpr int CONV_ROWS = 2, CONV_CALLS = 6;
    __device__ __forceinline__ void done(const pg8::Unit&) const {
        if (slot < 0) return;
        int lane = threadIdx.x & 63; asm volatile("" : "+v"(lane));
        const int wave = __builtin_amdgcn_readfirstlane(threadIdx.x >> 6);
        const int base = ((slot * NWAVES + wave) * CONV_CALLS + calls) * CONV_ROWS;
        if (calls < CONV_CALLS) {
#pragma unroll 1
            for (int j = 0; j < CONV_ROWS; ++j) { const int r = base + j; if (r < PNE) row_to_i8(pu + (size_t)r * D, u8 + (size_t)r * 256, su + r, lane); }
        }
        ++calls;
    }
};

struct Args { const float* in[16]; float* out; unsigned char* ws; int ph_lo, ph_hi; };
__global__ void __launch_bounds__(NTHREADS, 2) mk_fwd(Args args) {
    extern __shared__ __attribute__((aligned(16))) unsigned char lds_raw[];
    LAS unsigned char* lds = (LAS unsigned char*)lds_raw;
    volatile LAS unsigned* MISC = (volatile LAS unsigned*)(lds + MISC_OFF);
    const int tid0 = threadIdx.x;
    const int G = gridDim.x, bx = blockIdx.x;
    unsigned char* ws = args.ws;
    gu32* ctl = (gu32*)(ws + WS_CTL);
#define IN_(i) (args.in[i])
#define x_in IN_(0)
#define w_in IN_(1)
#define b_gate IN_(2)
#define sinks IN_(3)
#define conv_w IN_(4)
#define w_ao IN_(5)
#define w_co IN_(6)
#define w_o IN_(7)
#define ln1_g IN_(8)
#define ln1_b IN_(9)
#define w_q IN_(10)
#define sub_keys IN_(11)
#define peer_u IN_(12)
#define peer_v IN_(13)
#define ln2_g IN_(14)
#define ln2_b IN_(15)
#define WinT ((bf16*)(ws + WS_WIN))
#define WaT ((bf16*)(ws + WS_WA))
#define WcT ((bf16*)(ws + WS_WC))
#define WoT ((bf16*)(ws + WS_WO))
#define WfT ((bf16*)(ws + WS_WF))
#define XB ((bf16*)(ws + WS_XB))
#define MERGED ((bf16*)(ws + WS_MERGED))
#define Z ((bf16*)(ws + WS_Z))
#define R2B ((bf16*)(ws + WS_R2B))
#define H1B ((bf16*)(ws + WS_H1B))
#define SC ((float*)(ws + WS_SC))
#define EX ((int*)(ws + WS_EX))
#define GT ((float*)(ws + WS_GT))
#define AO ((bf16*)(ws + WS_AO))
#define CI ((bf16*)(ws + WS_CI))
#define TMP ((bf16*)(ws + WS_TMP))
#define U8 ((unsigned char*)(ws + WS_U8))
#define V8 ((unsigned char*)(ws + WS_V8))
#define SU ((float*)(ws + WS_SU))
#define SV ((float*)(ws + WS_SV))
#define PA ((int*)(ws + WS_PA))
#define ST ((float*)(ws + WS_ST))
#define WB ((float*)(ws + WS_WB))
#define XA8 ((signed char*)(ws + WS_XA8))
#define WIN8 ((signed char*)(ws + WS_WIN8))
#define SWIN ((float*)(ws + WS_SWIN))
#define SXA ((float*)(ws + WS_SXA))
#define WF8 ((signed char*)(ws + WS_WF8))
#define MG8 ((signed char*)(ws + WS_MG8))
#define WO8 ((signed char*)(ws + WS_WO8))
#define SMG ((float*)(ws + WS_SMG))
#define SWO ((float*)(ws + WS_SWO))
#define AO8 ((signed char*)(ws + WS_AO8))
#define CI8 ((signed char*)(ws + WS_CI8))
#define WA8 ((signed char*)(ws + WS_WA8))
#define WC8 ((signed char*)(ws + WS_WC8))
#define SAO ((float*)(ws + WS_S3))
#define SCI ((float*)(ws + WS_S3 + 65536))
#define SWA ((float*)(ws + WS_S3 + 131072))
#define SWC ((float*)(ws + WS_S3 + 196608))
#define SWF ((float*)(ws + WS_SWF))
#define XQ ((signed char*)(ws + WS_XQ))
#define SX ((float*)(ws + WS_SX))
#define SEG ((unsigned*)(ws + WS_SEG))
#define SOFF ((int*)(ws + WS_SOFF))
    for (int u = tid0; u < (LDS_BYTES - LDSCTL_OFF) / 4; u += NTHREADS) ((LAS unsigned*)(lds + LDSCTL_OFF))[u] = 0u;
    __syncthreads();
    XcdBarrier bar; bar.bar = (unsigned*)(ctl + CW_BAR); bar.x = 0; bar.st = nullptr;
    if (!MK_PER_PHASE) bar = xcd_barrier_post((unsigned*)(ctl + CW_BAR), MISC + 8);
    const int lo = args.ph_lo, hi = args.ph_hi;
#ifndef PH_MASK
#define PH_MASK 0xFFF
#endif
#define IN(k) (((PH_MASK >> (k)) & 1) && lo <= (k) && (k) < hi)
#ifndef DBL_BAR
#define DBL_BAR 0
#endif
#define SEAM(k) do { if (IN(k) && IN((k) + 1)) { xcd_barrier(bar); if (DBL_BAR) xcd_barrier(bar); } } while (0)
#ifndef DBL_MASK
#define DBL_MASK 0
#endif
#define REP(k) for (int rep_ = 0; rep_ < 1 + ((DBL_MASK >> (k)) & 1); ++rep_)
#define PHASE_TID() int tid = tid0; asm volatile("" : "+v"(tid)); const int lane = tid & 63, wave = __builtin_amdgcn_readfirstlane(tid >> 6); (void)lane; (void)wave

    if (IN(0)) REP(0) {
        PHASE_TID();
        const bool conv_first = ((bx >> 3) & 1) == 0;
#pragma unroll 1
        for (int part = 0; part < 2; ++part) {
            if ((part == 0) == conv_first) {
                int tid = tid0; asm volatile("" : "+v"(tid)); const int lane = tid & 63, wave = __builtin_amdgcn_readfirstlane(tid >> 6);
                LAS float* scr = (LAS float*)(lds + wave * 16384);
                const int gw = bx * NWAVES + wave, NGW = G * NWAVES;
                constexpr int I_IN = (D / 64) * (IN_W / 32), I_SQ = (D / 64) * (D / 32);
                for (int it = gw; it < I_IN + 3 * I_SQ; it += NGW) {
                    int r = it;
                    if (r < I_IN) { p0_transpose_item(w_in, D, IN_W, WinT, scr, r, lane); continue; } r -= I_IN;
                    if (r < I_SQ) { p0_transpose_item(w_ao, D, D, WaT, scr, r, lane); continue; } r -= I_SQ;
                    if (r < I_SQ) { p0_transpose_item(w_co, D, D, WcT, scr, r, lane); continue; } r -= I_SQ;
                    p0_transpose_item(w_o, D, D, WoT, scr, r, lane);
                }
                for (int r = gw; r < M; r += NGW) row_f32_to_i8(x_in + (size_t)r * D, XA8 + (size_t)r * D, SXA + r, lane);
                __syncthreads();
            }
            if (part == 0) for (int it = bx; it < 16 * 32; it += G) p0_wf_item(w_q, sub_keys, WfT, lds, it, tid);
        }
    }
    SEAM(0);
    if (IN(1)) REP(1) {
        { PHASE_TID();
          for (int r = bx * NWAVES + wave; r < IN_W + 2 * D; r += G * NWAVES) { if (r < IN_W) row_bf16_to_i8(WinT + (size_t)r * D, WIN8 + (size_t)r * D, SWIN + r, lane);
              else if (r < IN_W + D) { const int q = r - IN_W; row_bf16_to_i8(WfT + (size_t)q * D, WF8 + (size_t)q * D, SWF + q, lane); }
              else { const int q = r - IN_W - D; row_bf16_to_i8(WoT + (size_t)q * D, WO8 + (size_t)q * D, SWO + q, lane); } } }
        if (!MK_PER_PHASE) xcd_barrier(bar);
        pg8::Gemm g{(const bf16*)XA8, (const bf16*)WIN8, M, IN_W, D / 2}; ConvOrder S; S.init(M, IN_W, G, bx);
        S.pu = peer_u; S.pv = peer_v; S.u8 = U8; S.v8 = V8; S.su = SU; S.sv = SV; S.calls = 0;
        S.slot = (G == 256 && bx >= 64) ? bx - 64 : -1;
        pg8::EpiI8Bf16 E{Z, IN_W, SXA, SWIN};
        pg8::gemm_phase<pg8::EpiI8Bf16, ConvOrder, true, true, true>(lds, g, S, E);
        if (G != 256) {
            PHASE_TID();
            for (int r = bx * NWAVES + wave; r < 2 * PNE; r += G * NWAVES) { const bool sec = r >= PNE; const int e = sec ? r - PNE : r;
                if (sec) row_to_fp8(peer_v + (size_t)e * D, V8 + (size_t)e * 256, SV + e, lane); else row_to_i8(peer_u + (size_t)e * D, U8 + (size_t)e * 256, SU + e, lane); }
        }
    }
    SEAM(1);
    if (IN(2)) REP(2) {
        PHASE_TID();
        const bool conv_first = ((bx >> 3) & 1) == 0;
#pragma unroll 1
        for (int part = 0; part < 2; ++part) {
            if ((part == 0) == conv_first) { int t2 = tid0; asm volatile("" : "+v"(t2)); for (int it = bx; it < M / 32; it += G) conv_item(it, Z, conv_w, CI, t2); }
            if (part == 0) for (int u = bx; u < BATCH * NKVH * 16; u += G) attn_unit(u, Z, AO, sinks, lds, tid);
        }
    }
    SEAM(2);
    if (IN(3)) REP(3) {
        TwoPassOrder S; S.init(M, D, G, bx);
#ifndef P3_I8
#define P3_I8 1
#endif
        if (P3_I8 && !MK_PER_PHASE) {
            { PHASE_TID();
              for (int r = bx * NWAVES + wave; r < 2 * M + 2 * D; r += G * NWAVES) {
                  if (r < M) row_bf16_to_i8(AO + (size_t)r * D, AO8 + (size_t)r * D, SAO + r, lane);
                  else if (r < 2 * M) { const int q = r - M; row_bf16_to_i8(CI + (size_t)q * D, CI8 + (size_t)q * D, SCI + q, lane); }
                  else if (r < 2 * M + D) { const int q = r - 2 * M; row_bf16_to_i8(WaT + (size_t)q * D, WA8 + (size_t)q * D, SWA + q, lane); }
                  else { const int q = r - 2 * M - D; row_bf16_to_i8(WcT + (size_t)q * D, WC8 + (size_t)q * D, SWC + q, lane); } } }
            xcd_barrier(bar);
            pg8::Gemm g{(const bf16*)AO8, (const bf16*)WA8, M, D, D / 2, (const bf16*)CI8, (const bf16*)WC8};
            EpiGate2I8 E{pg8::EpiGateI8<0>{TMP, nullptr, Z + G_OFF, b_gate, D, IN_W, SAO, SWA}, pg8::EpiGateI8<1>{MERGED, TMP, Z + G_OFF + D, b_gate + D, D, IN_W, SCI, SWC}};
            pg8::gemm_phase<EpiGate2I8, TwoPassOrder, true, true, true>(lds, g, S, E);
        } else {
        pg8::Gemm g{AO, WaT, M, D, D, CI, WcT};
        EpiGate2 E{pg8::EpiGate<0>{TMP, nullptr, Z + G_OFF, b_gate, D, IN_W}, pg8::EpiGate<1>{MERGED, TMP, Z + G_OFF + D, b_gate + D, D, IN_W}};
        pg8::gemm_phase<EpiGate2, TwoPassOrder, true, true>(lds, g, S, E);
        }
    }
    SEAM(3);
    if (IN(4)) REP(4) {
        pg8::StaticOrder S; S.init(M, D, G, bx);
#ifndef P4_I8
#define P4_I8 1
#endif
        if (P4_I8 && !MK_PER_PHASE) {
            { PHASE_TID(); for (int r = bx * NWAVES + wave; r < M; r += G * NWAVES) row_bf16_to_i8(MERGED + (size_t)r * D, MG8 + (size_t)r * D, SMG + r, lane); }
            xcd_barrier(bar);
            pg8::Gemm g{(const bf16*)MG8, (const bf16*)WO8, M, D, D / 2};
            pg8::EpiResI8Bf16 E{H1B, D, x_in, ALPHA, SMG, SWO};
            pg8::gemm_phase<pg8::EpiResI8Bf16, pg8::StaticOrder, true, true, true>(lds, g, S, E);
        } else {
        pg8::Gemm g{MERGED, WoT, M, D, D};
        pg8::EpiResBf16 E{H1B, D, x_in, ALPHA};
        pg8::gemm_phase<pg8::EpiResBf16, pg8::StaticOrder, true, true>(lds, g, S, E);
        }
    }
    SEAM(4);
    if (IN(5)) REP(5) {
        PHASE_TID();
        const int gw = bx * NWAVES + wave, NGW = G * NWAVES;
        for (int m = gw; m < M; m += NGW) ln1_row(H1B + (size_t)m * D, XQ + (size_t)m * D, SX + m, ln1_g, ln1_b, lane);
    }
    SEAM(5);
    if (IN(6)) REP(6) {
        pg8::Gemm g{H1B, WfT, M, D, D}; pg8::StaticOrder S; S.init(M, D, G, bx);
#ifndef P6_I8
#define P6_I8 1
#endif
        if (G == 256 && P6_I8) { pg8::Gemm g8{(const bf16*)XQ, (const bf16*)WF8, M, D, D / 2}; EpiTopKI8 E{EX, GT, SX, SWF}; pg8::gemm_phase<EpiTopKI8, pg8::StaticOrder, false, true, true>(lds, g8, S, E); }
        else if (G == 256) { EpiTopK E{EX, GT}; pg8::gemm_phase<EpiTopK, pg8::StaticOrder, false, true>(lds, g, S, E); }
        else { pg8::EpiF32 E{SC, D, nullptr, 0.f}; pg8::gemm_phase<pg8::EpiF32, pg8::StaticOrder, true, true>(lds, g, S, E); }
    }
    SEAM(6);
    if (IN(7)) REP(7) {
        PHASE_TID();
        if (G != 256) for (int p = bx; p < (M * PH) / 128; p += G) topk_pass(p, SC, EX, GT, lds, tid);
        else { peer_shard_load(bx & 7, bx >> 3, U8, lds, tid);
               if (bx < PA_NCH) peer_bucket(bx, EX, SEG, SOFF, lds, tid); }
    }
    SEAM(7);
    if (IN(8)) REP(8) {
        PHASE_TID();
        if (G == 256) peer_a_lds(bx & 7, XQ, SEG, SOFF, bx >> 3, PA, lds, tid, peer_v, V8, SV, bx * 64);
        else {
        const int xcc = (int)(xb_xcc_id() & 7u);
#pragma unroll 1
#ifndef SCRAMBLE
#define SCRAMBLE 0
#endif
        for (int sl = 0; sl < 8; ++sl) { const int s = (xcc + sl + (SCRAMBLE ? wave : 0)) & 7;
            for (;;) { const int tg = q_pull((unsigned*)(ctl + CW_Q + 64 * (s + 16 * rep_)), lane); if (tg >= PEER_NTASK) break;
                int t0, nt; peer_task_tokens(tg, t0, nt); peer_a_task(t0, nt, s, XQ, EX, U8, PA, lane); } }
        }
    }
    SEAM(8);
    if (IN(9)) REP(9) {
        PHASE_TID();
        for (size_t i = (size_t)bx * NTHREADS + tid; i < (size_t)M * 128; i += (size_t)G * NTHREADS) peer_w_elem(i, EX, GT, SU, SV, SX, PA, WB);
    }
    SEAM(9);
    if (IN(10)) REP(10) {
        PHASE_TID();
        const int xcc = (int)(xb_xcc_id() & 7u);
#pragma unroll 1
#ifndef SCRAMBLE
#define SCRAMBLE 0
#endif
        for (int sl = 0; sl < 8; ++sl) { const int s = (xcc + sl + (SCRAMBLE ? wave : 0)) & 7;
            for (;;) { const int tg = q_pull((unsigned*)(ctl + CW_Q + 64 * (8 + s + 16 * rep_)), lane); if (tg >= PEER_NTASK) break;
                int t0, nt; peer_task_tokens(tg, t0, nt); peer_b_task(t0, nt, s, H1B, EX, WB, V8, R2B, ST, lane); } }
    }
    SEAM(10);
    if (IN(11)) REP(11) {
        PHASE_TID();
        const int gw = bx * NWAVES + wave, NGW = G * NWAVES;
        for (int t = gw; t < M; t += NGW) peer_c_row(t, R2B, args.out, ST, ln2_g, ln2_b, lane);
    }
#undef IN
#undef SEAM
}

extern "C" void kernel_launch(void* const* d_in, const int* in_sizes, int n_in, void* d_out, int out_size, void* d_ws, size_t ws_size, hipStream_t stream) {
    static int grid = 0;
    if (grid == 0) {
        if (n_in != 16 || out_size != M * D || ws_size < WS_END) { fprintf(stderr, "kernel_launch: unexpected shapes (n_in %d out %d ws %zu)\n", n_in, out_size, ws_size); grid = -1; return; }
        int dev = 0, cus = 0, per_cu = 0;
        if (hipGetDevice(&dev) != hipSuccess || hipDeviceGetAttribute(&cus, hipDeviceAttributeMultiprocessorCount, dev) != hipSuccess) { grid = -1; return; }
        if (hipFuncSetAttribute((const void*)mk_fwd, hipFuncAttributeMaxDynamicSharedMemorySize, LDS_BYTES) != hipSuccess) { fprintf(stderr, "kernel_launch: hipFuncSetAttribute failed\n"); grid = -1; return; }
        if (hipOccupancyMaxActiveBlocksPerMultiprocessor(&per_cu, (const void*)mk_fwd, NTHREADS, LDS_BYTES) != hipSuccess || per_cu < 1) { fprintf(stderr, "kernel_launch: occupancy query says %d\n", per_cu); per_cu = 1; }
        (void)hipGetLastError();
        if (per_cu > 1) per_cu = 1;
        grid = cus * per_cu;
    }
    if (grid < 0) return;
    if (hipMemsetAsync((char*)d_ws + WS_CTL, 0, CTL_ZERO_BYTES, stream) != hipSuccess) { fprintf(stderr, "kernel_launch: memset failed\n"); return; }
    Args a{};
    for (int i = 0; i < 16; ++i) a.in[i] = (const float*)d_in[i];
    a.out = (float*)d_out; a.ws = (unsigned char*)d_ws;
#if MK_PER_PHASE
    for (int p = 0; p < N_PHASES; ++p) { a.ph_lo = p; a.ph_hi = p + 1; hipLaunchKernelGGL(mk_fwd, dim3(grid), dim3(NTHREADS), LDS_BYTES, stream, a); }
#else
    a.ph_lo = 0; a.ph_hi = N_PHASES;
    void* kargs[] = {&a};
#ifdef PLAIN_LAUNCH
    (void)kargs; hipLaunchKernelGGL(mk_fwd, dim3(grid), dim3(NTHREADS), LDS_BYTES, stream, a); hipError_t e = hipPeekAtLastError();
#else
    hipError_t e = hipLaunchCooperativeKernel((const void*)mk_fwd, dim3(grid), dim3(NTHREADS), kargs, LDS_BYTES, stream);
#endif
    if (e != hipSuccess) fprintf(stderr, "kernel_launch: cooperative launch failed: %s (grid %d)\n", hipGetErrorString(e), grid);
#endif
}
```

```cpp
#include <hip/hip_runtime.h>
#include <cstdio>
#include <cstdint>
#include <type_traits>
namespace pg8 {
#define PG8_LAS __attribute__((address_space(3)))
typedef unsigned short bf16_t;
typedef short bf16x8 __attribute__((ext_vector_type(8)));
typedef float f32x4 __attribute__((ext_vector_type(4)));
typedef unsigned u32x4 __attribute__((ext_vector_type(4)));
constexpr int BM = 256, BK = 64, HALF = 128, HTB = HALF * BK * 2  , STAGE_BYTES = 8 * HTB, NXCD = 8, WGM = 8;

__host__ __device__ __forceinline__ int lds_byte(int r, int c) { const int st = (r >> 4) * 2 + (c >> 5), rr = r & 15, cc = c & 31, ob = rr * 64 + cc * 2; return st * 1024 + (ob ^ (((ob >> 9) & 1) << 5)); }
__host__ __device__ __forceinline__ void stage_rc(int b, int& R, int& C) { const int st = b / 1024, sb = b % 1024, swz = sb ^ (((sb >> 9) & 1) << 5); R = (st >> 1) * 16 + swz / 64; C = (st & 1) * 32 + (swz % 64) / 2; }
__host__ __device__ __forceinline__ int perm32(int rho) { const int n = rho >> 4, i = rho & 15; return 8 * (i >> 2) + 4 * n + (i & 3); }

struct Unit { int pm, pn, w; };
struct Gemm { const bf16_t* A; const bf16_t* Bt; int M, N, K; const bf16_t* A2 = nullptr; const bf16_t* Bt2 = nullptr; };

struct StaticOrder {
    int nM, nN, nwg, G, c;
    __host__ __device__ void init(int M, int N, int G_, int c_) { nM = M / BM; nN = N / BM; nwg = nM * nN; G = G_; c = c_; }
    __host__ __device__ bool next(int i, Unit& u) const {
        const long L = (long)i * G + c; if (L >= nwg) return false;
        int wgid = (int)L; { const int q = nwg / NXCD, r = nwg % NXCD, xcd = wgid % NXCD, off = wgid / NXCD; wgid = (xcd < r ? xcd * (q + 1) : r * (q + 1) + (xcd - r) * q) + off; }
        const int nig = WGM * nN, gid = wgid / nig, fm = gid * WGM, gsz = (nM - fm) < WGM ? (nM - fm) : WGM;
        u.pm = fm + ((wgid % nig) % gsz); u.pn = (wgid % nig) / gsz; u.w = 0; return true;
    }
    __device__ __forceinline__ void a_ready(const Unit&) const {}
    __device__ __forceinline__ void done(const Unit&) const {}
};


__device__ __forceinline__ unsigned cvt_pk_bf16(float lo, float hi) { unsigned r; asm volatile("v_cvt_pk_bf16_f32 %0, %1, %2" : "=v"(r) : "v"(lo), "v"(hi)); return r; }
__device__ __forceinline__ float bf_lo(unsigned w) { return __builtin_bit_cast(float, w << 16); }
__device__ __forceinline__ float bf_hi(unsigned w) { return __builtin_bit_cast(float, w & 0xffff0000u); }
__device__ __forceinline__ float sigmoidf_(float x) { return __builtin_amdgcn_rcpf(1.0f + __expf(-x)); }

struct EpiBf16 {
    static constexpr bool PERM = true, AFTER_DRAIN = false;
    bf16_t* O; int ldc;
    __device__ __forceinline__ void operator()(const f32x4 (&acc)[2][2][4][2], const Unit& u, int wr, int wc, int fr, int fq) const {
        const int row0 = u.pm * BM + wr * 64 + fr, col0 = u.pn * BM + wc * 32 + 8 * fq;
#pragma unroll
        for (int ai = 0; ai < 2; ++ai)
#pragma unroll
            for (int m = 0; m < 4; ++m) { bf16_t* rowp = O + (size_t)(row0 + ai * HALF + m * 16) * ldc + col0;
#pragma unroll
                for (int bj = 0; bj < 2; ++bj) { const f32x4 v0 = acc[ai][bj][m][0], v1 = acc[ai][bj][m][1];
                    u32x4 w; w.x = cvt_pk_bf16(v0[0], v0[1]); w.y = cvt_pk_bf16(v0[2], v0[3]); w.z = cvt_pk_bf16(v1[0], v1[1]); w.w = cvt_pk_bf16(v1[2], v1[3]);
                    *(u32x4*)(rowp + bj * HALF) = w; } }
    }
};
template <int SECOND> struct EpiGate {
    static constexpr bool PERM = true, AFTER_DRAIN = false;
    bf16_t* O; const bf16_t* T; const bf16_t* Zg; const float* bg; int ldc, ldz;
    __device__ __forceinline__ void operator()(const f32x4 (&acc)[2][2][4][2], const Unit& u, int wr, int wc, int fr, int fq) const {
        const int row0 = u.pm * BM + wr * 64 + fr, col0 = u.pn * BM + wc * 32 + 8 * fq;
        f32x4 bv[2][2];
#pragma unroll
        for (int bj = 0; bj < 2; ++bj)
#pragma unroll
            for (int n = 0; n < 2; ++n) bv[bj][n] = *(const f32x4*)(bg + col0 + bj * HALF + 4 * n);
#pragma unroll
        for (int ai = 0; ai < 2; ++ai)
#pragma unroll
            for (int m = 0; m < 4; ++m) { const size_t row = (size_t)(row0 + ai * HALF + m * 16);
#pragma unroll
                for (int bj = 0; bj < 2; ++bj) { const int c = col0 + bj * HALF;
                    const u32x4 zg = *(const u32x4*)(Zg + row * ldz + c);
                    f32x4 v0 = acc[ai][bj][m][0], v1 = acc[ai][bj][m][1];
                    v0[0] *= sigmoidf_(bf_lo(zg.x) + bv[bj][0][0]); v0[1] *= sigmoidf_(bf_hi(zg.x) + bv[bj][0][1]);
                    v0[2] *= sigmoidf_(bf_lo(zg.y) + bv[bj][0][2]); v0[3] *= sigmoidf_(bf_hi(zg.y) + bv[bj][0][3]);
                    v1[0] *= sigmoidf_(bf_lo(zg.z) + bv[bj][1][0]); v1[1] *= sigmoidf_(bf_hi(zg.z) + bv[bj][1][1]);
                    v1[2] *= sigmoidf_(bf_lo(zg.w) + bv[bj][1][2]); v1[3] *= sigmoidf_(bf_hi(zg.w) + bv[bj][1][3]);
                    if (SECOND) { const u32x4 t = *(const u32x4*)(T + row * ldc + c);
                        v0[0] += bf_lo(t.x); v0[1] += bf_hi(t.x); v0[2] += bf_lo(t.y); v0[3] += bf_hi(t.y);
                        v1[0] += bf_lo(t.z); v1[1] += bf_hi(t.z); v1[2] += bf_lo(t.w); v1[3] += bf_hi(t.w); }
                    u32x4 w; w.x = cvt_pk_bf16(v0[0], v0[1]); w.y = cvt_pk_bf16(v0[2], v0[3]); w.z = cvt_pk_bf16(v1[0], v1[1]); w.w = cvt_pk_bf16(v1[2], v1[3]);
                    *(u32x4*)(O + row * ldc + c) = w; } }
    }
};
struct EpiF32 {
    static constexpr bool PERM = false, AFTER_DRAIN = false;
    float* C; int ldc; const float* R; float scale;
    __device__ __forceinline__ void operator()(const f32x4 (&acc)[2][2][4][2], const Unit& u, int wr, int wc, int fr, int fq) const {
        const int row0 = u.pm * BM + wr * 64 + fr, col0 = u.pn * BM + wc * 32 + 4 * fq;
#pragma unroll
        for (int ai = 0; ai < 2; ++ai)
#pragma unroll
            for (int m = 0; m < 4; ++m) { const size_t off = (size_t)(row0 + ai * HALF + m * 16) * ldc + col0;
#pragma unroll
                for (int bj = 0; bj < 2; ++bj)
#pragma unroll
                    for (int n = 0; n < 2; ++n) { f32x4 v = acc[ai][bj][m][n];
                        if (R) v += *(const f32x4*)(R + off + bj * HALF + n * 16) * scale;
                        *(f32x4*)(C + off + bj * HALF + n * 16) = v; } }
    }
};
struct EpiResBf16 {
    static constexpr bool PERM = true, AFTER_DRAIN = false;
    bf16_t* O; int ldc; const float* R; float scale;
    __device__ __forceinline__ void operator()(const f32x4 (&acc)[2][2][4][2], const Unit& u, int wr, int wc, int fr, int fq) const {
        const int row0 = u.pm * BM + wr * 64 + fr, col0 = u.pn * BM + wc * 32 + 8 * fq;
#pragma unroll
        for (int ai = 0; ai < 2; ++ai)
#pragma unroll
            for (int m = 0; m < 4; ++m) { const size_t off = (size_t)(row0 + ai * HALF + m * 16) * ldc + col0;
#pragma unroll
                for (int bj = 0; bj < 2; ++bj) { const f32x4 r0 = *(const f32x4*)(R + off + bj * HALF), r1 = *(const f32x4*)(R + off + bj * HALF + 4);
                    const f32x4 v0 = acc[ai][bj][m][0] + r0 * scale, v1 = acc[ai][bj][m][1] + r1 * scale;
                    u32x4 w; w.x = cvt_pk_bf16(v0[0], v0[1]); w.y = cvt_pk_bf16(v0[2], v0[3]); w.z = cvt_pk_bf16(v1[0], v1[1]); w.w = cvt_pk_bf16(v1[2], v1[3]);
                    *(u32x4*)(O + off + bj * HALF) = w; } }
    }
};
typedef int i32x4e __attribute__((ext_vector_type(4)));
struct EpiI8Bf16 {
    static constexpr bool PERM = true, AFTER_DRAIN = false;
    bf16_t* O; int ldc; const float* sa; const float* sb;
    __device__ __forceinline__ void operator()(const i32x4e (&acc)[2][2][4][2], const Unit& u, int wr, int wc, int fr, int fq) const {
        const int row0 = u.pm * BM + wr * 64 + fr, col0 = u.pn * BM + wc * 32 + 8 * fq;
        f32x4 sbv[2][2];
#pragma unroll
        for (int bj = 0; bj < 2; ++bj)
#pragma unroll
            for (int n = 0; n < 2; ++n) sbv[bj][n] = *(const f32x4*)(sb + col0 + bj * HALF + 4 * n);
#pragma unroll
        for (int ai = 0; ai < 2; ++ai)
#pragma unroll
            for (int m = 0; m < 4; ++m) { const int row = row0 + ai * HALF + m * 16; const float sr = sa[row]; bf16_t* rowp = O + (size_t)row * ldc + col0;
#pragma unroll
                for (int bj = 0; bj < 2; ++bj) { const i32x4e a0 = acc[ai][bj][m][0], a1 = acc[ai][bj][m][1];
                    const f32x4 v0 = (f32x4){(float)a0[0], (float)a0[1], (float)a0[2], (float)a0[3]} * sbv[bj][0] * sr, v1 = (f32x4){(float)a1[0], (float)a1[1], (float)a1[2], (float)a1[3]} * sbv[bj][1] * sr;
                    u32x4 w; w.x = cvt_pk_bf16(v0[0], v0[1]); w.y = cvt_pk_bf16(v0[2], v0[3]); w.z = cvt_pk_bf16(v1[0], v1[1]); w.w = cvt_pk_bf16(v1[2], v1[3]);
                    *(u32x4*)(rowp + bj * HALF) = w; } }
    }
};
template <int SECOND> struct EpiGateI8 {
    static constexpr bool PERM = true, AFTER_DRAIN = false;
    bf16_t* O; const bf16_t* T; const bf16_t* Zg; const float* bg; int ldc, ldz; const float* sa; const float* sb;
    __device__ __forceinline__ void operator()(const i32x4e (&acc)[2][2][4][2], const Unit& u, int wr, int wc, int fr, int fq) const {
        const int row0 = u.pm * BM + wr * 64 + fr, col0 = u.pn * BM + wc * 32 + 8 * fq;
        f32x4 bv[2][2], sbv[2][2];
#pragma unroll
        for (int bj = 0; bj < 2; ++bj)
#pragma unroll
            for (int n = 0; n < 2; ++n) { bv[bj][n] = *(const f32x4*)(bg + col0 + bj * HALF + 4 * n); sbv[bj][n] = *(const f32x4*)(sb + col0 + bj * HALF + 4 * n); }
#pragma unroll
        for (int ai = 0; ai < 2; ++ai)
#pragma unroll
            for (int m = 0; m < 4; ++m) { const size_t row = (size_t)(row0 + ai * HALF + m * 16); const float sr = sa[row];
#pragma unroll
                for (int bj = 0; bj < 2; ++bj) { const int c = col0 + bj * HALF;
                    const u32x4 zg = *(const u32x4*)(Zg + row * ldz + c);
                    const i32x4e a0 = acc[ai][bj][m][0], a1 = acc[ai][bj][m][1];
                    f32x4 v0 = (f32x4){(float)a0[0], (float)a0[1], (float)a0[2], (float)a0[3]} * sbv[bj][0] * sr, v1 = (f32x4){(float)a1[0], (float)a1[1], (float)a1[2], (float)a1[3]} * sbv[bj][1] * sr;
                    v0[0] *= sigmoidf_(bf_lo(zg.x) + bv[bj][0][0]); v0[1] *= sigmoidf_(bf_hi(zg.x) + bv[bj][0][1]);
                    v0[2] *= sigmoidf_(bf_lo(zg.y) + bv[bj][0][2]); v0[3] *= sigmoidf_(bf_hi(zg.y) + bv[bj][0][3]);
                    v1[0] *= sigmoidf_(bf_lo(zg.z) + bv[bj][1][0]); v1[1] *= sigmoidf_(bf_hi(zg.z) + bv[bj][1][1]);
                    v1[2] *= sigmoidf_(bf_lo(zg.w) + bv[bj][1][2]); v1[3] *= sigmoidf_(bf_hi(zg.w) + bv[bj][1][3]);
                    if (SECOND) { const u32x4 t = *(const u32x4*)(T + row * ldc + c);
                        v0[0] += bf_lo(t.x); v0[1] += bf_hi(t.x); v0[2] += bf_lo(t.y); v0[3] += bf_hi(t.y);
                        v1[0] += bf_lo(t.z); v1[1] += bf_hi(t.z); v1[2] += bf_lo(t.w); v1[3] += bf_hi(t.w); }
                    u32x4 w; w.x = cvt_pk_bf16(v0[0], v0[1]); w.y = cvt_pk_bf16(v0[2], v0[3]); w.z = cvt_pk_bf16(v1[0], v1[1]); w.w = cvt_pk_bf16(v1[2], v1[3]);
                    *(u32x4*)(O + row * ldc + c) = w; } }
    }
};
struct EpiResI8Bf16 {
    static constexpr bool PERM = true, AFTER_DRAIN = false;
    bf16_t* O; int ldc; const float* R; float scale; const float* sa; const float* sb;
    __device__ __forceinline__ void operator()(const i32x4e (&acc)[2][2][4][2], const Unit& u, int wr, int wc, int fr, int fq) const {
        const int row0 = u.pm * BM + wr * 64 + fr, col0 = u.pn * BM + wc * 32 + 8 * fq;
        f32x4 sbv[2][2];
#pragma unroll
        for (int bj = 0; bj < 2; ++bj)
#pragma unroll
            for (int n = 0; n < 2; ++n) sbv[bj][n] = *(const f32x4*)(sb + col0 + bj * HALF + 4 * n);
#pragma unroll
        for (int ai = 0; ai < 2; ++ai)
#pragma unroll
            for (int m = 0; m < 4; ++m) { const int row = row0 + ai * HALF + m * 16; const float sr = sa[row]; const size_t off = (size_t)row * ldc + col0;
#pragma unroll
                for (int bj = 0; bj < 2; ++bj) { const f32x4 r0 = *(const f32x4*)(R + off + bj * HALF), r1 = *(const f32x4*)(R + off + bj * HALF + 4);
                    const i32x4e a0 = acc[ai][bj][m][0], a1 = acc[ai][bj][m][1];
                    const f32x4 v0 = (f32x4){(float)a0[0], (float)a0[1], (float)a0[2], (float)a0[3]} * sbv[bj][0] * sr + r0 * scale, v1 = (f32x4){(float)a1[0], (float)a1[1], (float)a1[2], (float)a1[3]} * sbv[bj][1] * sr + r1 * scale;
                    u32x4 w; w.x = cvt_pk_bf16(v0[0], v0[1]); w.y = cvt_pk_bf16(v0[2], v0[3]); w.z = cvt_pk_bf16(v1[0], v1[1]); w.w = cvt_pk_bf16(v1[2], v1[3]);
                    *(u32x4*)(O + off + bj * HALF) = w; } }
    }
};

typedef int i32x4 __attribute__((ext_vector_type(4)));
template <class E, class = void> struct epi_chains : std::false_type {};
template <class E> struct epi_chains<E, std::void_t<decltype(E::CHAIN)>> : std::true_type {};
template <class Epi, class Sched, bool ALIGN_EPI = false, bool SP2 = false, bool I8 = false>
__device__ __forceinline__ void gemm_phase(PG8_LAS unsigned char* lds, const Gemm g, const Sched& S, const Epi& E) {
    int tid_ = threadIdx.x; asm volatile("" : "+v"(tid_));
    const int tid = tid_, wid = __builtin_amdgcn_readfirstlane(tid >> 6), lane = tid & 63, wr = wid >> 2, wc = wid & 3, fr = lane & 15, fq = lane >> 4;
    const int K = g.K, nt = K / BK;
    unsigned voffA[2], voffB[2];
#pragma unroll
    for (int i = 0; i < 2; ++i) { int R, C; stage_rc(tid * 16 + i * 8192, R, C); const int Rb = Epi::PERM ? ((R & ~31) + perm32(R & 31)) : R;
        voffA[i] = (unsigned)(R * K + C) * 2u; voffB[i] = (unsigned)(Rb * K + C) * 2u; }
    const size_t kstep = (size_t)(BK * 2);
    const size_t hstep = (size_t)HALF * K * 2;
    const size_t tstep = 2 * hstep;
    const unsigned ldsw = (unsigned)wid * 1024u;
    const int aoff = lds_byte(wr * 64 + fr, fq * 8), boff = lds_byte(wc * 32 + fr, fq * 8);
#define PG8_SA(b, h) (((b) * 2 + (h)) * HTB)
#define PG8_SB(b, h) ((4 + (b) * 2 + (h)) * HTB)
#define PG8_STAGE(bufoff, gbase, voff) do { _Pragma("unroll") for (int _i = 0; _i < 2; ++_i) \
        __builtin_amdgcn_global_load_lds((const unsigned*)((const char*)(gbase) + (voff)[_i]), (PG8_LAS unsigned*)(lds + (bufoff) + ldsw + _i * 8192), 16, 0, 0); } while (0)
#define PG8_LDA(dst, b, h) do { _Pragma("unroll") for (int m = 0; m < 4; ++m) _Pragma("unroll") for (int k = 0; k < 2; ++k) dst[m][k] = *(const PG8_LAS bf16x8*)(lds + PG8_SA(b, h) + aoff + m * 2048 + k * 1024); } while (0)
#define PG8_LDB(dst, b, h) do { _Pragma("unroll") for (int n = 0; n < 2; ++n) _Pragma("unroll") for (int k = 0; k < 2; ++k) dst[n][k] = *(const PG8_LAS bf16x8*)(lds + PG8_SB(b, h) + boff + n * 2048 + k * 1024); } while (0)
#define PG8_MMA(ai, bj, At, Bt) do { __builtin_amdgcn_s_setprio(1); _Pragma("unroll") for (int m = 0; m < 4; ++m) _Pragma("unroll") for (int n = 0; n < 2; ++n) _Pragma("unroll") for (int k = 0; k < 2; ++k) \
        { if constexpr (I8) acc[ai][bj][m][n] = __builtin_bit_cast(acc_t, __builtin_amdgcn_mfma_i32_16x16x64_i8(__builtin_bit_cast(i32x4, Bt[n][k]), __builtin_bit_cast(i32x4, At[m][k]), __builtin_bit_cast(i32x4, acc[ai][bj][m][n]), 0, 0, 0)); \
          else acc[ai][bj][m][n] = __builtin_bit_cast(acc_t, __builtin_amdgcn_mfma_f32_16x16x32_bf16(Bt[n][k], At[m][k], __builtin_bit_cast(f32x4, acc[ai][bj][m][n]), 0, 0, 0)); } __builtin_amdgcn_s_setprio(0); } while (0)
#define PG8_WAIT_V(n) asm volatile("s_waitcnt vmcnt(" #n ")" ::: "memory")
#define PG8_WAIT_L(n) asm volatile("s_waitcnt lgkmcnt(" #n ")" ::: "memory")
#define PG8_BAR __builtin_amdgcn_s_barrier()
#define PG8_SCHED __builtin_amdgcn_sched_barrier(0)
    Unit cur, nxt; int ui = 0;
    if (!S.next(0, cur)) return;
    typedef typename std::conditional<I8, i32x4, f32x4>::type acc_t;
    acc_t acc[2][2][4][2];
#pragma unroll
    for (int a = 0; a < 2; ++a)
#pragma unroll
        for (int b = 0; b < 2; ++b)
#pragma unroll
            for (int m = 0; m < 4; ++m)
#pragma unroll
                for (int n = 0; n < 2; ++n) acc[a][b][m][n] = acc_t{};
    bf16x8 At[4][2], B0[2][2], B1[2][2];
    const char* cA = (const char*)(cur.w ? g.A2 : g.A) + (size_t)cur.pm * tstep; const char* cB = (const char*)(cur.w ? g.Bt2 : g.Bt) + (size_t)cur.pn * tstep;
    S.a_ready(cur);
    if constexpr (SP2) {
        PG8_STAGE(PG8_SB(0, 0), cB, voffB); PG8_STAGE(PG8_SB(0, 1), cB + hstep, voffB); PG8_STAGE(PG8_SA(0, 0), cA, voffA); PG8_STAGE(PG8_SA(0, 1), cA + hstep, voffA);
        if (wr == 1) PG8_BAR;
        PG8_WAIT_V(2); PG8_BAR;
        PG8_STAGE(PG8_SB(1, 0), cB + kstep, voffB); PG8_STAGE(PG8_SA(1, 0), cA + kstep, voffA); PG8_STAGE(PG8_SB(1, 1), cB + hstep + kstep, voffB);
        PG8_WAIT_V(6); PG8_BAR;
    } else {
        PG8_STAGE(PG8_SB(0, 0), cB, voffB); PG8_STAGE(PG8_SA(0, 0), cA, voffA); PG8_STAGE(PG8_SB(0, 1), cB + hstep, voffB); PG8_STAGE(PG8_SA(0, 1), cA + hstep, voffA);
        if (wr == 1) PG8_BAR;
        PG8_WAIT_V(4); PG8_BAR;
        PG8_STAGE(PG8_SB(1, 0), cB + kstep, voffB); PG8_STAGE(PG8_SA(1, 0), cA + kstep, voffA); PG8_STAGE(PG8_SB(1, 1), cB + hstep + kstep, voffB);
        PG8_WAIT_V(6); PG8_BAR;
    }
    for (;;) {
        const bool has_next = S.next(ui + 1, nxt);
        const char* nA = has_next ? (const char*)(nxt.w ? g.A2 : g.A) + (size_t)nxt.pm * tstep : cA; const char* nB = has_next ? (const char*)(nxt.w ? g.Bt2 : g.Bt) + (size_t)nxt.pn * tstep : cB;
        for (int t = 0; t < nt; t += 2) {
            const bool last = (t == nt - 2);
            const char* a1 = cA + (size_t)(t + 1) * kstep;
            const char* a2 = last ? nA : cA + (size_t)(t + 2) * kstep; const char* b2 = last ? nB : cB + (size_t)(t + 2) * kstep;
            const char* a3 = a2 + kstep; const char* b3 = b2 + kstep;
            if (last && has_next) S.a_ready(nxt);
            if constexpr (SP2) {
            PG8_LDB(B0, 0, 0); PG8_LDB(B1, 0, 1); PG8_SCHED; PG8_LDA(At, 0, 0); PG8_STAGE(PG8_SA(1, 1), a1 + hstep, voffA);
            PG8_WAIT_V(8); PG8_WAIT_L(0); PG8_BAR; PG8_MMA(0, 0, At, B0); PG8_MMA(0, 1, At, B1); PG8_BAR; PG8_SCHED;
            PG8_LDA(At, 0, 1); PG8_STAGE(PG8_SB(0, 0), b2, voffB); PG8_STAGE(PG8_SB(0, 1), b2 + hstep, voffB); PG8_STAGE(PG8_SA(0, 0), a2, voffA);
            PG8_WAIT_V(8); PG8_WAIT_L(0); PG8_BAR; PG8_MMA(1, 0, At, B0); PG8_MMA(1, 1, At, B1); PG8_BAR; PG8_SCHED;
            PG8_LDB(B0, 1, 0); PG8_LDB(B1, 1, 1); PG8_SCHED; PG8_LDA(At, 1, 0); PG8_STAGE(PG8_SA(0, 1), a2 + hstep, voffA);
            PG8_WAIT_V(8); PG8_WAIT_L(0); PG8_BAR; PG8_MMA(0, 0, At, B0); PG8_MMA(0, 1, At, B1); PG8_BAR; PG8_SCHED;
            PG8_LDA(At, 1, 1); PG8_STAGE(PG8_SB(1, 0), b3, voffB); PG8_STAGE(PG8_SB(1, 1), b3 + hstep, voffB); PG8_STAGE(PG8_SA(1, 0), a3, voffA);
            PG8_WAIT_V(8); PG8_WAIT_L(0); PG8_BAR; PG8_MMA(1, 0, At, B0); PG8_MMA(1, 1, At, B1); PG8_BAR; PG8_SCHED;
            } else {
            PG8_LDB(B0, 0, 0); PG8_SCHED; PG8_LDA(At, 0, 0); PG8_STAGE(PG8_SA(1, 1), a1 + hstep, voffA);
            PG8_WAIT_L(8); PG8_BAR; PG8_WAIT_L(0); PG8_MMA(0, 0, At, B0); PG8_BAR; PG8_SCHED;
            PG8_LDB(B1, 0, 1); PG8_STAGE(PG8_SB(0, 0), b2, voffB);
            PG8_BAR; PG8_WAIT_L(0); PG8_MMA(0, 1, At, B1); PG8_BAR;
            PG8_LDA(At, 0, 1); PG8_STAGE(PG8_SA(0, 0), a2, voffA);
            PG8_BAR; PG8_WAIT_L(0); PG8_MMA(1, 0, At, B0); PG8_BAR; PG8_SCHED;
            PG8_STAGE(PG8_SB(0, 1), b2 + hstep, voffB);
            PG8_WAIT_V(6); PG8_BAR; PG8_MMA(1, 1, At, B1); PG8_BAR;
            PG8_LDB(B0, 1, 0); PG8_SCHED; PG8_LDA(At, 1, 0); PG8_STAGE(PG8_SA(0, 1), a2 + hstep, voffA);
            PG8_WAIT_L(8); PG8_BAR; PG8_WAIT_L(0); PG8_MMA(0, 0, At, B0); PG8_BAR; PG8_SCHED;
            PG8_LDB(B1, 1, 1); PG8_STAGE(PG8_SB(1, 0), b3, voffB);
            PG8_BAR; PG8_WAIT_L(0); PG8_MMA(0, 1, At, B1); PG8_BAR;
            PG8_LDA(At, 1, 1); PG8_STAGE(PG8_SA(1, 0), a3, voffA);
            PG8_BAR; PG8_WAIT_L(0); PG8_MMA(1, 0, At, B0); PG8_BAR; PG8_SCHED;
            PG8_STAGE(PG8_SB(1, 1), b3 + hstep, voffB);
            PG8_WAIT_V(6); PG8_BAR; PG8_MMA(1, 1, At, B1); PG8_BAR;
            }
        }
        if constexpr (ALIGN_EPI) { if (wr == 0) PG8_BAR; }
        bool keep_acc = false;
        if constexpr (!Epi::AFTER_DRAIN) { if constexpr (epi_chains<Epi>::value) keep_acc = E.chain(acc, cur, wr, wc, fr, fq); else E(acc, cur, wr, wc, fr, fq); S.done(cur); }
        if (!has_next) break;
        if (!keep_acc) {
#pragma unroll
        for (int a = 0; a < 2; ++a)
#pragma unroll
            for (int b = 0; b < 2; ++b)
#pragma unroll
                for (int m = 0; m < 4; ++m)
#pragma unroll
                    for (int n = 0; n < 2; ++n) acc[a][b][m][n] = acc_t{};
        }
        cur = nxt; cA = nA; cB = nB; ++ui;
        if constexpr (ALIGN_EPI) { if (wr == 1) PG8_BAR; }
    }
    PG8_WAIT_V(0);
    if constexpr (!ALIGN_EPI) { if (wr == 0) PG8_BAR; }
    PG8_BAR;
    if constexpr (Epi::AFTER_DRAIN) { E.fused(acc, cur, wr, wc, fr, fq, lds, wid, lane); S.done(cur); }
#undef PG8_SA
#undef PG8_SB
#undef PG8_STAGE
#undef PG8_LDA
#undef PG8_LDB
#undef PG8_MMA
#undef PG8_WAIT_V
#undef PG8_WAIT_L
#undef PG8_BAR
#undef PG8_SCHED
}
}
#define GAS __attribute__((address_space(1)))
#define LAS __attribute__((address_space(3)))
typedef unsigned short bf16;
typedef unsigned v4u __attribute__((ext_vector_type(4)));
typedef float f32x4 __attribute__((ext_vector_type(4)));
typedef short bf16x8 __attribute__((ext_vector_type(8)));
typedef GAS unsigned gu32;
typedef GAS unsigned long long gu64;
#define RLX_AGENT __ATOMIC_RELAXED, __HIP_MEMORY_SCOPE_AGENT
#define LDS_WAIT() asm volatile("s_waitcnt lgkmcnt(0)" ::: "memory")
#define VM_WAIT() asm volatile("s_waitcnt vmcnt(0)" ::: "memory")
__device__ __forceinline__ unsigned long long rt() { return __builtin_amdgcn_s_memrealtime(); }
__device__ __forceinline__ unsigned f2bf(float f) { unsigned u = __builtin_bit_cast(unsigned, f); return (u + 0x7fffu + ((u >> 16) & 1u)) >> 16; }
__device__ __forceinline__ unsigned pk2(float lo, float hi) { return f2bf(lo) | (f2bf(hi) << 16); }

#define XB_TMO      128
#define XB_XCNT(j)  (256  + 64 * (j))
#define XB_XSUB(j)  (1280 + 64 * (j))
#define XB_XGEN(j)  (2304 + 64 * (j))
#define XB_TOP      3328
#define XB_TOPGEN   3392
#define XCD_BAR_WORDS 3456
#define XB_SPIN_CAP (1u << 18)

__device__ __forceinline__ unsigned xb_ld(unsigned* p)              { return __hip_atomic_load(p, __ATOMIC_RELAXED, __HIP_MEMORY_SCOPE_AGENT); }
__device__ __forceinline__ unsigned xb_add(unsigned* p, unsigned v) { return __hip_atomic_fetch_add(p, v, __ATOMIC_RELAXED, __HIP_MEMORY_SCOPE_AGENT); }
__device__ __forceinline__ unsigned xb_xcc_id() { return (unsigned)__builtin_amdgcn_s_getreg((3 << 11) | 20) & 0xFu; }
#define XB_SPIN(cond, bar) do { unsigned _sp = 0; while (cond) { __builtin_amdgcn_s_sleep(1); \
    if ((++_sp & 255u) == 0u) { if (xb_ld(&(bar)[XB_TMO])) break; if (_sp > XB_SPIN_CAP) { atomicAdd(&(bar)[XB_TMO], 1u); break; } } } } while (0)

struct XcdBarrier {
    unsigned* bar; unsigned x;
    volatile LAS unsigned* st;
};

__device__ __forceinline__ XcdBarrier xcd_barrier_post(unsigned* bar, volatile LAS unsigned* st) {
    XcdBarrier b; b.bar = bar; b.x = xb_xcc_id(); b.st = st;
    if (threadIdx.x == 0) (void)xb_add(&bar[XB_XCNT(b.x)], 1u);
    return b;
}
__device__ __forceinline__ void xcd_barrier_complete(unsigned* bar, unsigned x, unsigned& nloc, unsigned& nx) {
    const unsigned G = gridDim.x * gridDim.y * gridDim.z;
    unsigned sum, cnt, mine, sp = 0u;
    for (;;) {
        sum = 0u; cnt = 0u; mine = 0u;
#pragma unroll
        for (unsigned j = 0; j < 16; ++j) { const unsigned c = xb_ld(&bar[XB_XCNT(j)]); sum += c; cnt += (c > 0u) ? 1u : 0u; mine = (j == x) ? c : mine; }
        if (sum == G) break;
        __builtin_amdgcn_s_sleep(1);
        if ((++sp & 255u) == 0u) { if (xb_ld(&bar[XB_TMO])) break; if (sp > XB_SPIN_CAP) { atomicAdd(&bar[XB_TMO], 1u); break; } }
    }
    nloc = mine > 0u ? mine : 1u; nx = cnt > 0u ? cnt : 1u;
}

__device__ __forceinline__ void xcd_barrier(const XcdBarrier& b) {
    asm volatile("s_waitcnt vmcnt(0)" ::: "memory");
    __syncthreads();
    if (threadIdx.x == 0) {
        unsigned* bar = b.bar;
        __builtin_amdgcn_s_waitcnt(0);
        unsigned nloc = b.st[0], nx = b.st[1];
        if (nloc == 0u) { xcd_barrier_complete(bar, b.x, nloc, nx); b.st[0] = nloc; b.st[1] = nx; }
        const unsigned old = xb_add(&bar[XB_XSUB(b.x)], 1u);
        const unsigned gen = old / nloc;
        if (old + 1u == (gen + 1u) * nloc) {
            __builtin_amdgcn_fence(__ATOMIC_RELEASE, "agent");
            asm volatile("s_waitcnt vmcnt(0)" ::: "memory");
            const unsigned og = xb_add(&bar[XB_TOP], 1u);
            const unsigned tg = og / nx;
            if (og + 1u == (tg + 1u) * nx) xb_add(&bar[XB_TOPGEN], 1u);
            else XB_SPIN(xb_ld(&bar[XB_TOPGEN]) == tg, bar);
            __builtin_amdgcn_fence(__ATOMIC_ACQUIRE, "agent");
            xb_add(&bar[XB_XGEN(b.x)], 1u);
            asm volatile("s_waitcnt vmcnt(0)" ::: "memory");
        } else {
            XB_SPIN(xb_ld(&bar[XB_XGEN(b.x)]) == gen, bar);
            __builtin_amdgcn_fence(__ATOMIC_ACQUIRE, "agent");
            asm volatile("s_waitcnt vmcnt(0)" ::: "memory");
        }
    }
    __syncthreads();
}

constexpr int NWAVES = 8, NTHREADS = 512;
constexpr int BATCH = 4, SEQ = 2048, D = 2048, M = BATCH * SEQ;
constexpr int NQH = 32, NKVH = 4, HD = 64, QPKV = 8, WINDOW = 128;
constexpr int Q_OFF = 0, K_OFF = 2048, V_OFF = 2304, CB_OFF = 2560, CC_OFF = 4608, CH_OFF = 6656, G_OFF = 8704, IN_W = 12800;
constexpr int PH = 8, PNK = 128, PTOPK = 16, PNE = 16384;
constexpr float LN_EPS = 1e-5f;
constexpr float ALPHA = 1.189207115002721f;

#ifndef MK_PER_PHASE
#define MK_PER_PHASE 0
#endif
constexpr int N_PHASES = 12;

constexpr size_t MiB = 1u << 20;
constexpr size_t WS_CTL = 0, CTL_ZERO_BYTES = 1 * MiB;
constexpr size_t WS_WIN = 1 * MiB;
constexpr size_t WS_WA = 51 * MiB, WS_WC = 59 * MiB, WS_WO = 67 * MiB, WS_WF = 75 * MiB;
constexpr size_t WS_XB = 83 * MiB;
constexpr size_t WS_MERGED = WS_XB;
constexpr size_t WS_Z = 115 * MiB;
constexpr size_t WS_R2B = 115 * MiB;
constexpr size_t WS_H1B = 179 * MiB;
constexpr size_t WS_SC = 211 * MiB;
constexpr size_t WS_EX = 275 * MiB;
constexpr size_t WS_GT = 279 * MiB;
constexpr size_t WS_AO = 315 * MiB, WS_CI = 347 * MiB, WS_TMP = 379 * MiB;
constexpr size_t WS_U8 = 411 * MiB, WS_V8 = 443 * MiB;
constexpr size_t WS_SU = 475 * MiB, WS_SV = WS_SU + 65536;
constexpr size_t WS_PA = WS_SC;
constexpr size_t WS_XQ = 283 * MiB;
constexpr size_t WS_SX = 299 * MiB;
constexpr size_t WS_WB = 380 * MiB;
constexpr size_t WS_ST = 379 * MiB;
constexpr size_t WS_XA8 = WS_XB;
constexpr size_t WS_WIN8 = 476 * MiB;
constexpr size_t WS_SWIN = 501 * MiB, WS_SXA = WS_SWIN + 65536;
constexpr size_t WS_AO8 = 1 * MiB, WS_CI8 = 17 * MiB, WS_WA8 = 33 * MiB, WS_WC8 = 37 * MiB, WS_S3 = 41 * MiB;
constexpr size_t WS_WF8 = 502 * MiB;
constexpr size_t WS_SWF = WS_SXA + 65536;
constexpr size_t WS_MG8 = 1 * MiB;
constexpr size_t WS_WO8 = 506 * MiB;
constexpr size_t WS_SMG = WS_S3 + 262144, WS_SWO = WS_SWF + 16384;
constexpr size_t WS_SEG = 315 * MiB, WS_SOFF = 323 * MiB;
constexpr size_t WS_END = 510 * MiB;
constexpr int CW_Q = 12288;
constexpr size_t SLICE_BYTES = (size_t)PNE * 256;
constexpr int CW_BAR = 4096;

constexpr int RING_BYTES = 131072;
constexpr int LDSCTL_OFF = 163328, MISC_OFF = LDSCTL_OFF + 320;
constexpr int LDS_BYTES = LDSCTL_OFF + 512;

typedef float f32x16 __attribute__((ext_vector_type(16)));
typedef unsigned v2u __attribute__((ext_vector_type(2)));
__device__ __forceinline__ float wave_sum(float v) {
#pragma unroll
    for (int o = 1; o < 64; o <<= 1) v += __shfl_xor(v, o);
    return v;
}
__device__ __forceinline__ float vmaxf(float a, float b) { float r; asm("v_max_f32_e32 %0, %1, %2" : "=v"(r) : "v"(a), "v"(b)); return r; }
__device__ __forceinline__ float vminf(float a, float b) { float r; asm("v_min_f32_e32 %0, %1, %2" : "=v"(r) : "v"(a), "v"(b)); return r; }

__device__ __forceinline__ void p0_transpose_item(const float* W, int K, int N, bf16* WT, LAS float* scr, int item, int lane) {
    const int nblk = N / 32, kb = item / nblk, nb = item % nblk, k0 = 64 * kb, n0 = 32 * nb;
#pragma unroll 8
    for (int i = 0; i < 32; ++i) { const int kk = 2 * i + (lane >> 5); scr[kk * 33 + (lane & 31)] = W[(size_t)(k0 + kk) * N + n0 + (lane & 31)]; }
    LDS_WAIT(); asm volatile("" ::: "memory");
    const int c = lane & 7;
#pragma unroll
    for (int j = 0; j < 4; ++j) { const int n = (lane >> 3) + 8 * j; const LAS float* s = scr + (8 * c) * 33 + n;
        v4u o; o.x = pk2(s[0 * 33], s[1 * 33]); o.y = pk2(s[2 * 33], s[3 * 33]); o.z = pk2(s[4 * 33], s[5 * 33]); o.w = pk2(s[6 * 33], s[7 * 33]);
        *(GAS v4u*)(WT + (size_t)(n0 + n) * K + k0 + 8 * c) = o; }
    LDS_WAIT(); asm volatile("" ::: "memory");
}
__device__ __forceinline__ void p0_wf_item(const float* wq, const float* sk, bf16* WfT, LAS unsigned char* lds, int item, int tid) {
    const int hp = item >> 5, dt = item & 31;
    LAS f32x4* SK4 = (LAS f32x4*)lds;
    LAS f32x4* WQ4 = SK4 + 128 * 33;
    const float* skp = sk + (size_t)hp * 128 * 128;
    for (int i = tid; i < 128 * 32; i += NTHREADS) { const int n = i >> 5, c4 = i & 31; SK4[n * 33 + c4] = *(const f32x4*)(skp + n * 128 + 4 * c4); }
    for (int i = tid; i < 64 * 32; i += NTHREADS) { const int r = i >> 5, c4 = i & 31; WQ4[r * 33 + c4] = *(const f32x4*)(wq + (size_t)(64 * dt + r) * 2048 + hp * 128 + 4 * c4); }
    __syncthreads();
    const int td = tid & 15, tn = tid >> 4;
    float acc[4][4];
#pragma unroll
    for (int i = 0; i < 4; ++i)
#pragma unroll
        for (int j = 0; j < 4; ++j) acc[i][j] = 0.f;
#pragma unroll 4
    for (int c4 = 0; c4 < 32; ++c4) {
        f32x4 a[4], b[4];
#pragma unroll
        for (int i = 0; i < 4; ++i) a[i] = SK4[(4 * tn + i) * 33 + c4];
#pragma unroll
        for (int j = 0; j < 4; ++j) b[j] = WQ4[(td + 16 * j) * 33 + c4];
#pragma unroll
        for (int i = 0; i < 4; ++i)
#pragma unroll
            for (int j = 0; j < 4; ++j) acc[i][j] += a[i].x * b[j].x + a[i].y * b[j].y + a[i].z * b[j].z + a[i].w * b[j].w;
    }
#pragma unroll
    for (int i = 0; i < 4; ++i)
#pragma unroll
        for (int j = 0; j < 4; ++j) WfT[(size_t)(hp * 128 + 4 * tn + i) * 2048 + 64 * dt + td + 16 * j] = (bf16)f2bf(acc[i][j]);
    __syncthreads();
}

__device__ __forceinline__ int perm16(int o) { return 8 * ((o >> 2) & 1) + 4 * (o >> 3) + (o & 3); }
__device__ __forceinline__ void attn_unit(int unit, const bf16* z, bf16* ao, const float* sinks, LAS unsigned char* lds, int tid) {
    const int lane = tid & 63, wid = __builtin_amdgcn_readfirstlane(tid >> 6), r32 = lane & 31, hi = lane >> 5;
    const int nb = unit & 15, kvh = (unit >> 4) & 3, b = unit >> 6;
    LAS bf16* Ks = (LAS bf16*)lds;
    LAS bf16* Vt = (LAS bf16*)(lds + 256 * 144);
    const size_t tok0 = (size_t)b * SEQ;
#pragma unroll
    for (int i = 0; i < 4; ++i) {
        const int ci = tid + NTHREADS * i, key = ci >> 3, dc = ci & 7;
        int kpos = 128 * (nb - 1) + key; if (kpos < 0) kpos = 0;
        const bf16* src = z + (tok0 + kpos) * IN_W + K_OFF + kvh * HD + dc * 8;
        const v4u kv = *(const GAS v4u*)src, vv = *(const GAS v4u*)(src + (V_OFF - K_OFF));
        *(LAS v4u*)(Ks + key * 72 + dc * 8) = kv;
        const int pos = (key & ~15) + perm16(key & 15);
        LAS bf16* vp = Vt + (dc * 8) * 264 + pos;
        vp[0 * 264] = (bf16)(vv.x & 0xffffu); vp[1 * 264] = (bf16)(vv.x >> 16); vp[2 * 264] = (bf16)(vv.y & 0xffffu); vp[3 * 264] = (bf16)(vv.y >> 16);
        vp[4 * 264] = (bf16)(vv.z & 0xffffu); vp[5 * 264] = (bf16)(vv.z >> 16); vp[6 * 264] = (bf16)(vv.w & 0xffffu); vp[7 * 264] = (bf16)(vv.w >> 16);
    }
    __syncthreads();
    const int hq = kvh * QPKV + wid;
    const float LOG2E = 1.4426950408889634f;
    const float sink2 = sinks[hq] * LOG2E, sc = 0.125f * LOG2E;
#pragma unroll 1
    for (int qg = 0; qg < 4; ++qg) {
        const size_t tok = tok0 + 128 * nb + 32 * qg + r32;
        bf16x8 qf[4];
#pragma unroll
        for (int ks = 0; ks < 4; ++ks) qf[ks] = *(const GAS bf16x8*)(z + tok * IN_W + Q_OFF + hq * HD + 16 * ks + 8 * hi);
        f32x16 s[5];
#pragma unroll
        for (int kt = 0; kt < 5; ++kt) {
            s[kt] = (f32x16){0.f, 0.f, 0.f, 0.f, 0.f, 0.f, 0.f, 0.f, 0.f, 0.f, 0.f, 0.f, 0.f, 0.f, 0.f, 0.f};
#pragma unroll
            for (int ks = 0; ks < 4; ++ks) {
                const bf16x8 kf = *(const LAS bf16x8*)(Ks + (32 * (qg + kt) + r32) * 72 + 16 * ks + 8 * hi);
                s[kt] = __builtin_amdgcn_mfma_f32_32x32x16_bf16(kf, qf[ks], s[kt], 0, 0, 0);
            }
        }
        float mx = sink2;
#pragma unroll
        for (int kt = 0; kt < 5; ++kt) {
            const bool tile_dead = (nb == 0) && (qg + kt < 4);
#pragma unroll
            for (int r = 0; r < 16; ++r) {
                const int krow = (r & 3) + 8 * (r >> 2) + 4 * hi;
                bool valid = !tile_dead;
                if (kt == 0) valid = valid && (krow > r32);
                if (kt == 4) valid = valid && (krow <= r32);
                const float v = valid ? s[kt][r] * sc : -INFINITY;
                s[kt][r] = v; mx = fmaxf(mx, v);
            }
        }
        mx = fmaxf(mx, __shfl_xor(mx, 32));
        float sum = 0.f;
#pragma unroll
        for (int kt = 0; kt < 5; ++kt)
#pragma unroll
            for (int r = 0; r < 16; ++r) { const float p = __builtin_amdgcn_exp2f(s[kt][r] - mx); s[kt][r] = p; sum += p; }
        sum += __shfl_xor(sum, 32);
        const float inv = 1.0f / (sum + __builtin_amdgcn_exp2f(sink2 - mx));
        f32x16 o[2];
        o[0] = (f32x16){0.f, 0.f, 0.f, 0.f, 0.f, 0.f, 0.f, 0.f, 0.f, 0.f, 0.f, 0.f, 0.f, 0.f, 0.f, 0.f}; o[1] = o[0];
#pragma unroll
        for (int kt = 0; kt < 5; ++kt)
#pragma unroll
            for (int s2 = 0; s2 < 2; ++s2) {
                v4u pw; pw.x = pg8::cvt_pk_bf16(s[kt][8 * s2 + 0], s[kt][8 * s2 + 1]); pw.y = pg8::cvt_pk_bf16(s[kt][8 * s2 + 2], s[kt][8 * s2 + 3]);
                pw.z = pg8::cvt_pk_bf16(s[kt][8 * s2 + 4], s[kt][8 * s2 + 5]); pw.w = pg8::cvt_pk_bf16(s[kt][8 * s2 + 6], s[kt][8 * s2 + 7]);
                const bf16x8 pa = __builtin_bit_cast(bf16x8, pw);
#pragma unroll
                for (int dt = 0; dt < 2; ++dt) {
                    const bf16x8 vf = *(const LAS bf16x8*)(Vt + (32 * dt + r32) * 264 + 32 * (qg + kt) + 16 * s2 + 8 * hi);
                    o[dt] = __builtin_amdgcn_mfma_f32_32x32x16_bf16(vf, pa, o[dt], 0, 0, 0);
                }
            }
        bf16* op = ao + tok * D + hq * HD;
#pragma unroll
        for (int dt = 0; dt < 2; ++dt)
#pragma unroll
            for (int g = 0; g < 4; ++g) {
                v2u w; w.x = pg8::cvt_pk_bf16(o[dt][4 * g + 0] * inv, o[dt][4 * g + 1] * inv); w.y = pg8::cvt_pk_bf16(o[dt][4 * g + 2] * inv, o[dt][4 * g + 3] * inv);
                *(GAS v2u*)(op + 32 * dt + 8 * g + 4 * hi) = w;
            }
    }
    __syncthreads();
}
__device__ __forceinline__ void conv_item(int item, const bf16* z, const float* cw, bf16* ci, int tid) {
    const int c8 = tid & 255, half = tid >> 8, t0 = 32 * item + 16 * half, c0 = 8 * c8;
    float w0[8], w1[8], w2[8], u1[8], u2[8];
#pragma unroll
    for (int e = 0; e < 8; ++e) { w0[e] = cw[c0 + e]; w1[e] = cw[2048 + c0 + e]; w2[e] = cw[4096 + c0 + e]; u1[e] = 0.f; u2[e] = 0.f; }
    if ((t0 & (SEQ - 1)) != 0) {
#pragma unroll
        for (int k = 0; k < 2; ++k) {
            const bf16* zr = z + (size_t)(t0 - 2 + k) * IN_W + c0;
            const v4u a = *(const GAS v4u*)(zr + CC_OFF), h = *(const GAS v4u*)(zr + CH_OFF);
            float u[8];
            u[0] = pg8::bf_lo(a.x) * pg8::bf_lo(h.x); u[1] = pg8::bf_hi(a.x) * pg8::bf_hi(h.x); u[2] = pg8::bf_lo(a.y) * pg8::bf_lo(h.y); u[3] = pg8::bf_hi(a.y) * pg8::bf_hi(h.y);
            u[4] = pg8::bf_lo(a.z) * pg8::bf_lo(h.z); u[5] = pg8::bf_hi(a.z) * pg8::bf_hi(h.z); u[6] = pg8::bf_lo(a.w) * pg8::bf_lo(h.w); u[7] = pg8::bf_hi(a.w) * pg8::bf_hi(h.w);
#pragma unroll
            for (int e = 0; e < 8; ++e) { if (k == 0) u2[e] = u[e]; else u1[e] = u[e]; }
        }
    }
#pragma unroll 4
    for (int i = 0; i < 16; ++i) {
        const bf16* zr = z + (size_t)(t0 + i) * IN_W + c0;
        const v4u a = *(const GAS v4u*)(zr + CC_OFF), h = *(const GAS v4u*)(zr + CH_OFF), bb = *(const GAS v4u*)(zr + CB_OFF);
        float u[8], cb[8], y[8];
        u[0] = pg8::bf_lo(a.x) * pg8::bf_lo(h.x); u[1] = pg8::bf_hi(a.x) * pg8::bf_hi(h.x); u[2] = pg8::bf_lo(a.y) * pg8::bf_lo(h.y); u[3] = pg8::bf_hi(a.y) * pg8::bf_hi(h.y);
        u[4] = pg8::bf_lo(a.z) * pg8::bf_lo(h.z); u[5] = pg8::bf_hi(a.z) * pg8::bf_hi(h.z); u[6] = pg8::bf_lo(a.w) * pg8::bf_lo(h.w); u[7] = pg8::bf_hi(a.w) * pg8::bf_hi(h.w);
        cb[0] = pg8::bf_lo(bb.x); cb[1] = pg8::bf_hi(bb.x); cb[2] = pg8::bf_lo(bb.y); cb[3] = pg8::bf_hi(bb.y); cb[4] = pg8::bf_lo(bb.z); cb[5] = pg8::bf_hi(bb.z); cb[6] = pg8::bf_lo(bb.w); cb[7] = pg8::bf_hi(bb.w);
#pragma unroll
        for (int e = 0; e < 8; ++e) { y[e] = cb[e] * (w0[e] * u2[e] + w1[e] * u1[e] + w2[e] * u[e]); u2[e] = u1[e]; u1[e] = u[e]; }
        v4u o; o.x = pk2(y[0], y[1]); o.y = pk2(y[2], y[3]); o.z = pk2(y[4], y[5]); o.w = pk2(y[6], y[7]);
        *(GAS v4u*)(ci + (size_t)(t0 + i) * D + c0) = o;
    }
}

__device__ __forceinline__ unsigned pack_i8(const f32x4 v) {
    const int a = __float2int_rn(v.x), b = __float2int_rn(v.y), c = __float2int_rn(v.z), d = __float2int_rn(v.w);
    return ((unsigned)a & 0xffu) | (((unsigned)b & 0xffu) << 8) | (((unsigned)c & 0xffu) << 16) | ((unsigned)d << 24);
}
__device__ __forceinline__ unsigned pack_i8_2(float a, float b, float c, float d) {
    const int ia = __float2int_rn(a), ib = __float2int_rn(b), ic = __float2int_rn(c), id = __float2int_rn(d);
    return ((unsigned)ia & 0xffu) | (((unsigned)ib & 0xffu) << 8) | (((unsigned)ic & 0xffu) << 16) | ((unsigned)id << 24);
}
__device__ __forceinline__ void ln1_row(bf16* hbrow, signed char* xqrow, float* sxp, const float* g, const float* bta, int lane) {
    GAS v4u* xr = (GAS v4u*)hbrow + lane;
    float v[4][8]; float s = 0.f;
#pragma unroll
    for (int j = 0; j < 4; ++j) { const v4u w = xr[64 * j];
        v[j][0] = pg8::bf_lo(w.x); v[j][1] = pg8::bf_hi(w.x); v[j][2] = pg8::bf_lo(w.y); v[j][3] = pg8::bf_hi(w.y); v[j][4] = pg8::bf_lo(w.z); v[j][5] = pg8::bf_hi(w.z); v[j][6] = pg8::bf_lo(w.w); v[j][7] = pg8::bf_hi(w.w);
#pragma unroll
        for (int e = 0; e < 8; ++e) s += v[j][e]; }
    const float mean = wave_sum(s) * (1.f / D); float s2 = 0.f;
#pragma unroll
    for (int j = 0; j < 4; ++j)
#pragma unroll
        for (int e = 0; e < 8; ++e) { v[j][e] -= mean; s2 += v[j][e] * v[j][e]; }
    const float rstd = 1.f / sqrtf(wave_sum(s2) * (1.f / D) + LN_EPS);
    float mx = 0.f;
#pragma unroll
    for (int j = 0; j < 4; ++j) {
        const GAS f32x4* gp = (const GAS f32x4*)g + 2 * (lane + 64 * j); const GAS f32x4* bp = (const GAS f32x4*)bta + 2 * (lane + 64 * j);
        const f32x4 g0 = gp[0], g1 = gp[1], b0 = bp[0], b1 = bp[1];
        v[j][0] = v[j][0] * rstd * g0.x + b0.x; v[j][1] = v[j][1] * rstd * g0.y + b0.y; v[j][2] = v[j][2] * rstd * g0.z + b0.z; v[j][3] = v[j][3] * rstd * g0.w + b0.w;
        v[j][4] = v[j][4] * rstd * g1.x + b1.x; v[j][5] = v[j][5] * rstd * g1.y + b1.y; v[j][6] = v[j][6] * rstd * g1.z + b1.z; v[j][7] = v[j][7] * rstd * g1.w + b1.w;
        v4u o; o.x = pk2(v[j][0], v[j][1]); o.y = pk2(v[j][2], v[j][3]); o.z = pk2(v[j][4], v[j][5]); o.w = pk2(v[j][6], v[j][7]);
        xr[64 * j] = o;
#pragma unroll
        for (int e = 0; e < 8; ++e) mx = fmaxf(mx, fabsf(v[j][e]));
    }
#pragma unroll
    for (int o = 1; o < 64; o <<= 1) mx = fmaxf(mx, __shfl_xor(mx, o));
    const float qs = mx > 0.f ? 127.0f / mx : 1.0f;
    GAS v2u* q8 = (GAS v2u*)xqrow + lane;
#pragma unroll
    for (int j = 0; j < 4; ++j) { v2u o; o.x = pack_i8_2(v[j][0] * qs, v[j][1] * qs, v[j][2] * qs, v[j][3] * qs); o.y = pack_i8_2(v[j][4] * qs, v[j][5] * qs, v[j][6] * qs, v[j][7] * qs); q8[64 * j] = o; }
    if (lane == 0) *sxp = mx > 0.f ? mx * (1.0f / 127.0f) : 1.0f;
}

__device__ __forceinline__ void row_f32_to_i8(const float* src, signed char* dst, float* inv, int lane) {
    f32x4 v[8]; float mx = 0.f;
#pragma unroll
    for (int j = 0; j < 8; ++j) { v[j] = *((const GAS f32x4*)src + lane + 64 * j); mx = fmaxf(mx, fmaxf(fmaxf(fabsf(v[j].x), fabsf(v[j].y)), fmaxf(fabsf(v[j].z), fabsf(v[j].w)))); }
#pragma unroll
    for (int o = 1; o < 64; o <<= 1) mx = fmaxf(mx, __shfl_xor(mx, o));
    const float sc = mx > 0.f ? 127.0f / mx : 1.0f;
#pragma unroll
    for (int j = 0; j < 8; ++j) *((GAS unsigned*)dst + lane + 64 * j) = pack_i8_2(v[j].x * sc, v[j].y * sc, v[j].z * sc, v[j].w * sc);
    if (lane == 0) *inv = mx > 0.f ? mx * (1.0f / 127.0f) : 1.0f;
}
__device__ __forceinline__ void row_bf16_to_i8(const bf16* src, signed char* dst, float* inv, int lane) {
    float v[4][8]; float mx = 0.f;
#pragma unroll
    for (int j = 0; j < 4; ++j) { const v4u w = *((const GAS v4u*)src + lane + 64 * j);
        v[j][0] = pg8::bf_lo(w.x); v[j][1] = pg8::bf_hi(w.x); v[j][2] = pg8::bf_lo(w.y); v[j][3] = pg8::bf_hi(w.y); v[j][4] = pg8::bf_lo(w.z); v[j][5] = pg8::bf_hi(w.z); v[j][6] = pg8::bf_lo(w.w); v[j][7] = pg8::bf_hi(w.w);
#pragma unroll
        for (int e = 0; e < 8; ++e) mx = fmaxf(mx, fabsf(v[j][e])); }
#pragma unroll
    for (int o = 1; o < 64; o <<= 1) mx = fmaxf(mx, __shfl_xor(mx, o));
    const float sc = mx > 0.f ? 127.0f / mx : 1.0f;
#pragma unroll
    for (int j = 0; j < 4; ++j) { v2u o; o.x = pack_i8_2(v[j][0] * sc, v[j][1] * sc, v[j][2] * sc, v[j][3] * sc); o.y = pack_i8_2(v[j][4] * sc, v[j][5] * sc, v[j][6] * sc, v[j][7] * sc); *((GAS v2u*)dst + lane + 64 * j) = o; }
    if (lane == 0) *inv = mx > 0.f ? mx * (1.0f / 127.0f) : 1.0f;
}

constexpr int TK_ROWF = 136;
constexpr int TK_IDX_OFF = 256 * TK_ROWF * 4;
__device__ __forceinline__ void topk_core(LAS unsigned char* lds, size_t prob0, int pstride, int* experts, float* gates, int tid) {
    LAS float* S = (LAS float*)lds;
    LAS unsigned char* IDX = lds + TK_IDX_OFF;
    const int row = tid >> 1, sub = tid & 1;
#define TK_CE(a, b) do { const float h_ = vmaxf(a, b), l_ = vminf(a, b); a = h_; b = l_; } while (0)
#define TK_SORT16(V) do { _Pragma("unroll") for (int k_ = 2; k_ <= 16; k_ <<= 1) _Pragma("unroll") for (int j_ = k_ >> 1; j_ > 0; j_ >>= 1) _Pragma("unroll") for (int i_ = 0; i_ < 16; ++i_) { \
        const int l_i = i_ ^ j_; if (l_i > i_) { if ((i_ & k_) == 0) TK_CE(V[i_], V[l_i]); else TK_CE(V[l_i], V[i_]); } } } while (0)
#define TK_MERGE16(Lv, Xv) do { _Pragma("unroll") for (int j_ = 0; j_ < 16; ++j_) Lv[j_] = vmaxf(Lv[j_], Xv[15 - j_]); \
        _Pragma("unroll") for (int st_ = 8; st_ >= 1; st_ >>= 1) _Pragma("unroll") for (int j_ = 0; j_ < 16; ++j_) if ((j_ & st_) == 0) TK_CE(Lv[j_], Lv[j_ + st_]); } while (0)
    float L[16];
#pragma unroll
    for (int q = 0; q < 4; ++q) {
        float C[16];
#pragma unroll
        for (int i = 0; i < 4; ++i) { const int c4 = 2 * (4 * q + i) + sub;
            const f32x4 v = *(const LAS f32x4*)(S + row * TK_ROWF + 4 * c4);
#pragma unroll
            for (int e = 0; e < 4; ++e) { const float ve = v[e];
                C[4 * i + e] = __uint_as_float((__float_as_uint(ve) & ~0x7Fu) | (unsigned)(4 * c4 + e)); } }
        TK_SORT16(C);
        if (q == 0) {
#pragma unroll
            for (int j = 0; j < 16; ++j) L[j] = C[j];
        } else TK_MERGE16(L, C);
    }
    {
        float P[16];
#pragma unroll
        for (int j = 0; j < 16; ++j) P[j] = __shfl_xor(L[j], 1);
        TK_MERGE16(L, P);
    }
    if (sub == 0) {
#pragma unroll
        for (int q = 0; q < 4; ++q) {
            unsigned w = 0;
#pragma unroll
            for (int e = 0; e < 4; ++e) w |= (__builtin_bit_cast(unsigned, L[4 * q + e]) & 0x7Fu) << (8 * e);
            *(LAS unsigned*)(IDX + row * 16 + 4 * q) = w;
        }
    }
    float A[16], B[16];
#pragma unroll
    for (int j = 0; j < 16; ++j) { const float o = __shfl_xor(L[j], 2); const bool isb = (tid & 2) != 0; A[j] = isb ? o : L[j]; B[j] = isb ? L[j] : o; }
#define TK_KEY(i, j) __uint_as_float((__float_as_uint(A[i] + B[j]) & ~0xFFu) | (unsigned)(255 - ((i) * 16 + (j))))
    float F[16], X[16];
#pragma unroll
    for (int j = 0; j < 16; ++j) F[j] = TK_KEY(0, j);
#pragma unroll
    for (int i = 1; i < 16; ++i) X[i - 1] = TK_KEY(i, 0);
    X[15] = -INFINITY; TK_MERGE16(F, X);
#pragma unroll
    for (int i = 0; i < 16; ++i) X[i] = -INFINITY;
#pragma unroll
    for (int i = 1; i <= 7; ++i) X[i - 1] = TK_KEY(i, 1);
    TK_MERGE16(F, X);
#pragma unroll
    for (int i = 0; i < 16; ++i) X[i] = -INFINITY;
#pragma unroll
    for (int j = 2; j <= 7; ++j) X[j - 2] = TK_KEY(1, j);
    TK_MERGE16(F, X);
    { const float rest[6] = {TK_KEY(2, 2), TK_KEY(2, 3), TK_KEY(2, 4), TK_KEY(3, 2), TK_KEY(3, 3), TK_KEY(4, 2)};
#pragma unroll
      for (int r = 0; r < 6; ++r) { float x = rest[r];
#pragma unroll
          for (int k = 0; k < 16; ++k) { const float h = vmaxf(F[k], x); x = vminf(F[k], x); F[k] = h; } } }
    __syncthreads();
    if ((tid & 3) == 0) {
        const int rowA = (tid >> 2) * 2, rowB = rowA + 1;
        const size_t prob = prob0 + (size_t)pstride * (tid >> 2);
        float g[16]; int ex[16]; float gs = 0.f;
#pragma unroll
        for (int k = 0; k < 16; ++k) {
            const unsigned code = 255u - (__builtin_bit_cast(unsigned, F[k]) & 0xFFu);
            const int ia = IDX[rowA * 16 + (code >> 4)], ib = IDX[rowB * 16 + (code & 15)];
            ex[k] = ia * PNK + ib;
            g[k] = __expf(F[k] - F[0]); gs += g[k];
        }
        const float ginv = 1.0f / gs;
#pragma unroll
        for (int q = 0; q < 4; ++q) {
            *(GAS f32x4*)(gates + prob * 16 + 4 * q) = (f32x4){g[4 * q] * ginv, g[4 * q + 1] * ginv, g[4 * q + 2] * ginv, g[4 * q + 3] * ginv};
            typedef int i32x4 __attribute__((ext_vector_type(4)));
            *(GAS i32x4*)(experts + prob * 16 + 4 * q) = (i32x4){ex[4 * q], ex[4 * q + 1], ex[4 * q + 2], ex[4 * q + 3]};
        }
    }
    __syncthreads();
}
__device__ __forceinline__ void topk_pass(int pass, const float* scores, int* experts, float* gates, LAS unsigned char* lds, int tid) {
    LAS float* S = (LAS float*)lds;
    const float* src = scores + (size_t)pass * (256 * 128);
#pragma unroll 4
    for (int i = 0; i < 16; ++i) { const int f4 = tid + NTHREADS * i, row = f4 >> 5, c4 = f4 & 31; *(LAS f32x4*)(S + row * TK_ROWF + 4 * c4) = *(const GAS f32x4*)(src + (size_t)f4 * 4); }
    __syncthreads();
    topk_core(lds, (size_t)pass * 128, 1, experts, gates, tid);
}
struct EpiTopKI8 {
    static constexpr bool PERM = false, AFTER_DRAIN = true;
    int* experts; float* gates; const float* sa; const float* sb;
    __device__ __forceinline__ void fused(pg8::i32x4 (&acc)[2][2][4][2], const pg8::Unit& u, int wr, int wc, int fr, int fq, LAS unsigned char* lds, int wid, int lane) const {
        LAS float* S = (LAS float*)lds;
        const int tid = wid * 64 + lane;
        pg8::f32x4 sbv[2][2];
#pragma unroll
        for (int bj = 0; bj < 2; ++bj)
#pragma unroll
            for (int n = 0; n < 2; ++n) sbv[bj][n] = *(const GAS pg8::f32x4*)(sb + u.pn * 256 + bj * 128 + 32 * wc + 16 * n + 4 * fq);
#pragma unroll
        for (int ai = 0; ai < 2; ++ai) {
#pragma unroll
            for (int mm = 0; mm < 4; ++mm) { const int rl = 64 * wr + 16 * mm + fr; const float sr = sa[u.pm * 256 + 128 * ai + rl];
#pragma unroll
                for (int bj = 0; bj < 2; ++bj)
#pragma unroll
                    for (int n = 0; n < 2; ++n) { const pg8::i32x4 a = acc[ai][bj][mm][n];
                        *(LAS pg8::f32x4*)(S + (2 * rl + bj) * TK_ROWF + 32 * wc + 16 * n + 4 * fq) = (pg8::f32x4){(float)a[0], (float)a[1], (float)a[2], (float)a[3]} * sbv[bj][n] * sr; } }
            __syncthreads();
            topk_core(lds, ((size_t)u.pm * 256 + 128 * ai) * PH + u.pn, PH, experts, gates, tid);
        }
    }
};
struct EpiTopK {
    static constexpr bool PERM = false, AFTER_DRAIN = true;
    int* experts; float* gates;
    __device__ __forceinline__ void fused(pg8::f32x4 (&acc)[2][2][4][2], const pg8::Unit& u, int wr, int wc, int fr, int fq, LAS unsigned char* lds, int wid, int lane) const {
        LAS float* S = (LAS float*)lds;
        const int tid = wid * 64 + lane;
#pragma unroll
        for (int ai = 0; ai < 2; ++ai) {
#pragma unroll
            for (int bj = 0; bj < 2; ++bj)
#pragma unroll
                for (int mm = 0; mm < 4; ++mm)
#pragma unroll
                    for (int n = 0; n < 2; ++n) { const int rl = 64 * wr + 16 * mm + fr; *(LAS pg8::f32x4*)(S + (2 * rl + bj) * TK_ROWF + 32 * wc + 16 * n + 4 * fq) = acc[ai][bj][mm][n]; }
            __syncthreads();
            topk_core(lds, ((size_t)u.pm * 256 + 128 * ai) * PH + u.pn, PH, experts, gates, tid);
        }
    }
};

__device__ __forceinline__ float gelu_erf(float v) { return 0.5f * v * (1.0f + erff(v * 0.70710678118654752f)); }
typedef __bf16 bf16x2_t __attribute__((ext_vector_type(2)));
typedef float f32x2_t __attribute__((ext_vector_type(2)));
__device__ __forceinline__ float dot2bf(bf16x2_t a, unsigned b, float acc) { return __builtin_amdgcn_fdot2_f32_bf16(a, __builtin_bit_cast(bf16x2_t, b), acc, false); }
__device__ __forceinline__ float dot4f8(unsigned w8, unsigned x01, unsigned x23, float acc) {
    acc = dot2bf(__builtin_amdgcn_cvt_scalef32_pk_bf16_fp8(w8, 1.0f, false), x01, acc);
    return dot2bf(__builtin_amdgcn_cvt_scalef32_pk_bf16_fp8(w8, 1.0f, true), x23, acc);
}
__device__ __forceinline__ void axpy4f8(float* y, unsigned w8, float w) {
    const f32x2_t lo = __builtin_amdgcn_cvt_pk_f32_fp8(w8, false), hi = __builtin_amdgcn_cvt_pk_f32_fp8(w8, true);
    y[0] += w * lo.x; y[1] += w * lo.y; y[2] += w * hi.x; y[3] += w * hi.y;
}
__device__ __forceinline__ void axpy4f8v(f32x2_t* y2, unsigned w8, float w) {
    const f32x2_t lo = __builtin_amdgcn_cvt_pk_f32_fp8(w8, false), hi = __builtin_amdgcn_cvt_pk_f32_fp8(w8, true);
    const f32x2_t ww = {w, w};
    y2[0] = __builtin_elementwise_fma(lo, ww, y2[0]); y2[1] = __builtin_elementwise_fma(hi, ww, y2[1]);
}
__device__ __forceinline__ void row_to_fp8(const float* src, unsigned char* dst, float* inv, int lane) {
    f32x4 v[2][4]; float mx = 0.f;
#pragma unroll
    for (int j = 0; j < 2; ++j)
#pragma unroll
        for (int q = 0; q < 4; ++q) { v[j][q] = *((const GAS f32x4*)src + 4 * (lane + 64 * j) + q);
            mx = fmaxf(mx, fmaxf(fmaxf(fabsf(v[j][q].x), fabsf(v[j][q].y)), fmaxf(fabsf(v[j][q].z), fabsf(v[j][q].w)))); }
#pragma unroll
    for (int o = 1; o < 64; o <<= 1) mx = fmaxf(mx, __shfl_xor(mx, o));
    const float sc = mx > 0.f ? 384.0f / mx : 1.0f;
#pragma unroll
    for (int j = 0; j < 2; ++j) { v4u o;
        int w;
        w = 0; w = __builtin_amdgcn_cvt_pk_fp8_f32(v[j][0].x * sc, v[j][0].y * sc, w, false); w = __builtin_amdgcn_cvt_pk_fp8_f32(v[j][0].z * sc, v[j][0].w * sc, w, true); o.x = (unsigned)w;
        w = 0; w = __builtin_amdgcn_cvt_pk_fp8_f32(v[j][1].x * sc, v[j][1].y * sc, w, false); w = __builtin_amdgcn_cvt_pk_fp8_f32(v[j][1].z * sc, v[j][1].w * sc, w, true); o.y = (unsigned)w;
        w = 0; w = __builtin_amdgcn_cvt_pk_fp8_f32(v[j][2].x * sc, v[j][2].y * sc, w, false); w = __builtin_amdgcn_cvt_pk_fp8_f32(v[j][2].z * sc, v[j][2].w * sc, w, true); o.z = (unsigned)w;
        w = 0; w = __builtin_amdgcn_cvt_pk_fp8_f32(v[j][3].x * sc, v[j][3].y * sc, w, false); w = __builtin_amdgcn_cvt_pk_fp8_f32(v[j][3].z * sc, v[j][3].w * sc, w, true); o.w = (unsigned)w;
        { const int ch = lane + 64 * j; *((GAS v4u*)(dst + (size_t)(ch >> 4) * SLICE_BYTES) + (ch & 15)) = o; } }
    if (lane == 0) *inv = mx > 0.f ? mx * (1.0f / 384.0f) : 1.0f;
}
__device__ __forceinline__ void row_to_i8(const float* src, unsigned char* dst, float* inv, int lane) {
    f32x4 v[2][4]; float mx = 0.f;
#pragma unroll
    for (int j = 0; j < 2; ++j)
#pragma unroll
        for (int q = 0; q < 4; ++q) { v[j][q] = *((const GAS f32x4*)src + 4 * (lane + 64 * j) + q);
            mx = fmaxf(mx, fmaxf(fmaxf(fabsf(v[j][q].x), fabsf(v[j][q].y)), fmaxf(fabsf(v[j][q].z), fabsf(v[j][q].w)))); }
#pragma unroll
    for (int o = 1; o < 64; o <<= 1) mx = fmaxf(mx, __shfl_xor(mx, o));
    const float sc = mx > 0.f ? 127.0f / mx : 1.0f;
#pragma unroll
    for (int j = 0; j < 2; ++j) { v4u o; o.x = pack_i8(v[j][0] * sc); o.y = pack_i8(v[j][1] * sc); o.z = pack_i8(v[j][2] * sc); o.w = pack_i8(v[j][3] * sc);
        { const int ch = lane + 64 * j; *((GAS v4u*)(dst + (size_t)(ch >> 4) * SLICE_BYTES) + (ch & 15)) = o; } }
    if (lane == 0) *inv = mx > 0.f ? mx * (1.0f / 127.0f) : 1.0f;
}
__device__ __forceinline__ float row16_allsum(float a) {
    a += __builtin_bit_cast(float, __builtin_amdgcn_update_dpp(0, __builtin_bit_cast(int, a), 0x128, 0xf, 0xf, false));
    a += __builtin_bit_cast(float, __builtin_amdgcn_update_dpp(0, __builtin_bit_cast(int, a), 0x124, 0xf, 0xf, false));
    a += __builtin_bit_cast(float, __builtin_amdgcn_update_dpp(0, __builtin_bit_cast(int, a), 0x122, 0xf, 0xf, false));
    a += __builtin_bit_cast(float, __builtin_amdgcn_update_dpp(0, __builtin_bit_cast(int, a), 0x121, 0xf, 0xf, false));
    return a;
}
__device__ __forceinline__ int q_pull(unsigned* q, int lane) { int v = 0; if (lane == 0) v = (int)__hip_atomic_fetch_add(q, 1u, __ATOMIC_RELAXED, __HIP_MEMORY_SCOPE_AGENT); return __builtin_amdgcn_readfirstlane(v); }
constexpr int PEER_TG = 8;
constexpr int PEER_N8 = 640, PEER_N4 = 512, PEER_N2 = 512, PEER_NTASK = PEER_N8 + PEER_N4 + PEER_N2;
__device__ __forceinline__ void peer_task_tokens(int idx, int& t0, int& n) {
    if (idx < PEER_N8) { t0 = 8 * idx; n = 8; } else if (idx < PEER_N8 + PEER_N4) { t0 = 8 * PEER_N8 + 4 * (idx - PEER_N8); n = 4; } else { t0 = 8 * PEER_N8 + 4 * PEER_N4 + 2 * (idx - PEER_N8 - PEER_N4); n = 2; }
}
__device__ __forceinline__ int row16_allsum_i(int a) {
    a += __builtin_amdgcn_update_dpp(0, a, 0x128, 0xf, 0xf, false);
    a += __builtin_amdgcn_update_dpp(0, a, 0x124, 0xf, 0xf, false);
    a += __builtin_amdgcn_update_dpp(0, a, 0x122, 0xf, 0xf, false);
    a += __builtin_amdgcn_update_dpp(0, a, 0x121, 0xf, 0xf, false);
    return a;
}
#define PA_LOAD(R, IDV, HALF) do { _Pragma("unroll") for (int i_ = 0; i_ < 8; ++i_) { const unsigned e_ = (unsigned)__shfl(IDV, 4 * (i_ + 8 * (HALF)) + g); \
        R[i_] = *(const GAS v4u*)(ub + (e_ * 256u + offc)); } } while (0)
#define PA_COMP(R, HALF) do { _Pragma("unroll") for (int i_ = 0; i_ < 8; ++i_) { int a_ = __builtin_amdgcn_sdot4((int)R[i_].x, (int)xc.x, 0, false); a_ = __builtin_amdgcn_sdot4((int)R[i_].y, (int)xc.y, a_, false); \
        a_ = __builtin_amdgcn_sdot4((int)R[i_].z, (int)xc.z, a_, false); a_ = __builtin_amdgcn_sdot4((int)R[i_].w, (int)xc.w, a_, false); r16[8 * (HALF) + i_] = row16_allsum_i(a_); } } while (0)
__device__ __forceinline__ void peer_a_task(int t0, int ntok, int s, const signed char* xq, const int* experts, const unsigned char* u8s, int* pa, int lane_) {
    int lane = lane_; asm volatile("" : "+v"(lane));
    const int g = lane >> 4, c = lane & 15;
    const GAS unsigned char* ub = (const GAS unsigned char*)(u8s + (size_t)s * SLICE_BYTES);
    const unsigned offc = 16u * (unsigned)c;
    int idc0 = experts[(size_t)t0 * 128 + lane], idc1 = experts[(size_t)t0 * 128 + lane + 64];
    v4u xc = *(const GAS v4u*)(xq + (size_t)t0 * D + 256 * s + 16 * c);
    v4u RA[8], RB[8];
    PA_LOAD(RA, idc0, 0);
#pragma unroll 1
    for (int tt = 0; tt < ntok; ++tt) {
        const int t = t0 + tt, tn = tt + 1 < ntok ? t + 1 : t;
        const int idn0 = experts[(size_t)tn * 128 + lane], idn1 = experts[(size_t)tn * 128 + lane + 64];
        const v4u xn = *(const GAS v4u*)(xq + (size_t)tn * D + 256 * s + 16 * c);
#pragma unroll 1
        for (int hb = 0; hb < 2; ++hb) {
            const int idv = hb ? idc1 : idc0, idx = hb ? idn0 : idc1;
            int r16[16];
            PA_LOAD(RB, idv, 1); PA_COMP(RA, 0);
            asm volatile("" ::: "memory");
            PA_LOAD(RA, idx, 0); PA_COMP(RB, 1);
            if (c == 15) { typedef int i32x4 __attribute__((ext_vector_type(4))); GAS i32x4* dst = (GAS i32x4*)(pa + ((size_t)t * 8 + s) * 128 + g * 32 + 16 * hb);
#pragma unroll
                for (int q = 0; q < 4; ++q) dst[q] = (i32x4){r16[4 * q], r16[4 * q + 1], r16[4 * q + 2], r16[4 * q + 3]}; }
        }
        idc0 = idn0; idc1 = idn1; xc = xn;
    }
}
constexpr int PA_CH = 56, PA_NCH = (M + PA_CH - 1) / PA_CH, PA_NCH4 = (PA_NCH + 3) & ~3;
constexpr int PA_XT = 131072, PA_XTB = PA_CH * 256, PA_LOFF = PA_XT + 2 * PA_XTB;
static_assert(PA_LOFF + PA_NCH4 * 8 <= LDSCTL_OFF, "LDS map");
__device__ __forceinline__ void peer_shard_load(int s, int r, const unsigned char* u8s, LAS unsigned char* lds, int tid_) {
    int tid = tid_; asm volatile("" : "+v"(tid));
    const GAS unsigned char* src = (const GAS unsigned char*)(u8s + (size_t)s * SLICE_BYTES);
#pragma unroll 1
    for (int h = 0; h < 2; ++h) { v4u t[8];
#pragma unroll
        for (int j = 0; j < 8; ++j) { const int piece = tid + NTHREADS * (8 * h + j), el = piece >> 4, i = el >> 2, jj = ((r - i) & 31) + 32 * (el & 3);
            t[j] = *(const GAS v4u*)(src + ((size_t)(i * 128 + jj) * 256 + (size_t)((piece & 15) << 4))); }
#pragma unroll
        for (int j = 0; j < 8; ++j) *(LAS v4u*)(lds + 16 * (tid + NTHREADS * (8 * h + j))) = t[j]; }
}
__device__ __forceinline__ void peer_bucket(int q, const int* experts, unsigned* seg, int* soff, LAS unsigned char* lds, int tid_) {
    int tid = tid_; asm volatile("" : "+v"(tid));
    LAS int* cnt = (LAS int*)(lds + PA_XT);
    if (tid < 128) cnt[tid] = 0;
    __syncthreads();
    const int ntok = (M - q * PA_CH) < PA_CH ? (M - q * PA_CH) : PA_CH, nent = ntok * 128;
    const GAS int* ex = (const GAS int*)(experts + (size_t)q * PA_CH * 128);
    int ev[14];
#pragma unroll
    for (int j = 0; j < 14; ++j) { const int i = tid + NTHREADS * j; ev[j] = i < nent ? ex[i] : -1; }
#pragma unroll
    for (int j = 0; j < 14; ++j) if (ev[j] >= 0) __hip_atomic_fetch_add(cnt + (((ev[j] >> 7) + ev[j]) & 31), 1, __ATOMIC_RELAXED, __HIP_MEMORY_SCOPE_WORKGROUP);
    __syncthreads();
    if (tid < 64) { const int c = tid < 32 ? cnt[tid] : 0; int inc = c;
#pragma unroll
        for (int o = 1; o < 32; o <<= 1) { const int v = __shfl_up(inc, o); if (tid >= o) inc += v; }
        if (tid < 32) { cnt[32 + tid] = inc - c; soff[q * 33 + tid] = inc - c; if (tid == 31) soff[q * 33 + 32] = inc; } }
    __syncthreads();
    GAS unsigned* sg = (GAS unsigned*)(seg + (size_t)q * (PA_CH * 128));
#pragma unroll
    for (int j = 0; j < 14; ++j) if (ev[j] >= 0) { const int i = tid + NTHREADS * j, e = ev[j], r = ((e >> 7) + e) & 31;
        const int p = cnt[32 + r] + __hip_atomic_fetch_add(cnt + 96 + r, 1, __ATOMIC_RELAXED, __HIP_MEMORY_SCOPE_WORKGROUP);
        sg[p] = ((unsigned)(i >> 7) << 16) | ((unsigned)(i & 127) << 9) | (unsigned)(((e >> 7) << 2) | ((e >> 5) & 3)); }
    __syncthreads();
}
#define PAL_ISSUE(U, X, ENT, XT) do { const unsigned ua_ = ((ENT) & 511u) * 256u + l16, xa_ = (XT) + ((ENT) >> 16) * 256u + l16; \
        _Pragma("unroll") for (int j_ = 0; j_ < 8; ++j_) { U[j_] = *(const LAS v4u*)(ua_ ^ (unsigned)(j_ << 4)); X[j_] = *(const LAS v4u*)(xa_ ^ (unsigned)(j_ << 4)); } } while (0)
#define PAL_DOTS(U, X, ACC) do { int a0_ = 0, a1_ = 0; \
        _Pragma("unroll") for (int j_ = 0; j_ < 8; j_ += 2) { \
            a0_ = __builtin_amdgcn_sdot4((int)U[j_].x, (int)X[j_].x, a0_, false); a1_ = __builtin_amdgcn_sdot4((int)U[j_ + 1].x, (int)X[j_ + 1].x, a1_, false); \
            a0_ = __builtin_amdgcn_sdot4((int)U[j_].y, (int)X[j_].y, a0_, false); a1_ = __builtin_amdgcn_sdot4((int)U[j_ + 1].y, (int)X[j_ + 1].y, a1_, false); \
            a0_ = __builtin_amdgcn_sdot4((int)U[j_].z, (int)X[j_].z, a0_, false); a1_ = __builtin_amdgcn_sdot4((int)U[j_ + 1].z, (int)X[j_ + 1].z, a1_, false); \
            a0_ = __builtin_amdgcn_sdot4((int)U[j_].w, (int)X[j_].w, a0_, false); a1_ = __builtin_amdgcn_sdot4((int)U[j_ + 1].w, (int)X[j_ + 1].w, a1_, false); } \
        a0_ += a1_; ACC = a0_ + __builtin_amdgcn_update_dpp(0, a0_, 0x128, 0xf, 0xf, false); } while (0)
#define PAL_LOAD(Q, XA, XB, EN) do { int q_ = (Q); q_ = q_ < PA_NCH4 ? q_ : PA_NCH4 - 1; const GAS unsigned char* xq_ = xb + (size_t)q_ * (PA_CH * D); \
        XA = *(const GAS v4u*)(xq_ + voff0); XB = *(const GAS v4u*)(xq_ + voff1); EN = sg[(unsigned)(loff[2 * q_] + pidx)]; } while (0)
#define PAL_WRITE(Q, XA, XB) do { const int b_ = PA_XT + ((Q) & 1) * PA_XTB + 16 * tid; *(LAS v4u*)(lds + b_) = XA; if (tid < (PA_CH - 32) * 16) *(LAS v4u*)(lds + b_ + 16 * NTHREADS) = XB; } while (0)
#define PAL_STORE(QQ, E, A) do { const unsigned k_ = ((E) >> 9) & 127u; pa[((size_t)((QQ) * PA_CH + (int)((E) >> 16)) * 8 + s) * 128 + (k_ & 3u) * 32u + (k_ >> 2)] = (A); } while (0)
#define CV_NONE do { } while (0)
#define CV_ISSUE do { if (late && cv_it < 16) { const GAS f32x4* src_ = (const GAS f32x4*)(pv + (size_t)(cv_e0 + cv_it) * D); \
        _Pragma("unroll") for (int j_ = 0; j_ < 2; ++j_) _Pragma("unroll") for (int q_ = 0; q_ < 4; ++q_) cvr[j_][q_] = src_[4 * (lane + 64 * j_) + q_]; } } while (0)
#define CV_FINISH do { if (late && cv_it < 16) { float mx_ = 0.f; \
        _Pragma("unroll") for (int j_ = 0; j_ < 2; ++j_) _Pragma("unroll") for (int q_ = 0; q_ < 4; ++q_) mx_ = fmaxf(mx_, fmaxf(fmaxf(fabsf(cvr[j_][q_].x), fabsf(cvr[j_][q_].y)), fmaxf(fabsf(cvr[j_][q_].z), fabsf(cvr[j_][q_].w)))); \
        _Pragma("unroll") for (int o_ = 1; o_ < 64; o_ <<= 1) mx_ = fmaxf(mx_, __shfl_xor(mx_, o_)); \
        const float sc_ = mx_ > 0.f ? 384.0f / mx_ : 1.0f; const int e_ = cv_e0 + cv_it; \
        _Pragma("unroll") for (int j_ = 0; j_ < 2; ++j_) { v4u o_; int w_; \
            w_ = 0; w_ = __builtin_amdgcn_cvt_pk_fp8_f32(cvr[j_][0].x * sc_, cvr[j_][0].y * sc_, w_, false); w_ = __builtin_amdgcn_cvt_pk_fp8_f32(cvr[j_][0].z * sc_, cvr[j_][0].w * sc_, w_, true); o_.x = (unsigned)w_; \
            w_ = 0; w_ = __builtin_amdgcn_cvt_pk_fp8_f32(cvr[j_][1].x * sc_, cvr[j_][1].y * sc_, w_, false); w_ = __builtin_amdgcn_cvt_pk_fp8_f32(cvr[j_][1].z * sc_, cvr[j_][1].w * sc_, w_, true); o_.y = (unsigned)w_; \
            w_ = 0; w_ = __builtin_amdgcn_cvt_pk_fp8_f32(cvr[j_][2].x * sc_, cvr[j_][2].y * sc_, w_, false); w_ = __builtin_amdgcn_cvt_pk_fp8_f32(cvr[j_][2].z * sc_, cvr[j_][2].w * sc_, w_, true); o_.z = (unsigned)w_; \
            w_ = 0; w_ = __builtin_amdgcn_cvt_pk_fp8_f32(cvr[j_][3].x * sc_, cvr[j_][3].y * sc_, w_, false); w_ = __builtin_amdgcn_cvt_pk_fp8_f32(cvr[j_][3].z * sc_, cvr[j_][3].w * sc_, w_, true); o_.w = (unsigned)w_; \
            const int ch_ = lane + 64 * j_; *((GAS v4u*)(v8 + (size_t)e_ * 256 + (size_t)(ch_ >> 4) * SLICE_BYTES) + (ch_ & 15)) = o_; } \
        if (lane == 0) sv[e_] = mx_ > 0.f ? mx_ * (1.0f / 384.0f) : 1.0f; } } while (0)
#define PAL_STEP(Q, WXA, WXB, CXA, CXB, CEN, HOOK) do { const int q_s = (Q); \
        __syncthreads();                       \
        const unsigned e0_ = CEN; const int nb_s = loff[2 * q_s], n_s = loff[2 * q_s + 1]; const unsigned xt_s = (unsigned)(PA_XT + (q_s & 1) * PA_XTB); \
        PAL_LOAD(q_s + 4, CXA, CXB, CEN);        \
        if (late) { if (pidx < n_prev) { int a_; PAL_DOTS(U, X, a_); if (!(tid & 8)) PAL_STORE(q_s - 1, e_prev, a_); } } \
        _Pragma("unroll 1") for (int i_ = pidx + NTHREADS / 2; i_ < n_s; i_ += NTHREADS / 2) { const unsigned e1_ = sg[nb_s + i_]; PAL_ISSUE(U, X, e1_, xt_s); int a_; PAL_DOTS(U, X, a_); if (!(tid & 8)) PAL_STORE(q_s, e1_, a_); }        \
        PAL_WRITE(q_s + 1, WXA, WXB); \
        if (pidx < n_s) PAL_ISSUE(U, X, e0_, xt_s); \
        __builtin_amdgcn_sched_barrier(0); \
        if (!late) { if (pidx < n_s) { int a_; PAL_DOTS(U, X, a_); if (!(tid & 8)) PAL_STORE(q_s, e0_, a_); } } \
        HOOK; \
        e_prev = e0_; n_prev = n_s; \
    } while (0)
__device__ __forceinline__ void peer_a_lds(int s, const signed char* xq, const unsigned* seg, const int* soff, int r, int* pa, LAS unsigned char* lds, int tid_, const float* pv, unsigned char* v8, float* sv, int cv_e0) {
    int tid = tid_; asm volatile("" : "+v"(tid));
    const unsigned l16 = (unsigned)(tid & 15) << 4;
    const int pidx = (tid >> 4) * 8 + (tid & 7);
    const bool late = __builtin_amdgcn_readfirstlane(tid >> 8) != 0;
    const int lane = tid & 63; cv_e0 += (__builtin_amdgcn_readfirstlane(tid >> 6) & 3) * 16; f32x4 cvr[2][4]; int cv_it = 0;
#pragma unroll
    for (int j = 0; j < 2; ++j)
#pragma unroll
        for (int q = 0; q < 4; ++q) cvr[j][q] = (f32x4){0.f, 0.f, 0.f, 0.f};
    LAS int* loff = (LAS int*)(lds + PA_LOFF);
    if (tid < PA_NCH4) { int b = 0, e = 0; if (tid < PA_NCH) { b = soff[tid * 33 + r]; e = soff[tid * 33 + r + 1]; } loff[2 * tid] = tid * (PA_CH * 128) + b; loff[2 * tid + 1] = e - b; }
    __syncthreads();
    const GAS unsigned char* xb = (const GAS unsigned char*)(xq + 256 * s);
    const GAS unsigned* sg = (const GAS unsigned*)seg;
    const unsigned voff0 = (unsigned)(tid >> 4) * (unsigned)D + l16, voff1 = voff0 + ((tid >> 4) < PA_CH - 32 ? 32u * (unsigned)D : 0u);
    v4u x0a, x0b, x1a, x1b, x2a, x2b, x3a, x3b; unsigned en0, en1, en2, en3;
    v4u U[8], X[8]; unsigned e_prev = 0u; int n_prev = 0;
#pragma unroll
    for (int j = 0; j < 8; ++j) { U[j] = X[j] = (v4u){0u, 0u, 0u, 0u}; }
    PAL_LOAD(0, x0a, x0b, en0); PAL_LOAD(1, x1a, x1b, en1); PAL_LOAD(2, x2a, x2b, en2); PAL_LOAD(3, x3a, x3b, en3);
    PAL_WRITE(0, x0a, x0b);
#pragma unroll 1
    for (int q0 = 0; q0 < PA_NCH4; q0 += 4) {
        PAL_STEP(q0, x1a, x1b, x0a, x0b, en0, CV_ISSUE);
        PAL_STEP(q0 + 1, x2a, x2b, x1a, x1b, en1, CV_NONE);
        PAL_STEP(q0 + 2, x3a, x3b, x2a, x2b, en2, CV_NONE);
        PAL_STEP(q0 + 3, x0a, x0b, x3a, x3b, en3, CV_FINISH);
        ++cv_it;
    }
    __syncthreads();
}
__device__ __forceinline__ void peer_w_elem(size_t i, const int* experts, const float* gates, const float* su, const float* sv, const float* sx, const int* pa, float* wb) {
    const size_t t = i >> 7; const int k = (int)(i & 127), pos = (k & 3) * 32 + (k >> 2);
    const int e = experts[i];
    int a = 0;
#pragma unroll
    for (int s2 = 0; s2 < 8; ++s2) a += pa[(t * 8 + s2) * 128 + pos];
    wb[i] = gates[i] * gelu_erf((float)a * (su[e] * sx[t])) * sv[e];
}
#define PB_LOAD(R, IDV, HALF) do { _Pragma("unroll") for (int i_ = 0; i_ < 8; ++i_) { const unsigned e_ = (unsigned)__shfl(IDV, 4 * (i_ + 8 * (HALF)) + g); \
        R[i_] = *(const GAS v4u*)(vb + (e_ * 256u + offc)); } } while (0)
#define PB_COMP(R, WV, HALF) do { _Pragma("unroll") for (int i_ = 0; i_ < 8; ++i_) { const float wk_ = __shfl(WV, 4 * (i_ + 8 * (HALF)) + g); \
        axpy4f8v(&ya2[0], R[i_].x, wk_); axpy4f8v(&ya2[2], R[i_].y, wk_); axpy4f8v(&ya2[4], R[i_].z, wk_); axpy4f8v(&ya2[6], R[i_].w, wk_); } } while (0)
__device__ __forceinline__ void peer_b_task(int t0, int ntok, int s, const bf16* h1, const int* experts, const float* wb, const unsigned char* v8s, bf16* out, float* st, int lane_) {
    int lane = lane_; asm volatile("" : "+v"(lane));
    const int g = lane >> 4, c = lane & 15;
    const GAS unsigned char* vb = (const GAS unsigned char*)(v8s + (size_t)s * SLICE_BYTES);
    const unsigned offc = 16u * (unsigned)c;
    int idc0 = experts[(size_t)t0 * 128 + lane], idc1 = experts[(size_t)t0 * 128 + lane + 64];
    float wc0 = wb[(size_t)t0 * 128 + lane], wc1 = wb[(size_t)t0 * 128 + lane + 64];
    v4u RA[8], RB[8];
    PB_LOAD(RA, idc0, 0);
#pragma unroll 1
    for (int tt = 0; tt < ntok; ++tt) {
        const int t = t0 + tt, tn = tt + 1 < ntok ? t + 1 : t;
        const int idn0 = experts[(size_t)tn * 128 + lane], idn1 = experts[(size_t)tn * 128 + lane + 64];
        const float wn0 = wb[(size_t)tn * 128 + lane], wn1 = wb[(size_t)tn * 128 + lane + 64];
        f32x2_t ya2[8];
#pragma unroll
        for (int e = 0; e < 8; ++e) ya2[e] = (f32x2_t){0.f, 0.f};
#pragma unroll 1
        for (int hb = 0; hb < 2; ++hb) {
            const int idv = hb ? idc1 : idc0, idx = hb ? idn0 : idc1; const float wv = hb ? wc1 : wc0;
            PB_LOAD(RB, idv, 1); PB_COMP(RA, wv, 0);
            asm volatile("" ::: "memory");
            PB_LOAD(RA, idx, 0); PB_COMP(RB, wv, 1);
        }
        float ya[16];
#pragma unroll
        for (int e = 0; e < 8; ++e) { ya[2 * e] = ya2[e].x; ya[2 * e + 1] = ya2[e].y; }
#pragma unroll
        for (int e = 0; e < 16; ++e) { ya[e] += __shfl_xor(ya[e], 16); ya[e] += __shfl_xor(ya[e], 32); }
        const GAS v4u* hp = (const GAS v4u*)(h1 + (size_t)t * D + 256 * s + 16 * c);
        const v4u h0 = hp[0], h1v = hp[1];
        float hx[16];
        hx[0] = pg8::bf_lo(h0.x); hx[1] = pg8::bf_hi(h0.x); hx[2] = pg8::bf_lo(h0.y); hx[3] = pg8::bf_hi(h0.y); hx[4] = pg8::bf_lo(h0.z); hx[5] = pg8::bf_hi(h0.z); hx[6] = pg8::bf_lo(h0.w); hx[7] = pg8::bf_hi(h0.w);
        hx[8] = pg8::bf_lo(h1v.x); hx[9] = pg8::bf_hi(h1v.x); hx[10] = pg8::bf_lo(h1v.y); hx[11] = pg8::bf_hi(h1v.y); hx[12] = pg8::bf_lo(h1v.z); hx[13] = pg8::bf_hi(h1v.z); hx[14] = pg8::bf_lo(h1v.w); hx[15] = pg8::bf_hi(h1v.w);
        float sm = 0.f, sq = 0.f;
#pragma unroll
        for (int e = 0; e < 16; ++e) { ya[e] = hx[e] * ALPHA + ya[e]; sm += ya[e]; sq += ya[e] * ya[e]; }
        sm = row16_allsum(sm); sq = row16_allsum(sq);
        if (g == 0) { GAS v4u* op = (GAS v4u*)(out + (size_t)t * D + 256 * s + 16 * c);
            v4u o0, o1; o0.x = pk2(ya[0], ya[1]); o0.y = pk2(ya[2], ya[3]); o0.z = pk2(ya[4], ya[5]); o0.w = pk2(ya[6], ya[7]);
            o1.x = pk2(ya[8], ya[9]); o1.y = pk2(ya[10], ya[11]); o1.z = pk2(ya[12], ya[13]); o1.w = pk2(ya[14], ya[15]);
            op[0] = o0; op[1] = o1;
            if (c == 0) { st[((size_t)t * 8 + s) * 2] = sm; st[((size_t)t * 8 + s) * 2 + 1] = sq; } }
        idc0 = idn0; idc1 = idn1; wc0 = wn0; wc1 = wn1;
    }
}
__device__ __forceinline__ void peer_c_row(int t, const bf16* r2, float* out, const float* st, const float* g2, const float* b2, int lane) {
    float sm = 0.f, sq = 0.f;
#pragma unroll
    for (int s = 0; s < 8; ++s) { sm += st[((size_t)t * 8 + s) * 2]; sq += st[((size_t)t * 8 + s) * 2 + 1]; }
    const float mean = sm * (1.f / D), var = sq * (1.f / D) - mean * mean, rstd = 1.f / sqrtf(fmaxf(var, 0.f) + LN_EPS);
    const GAS v4u* xr = (const GAS v4u*)(r2 + (size_t)t * D) + lane;
    GAS f32x4* op = (GAS f32x4*)(out + (size_t)t * D);
#pragma unroll
    for (int j = 0; j < 4; ++j) { const v4u w = xr[64 * j]; const int c4 = 2 * (lane + 64 * j);
        const f32x4 g0 = *((const GAS f32x4*)g2 + c4), g1 = *((const GAS f32x4*)g2 + c4 + 1), b0 = *((const GAS f32x4*)b2 + c4), b1 = *((const GAS f32x4*)b2 + c4 + 1);
        const f32x4 v0 = (f32x4){pg8::bf_lo(w.x), pg8::bf_hi(w.x), pg8::bf_lo(w.y), pg8::bf_hi(w.y)}, v1 = (f32x4){pg8::bf_lo(w.z), pg8::bf_hi(w.z), pg8::bf_lo(w.w), pg8::bf_hi(w.w)};
        op[c4] = (v0 - mean) * rstd * g0 + b0; op[c4 + 1] = (v1 - mean) * rstd * g1 + b1; }
}

struct TwoPassOrder : pg8::StaticOrder {
    __device__ __forceinline__ bool next(int i, pg8::Unit& u) const { if (!pg8::StaticOrder::next(i >> 1, u)) return false; u.w = i & 1; return true; }
};
struct EpiGate2 {
    static constexpr bool PERM = true, AFTER_DRAIN = false;
    pg8::EpiGate<0> e0; pg8::EpiGate<1> e1;
    __device__ __forceinline__ void operator()(const pg8::f32x4 (&acc)[2][2][4][2], const pg8::Unit& u, int wr, int wc, int fr, int fq) const { if (u.w == 0) e0(acc, u, wr, wc, fr, fq); else e1(acc, u, wr, wc, fr, fq); }
};

struct EpiGate2I8 {
    static constexpr bool PERM = true, AFTER_DRAIN = false;
    pg8::EpiGateI8<0> e0; pg8::EpiGateI8<1> e1;
    __device__ __forceinline__ void operator()(const pg8::i32x4 (&acc)[2][2][4][2], const pg8::Unit& u, int wr, int wc, int fr, int fq) const { if (u.w == 0) e0(acc, u, wr, wc, fr, fq); else e1(acc, u, wr, wc, fr, fq); }
};
struct ConvOrder : pg8::StaticOrder {
    const float* pu; const float* pv; unsigned char* u8; unsigned char* v8; float* su; float* sv; int slot; mutable int calls;
    static constexpr int CONV_ROWS = 2, CONV_CALLS = 6;
    __device__ __forceinline__ void done(const pg8::Unit&) const {
        if (slot < 0) return;
        int lane = threadIdx.x & 63; asm volatile("" : "+v"(lane));
        const int wave = __builtin_amdgcn_readfirstlane(threadIdx.x >> 6);
        const int base = ((slot * NWAVES + wave) * CONV_CALLS + calls) * CONV_ROWS;
        if (calls < CONV_CALLS) {
#pragma unroll 1
            for (int j = 0; j < CONV_ROWS; ++j) { const int r = base + j; if (r < PNE) row_to_i8(pu + (size_t)r * D, u8 + (size_t)r * 256, su + r, lane); }
        }
        ++calls;
    }
};

struct Args { const float* in[16]; float* out; unsigned char* ws; int ph_lo, ph_hi; };
__global__ void __launch_bounds__(NTHREADS, 2) mk_fwd(Args args) {
    extern __shared__ __attribute__((aligned(16))) unsigned char lds_raw[];
    LAS unsigned char* lds = (LAS unsigned char*)lds_raw;
    volatile LAS unsigned* MISC = (volatile LAS unsigned*)(lds + MISC_OFF);
    const int tid0 = threadIdx.x;
    const int G = gridDim.x, bx = blockIdx.x;
    unsigned char* ws = args.ws;
    gu32* ctl = (gu32*)(ws + WS_CTL);
#define IN_(i) (args.in[i])
#define x_in IN_(0)
#define w_in IN_(1)
#define b_gate IN_(2)
#define sinks IN_(3)
#define conv_w IN_(4)
#define w_ao IN_(5)
#define w_co IN_(6)
#define w_o IN_(7)
#define ln1_g IN_(8)
#define ln1_b IN_(9)
#define w_q IN_(10)
#define sub_keys IN_(11)
#define peer_u IN_(12)
#define peer_v IN_(13)
#define ln2_g IN_(14)
#define ln2_b IN_(15)
#define WinT ((bf16*)(ws + WS_WIN))
#define WaT ((bf16*)(ws + WS_WA))
#define WcT ((bf16*)(ws + WS_WC))
#define WoT ((bf16*)(ws + WS_WO))
#define WfT ((bf16*)(ws + WS_WF))
#define XB ((bf16*)(ws + WS_XB))
#define MERGED ((bf16*)(ws + WS_MERGED))
#define Z ((bf16*)(ws + WS_Z))
#define R2B ((bf16*)(ws + WS_R2B))
#define H1B ((bf16*)(ws + WS_H1B))
#define SC ((float*)(ws + WS_SC))
#define EX ((int*)(ws + WS_EX))
#define GT ((float*)(ws + WS_GT))
#define AO ((bf16*)(ws + WS_AO))
#define CI ((bf16*)(ws + WS_CI))
#define TMP ((bf16*)(ws + WS_TMP))
#define U8 ((unsigned char*)(ws + WS_U8))
#define V8 ((unsigned char*)(ws + WS_V8))
#define SU ((float*)(ws + WS_SU))
#define SV ((float*)(ws + WS_SV))
#define PA ((int*)(ws + WS_PA))
#define ST ((float*)(ws + WS_ST))
#define WB ((float*)(ws + WS_WB))
#define XA8 ((signed char*)(ws + WS_XA8))
#define WIN8 ((signed char*)(ws + WS_WIN8))
#define SWIN ((float*)(ws + WS_SWIN))
#define SXA ((float*)(ws + WS_SXA))
#define WF8 ((signed char*)(ws + WS_WF8))
#define MG8 ((signed char*)(ws + WS_MG8))
#define WO8 ((signed char*)(ws + WS_WO8))
#define SMG ((float*)(ws + WS_SMG))
#define SWO ((float*)(ws + WS_SWO))
#define AO8 ((signed char*)(ws + WS_AO8))
#define CI8 ((signed char*)(ws + WS_CI8))
#define WA8 ((signed char*)(ws + WS_WA8))
#define WC8 ((signed char*)(ws + WS_WC8))
#define SAO ((float*)(ws + WS_S3))
#define SCI ((float*)(ws + WS_S3 + 65536))
#define SWA ((float*)(ws + WS_S3 + 131072))
#define SWC ((float*)(ws + WS_S3 + 196608))
#define SWF ((float*)(ws + WS_SWF))
#define XQ ((signed char*)(ws + WS_XQ))
#define SX ((float*)(ws + WS_SX))
#define SEG ((unsigned*)(ws + WS_SEG))
#define SOFF ((int*)(ws + WS_SOFF))
    for (int u = tid0; u < (LDS_BYTES - LDSCTL_OFF) / 4; u += NTHREADS) ((LAS unsigned*)(lds + LDSCTL_OFF))[u] = 0u;
    __syncthreads();
    XcdBarrier bar; bar.bar = (unsigned*)(ctl + CW_BAR); bar.x = 0; bar.st = nullptr;
    if (!MK_PER_PHASE) bar = xcd_barrier_post((unsigned*)(ctl + CW_BAR), MISC + 8);
    const int lo = args.ph_lo, hi = args.ph_hi;
#ifndef PH_MASK
#define PH_MASK 0xFFF
#endif
#define IN(k) (((PH_MASK >> (k)) & 1) && lo <= (k) && (k) < hi)
#ifndef DBL_BAR
#define DBL_BAR 0
#endif
#define SEAM(k) do { if (IN(k) && IN((k) + 1)) { xcd_barrier(bar); if (DBL_BAR) xcd_barrier(bar); } } while (0)
#ifndef DBL_MASK
#define DBL_MASK 0
#endif
#define REP(k) for (int rep_ = 0; rep_ < 1 + ((DBL_MASK >> (k)) & 1); ++rep_)
#define PHASE_TID() int tid = tid0; asm volatile("" : "+v"(tid)); const int lane = tid & 63, wave = __builtin_amdgcn_readfirstlane(tid >> 6); (void)lane; (void)wave

    if (IN(0)) REP(0) {
        PHASE_TID();
        const bool conv_first = ((bx >> 3) & 1) == 0;
#pragma unroll 1
        for (int part = 0; part < 2; ++part) {
            if ((part == 0) == conv_first) {
                int tid = tid0; asm volatile("" : "+v"(tid)); const int lane = tid & 63, wave = __builtin_amdgcn_readfirstlane(tid >> 6);
                LAS float* scr = (LAS float*)(lds + wave * 16384);
                const int gw = bx * NWAVES + wave, NGW = G * NWAVES;
                constexpr int I_IN = (D / 64) * (IN_W / 32), I_SQ = (D / 64) * (D / 32);
                for (int it = gw; it < I_IN + 3 * I_SQ; it += NGW) {
                    int r = it;
                    if (r < I_IN) { p0_transpose_item(w_in, D, IN_W, WinT, scr, r, lane); continue; } r -= I_IN;
                    if (r < I_SQ) { p0_transpose_item(w_ao, D, D, WaT, scr, r, lane); continue; } r -= I_SQ;
                    if (r < I_SQ) { p0_transpose_item(w_co, D, D, WcT, scr, r, lane); continue; } r -= I_SQ;
                    p0_transpose_item(w_o, D, D, WoT, scr, r, lane);
                }
                for (int r = gw; r < M; r += NGW) row_f32_to_i8(x_in + (size_t)r * D, XA8 + (size_t)r * D, SXA + r, lane);
                __syncthreads();
            }
            if (part == 0) for (int it = bx; it < 16 * 32; it += G) p0_wf_item(w_q, sub_keys, WfT, lds, it, tid);
        }
    }
    SEAM(0);
    if (IN(1)) REP(1) {
        { PHASE_TID();
          for (int r = bx * NWAVES + wave; r < IN_W + 2 * D; r += G * NWAVES) { if (r < IN_W) row_bf16_to_i8(WinT + (size_t)r * D, WIN8 + (size_t)r * D, SWIN + r, lane);
              else if (r < IN_W + D) { const int q = r - IN_W; row_bf16_to_i8(WfT + (size_t)q * D, WF8 + (size_t)q * D, SWF + q, lane); }
              else { const int q = r - IN_W - D; row_bf16_to_i8(WoT + (size_t)q * D, WO8 + (size_t)q * D, SWO + q, lane); } } }
        if (!MK_PER_PHASE) xcd_barrier(bar);
        pg8::Gemm g{(const bf16*)XA8, (const bf16*)WIN8, M, IN_W, D / 2}; ConvOrder S; S.init(M, IN_W, G, bx);
        S.pu = peer_u; S.pv = peer_v; S.u8 = U8; S.v8 = V8; S.su = SU; S.sv = SV; S.calls = 0;
        S.slot = (G == 256 && bx >= 64) ? bx - 64 : -1;
        pg8::EpiI8Bf16 E{Z, IN_W, SXA, SWIN};
        pg8::gemm_phase<pg8::EpiI8Bf16, ConvOrder, true, true, true>(lds, g, S, E);
        if (G != 256) {
            PHASE_TID();
            for (int r = bx * NWAVES + wave; r < 2 * PNE; r += G * NWAVES) { const bool sec = r >= PNE; const int e = sec ? r - PNE : r;
                if (sec) row_to_fp8(peer_v + (size_t)e * D, V8 + (size_t)e * 256, SV + e, lane); else row_to_i8(peer_u + (size_t)e * D, U8 + (size_t)e * 256, SU + e, lane); }
        }
    }
    SEAM(1);
    if (IN(2)) REP(2) {
        PHASE_TID();
        const bool conv_first = ((bx >> 3) & 1) == 0;
#pragma unroll 1
        for (int part = 0; part < 2; ++part) {
            if ((part == 0) == conv_first) { int t2 = tid0; asm volatile("" : "+v"(t2)); for (int it = bx; it < M / 32; it += G) conv_item(it, Z, conv_w, CI, t2); }
            if (part == 0) for (int u = bx; u < BATCH * NKVH * 16; u += G) attn_unit(u, Z, AO, sinks, lds, tid);
        }
    }
    SEAM(2);
    if (IN(3)) REP(3) {
        TwoPassOrder S; S.init(M, D, G, bx);
#ifndef P3_I8
#define P3_I8 1
#endif
        if (P3_I8 && !MK_PER_PHASE) {
            { PHASE_TID();
              for (int r = bx * NWAVES + wave; r < 2 * M + 2 * D; r += G * NWAVES) {
                  if (r < M) row_bf16_to_i8(AO + (size_t)r * D, AO8 + (size_t)r * D, SAO + r, lane);
                  else if (r < 2 * M) { const int q = r - M; row_bf16_to_i8(CI + (size_t)q * D, CI8 + (size_t)q * D, SCI + q, lane); }
                  else if (r < 2 * M + D) { const int q = r - 2 * M; row_bf16_to_i8(WaT + (size_t)q * D, WA8 + (size_t)q * D, SWA + q, lane); }
                  else { const int q = r - 2 * M - D; row_bf16_to_i8(WcT + (size_t)q * D, WC8 + (size_t)q * D, SWC + q, lane); } } }
            xcd_barrier(bar);
            pg8::Gemm g{(const bf16*)AO8, (const bf16*)WA8, M, D, D / 2, (const bf16*)CI8, (const bf16*)WC8};
            EpiGate2I8 E{pg8::EpiGateI8<0>{TMP, nullptr, Z + G_OFF, b_gate, D, IN_W, SAO, SWA}, pg8::EpiGateI8<1>{MERGED, TMP, Z + G_OFF + D, b_gate + D, D, IN_W, SCI, SWC}};
            pg8::gemm_phase<EpiGate2I8, TwoPassOrder, true, true, true>(lds, g, S, E);
        } else {
        pg8::Gemm g{AO, WaT, M, D, D, CI, WcT};
        EpiGate2 E{pg8::EpiGate<0>{TMP, nullptr, Z + G_OFF, b_gate, D, IN_W}, pg8::EpiGate<1>{MERGED, TMP, Z + G_OFF + D, b_gate + D, D, IN_W}};
        pg8::gemm_phase<EpiGate2, TwoPassOrder, true, true>(lds, g, S, E);
        }
    }
    SEAM(3);
    if (IN(4)) REP(4) {
        pg8::StaticOrder S; S.init(M, D, G, bx);
#ifndef P4_I8
#define P4_I8 1
#endif
        if (P4_I8 && !MK_PER_PHASE) {
            { PHASE_TID(); for (int r = bx * NWAVES + wave; r < M; r += G * NWAVES) row_bf16_to_i8(MERGED + (size_t)r * D, MG8 + (size_t)r * D, SMG + r, lane); }
            xcd_barrier(bar);
            pg8::Gemm g{(const bf16*)MG8, (const bf16*)WO8, M, D, D / 2};
            pg8::EpiResI8Bf16 E{H1B, D, x_in, ALPHA, SMG, SWO};
            pg8::gemm_phase<pg8::EpiResI8Bf16, pg8::StaticOrder, true, true, true>(lds, g, S, E);
        } else {
        pg8::Gemm g{MERGED, WoT, M, D, D};
        pg8::EpiResBf16 E{H1B, D, x_in, ALPHA};
        pg8::gemm_phase<pg8::EpiResBf16, pg8::StaticOrder, true, true>(lds, g, S, E);
        }
    }
    SEAM(4);
    if (IN(5)) REP(5) {
        PHASE_TID();
        const int gw = bx * NWAVES + wave, NGW = G * NWAVES;
        for (int m = gw; m < M; m += NGW) ln1_row(H1B + (size_t)m * D, XQ + (size_t)m * D, SX + m, ln1_g, ln1_b, lane);
    }
    SEAM(5);
    if (IN(6)) REP(6) {
        pg8::Gemm g{H1B, WfT, M, D, D}; pg8::StaticOrder S; S.init(M, D, G, bx);
#ifndef P6_I8
#define P6_I8 1
#endif
        if (G == 256 && P6_I8) { pg8::Gemm g8{(const bf16*)XQ, (const bf16*)WF8, M, D, D / 2}; EpiTopKI8 E{EX, GT, SX, SWF}; pg8::gemm_phase<EpiTopKI8, pg8::StaticOrder, false, true, true>(lds, g8, S, E); }
        else if (G == 256) { EpiTopK E{EX, GT}; pg8::gemm_phase<EpiTopK, pg8::StaticOrder, false, true>(lds, g, S, E); }
        else { pg8::EpiF32 E{SC, D, nullptr, 0.f}; pg8::gemm_phase<pg8::EpiF32, pg8::StaticOrder, true, true>(lds, g, S, E); }
    }
    SEAM(6);
    if (IN(7)) REP(7) {
        PHASE_TID();
        if (G != 256) for (int p = bx; p < (M * PH) / 128; p += G) topk_pass(p, SC, EX, GT, lds, tid);
        else { peer_shard_load(bx & 7, bx >> 3, U8, lds, tid);
               if (bx < PA_NCH) peer_bucket(bx, EX, SEG, SOFF, lds, tid); }
    }
    SEAM(7);
    if (IN(8)) REP(8) {
        PHASE_TID();
        if (G == 256) peer_a_lds(bx & 7, XQ, SEG, SOFF, bx >> 3, PA, lds, tid, peer_v, V8, SV, bx * 64);
        else {
        const int xcc = (int)(xb_xcc_id() & 7u);
#pragma unroll 1
#ifndef SCRAMBLE
#define SCRAMBLE 0
#endif
        for (int sl = 0; sl < 8; ++sl) { const int s = (xcc + sl + (SCRAMBLE ? wave : 0)) & 7;
            for (;;) { const int tg = q_pull((unsigned*)(ctl + CW_Q + 64 * (s + 16 * rep_)), lane); if (tg >= PEER_NTASK) break;
                int t0, nt; peer_task_tokens(tg, t0, nt); peer_a_task(t0, nt, s, XQ, EX, U8, PA, lane); } }
        }
    }
    SEAM(8);
    if (IN(9)) REP(9) {
        PHASE_TID();
        for (size_t i = (size_t)bx * NTHREADS + tid; i < (size_t)M * 128; i += (size_t)G * NTHREADS) peer_w_elem(i, EX, GT, SU, SV, SX, PA, WB);
    }
    SEAM(9);
    if (IN(10)) REP(10) {
        PHASE_TID();
        const int xcc = (int)(xb_xcc_id() & 7u);
#pragma unroll 1
#ifndef SCRAMBLE
#define SCRAMBLE 0
#endif
        for (int sl = 0; sl < 8; ++sl) { const int s = (xcc + sl + (SCRAMBLE ? wave : 0)) & 7;
            for (;;) { const int tg = q_pull((unsigned*)(ctl + CW_Q + 64 * (8 + s + 16 * rep_)), lane); if (tg >= PEER_NTASK) break;
                int t0, nt; peer_task_tokens(tg, t0, nt); peer_b_task(t0, nt, s, H1B, EX, WB, V8, R2B, ST, lane); } }
    }
    SEAM(10);
    if (IN(11)) REP(11) {
        PHASE_TID();
        const int gw = bx * NWAVES + wave, NGW = G * NWAVES;
        for (int t = gw; t < M; t += NGW) peer_c_row(t, R2B, args.out, ST, ln2_g, ln2_b, lane);
    }
#undef IN
#undef SEAM
}

extern "C" void kernel_launch(void* const* d_in, const int* in_sizes, int n_in, void* d_out, int out_size, void* d_ws, size_t ws_size, hipStream_t stream) {
    static int grid = 0;
    if (grid == 0) {
        if (n_in != 16 || out_size != M * D || ws_size < WS_END) { fprintf(stderr, "kernel_launch: unexpected shapes (n_in %d out %d ws %zu)\n", n_in, out_size, ws_size); grid = -1; return; }
        int dev = 0, cus = 0, per_cu = 0;
        if (hipGetDevice(&dev) != hipSuccess || hipDeviceGetAttribute(&cus, hipDeviceAttributeMultiprocessorCount, dev) != hipSuccess) { grid = -1; return; }
        if (hipFuncSetAttribute((const void*)mk_fwd, hipFuncAttributeMaxDynamicSharedMemorySize, LDS_BYTES) != hipSuccess) { fprintf(stderr, "kernel_launch: hipFuncSetAttribute failed\n"); grid = -1; return; }
        if (hipOccupancyMaxActiveBlocksPerMultiprocessor(&per_cu, (const void*)mk_fwd, NTHREADS, LDS_BYTES) != hipSuccess || per_cu < 1) { fprintf(stderr, "kernel_launch: occupancy query says %d\n", per_cu); per_cu = 1; }
        (void)hipGetLastError();
        if (per_cu > 1) per_cu = 1;
        grid = cus * per_cu;
    }
    if (grid < 0) return;
    if (hipMemsetAsync((char*)d_ws + WS_CTL, 0, CTL_ZERO_BYTES, stream) != hipSuccess) { fprintf(stderr, "kernel_launch: memset failed\n"); return; }
    Args a{};
    for (int i = 0; i < 16; ++i) a.in[i] = (const float*)d_in[i];
    a.out = (float*)d_out; a.ws = (unsigned char*)d_ws;
#if MK_PER_PHASE
    for (int p = 0; p < N_PHASES; ++p) { a.ph_lo = p; a.ph_hi = p + 1; hipLaunchKernelGGL(mk_fwd, dim3(grid), dim3(NTHREADS), LDS_BYTES, stream, a); }
#else
    a.ph_lo = 0; a.ph_hi = N_PHASES;
    void* kargs[] = {&a};
#ifdef PLAIN_LAUNCH
    (void)kargs; hipLaunchKernelGGL(mk_fwd, dim3(grid), dim3(NTHREADS), LDS_BYTES, stream, a); hipError_t e = hipPeekAtLastError();
#else
    hipError_t e = hipLaunchCooperativeKernel((const void*)mk_fwd, dim3(grid), dim3(NTHREADS), kargs, LDS_BYTES, stream);
#endif
    if (e != hipSuccess) fprintf(stderr, "kernel_launch: cooperative launch failed: %s (grid %d)\n", hipGetErrorString(e), grid);
#endif
}
```

```cpp
#include <hip/hip_runtime.h>
#include <cstdio>
#include <cstdint>
#include <type_traits>
namespace pg8 {
#define PG8_LAS __attribute__((address_space(3)))
typedef unsigned short bf16_t;
typedef short bf16x8 __attribute__((ext_vector_type(8)));
typedef float f32x4 __attribute__((ext_vector_type(4)));
typedef unsigned u32x4 __attribute__((ext_vector_type(4)));
constexpr int BM = 256, BK = 64, HALF = 128, HTB = HALF * BK * 2  , STAGE_BYTES = 8 * HTB, NXCD = 8, WGM = 8;

__host__ __device__ __forceinline__ int lds_byte(int r, int c) { const int st = (r >> 4) * 2 + (c >> 5), rr = r & 15, cc = c & 31, ob = rr * 64 + cc * 2; return st * 1024 + (ob ^ (((ob >> 9) & 1) << 5)); }
__host__ __device__ __forceinline__ void stage_rc(int b, int& R, int& C) { const int st = b / 1024, sb = b % 1024, swz = sb ^ (((sb >> 9) & 1) << 5); R = (st >> 1) * 16 + swz / 64; C = (st & 1) * 32 + (swz % 64) / 2; }
__host__ __device__ __forceinline__ int perm32(int rho) { const int n = rho >> 4, i = rho & 15; return 8 * (i >> 2) + 4 * n + (i & 3); }

struct Unit { int pm, pn, w; };
struct Gemm { const bf16_t* A; const bf16_t* Bt; int M, N, K; const bf16_t* A2 = nullptr; const bf16_t* Bt2 = nullptr; };

struct StaticOrder {
    int nM, nN, nwg, G, c;
    __host__ __device__ void init(int M, int N, int G_, int c_) { nM = M / BM; nN = N / BM; nwg = nM * nN; G = G_; c = c_; }
    __host__ __device__ bool next(int i, Unit& u) const {
        const long L = (long)i * G + c; if (L >= nwg) return false;
        int wgid = (int)L; { const int q = nwg / NXCD, r = nwg % NXCD, xcd = wgid % NXCD, off = wgid / NXCD; wgid = (xcd < r ? xcd * (q + 1) : r * (q + 1) + (xcd - r) * q) + off; }
        const int nig = WGM * nN, gid = wgid / nig, fm = gid * WGM, gsz = (nM - fm) < WGM ? (nM - fm) : WGM;
        u.pm = fm + ((wgid % nig) % gsz); u.pn = (wgid % nig) / gsz; u.w = 0; return true;
    }
    __device__ __forceinline__ void a_ready(const Unit&) const {}
    __device__ __forceinline__ void done(const Unit&) const {}
};


__device__ __forceinline__ unsigned cvt_pk_bf16(float lo, float hi) { unsigned r; asm volatile("v_cvt_pk_bf16_f32 %0, %1, %2" : "=v"(r) : "v"(lo), "v"(hi)); return r; }
__device__ __forceinline__ float bf_lo(unsigned w) { return __builtin_bit_cast(float, w << 16); }
__device__ __forceinline__ float bf_hi(unsigned w) { return __builtin_bit_cast(float, w & 0xffff0000u); }
__device__ __forceinline__ float sigmoidf_(float x) { return __builtin_amdgcn_rcpf(1.0f + __expf(-x)); }

struct EpiBf16 {
    static constexpr bool PERM = true, AFTER_DRAIN = false;
    bf16_t* O; int ldc;
    __device__ __forceinline__ void operator()(const f32x4 (&acc)[2][2][4][2], const Unit& u, int wr, int wc, int fr, int fq) const {
        const int row0 = u.pm * BM + wr * 64 + fr, col0 = u.pn * BM + wc * 32 + 8 * fq;
#pragma unroll
        for (int ai = 0; ai < 2; ++ai)
#pragma unroll
            for (int m = 0; m < 4; ++m) { bf16_t* rowp = O + (size_t)(row0 + ai * HALF + m * 16) * ldc + col0;
#pragma unroll
                for (int bj = 0; bj < 2; ++bj) { const f32x4 v0 = acc[ai][bj][m][0], v1 = acc[ai][bj][m][1];
                    u32x4 w; w.x = cvt_pk_bf16(v0[0], v0[1]); w.y = cvt_pk_bf16(v0[2], v0[3]); w.z = cvt_pk_bf16(v1[0], v1[1]); w.w = cvt_pk_bf16(v1[2], v1[3]);
                    *(u32x4*)(rowp + bj * HALF) = w; } }
    }
};
template <int SECOND> struct EpiGate {
    static constexpr bool PERM = true, AFTER_DRAIN = false;
    bf16_t* O; const bf16_t* T; const bf16_t* Zg; const float* bg; int ldc, ldz;
    __device__ __forceinline__ void operator()(const f32x4 (&acc)[2][2][4][2], const Unit& u, int wr, int wc, int fr, int fq) const {
        const int row0 = u.pm * BM + wr * 64 + fr, col0 = u.pn * BM + wc * 32 + 8 * fq;
        f32x4 bv[2][2];
#pragma unroll
        for (int bj = 0; bj < 2; ++bj)
#pragma unroll
            for (int n = 0; n < 2; ++n) bv[bj][n] = *(const f32x4*)(bg + col0 + bj * HALF + 4 * n);
#pragma unroll
        for (int ai = 0; ai < 2; ++ai)
#pragma unroll
            for (int m = 0; m < 4; ++m) { const size_t row = (size_t)(row0 + ai * HALF + m * 16);
#pragma unroll
                for (int bj = 0; bj < 2; ++bj) { const int c = col0 + bj * HALF;
                    const u32x4 zg = *(const u32x4*)(Zg + row * ldz + c);
                    f32x4 v0 = acc[ai][bj][m][0], v1 = acc[ai][bj][m][1];
                    v0[0] *= sigmoidf_(bf_lo(zg.x) + bv[bj][0][0]); v0[1] *= sigmoidf_(bf_hi(zg.x) + bv[bj][0][1]);
                    v0[2] *= sigmoidf_(bf_lo(zg.y) + bv[bj][0][2]); v0[3] *= sigmoidf_(bf_hi(zg.y) + bv[bj][0][3]);
                    v1[0] *= sigmoidf_(bf_lo(zg.z) + bv[bj][1][0]); v1[1] *= sigmoidf_(bf_hi(zg.z) + bv[bj][1][1]);
                    v1[2] *= sigmoidf_(bf_lo(zg.w) + bv[bj][1][2]); v1[3] *= sigmoidf_(bf_hi(zg.w) + bv[bj][1][3]);
                    if (SECOND) { const u32x4 t = *(const u32x4*)(T + row * ldc + c);
                        v0[0] += bf_lo(t.x); v0[1] += bf_hi(t.x); v0[2] += bf_lo(t.y); v0[3] += bf_hi(t.y);
                        v1[0] += bf_lo(t.z); v1[1] += bf_hi(t.z); v1[2] += bf_lo(t.w); v1[3] += bf_hi(t.w); }
                    u32x4 w; w.x = cvt_pk_bf16(v0[0], v0[1]); w.y = cvt_pk_bf16(v0[2], v0[3]); w.z = cvt_pk_bf16(v1[0], v1[1]); w.w = cvt_pk_bf16(v1[2], v1[3]);
                    *(u32x4*)(O + row * ldc + c) = w; } }
    }
};
struct EpiF32 {
    static constexpr bool PERM = false, AFTER_DRAIN = false;
    float* C; int ldc; const float* R; float scale;
    __device__ __forceinline__ void operator()(const f32x4 (&acc)[2][2][4][2], const Unit& u, int wr, int wc, int fr, int fq) const {
        const int row0 = u.pm * BM + wr * 64 + fr, col0 = u.pn * BM + wc * 32 + 4 * fq;
#pragma unroll
        for (int ai = 0; ai < 2; ++ai)
#pragma unroll
            for (int m = 0; m < 4; ++m) { const size_t off = (size_t)(row0 + ai * HALF + m * 16) * ldc + col0;
#pragma unroll
                for (int bj = 0; bj < 2; ++bj)
#pragma unroll
                    for (int n = 0; n < 2; ++n) { f32x4 v = acc[ai][bj][m][n];
                        if (R) v += *(const f32x4*)(R + off + bj * HALF + n * 16) * scale;
                        *(f32x4*)(C + off + bj * HALF + n * 16) = v; } }
    }
};
struct EpiResBf16 {
    static constexpr bool PERM = true, AFTER_DRAIN = false;
    bf16_t* O; int ldc; const float* R; float scale;
    __device__ __forceinline__ void operator()(const f32x4 (&acc)[2][2][4][2], const Unit& u, int wr, int wc, int fr, int fq) const {
        const int row0 = u.pm * BM + wr * 64 + fr, col0 = u.pn * BM + wc * 32 + 8 * fq;
#pragma unroll
        for (int ai = 0; ai < 2; ++ai)
#pragma unroll
            for (int m = 0; m < 4; ++m) { const size_t off = (size_t)(row0 + ai * HALF + m * 16) * ldc + col0;
#pragma unroll
                for (int bj = 0; bj < 2; ++bj) { const f32x4 r0 = *(const f32x4*)(R + off + bj * HALF), r1 = *(const f32x4*)(R + off + bj * HALF + 4);
                    const f32x4 v0 = acc[ai][bj][m][0] + r0 * scale, v1 = acc[ai][bj][m][1] + r1 * scale;
                    u32x4 w; w.x = cvt_pk_bf16(v0[0], v0[1]); w.y = cvt_pk_bf16(v0[2], v0[3]); w.z = cvt_pk_bf16(v1[0], v1[1]); w.w = cvt_pk_bf16(v1[2], v1[3]);
                    *(u32x4*)(O + off + bj * HALF) = w; } }
    }
};
typedef int i32x4e __attribute__((ext_vector_type(4)));
struct EpiI8Bf16 {
    static constexpr bool PERM = true, AFTER_DRAIN = false;
    bf16_t* O; int ldc; const float* sa; const float* sb;
    __device__ __forceinline__ void operator()(const i32x4e (&acc)[2][2][4][2], const Unit& u, int wr, int wc, int fr, int fq) const {
        const int row0 = u.pm * BM + wr * 64 + fr, col0 = u.pn * BM + wc * 32 + 8 * fq;
        f32x4 sbv[2][2];
#pragma unroll
        for (int bj = 0; bj < 2; ++bj)
#pragma unroll
            for (int n = 0; n < 2; ++n) sbv[bj][n] = *(const f32x4*)(sb + col0 + bj * HALF + 4 * n);
#pragma unroll
        for (int ai = 0; ai < 2; ++ai)
#pragma unroll
            for (int m = 0; m < 4; ++m) { const int row = row0 + ai * HALF + m * 16; const float sr = sa[row]; bf16_t* rowp = O + (size_t)row * ldc + col0;
#pragma unroll
                for (int bj = 0; bj < 2; ++bj) { const i32x4e a0 = acc[ai][bj][m][0], a1 = acc[ai][bj][m][1];
                    const f32x4 v0 = (f32x4){(float)a0[0], (float)a0[1], (float)a0[2], (float)a0[3]} * sbv[bj][0] * sr, v1 = (f32x4){(float)a1[0], (float)a1[1], (float)a1[2], (float)a1[3]} * sbv[bj][1] * sr;
                    u32x4 w; w.x = cvt_pk_bf16(v0[0], v0[1]); w.y = cvt_pk_bf16(v0[2], v0[3]); w.z = cvt_pk_bf16(v1[0], v1[1]); w.w = cvt_pk_bf16(v1[2], v1[3]);
                    *(u32x4*)(rowp + bj * HALF) = w; } }
    }
};
template <int SECOND> struct EpiGateI8 {
    static constexpr bool PERM = true, AFTER_DRAIN = false;
    bf16_t* O; const bf16_t* T; const bf16_t* Zg; const float* bg; int ldc, ldz; const float* sa; const float* sb;
    __device__ __forceinline__ void operator()(const i32x4e (&acc)[2][2][4][2], const Unit& u, int wr, int wc, int fr, int fq) const {
        const int row0 = u.pm * BM + wr * 64 + fr, col0 = u.pn * BM + wc * 32 + 8 * fq;
        f32x4 bv[2][2], sbv[2][2];
#pragma unroll
        for (int bj = 0; bj < 2; ++bj)
#pragma unroll
            for (int n = 0; n < 2; ++n) { bv[bj][n] = *(const f32x4*)(bg + col0 + bj * HALF + 4 * n); sbv[bj][n] = *(const f32x4*)(sb + col0 + bj * HALF + 4 * n); }
#pragma unroll
        for (int ai = 0; ai < 2; ++ai)
#pragma unroll
            for (int m = 0; m < 4; ++m) { const size_t row = (size_t)(row0 + ai * HALF + m * 16); const float sr = sa[row];
#pragma unroll
                for (int bj = 0; bj < 2; ++bj) { const int c = col0 + bj * HALF;
                    const u32x4 zg = *(const u32x4*)(Zg + row * ldz + c);
                    const i32x4e a0 = acc[ai][bj][m][0], a1 = acc[ai][bj][m][1];
                    f32x4 v0 = (f32x4){(float)a0[0], (float)a0[1], (float)a0[2], (float)a0[3]} * sbv[bj][0] * sr, v1 = (f32x4){(float)a1[0], (float)a1[1], (float)a1[2], (float)a1[3]} * sbv[bj][1] * sr;
                    v0[0] *= sigmoidf_(bf_lo(zg.x) + bv[bj][0][0]); v0[1] *= sigmoidf_(bf_hi(zg.x) + bv[bj][0][1]);
                    v0[2] *= sigmoidf_(bf_lo(zg.y) + bv[bj][0][2]); v0[3] *= sigmoidf_(bf_hi(zg.y) + bv[bj][0][3]);
                    v1[0] *= sigmoidf_(bf_lo(zg.z) + bv[bj][1][0]); v1[1] *= sigmoidf_(bf_hi(zg.z) + bv[bj][1][1]);
                    v1[2] *= sigmoidf_(bf_lo(zg.w) + bv[bj][1][2]); v1[3] *= sigmoidf_(bf_hi(zg.w) + bv[bj][1][3]);
                    if (SECOND) { const u32x4 t = *(const u32x4*)(T + row * ldc + c);
                        v0[0] += bf_lo(t.x); v0[1] += bf_hi(t.x); v0[2] += bf_lo(t.y); v0[3] += bf_hi(t.y);
                        v1[0] += bf_lo(t.z); v1[1] += bf_hi(t.z); v1[2] += bf_lo(t.w); v1[3] += bf_hi(t.w); }
                    u32x4 w; w.x = cvt_pk_bf16(v0[0], v0[1]); w.y = cvt_pk_bf16(v0[2], v0[3]); w.z = cvt_pk_bf16(v1[0], v1[1]); w.w = cvt_pk_bf16(v1[2], v1[3]);
                    *(u32x4*)(O + row * ldc + c) = w; } }
    }
};
struct EpiResI8Bf16 {
    static constexpr bool PERM = true, AFTER_DRAIN = false;
    bf16_t* O; int ldc; const float* R; float scale; const float* sa; const float* sb;
    __device__ __forceinline__ void operator()(const i32x4e (&acc)[2][2][4][2], const Unit& u, int wr, int wc, int fr, int fq) const {
        const int row0 = u.pm * BM + wr * 64 + fr, col0 = u.pn * BM + wc * 32 + 8 * fq;
        f32x4 sbv[2][2];
#pragma unroll
        for (int bj = 0; bj < 2; ++bj)
#pragma unroll
            for (int n = 0; n < 2; ++n) sbv[bj][n] = *(const f32x4*)(sb + col0 + bj * HALF + 4 * n);
#pragma unroll
        for (int ai = 0; ai < 2; ++ai)
#pragma unroll
            for (int m = 0; m < 4; ++m) { const int row = row0 + ai * HALF + m * 16; const float sr = sa[row]; const size_t off = (size_t)row * ldc + col0;
#pragma unroll
                for (int bj = 0; bj < 2; ++bj) { const f32x4 r0 = *(const f32x4*)(R + off + bj * HALF), r1 = *(const f32x4*)(R + off + bj * HALF + 4);
                    const i32x4e a0 = acc[ai][bj][m][0], a1 = acc[ai][bj][m][1];
                    const f32x4 v0 = (f32x4){(float)a0[0], (float)a0[1], (float)a0[2], (float)a0[3]} * sbv[bj][0] * sr + r0 * scale, v1 = (f32x4){(float)a1[0], (float)a1[1], (float)a1[2], (float)a1[3]} * sbv[bj][1] * sr + r1 * scale;
                    u32x4 w; w.x = cvt_pk_bf16(v0[0], v0[1]); w.y = cvt_pk_bf16(v0[2], v0[3]); w.z = cvt_pk_bf16(v1[0], v1[1]); w.w = cvt_pk_bf16(v1[2], v1[3]);
                    *(u32x4*)(O + off + bj * HALF) = w; } }
    }
};

typedef int i32x4 __attribute__((ext_vector_type(4)));
template <class E, class = void> struct epi_chains : std::false_type {};
template <class E> struct epi_chains<E, std::void_t<decltype(E::CHAIN)>> : std::true_type {};
template <class Epi, class Sched, bool ALIGN_EPI = false, bool SP2 = false, bool I8 = false>
__device__ __forceinline__ void gemm_phase(PG8_LAS unsigned char* lds, const Gemm g, const Sched& S, const Epi& E) {
    int tid_ = threadIdx.x; asm volatile("" : "+v"(tid_));
    const int tid = tid_, wid = __builtin_amdgcn_readfirstlane(tid >> 6), lane = tid & 63, wr = wid >> 2, wc = wid & 3, fr = lane & 15, fq = lane >> 4;
    const int K = g.K, nt = K / BK;
    unsigned voffA[2], voffB[2];
#pragma unroll
    for (int i = 0; i < 2; ++i) { int R, C; stage_rc(tid * 16 + i * 8192, R, C); const int Rb = Epi::PERM ? ((R & ~31) + perm32(R & 31)) : R;
        voffA[i] = (unsigned)(R * K + C) * 2u; voffB[i] = (unsigned)(Rb * K + C) * 2u; }
    const size_t kstep = (size_t)(BK * 2);
    const size_t hstep = (size_t)HALF * K * 2;
    const size_t tstep = 2 * hstep;
    const unsigned ldsw = (unsigned)wid * 1024u;
    const int aoff = lds_byte(wr * 64 + fr, fq * 8), boff = lds_byte(wc * 32 + fr, fq * 8);
#define PG8_SA(b, h) (((b) * 2 + (h)) * HTB)
#define PG8_SB(b, h) ((4 + (b) * 2 + (h)) * HTB)
#define PG8_STAGE(bufoff, gbase, voff) do { _Pragma("unroll") for (int _i = 0; _i < 2; ++_i) \
        __builtin_amdgcn_global_load_lds((const unsigned*)((const char*)(gbase) + (voff)[_i]), (PG8_LAS unsigned*)(lds + (bufoff) + ldsw + _i * 8192), 16, 0, 0); } while (0)
#define PG8_LDA(dst, b, h) do { _Pragma("unroll") for (int m = 0; m < 4; ++m) _Pragma("unroll") for (int k = 0; k < 2; ++k) dst[m][k] = *(const PG8_LAS bf16x8*)(lds + PG8_SA(b, h) + aoff + m * 2048 + k * 1024); } while (0)
#define PG8_LDB(dst, b, h) do { _Pragma("unroll") for (int n = 0; n < 2; ++n) _Pragma("unroll") for (int k = 0; k < 2; ++k) dst[n][k] = *(const PG8_LAS bf16x8*)(lds + PG8_SB(b, h) + boff + n * 2048 + k * 1024); } while (0)
#define PG8_MMA(ai, bj, At, Bt) do { __builtin_amdgcn_s_setprio(1); _Pragma("unroll") for (int m = 0; m < 4; ++m) _Pragma("unroll") for (int n = 0; n < 2; ++n) _Pragma("unroll") for (int k = 0; k < 2; ++k) \
        { if constexpr (I8) acc[ai][bj][m][n] = __builtin_bit_cast(acc_t, __builtin_amdgcn_mfma_i32_16x16x64_i8(__builtin_bit_cast(i32x4, Bt[n][k]), __builtin_bit_cast(i32x4, At[m][k]), __builtin_bit_cast(i32x4, acc[ai][bj][m][n]), 0, 0, 0)); \
          else acc[ai][bj][m][n] = __builtin_bit_cast(acc_t, __builtin_amdgcn_mfma_f32_16x16x32_bf16(Bt[n][k], At[m][k], __builtin_bit_cast(f32x4, acc[ai][bj][m][n]), 0, 0, 0)); } __builtin_amdgcn_s_setprio(0); } while (0)
#define PG8_WAIT_V(n) asm volatile("s_waitcnt vmcnt(" #n ")" ::: "memory")
#define PG8_WAIT_L(n) asm volatile("s_waitcnt lgkmcnt(" #n ")" ::: "memory")
#define PG8_BAR __builtin_amdgcn_s_barrier()
#define PG8_SCHED __builtin_amdgcn_sched_barrier(0)
    Unit cur, nxt; int ui = 0;
    if (!S.next(0, cur)) return;
    typedef typename std::conditional<I8, i32x4, f32x4>::type acc_t;
    acc_t acc[2][2][4][2];
#pragma unroll
    for (int a = 0; a < 2; ++a)
#pragma unroll
        for (int b = 0; b < 2; ++b)
#pragma unroll
            for (int m = 0; m < 4; ++m)
#pragma unroll
                for (int n = 0; n < 2; ++n) acc[a][b][m][n] = acc_t{};
    bf16x8 At[4][2], B0[2][2], B1[2][2];
    const char* cA = (const char*)(cur.w ? g.A2 : g.A) + (size_t)cur.pm * tstep; const char* cB = (const char*)(cur.w ? g.Bt2 : g.Bt) + (size_t)cur.pn * tstep;
    S.a_ready(cur);
    if constexpr (SP2) {
        PG8_STAGE(PG8_SB(0, 0), cB, voffB); PG8_STAGE(PG8_SB(0, 1), cB + hstep, voffB); PG8_STAGE(PG8_SA(0, 0), cA, voffA); PG8_STAGE(PG8_SA(0, 1), cA + hstep, voffA);
        if (wr == 1) PG8_BAR;
        PG8_WAIT_V(2); PG8_BAR;
        PG8_STAGE(PG8_SB(1, 0), cB + kstep, voffB); PG8_STAGE(PG8_SA(1, 0), cA + kstep, voffA); PG8_STAGE(PG8_SB(1, 1), cB + hstep + kstep, voffB);
        PG8_WAIT_V(6); PG8_BAR;
    } else {
        PG8_STAGE(PG8_SB(0, 0), cB, voffB); PG8_STAGE(PG8_SA(0, 0), cA, voffA); PG8_STAGE(PG8_SB(0, 1), cB + hstep, voffB); PG8_STAGE(PG8_SA(0, 1), cA + hstep, voffA);
        if (wr == 1) PG8_BAR;
        PG8_WAIT_V(4); PG8_BAR;
        PG8_STAGE(PG8_SB(1, 0), cB + kstep, voffB); PG8_STAGE(PG8_SA(1, 0), cA + kstep, voffA); PG8_STAGE(PG8_SB(1, 1), cB + hstep + kstep, voffB);
        PG8_WAIT_V(6); PG8_BAR;
    }
    for (;;) {
        const bool has_next = S.next(ui + 1, nxt);
        const char* nA = has_next ? (const char*)(nxt.w ? g.A2 : g.A) + (size_t)nxt.pm * tstep : cA; const char* nB = has_next ? (const char*)(nxt.w ? g.Bt2 : g.Bt) + (size_t)nxt.pn * tstep : cB;
        for (int t = 0; t < nt; t += 2) {
            const bool last = (t == nt - 2);
            const char* a1 = cA + (size_t)(t + 1) * kstep;
            const char* a2 = last ? nA : cA + (size_t)(t + 2) * kstep; const char* b2 = last ? nB : cB + (size_t)(t + 2) * kstep;
            const char* a3 = a2 + kstep; const char* b3 = b2 + kstep;
            if (last && has_next) S.a_ready(nxt);
            if constexpr (SP2) {
            PG8_LDB(B0, 0, 0); PG8_LDB(B1, 0, 1); PG8_SCHED; PG8_LDA(At, 0, 0); PG8_STAGE(PG8_SA(1, 1), a1 + hstep, voffA);
            PG8_WAIT_V(8); PG8_WAIT_L(0); PG8_BAR; PG8_MMA(0, 0, At, B0); PG8_MMA(0, 1, At, B1); PG8_BAR; PG8_SCHED;
            PG8_LDA(At, 0, 1); PG8_STAGE(PG8_SB(0, 0), b2, voffB); PG8_STAGE(PG8_SB(0, 1), b2 + hstep, voffB); PG8_STAGE(PG8_SA(0, 0), a2, voffA);
            PG8_WAIT_V(8); PG8_WAIT_L(0); PG8_BAR; PG8_MMA(1, 0, At, B0); PG8_MMA(1, 1, At, B1); PG8_BAR; PG8_SCHED;
            PG8_LDB(B0, 1, 0); PG8_LDB(B1, 1, 1); PG8_SCHED; PG8_LDA(At, 1, 0); PG8_STAGE(PG8_SA(0, 1), a2 + hstep, voffA);
            PG8_WAIT_V(8); PG8_WAIT_L(0); PG8_BAR; PG8_MMA(0, 0, At, B0); PG8_MMA(0, 1, At, B1); PG8_BAR; PG8_SCHED;
            PG8_LDA(At, 1, 1); PG8_STAGE(PG8_SB(1, 0), b3, voffB); PG8_STAGE(PG8_SB(1, 1), b3 + hstep, voffB); PG8_STAGE(PG8_SA(1, 0), a3, voffA);
            PG8_WAIT_V(8); PG8_WAIT_L(0); PG8_BAR; PG8_MMA(1, 0, At, B0); PG8_MMA(1, 1, At, B1); PG8_BAR; PG8_SCHED;
            } else {
            PG8_LDB(B0, 0, 0); PG8_SCHED; PG8_LDA(At, 0, 0); PG8_STAGE(PG8_SA(1, 1), a1 + hstep, voffA);
            PG8_WAIT_L(8); PG8_BAR; PG8_WAIT_L(0); PG8_MMA(0, 0, At, B0); PG8_BAR; PG8_SCHED;
            PG8_LDB(B1, 0, 1); PG8_STAGE(PG8_SB(0, 0), b2, voffB);
            PG8_BAR; PG8_WAIT_L(0); PG8_MMA(0, 1, At, B1); PG8_BAR;
            PG8_LDA(At, 0, 1); PG8_STAGE(PG8_SA(0, 0), a2, voffA);
            PG8_BAR; PG8_WAIT_L(0); PG8_MMA(1, 0, At, B0); PG8_BAR; PG8_SCHED;
            PG8_STAGE(PG8_SB(0, 1), b2 + hstep, voffB);
            PG8_WAIT_V(6); PG8_BAR; PG8_MMA(1, 1, At, B1); PG8_BAR;
            PG8_LDB(B0, 1, 0); PG8_SCHED; PG8_LDA(At, 1, 0); PG8_STAGE(PG8_SA(0, 1), a2 + hstep, voffA);
            PG8_WAIT_L(8); PG8_BAR; PG8_WAIT_L(0); PG8_MMA(0, 0, At, B0); PG8_BAR; PG8_SCHED;
            PG8_LDB(B1, 1, 1); PG8_STAGE(PG8_SB(1, 0), b3, voffB);
            PG8_BAR; PG8_WAIT_L(0); PG8_MMA(0, 1, At, B1); PG8_BAR;
            PG8_LDA(At, 1, 1); PG8_STAGE(PG8_SA(1, 0), a3, voffA);
            PG8_BAR; PG8_WAIT_L(0); PG8_MMA(1, 0, At, B0); PG8_BAR; PG8_SCHED;
            PG8_STAGE(PG8_SB(1, 1), b3 + hstep, voffB);
            PG8_WAIT_V(6); PG8_BAR; PG8_MMA(1, 1, At, B1); PG8_BAR;
            }
        }
        if constexpr (ALIGN_EPI) { if (wr == 0) PG8_BAR; }
        bool keep_acc = false;
        if constexpr (!Epi::AFTER_DRAIN) { if constexpr (epi_chains<Epi>::value) keep_acc = E.chain(acc, cur, wr, wc, fr, fq); else E(acc, cur, wr, wc, fr, fq); S.done(cur); }
        if (!has_next) break;
        if (!keep_acc) {
#pragma unroll
        for (int a = 0; a < 2; ++a)
#pragma unroll
            for (int b = 0; b < 2; ++b)
#pragma unroll
                for (int m = 0; m < 4; ++m)
#pragma unroll
                    for (int n = 0; n < 2; ++n) acc[a][b][m][n] = acc_t{};
        }
        cur = nxt; cA = nA; cB = nB; ++ui;
        if constexpr (ALIGN_EPI) { if (wr == 1) PG8_BAR; }
    }
    PG8_WAIT_V(0);
    if constexpr (!ALIGN_EPI) { if (wr == 0) PG8_BAR; }
    PG8_BAR;
    if constexpr (Epi::AFTER_DRAIN) { E.fused(acc, cur, wr, wc, fr, fq, lds, wid, lane); S.done(cur); }
#undef PG8_SA
#undef PG8_SB
#undef PG8_STAGE
#undef PG8_LDA
#undef PG8_LDB
#undef PG8_MMA
#undef PG8_WAIT_V
#undef PG8_WAIT_L
#undef PG8_BAR
#undef PG8_SCHED
}
}
#define GAS __attribute__((address_space(1)))
#define LAS __attribute__((address_space(3)))
typedef unsigned short bf16;
typedef unsigned v4u __attribute__((ext_vector_type(4)));
typedef float f32x4 __attribute__((ext_vector_type(4)));
typedef short bf16x8 __attribute__((ext_vector_type(8)));
typedef GAS unsigned gu32;
typedef GAS unsigned long long gu64;
#define RLX_AGENT __ATOMIC_RELAXED, __HIP_MEMORY_SCOPE_AGENT
#define LDS_WAIT() asm volatile("s_waitcnt lgkmcnt(0)" ::: "memory")
#define VM_WAIT() asm volatile("s_waitcnt vmcnt(0)" ::: "memory")
__device__ __forceinline__ unsigned long long rt() { return __builtin_amdgcn_s_memrealtime(); }
__device__ __forceinline__ unsigned f2bf(float f) { unsigned u = __builtin_bit_cast(unsigned, f); return (u + 0x7fffu + ((u >> 16) & 1u)) >> 16; }
__device__ __forceinline__ unsigned pk2(float lo, float hi) { return f2bf(lo) | (f2bf(hi) << 16); }

#define XB_TMO      128
#define XB_XCNT(j)  (256  + 64 * (j))
#define XB_XSUB(j)  (1280 + 64 * (j))
#define XB_XGEN(j)  (2304 + 64 * (j))
#define XB_TOP      3328
#define XB_TOPGEN   3392
#define XCD_BAR_WORDS 3456
#define XB_SPIN_CAP (1u << 18)

__device__ __forceinline__ unsigned xb_ld(unsigned* p)              { return __hip_atomic_load(p, __ATOMIC_RELAXED, __HIP_MEMORY_SCOPE_AGENT); }
__device__ __forceinline__ unsigned xb_add(unsigned* p, unsigned v) { return __hip_atomic_fetch_add(p, v, __ATOMIC_RELAXED, __HIP_MEMORY_SCOPE_AGENT); }
__device__ __forceinline__ unsigned xb_xcc_id() { return (unsigned)__builtin_amdgcn_s_getreg((3 << 11) | 20) & 0xFu; }
#define XB_SPIN(cond, bar) do { unsigned _sp = 0; while (cond) { __builtin_amdgcn_s_sleep(1); \
    if ((++_sp & 255u) == 0u) { if (xb_ld(&(bar)[XB_TMO])) break; if (_sp > XB_SPIN_CAP) { atomicAdd(&(bar)[XB_TMO], 1u); break; } } } } while (0)

struct XcdBarrier {
    unsigned* bar; unsigned x;
    volatile LAS unsigned* st;
};

__device__ __forceinline__ XcdBarrier xcd_barrier_post(unsigned* bar, volatile LAS unsigned* st) {
    XcdBarrier b; b.bar = bar; b.x = xb_xcc_id(); b.st = st;
    if (threadIdx.x == 0) (void)xb_add(&bar[XB_XCNT(b.x)], 1u);
    return b;
}
__device__ __forceinline__ void xcd_barrier_complete(unsigned* bar, unsigned x, unsigned& nloc, unsigned& nx) {
    const unsigned G = gridDim.x * gridDim.y * gridDim.z;
    unsigned sum, cnt, mine, sp = 0u;
    for (;;) {
        sum = 0u; cnt = 0u; mine = 0u;
#pragma unroll
        for (unsigned j = 0; j < 16; ++j) { const unsigned c = xb_ld(&bar[XB_XCNT(j)]); sum += c; cnt += (c > 0u) ? 1u : 0u; mine = (j == x) ? c : mine; }
        if (sum == G) break;
        __builtin_amdgcn_s_sleep(1);
        if ((++sp & 255u) == 0u) { if (xb_ld(&bar[XB_TMO])) break; if (sp > XB_SPIN_CAP) { atomicAdd(&bar[XB_TMO], 1u); break; } }
    }
    nloc = mine > 0u ? mine : 1u; nx = cnt > 0u ? cnt : 1u;
}

__device__ __forceinline__ void xcd_barrier(const XcdBarrier& b) {
    asm volatile("s_waitcnt vmcnt(0)" ::: "memory");
    __syncthreads();
    if (threadIdx.x == 0) {
        unsigned* bar = b.bar;
        __builtin_amdgcn_s_waitcnt(0);
        unsigned nloc = b.st[0], nx = b.st[1];
        if (nloc == 0u) { xcd_barrier_complete(bar, b.x, nloc, nx); b.st[0] = nloc; b.st[1] = nx; }
        const unsigned old = xb_add(&bar[XB_XSUB(b.x)], 1u);
        const unsigned gen = old / nloc;
        if (old + 1u == (gen + 1u) * nloc) {
            __builtin_amdgcn_fence(__ATOMIC_RELEASE, "agent");
            asm volatile("s_waitcnt vmcnt(0)" ::: "memory");
            const unsigned og = xb_add(&bar[XB_TOP], 1u);
            const unsigned tg = og / nx;
            if (og + 1u == (tg + 1u) * nx) xb_add(&bar[XB_TOPGEN], 1u);
            else XB_SPIN(xb_ld(&bar[XB_TOPGEN]) == tg, bar);
            __builtin_amdgcn_fence(__ATOMIC_ACQUIRE, "agent");
            xb_add(&bar[XB_XGEN(b.x)], 1u);
            asm volatile("s_waitcnt vmcnt(0)" ::: "memory");
        } else {
            XB_SPIN(xb_ld(&bar[XB_XGEN(b.x)]) == gen, bar);
            __builtin_amdgcn_fence(__ATOMIC_ACQUIRE, "agent");
            asm volatile("s_waitcnt vmcnt(0)" ::: "memory");
        }
    }
    __syncthreads();
}

constexpr int NWAVES = 8, NTHREADS = 512;
constexpr int BATCH = 4, SEQ = 2048, D = 2048, M = BATCH * SEQ;
constexpr int NQH = 32, NKVH = 4, HD = 64, QPKV = 8, WINDOW = 128;
constexpr int Q_OFF = 0, K_OFF = 2048, V_OFF = 2304, CB_OFF = 2560, CC_OFF = 4608, CH_OFF = 6656, G_OFF = 8704, IN_W = 12800;
constexpr int PH = 8, PNK = 128, PTOPK = 16, PNE = 16384;
constexpr float LN_EPS = 1e-5f;
constexpr float ALPHA = 1.189207115002721f;

#ifndef MK_PER_PHASE
#define MK_PER_PHASE 0
#endif
constexpr int N_PHASES = 12;

constexpr size_t MiB = 1u << 20;
constexpr size_t WS_CTL = 0, CTL_ZERO_BYTES = 1 * MiB;
constexpr size_t WS_WIN = 1 * MiB;
constexpr size_t WS_WA = 51 * MiB, WS_WC = 59 * MiB, WS_WO = 67 * MiB, WS_WF = 75 * MiB;
constexpr size_t WS_XB = 83 * MiB;
constexpr size_t WS_MERGED = WS_XB;
constexpr size_t WS_Z = 115 * MiB;
constexpr size_t WS_R2B = 115 * MiB;
constexpr size_t WS_H1B = 179 * MiB;
constexpr size_t WS_SC = 211 * MiB;
constexpr size_t WS_EX = 275 * MiB;
constexpr size_t WS_GT = 279 * MiB;
constexpr size_t WS_AO = 315 * MiB, WS_CI = 347 * MiB, WS_TMP = 379 * MiB;
constexpr size_t WS_U8 = 411 * MiB, WS_V8 = 443 * MiB;
constexpr size_t WS_SU = 475 * MiB, WS_SV = WS_SU + 65536;
constexpr size_t WS_PA = WS_SC;
constexpr size_t WS_XQ = 283 * MiB;
constexpr size_t WS_SX = 299 * MiB;
constexpr size_t WS_WB = 380 * MiB;
constexpr size_t WS_ST = 379 * MiB;
constexpr size_t WS_XA8 = WS_XB;
constexpr size_t WS_WIN8 = 476 * MiB;
constexpr size_t WS_SWIN = 501 * MiB, WS_SXA = WS_SWIN + 65536;
constexpr size_t WS_AO8 = 1 * MiB, WS_CI8 = 17 * MiB, WS_WA8 = 33 * MiB, WS_WC8 = 37 * MiB, WS_S3 = 41 * MiB;
constexpr size_t WS_WF8 = 502 * MiB;
constexpr size_t WS_SWF = WS_SXA + 65536;
constexpr size_t WS_MG8 = 1 * MiB;
constexpr size_t WS_WO8 = 506 * MiB;
constexpr size_t WS_SMG = WS_S3 + 262144, WS_SWO = WS_SWF + 16384;
constexpr size_t WS_SEG = 315 * MiB, WS_SOFF = 323 * MiB;
constexpr size_t WS_END = 510 * MiB;
constexpr int CW_Q = 12288;
constexpr size_t SLICE_BYTES = (size_t)PNE * 256;
constexpr int CW_BAR = 4096;

constexpr int RING_BYTES = 131072;
constexpr int LDSCTL_OFF = 163328, MISC_OFF = LDSCTL_OFF + 320;
constexpr int LDS_BYTES = LDSCTL_OFF + 512;

typedef float f32x16 __attribute__((ext_vector_type(16)));
typedef unsigned v2u __attribute__((ext_vector_type(2)));
__device__ __forceinline__ float wave_sum(float v) {
#pragma unroll
    for (int o = 1; o < 64; o <<= 1) v += __shfl_xor(v, o);
    return v;
}
__device__ __forceinline__ float vmaxf(float a, float b) { float r; asm("v_max_f32_e32 %0, %1, %2" : "=v"(r) : "v"(a), "v"(b)); return r; }
__device__ __forceinline__ float vminf(float a, float b) { float r; asm("v_min_f32_e32 %0, %1, %2" : "=v"(r) : "v"(a), "v"(b)); return r; }

__device__ __forceinline__ void p0_transpose_item(const float* W, int K, int N, bf16* WT, LAS float* scr, int item, int lane) {
    const int nblk = N / 32, kb = item / nblk, nb = item % nblk, k0 = 64 * kb, n0 = 32 * nb;
#pragma unroll 8
    for (int i = 0; i < 32; ++i) { const int kk = 2 * i + (lane >> 5); scr[kk * 33 + (lane & 31)] = W[(size_t)(k0 + kk) * N + n0 + (lane & 31)]; }
    LDS_WAIT(); asm volatile("" ::: "memory");
    const int c = lane & 7;
#pragma unroll
    for (int j = 0; j < 4; ++j) { const int n = (lane >> 3) + 8 * j; const LAS float* s = scr + (8 * c) * 33 + n;
        v4u o; o.x = pk2(s[0 * 33], s[1 * 33]); o.y = pk2(s[2 * 33], s[3 * 33]); o.z = pk2(s[4 * 33], s[5 * 33]); o.w = pk2(s[6 * 33], s[7 * 33]);
        *(GAS v4u*)(WT + (size_t)(n0 + n) * K + k0 + 8 * c) = o; }
    LDS_WAIT(); asm volatile("" ::: "memory");
}
__device__ __forceinline__ void p0_wf_item(const float* wq, const float* sk, bf16* WfT, LAS unsigned char* lds, int item, int tid) {
    const int hp = item >> 5, dt = item & 31;
    LAS f32x4* SK4 = (LAS f32x4*)lds;
    LAS f32x4* WQ4 = SK4 + 128 * 33;
    const float* skp = sk + (size_t)hp * 128 * 128;
    for (int i = tid; i < 128 * 32; i += NTHREADS) { const int n = i >> 5, c4 = i & 31; SK4[n * 33 + c4] = *(const f32x4*)(skp + n * 128 + 4 * c4); }
    for (int i = tid; i < 64 * 32; i += NTHREADS) { const int r = i >> 5, c4 = i & 31; WQ4[r * 33 + c4] = *(const f32x4*)(wq + (size_t)(64 * dt + r) * 2048 + hp * 128 + 4 * c4); }
    __syncthreads();
    const int td = tid & 15, tn = tid >> 4;
    float acc[4][4];
#pragma unroll
    for (int i = 0; i < 4; ++i)
#pragma unroll
        for (int j = 0; j < 4; ++j) acc[i][j] = 0.f;
#pragma unroll 4
    for (int c4 = 0; c4 < 32; ++c4) {
        f32x4 a[4], b[4];
#pragma unroll
        for (int i = 0; i < 4; ++i) a[i] = SK4[(4 * tn + i) * 33 + c4];
#pragma unroll
        for (int j = 0; j < 4; ++j) b[j] = WQ4[(td + 16 * j) * 33 + c4];
#pragma unroll
        for (int i = 0; i < 4; ++i)
#pragma unroll
            for (int j = 0; j < 4; ++j) acc[i][j] += a[i].x * b[j].x + a[i].y * b[j].y + a[i].z * b[j].z + a[i].w * b[j].w;
    }
#pragma unroll
    for (int i = 0; i < 4; ++i)
#pragma unroll
        for (int j = 0; j < 4; ++j) WfT[(size_t)(hp * 128 + 4 * tn + i) * 2048 + 64 * dt + td + 16 * j] = (bf16)f2bf(acc[i][j]);
    __syncthreads();
}

__device__ __forceinline__ int perm16(int o) { return 8 * ((o >> 2) & 1) + 4 * (o >> 3) + (o & 3); }
__device__ __forceinline__ void attn_unit(int unit, const bf16* z, bf16* ao, const float* sinks, LAS unsigned char* lds, int tid) {
    const int lane = tid & 63, wid = __builtin_amdgcn_readfirstlane(tid >> 6), r32 = lane & 31, hi = lane >> 5;
    const int nb = unit & 15, kvh = (unit >> 4) & 3, b = unit >> 6;
    LAS bf16* Ks = (LAS bf16*)lds;
    LAS bf16* Vt = (LAS bf16*)(lds + 256 * 144);
    const size_t tok0 = (size_t)b * SEQ;
#pragma unroll
    for (int i = 0; i < 4; ++i) {
        const int ci = tid + NTHREADS * i, key = ci >> 3, dc = ci & 7;
        int kpos = 128 * (nb - 1) + key; if (kpos < 0) kpos = 0;
        const bf16* src = z + (tok0 + kpos) * IN_W + K_OFF + kvh * HD + dc * 8;
        const v4u kv = *(const GAS v4u*)src, vv = *(const GAS v4u*)(src + (V_OFF - K_OFF));
        *(LAS v4u*)(Ks + key * 72 + dc * 8) = kv;
        const int pos = (key & ~15) + perm16(key & 15);
        LAS bf16* vp = Vt + (dc * 8) * 264 + pos;
        vp[0 * 264] = (bf16)(vv.x & 0xffffu); vp[1 * 264] = (bf16)(vv.x >> 16); vp[2 * 264] = (bf16)(vv.y & 0xffffu); vp[3 * 264] = (bf16)(vv.y >> 16);
        vp[4 * 264] = (bf16)(vv.z & 0xffffu); vp[5 * 264] = (bf16)(vv.z >> 16); vp[6 * 264] = (bf16)(vv.w & 0xffffu); vp[7 * 264] = (bf16)(vv.w >> 16);
    }
    __syncthreads();
    const int hq = kvh * QPKV + wid;
    const float LOG2E = 1.4426950408889634f;
    const float sink2 = sinks[hq] * LOG2E, sc = 0.125f * LOG2E;
#pragma unroll 1
    for (int qg = 0; qg < 4; ++qg) {
        const size_t tok = tok0 + 128 * nb + 32 * qg + r32;
        bf16x8 qf[4];
#pragma unroll
        for (int ks = 0; ks < 4; ++ks) qf[ks] = *(const GAS bf16x8*)(z + tok * IN_W + Q_OFF + hq * HD + 16 * ks + 8 * hi);
        f32x16 s[5];
#pragma unroll
        for (int kt = 0; kt < 5; ++kt) {
            s[kt] = (f32x16){0.f, 0.f, 0.f, 0.f, 0.f, 0.f, 0.f, 0.f, 0.f, 0.f, 0.f, 0.f, 0.f, 0.f, 0.f, 0.f};
#pragma unroll
            for (int ks = 0; ks < 4; ++ks) {
                const bf16x8 kf = *(const LAS bf16x8*)(Ks + (32 * (qg + kt) + r32) * 72 + 16 * ks + 8 * hi);
                s[kt] = __builtin_amdgcn_mfma_f32_32x32x16_bf16(kf, qf[ks], s[kt], 0, 0, 0);
            }
        }
        float mx = sink2;
#pragma unroll
        for (int kt = 0; kt < 5; ++kt) {
            const bool tile_dead = (nb == 0) && (qg + kt < 4);
#pragma unroll
            for (int r = 0; r < 16; ++r) {
                const int krow = (r & 3) + 8 * (r >> 2) + 4 * hi;
                bool valid = !tile_dead;
                if (kt == 0) valid = valid && (krow > r32);
                if (kt == 4) valid = valid && (krow <= r32);
                const float v = valid ? s[kt][r] * sc : -INFINITY;
                s[kt][r] = v; mx = fmaxf(mx, v);
            }
        }
        mx = fmaxf(mx, __shfl_xor(mx, 32));
        float sum = 0.f;
#pragma unroll
        for (int kt = 0; kt < 5; ++kt)
#pragma unroll
            for (int r = 0; r < 16; ++r) { const float p = __builtin_amdgcn_exp2f(s[kt][r] - mx); s[kt][r] = p; sum += p; }
        sum += __shfl_xor(sum, 32);
        const float inv = 1.0f / (sum + __builtin_amdgcn_exp2f(sink2 - mx));
        f32x16 o[2];
        o[0] = (f32x16){0.f, 0.f, 0.f, 0.f, 0.f, 0.f, 0.f, 0.f, 0.f, 0.f, 0.f, 0.f, 0.f, 0.f, 0.f, 0.f}; o[1] = o[0];
#pragma unroll
        for (int kt = 0; kt < 5; ++kt)
#pragma unroll
            for (int s2 = 0; s2 < 2; ++s2) {
                v4u pw; pw.x = pg8::cvt_pk_bf16(s[kt][8 * s2 + 0], s[kt][8 * s2 + 1]); pw.y = pg8::cvt_pk_bf16(s[kt][8 * s2 + 2], s[kt][8 * s2 + 3]);
                pw.z = pg8::cvt_pk_bf16(s[kt][8 * s2 + 4], s[kt][8 * s2 + 5]); pw.w = pg8::cvt_pk_bf16(s[kt][8 * s2 + 6], s[kt][8 * s2 + 7]);
                const bf16x8 pa = __builtin_bit_cast(bf16x8, pw);
#pragma unroll
                for (int dt = 0; dt < 2; ++dt) {
                    const bf16x8 vf = *(const LAS bf16x8*)(Vt + (32 * dt + r32) * 264 + 32 * (qg + kt) + 16 * s2 + 8 * hi);
                    o[dt] = __builtin_amdgcn_mfma_f32_32x32x16_bf16(vf, pa, o[dt], 0, 0, 0);
                }
            }
        bf16* op = ao + tok * D + hq * HD;
#pragma unroll
        for (int dt = 0; dt < 2; ++dt)
#pragma unroll
            for (int g = 0; g < 4; ++g) {
                v2u w; w.x = pg8::cvt_pk_bf16(o[dt][4 * g + 0] * inv, o[dt][4 * g + 1] * inv); w.y = pg8::cvt_pk_bf16(o[dt][4 * g + 2] * inv, o[dt][4 * g + 3] * inv);
                *(GAS v2u*)(op + 32 * dt + 8 * g + 4 * hi) = w;
            }
    }
    __syncthreads();
}
__device__ __forceinline__ void conv_item(int item, const bf16* z, const float* cw, bf16* ci, int tid) {
    const int c8 = tid & 255, half = tid >> 8, t0 = 32 * item + 16 * half, c0 = 8 * c8;
    float w0[8], w1[8], w2[8], u1[8], u2[8];
#pragma unroll
    for (int e = 0; e < 8; ++e) { w0[e] = cw[c0 + e]; w1[e] = cw[2048 + c0 + e]; w2[e] = cw[4096 + c0 + e]; u1[e] = 0.f; u2[e] = 0.f; }
    if ((t0 & (SEQ - 1)) != 0) {
#pragma unroll
        for (int k = 0; k < 2; ++k) {
            const bf16* zr = z + (size_t)(t0 - 2 + k) * IN_W + c0;
            const v4u a = *(const GAS v4u*)(zr + CC_OFF), h = *(const GAS v4u*)(zr + CH_OFF);
            float u[8];
            u[0] = pg8::bf_lo(a.x) * pg8::bf_lo(h.x); u[1] = pg8::bf_hi(a.x) * pg8::bf_hi(h.x); u[2] = pg8::bf_lo(a.y) * pg8::bf_lo(h.y); u[3] = pg8::bf_hi(a.y) * pg8::bf_hi(h.y);
            u[4] = pg8::bf_lo(a.z) * pg8::bf_lo(h.z); u[5] = pg8::bf_hi(a.z) * pg8::bf_hi(h.z); u[6] = pg8::bf_lo(a.w) * pg8::bf_lo(h.w); u[7] = pg8::bf_hi(a.w) * pg8::bf_hi(h.w);
#pragma unroll
            for (int e = 0; e < 8; ++e) { if (k == 0) u2[e] = u[e]; else u1[e] = u[e]; }
        }
    }
#pragma unroll 4
    for (int i = 0; i < 16; ++i) {
        const bf16* zr = z + (size_t)(t0 + i) * IN_W + c0;
        const v4u a = *(const GAS v4u*)(zr + CC_OFF), h = *(const GAS v4u*)(zr + CH_OFF), bb = *(const GAS v4u*)(zr + CB_OFF);
        float u[8], cb[8], y[8];
        u[0] = pg8::bf_lo(a.x) * pg8::bf_lo(h.x); u[1] = pg8::bf_hi(a.x) * pg8::bf_hi(h.x); u[2] = pg8::bf_lo(a.y) * pg8::bf_lo(h.y); u[3] = pg8::bf_hi(a.y) * pg8::bf_hi(h.y);
        u[4] = pg8::bf_lo(a.z) * pg8::bf_lo(h.z); u[5] = pg8::bf_hi(a.z) * pg8::bf_hi(h.z); u[6] = pg8::bf_lo(a.w) * pg8::bf_lo(h.w); u[7] = pg8::bf_hi(a.w) * pg8::bf_hi(h.w);
        cb[0] = pg8::bf_lo(bb.x); cb[1] = pg8::bf_hi(bb.x); cb[2] = pg8::bf_lo(bb.y); cb[3] = pg8::bf_hi(bb.y); cb[4] = pg8::bf_lo(bb.z); cb[5] = pg8::bf_hi(bb.z); cb[6] = pg8::bf_lo(bb.w); cb[7] = pg8::bf_hi(bb.w);
#pragma unroll
        for (int e = 0; e < 8; ++e) { y[e] = cb[e] * (w0[e] * u2[e] + w1[e] * u1[e] + w2[e] * u[e]); u2[e] = u1[e]; u1[e] = u[e]; }
        v4u o; o.x = pk2(y[0], y[1]); o.y = pk2(y[2], y[3]); o.z = pk2(y[4], y[5]); o.w = pk2(y[6], y[7]);
        *(GAS v4u*)(ci + (size_t)(t0 + i) * D + c0) = o;
    }
}

__device__ __forceinline__ unsigned pack_i8(const f32x4 v) {
    const int a = __float2int_rn(v.x), b = __float2int_rn(v.y), c = __float2int_rn(v.z), d = __float2int_rn(v.w);
    return ((unsigned)a & 0xffu) | (((unsigned)b & 0xffu) << 8) | (((unsigned)c & 0xffu) << 16) | ((unsigned)d << 24);
}
__device__ __forceinline__ unsigned pack_i8_2(float a, float b, float c, float d) {
    const int ia = __float2int_rn(a), ib = __float2int_rn(b), ic = __float2int_rn(c), id = __float2int_rn(d);
    return ((unsigned)ia & 0xffu) | (((unsigned)ib & 0xffu) << 8) | (((unsigned)ic & 0xffu) << 16) | ((unsigned)id << 24);
}
__device__ __forceinline__ void ln1_row(bf16* hbrow, signed char* xqrow, float* sxp, const float* g, const float* bta, int lane) {
    GAS v4u* xr = (GAS v4u*)hbrow + lane;
    float v[4][8]; float s = 0.f;
#pragma unroll
    for (int j = 0; j < 4; ++j) { const v4u w = xr[64 * j];
        v[j][0] = pg8::bf_lo(w.x); v[j][1] = pg8::bf_hi(w.x); v[j][2] = pg8::bf_lo(w.y); v[j][3] = pg8::bf_hi(w.y); v[j][4] = pg8::bf_lo(w.z); v[j][5] = pg8::bf_hi(w.z); v[j][6] = pg8::bf_lo(w.w); v[j][7] = pg8::bf_hi(w.w);
#pragma unroll
        for (int e = 0; e < 8; ++e) s += v[j][e]; }
    const float mean = wave_sum(s) * (1.f / D); float s2 = 0.f;
#pragma unroll
    for (int j = 0; j < 4; ++j)
#pragma unroll
        for (int e = 0; e < 8; ++e) { v[j][e] -= mean; s2 += v[j][e] * v[j][e]; }
    const float rstd = 1.f / sqrtf(wave_sum(s2) * (1.f / D) + LN_EPS);
    float mx = 0.f;
#pragma unroll
    for (int j = 0; j < 4; ++j) {
        const GAS f32x4* gp = (const GAS f32x4*)g + 2 * (lane + 64 * j); const GAS f32x4* bp = (const GAS f32x4*)bta + 2 * (lane + 64 * j);
        const f32x4 g0 = gp[0], g1 = gp[1], b0 = bp[0], b1 = bp[1];
        v[j][0] = v[j][0] * rstd * g0.x + b0.x; v[j][1] = v[j][1] * rstd * g0.y + b0.y; v[j][2] = v[j][2] * rstd * g0.z + b0.z; v[j][3] = v[j][3] * rstd * g0.w + b0.w;
        v[j][4] = v[j][4] * rstd * g1.x + b1.x; v[j][5] = v[j][5] * rstd * g1.y + b1.y; v[j][6] = v[j][6] * rstd * g1.z + b1.z; v[j][7] = v[j][7] * rstd * g1.w + b1.w;
        v4u o; o.x = pk2(v[j][0], v[j][1]); o.y = pk2(v[j][2], v[j][3]); o.z = pk2(v[j][4], v[j][5]); o.w = pk2(v[j][6], v[j][7]);
        xr[64 * j] = o;
#pragma unroll
        for (int e = 0; e < 8; ++e) mx = fmaxf(mx, fabsf(v[j][e]));
    }
#pragma unroll
    for (int o = 1; o < 64; o <<= 1) mx = fmaxf(mx, __shfl_xor(mx, o));
    const float qs = mx > 0.f ? 127.0f / mx : 1.0f;
    GAS v2u* q8 = (GAS v2u*)xqrow + lane;
#pragma unroll
    for (int j = 0; j < 4; ++j) { v2u o; o.x = pack_i8_2(v[j][0] * qs, v[j][1] * qs, v[j][2] * qs, v[j][3] * qs); o.y = pack_i8_2(v[j][4] * qs, v[j][5] * qs, v[j][6] * qs, v[j][7] * qs); q8[64 * j] = o; }
    if (lane == 0) *sxp = mx > 0.f ? mx * (1.0f / 127.0f) : 1.0f;
}

__device__ __forceinline__ void row_f32_to_i8(const float* src, signed char* dst, float* inv, int lane) {
    f32x4 v[8]; float mx = 0.f;
#pragma unroll
    for (int j = 0; j < 8; ++j) { v[j] = *((const GAS f32x4*)src + lane + 64 * j); mx = fmaxf(mx, fmaxf(fmaxf(fabsf(v[j].x), fabsf(v[j].y)), fmaxf(fabsf(v[j].z), fabsf(v[j].w)))); }
#pragma unroll
    for (int o = 1; o < 64; o <<= 1) mx = fmaxf(mx, __shfl_xor(mx, o));
    const float sc = mx > 0.f ? 127.0f / mx : 1.0f;
#pragma unroll
    for (int j = 0; j < 8; ++j) *((GAS unsigned*)dst + lane + 64 * j) = pack_i8_2(v[j].x * sc, v[j].y * sc, v[j].z * sc, v[j].w * sc);
    if (lane == 0) *inv = mx > 0.f ? mx * (1.0f / 127.0f) : 1.0f;
}
__device__ __forceinline__ void row_bf16_to_i8(const bf16* src, signed char* dst, float* inv, int lane) {
    float v[4][8]; float mx = 0.f;
#pragma unroll
    for (int j = 0; j < 4; ++j) { const v4u w = *((const GAS v4u*)src + lane + 64 * j);
        v[j][0] = pg8::bf_lo(w.x); v[j][1] = pg8::bf_hi(w.x); v[j][2] = pg8::bf_lo(w.y); v[j][3] = pg8::bf_hi(w.y); v[j][4] = pg8::bf_lo(w.z); v[j][5] = pg8::bf_hi(w.z); v[j][6] = pg8::bf_lo(w.w); v[j][7] = pg8::bf_hi(w.w);
#pragma unroll
        for (int e = 0; e < 8; ++e) mx = fmaxf(mx, fabsf(v[j][e])); }
#pragma unroll
    for (int o = 1; o < 64; o <<= 1) mx = fmaxf(mx, __shfl_xor(mx, o));
    const float sc = mx > 0.f ? 127.0f / mx : 1.0f;
#pragma unroll
    for (int j = 0; j < 4; ++j) { v2u o; o.x = pack_i8_2(v[j][0] * sc, v[j][1] * sc, v[j][2] * sc, v[j][3] * sc); o.y = pack_i8_2(v[j][4] * sc, v[j][5] * sc, v[j][6] * sc, v[j][7] * sc); *((GAS v2u*)dst + lane + 64 * j) = o; }
    if (lane == 0) *inv = mx > 0.f ? mx * (1.0f / 127.0f) : 1.0f;
}

constexpr int TK_ROWF = 136;
constexpr int TK_IDX_OFF = 256 * TK_ROWF * 4;
__device__ __forceinline__ void topk_core(LAS unsigned char* lds, size_t prob0, int pstride, int* experts, float* gates, int tid) {
    LAS float* S = (LAS float*)lds;
    LAS unsigned char* IDX = lds + TK_IDX_OFF;
    const int row = tid >> 1, sub = tid & 1;
#define TK_CE(a, b) do { const float h_ = vmaxf(a, b), l_ = vminf(a, b); a = h_; b = l_; } while (0)
#define TK_SORT16(V) do { _Pragma("unroll") for (int k_ = 2; k_ <= 16; k_ <<= 1) _Pragma("unroll") for (int j_ = k_ >> 1; j_ > 0; j_ >>= 1) _Pragma("unroll") for (int i_ = 0; i_ < 16; ++i_) { \
        const int l_i = i_ ^ j_; if (l_i > i_) { if ((i_ & k_) == 0) TK_CE(V[i_], V[l_i]); else TK_CE(V[l_i], V[i_]); } } } while (0)
#define TK_MERGE16(Lv, Xv) do { _Pragma("unroll") for (int j_ = 0; j_ < 16; ++j_) Lv[j_] = vmaxf(Lv[j_], Xv[15 - j_]); \
        _Pragma("unroll") for (int st_ = 8; st_ >= 1; st_ >>= 1) _Pragma("unroll") for (int j_ = 0; j_ < 16; ++j_) if ((j_ & st_) == 0) TK_CE(Lv[j_], Lv[j_ + st_]); } while (0)
    float L[16];
#pragma unroll
    for (int q = 0; q < 4; ++q) {
        float C[16];
#pragma unroll
        for (int i = 0; i < 4; ++i) { const int c4 = 2 * (4 * q + i) + sub;
            const f32x4 v = *(const LAS f32x4*)(S + row * TK_ROWF + 4 * c4);
#pragma unroll
            for (int e = 0; e < 4; ++e) { const float ve = v[e];
                C[4 * i + e] = __uint_as_float((__float_as_uint(ve) & ~0x7Fu) | (unsigned)(4 * c4 + e)); } }
        TK_SORT16(C);
        if (q == 0) {
#pragma unroll
            for (int j = 0; j < 16; ++j) L[j] = C[j];
        } else TK_MERGE16(L, C);
    }
    {
        float P[16];
#pragma unroll
        for (int j = 0; j < 16; ++j) P[j] = __shfl_xor(L[j], 1);
        TK_MERGE16(L, P);
    }
    if (sub == 0) {
#pragma unroll
        for (int q = 0; q < 4; ++q) {
            unsigned w = 0;
#pragma unroll
            for (int e = 0; e < 4; ++e) w |= (__builtin_bit_cast(unsigned, L[4 * q + e]) & 0x7Fu) << (8 * e);
            *(LAS unsigned*)(IDX + row * 16 + 4 * q) = w;
        }
    }
    float A[16], B[16];
#pragma unroll
    for (int j = 0; j < 16; ++j) { const float o = __shfl_xor(L[j], 2); const bool isb = (tid & 2) != 0; A[j] = isb ? o : L[j]; B[j] = isb ? L[j] : o; }
#define TK_KEY(i, j) __uint_as_float((__float_as_uint(A[i] + B[j]) & ~0xFFu) | (unsigned)(255 - ((i) * 16 + (j))))
    float F[16], X[16];
#pragma unroll
    for (int j = 0; j < 16; ++j) F[j] = TK_KEY(0, j);
#pragma unroll
    for (int i = 1; i < 16; ++i) X[i - 1] = TK_KEY(i, 0);
    X[15] = -INFINITY; TK_MERGE16(F, X);
#pragma unroll
    for (int i = 0; i < 16; ++i) X[i] = -INFINITY;
#pragma unroll
    for (int i = 1; i <= 7; ++i) X[i - 1] = TK_KEY(i, 1);
    TK_MERGE16(F, X);
#pragma unroll
    for (int i = 0; i < 16; ++i) X[i] = -INFINITY;
#pragma unroll
    for (int j = 2; j <= 7; ++j) X[j - 2] = TK_KEY(1, j);
    TK_MERGE16(F, X);
    { const float rest[6] = {TK_KEY(2, 2), TK_KEY(2, 3), TK_KEY(2, 4), TK_KEY(3, 2), TK_KEY(3, 3), TK_KEY(4, 2)};
#pragma unroll
      for (int r = 0; r < 6; ++r) { float x = rest[r];
#pragma unroll
          for (int k = 0; k < 16; ++k) { const float h = vmaxf(F[k], x); x = vminf(F[k], x); F[k] = h; } } }
    __syncthreads();
    if ((tid & 3) == 0) {
        const int rowA = (tid >> 2) * 2, rowB = rowA + 1;
        const size_t prob = prob0 + (size_t)pstride * (tid >> 2);
        float g[16]; int ex[16]; float gs = 0.f;
#pragma unroll
        for (int k = 0; k < 16; ++k) {
            const unsigned code = 255u - (__builtin_bit_cast(unsigned, F[k]) & 0xFFu);
            const int ia = IDX[rowA * 16 + (code >> 4)], ib = IDX[rowB * 16 + (code & 15)];
            ex[k] = ia * PNK + ib;
            g[k] = __expf(F[k] - F[0]); gs += g[k];
        }
        const float ginv = 1.0f / gs;
#pragma unroll
        for (int q = 0; q < 4; ++q) {
            *(GAS f32x4*)(gates + prob * 16 + 4 * q) = (f32x4){g[4 * q] * ginv, g[4 * q + 1] * ginv, g[4 * q + 2] * ginv, g[4 * q + 3] * ginv};
            typedef int i32x4 __attribute__((ext_vector_type(4)));
            *(GAS i32x4*)(experts + prob * 16 + 4 * q) = (i32x4){ex[4 * q], ex[4 * q + 1], ex[4 * q + 2], ex[4 * q + 3]};
        }
    }
    __syncthreads();
}
__device__ __forceinline__ void topk_pass(int pass, const float* scores, int* experts, float* gates, LAS unsigned char* lds, int tid) {
    LAS float* S = (LAS float*)lds;
    const float* src = scores + (size_t)pass * (256 * 128);
#pragma unroll 4
    for (int i = 0; i < 16; ++i) { const int f4 = tid + NTHREADS * i, row = f4 >> 5, c4 = f4 & 31; *(LAS f32x4*)(S + row * TK_ROWF + 4 * c4) = *(const GAS f32x4*)(src + (size_t)f4 * 4); }
    __syncthreads();
    topk_core(lds, (size_t)pass * 128, 1, experts, gates, tid);
}
struct EpiTopKI8 {
    static constexpr bool PERM = false, AFTER_DRAIN = true;
    int* experts; float* gates; const float* sa; const float* sb;
    __device__ __forceinline__ void fused(pg8::i32x4 (&acc)[2][2][4][2], const pg8::Unit& u, int wr, int wc, int fr, int fq, LAS unsigned char* lds, int wid, int lane) const {
        LAS float* S = (LAS float*)lds;
        const int tid = wid * 64 + lane;
        pg8::f32x4 sbv[2][2];
#pragma unroll
        for (int bj = 0; bj < 2; ++bj)
#pragma unroll
            for (int n = 0; n < 2; ++n) sbv[bj][n] = *(const GAS pg8::f32x4*)(sb + u.pn * 256 + bj * 128 + 32 * wc + 16 * n + 4 * fq);
#pragma unroll
        for (int ai = 0; ai < 2; ++ai) {
#pragma unroll
            for (int mm = 0; mm < 4; ++mm) { const int rl = 64 * wr + 16 * mm + fr; const float sr = sa[u.pm * 256 + 128 * ai + rl];
#pragma unroll
                for (int bj = 0; bj < 2; ++bj)
#pragma unroll
                    for (int n = 0; n < 2; ++n) { const pg8::i32x4 a = acc[ai][bj][mm][n];
                        *(LAS pg8::f32x4*)(S + (2 * rl + bj) * TK_ROWF + 32 * wc + 16 * n + 4 * fq) = (pg8::f32x4){(float)a[0], (float)a[1], (float)a[2], (float)a[3]} * sbv[bj][n] * sr; } }
            __syncthreads();
            topk_core(lds, ((size_t)u.pm * 256 + 128 * ai) * PH + u.pn, PH, experts, gates, tid);
        }
    }
};
struct EpiTopK {
    static constexpr bool PERM = false, AFTER_DRAIN = true;
    int* experts; float* gates;
    __device__ __forceinline__ void fused(pg8::f32x4 (&acc)[2][2][4][2], const pg8::Unit& u, int wr, int wc, int fr, int fq, LAS unsigned char* lds, int wid, int lane) const {
        LAS float* S = (LAS float*)lds;
        const int tid = wid * 64 + lane;
#pragma unroll
        for (int ai = 0; ai < 2; ++ai) {
#pragma unroll
            for (int bj = 0; bj < 2; ++bj)
#pragma unroll
                for (int mm = 0; mm < 4; ++mm)
#pragma unroll
                    for (int n = 0; n < 2; ++n) { const int rl = 64 * wr + 16 * mm + fr; *(LAS pg8::f32x4*)(S + (2 * rl + bj) * TK_ROWF + 32 * wc + 16 * n + 4 * fq) = acc[ai][bj][mm][n]; }
            __syncthreads();
            topk_core(lds, ((size_t)u.pm * 256 + 128 * ai) * PH + u.pn, PH, experts, gates, tid);
        }
    }
};

__device__ __forceinline__ float gelu_erf(float v) { return 0.5f * v * (1.0f + erff(v * 0.70710678118654752f)); }
typedef __bf16 bf16x2_t __attribute__((ext_vector_type(2)));
typedef float f32x2_t __attribute__((ext_vector_type(2)));
__device__ __forceinline__ float dot2bf(bf16x2_t a, unsigned b, float acc) { return __builtin_amdgcn_fdot2_f32_bf16(a, __builtin_bit_cast(bf16x2_t, b), acc, false); }
__device__ __forceinline__ float dot4f8(unsigned w8, unsigned x01, unsigned x23, float acc) {
    acc = dot2bf(__builtin_amdgcn_cvt_scalef32_pk_bf16_fp8(w8, 1.0f, false), x01, acc);
    return dot2bf(__builtin_amdgcn_cvt_scalef32_pk_bf16_fp8(w8, 1.0f, true), x23, acc);
}
__device__ __forceinline__ void axpy4f8(float* y, unsigned w8, float w) {
    const f32x2_t lo = __builtin_amdgcn_cvt_pk_f32_fp8(w8, false), hi = __builtin_amdgcn_cvt_pk_f32_fp8(w8, true);
    y[0] += w * lo.x; y[1] += w * lo.y; y[2] += w * hi.x; y[3] += w * hi.y;
}
__device__ __forceinline__ void axpy4f8v(f32x2_t* y2, unsigned w8, float w) {
    const f32x2_t lo = __builtin_amdgcn_cvt_pk_f32_fp8(w8, false), hi = __builtin_amdgcn_cvt_pk_f32_fp8(w8, true);
    const f32x2_t ww = {w, w};
    y2[0] = __builtin_elementwise_fma(lo, ww, y2[0]); y2[1] = __builtin_elementwise_fma(hi, ww, y2[1]);
}
__device__ __forceinline__ void row_to_fp8(const float* src, unsigned char* dst, float* inv, int lane) {
    f32x4 v[2][4]; float mx = 0.f;
#pragma unroll
    for (int j = 0; j < 2; ++j)
#pragma unroll
        for (int q = 0; q < 4; ++q) { v[j][q] = *((const GAS f32x4*)src + 4 * (lane + 64 * j) + q);
            mx = fmaxf(mx, fmaxf(fmaxf(fabsf(v[j][q].x), fabsf(v[j][q].y)), fmaxf(fabsf(v[j][q].z), fabsf(v[j][q].w)))); }
#pragma unroll
    for (int o = 1; o < 64; o <<= 1) mx = fmaxf(mx, __shfl_xor(mx, o));
    const float sc = mx > 0.f ? 384.0f / mx : 1.0f;
#pragma unroll
    for (int j = 0; j < 2; ++j) { v4u o;
        int w;
        w = 0; w = __builtin_amdgcn_cvt_pk_fp8_f32(v[j][0].x * sc, v[j][0].y * sc, w, false); w = __builtin_amdgcn_cvt_pk_fp8_f32(v[j][0].z * sc, v[j][0].w * sc, w, true); o.x = (unsigned)w;
        w = 0; w = __builtin_amdgcn_cvt_pk_fp8_f32(v[j][1].x * sc, v[j][1].y * sc, w, false); w = __builtin_amdgcn_cvt_pk_fp8_f32(v[j][1].z * sc, v[j][1].w * sc, w, true); o.y = (unsigned)w;
        w = 0; w = __builtin_amdgcn_cvt_pk_fp8_f32(v[j][2].x * sc, v[j][2].y * sc, w, false); w = __builtin_amdgcn_cvt_pk_fp8_f32(v[j][2].z * sc, v[j][2].w * sc, w, true); o.z = (unsigned)w;
        w = 0; w = __builtin_amdgcn_cvt_pk_fp8_f32(v[j][3].x * sc, v[j][3].y * sc, w, false); w = __builtin_amdgcn_cvt_pk_fp8_f32(v[j][3].z * sc, v[j][3].w * sc, w, true); o.w = (unsigned)w;
        { const int ch = lane + 64 * j; *((GAS v4u*)(dst + (size_t)(ch >> 4) * SLICE_BYTES) + (ch & 15)) = o; } }
    if (lane == 0) *inv = mx > 0.f ? mx * (1.0f / 384.0f) : 1.0f;
}
__device__ __forceinline__ void row_to_i8(const float* src, unsigned char* dst, float* inv, int lane) {
    f32x4 v[2][4]; float mx = 0.f;
#pragma unroll
    for (int j = 0; j < 2; ++j)
#pragma unroll
        for (int q = 0; q < 4; ++q) { v[j][q] = *((const GAS f32x4*)src + 4 * (lane + 64 * j) + q);
            mx = fmaxf(mx, fmaxf(fmaxf(fabsf(v[j][q].x), fabsf(v[j][q].y)), fmaxf(fabsf(v[j][q].z), fabsf(v[j][q].w)))); }
#pragma unroll
    for (int o = 1; o < 64; o <<= 1) mx = fmaxf(mx, __shfl_xor(mx, o));
    const float sc = mx > 0.f ? 127.0f / mx : 1.0f;
#pragma unroll
    for (int j = 0; j < 2; ++j) { v4u o; o.x = pack_i8(v[j][0] * sc); o.y = pack_i8(v[j][1] * sc); o.z = pack_i8(v[j][2] * sc); o.w = pack_i8(v[j][3] * sc);
        { const int ch = lane + 64 * j; *((GAS v4u*)(dst + (size_t)(ch >> 4) * SLICE_BYTES) + (ch & 15)) = o; } }
    if (lane == 0) *inv = mx > 0.f ? mx * (1.0f / 127.0f) : 1.0f;
}
__device__ __forceinline__ float row16_allsum(float a) {
    a += __builtin_bit_cast(float, __builtin_amdgcn_update_dpp(0, __builtin_bit_cast(int, a), 0x128, 0xf, 0xf, false));
    a += __builtin_bit_cast(float, __builtin_amdgcn_update_dpp(0, __builtin_bit_cast(int, a), 0x124, 0xf, 0xf, false));
    a += __builtin_bit_cast(float, __builtin_amdgcn_update_dpp(0, __builtin_bit_cast(int, a), 0x122, 0xf, 0xf, false));
    a += __builtin_bit_cast(float, __builtin_amdgcn_update_dpp(0, __builtin_bit_cast(int, a), 0x121, 0xf, 0xf, false));
    return a;
}
__device__ __forceinline__ int q_pull(unsigned* q, int lane) { int v = 0; if (lane == 0) v = (int)__hip_atomic_fetch_add(q, 1u, __ATOMIC_RELAXED, __HIP_MEMORY_SCOPE_AGENT); return __builtin_amdgcn_readfirstlane(v); }
constexpr int PEER_TG = 8;
constexpr int PEER_N8 = 640, PEER_N4 = 512, PEER_N2 = 512, PEER_NTASK = PEER_N8 + PEER_N4 + PEER_N2;
__device__ __forceinline__ void peer_task_tokens(int idx, int& t0, int& n) {
    if (idx < PEER_N8) { t0 = 8 * idx; n = 8; } else if (idx < PEER_N8 + PEER_N4) { t0 = 8 * PEER_N8 + 4 * (idx - PEER_N8); n = 4; } else { t0 = 8 * PEER_N8 + 4 * PEER_N4 + 2 * (idx - PEER_N8 - PEER_N4); n = 2; }
}
__device__ __forceinline__ int row16_allsum_i(int a) {
    a += __builtin_amdgcn_update_dpp(0, a, 0x128, 0xf, 0xf, false);
    a += __builtin_amdgcn_update_dpp(0, a, 0x124, 0xf, 0xf, false);
    a += __builtin_amdgcn_update_dpp(0, a, 0x122, 0xf, 0xf, false);
    a += __builtin_amdgcn_update_dpp(0, a, 0x121, 0xf, 0xf, false);
    return a;
}
#define PA_LOAD(R, IDV, HALF) do { _Pragma("unroll") for (int i_ = 0; i_ < 8; ++i_) { const unsigned e_ = (unsigned)__shfl(IDV, 4 * (i_ + 8 * (HALF)) + g); \
        R[i_] = *(const GAS v4u*)(ub + (e_ * 256u + offc)); } } while (0)
#define PA_COMP(R, HALF) do { _Pragma("unroll") for (int i_ = 0; i_ < 8; ++i_) { int a_ = __builtin_amdgcn_sdot4((int)R[i_].x, (int)xc.x, 0, false); a_ = __builtin_amdgcn_sdot4((int)R[i_].y, (int)xc.y, a_, false); \
        a_ = __builtin_amdgcn_sdot4((int)R[i_].z, (int)xc.z, a_, false); a_ = __builtin_amdgcn_sdot4((int)R[i_].w, (int)xc.w, a_, false); r16[8 * (HALF) + i_] = row16_allsum_i(a_); } } while (0)
__device__ __forceinline__ void peer_a_task(int t0, int ntok, int s, const signed char* xq, const int* experts, const unsigned char* u8s, int* pa, int lane_) {
    int lane = lane_; asm volatile("" : "+v"(lane));
    const int g = lane >> 4, c = lane & 15;
    const GAS unsigned char* ub = (const GAS unsigned char*)(u8s + (size_t)s * SLICE_BYTES);
    const unsigned offc = 16u * (unsigned)c;
    int idc0 = experts[(size_t)t0 * 128 + lane], idc1 = experts[(size_t)t0 * 128 + lane + 64];
    v4u xc = *(const GAS v4u*)(xq + (size_t)t0 * D + 256 * s + 16 * c);
    v4u RA[8], RB[8];
    PA_LOAD(RA, idc0, 0);
#pragma unroll 1
    for (int tt = 0; tt < ntok; ++tt) {
        const int t = t0 + tt, tn = tt + 1 < ntok ? t + 1 : t;
        const int idn0 = experts[(size_t)tn * 128 + lane], idn1 = experts[(size_t)tn * 128 + lane + 64];
        const v4u xn = *(const GAS v4u*)(xq + (size_t)tn * D + 256 * s + 16 * c);
#pragma unroll 1
        for (int hb = 0; hb < 2; ++hb) {
            const int idv = hb ? idc1 : idc0, idx = hb ? idn0 : idc1;
            int r16[16];
            PA_LOAD(RB, idv, 1); PA_COMP(RA, 0);
            asm volatile("" ::: "memory");
            PA_LOAD(RA, idx, 0); PA_COMP(RB, 1);
            if (c == 15) { typedef int i32x4 __attribute__((ext_vector_type(4))); GAS i32x4* dst = (GAS i32x4*)(pa + ((size_t)t * 8 + s) * 128 + g * 32 + 16 * hb);
#pragma unroll
                for (int q = 0; q < 4; ++q) dst[q] = (i32x4){r16[4 * q], r16[4 * q + 1], r16[4 * q + 2], r16[4 * q + 3]}; }
        }
        idc0 = idn0; idc1 = idn1; xc = xn;
    }
}
constexpr int PA_CH = 56, PA_NCH = (M + PA_CH - 1) / PA_CH, PA_NCH4 = (PA_NCH + 3) & ~3;
constexpr int PA_XT = 131072, PA_XTB = PA_CH * 256, PA_LOFF = PA_XT + 2 * PA_XTB;
static_assert(PA_LOFF + PA_NCH4 * 8 <= LDSCTL_OFF, "LDS map");
__device__ __forceinline__ void peer_shard_load(int s, int r, const unsigned char* u8s, LAS unsigned char* lds, int tid_) {
    int tid = tid_; asm volatile("" : "+v"(tid));
    const GAS unsigned char* src = (const GAS unsigned char*)(u8s + (size_t)s * SLICE_BYTES);
#pragma unroll 1
    for (int h = 0; h < 2; ++h) { v4u t[8];
#pragma unroll
        for (int j = 0; j < 8; ++j) { const int piece = tid + NTHREADS * (8 * h + j), el = piece >> 4, i = el >> 2, jj = ((r - i) & 31) + 32 * (el & 3);
            t[j] = *(const GAS v4u*)(src + ((size_t)(i * 128 + jj) * 256 + (size_t)((piece & 15) << 4))); }
#pragma unroll
        for (int j = 0; j < 8; ++j) *(LAS v4u*)(lds + 16 * (tid + NTHREADS * (8 * h + j))) = t[j]; }
}
__device__ __forceinline__ void peer_bucket(int q, const int* experts, unsigned* seg, int* soff, LAS unsigned char* lds, int tid_) {
    int tid = tid_; asm volatile("" : "+v"(tid));
    LAS int* cnt = (LAS int*)(lds + PA_XT);
    if (tid < 128) cnt[tid] = 0;
    __syncthreads();
    const int ntok = (M - q * PA_CH) < PA_CH ? (M - q * PA_CH) : PA_CH, nent = ntok * 128;
    const GAS int* ex = (const GAS int*)(experts + (size_t)q * PA_CH * 128);
    int ev[14];
#pragma unroll
    for (int j = 0; j < 14; ++j) { const int i = tid + NTHREADS * j; ev[j] = i < nent ? ex[i] : -1; }
#pragma unroll
    for (int j = 0; j < 14; ++j) if (ev[j] >= 0) __hip_atomic_fetch_add(cnt + (((ev[j] >> 7) + ev[j]) & 31), 1, __ATOMIC_RELAXED, __HIP_MEMORY_SCOPE_WORKGROUP);
    __syncthreads();
    if (tid < 64) { const int c = tid < 32 ? cnt[tid] : 0; int inc = c;
#pragma unroll
        for (int o = 1; o < 32; o <<= 1) { const int v = __shfl_up(inc, o); if (tid >= o) inc += v; }
        if (tid < 32) { cnt[32 + tid] = inc - c; soff[q * 33 + tid] = inc - c; if (tid == 31) soff[q * 33 + 32] = inc; } }
    __syncthreads();
    GAS unsigned* sg = (GAS unsigned*)(seg + (size_t)q * (PA_CH * 128));
#pragma unroll
    for (int j = 0; j < 14; ++j) if (ev[j] >= 0) { const int i = tid + NTHREADS * j, e = ev[j], r = ((e >> 7) + e) & 31;
        const int p = cnt[32 + r] + __hip_atomic_fetch_add(cnt + 96 + r, 1, __ATOMIC_RELAXED, __HIP_MEMORY_SCOPE_WORKGROUP);
        sg[p] = ((unsigned)(i >> 7) << 16) | ((unsigned)(i & 127) << 9) | (unsigned)(((e >> 7) << 2) | ((e >> 5) & 3)); }
    __syncthreads();
}
#define PAL_ISSUE(U, X, ENT, XT) do { const unsigned ua_ = ((ENT) & 511u) * 256u + l16, xa_ = (XT) + ((ENT) >> 16) * 256u + l16; \
        _Pragma("unroll") for (int j_ = 0; j_ < 8; ++j_) { U[j_] = *(const LAS v4u*)(ua_ ^ (unsigned)(j_ << 4)); X[j_] = *(const LAS v4u*)(xa_ ^ (unsigned)(j_ << 4)); } } while (0)
#define PAL_DOTS(U, X, ACC) do { int a0_ = 0, a1_ = 0; \
        _Pragma("unroll") for (int j_ = 0; j_ < 8; j_ += 2) { \
            a0_ = __builtin_amdgcn_sdot4((int)U[j_].x, (int)X[j_].x, a0_, false); a1_ = __builtin_amdgcn_sdot4((int)U[j_ + 1].x, (int)X[j_ + 1].x, a1_, false); \
            a0_ = __builtin_amdgcn_sdot4((int)U[j_].y, (int)X[j_].y, a0_, false); a1_ = __builtin_amdgcn_sdot4((int)U[j_ + 1].y, (int)X[j_ + 1].y, a1_, false); \
            a0_ = __builtin_amdgcn_sdot4((int)U[j_].z, (int)X[j_].z, a0_, false); a1_ = __builtin_amdgcn_sdot4((int)U[j_ + 1].z, (int)X[j_ + 1].z, a1_, false); \
            a0_ = __builtin_amdgcn_sdot4((int)U[j_].w, (int)X[j_].w, a0_, false); a1_ = __builtin_amdgcn_sdot4((int)U[j_ + 1].w, (int)X[j_ + 1].w, a1_, false); } \
        a0_ += a1_; ACC = a0_ + __builtin_amdgcn_update_dpp(0, a0_, 0x128, 0xf, 0xf, false); } while (0)
#define PAL_LOAD(Q, XA, XB, EN) do { int q_ = (Q); q_ = q_ < PA_NCH4 ? q_ : PA_NCH4 - 1; const GAS unsigned char* xq_ = xb + (size_t)q_ * (PA_CH * D); \
        XA = *(const GAS v4u*)(xq_ + voff0); XB = *(const GAS v4u*)(xq_ + voff1); EN = sg[(unsigned)(loff[2 * q_] + pidx)]; } while (0)
#define PAL_WRITE(Q, XA, XB) do { const int b_ = PA_XT + ((Q) & 1) * PA_XTB + 16 * tid; *(LAS v4u*)(lds + b_) = XA; if (tid < (PA_CH - 32) * 16) *(LAS v4u*)(lds + b_ + 16 * NTHREADS) = XB; } while (0)
#define PAL_STORE(QQ, E, A) do { const unsigned k_ = ((E) >> 9) & 127u; pa[((size_t)((QQ) * PA_CH + (int)((E) >> 16)) * 8 + s) * 128 + (k_ & 3u) * 32u + (k_ >> 2)] = (A); } while (0)
#define CV_NONE do { } while (0)
#define CV_ISSUE do { if (late && cv_it < 16) { const GAS f32x4* src_ = (const GAS f32x4*)(pv + (size_t)(cv_e0 + cv_it) * D); \
        _Pragma("unroll") for (int j_ = 0; j_ < 2; ++j_) _Pragma("unroll") for (int q_ = 0; q_ < 4; ++q_) cvr[j_][q_] = src_[4 * (lane + 64 * j_) + q_]; } } while (0)
#define CV_FINISH do { if (late && cv_it < 16) { float mx_ = 0.f; \
        _Pragma("unroll") for (int j_ = 0; j_ < 2; ++j_) _Pragma("unroll") for (int q_ = 0; q_ < 4; ++q_) mx_ = fmaxf(mx_, fmaxf(fmaxf(fabsf(cvr[j_][q_].x), fabsf(cvr[j_][q_].y)), fmaxf(fabsf(cvr[j_][q_].z), fabsf(cvr[j_][q_].w)))); \
        _Pragma("unroll") for (int o_ = 1; o_ < 64; o_ <<= 1) mx_ = fmaxf(mx_, __shfl_xor(mx_, o_)); \
        const float sc_ = mx_ > 0.f ? 384.0f / mx_ : 1.0f; const int e_ = cv_e0 + cv_it; \
        _Pragma("unroll") for (int j_ = 0; j_ < 2; ++j_) { v4u o_; int w_; \
            w_ = 0; w_ = __builtin_amdgcn_cvt_pk_fp8_f32(cvr[j_][0].x * sc_, cvr[j_][0].y * sc_, w_, false); w_ = __builtin_amdgcn_cvt_pk_fp8_f32(cvr[j_][0].z * sc_, cvr[j_][0].w * sc_, w_, true); o_.x = (unsigned)w_; \
            w_ = 0; w_ = __builtin_amdgcn_cvt_pk_fp8_f32(cvr[j_][1].x * sc_, cvr[j_][1].y * sc_, w_, false); w_ = __builtin_amdgcn_cvt_pk_fp8_f32(cvr[j_][1].z * sc_, cvr[j_][1].w * sc_, w_, true); o_.y = (unsigned)w_; \
            w_ = 0; w_ = __builtin_amdgcn_cvt_pk_fp8_f32(cvr[j_][2].x * sc_, cvr[j_][2].y * sc_, w_, false); w_ = __builtin_amdgcn_cvt_pk_fp8_f32(cvr[j_][2].z * sc_, cvr[j_][2].w * sc_, w_, true); o_.z = (unsigned)w_; \
            w_ = 0; w_ = __builtin_amdgcn_cvt_pk_fp8_f32(cvr[j_][3].x * sc_, cvr[j_][3].y * sc_, w_, false); w_ = __builtin_amdgcn_cvt_pk_fp8_f32(cvr[j_][3].z * sc_, cvr[j_][3].w * sc_, w_, true); o_.w = (unsigned)w_; \
            const int ch_ = lane + 64 * j_; *((GAS v4u*)(v8 + (size_t)e_ * 256 + (size_t)(ch_ >> 4) * SLICE_BYTES) + (ch_ & 15)) = o_; } \
        if (lane == 0) sv[e_] = mx_ > 0.f ? mx_ * (1.0f / 384.0f) : 1.0f; } } while (0)
#define PAL_STEP(Q, WXA, WXB, CXA, CXB, CEN, HOOK) do { const int q_s = (Q); \
        __syncthreads();                       \
        const unsigned e0_ = CEN; const int nb_s = loff[2 * q_s], n_s = loff[2 * q_s + 1]; const unsigned xt_s = (unsigned)(PA_XT + (q_s & 1) * PA_XTB); \
        PAL_LOAD(q_s + 4, CXA, CXB, CEN);        \
        if (late) { if (pidx < n_prev) { int a_; PAL_DOTS(U, X, a_); if (!(tid & 8)) PAL_STORE(q_s - 1, e_prev, a_); } } \
        _Pragma("unroll 1") for (int i_ = pidx + NTHREADS / 2; i_ < n_s; i_ += NTHREADS / 2) { const unsigned e1_ = sg[nb_s + i_]; PAL_ISSUE(U, X, e1_, xt_s); int a_; PAL_DOTS(U, X, a_); if (!(tid & 8)) PAL_STORE(q_s, e1_, a_); }        \
        PAL_WRITE(q_s + 1, WXA, WXB); \
        if (pidx < n_s) PAL_ISSUE(U, X, e0_, xt_s); \
        __builtin_amdgcn_sched_barrier(0); \
        if (!late) { if (pidx < n_s) { int a_; PAL_DOTS(U, X, a_); if (!(tid & 8)) PAL_STORE(q_s, e0_, a_); } } \
        HOOK; \
        e_prev = e0_; n_prev = n_s; \
    } while (0)
__device__ __forceinline__ void peer_a_lds(int s, const signed char* xq, const unsigned* seg, const int* soff, int r, int* pa, LAS unsigned char* lds, int tid_, const float* pv, unsigned char* v8, float* sv, int cv_e0) {
    int tid = tid_; asm volatile("" : "+v"(tid));
    const unsigned l16 = (unsigned)(tid & 15) << 4;
    const int pidx = (tid >> 4) * 8 + (tid & 7);
    const bool late = __builtin_amdgcn_readfirstlane(tid >> 8) != 0;
    const int lane = tid & 63; cv_e0 += (__builtin_amdgcn_readfirstlane(tid >> 6) & 3) * 16; f32x4 cvr[2][4]; int cv_it = 0;
#pragma unroll
    for (int j = 0; j < 2; ++j)
#pragma unroll
        for (int q = 0; q < 4; ++q) cvr[j][q] = (f32x4){0.f, 0.f, 0.f, 0.f};
    LAS int* loff = (LAS int*)(lds + PA_LOFF);
    if (tid < PA_NCH4) { int b = 0, e = 0; if (tid < PA_NCH) { b = soff[tid * 33 + r]; e = soff[tid * 33 + r + 1]; } loff[2 * tid] = tid * (PA_CH * 128) + b; loff[2 * tid + 1] = e - b; }
    __syncthreads();
    const GAS unsigned char* xb = (const GAS unsigned char*)(xq + 256 * s);
    const GAS unsigned* sg = (const GAS unsigned*)seg;
    const unsigned voff0 = (unsigned)(tid >> 4) * (unsigned)D + l16, voff1 = voff0 + ((tid >> 4) < PA_CH - 32 ? 32u * (unsigned)D : 0u);
    v4u x0a, x0b, x1a, x1b, x2a, x2b, x3a, x3b; unsigned en0, en1, en2, en3;
    v4u U[8], X[8]; unsigned e_prev = 0u; int n_prev = 0;
#pragma unroll
    for (int j = 0; j < 8; ++j) { U[j] = X[j] = (v4u){0u, 0u, 0u, 0u}; }
    PAL_LOAD(0, x0a, x0b, en0); PAL_LOAD(1, x1a, x1b, en1); PAL_LOAD(2, x2a, x2b, en2); PAL_LOAD(3, x3a, x3b, en3);
    PAL_WRITE(0, x0a, x0b);
#pragma unroll 1
    for (int q0 = 0; q0 < PA_NCH4; q0 += 4) {
        PAL_STEP(q0, x1a, x1b, x0a, x0b, en0, CV_ISSUE);
        PAL_STEP(q0 + 1, x2a, x2b, x1a, x1b, en1, CV_NONE);
        PAL_STEP(q0 + 2, x3a, x3b, x2a, x2b, en2, CV_NONE);
        PAL_STEP(q0 + 3, x0a, x0b, x3a, x3b, en3, CV_FINISH);
        ++cv_it;
    }
    __syncthreads();
}
__device__ __forceinline__ void peer_w_elem(size_t i, const int* experts, const float* gates, const float* su, const float* sv, const float* sx, const int* pa, float* wb) {
    const size_t t = i >> 7; const int k = (int)(i & 127), pos = (k & 3) * 32 + (k >> 2);
    const int e = experts[i];
    int a = 0;
#pragma unroll
    for (int s2 = 0; s2 < 8; ++s2) a += pa[(t * 8 + s2) * 128 + pos];
    wb[i] = gates[i] * gelu_erf((float)a * (su[e] * sx[t])) * sv[e];
}
#define PB_LOAD(R, IDV, HALF) do { _Pragma("unroll") for (int i_ = 0; i_ < 8; ++i_) { const unsigned e_ = (unsigned)__shfl(IDV, 4 * (i_ + 8 * (HALF)) + g); \
        R[i_] = *(const GAS v4u*)(vb + (e_ * 256u + offc)); } } while (0)
#define PB_COMP(R, WV, HALF) do { _Pragma("unroll") for (int i_ = 0; i_ < 8; ++i_) { const float wk_ = __shfl(WV, 4 * (i_ + 8 * (HALF)) + g); \
        axpy4f8v(&ya2[0], R[i_].x, wk_); axpy4f8v(&ya2[2], R[i_].y, wk_); axpy4f8v(&ya2[4], R[i_].z, wk_); axpy4f8v(&ya2[6], R[i_].w, wk_); } } while (0)
__device__ __forceinline__ void peer_b_task(int t0, int ntok, int s, const bf16* h1, const int* experts, const float* wb, const unsigned char* v8s, bf16* out, float* st, int lane_) {
    int lane = lane_; asm volatile("" : "+v"(lane));
    const int g = lane >> 4, c = lane & 15;
    const GAS unsigned char* vb = (const GAS unsigned char*)(v8s + (size_t)s * SLICE_BYTES);
    const unsigned offc = 16u * (unsigned)c;
    int idc0 = experts[(size_t)t0 * 128 + lane], idc1 = experts[(size_t)t0 * 128 + lane + 64];
    float wc0 = wb[(size_t)t0 * 128 + lane], wc1 = wb[(size_t)t0 * 128 + lane + 64];
    v4u RA[8], RB[8];
    PB_LOAD(RA, idc0, 0);
#pragma unroll 1
    for (int tt = 0; tt < ntok; ++tt) {
        const int t = t0 + tt, tn = tt + 1 < ntok ? t + 1 : t;
        const int idn0 = experts[(size_t)tn * 128 + lane], idn1 = experts[(size_t)tn * 128 + lane + 64];
        const float wn0 = wb[(size_t)tn * 128 + lane], wn1 = wb[(size_t)tn * 128 + lane + 64];
        f32x2_t ya2[8];
#pragma unroll
        for (int e = 0; e < 8; ++e) ya2[e] = (f32x2_t){0.f, 0.f};
#pragma unroll 1
        for (int hb = 0; hb < 2; ++hb) {
            const int idv = hb ? idc1 : idc0, idx = hb ? idn0 : idc1; const float wv = hb ? wc1 : wc0;
            PB_LOAD(RB, idv, 1); PB_COMP(RA, wv, 0);
            asm volatile("" ::: "memory");
            PB_LOAD(RA, idx, 0); PB_COMP(RB, wv, 1);
        }
        float ya[16];
#pragma unroll
        for (int e = 0; e < 8; ++e) { ya[2 * e] = ya2[e].x; ya[2 * e + 1] = ya2[e].y; }
#pragma unroll
        for (int e = 0; e < 16; ++e) { ya[e] += __shfl_xor(ya[e], 16); ya[e] += __shfl_xor(ya[e], 32); }
        const GAS v4u* hp = (const GAS v4u*)(h1 + (size_t)t * D + 256 * s + 16 * c);
        const v4u h0 = hp[0], h1v = hp[1];
        float hx[16];
        hx[0] = pg8::bf_lo(h0.x); hx[1] = pg8::bf_hi(h0.x); hx[2] = pg8::bf_lo(h0.y); hx[3] = pg8::bf_hi(h0.y); hx[4] = pg8::bf_lo(h0.z); hx[5] = pg8::bf_hi(h0.z); hx[6] = pg8::bf_lo(h0.w); hx[7] = pg8::bf_hi(h0.w);
        hx[8] = pg8::bf_lo(h1v.x); hx[9] = pg8::bf_hi(h1v.x); hx[10] = pg8::bf_lo(h1v.y); hx[11] = pg8::bf_hi(h1v.y); hx[12] = pg8::bf_lo(h1v.z); hx[13] = pg8::bf_hi(h1v.z); hx[14] = pg8::bf_lo(h1v.w); hx[15] = pg8::bf_hi(h1v.w);
        float sm = 0.f, sq = 0.f;
#pragma unroll
        for (int e = 0; e < 16; ++e) { ya[e] = hx[e] * ALPHA + ya[e]; sm += ya[e]; sq += ya[e] * ya[e]; }
        sm = row16_allsum(sm); sq = row16_allsum(sq);
        if (g == 0) { GAS v4u* op = (GAS v4u*)(out + (size_t)t * D + 256 * s + 16 * c);
            v4u o0, o1; o0.x = pk2(ya[0], ya[1]); o0.y = pk2(ya[2], ya[3]); o0.z = pk2(ya[4], ya[5]); o0.w = pk2(ya[6], ya[7]);
            o1.x = pk2(ya[8], ya[9]); o1.y = pk2(ya[10], ya[11]); o1.z = pk2(ya[12], ya[13]); o1.w = pk2(ya[14], ya[15]);
            op[0] = o0; op[1] = o1;
            if (c == 0) { st[((size_t)t * 8 + s) * 2] = sm; st[((size_t)t * 8 + s) * 2 + 1] = sq; } }
        idc0 = idn0; idc1 = idn1; wc0 = wn0; wc1 = wn1;
    }
}
__device__ __forceinline__ void peer_w_pack(int bx, const int* experts, const float* gates, const float* su, const float* sv, const float* sx, const int* pa, unsigned* pw, LAS unsigned char* lds, int tid_) {
    int tid = tid_; asm volatile("" : "+v"(tid));
    LAS unsigned* T = (LAS unsigned*)(lds + PA_XT);
    const size_t i0 = (size_t)bx * 32 * 128;
#pragma unroll 1
    for (int j = 0; j < 8; ++j) { const int il = tid + NTHREADS * j; const size_t i = i0 + il; const size_t t = i >> 7; const int k = il & 127, pos = (k & 3) * 32 + (k >> 2);
        const int e = experts[i]; int a = 0;
#pragma unroll
        for (int s2 = 0; s2 < 8; ++s2) a += pa[(t * 8 + s2) * 128 + pos];
        const float w = gates[i] * gelu_erf((float)a * (su[e] * sx[t])) * sv[e];
        T[(il >> 7) * 129 + k] = (f2bf(w) << 16) | (unsigned)e; }
    __syncthreads();
    GAS unsigned* dst = (GAS unsigned*)(pw + (size_t)(bx >> 1) * (128 * 64) + 32 * (bx & 1));
#pragma unroll
    for (int j = 0; j < 8; ++j) { const int il = tid + NTHREADS * j, k = il >> 5, tl = il & 31; dst[k * 64 + tl] = T[tl * 129 + k]; }
    __syncthreads();
}
__device__ __forceinline__ void peer_vshard_load(int x, int i, const unsigned char* v8s, LAS unsigned char* lds, int tid_) {
    int tid = tid_; asm volatile("" : "+v"(tid));
    const GAS unsigned char* src = (const GAS unsigned char*)(v8s + (size_t)x * SLICE_BYTES + 8 * i);
#pragma unroll 1
    for (int h = 0; h < 4; ++h) { v2u t[8];
#pragma unroll
        for (int j = 0; j < 8; ++j) t[j] = *(const GAS v2u*)(src + (size_t)(tid + NTHREADS * (8 * h + j)) * 256);
#pragma unroll
        for (int j = 0; j < 8; ++j) *(LAS v2u*)(lds + 8 * (tid + NTHREADS * (8 * h + j))) = t[j]; }
}
#define PB2_LOADW(W, KB) do { _Pragma("unroll") for (int j_ = 0; j_ < 16; ++j_) W[j_] = pwT[(16 * (KB) + j_) * 64]; } while (0)
#define PB2_GROUP(W) do { v2u V_[16]; \
        _Pragma("unroll") for (int j_ = 0; j_ < 16; ++j_) V_[j_] = *(const LAS v2u*)((W[j_] & 0xFFFFu) << 3);        \
        __builtin_amdgcn_sched_barrier(0); \
        _Pragma("unroll") for (int j_ = 0; j_ < 16; ++j_) { const float w_ = __builtin_bit_cast(float, W[j_] & 0xFFFF0000u); axpy4f8v(&acc[0], V_[j_].x, w_); axpy4f8v(&acc[2], V_[j_].y, w_); } } while (0)
__device__ __forceinline__ void peer_b2(int x, int i, const bf16* h1, const unsigned* pw, bf16* out, int tid_) {
    int tid = tid_; asm volatile("" : "+v"(tid));
    const int lane = tid & 63, wave = __builtin_amdgcn_readfirstlane(tid >> 6);
    const int colb = 256 * x + 8 * i;
#pragma unroll 1
    for (int T = wave; T < M / 64; T += NWAVES) {
        const GAS unsigned* pwT = (const GAS unsigned*)(pw + (size_t)T * (128 * 64) + lane);
        f32x2_t acc[4];
#pragma unroll
        for (int c = 0; c < 4; ++c) acc[c] = (f32x2_t){0.f, 0.f};
        unsigned W0[16], W1[16];
        PB2_LOADW(W0, 0);
#pragma unroll 1
        for (int kb = 0; kb < 8; kb += 2) {
            PB2_LOADW(W1, kb + 1);
            PB2_GROUP(W0);
            if (kb + 2 < 8) PB2_LOADW(W0, kb + 2);
            PB2_GROUP(W1);
        }
        const size_t ro = (size_t)(T * 64 + lane) * D + colb;
        const v4u h = *(const GAS v4u*)(h1 + ro);
        v4u o; o.x = pk2(pg8::bf_lo(h.x) * ALPHA + acc[0].x, pg8::bf_hi(h.x) * ALPHA + acc[0].y); o.y = pk2(pg8::bf_lo(h.y) * ALPHA + acc[1].x, pg8::bf_hi(h.y) * ALPHA + acc[1].y);
        o.z = pk2(pg8::bf_lo(h.z) * ALPHA + acc[2].x, pg8::bf_hi(h.z) * ALPHA + acc[2].y); o.w = pk2(pg8::bf_lo(h.w) * ALPHA + acc[3].x, pg8::bf_hi(h.w) * ALPHA + acc[3].y);
        *(GAS v4u*)(out + ro) = o;
    }
}
__device__ __forceinline__ void peer_c2_row(int t, const bf16* r2, float* out, const float* g2, const float* b2, int lane) {
    const GAS v4u* xr = (const GAS v4u*)(r2 + (size_t)t * D) + lane;
    v4u w[4]; float sm = 0.f;
#pragma unroll
    for (int j = 0; j < 4; ++j) { w[j] = xr[64 * j]; sm += (pg8::bf_lo(w[j].x) + pg8::bf_hi(w[j].x)) + (pg8::bf_lo(w[j].y) + pg8::bf_hi(w[j].y)) + (pg8::bf_lo(w[j].z) + pg8::bf_hi(w[j].z)) + (pg8::bf_lo(w[j].w) + pg8::bf_hi(w[j].w)); }
    const float mean = wave_sum(sm) * (1.f / D);
    float sq = 0.f;
#pragma unroll
    for (int j = 0; j < 4; ++j) { float d;
        d = pg8::bf_lo(w[j].x) - mean; sq += d * d; d = pg8::bf_hi(w[j].x) - mean; sq += d * d; d = pg8::bf_lo(w[j].y) - mean; sq += d * d; d = pg8::bf_hi(w[j].y) - mean; sq += d * d;
        d = pg8::bf_lo(w[j].z) - mean; sq += d * d; d = pg8::bf_hi(w[j].z) - mean; sq += d * d; d = pg8::bf_lo(w[j].w) - mean; sq += d * d; d = pg8::bf_hi(w[j].w) - mean; sq += d * d; }
    const float rstd = 1.f / sqrtf(wave_sum(sq) * (1.f / D) + LN_EPS);
    GAS f32x4* op = (GAS f32x4*)(out + (size_t)t * D);
#pragma unroll
    for (int j = 0; j < 4; ++j) { const int c4 = 2 * (lane + 64 * j);
        const f32x4 g0 = *((const GAS f32x4*)g2 + c4), g1 = *((const GAS f32x4*)g2 + c4 + 1), b0 = *((const GAS f32x4*)b2 + c4), b1 = *((const GAS f32x4*)b2 + c4 + 1);
        const f32x4 v0 = (f32x4){pg8::bf_lo(w[j].x), pg8::bf_hi(w[j].x), pg8::bf_lo(w[j].y), pg8::bf_hi(w[j].y)}, v1 = (f32x4){pg8::bf_lo(w[j].z), pg8::bf_hi(w[j].z), pg8::bf_lo(w[j].w), pg8::bf_hi(w[j].w)};
        op[c4] = (v0 - mean) * rstd * g0 + b0; op[c4 + 1] = (v1 - mean) * rstd * g1 + b1; }
}
__device__ __forceinline__ void peer_c_row(int t, const bf16* r2, float* out, const float* st, const float* g2, const float* b2, int lane) {
    float sm = 0.f, sq = 0.f;
#pragma unroll
    for (int s = 0; s < 8; ++s) { sm += st[((size_t)t * 8 + s) * 2]; sq += st[((size_t)t * 8 + s) * 2 + 1]; }
    const float mean = sm * (1.f / D), var = sq * (1.f / D) - mean * mean, rstd = 1.f / sqrtf(fmaxf(var, 0.f) + LN_EPS);
    const GAS v4u* xr = (const GAS v4u*)(r2 + (size_t)t * D) + lane;
    GAS f32x4* op = (GAS f32x4*)(out + (size_t)t * D);
#pragma unroll
    for (int j = 0; j < 4; ++j) { const v4u w = xr[64 * j]; const int c4 = 2 * (lane + 64 * j);
        const f32x4 g0 = *((const GAS f32x4*)g2 + c4), g1 = *((const GAS f32x4*)g2 + c4 + 1), b0 = *((const GAS f32x4*)b2 + c4), b1 = *((const GAS f32x4*)b2 + c4 + 1);
        const f32x4 v0 = (f32x4){pg8::bf_lo(w.x), pg8::bf_hi(w.x), pg8::bf_lo(w.y), pg8::bf_hi(w.y)}, v1 = (f32x4){pg8::bf_lo(w.z), pg8::bf_hi(w.z), pg8::bf_lo(w.w), pg8::bf_hi(w.w)};
        op[c4] = (v0 - mean) * rstd * g0 + b0; op[c4 + 1] = (v1 - mean) * rstd * g1 + b1; }
}

struct TwoPassOrder : pg8::StaticOrder {
    __device__ __forceinline__ bool next(int i, pg8::Unit& u) const { if (!pg8::StaticOrder::next(i >> 1, u)) return false; u.w = i & 1; return true; }
};
struct EpiGate2 {
    static constexpr bool PERM = true, AFTER_DRAIN = false;
    pg8::EpiGate<0> e0; pg8::EpiGate<1> e1;
    __device__ __forceinline__ void operator()(const pg8::f32x4 (&acc)[2][2][4][2], const pg8::Unit& u, int wr, int wc, int fr, int fq) const { if (u.w == 0) e0(acc, u, wr, wc, fr, fq); else e1(acc, u, wr, wc, fr, fq); }
};

struct EpiGate2I8 {
    static constexpr bool PERM = true, AFTER_DRAIN = false;
    pg8::EpiGateI8<0> e0; pg8::EpiGateI8<1> e1;
    __device__ __forceinline__ void operator()(const pg8::i32x4 (&acc)[2][2][4][2], const pg8::Unit& u, int wr, int wc, int fr, int fq) const { if (u.w == 0) e0(acc, u, wr, wc, fr, fq); else e1(acc, u, wr, wc, fr, fq); }
};
struct ConvOrder : pg8::StaticOrder {
    const float* pu; const float* pv; unsigned char* u8; unsigned char* v8; float* su; float* sv; int slot; mutable int calls;
    static constexpr int CONV_ROWS = 2, CONV_CALLS = 6;
    __device__ __forceinline__ void done(const pg8::Unit&) const {
        if (slot < 0) return;
        int lane = threadIdx.x & 63; asm volatile("" : "+v"(lane));
        const int wave = __builtin_amdgcn_readfirstlane(threadIdx.x >> 6);
        const int base = ((slot * NWAVES + wave) * CONV_CALLS + calls) * CONV_ROWS;
        if (calls < CONV_CALLS) {
#pragma unroll 1
            for (int j = 0; j < CONV_ROWS; ++j) { const int r = base + j; if (r < PNE) row_to_i8(pu + (size_t)r * D, u8 + (size_t)r * 256, su + r, lane); }
        }
        ++calls;
    }
};

struct Args { const float* in[16]; float* out; unsigned char* ws; int ph_lo, ph_hi; };
__global__ void __launch_bounds__(NTHREADS, 2) mk_fwd(Args args) {
    extern __shared__ __attribute__((aligned(16))) unsigned char lds_raw[];
    LAS unsigned char* lds = (LAS unsigned char*)lds_raw;
    volatile LAS unsigned* MISC = (volatile LAS unsigned*)(lds + MISC_OFF);
    const int tid0 = threadIdx.x;
    const int G = gridDim.x, bx = blockIdx.x;
    unsigned char* ws = args.ws;
    gu32* ctl = (gu32*)(ws + WS_CTL);
#define IN_(i) (args.in[i])
#define x_in IN_(0)
#define w_in IN_(1)
#define b_gate IN_(2)
#define sinks IN_(3)
#define conv_w IN_(4)
#define w_ao IN_(5)
#define w_co IN_(6)
#define w_o IN_(7)
#define ln1_g IN_(8)
#define ln1_b IN_(9)
#define w_q IN_(10)
#define sub_keys IN_(11)
#define peer_u IN_(12)
#define peer_v IN_(13)
#define ln2_g IN_(14)
#define ln2_b IN_(15)
#define WinT ((bf16*)(ws + WS_WIN))
#define WaT ((bf16*)(ws + WS_WA))
#define WcT ((bf16*)(ws + WS_WC))
#define WoT ((bf16*)(ws + WS_WO))
#define WfT ((bf16*)(ws + WS_WF))
#define XB ((bf16*)(ws + WS_XB))
#define MERGED ((bf16*)(ws + WS_MERGED))
#define Z ((bf16*)(ws + WS_Z))
#define R2B ((bf16*)(ws + WS_R2B))
#define H1B ((bf16*)(ws + WS_H1B))
#define SC ((float*)(ws + WS_SC))
#define EX ((int*)(ws + WS_EX))
#define GT ((float*)(ws + WS_GT))
#define AO ((bf16*)(ws + WS_AO))
#define CI ((bf16*)(ws + WS_CI))
#define TMP ((bf16*)(ws + WS_TMP))
#define U8 ((unsigned char*)(ws + WS_U8))
#define V8 ((unsigned char*)(ws + WS_V8))
#define SU ((float*)(ws + WS_SU))
#define SV ((float*)(ws + WS_SV))
#define PA ((int*)(ws + WS_PA))
#define ST ((float*)(ws + WS_ST))
#define WB ((float*)(ws + WS_WB))
#define XA8 ((signed char*)(ws + WS_XA8))
#define WIN8 ((signed char*)(ws + WS_WIN8))
#define SWIN ((float*)(ws + WS_SWIN))
#define SXA ((float*)(ws + WS_SXA))
#define WF8 ((signed char*)(ws + WS_WF8))
#define MG8 ((signed char*)(ws + WS_MG8))
#define WO8 ((signed char*)(ws + WS_WO8))
#define SMG ((float*)(ws + WS_SMG))
#define SWO ((float*)(ws + WS_SWO))
#define AO8 ((signed char*)(ws + WS_AO8))
#define CI8 ((signed char*)(ws + WS_CI8))
#define WA8 ((signed char*)(ws + WS_WA8))
#define WC8 ((signed char*)(ws + WS_WC8))
#define SAO ((float*)(ws + WS_S3))
#define SCI ((float*)(ws + WS_S3 + 65536))
#define SWA ((float*)(ws + WS_S3 + 131072))
#define SWC ((float*)(ws + WS_S3 + 196608))
#define SWF ((float*)(ws + WS_SWF))
#define XQ ((signed char*)(ws + WS_XQ))
#define SX ((float*)(ws + WS_SX))
#define SEG ((unsigned*)(ws + WS_SEG))
#define SOFF ((int*)(ws + WS_SOFF))
    for (int u = tid0; u < (LDS_BYTES - LDSCTL_OFF) / 4; u += NTHREADS) ((LAS unsigned*)(lds + LDSCTL_OFF))[u] = 0u;
    __syncthreads();
    XcdBarrier bar; bar.bar = (unsigned*)(ctl + CW_BAR); bar.x = 0; bar.st = nullptr;
    if (!MK_PER_PHASE) bar = xcd_barrier_post((unsigned*)(ctl + CW_BAR), MISC + 8);
    const int lo = args.ph_lo, hi = args.ph_hi;
#ifndef PH_MASK
#define PH_MASK 0xFFF
#endif
#define IN(k) (((PH_MASK >> (k)) & 1) && lo <= (k) && (k) < hi)
#ifndef DBL_BAR
#define DBL_BAR 0
#endif
#define SEAM(k) do { if (IN(k) && IN((k) + 1)) { xcd_barrier(bar); if (DBL_BAR) xcd_barrier(bar); } } while (0)
#ifndef DBL_MASK
#define DBL_MASK 0
#endif
#define REP(k) for (int rep_ = 0; rep_ < 1 + ((DBL_MASK >> (k)) & 1); ++rep_)
#define PHASE_TID() int tid = tid0; asm volatile("" : "+v"(tid)); const int lane = tid & 63, wave = __builtin_amdgcn_readfirstlane(tid >> 6); (void)lane; (void)wave

    if (IN(0)) REP(0) {
        PHASE_TID();
        const bool conv_first = ((bx >> 3) & 1) == 0;
#pragma unroll 1
        for (int part = 0; part < 2; ++part) {
            if ((part == 0) == conv_first) {
                int tid = tid0; asm volatile("" : "+v"(tid)); const int lane = tid & 63, wave = __builtin_amdgcn_readfirstlane(tid >> 6);
                LAS float* scr = (LAS float*)(lds + wave * 16384);
                const int gw = bx * NWAVES + wave, NGW = G * NWAVES;
                constexpr int I_IN = (D / 64) * (IN_W / 32), I_SQ = (D / 64) * (D / 32);
                for (int it = gw; it < I_IN + 3 * I_SQ; it += NGW) {
                    int r = it;
                    if (r < I_IN) { p0_transpose_item(w_in, D, IN_W, WinT, scr, r, lane); continue; } r -= I_IN;
                    if (r < I_SQ) { p0_transpose_item(w_ao, D, D, WaT, scr, r, lane); continue; } r -= I_SQ;
                    if (r < I_SQ) { p0_transpose_item(w_co, D, D, WcT, scr, r, lane); continue; } r -= I_SQ;
                    p0_transpose_item(w_o, D, D, WoT, scr, r, lane);
                }
                for (int r = gw; r < M; r += NGW) row_f32_to_i8(x_in + (size_t)r * D, XA8 + (size_t)r * D, SXA + r, lane);
                __syncthreads();
            }
            if (part == 0) for (int it = bx; it < 16 * 32; it += G) p0_wf_item(w_q, sub_keys, WfT, lds, it, tid);
        }
    }
    SEAM(0);
    if (IN(1)) REP(1) {
        { PHASE_TID();
          for (int r = bx * NWAVES + wave; r < IN_W + 2 * D; r += G * NWAVES) { if (r < IN_W) row_bf16_to_i8(WinT + (size_t)r * D, WIN8 + (size_t)r * D, SWIN + r, lane);
              else if (r < IN_W + D) { const int q = r - IN_W; row_bf16_to_i8(WfT + (size_t)q * D, WF8 + (size_t)q * D, SWF + q, lane); }
              else { const int q = r - IN_W - D; row_bf16_to_i8(WoT + (size_t)q * D, WO8 + (size_t)q * D, SWO + q, lane); } } }
        if (!MK_PER_PHASE) xcd_barrier(bar);
        pg8::Gemm g{(const bf16*)XA8, (const bf16*)WIN8, M, IN_W, D / 2}; ConvOrder S; S.init(M, IN_W, G, bx);
        S.pu = peer_u; S.pv = peer_v; S.u8 = U8; S.v8 = V8; S.su = SU; S.sv = SV; S.calls = 0;
        S.slot = (G == 256 && bx >= 64) ? bx - 64 : -1;
        pg8::EpiI8Bf16 E{Z, IN_W, SXA, SWIN};
        pg8::gemm_phase<pg8::EpiI8Bf16, ConvOrder, true, true, true>(lds, g, S, E);
        if (G != 256) {
            PHASE_TID();
            for (int r = bx * NWAVES + wave; r < 2 * PNE; r += G * NWAVES) { const bool sec = r >= PNE; const int e = sec ? r - PNE : r;
                if (sec) row_to_fp8(peer_v + (size_t)e * D, V8 + (size_t)e * 256, SV + e, lane); else row_to_i8(peer_u + (size_t)e * D, U8 + (size_t)e * 256, SU + e, lane); }
        }
    }
    SEAM(1);
    if (IN(2)) REP(2) {
        PHASE_TID();
        const bool conv_first = ((bx >> 3) & 1) == 0;
#pragma unroll 1
        for (int part = 0; part < 2; ++part) {
            if ((part == 0) == conv_first) { int t2 = tid0; asm volatile("" : "+v"(t2)); for (int it = bx; it < M / 32; it += G) conv_item(it, Z, conv_w, CI, t2); }
            if (part == 0) for (int u = bx; u < BATCH * NKVH * 16; u += G) attn_unit(u, Z, AO, sinks, lds, tid);
        }
    }
    SEAM(2);
    if (IN(3)) REP(3) {
        TwoPassOrder S; S.init(M, D, G, bx);
#ifndef P3_I8
#define P3_I8 1
#endif
        if (P3_I8 && !MK_PER_PHASE) {
            { PHASE_TID();
              for (int r = bx * NWAVES + wave; r < 2 * M + 2 * D; r += G * NWAVES) {
                  if (r < M) row_bf16_to_i8(AO + (size_t)r * D, AO8 + (size_t)r * D, SAO + r, lane);
                  else if (r < 2 * M) { const int q = r - M; row_bf16_to_i8(CI + (size_t)q * D, CI8 + (size_t)q * D, SCI + q, lane); }
                  else if (r < 2 * M + D) { const int q = r - 2 * M; row_bf16_to_i8(WaT + (size_t)q * D, WA8 + (size_t)q * D, SWA + q, lane); }
                  else { const int q = r - 2 * M - D; row_bf16_to_i8(WcT + (size_t)q * D, WC8 + (size_t)q * D, SWC + q, lane); } } }
            xcd_barrier(bar);
            pg8::Gemm g{(const bf16*)AO8, (const bf16*)WA8, M, D, D / 2, (const bf16*)CI8, (const bf16*)WC8};
            EpiGate2I8 E{pg8::EpiGateI8<0>{TMP, nullptr, Z + G_OFF, b_gate, D, IN_W, SAO, SWA}, pg8::EpiGateI8<1>{MERGED, TMP, Z + G_OFF + D, b_gate + D, D, IN_W, SCI, SWC}};
            pg8::gemm_phase<EpiGate2I8, TwoPassOrder, true, true, true>(lds, g, S, E);
        } else {
        pg8::Gemm g{AO, WaT, M, D, D, CI, WcT};
        EpiGate2 E{pg8::EpiGate<0>{TMP, nullptr, Z + G_OFF, b_gate, D, IN_W}, pg8::EpiGate<1>{MERGED, TMP, Z + G_OFF + D, b_gate + D, D, IN_W}};
        pg8::gemm_phase<EpiGate2, TwoPassOrder, true, true>(lds, g, S, E);
        }
    }
    SEAM(3);
    if (IN(4)) REP(4) {
        pg8::StaticOrder S; S.init(M, D, G, bx);
#ifndef P4_I8
#define P4_I8 1
#endif
        if (P4_I8 && !MK_PER_PHASE) {
            { PHASE_TID(); for (int r = bx * NWAVES + wave; r < M; r += G * NWAVES) row_bf16_to_i8(MERGED + (size_t)r * D, MG8 + (size_t)r * D, SMG + r, lane); }
            xcd_barrier(bar);
            pg8::Gemm g{(const bf16*)MG8, (const bf16*)WO8, M, D, D / 2};
            pg8::EpiResI8Bf16 E{H1B, D, x_in, ALPHA, SMG, SWO};
            pg8::gemm_phase<pg8::EpiResI8Bf16, pg8::StaticOrder, true, true, true>(lds, g, S, E);
        } else {
        pg8::Gemm g{MERGED, WoT, M, D, D};
        pg8::EpiResBf16 E{H1B, D, x_in, ALPHA};
        pg8::gemm_phase<pg8::EpiResBf16, pg8::StaticOrder, true, true>(lds, g, S, E);
        }
    }
    SEAM(4);
    if (IN(5)) REP(5) {
        PHASE_TID();
        const int gw = bx * NWAVES + wave, NGW = G * NWAVES;
        for (int m = gw; m < M; m += NGW) ln1_row(H1B + (size_t)m * D, XQ + (size_t)m * D, SX + m, ln1_g, ln1_b, lane);
    }
    SEAM(5);
    if (IN(6)) REP(6) {
        pg8::Gemm g{H1B, WfT, M, D, D}; pg8::StaticOrder S; S.init(M, D, G, bx);
#ifndef P6_I8
#define P6_I8 1
#endif
        if (G == 256 && P6_I8) { pg8::Gemm g8{(const bf16*)XQ, (const bf16*)WF8, M, D, D / 2}; EpiTopKI8 E{EX, GT, SX, SWF}; pg8::gemm_phase<EpiTopKI8, pg8::StaticOrder, false, true, true>(lds, g8, S, E); }
        else if (G == 256) { EpiTopK E{EX, GT}; pg8::gemm_phase<EpiTopK, pg8::StaticOrder, false, true>(lds, g, S, E); }
        else { pg8::EpiF32 E{SC, D, nullptr, 0.f}; pg8::gemm_phase<pg8::EpiF32, pg8::StaticOrder, true, true>(lds, g, S, E); }
    }
    SEAM(6);
    if (IN(7)) REP(7) {
        PHASE_TID();
        if (G != 256) for (int p = bx; p < (M * PH) / 128; p += G) topk_pass(p, SC, EX, GT, lds, tid);
        else { peer_shard_load(bx & 7, bx >> 3, U8, lds, tid);
               if (bx < PA_NCH) peer_bucket(bx, EX, SEG, SOFF, lds, tid); }
    }
    SEAM(7);
    if (IN(8)) REP(8) {
        PHASE_TID();
        if (G == 256) peer_a_lds(bx & 7, XQ, SEG, SOFF, bx >> 3, PA, lds, tid, peer_v, V8, SV, bx * 64);
        else {
        const int xcc = (int)(xb_xcc_id() & 7u);
#pragma unroll 1
#ifndef SCRAMBLE
#define SCRAMBLE 0
#endif
        for (int sl = 0; sl < 8; ++sl) { const int s = (xcc + sl + (SCRAMBLE ? wave : 0)) & 7;
            for (;;) { const int tg = q_pull((unsigned*)(ctl + CW_Q + 64 * (s + 16 * rep_)), lane); if (tg >= PEER_NTASK) break;
                int t0, nt; peer_task_tokens(tg, t0, nt); peer_a_task(t0, nt, s, XQ, EX, U8, PA, lane); } }
        }
    }
    SEAM(8);
    if (IN(9)) REP(9) {
        PHASE_TID();
        if (G == 256) { peer_w_pack(bx, EX, GT, SU, SV, SX, PA, (unsigned*)WB, lds, tid); peer_vshard_load(bx & 7, bx >> 3, V8, lds, tid); }
        else
        for (size_t i = (size_t)bx * NTHREADS + tid; i < (size_t)M * 128; i += (size_t)G * NTHREADS) peer_w_elem(i, EX, GT, SU, SV, SX, PA, WB);
    }
    SEAM(9);
    if (IN(10)) REP(10) {
        PHASE_TID();
        if (G == 256) { __syncthreads(); peer_b2(bx & 7, bx >> 3, H1B, (const unsigned*)WB, R2B, tid); }
        else {
        const int xcc = (int)(xb_xcc_id() & 7u);
#pragma unroll 1
#ifndef SCRAMBLE
#define SCRAMBLE 0
#endif
        for (int sl = 0; sl < 8; ++sl) { const int s = (xcc + sl + (SCRAMBLE ? wave : 0)) & 7;
            for (;;) { const int tg = q_pull((unsigned*)(ctl + CW_Q + 64 * (8 + s + 16 * rep_)), lane); if (tg >= PEER_NTASK) break;
                int t0, nt; peer_task_tokens(tg, t0, nt); peer_b_task(t0, nt, s, H1B, EX, WB, V8, R2B, ST, lane); } }
        }
    }
    SEAM(10);
    if (IN(11)) REP(11) {
        PHASE_TID();
        const int gw = bx * NWAVES + wave, NGW = G * NWAVES;
        if (G == 256) { for (int t = gw; t < M; t += NGW) peer_c2_row(t, R2B, args.out, ln2_g, ln2_b, lane); }
        else for (int t = gw; t < M; t += NGW) peer_c_row(t, R2B, args.out, ST, ln2_g, ln2_b, lane);
    }
#undef IN
#undef SEAM
}

extern "C" void kernel_launch(void* const* d_in, const int* in_sizes, int n_in, void* d_out, int out_size, void* d_ws, size_t ws_size, hipStream_t stream) {
    static int grid = 0;
    if (grid == 0) {
        if (n_in != 16 || out_size != M * D || ws_size < WS_END) { fprintf(stderr, "kernel_launch: unexpected shapes (n_in %d out %d ws %zu)\n", n_in, out_size, ws_size); grid = -1; return; }
        int dev = 0, cus = 0, per_cu = 0;
        if (hipGetDevice(&dev) != hipSuccess || hipDeviceGetAttribute(&cus, hipDeviceAttributeMultiprocessorCount, dev) != hipSuccess) { grid = -1; return; }
        if (hipFuncSetAttribute((const void*)mk_fwd, hipFuncAttributeMaxDynamicSharedMemorySize, LDS_BYTES) != hipSuccess) { fprintf(stderr, "kernel_launch: hipFuncSetAttribute failed\n"); grid = -1; return; }
        if (hipOccupancyMaxActiveBlocksPerMultiprocessor(&per_cu, (const void*)mk_fwd, NTHREADS, LDS_BYTES) != hipSuccess || per_cu < 1) { fprintf(stderr, "kernel_launch: occupancy query says %d\n", per_cu); per_cu = 1; }
        (void)hipGetLastError();
        if (per_cu > 1) per_cu = 1;
        grid = cus * per_cu;
    }
    if (grid < 0) return;
    if (hipMemsetAsync((char*)d_ws + WS_CTL, 0, CTL_ZERO_BYTES, stream) != hipSuccess) { fprintf(stderr, "kernel_launch: memset failed\n"); return; }
    Args a{};
    for (int i = 0; i < 16; ++i) a.in[i] = (const float*)d_in[i];
    a.out = (float*)d_out; a.ws = (unsigned char*)d_ws;
#if MK_PER_PHASE
    for (int p = 0; p < N_PHASES; ++p) { a.ph_lo = p; a.ph_hi = p + 1; hipLaunchKernelGGL(mk_fwd, dim3(grid), dim3(NTHREADS), LDS_BYTES, stream, a); }
#else
    a.ph_lo = 0; a.ph_hi = N_PHASES;
    void* kargs[] = {&a};
#ifdef PLAIN_LAUNCH
    (void)kargs; hipLaunchKernelGGL(mk_fwd, dim3(grid), dim3(NTHREADS), LDS_BYTES, stream, a); hipError_t e = hipPeekAtLastError();
#else
    hipError_t e = hipLaunchCooperativeKernel((const void*)mk_fwd, dim3(grid), dim3(NTHREADS), kargs, LDS_BYTES, stream);
#endif
    if (e != hipSuccess) fprintf(stderr, "kernel_launch: cooperative launch failed: %s (grid %d)\n", hipGetErrorString(e), grid);
#endif
}
```

```cpp
#include <hip/hip_runtime.h>
#include <cstdio>
#include <cstdint>
#include <type_traits>
namespace pg8 {
#define PG8_LAS __attribute__((address_space(3)))
typedef unsigned short bf16_t;
typedef short bf16x8 __attribute__((ext_vector_type(8)));
typedef float f32x4 __attribute__((ext_vector_type(4)));
typedef unsigned u32x4 __attribute__((ext_vector_type(4)));
constexpr int BM = 256, BK = 64, HALF = 128, HTB = HALF * BK * 2  , STAGE_BYTES = 8 * HTB, NXCD = 8, WGM = 8;

__host__ __device__ __forceinline__ int lds_byte(int r, int c) { const int st = (r >> 4) * 2 + (c >> 5), rr = r & 15, cc = c & 31, ob = rr * 64 + cc * 2; return st * 1024 + (ob ^ (((ob >> 9) & 1) << 5)); }
__host__ __device__ __forceinline__ void stage_rc(int b, int& R, int& C) { const int st = b / 1024, sb = b % 1024, swz = sb ^ (((sb >> 9) & 1) << 5); R = (st >> 1) * 16 + swz / 64; C = (st & 1) * 32 + (swz % 64) / 2; }
__host__ __device__ __forceinline__ int perm32(int rho) { const int n = rho >> 4, i = rho & 15; return 8 * (i >> 2) + 4 * n + (i & 3); }

struct Unit { int pm, pn, w; };
struct Gemm { const bf16_t* A; const bf16_t* Bt; int M, N, K; const bf16_t* A2 = nullptr; const bf16_t* Bt2 = nullptr; };

struct StaticOrder {
    int nM, nN, nwg, G, c;
    __host__ __device__ void init(int M, int N, int G_, int c_) { nM = M / BM; nN = N / BM; nwg = nM * nN; G = G_; c = c_; }
    __host__ __device__ bool next(int i, Unit& u) const {
        const long L = (long)i * G + c; if (L >= nwg) return false;
        int wgid = (int)L; { const int q = nwg / NXCD, r = nwg % NXCD, xcd = wgid % NXCD, off = wgid / NXCD; wgid = (xcd < r ? xcd * (q + 1) : r * (q + 1) + (xcd - r) * q) + off; }
        const int nig = WGM * nN, gid = wgid / nig, fm = gid * WGM, gsz = (nM - fm) < WGM ? (nM - fm) : WGM;
        u.pm = fm + ((wgid % nig) % gsz); u.pn = (wgid % nig) / gsz; u.w = 0; return true;
    }
    __device__ __forceinline__ void a_ready(const Unit&) const {}
    __device__ __forceinline__ void done(const Unit&) const {}
};


__device__ __forceinline__ unsigned cvt_pk_bf16(float lo, float hi) { unsigned r; asm volatile("v_cvt_pk_bf16_f32 %0, %1, %2" : "=v"(r) : "v"(lo), "v"(hi)); return r; }
__device__ __forceinline__ float bf_lo(unsigned w) { return __builtin_bit_cast(float, w << 16); }
__device__ __forceinline__ float bf_hi(unsigned w) { return __builtin_bit_cast(float, w & 0xffff0000u); }
__device__ __forceinline__ float sigmoidf_(float x) { return __builtin_amdgcn_rcpf(1.0f + __expf(-x)); }

struct EpiBf16 {
    static constexpr bool PERM = true, AFTER_DRAIN = false;
    bf16_t* O; int ldc;
    __device__ __forceinline__ void operator()(const f32x4 (&acc)[2][2][4][2], const Unit& u, int wr, int wc, int fr, int fq) const {
        const int row0 = u.pm * BM + wr * 64 + fr, col0 = u.pn * BM + wc * 32 + 8 * fq;
#pragma unroll
        for (int ai = 0; ai < 2; ++ai)
#pragma unroll
            for (int m = 0; m < 4; ++m) { bf16_t* rowp = O + (size_t)(row0 + ai * HALF + m * 16) * ldc + col0;
#pragma unroll
                for (int bj = 0; bj < 2; ++bj) { const f32x4 v0 = acc[ai][bj][m][0], v1 = acc[ai][bj][m][1];
                    u32x4 w; w.x = cvt_pk_bf16(v0[0], v0[1]); w.y = cvt_pk_bf16(v0[2], v0[3]); w.z = cvt_pk_bf16(v1[0], v1[1]); w.w = cvt_pk_bf16(v1[2], v1[3]);
                    *(u32x4*)(rowp + bj * HALF) = w; } }
    }
};
template <int SECOND> struct EpiGate {
    static constexpr bool PERM = true, AFTER_DRAIN = false;
    bf16_t* O; const bf16_t* T; const bf16_t* Zg; const float* bg; int ldc, ldz;
    __device__ __forceinline__ void operator()(const f32x4 (&acc)[2][2][4][2], const Unit& u, int wr, int wc, int fr, int fq) const {
        const int row0 = u.pm * BM + wr * 64 + fr, col0 = u.pn * BM + wc * 32 + 8 * fq;
        f32x4 bv[2][2];
#pragma unroll
        for (int bj = 0; bj < 2; ++bj)
#pragma unroll
            for (int n = 0; n < 2; ++n) bv[bj][n] = *(const f32x4*)(bg + col0 + bj * HALF + 4 * n);
#pragma unroll
        for (int ai = 0; ai < 2; ++ai)
#pragma unroll
            for (int m = 0; m < 4; ++m) { const size_t row = (size_t)(row0 + ai * HALF + m * 16);
#pragma unroll
                for (int bj = 0; bj < 2; ++bj) { const int c = col0 + bj * HALF;
                    const u32x4 zg = *(const u32x4*)(Zg + row * ldz + c);
                    f32x4 v0 = acc[ai][bj][m][0], v1 = acc[ai][bj][m][1];
                    v0[0] *= sigmoidf_(bf_lo(zg.x) + bv[bj][0][0]); v0[1] *= sigmoidf_(bf_hi(zg.x) + bv[bj][0][1]);
                    v0[2] *= sigmoidf_(bf_lo(zg.y) + bv[bj][0][2]); v0[3] *= sigmoidf_(bf_hi(zg.y) + bv[bj][0][3]);
                    v1[0] *= sigmoidf_(bf_lo(zg.z) + bv[bj][1][0]); v1[1] *= sigmoidf_(bf_hi(zg.z) + bv[bj][1][1]);
                    v1[2] *= sigmoidf_(bf_lo(zg.w) + bv[bj][1][2]); v1[3] *= sigmoidf_(bf_hi(zg.w) + bv[bj][1][3]);
                    if (SECOND) { const u32x4 t = *(const u32x4*)(T + row * ldc + c);
                        v0[0] += bf_lo(t.x); v0[1] += bf_hi(t.x); v0[2] += bf_lo(t.y); v0[3] += bf_hi(t.y);
                        v1[0] += bf_lo(t.z); v1[1] += bf_hi(t.z); v1[2] += bf_lo(t.w); v1[3] += bf_hi(t.w); }
                    u32x4 w; w.x = cvt_pk_bf16(v0[0], v0[1]); w.y = cvt_pk_bf16(v0[2], v0[3]); w.z = cvt_pk_bf16(v1[0], v1[1]); w.w = cvt_pk_bf16(v1[2], v1[3]);
                    *(u32x4*)(O + row * ldc + c) = w; } }
    }
};
struct EpiF32 {
    static constexpr bool PERM = false, AFTER_DRAIN = false;
    float* C; int ldc; const float* R; float scale;
    __device__ __forceinline__ void operator()(const f32x4 (&acc)[2][2][4][2], const Unit& u, int wr, int wc, int fr, int fq) const {
        const int row0 = u.pm * BM + wr * 64 + fr, col0 = u.pn * BM + wc * 32 + 4 * fq;
#pragma unroll
        for (int ai = 0; ai < 2; ++ai)
#pragma unroll
            for (int m = 0; m < 4; ++m) { const size_t off = (size_t)(row0 + ai * HALF + m * 16) * ldc + col0;
#pragma unroll
                for (int bj = 0; bj < 2; ++bj)
#pragma unroll
                    for (int n = 0; n < 2; ++n) { f32x4 v = acc[ai][bj][m][n];
                        if (R) v += *(const f32x4*)(R + off + bj * HALF + n * 16) * scale;
                        *(f32x4*)(C + off + bj * HALF + n * 16) = v; } }
    }
};
struct EpiResBf16 {
    static constexpr bool PERM = true, AFTER_DRAIN = false;
    bf16_t* O; int ldc; const float* R; float scale;
    __device__ __forceinline__ void operator()(const f32x4 (&acc)[2][2][4][2], const Unit& u, int wr, int wc, int fr, int fq) const {
        const int row0 = u.pm * BM + wr * 64 + fr, col0 = u.pn * BM + wc * 32 + 8 * fq;
#pragma unroll
        for (int ai = 0; ai < 2; ++ai)
#pragma unroll
            for (int m = 0; m < 4; ++m) { const size_t off = (size_t)(row0 + ai * HALF + m * 16) * ldc + col0;
#pragma unroll
                for (int bj = 0; bj < 2; ++bj) { const f32x4 r0 = *(const f32x4*)(R + off + bj * HALF), r1 = *(const f32x4*)(R + off + bj * HALF + 4);
                    const f32x4 v0 = acc[ai][bj][m][0] + r0 * scale, v1 = acc[ai][bj][m][1] + r1 * scale;
                    u32x4 w; w.x = cvt_pk_bf16(v0[0], v0[1]); w.y = cvt_pk_bf16(v0[2], v0[3]); w.z = cvt_pk_bf16(v1[0], v1[1]); w.w = cvt_pk_bf16(v1[2], v1[3]);
                    *(u32x4*)(O + off + bj * HALF) = w; } }
    }
};
typedef int i32x4e __attribute__((ext_vector_type(4)));
struct EpiI8Bf16 {
    static constexpr bool PERM = true, AFTER_DRAIN = false;
    bf16_t* O; int ldc; const float* sa; const float* sb;
    __device__ __forceinline__ void operator()(const i32x4e (&acc)[2][2][4][2], const Unit& u, int wr, int wc, int fr, int fq) const {
        const int row0 = u.pm * BM + wr * 64 + fr, col0 = u.pn * BM + wc * 32 + 8 * fq;
        f32x4 sbv[2][2];
#pragma unroll
        for (int bj = 0; bj < 2; ++bj)
#pragma unroll
            for (int n = 0; n < 2; ++n) sbv[bj][n] = *(const f32x4*)(sb + col0 + bj * HALF + 4 * n);
#pragma unroll
        for (int ai = 0; ai < 2; ++ai)
#pragma unroll
            for (int m = 0; m < 4; ++m) { const int row = row0 + ai * HALF + m * 16; const float sr = sa[row]; bf16_t* rowp = O + (size_t)row * ldc + col0;
#pragma unroll
                for (int bj = 0; bj < 2; ++bj) { const i32x4e a0 = acc[ai][bj][m][0], a1 = acc[ai][bj][m][1];
                    const f32x4 v0 = (f32x4){(float)a0[0], (float)a0[1], (float)a0[2], (float)a0[3]} * sbv[bj][0] * sr, v1 = (f32x4){(float)a1[0], (float)a1[1], (float)a1[2], (float)a1[3]} * sbv[bj][1] * sr;
                    u32x4 w; w.x = cvt_pk_bf16(v0[0], v0[1]); w.y = cvt_pk_bf16(v0[2], v0[3]); w.z = cvt_pk_bf16(v1[0], v1[1]); w.w = cvt_pk_bf16(v1[2], v1[3]);
                    *(u32x4*)(rowp + bj * HALF) = w; } }
    }
};
struct EpiI8Bf16Z {
    static constexpr bool PERM = true, AFTER_DRAIN = false;
    static constexpr int P_LO = 18, P_HI = 34, PC_OFF = 4608;
    bf16_t* O; int ldc; const float* sa; const float* sb;
    __device__ __forceinline__ void operator()(const i32x4e (&acc)[2][2][4][2], const Unit& u, int wr, int wc, int fr, int fq) const {
        const int row0 = u.pm * BM + wr * 64 + fr, col0 = u.pn * BM + wc * 32 + 8 * fq;
        f32x4 sbv[2][2];
#pragma unroll
        for (int bj = 0; bj < 2; ++bj)
#pragma unroll
            for (int n = 0; n < 2; ++n) sbv[bj][n] = *(const f32x4*)(sb + col0 + bj * HALF + 4 * n);
        if (u.pn >= P_LO && u.pn < P_HI) {
            const int pc0 = PC_OFF + (u.pn - P_LO) * HALF + wc * 32 + 8 * fq;
            float srp[2][4];
#pragma unroll
            for (int ai = 0; ai < 2; ++ai)
#pragma unroll
                for (int m = 0; m < 4; ++m) srp[ai][m] = sa[row0 + ai * HALF + m * 16];
#pragma unroll
            for (int ai = 0; ai < 2; ++ai)
#pragma unroll
                for (int m = 0; m < 4; ++m) { const int row = row0 + ai * HALF + m * 16; const float sr = srp[ai][m], sr2 = sr * sr;
                    const i32x4e a0 = acc[ai][0][m][0], a1 = acc[ai][0][m][1], h0 = acc[ai][1][m][0], h1 = acc[ai][1][m][1];
                    const f32x4 v0 = (f32x4){(float)a0[0], (float)a0[1], (float)a0[2], (float)a0[3]} * sbv[0][0] * ((f32x4){(float)h0[0], (float)h0[1], (float)h0[2], (float)h0[3]} * sbv[1][0]) * sr2;
                    const f32x4 v1 = (f32x4){(float)a1[0], (float)a1[1], (float)a1[2], (float)a1[3]} * sbv[0][1] * ((f32x4){(float)h1[0], (float)h1[1], (float)h1[2], (float)h1[3]} * sbv[1][1]) * sr2;
                    u32x4 w; w.x = cvt_pk_bf16(v0[0], v0[1]); w.y = cvt_pk_bf16(v0[2], v0[3]); w.z = cvt_pk_bf16(v1[0], v1[1]); w.w = cvt_pk_bf16(v1[2], v1[3]);
                    *(u32x4*)(O + (size_t)row * ldc + pc0) = w; }
            asm volatile("s_waitcnt vmcnt(0)" ::: "memory");
            return;
        }
        float srv[2][4];
#pragma unroll
        for (int ai = 0; ai < 2; ++ai)
#pragma unroll
            for (int m = 0; m < 4; ++m) srv[ai][m] = sa[row0 + ai * HALF + m * 16];
#pragma unroll
        for (int ai = 0; ai < 2; ++ai)
#pragma unroll
            for (int m = 0; m < 4; ++m) { const int row = row0 + ai * HALF + m * 16; const float sr = srv[ai][m]; bf16_t* rowp = O + (size_t)row * ldc + col0;
#pragma unroll
                for (int bj = 0; bj < 2; ++bj) { const i32x4e a0 = acc[ai][bj][m][0], a1 = acc[ai][bj][m][1];
                    const f32x4 v0 = (f32x4){(float)a0[0], (float)a0[1], (float)a0[2], (float)a0[3]} * sbv[bj][0] * sr, v1 = (f32x4){(float)a1[0], (float)a1[1], (float)a1[2], (float)a1[3]} * sbv[bj][1] * sr;
                    u32x4 w; w.x = cvt_pk_bf16(v0[0], v0[1]); w.y = cvt_pk_bf16(v0[2], v0[3]); w.z = cvt_pk_bf16(v1[0], v1[1]); w.w = cvt_pk_bf16(v1[2], v1[3]);
                    *(u32x4*)(rowp + bj * HALF) = w; } }
        asm volatile("s_waitcnt vmcnt(0)" ::: "memory");
    }
};
template <int SECOND> struct EpiGateI8 {
    static constexpr bool PERM = true, AFTER_DRAIN = false;
    bf16_t* O; const bf16_t* T; const bf16_t* Zg; const float* bg; int ldc, ldz; const float* sa; const float* sb;
    __device__ __forceinline__ void operator()(const i32x4e (&acc)[2][2][4][2], const Unit& u, int wr, int wc, int fr, int fq) const {
        const int row0 = u.pm * BM + wr * 64 + fr, col0 = u.pn * BM + wc * 32 + 8 * fq;
        f32x4 bv[2][2], sbv[2][2];
#pragma unroll
        for (int bj = 0; bj < 2; ++bj)
#pragma unroll
            for (int n = 0; n < 2; ++n) { bv[bj][n] = *(const f32x4*)(bg + col0 + bj * HALF + 4 * n); sbv[bj][n] = *(const f32x4*)(sb + col0 + bj * HALF + 4 * n); }
#pragma unroll
        for (int ai = 0; ai < 2; ++ai)
#pragma unroll
            for (int m = 0; m < 4; ++m) { const size_t row = (size_t)(row0 + ai * HALF + m * 16); const float sr = sa[row];
                u32x4 zgv[2], tv[2];
#pragma unroll
                for (int bj = 0; bj < 2; ++bj) { const int c = col0 + bj * HALF; zgv[bj] = *(const u32x4*)(Zg + row * ldz + c); if (SECOND) tv[bj] = *(const u32x4*)(T + row * ldc + c); else tv[bj] = (u32x4){0u, 0u, 0u, 0u}; }
#pragma unroll
                for (int bj = 0; bj < 2; ++bj) { const int c = col0 + bj * HALF;
                    const u32x4 zg = zgv[bj];
                    const i32x4e a0 = acc[ai][bj][m][0], a1 = acc[ai][bj][m][1];
                    f32x4 v0 = (f32x4){(float)a0[0], (float)a0[1], (float)a0[2], (float)a0[3]} * sbv[bj][0] * sr, v1 = (f32x4){(float)a1[0], (float)a1[1], (float)a1[2], (float)a1[3]} * sbv[bj][1] * sr;
                    v0[0] *= sigmoidf_(bf_lo(zg.x) + bv[bj][0][0]); v0[1] *= sigmoidf_(bf_hi(zg.x) + bv[bj][0][1]);
                    v0[2] *= sigmoidf_(bf_lo(zg.y) + bv[bj][0][2]); v0[3] *= sigmoidf_(bf_hi(zg.y) + bv[bj][0][3]);
                    v1[0] *= sigmoidf_(bf_lo(zg.z) + bv[bj][1][0]); v1[1] *= sigmoidf_(bf_hi(zg.z) + bv[bj][1][1]);
                    v1[2] *= sigmoidf_(bf_lo(zg.w) + bv[bj][1][2]); v1[3] *= sigmoidf_(bf_hi(zg.w) + bv[bj][1][3]);
                    if (SECOND) { const u32x4 t = tv[bj];
                        v0[0] += bf_lo(t.x); v0[1] += bf_hi(t.x); v0[2] += bf_lo(t.y); v0[3] += bf_hi(t.y);
                        v1[0] += bf_lo(t.z); v1[1] += bf_hi(t.z); v1[2] += bf_lo(t.w); v1[3] += bf_hi(t.w); }
                    u32x4 w; w.x = cvt_pk_bf16(v0[0], v0[1]); w.y = cvt_pk_bf16(v0[2], v0[3]); w.z = cvt_pk_bf16(v1[0], v1[1]); w.w = cvt_pk_bf16(v1[2], v1[3]);
                    *(u32x4*)(O + row * ldc + c) = w; } }
    }
};
struct EpiResI8Bf16 {
    static constexpr bool PERM = true, AFTER_DRAIN = false;
    bf16_t* O; int ldc; const float* R; float scale; const float* sa; const float* sb;
    __device__ __forceinline__ void operator()(const i32x4e (&acc)[2][2][4][2], const Unit& u, int wr, int wc, int fr, int fq) const {
        const int row0 = u.pm * BM + wr * 64 + fr, col0 = u.pn * BM + wc * 32 + 8 * fq;
        f32x4 sbv[2][2];
#pragma unroll
        for (int bj = 0; bj < 2; ++bj)
#pragma unroll
            for (int n = 0; n < 2; ++n) sbv[bj][n] = *(const f32x4*)(sb + col0 + bj * HALF + 4 * n);
#pragma unroll
        for (int ai = 0; ai < 2; ++ai)
#pragma unroll
            for (int m = 0; m < 4; ++m) { const int row = row0 + ai * HALF + m * 16; const float sr = sa[row]; const size_t off = (size_t)row * ldc + col0;
                f32x4 rv[2][2];
#pragma unroll
                for (int bj = 0; bj < 2; ++bj) { rv[bj][0] = *(const f32x4*)(R + off + bj * HALF); rv[bj][1] = *(const f32x4*)(R + off + bj * HALF + 4); }
#pragma unroll
                for (int bj = 0; bj < 2; ++bj) { const f32x4 r0 = rv[bj][0], r1 = rv[bj][1];
                    const i32x4e a0 = acc[ai][bj][m][0], a1 = acc[ai][bj][m][1];
                    const f32x4 v0 = (f32x4){(float)a0[0], (float)a0[1], (float)a0[2], (float)a0[3]} * sbv[bj][0] * sr + r0 * scale, v1 = (f32x4){(float)a1[0], (float)a1[1], (float)a1[2], (float)a1[3]} * sbv[bj][1] * sr + r1 * scale;
                    u32x4 w; w.x = cvt_pk_bf16(v0[0], v0[1]); w.y = cvt_pk_bf16(v0[2], v0[3]); w.z = cvt_pk_bf16(v1[0], v1[1]); w.w = cvt_pk_bf16(v1[2], v1[3]);
                    *(u32x4*)(O + off + bj * HALF) = w; } }
    }
};

typedef int i32x4 __attribute__((ext_vector_type(4)));
template <class E, class = void> struct epi_chains : std::false_type {};
template <class E> struct epi_chains<E, std::void_t<decltype(E::CHAIN)>> : std::true_type {};
template <class Epi, class Sched, bool ALIGN_EPI = false, bool SP2 = false, bool I8 = false>
__device__ __forceinline__ void gemm_phase(PG8_LAS unsigned char* lds, const Gemm g, const Sched& S, const Epi& E) {
    int tid_ = threadIdx.x; asm volatile("" : "+v"(tid_));
    const int tid = tid_, wid = __builtin_amdgcn_readfirstlane(tid >> 6), lane = tid & 63, wr = wid >> 2, wc = wid & 3, fr = lane & 15, fq = lane >> 4;
    const int K = g.K, nt = K / BK;
    unsigned voffA[2], voffB[2];
#pragma unroll
    for (int i = 0; i < 2; ++i) { int R, C; stage_rc(tid * 16 + i * 8192, R, C); const int Rb = Epi::PERM ? ((R & ~31) + perm32(R & 31)) : R;
        voffA[i] = (unsigned)(R * K + C) * 2u; voffB[i] = (unsigned)(Rb * K + C) * 2u; }
    const size_t kstep = (size_t)(BK * 2);
    const size_t hstep = (size_t)HALF * K * 2;
    const size_t tstep = 2 * hstep;
    const unsigned ldsw = (unsigned)wid * 1024u;
    const int aoff = lds_byte(wr * 64 + fr, fq * 8), boff = lds_byte(wc * 32 + fr, fq * 8);
#define PG8_SA(b, h) (((b) * 2 + (h)) * HTB)
#define PG8_SB(b, h) ((4 + (b) * 2 + (h)) * HTB)
#define PG8_STAGE(bufoff, gbase, voff) do { _Pragma("unroll") for (int _i = 0; _i < 2; ++_i) \
        __builtin_amdgcn_global_load_lds((const unsigned*)((const char*)(gbase) + (voff)[_i]), (PG8_LAS unsigned*)(lds + (bufoff) + ldsw + _i * 8192), 16, 0, 0); } while (0)
#define PG8_LDA(dst, b, h) do { _Pragma("unroll") for (int m = 0; m < 4; ++m) _Pragma("unroll") for (int k = 0; k < 2; ++k) dst[m][k] = *(const PG8_LAS bf16x8*)(lds + PG8_SA(b, h) + aoff + m * 2048 + k * 1024); } while (0)
#define PG8_LDB(dst, b, h) do { _Pragma("unroll") for (int n = 0; n < 2; ++n) _Pragma("unroll") for (int k = 0; k < 2; ++k) dst[n][k] = *(const PG8_LAS bf16x8*)(lds + PG8_SB(b, h) + boff + n * 2048 + k * 1024); } while (0)
#define PG8_MMA(ai, bj, At, Bt) do { __builtin_amdgcn_s_setprio(1); _Pragma("unroll") for (int m = 0; m < 4; ++m) _Pragma("unroll") for (int n = 0; n < 2; ++n) _Pragma("unroll") for (int k = 0; k < 2; ++k) \
        { if constexpr (I8) acc[ai][bj][m][n] = __builtin_bit_cast(acc_t, __builtin_amdgcn_mfma_i32_16x16x64_i8(__builtin_bit_cast(i32x4, Bt[n][k]), __builtin_bit_cast(i32x4, At[m][k]), __builtin_bit_cast(i32x4, acc[ai][bj][m][n]), 0, 0, 0)); \
          else acc[ai][bj][m][n] = __builtin_bit_cast(acc_t, __builtin_amdgcn_mfma_f32_16x16x32_bf16(Bt[n][k], At[m][k], __builtin_bit_cast(f32x4, acc[ai][bj][m][n]), 0, 0, 0)); } __builtin_amdgcn_s_setprio(0); } while (0)
#define PG8_WAIT_V(n) asm volatile("s_waitcnt vmcnt(" #n ")" ::: "memory")
#define PG8_WAIT_L(n) asm volatile("s_waitcnt lgkmcnt(" #n ")" ::: "memory")
#define PG8_BAR __builtin_amdgcn_s_barrier()
#define PG8_SCHED __builtin_amdgcn_sched_barrier(0)
    Unit cur, nxt; int ui = 0;
    if (!S.next(0, cur)) return;
    typedef typename std::conditional<I8, i32x4, f32x4>::type acc_t;
    acc_t acc[2][2][4][2];
#pragma unroll
    for (int a = 0; a < 2; ++a)
#pragma unroll
        for (int b = 0; b < 2; ++b)
#pragma unroll
            for (int m = 0; m < 4; ++m)
#pragma unroll
                for (int n = 0; n < 2; ++n) acc[a][b][m][n] = acc_t{};
    bf16x8 At[4][2], B0[2][2], B1[2][2];
    const char* cA = (const char*)(cur.w ? g.A2 : g.A) + (size_t)cur.pm * tstep; const char* cB = (const char*)(cur.w ? g.Bt2 : g.Bt) + (size_t)cur.pn * tstep;
    S.a_ready(cur);
    if constexpr (SP2) {
        PG8_STAGE(PG8_SB(0, 0), cB, voffB); PG8_STAGE(PG8_SB(0, 1), cB + hstep, voffB); PG8_STAGE(PG8_SA(0, 0), cA, voffA); PG8_STAGE(PG8_SA(0, 1), cA + hstep, voffA);
        if (wr == 1) PG8_BAR;
        PG8_WAIT_V(2); PG8_BAR;
        PG8_STAGE(PG8_SB(1, 0), cB + kstep, voffB); PG8_STAGE(PG8_SA(1, 0), cA + kstep, voffA); PG8_STAGE(PG8_SB(1, 1), cB + hstep + kstep, voffB);
        PG8_WAIT_V(6); PG8_BAR;
    } else {
        PG8_STAGE(PG8_SB(0, 0), cB, voffB); PG8_STAGE(PG8_SA(0, 0), cA, voffA); PG8_STAGE(PG8_SB(0, 1), cB + hstep, voffB); PG8_STAGE(PG8_SA(0, 1), cA + hstep, voffA);
        if (wr == 1) PG8_BAR;
        PG8_WAIT_V(4); PG8_BAR;
        PG8_STAGE(PG8_SB(1, 0), cB + kstep, voffB); PG8_STAGE(PG8_SA(1, 0), cA + kstep, voffA); PG8_STAGE(PG8_SB(1, 1), cB + hstep + kstep, voffB);
        PG8_WAIT_V(6); PG8_BAR;
    }
    for (;;) {
        const bool has_next = S.next(ui + 1, nxt);
        const char* nA = has_next ? (const char*)(nxt.w ? g.A2 : g.A) + (size_t)nxt.pm * tstep : cA; const char* nB = has_next ? (const char*)(nxt.w ? g.Bt2 : g.Bt) + (size_t)nxt.pn * tstep : cB;
        for (int t = 0; t < nt; t += 2) {
            const bool last = (t == nt - 2);
            const char* a1 = cA + (size_t)(t + 1) * kstep;
            const char* a2 = last ? nA : cA + (size_t)(t + 2) * kstep; const char* b2 = last ? nB : cB + (size_t)(t + 2) * kstep;
            const char* a3 = a2 + kstep; const char* b3 = b2 + kstep;
            if (last && has_next) S.a_ready(nxt);
            if constexpr (SP2) {
            PG8_LDB(B0, 0, 0); PG8_LDB(B1, 0, 1); PG8_SCHED; PG8_LDA(At, 0, 0); PG8_STAGE(PG8_SA(1, 1), a1 + hstep, voffA);
            PG8_WAIT_V(8); PG8_WAIT_L(0); PG8_BAR; PG8_MMA(0, 0, At, B0); PG8_MMA(0, 1, At, B1); PG8_BAR; PG8_SCHED;
            PG8_LDA(At, 0, 1); PG8_STAGE(PG8_SB(0, 0), b2, voffB); PG8_STAGE(PG8_SB(0, 1), b2 + hstep, voffB); PG8_STAGE(PG8_SA(0, 0), a2, voffA);
            PG8_WAIT_V(8); PG8_WAIT_L(0); PG8_BAR; PG8_MMA(1, 0, At, B0); PG8_MMA(1, 1, At, B1); PG8_BAR; PG8_SCHED;
            PG8_LDB(B0, 1, 0); PG8_LDB(B1, 1, 1); PG8_SCHED; PG8_LDA(At, 1, 0); PG8_STAGE(PG8_SA(0, 1), a2 + hstep, voffA);
            PG8_WAIT_V(8); PG8_WAIT_L(0); PG8_BAR; PG8_MMA(0, 0, At, B0); PG8_MMA(0, 1, At, B1); PG8_BAR; PG8_SCHED;
            PG8_LDA(At, 1, 1); PG8_STAGE(PG8_SB(1, 0), b3, voffB); PG8_STAGE(PG8_SB(1, 1), b3 + hstep, voffB); PG8_STAGE(PG8_SA(1, 0), a3, voffA);
            PG8_WAIT_V(8); PG8_WAIT_L(0); PG8_BAR; PG8_MMA(1, 0, At, B0); PG8_MMA(1, 1, At, B1); PG8_BAR; PG8_SCHED;
            } else {
            PG8_LDB(B0, 0, 0); PG8_SCHED; PG8_LDA(At, 0, 0); PG8_STAGE(PG8_SA(1, 1), a1 + hstep, voffA);
            PG8_WAIT_L(8); PG8_BAR; PG8_WAIT_L(0); PG8_MMA(0, 0, At, B0); PG8_BAR; PG8_SCHED;
            PG8_LDB(B1, 0, 1); PG8_STAGE(PG8_SB(0, 0), b2, voffB);
            PG8_BAR; PG8_WAIT_L(0); PG8_MMA(0, 1, At, B1); PG8_BAR;
            PG8_LDA(At, 0, 1); PG8_STAGE(PG8_SA(0, 0), a2, voffA);
            PG8_BAR; PG8_WAIT_L(0); PG8_MMA(1, 0, At, B0); PG8_BAR; PG8_SCHED;
            PG8_STAGE(PG8_SB(0, 1), b2 + hstep, voffB);
            PG8_WAIT_V(6); PG8_BAR; PG8_MMA(1, 1, At, B1); PG8_BAR;
            PG8_LDB(B0, 1, 0); PG8_SCHED; PG8_LDA(At, 1, 0); PG8_STAGE(PG8_SA(0, 1), a2 + hstep, voffA);
            PG8_WAIT_L(8); PG8_BAR; PG8_WAIT_L(0); PG8_MMA(0, 0, At, B0); PG8_BAR; PG8_SCHED;
            PG8_LDB(B1, 1, 1); PG8_STAGE(PG8_SB(1, 0), b3, voffB);
            PG8_BAR; PG8_WAIT_L(0); PG8_MMA(0, 1, At, B1); PG8_BAR;
            PG8_LDA(At, 1, 1); PG8_STAGE(PG8_SA(1, 0), a3, voffA);
            PG8_BAR; PG8_WAIT_L(0); PG8_MMA(1, 0, At, B0); PG8_BAR; PG8_SCHED;
            PG8_STAGE(PG8_SB(1, 1), b3 + hstep, voffB);
            PG8_WAIT_V(6); PG8_BAR; PG8_MMA(1, 1, At, B1); PG8_BAR;
            }
        }
        if constexpr (ALIGN_EPI) { if (wr == 0) PG8_BAR; }
        bool keep_acc = false;
        if constexpr (!Epi::AFTER_DRAIN) { if constexpr (epi_chains<Epi>::value) keep_acc = E.chain(acc, cur, wr, wc, fr, fq); else E(acc, cur, wr, wc, fr, fq); S.done(cur); }
        if (!has_next) break;
        if (!keep_acc) {
#pragma unroll
        for (int a = 0; a < 2; ++a)
#pragma unroll
            for (int b = 0; b < 2; ++b)
#pragma unroll
                for (int m = 0; m < 4; ++m)
#pragma unroll
                    for (int n = 0; n < 2; ++n) acc[a][b][m][n] = acc_t{};
        }
        cur = nxt; cA = nA; cB = nB; ++ui;
        if constexpr (ALIGN_EPI) { if (wr == 1) PG8_BAR; }
    }
    PG8_WAIT_V(0);
    if constexpr (!ALIGN_EPI) { if (wr == 0) PG8_BAR; }
    PG8_BAR;
    if constexpr (Epi::AFTER_DRAIN) { E.fused(acc, cur, wr, wc, fr, fq, lds, wid, lane); S.done(cur); }
#undef PG8_SA
#undef PG8_SB
#undef PG8_STAGE
#undef PG8_LDA
#undef PG8_LDB
#undef PG8_MMA
#undef PG8_WAIT_V
#undef PG8_WAIT_L
#undef PG8_BAR
#undef PG8_SCHED
}
}
#define GAS __attribute__((address_space(1)))
#define LAS __attribute__((address_space(3)))
typedef unsigned short bf16;
typedef unsigned v4u __attribute__((ext_vector_type(4)));
typedef float f32x4 __attribute__((ext_vector_type(4)));
typedef short bf16x8 __attribute__((ext_vector_type(8)));
typedef GAS unsigned gu32;
typedef GAS unsigned long long gu64;
#define RLX_AGENT __ATOMIC_RELAXED, __HIP_MEMORY_SCOPE_AGENT
#define LDS_WAIT() asm volatile("s_waitcnt lgkmcnt(0)" ::: "memory")
#define VM_WAIT() asm volatile("s_waitcnt vmcnt(0)" ::: "memory")
__device__ __forceinline__ unsigned long long rt() { return __builtin_amdgcn_s_memrealtime(); }
__device__ __forceinline__ unsigned f2bf(float f) { unsigned u = __builtin_bit_cast(unsigned, f); return (u + 0x7fffu + ((u >> 16) & 1u)) >> 16; }
__device__ __forceinline__ unsigned pk2(float lo, float hi) { unsigned r; asm("v_cvt_pk_bf16_f32 %0, %1, %2" : "=v"(r) : "v"(lo), "v"(hi)); return r; }

#define XB_TMO      128
#define XB_XCNT(j)  (256  + 64 * (j))
#define XB_XSUB(j)  (1280 + 64 * (j))
#define XB_XGEN(j)  (2304 + 64 * (j))
#define XB_TOP      3328
#define XB_TOPGEN   3392
#define XCD_BAR_WORDS 3456
#define XB_SPIN_CAP (1u << 18)

__device__ __forceinline__ unsigned xb_ld(unsigned* p)              { return __hip_atomic_load(p, __ATOMIC_RELAXED, __HIP_MEMORY_SCOPE_AGENT); }
__device__ __forceinline__ unsigned xb_add(unsigned* p, unsigned v) { return __hip_atomic_fetch_add(p, v, __ATOMIC_RELAXED, __HIP_MEMORY_SCOPE_AGENT); }
__device__ __forceinline__ unsigned xb_xcc_id() { return (unsigned)__builtin_amdgcn_s_getreg((3 << 11) | 20) & 0xFu; }
#define XB_SPIN(cond, bar) do { unsigned _sp = 0; while (cond) { __builtin_amdgcn_s_sleep(1); \
    if ((++_sp & 255u) == 0u) { if (xb_ld(&(bar)[XB_TMO])) break; if (_sp > XB_SPIN_CAP) { atomicAdd(&(bar)[XB_TMO], 1u); break; } } } } while (0)

struct XcdBarrier {
    unsigned* bar; unsigned x;
    volatile LAS unsigned* st;
};

__device__ __forceinline__ XcdBarrier xcd_barrier_post(unsigned* bar, volatile LAS unsigned* st) {
    XcdBarrier b; b.bar = bar; b.x = xb_xcc_id(); b.st = st;
    if (threadIdx.x == 0) (void)xb_add(&bar[XB_XCNT(b.x)], 1u);
    return b;
}
__device__ __forceinline__ void xcd_barrier_complete(unsigned* bar, unsigned x, unsigned& nloc, unsigned& nx) {
    const unsigned G = gridDim.x * gridDim.y * gridDim.z;
    unsigned sum, cnt, mine, sp = 0u;
    for (;;) {
        sum = 0u; cnt = 0u; mine = 0u;
#pragma unroll
        for (unsigned j = 0; j < 16; ++j) { const unsigned c = xb_ld(&bar[XB_XCNT(j)]); sum += c; cnt += (c > 0u) ? 1u : 0u; mine = (j == x) ? c : mine; }
        if (sum == G) break;
        __builtin_amdgcn_s_sleep(1);
        if ((++sp & 255u) == 0u) { if (xb_ld(&bar[XB_TMO])) break; if (sp > XB_SPIN_CAP) { atomicAdd(&bar[XB_TMO], 1u); break; } }
    }
    nloc = mine > 0u ? mine : 1u; nx = cnt > 0u ? cnt : 1u;
}

__device__ __forceinline__ void xcd_barrier(const XcdBarrier& b) {
    asm volatile("s_waitcnt vmcnt(0)" ::: "memory");
    __syncthreads();
    if (threadIdx.x == 0) {
        unsigned* bar = b.bar;
        __builtin_amdgcn_s_waitcnt(0);
        unsigned nloc = b.st[0], nx = b.st[1];
        if (nloc == 0u) { xcd_barrier_complete(bar, b.x, nloc, nx); b.st[0] = nloc; b.st[1] = nx; }
        const unsigned old = xb_add(&bar[XB_XSUB(b.x)], 1u);
        const unsigned gen = old / nloc;
        if (old + 1u == (gen + 1u) * nloc) {
            __builtin_amdgcn_fence(__ATOMIC_RELEASE, "agent");
            asm volatile("s_waitcnt vmcnt(0)" ::: "memory");
            const unsigned og = xb_add(&bar[XB_TOP], 1u);
            const unsigned tg = og / nx;
            if (og + 1u == (tg + 1u) * nx) xb_add(&bar[XB_TOPGEN], 1u);
            else XB_SPIN(xb_ld(&bar[XB_TOPGEN]) == tg, bar);
            __builtin_amdgcn_fence(__ATOMIC_ACQUIRE, "agent");
            xb_add(&bar[XB_XGEN(b.x)], 1u);
            asm volatile("s_waitcnt vmcnt(0)" ::: "memory");
        } else {
            XB_SPIN(xb_ld(&bar[XB_XGEN(b.x)]) == gen, bar);
            __builtin_amdgcn_fence(__ATOMIC_ACQUIRE, "agent");
            asm volatile("s_waitcnt vmcnt(0)" ::: "memory");
        }
    }
    __syncthreads();
}

constexpr int NWAVES = 8, NTHREADS = 512;
constexpr int BATCH = 4, SEQ = 2048, D = 2048, M = BATCH * SEQ;
constexpr int NQH = 32, NKVH = 4, HD = 64, QPKV = 8, WINDOW = 128;
constexpr int Q_OFF = 0, K_OFF = 2048, V_OFF = 2304, CB_OFF = 2560, CC_OFF = 4608, CH_OFF = 6656, G_OFF = 8704, IN_W = 12800;
constexpr int PH = 8, PNK = 128, PTOPK = 16, PNE = 16384;
constexpr float LN_EPS = 1e-5f;
constexpr float ALPHA = 1.189207115002721f;

#ifndef MK_PER_PHASE
#define MK_PER_PHASE 0
#endif
constexpr int N_PHASES = 12;

constexpr size_t MiB = 1u << 20;
constexpr size_t WS_CTL = 0, CTL_ZERO_BYTES = 1 * MiB;
constexpr size_t WS_WIN = 1 * MiB;
constexpr size_t WS_WA = 51 * MiB, WS_WC = 59 * MiB, WS_WO = 67 * MiB, WS_WF = 75 * MiB;
constexpr size_t WS_XB = 83 * MiB;
constexpr size_t WS_MERGED = WS_XB;
constexpr size_t WS_Z = 115 * MiB;
constexpr size_t WS_R2B = 115 * MiB;
constexpr size_t WS_H1B = 179 * MiB;
constexpr size_t WS_SC = 211 * MiB;
constexpr size_t WS_EX = 275 * MiB;
constexpr size_t WS_GT = 279 * MiB;
constexpr size_t WS_AO = 315 * MiB, WS_CI = 347 * MiB, WS_TMP = 379 * MiB;
constexpr size_t WS_U8 = 411 * MiB, WS_V8 = 443 * MiB;
constexpr size_t WS_SU = 475 * MiB, WS_SV = WS_SU + 65536;
constexpr size_t WS_PA = WS_SC;
constexpr size_t WS_XQ = 283 * MiB;
constexpr size_t WS_SX = 299 * MiB;
constexpr size_t WS_WB = 380 * MiB;
constexpr size_t WS_ST = 379 * MiB;
constexpr size_t WS_XA8 = WS_XB;
constexpr size_t WS_WIN8 = 476 * MiB;
constexpr size_t WS_SWIN = 501 * MiB, WS_SXA = WS_SWIN + 65536;
constexpr size_t WS_AO8 = 1 * MiB, WS_CI8 = 17 * MiB, WS_WA8 = 33 * MiB, WS_WC8 = 37 * MiB, WS_S3 = 41 * MiB;
constexpr size_t WS_WF8 = 502 * MiB;
constexpr size_t WS_SWF = WS_SXA + 65536;
constexpr size_t WS_MG8 = 1 * MiB;
constexpr size_t WS_WO8 = 506 * MiB;
constexpr size_t WS_SMG = WS_S3 + 262144, WS_SWO = WS_SWF + 16384;
constexpr size_t WS_SEG = 315 * MiB, WS_SOFF = 323 * MiB;
constexpr size_t WS_V8T = 347 * MiB;
constexpr size_t WS_END = 510 * MiB;
constexpr int CW_Q = 12288;
constexpr size_t SLICE_BYTES = (size_t)PNE * 256;
constexpr int CW_BAR = 4096;

constexpr int RING_BYTES = 131072;
constexpr int LDSCTL_OFF = 163328, MISC_OFF = LDSCTL_OFF + 320;
constexpr int LDS_BYTES = LDSCTL_OFF + 512;

typedef float f32x16 __attribute__((ext_vector_type(16)));
typedef unsigned v2u __attribute__((ext_vector_type(2)));
__device__ __forceinline__ float wave_sum(float v) {
#pragma unroll
    for (int o = 1; o < 64; o <<= 1) v += __shfl_xor(v, o);
    return v;
}
__device__ __forceinline__ float vmaxf(float a, float b) { float r; asm("v_max_f32_e32 %0, %1, %2" : "=v"(r) : "v"(a), "v"(b)); return r; }
__device__ __forceinline__ float vminf(float a, float b) { float r; asm("v_min_f32_e32 %0, %1, %2" : "=v"(r) : "v"(a), "v"(b)); return r; }

template <bool REMAP = false> __device__ __forceinline__ void p0_transpose_item(const float* W, int K, int N, bf16* WT, LAS float* scr, int item, int lane) {
    const int nblk = N / 32, kb = item / nblk, nb = item % nblk, k0 = 64 * kb, n0 = 32 * nb;
    int n0w = n0;
    if (REMAP) { if (n0 >= CC_OFF && n0 < CH_OFF) { const int c = n0 - CC_OFF; n0w = CC_OFF + 256 * (c >> 7) + (c & 127); } else if (n0 >= CH_OFF && n0 < G_OFF) { const int c = n0 - CH_OFF; n0w = CC_OFF + 256 * (c >> 7) + 128 + (c & 127); } }
#pragma unroll 8
    for (int i = 0; i < 32; ++i) { const int kk = 2 * i + (lane >> 5); scr[kk * 33 + (lane & 31)] = W[(size_t)(k0 + kk) * N + n0 + (lane & 31)]; }
    LDS_WAIT(); asm volatile("" ::: "memory");
    const int c = lane & 7;
#pragma unroll
    for (int j = 0; j < 4; ++j) { const int n = (lane >> 3) + 8 * j; const LAS float* s = scr + (8 * c) * 33 + n;
        v4u o; o.x = pk2(s[0 * 33], s[1 * 33]); o.y = pk2(s[2 * 33], s[3 * 33]); o.z = pk2(s[4 * 33], s[5 * 33]); o.w = pk2(s[6 * 33], s[7 * 33]);
        *(GAS v4u*)(WT + (size_t)(n0w + n) * K + k0 + 8 * c) = o; }
    LDS_WAIT(); asm volatile("" ::: "memory");
}
__device__ __forceinline__ void p0_wf_item(const float* wq, const float* sk, bf16* WfT, LAS unsigned char* lds, int item, int tid) {
    const int hp = item >> 5, dt = item & 31;
    LAS f32x4* SK4 = (LAS f32x4*)lds;
    LAS f32x4* WQ4 = SK4 + 128 * 33;
    const float* skp = sk + (size_t)hp * 128 * 128;
    for (int i = tid; i < 128 * 32; i += NTHREADS) { const int n = i >> 5, c4 = i & 31; SK4[n * 33 + c4] = *(const f32x4*)(skp + n * 128 + 4 * c4); }
    for (int i = tid; i < 64 * 32; i += NTHREADS) { const int r = i >> 5, c4 = i & 31; WQ4[r * 33 + c4] = *(const f32x4*)(wq + (size_t)(64 * dt + r) * 2048 + hp * 128 + 4 * c4); }
    __syncthreads();
    const int td = tid & 15, tn = tid >> 4;
    float acc[4][4];
#pragma unroll
    for (int i = 0; i < 4; ++i)
#pragma unroll
        for (int j = 0; j < 4; ++j) acc[i][j] = 0.f;
#pragma unroll 4
    for (int c4 = 0; c4 < 32; ++c4) {
        f32x4 a[4], b[4];
#pragma unroll
        for (int i = 0; i < 4; ++i) a[i] = SK4[(4 * tn + i) * 33 + c4];
#pragma unroll
        for (int j = 0; j < 4; ++j) b[j] = WQ4[(td + 16 * j) * 33 + c4];
#pragma unroll
        for (int i = 0; i < 4; ++i)
#pragma unroll
            for (int j = 0; j < 4; ++j) acc[i][j] += a[i].x * b[j].x + a[i].y * b[j].y + a[i].z * b[j].z + a[i].w * b[j].w;
    }
#pragma unroll
    for (int i = 0; i < 4; ++i)
#pragma unroll
        for (int j = 0; j < 4; ++j) WfT[(size_t)(hp * 128 + 4 * tn + i) * 2048 + 64 * dt + td + 16 * j] = (bf16)f2bf(acc[i][j]);
    __syncthreads();
}

__device__ __forceinline__ int perm16(int o) { return 8 * ((o >> 2) & 1) + 4 * (o >> 3) + (o & 3); }
__device__ __forceinline__ void attn_unit(int unit, const bf16* z, bf16* ao, const float* sinks, LAS unsigned char* lds, int tid) {
    const int lane = tid & 63, wid = __builtin_amdgcn_readfirstlane(tid >> 6), r32 = lane & 31, hi = lane >> 5;
    const int nb = unit & 15, kvh = (unit >> 4) & 3, b = unit >> 6;
    LAS bf16* Ks = (LAS bf16*)lds;
    LAS bf16* Vt = (LAS bf16*)(lds + 256 * 144);
    const size_t tok0 = (size_t)b * SEQ;
#pragma unroll
    for (int i = 0; i < 4; ++i) {
        const int ci = tid + NTHREADS * i, key = ci >> 3, dc = ci & 7;
        int kpos = 128 * (nb - 1) + key; if (kpos < 0) kpos = 0;
        const bf16* src = z + (tok0 + kpos) * IN_W + K_OFF + kvh * HD + dc * 8;
        const v4u kv = *(const GAS v4u*)src, vv = *(const GAS v4u*)(src + (V_OFF - K_OFF));
        *(LAS v4u*)(Ks + key * 72 + dc * 8) = kv;
        const int pos = (key & ~15) + perm16(key & 15);
        LAS bf16* vp = Vt + (dc * 8) * 264 + pos;
        vp[0 * 264] = (bf16)(vv.x & 0xffffu); vp[1 * 264] = (bf16)(vv.x >> 16); vp[2 * 264] = (bf16)(vv.y & 0xffffu); vp[3 * 264] = (bf16)(vv.y >> 16);
        vp[4 * 264] = (bf16)(vv.z & 0xffffu); vp[5 * 264] = (bf16)(vv.z >> 16); vp[6 * 264] = (bf16)(vv.w & 0xffffu); vp[7 * 264] = (bf16)(vv.w >> 16);
    }
    __syncthreads();
    const int hq = kvh * QPKV + wid;
    const float LOG2E = 1.4426950408889634f;
    const float sink2 = sinks[hq] * LOG2E, sc = 0.125f * LOG2E;
#pragma unroll 1
    for (int qg = 0; qg < 4; ++qg) {
        const size_t tok = tok0 + 128 * nb + 32 * qg + r32;
        bf16x8 qf[4];
#pragma unroll
        for (int ks = 0; ks < 4; ++ks) qf[ks] = *(const GAS bf16x8*)(z + tok * IN_W + Q_OFF + hq * HD + 16 * ks + 8 * hi);
        f32x16 s[5];
#pragma unroll
        for (int kt = 0; kt < 5; ++kt) {
            s[kt] = (f32x16){0.f, 0.f, 0.f, 0.f, 0.f, 0.f, 0.f, 0.f, 0.f, 0.f, 0.f, 0.f, 0.f, 0.f, 0.f, 0.f};
#pragma unroll
            for (int ks = 0; ks < 4; ++ks) {
                const bf16x8 kf = *(const LAS bf16x8*)(Ks + (32 * (qg + kt) + r32) * 72 + 16 * ks + 8 * hi);
                s[kt] = __builtin_amdgcn_mfma_f32_32x32x16_bf16(kf, qf[ks], s[kt], 0, 0, 0);
            }
        }
        float mx = sink2;
#pragma unroll
        for (int kt = 0; kt < 5; ++kt) {
            const bool tile_dead = (nb == 0) && (qg + kt < 4);
#pragma unroll
            for (int r = 0; r < 16; ++r) {
                const int krow = (r & 3) + 8 * (r >> 2) + 4 * hi;
                bool valid = !tile_dead;
                if (kt == 0) valid = valid && (krow > r32);
                if (kt == 4) valid = valid && (krow <= r32);
                const float v = valid ? s[kt][r] * sc : -INFINITY;
                s[kt][r] = v; mx = fmaxf(mx, v);
            }
        }
        mx = fmaxf(mx, __shfl_xor(mx, 32));
        float sum = 0.f;
#pragma unroll
        for (int kt = 0; kt < 5; ++kt)
#pragma unroll
            for (int r = 0; r < 16; ++r) { const float p = __builtin_amdgcn_exp2f(s[kt][r] - mx); s[kt][r] = p; sum += p; }
        sum += __shfl_xor(sum, 32);
        const float inv = 1.0f / (sum + __builtin_amdgcn_exp2f(sink2 - mx));
        f32x16 o[2];
        o[0] = (f32x16){0.f, 0.f, 0.f, 0.f, 0.f, 0.f, 0.f, 0.f, 0.f, 0.f, 0.f, 0.f, 0.f, 0.f, 0.f, 0.f}; o[1] = o[0];
#pragma unroll
        for (int kt = 0; kt < 5; ++kt)
#pragma unroll
            for (int s2 = 0; s2 < 2; ++s2) {
                v4u pw; pw.x = pg8::cvt_pk_bf16(s[kt][8 * s2 + 0], s[kt][8 * s2 + 1]); pw.y = pg8::cvt_pk_bf16(s[kt][8 * s2 + 2], s[kt][8 * s2 + 3]);
                pw.z = pg8::cvt_pk_bf16(s[kt][8 * s2 + 4], s[kt][8 * s2 + 5]); pw.w = pg8::cvt_pk_bf16(s[kt][8 * s2 + 6], s[kt][8 * s2 + 7]);
                const bf16x8 pa = __builtin_bit_cast(bf16x8, pw);
#pragma unroll
                for (int dt = 0; dt < 2; ++dt) {
                    const bf16x8 vf = *(const LAS bf16x8*)(Vt + (32 * dt + r32) * 264 + 32 * (qg + kt) + 16 * s2 + 8 * hi);
                    o[dt] = __builtin_amdgcn_mfma_f32_32x32x16_bf16(vf, pa, o[dt], 0, 0, 0);
                }
            }
        LAS unsigned char* og = lds + 256 * 144 + 64 * 528 + wid * 4608;
#pragma unroll
        for (int dt = 0; dt < 2; ++dt)
#pragma unroll
            for (int g = 0; g < 4; ++g) {
                v2u w; w.x = pg8::cvt_pk_bf16(o[dt][4 * g + 0] * inv, o[dt][4 * g + 1] * inv); w.y = pg8::cvt_pk_bf16(o[dt][4 * g + 2] * inv, o[dt][4 * g + 3] * inv);
                *(LAS v2u*)(og + r32 * 144 + (32 * dt + 8 * g + 4 * hi) * 2) = w;
            }
#pragma unroll
        for (int q4 = 0; q4 < 4; ++q4) { const int pc = lane + 64 * q4, row = pc >> 3, cch = pc & 7;
            const v4u w = *(const LAS v4u*)(og + row * 144 + cch * 16);
            *(GAS v4u*)(ao + (tok0 + 128 * nb + 32 * qg + row) * D + hq * HD + 8 * cch) = w; }
    }
    __syncthreads();
}
__device__ __forceinline__ void conv_item(int item, const bf16* z, const float* cw, bf16* ci, int tid) {
    const int c8 = tid & 255, half = tid >> 8, t0 = 32 * item + 16 * half, c0 = 8 * c8;
    float w0[8], w1[8], w2[8], u1[8], u2[8];
#pragma unroll
    for (int e = 0; e < 8; ++e) { w0[e] = cw[c0 + e]; w1[e] = cw[2048 + c0 + e]; w2[e] = cw[4096 + c0 + e]; u1[e] = 0.f; u2[e] = 0.f; }
    if ((t0 & (SEQ - 1)) != 0) {
#pragma unroll
        for (int k = 0; k < 2; ++k) {
            const bf16* zr = z + (size_t)(t0 - 2 + k) * IN_W + c0;
            const v4u a = *(const GAS v4u*)(zr + CC_OFF);
            float u[8];
            u[0] = pg8::bf_lo(a.x); u[1] = pg8::bf_hi(a.x); u[2] = pg8::bf_lo(a.y); u[3] = pg8::bf_hi(a.y); u[4] = pg8::bf_lo(a.z); u[5] = pg8::bf_hi(a.z); u[6] = pg8::bf_lo(a.w); u[7] = pg8::bf_hi(a.w);
#pragma unroll
            for (int e = 0; e < 8; ++e) { if (k == 0) u2[e] = u[e]; else u1[e] = u[e]; }
        }
    }
#pragma unroll 4
    for (int i = 0; i < 16; ++i) {
        const bf16* zr = z + (size_t)(t0 + i) * IN_W + c0;
        const v4u a = *(const GAS v4u*)(zr + CC_OFF), bb = *(const GAS v4u*)(zr + CB_OFF);
        float u[8], cb[8], y[8];
        u[0] = pg8::bf_lo(a.x); u[1] = pg8::bf_hi(a.x); u[2] = pg8::bf_lo(a.y); u[3] = pg8::bf_hi(a.y); u[4] = pg8::bf_lo(a.z); u[5] = pg8::bf_hi(a.z); u[6] = pg8::bf_lo(a.w); u[7] = pg8::bf_hi(a.w);
        cb[0] = pg8::bf_lo(bb.x); cb[1] = pg8::bf_hi(bb.x); cb[2] = pg8::bf_lo(bb.y); cb[3] = pg8::bf_hi(bb.y); cb[4] = pg8::bf_lo(bb.z); cb[5] = pg8::bf_hi(bb.z); cb[6] = pg8::bf_lo(bb.w); cb[7] = pg8::bf_hi(bb.w);
#pragma unroll
        for (int e = 0; e < 8; ++e) { y[e] = cb[e] * (w0[e] * u2[e] + w1[e] * u1[e] + w2[e] * u[e]); u2[e] = u1[e]; u1[e] = u[e]; }
        v4u o; o.x = pk2(y[0], y[1]); o.y = pk2(y[2], y[3]); o.z = pk2(y[4], y[5]); o.w = pk2(y[6], y[7]);
        *(GAS v4u*)(ci + (size_t)(t0 + i) * D + c0) = o;
    }
}

__device__ __forceinline__ unsigned pack_i8(const f32x4 v) {
    const int a = __float2int_rn(v.x), b = __float2int_rn(v.y), c = __float2int_rn(v.z), d = __float2int_rn(v.w);
    return ((unsigned)a & 0xffu) | (((unsigned)b & 0xffu) << 8) | (((unsigned)c & 0xffu) << 16) | ((unsigned)d << 24);
}
__device__ __forceinline__ unsigned pack_i8_2(float a, float b, float c, float d) {
    const int ia = __float2int_rn(a), ib = __float2int_rn(b), ic = __float2int_rn(c), id = __float2int_rn(d);
    return ((unsigned)ia & 0xffu) | (((unsigned)ib & 0xffu) << 8) | (((unsigned)ic & 0xffu) << 16) | ((unsigned)id << 24);
}
__device__ __forceinline__ void ln1_row(bf16* hbrow, signed char* xqrow, float* sxp, const float* g, const float* bta, int lane) {
    GAS v4u* xr = (GAS v4u*)hbrow + lane;
    float v[4][8]; float s = 0.f;
#pragma unroll
    for (int j = 0; j < 4; ++j) { const v4u w = xr[64 * j];
        v[j][0] = pg8::bf_lo(w.x); v[j][1] = pg8::bf_hi(w.x); v[j][2] = pg8::bf_lo(w.y); v[j][3] = pg8::bf_hi(w.y); v[j][4] = pg8::bf_lo(w.z); v[j][5] = pg8::bf_hi(w.z); v[j][6] = pg8::bf_lo(w.w); v[j][7] = pg8::bf_hi(w.w);
#pragma unroll
        for (int e = 0; e < 8; ++e) s += v[j][e]; }
    const float mean = wave_sum(s) * (1.f / D); float s2 = 0.f;
#pragma unroll
    for (int j = 0; j < 4; ++j)
#pragma unroll
        for (int e = 0; e < 8; ++e) { v[j][e] -= mean; s2 += v[j][e] * v[j][e]; }
    const float rstd = 1.f / sqrtf(wave_sum(s2) * (1.f / D) + LN_EPS);
    float mx = 0.f;
#pragma unroll
    for (int j = 0; j < 4; ++j) {
        const GAS f32x4* gp = (const GAS f32x4*)g + 2 * (lane + 64 * j); const GAS f32x4* bp = (const GAS f32x4*)bta + 2 * (lane + 64 * j);
        const f32x4 g0 = gp[0], g1 = gp[1], b0 = bp[0], b1 = bp[1];
        v[j][0] = v[j][0] * rstd * g0.x + b0.x; v[j][1] = v[j][1] * rstd * g0.y + b0.y; v[j][2] = v[j][2] * rstd * g0.z + b0.z; v[j][3] = v[j][3] * rstd * g0.w + b0.w;
        v[j][4] = v[j][4] * rstd * g1.x + b1.x; v[j][5] = v[j][5] * rstd * g1.y + b1.y; v[j][6] = v[j][6] * rstd * g1.z + b1.z; v[j][7] = v[j][7] * rstd * g1.w + b1.w;
        v4u o; o.x = pk2(v[j][0], v[j][1]); o.y = pk2(v[j][2], v[j][3]); o.z = pk2(v[j][4], v[j][5]); o.w = pk2(v[j][6], v[j][7]);
        xr[64 * j] = o;
#pragma unroll
        for (int e = 0; e < 8; ++e) mx = fmaxf(mx, fabsf(v[j][e]));
    }
#pragma unroll
    for (int o = 1; o < 64; o <<= 1) mx = fmaxf(mx, __shfl_xor(mx, o));
    const float qs = mx > 0.f ? 127.0f / mx : 1.0f;
    GAS v2u* q8 = (GAS v2u*)xqrow + lane;
#pragma unroll
    for (int j = 0; j < 4; ++j) { v2u o; o.x = pack_i8_2(v[j][0] * qs, v[j][1] * qs, v[j][2] * qs, v[j][3] * qs); o.y = pack_i8_2(v[j][4] * qs, v[j][5] * qs, v[j][6] * qs, v[j][7] * qs); q8[64 * j] = o; }
    if (lane == 0) *sxp = mx > 0.f ? mx * (1.0f / 127.0f) : 1.0f;
}
__device__ __forceinline__ void ln1_row_h(bf16* hbrow, signed char* xqrow, float* sxp, const f32x4 (&G0)[4], const f32x4 (&G1)[4], const f32x4 (&B0)[4], const f32x4 (&B1)[4], int lane) {
    GAS v4u* xr = (GAS v4u*)hbrow + lane;
    float v[4][8]; float s = 0.f;
#pragma unroll
    for (int j = 0; j < 4; ++j) { const v4u w = xr[64 * j];
        v[j][0] = pg8::bf_lo(w.x); v[j][1] = pg8::bf_hi(w.x); v[j][2] = pg8::bf_lo(w.y); v[j][3] = pg8::bf_hi(w.y); v[j][4] = pg8::bf_lo(w.z); v[j][5] = pg8::bf_hi(w.z); v[j][6] = pg8::bf_lo(w.w); v[j][7] = pg8::bf_hi(w.w);
#pragma unroll
        for (int e = 0; e < 8; ++e) s += v[j][e]; }
    const float mean = wave_sum(s) * (1.f / D); float s2 = 0.f;
#pragma unroll
    for (int j = 0; j < 4; ++j)
#pragma unroll
        for (int e = 0; e < 8; ++e) { v[j][e] -= mean; s2 += v[j][e] * v[j][e]; }
    const float rstd = 1.f / sqrtf(wave_sum(s2) * (1.f / D) + LN_EPS);
    float mx = 0.f;
#pragma unroll
    for (int j = 0; j < 4; ++j) {
        const f32x4 g0 = G0[j], g1 = G1[j], b0 = B0[j], b1 = B1[j];
        v[j][0] = v[j][0] * rstd * g0.x + b0.x; v[j][1] = v[j][1] * rstd * g0.y + b0.y; v[j][2] = v[j][2] * rstd * g0.z + b0.z; v[j][3] = v[j][3] * rstd * g0.w + b0.w;
        v[j][4] = v[j][4] * rstd * g1.x + b1.x; v[j][5] = v[j][5] * rstd * g1.y + b1.y; v[j][6] = v[j][6] * rstd * g1.z + b1.z; v[j][7] = v[j][7] * rstd * g1.w + b1.w;
        v4u o; o.x = pk2(v[j][0], v[j][1]); o.y = pk2(v[j][2], v[j][3]); o.z = pk2(v[j][4], v[j][5]); o.w = pk2(v[j][6], v[j][7]);
        xr[64 * j] = o;
#pragma unroll
        for (int e = 0; e < 8; ++e) mx = fmaxf(mx, fabsf(v[j][e]));
    }
#pragma unroll
    for (int o = 1; o < 64; o <<= 1) mx = fmaxf(mx, __shfl_xor(mx, o));
    const float qs = mx > 0.f ? 127.0f / mx : 1.0f;
    GAS v2u* q8 = (GAS v2u*)xqrow + lane;
#pragma unroll
    for (int j = 0; j < 4; ++j) { v2u o; o.x = pack_i8_2(v[j][0] * qs, v[j][1] * qs, v[j][2] * qs, v[j][3] * qs); o.y = pack_i8_2(v[j][4] * qs, v[j][5] * qs, v[j][6] * qs, v[j][7] * qs); q8[64 * j] = o; }
    if (lane == 0) *sxp = mx > 0.f ? mx * (1.0f / 127.0f) : 1.0f;
}

__device__ __forceinline__ void row_f32_to_i8(const float* src, signed char* dst, float* inv, int lane) {
    f32x4 v[8]; float mx = 0.f;
#pragma unroll
    for (int j = 0; j < 8; ++j) { v[j] = *((const GAS f32x4*)src + lane + 64 * j); mx = fmaxf(mx, fmaxf(fmaxf(fabsf(v[j].x), fabsf(v[j].y)), fmaxf(fabsf(v[j].z), fabsf(v[j].w)))); }
#pragma unroll
    for (int o = 1; o < 64; o <<= 1) mx = fmaxf(mx, __shfl_xor(mx, o));
    const float sc = mx > 0.f ? 127.0f / mx : 1.0f;
#pragma unroll
    for (int j = 0; j < 8; ++j) *((GAS unsigned*)dst + lane + 64 * j) = pack_i8_2(v[j].x * sc, v[j].y * sc, v[j].z * sc, v[j].w * sc);
    if (lane == 0) *inv = mx > 0.f ? mx * (1.0f / 127.0f) : 1.0f;
}
__device__ __forceinline__ void row_bf16_to_i8(const bf16* src, signed char* dst, float* inv, int lane) {
    float v[4][8]; float mx = 0.f;
#pragma unroll
    for (int j = 0; j < 4; ++j) { const v4u w = *((const GAS v4u*)src + lane + 64 * j);
        v[j][0] = pg8::bf_lo(w.x); v[j][1] = pg8::bf_hi(w.x); v[j][2] = pg8::bf_lo(w.y); v[j][3] = pg8::bf_hi(w.y); v[j][4] = pg8::bf_lo(w.z); v[j][5] = pg8::bf_hi(w.z); v[j][6] = pg8::bf_lo(w.w); v[j][7] = pg8::bf_hi(w.w);
#pragma unroll
        for (int e = 0; e < 8; ++e) mx = fmaxf(mx, fabsf(v[j][e])); }
#pragma unroll
    for (int o = 1; o < 64; o <<= 1) mx = fmaxf(mx, __shfl_xor(mx, o));
    const float sc = mx > 0.f ? 127.0f / mx : 1.0f;
#pragma unroll
    for (int j = 0; j < 4; ++j) { v2u o; o.x = pack_i8_2(v[j][0] * sc, v[j][1] * sc, v[j][2] * sc, v[j][3] * sc); o.y = pack_i8_2(v[j][4] * sc, v[j][5] * sc, v[j][6] * sc, v[j][7] * sc); *((GAS v2u*)dst + lane + 64 * j) = o; }
    if (lane == 0) *inv = mx > 0.f ? mx * (1.0f / 127.0f) : 1.0f;
}

constexpr int TK_ROWF = 136;
constexpr int TK_IDX_OFF = 256 * TK_ROWF * 4;
__device__ __forceinline__ void topk_core(LAS unsigned char* lds, size_t prob0, int pstride, int* experts, float* gates, int tid) {
    LAS float* S = (LAS float*)lds;
    LAS unsigned char* IDX = lds + TK_IDX_OFF;
    const int row = tid >> 1, sub = tid & 1;
#define TK_CE(a, b) do { const float h_ = vmaxf(a, b), l_ = vminf(a, b); a = h_; b = l_; } while (0)
#define TK_SORT16(V) do { _Pragma("unroll") for (int k_ = 2; k_ <= 16; k_ <<= 1) _Pragma("unroll") for (int j_ = k_ >> 1; j_ > 0; j_ >>= 1) _Pragma("unroll") for (int i_ = 0; i_ < 16; ++i_) { \
        const int l_i = i_ ^ j_; if (l_i > i_) { if ((i_ & k_) == 0) TK_CE(V[i_], V[l_i]); else TK_CE(V[l_i], V[i_]); } } } while (0)
#define TK_MERGE16(Lv, Xv) do { _Pragma("unroll") for (int j_ = 0; j_ < 16; ++j_) Lv[j_] = vmaxf(Lv[j_], Xv[15 - j_]); \
        _Pragma("unroll") for (int st_ = 8; st_ >= 1; st_ >>= 1) _Pragma("unroll") for (int j_ = 0; j_ < 16; ++j_) if ((j_ & st_) == 0) TK_CE(Lv[j_], Lv[j_ + st_]); } while (0)
    float L[16];
#pragma unroll
    for (int q = 0; q < 4; ++q) {
        float C[16];
#pragma unroll
        for (int i = 0; i < 4; ++i) { const int c4 = 2 * (4 * q + i) + sub;
            const f32x4 v = *(const LAS f32x4*)(S + row * TK_ROWF + 4 * c4);
#pragma unroll
            for (int e = 0; e < 4; ++e) { const float ve = v[e];
                C[4 * i + e] = __uint_as_float((__float_as_uint(ve) & ~0x7Fu) | (unsigned)(4 * c4 + e)); } }
        TK_SORT16(C);
        if (q == 0) {
#pragma unroll
            for (int j = 0; j < 16; ++j) L[j] = C[j];
        } else TK_MERGE16(L, C);
    }
    {
        float P[16];
#pragma unroll
        for (int j = 0; j < 16; ++j) P[j] = __shfl_xor(L[j], 1);
        TK_MERGE16(L, P);
    }
    if (sub == 0) {
#pragma unroll
        for (int q = 0; q < 4; ++q) {
            unsigned w = 0;
#pragma unroll
            for (int e = 0; e < 4; ++e) w |= (__builtin_bit_cast(unsigned, L[4 * q + e]) & 0x7Fu) << (8 * e);
            *(LAS unsigned*)(IDX + row * 16 + 4 * q) = w;
        }
    }
    float A[16], B[16];
#pragma unroll
    for (int j = 0; j < 16; ++j) { const float o = __shfl_xor(L[j], 2); const bool isb = (tid & 2) != 0; A[j] = isb ? o : L[j]; B[j] = isb ? L[j] : o; }
#define TK_KEY(i, j) __uint_as_float((__float_as_uint(A[i] + B[j]) & ~0xFFu) | (unsigned)(255 - ((i) * 16 + (j))))
    float F[16], X[16];
#pragma unroll
    for (int j = 0; j < 16; ++j) F[j] = TK_KEY(0, j);
#pragma unroll
    for (int i = 1; i < 16; ++i) X[i - 1] = TK_KEY(i, 0);
    X[15] = -INFINITY; TK_MERGE16(F, X);
#pragma unroll
    for (int i = 0; i < 16; ++i) X[i] = -INFINITY;
#pragma unroll
    for (int i = 1; i <= 7; ++i) X[i - 1] = TK_KEY(i, 1);
    TK_MERGE16(F, X);
#pragma unroll
    for (int i = 0; i < 16; ++i) X[i] = -INFINITY;
#pragma unroll
    for (int j = 2; j <= 7; ++j) X[j - 2] = TK_KEY(1, j);
    TK_MERGE16(F, X);
    { const float rest[6] = {TK_KEY(2, 2), TK_KEY(2, 3), TK_KEY(2, 4), TK_KEY(3, 2), TK_KEY(3, 3), TK_KEY(4, 2)};
#pragma unroll
      for (int r = 0; r < 6; ++r) { float x = rest[r];
#pragma unroll
          for (int k = 0; k < 16; ++k) { const float h = vmaxf(F[k], x); x = vminf(F[k], x); F[k] = h; } } }
    __syncthreads();
    if ((tid & 3) == 0) {
        const int rowA = (tid >> 2) * 2, rowB = rowA + 1;
        const size_t prob = prob0 + (size_t)pstride * (tid >> 2);
        float g[16]; int ex[16]; float gs = 0.f;
#pragma unroll
        for (int k = 0; k < 16; ++k) {
            const unsigned code = 255u - (__builtin_bit_cast(unsigned, F[k]) & 0xFFu);
            const int ia = IDX[rowA * 16 + (code >> 4)], ib = IDX[rowB * 16 + (code & 15)];
            ex[k] = ia * PNK + ib;
            g[k] = __expf(F[k] - F[0]); gs += g[k];
        }
        const float ginv = 1.0f / gs;
#pragma unroll
        for (int q = 0; q < 4; ++q) {
            *(GAS f32x4*)(gates + prob * 16 + 4 * q) = (f32x4){g[4 * q] * ginv, g[4 * q + 1] * ginv, g[4 * q + 2] * ginv, g[4 * q + 3] * ginv};
            typedef int i32x4 __attribute__((ext_vector_type(4)));
            *(GAS i32x4*)(experts + prob * 16 + 4 * q) = (i32x4){ex[4 * q], ex[4 * q + 1], ex[4 * q + 2], ex[4 * q + 3]};
        }
    }
    __syncthreads();
}
__device__ __forceinline__ void topk_pass(int pass, const float* scores, int* experts, float* gates, LAS unsigned char* lds, int tid) {
    LAS float* S = (LAS float*)lds;
    const float* src = scores + (size_t)pass * (256 * 128);
#pragma unroll 4
    for (int i = 0; i < 16; ++i) { const int f4 = tid + NTHREADS * i, row = f4 >> 5, c4 = f4 & 31; *(LAS f32x4*)(S + row * TK_ROWF + 4 * c4) = *(const GAS f32x4*)(src + (size_t)f4 * 4); }
    __syncthreads();
    topk_core(lds, (size_t)pass * 128, 1, experts, gates, tid);
}
struct EpiTopKI8 {
    static constexpr bool PERM = false, AFTER_DRAIN = true;
    int* experts; float* gates; const float* sa; const float* sb;
    __device__ __forceinline__ void fused(pg8::i32x4 (&acc)[2][2][4][2], const pg8::Unit& u, int wr, int wc, int fr, int fq, LAS unsigned char* lds, int wid, int lane) const {
        LAS float* S = (LAS float*)lds;
        const int tid = wid * 64 + lane;
        pg8::f32x4 sbv[2][2];
#pragma unroll
        for (int bj = 0; bj < 2; ++bj)
#pragma unroll
            for (int n = 0; n < 2; ++n) sbv[bj][n] = *(const GAS pg8::f32x4*)(sb + u.pn * 256 + bj * 128 + 32 * wc + 16 * n + 4 * fq);
        float srv[2][4];
#pragma unroll
        for (int ai = 0; ai < 2; ++ai)
#pragma unroll
            for (int mm = 0; mm < 4; ++mm) srv[ai][mm] = sa[u.pm * 256 + 128 * ai + 64 * wr + 16 * mm + fr];
#pragma unroll
        for (int ai = 0; ai < 2; ++ai) {
#pragma unroll
            for (int mm = 0; mm < 4; ++mm) { const int rl = 64 * wr + 16 * mm + fr; const float sr = srv[ai][mm];
#pragma unroll
                for (int bj = 0; bj < 2; ++bj)
#pragma unroll
                    for (int n = 0; n < 2; ++n) { const pg8::i32x4 a = acc[ai][bj][mm][n];
                        *(LAS pg8::f32x4*)(S + (2 * rl + bj) * TK_ROWF + 32 * wc + 16 * n + 4 * fq) = (pg8::f32x4){(float)a[0], (float)a[1], (float)a[2], (float)a[3]} * sbv[bj][n] * sr; } }
            __syncthreads();
            topk_core(lds, ((size_t)u.pm * 256 + 128 * ai) * PH + u.pn, PH, experts, gates, tid);
        }
    }
};
struct EpiTopK {
    static constexpr bool PERM = false, AFTER_DRAIN = true;
    int* experts; float* gates;
    __device__ __forceinline__ void fused(pg8::f32x4 (&acc)[2][2][4][2], const pg8::Unit& u, int wr, int wc, int fr, int fq, LAS unsigned char* lds, int wid, int lane) const {
        LAS float* S = (LAS float*)lds;
        const int tid = wid * 64 + lane;
#pragma unroll
        for (int ai = 0; ai < 2; ++ai) {
#pragma unroll
            for (int bj = 0; bj < 2; ++bj)
#pragma unroll
                for (int mm = 0; mm < 4; ++mm)
#pragma unroll
                    for (int n = 0; n < 2; ++n) { const int rl = 64 * wr + 16 * mm + fr; *(LAS pg8::f32x4*)(S + (2 * rl + bj) * TK_ROWF + 32 * wc + 16 * n + 4 * fq) = acc[ai][bj][mm][n]; }
            __syncthreads();
            topk_core(lds, ((size_t)u.pm * 256 + 128 * ai) * PH + u.pn, PH, experts, gates, tid);
        }
    }
};

__device__ __forceinline__ float gelu_erf(float v) { return 0.5f * v * (1.0f + erff(v * 0.70710678118654752f)); }
typedef __bf16 bf16x2_t __attribute__((ext_vector_type(2)));
typedef float f32x2_t __attribute__((ext_vector_type(2)));
__device__ __forceinline__ float dot2bf(bf16x2_t a, unsigned b, float acc) { return __builtin_amdgcn_fdot2_f32_bf16(a, __builtin_bit_cast(bf16x2_t, b), acc, false); }
__device__ __forceinline__ float dot4f8(unsigned w8, unsigned x01, unsigned x23, float acc) {
    acc = dot2bf(__builtin_amdgcn_cvt_scalef32_pk_bf16_fp8(w8, 1.0f, false), x01, acc);
    return dot2bf(__builtin_amdgcn_cvt_scalef32_pk_bf16_fp8(w8, 1.0f, true), x23, acc);
}
__device__ __forceinline__ void axpy4f8(float* y, unsigned w8, float w) {
    const f32x2_t lo = __builtin_amdgcn_cvt_pk_f32_fp8(w8, false), hi = __builtin_amdgcn_cvt_pk_f32_fp8(w8, true);
    y[0] += w * lo.x; y[1] += w * lo.y; y[2] += w * hi.x; y[3] += w * hi.y;
}
__device__ __forceinline__ void axpy4f8v(f32x2_t* y2, unsigned w8, float w) {
    const f32x2_t lo = __builtin_amdgcn_cvt_pk_f32_fp8(w8, false), hi = __builtin_amdgcn_cvt_pk_f32_fp8(w8, true);
    const f32x2_t ww = {w, w};
    y2[0] = __builtin_elementwise_fma(lo, ww, y2[0]); y2[1] = __builtin_elementwise_fma(hi, ww, y2[1]);
}
__device__ __forceinline__ void row_to_fp8(const float* src, unsigned char* dst, float* inv, int lane) {
    f32x4 v[2][4]; float mx = 0.f;
#pragma unroll
    for (int j = 0; j < 2; ++j)
#pragma unroll
        for (int q = 0; q < 4; ++q) { v[j][q] = *((const GAS f32x4*)src + 4 * (lane + 64 * j) + q);
            mx = fmaxf(mx, fmaxf(fmaxf(fabsf(v[j][q].x), fabsf(v[j][q].y)), fmaxf(fabsf(v[j][q].z), fabsf(v[j][q].w)))); }
#pragma unroll
    for (int o = 1; o < 64; o <<= 1) mx = fmaxf(mx, __shfl_xor(mx, o));
    const float sc = mx > 0.f ? 384.0f / mx : 1.0f;
#pragma unroll
    for (int j = 0; j < 2; ++j) { v4u o;
        int w;
        w = 0; w = __builtin_amdgcn_cvt_pk_fp8_f32(v[j][0].x * sc, v[j][0].y * sc, w, false); w = __builtin_amdgcn_cvt_pk_fp8_f32(v[j][0].z * sc, v[j][0].w * sc, w, true); o.x = (unsigned)w;
        w = 0; w = __builtin_amdgcn_cvt_pk_fp8_f32(v[j][1].x * sc, v[j][1].y * sc, w, false); w = __builtin_amdgcn_cvt_pk_fp8_f32(v[j][1].z * sc, v[j][1].w * sc, w, true); o.y = (unsigned)w;
        w = 0; w = __builtin_amdgcn_cvt_pk_fp8_f32(v[j][2].x * sc, v[j][2].y * sc, w, false); w = __builtin_amdgcn_cvt_pk_fp8_f32(v[j][2].z * sc, v[j][2].w * sc, w, true); o.z = (unsigned)w;
        w = 0; w = __builtin_amdgcn_cvt_pk_fp8_f32(v[j][3].x * sc, v[j][3].y * sc, w, false); w = __builtin_amdgcn_cvt_pk_fp8_f32(v[j][3].z * sc, v[j][3].w * sc, w, true); o.w = (unsigned)w;
        { const int ch = lane + 64 * j; *((GAS v4u*)(dst + (size_t)(ch >> 4) * SLICE_BYTES) + (ch & 15)) = o; } }
    if (lane == 0) *inv = mx > 0.f ? mx * (1.0f / 384.0f) : 1.0f;
}
__device__ __forceinline__ void row_to_i8(const float* src, unsigned char* dst, float* inv, int lane) {
    f32x4 v[2][4]; float mx = 0.f;
#pragma unroll
    for (int j = 0; j < 2; ++j)
#pragma unroll
        for (int q = 0; q < 4; ++q) { v[j][q] = *((const GAS f32x4*)src + 4 * (lane + 64 * j) + q);
            mx = fmaxf(mx, fmaxf(fmaxf(fabsf(v[j][q].x), fabsf(v[j][q].y)), fmaxf(fabsf(v[j][q].z), fabsf(v[j][q].w)))); }
#pragma unroll
    for (int o = 1; o < 64; o <<= 1) mx = fmaxf(mx, __shfl_xor(mx, o));
    const float sc = mx > 0.f ? 127.0f / mx : 1.0f;
#pragma unroll
    for (int j = 0; j < 2; ++j) { v4u o; o.x = pack_i8(v[j][0] * sc); o.y = pack_i8(v[j][1] * sc); o.z = pack_i8(v[j][2] * sc); o.w = pack_i8(v[j][3] * sc);
        { const int ch = lane + 64 * j; *((GAS v4u*)(dst + (size_t)(ch >> 4) * SLICE_BYTES) + (ch & 15)) = o; } }
    if (lane == 0) *inv = mx > 0.f ? mx * (1.0f / 127.0f) : 1.0f;
}
__device__ __forceinline__ float row16_allsum(float a) {
    a += __builtin_bit_cast(float, __builtin_amdgcn_update_dpp(0, __builtin_bit_cast(int, a), 0x128, 0xf, 0xf, false));
    a += __builtin_bit_cast(float, __builtin_amdgcn_update_dpp(0, __builtin_bit_cast(int, a), 0x124, 0xf, 0xf, false));
    a += __builtin_bit_cast(float, __builtin_amdgcn_update_dpp(0, __builtin_bit_cast(int, a), 0x122, 0xf, 0xf, false));
    a += __builtin_bit_cast(float, __builtin_amdgcn_update_dpp(0, __builtin_bit_cast(int, a), 0x121, 0xf, 0xf, false));
    return a;
}
__device__ __forceinline__ int q_pull(unsigned* q, int lane) { int v = 0; if (lane == 0) v = (int)__hip_atomic_fetch_add(q, 1u, __ATOMIC_RELAXED, __HIP_MEMORY_SCOPE_AGENT); return __builtin_amdgcn_readfirstlane(v); }
constexpr int PEER_TG = 8;
constexpr int PEER_N8 = 640, PEER_N4 = 512, PEER_N2 = 512, PEER_NTASK = PEER_N8 + PEER_N4 + PEER_N2;
__device__ __forceinline__ void peer_task_tokens(int idx, int& t0, int& n) {
    if (idx < PEER_N8) { t0 = 8 * idx; n = 8; } else if (idx < PEER_N8 + PEER_N4) { t0 = 8 * PEER_N8 + 4 * (idx - PEER_N8); n = 4; } else { t0 = 8 * PEER_N8 + 4 * PEER_N4 + 2 * (idx - PEER_N8 - PEER_N4); n = 2; }
}
__device__ __forceinline__ int row16_allsum_i(int a) {
    a += __builtin_amdgcn_update_dpp(0, a, 0x128, 0xf, 0xf, false);
    a += __builtin_amdgcn_update_dpp(0, a, 0x124, 0xf, 0xf, false);
    a += __builtin_amdgcn_update_dpp(0, a, 0x122, 0xf, 0xf, false);
    a += __builtin_amdgcn_update_dpp(0, a, 0x121, 0xf, 0xf, false);
    return a;
}
#define PA_LOAD(R, IDV, HALF) do { _Pragma("unroll") for (int i_ = 0; i_ < 8; ++i_) { const unsigned e_ = (unsigned)__shfl(IDV, 4 * (i_ + 8 * (HALF)) + g); \
        R[i_] = *(const GAS v4u*)(ub + (e_ * 256u + offc)); } } while (0)
#define PA_COMP(R, HALF) do { _Pragma("unroll") for (int i_ = 0; i_ < 8; ++i_) { int a_ = __builtin_amdgcn_sdot4((int)R[i_].x, (int)xc.x, 0, false); a_ = __builtin_amdgcn_sdot4((int)R[i_].y, (int)xc.y, a_, false); \
        a_ = __builtin_amdgcn_sdot4((int)R[i_].z, (int)xc.z, a_, false); a_ = __builtin_amdgcn_sdot4((int)R[i_].w, (int)xc.w, a_, false); r16[8 * (HALF) + i_] = row16_allsum_i(a_); } } while (0)
__device__ __forceinline__ void peer_a_task(int t0, int ntok, int s, const signed char* xq, const int* experts, const unsigned char* u8s, int* pa, int lane_) {
    int lane = lane_; asm volatile("" : "+v"(lane));
    const int g = lane >> 4, c = lane & 15;
    const GAS unsigned char* ub = (const GAS unsigned char*)(u8s + (size_t)s * SLICE_BYTES);
    const unsigned offc = 16u * (unsigned)c;
    int idc0 = experts[(size_t)t0 * 128 + lane], idc1 = experts[(size_t)t0 * 128 + lane + 64];
    v4u xc = *(const GAS v4u*)(xq + (size_t)t0 * D + 256 * s + 16 * c);
    v4u RA[8], RB[8];
    PA_LOAD(RA, idc0, 0);
#pragma unroll 1
    for (int tt = 0; tt < ntok; ++tt) {
        const int t = t0 + tt, tn = tt + 1 < ntok ? t + 1 : t;
        const int idn0 = experts[(size_t)tn * 128 + lane], idn1 = experts[(size_t)tn * 128 + lane + 64];
        const v4u xn = *(const GAS v4u*)(xq + (size_t)tn * D + 256 * s + 16 * c);
#pragma unroll 1
        for (int hb = 0; hb < 2; ++hb) {
            const int idv = hb ? idc1 : idc0, idx = hb ? idn0 : idc1;
            int r16[16];
            PA_LOAD(RB, idv, 1); PA_COMP(RA, 0);
            asm volatile("" ::: "memory");
            PA_LOAD(RA, idx, 0); PA_COMP(RB, 1);
            if (c == 15) { typedef int i32x4 __attribute__((ext_vector_type(4))); GAS i32x4* dst = (GAS i32x4*)(pa + ((size_t)t * 8 + s) * 128 + g * 32 + 16 * hb);
#pragma unroll
                for (int q = 0; q < 4; ++q) dst[q] = (i32x4){r16[4 * q], r16[4 * q + 1], r16[4 * q + 2], r16[4 * q + 3]}; }
        }
        idc0 = idn0; idc1 = idn1; xc = xn;
    }
}
constexpr int PA_CH = 56, PA_NCH = (M + PA_CH - 1) / PA_CH, PA_NCH4 = (PA_NCH + 3) & ~3;
constexpr int PA_XT = 131072, PA_XTB = PA_CH * 256, PA_LOFF = PA_XT + 2 * PA_XTB;
static_assert(PA_LOFF + PA_NCH4 * 8 <= LDSCTL_OFF, "LDS map");
__device__ __forceinline__ void peer_shard_load(int s, int r, const unsigned char* u8s, LAS unsigned char* lds, int tid_) {
    int tid = tid_; asm volatile("" : "+v"(tid));
    const GAS unsigned char* src = (const GAS unsigned char*)(u8s + (size_t)s * SLICE_BYTES);
#pragma unroll 1
    for (int h = 0; h < 2; ++h) { v4u t[8];
#pragma unroll
        for (int j = 0; j < 8; ++j) { const int piece = tid + NTHREADS * (8 * h + j), el = piece >> 4, i = el >> 2, jj = ((r - i) & 31) + 32 * (el & 3);
            t[j] = *(const GAS v4u*)(src + ((size_t)(i * 128 + jj) * 256 + (size_t)((piece & 15) << 4))); }
#pragma unroll
        for (int j = 0; j < 8; ++j) *(LAS v4u*)(lds + 16 * (tid + NTHREADS * (8 * h + j))) = t[j]; }
}
__device__ __forceinline__ void peer_bucket(int q, const int* experts, unsigned* seg, int* soff, LAS unsigned char* lds, int tid_) {
    int tid = tid_; asm volatile("" : "+v"(tid));
    LAS int* cnt = (LAS int*)(lds + PA_XT);
    if (tid < 128) cnt[tid] = 0;
    __syncthreads();
    const int ntok = (M - q * PA_CH) < PA_CH ? (M - q * PA_CH) : PA_CH, nent = ntok * 128;
    const GAS int* ex = (const GAS int*)(experts + (size_t)q * PA_CH * 128);
    int ev[14];
#pragma unroll
    for (int j = 0; j < 14; ++j) { const int i = tid + NTHREADS * j; ev[j] = i < nent ? ex[i] : -1; }
#pragma unroll
    for (int j = 0; j < 14; ++j) if (ev[j] >= 0) __hip_atomic_fetch_add(cnt + (((ev[j] >> 7) + ev[j]) & 31), 1, __ATOMIC_RELAXED, __HIP_MEMORY_SCOPE_WORKGROUP);
    __syncthreads();
    if (tid < 64) { const int c = tid < 32 ? cnt[tid] : 0; int inc = c;
#pragma unroll
        for (int o = 1; o < 32; o <<= 1) { const int v = __shfl_up(inc, o); if (tid >= o) inc += v; }
        if (tid < 32) { cnt[32 + tid] = inc - c; soff[q * 33 + tid] = inc - c; if (tid == 31) soff[q * 33 + 32] = inc; } }
    __syncthreads();
    GAS unsigned* sg = (GAS unsigned*)(seg + (size_t)q * (PA_CH * 128));
#pragma unroll
    for (int j = 0; j < 14; ++j) if (ev[j] >= 0) { const int i = tid + NTHREADS * j, e = ev[j], r = ((e >> 7) + e) & 31;
        const int p = cnt[32 + r] + __hip_atomic_fetch_add(cnt + 96 + r, 1, __ATOMIC_RELAXED, __HIP_MEMORY_SCOPE_WORKGROUP);
        sg[p] = ((unsigned)(i >> 7) << 16) | ((unsigned)(i & 127) << 9) | (unsigned)(((e >> 7) << 2) | ((e >> 5) & 3)); }
    __syncthreads();
}
#define PAL_ISSUE(U, X, ENT, XT) do { const unsigned ua_ = ((ENT) & 511u) * 256u + l16, xa_ = (XT) + ((ENT) >> 16) * 256u + l16; \
        _Pragma("unroll") for (int j_ = 0; j_ < 8; ++j_) { U[j_] = *(const LAS v4u*)(ua_ ^ (unsigned)(j_ << 4)); X[j_] = *(const LAS v4u*)(xa_ ^ (unsigned)(j_ << 4)); } } while (0)
#define PAL_DOTS(U, X, ACC) do { int a0_ = 0, a1_ = 0; \
        _Pragma("unroll") for (int j_ = 0; j_ < 8; j_ += 2) { \
            a0_ = __builtin_amdgcn_sdot4((int)U[j_].x, (int)X[j_].x, a0_, false); a1_ = __builtin_amdgcn_sdot4((int)U[j_ + 1].x, (int)X[j_ + 1].x, a1_, false); \
            a0_ = __builtin_amdgcn_sdot4((int)U[j_].y, (int)X[j_].y, a0_, false); a1_ = __builtin_amdgcn_sdot4((int)U[j_ + 1].y, (int)X[j_ + 1].y, a1_, false); \
            a0_ = __builtin_amdgcn_sdot4((int)U[j_].z, (int)X[j_].z, a0_, false); a1_ = __builtin_amdgcn_sdot4((int)U[j_ + 1].z, (int)X[j_ + 1].z, a1_, false); \
            a0_ = __builtin_amdgcn_sdot4((int)U[j_].w, (int)X[j_].w, a0_, false); a1_ = __builtin_amdgcn_sdot4((int)U[j_ + 1].w, (int)X[j_ + 1].w, a1_, false); } \
        a0_ += a1_; ACC = a0_ + __builtin_amdgcn_update_dpp(0, a0_, 0x128, 0xf, 0xf, false); } while (0)
#define PAL_LOAD(Q, XA, XB, EN) do { int q_ = (Q); q_ = q_ < PA_NCH4 ? q_ : PA_NCH4 - 1; const GAS unsigned char* xq_ = xb + (size_t)q_ * (PA_CH * D); \
        XA = *(const GAS v4u*)(xq_ + voff0); XB = *(const GAS v4u*)(xq_ + voff1); EN = sg[(unsigned)(loff[2 * q_] + pidx)]; } while (0)
#define PAL_WRITE(Q, XA, XB) do { const int b_ = PA_XT + ((Q) & 1) * PA_XTB + 16 * tid; *(LAS v4u*)(lds + b_) = XA; if (tid < (PA_CH - 32) * 16) *(LAS v4u*)(lds + b_ + 16 * NTHREADS) = XB; } while (0)
#define PAL_STORE(QQ, E, A) do { const unsigned k_ = ((E) >> 9) & 127u; pa[((size_t)((QQ) * PA_CH + (int)((E) >> 16)) * 8 + s) * 128 + (k_ & 3u) * 32u + (k_ >> 2)] = (A); } while (0)
#define CV_NONE do { } while (0)
#define CV_ISSUE do { if (late && cv_it < 16) { const GAS f32x4* src_ = (const GAS f32x4*)(pv + (size_t)(cv_e0 + cv_it) * D); \
        _Pragma("unroll") for (int j_ = 0; j_ < 2; ++j_) _Pragma("unroll") for (int q_ = 0; q_ < 4; ++q_) cvr[j_][q_] = src_[4 * (lane + 64 * j_) + q_]; } } while (0)
#define CV_FINISH do { if (late && cv_it < 16) { float mx_ = 0.f; \
        _Pragma("unroll") for (int j_ = 0; j_ < 2; ++j_) _Pragma("unroll") for (int q_ = 0; q_ < 4; ++q_) mx_ = fmaxf(mx_, fmaxf(fmaxf(fabsf(cvr[j_][q_].x), fabsf(cvr[j_][q_].y)), fmaxf(fabsf(cvr[j_][q_].z), fabsf(cvr[j_][q_].w)))); \
        _Pragma("unroll") for (int o_ = 1; o_ < 64; o_ <<= 1) mx_ = fmaxf(mx_, __shfl_xor(mx_, o_)); \
        const float sc_ = mx_ > 0.f ? 384.0f / mx_ : 1.0f; const int e_ = cv_e0 + cv_it; \
        _Pragma("unroll") for (int j_ = 0; j_ < 2; ++j_) { v4u o_; int w_; \
            w_ = 0; w_ = __builtin_amdgcn_cvt_pk_fp8_f32(cvr[j_][0].x * sc_, cvr[j_][0].y * sc_, w_, false); w_ = __builtin_amdgcn_cvt_pk_fp8_f32(cvr[j_][0].z * sc_, cvr[j_][0].w * sc_, w_, true); o_.x = (unsigned)w_; \
            w_ = 0; w_ = __builtin_amdgcn_cvt_pk_fp8_f32(cvr[j_][1].x * sc_, cvr[j_][1].y * sc_, w_, false); w_ = __builtin_amdgcn_cvt_pk_fp8_f32(cvr[j_][1].z * sc_, cvr[j_][1].w * sc_, w_, true); o_.y = (unsigned)w_; \
            w_ = 0; w_ = __builtin_amdgcn_cvt_pk_fp8_f32(cvr[j_][2].x * sc_, cvr[j_][2].y * sc_, w_, false); w_ = __builtin_amdgcn_cvt_pk_fp8_f32(cvr[j_][2].z * sc_, cvr[j_][2].w * sc_, w_, true); o_.z = (unsigned)w_; \
            w_ = 0; w_ = __builtin_amdgcn_cvt_pk_fp8_f32(cvr[j_][3].x * sc_, cvr[j_][3].y * sc_, w_, false); w_ = __builtin_amdgcn_cvt_pk_fp8_f32(cvr[j_][3].z * sc_, cvr[j_][3].w * sc_, w_, true); o_.w = (unsigned)w_; \
            const int ch_ = lane + 64 * j_; *((GAS v4u*)(v8 + (size_t)e_ * 256 + (size_t)(ch_ >> 4) * SLICE_BYTES) + (ch_ & 15)) = o_; } \
        if (lane == 0) sv[e_] = mx_ > 0.f ? mx_ * (1.0f / 384.0f) : 1.0f; } } while (0)
#define PAL_STEP(Q, WXA, WXB, CXA, CXB, CEN, HOOK) do { const int q_s = (Q); \
        __syncthreads();                       \
        const unsigned e0_ = CEN; const int nb_s = loff[2 * q_s], n_s = loff[2 * q_s + 1]; const unsigned xt_s = (unsigned)(PA_XT + (q_s & 1) * PA_XTB); \
        PAL_LOAD(q_s + 4, CXA, CXB, CEN);        \
        if (late) { if (pidx < n_prev) { int a_; PAL_DOTS(U, X, a_); if (!(tid & 8)) PAL_STORE(q_s - 1, e_prev, a_); } } \
        _Pragma("unroll 1") for (int i_ = pidx + NTHREADS / 2; i_ < n_s; i_ += NTHREADS / 2) { const unsigned e1_ = sg[nb_s + i_]; PAL_ISSUE(U, X, e1_, xt_s); int a_; PAL_DOTS(U, X, a_); if (!(tid & 8)) PAL_STORE(q_s, e1_, a_); }        \
        PAL_WRITE(q_s + 1, WXA, WXB); \
        if (pidx < n_s) PAL_ISSUE(U, X, e0_, xt_s); \
        __builtin_amdgcn_sched_barrier(0); \
        if (!late) { if (pidx < n_s) { int a_; PAL_DOTS(U, X, a_); if (!(tid & 8)) PAL_STORE(q_s, e0_, a_); } } \
        HOOK; \
        e_prev = e0_; n_prev = n_s; \
    } while (0)
__device__ __forceinline__ void peer_a_lds(int s, const signed char* xq, const unsigned* seg, const int* soff, int r, int* pa, LAS unsigned char* lds, int tid_, const float* pv, unsigned char* v8, float* sv, int cv_e0) {
    int tid = tid_; asm volatile("" : "+v"(tid));
    const unsigned l16 = (unsigned)(tid & 15) << 4;
    const int pidx = (tid >> 4) * 8 + (tid & 7);
    const bool late = __builtin_amdgcn_readfirstlane(tid >> 8) != 0;
    const int lane = tid & 63; cv_e0 += (__builtin_amdgcn_readfirstlane(tid >> 6) & 3) * 16; f32x4 cvr[2][4]; int cv_it = 0;
#pragma unroll
    for (int j = 0; j < 2; ++j)
#pragma unroll
        for (int q = 0; q < 4; ++q) cvr[j][q] = (f32x4){0.f, 0.f, 0.f, 0.f};
    LAS int* loff = (LAS int*)(lds + PA_LOFF);
    if (tid < PA_NCH4) { int b = 0, e = 0; if (tid < PA_NCH) { b = soff[tid * 33 + r]; e = soff[tid * 33 + r + 1]; } loff[2 * tid] = tid * (PA_CH * 128) + b; loff[2 * tid + 1] = e - b; }
    __syncthreads();
    const GAS unsigned char* xb = (const GAS unsigned char*)(xq + 256 * s);
    const GAS unsigned* sg = (const GAS unsigned*)seg;
    const unsigned voff0 = (unsigned)(tid >> 4) * (unsigned)D + l16, voff1 = voff0 + ((tid >> 4) < PA_CH - 32 ? 32u * (unsigned)D : 0u);
    v4u x0a, x0b, x1a, x1b, x2a, x2b, x3a, x3b; unsigned en0, en1, en2, en3;
    v4u U[8], X[8]; unsigned e_prev = 0u; int n_prev = 0;
#pragma unroll
    for (int j = 0; j < 8; ++j) { U[j] = X[j] = (v4u){0u, 0u, 0u, 0u}; }
    PAL_LOAD(0, x0a, x0b, en0); PAL_LOAD(1, x1a, x1b, en1); PAL_LOAD(2, x2a, x2b, en2); PAL_LOAD(3, x3a, x3b, en3);
    PAL_WRITE(0, x0a, x0b);
#pragma unroll 1
    for (int q0 = 0; q0 < PA_NCH4; q0 += 4) {
        PAL_STEP(q0, x1a, x1b, x0a, x0b, en0, CV_ISSUE);
        PAL_STEP(q0 + 1, x2a, x2b, x1a, x1b, en1, CV_NONE);
        PAL_STEP(q0 + 2, x3a, x3b, x2a, x2b, en2, CV_NONE);
        PAL_STEP(q0 + 3, x0a, x0b, x3a, x3b, en3, CV_FINISH);
        ++cv_it;
    }
    __syncthreads();
}
constexpr int PA2_XW = 7 * 256, PA2_LOFF = PA_XT + NWAVES * PA2_XW;
static_assert(PA2_LOFF + NWAVES * PA_NCH4 * 8 <= LDSCTL_OFF, "LDS map");
__device__ __forceinline__ void peer_bucket2(int q, const int* experts, unsigned* seg, int* soff, LAS unsigned char* lds, int tid_) {
    int tid = tid_; asm volatile("" : "+v"(tid));
    LAS int* cnt = (LAS int*)(lds + PA_XT);
    for (int i = tid; i < 840; i += NTHREADS) cnt[i] = 0;
    __syncthreads();
    const int ntok = (M - q * PA_CH) < PA_CH ? (M - q * PA_CH) : PA_CH, nent = ntok * 128;
    const GAS int* ex = (const GAS int*)(experts + (size_t)q * PA_CH * 128);
    int ev[14];
#pragma unroll
    for (int j = 0; j < 14; ++j) { const int i = tid + NTHREADS * j; ev[j] = i < nent ? ex[i] : -1; }
#pragma unroll
    for (int j = 0; j < 14; ++j) if (ev[j] >= 0) { const int i = tid + NTHREADS * j; __hip_atomic_fetch_add(cnt + ((((ev[j] >> 7) + ev[j]) & 31) * 8 + ((i >> 7) & 7)), 1, __ATOMIC_RELAXED, __HIP_MEMORY_SCOPE_WORKGROUP); }
    __syncthreads();
    int c = 0, inc = 0;
    if (tid < 256) { c = cnt[tid]; inc = c;
#pragma unroll
        for (int o = 1; o < 64; o <<= 1) { const int v = __shfl_up(inc, o); if ((tid & 63) >= o) inc += v; }
        if ((tid & 63) == 63) cnt[832 + (tid >> 6)] = inc; }
    __syncthreads();
    if (tid < 256) { int base = 0;
#pragma unroll
        for (int w2 = 0; w2 < 4; ++w2) if (w2 < (tid >> 6)) base += cnt[832 + w2];
        cnt[256 + tid] = base + inc - c; soff[q * 257 + tid] = base + inc - c; if (tid == 255) soff[q * 257 + 256] = base + inc; }
    __syncthreads();
    GAS unsigned* sg = (GAS unsigned*)(seg + (size_t)q * (PA_CH * 128));
#pragma unroll
    for (int j = 0; j < 14; ++j) if (ev[j] >= 0) { const int i = tid + NTHREADS * j, e = ev[j], bin = ((((e >> 7) + e) & 31) * 8) + ((i >> 7) & 7);
        const int p = cnt[256 + bin] + __hip_atomic_fetch_add(cnt + 544 + bin, 1, __ATOMIC_RELAXED, __HIP_MEMORY_SCOPE_WORKGROUP);
        sg[p] = ((unsigned)(i >> 7) << 16) | ((unsigned)(i & 127) << 9) | (unsigned)(((e >> 7) << 2) | ((e >> 5) & 3)); }
    __syncthreads();
}
#define PA2_LOAD(Q, XA, XB, EN, EM) do { int q_ = (Q); q_ = q_ < PA_NCH4 ? q_ : PA_NCH4 - 1; const GAS unsigned char* xq_ = xbw + (size_t)q_ * (PA_CH * D); \
        XA = *(const GAS v4u*)(xq_ + voff0); XB = *(const GAS v4u*)(xq_ + voff1); const unsigned lb_ = (unsigned)(loff[2 * q_] + pidx); EN = sg[lb_]; EM = sg[lb_ + 32u]; } while (0)
#define PA2_WRITE(XA, XB) do { *(LAS v4u*)(xw + 16 * lane) = XA; if (lane < 48) *(LAS v4u*)(xw + 16 * (64 + lane)) = XB; } while (0)
#define PA2_PAIR(ENT) do { const unsigned e_ = (ENT); const unsigned ua_ = (e_ & 511u) * 256u + l16, xa_ = xwa + ((e_ >> 19) << 8) + l16; v4u U[8], X[8]; \
        _Pragma("unroll") for (int j_ = 0; j_ < 8; ++j_) { U[j_] = *(const LAS v4u*)(ua_ ^ (unsigned)(j_ << 4)); X[j_] = *(const LAS v4u*)(xa_ ^ (unsigned)(j_ << 4)); } \
        __builtin_amdgcn_sched_barrier(0); int a_; PAL_DOTS(U, X, a_); if (!(lane & 8)) PAL_STORE(q_s, e_, a_); } while (0)
#define PA2_STEP(Q, CXA, CXB, CEN, CEM, HOOK) do { const int q_s = (Q); \
        const unsigned e0_ = CEN, e2_ = CEM; const int nb_s = loff[2 * q_s], n_s = loff[2 * q_s + 1]; \
        PA2_WRITE(CXA, CXB);                        \
        PA2_LOAD(q_s + 4, CXA, CXB, CEN, CEM); \
        if (pidx < n_s) PA2_PAIR(e0_); \
        if (pidx + 32 < n_s) PA2_PAIR(e2_); \
        _Pragma("unroll 1") for (int i_ = pidx + 64; i_ < n_s; i_ += 32) { const unsigned e1_ = sg[nb_s + i_]; PA2_PAIR(e1_); } \
        HOOK; \
    } while (0)
__device__ __forceinline__ void peer_a_lds2(int s, const signed char* xq, const unsigned* seg, const int* soff, int r, int* pa, LAS unsigned char* lds, int tid_, const float* pv, unsigned char* v8, float* sv, int cv_e0) {
    int tid = tid_; asm volatile("" : "+v"(tid));
    const int lane = tid & 63, wave = __builtin_amdgcn_readfirstlane(tid >> 6);
    const unsigned l16 = (unsigned)(lane & 15) << 4;
    const int pidx = (lane >> 4) * 8 + (lane & 7);
    const bool late = wave >= 4;
    cv_e0 += (wave & 3) * 16; f32x4 cvr[2][4]; int cv_it = 0;
#pragma unroll
    for (int j = 0; j < 2; ++j)
#pragma unroll
        for (int q = 0; q < 4; ++q) cvr[j][q] = (f32x4){0.f, 0.f, 0.f, 0.f};
    LAS int* loff = (LAS int*)(lds + PA2_LOFF + wave * (PA_NCH4 * 8));
    for (int q = lane; q < PA_NCH4; q += 64) { int b = 0, e = 0; if (q < PA_NCH) { b = soff[q * 257 + r * 8 + wave]; e = soff[q * 257 + r * 8 + wave + 1]; } loff[2 * q] = q * (PA_CH * 128) + b; loff[2 * q + 1] = e - b; }
    LAS unsigned char* xw = lds + PA_XT + wave * PA2_XW;
    const unsigned xwa = (unsigned)(PA_XT + wave * PA2_XW);
    const GAS unsigned char* xbw = (const GAS unsigned char*)(xq + 256 * s + (size_t)wave * D);
    const GAS unsigned* sg = (const GAS unsigned*)seg;
    const unsigned voff0 = (unsigned)(lane >> 4) * (unsigned)(8 * D) + l16, voff1 = voff0 + (lane < 48 ? 4u * (unsigned)(8 * D) : 0u);
    v4u x0a, x0b, x1a, x1b, x2a, x2b, x3a, x3b; unsigned en0, en1, en2, en3, em0, em1, em2, em3;
    PA2_LOAD(0, x0a, x0b, en0, em0); PA2_LOAD(1, x1a, x1b, en1, em1); PA2_LOAD(2, x2a, x2b, en2, em2); PA2_LOAD(3, x3a, x3b, en3, em3);
#pragma unroll 1
    for (int q0 = 0; q0 < PA_NCH4; q0 += 4) {
        PA2_STEP(q0, x0a, x0b, en0, em0, CV_ISSUE);
        PA2_STEP(q0 + 1, x1a, x1b, en1, em1, CV_NONE);
        PA2_STEP(q0 + 2, x2a, x2b, en2, em2, CV_NONE);
        PA2_STEP(q0 + 3, x3a, x3b, en3, em3, CV_FINISH);
        ++cv_it;
    }
    __syncthreads();
}
constexpr int T3_CH = 96, T3_NCH = (M + T3_CH - 1) / T3_CH, T3_NCH4 = (T3_NCH + 3) & ~3;
constexpr int T3_XW = 12 * 256, T3_LOFF = PA_XT + NWAVES * T3_XW;
static_assert(T3_LOFF + NWAVES * T3_NCH4 * 8 <= LDSCTL_OFF, "LDS map");
__device__ __forceinline__ void peer_bucket3(int qh, const int* experts, unsigned* seg, int* soff, LAS unsigned char* lds, int tid_, int sx, int r, const unsigned char* u8s) {
    int tid = tid_; asm volatile("" : "+v"(tid));
    const int q = qh >> 1, h = qh & 1;
    LAS int* cnt = (LAS int*)(lds + PA_XT);
    for (int i = tid; i < 840; i += NTHREADS) cnt[i] = 0;
    __syncthreads();
    const int ntok = (M - q * T3_CH) < T3_CH ? (M - q * T3_CH) : T3_CH;
    const GAS int* ex = (const GAS int*)(experts + (size_t)q * T3_CH * 128);
    int ev[12];
#pragma unroll
    for (int j = 0; j < 12; ++j) { const int il = tid + NTHREADS * j, tq = il >> 7, tl = ((tq >> 2) << 3) + 4 * h + (tq & 3); ev[j] = tl < ntok ? ex[tl * 128 + (il & 127)] : -1; }
    const GAS unsigned char* usrc = (const GAS unsigned char*)(u8s + (size_t)sx * SLICE_BYTES);
    v4u ut[8];
#pragma unroll
    for (int j = 0; j < 8; ++j) { const int piece = tid + NTHREADS * (8 + j), el = piece >> 4, i = el >> 2, jj = ((r - i) & 31) + 32 * (el & 3);
        ut[j] = *(const GAS v4u*)(usrc + ((size_t)(i * 128 + jj) * 256 + (size_t)((piece & 15) << 4))); }
#pragma unroll
    for (int j = 0; j < 12; ++j) if (ev[j] >= 0) { const int il = tid + NTHREADS * j; __hip_atomic_fetch_add(cnt + ((((ev[j] >> 7) + ev[j]) & 31) * 4 + ((il >> 7) & 3)), 1, __ATOMIC_RELAXED, __HIP_MEMORY_SCOPE_WORKGROUP); }
    __syncthreads();
    int c = 0, inc = 0;
    if (tid < 256) { c = cnt[tid]; inc = c;
#pragma unroll
        for (int o = 1; o < 64; o <<= 1) { const int v = __shfl_up(inc, o); if ((tid & 63) >= o) inc += v; }
        if ((tid & 63) == 63) cnt[832 + (tid >> 6)] = inc; }
    __syncthreads();
    if (tid < 256) { int base = 0;
#pragma unroll
        for (int w2 = 0; w2 < 4; ++w2) if (w2 < (tid >> 6)) base += cnt[832 + w2];
        cnt[256 + tid] = base + inc - c; if (tid <= 128) soff[q * 258 + h * 129 + tid] = h * (T3_CH * 64) + base + inc - c; }
    __syncthreads();
#pragma unroll
    for (int j = 0; j < 8; ++j) *(LAS v4u*)(lds + 16 * (tid + NTHREADS * (8 + j))) = ut[j];
#pragma unroll
    for (int j = 0; j < 8; ++j) { const int piece = tid + NTHREADS * j, el = piece >> 4, i = el >> 2, jj = ((r - i) & 31) + 32 * (el & 3);
        ut[j] = *(const GAS v4u*)(usrc + ((size_t)(i * 128 + jj) * 256 + (size_t)((piece & 15) << 4))); }
    GAS unsigned* sg = (GAS unsigned*)(seg + (size_t)q * (T3_CH * 128) + h * (T3_CH * 64));
#pragma unroll
    for (int j = 0; j < 12; ++j) if (ev[j] >= 0) { const int il = tid + NTHREADS * j, tq = il >> 7, i = ((((tq >> 2) << 3) + 4 * h + (tq & 3)) << 7) | (il & 127), e = ev[j], bin = ((((e >> 7) + e) & 31) * 4) + (tq & 3);
        const int p = cnt[256 + bin] + __hip_atomic_fetch_add(cnt + 544 + bin, 1, __ATOMIC_RELAXED, __HIP_MEMORY_SCOPE_WORKGROUP);
        ((LAS unsigned*)lds)[p] = ((unsigned)(i >> 7) << 16) | ((unsigned)(i & 127) << 9) | (unsigned)(((e >> 7) << 2) | ((e >> 5) & 3)); }
    __syncthreads();
    const int tot = cnt[256 + 128];
#pragma unroll
    for (int j = 0; j < 3; ++j) { const int i4 = tid + NTHREADS * j; if (4 * i4 < tot) *((GAS v4u*)sg + i4) = *((const LAS v4u*)lds + i4); }
    __syncthreads();
#pragma unroll
    for (int j = 0; j < 8; ++j) *(LAS v4u*)(lds + 16 * (tid + NTHREADS * j)) = ut[j];
}
#define T3_LOAD(Q, XA, XB, XC, EN) do { int q_ = (Q); q_ = q_ < T3_NCH4 ? q_ : T3_NCH4 - 1; const GAS unsigned char* xq_ = xbw + (size_t)q_ * (T3_CH * D); \
        XA = *(const GAS v4u*)(xq_ + voff0); XB = *(const GAS v4u*)(xq_ + voff0 + 4 * 8 * D); XC = *(const GAS v4u*)(xq_ + voff0 + 8 * 8 * D); EN = sg[(unsigned)(loff[2 * q_] + lane)]; } while (0)
#define T3_WRITE(XA, XB, XC) do { *(LAS v4u*)(xw + 16 * lane) = XA; *(LAS v4u*)(xw + 16 * (64 + lane)) = XB; *(LAS v4u*)(xw + 16 * (128 + lane)) = XC; } while (0)
#define T3_HALF(H) do { v4u U[8], X[8]; \
        _Pragma("unroll") for (int j_ = 0; j_ < 8; ++j_) { U[j_] = *(const LAS v4u*)(ua_ ^ (unsigned)((8 * (H) + j_) << 4)); X[j_] = *(const LAS v4u*)(xa_ ^ (unsigned)((8 * (H) + j_) << 4)); } \
        __builtin_amdgcn_sched_barrier(0); \
        _Pragma("unroll") for (int j_ = 0; j_ < 8; j_ += 2) { \
            a0_ = __builtin_amdgcn_sdot4((int)U[j_].x, (int)X[j_].x, a0_, false); a1_ = __builtin_amdgcn_sdot4((int)U[j_ + 1].x, (int)X[j_ + 1].x, a1_, false); \
            a0_ = __builtin_amdgcn_sdot4((int)U[j_].y, (int)X[j_].y, a0_, false); a1_ = __builtin_amdgcn_sdot4((int)U[j_ + 1].y, (int)X[j_ + 1].y, a1_, false); \
            a0_ = __builtin_amdgcn_sdot4((int)U[j_].z, (int)X[j_].z, a0_, false); a1_ = __builtin_amdgcn_sdot4((int)U[j_ + 1].z, (int)X[j_ + 1].z, a1_, false); \
            a0_ = __builtin_amdgcn_sdot4((int)U[j_].w, (int)X[j_].w, a0_, false); a1_ = __builtin_amdgcn_sdot4((int)U[j_ + 1].w, (int)X[j_ + 1].w, a1_, false); } } while (0)
#define T3_PAIR(ENT) do { const unsigned e_ = (ENT); const unsigned ua_ = (e_ & 511u) * 256u + l16, xa_ = xwa + ((e_ >> 19) << 8) + l16; int a0_ = 0, a1_ = 0; \
        T3_HALF(0); T3_HALF(1); const unsigned k_ = (e_ >> 9) & 127u; \
        pa[((size_t)(q_s * T3_CH + (int)(e_ >> 16)) * 8 + s) * 128 + (k_ & 3u) * 32u + (k_ >> 2)] = a0_ + a1_; } while (0)
#define T3_STEP(Q, CXA, CXB, CXC, CEN, HOOK) do { const int q_s = (Q); \
        const unsigned e0_ = CEN; const int nb_s = loff[2 * q_s], n_s = loff[2 * q_s + 1]; \
        T3_WRITE(CXA, CXB, CXC);                    \
        T3_LOAD(q_s + 4, CXA, CXB, CXC, CEN); \
        if (lane < n_s) T3_PAIR(e0_); \
        _Pragma("unroll 1") for (int i_ = lane + 64; i_ < n_s; i_ += 64) { const unsigned e1_ = sg[nb_s + i_]; T3_PAIR(e1_); }        \
        HOOK; \
    } while (0)
__device__ __forceinline__ void peer_a_lds3(int s, const signed char* xq, const unsigned* seg, const int* soff, int r, int* pa, LAS unsigned char* lds, int tid_, const float* pv, unsigned char* v8, float* sv, int cv_e0, unsigned char* v8t) {
    int tid = tid_; asm volatile("" : "+v"(tid));
    const int lane = tid & 63, wave = __builtin_amdgcn_readfirstlane(tid >> 6);
    const unsigned l16 = (unsigned)(lane & 15) << 4;
    const bool late = wave >= 4;
    cv_e0 += (wave & 3) * 16; f32x4 cvr[2][4]; int cv_it = 0;
#pragma unroll
    for (int j = 0; j < 2; ++j)
#pragma unroll
        for (int q = 0; q < 4; ++q) cvr[j][q] = (f32x4){0.f, 0.f, 0.f, 0.f};
    LAS int* loff = (LAS int*)(lds + T3_LOFF + wave * (T3_NCH4 * 8));
    { static_assert(T3_NCH4 <= 128, "two list-table entries per lane");
      const int qa = lane, qb = lane + 64; int ba = 0, ea = 0, bb = 0, eb = 0;
      const int so = (wave >> 2) * 129 + r * 4 + (wave & 3);
      if (qa < T3_NCH) { ba = soff[qa * 258 + so]; ea = soff[qa * 258 + so + 1]; }
      if (qb < T3_NCH) { bb = soff[qb * 258 + so]; eb = soff[qb * 258 + so + 1]; }
      loff[2 * qa] = qa * (T3_CH * 128) + ba; loff[2 * qa + 1] = ea - ba;
      if (qb < T3_NCH4) { loff[2 * qb] = qb * (T3_CH * 128) + bb; loff[2 * qb + 1] = eb - bb; } }
    LAS unsigned char* xw = lds + PA_XT + wave * T3_XW;
    const unsigned xwa = (unsigned)(PA_XT + wave * T3_XW);
    const GAS unsigned char* xbw = (const GAS unsigned char*)(xq + 256 * s + (size_t)wave * D);
    const GAS unsigned* sg = (const GAS unsigned*)seg;
    const unsigned voff0 = (unsigned)(lane >> 4) * (unsigned)(8 * D) + l16;
    v4u x0a, x0b, x0c, x1a, x1b, x1c, x2a, x2b, x2c, x3a, x3b, x3c; unsigned en0, en1, en2, en3;
    T3_LOAD(0, x0a, x0b, x0c, en0); T3_LOAD(1, x1a, x1b, x1c, en1); T3_LOAD(2, x2a, x2b, x2c, en2); T3_LOAD(3, x3a, x3b, x3c, en3);
#pragma unroll 1
    for (int q0 = 0; q0 < T3_NCH4; q0 += 4) {
        T3_STEP(q0, x0a, x0b, x0c, en0, CV_ISSUE);
        T3_STEP(q0 + 1, x1a, x1b, x1c, en1, CV_NONE);
        T3_STEP(q0 + 2, x2a, x2b, x2c, en2, CV_NONE);
        T3_STEP(q0 + 3, x3a, x3b, x3c, en3, CV_FINISH);
        ++cv_it;
    }
    VM_WAIT();
    __syncthreads();
    {
        LAS unsigned char* st = lds + wave * 4096;
        const int cvb = (cv_e0 - (wave & 3) * 16) >> 4;
#pragma unroll 1
        for (int uu = 0; uu < 4; ++uu) { const int unit = wave * 4 + uu, blk = cvb + (unit >> 3), xs = unit & 7;
            const GAS unsigned char* src = (const GAS unsigned char*)(v8 + (size_t)xs * SLICE_BYTES + (size_t)blk * 4096);
            v4u r4[4];
#pragma unroll
            for (int q = 0; q < 4; ++q) r4[q] = *(const GAS v4u*)(src + 16 * (lane + 64 * q));
#pragma unroll
            for (int q = 0; q < 4; ++q) *(LAS v4u*)(st + 16 * (lane + 64 * q)) = r4[q];
            LDS_WAIT();
            GAS unsigned char* dstp = (GAS unsigned char*)(v8t + (size_t)xs * SLICE_BYTES + (size_t)blk * 4096);
#pragma unroll
            for (int q = 0; q < 4; ++q) { const int d = 16 * (lane + 64 * q), ci = d >> 7, it0 = (d & 127) >> 3;
                const v2u lo = *(const LAS v2u*)(st + it0 * 256 + ci * 8), hi = *(const LAS v2u*)(st + (it0 + 1) * 256 + ci * 8);
                *(GAS v4u*)(dstp + d) = (v4u){lo.x, lo.y, hi.x, hi.y}; }
            LDS_WAIT();
        }
    }
}
__device__ __forceinline__ void peer_w_elem(size_t i, const int* experts, const float* gates, const float* su, const float* sv, const float* sx, const int* pa, float* wb) {
    const size_t t = i >> 7; const int k = (int)(i & 127), pos = (k & 3) * 32 + (k >> 2);
    const int e = experts[i];
    int a = 0;
#pragma unroll
    for (int s2 = 0; s2 < 8; ++s2) a += pa[(t * 8 + s2) * 128 + pos];
    wb[i] = gates[i] * gelu_erf((float)a * (su[e] * sx[t])) * sv[e];
}
#define PB_LOAD(R, IDV, HALF) do { _Pragma("unroll") for (int i_ = 0; i_ < 8; ++i_) { const unsigned e_ = (unsigned)__shfl(IDV, 4 * (i_ + 8 * (HALF)) + g); \
        R[i_] = *(const GAS v4u*)(vb + (e_ * 256u + offc)); } } while (0)
#define PB_COMP(R, WV, HALF) do { _Pragma("unroll") for (int i_ = 0; i_ < 8; ++i_) { const float wk_ = __shfl(WV, 4 * (i_ + 8 * (HALF)) + g); \
        axpy4f8v(&ya2[0], R[i_].x, wk_); axpy4f8v(&ya2[2], R[i_].y, wk_); axpy4f8v(&ya2[4], R[i_].z, wk_); axpy4f8v(&ya2[6], R[i_].w, wk_); } } while (0)
__device__ __forceinline__ void peer_b_task(int t0, int ntok, int s, const bf16* h1, const int* experts, const float* wb, const unsigned char* v8s, bf16* out, float* st, int lane_) {
    int lane = lane_; asm volatile("" : "+v"(lane));
    const int g = lane >> 4, c = lane & 15;
    const GAS unsigned char* vb = (const GAS unsigned char*)(v8s + (size_t)s * SLICE_BYTES);
    const unsigned offc = 16u * (unsigned)c;
    int idc0 = experts[(size_t)t0 * 128 + lane], idc1 = experts[(size_t)t0 * 128 + lane + 64];
    float wc0 = wb[(size_t)t0 * 128 + lane], wc1 = wb[(size_t)t0 * 128 + lane + 64];
    v4u RA[8], RB[8];
    PB_LOAD(RA, idc0, 0);
#pragma unroll 1
    for (int tt = 0; tt < ntok; ++tt) {
        const int t = t0 + tt, tn = tt + 1 < ntok ? t + 1 : t;
        const int idn0 = experts[(size_t)tn * 128 + lane], idn1 = experts[(size_t)tn * 128 + lane + 64];
        const float wn0 = wb[(size_t)tn * 128 + lane], wn1 = wb[(size_t)tn * 128 + lane + 64];
        f32x2_t ya2[8];
#pragma unroll
        for (int e = 0; e < 8; ++e) ya2[e] = (f32x2_t){0.f, 0.f};
#pragma unroll 1
        for (int hb = 0; hb < 2; ++hb) {
            const int idv = hb ? idc1 : idc0, idx = hb ? idn0 : idc1; const float wv = hb ? wc1 : wc0;
            PB_LOAD(RB, idv, 1); PB_COMP(RA, wv, 0);
            asm volatile("" ::: "memory");
            PB_LOAD(RA, idx, 0); PB_COMP(RB, wv, 1);
        }
        float ya[16];
#pragma unroll
        for (int e = 0; e < 8; ++e) { ya[2 * e] = ya2[e].x; ya[2 * e + 1] = ya2[e].y; }
#pragma unroll
        for (int e = 0; e < 16; ++e) { ya[e] += __shfl_xor(ya[e], 16); ya[e] += __shfl_xor(ya[e], 32); }
        const GAS v4u* hp = (const GAS v4u*)(h1 + (size_t)t * D + 256 * s + 16 * c);
        const v4u h0 = hp[0], h1v = hp[1];
        float hx[16];
        hx[0] = pg8::bf_lo(h0.x); hx[1] = pg8::bf_hi(h0.x); hx[2] = pg8::bf_lo(h0.y); hx[3] = pg8::bf_hi(h0.y); hx[4] = pg8::bf_lo(h0.z); hx[5] = pg8::bf_hi(h0.z); hx[6] = pg8::bf_lo(h0.w); hx[7] = pg8::bf_hi(h0.w);
        hx[8] = pg8::bf_lo(h1v.x); hx[9] = pg8::bf_hi(h1v.x); hx[10] = pg8::bf_lo(h1v.y); hx[11] = pg8::bf_hi(h1v.y); hx[12] = pg8::bf_lo(h1v.z); hx[13] = pg8::bf_hi(h1v.z); hx[14] = pg8::bf_lo(h1v.w); hx[15] = pg8::bf_hi(h1v.w);
        float sm = 0.f, sq = 0.f;
#pragma unroll
        for (int e = 0; e < 16; ++e) { ya[e] = hx[e] * ALPHA + ya[e]; sm += ya[e]; sq += ya[e] * ya[e]; }
        sm = row16_allsum(sm); sq = row16_allsum(sq);
        if (g == 0) { GAS v4u* op = (GAS v4u*)(out + (size_t)t * D + 256 * s + 16 * c);
            v4u o0, o1; o0.x = pk2(ya[0], ya[1]); o0.y = pk2(ya[2], ya[3]); o0.z = pk2(ya[4], ya[5]); o0.w = pk2(ya[6], ya[7]);
            o1.x = pk2(ya[8], ya[9]); o1.y = pk2(ya[10], ya[11]); o1.z = pk2(ya[12], ya[13]); o1.w = pk2(ya[14], ya[15]);
            op[0] = o0; op[1] = o1;
            if (c == 0) { st[((size_t)t * 8 + s) * 2] = sm; st[((size_t)t * 8 + s) * 2 + 1] = sq; } }
        idc0 = idn0; idc1 = idn1; wc0 = wn0; wc1 = wn1;
    }
}
__device__ __forceinline__ void peer_w_pack(int bx, const int* experts, const float* gates, const float* su, const float* sv, const float* sx, const int* pa, unsigned* pw, const unsigned char* v8t, LAS unsigned char* lds, int tid_) {
    int tid = tid_; asm volatile("" : "+v"(tid));
    LAS unsigned* T = (LAS unsigned*)(lds + PA_XT);
    const size_t i0 = (size_t)bx * 32 * 128;
#pragma unroll 1
    for (int j4 = 0; j4 < 8; j4 += 8) {
      int e4[8], a4[8]; float g4[8], sx4[8];
#pragma unroll
      for (int jj = 0; jj < 8; ++jj) { const int il = tid + NTHREADS * (j4 + jj); const size_t i = i0 + il; const size_t t = i >> 7; const int k = il & 127, pos = (k & 3) * 32 + (k >> 2);
          e4[jj] = experts[i]; g4[jj] = gates[i]; sx4[jj] = sx[t]; int a = 0;
#pragma unroll
          for (int s2 = 0; s2 < 8; ++s2) a += pa[(t * 8 + s2) * 128 + pos];
          a4[jj] = a; }
      float su4[8], sv4[8];
#pragma unroll
      for (int jj = 0; jj < 8; ++jj) { su4[jj] = su[e4[jj]]; sv4[jj] = sv[e4[jj]]; }
#pragma unroll
      for (int jj = 0; jj < 8; ++jj) { const int j = j4 + jj; const int il = tid + NTHREADS * j; const int k = il & 127; const int e = e4[jj];
        const float w = g4[jj] * gelu_erf((float)a4[jj] * (su4[jj] * sx4[jj])) * sv4[jj];
        T[(il >> 7) * 129 + k] = ((__builtin_bit_cast(unsigned, w * 0.994140625f) + 0x10000u) & 0xFFFE0000u) | ((unsigned)e << 3); } }
    __syncthreads();
    const GAS unsigned char* vsrc = (const GAS unsigned char*)(v8t + (size_t)(bx & 7) * SLICE_BYTES + 128 * (bx >> 3));
    v4u vsh[8];
#pragma unroll
    for (int j = 0; j < 8; ++j) { const int idx = tid + NTHREADS * j; vsh[j] = *(const GAS v4u*)(vsrc + (size_t)(idx >> 3) * 4096 + 16 * (idx & 7)); }
    GAS unsigned* dst = (GAS unsigned*)(pw + (size_t)(bx >> 1) * (128 * 64) + 4 * 32 * (bx & 1));
#pragma unroll
    for (int j = 0; j < 8; ++j) { const int il = tid + NTHREADS * j, k4 = il >> 7, tl = (il >> 2) & 31, kk = il & 3; dst[k4 * 256 + 4 * tl + kk] = T[tl * 129 + 4 * k4 + kk]; }
    __syncthreads();
#pragma unroll
    for (int j = 0; j < 8; ++j) *(LAS v4u*)(lds + 16 * (tid + NTHREADS * j)) = vsh[j];
#pragma unroll
    for (int j = 0; j < 8; ++j) { const int idx = tid + NTHREADS * (8 + j); vsh[j] = *(const GAS v4u*)(vsrc + (size_t)(idx >> 3) * 4096 + 16 * (idx & 7)); }
#pragma unroll
    for (int j = 0; j < 8; ++j) *(LAS v4u*)(lds + 16 * (tid + NTHREADS * (8 + j))) = vsh[j];
}
__device__ __forceinline__ void peer_vshard_load(int x, int i, const unsigned char* v8t, LAS unsigned char* lds, int tid_) {
    int tid = tid_; asm volatile("" : "+v"(tid));
    const GAS unsigned char* src = (const GAS unsigned char*)(v8t + (size_t)x * SLICE_BYTES + 128 * i);
#pragma unroll 1
    for (int h = 0; h < 2; ++h) { v4u t[8];
#pragma unroll
        for (int j = 0; j < 8; ++j) { const int idx = tid + NTHREADS * (8 * h + j); t[j] = *(const GAS v4u*)(src + (size_t)(idx >> 3) * 4096 + 16 * (idx & 7)); }
#pragma unroll
        for (int j = 0; j < 8; ++j) *(LAS v4u*)(lds + 16 * (tid + NTHREADS * (8 * h + j))) = t[j]; }
}
#define PB2_LOADW(W, G_) do { const int g_ = (G_) < 8 * (M / 64 / NWAVES) ? (G_) : 8 * (M / 64 / NWAVES) - 1; const GAS v4u* p_ = pw0 + (size_t)(g_ >> 3) * (NWAVES * 128 * 16) + (g_ & 7) * (4 * 64); \
        _Pragma("unroll") for (int j_ = 0; j_ < 4; ++j_) W[j_] = p_[j_ * 64]; } while (0)
#define PB2_FMA_LO(ACC, CV, WW) asm("v_pk_fma_f32 %0, %1, %2, %0 op_sel_hi:[1,0,1]" : "+v"(ACC) : "v"(CV), "v"(WW))
#define PB2_FMA_HI(ACC, CV, WW) asm("v_pk_fma_f32 %0, %1, %2, %0 op_sel:[0,1,0] op_sel_hi:[1,1,1]" : "+v"(ACC) : "v"(CV), "v"(WW))
#define PB2_PAIRC(VV, WW, HI) do { const f32x2_t l0_ = __builtin_amdgcn_cvt_pk_f32_fp8((VV).x, false), h0_ = __builtin_amdgcn_cvt_pk_f32_fp8((VV).x, true), l1_ = __builtin_amdgcn_cvt_pk_f32_fp8((VV).y, false), h1_ = __builtin_amdgcn_cvt_pk_f32_fp8((VV).y, true); \
        if (HI) { PB2_FMA_HI(acc[0], l0_, WW); PB2_FMA_HI(acc[1], h0_, WW); PB2_FMA_HI(acc[2], l1_, WW); PB2_FMA_HI(acc[3], h1_, WW); } \
        else { PB2_FMA_LO(acc[0], l0_, WW); PB2_FMA_LO(acc[1], h0_, WW); PB2_FMA_LO(acc[2], l1_, WW); PB2_FMA_LO(acc[3], h1_, WW); } } while (0)
#define PB2_ISSUE(V, W) do { _Pragma("unroll") for (int j_ = 0; j_ < 4; ++j_) { V[4 * j_] = *(const LAS v2u*)(W[j_].x & 0x1FFF8u); V[4 * j_ + 1] = *(const LAS v2u*)(W[j_].y & 0x1FFF8u); \
        V[4 * j_ + 2] = *(const LAS v2u*)(W[j_].z & 0x1FFF8u); V[4 * j_ + 3] = *(const LAS v2u*)(W[j_].w & 0x1FFF8u); } } while (0)
#define PB2_COMPUTE(V, W) do { _Pragma("unroll") for (int j_ = 0; j_ < 4; ++j_) { const v2u wxy_ = {W[j_].x, W[j_].y}, wzw_ = {W[j_].z, W[j_].w}; \
            PB2_PAIRC(V[4 * j_], wxy_, 0); PB2_PAIRC(V[4 * j_ + 1], wxy_, 1); PB2_PAIRC(V[4 * j_ + 2], wzw_, 0); PB2_PAIRC(V[4 * j_ + 3], wzw_, 1); } } while (0)
#define PB2_STEP(W, WN, VC, VN, G_) do { PB2_ISSUE(VN, WN); __builtin_amdgcn_sched_barrier(0); PB2_COMPUTE(VC, W); __builtin_amdgcn_sched_barrier(0); PB2_LOADW(W, (G_) + 4); } while (0)
__device__ __forceinline__ void peer_b2(int x, int i, const bf16* h1, const unsigned* pw, bf16* out, int tid_) {
    int tid = tid_; asm volatile("" : "+v"(tid));
    const int lane = tid & 63, wave = __builtin_amdgcn_readfirstlane(tid >> 6);
    const int colb = 256 * x + 8 * i;
    const GAS v4u* pw0 = (const GAS v4u*)(pw + (size_t)wave * (128 * 64)) + lane;
    v4u W0[4], W1[4], W2[4], W3[4];
    v2u VA[16], VB[16];
    PB2_LOADW(W0, 0); PB2_LOADW(W1, 1); PB2_LOADW(W2, 2); PB2_LOADW(W3, 3);
    PB2_ISSUE(VA, W0);
#define PB2_TILE(TL, OV, RO) do { const int T_ = wave + NWAVES * (TL); RO = (size_t)(T_ * 64 + lane) * D + colb; const v4u h = *(const GAS v4u*)(h1 + RO); \
        f32x2_t acc[4]; _Pragma("unroll") for (int c_ = 0; c_ < 4; ++c_) acc[c_] = (f32x2_t){0.f, 0.f}; const int g0 = 8 * (TL); \
        PB2_STEP(W0, W1, VA, VB, g0); PB2_STEP(W1, W2, VB, VA, g0 + 1); PB2_STEP(W2, W3, VA, VB, g0 + 2); PB2_STEP(W3, W0, VB, VA, g0 + 3); \
        PB2_STEP(W0, W1, VA, VB, g0 + 4); PB2_STEP(W1, W2, VB, VA, g0 + 5); PB2_STEP(W2, W3, VA, VB, g0 + 6); PB2_STEP(W3, W0, VB, VA, g0 + 7); \
        OV.x = pk2(pg8::bf_lo(h.x) * ALPHA + acc[0].x, pg8::bf_hi(h.x) * ALPHA + acc[0].y); OV.y = pk2(pg8::bf_lo(h.y) * ALPHA + acc[1].x, pg8::bf_hi(h.y) * ALPHA + acc[1].y); \
        OV.z = pk2(pg8::bf_lo(h.z) * ALPHA + acc[2].x, pg8::bf_hi(h.z) * ALPHA + acc[2].y); OV.w = pk2(pg8::bf_lo(h.w) * ALPHA + acc[3].x, pg8::bf_hi(h.w) * ALPHA + acc[3].y); } while (0)
#pragma unroll 1
    for (int tl = 0; tl < M / 64 / NWAVES; tl += 2) {
        v4u o0, o1; size_t ro0, ro1;
        PB2_TILE(tl, o0, ro0);
        PB2_TILE(tl + 1, o1, ro1);
        *(GAS v4u*)(out + ro0) = o0; *(GAS v4u*)(out + ro1) = o1;
    }
}
__device__ __forceinline__ void peer_c2_row(int t, const bf16* r2, float* out, const float* g2, const float* b2, int lane) {
    const GAS v4u* xr = (const GAS v4u*)(r2 + (size_t)t * D) + lane;
    v4u w[4]; float sm = 0.f;
#pragma unroll
    for (int j = 0; j < 4; ++j) { w[j] = xr[64 * j]; sm += (pg8::bf_lo(w[j].x) + pg8::bf_hi(w[j].x)) + (pg8::bf_lo(w[j].y) + pg8::bf_hi(w[j].y)) + (pg8::bf_lo(w[j].z) + pg8::bf_hi(w[j].z)) + (pg8::bf_lo(w[j].w) + pg8::bf_hi(w[j].w)); }
    const float mean = wave_sum(sm) * (1.f / D);
    float sq = 0.f;
#pragma unroll
    for (int j = 0; j < 4; ++j) { float d;
        d = pg8::bf_lo(w[j].x) - mean; sq += d * d; d = pg8::bf_hi(w[j].x) - mean; sq += d * d; d = pg8::bf_lo(w[j].y) - mean; sq += d * d; d = pg8::bf_hi(w[j].y) - mean; sq += d * d;
        d = pg8::bf_lo(w[j].z) - mean; sq += d * d; d = pg8::bf_hi(w[j].z) - mean; sq += d * d; d = pg8::bf_lo(w[j].w) - mean; sq += d * d; d = pg8::bf_hi(w[j].w) - mean; sq += d * d; }
    const float rstd = 1.f / sqrtf(wave_sum(sq) * (1.f / D) + LN_EPS);
    GAS f32x4* op = (GAS f32x4*)(out + (size_t)t * D);
#pragma unroll
    for (int j = 0; j < 4; ++j) { const int c4 = 2 * (lane + 64 * j);
        const f32x4 g0 = *((const GAS f32x4*)g2 + c4), g1 = *((const GAS f32x4*)g2 + c4 + 1), b0 = *((const GAS f32x4*)b2 + c4), b1 = *((const GAS f32x4*)b2 + c4 + 1);
        const f32x4 v0 = (f32x4){pg8::bf_lo(w[j].x), pg8::bf_hi(w[j].x), pg8::bf_lo(w[j].y), pg8::bf_hi(w[j].y)}, v1 = (f32x4){pg8::bf_lo(w[j].z), pg8::bf_hi(w[j].z), pg8::bf_lo(w[j].w), pg8::bf_hi(w[j].w)};
        op[c4] = (v0 - mean) * rstd * g0 + b0; op[c4 + 1] = (v1 - mean) * rstd * g1 + b1; }
}
__device__ __forceinline__ void peer_c2_row_h(int t, const bf16* r2, float* out, const f32x4 (&G0)[4], const f32x4 (&G1)[4], const f32x4 (&B0)[4], const f32x4 (&B1)[4], int lane) {
    const GAS v4u* xr = (const GAS v4u*)(r2 + (size_t)t * D) + lane;
    v4u w[4]; float sm = 0.f;
#pragma unroll
    for (int j = 0; j < 4; ++j) { w[j] = xr[64 * j]; sm += (pg8::bf_lo(w[j].x) + pg8::bf_hi(w[j].x)) + (pg8::bf_lo(w[j].y) + pg8::bf_hi(w[j].y)) + (pg8::bf_lo(w[j].z) + pg8::bf_hi(w[j].z)) + (pg8::bf_lo(w[j].w) + pg8::bf_hi(w[j].w)); }
    const float mean = wave_sum(sm) * (1.f / D);
    float sq = 0.f;
#pragma unroll
    for (int j = 0; j < 4; ++j) { float d;
        d = pg8::bf_lo(w[j].x) - mean; sq += d * d; d = pg8::bf_hi(w[j].x) - mean; sq += d * d; d = pg8::bf_lo(w[j].y) - mean; sq += d * d; d = pg8::bf_hi(w[j].y) - mean; sq += d * d;
        d = pg8::bf_lo(w[j].z) - mean; sq += d * d; d = pg8::bf_hi(w[j].z) - mean; sq += d * d; d = pg8::bf_lo(w[j].w) - mean; sq += d * d; d = pg8::bf_hi(w[j].w) - mean; sq += d * d; }
    const float rstd = 1.f / sqrtf(wave_sum(sq) * (1.f / D) + LN_EPS);
    GAS f32x4* op = (GAS f32x4*)(out + (size_t)t * D);
#pragma unroll
    for (int j = 0; j < 4; ++j) { const int c4 = 2 * (lane + 64 * j);
        const f32x4 g0 = G0[j], g1 = G1[j], b0 = B0[j], b1 = B1[j];
        const f32x4 v0 = (f32x4){pg8::bf_lo(w[j].x), pg8::bf_hi(w[j].x), pg8::bf_lo(w[j].y), pg8::bf_hi(w[j].y)}, v1 = (f32x4){pg8::bf_lo(w[j].z), pg8::bf_hi(w[j].z), pg8::bf_lo(w[j].w), pg8::bf_hi(w[j].w)};
        op[c4] = (v0 - mean) * rstd * g0 + b0; op[c4 + 1] = (v1 - mean) * rstd * g1 + b1; }
}
__device__ __forceinline__ void peer_c_row(int t, const bf16* r2, float* out, const float* st, const float* g2, const float* b2, int lane) {
    float sm = 0.f, sq = 0.f;
#pragma unroll
    for (int s = 0; s < 8; ++s) { sm += st[((size_t)t * 8 + s) * 2]; sq += st[((size_t)t * 8 + s) * 2 + 1]; }
    const float mean = sm * (1.f / D), var = sq * (1.f / D) - mean * mean, rstd = 1.f / sqrtf(fmaxf(var, 0.f) + LN_EPS);
    const GAS v4u* xr = (const GAS v4u*)(r2 + (size_t)t * D) + lane;
    GAS f32x4* op = (GAS f32x4*)(out + (size_t)t * D);
#pragma unroll
    for (int j = 0; j < 4; ++j) { const v4u w = xr[64 * j]; const int c4 = 2 * (lane + 64 * j);
        const f32x4 g0 = *((const GAS f32x4*)g2 + c4), g1 = *((const GAS f32x4*)g2 + c4 + 1), b0 = *((const GAS f32x4*)b2 + c4), b1 = *((const GAS f32x4*)b2 + c4 + 1);
        const f32x4 v0 = (f32x4){pg8::bf_lo(w.x), pg8::bf_hi(w.x), pg8::bf_lo(w.y), pg8::bf_hi(w.y)}, v1 = (f32x4){pg8::bf_lo(w.z), pg8::bf_hi(w.z), pg8::bf_lo(w.w), pg8::bf_hi(w.w)};
        op[c4] = (v0 - mean) * rstd * g0 + b0; op[c4 + 1] = (v1 - mean) * rstd * g1 + b1; }
}

struct TwoPassOrder : pg8::StaticOrder {
    __device__ __forceinline__ bool next(int i, pg8::Unit& u) const { if (!pg8::StaticOrder::next(i >> 1, u)) return false; u.w = i & 1; return true; }
};
struct EpiGate2 {
    static constexpr bool PERM = true, AFTER_DRAIN = false;
    pg8::EpiGate<0> e0; pg8::EpiGate<1> e1;
    __device__ __forceinline__ void operator()(const pg8::f32x4 (&acc)[2][2][4][2], const pg8::Unit& u, int wr, int wc, int fr, int fq) const { if (u.w == 0) e0(acc, u, wr, wc, fr, fq); else e1(acc, u, wr, wc, fr, fq); }
};

struct EpiGate2I8 {
    static constexpr bool PERM = true, AFTER_DRAIN = false;
    pg8::EpiGateI8<0> e0; pg8::EpiGateI8<1> e1;
    __device__ __forceinline__ void operator()(const pg8::i32x4 (&acc)[2][2][4][2], const pg8::Unit& u, int wr, int wc, int fr, int fq) const { if (u.w == 0) e0(acc, u, wr, wc, fr, fq); else e1(acc, u, wr, wc, fr, fq); }
};
struct ConvOrder : pg8::StaticOrder {
    const float* pu; const float* pv; unsigned char* u8; unsigned char* v8; float* su; float* sv; int slot; mutable int calls;
    static constexpr int CONV_ROWS = 2, CONV_CALLS = 6;
    __device__ __forceinline__ void done(const pg8::Unit&) const {
        if (slot < 0) return;
        int lane = threadIdx.x & 63; asm volatile("" : "+v"(lane));
        const int wave = __builtin_amdgcn_readfirstlane(threadIdx.x >> 6);
        const int base = ((slot * NWAVES + wave) * CONV_CALLS + calls) * CONV_ROWS;
        if (calls < CONV_CALLS) {
#pragma unroll 1
            for (int j = 0; j < CONV_ROWS; ++j) { const int r = base + j; if (r < PNE) row_to_i8(pu + (size_t)r * D, u8 + (size_t)r * 256, su + r, lane); }
        }
        ++calls;
    }
};

struct Args { const float* in[16]; float* out; unsigned char* ws; int ph_lo, ph_hi; };
__global__ void __launch_bounds__(NTHREADS, 2) mk_fwd(Args args) {
    extern __shared__ __attribute__((aligned(16))) unsigned char lds_raw[];
    LAS unsigned char* lds = (LAS unsigned char*)lds_raw;
    volatile LAS unsigned* MISC = (volatile LAS unsigned*)(lds + MISC_OFF);
    const int tid0 = threadIdx.x;
    const int G = gridDim.x, bx = blockIdx.x;
    unsigned char* ws = args.ws;
    gu32* ctl = (gu32*)(ws + WS_CTL);
#define IN_(i) (args.in[i])
#define x_in IN_(0)
#define w_in IN_(1)
#define b_gate IN_(2)
#define sinks IN_(3)
#define conv_w IN_(4)
#define w_ao IN_(5)
#define w_co IN_(6)
#define w_o IN_(7)
#define ln1_g IN_(8)
#define ln1_b IN_(9)
#define w_q IN_(10)
#define sub_keys IN_(11)
#define peer_u IN_(12)
#define peer_v IN_(13)
#define ln2_g IN_(14)
#define ln2_b IN_(15)
#define WinT ((bf16*)(ws + WS_WIN))
#define WaT ((bf16*)(ws + WS_WA))
#define WcT ((bf16*)(ws + WS_WC))
#define WoT ((bf16*)(ws + WS_WO))
#define WfT ((bf16*)(ws + WS_WF))
#define XB ((bf16*)(ws + WS_XB))
#define MERGED ((bf16*)(ws + WS_MERGED))
#define Z ((bf16*)(ws + WS_Z))
#define R2B ((bf16*)(ws + WS_R2B))
#define H1B ((bf16*)(ws + WS_H1B))
#define SC ((float*)(ws + WS_SC))
#define EX ((int*)(ws + WS_EX))
#define GT ((float*)(ws + WS_GT))
#define AO ((bf16*)(ws + WS_AO))
#define CI ((bf16*)(ws + WS_CI))
#define TMP ((bf16*)(ws + WS_TMP))
#define U8 ((unsigned char*)(ws + WS_U8))
#define V8 ((unsigned char*)(ws + WS_V8))
#define SU ((float*)(ws + WS_SU))
#define SV ((float*)(ws + WS_SV))
#define PA ((int*)(ws + WS_PA))
#define ST ((float*)(ws + WS_ST))
#define WB ((float*)(ws + WS_WB))
#define XA8 ((signed char*)(ws + WS_XA8))
#define WIN8 ((signed char*)(ws + WS_WIN8))
#define SWIN ((float*)(ws + WS_SWIN))
#define SXA ((float*)(ws + WS_SXA))
#define WF8 ((signed char*)(ws + WS_WF8))
#define MG8 ((signed char*)(ws + WS_MG8))
#define WO8 ((signed char*)(ws + WS_WO8))
#define SMG ((float*)(ws + WS_SMG))
#define SWO ((float*)(ws + WS_SWO))
#define AO8 ((signed char*)(ws + WS_AO8))
#define CI8 ((signed char*)(ws + WS_CI8))
#define WA8 ((signed char*)(ws + WS_WA8))
#define WC8 ((signed char*)(ws + WS_WC8))
#define SAO ((float*)(ws + WS_S3))
#define SCI ((float*)(ws + WS_S3 + 65536))
#define SWA ((float*)(ws + WS_S3 + 131072))
#define SWC ((float*)(ws + WS_S3 + 196608))
#define SWF ((float*)(ws + WS_SWF))
#define XQ ((signed char*)(ws + WS_XQ))
#define SX ((float*)(ws + WS_SX))
#define SEG ((unsigned*)(ws + WS_SEG))
#define V8T ((unsigned char*)(ws + WS_V8T))
#define SOFF ((int*)(ws + WS_SOFF))
    for (int u = tid0; u < (LDS_BYTES - LDSCTL_OFF) / 4; u += NTHREADS) ((LAS unsigned*)(lds + LDSCTL_OFF))[u] = 0u;
    __syncthreads();
    XcdBarrier bar; bar.bar = (unsigned*)(ctl + CW_BAR); bar.x = 0; bar.st = nullptr;
    if (!MK_PER_PHASE) bar = xcd_barrier_post((unsigned*)(ctl + CW_BAR), MISC + 8);
    const int lo = args.ph_lo, hi = args.ph_hi;
#ifndef PH_MASK
#define PH_MASK 0xFFF
#endif
#define IN(k) (((PH_MASK >> (k)) & 1) && lo <= (k) && (k) < hi)
#ifndef DBL_BAR
#define DBL_BAR 0
#endif
#define SEAM(k) do { if (IN(k) && IN((k) + 1)) { xcd_barrier(bar); if (DBL_BAR) xcd_barrier(bar); } } while (0)
#ifndef DBL_MASK
#define DBL_MASK 0
#endif
#define REP(k) for (int rep_ = 0; rep_ < 1 + ((DBL_MASK >> (k)) & 1); ++rep_)
#define PHASE_TID() int tid = tid0; asm volatile("" : "+v"(tid)); const int lane = tid & 63, wave = __builtin_amdgcn_readfirstlane(tid >> 6); (void)lane; (void)wave

    if (IN(0)) REP(0) {
        PHASE_TID();
        const bool conv_first = ((bx >> 3) & 1) == 0;
#pragma unroll 1
        for (int part = 0; part < 2; ++part) {
            if ((part == 0) == conv_first) {
                int tid = tid0; asm volatile("" : "+v"(tid)); const int lane = tid & 63, wave = __builtin_amdgcn_readfirstlane(tid >> 6);
                LAS float* scr = (LAS float*)(lds + wave * 16384);
                const int gw = bx * NWAVES + wave, NGW = G * NWAVES;
                constexpr int I_IN = (D / 64) * (IN_W / 32), I_SQ = (D / 64) * (D / 32);
                for (int it = gw; it < I_IN + 3 * I_SQ; it += NGW) {
                    int r = it;
                    if (r < I_IN) { p0_transpose_item<true>(w_in, D, IN_W, WinT, scr, r, lane); continue; } r -= I_IN;
                    if (r < I_SQ) { p0_transpose_item(w_ao, D, D, WaT, scr, r, lane); continue; } r -= I_SQ;
                    if (r < I_SQ) { p0_transpose_item(w_co, D, D, WcT, scr, r, lane); continue; } r -= I_SQ;
                    p0_transpose_item(w_o, D, D, WoT, scr, r, lane);
                }
                for (int r = gw; r < M; r += NGW) row_f32_to_i8(x_in + (size_t)r * D, XA8 + (size_t)r * D, SXA + r, lane);
                __syncthreads();
            }
            if (part == 0) for (int it = bx; it < 16 * 32; it += G) p0_wf_item(w_q, sub_keys, WfT, lds, it, tid);
        }
    }
    SEAM(0);
    if (IN(1)) REP(1) {
        { PHASE_TID();
          for (int r = bx * NWAVES + wave; r < IN_W + 2 * D; r += G * NWAVES) { if (r < IN_W) row_bf16_to_i8(WinT + (size_t)r * D, WIN8 + (size_t)r * D, SWIN + r, lane);
              else if (r < IN_W + D) { const int q = r - IN_W; row_bf16_to_i8(WfT + (size_t)q * D, WF8 + (size_t)q * D, SWF + q, lane); }
              else { const int q = r - IN_W - D; row_bf16_to_i8(WoT + (size_t)q * D, WO8 + (size_t)q * D, SWO + q, lane); } } }
        if (!MK_PER_PHASE) xcd_barrier(bar);
        pg8::Gemm g{(const bf16*)XA8, (const bf16*)WIN8, M, IN_W, D / 2}; ConvOrder S; S.init(M, IN_W, G, bx);
        S.pu = peer_u; S.pv = peer_v; S.u8 = U8; S.v8 = V8; S.su = SU; S.sv = SV; S.calls = 0;
        S.slot = (G == 256 && bx >= 64) ? bx - 64 : -1;
        pg8::EpiI8Bf16Z E{Z, IN_W, SXA, SWIN};
        pg8::gemm_phase<pg8::EpiI8Bf16Z, ConvOrder, true, true, true>(lds, g, S, E);
        if (G != 256) {
            PHASE_TID();
            for (int r = bx * NWAVES + wave; r < 2 * PNE; r += G * NWAVES) { const bool sec = r >= PNE; const int e = sec ? r - PNE : r;
                if (sec) row_to_fp8(peer_v + (size_t)e * D, V8 + (size_t)e * 256, SV + e, lane); else row_to_i8(peer_u + (size_t)e * D, U8 + (size_t)e * 256, SU + e, lane); }
        }
    }
    SEAM(1);
    if (IN(2)) REP(2) {
        PHASE_TID();
        const bool conv_first = ((bx >> 3) & 1) == 0;
#pragma unroll 1
        for (int part = 0; part < 2; ++part) {
            if ((part == 0) == conv_first) { int t2 = tid0; asm volatile("" : "+v"(t2)); for (int it = bx; it < M / 32; it += G) conv_item(it, Z, conv_w, CI, t2); }
            if (part == 0) for (int u = bx; u < BATCH * NKVH * 16; u += G) attn_unit(u, Z, AO, sinks, lds, tid);
        }
    }
    SEAM(2);
    if (IN(3)) REP(3) {
        TwoPassOrder S; S.init(M, D, G, bx);
#ifndef P3_I8
#define P3_I8 1
#endif
        if (P3_I8 && !MK_PER_PHASE) {
            { PHASE_TID();
              for (int r = bx * NWAVES + wave; r < 2 * M + 2 * D; r += G * NWAVES) {
                  if (r < M) row_bf16_to_i8(AO + (size_t)r * D, AO8 + (size_t)r * D, SAO + r, lane);
                  else if (r < 2 * M) { const int q = r - M; row_bf16_to_i8(CI + (size_t)q * D, CI8 + (size_t)q * D, SCI + q, lane); }
                  else if (r < 2 * M + D) { const int q = r - 2 * M; row_bf16_to_i8(WaT + (size_t)q * D, WA8 + (size_t)q * D, SWA + q, lane); }
                  else { const int q = r - 2 * M - D; row_bf16_to_i8(WcT + (size_t)q * D, WC8 + (size_t)q * D, SWC + q, lane); } } }
            xcd_barrier(bar);
            pg8::Gemm g{(const bf16*)AO8, (const bf16*)WA8, M, D, D / 2, (const bf16*)CI8, (const bf16*)WC8};
            EpiGate2I8 E{pg8::EpiGateI8<0>{TMP, nullptr, Z + G_OFF, b_gate, D, IN_W, SAO, SWA}, pg8::EpiGateI8<1>{MERGED, TMP, Z + G_OFF + D, b_gate + D, D, IN_W, SCI, SWC}};
            pg8::gemm_phase<EpiGate2I8, TwoPassOrder, true, true, true>(lds, g, S, E);
        } else {
        pg8::Gemm g{AO, WaT, M, D, D, CI, WcT};
        EpiGate2 E{pg8::EpiGate<0>{TMP, nullptr, Z + G_OFF, b_gate, D, IN_W}, pg8::EpiGate<1>{MERGED, TMP, Z + G_OFF + D, b_gate + D, D, IN_W}};
        pg8::gemm_phase<EpiGate2, TwoPassOrder, true, true>(lds, g, S, E);
        }
    }
    SEAM(3);
    if (IN(4)) REP(4) {
        pg8::StaticOrder S; S.init(M, D, G, bx);
#ifndef P4_I8
#define P4_I8 1
#endif
        if (P4_I8 && !MK_PER_PHASE) {
            { PHASE_TID(); for (int r = bx * NWAVES + wave; r < M; r += G * NWAVES) row_bf16_to_i8(MERGED + (size_t)r * D, MG8 + (size_t)r * D, SMG + r, lane); }
            xcd_barrier(bar);
            pg8::Gemm g{(const bf16*)MG8, (const bf16*)WO8, M, D, D / 2};
            pg8::EpiResI8Bf16 E{H1B, D, x_in, ALPHA, SMG, SWO};
            pg8::gemm_phase<pg8::EpiResI8Bf16, pg8::StaticOrder, true, true, true>(lds, g, S, E);
        } else {
        pg8::Gemm g{MERGED, WoT, M, D, D};
        pg8::EpiResBf16 E{H1B, D, x_in, ALPHA};
        pg8::gemm_phase<pg8::EpiResBf16, pg8::StaticOrder, true, true>(lds, g, S, E);
        }
    }
    SEAM(4);
    if (IN(5)) REP(5) {
        PHASE_TID();
        const int gw = bx * NWAVES + wave, NGW = G * NWAVES;
        f32x4 G0[4], G1[4], B0[4], B1[4];
#pragma unroll
        for (int j = 0; j < 4; ++j) { const GAS f32x4* gp = (const GAS f32x4*)ln1_g + 2 * (lane + 64 * j); const GAS f32x4* bp = (const GAS f32x4*)ln1_b + 2 * (lane + 64 * j); G0[j] = gp[0]; G1[j] = gp[1]; B0[j] = bp[0]; B1[j] = bp[1]; }
        for (int m = gw; m < M; m += NGW) ln1_row_h(H1B + (size_t)m * D, XQ + (size_t)m * D, SX + m, G0, G1, B0, B1, lane);
    }
    SEAM(5);
    if (IN(6)) REP(6) {
        pg8::Gemm g{H1B, WfT, M, D, D}; pg8::StaticOrder S; S.init(M, D, G, bx);
#ifndef P6_I8
#define P6_I8 1
#endif
        if (G == 256 && P6_I8) { pg8::Gemm g8{(const bf16*)XQ, (const bf16*)WF8, M, D, D / 2}; EpiTopKI8 E{EX, GT, SX, SWF}; pg8::gemm_phase<EpiTopKI8, pg8::StaticOrder, false, true, true>(lds, g8, S, E); }
        else if (G == 256) { EpiTopK E{EX, GT}; pg8::gemm_phase<EpiTopK, pg8::StaticOrder, false, true>(lds, g, S, E); }
        else { pg8::EpiF32 E{SC, D, nullptr, 0.f}; pg8::gemm_phase<pg8::EpiF32, pg8::StaticOrder, true, true>(lds, g, S, E); }
    }
    SEAM(6);
    if (IN(7)) REP(7) {
        PHASE_TID();
        if (G != 256) for (int p = bx; p < (M * PH) / 128; p += G) topk_pass(p, SC, EX, GT, lds, tid);
        else { if (bx < 2 * T3_NCH) peer_bucket3(bx, EX, SEG, SOFF, lds, tid, bx & 7, bx >> 3, U8);
               else peer_shard_load(bx & 7, bx >> 3, U8, lds, tid); }
    }
    SEAM(7);
    if (IN(8)) REP(8) {
        PHASE_TID();
        if (G == 256) peer_a_lds3(bx & 7, XQ, SEG, SOFF, bx >> 3, PA, lds, tid, peer_v, V8, SV, bx * 64, V8T);
        else {
        const int xcc = (int)(xb_xcc_id() & 7u);
#pragma unroll 1
#ifndef SCRAMBLE
#define SCRAMBLE 0
#endif
        for (int sl = 0; sl < 8; ++sl) { const int s = (xcc + sl + (SCRAMBLE ? wave : 0)) & 7;
            for (;;) { const int tg = q_pull((unsigned*)(ctl + CW_Q + 64 * (s + 16 * rep_)), lane); if (tg >= PEER_NTASK) break;
                int t0, nt; peer_task_tokens(tg, t0, nt); peer_a_task(t0, nt, s, XQ, EX, U8, PA, lane); } }
        }
    }
    SEAM(8);
    if (IN(9)) REP(9) {
        PHASE_TID();
        if (G == 256) peer_w_pack(bx, EX, GT, SU, SV, SX, PA, (unsigned*)WB, V8T, lds, tid);
        else
        for (size_t i = (size_t)bx * NTHREADS + tid; i < (size_t)M * 128; i += (size_t)G * NTHREADS) peer_w_elem(i, EX, GT, SU, SV, SX, PA, WB);
    }
    SEAM(9);
    if (IN(10)) REP(10) {
        PHASE_TID();
        if (G == 256) { __syncthreads(); peer_b2(bx & 7, bx >> 3, H1B, (const unsigned*)WB, R2B, tid); }
        else {
        const int xcc = (int)(xb_xcc_id() & 7u);
#pragma unroll 1
#ifndef SCRAMBLE
#define SCRAMBLE 0
#endif
        for (int sl = 0; sl < 8; ++sl) { const int s = (xcc + sl + (SCRAMBLE ? wave : 0)) & 7;
            for (;;) { const int tg = q_pull((unsigned*)(ctl + CW_Q + 64 * (8 + s + 16 * rep_)), lane); if (tg >= PEER_NTASK) break;
                int t0, nt; peer_task_tokens(tg, t0, nt); peer_b_task(t0, nt, s, H1B, EX, WB, V8, R2B, ST, lane); } }
        }
    }
    SEAM(10);
    if (IN(11)) REP(11) {
        PHASE_TID();
        const int gw = bx * NWAVES + wave, NGW = G * NWAVES;
        if (G == 256) { f32x4 G0[4], G1[4], B0[4], B1[4];
#pragma unroll
            for (int j = 0; j < 4; ++j) { const GAS f32x4* gp = (const GAS f32x4*)ln2_g + 2 * (lane + 64 * j); const GAS f32x4* bp = (const GAS f32x4*)ln2_b + 2 * (lane + 64 * j); G0[j] = gp[0]; G1[j] = gp[1]; B0[j] = bp[0]; B1[j] = bp[1]; }
            for (int t = gw; t < M; t += NGW) peer_c2_row_h(t, R2B, args.out, G0, G1, B0, B1, lane); }
        else for (int t = gw; t < M; t += NGW) peer_c_row(t, R2B, args.out, ST, ln2_g, ln2_b, lane);
    }
#undef IN
#undef SEAM
}

extern "C" void kernel_launch(void* const* d_in, const int* in_sizes, int n_in, void* d_out, int out_size, void* d_ws, size_t ws_size, hipStream_t stream) {
    static int grid = 0;
    if (grid == 0) {
        if (n_in != 16 || out_size != M * D || ws_size < WS_END) { fprintf(stderr, "kernel_launch: unexpected shapes (n_in %d out %d ws %zu)\n", n_in, out_size, ws_size); grid = -1; return; }
        int dev = 0, cus = 0, per_cu = 0;
        if (hipGetDevice(&dev) != hipSuccess || hipDeviceGetAttribute(&cus, hipDeviceAttributeMultiprocessorCount, dev) != hipSuccess) { grid = -1; return; }
        if (hipFuncSetAttribute((const void*)mk_fwd, hipFuncAttributeMaxDynamicSharedMemorySize, LDS_BYTES) != hipSuccess) { fprintf(stderr, "kernel_launch: hipFuncSetAttribute failed\n"); grid = -1; return; }
        if (hipOccupancyMaxActiveBlocksPerMultiprocessor(&per_cu, (const void*)mk_fwd, NTHREADS, LDS_BYTES) != hipSuccess || per_cu < 1) { fprintf(stderr, "kernel_launch: occupancy query says %d\n", per_cu); per_cu = 1; }
        (void)hipGetLastError();
        if (per_cu > 1) per_cu = 1;
        grid = cus * per_cu;
    }
    if (grid < 0) return;
    if (hipMemsetAsync((char*)d_ws + WS_CTL, 0, CTL_ZERO_BYTES, stream) != hipSuccess) { fprintf(stderr, "kernel_launch: memset failed\n"); return; }
    Args a{};
    for (int i = 0; i < 16; ++i) a.in[i] = (const float*)d_in[i];
    a.out = (float*)d_out; a.ws = (unsigned char*)d_ws;
#if MK_PER_PHASE
    for (int p = 0; p < N_PHASES; ++p) { a.ph_lo = p; a.ph_hi = p + 1; hipLaunchKernelGGL(mk_fwd, dim3(grid), dim3(NTHREADS), LDS_BYTES, stream, a); }
#else
    a.ph_lo = 0; a.ph_hi = N_PHASES;
    void* kargs[] = {&a};
#ifdef PLAIN_LAUNCH
    (void)kargs; hipLaunchKernelGGL(mk_fwd, dim3(grid), dim3(NTHREADS), LDS_BYTES, stream, a); hipError_t e = hipPeekAtLastError();
#else
    hipError_t e = hipLaunchCooperativeKernel((const void*)mk_fwd, dim3(grid), dim3(NTHREADS), kargs, LDS_BYTES, stream);
#endif
    if (e != hipSuccess) fprintf(stderr, "kernel_launch: cooperative launch failed: %s (grid %d)\n", hipGetErrorString(e), grid);
#endif
}
```
